# Optimizing an MI355X kernel written in HIP

```python
import math
import jax, jax.numpy as jnp
from jax import lax
import numpy as np

D_MODEL = 1024
BATCH = 8
SEQ = 4096
DEPTH = 1

N_META = 16
ATT_HEADS = 4
ATT_HEAD_DIM = 64
ATT_V_DIM = 2 * ATT_HEAD_DIM
REC_HEADS = 4
REC_DK = 128
REC_DV = 128
ATT_WIDTH = ATT_HEADS * ATT_V_DIM
REC_WIDTH = REC_HEADS * REC_DV
MIX_WIDTH = ATT_WIDTH + REC_WIDTH
COL_SIZES = (
    ATT_HEADS * 2 * ATT_HEAD_DIM,
    ATT_HEADS * 2 * ATT_HEAD_DIM,
    ATT_WIDTH,
    REC_HEADS * REC_DK,
    REC_HEADS * REC_DK,
    REC_WIDTH,
    REC_WIDTH,
)
IN_COLS = sum(COL_SIZES)
SPLIT_POINTS = tuple(int(v) for v in np.cumsum(COL_SIZES)[:-1])
Q_BLOCK = 128
REC_CHUNK = 64
ROPE_THETA = 10000.0
PEER_HEADS = 8
PEER_QUERY_DIM = 256
N_KEYS = 128
N_EXPERTS = N_KEYS * N_KEYS
PEER_TOPK = 16
PEER_BLOCK = 128
EPS = 1e-6

kernel_name = "hymba_diffattn_hgrn2_peer"


def rmsnorm(x, w):
    xf = x.astype(jnp.float32)
    y = xf * lax.rsqrt(jnp.mean(xf * xf, axis=-1, keepdims=True) + EPS)
    return (y * w.astype(jnp.float32)).astype(x.dtype)


def rope_tables(T, d):
    inv_freq = ROPE_THETA ** (-jnp.arange(0, d, 2, dtype=jnp.float32) / d)
    ang = jnp.arange(T, dtype=jnp.float32)[:, None] * inv_freq[None, :]
    ang = jnp.concatenate([ang, ang], axis=-1)
    return jnp.cos(ang), jnp.sin(ang)


def apply_rope(z, cos, sin):
    half = z.shape[-1] // 2
    rot = jnp.concatenate([-z[..., half:], z[..., :half]], axis=-1)
    return (z * cos.astype(z.dtype) + rot * sin.astype(z.dtype)).astype(z.dtype)


def lambda_init(layer_idx):
    return 0.8 - 0.6 * math.exp(-0.3 * layer_idx)


def diff_attention(aq, ak, av, lq1, lk1, lq2, lk2, subln_w, lam_init, cos, sin):
    B, T, _ = aq.shape
    q = apply_rope(aq.reshape(B, T, ATT_HEADS, 2, ATT_HEAD_DIM).transpose(3, 0, 2, 1, 4), cos, sin)
    k = apply_rope(ak.reshape(B, T, ATT_HEADS, 2, ATT_HEAD_DIM).transpose(3, 0, 2, 1, 4), cos, sin)
    v = av.reshape(B, T, ATT_HEADS, ATT_V_DIM).transpose(0, 2, 1, 3)
    q = q * (ATT_HEAD_DIM ** -0.5)
    lam = (jnp.exp(jnp.sum(lq1.astype(jnp.float32) * lk1.astype(jnp.float32)))
           - jnp.exp(jnp.sum(lq2.astype(jnp.float32) * lk2.astype(jnp.float32))) + lam_init)
    neg = jnp.finfo(jnp.float32).min

    def block(q_blk, k_blk, v_blk, q_start):
        nq, nk = q_blk.shape[-2], k_blk.shape[-2]
        mask = jnp.arange(nk)[None, :] <= (q_start + jnp.arange(nq))[:, None]
        s = jnp.einsum('pbhqd,pbhkd->pbhqk', q_blk, k_blk).astype(jnp.float32)
        p = jax.nn.softmax(jnp.where(mask, s, neg), axis=-1)
        w = p[0] - lam * p[1]
        return jnp.einsum('bhqk,bhkv->bhqv', w.astype(v_blk.dtype), v_blk)

    outs = [block(q[..., :N_META, :], k[..., :N_META, :], v[:, :, :N_META], 0)]
    for i in range((T - N_META) // Q_BLOCK):
        s0 = N_META + i * Q_BLOCK
        e0 = s0 + Q_BLOCK
        outs.append(block(q[..., s0:e0, :], k[..., :e0, :], v[:, :, :e0], s0))
    o = jnp.concatenate(outs, axis=2)
    o = rmsnorm(o, subln_w) * (1.0 - lam_init)
    return o.transpose(0, 2, 1, 3).reshape(B, T, ATT_WIDTH)


def gla_chunk(S, q, k, v, g):
    C = q.shape[2]
    cum = jnp.cumsum(g, axis=2)
    inter = jnp.einsum('bhtc,bhcv->bhtv', q * jnp.exp(cum), S)
    causal = jnp.tril(jnp.ones((C, C), dtype=bool))[:, :, None]
    diff = cum[:, :, :, None, :] - cum[:, :, None, :, :]
    decay = jnp.where(causal, jnp.exp(jnp.where(causal, diff, 0.0)), 0.0)
    A = jnp.einsum('bhtc,bhsc,bhtsc->bhts', q, k, decay)
    intra = jnp.einsum('bhts,bhsv->bhtv', A, v)
    last = cum[:, :, -1]
    S_new = (jnp.exp(last)[..., None] * S
             + jnp.einsum('bhsc,bhsv->bhcv', k * jnp.exp(last[:, :, None, :] - cum), v))
    return S_new, inter + intra


def hgrn2(rq, rf, ri, rg, lb, norm_w):
    B, T, _ = rq.shape

    def heads(z, d):
        return z.reshape(B, T, REC_HEADS, d).transpose(0, 2, 1, 3).astype(jnp.float32)

    q = jax.nn.silu(heads(rq, REC_DK))
    lbh = lb.reshape(REC_HEADS, 1, REC_DK)
    f = lbh + (1.0 - lbh) * jax.nn.sigmoid(heads(rf, REC_DK))
    k = 1.0 - f
    g = jnp.log(f)
    v = heads(ri, REC_DV)
    S0 = jnp.zeros((B, REC_HEADS, REC_DK, REC_DV), jnp.float32)
    S_meta, o_meta = gla_chunk(S0, q[:, :, :N_META], k[:, :, :N_META], v[:, :, :N_META], g[:, :, :N_META])
    n_chunks = (T - N_META) // REC_CHUNK

    def to_chunks(z):
        z = z[:, :, N_META:].reshape(B, REC_HEADS, n_chunks, REC_CHUNK, z.shape[-1])
        return z.transpose(2, 0, 1, 3, 4)

    _, o_real = lax.scan(lambda S, xs: gla_chunk(S, *xs), S_meta,
                         (to_chunks(q), to_chunks(k), to_chunks(v), to_chunks(g)))
    o_real = o_real.transpose(1, 2, 0, 3, 4).reshape(B, REC_HEADS, T - N_META, REC_DV)
    o = jnp.concatenate([o_meta, o_real], axis=2)
    o = rmsnorm(o, norm_w[:, None, :])
    o = o.transpose(0, 2, 1, 3).reshape(B, T, REC_WIDTH) * jax.nn.silu(rg.astype(jnp.float32))
    return o.astype(rq.dtype)


def token_mix(a, w_in, lb, rec_norm_w, lq1, lk1, lq2, lk2, subln_w, w_out, lam_init, cos, sin):
    proj = jnp.einsum('btd,dc->btc', a, w_in)
    aq, ak, av, rq, rf, ri, rg = jnp.split(proj, SPLIT_POINTS, axis=-1)
    att = diff_attention(aq, ak, av, lq1, lk1, lq2, lk2, subln_w, lam_init, cos, sin)
    rec = hgrn2(rq, rf, ri, rg, lb, rec_norm_w)
    mixed = jnp.concatenate([att, rec.astype(att.dtype)], axis=-1)
    return jnp.einsum('btc,cd->btd', mixed, w_out)


def peer_ffn(h, w_query, subkeys, u_table, v_table):
    B, T, D = h.shape
    n = B * T
    pad = (-n) % PEER_BLOCK
    blocks = jnp.pad(h.reshape(n, D), ((0, pad), (0, 0))).reshape(-1, PEER_BLOCK, D)

    def one_block(xb):
        q = jnp.einsum('nd,dc->nc', xb, w_query).reshape(PEER_BLOCK, PEER_HEADS, 2, PEER_QUERY_DIM // 2)
        s = jnp.einsum('nhpc,hpkc->nhpk', q, subkeys).astype(jnp.float32)
        sv, si = lax.top_k(s, PEER_TOPK)
        cand_s = (sv[:, :, 0, :, None] + sv[:, :, 1, None, :]).reshape(PEER_BLOCK, PEER_HEADS, PEER_TOPK * PEER_TOPK)
        cand_i = (si[:, :, 0, :, None] * N_KEYS + si[:, :, 1, None, :]).reshape(PEER_BLOCK, PEER_HEADS, PEER_TOPK * PEER_TOPK)
        top_s, pos = lax.top_k(cand_s, PEER_TOPK)
        experts = jnp.take_along_axis(cand_i, pos, axis=-1).reshape(PEER_BLOCK, PEER_HEADS * PEER_TOPK)
        gates = jax.nn.softmax(top_s, axis=-1).reshape(PEER_BLOCK, PEER_HEADS * PEER_TOPK)
        u = u_table[experts]
        hid = jax.nn.gelu(jnp.einsum('nkd,nd->nk', u, xb).astype(jnp.float32), approximate=False) * gates
        return jnp.einsum('nk,nkd->nd', hid.astype(xb.dtype), v_table[experts])

    y = lax.map(one_block, blocks).reshape(-1, D)[:n]
    return y.reshape(B, T, D)


def setup_inputs(seed: int = 0) -> dict:
    key = jax.random.key(seed)
    ks = jax.random.split(key, 18)
    nrm = jax.random.normal
    f32 = jnp.float32
    return {
        "x": nrm(ks[0], (BATCH, SEQ, D_MODEL), f32),
        "meta_tokens": nrm(ks[1], (N_META, D_MODEL), f32),
        "mix_norm_w": 1.0 + 0.02 * nrm(ks[2], (DEPTH, D_MODEL), f32),
        "w_in": nrm(ks[3], (DEPTH, D_MODEL, IN_COLS), f32) * D_MODEL ** -0.5,
        "rec_lb_logits": 0.5 * nrm(ks[4], (DEPTH + 1, REC_HEADS * REC_DK), f32),
        "rec_norm_w": 1.0 + 0.02 * nrm(ks[5], (DEPTH, REC_HEADS, REC_DV), f32),
        "diff_lambda_q1": 0.1 * nrm(ks[6], (DEPTH, ATT_HEAD_DIM), f32),
        "diff_lambda_k1": 0.1 * nrm(ks[7], (DEPTH, ATT_HEAD_DIM), f32),
        "diff_lambda_q2": 0.1 * nrm(ks[8], (DEPTH, ATT_HEAD_DIM), f32),
        "diff_lambda_k2": 0.1 * nrm(ks[9], (DEPTH, ATT_HEAD_DIM), f32),
        "diff_subln_w": 1.0 + 0.02 * nrm(ks[10], (DEPTH, ATT_V_DIM), f32),
        "w_out": nrm(ks[11], (DEPTH, MIX_WIDTH, D_MODEL), f32) * MIX_WIDTH ** -0.5,
        "ffn_norm_w": 1.0 + 0.02 * nrm(ks[12], (DEPTH, D_MODEL), f32),
        "peer_w_query": nrm(ks[13], (DEPTH, D_MODEL, PEER_HEADS * PEER_QUERY_DIM), f32) * D_MODEL ** -0.5,
        "peer_subkeys": nrm(ks[14], (DEPTH, PEER_HEADS, 2, N_KEYS, PEER_QUERY_DIM // 2), f32) * (PEER_QUERY_DIM // 2) ** -0.5,
        "peer_u": nrm(ks[15], (DEPTH, N_EXPERTS, D_MODEL), f32) * D_MODEL ** -0.5,
        "peer_v": nrm(ks[16], (DEPTH, N_EXPERTS, D_MODEL), f32) * PEER_HEADS ** -0.5,
        "final_norm_w": 1.0 + 0.02 * nrm(ks[17], (D_MODEL,), f32),
    }


def reference(x, meta_tokens, mix_norm_w, w_in, rec_lb_logits, rec_norm_w,
              diff_lambda_q1, diff_lambda_k1, diff_lambda_q2, diff_lambda_k2,
              diff_subln_w, w_out, ffn_norm_w, peer_w_query, peer_subkeys,
              peer_u, peer_v, final_norm_w):
    B = x.shape[0]
    T = N_META + x.shape[1]
    meta = jnp.broadcast_to(meta_tokens[None].astype(x.dtype), (B, N_META, D_MODEL))
    h = jnp.concatenate([meta, x], axis=1)
    cos, sin = rope_tables(T, ATT_HEAD_DIM)
    lb_all = jnp.cumsum(jax.nn.softmax(rec_lb_logits.astype(jnp.float32), axis=0), axis=0)
    for l in range(DEPTH):
        a = rmsnorm(h, mix_norm_w[l])
        h = h + token_mix(a, w_in[l], lb_all[l], rec_norm_w[l],
                          diff_lambda_q1[l], diff_lambda_k1[l], diff_lambda_q2[l], diff_lambda_k2[l],
                          diff_subln_w[l], w_out[l], lambda_init(l), cos, sin).astype(h.dtype)
        if l == DEPTH - 1:
            h = h[:, N_META:]
        h = h + peer_ffn(rmsnorm(h, ffn_norm_w[l]), peer_w_query[l], peer_subkeys[l],
                         peer_u[l], peer_v[l]).astype(h.dtype)
    return rmsnorm(h, final_norm_w)
```

```cpp
#include <hip/hip_runtime.h>
#include <hip/hip_cooperative_groups.h>
#include <cstdio>
#include <cstdint>
#define DBG_SEL 1
namespace cg = cooperative_groups;

constexpr int BATCH = 8, SEQ = 4096, DM = 1024, NMETA = 16;
constexpr int NTOK = BATCH * SEQ;
constexpr int M1 = NTOK + 256;
constexpr int NCOL1 = 3584;
constexpr int TPOS = NMETA + SEQ;
constexpr int KT = 65;
constexpr int KPAD = 48;
constexpr int HT = 4128;
constexpr int NEXP = 16384;
constexpr float EPS = 1e-6f;
constexpr float LAM_INIT = 0.2f;
constexpr float QSCALE = 0.125f * 1.4426950408889634f;
constexpr int NTHREADS = 512, NWAVES = 8;

typedef unsigned short bf16_t;
typedef short bf16x8 __attribute__((ext_vector_type(8)));
typedef float f32x4 __attribute__((ext_vector_type(4)));
typedef float f32x16 __attribute__((ext_vector_type(16)));
typedef float f32x2 __attribute__((ext_vector_type(2)));
typedef unsigned u32x4 __attribute__((ext_vector_type(4)));
typedef unsigned u32x2 __attribute__((ext_vector_type(2)));
typedef __bf16 bf16x2_t __attribute__((ext_vector_type(2)));
typedef short s16x4 __attribute__((ext_vector_type(4)));
#define LAS __attribute__((address_space(3)))
#define DI __device__ __forceinline__
__device__ __forceinline__ int tid_() { int t = threadIdx.x; asm volatile("" : "+v"(t)); return t; }

constexpr size_t al256(size_t x) { return (x + 255) & ~(size_t)255; }
constexpr size_t WS_CTL = 0, CTL_BYTES = 65536;
constexpr size_t WS_W1T = WS_CTL + CTL_BYTES;
constexpr size_t WS_W2T = WS_W1T + (size_t)NCOL1 * DM * 2;
constexpr size_t WS_W3T = WS_W2T + (size_t)DM * DM * 2;
constexpr size_t WS_SKB = WS_W3T + (size_t)2048 * DM * 2;
constexpr size_t WS_UB = WS_SKB + (size_t)16 * 128 * 128 * 2;
constexpr size_t WS_VB = WS_UB + (size_t)NEXP * DM * 2;
constexpr size_t WS_ROPE = WS_VB + (size_t)NEXP * DM * 2;
constexpr size_t WS_LB = WS_ROPE + (size_t)TPOS * 64 * 4;
constexpr size_t WS_R1 = WS_LB + 4096;
constexpr size_t WS_SSQ = WS_R1 + al256((size_t)M1 * 4);
constexpr size_t WS_XB = WS_SSQ + (size_t)NTOK * 4;
constexpr size_t WS_C = WS_XB + (size_t)M1 * DM * 2;
constexpr size_t WS_Q = WS_C;
constexpr size_t WS_K = WS_Q + (size_t)NTOK * 512 * 2;
constexpr size_t WS_V = WS_K + (size_t)BATCH * 4 * 2 * KT * 8192;
constexpr size_t WS_HQ = WS_V + (size_t)BATCH * 4 * KT * 16384;
constexpr size_t WS_HV = WS_HQ + (size_t)BATCH * 4 * HT * 128 * 2;
constexpr size_t WS_HG = WS_HV + (size_t)BATCH * 4 * HT * 128 * 2;
constexpr size_t WS_SG = WS_HG + (size_t)BATCH * 4 * HT * 128 * 4;
constexpr size_t WS_CEND = WS_SG + (size_t)NTOK * 512 * 2;
constexpr size_t WS_PQ = WS_C;
constexpr size_t WS_EIDX = WS_PQ + (size_t)NTOK * 2048 * 2;
constexpr size_t WS_EGATE = WS_EIDX + (size_t)NTOK * 128 * 4;
constexpr size_t WS_HID = WS_EGATE + (size_t)NTOK * 128 * 4;
static_assert(WS_HID + (size_t)NTOK * 128 * 4 <= WS_CEND, "overlay fits");
constexpr size_t WS_MIX = WS_CEND;
constexpr size_t WS_END = WS_MIX + (size_t)NTOK * DM * 2;
static_assert(WS_END <= (size_t)512 * 1024 * 1024, "workspace map must fit 512 MiB");

struct Params {
    const float* x; const float* meta; const float* mix_norm_w; const float* w_in; const float* lb_logits; const float* rec_norm_w;
    const float* lq1; const float* lk1; const float* lq2; const float* lk2; const float* subln_w; const float* w_out; const float* ffn_norm_w;
    const float* wq; const float* subkeys; const float* pu; const float* pv; const float* final_w;
    float* out; unsigned char* ws;
};

DI unsigned f2bf(float f) { unsigned u = __builtin_bit_cast(unsigned, f); return (u + 0x7fffu + ((u >> 16) & 1u)) >> 16; }
DI float bf2f(unsigned b) { return __builtin_bit_cast(float, b << 16); }
DI unsigned cvtpk(float lo, float hi) { f32x2 v = {lo, hi}; bf16x2_t b = __builtin_convertvector(v, bf16x2_t); return __builtin_bit_cast(unsigned, b); }
DI float wave_sum(float v) {
#pragma unroll
    for (int o = 1; o < 64; o <<= 1) v += __shfl_xor(v, o);
    return v;
}
DI float sigmoidf_(float x) { return 1.f / (1.f + __expf(-x)); }
DI float siluf_(float x) { return x * sigmoidf_(x); }

DI int sigma_col(int c) {
    if (c >= 1024) return c;
    const int cc = c & 63, a = cc >> 5, fq = (cc >> 3) & 3, n = (cc >> 2) & 1, j = cc & 3;
    return (c & ~63) + 4 * (4 * a + fq) + 32 * n + j;
}
template <bool PERMUTE>
DI void p0_transpose_item(const float* W, int K, int N, const float* scale, bf16_t* WT, LAS float* scr, int item, int lane) {
    const int nblk = N / 32, kb = item / nblk, nb = item % nblk, k0 = 64 * kb, n0 = 32 * nb;
    const int ncol = PERMUTE ? sigma_col(n0 + (lane & 31)) : n0 + (lane & 31);
#pragma unroll 8
    for (int i = 0; i < 32; ++i) { const int kk = 2 * i + (lane >> 5); float s = scale ? scale[k0 + kk] : 1.f; scr[kk * 33 + (lane & 31)] = W[(size_t)(k0 + kk) * N + ncol] * s; }
    asm volatile("s_waitcnt lgkmcnt(0)" ::: "memory");
    const int c = lane & 7;
#pragma unroll
    for (int j = 0; j < 4; ++j) { const int n = (lane >> 3) + 8 * j; const LAS float* s = scr + (8 * c) * 33 + n;
        u32x4 o; o.x = cvtpk(s[0 * 33], s[1 * 33]); o.y = cvtpk(s[2 * 33], s[3 * 33]); o.z = cvtpk(s[4 * 33], s[5 * 33]); o.w = cvtpk(s[6 * 33], s[7 * 33]);
        *(u32x4*)(WT + (size_t)(n0 + n) * K + k0 + 8 * c) = o; }
    asm volatile("s_waitcnt lgkmcnt(0)" ::: "memory");
}

DI void phase0(const Params& P, char* lds, int bid, int nblk) {
    const int tid = tid_(), lane = tid & 63, wave = __builtin_amdgcn_readfirstlane(tid >> 6);
    unsigned char* ws = P.ws;
    LAS float* scr = (LAS float*)(lds) + wave * (64 * 33);
    const int gw = bid * NWAVES + wave, NGW = nblk * NWAVES;
    constexpr int I1 = (DM / 64) * (NCOL1 / 32), I2 = (DM / 64) * (DM / 32), I3 = (DM / 64) * (2048 / 32);
    for (int it = gw; it < I1 + I2 + I3; it += NGW) {
        int r = it;
        if (r < I1) { p0_transpose_item<true>(P.w_in, DM, NCOL1, P.mix_norm_w, (bf16_t*)(ws + WS_W1T), scr, r, lane); continue; } r -= I1;
        if (r < I2) { p0_transpose_item<false>(P.w_out, DM, DM, nullptr, (bf16_t*)(ws + WS_W2T), scr, r, lane); continue; } r -= I2;
        p0_transpose_item<false>(P.wq, DM, 2048, P.ffn_norm_w, (bf16_t*)(ws + WS_W3T), scr, r, lane);
    }
    for (int m = gw; m < M1; m += NGW) {
        bf16_t* orow = (bf16_t*)(ws + WS_XB) + (size_t)m * DM;
        float* r1 = (float*)(ws + WS_R1);
        unsigned long long* o8 = (unsigned long long*)orow + lane;
        if (m >= NTOK + NMETA) { for (int j = 0; j < 4; ++j) o8[64 * j] = 0ull; if (lane == 0) r1[m] = 0.f; continue; }
        const float* xrow = (m < NTOK) ? P.x + (size_t)m * DM : P.meta + (size_t)(m - NTOK) * DM;
        const f32x4* xr = (const f32x4*)xrow + lane;
        f32x4 v[4]; float s = 0.f;
#pragma unroll
        for (int j = 0; j < 4; ++j) { v[j] = xr[64 * j]; s += (v[j].x * v[j].x + v[j].y * v[j].y) + (v[j].z * v[j].z + v[j].w * v[j].w); }
        s = wave_sum(s);
        if (lane == 0) r1[m] = 1.f / sqrtf(s * (1.f / DM) + EPS);
#pragma unroll
        for (int j = 0; j < 4; ++j) o8[64 * j] = (unsigned long long)cvtpk(v[j].x, v[j].y) | ((unsigned long long)cvtpk(v[j].z, v[j].w) << 32);
    }
    {
        const size_t gt = (size_t)bid * NTHREADS + tid, NGT = (size_t)nblk * NTHREADS;
        const size_t nu = (size_t)NEXP * DM / 8, ns = (size_t)16 * 128 * 128 / 8;
        for (size_t i = gt; i < 2 * nu + ns; i += NGT) {
            const float* src; bf16_t* dst; size_t e;
            if (i < nu) { src = P.pu; dst = (bf16_t*)(ws + WS_UB); e = i; }
            else if (i < 2 * nu) { src = P.pv; dst = (bf16_t*)(ws + WS_VB); e = i - nu; }
            else { src = P.subkeys; dst = (bf16_t*)(ws + WS_SKB); e = i - 2 * nu; }
            const f32x4 a = ((const f32x4*)src)[2 * e], b = ((const f32x4*)src)[2 * e + 1];
            u32x4 o; o.x = cvtpk(a.x, a.y); o.y = cvtpk(a.z, a.w); o.z = cvtpk(b.x, b.y); o.w = cvtpk(b.z, b.w);
            ((u32x4*)dst)[e] = o;
        }
        float* rope = (float*)(ws + WS_ROPE);
        for (size_t i = gt; i < (size_t)TPOS * 32; i += NGT) {
            const int t = (int)(i >> 5), f = (int)(i & 31);
            const double inv = exp2(-(double)f * (13.287712379549449 / 32.0));
            const double ang = (double)t * inv;
            rope[(size_t)t * 64 + f] = (float)cos(ang); rope[(size_t)t * 64 + 32 + f] = (float)sin(ang);
        }
        float* ssq = (float*)(ws + WS_SSQ);
        for (size_t i = gt; i < (size_t)NTOK; i += NGT) ssq[i] = 0.f;
        for (size_t i = gt; i < (size_t)BATCH * 4 * 2 * 512; i += NGT) { const size_t img = i >> 9, o = i & 511; ((u32x4*)(ws + WS_K + img * KT * 8192))[o] = (u32x4){0u, 0u, 0u, 0u}; }
        for (size_t i = gt; i < (size_t)BATCH * 4 * 1024; i += NGT) { const size_t img = i >> 10, o = i & 1023; ((u32x4*)(ws + WS_V + img * KT * 16384))[o] = (u32x4){0u, 0u, 0u, 0u}; }
        for (size_t i = gt; i < (size_t)BATCH * 4 * 16 * 16; i += NGT) { const size_t bh = i >> 8, o = i & 255;
            ((u32x4*)(ws + WS_HQ + bh * HT * 256))[o] = (u32x4){0u, 0u, 0u, 0u}; ((u32x4*)(ws + WS_HV + bh * HT * 256))[o] = (u32x4){0u, 0u, 0u, 0u}; }
        for (size_t i = gt; i < (size_t)BATCH * 4 * 16 * 32; i += NGT) { const size_t bh = i >> 9, o = i & 511; ((u32x4*)(ws + WS_HG + bh * HT * 512))[o] = (u32x4){0u, 0u, 0u, 0u}; }
        float* lb = (float*)(ws + WS_LB);
        if (gt < 512) lb[gt] = sigmoidf_(P.lb_logits[gt] - P.lb_logits[512 + gt]);
        if (bid == 0 && wave == 0) {
            const float a = wave_sum(P.lq1[lane] * P.lk1[lane]), b = wave_sum(P.lq2[lane] * P.lk2[lane]);
            if (lane == 0) lb[512] = __expf(a) - __expf(b) + LAM_INIT;
        }
    }
}

namespace pg8 {
#define PG8_LAS __attribute__((address_space(3)))
typedef unsigned short bf16_t;
typedef short bf16x8 __attribute__((ext_vector_type(8)));
typedef float f32x4 __attribute__((ext_vector_type(4)));
typedef unsigned u32x4 __attribute__((ext_vector_type(4)));
constexpr int BM = 256, BK = 64, HALF = 128, HTB = HALF * BK * 2  , STAGE_BYTES = 8 * HTB, NXCD = 8, WGM = 8;

__host__ __device__ __forceinline__ int lds_byte(int r, int c) { const int st = (r >> 4) * 2 + (c >> 5), rr = r & 15, cc = c & 31, ob = rr * 64 + cc * 2; return st * 1024 + (ob ^ (((ob >> 9) & 1) << 5)); }
__host__ __device__ __forceinline__ void stage_rc(int b, int& R, int& C) { const int st = b / 1024, sb = b % 1024, swz = sb ^ (((sb >> 9) & 1) << 5); R = (st >> 1) * 16 + swz / 64; C = (st & 1) * 32 + (swz % 64) / 2; }
__host__ __device__ __forceinline__ int perm32(int rho) { const int n = rho >> 4, i = rho & 15; return 8 * (i >> 2) + 4 * n + (i & 3); }

struct Unit { int pm, pn; };
struct Gemm { const bf16_t* A; const bf16_t* Bt; int M, N, K; };

struct StaticOrder {
    int nM, nN, nwg, G, c;
    __host__ __device__ void init(int M, int N, int G_, int c_) { nM = M / BM; nN = N / BM; nwg = nM * nN; G = G_; c = c_; }
    __host__ __device__ bool next(int i, Unit& u) const {
        const long L = (long)i * G + c; if (L >= nwg) return false;
        int wgid = (int)L; { const int q = nwg / NXCD, r = nwg % NXCD, xcd = wgid % NXCD, off = wgid / NXCD; wgid = (xcd < r ? xcd * (q + 1) : r * (q + 1) + (xcd - r) * q) + off; }
        const int nig = WGM * nN, gid = wgid / nig, fm = gid * WGM, gsz = (nM - fm) < WGM ? (nM - fm) : WGM;
        u.pm = fm + ((wgid % nig) % gsz); u.pn = (wgid % nig) / gsz; return true;
    }
    __device__ __forceinline__ void a_ready(const Unit&) const {}
    __device__ __forceinline__ void done(const Unit&) const {}
};

template <class Epi, class Sched, bool ALIGN_EPI = false, bool SP2 = false>
__device__ __forceinline__ void gemm_phase(PG8_LAS unsigned char* lds, const Gemm g, const Sched& S, const Epi& E) {
    const int tid = tid_(), wid = __builtin_amdgcn_readfirstlane(tid >> 6), lane = tid & 63, wr = wid >> 2, wc = wid & 3, fr = lane & 15, fq = lane >> 4;
    const int K = g.K, nt = K / BK;
    unsigned voffA[2], voffB[2];
#pragma unroll
    for (int i = 0; i < 2; ++i) { int R, C; stage_rc(tid * 16 + i * 8192, R, C); const int Rb = Epi::PERM ? ((R & ~31) + perm32(R & 31)) : R;
        voffA[i] = (unsigned)(R * K + C) * 2u; voffB[i] = (unsigned)(Rb * K + C) * 2u; }
    const size_t kstep = (size_t)(BK * 2);
    const size_t hstep = (size_t)HALF * K * 2;
    const size_t tstep = 2 * hstep;
    const unsigned ldsw = (unsigned)wid * 1024u;
    const int aoff = lds_byte(wr * 64 + fr, fq * 8), boff = lds_byte(wc * 32 + fr, fq * 8);
#define PG8_SA(b, h) (((b) * 2 + (h)) * HTB)
#define PG8_SB(b, h) ((4 + (b) * 2 + (h)) * HTB)
#define PG8_STAGE(bufoff, gbase, voff) do { _Pragma("unroll") for (int _i = 0; _i < 2; ++_i) \
        __builtin_amdgcn_global_load_lds((const unsigned*)((const char*)(gbase) + (voff)[_i]), (PG8_LAS unsigned*)(lds + (bufoff) + ldsw + _i * 8192), 16, 0, 0); } while (0)
#define PG8_LDA(dst, b, h) do { _Pragma("unroll") for (int m = 0; m < 4; ++m) _Pragma("unroll") for (int k = 0; k < 2; ++k) dst[m][k] = *(const PG8_LAS bf16x8*)(lds + PG8_SA(b, h) + aoff + m * 2048 + k * 1024); } while (0)
#define PG8_LDB(dst, b, h) do { _Pragma("unroll") for (int n = 0; n < 2; ++n) _Pragma("unroll") for (int k = 0; k < 2; ++k) dst[n][k] = *(const PG8_LAS bf16x8*)(lds + PG8_SB(b, h) + boff + n * 2048 + k * 1024); } while (0)
#define PG8_MMA(ai, bj, At, Bt) do { __builtin_amdgcn_s_setprio(1); _Pragma("unroll") for (int m = 0; m < 4; ++m) _Pragma("unroll") for (int n = 0; n < 2; ++n) _Pragma("unroll") for (int k = 0; k < 2; ++k) \
        acc[ai][bj][m][n] = __builtin_amdgcn_mfma_f32_16x16x32_bf16(Bt[n][k], At[m][k], acc[ai][bj][m][n], 0, 0, 0); __builtin_amdgcn_s_setprio(0); } while (0)
#define PG8_WAIT_V(n) asm volatile("s_waitcnt vmcnt(" #n ")" ::: "memory")
#define PG8_WAIT_L(n) asm volatile("s_waitcnt lgkmcnt(" #n ")" ::: "memory")
#define PG8_BAR __builtin_amdgcn_s_barrier()
#define PG8_SCHED __builtin_amdgcn_sched_barrier(0)
    Unit cur, nxt; int ui = 0;
    if (!S.next(0, cur)) return;
    f32x4 acc[2][2][4][2];
#pragma unroll
    for (int a = 0; a < 2; ++a)
#pragma unroll
        for (int b = 0; b < 2; ++b)
#pragma unroll
            for (int m = 0; m < 4; ++m)
#pragma unroll
                for (int n = 0; n < 2; ++n) acc[a][b][m][n] = (f32x4){0.f, 0.f, 0.f, 0.f};
    bf16x8 At[4][2], B0[2][2], B1[2][2];
    const char* cA = (const char*)g.A + (size_t)cur.pm * tstep; const char* cB = (const char*)g.Bt + (size_t)cur.pn * tstep;
    S.a_ready(cur);
    if constexpr (SP2) {
        PG8_STAGE(PG8_SB(0, 0), cB, voffB); PG8_STAGE(PG8_SB(0, 1), cB + hstep, voffB); PG8_STAGE(PG8_SA(0, 0), cA, voffA); PG8_STAGE(PG8_SA(0, 1), cA + hstep, voffA);
        if (wr == 1) PG8_BAR;
        PG8_WAIT_V(2); PG8_BAR;
        PG8_STAGE(PG8_SB(1, 0), cB + kstep, voffB); PG8_STAGE(PG8_SA(1, 0), cA + kstep, voffA); PG8_STAGE(PG8_SB(1, 1), cB + hstep + kstep, voffB);
        PG8_WAIT_V(6); PG8_BAR;
    } else {
        PG8_STAGE(PG8_SB(0, 0), cB, voffB); PG8_STAGE(PG8_SA(0, 0), cA, voffA); PG8_STAGE(PG8_SB(0, 1), cB + hstep, voffB); PG8_STAGE(PG8_SA(0, 1), cA + hstep, voffA);
        if (wr == 1) PG8_BAR;
        PG8_WAIT_V(4); PG8_BAR;
        PG8_STAGE(PG8_SB(1, 0), cB + kstep, voffB); PG8_STAGE(PG8_SA(1, 0), cA + kstep, voffA); PG8_STAGE(PG8_SB(1, 1), cB + hstep + kstep, voffB);
        PG8_WAIT_V(6); PG8_BAR;
    }
    for (;;) {
        const bool has_next = S.next(ui + 1, nxt);
        const char* nA = has_next ? (const char*)g.A + (size_t)nxt.pm * tstep : cA; const char* nB = has_next ? (const char*)g.Bt + (size_t)nxt.pn * tstep : cB;
        for (int t = 0; t < nt; t += 2) {
            const bool last = (t == nt - 2);
            const char* a1 = cA + (size_t)(t + 1) * kstep;
            const char* a2 = last ? nA : cA + (size_t)(t + 2) * kstep; const char* b2 = last ? nB : cB + (size_t)(t + 2) * kstep;
            const char* a3 = a2 + kstep; const char* b3 = b2 + kstep;
            if (last && has_next) S.a_ready(nxt);
            if constexpr (SP2) {
            PG8_LDB(B0, 0, 0); PG8_LDB(B1, 0, 1); PG8_SCHED; PG8_LDA(At, 0, 0); PG8_STAGE(PG8_SA(1, 1), a1 + hstep, voffA);
            PG8_WAIT_V(8); PG8_WAIT_L(0); PG8_BAR; PG8_MMA(0, 0, At, B0); PG8_MMA(0, 1, At, B1); PG8_BAR; PG8_SCHED;
            PG8_LDA(At, 0, 1); PG8_STAGE(PG8_SB(0, 0), b2, voffB); PG8_STAGE(PG8_SB(0, 1), b2 + hstep, voffB); PG8_STAGE(PG8_SA(0, 0), a2, voffA);
            PG8_WAIT_V(8); PG8_WAIT_L(0); PG8_BAR; PG8_MMA(1, 0, At, B0); PG8_MMA(1, 1, At, B1); PG8_BAR; PG8_SCHED;
            PG8_LDB(B0, 1, 0); PG8_LDB(B1, 1, 1); PG8_SCHED; PG8_LDA(At, 1, 0); PG8_STAGE(PG8_SA(0, 1), a2 + hstep, voffA);
            PG8_WAIT_V(8); PG8_WAIT_L(0); PG8_BAR; PG8_MMA(0, 0, At, B0); PG8_MMA(0, 1, At, B1); PG8_BAR; PG8_SCHED;
            PG8_LDA(At, 1, 1); PG8_STAGE(PG8_SB(1, 0), b3, voffB); PG8_STAGE(PG8_SB(1, 1), b3 + hstep, voffB); PG8_STAGE(PG8_SA(1, 0), a3, voffA);
            PG8_WAIT_V(8); PG8_WAIT_L(0); PG8_BAR; PG8_MMA(1, 0, At, B0); PG8_MMA(1, 1, At, B1); PG8_BAR; PG8_SCHED;
            } else {
            PG8_LDB(B0, 0, 0); PG8_SCHED; PG8_LDA(At, 0, 0); PG8_STAGE(PG8_SA(1, 1), a1 + hstep, voffA);
            PG8_WAIT_L(8); PG8_BAR; PG8_WAIT_L(0); PG8_MMA(0, 0, At, B0); PG8_BAR; PG8_SCHED;
            PG8_LDB(B1, 0, 1); PG8_STAGE(PG8_SB(0, 0), b2, voffB);
            PG8_BAR; PG8_WAIT_L(0); PG8_MMA(0, 1, At, B1); PG8_BAR;
            PG8_LDA(At, 0, 1); PG8_STAGE(PG8_SA(0, 0), a2, voffA);
            PG8_BAR; PG8_WAIT_L(0); PG8_MMA(1, 0, At, B0); PG8_BAR; PG8_SCHED;
            PG8_STAGE(PG8_SB(0, 1), b2 + hstep, voffB);
            PG8_WAIT_V(6); PG8_BAR; PG8_MMA(1, 1, At, B1); PG8_BAR;
            PG8_LDB(B0, 1, 0); PG8_SCHED; PG8_LDA(At, 1, 0); PG8_STAGE(PG8_SA(0, 1), a2 + hstep, voffA);
            PG8_WAIT_L(8); PG8_BAR; PG8_WAIT_L(0); PG8_MMA(0, 0, At, B0); PG8_BAR; PG8_SCHED;
            PG8_LDB(B1, 1, 1); PG8_STAGE(PG8_SB(1, 0), b3, voffB);
            PG8_BAR; PG8_WAIT_L(0); PG8_MMA(0, 1, At, B1); PG8_BAR;
            PG8_LDA(At, 1, 1); PG8_STAGE(PG8_SA(1, 0), a3, voffA);
            PG8_BAR; PG8_WAIT_L(0); PG8_MMA(1, 0, At, B0); PG8_BAR; PG8_SCHED;
            PG8_STAGE(PG8_SB(1, 1), b3 + hstep, voffB);
            PG8_WAIT_V(6); PG8_BAR; PG8_MMA(1, 1, At, B1); PG8_BAR;
            }
        }
        if constexpr (ALIGN_EPI) { if (wr == 0) PG8_BAR; }
        if constexpr (!Epi::AFTER_DRAIN) { E(acc, cur, wr, wc, fr, fq); S.done(cur); }
        if (!has_next) break;
#pragma unroll
        for (int a = 0; a < 2; ++a)
#pragma unroll
            for (int b = 0; b < 2; ++b)
#pragma unroll
                for (int m = 0; m < 4; ++m)
#pragma unroll
                    for (int n = 0; n < 2; ++n) acc[a][b][m][n] = (f32x4){0.f, 0.f, 0.f, 0.f};
        cur = nxt; cA = nA; cB = nB; ++ui;
        if constexpr (ALIGN_EPI) { if (wr == 1) PG8_BAR; }
    }
    PG8_WAIT_V(0);
    if constexpr (!ALIGN_EPI) { if (wr == 0) PG8_BAR; }
    PG8_BAR;
    if constexpr (Epi::AFTER_DRAIN) { E.fused(acc, cur, wr, wc, fr, fq, lds, wid, lane); S.done(cur); }
#undef PG8_SA
#undef PG8_SB
#undef PG8_STAGE
#undef PG8_LDA
#undef PG8_LDB
#undef PG8_MMA
#undef PG8_WAIT_V
#undef PG8_WAIT_L
#undef PG8_BAR
#undef PG8_SCHED
}
}

DI u32x2 pack4(f32x4 v) { u32x2 r; r.x = cvtpk(v.x, v.y); r.y = cvtpk(v.z, v.w); return r; }
DI u32x4 pack8(f32x4 a, f32x4 b) { u32x4 r; r.x = cvtpk(a.x, a.y); r.y = cvtpk(a.z, a.w); r.z = cvtpk(b.x, b.y); r.w = cvtpk(b.z, b.w); return r; }

struct Epi1 {
    static constexpr bool PERM = true, AFTER_DRAIN = false;
    unsigned char* ws;
    DI void operator()(const f32x4 (&acc)[2][2][4][2], const pg8::Unit& u, int wr, int wc, int fr, int fq) const {
        const float* r1p = (const float*)(ws + WS_R1);
        const float* rope = (const float*)(ws + WS_ROPE);
        const float* lbp = (const float*)(ws + WS_LB);
        const int seg = u.pn >> 1;
#pragma unroll
        for (int ai = 0; ai < 2; ++ai)
#pragma unroll
            for (int m = 0; m < 4; ++m) {
                const int row = u.pm * 256 + ai * 128 + wr * 64 + m * 16 + fr;
                const bool meta = row >= NTOK;
                if (row >= NTOK + NMETA) continue;
                const float r1 = r1p[row];
                const int b = meta ? 0 : (row >> 12), t = meta ? (row - NTOK) : ((row & 4095) + NMETA);
                const int nrep = meta ? BATCH : 1;
#pragma unroll
                for (int bj = 0; bj < 2; ++bj) {
                    const int cs = (u.pn & 1) * 256 + bj * 128 + wc * 32 + 8 * fq;
                    const f32x4 v0 = acc[ai][bj][m][0] * r1, v1 = acc[ai][bj][m][1] * r1;
                    const int h = cs >> 7;
                    if (seg <= 1) {
                        const int comp = (cs >> 6) & 1, cc = cs & 63, i0 = 16 * (cc >> 5) + 4 * fq;
                        const f32x4 c4 = *(const f32x4*)(rope + (size_t)t * 64 + i0), s4 = *(const f32x4*)(rope + (size_t)t * 64 + 32 + i0);
                        f32x4 lo = v0 * c4 - v1 * s4, hi = v1 * c4 + v0 * s4;
                        if (seg == 0) {
                            if (meta) continue;
                            lo = lo * QSCALE; hi = hi * QSCALE;
                            bf16_t* qp = (bf16_t*)(ws + WS_Q) + ((size_t)(((b * 4 + h) * 2 + comp) * SEQ + (row & 4095))) * 64;
                            *(u32x2*)(qp + i0) = pack4(lo); *(u32x2*)(qp + i0 + 32) = pack4(hi);
                        } else {
                            const int pp = t + KPAD, tile = pp >> 6, key = pp & 63;
                            for (int bb = 0; bb < nrep; ++bb) {
                                const int b_ = meta ? bb : b;
                                unsigned char* img = ws + WS_K + ((size_t)((b_ * 4 + h) * 2 + comp) * KT + tile) * 8192;
                                *(u32x2*)(img + (i0 >> 3) * 1024 + key * 16 + (i0 & 7) * 2) = pack4(lo);
                                *(u32x2*)(img + ((i0 >> 3) + 4) * 1024 + key * 16 + (i0 & 7) * 2) = pack4(hi);
                            }
                        }
                    } else if (seg == 2) {
                        const int dv = cs & 127, pp = t + KPAD, tile = pp >> 6, key = pp & 63;
                        const u32x4 w = pack8(v0, v1);
                        for (int bb = 0; bb < nrep; ++bb) {
                            const int b_ = meta ? bb : b;
                            unsigned char* img = ws + WS_V + ((size_t)(b_ * 4 + h) * KT + tile) * 16384;
                            *(u32x4*)(img + (dv >> 5) * 4096 + key * 64 + (dv & 31) * 2) = w;
                        }
                    } else if (seg == 3 || seg == 5) {
                        const int dv = cs & 127;
                        f32x4 a = v0, c = v1;
                        if (seg == 3) { a.x = siluf_(a.x); a.y = siluf_(a.y); a.z = siluf_(a.z); a.w = siluf_(a.w); c.x = siluf_(c.x); c.y = siluf_(c.y); c.z = siluf_(c.z); c.w = siluf_(c.w); }
                        const u32x4 w = pack8(a, c);
                        const size_t base = (seg == 3) ? WS_HQ : WS_HV;
                        for (int bb = 0; bb < nrep; ++bb) {
                            const int b_ = meta ? bb : b;
                            *(u32x4*)((bf16_t*)(ws + base) + ((size_t)(b_ * 4 + h) * HT + t + 16) * 128 + dv) = w;
                        }
                    } else if (seg == 4) {
                        const int dv = cs & 127;
                        const f32x4 l0 = *(const f32x4*)(lbp + cs), l1 = *(const f32x4*)(lbp + cs + 4);
                        f32x4 g0, g1;
#pragma unroll
                        for (int e = 0; e < 4; ++e) { g0[e] = __logf(l0[e] + (1.f - l0[e]) * sigmoidf_(v0[e])); g1[e] = __logf(l1[e] + (1.f - l1[e]) * sigmoidf_(v1[e])); }
                        for (int bb = 0; bb < nrep; ++bb) {
                            const int b_ = meta ? bb : b;
                            float* gp = (float*)(ws + WS_HG) + ((size_t)(b_ * 4 + h) * HT + t + 16) * 128 + dv;
                            *(f32x4*)gp = g0; *(f32x4*)(gp + 4) = g1;
                        }
                    } else {
                        if (meta) continue;
                        f32x4 a = v0, c = v1;
                        a.x = siluf_(a.x); a.y = siluf_(a.y); a.z = siluf_(a.z); a.w = siluf_(a.w); c.x = siluf_(c.x); c.y = siluf_(c.y); c.z = siluf_(c.z); c.w = siluf_(c.w);
                        *(u32x4*)((bf16_t*)(ws + WS_SG) + (size_t)row * 512 + cs) = pack8(a, c);
                    }
                }
            }
    }
};

struct Epi3 {
    static constexpr bool PERM = true, AFTER_DRAIN = false;
    const float* x; float* H; bf16_t* HB; float* ssq;
    DI void operator()(const f32x4 (&acc)[2][2][4][2], const pg8::Unit& u, int wr, int wc, int fr, int fq) const {
#pragma unroll
        for (int ai = 0; ai < 2; ++ai)
#pragma unroll
            for (int m = 0; m < 4; ++m) {
                const int row = u.pm * 256 + ai * 128 + wr * 64 + m * 16 + fr;
                float s = 0.f;
#pragma unroll
                for (int bj = 0; bj < 2; ++bj) {
                    const int col = u.pn * 256 + bj * 128 + wc * 32 + 8 * fq;
                    const size_t o = (size_t)row * DM + col;
                    const f32x4 h0 = *(const f32x4*)(x + o) + acc[ai][bj][m][0], h1 = *(const f32x4*)(x + o + 4) + acc[ai][bj][m][1];
                    *(f32x4*)(H + o) = h0; *(f32x4*)(H + o + 4) = h1;
                    *(u32x4*)(HB + o) = pack8(h0, h1);
                    s += (h0.x * h0.x + h0.y * h0.y) + (h0.z * h0.z + h0.w * h0.w) + (h1.x * h1.x + h1.y * h1.y) + (h1.z * h1.z + h1.w * h1.w);
                }
                s += __shfl_xor(s, 16); s += __shfl_xor(s, 32);
                if (fq == 0) atomicAdd(ssq + row, s);
            }
    }
};

struct Epi4 {
    static constexpr bool PERM = true, AFTER_DRAIN = false;
    const float* ssq; bf16_t* PQ;
    DI void operator()(const f32x4 (&acc)[2][2][4][2], const pg8::Unit& u, int wr, int wc, int fr, int fq) const {
#pragma unroll
        for (int ai = 0; ai < 2; ++ai)
#pragma unroll
            for (int m = 0; m < 4; ++m) {
                const int row = u.pm * 256 + ai * 128 + wr * 64 + m * 16 + fr;
                const float r2 = 1.f / sqrtf(ssq[row] * (1.f / DM) + EPS);
#pragma unroll
                for (int bj = 0; bj < 2; ++bj) {
                    const int col = u.pn * 256 + bj * 128 + wc * 32 + 8 * fq;
                    *(u32x4*)(PQ + (size_t)row * 2048 + col) = pack8(acc[ai][bj][m][0] * r2, acc[ai][bj][m][1] * r2);
                }
            }
    }
};

template <class Epi>
DI void gemm_run(char* lds, const bf16_t* A, const bf16_t* Bt, int M, int N, int K, const Epi& E, int bid, int nblk) {
    pg8::Gemm g{A, Bt, M, N, K}; pg8::StaticOrder S; S.init(M, N, nblk, bid);
    pg8::gemm_phase<Epi, pg8::StaticOrder, true, true>((LAS unsigned char*)lds, g, S, E);
}
#define MFMA32(a, b, c) __builtin_amdgcn_mfma_f32_32x32x16_bf16(a, b, c, 0, 0, 0)
typedef short v4i16_t __attribute__((ext_vector_type(4)));
DI int crow(int r, int hi) { return (r & 3) + 8 * (r >> 2) + 4 * hi; }
DI s16x4 vtr(const LAS char* p) { return __builtin_bit_cast(s16x4, __builtin_amdgcn_ds_read_tr16_b64_v4i16((LAS v4i16_t*)p)); }
DI void glds16(const void* g, LAS char* l) { __builtin_amdgcn_global_load_lds((const unsigned*)g, (LAS unsigned*)l, 16, 0, 0); }
DI float swap_max(float m) { auto rr = __builtin_amdgcn_permlane32_swap(__float_as_uint(m), __float_as_uint(m), false, false); return fmaxf(__uint_as_float(rr[0]), __uint_as_float(rr[1])); }
DI float swap_sum(float m) { auto rr = __builtin_amdgcn_permlane32_swap(__float_as_uint(m), __float_as_uint(m), false, false); return __uint_as_float(rr[0]) + __uint_as_float(rr[1]); }
constexpr int ATT_BUF = 32768, ATT_WSF = 65536;
constexpr float ATT_THR = 8.f;

DI void attn_unit(const Params& P, int b, int h, int j, char* lds_g) {
    LAS char* lds = (LAS char*)lds_g;
    const int tid = tid_(), lane = tid & 63, r32 = lane & 31, hi = lane >> 5;
    const int wid = __builtin_amdgcn_readfirstlane(tid >> 6), comp = wid >> 2, wq = wid & 3;
    const unsigned char* ws = P.ws;
    const int bh = b * 4 + h;
    const bf16_t* Qw = (const bf16_t*)(ws + WS_Q) + ((size_t)((bh * 2 + comp) * SEQ + 128 * j + 32 * wq)) * 64;
    bf16x8 qr[4];
#pragma unroll
    for (int d0 = 0; d0 < 4; ++d0) qr[d0] = *(const bf16x8*)(Qw + r32 * 64 + d0 * 16 + hi * 8);
    const unsigned char* kimg0 = ws + WS_K + (size_t)(bh * 2) * KT * 8192 + wid * 1024 + lane * 16;
    const unsigned char* kimg1 = kimg0 + (size_t)KT * 8192;
    const unsigned char* vimg = ws + WS_V + (size_t)bh * KT * 16384 + wid * 1024 + lane * 16;
    const int NT = 2 * j + 3, my_last = (wq < 2) ? 2 * j + 1 : 2 * j + 2;
    LAS float* wsf = (LAS float*)(lds + ATT_WSF) + wid * 64;
#define ATT_ISSUE(t, s) do { LAS char* d_ = lds + (s) * ATT_BUF + wid * 1024; \
        glds16(kimg0 + (size_t)(t) * 8192, d_); glds16(kimg1 + (size_t)(t) * 8192, d_ + 8192); \
        glds16(vimg + (size_t)(t) * 16384, d_ + 16384); glds16(vimg + (size_t)(t) * 16384 + 8192, d_ + 24576); } while (0)
    f32x16 o[4];
#pragma unroll
    for (int nb = 0; nb < 4; ++nb) o[nb] = f32x16{};
    float mref = 0.f, lsum = 0.f;
    const int qpos = 64 + 128 * j + 32 * wq + r32;
    ATT_ISSUE(0, 0);
    __syncthreads();
    for (int t = 0; t < NT; ++t) {
        const int s = t & 1;
        if (t + 1 < NT) ATT_ISSUE(t + 1, s ^ 1);
        if (t <= my_last) {
            const LAS char* kp = lds + s * ATT_BUF + comp * 8192 + hi * 1024 + r32 * 16;
            f32x16 s0 = f32x16{}, s1 = f32x16{};
#pragma unroll
            for (int d0 = 0; d0 < 4; ++d0) {
                const bf16x8 k0 = *(const LAS bf16x8*)(kp + d0 * 2048), k1 = *(const LAS bf16x8*)(kp + d0 * 2048 + 512);
                s0 = MFMA32(k0, qr[d0], s0); s1 = MFMA32(k1, qr[d0], s1);
            }
            if (t == 0) {
#pragma unroll
                for (int r = 0; r < 16; ++r) { s0[r] = -INFINITY; if (32 + crow(r, hi) < KPAD) s1[r] = -INFINITY; }
            }
            if (t >= 2 * j + 1) {
                const int kb = 64 * t + 4 * hi;
#pragma unroll
                for (int r = 0; r < 16; ++r) { const int kv = kb + (r & 3) + 8 * (r >> 2); if (kv > qpos) s0[r] = -INFINITY; if (kv + 32 > qpos) s1[r] = -INFINITY; }
            }
            float rm = fmaxf(s0[0], s1[0]);
#pragma unroll
            for (int r = 1; r < 16; ++r) rm = fmaxf(rm, fmaxf(s0[r], s1[r]));
            rm = swap_max(rm);
            if (t == 0) mref = rm;
            else {
                const float grow = rm - mref;
                if (__any(grow > ATT_THR)) {
                    const float dl = fmaxf(grow, 0.f), f = __builtin_amdgcn_exp2f(-dl);
                    mref += dl; lsum *= f;
                    if (hi == 0) wsf[r32] = f;
                    asm volatile("s_waitcnt lgkmcnt(0)" ::: "memory");
#pragma unroll
                    for (int r = 0; r < 16; ++r) { const float fr_ = wsf[crow(r, hi)];
#pragma unroll
                        for (int nb = 0; nb < 4; ++nb) o[nb][r] *= fr_; }
                }
            }
            float ps = 0.f;
#pragma unroll
            for (int r = 0; r < 16; ++r) { s0[r] = __builtin_amdgcn_exp2f(s0[r] - mref); s1[r] = __builtin_amdgcn_exp2f(s1[r] - mref); ps += s0[r] + s1[r]; }
            lsum += ps;
            const LAS char* vp = lds + s * ATT_BUF + 16384 + ((lane >> 4) & 1) * 32 + (lane & 3) * 8 + (4 * hi + ((lane & 15) >> 2)) * 64;
#pragma unroll
            for (int ks = 0; ks < 4; ++ks) {
                u32x4 pw;
                if (ks < 2) { pw.x = cvtpk(s0[8 * ks], s0[8 * ks + 1]); pw.y = cvtpk(s0[8 * ks + 2], s0[8 * ks + 3]); pw.z = cvtpk(s0[8 * ks + 4], s0[8 * ks + 5]); pw.w = cvtpk(s0[8 * ks + 6], s0[8 * ks + 7]); }
                else { const int q_ = ks - 2; pw.x = cvtpk(s1[8 * q_], s1[8 * q_ + 1]); pw.y = cvtpk(s1[8 * q_ + 2], s1[8 * q_ + 3]); pw.z = cvtpk(s1[8 * q_ + 4], s1[8 * q_ + 5]); pw.w = cvtpk(s1[8 * q_ + 6], s1[8 * q_ + 7]); }
                const bf16x8 pa = __builtin_bit_cast(bf16x8, pw);
#pragma unroll
                for (int nb = 0; nb < 4; ++nb) {
                    const s16x4 vlo = vtr(vp + nb * 4096 + ks * 1024), vhi = vtr(vp + nb * 4096 + ks * 1024 + 512);
                    const bf16x8 vb = (bf16x8){vlo[0], vlo[1], vlo[2], vlo[3], vhi[0], vhi[1], vhi[2], vhi[3]};
                    o[nb] = MFMA32(pa, vb, o[nb]);
                }
            }
        }
        __syncthreads();
    }
#undef ATT_ISSUE
    lsum = swap_sum(lsum);
    if (hi == 0) wsf[r32] = lsum;
    asm volatile("s_waitcnt lgkmcnt(0)" ::: "memory");
    float rli[16];
#pragma unroll
    for (int r = 0; r < 16; ++r) rli[r] = 1.f / wsf[crow(r, hi)];
    const float lam = ((const float*)(ws + WS_LB))[512];
    LAS float* ex = (LAS float*)lds + wq * 4096;
    if (comp == 1) {
#pragma unroll
        for (int r = 0; r < 16; ++r)
#pragma unroll
            for (int nb = 0; nb < 4; ++nb) ex[(r * 4 + nb) * 64 + lane] = o[nb][r] * rli[r] * lam;
    }
    __syncthreads();
    if (comp == 0) {
        float ss[16];
#pragma unroll
        for (int r = 0; r < 16; ++r) { float a = 0.f;
#pragma unroll
            for (int nb = 0; nb < 4; ++nb) { const float v = o[nb][r] * rli[r] - ex[(r * 4 + nb) * 64 + lane]; o[nb][r] = v; a += v * v; }
            ss[r] = a; }
#pragma unroll
        for (int r = 0; r < 16; ++r) { float a = ss[r]; a += __shfl_xor(a, 1); a += __shfl_xor(a, 2); a += __shfl_xor(a, 4); a += __shfl_xor(a, 8); a += __shfl_xor(a, 16); ss[r] = (1.f - LAM_INIT) / sqrtf(a * (1.f / 128.f) + EPS); }
        bf16_t* mix = (bf16_t*)(ws + WS_MIX) + ((size_t)(b * SEQ + 128 * j + 32 * wq)) * DM + h * 128;
#pragma unroll
        for (int nb = 0; nb < 4; ++nb) { const float w = P.subln_w[32 * nb + r32];
#pragma unroll
            for (int r = 0; r < 16; ++r) mix[(size_t)crow(r, hi) * DM + 32 * nb + r32] = (bf16_t)f2bf(o[nb][r] * ss[r] * w); }
    }
    __syncthreads();
}
#define MFMA16(a, b, c) __builtin_amdgcn_mfma_f32_16x16x32_bf16(a, b, c, 0, 0, 0)
constexpr int HG_STR = 272;
constexpr int HL_QA = 0, HL_QB = HL_QA + 32 * HG_STR, HL_KB = HL_QB + 32 * HG_STR, HL_KT = HL_KB + 32 * HG_STR, HL_VV = HL_KT + 32 * HG_STR;
constexpr int HL_PS = HL_VV + 32 * HG_STR;
constexpr int HL_D = HL_PS + 4 * 128 * 4;
constexpr int HL_OUT = HL_D + 128 * 4;
constexpr int HL_END = HL_OUT + 32 * 132 * 4;

DI void hgrn_unit(const Params& P, int b, int h, char* lds_g) {
    LAS char* lds = (LAS char*)lds_g;
    const int tid = tid_(), lane = tid & 63, c16 = lane & 15, g4 = lane >> 4;
    const int wid = __builtin_amdgcn_readfirstlane(tid >> 6);
    const unsigned char* ws = P.ws;
    const int bh = b * 4 + h;
    const float* HG = (const float*)(ws + WS_HG) + (size_t)bh * HT * 128;
    const bf16_t* HQ = (const bf16_t*)(ws + WS_HQ) + (size_t)bh * HT * 128;
    const bf16_t* HV = (const bf16_t*)(ws + WS_HV) + (size_t)bh * HT * 128;
    const int ch = tid & 127, part = tid >> 7;
    const int vrow = tid >> 4, vcol = (tid & 15) * 8;
    f32x4 S[8];
#pragma unroll
    for (int i = 0; i < 8; ++i) S[i] = (f32x4){0.f, 0.f, 0.f, 0.f};
    float g8[8]; unsigned short q8[8]; u32x4 v16;
#define HG_LOAD(c) do { const size_t r0 = (size_t)(32 * (c) + 8 * part); \
        _Pragma("unroll") for (int e = 0; e < 8; ++e) { g8[e] = HG[(r0 + e) * 128 + ch]; q8[e] = HQ[(r0 + e) * 128 + ch]; } \
        v16 = *(const u32x4*)(HV + ((size_t)(32 * (c)) + vrow) * 128 + vcol); } while (0)
    HG_LOAD(0);
    for (int c = 0; c < 129; ++c) {
        float p8[8]; { float a = 0.f;
#pragma unroll
            for (int e = 0; e < 8; ++e) { a += g8[e]; p8[e] = a; } }
        ((LAS float*)(lds + HL_PS))[part * 128 + ch] = p8[7];
        __syncthreads();
        {
            const LAS float* ps = (const LAS float*)(lds + HL_PS);
            const float t0 = ps[ch], t1 = ps[128 + ch], t2 = ps[256 + ch], t3 = ps[384 + ch];
            const float off = (part > 0 ? t0 : 0.f) + (part > 1 ? t1 : 0.f) + (part > 2 ? t2 : 0.f);
            const float mid = t0 + t1, last = mid + t2 + t3;
            const float em = __expf(mid), el = __expf(last - mid);
            if (part == 0) ((LAS float*)(lds + HL_D))[ch] = __expf(last);
#pragma unroll
            for (int e = 0; e < 8; ++e) {
                const int tk = 8 * part + e;
                const float cum = off + p8[e];
                const float e1 = __expf(cum - mid), e2 = 1.f / e1;
                const float q = bf2f(q8[e]), k = 1.f - __expf(g8[e]);
                const float qb = q * e1, qa = qb * em, kb = k * e2, kt = kb * el;
                *(LAS bf16_t*)(lds + HL_QA + tk * HG_STR + ch * 2) = (bf16_t)f2bf(qa);
                *(LAS bf16_t*)(lds + HL_QB + tk * HG_STR + ch * 2) = (bf16_t)f2bf(qb);
                *(LAS bf16_t*)(lds + HL_KB + tk * HG_STR + ch * 2) = (bf16_t)f2bf(kb);
                *(LAS bf16_t*)(lds + HL_KT + tk * HG_STR + ch * 2) = (bf16_t)f2bf(kt);
            }
            *(LAS u32x4*)(lds + HL_VV + vrow * HG_STR + vcol * 2) = v16;
        }
        if (c + 1 < 129) HG_LOAD(c + 1);
        __syncthreads();
        {
            f32x4 oacc[2] = {(f32x4){0.f, 0.f, 0.f, 0.f}, (f32x4){0.f, 0.f, 0.f, 0.f}};
#pragma unroll
            for (int ks = 0; ks < 4; ++ks) {
                u32x4 sp; sp.x = cvtpk(S[2 * ks][0], S[2 * ks][1]); sp.y = cvtpk(S[2 * ks][2], S[2 * ks][3]); sp.z = cvtpk(S[2 * ks + 1][0], S[2 * ks + 1][1]); sp.w = cvtpk(S[2 * ks + 1][2], S[2 * ks + 1][3]);
                const bf16x8 sf = __builtin_bit_cast(bf16x8, sp);
#pragma unroll
                for (int nt = 0; nt < 2; ++nt) {
                    const LAS char* qp = lds + HL_QA + (16 * nt + c16) * HG_STR + (32 * ks + 4 * g4) * 2;
                    const u32x2 lo = *(const LAS u32x2*)qp, hi2 = *(const LAS u32x2*)(qp + 32);
                    const bf16x8 qf = __builtin_bit_cast(bf16x8, (u32x4){lo.x, lo.y, hi2.x, hi2.y});
                    oacc[nt] = MFMA16(sf, qf, oacc[nt]);
                }
            }
            f32x4 at00 = (f32x4){0.f, 0.f, 0.f, 0.f}, at01 = at00, at11 = at00;
#pragma unroll
            for (int ks = 0; ks < 4; ++ks) {
                const bf16x8 ka0 = *(const LAS bf16x8*)(lds + HL_KB + c16 * HG_STR + (32 * ks + 8 * g4) * 2);
                const bf16x8 ka1 = *(const LAS bf16x8*)(lds + HL_KB + (16 + c16) * HG_STR + (32 * ks + 8 * g4) * 2);
                const bf16x8 qn0 = *(const LAS bf16x8*)(lds + HL_QB + c16 * HG_STR + (32 * ks + 8 * g4) * 2);
                const bf16x8 qn1 = *(const LAS bf16x8*)(lds + HL_QB + (16 + c16) * HG_STR + (32 * ks + 8 * g4) * 2);
                at00 = MFMA16(ka0, qn0, at00); at01 = MFMA16(ka0, qn1, at01); at11 = MFMA16(ka1, qn1, at11);
            }
#pragma unroll
            for (int r = 0; r < 4; ++r) { if (4 * g4 + r > c16) { at00[r] = 0.f; at11[r] = 0.f; } }
            {
                const LAS char* vp = lds + HL_VV + (4 * g4 + (c16 >> 2)) * HG_STR + (16 * wid + 4 * (c16 & 3)) * 2;
                const s16x4 vlo = vtr(vp), vhi = vtr(vp + 16 * HG_STR);
                const bf16x8 va = (bf16x8){vlo[0], vlo[1], vlo[2], vlo[3], vhi[0], vhi[1], vhi[2], vhi[3]};
                u32x4 b0; b0.x = cvtpk(at00[0], at00[1]); b0.y = cvtpk(at00[2], at00[3]); b0.z = 0u; b0.w = 0u;
                u32x4 b1; b1.x = cvtpk(at01[0], at01[1]); b1.y = cvtpk(at01[2], at01[3]); b1.z = cvtpk(at11[0], at11[1]); b1.w = cvtpk(at11[2], at11[3]);
                oacc[0] = MFMA16(va, __builtin_bit_cast(bf16x8, b0), oacc[0]);
                oacc[1] = MFMA16(va, __builtin_bit_cast(bf16x8, b1), oacc[1]);
            }
#pragma unroll
            for (int nt = 0; nt < 2; ++nt) *(LAS f32x4*)(lds + HL_OUT + ((16 * nt + c16) * 132 + 16 * wid + 4 * g4) * 4) = oacc[nt];
            {
                const LAS char* vp = lds + HL_VV + (8 * g4 + (c16 >> 2)) * HG_STR + (16 * wid + 4 * (c16 & 3)) * 2;
                const s16x4 vlo = vtr(vp), vhi = vtr(vp + 4 * HG_STR);
                const bf16x8 vb = (bf16x8){vlo[0], vlo[1], vlo[2], vlo[3], vhi[0], vhi[1], vhi[2], vhi[3]};
#pragma unroll
                for (int i = 0; i < 8; ++i) {
                    const f32x4 d4 = *(const LAS f32x4*)(lds + HL_D + (16 * i + 4 * g4) * 4);
                    const LAS char* kp = lds + HL_KT + (8 * g4 + (c16 >> 2)) * HG_STR + (16 * i + 4 * (c16 & 3)) * 2;
                    const s16x4 klo = vtr(kp), khi = vtr(kp + 4 * HG_STR);
                    const bf16x8 ka = (bf16x8){klo[0], klo[1], klo[2], klo[3], khi[0], khi[1], khi[2], khi[3]};
                    S[i] = MFMA16(ka, vb, S[i] * d4);
                }
            }
        }
        __syncthreads();
        if (c > 0) {
            const LAS float* op = (const LAS float*)(lds + HL_OUT) + vrow * 132 + vcol;
            const f32x4 a = *(const LAS f32x4*)op, bq = *(const LAS f32x4*)(op + 4);
            float ss = (a.x * a.x + a.y * a.y) + (a.z * a.z + a.w * a.w) + (bq.x * bq.x + bq.y * bq.y) + (bq.z * bq.z + bq.w * bq.w);
            ss += __shfl_xor(ss, 1); ss += __shfl_xor(ss, 2); ss += __shfl_xor(ss, 4); ss += __shfl_xor(ss, 8);
            const float rs = 1.f / sqrtf(ss * (1.f / 128.f) + EPS);
            const size_t row = (size_t)b * SEQ + 32 * (c - 1) + vrow;
            const u32x4 gv = *(const u32x4*)((const bf16_t*)(ws + WS_SG) + row * 512 + h * 128 + vcol);
            const f32x4 w0 = *(const f32x4*)(P.rec_norm_w + h * 128 + vcol), w1 = *(const f32x4*)(P.rec_norm_w + h * 128 + vcol + 4);
            f32x4 r0, r1;
            r0.x = a.x * rs * w0.x * bf2f(gv.x & 0xffffu); r0.y = a.y * rs * w0.y * bf2f(gv.x >> 16);
            r0.z = a.z * rs * w0.z * bf2f(gv.y & 0xffffu); r0.w = a.w * rs * w0.w * bf2f(gv.y >> 16);
            r1.x = bq.x * rs * w1.x * bf2f(gv.z & 0xffffu); r1.y = bq.y * rs * w1.y * bf2f(gv.z >> 16);
            r1.z = bq.z * rs * w1.z * bf2f(gv.w & 0xffffu); r1.w = bq.w * rs * w1.w * bf2f(gv.w >> 16);
            *(u32x4*)((bf16_t*)(ws + WS_MIX) + row * DM + 512 + h * 128 + vcol) = pack8(r0, r1);
        }
    }
#undef HG_LOAD
    __syncthreads();
}
template <int CTRL> DI float dpp_f(float v) { return __builtin_bit_cast(float, __builtin_amdgcn_update_dpp(0, __builtin_bit_cast(int, v), CTRL, 0xf, 0xf, false)); }
DI float row16_max(float v) { v = fmaxf(v, dpp_f<0x128>(v)); v = fmaxf(v, dpp_f<0x124>(v)); v = fmaxf(v, dpp_f<0x122>(v)); v = fmaxf(v, dpp_f<0x121>(v)); return v; }
DI float row16_sum(float v) { v += dpp_f<0x128>(v); v += dpp_f<0x124>(v); v += dpp_f<0x122>(v); v += dpp_f<0x121>(v); return v; }
constexpr int TK_SC = 0, TK_TOPV = 65536, TK_TOPI = TK_TOPV + 8192;

DI void topk_item(const Params& P, int tt, int hh, char* lds_g) {
    LAS char* lds = (LAS char*)lds_g;
    const int tid = tid_(), lane = tid & 63, r32 = lane & 31, hi = lane >> 5, l16 = lane & 15, rg = lane >> 4;
    const int wid = __builtin_amdgcn_readfirstlane(tid >> 6);
    const unsigned char* ws = P.ws;
    {
        const int p = wid >> 2, tb = wid & 1, kh = (wid >> 1) & 1;
        const bf16_t* qp = (const bf16_t*)(ws + WS_PQ) + (size_t)(64 * tt + 32 * tb + r32) * 2048 + hh * 256 + p * 128 + 8 * hi;
        const bf16_t* kp = (const bf16_t*)(ws + WS_SKB) + (size_t)((hh * 2 + p) * 128 + 64 * kh + r32) * 128 + 8 * hi;
        f32x16 a0 = f32x16{}, a1 = f32x16{};
#pragma unroll
        for (int ks = 0; ks < 8; ++ks) {
            const bf16x8 qa = *(const bf16x8*)(qp + 16 * ks);
            const bf16x8 k0 = *(const bf16x8*)(kp + 16 * ks), k1 = *(const bf16x8*)(kp + 32 * 128 + 16 * ks);
            a0 = MFMA32(qa, k0, a0); a1 = MFMA32(qa, k1, a1);
        }
        LAS float* sc = (LAS float*)(lds + TK_SC) + (p * 64 + 32 * tb) * 128 + 64 * kh + r32;
#pragma unroll
        for (int r = 0; r < 16; ++r) { sc[crow(r, hi) * 128] = a0[r]; sc[crow(r, hi) * 128 + 32] = a1[r]; }
    }
    __syncthreads();
#pragma unroll 1
    for (int ps = 0; ps < 4; ++ps) {
        const int rr = (wid * 4 + ps) * 4 + rg;
        const LAS float* row = (const LAS float*)(lds + TK_SC) + rr * 128;
        float v[8];
#pragma unroll
        for (int e = 0; e < 8; ++e) { const int key = l16 + 16 * e; v[e] = __uint_as_float((__float_as_uint(row[key]) & 0xFFFFFF80u) | (unsigned)key); }
        float topv = 0.f;
#pragma unroll 1
        for (int it = 0; it < 16; ++it) {
            float m = fmaxf(fmaxf(fmaxf(v[0], v[1]), fmaxf(v[2], v[3])), fmaxf(fmaxf(v[4], v[5]), fmaxf(v[6], v[7])));
            m = row16_max(m);
#pragma unroll
            for (int e = 0; e < 8; ++e) v[e] = (v[e] == m) ? -INFINITY : v[e];
            if (l16 == it) topv = m;
        }
        const int key = (int)(__float_as_uint(topv) & 127u);
        ((LAS float*)(lds + TK_TOPV))[rr * 16 + l16] = row[key];
        ((LAS int*)(lds + TK_TOPI))[rr * 16 + l16] = key;
    }
    __syncthreads();
#pragma unroll 1
    for (int ps = 0; ps < 2; ++ps) {
        const int tok = (wid * 2 + ps) * 4 + rg;
        const LAS float* tv0 = (const LAS float*)(lds + TK_TOPV) + tok * 16; const LAS float* tv1 = tv0 + 64 * 16;
        const LAS int* ti0 = (const LAS int*)(lds + TK_TOPI) + tok * 16; const LAS int* ti1 = ti0 + 64 * 16;
        const float a0 = tv0[l16];
        float v[16];
#pragma unroll
        for (int j = 0; j < 16; ++j) v[j] = __uint_as_float((__float_as_uint(a0 + tv1[j]) & 0xFFFFFF00u) | (unsigned)(l16 * 16 + j));
        float topv = 0.f;
#pragma unroll 1
        for (int it = 0; it < 16; ++it) {
            float m = v[0];
#pragma unroll
            for (int j = 1; j < 16; ++j) m = fmaxf(m, v[j]);
            m = row16_max(m);
#pragma unroll
            for (int j = 0; j < 16; ++j) v[j] = (v[j] == m) ? -INFINITY : v[j];
            if (l16 == it) topv = m;
        }
        const int pos = (int)(__float_as_uint(topv) & 255u), ci = pos >> 4, cj = pos & 15;
        const float s = tv0[ci] + tv1[cj];
        const int eid = ti0[ci] * 128 + ti1[cj];
        const float mx = row16_max(s), ex = __expf(s - mx), sum = row16_sum(ex);
        const size_t o = (size_t)(64 * tt + tok) * 128 + hh * 16 + l16;
        ((int*)(ws + WS_EIDX))[o] = eid;
        ((float*)(ws + WS_EGATE))[o] = ex / sum;
    }
    __syncthreads();
}

DI float gelu_exact(float x) { return 0.5f * x * (1.f + erff(x * 0.70710678118654752f)); }
typedef __bf16 bf16x8_t __attribute__((ext_vector_type(8)));
DI float dot8(u32x4 a, u32x4 x, float acc) {
    const bf16x8_t a8 = __builtin_bit_cast(bf16x8_t, a), x8 = __builtin_bit_cast(bf16x8_t, x);
    acc = __builtin_amdgcn_fdot2_f32_bf16(__builtin_shufflevector(a8, a8, 0, 1), __builtin_shufflevector(x8, x8, 0, 1), acc, false);
    acc = __builtin_amdgcn_fdot2_f32_bf16(__builtin_shufflevector(a8, a8, 2, 3), __builtin_shufflevector(x8, x8, 2, 3), acc, false);
    acc = __builtin_amdgcn_fdot2_f32_bf16(__builtin_shufflevector(a8, a8, 4, 5), __builtin_shufflevector(x8, x8, 4, 5), acc, false);
    acc = __builtin_amdgcn_fdot2_f32_bf16(__builtin_shufflevector(a8, a8, 6, 7), __builtin_shufflevector(x8, x8, 6, 7), acc, false);
    return acc;
}
DI float readlane_f(float v, int l) { return __builtin_bit_cast(float, __builtin_amdgcn_readlane(__builtin_bit_cast(int, v), l)); }
DI float wave_sum_dpp(float v) {
    v = row16_sum(v);
    return (readlane_f(v, 0) + readlane_f(v, 16)) + (readlane_f(v, 32) + readlane_f(v, 48));
}

DI void peer_hid_phase(const Params& P, int bid, int nblk) {
    const int tid = tid_(), lane = tid & 63, wave = __builtin_amdgcn_readfirstlane(tid >> 6);
    const unsigned char* ws = P.ws;
    const bf16_t* UB = (const bf16_t*)(ws + WS_UB);
    const int gw = bid * NWAVES + wave, NGW = nblk * NWAVES;
    const f32x4 w0 = *(const f32x4*)(P.ffn_norm_w + 8 * lane), w1 = *(const f32x4*)(P.ffn_norm_w + 8 * lane + 4), w2 = *(const f32x4*)(P.ffn_norm_w + 512 + 8 * lane), w3 = *(const f32x4*)(P.ffn_norm_w + 516 + 8 * lane);
    for (int n = gw; n < NTOK; n += NGW) {
        const float* hrow = P.out + (size_t)n * DM;
        f32x4 h0 = *(const f32x4*)(hrow + 8 * lane), h1 = *(const f32x4*)(hrow + 8 * lane + 4), h2 = *(const f32x4*)(hrow + 512 + 8 * lane), h3 = *(const f32x4*)(hrow + 516 + 8 * lane);
        float ss = (h0.x * h0.x + h0.y * h0.y) + (h0.z * h0.z + h0.w * h0.w) + (h1.x * h1.x + h1.y * h1.y) + (h1.z * h1.z + h1.w * h1.w)
                 + (h2.x * h2.x + h2.y * h2.y) + (h2.z * h2.z + h2.w * h2.w) + (h3.x * h3.x + h3.y * h3.y) + (h3.z * h3.z + h3.w * h3.w);
        ss = wave_sum_dpp(ss);
        const float r2 = 1.f / sqrtf(ss * (1.f / DM) + EPS);
        h0 = h0 * w0 * r2; h1 = h1 * w1 * r2; h2 = h2 * w2 * r2; h3 = h3 * w3 * r2;
        const u32x4 xlo = pack8(h0, h1), xhi = pack8(h2, h3);
        const int* eidx = (const int*)(ws + WS_EIDX) + (size_t)n * 128;
        const float* egate = (const float*)(ws + WS_EGATE) + (size_t)n * 128;
        const int id0 = eidx[lane], id1 = eidx[64 + lane];
        float hid0 = 0.f, hid1 = 0.f;
#pragma unroll 1
        for (int k0 = 0; k0 < 128; k0 += 8) {
            u32x4 ra[8], rb[8];
#pragma unroll
            for (int e = 0; e < 8; ++e) {
                const int k = k0 + e;
                const int id = (k0 < 64) ? __builtin_amdgcn_readlane(id0, k & 63) : __builtin_amdgcn_readlane(id1, k & 63);
                const bf16_t* rowp = UB + (size_t)id * DM;
                ra[e] = *(const u32x4*)(rowp + 8 * lane); rb[e] = *(const u32x4*)(rowp + 512 + 8 * lane);
            }
#pragma unroll
            for (int e = 0; e < 8; ++e) {
                const int k = k0 + e;
                float d = dot8(ra[e], xlo, 0.f); d = dot8(rb[e], xhi, d);
                d = wave_sum_dpp(d);
                if (k0 < 64) { if (lane == (k & 63)) hid0 = d; } else { if (lane == (k & 63)) hid1 = d; }
            }
        }
        float* hid = (float*)(ws + WS_HID) + (size_t)n * 128;
        hid[lane] = gelu_exact(hid0) * egate[lane];
        hid[64 + lane] = gelu_exact(hid1) * egate[64 + lane];
    }
}

DI void peer_out_phase(const Params& P, int bid, int nblk) {
    const int tid = tid_(), lane = tid & 63, wave = __builtin_amdgcn_readfirstlane(tid >> 6);
    const unsigned char* ws = P.ws;
    const bf16_t* VB = (const bf16_t*)(ws + WS_VB);
    const int gw = bid * NWAVES + wave, NGW = nblk * NWAVES;
    const f32x4 w0 = *(const f32x4*)(P.final_w + 8 * lane), w1 = *(const f32x4*)(P.final_w + 8 * lane + 4), w2 = *(const f32x4*)(P.final_w + 512 + 8 * lane), w3 = *(const f32x4*)(P.final_w + 516 + 8 * lane);
    for (int n = gw; n < NTOK; n += NGW) {
        const int* eidx = (const int*)(ws + WS_EIDX) + (size_t)n * 128;
        const float* hid = (const float*)(ws + WS_HID) + (size_t)n * 128;
        const int id0 = eidx[lane], id1 = eidx[64 + lane];
        const float c0 = hid[lane], c1 = hid[64 + lane];
        float acc[16];
#pragma unroll
        for (int i = 0; i < 16; ++i) acc[i] = 0.f;
#pragma unroll 1
        for (int k0 = 0; k0 < 128; k0 += 8) {
            u32x4 ra[8], rb[8]; float cf[8];
#pragma unroll
            for (int e = 0; e < 8; ++e) {
                const int k = k0 + e;
                const int id = (k0 < 64) ? __builtin_amdgcn_readlane(id0, k & 63) : __builtin_amdgcn_readlane(id1, k & 63);
                cf[e] = (k0 < 64) ? readlane_f(c0, k & 63) : readlane_f(c1, k & 63);
                const bf16_t* rowp = VB + (size_t)id * DM;
                ra[e] = *(const u32x4*)(rowp + 8 * lane); rb[e] = *(const u32x4*)(rowp + 512 + 8 * lane);
            }
#pragma unroll
            for (int e = 0; e < 8; ++e) {
                const float c = cf[e];
                const unsigned uu[8] = {ra[e].x, ra[e].y, ra[e].z, ra[e].w, rb[e].x, rb[e].y, rb[e].z, rb[e].w};
#pragma unroll
                for (int q = 0; q < 8; ++q) { acc[2 * q] += c * __uint_as_float(uu[q] << 16); acc[2 * q + 1] += c * __uint_as_float(uu[q] & 0xffff0000u); }
            }
        }
        float* orow = P.out + (size_t)n * DM;
        f32x4 h0 = *(const f32x4*)(orow + 8 * lane), h1 = *(const f32x4*)(orow + 8 * lane + 4), h2 = *(const f32x4*)(orow + 512 + 8 * lane), h3 = *(const f32x4*)(orow + 516 + 8 * lane);
        h0 += (f32x4){acc[0], acc[1], acc[2], acc[3]}; h1 += (f32x4){acc[4], acc[5], acc[6], acc[7]};
        h2 += (f32x4){acc[8], acc[9], acc[10], acc[11]}; h3 += (f32x4){acc[12], acc[13], acc[14], acc[15]};
        float ss = (h0.x * h0.x + h0.y * h0.y) + (h0.z * h0.z + h0.w * h0.w) + (h1.x * h1.x + h1.y * h1.y) + (h1.z * h1.z + h1.w * h1.w)
                 + (h2.x * h2.x + h2.y * h2.y) + (h2.z * h2.z + h2.w * h2.w) + (h3.x * h3.x + h3.y * h3.y) + (h3.z * h3.z + h3.w * h3.w);
        ss = wave_sum_dpp(ss);
        const float rs = 1.f / sqrtf(ss * (1.f / DM) + EPS);
        *(f32x4*)(orow + 8 * lane) = h0 * w0 * rs; *(f32x4*)(orow + 8 * lane + 4) = h1 * w1 * rs;
        *(f32x4*)(orow + 512 + 8 * lane) = h2 * w2 * rs; *(f32x4*)(orow + 516 + 8 * lane) = h3 * w3 * rs;
    }
}

#ifdef DBG_CHECK
DI void dbg_max(float* slot, float v) { atomicMax((unsigned*)slot, __float_as_uint(fmaxf(v, 0.f))); }
DI void dbg_check_topk(const Params& P, char* lds_g, int bid, int nblk) {
    LAS char* lds = (LAS char*)lds_g;
    const int tid = tid_(), lane = tid & 63, wave = __builtin_amdgcn_readfirstlane(tid >> 6);
    const unsigned char* ws = P.ws; float* dbg = (float*)(ws + WS_CTL) + 64;
    LAS float* sc = (LAS float*)(lds) + wave * 1024;
    const int gw = bid * NWAVES + wave;
    const int token = (gw * 37) % NTOK, hh = gw & 7;
    for (int p = 0; p < 2; ++p) for (int kk = 0; kk < 2; ++kk) {
        const int key = lane + 64 * kk; float a = 0.f;
        const bf16_t* q = (const bf16_t*)(ws + WS_PQ) + (size_t)token * 2048 + hh * 256 + p * 128;
        const bf16_t* sk = (const bf16_t*)(ws + WS_SKB) + (size_t)((hh * 2 + p) * 128 + key) * 128;
        for (int c = 0; c < 128; ++c) a += bf2f(q[c]) * bf2f(sk[c]);
        sc[p * 128 + key] = a;
    }
    asm volatile("s_waitcnt lgkmcnt(0)" ::: "memory");
    for (int p = 0; p < 2; ++p) for (int kk = 0; kk < 2; ++kk) {
        const int key = lane + 64 * kk; const float v = sc[p * 128 + key]; int rank = 0;
        for (int o = 0; o < 128; ++o) { const float w = sc[p * 128 + o]; rank += (w > v || (w == v && o < key)) ? 1 : 0; }
        if (rank < 16) { sc[256 + p * 16 + rank] = v; sc[288 + p * 16 + rank] = __int_as_float(key); }
    }
    asm volatile("s_waitcnt lgkmcnt(0)" ::: "memory");
    for (int e = 0; e < 4; ++e) {
        const int c = lane * 4 + e, i = c >> 4, j = c & 15; const float v = sc[256 + i] + sc[272 + j]; int rank = 0;
        for (int o = 0; o < 256; ++o) { const float w = sc[256 + (o >> 4)] + sc[272 + (o & 15)]; rank += (w > v || (w == v && o < c)) ? 1 : 0; }
        if (rank < 16) { sc[320 + rank] = __int_as_float(__float_as_int(sc[288 + i]) * 128 + __float_as_int(sc[304 + j])); sc[336 + rank] = v; }
    }
    asm volatile("s_waitcnt lgkmcnt(0)" ::: "memory");
    if (lane < 16) {
        const int eid = __float_as_int(sc[320 + lane]); const float sv = sc[336 + lane];
        float mx = sc[336], sum = 0.f; for (int o = 0; o < 16; ++o) sum += __expf(sc[336 + o] - mx);
        const float gate = __expf(sv - mx) / sum;
        const int* eidx = (const int*)(ws + WS_EIDX) + (size_t)token * 128 + hh * 16; const float* eg = (const float*)(ws + WS_EGATE) + (size_t)token * 128 + hh * 16;
        int found = -1; for (int o = 0; o < 16; ++o) if (eidx[o] == eid) found = o;
        if (found < 0) atomicAdd(dbg + 0, 1.f); else dbg_max(dbg + 1, fabsf(eg[found] - gate));
    }
    if (lane == 0) atomicAdd(dbg + 2, 16.f);
}
DI void dbg_check_hid(const Params& P, int bid, int nblk) {
    const int tid = tid_(), lane = tid & 63, wave = __builtin_amdgcn_readfirstlane(tid >> 6);
    const unsigned char* ws = P.ws; float* dbg = (float*)(ws + WS_CTL) + 64;
    const int gw = bid * NWAVES + wave; const int token = (gw * 53) % NTOK;
    const float* hrow = P.out + (size_t)token * DM;
    float ss = 0.f; for (int c = lane; c < DM; c += 64) ss += hrow[c] * hrow[c];
    ss = wave_sum(ss); const float r2 = 1.f / sqrtf(ss / DM + EPS);
    for (int kk = 0; kk < 2; ++kk) {
        const int k = lane + 64 * kk; const int eid = ((const int*)(ws + WS_EIDX))[(size_t)token * 128 + k];
        const float* urow = P.pu + (size_t)eid * DM; float d = 0.f;
        for (int c = 0; c < DM; ++c) d += urow[c] * (hrow[c] * r2 * P.ffn_norm_w[c]);
        const float hidv = gelu_exact(d) * ((const float*)(ws + WS_EGATE))[(size_t)token * 128 + k];
        const float got = ((const float*)(ws + WS_HID))[(size_t)token * 128 + k];
        dbg_max(dbg + 3, fabsf(got - hidv)); dbg_max(dbg + 4, fabsf(hidv));
    }
}
DI float dbg_enc(float m) { return 8.f + log10f(fmaxf(m, 1e-8f)); }
#endif

#ifdef DBG_CHECK
DI void dbg_check_attn(const Params& P, int bid, int nblk) {
    const int tid = tid_(), lane = tid & 63, wave = __builtin_amdgcn_readfirstlane(tid >> 6);
    const unsigned char* ws = P.ws; float* dbg = (float*)(ws + WS_CTL) + 64;
    const int gw = bid * NWAVES + wave;
    const unsigned hsh = (unsigned)gw * 2654435761u;
    const int b = (hsh >> 8) & 7, h = (hsh >> 11) & 3, i = (int)((hsh >> 13) % 4096u), bh = b * 4 + h;
    const float lam = ((const float*)(ws + WS_LB))[512];
    float oc[2][2], lsum[2], mx[2];
    for (int c = 0; c < 2; ++c) { oc[c][0] = oc[c][1] = 0.f; lsum[c] = 0.f; mx[c] = -1e30f; }
    for (int pp = KPAD; pp <= 64 + i; ++pp) {
        const int tile = pp >> 6, key = pp & 63;
        for (int c = 0; c < 2; ++c) {
            const bf16_t* q = (const bf16_t*)(ws + WS_Q) + ((size_t)((bh * 2 + c) * SEQ + i)) * 64;
            const unsigned char* kimg = ws + WS_K + ((size_t)(bh * 2 + c) * KT + tile) * 8192;
            float sdot = 0.f;
            for (int d = 0; d < 64; ++d) sdot += bf2f(q[d]) * bf2f(*(const bf16_t*)(kimg + (d >> 3) * 1024 + key * 16 + (d & 7) * 2));
            const float mn = fmaxf(mx[c], sdot), al = exp2f(mx[c] - mn), pe = exp2f(sdot - mn);
            const unsigned char* vimg = ws + WS_V + ((size_t)bh * KT + tile) * 16384;
            for (int e = 0; e < 2; ++e) { const int dv = lane + 64 * e; oc[c][e] = oc[c][e] * al + pe * bf2f(*(const bf16_t*)(vimg + (dv >> 5) * 4096 + key * 64 + (dv & 31) * 2)); }
            lsum[c] = lsum[c] * al + pe; mx[c] = mn;
        }
    }
    float o[2], ss = 0.f;
    for (int e = 0; e < 2; ++e) { o[e] = oc[0][e] / lsum[0] - lam * oc[1][e] / lsum[1]; ss += o[e] * o[e]; }
    ss = wave_sum(ss); const float rs = (1.f - LAM_INIT) / sqrtf(ss / 128.f + EPS);
    for (int e = 0; e < 2; ++e) { const int dv = lane + 64 * e; const float want = o[e] * rs * P.subln_w[dv];
        const float got = bf2f(((const bf16_t*)(ws + WS_MIX))[(size_t)(b * SEQ + i) * DM + h * 128 + dv]);
        dbg_max(dbg + 5, fabsf(got - want)); dbg_max(dbg + 6, fabsf(want)); }
}
DI void dbg_check_hgrn(const Params& P, char* lds_g, int bid, int nblk) {
    if (bid >= 32) return;
    LAS float* L = (LAS float*)lds_g;
    const int tid = tid_(), dv = tid & 127, qt = tid >> 7;
    const unsigned char* ws = P.ws; float* dbg = (float*)(ws + WS_CTL) + 64;
    const int bh = bid, b = bid >> 2, h = bid & 3;
    const float* HG = (const float*)(ws + WS_HG) + (size_t)bh * HT * 128;
    const bf16_t* HQ = (const bf16_t*)(ws + WS_HQ) + (size_t)bh * HT * 128;
    const bf16_t* HV = (const bf16_t*)(ws + WS_HV) + (size_t)bh * HT * 128;
    float S[32];
#pragma unroll
    for (int j = 0; j < 32; ++j) S[j] = 0.f;
    for (int pp = 16; pp < HT; ++pp) {
        if (tid < 128) { L[tid] = __expf(HG[(size_t)pp * 128 + tid]); L[128 + tid] = bf2f(HQ[(size_t)pp * 128 + tid]); L[256 + tid] = bf2f(HV[(size_t)pp * 128 + tid]); }
        __syncthreads();
        const float v = L[256 + dv]; float part = 0.f;
#pragma unroll
        for (int j = 0; j < 32; ++j) { const float f = L[32 * qt + j]; S[j] = f * S[j] + (1.f - f) * v; part += L[128 + 32 * qt + j] * S[j]; }
        L[384 + qt * 128 + dv] = part;
        __syncthreads();
        if (tid < 128) { const float o = L[384 + dv] + L[512 + dv] + L[640 + dv] + L[768 + dv]; L[896 + dv] = o; }
        __syncthreads();
        if (tid < 128 && pp >= 32) {
            float ss = 0.f; for (int j = 0; j < 128; ++j) ss += L[896 + j] * L[896 + j];
            const float rs = 1.f / sqrtf(ss / 128.f + EPS);
            const size_t row = (size_t)b * SEQ + (pp - 32);
            const float want = L[896 + dv] * rs * P.rec_norm_w[h * 128 + dv] * bf2f(((const bf16_t*)(ws + WS_SG))[row * 512 + h * 128 + dv]);
            const float got = bf2f(((const bf16_t*)(ws + WS_MIX))[row * DM + 512 + h * 128 + dv]);
            dbg_max(dbg + 7, fabsf(got - want)); dbg_max(dbg + 8, fabsf(want));
        }
        __syncthreads();
    }
}
#endif

#ifdef DBG_CHECK
DI float dbg_proj(const Params& P, int m, int c) {
    const float* xrow = (m < NTOK) ? P.x + (size_t)m * DM : P.meta + (size_t)(m - NTOK) * DM;
    float ss = 0.f, a = 0.f;
    for (int k = 0; k < DM; ++k) { const float xv = xrow[k]; ss += xv * xv; a += xv * P.mix_norm_w[k] * P.w_in[(size_t)k * NCOL1 + c]; }
    return a / sqrtf(ss / DM + EPS);
}
DI void dbg_check_gemm1(const Params& P, int bid, int nblk) {
    const unsigned char* ws = P.ws; float* dbg = (float*)(ws + WS_CTL) + 64;
    const int gt = bid * NTHREADS + tid_();
    if (gt >= 7 * 4096) return;
    const unsigned hsh = (unsigned)gt * 2654435761u;
    const int seg = gt % 7, cs = (hsh >> 7) & 511;
    const bool meta = ((gt / 7) & 15) == 0;
    const int m = meta ? NTOK + ((hsh >> 20) & 15) : (int)((hsh >> 3) % (unsigned)NTOK);
    const int b = meta ? (int)((hsh >> 25) & 7) : (m >> 12), t = meta ? (m - NTOK) : ((m & 4095) + NMETA);
    const int h = cs >> 7;
    float want = 0.f, got = 0.f;
    if (seg <= 1) {
        if (seg == 0 && meta) return;
        const int comp = (cs >> 6) & 1, d = cs & 63, dlo = d & 31;
        const float zlo = dbg_proj(P, m, seg * 512 + (cs & ~63) + dlo), zhi = dbg_proj(P, m, seg * 512 + (cs & ~63) + dlo + 32);
        const double inv = exp2(-(double)dlo * (13.287712379549449 / 32.0)); const float cv = (float)cos((double)t * inv), sv = (float)sin((double)t * inv);
        want = (d < 32) ? zlo * cv - zhi * sv : zhi * cv + zlo * sv;
        if (seg == 0) { want *= QSCALE; got = bf2f(((const bf16_t*)(ws + WS_Q))[((size_t)(((b * 4 + h) * 2 + comp) * SEQ + (m & 4095))) * 64 + d]); }
        else { const int pp = t + KPAD; got = bf2f(*(const bf16_t*)(ws + WS_K + ((size_t)((b * 4 + h) * 2 + comp) * KT + (pp >> 6)) * 8192 + (d >> 3) * 1024 + (pp & 63) * 16 + (d & 7) * 2)); }
    } else {
        const float z = dbg_proj(P, m, seg * 512 + cs); const int dv = cs & 127;
        if (seg == 2) { const int pp = t + KPAD; want = z; got = bf2f(*(const bf16_t*)(ws + WS_V + ((size_t)(b * 4 + h) * KT + (pp >> 6)) * 16384 + (dv >> 5) * 4096 + (pp & 63) * 64 + (dv & 31) * 2)); }
        else if (seg == 3) { want = siluf_(z); got = bf2f(((const bf16_t*)(ws + WS_HQ))[((size_t)(b * 4 + h) * HT + t + 16) * 128 + dv]); }
        else if (seg == 4) { const float l0 = P.lb_logits[cs], l1 = P.lb_logits[512 + cs], lb = __expf(l0) / (__expf(l0) + __expf(l1)); want = __logf(lb + (1.f - lb) * sigmoidf_(z)); got = ((const float*)(ws + WS_HG))[((size_t)(b * 4 + h) * HT + t + 16) * 128 + dv]; }
        else if (seg == 5) { want = z; got = bf2f(((const bf16_t*)(ws + WS_HV))[((size_t)(b * 4 + h) * HT + t + 16) * 128 + dv]); }
        else { if (meta) return; want = siluf_(z); got = bf2f(((const bf16_t*)(ws + WS_SG))[(size_t)m * 512 + cs]); }
    }
    dbg_max(dbg + 16 + seg + (meta ? 8 : 0), fabsf(got - want));
}
#endif
constexpr int LDS_BYTES = 147456;
constexpr int LDS_ITEM = LDS_BYTES - 64;
constexpr int N_HGRN_ITEMS = BATCH * 4, N_ATT_ITEMS = BATCH * 4 * 32;

DI void mixer_phase(const Params& P, char* lds) {
    unsigned* ctr = (unsigned*)(P.ws + WS_CTL);
    for (;;) {
        if (tid_() == 0) *(LAS int*)((LAS char*)lds + LDS_ITEM) = (int)atomicAdd(ctr, 1u);
        __syncthreads();
        const int item = *(LAS int*)((LAS char*)lds + LDS_ITEM);
        __syncthreads();
        if (item >= N_HGRN_ITEMS + N_ATT_ITEMS) break;
        if (item < N_HGRN_ITEMS) hgrn_unit(P, item >> 2, item & 3, lds);
        else { const int a = item - N_HGRN_ITEMS, j = 31 - (a >> 5), bh = a & 31; attn_unit(P, bh >> 2, bh & 3, j, lds); }
    }
}

__global__ void __launch_bounds__(NTHREADS, 2) fwd_megakernel(Params P) {
    extern __shared__ __attribute__((aligned(16))) char lds[];
    cg::grid_group grid = cg::this_grid();
    const int bid = blockIdx.x, nblk = gridDim.x;
    unsigned char* ws = P.ws;
    phase0(P, lds, bid, nblk);
    grid.sync();
    { Epi1 e{ws}; gemm_run(lds, (const bf16_t*)(ws + WS_XB), (const bf16_t*)(ws + WS_W1T), M1, NCOL1, DM, e, bid, nblk); }
    grid.sync();
#if defined(DBG_CHECK) && DBG_SEL == 3
    dbg_check_gemm1(P, bid, nblk);
    grid.sync();
    {
        const float* dbg = (const float*)(ws + WS_CTL) + 64;
        float mxe = 0.f; int arg = 0; for (int q = 0; q < 16; ++q) if (dbg[16 + q] > mxe) { mxe = dbg[16 + q]; arg = q; }
        const float c1 = sqrtf(100.f * dbg_enc(mxe)), c2 = 1000.f * (1.f + arg);
        const size_t gt = (size_t)bid * NTHREADS + threadIdx.x, NGT = (size_t)nblk * NTHREADS;
        for (size_t i = gt; i < (size_t)NTOK * DM; i += NGT) P.out[i] = (i == 0) ? c2 : c1;
    }
    return;
#endif
    mixer_phase(P, lds);
    grid.sync();
#if defined(DBG_CHECK) && DBG_SEL == 2
    dbg_check_attn(P, bid, nblk);
    dbg_check_hgrn(P, lds, bid, nblk);
    grid.sync();
    {
        const float* dbg = (const float*)(ws + WS_CTL) + 64;
        const float c1 = sqrtf(100.f * dbg_enc(dbg[5] / fmaxf(dbg[6], 1e-20f))), c2 = 1000.f * dbg_enc(dbg[7] / fmaxf(dbg[8], 1e-20f));
        const size_t gt = (size_t)bid * NTHREADS + threadIdx.x, NGT = (size_t)nblk * NTHREADS;
        for (size_t i = gt; i < (size_t)NTOK * DM; i += NGT) P.out[i] = (i == 0) ? c2 : c1;
    }
    return;
#endif
    { Epi3 e{P.x, P.out, (bf16_t*)(ws + WS_XB), (float*)(ws + WS_SSQ)}; gemm_run(lds, (const bf16_t*)(ws + WS_MIX), (const bf16_t*)(ws + WS_W2T), NTOK, DM, DM, e, bid, nblk); }
    grid.sync();
    { Epi4 e{(const float*)(ws + WS_SSQ), (bf16_t*)(ws + WS_PQ)}; gemm_run(lds, (const bf16_t*)(ws + WS_XB), (const bf16_t*)(ws + WS_W3T), NTOK, 2048, DM, e, bid, nblk); }
    grid.sync();
    for (int it = bid; it < (NTOK / 64) * 8; it += nblk) topk_item(P, it >> 3, it & 7, lds);
    grid.sync();
#ifdef DBG_CHECK
    dbg_check_topk(P, lds, bid, nblk);
#endif
    peer_hid_phase(P, bid, nblk);
    grid.sync();
#ifdef DBG_CHECK
    dbg_check_hid(P, bid, nblk);
    grid.sync();
    {
        const float* dbg = (const float*)(ws + WS_CTL) + 64;
        const float mA = DBG_SEL == 0 ? dbg[0] / fmaxf(dbg[2], 1.f) : dbg[3] / fmaxf(dbg[4], 1e-20f);
        const float mB = DBG_SEL == 0 ? dbg[1] : dbg[4];
        const float c1 = sqrtf(100.f * dbg_enc(mA)), c2 = 1000.f * dbg_enc(mB);
        const size_t gt = (size_t)bid * NTHREADS + threadIdx.x, NGT = (size_t)nblk * NTHREADS;
        for (size_t i = gt; i < (size_t)NTOK * DM; i += NGT) P.out[i] = (i == 0) ? c2 : c1;
    }
#else
    peer_out_phase(P, bid, nblk);
#endif
}

extern "C" void kernel_launch(void* const* d_in, const int* in_sizes, int n_in, void* d_out, int out_size, void* d_ws, size_t ws_size, hipStream_t stream) {
    static int grid = 0;
    if (grid == 0) {
        int dev = 0, cus = 0, per_cu = 0;
        (void)hipGetDevice(&dev);
        (void)hipDeviceGetAttribute(&cus, hipDeviceAttributeMultiprocessorCount, dev);
        (void)hipFuncSetAttribute((const void*)fwd_megakernel, hipFuncAttributeMaxDynamicSharedMemorySize, LDS_BYTES);
        (void)hipOccupancyMaxActiveBlocksPerMultiprocessor(&per_cu, (const void*)fwd_megakernel, NTHREADS, LDS_BYTES);
        if (per_cu < 1) { fprintf(stderr, "kernel_launch: occupancy query says %d blocks per CU\n", per_cu); per_cu = 1; }
        grid = cus * 1;
        if (ws_size < WS_END) { fprintf(stderr, "kernel_launch: workspace too small: %zu < %zu\n", ws_size, (size_t)WS_END); grid = -1; }
    }
    if (grid < 0) return;
    (void)hipMemsetAsync((char*)d_ws + WS_CTL, 0, CTL_BYTES, stream);
    Params p{};
    p.x = (const float*)d_in[0]; p.meta = (const float*)d_in[1]; p.mix_norm_w = (const float*)d_in[2]; p.w_in = (const float*)d_in[3];
    p.lb_logits = (const float*)d_in[4]; p.rec_norm_w = (const float*)d_in[5]; p.lq1 = (const float*)d_in[6]; p.lk1 = (const float*)d_in[7];
    p.lq2 = (const float*)d_in[8]; p.lk2 = (const float*)d_in[9]; p.subln_w = (const float*)d_in[10]; p.w_out = (const float*)d_in[11];
    p.ffn_norm_w = (const float*)d_in[12]; p.wq = (const float*)d_in[13]; p.subkeys = (const float*)d_in[14]; p.pu = (const float*)d_in[15];
    p.pv = (const float*)d_in[16]; p.final_w = (const float*)d_in[17];
    p.out = (float*)d_out; p.ws = (unsigned char*)d_ws;
    void* args[] = {&p};
    hipError_t e = hipLaunchCooperativeKernel((const void*)fwd_megakernel, dim3(grid), dim3(NTHREADS), args, LDS_BYTES, stream);
    if (e != hipSuccess) fprintf(stderr, "cooperative launch failed: %s (grid %d)\n", hipGetErrorString(e), grid);
}
```

```cpp
#include <hip/hip_runtime.h>
#include <hip/hip_cooperative_groups.h>
#include <cstdio>
#include <cstdint>
#define DBG_SEL 1
namespace cg = cooperative_groups;

constexpr int BATCH = 8, SEQ = 4096, DM = 1024, NMETA = 16;
constexpr int NTOK = BATCH * SEQ;
constexpr int M1 = NTOK + 256;
constexpr int NCOL1 = 3584;
constexpr int TPOS = NMETA + SEQ;
constexpr int KT = 65;
constexpr int KPAD = 48;
constexpr int HT = 4128;
constexpr int NEXP = 16384;
constexpr float EPS = 1e-6f;
constexpr float LAM_INIT = 0.2f;
constexpr float QSCALE = 0.125f * 1.4426950408889634f;
constexpr int NTHREADS = 512, NWAVES = 8;

typedef unsigned short bf16_t;
typedef short bf16x8 __attribute__((ext_vector_type(8)));
typedef float f32x4 __attribute__((ext_vector_type(4)));
typedef float f32x16 __attribute__((ext_vector_type(16)));
typedef float f32x2 __attribute__((ext_vector_type(2)));
typedef unsigned u32x4 __attribute__((ext_vector_type(4)));
typedef unsigned u32x2 __attribute__((ext_vector_type(2)));
typedef __bf16 bf16x2_t __attribute__((ext_vector_type(2)));
typedef short s16x4 __attribute__((ext_vector_type(4)));
#define LAS __attribute__((address_space(3)))
#define DI __device__ __forceinline__
__device__ __forceinline__ int tid_() { int t = threadIdx.x; asm volatile("" : "+v"(t)); return t; }

constexpr size_t al256(size_t x) { return (x + 255) & ~(size_t)255; }
constexpr size_t WS_CTL = 0, CTL_BYTES = 65536;
constexpr size_t WS_W1T = WS_CTL + CTL_BYTES;
constexpr size_t WS_W2T = WS_W1T + (size_t)NCOL1 * DM * 2;
constexpr size_t WS_W3T = WS_W2T + (size_t)DM * DM * 2;
constexpr size_t WS_SKB = WS_W3T + (size_t)2048 * DM * 2;
constexpr size_t WS_UB = WS_SKB + (size_t)16 * 128 * 128 * 2;
constexpr size_t WS_VB = WS_UB + (size_t)NEXP * DM * 2;
constexpr size_t WS_USC = WS_UB + (size_t)NEXP * DM, WS_VSC = WS_VB + (size_t)NEXP * DM;
constexpr size_t WS_ROPE = WS_VB + (size_t)NEXP * DM * 2;
constexpr size_t WS_LB = WS_ROPE + (size_t)TPOS * 64 * 4;
constexpr size_t WS_R1 = WS_LB + 4096;
constexpr size_t WS_SSQ = WS_R1 + al256((size_t)M1 * 4);
constexpr size_t WS_XB = WS_SSQ + (size_t)NTOK * 4;
constexpr size_t WS_C = WS_XB + (size_t)M1 * DM * 2;
constexpr size_t WS_Q = WS_C;
constexpr size_t WS_K = WS_Q + (size_t)NTOK * 512 * 2;
constexpr size_t WS_V = WS_K + (size_t)BATCH * 4 * 2 * KT * 8192;
constexpr size_t WS_HQ = WS_V + (size_t)BATCH * 4 * KT * 16384;
constexpr size_t WS_HV = WS_HQ + (size_t)BATCH * 4 * HT * 128 * 2;
constexpr size_t WS_HG = WS_HV + (size_t)BATCH * 4 * HT * 128 * 2;
constexpr size_t WS_SG = WS_HG + (size_t)BATCH * 4 * HT * 128 * 4;
constexpr size_t WS_CEND = WS_SG + (size_t)NTOK * 512 * 2;
constexpr size_t WS_PQ = WS_C;
constexpr size_t WS_EIDX = WS_PQ + (size_t)NTOK * 2048 * 2;
constexpr size_t WS_EGATE = WS_EIDX + (size_t)NTOK * 128 * 4;
constexpr size_t WS_HID = WS_EGATE + (size_t)NTOK * 128 * 4;
static_assert(WS_HID + (size_t)NTOK * 128 * 4 <= WS_CEND, "overlay fits");
constexpr size_t WS_MIX = WS_CEND;
constexpr size_t WS_END = WS_MIX + (size_t)NTOK * DM * 2;
static_assert(WS_END <= (size_t)512 * 1024 * 1024, "workspace map must fit 512 MiB");

struct Params {
    const float* x; const float* meta; const float* mix_norm_w; const float* w_in; const float* lb_logits; const float* rec_norm_w;
    const float* lq1; const float* lk1; const float* lq2; const float* lk2; const float* subln_w; const float* w_out; const float* ffn_norm_w;
    const float* wq; const float* subkeys; const float* pu; const float* pv; const float* final_w;
    float* out; unsigned char* ws;
};

DI unsigned f2bf(float f) { unsigned u = __builtin_bit_cast(unsigned, f); return (u + 0x7fffu + ((u >> 16) & 1u)) >> 16; }
DI float bf2f(unsigned b) { return __builtin_bit_cast(float, b << 16); }
DI unsigned cvtpk(float lo, float hi) { f32x2 v = {lo, hi}; bf16x2_t b = __builtin_convertvector(v, bf16x2_t); return __builtin_bit_cast(unsigned, b); }
DI float wave_sum(float v) {
#pragma unroll
    for (int o = 1; o < 64; o <<= 1) v += __shfl_xor(v, o);
    return v;
}
DI float sigmoidf_(float x) { return 1.f / (1.f + __expf(-x)); }
DI float siluf_(float x) { return x * sigmoidf_(x); }

DI int sigma_col(int c) {
    if (c >= 1024) return c;
    const int cc = c & 63, a = cc >> 5, fq = (cc >> 3) & 3, n = (cc >> 2) & 1, j = cc & 3;
    return (c & ~63) + 4 * (4 * a + fq) + 32 * n + j;
}
template <bool PERMUTE>
DI void p0_transpose_item(const float* W, int K, int N, const float* scale, bf16_t* WT, LAS float* scr, int item, int lane) {
    const int nblk = N / 32, kb = item / nblk, nb = item % nblk, k0 = 64 * kb, n0 = 32 * nb;
    const int ncol = PERMUTE ? sigma_col(n0 + (lane & 31)) : n0 + (lane & 31);
#pragma unroll 8
    for (int i = 0; i < 32; ++i) { const int kk = 2 * i + (lane >> 5); float s = scale ? scale[k0 + kk] : 1.f; scr[kk * 33 + (lane & 31)] = W[(size_t)(k0 + kk) * N + ncol] * s; }
    asm volatile("s_waitcnt lgkmcnt(0)" ::: "memory");
    const int c = lane & 7;
#pragma unroll
    for (int j = 0; j < 4; ++j) { const int n = (lane >> 3) + 8 * j; const LAS float* s = scr + (8 * c) * 33 + n;
        u32x4 o; o.x = cvtpk(s[0 * 33], s[1 * 33]); o.y = cvtpk(s[2 * 33], s[3 * 33]); o.z = cvtpk(s[4 * 33], s[5 * 33]); o.w = cvtpk(s[6 * 33], s[7 * 33]);
        *(u32x4*)(WT + (size_t)(n0 + n) * K + k0 + 8 * c) = o; }
    asm volatile("s_waitcnt lgkmcnt(0)" ::: "memory");
}

DI void phase0(const Params& P, char* lds, int bid, int nblk) {
    const int tid = tid_(), lane = tid & 63, wave = __builtin_amdgcn_readfirstlane(tid >> 6);
    unsigned char* ws = P.ws;
    LAS float* scr = (LAS float*)(lds) + wave * (64 * 33);
    const int gw = bid * NWAVES + wave, NGW = nblk * NWAVES;
    constexpr int I1 = (DM / 64) * (NCOL1 / 32), I2 = (DM / 64) * (DM / 32), I3 = (DM / 64) * (2048 / 32);
    for (int it = gw; it < I1 + I2 + I3; it += NGW) {
        int r = it;
        if (r < I1) { p0_transpose_item<true>(P.w_in, DM, NCOL1, P.mix_norm_w, (bf16_t*)(ws + WS_W1T), scr, r, lane); continue; } r -= I1;
        if (r < I2) { p0_transpose_item<false>(P.w_out, DM, DM, nullptr, (bf16_t*)(ws + WS_W2T), scr, r, lane); continue; } r -= I2;
        p0_transpose_item<false>(P.wq, DM, 2048, P.ffn_norm_w, (bf16_t*)(ws + WS_W3T), scr, r, lane);
    }
    for (int m = gw; m < M1; m += NGW) {
        bf16_t* orow = (bf16_t*)(ws + WS_XB) + (size_t)m * DM;
        float* r1 = (float*)(ws + WS_R1);
        unsigned long long* o8 = (unsigned long long*)orow + lane;
        if (m >= NTOK + NMETA) { for (int j = 0; j < 4; ++j) o8[64 * j] = 0ull; if (lane == 0) r1[m] = 0.f; continue; }
        const float* xrow = (m < NTOK) ? P.x + (size_t)m * DM : P.meta + (size_t)(m - NTOK) * DM;
        const f32x4* xr = (const f32x4*)xrow + lane;
        f32x4 v[4]; float s = 0.f;
#pragma unroll
        for (int j = 0; j < 4; ++j) { v[j] = xr[64 * j]; s += (v[j].x * v[j].x + v[j].y * v[j].y) + (v[j].z * v[j].z + v[j].w * v[j].w); }
        s = wave_sum(s);
        if (lane == 0) r1[m] = 1.f / sqrtf(s * (1.f / DM) + EPS);
#pragma unroll
        for (int j = 0; j < 4; ++j) o8[64 * j] = (unsigned long long)cvtpk(v[j].x, v[j].y) | ((unsigned long long)cvtpk(v[j].z, v[j].w) << 32);
    }
    {
        const size_t gt = (size_t)bid * NTHREADS + tid, NGT = (size_t)nblk * NTHREADS;
        const size_t ns = (size_t)16 * 128 * 128 / 8;
        for (size_t e = gt; e < ns; e += NGT) {
            const f32x4 a = ((const f32x4*)P.subkeys)[2 * e], b = ((const f32x4*)P.subkeys)[2 * e + 1];
            u32x4 o; o.x = cvtpk(a.x, a.y); o.y = cvtpk(a.z, a.w); o.z = cvtpk(b.x, b.y); o.w = cvtpk(b.z, b.w);
            ((u32x4*)(ws + WS_SKB))[e] = o;
        }
        for (int r = gw; r < 2 * NEXP; r += NGW) {
            const bool isv = r >= NEXP; const int e = isv ? r - NEXP : r;
            const float* src = (isv ? P.pv : P.pu) + (size_t)e * DM + 16 * lane;
            const f32x4 a = *(const f32x4*)src, b = *(const f32x4*)(src + 4), c = *(const f32x4*)(src + 8), d = *(const f32x4*)(src + 12);
            float am = fmaxf(fmaxf(fmaxf(fabsf(a.x), fabsf(a.y)), fmaxf(fabsf(a.z), fabsf(a.w))), fmaxf(fmaxf(fabsf(b.x), fabsf(b.y)), fmaxf(fabsf(b.z), fabsf(b.w))));
            am = fmaxf(am, fmaxf(fmaxf(fmaxf(fabsf(c.x), fabsf(c.y)), fmaxf(fabsf(c.z), fabsf(c.w))), fmaxf(fmaxf(fabsf(d.x), fabsf(d.y)), fmaxf(fabsf(d.z), fabsf(d.w)))));
#pragma unroll
            for (int o = 1; o < 64; o <<= 1) am = fmaxf(am, __shfl_xor(am, o));
            const float sc = (am > 0.f) ? exp2f(floorf(log2f(224.f / am))) : 1.f;
            int w0 = __builtin_amdgcn_cvt_pk_fp8_f32(a.x * sc, a.y * sc, 0, false); w0 = __builtin_amdgcn_cvt_pk_fp8_f32(a.z * sc, a.w * sc, w0, true);
            int w1 = __builtin_amdgcn_cvt_pk_fp8_f32(b.x * sc, b.y * sc, 0, false); w1 = __builtin_amdgcn_cvt_pk_fp8_f32(b.z * sc, b.w * sc, w1, true);
            int w2 = __builtin_amdgcn_cvt_pk_fp8_f32(c.x * sc, c.y * sc, 0, false); w2 = __builtin_amdgcn_cvt_pk_fp8_f32(c.z * sc, c.w * sc, w2, true);
            int w3 = __builtin_amdgcn_cvt_pk_fp8_f32(d.x * sc, d.y * sc, 0, false); w3 = __builtin_amdgcn_cvt_pk_fp8_f32(d.z * sc, d.w * sc, w3, true);
            unsigned char* dst = ws + (isv ? WS_VB : WS_UB) + (size_t)e * DM + 16 * lane;
            *(u32x4*)dst = (u32x4){(unsigned)w0, (unsigned)w1, (unsigned)w2, (unsigned)w3};
            if (lane == 0) ((float*)(ws + (isv ? WS_VSC : WS_USC)))[e] = 1.f / sc;
        }
        float* rope = (float*)(ws + WS_ROPE);
        for (size_t i = gt; i < (size_t)TPOS * 32; i += NGT) {
            const int t = (int)(i >> 5), f = (int)(i & 31);
            const double inv = exp2(-(double)f * (13.287712379549449 / 32.0));
            const double ang = (double)t * inv;
            rope[(size_t)t * 64 + f] = (float)cos(ang); rope[(size_t)t * 64 + 32 + f] = (float)sin(ang);
        }
        float* ssq = (float*)(ws + WS_SSQ);
        for (size_t i = gt; i < (size_t)NTOK; i += NGT) ssq[i] = 0.f;
        for (size_t i = gt; i < (size_t)BATCH * 4 * 2 * 512; i += NGT) { const size_t img = i >> 9, o = i & 511; ((u32x4*)(ws + WS_K + img * KT * 8192))[o] = (u32x4){0u, 0u, 0u, 0u}; }
        for (size_t i = gt; i < (size_t)BATCH * 4 * 1024; i += NGT) { const size_t img = i >> 10, o = i & 1023; ((u32x4*)(ws + WS_V + img * KT * 16384))[o] = (u32x4){0u, 0u, 0u, 0u}; }
        for (size_t i = gt; i < (size_t)BATCH * 4 * 16 * 16; i += NGT) { const size_t bh = i >> 8, o = i & 255;
            ((u32x4*)(ws + WS_HQ + bh * HT * 256))[o] = (u32x4){0u, 0u, 0u, 0u}; ((u32x4*)(ws + WS_HV + bh * HT * 256))[o] = (u32x4){0u, 0u, 0u, 0u}; }
        for (size_t i = gt; i < (size_t)BATCH * 4 * 16 * 32; i += NGT) { const size_t bh = i >> 9, o = i & 511; ((u32x4*)(ws + WS_HG + bh * HT * 512))[o] = (u32x4){0u, 0u, 0u, 0u}; }
        float* lb = (float*)(ws + WS_LB);
        if (gt < 512) lb[gt] = sigmoidf_(P.lb_logits[gt] - P.lb_logits[512 + gt]);
        if (bid == 0 && wave == 0) {
            const float a = wave_sum(P.lq1[lane] * P.lk1[lane]), b = wave_sum(P.lq2[lane] * P.lk2[lane]);
            if (lane == 0) lb[512] = __expf(a) - __expf(b) + LAM_INIT;
        }
    }
}

namespace pg8 {
#define PG8_LAS __attribute__((address_space(3)))
typedef unsigned short bf16_t;
typedef short bf16x8 __attribute__((ext_vector_type(8)));
typedef float f32x4 __attribute__((ext_vector_type(4)));
typedef unsigned u32x4 __attribute__((ext_vector_type(4)));
constexpr int BM = 256, BK = 64, HALF = 128, HTB = HALF * BK * 2  , STAGE_BYTES = 8 * HTB, NXCD = 8, WGM = 8;

__host__ __device__ __forceinline__ int lds_byte(int r, int c) { const int st = (r >> 4) * 2 + (c >> 5), rr = r & 15, cc = c & 31, ob = rr * 64 + cc * 2; return st * 1024 + (ob ^ (((ob >> 9) & 1) << 5)); }
__host__ __device__ __forceinline__ void stage_rc(int b, int& R, int& C) { const int st = b / 1024, sb = b % 1024, swz = sb ^ (((sb >> 9) & 1) << 5); R = (st >> 1) * 16 + swz / 64; C = (st & 1) * 32 + (swz % 64) / 2; }
__host__ __device__ __forceinline__ int perm32(int rho) { const int n = rho >> 4, i = rho & 15; return 8 * (i >> 2) + 4 * n + (i & 3); }

struct Unit { int pm, pn; };
struct Gemm { const bf16_t* A; const bf16_t* Bt; int M, N, K; };

struct StaticOrder {
    int nM, nN, nwg, G, c;
    __host__ __device__ void init(int M, int N, int G_, int c_) { nM = M / BM; nN = N / BM; nwg = nM * nN; G = G_; c = c_; }
    __host__ __device__ bool next(int i, Unit& u) const {
        const long L = (long)i * G + c; if (L >= nwg) return false;
        int wgid = (int)L; { const int q = nwg / NXCD, r = nwg % NXCD, xcd = wgid % NXCD, off = wgid / NXCD; wgid = (xcd < r ? xcd * (q + 1) : r * (q + 1) + (xcd - r) * q) + off; }
        const int nig = WGM * nN, gid = wgid / nig, fm = gid * WGM, gsz = (nM - fm) < WGM ? (nM - fm) : WGM;
        u.pm = fm + ((wgid % nig) % gsz); u.pn = (wgid % nig) / gsz; return true;
    }
    __device__ __forceinline__ void a_ready(const Unit&) const {}
    __device__ __forceinline__ void done(const Unit&) const {}
};

template <class Epi, class Sched, bool ALIGN_EPI = false, bool SP2 = false>
__device__ __forceinline__ void gemm_phase(PG8_LAS unsigned char* lds, const Gemm g, const Sched& S, const Epi& E) {
    const int tid = tid_(), wid = __builtin_amdgcn_readfirstlane(tid >> 6), lane = tid & 63, wr = wid >> 2, wc = wid & 3, fr = lane & 15, fq = lane >> 4;
    const int K = g.K, nt = K / BK;
    unsigned voffA[2], voffB[2];
#pragma unroll
    for (int i = 0; i < 2; ++i) { int R, C; stage_rc(tid * 16 + i * 8192, R, C); const int Rb = Epi::PERM ? ((R & ~31) + perm32(R & 31)) : R;
        voffA[i] = (unsigned)(R * K + C) * 2u; voffB[i] = (unsigned)(Rb * K + C) * 2u; }
    const size_t kstep = (size_t)(BK * 2);
    const size_t hstep = (size_t)HALF * K * 2;
    const size_t tstep = 2 * hstep;
    const unsigned ldsw = (unsigned)wid * 1024u;
    const int aoff = lds_byte(wr * 64 + fr, fq * 8), boff = lds_byte(wc * 32 + fr, fq * 8);
#define PG8_SA(b, h) (((b) * 2 + (h)) * HTB)
#define PG8_SB(b, h) ((4 + (b) * 2 + (h)) * HTB)
#define PG8_STAGE(bufoff, gbase, voff) do { _Pragma("unroll") for (int _i = 0; _i < 2; ++_i) \
        __builtin_amdgcn_global_load_lds((const unsigned*)((const char*)(gbase) + (voff)[_i]), (PG8_LAS unsigned*)(lds + (bufoff) + ldsw + _i * 8192), 16, 0, 0); } while (0)
#define PG8_LDA(dst, b, h) do { _Pragma("unroll") for (int m = 0; m < 4; ++m) _Pragma("unroll") for (int k = 0; k < 2; ++k) dst[m][k] = *(const PG8_LAS bf16x8*)(lds + PG8_SA(b, h) + aoff + m * 2048 + k * 1024); } while (0)
#define PG8_LDB(dst, b, h) do { _Pragma("unroll") for (int n = 0; n < 2; ++n) _Pragma("unroll") for (int k = 0; k < 2; ++k) dst[n][k] = *(const PG8_LAS bf16x8*)(lds + PG8_SB(b, h) + boff + n * 2048 + k * 1024); } while (0)
#define PG8_MMA(ai, bj, At, Bt) do { __builtin_amdgcn_s_setprio(1); _Pragma("unroll") for (int m = 0; m < 4; ++m) _Pragma("unroll") for (int n = 0; n < 2; ++n) _Pragma("unroll") for (int k = 0; k < 2; ++k) \
        acc[ai][bj][m][n] = __builtin_amdgcn_mfma_f32_16x16x32_bf16(Bt[n][k], At[m][k], acc[ai][bj][m][n], 0, 0, 0); __builtin_amdgcn_s_setprio(0); } while (0)
#define PG8_WAIT_V(n) asm volatile("s_waitcnt vmcnt(" #n ")" ::: "memory")
#define PG8_WAIT_L(n) asm volatile("s_waitcnt lgkmcnt(" #n ")" ::: "memory")
#define PG8_BAR __builtin_amdgcn_s_barrier()
#define PG8_SCHED __builtin_amdgcn_sched_barrier(0)
    Unit cur, nxt; int ui = 0;
    if (!S.next(0, cur)) return;
    f32x4 acc[2][2][4][2];
#pragma unroll
    for (int a = 0; a < 2; ++a)
#pragma unroll
        for (int b = 0; b < 2; ++b)
#pragma unroll
            for (int m = 0; m < 4; ++m)
#pragma unroll
                for (int n = 0; n < 2; ++n) acc[a][b][m][n] = (f32x4){0.f, 0.f, 0.f, 0.f};
    bf16x8 At[4][2], B0[2][2], B1[2][2];
    const char* cA = (const char*)g.A + (size_t)cur.pm * tstep; const char* cB = (const char*)g.Bt + (size_t)cur.pn * tstep;
    S.a_ready(cur);
    if constexpr (SP2) {
        PG8_STAGE(PG8_SB(0, 0), cB, voffB); PG8_STAGE(PG8_SB(0, 1), cB + hstep, voffB); PG8_STAGE(PG8_SA(0, 0), cA, voffA); PG8_STAGE(PG8_SA(0, 1), cA + hstep, voffA);
        if (wr == 1) PG8_BAR;
        PG8_WAIT_V(2); PG8_BAR;
        PG8_STAGE(PG8_SB(1, 0), cB + kstep, voffB); PG8_STAGE(PG8_SA(1, 0), cA + kstep, voffA); PG8_STAGE(PG8_SB(1, 1), cB + hstep + kstep, voffB);
        PG8_WAIT_V(6); PG8_BAR;
    } else {
        PG8_STAGE(PG8_SB(0, 0), cB, voffB); PG8_STAGE(PG8_SA(0, 0), cA, voffA); PG8_STAGE(PG8_SB(0, 1), cB + hstep, voffB); PG8_STAGE(PG8_SA(0, 1), cA + hstep, voffA);
        if (wr == 1) PG8_BAR;
        PG8_WAIT_V(4); PG8_BAR;
        PG8_STAGE(PG8_SB(1, 0), cB + kstep, voffB); PG8_STAGE(PG8_SA(1, 0), cA + kstep, voffA); PG8_STAGE(PG8_SB(1, 1), cB + hstep + kstep, voffB);
        PG8_WAIT_V(6); PG8_BAR;
    }
    for (;;) {
        const bool has_next = S.next(ui + 1, nxt);
        const char* nA = has_next ? (const char*)g.A + (size_t)nxt.pm * tstep : cA; const char* nB = has_next ? (const char*)g.Bt + (size_t)nxt.pn * tstep : cB;
        for (int t = 0; t < nt; t += 2) {
            const bool last = (t == nt - 2);
            const char* a1 = cA + (size_t)(t + 1) * kstep;
            const char* a2 = last ? nA : cA + (size_t)(t + 2) * kstep; const char* b2 = last ? nB : cB + (size_t)(t + 2) * kstep;
            const char* a3 = a2 + kstep; const char* b3 = b2 + kstep;
            if (last && has_next) S.a_ready(nxt);
            if constexpr (SP2) {
            PG8_LDB(B0, 0, 0); PG8_LDB(B1, 0, 1); PG8_SCHED; PG8_LDA(At, 0, 0); PG8_STAGE(PG8_SA(1, 1), a1 + hstep, voffA);
            PG8_WAIT_V(8); PG8_WAIT_L(0); PG8_BAR; PG8_MMA(0, 0, At, B0); PG8_MMA(0, 1, At, B1); PG8_BAR; PG8_SCHED;
            PG8_LDA(At, 0, 1); PG8_STAGE(PG8_SB(0, 0), b2, voffB); PG8_STAGE(PG8_SB(0, 1), b2 + hstep, voffB); PG8_STAGE(PG8_SA(0, 0), a2, voffA);
            PG8_WAIT_V(8); PG8_WAIT_L(0); PG8_BAR; PG8_MMA(1, 0, At, B0); PG8_MMA(1, 1, At, B1); PG8_BAR; PG8_SCHED;
            PG8_LDB(B0, 1, 0); PG8_LDB(B1, 1, 1); PG8_SCHED; PG8_LDA(At, 1, 0); PG8_STAGE(PG8_SA(0, 1), a2 + hstep, voffA);
            PG8_WAIT_V(8); PG8_WAIT_L(0); PG8_BAR; PG8_MMA(0, 0, At, B0); PG8_MMA(0, 1, At, B1); PG8_BAR; PG8_SCHED;
            PG8_LDA(At, 1, 1); PG8_STAGE(PG8_SB(1, 0), b3, voffB); PG8_STAGE(PG8_SB(1, 1), b3 + hstep, voffB); PG8_STAGE(PG8_SA(1, 0), a3, voffA);
            PG8_WAIT_V(8); PG8_WAIT_L(0); PG8_BAR; PG8_MMA(1, 0, At, B0); PG8_MMA(1, 1, At, B1); PG8_BAR; PG8_SCHED;
            } else {
            PG8_LDB(B0, 0, 0); PG8_SCHED; PG8_LDA(At, 0, 0); PG8_STAGE(PG8_SA(1, 1), a1 + hstep, voffA);
            PG8_WAIT_L(8); PG8_BAR; PG8_WAIT_L(0); PG8_MMA(0, 0, At, B0); PG8_BAR; PG8_SCHED;
            PG8_LDB(B1, 0, 1); PG8_STAGE(PG8_SB(0, 0), b2, voffB);
            PG8_BAR; PG8_WAIT_L(0); PG8_MMA(0, 1, At, B1); PG8_BAR;
            PG8_LDA(At, 0, 1); PG8_STAGE(PG8_SA(0, 0), a2, voffA);
            PG8_BAR; PG8_WAIT_L(0); PG8_MMA(1, 0, At, B0); PG8_BAR; PG8_SCHED;
            PG8_STAGE(PG8_SB(0, 1), b2 + hstep, voffB);
            PG8_WAIT_V(6); PG8_BAR; PG8_MMA(1, 1, At, B1); PG8_BAR;
            PG8_LDB(B0, 1, 0); PG8_SCHED; PG8_LDA(At, 1, 0); PG8_STAGE(PG8_SA(0, 1), a2 + hstep, voffA);
            PG8_WAIT_L(8); PG8_BAR; PG8_WAIT_L(0); PG8_MMA(0, 0, At, B0); PG8_BAR; PG8_SCHED;
            PG8_LDB(B1, 1, 1); PG8_STAGE(PG8_SB(1, 0), b3, voffB);
            PG8_BAR; PG8_WAIT_L(0); PG8_MMA(0, 1, At, B1); PG8_BAR;
            PG8_LDA(At, 1, 1); PG8_STAGE(PG8_SA(1, 0), a3, voffA);
            PG8_BAR; PG8_WAIT_L(0); PG8_MMA(1, 0, At, B0); PG8_BAR; PG8_SCHED;
            PG8_STAGE(PG8_SB(1, 1), b3 + hstep, voffB);
            PG8_WAIT_V(6); PG8_BAR; PG8_MMA(1, 1, At, B1); PG8_BAR;
            }
        }
        if constexpr (ALIGN_EPI) { if (wr == 0) PG8_BAR; }
        if constexpr (!Epi::AFTER_DRAIN) { E(acc, cur, wr, wc, fr, fq); S.done(cur); }
        if (!has_next) break;
#pragma unroll
        for (int a = 0; a < 2; ++a)
#pragma unroll
            for (int b = 0; b < 2; ++b)
#pragma unroll
                for (int m = 0; m < 4; ++m)
#pragma unroll
                    for (int n = 0; n < 2; ++n) acc[a][b][m][n] = (f32x4){0.f, 0.f, 0.f, 0.f};
        cur = nxt; cA = nA; cB = nB; ++ui;
        if constexpr (ALIGN_EPI) { if (wr == 1) PG8_BAR; }
    }
    PG8_WAIT_V(0);
    if constexpr (!ALIGN_EPI) { if (wr == 0) PG8_BAR; }
    PG8_BAR;
    if constexpr (Epi::AFTER_DRAIN) { E.fused(acc, cur, wr, wc, fr, fq, lds, wid, lane); S.done(cur); }
#undef PG8_SA
#undef PG8_SB
#undef PG8_STAGE
#undef PG8_LDA
#undef PG8_LDB
#undef PG8_MMA
#undef PG8_WAIT_V
#undef PG8_WAIT_L
#undef PG8_BAR
#undef PG8_SCHED
}
}

DI u32x2 pack4(f32x4 v) { u32x2 r; r.x = cvtpk(v.x, v.y); r.y = cvtpk(v.z, v.w); return r; }
DI u32x4 pack8(f32x4 a, f32x4 b) { u32x4 r; r.x = cvtpk(a.x, a.y); r.y = cvtpk(a.z, a.w); r.z = cvtpk(b.x, b.y); r.w = cvtpk(b.z, b.w); return r; }

struct Epi1 {
    static constexpr bool PERM = true, AFTER_DRAIN = false;
    unsigned char* ws;
    DI void operator()(const f32x4 (&acc)[2][2][4][2], const pg8::Unit& u, int wr, int wc, int fr, int fq) const {
        const float* r1p = (const float*)(ws + WS_R1);
        const float* rope = (const float*)(ws + WS_ROPE);
        const float* lbp = (const float*)(ws + WS_LB);
        const int seg = u.pn >> 1;
#pragma unroll
        for (int ai = 0; ai < 2; ++ai)
#pragma unroll
            for (int m = 0; m < 4; ++m) {
                const int row = u.pm * 256 + ai * 128 + wr * 64 + m * 16 + fr;
                const bool meta = row >= NTOK;
                if (row >= NTOK + NMETA) continue;
                const float r1 = r1p[row];
                const int b = meta ? 0 : (row >> 12), t = meta ? (row - NTOK) : ((row & 4095) + NMETA);
                const int nrep = meta ? BATCH : 1;
#pragma unroll
                for (int bj = 0; bj < 2; ++bj) {
                    const int cs = (u.pn & 1) * 256 + bj * 128 + wc * 32 + 8 * fq;
                    const f32x4 v0 = acc[ai][bj][m][0] * r1, v1 = acc[ai][bj][m][1] * r1;
                    const int h = cs >> 7;
                    if (seg <= 1) {
                        const int comp = (cs >> 6) & 1, cc = cs & 63, i0 = 16 * (cc >> 5) + 4 * fq;
                        const f32x4 c4 = *(const f32x4*)(rope + (size_t)t * 64 + i0), s4 = *(const f32x4*)(rope + (size_t)t * 64 + 32 + i0);
                        f32x4 lo = v0 * c4 - v1 * s4, hi = v1 * c4 + v0 * s4;
                        if (seg == 0) {
                            if (meta) continue;
                            lo = lo * QSCALE; hi = hi * QSCALE;
                            bf16_t* qp = (bf16_t*)(ws + WS_Q) + ((size_t)(((b * 4 + h) * 2 + comp) * SEQ + (row & 4095))) * 64;
                            *(u32x2*)(qp + i0) = pack4(lo); *(u32x2*)(qp + i0 + 32) = pack4(hi);
                        } else {
                            const int pp = t + KPAD, tile = pp >> 6, key = pp & 63;
                            for (int bb = 0; bb < nrep; ++bb) {
                                const int b_ = meta ? bb : b;
                                unsigned char* img = ws + WS_K + ((size_t)((b_ * 4 + h) * 2 + comp) * KT + tile) * 8192;
                                *(u32x2*)(img + (i0 >> 3) * 1024 + key * 16 + (i0 & 7) * 2) = pack4(lo);
                                *(u32x2*)(img + ((i0 >> 3) + 4) * 1024 + key * 16 + (i0 & 7) * 2) = pack4(hi);
                            }
                        }
                    } else if (seg == 2) {
                        const int dv = cs & 127, pp = t + KPAD, tile = pp >> 6, key = pp & 63;
                        const u32x4 w = pack8(v0, v1);
                        for (int bb = 0; bb < nrep; ++bb) {
                            const int b_ = meta ? bb : b;
                            unsigned char* img = ws + WS_V + ((size_t)(b_ * 4 + h) * KT + tile) * 16384;
                            *(u32x4*)(img + (dv >> 5) * 4096 + key * 64 + (dv & 31) * 2) = w;
                        }
                    } else if (seg == 3 || seg == 5) {
                        const int dv = cs & 127;
                        f32x4 a = v0, c = v1;
                        if (seg == 3) { a.x = siluf_(a.x); a.y = siluf_(a.y); a.z = siluf_(a.z); a.w = siluf_(a.w); c.x = siluf_(c.x); c.y = siluf_(c.y); c.z = siluf_(c.z); c.w = siluf_(c.w); }
                        const u32x4 w = pack8(a, c);
                        const size_t base = (seg == 3) ? WS_HQ : WS_HV;
                        for (int bb = 0; bb < nrep; ++bb) {
                            const int b_ = meta ? bb : b;
                            *(u32x4*)((bf16_t*)(ws + base) + ((size_t)(b_ * 4 + h) * HT + t + 16) * 128 + dv) = w;
                        }
                    } else if (seg == 4) {
                        const int dv = cs & 127;
                        const f32x4 l0 = *(const f32x4*)(lbp + cs), l1 = *(const f32x4*)(lbp + cs + 4);
                        f32x4 g0, g1;
#pragma unroll
                        for (int e = 0; e < 4; ++e) { g0[e] = __logf(l0[e] + (1.f - l0[e]) * sigmoidf_(v0[e])); g1[e] = __logf(l1[e] + (1.f - l1[e]) * sigmoidf_(v1[e])); }
                        for (int bb = 0; bb < nrep; ++bb) {
                            const int b_ = meta ? bb : b;
                            float* gp = (float*)(ws + WS_HG) + ((size_t)(b_ * 4 + h) * HT + t + 16) * 128 + dv;
                            *(f32x4*)gp = g0; *(f32x4*)(gp + 4) = g1;
                        }
                    } else {
                        if (meta) continue;
                        f32x4 a = v0, c = v1;
                        a.x = siluf_(a.x); a.y = siluf_(a.y); a.z = siluf_(a.z); a.w = siluf_(a.w); c.x = siluf_(c.x); c.y = siluf_(c.y); c.z = siluf_(c.z); c.w = siluf_(c.w);
                        *(u32x4*)((bf16_t*)(ws + WS_SG) + (size_t)row * 512 + cs) = pack8(a, c);
                    }
                }
            }
    }
};

struct Epi3 {
    static constexpr bool PERM = true, AFTER_DRAIN = false;
    const float* x; float* H; bf16_t* HB; float* ssq;
    DI void operator()(const f32x4 (&acc)[2][2][4][2], const pg8::Unit& u, int wr, int wc, int fr, int fq) const {
#pragma unroll
        for (int ai = 0; ai < 2; ++ai)
#pragma unroll
            for (int m = 0; m < 4; ++m) {
                const int row = u.pm * 256 + ai * 128 + wr * 64 + m * 16 + fr;
                float s = 0.f;
#pragma unroll
                for (int bj = 0; bj < 2; ++bj) {
                    const int col = u.pn * 256 + bj * 128 + wc * 32 + 8 * fq;
                    const size_t o = (size_t)row * DM + col;
                    const f32x4 h0 = *(const f32x4*)(x + o) + acc[ai][bj][m][0], h1 = *(const f32x4*)(x + o + 4) + acc[ai][bj][m][1];
                    *(f32x4*)(H + o) = h0; *(f32x4*)(H + o + 4) = h1;
                    *(u32x4*)(HB + o) = pack8(h0, h1);
                    s += (h0.x * h0.x + h0.y * h0.y) + (h0.z * h0.z + h0.w * h0.w) + (h1.x * h1.x + h1.y * h1.y) + (h1.z * h1.z + h1.w * h1.w);
                }
                s += __shfl_xor(s, 16); s += __shfl_xor(s, 32);
                if (fq == 0) atomicAdd(ssq + row, s);
            }
    }
};

struct Epi4 {
    static constexpr bool PERM = true, AFTER_DRAIN = false;
    const float* ssq; bf16_t* PQ;
    DI void operator()(const f32x4 (&acc)[2][2][4][2], const pg8::Unit& u, int wr, int wc, int fr, int fq) const {
#pragma unroll
        for (int ai = 0; ai < 2; ++ai)
#pragma unroll
            for (int m = 0; m < 4; ++m) {
                const int row = u.pm * 256 + ai * 128 + wr * 64 + m * 16 + fr;
                const float r2 = 1.f / sqrtf(ssq[row] * (1.f / DM) + EPS);
#pragma unroll
                for (int bj = 0; bj < 2; ++bj) {
                    const int col = u.pn * 256 + bj * 128 + wc * 32 + 8 * fq;
                    *(u32x4*)(PQ + (size_t)row * 2048 + col) = pack8(acc[ai][bj][m][0] * r2, acc[ai][bj][m][1] * r2);
                }
            }
    }
};

template <class Epi>
DI void gemm_run(char* lds, const bf16_t* A, const bf16_t* Bt, int M, int N, int K, const Epi& E, int bid, int nblk) {
    pg8::Gemm g{A, Bt, M, N, K}; pg8::StaticOrder S; S.init(M, N, nblk, bid);
    pg8::gemm_phase<Epi, pg8::StaticOrder, true, true>((LAS unsigned char*)lds, g, S, E);
}
#define MFMA32(a, b, c) __builtin_amdgcn_mfma_f32_32x32x16_bf16(a, b, c, 0, 0, 0)
typedef short v4i16_t __attribute__((ext_vector_type(4)));
DI int crow(int r, int hi) { return (r & 3) + 8 * (r >> 2) + 4 * hi; }
DI s16x4 vtr(const LAS char* p) { return __builtin_bit_cast(s16x4, __builtin_amdgcn_ds_read_tr16_b64_v4i16((LAS v4i16_t*)p)); }
DI void glds16(const void* g, LAS char* l) { __builtin_amdgcn_global_load_lds((const unsigned*)g, (LAS unsigned*)l, 16, 0, 0); }
DI float swap_max(float m) { auto rr = __builtin_amdgcn_permlane32_swap(__float_as_uint(m), __float_as_uint(m), false, false); return fmaxf(__uint_as_float(rr[0]), __uint_as_float(rr[1])); }
DI float swap_sum(float m) { auto rr = __builtin_amdgcn_permlane32_swap(__float_as_uint(m), __float_as_uint(m), false, false); return __uint_as_float(rr[0]) + __uint_as_float(rr[1]); }
constexpr int ATT_BUF = 32768, ATT_WSF = 65536;
constexpr float ATT_THR = 8.f;

DI void attn_unit(const Params& P, int b, int h, int j, char* lds_g) {
    LAS char* lds = (LAS char*)lds_g;
    const int tid = tid_(), lane = tid & 63, r32 = lane & 31, hi = lane >> 5;
    const int wid = __builtin_amdgcn_readfirstlane(tid >> 6), comp = wid >> 2, wq = wid & 3;
    const unsigned char* ws = P.ws;
    const int bh = b * 4 + h;
    const bf16_t* Qw = (const bf16_t*)(ws + WS_Q) + ((size_t)((bh * 2 + comp) * SEQ + 128 * j + 32 * wq)) * 64;
    bf16x8 qr[4];
#pragma unroll
    for (int d0 = 0; d0 < 4; ++d0) qr[d0] = *(const bf16x8*)(Qw + r32 * 64 + d0 * 16 + hi * 8);
    const unsigned char* kimg0 = ws + WS_K + (size_t)(bh * 2) * KT * 8192 + wid * 1024 + lane * 16;
    const unsigned char* kimg1 = kimg0 + (size_t)KT * 8192;
    const unsigned char* vimg = ws + WS_V + (size_t)bh * KT * 16384 + wid * 1024 + lane * 16;
    const int NT = 2 * j + 3, my_last = (wq < 2) ? 2 * j + 1 : 2 * j + 2;
    LAS float* wsf = (LAS float*)(lds + ATT_WSF) + wid * 64;
#define ATT_ISSUE(t, s) do { LAS char* d_ = lds + (s) * ATT_BUF + wid * 1024; \
        glds16(kimg0 + (size_t)(t) * 8192, d_); glds16(kimg1 + (size_t)(t) * 8192, d_ + 8192); \
        glds16(vimg + (size_t)(t) * 16384, d_ + 16384); glds16(vimg + (size_t)(t) * 16384 + 8192, d_ + 24576); } while (0)
    f32x16 o[4];
#pragma unroll
    for (int nb = 0; nb < 4; ++nb) o[nb] = f32x16{};
    float mref = 0.f, lsum = 0.f;
    const int qpos = 64 + 128 * j + 32 * wq + r32;
    ATT_ISSUE(0, 0);
    __syncthreads();
    for (int t = 0; t < NT; ++t) {
        const int s = t & 1;
        if (t + 1 < NT) ATT_ISSUE(t + 1, s ^ 1);
        if (t <= my_last) {
            const LAS char* kp = lds + s * ATT_BUF + comp * 8192 + hi * 1024 + r32 * 16;
            f32x16 s0 = f32x16{}, s1 = f32x16{};
#pragma unroll
            for (int d0 = 0; d0 < 4; ++d0) {
                const bf16x8 k0 = *(const LAS bf16x8*)(kp + d0 * 2048), k1 = *(const LAS bf16x8*)(kp + d0 * 2048 + 512);
                s0 = MFMA32(k0, qr[d0], s0); s1 = MFMA32(k1, qr[d0], s1);
            }
            if (t == 0) {
#pragma unroll
                for (int r = 0; r < 16; ++r) { s0[r] = -INFINITY; if (32 + crow(r, hi) < KPAD) s1[r] = -INFINITY; }
            }
            if (t >= 2 * j + 1) {
                const int kb = 64 * t + 4 * hi;
#pragma unroll
                for (int r = 0; r < 16; ++r) { const int kv = kb + (r & 3) + 8 * (r >> 2); if (kv > qpos) s0[r] = -INFINITY; if (kv + 32 > qpos) s1[r] = -INFINITY; }
            }
            float rm = fmaxf(s0[0], s1[0]);
#pragma unroll
            for (int r = 1; r < 16; ++r) rm = fmaxf(rm, fmaxf(s0[r], s1[r]));
            rm = swap_max(rm);
            if (t == 0) mref = rm;
            else {
                const float grow = rm - mref;
                if (__any(grow > ATT_THR)) {
                    const float dl = fmaxf(grow, 0.f), f = __builtin_amdgcn_exp2f(-dl);
                    mref += dl; lsum *= f;
                    if (hi == 0) wsf[r32] = f;
                    asm volatile("s_waitcnt lgkmcnt(0)" ::: "memory");
#pragma unroll
                    for (int r = 0; r < 16; ++r) { const float fr_ = wsf[crow(r, hi)];
#pragma unroll
                        for (int nb = 0; nb < 4; ++nb) o[nb][r] *= fr_; }
                }
            }
            float ps = 0.f;
#pragma unroll
            for (int r = 0; r < 16; ++r) { s0[r] = __builtin_amdgcn_exp2f(s0[r] - mref); s1[r] = __builtin_amdgcn_exp2f(s1[r] - mref); ps += s0[r] + s1[r]; }
            lsum += ps;
            const LAS char* vp = lds + s * ATT_BUF + 16384 + ((lane >> 4) & 1) * 32 + (lane & 3) * 8 + (4 * hi + ((lane & 15) >> 2)) * 64;
#pragma unroll
            for (int ks = 0; ks < 4; ++ks) {
                u32x4 pw;
                if (ks < 2) { pw.x = cvtpk(s0[8 * ks], s0[8 * ks + 1]); pw.y = cvtpk(s0[8 * ks + 2], s0[8 * ks + 3]); pw.z = cvtpk(s0[8 * ks + 4], s0[8 * ks + 5]); pw.w = cvtpk(s0[8 * ks + 6], s0[8 * ks + 7]); }
                else { const int q_ = ks - 2; pw.x = cvtpk(s1[8 * q_], s1[8 * q_ + 1]); pw.y = cvtpk(s1[8 * q_ + 2], s1[8 * q_ + 3]); pw.z = cvtpk(s1[8 * q_ + 4], s1[8 * q_ + 5]); pw.w = cvtpk(s1[8 * q_ + 6], s1[8 * q_ + 7]); }
                const bf16x8 pa = __builtin_bit_cast(bf16x8, pw);
#pragma unroll
                for (int nb = 0; nb < 4; ++nb) {
                    const s16x4 vlo = vtr(vp + nb * 4096 + ks * 1024), vhi = vtr(vp + nb * 4096 + ks * 1024 + 512);
                    const bf16x8 vb = (bf16x8){vlo[0], vlo[1], vlo[2], vlo[3], vhi[0], vhi[1], vhi[2], vhi[3]};
                    o[nb] = MFMA32(pa, vb, o[nb]);
                }
            }
        }
        __syncthreads();
    }
#undef ATT_ISSUE
    lsum = swap_sum(lsum);
    if (hi == 0) wsf[r32] = lsum;
    asm volatile("s_waitcnt lgkmcnt(0)" ::: "memory");
    float rli[16];
#pragma unroll
    for (int r = 0; r < 16; ++r) rli[r] = 1.f / wsf[crow(r, hi)];
    const float lam = ((const float*)(ws + WS_LB))[512];
    LAS float* ex = (LAS float*)lds + wq * 4096;
    if (comp == 1) {
#pragma unroll
        for (int r = 0; r < 16; ++r)
#pragma unroll
            for (int nb = 0; nb < 4; ++nb) ex[(r * 4 + nb) * 64 + lane] = o[nb][r] * rli[r] * lam;
    }
    __syncthreads();
    if (comp == 0) {
        float ss[16];
#pragma unroll
        for (int r = 0; r < 16; ++r) { float a = 0.f;
#pragma unroll
            for (int nb = 0; nb < 4; ++nb) { const float v = o[nb][r] * rli[r] - ex[(r * 4 + nb) * 64 + lane]; o[nb][r] = v; a += v * v; }
            ss[r] = a; }
#pragma unroll
        for (int r = 0; r < 16; ++r) { float a = ss[r]; a += __shfl_xor(a, 1); a += __shfl_xor(a, 2); a += __shfl_xor(a, 4); a += __shfl_xor(a, 8); a += __shfl_xor(a, 16); ss[r] = (1.f - LAM_INIT) / sqrtf(a * (1.f / 128.f) + EPS); }
        bf16_t* mix = (bf16_t*)(ws + WS_MIX) + ((size_t)(b * SEQ + 128 * j + 32 * wq)) * DM + h * 128;
#pragma unroll
        for (int nb = 0; nb < 4; ++nb) { const float w = P.subln_w[32 * nb + r32];
#pragma unroll
            for (int r = 0; r < 16; ++r) mix[(size_t)crow(r, hi) * DM + 32 * nb + r32] = (bf16_t)f2bf(o[nb][r] * ss[r] * w); }
    }
    __syncthreads();
}
#define MFMA16(a, b, c) __builtin_amdgcn_mfma_f32_16x16x32_bf16(a, b, c, 0, 0, 0)
constexpr int HG_STR = 272;
constexpr int HL_QA = 0, HL_QB = HL_QA + 32 * HG_STR, HL_KB = HL_QB + 32 * HG_STR, HL_KT = HL_KB + 32 * HG_STR, HL_VV = HL_KT + 32 * HG_STR;
constexpr int HL_PS = HL_VV + 32 * HG_STR;
constexpr int HL_D = HL_PS + 4 * 128 * 4;
constexpr int HL_OUT = HL_D + 128 * 4;
constexpr int HL_END = HL_OUT + 32 * 132 * 4;

DI void hgrn_unit(const Params& P, int b, int h, char* lds_g) {
    LAS char* lds = (LAS char*)lds_g;
    const int tid = tid_(), lane = tid & 63, c16 = lane & 15, g4 = lane >> 4;
    const int wid = __builtin_amdgcn_readfirstlane(tid >> 6);
    const unsigned char* ws = P.ws;
    const int bh = b * 4 + h;
    const float* HG = (const float*)(ws + WS_HG) + (size_t)bh * HT * 128;
    const bf16_t* HQ = (const bf16_t*)(ws + WS_HQ) + (size_t)bh * HT * 128;
    const bf16_t* HV = (const bf16_t*)(ws + WS_HV) + (size_t)bh * HT * 128;
    const int ch = tid & 127, part = tid >> 7;
    const int vrow = tid >> 4, vcol = (tid & 15) * 8;
    f32x4 S[8];
#pragma unroll
    for (int i = 0; i < 8; ++i) S[i] = (f32x4){0.f, 0.f, 0.f, 0.f};
    float g8[8]; unsigned short q8[8]; u32x4 v16;
#define HG_LOAD(c) do { const size_t r0 = (size_t)(32 * (c) + 8 * part); \
        _Pragma("unroll") for (int e = 0; e < 8; ++e) { g8[e] = HG[(r0 + e) * 128 + ch]; q8[e] = HQ[(r0 + e) * 128 + ch]; } \
        v16 = *(const u32x4*)(HV + ((size_t)(32 * (c)) + vrow) * 128 + vcol); } while (0)
    HG_LOAD(0);
    for (int c = 0; c < 129; ++c) {
        float p8[8]; { float a = 0.f;
#pragma unroll
            for (int e = 0; e < 8; ++e) { a += g8[e]; p8[e] = a; } }
        ((LAS float*)(lds + HL_PS))[part * 128 + ch] = p8[7];
        __syncthreads();
        {
            const LAS float* ps = (const LAS float*)(lds + HL_PS);
            const float t0 = ps[ch], t1 = ps[128 + ch], t2 = ps[256 + ch], t3 = ps[384 + ch];
            const float off = (part > 0 ? t0 : 0.f) + (part > 1 ? t1 : 0.f) + (part > 2 ? t2 : 0.f);
            const float mid = t0 + t1, last = mid + t2 + t3;
            const float em = __expf(mid), el = __expf(last - mid);
            if (part == 0) ((LAS float*)(lds + HL_D))[ch] = __expf(last);
#pragma unroll
            for (int e = 0; e < 8; ++e) {
                const int tk = 8 * part + e;
                const float cum = off + p8[e];
                const float e1 = __expf(cum - mid), e2 = 1.f / e1;
                const float q = bf2f(q8[e]), k = 1.f - __expf(g8[e]);
                const float qb = q * e1, qa = qb * em, kb = k * e2, kt = kb * el;
                *(LAS bf16_t*)(lds + HL_QA + tk * HG_STR + ch * 2) = (bf16_t)f2bf(qa);
                *(LAS bf16_t*)(lds + HL_QB + tk * HG_STR + ch * 2) = (bf16_t)f2bf(qb);
                *(LAS bf16_t*)(lds + HL_KB + tk * HG_STR + ch * 2) = (bf16_t)f2bf(kb);
                *(LAS bf16_t*)(lds + HL_KT + tk * HG_STR + ch * 2) = (bf16_t)f2bf(kt);
            }
            *(LAS u32x4*)(lds + HL_VV + vrow * HG_STR + vcol * 2) = v16;
        }
        if (c + 1 < 129) HG_LOAD(c + 1);
        __syncthreads();
        {
            f32x4 oacc[2] = {(f32x4){0.f, 0.f, 0.f, 0.f}, (f32x4){0.f, 0.f, 0.f, 0.f}};
#pragma unroll
            for (int ks = 0; ks < 4; ++ks) {
                u32x4 sp; sp.x = cvtpk(S[2 * ks][0], S[2 * ks][1]); sp.y = cvtpk(S[2 * ks][2], S[2 * ks][3]); sp.z = cvtpk(S[2 * ks + 1][0], S[2 * ks + 1][1]); sp.w = cvtpk(S[2 * ks + 1][2], S[2 * ks + 1][3]);
                const bf16x8 sf = __builtin_bit_cast(bf16x8, sp);
#pragma unroll
                for (int nt = 0; nt < 2; ++nt) {
                    const LAS char* qp = lds + HL_QA + (16 * nt + c16) * HG_STR + (32 * ks + 4 * g4) * 2;
                    const u32x2 lo = *(const LAS u32x2*)qp, hi2 = *(const LAS u32x2*)(qp + 32);
                    const bf16x8 qf = __builtin_bit_cast(bf16x8, (u32x4){lo.x, lo.y, hi2.x, hi2.y});
                    oacc[nt] = MFMA16(sf, qf, oacc[nt]);
                }
            }
            f32x4 at00 = (f32x4){0.f, 0.f, 0.f, 0.f}, at01 = at00, at11 = at00;
#pragma unroll
            for (int ks = 0; ks < 4; ++ks) {
                const bf16x8 ka0 = *(const LAS bf16x8*)(lds + HL_KB + c16 * HG_STR + (32 * ks + 8 * g4) * 2);
                const bf16x8 ka1 = *(const LAS bf16x8*)(lds + HL_KB + (16 + c16) * HG_STR + (32 * ks + 8 * g4) * 2);
                const bf16x8 qn0 = *(const LAS bf16x8*)(lds + HL_QB + c16 * HG_STR + (32 * ks + 8 * g4) * 2);
                const bf16x8 qn1 = *(const LAS bf16x8*)(lds + HL_QB + (16 + c16) * HG_STR + (32 * ks + 8 * g4) * 2);
                at00 = MFMA16(ka0, qn0, at00); at01 = MFMA16(ka0, qn1, at01); at11 = MFMA16(ka1, qn1, at11);
            }
#pragma unroll
            for (int r = 0; r < 4; ++r) { if (4 * g4 + r > c16) { at00[r] = 0.f; at11[r] = 0.f; } }
            {
                const LAS char* vp = lds + HL_VV + (4 * g4 + (c16 >> 2)) * HG_STR + (16 * wid + 4 * (c16 & 3)) * 2;
                const s16x4 vlo = vtr(vp), vhi = vtr(vp + 16 * HG_STR);
                const bf16x8 va = (bf16x8){vlo[0], vlo[1], vlo[2], vlo[3], vhi[0], vhi[1], vhi[2], vhi[3]};
                u32x4 b0; b0.x = cvtpk(at00[0], at00[1]); b0.y = cvtpk(at00[2], at00[3]); b0.z = 0u; b0.w = 0u;
                u32x4 b1; b1.x = cvtpk(at01[0], at01[1]); b1.y = cvtpk(at01[2], at01[3]); b1.z = cvtpk(at11[0], at11[1]); b1.w = cvtpk(at11[2], at11[3]);
                oacc[0] = MFMA16(va, __builtin_bit_cast(bf16x8, b0), oacc[0]);
                oacc[1] = MFMA16(va, __builtin_bit_cast(bf16x8, b1), oacc[1]);
            }
#pragma unroll
            for (int nt = 0; nt < 2; ++nt) *(LAS f32x4*)(lds + HL_OUT + ((16 * nt + c16) * 132 + 16 * wid + 4 * g4) * 4) = oacc[nt];
            {
                const LAS char* vp = lds + HL_VV + (8 * g4 + (c16 >> 2)) * HG_STR + (16 * wid + 4 * (c16 & 3)) * 2;
                const s16x4 vlo = vtr(vp), vhi = vtr(vp + 4 * HG_STR);
                const bf16x8 vb = (bf16x8){vlo[0], vlo[1], vlo[2], vlo[3], vhi[0], vhi[1], vhi[2], vhi[3]};
#pragma unroll
                for (int i = 0; i < 8; ++i) {
                    const f32x4 d4 = *(const LAS f32x4*)(lds + HL_D + (16 * i + 4 * g4) * 4);
                    const LAS char* kp = lds + HL_KT + (8 * g4 + (c16 >> 2)) * HG_STR + (16 * i + 4 * (c16 & 3)) * 2;
                    const s16x4 klo = vtr(kp), khi = vtr(kp + 4 * HG_STR);
                    const bf16x8 ka = (bf16x8){klo[0], klo[1], klo[2], klo[3], khi[0], khi[1], khi[2], khi[3]};
                    S[i] = MFMA16(ka, vb, S[i] * d4);
                }
            }
        }
        __syncthreads();
        if (c > 0) {
            const LAS float* op = (const LAS float*)(lds + HL_OUT) + vrow * 132 + vcol;
            const f32x4 a = *(const LAS f32x4*)op, bq = *(const LAS f32x4*)(op + 4);
            float ss = (a.x * a.x + a.y * a.y) + (a.z * a.z + a.w * a.w) + (bq.x * bq.x + bq.y * bq.y) + (bq.z * bq.z + bq.w * bq.w);
            ss += __shfl_xor(ss, 1); ss += __shfl_xor(ss, 2); ss += __shfl_xor(ss, 4); ss += __shfl_xor(ss, 8);
            const float rs = 1.f / sqrtf(ss * (1.f / 128.f) + EPS);
            const size_t row = (size_t)b * SEQ + 32 * (c - 1) + vrow;
            const u32x4 gv = *(const u32x4*)((const bf16_t*)(ws + WS_SG) + row * 512 + h * 128 + vcol);
            const f32x4 w0 = *(const f32x4*)(P.rec_norm_w + h * 128 + vcol), w1 = *(const f32x4*)(P.rec_norm_w + h * 128 + vcol + 4);
            f32x4 r0, r1;
            r0.x = a.x * rs * w0.x * bf2f(gv.x & 0xffffu); r0.y = a.y * rs * w0.y * bf2f(gv.x >> 16);
            r0.z = a.z * rs * w0.z * bf2f(gv.y & 0xffffu); r0.w = a.w * rs * w0.w * bf2f(gv.y >> 16);
            r1.x = bq.x * rs * w1.x * bf2f(gv.z & 0xffffu); r1.y = bq.y * rs * w1.y * bf2f(gv.z >> 16);
            r1.z = bq.z * rs * w1.z * bf2f(gv.w & 0xffffu); r1.w = bq.w * rs * w1.w * bf2f(gv.w >> 16);
            *(u32x4*)((bf16_t*)(ws + WS_MIX) + row * DM + 512 + h * 128 + vcol) = pack8(r0, r1);
        }
    }
#undef HG_LOAD
    __syncthreads();
}
template <int CTRL> DI float dpp_f(float v) { return __builtin_bit_cast(float, __builtin_amdgcn_update_dpp(0, __builtin_bit_cast(int, v), CTRL, 0xf, 0xf, false)); }
DI float row16_max(float v) { v = fmaxf(v, dpp_f<0x128>(v)); v = fmaxf(v, dpp_f<0x124>(v)); v = fmaxf(v, dpp_f<0x122>(v)); v = fmaxf(v, dpp_f<0x121>(v)); return v; }
DI float row16_sum(float v) { v += dpp_f<0x128>(v); v += dpp_f<0x124>(v); v += dpp_f<0x122>(v); v += dpp_f<0x121>(v); return v; }
#define CE_D(a, b) do { const float hi_ = fmaxf(a, b), lo_ = fminf(a, b); a = hi_; b = lo_; } while (0)
DI void bitonic_sort16(float (&v)[16]) {
#pragma unroll
    for (int k = 2; k <= 16; k *= 2)
#pragma unroll
        for (int j = k / 2; j > 0; j /= 2)
#pragma unroll
            for (int i = 0; i < 16; ++i) { const int l = i ^ j; if (l > i) { if ((i & k) == 0) CE_D(v[i], v[l]); else CE_D(v[l], v[i]); } }
}
DI void merge_top16(float (&a)[16], const float (&b)[16]) {
#pragma unroll
    for (int i = 0; i < 16; ++i) a[i] = fmaxf(a[i], b[15 - i]);
#pragma unroll
    for (int j = 8; j > 0; j /= 2)
#pragma unroll
        for (int i = 0; i < 16; ++i) { const int l = i ^ j; if (l > i) CE_D(a[i], a[l]); }
}
DI float embed7(float v, unsigned code) { return __uint_as_float((__float_as_uint(v) & 0xFFFFFF80u) | code); }
DI float embed8(float v, unsigned code) { return __uint_as_float((__float_as_uint(v) & 0xFFFFFF00u) | code); }

DI void topk_list(const bf16_t* qp, const bf16_t* kp, int hi, float (&top)[16]) {
    f32x16 acc[4];
#pragma unroll
    for (int kb = 0; kb < 4; ++kb) acc[kb] = f32x16{};
#pragma unroll
    for (int ks = 0; ks < 8; ++ks) {
        const bf16x8 qf = *(const bf16x8*)(qp + 16 * ks);
#pragma unroll
        for (int kb = 0; kb < 4; ++kb) { const bf16x8 kf = *(const bf16x8*)(kp + (size_t)kb * 32 * 128 + 16 * ks); acc[kb] = MFMA32(kf, qf, acc[kb]); }
    }
    float blk[16];
#pragma unroll
    for (int kb = 0; kb < 4; ++kb) {
#pragma unroll
        for (int r = 0; r < 16; ++r) { const unsigned code = (unsigned)(32 * kb + (r & 3) + 8 * (r >> 2)) | (unsigned)(4 * hi); if (kb == 0) top[r] = embed7(acc[kb][r], code); else blk[r] = embed7(acc[kb][r], code); }
        if (kb == 0) bitonic_sort16(top); else { bitonic_sort16(blk); merge_top16(top, blk); }
    }
    float l0[16], l1[16];
#pragma unroll
    for (int r = 0; r < 16; ++r) { auto rr = __builtin_amdgcn_permlane32_swap(__float_as_uint(top[r]), __float_as_uint(top[r]), false, false); l0[r] = __uint_as_float(rr[0]); l1[r] = __uint_as_float(rr[1]); }
    merge_top16(l0, l1);
#pragma unroll
    for (int r = 0; r < 16; ++r) top[r] = l0[r];
}

DI void topk_wave_item(const Params& P, int tb, int hh, LAS char* wlds) {
    const int lane = tid_() & 63, r32 = lane & 31, hi = lane >> 5;
    const unsigned char* ws = P.ws;
    const bf16_t* qp = (const bf16_t*)(ws + WS_PQ) + (size_t)(32 * tb + r32) * 2048 + hh * 256 + 8 * hi;
    const bf16_t* kp = (const bf16_t*)(ws + WS_SKB) + (size_t)(hh * 2 * 128 + r32) * 128 + 8 * hi;
    float A[16], B[16];
    topk_list(qp, kp, hi, A);
    topk_list(qp + 128, kp + 128 * 128, hi, B);
    LAS unsigned* my = (LAS unsigned*)(wlds + lane * 32);
#pragma unroll
    for (int w = 0; w < 4; ++w) {
        my[w] = (__float_as_uint(A[4 * w]) & 127u) | ((__float_as_uint(A[4 * w + 1]) & 127u) << 8) | ((__float_as_uint(A[4 * w + 2]) & 127u) << 16) | ((__float_as_uint(A[4 * w + 3]) & 127u) << 24);
        my[4 + w] = (__float_as_uint(B[4 * w]) & 127u) | ((__float_as_uint(B[4 * w + 1]) & 127u) << 8) | ((__float_as_uint(B[4 * w + 2]) & 127u) << 16) | ((__float_as_uint(B[4 * w + 3]) & 127u) << 24);
    }
#pragma unroll
    for (int r = 0; r < 16; ++r) { A[r] = __uint_as_float(__float_as_uint(A[r]) & 0xFFFFFF80u); B[r] = __uint_as_float(__float_as_uint(B[r]) & 0xFFFFFF80u); }
    float T[16], R1[16], X[16], Y[16];
#pragma unroll
    for (int j = 0; j < 16; ++j) { T[j] = embed8(A[0] + B[j], (unsigned)j); R1[j] = (j < 8) ? embed8(A[1] + B[j], (unsigned)(16 + j)) : -INFINITY; }
#define CAND(i, j) embed8(A[i] + B[j], (unsigned)(16 * (i) + (j)))
    X[0] = CAND(2, 0); X[1] = CAND(2, 1); X[2] = CAND(2, 2); X[3] = CAND(2, 3); X[4] = CAND(2, 4); X[5] = CAND(3, 0); X[6] = CAND(3, 1); X[7] = CAND(3, 2);
    X[8] = CAND(3, 3); X[9] = CAND(4, 0); X[10] = CAND(4, 1); X[11] = CAND(4, 2); X[12] = CAND(5, 0); X[13] = CAND(5, 1); X[14] = CAND(6, 0); X[15] = CAND(6, 1);
    Y[0] = CAND(7, 0); Y[1] = CAND(7, 1); Y[2] = CAND(8, 0); Y[3] = CAND(9, 0); Y[4] = CAND(10, 0); Y[5] = CAND(11, 0); Y[6] = CAND(12, 0); Y[7] = CAND(13, 0);
    Y[8] = CAND(14, 0); Y[9] = CAND(15, 0); Y[10] = -INFINITY; Y[11] = -INFINITY; Y[12] = -INFINITY; Y[13] = -INFINITY; Y[14] = -INFINITY; Y[15] = -INFINITY;
#undef CAND
    bitonic_sort16(X); bitonic_sort16(Y);
    merge_top16(T, R1); merge_top16(T, X); merge_top16(T, Y);
    asm volatile("s_waitcnt lgkmcnt(0)" ::: "memory");
    float ssum = 0.f, e[16]; int eid[16];
    const float t0 = __uint_as_float(__float_as_uint(T[0]) & 0xFFFFFF00u);
#pragma unroll
    for (int r = 0; r < 16; ++r) {
        const unsigned bits = __float_as_uint(T[r]); const unsigned code = bits & 255u;
        e[r] = __expf(__uint_as_float(bits & 0xFFFFFF00u) - t0); ssum += e[r];
        const int ka = ((const LAS unsigned char*)my)[code >> 4], kb_ = ((const LAS unsigned char*)my)[16 + (code & 15u)];
        eid[r] = ka * 128 + kb_;
    }
    const float inv = 1.f / ssum;
    const size_t o = (size_t)(32 * tb + r32) * 128 + hh * 16 + 8 * hi;
    int* ei = (int*)(ws + WS_EIDX) + o; float* eg = (float*)(ws + WS_EGATE) + o;
    typedef int i32x4 __attribute__((ext_vector_type(4)));
    i32x4 w0, w1; f32x4 g0, g1;
    const unsigned mh = 0u - (unsigned)hi;
#define SELU(a, b) ((((unsigned)(b)) & mh) | (((unsigned)(a)) & ~mh))
#pragma unroll
    for (int q = 0; q < 4; ++q) { w0[q] = (int)SELU(eid[q], eid[8 + q]); w1[q] = (int)SELU(eid[4 + q], eid[12 + q]);
        g0[q] = __uint_as_float(SELU(__float_as_uint(e[q]), __float_as_uint(e[8 + q]))) * inv; g1[q] = __uint_as_float(SELU(__float_as_uint(e[4 + q]), __float_as_uint(e[12 + q]))) * inv; }
#undef SELU
    *(i32x4*)ei = w0; *(i32x4*)(ei + 4) = w1; *(f32x4*)eg = g0; *(f32x4*)(eg + 4) = g1;
}

DI void topk_phase(const Params& P, char* lds_g, int bid, int nblk) {
    const int wave = __builtin_amdgcn_readfirstlane(tid_() >> 6);
    LAS char* wlds = (LAS char*)lds_g + wave * 2048;
    const int gw = bid * NWAVES + wave, NGW = nblk * NWAVES;
    for (int it = gw; it < (NTOK / 32) * 8; it += NGW) topk_wave_item(P, it >> 3, it & 7, wlds);
}

DI float gelu_exact(float x) { return 0.5f * x * (1.f + erff(x * 0.70710678118654752f)); }
typedef __bf16 bf16x8_t __attribute__((ext_vector_type(8)));
DI float dot8(u32x4 a, u32x4 x, float acc) {
    const bf16x8_t a8 = __builtin_bit_cast(bf16x8_t, a), x8 = __builtin_bit_cast(bf16x8_t, x);
    acc = __builtin_amdgcn_fdot2_f32_bf16(__builtin_shufflevector(a8, a8, 0, 1), __builtin_shufflevector(x8, x8, 0, 1), acc, false);
    acc = __builtin_amdgcn_fdot2_f32_bf16(__builtin_shufflevector(a8, a8, 2, 3), __builtin_shufflevector(x8, x8, 2, 3), acc, false);
    acc = __builtin_amdgcn_fdot2_f32_bf16(__builtin_shufflevector(a8, a8, 4, 5), __builtin_shufflevector(x8, x8, 4, 5), acc, false);
    acc = __builtin_amdgcn_fdot2_f32_bf16(__builtin_shufflevector(a8, a8, 6, 7), __builtin_shufflevector(x8, x8, 6, 7), acc, false);
    return acc;
}
DI float readlane_f(float v, int l) { return __builtin_bit_cast(float, __builtin_amdgcn_readlane(__builtin_bit_cast(int, v), l)); }
DI float wave_sum_dpp(float v) {
    v = row16_sum(v);
    return (readlane_f(v, 0) + readlane_f(v, 16)) + (readlane_f(v, 32) + readlane_f(v, 48));
}

DI float dot16_fp8(u32x4 w, const f32x2 (&x)[8]) {
    f32x2 acc = __builtin_amdgcn_cvt_pk_f32_fp8((int)w.x, false) * x[0];
    acc = __builtin_amdgcn_cvt_pk_f32_fp8((int)w.x, true) * x[1] + acc;
    acc = __builtin_amdgcn_cvt_pk_f32_fp8((int)w.y, false) * x[2] + acc;
    acc = __builtin_amdgcn_cvt_pk_f32_fp8((int)w.y, true) * x[3] + acc;
    acc = __builtin_amdgcn_cvt_pk_f32_fp8((int)w.z, false) * x[4] + acc;
    acc = __builtin_amdgcn_cvt_pk_f32_fp8((int)w.z, true) * x[5] + acc;
    acc = __builtin_amdgcn_cvt_pk_f32_fp8((int)w.w, false) * x[6] + acc;
    acc = __builtin_amdgcn_cvt_pk_f32_fp8((int)w.w, true) * x[7] + acc;
    return acc.x + acc.y;
}
DI void peer_hid_phase(const Params& P, int bid, int nblk) {
    const int tid = tid_(), lane = tid & 63, wave = __builtin_amdgcn_readfirstlane(tid >> 6);
    const unsigned char* ws = P.ws;
    const unsigned char* U8 = ws + WS_UB; const float* USC = (const float*)(ws + WS_USC);
    const int gw = bid * NWAVES + wave, NGW = nblk * NWAVES;
    f32x4 wv[4];
#pragma unroll
    for (int q = 0; q < 4; ++q) wv[q] = *(const f32x4*)(P.ffn_norm_w + 16 * lane + 4 * q);
    for (int n = gw; n < NTOK; n += NGW) {
        const float* hrow = P.out + (size_t)n * DM + 16 * lane;
        f32x4 h[4]; float ss = 0.f;
#pragma unroll
        for (int q = 0; q < 4; ++q) { h[q] = *(const f32x4*)(hrow + 4 * q); ss += (h[q].x * h[q].x + h[q].y * h[q].y) + (h[q].z * h[q].z + h[q].w * h[q].w); }
        ss = wave_sum_dpp(ss);
        const float r2 = 1.f / sqrtf(ss * (1.f / DM) + EPS);
        f32x2 x[8];
#pragma unroll
        for (int q = 0; q < 4; ++q) { const f32x4 t = h[q] * wv[q] * r2; x[2 * q] = (f32x2){t.x, t.y}; x[2 * q + 1] = (f32x2){t.z, t.w}; }
        const int* eidx = (const int*)(ws + WS_EIDX) + (size_t)n * 128;
        const float* egate = (const float*)(ws + WS_EGATE) + (size_t)n * 128;
        const int id0 = eidx[lane], id1 = eidx[64 + lane];
        float hid0 = 0.f, hid1 = 0.f;
#pragma unroll 1
        for (int k0 = 0; k0 < 128; k0 += 16) {
            u32x4 ra[16]; float sc[16];
#pragma unroll
            for (int e = 0; e < 16; ++e) {
                const int k = k0 + e;
                const int id = (k0 < 64) ? __builtin_amdgcn_readlane(id0, k & 63) : __builtin_amdgcn_readlane(id1, k & 63);
                ra[e] = *(const u32x4*)(U8 + (size_t)id * DM + 16 * lane); sc[e] = USC[id];
            }
#pragma unroll
            for (int e = 0; e < 16; ++e) {
                const int k = k0 + e;
                const float d = wave_sum_dpp(dot16_fp8(ra[e], x)) * sc[e];
                if (k0 < 64) { if (lane == (k & 63)) hid0 = d; } else { if (lane == (k & 63)) hid1 = d; }
            }
        }
        float* hid = (float*)(ws + WS_HID) + (size_t)n * 128;
        hid[lane] = gelu_exact(hid0) * egate[lane];
        hid[64 + lane] = gelu_exact(hid1) * egate[64 + lane];
    }
}

DI void peer_out_phase(const Params& P, int bid, int nblk) {
    const int tid = tid_(), lane = tid & 63, wave = __builtin_amdgcn_readfirstlane(tid >> 6);
    const unsigned char* ws = P.ws;
    const unsigned char* V8 = ws + WS_VB; const float* VSC = (const float*)(ws + WS_VSC);
    const int gw = bid * NWAVES + wave, NGW = nblk * NWAVES;
    f32x4 wv[4];
#pragma unroll
    for (int q = 0; q < 4; ++q) wv[q] = *(const f32x4*)(P.final_w + 16 * lane + 4 * q);
    for (int n = gw; n < NTOK; n += NGW) {
        const int* eidx = (const int*)(ws + WS_EIDX) + (size_t)n * 128;
        const float* hid = (const float*)(ws + WS_HID) + (size_t)n * 128;
        const int id0 = eidx[lane], id1 = eidx[64 + lane];
        const float c0 = hid[lane], c1 = hid[64 + lane];
        f32x2 acc[8];
#pragma unroll
        for (int i = 0; i < 8; ++i) acc[i] = (f32x2){0.f, 0.f};
#pragma unroll 1
        for (int k0 = 0; k0 < 128; k0 += 16) {
            u32x4 ra[16]; float cf[16];
#pragma unroll
            for (int e = 0; e < 16; ++e) {
                const int k = k0 + e;
                const int id = (k0 < 64) ? __builtin_amdgcn_readlane(id0, k & 63) : __builtin_amdgcn_readlane(id1, k & 63);
                cf[e] = ((k0 < 64) ? readlane_f(c0, k & 63) : readlane_f(c1, k & 63)) * VSC[id];
                ra[e] = *(const u32x4*)(V8 + (size_t)id * DM + 16 * lane);
            }
#pragma unroll
            for (int e = 0; e < 16; ++e) {
                const f32x2 c = (f32x2){cf[e], cf[e]}; const u32x4 w = ra[e];
                acc[0] = __builtin_amdgcn_cvt_pk_f32_fp8((int)w.x, false) * c + acc[0]; acc[1] = __builtin_amdgcn_cvt_pk_f32_fp8((int)w.x, true) * c + acc[1];
                acc[2] = __builtin_amdgcn_cvt_pk_f32_fp8((int)w.y, false) * c + acc[2]; acc[3] = __builtin_amdgcn_cvt_pk_f32_fp8((int)w.y, true) * c + acc[3];
                acc[4] = __builtin_amdgcn_cvt_pk_f32_fp8((int)w.z, false) * c + acc[4]; acc[5] = __builtin_amdgcn_cvt_pk_f32_fp8((int)w.z, true) * c + acc[5];
                acc[6] = __builtin_amdgcn_cvt_pk_f32_fp8((int)w.w, false) * c + acc[6]; acc[7] = __builtin_amdgcn_cvt_pk_f32_fp8((int)w.w, true) * c + acc[7];
            }
        }
        float* orow = P.out + (size_t)n * DM + 16 * lane;
        f32x4 h[4]; float ss = 0.f;
#pragma unroll
        for (int q = 0; q < 4; ++q) { h[q] = *(const f32x4*)(orow + 4 * q) + (f32x4){acc[2 * q].x, acc[2 * q].y, acc[2 * q + 1].x, acc[2 * q + 1].y}; ss += (h[q].x * h[q].x + h[q].y * h[q].y) + (h[q].z * h[q].z + h[q].w * h[q].w); }
        ss = wave_sum_dpp(ss);
        const float rs = 1.f / sqrtf(ss * (1.f / DM) + EPS);
#pragma unroll
        for (int q = 0; q < 4; ++q) *(f32x4*)(orow + 4 * q) = h[q] * wv[q] * rs;
    }
}

#ifdef DBG_CHECK
DI void dbg_max(float* slot, float v) { atomicMax((unsigned*)slot, __float_as_uint(fmaxf(v, 0.f))); }
DI void dbg_check_topk(const Params& P, char* lds_g, int bid, int nblk) {
    LAS char* lds = (LAS char*)lds_g;
    const int tid = tid_(), lane = tid & 63, wave = __builtin_amdgcn_readfirstlane(tid >> 6);
    const unsigned char* ws = P.ws; float* dbg = (float*)(ws + WS_CTL) + 64;
    LAS float* sc = (LAS float*)(lds) + wave * 1024;
    const int gw = bid * NWAVES + wave;
    const int token = (gw * 37) % NTOK, hh = gw & 7;
    for (int p = 0; p < 2; ++p) for (int kk = 0; kk < 2; ++kk) {
        const int key = lane + 64 * kk; float a = 0.f;
        const bf16_t* q = (const bf16_t*)(ws + WS_PQ) + (size_t)token * 2048 + hh * 256 + p * 128;
        const bf16_t* sk = (const bf16_t*)(ws + WS_SKB) + (size_t)((hh * 2 + p) * 128 + key) * 128;
        for (int c = 0; c < 128; ++c) a += bf2f(q[c]) * bf2f(sk[c]);
        sc[p * 128 + key] = a;
    }
    asm volatile("s_waitcnt lgkmcnt(0)" ::: "memory");
    for (int p = 0; p < 2; ++p) for (int kk = 0; kk < 2; ++kk) {
        const int key = lane + 64 * kk; const float v = sc[p * 128 + key]; int rank = 0;
        for (int o = 0; o < 128; ++o) { const float w = sc[p * 128 + o]; rank += (w > v || (w == v && o < key)) ? 1 : 0; }
        if (rank < 16) { sc[256 + p * 16 + rank] = v; sc[288 + p * 16 + rank] = __int_as_float(key); }
    }
    asm volatile("s_waitcnt lgkmcnt(0)" ::: "memory");
    for (int e = 0; e < 4; ++e) {
        const int c = lane * 4 + e, i = c >> 4, j = c & 15; const float v = sc[256 + i] + sc[272 + j]; int rank = 0;
        for (int o = 0; o < 256; ++o) { const float w = sc[256 + (o >> 4)] + sc[272 + (o & 15)]; rank += (w > v || (w == v && o < c)) ? 1 : 0; }
        if (rank < 16) { sc[320 + rank] = __int_as_float(__float_as_int(sc[288 + i]) * 128 + __float_as_int(sc[304 + j])); sc[336 + rank] = v; }
    }
    asm volatile("s_waitcnt lgkmcnt(0)" ::: "memory");
    if (lane < 16) {
        const int eid = __float_as_int(sc[320 + lane]); const float sv = sc[336 + lane];
        float mx = sc[336], sum = 0.f; for (int o = 0; o < 16; ++o) sum += __expf(sc[336 + o] - mx);
        const float gate = __expf(sv - mx) / sum;
        const int* eidx = (const int*)(ws + WS_EIDX) + (size_t)token * 128 + hh * 16; const float* eg = (const float*)(ws + WS_EGATE) + (size_t)token * 128 + hh * 16;
        int found = -1; for (int o = 0; o < 16; ++o) if (eidx[o] == eid) found = o;
        if (found < 0) atomicAdd(dbg + 0, 1.f); else dbg_max(dbg + 1, fabsf(eg[found] - gate));
    }
    if (lane == 0) atomicAdd(dbg + 2, 16.f);
}
DI void dbg_check_hid(const Params& P, int bid, int nblk) {
    const int tid = tid_(), lane = tid & 63, wave = __builtin_amdgcn_readfirstlane(tid >> 6);
    const unsigned char* ws = P.ws; float* dbg = (float*)(ws + WS_CTL) + 64;
    const int gw = bid * NWAVES + wave; const int token = (gw * 53) % NTOK;
    const float* hrow = P.out + (size_t)token * DM;
    float ss = 0.f; for (int c = lane; c < DM; c += 64) ss += hrow[c] * hrow[c];
    ss = wave_sum(ss); const float r2 = 1.f / sqrtf(ss / DM + EPS);
    for (int kk = 0; kk < 2; ++kk) {
        const int k = lane + 64 * kk; const int eid = ((const int*)(ws + WS_EIDX))[(size_t)token * 128 + k];
        const float* urow = P.pu + (size_t)eid * DM; float d = 0.f;
        for (int c = 0; c < DM; ++c) d += urow[c] * (hrow[c] * r2 * P.ffn_norm_w[c]);
        const float hidv = gelu_exact(d) * ((const float*)(ws + WS_EGATE))[(size_t)token * 128 + k];
        const float got = ((const float*)(ws + WS_HID))[(size_t)token * 128 + k];
        dbg_max(dbg + 3, fabsf(got - hidv)); dbg_max(dbg + 4, fabsf(hidv));
    }
}
DI float dbg_enc(float m) { return 8.f + log10f(fmaxf(m, 1e-8f)); }
#endif

#ifdef DBG_CHECK
DI void dbg_check_attn(const Params& P, int bid, int nblk) {
    const int tid = tid_(), lane = tid & 63, wave = __builtin_amdgcn_readfirstlane(tid >> 6);
    const unsigned char* ws = P.ws; float* dbg = (float*)(ws + WS_CTL) + 64;
    const int gw = bid * NWAVES + wave;
    const unsigned hsh = (unsigned)gw * 2654435761u;
    const int b = (hsh >> 8) & 7, h = (hsh >> 11) & 3, i = (int)((hsh >> 13) % 4096u), bh = b * 4 + h;
    const float lam = ((const float*)(ws + WS_LB))[512];
    float oc[2][2], lsum[2], mx[2];
    for (int c = 0; c < 2; ++c) { oc[c][0] = oc[c][1] = 0.f; lsum[c] = 0.f; mx[c] = -1e30f; }
    for (int pp = KPAD; pp <= 64 + i; ++pp) {
        const int tile = pp >> 6, key = pp & 63;
        for (int c = 0; c < 2; ++c) {
            const bf16_t* q = (const bf16_t*)(ws + WS_Q) + ((size_t)((bh * 2 + c) * SEQ + i)) * 64;
            const unsigned char* kimg = ws + WS_K + ((size_t)(bh * 2 + c) * KT + tile) * 8192;
            float sdot = 0.f;
            for (int d = 0; d < 64; ++d) sdot += bf2f(q[d]) * bf2f(*(const bf16_t*)(kimg + (d >> 3) * 1024 + key * 16 + (d & 7) * 2));
            const float mn = fmaxf(mx[c], sdot), al = exp2f(mx[c] - mn), pe = exp2f(sdot - mn);
            const unsigned char* vimg = ws + WS_V + ((size_t)bh * KT + tile) * 16384;
            for (int e = 0; e < 2; ++e) { const int dv = lane + 64 * e; oc[c][e] = oc[c][e] * al + pe * bf2f(*(const bf16_t*)(vimg + (dv >> 5) * 4096 + key * 64 + (dv & 31) * 2)); }
            lsum[c] = lsum[c] * al + pe; mx[c] = mn;
        }
    }
    float o[2], ss = 0.f;
    for (int e = 0; e < 2; ++e) { o[e] = oc[0][e] / lsum[0] - lam * oc[1][e] / lsum[1]; ss += o[e] * o[e]; }
    ss = wave_sum(ss); const float rs = (1.f - LAM_INIT) / sqrtf(ss / 128.f + EPS);
    for (int e = 0; e < 2; ++e) { const int dv = lane + 64 * e; const float want = o[e] * rs * P.subln_w[dv];
        const float got = bf2f(((const bf16_t*)(ws + WS_MIX))[(size_t)(b * SEQ + i) * DM + h * 128 + dv]);
        dbg_max(dbg + 5, fabsf(got - want)); dbg_max(dbg + 6, fabsf(want)); }
}
DI void dbg_check_hgrn(const Params& P, char* lds_g, int bid, int nblk) {
    if (bid >= 32) return;
    LAS float* L = (LAS float*)lds_g;
    const int tid = tid_(), dv = tid & 127, qt = tid >> 7;
    const unsigned char* ws = P.ws; float* dbg = (float*)(ws + WS_CTL) + 64;
    const int bh = bid, b = bid >> 2, h = bid & 3;
    const float* HG = (const float*)(ws + WS_HG) + (size_t)bh * HT * 128;
    const bf16_t* HQ = (const bf16_t*)(ws + WS_HQ) + (size_t)bh * HT * 128;
    const bf16_t* HV = (const bf16_t*)(ws + WS_HV) + (size_t)bh * HT * 128;
    float S[32];
#pragma unroll
    for (int j = 0; j < 32; ++j) S[j] = 0.f;
    for (int pp = 16; pp < HT; ++pp) {
        if (tid < 128) { L[tid] = __expf(HG[(size_t)pp * 128 + tid]); L[128 + tid] = bf2f(HQ[(size_t)pp * 128 + tid]); L[256 + tid] = bf2f(HV[(size_t)pp * 128 + tid]); }
        __syncthreads();
        const float v = L[256 + dv]; float part = 0.f;
#pragma unroll
        for (int j = 0; j < 32; ++j) { const float f = L[32 * qt + j]; S[j] = f * S[j] + (1.f - f) * v; part += L[128 + 32 * qt + j] * S[j]; }
        L[384 + qt * 128 + dv] = part;
        __syncthreads();
        if (tid < 128) { const float o = L[384 + dv] + L[512 + dv] + L[640 + dv] + L[768 + dv]; L[896 + dv] = o; }
        __syncthreads();
        if (tid < 128 && pp >= 32) {
            float ss = 0.f; for (int j = 0; j < 128; ++j) ss += L[896 + j] * L[896 + j];
            const float rs = 1.f / sqrtf(ss / 128.f + EPS);
            const size_t row = (size_t)b * SEQ + (pp - 32);
            const float want = L[896 + dv] * rs * P.rec_norm_w[h * 128 + dv] * bf2f(((const bf16_t*)(ws + WS_SG))[row * 512 + h * 128 + dv]);
            const float got = bf2f(((const bf16_t*)(ws + WS_MIX))[row * DM + 512 + h * 128 + dv]);
            dbg_max(dbg + 7, fabsf(got - want)); dbg_max(dbg + 8, fabsf(want));
        }
        __syncthreads();
    }
}
#endif

#ifdef DBG_CHECK
DI float dbg_proj(const Params& P, int m, int c) {
    const float* xrow = (m < NTOK) ? P.x + (size_t)m * DM : P.meta + (size_t)(m - NTOK) * DM;
    float ss = 0.f, a = 0.f;
    for (int k = 0; k < DM; ++k) { const float xv = xrow[k]; ss += xv * xv; a += xv * P.mix_norm_w[k] * P.w_in[(size_t)k * NCOL1 + c]; }
    return a / sqrtf(ss / DM + EPS);
}
DI void dbg_check_gemm1(const Params& P, int bid, int nblk) {
    const unsigned char* ws = P.ws; float* dbg = (float*)(ws + WS_CTL) + 64;
    const int gt = bid * NTHREADS + tid_();
    if (gt >= 7 * 4096) return;
    const unsigned hsh = (unsigned)gt * 2654435761u;
    const int seg = gt % 7, cs = (hsh >> 7) & 511;
    const bool meta = ((gt / 7) & 15) == 0;
    const int m = meta ? NTOK + ((hsh >> 20) & 15) : (int)((hsh >> 3) % (unsigned)NTOK);
    const int b = meta ? (int)((hsh >> 25) & 7) : (m >> 12), t = meta ? (m - NTOK) : ((m & 4095) + NMETA);
    const int h = cs >> 7;
    float want = 0.f, got = 0.f;
    if (seg <= 1) {
        if (seg == 0 && meta) return;
        const int comp = (cs >> 6) & 1, d = cs & 63, dlo = d & 31;
        const float zlo = dbg_proj(P, m, seg * 512 + (cs & ~63) + dlo), zhi = dbg_proj(P, m, seg * 512 + (cs & ~63) + dlo + 32);
        const double inv = exp2(-(double)dlo * (13.287712379549449 / 32.0)); const float cv = (float)cos((double)t * inv), sv = (float)sin((double)t * inv);
        want = (d < 32) ? zlo * cv - zhi * sv : zhi * cv + zlo * sv;
        if (seg == 0) { want *= QSCALE; got = bf2f(((const bf16_t*)(ws + WS_Q))[((size_t)(((b * 4 + h) * 2 + comp) * SEQ + (m & 4095))) * 64 + d]); }
        else { const int pp = t + KPAD; got = bf2f(*(const bf16_t*)(ws + WS_K + ((size_t)((b * 4 + h) * 2 + comp) * KT + (pp >> 6)) * 8192 + (d >> 3) * 1024 + (pp & 63) * 16 + (d & 7) * 2)); }
    } else {
        const float z = dbg_proj(P, m, seg * 512 + cs); const int dv = cs & 127;
        if (seg == 2) { const int pp = t + KPAD; want = z; got = bf2f(*(const bf16_t*)(ws + WS_V + ((size_t)(b * 4 + h) * KT + (pp >> 6)) * 16384 + (dv >> 5) * 4096 + (pp & 63) * 64 + (dv & 31) * 2)); }
        else if (seg == 3) { want = siluf_(z); got = bf2f(((const bf16_t*)(ws + WS_HQ))[((size_t)(b * 4 + h) * HT + t + 16) * 128 + dv]); }
        else if (seg == 4) { const float l0 = P.lb_logits[cs], l1 = P.lb_logits[512 + cs], lb = __expf(l0) / (__expf(l0) + __expf(l1)); want = __logf(lb + (1.f - lb) * sigmoidf_(z)); got = ((const float*)(ws + WS_HG))[((size_t)(b * 4 + h) * HT + t + 16) * 128 + dv]; }
        else if (seg == 5) { want = z; got = bf2f(((const bf16_t*)(ws + WS_HV))[((size_t)(b * 4 + h) * HT + t + 16) * 128 + dv]); }
        else { if (meta) return; want = siluf_(z); got = bf2f(((const bf16_t*)(ws + WS_SG))[(size_t)m * 512 + cs]); }
    }
    dbg_max(dbg + 16 + seg + (meta ? 8 : 0), fabsf(got - want));
}
#endif
constexpr int LDS_BYTES = 147456;
constexpr int LDS_ITEM = LDS_BYTES - 64;
constexpr int N_HGRN_ITEMS = BATCH * 4, N_ATT_ITEMS = BATCH * 4 * 32;

DI void mixer_phase(const Params& P, char* lds) {
    unsigned* ctr = (unsigned*)(P.ws + WS_CTL);
    for (;;) {
        if (tid_() == 0) *(LAS int*)((LAS char*)lds + LDS_ITEM) = (int)atomicAdd(ctr, 1u);
        __syncthreads();
        const int item = *(LAS int*)((LAS char*)lds + LDS_ITEM);
        __syncthreads();
        if (item >= N_HGRN_ITEMS + N_ATT_ITEMS) break;
        if (item < N_HGRN_ITEMS) hgrn_unit(P, item >> 2, item & 3, lds);
        else { const int a = item - N_HGRN_ITEMS, j = 31 - (a >> 5), bh = a & 31; attn_unit(P, bh >> 2, bh & 3, j, lds); }
    }
}

__global__ void __launch_bounds__(NTHREADS, 2) fwd_megakernel(Params P) {
    extern __shared__ __attribute__((aligned(16))) char lds[];
    cg::grid_group grid = cg::this_grid();
    const int bid = blockIdx.x, nblk = gridDim.x;
    unsigned char* ws = P.ws;
    phase0(P, lds, bid, nblk);
    grid.sync();
    { Epi1 e{ws}; gemm_run(lds, (const bf16_t*)(ws + WS_XB), (const bf16_t*)(ws + WS_W1T), M1, NCOL1, DM, e, bid, nblk); }
    grid.sync();
#if defined(DBG_CHECK) && DBG_SEL == 3
    dbg_check_gemm1(P, bid, nblk);
    grid.sync();
    {
        const float* dbg = (const float*)(ws + WS_CTL) + 64;
        float mxe = 0.f; int arg = 0; for (int q = 0; q < 16; ++q) if (dbg[16 + q] > mxe) { mxe = dbg[16 + q]; arg = q; }
        const float c1 = sqrtf(100.f * dbg_enc(mxe)), c2 = 1000.f * (1.f + arg);
        const size_t gt = (size_t)bid * NTHREADS + threadIdx.x, NGT = (size_t)nblk * NTHREADS;
        for (size_t i = gt; i < (size_t)NTOK * DM; i += NGT) P.out[i] = (i == 0) ? c2 : c1;
    }
    return;
#endif
    mixer_phase(P, lds);
    grid.sync();
#if defined(DBG_CHECK) && DBG_SEL == 2
    dbg_check_attn(P, bid, nblk);
    dbg_check_hgrn(P, lds, bid, nblk);
    grid.sync();
    {
        const float* dbg = (const float*)(ws + WS_CTL) + 64;
        const float c1 = sqrtf(100.f * dbg_enc(dbg[5] / fmaxf(dbg[6], 1e-20f))), c2 = 1000.f * dbg_enc(dbg[7] / fmaxf(dbg[8], 1e-20f));
        const size_t gt = (size_t)bid * NTHREADS + threadIdx.x, NGT = (size_t)nblk * NTHREADS;
        for (size_t i = gt; i < (size_t)NTOK * DM; i += NGT) P.out[i] = (i == 0) ? c2 : c1;
    }
    return;
#endif
    { Epi3 e{P.x, P.out, (bf16_t*)(ws + WS_XB), (float*)(ws + WS_SSQ)}; gemm_run(lds, (const bf16_t*)(ws + WS_MIX), (const bf16_t*)(ws + WS_W2T), NTOK, DM, DM, e, bid, nblk); }
    grid.sync();
    { Epi4 e{(const float*)(ws + WS_SSQ), (bf16_t*)(ws + WS_PQ)}; gemm_run(lds, (const bf16_t*)(ws + WS_XB), (const bf16_t*)(ws + WS_W3T), NTOK, 2048, DM, e, bid, nblk); }
    grid.sync();
    topk_phase(P, lds, bid, nblk);
    grid.sync();
#ifdef DBG_CHECK
    dbg_check_topk(P, lds, bid, nblk);
#endif
    peer_hid_phase(P, bid, nblk);
    grid.sync();
#ifdef DBG_CHECK
    dbg_check_hid(P, bid, nblk);
    grid.sync();
    {
        const float* dbg = (const float*)(ws + WS_CTL) + 64;
        const float mA = DBG_SEL == 0 ? dbg[0] / fmaxf(dbg[2], 1.f) : dbg[3] / fmaxf(dbg[4], 1e-20f);
        const float mB = DBG_SEL == 0 ? dbg[1] : dbg[4];
        const float c1 = sqrtf(100.f * dbg_enc(mA)), c2 = 1000.f * dbg_enc(mB);
        const size_t gt = (size_t)bid * NTHREADS + threadIdx.x, NGT = (size_t)nblk * NTHREADS;
        for (size_t i = gt; i < (size_t)NTOK * DM; i += NGT) P.out[i] = (i == 0) ? c2 : c1;
    }
#else
    peer_out_phase(P, bid, nblk);
#endif
}

extern "C" void kernel_launch(void* const* d_in, const int* in_sizes, int n_in, void* d_out, int out_size, void* d_ws, size_t ws_size, hipStream_t stream) {
    static int grid = 0;
    if (grid == 0) {
        int dev = 0, cus = 0, per_cu = 0;
        (void)hipGetDevice(&dev);
        (void)hipDeviceGetAttribute(&cus, hipDeviceAttributeMultiprocessorCount, dev);
        (void)hipFuncSetAttribute((const void*)fwd_megakernel, hipFuncAttributeMaxDynamicSharedMemorySize, LDS_BYTES);
        (void)hipOccupancyMaxActiveBlocksPerMultiprocessor(&per_cu, (const void*)fwd_megakernel, NTHREADS, LDS_BYTES);
        if (per_cu < 1) { fprintf(stderr, "kernel_launch: occupancy query says %d blocks per CU\n", per_cu); per_cu = 1; }
        grid = cus * 1;
        if (ws_size < WS_END) { fprintf(stderr, "kernel_launch: workspace too small: %zu < %zu\n", ws_size, (size_t)WS_END); grid = -1; }
    }
    if (grid < 0) return;
    (void)hipMemsetAsync((char*)d_ws + WS_CTL, 0, CTL_BYTES, stream);
    Params p{};
    p.x = (const float*)d_in[0]; p.meta = (const float*)d_in[1]; p.mix_norm_w = (const float*)d_in[2]; p.w_in = (const float*)d_in[3];
    p.lb_logits = (const float*)d_in[4]; p.rec_norm_w = (const float*)d_in[5]; p.lq1 = (const float*)d_in[6]; p.lk1 = (const float*)d_in[7];
    p.lq2 = (const float*)d_in[8]; p.lk2 = (const float*)d_in[9]; p.subln_w = (const float*)d_in[10]; p.w_out = (const float*)d_in[11];
    p.ffn_norm_w = (const float*)d_in[12]; p.wq = (const float*)d_in[13]; p.subkeys = (const float*)d_in[14]; p.pu = (const float*)d_in[15];
    p.pv = (const float*)d_in[16]; p.final_w = (const float*)d_in[17];
    p.out = (float*)d_out; p.ws = (unsigned char*)d_ws;
    void* args[] = {&p};
    hipError_t e = hipLaunchCooperativeKernel((const void*)fwd_megakernel, dim3(grid), dim3(NTHREADS), args, LDS_BYTES, stream);
    if (e != hipSuccess) fprintf(stderr, "cooperative launch failed: %s (grid %d)\n", hipGetErrorString(e), grid);
}
```

```cpp
#include <hip/hip_runtime.h>
#include <hip/hip_cooperative_groups.h>
#include <cstdio>
#include <cstdint>
#define DBG_SEL 1
namespace cg = cooperative_groups;

constexpr int BATCH = 8, SEQ = 4096, DM = 1024, NMETA = 16;
constexpr int NTOK = BATCH * SEQ;
constexpr int M1 = NTOK + 256;
constexpr int NCOL1 = 3584;
constexpr int TPOS = NMETA + SEQ;
constexpr int KT = 65;
constexpr int KPAD = 48;
constexpr int HT = 4128;
constexpr int NEXP = 16384;
constexpr float EPS = 1e-6f;
constexpr float LAM_INIT = 0.2f;
constexpr float QSCALE = 0.125f * 1.4426950408889634f;
constexpr int NTHREADS = 512, NWAVES = 8;
constexpr int LDS_BYTES = 147456;
constexpr int LDS_ITEM = LDS_BYTES - 64, LDS_XB = LDS_BYTES - 32;

typedef unsigned short bf16_t;
typedef short bf16x8 __attribute__((ext_vector_type(8)));
typedef float f32x4 __attribute__((ext_vector_type(4)));
typedef float f32x16 __attribute__((ext_vector_type(16)));
typedef float f32x2 __attribute__((ext_vector_type(2)));
typedef unsigned u32x4 __attribute__((ext_vector_type(4)));
typedef unsigned u32x2 __attribute__((ext_vector_type(2)));
typedef __bf16 bf16x2_t __attribute__((ext_vector_type(2)));
typedef short s16x4 __attribute__((ext_vector_type(4)));
#define LAS __attribute__((address_space(3)))
#define DI __device__ __forceinline__
__device__ __forceinline__ int tid_() { int t = threadIdx.x; asm volatile("" : "+v"(t)); return t; }

constexpr size_t al256(size_t x) { return (x + 255) & ~(size_t)255; }
constexpr size_t WS_CTL = 0, CTL_BYTES = 65536;
constexpr size_t WS_W1T = WS_CTL + CTL_BYTES;
constexpr size_t WS_W2T = WS_W1T + (size_t)NCOL1 * DM * 2;
constexpr size_t WS_W3T = WS_W2T + (size_t)DM * DM * 2;
constexpr size_t WS_SKB = WS_W3T + (size_t)2048 * DM * 2;
constexpr size_t WS_UB = WS_SKB + (size_t)16 * 128 * 128 * 2;
constexpr size_t WS_VB = WS_UB + (size_t)NEXP * DM * 2;
constexpr size_t WS_USC = WS_UB + (size_t)NEXP * DM, WS_VSC = WS_VB + (size_t)NEXP * DM;
constexpr size_t WS_ROPE = WS_VB + (size_t)NEXP * DM * 2;
constexpr size_t WS_LB = WS_ROPE + (size_t)TPOS * 64 * 4;
constexpr size_t WS_R1 = WS_LB + 4096;
constexpr size_t WS_SSQ = WS_R1 + al256((size_t)M1 * 4);
constexpr size_t WS_SSQ2 = WS_SSQ + (size_t)NTOK * 4;
constexpr size_t WS_XB = WS_SSQ2 + (size_t)NTOK * 4;
constexpr size_t WS_C = WS_XB + (size_t)M1 * DM * 2;
constexpr size_t WS_Q = WS_C;
constexpr size_t WS_K = WS_Q + (size_t)NTOK * 512 * 2;
constexpr size_t WS_V = WS_K + (size_t)BATCH * 4 * 2 * KT * 8192;
constexpr size_t WS_HQ = WS_V + (size_t)BATCH * 4 * KT * 16384;
constexpr size_t WS_HV = WS_HQ + (size_t)BATCH * 4 * HT * 128 * 2;
constexpr size_t WS_HG = WS_HV + (size_t)BATCH * 4 * HT * 128 * 2;
constexpr size_t WS_SG = WS_HG + (size_t)BATCH * 4 * HT * 128 * 4;
constexpr size_t WS_CEND = WS_SG + (size_t)NTOK * 512 * 2;
constexpr size_t WS_PQ = WS_C;
constexpr size_t WS_EIDX = WS_PQ + (size_t)NTOK * 2048 * 2;
constexpr size_t WS_EGATE = WS_EIDX + (size_t)NTOK * 128 * 4;
constexpr size_t WS_HID = WS_EGATE + (size_t)NTOK * 128 * 4;
constexpr size_t WS_XN8 = WS_HID + (size_t)NTOK * 128 * 4;
constexpr size_t WS_XSC = WS_XN8 + (size_t)NTOK * DM;
static_assert(WS_XSC + (size_t)NTOK * 4 <= WS_CEND, "overlay fits");
constexpr size_t WS_HIDP = WS_PQ;
constexpr size_t WS_MIX = WS_CEND;
constexpr size_t WS_HQA = WS_MIX + (size_t)NTOK * DM * 2;
constexpr size_t WS_HD = WS_HQA + (size_t)BATCH * 4 * HT * 128 * 2;
constexpr size_t WS_END = WS_HD + (size_t)BATCH * 4 * 129 * 128 * 4;
static_assert(WS_END <= (size_t)512 * 1024 * 1024, "workspace map must fit 512 MiB");

struct Params {
    const float* x; const float* meta; const float* mix_norm_w; const float* w_in; const float* lb_logits; const float* rec_norm_w;
    const float* lq1; const float* lk1; const float* lq2; const float* lk2; const float* subln_w; const float* w_out; const float* ffn_norm_w;
    const float* wq; const float* subkeys; const float* pu; const float* pv; const float* final_w;
    float* out; unsigned char* ws;
};

DI unsigned f2bf(float f) { unsigned u = __builtin_bit_cast(unsigned, f); return (u + 0x7fffu + ((u >> 16) & 1u)) >> 16; }
DI float bf2f(unsigned b) { return __builtin_bit_cast(float, b << 16); }
DI unsigned cvtpk(float lo, float hi) { f32x2 v = {lo, hi}; bf16x2_t b = __builtin_convertvector(v, bf16x2_t); return __builtin_bit_cast(unsigned, b); }
DI float wave_sum(float v) {
#pragma unroll
    for (int o = 1; o < 64; o <<= 1) v += __shfl_xor(v, o);
    return v;
}
DI float sigmoidf_(float x) { return 1.f / (1.f + __expf(-x)); }
DI float siluf_(float x) { return x * sigmoidf_(x); }

DI int sigma_col(int c) {
    if (c >= 1024) return c;
    const int cc = c & 63, a = cc >> 5, fq = (cc >> 3) & 3, n = (cc >> 2) & 1, j = cc & 3;
    return (c & ~63) + 4 * (4 * a + fq) + 32 * n + j;
}
template <bool PERMUTE>
DI void p0_transpose_item(const float* W, int K, int N, const float* scale, bf16_t* WT, LAS float* scr, int item, int lane) {
    const int nblk = N / 32, kb = item / nblk, nb = item % nblk, k0 = 64 * kb, n0 = 32 * nb;
    const int ncol = PERMUTE ? sigma_col(n0 + (lane & 31)) : n0 + (lane & 31);
#pragma unroll 8
    for (int i = 0; i < 32; ++i) { const int kk = 2 * i + (lane >> 5); float s = scale ? scale[k0 + kk] : 1.f; scr[kk * 33 + (lane & 31)] = W[(size_t)(k0 + kk) * N + ncol] * s; }
    asm volatile("s_waitcnt lgkmcnt(0)" ::: "memory");
    const int c = lane & 7;
#pragma unroll
    for (int j = 0; j < 4; ++j) { const int n = (lane >> 3) + 8 * j; const LAS float* s = scr + (8 * c) * 33 + n;
        u32x4 o; o.x = cvtpk(s[0 * 33], s[1 * 33]); o.y = cvtpk(s[2 * 33], s[3 * 33]); o.z = cvtpk(s[4 * 33], s[5 * 33]); o.w = cvtpk(s[6 * 33], s[7 * 33]);
        *(u32x4*)(WT + (size_t)(n0 + n) * K + k0 + 8 * c) = o; }
    asm volatile("s_waitcnt lgkmcnt(0)" ::: "memory");
}

DI void phase0(const Params& P, char* lds, int bid, int nblk) {
    const int tid = tid_(), lane = tid & 63, wave = __builtin_amdgcn_readfirstlane(tid >> 6);
    unsigned char* ws = P.ws;
    LAS float* scr = (LAS float*)(lds) + wave * (64 * 33);
    const int gw = bid * NWAVES + wave, NGW = nblk * NWAVES;
    constexpr int I1 = (DM / 64) * (NCOL1 / 32), I2 = (DM / 64) * (DM / 32), I3 = (DM / 64) * (2048 / 32);
    for (int it = gw; it < I1 + I2 + I3; it += NGW) {
        int r = it;
        if (r < I1) { p0_transpose_item<true>(P.w_in, DM, NCOL1, P.mix_norm_w, (bf16_t*)(ws + WS_W1T), scr, r, lane); continue; } r -= I1;
        if (r < I2) { p0_transpose_item<false>(P.w_out, DM, DM, nullptr, (bf16_t*)(ws + WS_W2T), scr, r, lane); continue; } r -= I2;
        p0_transpose_item<false>(P.wq, DM, 2048, P.ffn_norm_w, (bf16_t*)(ws + WS_W3T), scr, r, lane);
    }
    for (int m = gw; m < M1; m += NGW) {
        bf16_t* orow = (bf16_t*)(ws + WS_XB) + (size_t)m * DM;
        float* r1 = (float*)(ws + WS_R1);
        unsigned long long* o8 = (unsigned long long*)orow + lane;
        if (m >= NTOK + NMETA) { for (int j = 0; j < 4; ++j) o8[64 * j] = 0ull; if (lane == 0) r1[m] = 0.f; continue; }
        const float* xrow = (m < NTOK) ? P.x + (size_t)m * DM : P.meta + (size_t)(m - NTOK) * DM;
        const f32x4* xr = (const f32x4*)xrow + lane;
        f32x4 v[4]; float s = 0.f;
#pragma unroll
        for (int j = 0; j < 4; ++j) { v[j] = xr[64 * j]; s += (v[j].x * v[j].x + v[j].y * v[j].y) + (v[j].z * v[j].z + v[j].w * v[j].w); }
        s = wave_sum(s);
        if (lane == 0) r1[m] = 1.f / sqrtf(s * (1.f / DM) + EPS);
#pragma unroll
        for (int j = 0; j < 4; ++j) o8[64 * j] = (unsigned long long)cvtpk(v[j].x, v[j].y) | ((unsigned long long)cvtpk(v[j].z, v[j].w) << 32);
    }
    {
        const size_t gt = (size_t)bid * NTHREADS + tid, NGT = (size_t)nblk * NTHREADS;
        const size_t ns = (size_t)16 * 128 * 128 / 8;
        for (size_t e = gt; e < ns; e += NGT) {
            const f32x4 a = ((const f32x4*)P.subkeys)[2 * e], b = ((const f32x4*)P.subkeys)[2 * e + 1];
            u32x4 o; o.x = cvtpk(a.x, a.y); o.y = cvtpk(a.z, a.w); o.z = cvtpk(b.x, b.y); o.w = cvtpk(b.z, b.w);
            ((u32x4*)(ws + WS_SKB))[e] = o;
        }
        for (int r = gw; r < 2 * NEXP; r += NGW) {
            const bool isv = r >= NEXP; const int e = isv ? r - NEXP : r;
            const float* src = (isv ? P.pv : P.pu) + (size_t)e * DM + 16 * lane;
            const f32x4 a = *(const f32x4*)src, b = *(const f32x4*)(src + 4), c = *(const f32x4*)(src + 8), d = *(const f32x4*)(src + 12);
            float am = fmaxf(fmaxf(fmaxf(fabsf(a.x), fabsf(a.y)), fmaxf(fabsf(a.z), fabsf(a.w))), fmaxf(fmaxf(fabsf(b.x), fabsf(b.y)), fmaxf(fabsf(b.z), fabsf(b.w))));
            am = fmaxf(am, fmaxf(fmaxf(fmaxf(fabsf(c.x), fabsf(c.y)), fmaxf(fabsf(c.z), fabsf(c.w))), fmaxf(fmaxf(fabsf(d.x), fabsf(d.y)), fmaxf(fabsf(d.z), fabsf(d.w)))));
#pragma unroll
            for (int o = 1; o < 64; o <<= 1) am = fmaxf(am, __shfl_xor(am, o));
            const float sc = (am > 0.f) ? exp2f(floorf(log2f(224.f / am))) : 1.f;
            int w0 = __builtin_amdgcn_cvt_pk_fp8_f32(a.x * sc, a.y * sc, 0, false); w0 = __builtin_amdgcn_cvt_pk_fp8_f32(a.z * sc, a.w * sc, w0, true);
            int w1 = __builtin_amdgcn_cvt_pk_fp8_f32(b.x * sc, b.y * sc, 0, false); w1 = __builtin_amdgcn_cvt_pk_fp8_f32(b.z * sc, b.w * sc, w1, true);
            int w2 = __builtin_amdgcn_cvt_pk_fp8_f32(c.x * sc, c.y * sc, 0, false); w2 = __builtin_amdgcn_cvt_pk_fp8_f32(c.z * sc, c.w * sc, w2, true);
            int w3 = __builtin_amdgcn_cvt_pk_fp8_f32(d.x * sc, d.y * sc, 0, false); w3 = __builtin_amdgcn_cvt_pk_fp8_f32(d.z * sc, d.w * sc, w3, true);
            unsigned char* dst = ws + (isv ? WS_VB : WS_UB) + (size_t)(lane >> 3) * ((size_t)NEXP * 128) + (size_t)e * 128 + 16 * (lane & 7);
            *(u32x4*)dst = (u32x4){(unsigned)w0, (unsigned)w1, (unsigned)w2, (unsigned)w3};
            if (lane == 0) ((float*)(ws + (isv ? WS_VSC : WS_USC)))[e] = 1.f / sc;
        }
        float* rope = (float*)(ws + WS_ROPE);
        for (size_t i = gt; i < (size_t)TPOS * 32; i += NGT) {
            const int t = (int)(i >> 5), f = (int)(i & 31);
            const double inv = exp2(-(double)f * (13.287712379549449 / 32.0));
            const double ang = (double)t * inv;
            rope[(size_t)t * 64 + f] = (float)cos(ang); rope[(size_t)t * 64 + 32 + f] = (float)sin(ang);
        }
        float* ssq = (float*)(ws + WS_SSQ);
        for (size_t i = gt; i < (size_t)2 * NTOK; i += NGT) ssq[i] = 0.f;
        for (size_t i = gt; i < (size_t)BATCH * 4 * 2 * 512; i += NGT) { const size_t img = i >> 9, o = i & 511; ((u32x4*)(ws + WS_K + img * KT * 8192))[o] = (u32x4){0u, 0u, 0u, 0u}; }
        for (size_t i = gt; i < (size_t)BATCH * 4 * 1024; i += NGT) { const size_t img = i >> 10, o = i & 1023; ((u32x4*)(ws + WS_V + img * KT * 16384))[o] = (u32x4){0u, 0u, 0u, 0u}; }
        for (size_t i = gt; i < (size_t)BATCH * 4 * 16 * 16; i += NGT) { const size_t bh = i >> 8, o = i & 255;
            ((u32x4*)(ws + WS_HQ + bh * HT * 256))[o] = (u32x4){0u, 0u, 0u, 0u}; ((u32x4*)(ws + WS_HV + bh * HT * 256))[o] = (u32x4){0u, 0u, 0u, 0u}; }
        for (size_t i = gt; i < (size_t)BATCH * 4 * 16 * 32; i += NGT) { const size_t bh = i >> 9, o = i & 511; ((u32x4*)(ws + WS_HG + bh * HT * 512))[o] = (u32x4){0u, 0u, 0u, 0u}; }
        float* lb = (float*)(ws + WS_LB);
        if (gt < 512) lb[gt] = sigmoidf_(P.lb_logits[gt] - P.lb_logits[512 + gt]);
        if (bid == 0 && wave == 0) {
            const float a = wave_sum(P.lq1[lane] * P.lk1[lane]), b = wave_sum(P.lq2[lane] * P.lk2[lane]);
            if (lane == 0) lb[512] = __expf(a) - __expf(b) + LAM_INIT;
        }
    }
}

namespace pg8 {
#define PG8_LAS __attribute__((address_space(3)))
typedef unsigned short bf16_t;
typedef short bf16x8 __attribute__((ext_vector_type(8)));
typedef float f32x4 __attribute__((ext_vector_type(4)));
typedef unsigned u32x4 __attribute__((ext_vector_type(4)));
constexpr int BM = 256, BK = 64, HALF = 128, HTB = HALF * BK * 2  , STAGE_BYTES = 8 * HTB, NXCD = 8, WGM = 8;

__host__ __device__ __forceinline__ int lds_byte(int r, int c) { const int st = (r >> 4) * 2 + (c >> 5), rr = r & 15, cc = c & 31, ob = rr * 64 + cc * 2; return st * 1024 + (ob ^ (((ob >> 9) & 1) << 5)); }
__host__ __device__ __forceinline__ void stage_rc(int b, int& R, int& C) { const int st = b / 1024, sb = b % 1024, swz = sb ^ (((sb >> 9) & 1) << 5); R = (st >> 1) * 16 + swz / 64; C = (st & 1) * 32 + (swz % 64) / 2; }
__host__ __device__ __forceinline__ int perm32(int rho) { const int n = rho >> 4, i = rho & 15; return 8 * (i >> 2) + 4 * n + (i & 3); }

struct Unit { int pm, pn; };
struct Gemm { const bf16_t* A; const bf16_t* Bt; int M, N, K; };

struct StaticOrder {
    int nM, nN, nwg, G, c;
    __host__ __device__ void init(int M, int N, int G_, int c_) { nM = M / BM; nN = N / BM; nwg = nM * nN; G = G_; c = c_; }
    __host__ __device__ bool next(int i, Unit& u) const {
        const long L = (long)i * G + c; if (L >= nwg) return false;
        int wgid = (int)L; { const int q = nwg / NXCD, r = nwg % NXCD, xcd = wgid % NXCD, off = wgid / NXCD; wgid = (xcd < r ? xcd * (q + 1) : r * (q + 1) + (xcd - r) * q) + off; }
        const int nig = WGM * nN, gid = wgid / nig, fm = gid * WGM, gsz = (nM - fm) < WGM ? (nM - fm) : WGM;
        u.pm = fm + ((wgid % nig) % gsz); u.pn = (wgid % nig) / gsz; return true;
    }
    __device__ __forceinline__ void a_ready(const Unit&) const {}
    __device__ __forceinline__ void done(const Unit&) const {}
};

template <class Epi, class Sched, bool ALIGN_EPI = false, bool SP2 = false>
__device__ __forceinline__ void gemm_phase(PG8_LAS unsigned char* lds, const Gemm g, const Sched& S, const Epi& E) {
    const int tid = tid_(), wid = __builtin_amdgcn_readfirstlane(tid >> 6), lane = tid & 63, wr = wid >> 2, wc = wid & 3, fr = lane & 15, fq = lane >> 4;
    const int K = g.K, nt = K / BK;
    unsigned voffA[2], voffB[2];
#pragma unroll
    for (int i = 0; i < 2; ++i) { int R, C; stage_rc(tid * 16 + i * 8192, R, C); const int Rb = Epi::PERM ? ((R & ~31) + perm32(R & 31)) : R;
        voffA[i] = (unsigned)(R * K + C) * 2u; voffB[i] = (unsigned)(Rb * K + C) * 2u; }
    const size_t kstep = (size_t)(BK * 2);
    const size_t hstep = (size_t)HALF * K * 2;
    const size_t tstep = 2 * hstep;
    const unsigned ldsw = (unsigned)wid * 1024u;
    const int aoff = lds_byte(wr * 64 + fr, fq * 8), boff = lds_byte(wc * 32 + fr, fq * 8);
#define PG8_SA(b, h) (((b) * 2 + (h)) * HTB)
#define PG8_SB(b, h) ((4 + (b) * 2 + (h)) * HTB)
#define PG8_STAGE(bufoff, gbase, voff) do { _Pragma("unroll") for (int _i = 0; _i < 2; ++_i) \
        __builtin_amdgcn_global_load_lds((const unsigned*)((const char*)(gbase) + (voff)[_i]), (PG8_LAS unsigned*)(lds + (bufoff) + ldsw + _i * 8192), 16, 0, 0); } while (0)
#define PG8_LDA(dst, b, h) do { _Pragma("unroll") for (int m = 0; m < 4; ++m) _Pragma("unroll") for (int k = 0; k < 2; ++k) dst[m][k] = *(const PG8_LAS bf16x8*)(lds + PG8_SA(b, h) + aoff + m * 2048 + k * 1024); } while (0)
#define PG8_LDB(dst, b, h) do { _Pragma("unroll") for (int n = 0; n < 2; ++n) _Pragma("unroll") for (int k = 0; k < 2; ++k) dst[n][k] = *(const PG8_LAS bf16x8*)(lds + PG8_SB(b, h) + boff + n * 2048 + k * 1024); } while (0)
#define PG8_MMA(ai, bj, At, Bt) do { __builtin_amdgcn_s_setprio(1); _Pragma("unroll") for (int m = 0; m < 4; ++m) _Pragma("unroll") for (int n = 0; n < 2; ++n) _Pragma("unroll") for (int k = 0; k < 2; ++k) \
        acc[ai][bj][m][n] = __builtin_amdgcn_mfma_f32_16x16x32_bf16(Bt[n][k], At[m][k], acc[ai][bj][m][n], 0, 0, 0); __builtin_amdgcn_s_setprio(0); } while (0)
#define PG8_WAIT_V(n) asm volatile("s_waitcnt vmcnt(" #n ")" ::: "memory")
#define PG8_WAIT_L(n) asm volatile("s_waitcnt lgkmcnt(" #n ")" ::: "memory")
#define PG8_BAR __builtin_amdgcn_s_barrier()
#define PG8_SCHED __builtin_amdgcn_sched_barrier(0)
    Unit cur, nxt; int ui = 0;
    if (!S.next(0, cur)) return;
    f32x4 acc[2][2][4][2];
#pragma unroll
    for (int a = 0; a < 2; ++a)
#pragma unroll
        for (int b = 0; b < 2; ++b)
#pragma unroll
            for (int m = 0; m < 4; ++m)
#pragma unroll
                for (int n = 0; n < 2; ++n) acc[a][b][m][n] = (f32x4){0.f, 0.f, 0.f, 0.f};
    bf16x8 At[4][2], B0[2][2], B1[2][2];
    const char* cA = (const char*)g.A + (size_t)cur.pm * tstep; const char* cB = (const char*)g.Bt + (size_t)cur.pn * tstep;
    S.a_ready(cur);
    if constexpr (SP2) {
        PG8_STAGE(PG8_SB(0, 0), cB, voffB); PG8_STAGE(PG8_SB(0, 1), cB + hstep, voffB); PG8_STAGE(PG8_SA(0, 0), cA, voffA); PG8_STAGE(PG8_SA(0, 1), cA + hstep, voffA);
        if (wr == 1) PG8_BAR;
        PG8_WAIT_V(2); PG8_BAR;
        PG8_STAGE(PG8_SB(1, 0), cB + kstep, voffB); PG8_STAGE(PG8_SA(1, 0), cA + kstep, voffA); PG8_STAGE(PG8_SB(1, 1), cB + hstep + kstep, voffB);
        PG8_WAIT_V(6); PG8_BAR;
    } else {
        PG8_STAGE(PG8_SB(0, 0), cB, voffB); PG8_STAGE(PG8_SA(0, 0), cA, voffA); PG8_STAGE(PG8_SB(0, 1), cB + hstep, voffB); PG8_STAGE(PG8_SA(0, 1), cA + hstep, voffA);
        if (wr == 1) PG8_BAR;
        PG8_WAIT_V(4); PG8_BAR;
        PG8_STAGE(PG8_SB(1, 0), cB + kstep, voffB); PG8_STAGE(PG8_SA(1, 0), cA + kstep, voffA); PG8_STAGE(PG8_SB(1, 1), cB + hstep + kstep, voffB);
        PG8_WAIT_V(6); PG8_BAR;
    }
    for (;;) {
        const bool has_next = S.next(ui + 1, nxt);
        const char* nA = has_next ? (const char*)g.A + (size_t)nxt.pm * tstep : cA; const char* nB = has_next ? (const char*)g.Bt + (size_t)nxt.pn * tstep : cB;
        for (int t = 0; t < nt; t += 2) {
            const bool last = (t == nt - 2);
            const char* a1 = cA + (size_t)(t + 1) * kstep;
            const char* a2 = last ? nA : cA + (size_t)(t + 2) * kstep; const char* b2 = last ? nB : cB + (size_t)(t + 2) * kstep;
            const char* a3 = a2 + kstep; const char* b3 = b2 + kstep;
            if (last && has_next) S.a_ready(nxt);
            if constexpr (SP2) {
            PG8_LDB(B0, 0, 0); PG8_LDB(B1, 0, 1); PG8_SCHED; PG8_LDA(At, 0, 0); PG8_STAGE(PG8_SA(1, 1), a1 + hstep, voffA);
            PG8_WAIT_V(8); PG8_WAIT_L(0); PG8_BAR; PG8_MMA(0, 0, At, B0); PG8_MMA(0, 1, At, B1); PG8_BAR; PG8_SCHED;
            PG8_LDA(At, 0, 1); PG8_STAGE(PG8_SB(0, 0), b2, voffB); PG8_STAGE(PG8_SB(0, 1), b2 + hstep, voffB); PG8_STAGE(PG8_SA(0, 0), a2, voffA);
            PG8_WAIT_V(8); PG8_WAIT_L(0); PG8_BAR; PG8_MMA(1, 0, At, B0); PG8_MMA(1, 1, At, B1); PG8_BAR; PG8_SCHED;
            PG8_LDB(B0, 1, 0); PG8_LDB(B1, 1, 1); PG8_SCHED; PG8_LDA(At, 1, 0); PG8_STAGE(PG8_SA(0, 1), a2 + hstep, voffA);
            PG8_WAIT_V(8); PG8_WAIT_L(0); PG8_BAR; PG8_MMA(0, 0, At, B0); PG8_MMA(0, 1, At, B1); PG8_BAR; PG8_SCHED;
            PG8_LDA(At, 1, 1); PG8_STAGE(PG8_SB(1, 0), b3, voffB); PG8_STAGE(PG8_SB(1, 1), b3 + hstep, voffB); PG8_STAGE(PG8_SA(1, 0), a3, voffA);
            PG8_WAIT_V(8); PG8_WAIT_L(0); PG8_BAR; PG8_MMA(1, 0, At, B0); PG8_MMA(1, 1, At, B1); PG8_BAR; PG8_SCHED;
            } else {
            PG8_LDB(B0, 0, 0); PG8_SCHED; PG8_LDA(At, 0, 0); PG8_STAGE(PG8_SA(1, 1), a1 + hstep, voffA);
            PG8_WAIT_L(8); PG8_BAR; PG8_WAIT_L(0); PG8_MMA(0, 0, At, B0); PG8_BAR; PG8_SCHED;
            PG8_LDB(B1, 0, 1); PG8_STAGE(PG8_SB(0, 0), b2, voffB);
            PG8_BAR; PG8_WAIT_L(0); PG8_MMA(0, 1, At, B1); PG8_BAR;
            PG8_LDA(At, 0, 1); PG8_STAGE(PG8_SA(0, 0), a2, voffA);
            PG8_BAR; PG8_WAIT_L(0); PG8_MMA(1, 0, At, B0); PG8_BAR; PG8_SCHED;
            PG8_STAGE(PG8_SB(0, 1), b2 + hstep, voffB);
            PG8_WAIT_V(6); PG8_BAR; PG8_MMA(1, 1, At, B1); PG8_BAR;
            PG8_LDB(B0, 1, 0); PG8_SCHED; PG8_LDA(At, 1, 0); PG8_STAGE(PG8_SA(0, 1), a2 + hstep, voffA);
            PG8_WAIT_L(8); PG8_BAR; PG8_WAIT_L(0); PG8_MMA(0, 0, At, B0); PG8_BAR; PG8_SCHED;
            PG8_LDB(B1, 1, 1); PG8_STAGE(PG8_SB(1, 0), b3, voffB);
            PG8_BAR; PG8_WAIT_L(0); PG8_MMA(0, 1, At, B1); PG8_BAR;
            PG8_LDA(At, 1, 1); PG8_STAGE(PG8_SA(1, 0), a3, voffA);
            PG8_BAR; PG8_WAIT_L(0); PG8_MMA(1, 0, At, B0); PG8_BAR; PG8_SCHED;
            PG8_STAGE(PG8_SB(1, 1), b3 + hstep, voffB);
            PG8_WAIT_V(6); PG8_BAR; PG8_MMA(1, 1, At, B1); PG8_BAR;
            }
        }
        if constexpr (ALIGN_EPI) { if (wr == 0) PG8_BAR; }
        if constexpr (!Epi::AFTER_DRAIN) { E(acc, cur, wr, wc, fr, fq); S.done(cur); }
        if (!has_next) break;
#pragma unroll
        for (int a = 0; a < 2; ++a)
#pragma unroll
            for (int b = 0; b < 2; ++b)
#pragma unroll
                for (int m = 0; m < 4; ++m)
#pragma unroll
                    for (int n = 0; n < 2; ++n) acc[a][b][m][n] = (f32x4){0.f, 0.f, 0.f, 0.f};
        cur = nxt; cA = nA; cB = nB; ++ui;
        if constexpr (ALIGN_EPI) { if (wr == 1) PG8_BAR; }
    }
    PG8_WAIT_V(0);
    if constexpr (!ALIGN_EPI) { if (wr == 0) PG8_BAR; }
    PG8_BAR;
    if constexpr (Epi::AFTER_DRAIN) { E.fused(acc, cur, wr, wc, fr, fq, lds, wid, lane); S.done(cur); }
#undef PG8_SA
#undef PG8_SB
#undef PG8_STAGE
#undef PG8_LDA
#undef PG8_LDB
#undef PG8_MMA
#undef PG8_WAIT_V
#undef PG8_WAIT_L
#undef PG8_BAR
#undef PG8_SCHED
}
}

DI u32x2 pack4(f32x4 v) { u32x2 r; r.x = cvtpk(v.x, v.y); r.y = cvtpk(v.z, v.w); return r; }
DI u32x4 pack8(f32x4 a, f32x4 b) { u32x4 r; r.x = cvtpk(a.x, a.y); r.y = cvtpk(a.z, a.w); r.z = cvtpk(b.x, b.y); r.w = cvtpk(b.z, b.w); return r; }

struct Epi1 {
    static constexpr bool PERM = true, AFTER_DRAIN = false;
    unsigned char* ws;
    DI void operator()(const f32x4 (&acc)[2][2][4][2], const pg8::Unit& u, int wr, int wc, int fr, int fq) const {
        const float* r1p = (const float*)(ws + WS_R1);
        const float* rope = (const float*)(ws + WS_ROPE);
        const float* lbp = (const float*)(ws + WS_LB);
        const int seg = u.pn >> 1;
#pragma unroll
        for (int ai = 0; ai < 2; ++ai)
#pragma unroll
            for (int m = 0; m < 4; ++m) {
                const int row = u.pm * 256 + ai * 128 + wr * 64 + m * 16 + fr;
                const bool meta = row >= NTOK;
                if (row >= NTOK + NMETA) continue;
                const float r1 = r1p[row];
                const int b = meta ? 0 : (row >> 12), t = meta ? (row - NTOK) : ((row & 4095) + NMETA);
                const int nrep = meta ? BATCH : 1;
#pragma unroll
                for (int bj = 0; bj < 2; ++bj) {
                    const int cs = (u.pn & 1) * 256 + bj * 128 + wc * 32 + 8 * fq;
                    const f32x4 v0 = acc[ai][bj][m][0] * r1, v1 = acc[ai][bj][m][1] * r1;
                    const int h = cs >> 7;
                    if (seg <= 1) {
                        const int comp = (cs >> 6) & 1, cc = cs & 63, i0 = 16 * (cc >> 5) + 4 * fq;
                        const f32x4 c4 = *(const f32x4*)(rope + (size_t)t * 64 + i0), s4 = *(const f32x4*)(rope + (size_t)t * 64 + 32 + i0);
                        f32x4 lo = v0 * c4 - v1 * s4, hi = v1 * c4 + v0 * s4;
                        if (seg == 0) {
                            if (meta) continue;
                            lo = lo * QSCALE; hi = hi * QSCALE;
                            bf16_t* qp = (bf16_t*)(ws + WS_Q) + ((size_t)(((b * 4 + h) * 2 + comp) * SEQ + (row & 4095))) * 64;
                            *(u32x2*)(qp + i0) = pack4(lo); *(u32x2*)(qp + i0 + 32) = pack4(hi);
                        } else {
                            const int pp = t + KPAD, tile = pp >> 6, key = pp & 63;
                            for (int bb = 0; bb < nrep; ++bb) {
                                const int b_ = meta ? bb : b;
                                unsigned char* img = ws + WS_K + ((size_t)((b_ * 4 + h) * 2 + comp) * KT + tile) * 8192;
                                *(u32x2*)(img + (i0 >> 3) * 1024 + key * 16 + (i0 & 7) * 2) = pack4(lo);
                                *(u32x2*)(img + ((i0 >> 3) + 4) * 1024 + key * 16 + (i0 & 7) * 2) = pack4(hi);
                            }
                        }
                    } else if (seg == 2) {
                        const int dv = cs & 127, pp = t + KPAD, tile = pp >> 6, key = pp & 63;
                        const u32x4 w = pack8(v0, v1);
                        for (int bb = 0; bb < nrep; ++bb) {
                            const int b_ = meta ? bb : b;
                            unsigned char* img = ws + WS_V + ((size_t)(b_ * 4 + h) * KT + tile) * 16384;
                            *(u32x4*)(img + (dv >> 5) * 4096 + key * 64 + (dv & 31) * 2) = w;
                        }
                    } else if (seg == 3 || seg == 5) {
                        const int dv = cs & 127;
                        f32x4 a = v0, c = v1;
                        if (seg == 3) { a.x = siluf_(a.x); a.y = siluf_(a.y); a.z = siluf_(a.z); a.w = siluf_(a.w); c.x = siluf_(c.x); c.y = siluf_(c.y); c.z = siluf_(c.z); c.w = siluf_(c.w); }
                        const u32x4 w = pack8(a, c);
                        const size_t base = (seg == 3) ? WS_HQ : WS_HV;
                        for (int bb = 0; bb < nrep; ++bb) {
                            const int b_ = meta ? bb : b;
                            *(u32x4*)((bf16_t*)(ws + base) + ((size_t)(b_ * 4 + h) * HT + t + 16) * 128 + dv) = w;
                        }
                    } else if (seg == 4) {
                        const int dv = cs & 127;
                        const f32x4 l0 = *(const f32x4*)(lbp + cs), l1 = *(const f32x4*)(lbp + cs + 4);
                        f32x4 g0, g1;
#pragma unroll
                        for (int e = 0; e < 4; ++e) { g0[e] = __logf(l0[e] + (1.f - l0[e]) * sigmoidf_(v0[e])); g1[e] = __logf(l1[e] + (1.f - l1[e]) * sigmoidf_(v1[e])); }
                        for (int bb = 0; bb < nrep; ++bb) {
                            const int b_ = meta ? bb : b;
                            float* gp = (float*)(ws + WS_HG) + ((size_t)(b_ * 4 + h) * HT + t + 16) * 128 + dv;
                            *(f32x4*)gp = g0; *(f32x4*)(gp + 4) = g1;
                        }
                    } else {
                        if (meta) continue;
                        f32x4 a = v0, c = v1;
                        a.x = siluf_(a.x); a.y = siluf_(a.y); a.z = siluf_(a.z); a.w = siluf_(a.w); c.x = siluf_(c.x); c.y = siluf_(c.y); c.z = siluf_(c.z); c.w = siluf_(c.w);
                        *(u32x4*)((bf16_t*)(ws + WS_SG) + (size_t)row * 512 + cs) = pack8(a, c);
                    }
                }
            }
    }
};

struct Epi3 {
    static constexpr bool PERM = true, AFTER_DRAIN = false;
    const float* x; float* H; bf16_t* HB; float* ssq;
    DI void operator()(const f32x4 (&acc)[2][2][4][2], const pg8::Unit& u, int wr, int wc, int fr, int fq) const {
#pragma unroll
        for (int ai = 0; ai < 2; ++ai)
#pragma unroll
            for (int m = 0; m < 4; ++m) {
                const int row = u.pm * 256 + ai * 128 + wr * 64 + m * 16 + fr;
                float s = 0.f;
#pragma unroll
                for (int bj = 0; bj < 2; ++bj) {
                    const int col = u.pn * 256 + bj * 128 + wc * 32 + 8 * fq;
                    const size_t o = (size_t)row * DM + col;
                    const f32x4 h0 = *(const f32x4*)(x + o) + acc[ai][bj][m][0], h1 = *(const f32x4*)(x + o + 4) + acc[ai][bj][m][1];
                    *(f32x4*)(H + o) = h0; *(f32x4*)(H + o + 4) = h1;
                    *(u32x4*)(HB + o) = pack8(h0, h1);
                    s += (h0.x * h0.x + h0.y * h0.y) + (h0.z * h0.z + h0.w * h0.w) + (h1.x * h1.x + h1.y * h1.y) + (h1.z * h1.z + h1.w * h1.w);
                }
                s += __shfl_xor(s, 16); s += __shfl_xor(s, 32);
                if (fq == 0) atomicAdd(ssq + row, s);
            }
    }
};

struct Epi4 {
    static constexpr bool PERM = true, AFTER_DRAIN = false;
    const float* ssq; bf16_t* PQ;
    DI void operator()(const f32x4 (&acc)[2][2][4][2], const pg8::Unit& u, int wr, int wc, int fr, int fq) const {
#pragma unroll
        for (int ai = 0; ai < 2; ++ai)
#pragma unroll
            for (int m = 0; m < 4; ++m) {
                const int row = u.pm * 256 + ai * 128 + wr * 64 + m * 16 + fr;
                const float r2 = 1.f / sqrtf(ssq[row] * (1.f / DM) + EPS);
#pragma unroll
                for (int bj = 0; bj < 2; ++bj) {
                    const int col = u.pn * 256 + bj * 128 + wc * 32 + 8 * fq;
                    *(u32x4*)(PQ + (size_t)row * 2048 + col) = pack8(acc[ai][bj][m][0] * r2, acc[ai][bj][m][1] * r2);
                }
            }
    }
};

template <class Epi>
DI void gemm_run(char* lds, const bf16_t* A, const bf16_t* Bt, int M, int N, int K, const Epi& E, int bid, int nblk) {
    pg8::Gemm g{A, Bt, M, N, K}; pg8::StaticOrder S; S.init(M, N, nblk, bid);
    pg8::gemm_phase<Epi, pg8::StaticOrder, true, true>((LAS unsigned char*)lds, g, S, E);
}
#define MFMA32(a, b, c) __builtin_amdgcn_mfma_f32_32x32x16_bf16(a, b, c, 0, 0, 0)
typedef short v4i16_t __attribute__((ext_vector_type(4)));
DI int crow(int r, int hi) { return (r & 3) + 8 * (r >> 2) + 4 * hi; }
DI s16x4 vtr(const LAS char* p) { return __builtin_bit_cast(s16x4, __builtin_amdgcn_ds_read_tr16_b64_v4i16((LAS v4i16_t*)p)); }
DI void glds16(const void* g, LAS char* l) { __builtin_amdgcn_global_load_lds((const unsigned*)g, (LAS unsigned*)l, 16, 0, 0); }
DI float swap_max(float m) { auto rr = __builtin_amdgcn_permlane32_swap(__float_as_uint(m), __float_as_uint(m), false, false); return fmaxf(__uint_as_float(rr[0]), __uint_as_float(rr[1])); }
DI float swap_sum(float m) { auto rr = __builtin_amdgcn_permlane32_swap(__float_as_uint(m), __float_as_uint(m), false, false); return __uint_as_float(rr[0]) + __uint_as_float(rr[1]); }
constexpr int ATT_BUF = 32768, ATT_WSF = 65536;
constexpr float ATT_THR = 8.f;

DI void attn_unit(const Params& P, int b, int h, int j, char* lds_g) {
    LAS char* lds = (LAS char*)lds_g;
    const int tid = tid_(), lane = tid & 63, r32 = lane & 31, hi = lane >> 5;
    const int wid = __builtin_amdgcn_readfirstlane(tid >> 6), comp = wid >> 2, wq = wid & 3;
    const unsigned char* ws = P.ws;
    const int bh = b * 4 + h;
    const bf16_t* Qw = (const bf16_t*)(ws + WS_Q) + ((size_t)((bh * 2 + comp) * SEQ + 128 * j + 32 * wq)) * 64;
    bf16x8 qr[4];
#pragma unroll
    for (int d0 = 0; d0 < 4; ++d0) qr[d0] = *(const bf16x8*)(Qw + r32 * 64 + d0 * 16 + hi * 8);
    const unsigned char* kimg0 = ws + WS_K + (size_t)(bh * 2) * KT * 8192 + wid * 1024 + lane * 16;
    const unsigned char* kimg1 = kimg0 + (size_t)KT * 8192;
    const unsigned char* vimg = ws + WS_V + (size_t)bh * KT * 16384 + wid * 1024 + lane * 16;
    const int NT = 2 * j + 3, my_last = (wq < 2) ? 2 * j + 1 : 2 * j + 2;
    LAS float* wsf = (LAS float*)(lds + ATT_WSF) + wid * 64;
#define ATT_ISSUE(t, s) do { LAS char* d_ = lds + (s) * ATT_BUF + wid * 1024; \
        glds16(kimg0 + (size_t)(t) * 8192, d_); glds16(kimg1 + (size_t)(t) * 8192, d_ + 8192); \
        glds16(vimg + (size_t)(t) * 16384, d_ + 16384); glds16(vimg + (size_t)(t) * 16384 + 8192, d_ + 24576); } while (0)
    f32x16 o[4];
#pragma unroll
    for (int nb = 0; nb < 4; ++nb) o[nb] = f32x16{};
    float mref = 0.f, lsum = 0.f;
    const int qpos = 64 + 128 * j + 32 * wq + r32;
    ATT_ISSUE(0, 0);
    __syncthreads();
    for (int t = 0; t < NT; ++t) {
        const int s = t & 1;
        if (t + 1 < NT) ATT_ISSUE(t + 1, s ^ 1);
        if (t <= my_last) {
            const LAS char* kp = lds + s * ATT_BUF + comp * 8192 + hi * 1024 + r32 * 16;
            f32x16 s0 = f32x16{}, s1 = f32x16{};
#pragma unroll
            for (int d0 = 0; d0 < 4; ++d0) {
                const bf16x8 k0 = *(const LAS bf16x8*)(kp + d0 * 2048), k1 = *(const LAS bf16x8*)(kp + d0 * 2048 + 512);
                s0 = MFMA32(k0, qr[d0], s0); s1 = MFMA32(k1, qr[d0], s1);
            }
            if (t == 0) {
#pragma unroll
                for (int r = 0; r < 16; ++r) { s0[r] = -INFINITY; if (32 + crow(r, hi) < KPAD) s1[r] = -INFINITY; }
            }
            if (t >= 2 * j + 1) {
                const int kb = 64 * t + 4 * hi;
#pragma unroll
                for (int r = 0; r < 16; ++r) { const int kv = kb + (r & 3) + 8 * (r >> 2); if (kv > qpos) s0[r] = -INFINITY; if (kv + 32 > qpos) s1[r] = -INFINITY; }
            }
            float rm = fmaxf(s0[0], s1[0]);
#pragma unroll
            for (int r = 1; r < 16; ++r) rm = fmaxf(rm, fmaxf(s0[r], s1[r]));
            rm = swap_max(rm);
            if (t == 0) mref = rm;
            else {
                const float grow = rm - mref;
                if (__any(grow > ATT_THR)) {
                    const float dl = fmaxf(grow, 0.f), f = __builtin_amdgcn_exp2f(-dl);
                    mref += dl; lsum *= f;
                    if (hi == 0) wsf[r32] = f;
                    asm volatile("s_waitcnt lgkmcnt(0)" ::: "memory");
#pragma unroll
                    for (int r = 0; r < 16; ++r) { const float fr_ = wsf[crow(r, hi)];
#pragma unroll
                        for (int nb = 0; nb < 4; ++nb) o[nb][r] *= fr_; }
                }
            }
            float ps = 0.f;
#pragma unroll
            for (int r = 0; r < 16; ++r) { s0[r] = __builtin_amdgcn_exp2f(s0[r] - mref); s1[r] = __builtin_amdgcn_exp2f(s1[r] - mref); ps += s0[r] + s1[r]; }
            lsum += ps;
            const LAS char* vp = lds + s * ATT_BUF + 16384 + ((lane >> 4) & 1) * 32 + (lane & 3) * 8 + (4 * hi + ((lane & 15) >> 2)) * 64;
#pragma unroll
            for (int ks = 0; ks < 4; ++ks) {
                u32x4 pw;
                if (ks < 2) { pw.x = cvtpk(s0[8 * ks], s0[8 * ks + 1]); pw.y = cvtpk(s0[8 * ks + 2], s0[8 * ks + 3]); pw.z = cvtpk(s0[8 * ks + 4], s0[8 * ks + 5]); pw.w = cvtpk(s0[8 * ks + 6], s0[8 * ks + 7]); }
                else { const int q_ = ks - 2; pw.x = cvtpk(s1[8 * q_], s1[8 * q_ + 1]); pw.y = cvtpk(s1[8 * q_ + 2], s1[8 * q_ + 3]); pw.z = cvtpk(s1[8 * q_ + 4], s1[8 * q_ + 5]); pw.w = cvtpk(s1[8 * q_ + 6], s1[8 * q_ + 7]); }
                const bf16x8 pa = __builtin_bit_cast(bf16x8, pw);
#pragma unroll
                for (int nb = 0; nb < 4; ++nb) {
                    const s16x4 vlo = vtr(vp + nb * 4096 + ks * 1024), vhi = vtr(vp + nb * 4096 + ks * 1024 + 512);
                    const bf16x8 vb = (bf16x8){vlo[0], vlo[1], vlo[2], vlo[3], vhi[0], vhi[1], vhi[2], vhi[3]};
                    o[nb] = MFMA32(pa, vb, o[nb]);
                }
            }
        }
        __syncthreads();
    }
#undef ATT_ISSUE
    lsum = swap_sum(lsum);
    if (hi == 0) wsf[r32] = lsum;
    asm volatile("s_waitcnt lgkmcnt(0)" ::: "memory");
    float rli[16];
#pragma unroll
    for (int r = 0; r < 16; ++r) rli[r] = 1.f / wsf[crow(r, hi)];
    const float lam = ((const float*)(ws + WS_LB))[512];
    LAS float* ex = (LAS float*)lds + wq * 4096;
    if (comp == 1) {
#pragma unroll
        for (int r = 0; r < 16; ++r)
#pragma unroll
            for (int nb = 0; nb < 4; ++nb) ex[(r * 4 + nb) * 64 + lane] = o[nb][r] * rli[r] * lam;
    }
    __syncthreads();
    if (comp == 0) {
        float ss[16];
#pragma unroll
        for (int r = 0; r < 16; ++r) { float a = 0.f;
#pragma unroll
            for (int nb = 0; nb < 4; ++nb) { const float v = o[nb][r] * rli[r] - ex[(r * 4 + nb) * 64 + lane]; o[nb][r] = v; a += v * v; }
            ss[r] = a; }
#pragma unroll
        for (int r = 0; r < 16; ++r) { float a = ss[r]; a += __shfl_xor(a, 1); a += __shfl_xor(a, 2); a += __shfl_xor(a, 4); a += __shfl_xor(a, 8); a += __shfl_xor(a, 16); ss[r] = (1.f - LAM_INIT) / sqrtf(a * (1.f / 128.f) + EPS); }
        bf16_t* mix = (bf16_t*)(ws + WS_MIX) + ((size_t)(b * SEQ + 128 * j + 32 * wq)) * DM + h * 128;
#pragma unroll
        for (int nb = 0; nb < 4; ++nb) { const float w = P.subln_w[32 * nb + r32];
#pragma unroll
            for (int r = 0; r < 16; ++r) mix[(size_t)crow(r, hi) * DM + 32 * nb + r32] = (bf16_t)f2bf(o[nb][r] * ss[r] * w); }
    }
    __syncthreads();
}
#define MFMA16(a, b, c) __builtin_amdgcn_mfma_f32_16x16x32_bf16(a, b, c, 0, 0, 0)
constexpr int HG_STR = 272;
constexpr int HL_QA = 0, HL_QB = HL_QA + 32 * HG_STR, HL_KB = HL_QB + 32 * HG_STR, HL_KT = HL_KB + 32 * HG_STR, HL_VV = HL_KT + 32 * HG_STR;
constexpr int HL_PS = HL_VV + 32 * HG_STR;
constexpr int HL_D = HL_PS + 4 * 128 * 4;
constexpr int HL_OUT = HL_D + 128 * 4;
constexpr int HL_END = HL_OUT + 32 * 132 * 4;

DI void hgrn_prep_item(const Params& P, int bh, int c, char* lds_g) {
    LAS char* lds = (LAS char*)lds_g;
    const int tid = tid_(), ch = tid & 127, part = tid >> 7;
    unsigned char* ws = P.ws;
    float* HG = (float*)(ws + WS_HG) + (size_t)bh * HT * 128;
    bf16_t* HQ = (bf16_t*)(ws + WS_HQ) + (size_t)bh * HT * 128;
    bf16_t* HQA = (bf16_t*)(ws + WS_HQA) + (size_t)bh * HT * 128;
    const size_t r0 = (size_t)(32 * c + 8 * part);
    float g8[8], p8[8]; unsigned short q8[8];
    { float a = 0.f;
#pragma unroll
      for (int e = 0; e < 8; ++e) { g8[e] = HG[(r0 + e) * 128 + ch]; q8[e] = HQ[(r0 + e) * 128 + ch]; a += g8[e]; p8[e] = a; } }
    ((LAS float*)lds)[part * 128 + ch] = p8[7];
    __syncthreads();
    const LAS float* ps = (const LAS float*)lds;
    const float t0 = ps[ch], t1 = ps[128 + ch], t2 = ps[256 + ch], t3 = ps[384 + ch];
    const float off = (part > 0 ? t0 : 0.f) + (part > 1 ? t1 : 0.f) + (part > 2 ? t2 : 0.f);
    const float mid = t0 + t1, last = mid + t2 + t3;
    const float em = __expf(mid), el = __expf(last - mid);
    if (part == 0) ((float*)(ws + WS_HD))[((size_t)bh * 129 + c) * 128 + ch] = __expf(last);
#pragma unroll
    for (int e = 0; e < 8; ++e) {
        const float cum = off + p8[e];
        const float e1 = __expf(cum - mid), e2 = 1.f / e1;
        const float q = bf2f(q8[e]), k = 1.f - __expf(g8[e]);
        const float qb = q * e1, qa = qb * em, kb = k * e2, kt = kb * el;
        HQA[(r0 + e) * 128 + ch] = (bf16_t)f2bf(qa);
        HQ[(r0 + e) * 128 + ch] = (bf16_t)f2bf(qb);
        bf16_t* krow = (bf16_t*)(HG + (r0 + e) * 128);
        krow[ch] = (bf16_t)f2bf(kb); krow[128 + ch] = (bf16_t)f2bf(kt);
    }
    __syncthreads();
}

DI void hgrn_unit(const Params& P, int b, int h, char* lds_g) {
    LAS char* lds = (LAS char*)lds_g;
    const int tid = tid_(), lane = tid & 63, c16 = lane & 15, g4 = lane >> 4;
    const int wid = __builtin_amdgcn_readfirstlane(tid >> 6);
    const unsigned char* ws = P.ws;
    const int bh = b * 4 + h;
    const bf16_t* HQA = (const bf16_t*)(ws + WS_HQA) + (size_t)bh * HT * 128;
    const bf16_t* HQB = (const bf16_t*)(ws + WS_HQ) + (size_t)bh * HT * 128;
    const unsigned char* HK = ws + WS_HG + (size_t)bh * HT * 512;
    const bf16_t* HV = (const bf16_t*)(ws + WS_HV) + (size_t)bh * HT * 128;
    const float* HD = (const float*)(ws + WS_HD) + (size_t)bh * 129 * 128;
    const int vrow = tid >> 4, vcol = (tid & 15) * 8;
    f32x4 S[8];
#pragma unroll
    for (int i = 0; i < 8; ++i) S[i] = (f32x4){0.f, 0.f, 0.f, 0.f};
    u32x4 tqa, tqb, tkb, tkt, tv; f32x4 td = (f32x4){0.f, 0.f, 0.f, 0.f};
#define HG_LOAD(c) do { const size_t r_ = (size_t)(32 * (c)) + vrow; \
        tqa = *(const u32x4*)(HQA + r_ * 128 + vcol); tqb = *(const u32x4*)(HQB + r_ * 128 + vcol); \
        tkb = *(const u32x4*)(HK + r_ * 512 + vcol * 2); tkt = *(const u32x4*)(HK + r_ * 512 + 256 + vcol * 2); \
        tv = *(const u32x4*)(HV + r_ * 128 + vcol); if (tid < 32) td = *(const f32x4*)(HD + (size_t)(c) * 128 + tid * 4); } while (0)
    HG_LOAD(0);
    for (int c = 0; c < 129; ++c) {
        *(LAS u32x4*)(lds + HL_QA + vrow * HG_STR + vcol * 2) = tqa; *(LAS u32x4*)(lds + HL_QB + vrow * HG_STR + vcol * 2) = tqb;
        *(LAS u32x4*)(lds + HL_KB + vrow * HG_STR + vcol * 2) = tkb; *(LAS u32x4*)(lds + HL_KT + vrow * HG_STR + vcol * 2) = tkt;
        *(LAS u32x4*)(lds + HL_VV + vrow * HG_STR + vcol * 2) = tv;
        if (tid < 32) *(LAS f32x4*)(lds + HL_D + tid * 16) = td;
        if (c + 1 < 129) HG_LOAD(c + 1);
        __syncthreads();
        {
            f32x4 oacc[2] = {(f32x4){0.f, 0.f, 0.f, 0.f}, (f32x4){0.f, 0.f, 0.f, 0.f}};
#pragma unroll
            for (int ks = 0; ks < 4; ++ks) {
                u32x4 sp; sp.x = cvtpk(S[2 * ks][0], S[2 * ks][1]); sp.y = cvtpk(S[2 * ks][2], S[2 * ks][3]); sp.z = cvtpk(S[2 * ks + 1][0], S[2 * ks + 1][1]); sp.w = cvtpk(S[2 * ks + 1][2], S[2 * ks + 1][3]);
                const bf16x8 sf = __builtin_bit_cast(bf16x8, sp);
#pragma unroll
                for (int nt = 0; nt < 2; ++nt) {
                    const LAS char* qp = lds + HL_QA + (16 * nt + c16) * HG_STR + (32 * ks + 4 * g4) * 2;
                    const u32x2 lo = *(const LAS u32x2*)qp, hi2 = *(const LAS u32x2*)(qp + 32);
                    const bf16x8 qf = __builtin_bit_cast(bf16x8, (u32x4){lo.x, lo.y, hi2.x, hi2.y});
                    oacc[nt] = MFMA16(sf, qf, oacc[nt]);
                }
            }
            f32x4 at00 = (f32x4){0.f, 0.f, 0.f, 0.f}, at01 = at00, at11 = at00;
#pragma unroll
            for (int ks = 0; ks < 4; ++ks) {
                const bf16x8 ka0 = *(const LAS bf16x8*)(lds + HL_KB + c16 * HG_STR + (32 * ks + 8 * g4) * 2);
                const bf16x8 ka1 = *(const LAS bf16x8*)(lds + HL_KB + (16 + c16) * HG_STR + (32 * ks + 8 * g4) * 2);
                const bf16x8 qn0 = *(const LAS bf16x8*)(lds + HL_QB + c16 * HG_STR + (32 * ks + 8 * g4) * 2);
                const bf16x8 qn1 = *(const LAS bf16x8*)(lds + HL_QB + (16 + c16) * HG_STR + (32 * ks + 8 * g4) * 2);
                at00 = MFMA16(ka0, qn0, at00); at01 = MFMA16(ka0, qn1, at01); at11 = MFMA16(ka1, qn1, at11);
            }
#pragma unroll
            for (int r = 0; r < 4; ++r) { if (4 * g4 + r > c16) { at00[r] = 0.f; at11[r] = 0.f; } }
            {
                const LAS char* vp = lds + HL_VV + (4 * g4 + (c16 >> 2)) * HG_STR + (16 * wid + 4 * (c16 & 3)) * 2;
                const s16x4 vlo = vtr(vp), vhi = vtr(vp + 16 * HG_STR);
                const bf16x8 va = (bf16x8){vlo[0], vlo[1], vlo[2], vlo[3], vhi[0], vhi[1], vhi[2], vhi[3]};
                u32x4 b0; b0.x = cvtpk(at00[0], at00[1]); b0.y = cvtpk(at00[2], at00[3]); b0.z = 0u; b0.w = 0u;
                u32x4 b1; b1.x = cvtpk(at01[0], at01[1]); b1.y = cvtpk(at01[2], at01[3]); b1.z = cvtpk(at11[0], at11[1]); b1.w = cvtpk(at11[2], at11[3]);
                oacc[0] = MFMA16(va, __builtin_bit_cast(bf16x8, b0), oacc[0]);
                oacc[1] = MFMA16(va, __builtin_bit_cast(bf16x8, b1), oacc[1]);
            }
#pragma unroll
            for (int nt = 0; nt < 2; ++nt) *(LAS f32x4*)(lds + HL_OUT + ((16 * nt + c16) * 132 + 16 * wid + 4 * g4) * 4) = oacc[nt];
            {
                const LAS char* vp = lds + HL_VV + (8 * g4 + (c16 >> 2)) * HG_STR + (16 * wid + 4 * (c16 & 3)) * 2;
                const s16x4 vlo = vtr(vp), vhi = vtr(vp + 4 * HG_STR);
                const bf16x8 vb = (bf16x8){vlo[0], vlo[1], vlo[2], vlo[3], vhi[0], vhi[1], vhi[2], vhi[3]};
#pragma unroll
                for (int i = 0; i < 8; ++i) {
                    const f32x4 d4 = *(const LAS f32x4*)(lds + HL_D + (16 * i + 4 * g4) * 4);
                    const LAS char* kp = lds + HL_KT + (8 * g4 + (c16 >> 2)) * HG_STR + (16 * i + 4 * (c16 & 3)) * 2;
                    const s16x4 klo = vtr(kp), khi = vtr(kp + 4 * HG_STR);
                    const bf16x8 ka = (bf16x8){klo[0], klo[1], klo[2], klo[3], khi[0], khi[1], khi[2], khi[3]};
                    S[i] = MFMA16(ka, vb, S[i] * d4);
                }
            }
        }
        __syncthreads();
        if (c > 0) {
            const LAS float* op = (const LAS float*)(lds + HL_OUT) + vrow * 132 + vcol;
            const f32x4 a = *(const LAS f32x4*)op, bq = *(const LAS f32x4*)(op + 4);
            float ss = (a.x * a.x + a.y * a.y) + (a.z * a.z + a.w * a.w) + (bq.x * bq.x + bq.y * bq.y) + (bq.z * bq.z + bq.w * bq.w);
            ss += __shfl_xor(ss, 1); ss += __shfl_xor(ss, 2); ss += __shfl_xor(ss, 4); ss += __shfl_xor(ss, 8);
            const float rs = 1.f / sqrtf(ss * (1.f / 128.f) + EPS);
            const size_t row = (size_t)b * SEQ + 32 * (c - 1) + vrow;
            const u32x4 gv = *(const u32x4*)((const bf16_t*)(ws + WS_SG) + row * 512 + h * 128 + vcol);
            const f32x4 w0 = *(const f32x4*)(P.rec_norm_w + h * 128 + vcol), w1 = *(const f32x4*)(P.rec_norm_w + h * 128 + vcol + 4);
            f32x4 r0, r1;
            r0.x = a.x * rs * w0.x * bf2f(gv.x & 0xffffu); r0.y = a.y * rs * w0.y * bf2f(gv.x >> 16);
            r0.z = a.z * rs * w0.z * bf2f(gv.y & 0xffffu); r0.w = a.w * rs * w0.w * bf2f(gv.y >> 16);
            r1.x = bq.x * rs * w1.x * bf2f(gv.z & 0xffffu); r1.y = bq.y * rs * w1.y * bf2f(gv.z >> 16);
            r1.z = bq.z * rs * w1.z * bf2f(gv.w & 0xffffu); r1.w = bq.w * rs * w1.w * bf2f(gv.w >> 16);
            *(u32x4*)((bf16_t*)(ws + WS_MIX) + row * DM + 512 + h * 128 + vcol) = pack8(r0, r1);
        }
    }
#undef HG_LOAD
    __syncthreads();
}
template <int CTRL> DI float dpp_f(float v) { return __builtin_bit_cast(float, __builtin_amdgcn_update_dpp(0, __builtin_bit_cast(int, v), CTRL, 0xf, 0xf, false)); }
DI float row16_max(float v) { v = fmaxf(v, dpp_f<0x128>(v)); v = fmaxf(v, dpp_f<0x124>(v)); v = fmaxf(v, dpp_f<0x122>(v)); v = fmaxf(v, dpp_f<0x121>(v)); return v; }
DI float row16_sum(float v) { v += dpp_f<0x128>(v); v += dpp_f<0x124>(v); v += dpp_f<0x122>(v); v += dpp_f<0x121>(v); return v; }
#define CE_D(a, b) do { const float hi_ = fmaxf(a, b), lo_ = fminf(a, b); a = hi_; b = lo_; } while (0)
DI void bitonic_sort16(float (&v)[16]) {
#pragma unroll
    for (int k = 2; k <= 16; k *= 2)
#pragma unroll
        for (int j = k / 2; j > 0; j /= 2)
#pragma unroll
            for (int i = 0; i < 16; ++i) { const int l = i ^ j; if (l > i) { if ((i & k) == 0) CE_D(v[i], v[l]); else CE_D(v[l], v[i]); } }
}
DI void merge_top16(float (&a)[16], const float (&b)[16]) {
#pragma unroll
    for (int i = 0; i < 16; ++i) a[i] = fmaxf(a[i], b[15 - i]);
#pragma unroll
    for (int j = 8; j > 0; j /= 2)
#pragma unroll
        for (int i = 0; i < 16; ++i) { const int l = i ^ j; if (l > i) CE_D(a[i], a[l]); }
}
DI float embed7(float v, unsigned code) { return __uint_as_float((__float_as_uint(v) & 0xFFFFFF80u) | code); }
DI float embed8(float v, unsigned code) { return __uint_as_float((__float_as_uint(v) & 0xFFFFFF00u) | code); }

DI void topk_list(const bf16_t* qp, const bf16_t* kp, int hi, float (&top)[16]) {
    f32x16 acc[4];
#pragma unroll
    for (int kb = 0; kb < 4; ++kb) acc[kb] = f32x16{};
#pragma unroll
    for (int ks = 0; ks < 8; ++ks) {
        const bf16x8 qf = *(const bf16x8*)(qp + 16 * ks);
#pragma unroll
        for (int kb = 0; kb < 4; ++kb) { const bf16x8 kf = *(const bf16x8*)(kp + (size_t)kb * 32 * 128 + 16 * ks); acc[kb] = MFMA32(kf, qf, acc[kb]); }
    }
    float blk[16];
#pragma unroll
    for (int kb = 0; kb < 4; ++kb) {
#pragma unroll
        for (int r = 0; r < 16; ++r) { const unsigned code = (unsigned)(32 * kb + (r & 3) + 8 * (r >> 2)) | (unsigned)(4 * hi); if (kb == 0) top[r] = embed7(acc[kb][r], code); else blk[r] = embed7(acc[kb][r], code); }
        if (kb == 0) bitonic_sort16(top); else { bitonic_sort16(blk); merge_top16(top, blk); }
    }
    float l0[16], l1[16];
#pragma unroll
    for (int r = 0; r < 16; ++r) { auto rr = __builtin_amdgcn_permlane32_swap(__float_as_uint(top[r]), __float_as_uint(top[r]), false, false); l0[r] = __uint_as_float(rr[0]); l1[r] = __uint_as_float(rr[1]); }
    merge_top16(l0, l1);
#pragma unroll
    for (int r = 0; r < 16; ++r) top[r] = l0[r];
}

DI void topk_wave_item(const Params& P, int tb, int hh, LAS char* wlds) {
    const int lane = tid_() & 63, r32 = lane & 31, hi = lane >> 5;
    const unsigned char* ws = P.ws;
    const bf16_t* qp = (const bf16_t*)(ws + WS_PQ) + (size_t)(32 * tb + r32) * 2048 + hh * 256 + 8 * hi;
    const bf16_t* kp = (const bf16_t*)(ws + WS_SKB) + (size_t)(hh * 2 * 128 + r32) * 128 + 8 * hi;
    float A[16], B[16];
    topk_list(qp, kp, hi, A);
    topk_list(qp + 128, kp + 128 * 128, hi, B);
    LAS unsigned* my = (LAS unsigned*)(wlds + lane * 32);
#pragma unroll
    for (int w = 0; w < 4; ++w) {
        my[w] = (__float_as_uint(A[4 * w]) & 127u) | ((__float_as_uint(A[4 * w + 1]) & 127u) << 8) | ((__float_as_uint(A[4 * w + 2]) & 127u) << 16) | ((__float_as_uint(A[4 * w + 3]) & 127u) << 24);
        my[4 + w] = (__float_as_uint(B[4 * w]) & 127u) | ((__float_as_uint(B[4 * w + 1]) & 127u) << 8) | ((__float_as_uint(B[4 * w + 2]) & 127u) << 16) | ((__float_as_uint(B[4 * w + 3]) & 127u) << 24);
    }
#pragma unroll
    for (int r = 0; r < 16; ++r) { A[r] = __uint_as_float(__float_as_uint(A[r]) & 0xFFFFFF80u); B[r] = __uint_as_float(__float_as_uint(B[r]) & 0xFFFFFF80u); }
    float T[16], R1[16], X[16], Y[16];
#pragma unroll
    for (int j = 0; j < 16; ++j) { T[j] = embed8(A[0] + B[j], (unsigned)j); R1[j] = (j < 8) ? embed8(A[1] + B[j], (unsigned)(16 + j)) : -INFINITY; }
#define CAND(i, j) embed8(A[i] + B[j], (unsigned)(16 * (i) + (j)))
    X[0] = CAND(2, 0); X[1] = CAND(2, 1); X[2] = CAND(2, 2); X[3] = CAND(2, 3); X[4] = CAND(2, 4); X[5] = CAND(3, 0); X[6] = CAND(3, 1); X[7] = CAND(3, 2);
    X[8] = CAND(3, 3); X[9] = CAND(4, 0); X[10] = CAND(4, 1); X[11] = CAND(4, 2); X[12] = CAND(5, 0); X[13] = CAND(5, 1); X[14] = CAND(6, 0); X[15] = CAND(6, 1);
    Y[0] = CAND(7, 0); Y[1] = CAND(7, 1); Y[2] = CAND(8, 0); Y[3] = CAND(9, 0); Y[4] = CAND(10, 0); Y[5] = CAND(11, 0); Y[6] = CAND(12, 0); Y[7] = CAND(13, 0);
    Y[8] = CAND(14, 0); Y[9] = CAND(15, 0); Y[10] = -INFINITY; Y[11] = -INFINITY; Y[12] = -INFINITY; Y[13] = -INFINITY; Y[14] = -INFINITY; Y[15] = -INFINITY;
#undef CAND
    bitonic_sort16(X); bitonic_sort16(Y);
    merge_top16(T, R1); merge_top16(T, X); merge_top16(T, Y);
    asm volatile("s_waitcnt lgkmcnt(0)" ::: "memory");
    float ssum = 0.f, e[16]; int eid[16];
    const float t0 = __uint_as_float(__float_as_uint(T[0]) & 0xFFFFFF00u);
#pragma unroll
    for (int r = 0; r < 16; ++r) {
        const unsigned bits = __float_as_uint(T[r]); const unsigned code = bits & 255u;
        e[r] = __expf(__uint_as_float(bits & 0xFFFFFF00u) - t0); ssum += e[r];
        const int ka = ((const LAS unsigned char*)my)[code >> 4], kb_ = ((const LAS unsigned char*)my)[16 + (code & 15u)];
        eid[r] = ka * 128 + kb_;
    }
    const float inv = 1.f / ssum;
    const size_t o = (size_t)(32 * tb + r32) * 128 + hh * 16 + 8 * hi;
    int* ei = (int*)(ws + WS_EIDX) + o; float* eg = (float*)(ws + WS_EGATE) + o;
    typedef int i32x4 __attribute__((ext_vector_type(4)));
    i32x4 w0, w1; f32x4 g0, g1;
    const unsigned mh = 0u - (unsigned)hi;
#define SELU(a, b) ((((unsigned)(b)) & mh) | (((unsigned)(a)) & ~mh))
#pragma unroll
    for (int q = 0; q < 4; ++q) { w0[q] = (int)SELU(eid[q], eid[8 + q]); w1[q] = (int)SELU(eid[4 + q], eid[12 + q]);
        g0[q] = __uint_as_float(SELU(__float_as_uint(e[q]), __float_as_uint(e[8 + q]))) * inv; g1[q] = __uint_as_float(SELU(__float_as_uint(e[4 + q]), __float_as_uint(e[12 + q]))) * inv; }
#undef SELU
    *(i32x4*)ei = w0; *(i32x4*)(ei + 4) = w1; *(f32x4*)eg = g0; *(f32x4*)(eg + 4) = g1;
}

DI void topk_phase(const Params& P, char* lds_g, int bid, int nblk) {
    const int wave = __builtin_amdgcn_readfirstlane(tid_() >> 6);
    LAS char* wlds = (LAS char*)lds_g + wave * 2048;
    const int gw = bid * NWAVES + wave, NGW = nblk * NWAVES;
    for (int it = gw; it < (NTOK / 32) * 8; it += NGW) topk_wave_item(P, it >> 3, it & 7, wlds);
}

DI float gelu_exact(float x) { return 0.5f * x * (1.f + erff(x * 0.70710678118654752f)); }
typedef __bf16 bf16x8_t __attribute__((ext_vector_type(8)));
DI float dot8(u32x4 a, u32x4 x, float acc) {
    const bf16x8_t a8 = __builtin_bit_cast(bf16x8_t, a), x8 = __builtin_bit_cast(bf16x8_t, x);
    acc = __builtin_amdgcn_fdot2_f32_bf16(__builtin_shufflevector(a8, a8, 0, 1), __builtin_shufflevector(x8, x8, 0, 1), acc, false);
    acc = __builtin_amdgcn_fdot2_f32_bf16(__builtin_shufflevector(a8, a8, 2, 3), __builtin_shufflevector(x8, x8, 2, 3), acc, false);
    acc = __builtin_amdgcn_fdot2_f32_bf16(__builtin_shufflevector(a8, a8, 4, 5), __builtin_shufflevector(x8, x8, 4, 5), acc, false);
    acc = __builtin_amdgcn_fdot2_f32_bf16(__builtin_shufflevector(a8, a8, 6, 7), __builtin_shufflevector(x8, x8, 6, 7), acc, false);
    return acc;
}
DI float readlane_f(float v, int l) { return __builtin_bit_cast(float, __builtin_amdgcn_readlane(__builtin_bit_cast(int, v), l)); }
DI float wave_sum_dpp(float v) {
    v = row16_sum(v);
    return (readlane_f(v, 0) + readlane_f(v, 16)) + (readlane_f(v, 32) + readlane_f(v, 48));
}

DI float dot16_fp8(u32x4 w, const f32x2 (&x)[8]) {
    f32x2 acc = __builtin_amdgcn_cvt_pk_f32_fp8((int)w.x, false) * x[0];
    acc = __builtin_amdgcn_cvt_pk_f32_fp8((int)w.x, true) * x[1] + acc;
    acc = __builtin_amdgcn_cvt_pk_f32_fp8((int)w.y, false) * x[2] + acc;
    acc = __builtin_amdgcn_cvt_pk_f32_fp8((int)w.y, true) * x[3] + acc;
    acc = __builtin_amdgcn_cvt_pk_f32_fp8((int)w.z, false) * x[4] + acc;
    acc = __builtin_amdgcn_cvt_pk_f32_fp8((int)w.z, true) * x[5] + acc;
    acc = __builtin_amdgcn_cvt_pk_f32_fp8((int)w.w, false) * x[6] + acc;
    acc = __builtin_amdgcn_cvt_pk_f32_fp8((int)w.w, true) * x[7] + acc;
    return acc.x + acc.y;
}
DI void peer_hid_phase(const Params& P, int bid, int nblk) {
    const int tid = tid_(), lane = tid & 63, wave = __builtin_amdgcn_readfirstlane(tid >> 6);
    const unsigned char* ws = P.ws;
    const unsigned char* U8 = ws + WS_UB; const float* USC = (const float*)(ws + WS_USC);
    const int gw = bid * NWAVES + wave, NGW = nblk * NWAVES;
    f32x4 wv[4];
#pragma unroll
    for (int q = 0; q < 4; ++q) wv[q] = *(const f32x4*)(P.ffn_norm_w + 16 * lane + 4 * q);
    for (int n = gw; n < NTOK; n += NGW) {
        const float* hrow = P.out + (size_t)n * DM + 16 * lane;
        f32x4 h[4]; float ss = 0.f;
#pragma unroll
        for (int q = 0; q < 4; ++q) { h[q] = *(const f32x4*)(hrow + 4 * q); ss += (h[q].x * h[q].x + h[q].y * h[q].y) + (h[q].z * h[q].z + h[q].w * h[q].w); }
        ss = wave_sum_dpp(ss);
        const float r2 = 1.f / sqrtf(ss * (1.f / DM) + EPS);
        f32x2 x[8];
#pragma unroll
        for (int q = 0; q < 4; ++q) { const f32x4 t = h[q] * wv[q] * r2; x[2 * q] = (f32x2){t.x, t.y}; x[2 * q + 1] = (f32x2){t.z, t.w}; }
        const int* eidx = (const int*)(ws + WS_EIDX) + (size_t)n * 128;
        const float* egate = (const float*)(ws + WS_EGATE) + (size_t)n * 128;
        const int id0 = eidx[lane], id1 = eidx[64 + lane];
        float hid0 = 0.f, hid1 = 0.f;
#pragma unroll 1
        for (int k0 = 0; k0 < 128; k0 += 16) {
            u32x4 ra[16]; float sc[16];
#pragma unroll
            for (int e = 0; e < 16; ++e) {
                const int k = k0 + e;
                const int id = (k0 < 64) ? __builtin_amdgcn_readlane(id0, k & 63) : __builtin_amdgcn_readlane(id1, k & 63);
                ra[e] = *(const u32x4*)(U8 + (size_t)id * DM + 16 * lane); sc[e] = USC[id];
            }
#pragma unroll
            for (int e = 0; e < 16; ++e) {
                const int k = k0 + e;
                const float d = wave_sum_dpp(dot16_fp8(ra[e], x)) * sc[e];
                if (k0 < 64) { if (lane == (k & 63)) hid0 = d; } else { if (lane == (k & 63)) hid1 = d; }
            }
        }
        float* hid = (float*)(ws + WS_HID) + (size_t)n * 128;
        hid[lane] = gelu_exact(hid0) * egate[lane];
        hid[64 + lane] = gelu_exact(hid1) * egate[64 + lane];
    }
}

DI void peer_out_phase(const Params& P, int bid, int nblk) {
    const int tid = tid_(), lane = tid & 63, wave = __builtin_amdgcn_readfirstlane(tid >> 6);
    const unsigned char* ws = P.ws;
    const unsigned char* V8 = ws + WS_VB; const float* VSC = (const float*)(ws + WS_VSC);
    const int gw = bid * NWAVES + wave, NGW = nblk * NWAVES;
    f32x4 wv[4];
#pragma unroll
    for (int q = 0; q < 4; ++q) wv[q] = *(const f32x4*)(P.final_w + 16 * lane + 4 * q);
    for (int n = gw; n < NTOK; n += NGW) {
        const int* eidx = (const int*)(ws + WS_EIDX) + (size_t)n * 128;
        const float* hid = (const float*)(ws + WS_HID) + (size_t)n * 128;
        const int id0 = eidx[lane], id1 = eidx[64 + lane];
        const float c0 = hid[lane], c1 = hid[64 + lane];
        f32x2 acc[8];
#pragma unroll
        for (int i = 0; i < 8; ++i) acc[i] = (f32x2){0.f, 0.f};
#pragma unroll 1
        for (int k0 = 0; k0 < 128; k0 += 16) {
            u32x4 ra[16]; float cf[16];
#pragma unroll
            for (int e = 0; e < 16; ++e) {
                const int k = k0 + e;
                const int id = (k0 < 64) ? __builtin_amdgcn_readlane(id0, k & 63) : __builtin_amdgcn_readlane(id1, k & 63);
                cf[e] = ((k0 < 64) ? readlane_f(c0, k & 63) : readlane_f(c1, k & 63)) * VSC[id];
                ra[e] = *(const u32x4*)(V8 + (size_t)id * DM + 16 * lane);
            }
#pragma unroll
            for (int e = 0; e < 16; ++e) {
                const f32x2 c = (f32x2){cf[e], cf[e]}; const u32x4 w = ra[e];
                acc[0] = __builtin_amdgcn_cvt_pk_f32_fp8((int)w.x, false) * c + acc[0]; acc[1] = __builtin_amdgcn_cvt_pk_f32_fp8((int)w.x, true) * c + acc[1];
                acc[2] = __builtin_amdgcn_cvt_pk_f32_fp8((int)w.y, false) * c + acc[2]; acc[3] = __builtin_amdgcn_cvt_pk_f32_fp8((int)w.y, true) * c + acc[3];
                acc[4] = __builtin_amdgcn_cvt_pk_f32_fp8((int)w.z, false) * c + acc[4]; acc[5] = __builtin_amdgcn_cvt_pk_f32_fp8((int)w.z, true) * c + acc[5];
                acc[6] = __builtin_amdgcn_cvt_pk_f32_fp8((int)w.w, false) * c + acc[6]; acc[7] = __builtin_amdgcn_cvt_pk_f32_fp8((int)w.w, true) * c + acc[7];
            }
        }
        float* orow = P.out + (size_t)n * DM + 16 * lane;
        f32x4 h[4]; float ss = 0.f;
#pragma unroll
        for (int q = 0; q < 4; ++q) { h[q] = *(const f32x4*)(orow + 4 * q) + (f32x4){acc[2 * q].x, acc[2 * q].y, acc[2 * q + 1].x, acc[2 * q + 1].y}; ss += (h[q].x * h[q].x + h[q].y * h[q].y) + (h[q].z * h[q].z + h[q].w * h[q].w); }
        ss = wave_sum_dpp(ss);
        const float rs = 1.f / sqrtf(ss * (1.f / DM) + EPS);
#pragma unroll
        for (int q = 0; q < 4; ++q) *(f32x4*)(orow + 4 * q) = h[q] * wv[q] * rs;
    }
}

#ifdef DBG_CHECK
DI void dbg_max(float* slot, float v) { atomicMax((unsigned*)slot, __float_as_uint(fmaxf(v, 0.f))); }
DI void dbg_check_topk(const Params& P, char* lds_g, int bid, int nblk) {
    LAS char* lds = (LAS char*)lds_g;
    const int tid = tid_(), lane = tid & 63, wave = __builtin_amdgcn_readfirstlane(tid >> 6);
    const unsigned char* ws = P.ws; float* dbg = (float*)(ws + WS_CTL) + 64;
    LAS float* sc = (LAS float*)(lds) + wave * 1024;
    const int gw = bid * NWAVES + wave;
    const int token = (gw * 37) % NTOK, hh = gw & 7;
    for (int p = 0; p < 2; ++p) for (int kk = 0; kk < 2; ++kk) {
        const int key = lane + 64 * kk; float a = 0.f;
        const bf16_t* q = (const bf16_t*)(ws + WS_PQ) + (size_t)token * 2048 + hh * 256 + p * 128;
        const bf16_t* sk = (const bf16_t*)(ws + WS_SKB) + (size_t)((hh * 2 + p) * 128 + key) * 128;
        for (int c = 0; c < 128; ++c) a += bf2f(q[c]) * bf2f(sk[c]);
        sc[p * 128 + key] = a;
    }
    asm volatile("s_waitcnt lgkmcnt(0)" ::: "memory");
    for (int p = 0; p < 2; ++p) for (int kk = 0; kk < 2; ++kk) {
        const int key = lane + 64 * kk; const float v = sc[p * 128 + key]; int rank = 0;
        for (int o = 0; o < 128; ++o) { const float w = sc[p * 128 + o]; rank += (w > v || (w == v && o < key)) ? 1 : 0; }
        if (rank < 16) { sc[256 + p * 16 + rank] = v; sc[288 + p * 16 + rank] = __int_as_float(key); }
    }
    asm volatile("s_waitcnt lgkmcnt(0)" ::: "memory");
    for (int e = 0; e < 4; ++e) {
        const int c = lane * 4 + e, i = c >> 4, j = c & 15; const float v = sc[256 + i] + sc[272 + j]; int rank = 0;
        for (int o = 0; o < 256; ++o) { const float w = sc[256 + (o >> 4)] + sc[272 + (o & 15)]; rank += (w > v || (w == v && o < c)) ? 1 : 0; }
        if (rank < 16) { sc[320 + rank] = __int_as_float(__float_as_int(sc[288 + i]) * 128 + __float_as_int(sc[304 + j])); sc[336 + rank] = v; }
    }
    asm volatile("s_waitcnt lgkmcnt(0)" ::: "memory");
    if (lane < 16) {
        const int eid = __float_as_int(sc[320 + lane]); const float sv = sc[336 + lane];
        float mx = sc[336], sum = 0.f; for (int o = 0; o < 16; ++o) sum += __expf(sc[336 + o] - mx);
        const float gate = __expf(sv - mx) / sum;
        const int* eidx = (const int*)(ws + WS_EIDX) + (size_t)token * 128 + hh * 16; const float* eg = (const float*)(ws + WS_EGATE) + (size_t)token * 128 + hh * 16;
        int found = -1; for (int o = 0; o < 16; ++o) if (eidx[o] == eid) found = o;
        if (found < 0) atomicAdd(dbg + 0, 1.f); else dbg_max(dbg + 1, fabsf(eg[found] - gate));
    }
    if (lane == 0) atomicAdd(dbg + 2, 16.f);
}
DI void dbg_check_hid(const Params& P, int bid, int nblk) {
    const int tid = tid_(), lane = tid & 63, wave = __builtin_amdgcn_readfirstlane(tid >> 6);
    const unsigned char* ws = P.ws; float* dbg = (float*)(ws + WS_CTL) + 64;
    const int gw = bid * NWAVES + wave; const int token = (gw * 53) % NTOK;
    const float* hrow = P.out + (size_t)token * DM;
    float ss = 0.f; for (int c = lane; c < DM; c += 64) ss += hrow[c] * hrow[c];
    ss = wave_sum(ss); const float r2 = 1.f / sqrtf(ss / DM + EPS);
    for (int kk = 0; kk < 2; ++kk) {
        const int k = lane + 64 * kk; const int eid = ((const int*)(ws + WS_EIDX))[(size_t)token * 128 + k];
        const float* urow = P.pu + (size_t)eid * DM; float d = 0.f;
        for (int c = 0; c < DM; ++c) d += urow[c] * (hrow[c] * r2 * P.ffn_norm_w[c]);
        const float hidv = gelu_exact(d) * ((const float*)(ws + WS_EGATE))[(size_t)token * 128 + k];
        const float got = ((const float*)(ws + WS_HID))[(size_t)token * 128 + k];
        dbg_max(dbg + 3, fabsf(got - hidv)); dbg_max(dbg + 4, fabsf(hidv));
    }
}
DI float dbg_enc(float m) { return 8.f + log10f(fmaxf(m, 1e-8f)); }
#endif

#ifdef DBG_CHECK
DI void dbg_check_attn(const Params& P, int bid, int nblk) {
    const int tid = tid_(), lane = tid & 63, wave = __builtin_amdgcn_readfirstlane(tid >> 6);
    const unsigned char* ws = P.ws; float* dbg = (float*)(ws + WS_CTL) + 64;
    const int gw = bid * NWAVES + wave;
    const unsigned hsh = (unsigned)gw * 2654435761u;
    const int b = (hsh >> 8) & 7, h = (hsh >> 11) & 3, i = (int)((hsh >> 13) % 4096u), bh = b * 4 + h;
    const float lam = ((const float*)(ws + WS_LB))[512];
    float oc[2][2], lsum[2], mx[2];
    for (int c = 0; c < 2; ++c) { oc[c][0] = oc[c][1] = 0.f; lsum[c] = 0.f; mx[c] = -1e30f; }
    for (int pp = KPAD; pp <= 64 + i; ++pp) {
        const int tile = pp >> 6, key = pp & 63;
        for (int c = 0; c < 2; ++c) {
            const bf16_t* q = (const bf16_t*)(ws + WS_Q) + ((size_t)((bh * 2 + c) * SEQ + i)) * 64;
            const unsigned char* kimg = ws + WS_K + ((size_t)(bh * 2 + c) * KT + tile) * 8192;
            float sdot = 0.f;
            for (int d = 0; d < 64; ++d) sdot += bf2f(q[d]) * bf2f(*(const bf16_t*)(kimg + (d >> 3) * 1024 + key * 16 + (d & 7) * 2));
            const float mn = fmaxf(mx[c], sdot), al = exp2f(mx[c] - mn), pe = exp2f(sdot - mn);
            const unsigned char* vimg = ws + WS_V + ((size_t)bh * KT + tile) * 16384;
            for (int e = 0; e < 2; ++e) { const int dv = lane + 64 * e; oc[c][e] = oc[c][e] * al + pe * bf2f(*(const bf16_t*)(vimg + (dv >> 5) * 4096 + key * 64 + (dv & 31) * 2)); }
            lsum[c] = lsum[c] * al + pe; mx[c] = mn;
        }
    }
    float o[2], ss = 0.f;
    for (int e = 0; e < 2; ++e) { o[e] = oc[0][e] / lsum[0] - lam * oc[1][e] / lsum[1]; ss += o[e] * o[e]; }
    ss = wave_sum(ss); const float rs = (1.f - LAM_INIT) / sqrtf(ss / 128.f + EPS);
    for (int e = 0; e < 2; ++e) { const int dv = lane + 64 * e; const float want = o[e] * rs * P.subln_w[dv];
        const float got = bf2f(((const bf16_t*)(ws + WS_MIX))[(size_t)(b * SEQ + i) * DM + h * 128 + dv]);
        dbg_max(dbg + 5, fabsf(got - want)); dbg_max(dbg + 6, fabsf(want)); }
}
DI void dbg_check_hgrn(const Params& P, char* lds_g, int bid, int nblk) {
    if (bid >= 32) return;
    LAS float* L = (LAS float*)lds_g;
    const int tid = tid_(), dv = tid & 127, qt = tid >> 7;
    const unsigned char* ws = P.ws; float* dbg = (float*)(ws + WS_CTL) + 64;
    const int bh = bid, b = bid >> 2, h = bid & 3;
    const float* HG = (const float*)(ws + WS_HG) + (size_t)bh * HT * 128;
    const bf16_t* HQ = (const bf16_t*)(ws + WS_HQ) + (size_t)bh * HT * 128;
    const bf16_t* HV = (const bf16_t*)(ws + WS_HV) + (size_t)bh * HT * 128;
    float S[32];
#pragma unroll
    for (int j = 0; j < 32; ++j) S[j] = 0.f;
    for (int pp = 16; pp < HT; ++pp) {
        if (tid < 128) { L[tid] = __expf(HG[(size_t)pp * 128 + tid]); L[128 + tid] = bf2f(HQ[(size_t)pp * 128 + tid]); L[256 + tid] = bf2f(HV[(size_t)pp * 128 + tid]); }
        __syncthreads();
        const float v = L[256 + dv]; float part = 0.f;
#pragma unroll
        for (int j = 0; j < 32; ++j) { const float f = L[32 * qt + j]; S[j] = f * S[j] + (1.f - f) * v; part += L[128 + 32 * qt + j] * S[j]; }
        L[384 + qt * 128 + dv] = part;
        __syncthreads();
        if (tid < 128) { const float o = L[384 + dv] + L[512 + dv] + L[640 + dv] + L[768 + dv]; L[896 + dv] = o; }
        __syncthreads();
        if (tid < 128 && pp >= 32) {
            float ss = 0.f; for (int j = 0; j < 128; ++j) ss += L[896 + j] * L[896 + j];
            const float rs = 1.f / sqrtf(ss / 128.f + EPS);
            const size_t row = (size_t)b * SEQ + (pp - 32);
            const float want = L[896 + dv] * rs * P.rec_norm_w[h * 128 + dv] * bf2f(((const bf16_t*)(ws + WS_SG))[row * 512 + h * 128 + dv]);
            const float got = bf2f(((const bf16_t*)(ws + WS_MIX))[row * DM + 512 + h * 128 + dv]);
            dbg_max(dbg + 7, fabsf(got - want)); dbg_max(dbg + 8, fabsf(want));
        }
        __syncthreads();
    }
}
#endif

#ifdef DBG_CHECK
DI float dbg_proj(const Params& P, int m, int c) {
    const float* xrow = (m < NTOK) ? P.x + (size_t)m * DM : P.meta + (size_t)(m - NTOK) * DM;
    float ss = 0.f, a = 0.f;
    for (int k = 0; k < DM; ++k) { const float xv = xrow[k]; ss += xv * xv; a += xv * P.mix_norm_w[k] * P.w_in[(size_t)k * NCOL1 + c]; }
    return a / sqrtf(ss / DM + EPS);
}
DI void dbg_check_gemm1(const Params& P, int bid, int nblk) {
    const unsigned char* ws = P.ws; float* dbg = (float*)(ws + WS_CTL) + 64;
    const int gt = bid * NTHREADS + tid_();
    if (gt >= 7 * 4096) return;
    const unsigned hsh = (unsigned)gt * 2654435761u;
    const int seg = gt % 7, cs = (hsh >> 7) & 511;
    const bool meta = ((gt / 7) & 15) == 0;
    const int m = meta ? NTOK + ((hsh >> 20) & 15) : (int)((hsh >> 3) % (unsigned)NTOK);
    const int b = meta ? (int)((hsh >> 25) & 7) : (m >> 12), t = meta ? (m - NTOK) : ((m & 4095) + NMETA);
    const int h = cs >> 7;
    float want = 0.f, got = 0.f;
    if (seg <= 1) {
        if (seg == 0 && meta) return;
        const int comp = (cs >> 6) & 1, d = cs & 63, dlo = d & 31;
        const float zlo = dbg_proj(P, m, seg * 512 + (cs & ~63) + dlo), zhi = dbg_proj(P, m, seg * 512 + (cs & ~63) + dlo + 32);
        const double inv = exp2(-(double)dlo * (13.287712379549449 / 32.0)); const float cv = (float)cos((double)t * inv), sv = (float)sin((double)t * inv);
        want = (d < 32) ? zlo * cv - zhi * sv : zhi * cv + zlo * sv;
        if (seg == 0) { want *= QSCALE; got = bf2f(((const bf16_t*)(ws + WS_Q))[((size_t)(((b * 4 + h) * 2 + comp) * SEQ + (m & 4095))) * 64 + d]); }
        else { const int pp = t + KPAD; got = bf2f(*(const bf16_t*)(ws + WS_K + ((size_t)((b * 4 + h) * 2 + comp) * KT + (pp >> 6)) * 8192 + (d >> 3) * 1024 + (pp & 63) * 16 + (d & 7) * 2)); }
    } else {
        const float z = dbg_proj(P, m, seg * 512 + cs); const int dv = cs & 127;
        if (seg == 2) { const int pp = t + KPAD; want = z; got = bf2f(*(const bf16_t*)(ws + WS_V + ((size_t)(b * 4 + h) * KT + (pp >> 6)) * 16384 + (dv >> 5) * 4096 + (pp & 63) * 64 + (dv & 31) * 2)); }
        else if (seg == 3) { want = siluf_(z); got = bf2f(((const bf16_t*)(ws + WS_HQ))[((size_t)(b * 4 + h) * HT + t + 16) * 128 + dv]); }
        else if (seg == 4) { const float l0 = P.lb_logits[cs], l1 = P.lb_logits[512 + cs], lb = __expf(l0) / (__expf(l0) + __expf(l1)); want = __logf(lb + (1.f - lb) * sigmoidf_(z)); got = ((const float*)(ws + WS_HG))[((size_t)(b * 4 + h) * HT + t + 16) * 128 + dv]; }
        else if (seg == 5) { want = z; got = bf2f(((const bf16_t*)(ws + WS_HV))[((size_t)(b * 4 + h) * HT + t + 16) * 128 + dv]); }
        else { if (meta) return; want = siluf_(z); got = bf2f(((const bf16_t*)(ws + WS_SG))[(size_t)m * 512 + cs]); }
    }
    dbg_max(dbg + 16 + seg + (meta ? 8 : 0), fabsf(got - want));
}
#endif
typedef unsigned u32x4v __attribute__((vector_size(16)));
DI float oct_sum(float v) {
    v += dpp_f<0xB1>(v); v += dpp_f<0x4E>(v); v += dpp_f<0x141>(v); return v;
}
DI unsigned my_xcc_id() { return (unsigned)__builtin_amdgcn_s_getreg((3 << 11) | 20) & 7u; }
constexpr int CTL_G1 = 16, CTL_G2 = 32;

DI void xn8_rows(const Params& P, int bid, int nblk) {
    const int tid = tid_(), lane = tid & 63, wave = __builtin_amdgcn_readfirstlane(tid >> 6);
    unsigned char* ws = P.ws;
    const int gw = bid * NWAVES + wave, NGW = nblk * NWAVES;
    f32x4 wv[4];
#pragma unroll
    for (int q = 0; q < 4; ++q) wv[q] = *(const f32x4*)(P.ffn_norm_w + 16 * lane + 4 * q);
    for (int n = gw; n < NTOK; n += NGW) {
        const float* hrow = P.out + (size_t)n * DM + 16 * lane;
        const float r2 = 1.f / sqrtf(((const float*)(ws + WS_SSQ))[n] * (1.f / DM) + EPS);
        f32x4 t[4]; float am = 0.f;
#pragma unroll
        for (int q = 0; q < 4; ++q) { t[q] = *(const f32x4*)(hrow + 4 * q) * wv[q] * r2; am = fmaxf(am, fmaxf(fmaxf(fabsf(t[q].x), fabsf(t[q].y)), fmaxf(fabsf(t[q].z), fabsf(t[q].w)))); }
        am = row16_max(am); am = fmaxf(fmaxf(readlane_f(am, 0), readlane_f(am, 16)), fmaxf(readlane_f(am, 32), readlane_f(am, 48)));
        const float sc = (am > 0.f) ? exp2f(floorf(log2f(224.f / am))) : 1.f;
        int w[4];
#pragma unroll
        for (int q = 0; q < 4; ++q) { w[q] = __builtin_amdgcn_cvt_pk_fp8_f32(t[q].x * sc, t[q].y * sc, 0, false); w[q] = __builtin_amdgcn_cvt_pk_fp8_f32(t[q].z * sc, t[q].w * sc, w[q], true); }
        *(u32x4*)(ws + WS_XN8 + (size_t)n * DM + 16 * lane) = (u32x4){(unsigned)w[0], (unsigned)w[1], (unsigned)w[2], (unsigned)w[3]};
        if (lane == 0) ((float*)(ws + WS_XSC))[n] = 1.f / sc;
    }
}
typedef int i32x4 __attribute__((ext_vector_type(4)));
struct GMeta { i32x4 id[4]; f32x4 c[4]; u32x4 xq; };
template <int WHICH>
DI void g_meta(const Params& P, int n, int x, GMeta& M) {
    const int lane = tid_() & 63, i = lane & 7, g = lane >> 3;
    const i32x4* ip = (const i32x4*)((const int*)(P.ws + WS_EIDX) + (size_t)n * 128 + 16 * g);
#pragma unroll
    for (int q = 0; q < 4; ++q) M.id[q] = ip[q];
    if (WHICH == 1) M.xq = *(const u32x4*)(P.ws + WS_XN8 + (size_t)n * DM + 128 * x + 16 * i);
    else { const f32x4* cp = (const f32x4*)((const float*)(P.ws + WS_HID) + (size_t)n * 128 + 16 * g);
#pragma unroll
        for (int q = 0; q < 4; ++q) M.c[q] = cp[q]; }
}
DI void g_issue(int x, const GMeta& M, u32x4v (&rw)[16], __amdgpu_buffer_rsrc_t rs) {
    const int i = tid_() & 7;
    const unsigned lo = (unsigned)x * (unsigned)(NEXP * 128) + (unsigned)(16 * i);
#pragma unroll
    for (int j = 0; j < 16; ++j) rw[j] = __builtin_amdgcn_raw_buffer_load_b128(rs, ((unsigned)M.id[j >> 2][j & 3] << 7) + lo, 0, 0);
}
DI void g1_finish(const Params& P, int n, int x, u32x4 xq, const u32x4v (&rw)[16]) {
    const int lane = tid_() & 63, i = lane & 7, g = lane >> 3;
    f32x2 xv[8];
    xv[0] = __builtin_amdgcn_cvt_pk_f32_fp8((int)xq.x, false); xv[1] = __builtin_amdgcn_cvt_pk_f32_fp8((int)xq.x, true);
    xv[2] = __builtin_amdgcn_cvt_pk_f32_fp8((int)xq.y, false); xv[3] = __builtin_amdgcn_cvt_pk_f32_fp8((int)xq.y, true);
    xv[4] = __builtin_amdgcn_cvt_pk_f32_fp8((int)xq.z, false); xv[5] = __builtin_amdgcn_cvt_pk_f32_fp8((int)xq.z, true);
    xv[6] = __builtin_amdgcn_cvt_pk_f32_fp8((int)xq.w, false); xv[7] = __builtin_amdgcn_cvt_pk_f32_fp8((int)xq.w, true);
    float pd[16];
#pragma unroll
    for (int j = 0; j < 16; ++j) pd[j] = dot16_fp8(__builtin_bit_cast(u32x4, rw[j]), xv);
    const unsigned m1 = 0u - (unsigned)((i >> 2) & 1), m2 = 0u - (unsigned)(i & 1), m3 = 0u - (unsigned)((i >> 1) & 1);
#define BSEL(a, b, m) __uint_as_float((__float_as_uint(a) & ~(m)) | (__float_as_uint(b) & (m)))
    float z[8], w[4], u[2];
#pragma unroll
    for (int q = 0; q < 8; ++q) { const float snd = BSEL(pd[q + 8], pd[q], m1), kep = BSEL(pd[q], pd[q + 8], m1); z[q] = kep + dpp_f<0x141>(snd); }
#pragma unroll
    for (int q = 0; q < 4; ++q) { const float snd = BSEL(z[q + 4], z[q], m2), kep = BSEL(z[q], z[q + 4], m2); w[q] = kep + dpp_f<0xB1>(snd); }
#pragma unroll
    for (int q = 0; q < 2; ++q) { const float snd = BSEL(w[q + 2], w[q], m3), kep = BSEL(w[q], w[q + 2], m3); u[q] = kep + dpp_f<0x4E>(snd); }
    const int j0 = 8 * ((i >> 2) & 1) + 4 * (i & 1) + 2 * ((i >> 1) & 1);
#undef BSEL
    *(f32x2*)((float*)(P.ws + WS_HIDP) + ((size_t)x * NTOK + n) * 128 + 16 * g + j0) = (f32x2){u[0], u[1]};
}
DI void g2_finish(const Params& P, int n, int x, const f32x4 (&cv)[4], const u32x4v (&rw)[16]) {
    const int lane = tid_() & 63, i = lane & 7, g = lane >> 3;
    f32x2 acc[8];
#pragma unroll
    for (int q = 0; q < 8; ++q) acc[q] = (f32x2){0.f, 0.f};
#pragma unroll
    for (int j = 0; j < 16; ++j) {
        const float cj = cv[j >> 2][j & 3]; const f32x2 c = (f32x2){cj, cj}; const u32x4 w = __builtin_bit_cast(u32x4, rw[j]);
        acc[0] = __builtin_amdgcn_cvt_pk_f32_fp8((int)w.x, false) * c + acc[0]; acc[1] = __builtin_amdgcn_cvt_pk_f32_fp8((int)w.x, true) * c + acc[1];
        acc[2] = __builtin_amdgcn_cvt_pk_f32_fp8((int)w.y, false) * c + acc[2]; acc[3] = __builtin_amdgcn_cvt_pk_f32_fp8((int)w.y, true) * c + acc[3];
        acc[4] = __builtin_amdgcn_cvt_pk_f32_fp8((int)w.z, false) * c + acc[4]; acc[5] = __builtin_amdgcn_cvt_pk_f32_fp8((int)w.z, true) * c + acc[5];
        acc[6] = __builtin_amdgcn_cvt_pk_f32_fp8((int)w.w, false) * c + acc[6]; acc[7] = __builtin_amdgcn_cvt_pk_f32_fp8((int)w.w, true) * c + acc[7];
    }
    float y[16], z[8], w[4];
#pragma unroll
    for (int q = 0; q < 8; ++q) { y[2 * q] = acc[q].x; y[2 * q + 1] = acc[q].y; }
#pragma unroll
    for (int q = 0; q < 8; ++q) { auto rr = __builtin_amdgcn_permlane32_swap(__float_as_uint(y[q]), __float_as_uint(y[q + 8]), false, false); z[q] = __uint_as_float(rr[0]) + __uint_as_float(rr[1]); }
#pragma unroll
    for (int q = 0; q < 4; ++q) { auto rr = __builtin_amdgcn_permlane16_swap(__float_as_uint(z[q]), __float_as_uint(z[q + 4]), false, false); w[q] = __uint_as_float(rr[0]) + __uint_as_float(rr[1]); }
    const unsigned m3 = 0u - (unsigned)(g & 1);
#define BSEL(a, b, m) __uint_as_float((__float_as_uint(a) & ~(m)) | (__float_as_uint(b) & (m)))
    const float k0 = BSEL(w[0], w[2], m3) + dpp_f<0x128>(BSEL(w[2], w[0], m3)), k1 = BSEL(w[1], w[3], m3) + dpp_f<0x128>(BSEL(w[3], w[1], m3));
#undef BSEL
    float* hp = P.out + (size_t)n * DM + 128 * x + 16 * i + 2 * g;
    const f32x2 t = *(const f32x2*)hp + (f32x2){k0, k1}; *(f32x2*)hp = t;
    const float ss = wave_sum_dpp(t.x * t.x + t.y * t.y);
    if (lane == 0) atomicAdd((float*)(P.ws + WS_SSQ2) + n, ss);
}
constexpr int SL_CHUNK = 128, SL_T = SL_CHUNK / NWAVES;
#define SB() __builtin_amdgcn_sched_barrier(0)
template <int WHICH>
DI void g_chunk(const Params& P, int nbase, int x, __amdgpu_buffer_rsrc_t rs) {
    GMeta MA, MB; u32x4v RA[16], RB[16];
    g_meta<WHICH>(P, nbase, x, MA); SB(); g_meta<WHICH>(P, nbase + 8, x, MB); SB(); g_issue(x, MA, RA, rs); SB();
#pragma unroll
    for (int t = 0; t < SL_T; t += 2) {
        const u32x4 xA = MA.xq; const f32x4 cA[4] = {MA.c[0], MA.c[1], MA.c[2], MA.c[3]};
        if (t + 2 < SL_T) { g_meta<WHICH>(P, nbase + 8 * (t + 2), x, MA); SB(); }
        g_issue(x, MB, RB, rs); SB();
        if (WHICH == 1) g1_finish(P, nbase + 8 * t, x, xA, RA); else g2_finish(P, nbase + 8 * t, x, cA, RA);
        SB();
        const u32x4 xB = MB.xq; const f32x4 cB[4] = {MB.c[0], MB.c[1], MB.c[2], MB.c[3]};
        if (t + 3 < SL_T) { g_meta<WHICH>(P, nbase + 8 * (t + 3), x, MB); SB(); }
        if (t + 2 < SL_T) { g_issue(x, MA, RA, rs); SB(); }
        if (WHICH == 1) g1_finish(P, nbase + 8 * (t + 1), x, xB, RB); else g2_finish(P, nbase + 8 * (t + 1), x, cB, RB);
        SB();
    }
}
template <int WHICH>
DI void sliced_phase(const Params& P, char* lds_g) {
    const int tid = tid_(), wave = __builtin_amdgcn_readfirstlane(tid >> 6);
    unsigned* ctr = (unsigned*)(P.ws + WS_CTL) + (WHICH == 1 ? CTL_G1 : CTL_G2);
    const __amdgpu_buffer_rsrc_t rs = __builtin_amdgcn_make_buffer_rsrc((void*)(P.ws + (WHICH == 1 ? WS_UB : WS_VB)), 0, NEXP * DM, 0x00020000);
    const int x0 = (int)my_xcc_id();
    LAS int* slot = (LAS int*)((LAS char*)lds_g + LDS_ITEM);
    for (int s = 0; s < 8; ++s) {
        const int x = (x0 + s) & 7;
        for (;;) {
            if (tid == 0) *slot = (int)atomicAdd(ctr + x, 1u);
            __syncthreads();
            const int chunk = *slot;
            __syncthreads();
            if (chunk >= NTOK / SL_CHUNK) break;
            g_chunk<WHICH>(P, chunk * SL_CHUNK + wave, x, rs);
        }
    }
}
DI void hid_reduce_phase(const Params& P, int bid, int nblk) {
    const unsigned char* ws = P.ws;
    const size_t gt = (size_t)bid * NTHREADS + tid_(), NGT = (size_t)nblk * NTHREADS;
    const float* hp = (const float*)(ws + WS_HIDP);
    for (size_t o = gt; o < (size_t)NTOK * 128; o += NGT) {
        float a = 0.f;
#pragma unroll
        for (int x = 0; x < 8; ++x) a += hp[(size_t)x * NTOK * 128 + o];
        const int e = ((const int*)(ws + WS_EIDX))[o];
        const float d = a * ((const float*)(ws + WS_USC))[e] * ((const float*)(ws + WS_XSC))[o >> 7];
        ((float*)(ws + WS_HID))[o] = gelu_exact(d) * ((const float*)(ws + WS_EGATE))[o] * ((const float*)(ws + WS_VSC))[e];
    }
}
DI void final_norm_phase(const Params& P, int bid, int nblk) {
    const size_t gt = (size_t)bid * NTHREADS + tid_(), NGT = (size_t)nblk * NTHREADS;
    const float* ssq = (const float*)(P.ws + WS_SSQ2);
    for (size_t o = gt; o < (size_t)NTOK * DM / 4; o += NGT) {
        const size_t n = o >> 8; const int c4 = (int)(o & 255);
        const float rs = 1.f / sqrtf(ssq[n] * (1.f / DM) + EPS);
        f32x4* pp = (f32x4*)P.out + o;
        *pp = *pp * ((const f32x4*)P.final_w)[c4] * rs;
    }
}

#define XB_TMO      128
#define XB_XCNT(j)  (256  + 64 * (j))
#define XB_XSUB(j)  (1280 + 64 * (j))
#define XB_XGEN(j)  (2304 + 64 * (j))
#define XB_TOP      3328
#define XB_TOPGEN   3392
#define XCD_BAR_WORDS 3456
#define XB_SPIN_CAP (1u << 18)

__device__ __forceinline__ unsigned xb_ld(unsigned* p)              { return __hip_atomic_load(p, __ATOMIC_RELAXED, __HIP_MEMORY_SCOPE_AGENT); }
__device__ __forceinline__ unsigned xb_add(unsigned* p, unsigned v) { return __hip_atomic_fetch_add(p, v, __ATOMIC_RELAXED, __HIP_MEMORY_SCOPE_AGENT); }
__device__ __forceinline__ unsigned xb_xcc_id() { return (unsigned)__builtin_amdgcn_s_getreg((3 << 11) | 20) & 0xFu; }
#define XB_SPIN(cond, bar) do { unsigned _sp = 0; while (cond) { __builtin_amdgcn_s_sleep(1); \
    if ((++_sp & 255u) == 0u) { if (xb_ld(&(bar)[XB_TMO])) break; if (_sp > XB_SPIN_CAP) { atomicAdd(&(bar)[XB_TMO], 1u); break; } } } } while (0)

struct XcdBarrier {
    unsigned* bar; unsigned x;
    volatile LAS unsigned* st;
};

__device__ __forceinline__ XcdBarrier xcd_barrier_post(unsigned* bar, volatile LAS unsigned* st) {
    XcdBarrier b; b.bar = bar; b.x = xb_xcc_id(); b.st = st;
    if (threadIdx.x == 0) (void)xb_add(&bar[XB_XCNT(b.x)], 1u);
    return b;
}
__device__ __forceinline__ void xcd_barrier_complete(unsigned* bar, unsigned x, unsigned& nloc, unsigned& nx) {
    const unsigned G = gridDim.x * gridDim.y * gridDim.z;
    unsigned sum, cnt, mine, sp = 0u;
    for (;;) {
        sum = 0u; cnt = 0u; mine = 0u;
#pragma unroll
        for (unsigned j = 0; j < 16; ++j) { const unsigned c = xb_ld(&bar[XB_XCNT(j)]); sum += c; cnt += (c > 0u) ? 1u : 0u; mine = (j == x) ? c : mine; }
        if (sum == G) break;
        __builtin_amdgcn_s_sleep(1);
        if ((++sp & 255u) == 0u) { if (xb_ld(&bar[XB_TMO])) break; if (sp > XB_SPIN_CAP) { atomicAdd(&bar[XB_TMO], 1u); break; } }
    }
    nloc = mine > 0u ? mine : 1u; nx = cnt > 0u ? cnt : 1u;
}

__device__ __forceinline__ void xcd_barrier(const XcdBarrier& b) {
    asm volatile("s_waitcnt vmcnt(0)" ::: "memory");
    __syncthreads();
    if (threadIdx.x == 0) {
        unsigned* bar = b.bar;
        __builtin_amdgcn_s_waitcnt(0);
        unsigned nloc = b.st[0], nx = b.st[1];
        if (nloc == 0u) { xcd_barrier_complete(bar, b.x, nloc, nx); b.st[0] = nloc; b.st[1] = nx; }
        const unsigned old = xb_add(&bar[XB_XSUB(b.x)], 1u);
        const unsigned gen = old / nloc;
        if (old + 1u == (gen + 1u) * nloc) {
            __builtin_amdgcn_fence(__ATOMIC_RELEASE, "agent");
            asm volatile("s_waitcnt vmcnt(0)" ::: "memory");
            const unsigned og = xb_add(&bar[XB_TOP], 1u);
            const unsigned tg = og / nx;
            if (og + 1u == (tg + 1u) * nx) xb_add(&bar[XB_TOPGEN], 1u);
            else XB_SPIN(xb_ld(&bar[XB_TOPGEN]) == tg, bar);
            __builtin_amdgcn_fence(__ATOMIC_ACQUIRE, "agent");
            xb_add(&bar[XB_XGEN(b.x)], 1u);
            asm volatile("s_waitcnt vmcnt(0)" ::: "memory");
        } else {
            XB_SPIN(xb_ld(&bar[XB_XGEN(b.x)]) == gen, bar);
            __builtin_amdgcn_fence(__ATOMIC_ACQUIRE, "agent");
            asm volatile("s_waitcnt vmcnt(0)" ::: "memory");
        }
    }
    __syncthreads();
}

constexpr int CTL_XB_WORD = 2048;
static_assert((CTL_XB_WORD + 3456) * 4 <= (int)CTL_BYTES, "barrier words inside CTL");
constexpr int N_HGRN_ITEMS = BATCH * 4, N_ATT_ITEMS = BATCH * 4 * 32;

DI void mixer_phase(const Params& P, char* lds) {
    unsigned* ctr = (unsigned*)(P.ws + WS_CTL);
    for (;;) {
        if (tid_() == 0) *(LAS int*)((LAS char*)lds + LDS_ITEM) = (int)atomicAdd(ctr, 1u);
        __syncthreads();
        const int item = *(LAS int*)((LAS char*)lds + LDS_ITEM);
        __syncthreads();
        if (item >= N_HGRN_ITEMS + N_ATT_ITEMS) break;
        if (item < N_HGRN_ITEMS) hgrn_unit(P, item >> 2, item & 3, lds);
        else { const int a = item - N_HGRN_ITEMS, j = 31 - (a >> 5), bh = a & 31; attn_unit(P, bh >> 2, bh & 3, j, lds); }
    }
}

__global__ void __launch_bounds__(NTHREADS, 2) fwd_megakernel(Params P) {
    extern __shared__ __attribute__((aligned(16))) char lds[];
    cg::grid_group grid = cg::this_grid();
    const int bid = blockIdx.x, nblk = gridDim.x;
    unsigned char* ws = P.ws;
    volatile LAS unsigned* xst = (volatile LAS unsigned*)((LAS char*)lds + LDS_XB);
    if (threadIdx.x < 4) xst[threadIdx.x] = 0u;
    __syncthreads();
    const XcdBarrier xbar = xcd_barrier_post((unsigned*)(ws + WS_CTL) + CTL_XB_WORD, xst);
    phase0(P, lds, bid, nblk);
    grid.sync();
    { Epi1 e{ws}; gemm_run(lds, (const bf16_t*)(ws + WS_XB), (const bf16_t*)(ws + WS_W1T), M1, NCOL1, DM, e, bid, nblk); }
    xcd_barrier(xbar);
#if defined(DBG_CHECK) && DBG_SEL == 3
    dbg_check_gemm1(P, bid, nblk);
    xcd_barrier(xbar);
    {
        const float* dbg = (const float*)(ws + WS_CTL) + 64;
        float mxe = 0.f; int arg = 0; for (int q = 0; q < 16; ++q) if (dbg[16 + q] > mxe) { mxe = dbg[16 + q]; arg = q; }
        const float c1 = sqrtf(100.f * dbg_enc(mxe)), c2 = 1000.f * (1.f + arg);
        const size_t gt = (size_t)bid * NTHREADS + threadIdx.x, NGT = (size_t)nblk * NTHREADS;
        for (size_t i = gt; i < (size_t)NTOK * DM; i += NGT) P.out[i] = (i == 0) ? c2 : c1;
    }
    return;
#endif
    for (int it = bid; it < 32 * 129; it += nblk) hgrn_prep_item(P, it & 31, it >> 5, lds);
    xcd_barrier(xbar);
    mixer_phase(P, lds);
    xcd_barrier(xbar);
#if defined(DBG_CHECK) && DBG_SEL == 2
    dbg_check_attn(P, bid, nblk);
    dbg_check_hgrn(P, lds, bid, nblk);
    xcd_barrier(xbar);
    {
        const float* dbg = (const float*)(ws + WS_CTL) + 64;
        const float c1 = sqrtf(100.f * dbg_enc(dbg[5] / fmaxf(dbg[6], 1e-20f))), c2 = 1000.f * dbg_enc(dbg[7] / fmaxf(dbg[8], 1e-20f));
        const size_t gt = (size_t)bid * NTHREADS + threadIdx.x, NGT = (size_t)nblk * NTHREADS;
        for (size_t i = gt; i < (size_t)NTOK * DM; i += NGT) P.out[i] = (i == 0) ? c2 : c1;
    }
    return;
#endif
    { Epi3 e{P.x, P.out, (bf16_t*)(ws + WS_XB), (float*)(ws + WS_SSQ)}; gemm_run(lds, (const bf16_t*)(ws + WS_MIX), (const bf16_t*)(ws + WS_W2T), NTOK, DM, DM, e, bid, nblk); }
    xcd_barrier(xbar);
    { Epi4 e{(const float*)(ws + WS_SSQ), (bf16_t*)(ws + WS_PQ)}; gemm_run(lds, (const bf16_t*)(ws + WS_XB), (const bf16_t*)(ws + WS_W3T), NTOK, 2048, DM, e, bid, nblk); }
    xcd_barrier(xbar);
    topk_phase(P, lds, bid, nblk);
    xn8_rows(P, bid, nblk);
    xcd_barrier(xbar);
#ifdef DBG_CHECK
    dbg_check_topk(P, lds, bid, nblk);
#endif
    sliced_phase<1>(P, lds);
    xcd_barrier(xbar);
    hid_reduce_phase(P, bid, nblk);
    xcd_barrier(xbar);
#ifdef DBG_CHECK
    dbg_check_hid(P, bid, nblk);
    xcd_barrier(xbar);
    {
        const float* dbg = (const float*)(ws + WS_CTL) + 64;
        const float mA = DBG_SEL == 0 ? dbg[0] / fmaxf(dbg[2], 1.f) : dbg[3] / fmaxf(dbg[4], 1e-20f);
        const float mB = DBG_SEL == 0 ? dbg[1] : dbg[4];
        const float c1 = sqrtf(100.f * dbg_enc(mA)), c2 = 1000.f * dbg_enc(mB);
        const size_t gt = (size_t)bid * NTHREADS + threadIdx.x, NGT = (size_t)nblk * NTHREADS;
        for (size_t i = gt; i < (size_t)NTOK * DM; i += NGT) P.out[i] = (i == 0) ? c2 : c1;
    }
#else
    sliced_phase<2>(P, lds);
    xcd_barrier(xbar);
    final_norm_phase(P, bid, nblk);
#endif
}

extern "C" void kernel_launch(void* const* d_in, const int* in_sizes, int n_in, void* d_out, int out_size, void* d_ws, size_t ws_size, hipStream_t stream) {
    static int grid = 0;
    if (grid == 0) {
        int dev = 0, cus = 0, per_cu = 0;
        (void)hipGetDevice(&dev);
        (void)hipDeviceGetAttribute(&cus, hipDeviceAttributeMultiprocessorCount, dev);
        (void)hipFuncSetAttribute((const void*)fwd_megakernel, hipFuncAttributeMaxDynamicSharedMemorySize, LDS_BYTES);
        (void)hipOccupancyMaxActiveBlocksPerMultiprocessor(&per_cu, (const void*)fwd_megakernel, NTHREADS, LDS_BYTES);
        if (per_cu < 1) { fprintf(stderr, "kernel_launch: occupancy query says %d blocks per CU\n", per_cu); per_cu = 1; }
        grid = cus * 1;
        if (ws_size < WS_END) { fprintf(stderr, "kernel_launch: workspace too small: %zu < %zu\n", ws_size, (size_t)WS_END); grid = -1; }
    }
    if (grid < 0) return;
    (void)hipMemsetAsync((char*)d_ws + WS_CTL, 0, CTL_BYTES, stream);
    Params p{};
    p.x = (const float*)d_in[0]; p.meta = (const float*)d_in[1]; p.mix_norm_w = (const float*)d_in[2]; p.w_in = (const float*)d_in[3];
    p.lb_logits = (const float*)d_in[4]; p.rec_norm_w = (const float*)d_in[5]; p.lq1 = (const float*)d_in[6]; p.lk1 = (const float*)d_in[7];
    p.lq2 = (const float*)d_in[8]; p.lk2 = (const float*)d_in[9]; p.subln_w = (const float*)d_in[10]; p.w_out = (const float*)d_in[11];
    p.ffn_norm_w = (const float*)d_in[12]; p.wq = (const float*)d_in[13]; p.subkeys = (const float*)d_in[14]; p.pu = (const float*)d_in[15];
    p.pv = (const float*)d_in[16]; p.final_w = (const float*)d_in[17];
    p.out = (float*)d_out; p.ws = (unsigned char*)d_ws;
    void* args[] = {&p};
    hipError_t e = hipLaunchCooperativeKernel((const void*)fwd_megakernel, dim3(grid), dim3(NTHREADS), args, LDS_BYTES, stream);
    if (e != hipSuccess) fprintf(stderr, "cooperative launch failed: %s (grid %d)\n", hipGetErrorString(e), grid);
}
```

```cpp
#include <hip/hip_runtime.h>
#include <hip/hip_cooperative_groups.h>
#include <cstdio>
#include <cstdint>
#define DBG_SEL 1
namespace cg = cooperative_groups;

constexpr int BATCH = 8, SEQ = 4096, DM = 1024, NMETA = 16;
constexpr int NTOK = BATCH * SEQ;
constexpr int M1 = NTOK + 256;
constexpr int NCOL1 = 3584;
constexpr int TPOS = NMETA + SEQ;
constexpr int KT = 65;
constexpr int KPAD = 48;
constexpr int HT = 4128;
constexpr int NEXP = 16384;
constexpr float EPS = 1e-6f;
constexpr float LAM_INIT = 0.2f;
constexpr float QSCALE = 0.125f * 1.4426950408889634f;
constexpr int NTHREADS = 512, NWAVES = 8;
constexpr int LDS_BYTES = 163840;
constexpr int LDS_ITEM = LDS_BYTES - 64, LDS_XB = LDS_BYTES - 32;

typedef unsigned short bf16_t;
typedef short bf16x8 __attribute__((ext_vector_type(8)));
typedef float f32x4 __attribute__((ext_vector_type(4)));
typedef float f32x16 __attribute__((ext_vector_type(16)));
typedef float f32x2 __attribute__((ext_vector_type(2)));
typedef unsigned u32x4 __attribute__((ext_vector_type(4)));
typedef unsigned u32x2 __attribute__((ext_vector_type(2)));
typedef __bf16 bf16x2_t __attribute__((ext_vector_type(2)));
typedef short s16x4 __attribute__((ext_vector_type(4)));
#define LAS __attribute__((address_space(3)))
#define DI __device__ __forceinline__
__device__ __forceinline__ int tid_() { int t = threadIdx.x; asm volatile("" : "+v"(t)); return t; }

constexpr size_t al256(size_t x) { return (x + 255) & ~(size_t)255; }
constexpr size_t WS_CTL = 0, CTL_BYTES = 65536;
constexpr size_t WS_W1T = WS_CTL + CTL_BYTES;
constexpr size_t WS_W2T = WS_W1T + (size_t)NCOL1 * DM * 2;
constexpr size_t WS_W3T = WS_W2T + (size_t)DM * DM * 2;
constexpr size_t WS_SKB = WS_W3T + (size_t)2048 * DM * 2;
constexpr size_t WS_UB = WS_SKB + (size_t)16 * 128 * 128 * 2;
constexpr size_t WS_VB = WS_UB + (size_t)NEXP * DM * 2;
constexpr size_t WS_USC = WS_UB + (size_t)NEXP * DM, WS_VSC = WS_VB + (size_t)NEXP * DM;
constexpr size_t WS_ROPE = WS_VB + (size_t)NEXP * DM * 2;
constexpr size_t WS_LB = WS_ROPE + (size_t)TPOS * 64 * 4;
constexpr size_t WS_R1 = WS_LB + 4096;
constexpr size_t WS_SSQ = WS_R1 + al256((size_t)M1 * 4);
constexpr size_t WS_SSQ2 = WS_SSQ + (size_t)NTOK * 4;
constexpr size_t WS_XB = WS_SSQ2 + (size_t)NTOK * 4;
constexpr size_t WS_C = WS_XB + (size_t)M1 * DM * 2;
constexpr size_t WS_Q = WS_C;
constexpr size_t WS_K = WS_Q + (size_t)NTOK * 512 * 2;
constexpr size_t WS_V = WS_K + (size_t)BATCH * 4 * 2 * KT * 8192;
constexpr size_t WS_HQ = WS_V + (size_t)BATCH * 4 * KT * 16384;
constexpr size_t WS_HV = WS_HQ + (size_t)BATCH * 4 * HT * 128 * 2;
constexpr size_t WS_HG = WS_HV + (size_t)BATCH * 4 * HT * 128 * 2;
constexpr size_t WS_SG = WS_HG + (size_t)BATCH * 4 * HT * 128 * 4;
constexpr size_t WS_CEND = WS_SG + (size_t)NTOK * 512 * 2;
constexpr size_t WS_PQ = WS_C;
constexpr size_t WS_EIDX = WS_PQ + (size_t)NTOK * 2048 * 2;
constexpr size_t WS_EGATE = WS_EIDX + (size_t)NTOK * 128 * 4;
constexpr size_t WS_HID = WS_EGATE + (size_t)NTOK * 128 * 4;
constexpr size_t WS_XN8 = WS_HID + (size_t)NTOK * 128 * 4;
constexpr size_t WS_XSC = WS_XN8 + (size_t)NTOK * DM;
constexpr size_t WS_C8 = WS_XSC + (size_t)NTOK * 4;
constexpr size_t WS_CSC = WS_C8 + (size_t)NTOK * 128;
static_assert(WS_CSC + (size_t)NTOK * 4 <= WS_CEND, "overlay fits");
constexpr size_t WS_HIDP = WS_PQ;
constexpr size_t WS_MIX = WS_CEND;
constexpr size_t WS_HQA = WS_MIX + (size_t)NTOK * DM * 2;
constexpr size_t WS_HD = WS_HQA + (size_t)BATCH * 4 * HT * 128 * 2;
constexpr size_t WS_END = WS_HD + (size_t)BATCH * 4 * 129 * 128 * 4;
static_assert(WS_END <= (size_t)512 * 1024 * 1024, "workspace map must fit 512 MiB");

struct Params {
    const float* x; const float* meta; const float* mix_norm_w; const float* w_in; const float* lb_logits; const float* rec_norm_w;
    const float* lq1; const float* lk1; const float* lq2; const float* lk2; const float* subln_w; const float* w_out; const float* ffn_norm_w;
    const float* wq; const float* subkeys; const float* pu; const float* pv; const float* final_w;
    float* out; unsigned char* ws;
};

DI unsigned f2bf(float f) { unsigned u = __builtin_bit_cast(unsigned, f); return (u + 0x7fffu + ((u >> 16) & 1u)) >> 16; }
DI float bf2f(unsigned b) { return __builtin_bit_cast(float, b << 16); }
DI unsigned cvtpk(float lo, float hi) { f32x2 v = {lo, hi}; bf16x2_t b = __builtin_convertvector(v, bf16x2_t); return __builtin_bit_cast(unsigned, b); }
DI float wave_sum(float v) {
#pragma unroll
    for (int o = 1; o < 64; o <<= 1) v += __shfl_xor(v, o);
    return v;
}
DI float sigmoidf_(float x) { return 1.f / (1.f + __expf(-x)); }
DI float siluf_(float x) { return x * sigmoidf_(x); }

DI int sigma_col(int c) {
    if (c >= 1024) return c;
    const int cc = c & 63, a = cc >> 5, fq = (cc >> 3) & 3, n = (cc >> 2) & 1, j = cc & 3;
    return (c & ~63) + 4 * (4 * a + fq) + 32 * n + j;
}
template <bool PERMUTE>
DI void p0_transpose_item(const float* W, int K, int N, const float* scale, bf16_t* WT, LAS float* scr, int item, int lane) {
    const int nblk = N / 32, kb = item / nblk, nb = item % nblk, k0 = 64 * kb, n0 = 32 * nb;
    const int ncol = PERMUTE ? sigma_col(n0 + (lane & 31)) : n0 + (lane & 31);
#pragma unroll 8
    for (int i = 0; i < 32; ++i) { const int kk = 2 * i + (lane >> 5); float s = scale ? scale[k0 + kk] : 1.f; scr[kk * 33 + (lane & 31)] = W[(size_t)(k0 + kk) * N + ncol] * s; }
    asm volatile("s_waitcnt lgkmcnt(0)" ::: "memory");
    const int c = lane & 7;
#pragma unroll
    for (int j = 0; j < 4; ++j) { const int n = (lane >> 3) + 8 * j; const LAS float* s = scr + (8 * c) * 33 + n;
        u32x4 o; o.x = cvtpk(s[0 * 33], s[1 * 33]); o.y = cvtpk(s[2 * 33], s[3 * 33]); o.z = cvtpk(s[4 * 33], s[5 * 33]); o.w = cvtpk(s[6 * 33], s[7 * 33]);
        *(u32x4*)(WT + (size_t)(n0 + n) * K + k0 + 8 * c) = o; }
    asm volatile("s_waitcnt lgkmcnt(0)" ::: "memory");
}

DI void table_fp8_rows(const Params& P, int first, int stride) {
    const int lane = tid_() & 63;
    unsigned char* ws = P.ws;
    for (int r = first; r < 2 * NEXP; r += stride) {
        const bool isv = r >= NEXP; const int e = isv ? r - NEXP : r;
        const f32x4* src = (const f32x4*)((isv ? P.pv : P.pu) + (size_t)e * DM) + lane;
        f32x4 v[4]; float am = 0.f;
#pragma unroll
        for (int q = 0; q < 4; ++q) { v[q] = src[64 * q]; am = fmaxf(am, fmaxf(fmaxf(fabsf(v[q].x), fabsf(v[q].y)), fmaxf(fabsf(v[q].z), fabsf(v[q].w)))); }
#pragma unroll
        for (int o = 1; o < 64; o <<= 1) am = fmaxf(am, __shfl_xor(am, o));
        const float sc = (am > 0.f) ? exp2f(floorf(log2f(224.f / am))) : 1.f;
        unsigned char* dst = ws + (isv ? WS_VB : WS_UB) + (size_t)e * 128;
#pragma unroll
        for (int q = 0; q < 4; ++q) {
            int w = __builtin_amdgcn_cvt_pk_fp8_f32(v[q].x * sc, v[q].y * sc, 0, false); w = __builtin_amdgcn_cvt_pk_fp8_f32(v[q].z * sc, v[q].w * sc, w, true);
            const int col = 256 * q + 4 * lane;
            *(unsigned*)(dst + (size_t)(col >> 7) * ((size_t)NEXP * 128) + (col & 127)) = (unsigned)w;
        }
        if (lane == 0) ((float*)(ws + (isv ? WS_VSC : WS_USC)))[e] = 1.f / sc;
    }
}

DI void phase0(const Params& P, char* lds, int bid, int nblk) {
    const int tid = tid_(), lane = tid & 63, wave = __builtin_amdgcn_readfirstlane(tid >> 6);
    unsigned char* ws = P.ws;
    LAS float* scr = (LAS float*)(lds) + wave * (64 * 33);
    const int gw = bid * NWAVES + wave, NGW = nblk * NWAVES;
    constexpr int I1 = (DM / 64) * (NCOL1 / 32), I2 = (DM / 64) * (DM / 32), I3 = (DM / 64) * (2048 / 32);
    for (int it = gw; it < I1 + I2 + I3; it += NGW) {
        int r = it;
        if (r < I1) { p0_transpose_item<true>(P.w_in, DM, NCOL1, P.mix_norm_w, (bf16_t*)(ws + WS_W1T), scr, r, lane); continue; } r -= I1;
        if (r < I2) { p0_transpose_item<false>(P.w_out, DM, DM, nullptr, (bf16_t*)(ws + WS_W2T), scr, r, lane); continue; } r -= I2;
        p0_transpose_item<false>(P.wq, DM, 2048, P.ffn_norm_w, (bf16_t*)(ws + WS_W3T), scr, r, lane);
    }
    for (int m = gw; m < M1; m += NGW) {
        bf16_t* orow = (bf16_t*)(ws + WS_XB) + (size_t)m * DM;
        float* r1 = (float*)(ws + WS_R1);
        unsigned long long* o8 = (unsigned long long*)orow + lane;
        if (m >= NTOK + NMETA) { for (int j = 0; j < 4; ++j) o8[64 * j] = 0ull; if (lane == 0) r1[m] = 0.f; continue; }
        const float* xrow = (m < NTOK) ? P.x + (size_t)m * DM : P.meta + (size_t)(m - NTOK) * DM;
        const f32x4* xr = (const f32x4*)xrow + lane;
        f32x4 v[4]; float s = 0.f;
#pragma unroll
        for (int j = 0; j < 4; ++j) { v[j] = xr[64 * j]; s += (v[j].x * v[j].x + v[j].y * v[j].y) + (v[j].z * v[j].z + v[j].w * v[j].w); }
        s = wave_sum(s);
        if (lane == 0) r1[m] = 1.f / sqrtf(s * (1.f / DM) + EPS);
#pragma unroll
        for (int j = 0; j < 4; ++j) o8[64 * j] = (unsigned long long)cvtpk(v[j].x, v[j].y) | ((unsigned long long)cvtpk(v[j].z, v[j].w) << 32);
    }
    {
        const size_t gt = (size_t)bid * NTHREADS + tid, NGT = (size_t)nblk * NTHREADS;
        const size_t ns = (size_t)16 * 128 * 128 / 8;
        for (size_t e = gt; e < ns; e += NGT) {
            const f32x4 a = ((const f32x4*)P.subkeys)[2 * e], b = ((const f32x4*)P.subkeys)[2 * e + 1];
            u32x4 o; o.x = cvtpk(a.x, a.y); o.y = cvtpk(a.z, a.w); o.z = cvtpk(b.x, b.y); o.w = cvtpk(b.z, b.w);
            ((u32x4*)(ws + WS_SKB))[e] = o;
        }
        float* rope = (float*)(ws + WS_ROPE);
        for (size_t i = gt; i < (size_t)TPOS * 32; i += NGT) {
            const int t = (int)(i >> 5), f = (int)(i & 31);
            const double inv = exp2(-(double)f * (13.287712379549449 / 32.0));
            const double ang = (double)t * inv;
            rope[(size_t)t * 64 + f] = (float)cos(ang); rope[(size_t)t * 64 + 32 + f] = (float)sin(ang);
        }
        float* ssq = (float*)(ws + WS_SSQ);
        for (size_t i = gt; i < (size_t)2 * NTOK; i += NGT) ssq[i] = 0.f;
        for (size_t i = gt; i < (size_t)BATCH * 4 * 2 * 512; i += NGT) { const size_t img = i >> 9, o = i & 511; ((u32x4*)(ws + WS_K + img * KT * 8192))[o] = (u32x4){0u, 0u, 0u, 0u}; }
        for (size_t i = gt; i < (size_t)BATCH * 4 * 1024; i += NGT) { const size_t img = i >> 10, o = i & 1023; ((u32x4*)(ws + WS_V + img * KT * 16384))[o] = (u32x4){0u, 0u, 0u, 0u}; }
        for (size_t i = gt; i < (size_t)BATCH * 4 * 16 * 16; i += NGT) { const size_t bh = i >> 8, o = i & 255;
            ((u32x4*)(ws + WS_HQ + bh * HT * 256))[o] = (u32x4){0u, 0u, 0u, 0u}; ((u32x4*)(ws + WS_HV + bh * HT * 256))[o] = (u32x4){0u, 0u, 0u, 0u}; }
        for (size_t i = gt; i < (size_t)BATCH * 4 * 16 * 32; i += NGT) { const size_t bh = i >> 9, o = i & 511; ((u32x4*)(ws + WS_HG + bh * HT * 512))[o] = (u32x4){0u, 0u, 0u, 0u}; }
        float* lb = (float*)(ws + WS_LB);
        if (gt < 512) lb[gt] = sigmoidf_(P.lb_logits[gt] - P.lb_logits[512 + gt]);
        if (bid == 0 && wave == 0) {
            const float a = wave_sum(P.lq1[lane] * P.lk1[lane]), b = wave_sum(P.lq2[lane] * P.lk2[lane]);
            if (lane == 0) lb[512] = __expf(a) - __expf(b) + LAM_INIT;
        }
    }
}

namespace pg8 {
#define PG8_LAS __attribute__((address_space(3)))
typedef unsigned short bf16_t;
typedef short bf16x8 __attribute__((ext_vector_type(8)));
typedef float f32x4 __attribute__((ext_vector_type(4)));
typedef unsigned u32x4 __attribute__((ext_vector_type(4)));
constexpr int BM = 256, BK = 64, HALF = 128, HTB = HALF * BK * 2  , STAGE_BYTES = 8 * HTB, NXCD = 8, WGM = 8;

__host__ __device__ __forceinline__ int lds_byte(int r, int c) { const int st = (r >> 4) * 2 + (c >> 5), rr = r & 15, cc = c & 31, ob = rr * 64 + cc * 2; return st * 1024 + (ob ^ (((ob >> 9) & 1) << 5)); }
__host__ __device__ __forceinline__ void stage_rc(int b, int& R, int& C) { const int st = b / 1024, sb = b % 1024, swz = sb ^ (((sb >> 9) & 1) << 5); R = (st >> 1) * 16 + swz / 64; C = (st & 1) * 32 + (swz % 64) / 2; }
__host__ __device__ __forceinline__ int perm32(int rho) { const int n = rho >> 4, i = rho & 15; return 8 * (i >> 2) + 4 * n + (i & 3); }

struct Unit { int pm, pn; };
struct Gemm { const bf16_t* A; const bf16_t* Bt; int M, N, K; };

struct StaticOrder {
    int nM, nN, nwg, G, c;
    __host__ __device__ void init(int M, int N, int G_, int c_) { nM = M / BM; nN = N / BM; nwg = nM * nN; G = G_; c = c_; }
    __host__ __device__ bool next(int i, Unit& u) const {
        const long L = (long)i * G + c; if (L >= nwg) return false;
        int wgid = (int)L; { const int q = nwg / NXCD, r = nwg % NXCD, xcd = wgid % NXCD, off = wgid / NXCD; wgid = (xcd < r ? xcd * (q + 1) : r * (q + 1) + (xcd - r) * q) + off; }
        const int nig = WGM * nN, gid = wgid / nig, fm = gid * WGM, gsz = (nM - fm) < WGM ? (nM - fm) : WGM;
        u.pm = fm + ((wgid % nig) % gsz); u.pn = (wgid % nig) / gsz; return true;
    }
    __device__ __forceinline__ void a_ready(const Unit&) const {}
    __device__ __forceinline__ void done(const Unit&) const {}
};

template <class Epi, class Sched, bool ALIGN_EPI = false, bool SP2 = false>
__device__ __forceinline__ void gemm_phase(PG8_LAS unsigned char* lds, const Gemm g, const Sched& S, const Epi& E) {
    const int tid = tid_(), wid = __builtin_amdgcn_readfirstlane(tid >> 6), lane = tid & 63, wr = wid >> 2, wc = wid & 3, fr = lane & 15, fq = lane >> 4;
    const int K = g.K, nt = K / BK;
    unsigned voffA[2], voffB[2];
#pragma unroll
    for (int i = 0; i < 2; ++i) { int R, C; stage_rc(tid * 16 + i * 8192, R, C); const int Rb = Epi::PERM ? ((R & ~31) + perm32(R & 31)) : R;
        voffA[i] = (unsigned)(R * K + C) * 2u; voffB[i] = (unsigned)(Rb * K + C) * 2u; }
    const size_t kstep = (size_t)(BK * 2);
    const size_t hstep = (size_t)HALF * K * 2;
    const size_t tstep = 2 * hstep;
    const unsigned ldsw = (unsigned)wid * 1024u;
    const int aoff = lds_byte(wr * 64 + fr, fq * 8), boff = lds_byte(wc * 32 + fr, fq * 8);
#define PG8_SA(b, h) (((b) * 2 + (h)) * HTB)
#define PG8_SB(b, h) ((4 + (b) * 2 + (h)) * HTB)
#define PG8_STAGE(bufoff, gbase, voff) do { _Pragma("unroll") for (int _i = 0; _i < 2; ++_i) \
        __builtin_amdgcn_global_load_lds((const unsigned*)((const char*)(gbase) + (voff)[_i]), (PG8_LAS unsigned*)(lds + (bufoff) + ldsw + _i * 8192), 16, 0, 0); } while (0)
#define PG8_LDA(dst, b, h) do { _Pragma("unroll") for (int m = 0; m < 4; ++m) _Pragma("unroll") for (int k = 0; k < 2; ++k) dst[m][k] = *(const PG8_LAS bf16x8*)(lds + PG8_SA(b, h) + aoff + m * 2048 + k * 1024); } while (0)
#define PG8_LDB(dst, b, h) do { _Pragma("unroll") for (int n = 0; n < 2; ++n) _Pragma("unroll") for (int k = 0; k < 2; ++k) dst[n][k] = *(const PG8_LAS bf16x8*)(lds + PG8_SB(b, h) + boff + n * 2048 + k * 1024); } while (0)
#define PG8_MMA(ai, bj, At, Bt) do { __builtin_amdgcn_s_setprio(1); _Pragma("unroll") for (int m = 0; m < 4; ++m) _Pragma("unroll") for (int n = 0; n < 2; ++n) _Pragma("unroll") for (int k = 0; k < 2; ++k) \
        acc[ai][bj][m][n] = __builtin_amdgcn_mfma_f32_16x16x32_bf16(Bt[n][k], At[m][k], acc[ai][bj][m][n], 0, 0, 0); __builtin_amdgcn_s_setprio(0); } while (0)
#define PG8_WAIT_V(n) asm volatile("s_waitcnt vmcnt(" #n ")" ::: "memory")
#define PG8_WAIT_L(n) asm volatile("s_waitcnt lgkmcnt(" #n ")" ::: "memory")
#define PG8_BAR __builtin_amdgcn_s_barrier()
#define PG8_SCHED __builtin_amdgcn_sched_barrier(0)
    Unit cur, nxt; int ui = 0;
    if (!S.next(0, cur)) return;
    f32x4 acc[2][2][4][2];
#pragma unroll
    for (int a = 0; a < 2; ++a)
#pragma unroll
        for (int b = 0; b < 2; ++b)
#pragma unroll
            for (int m = 0; m < 4; ++m)
#pragma unroll
                for (int n = 0; n < 2; ++n) acc[a][b][m][n] = (f32x4){0.f, 0.f, 0.f, 0.f};
    bf16x8 At[4][2], B0[2][2], B1[2][2];
    const char* cA = (const char*)g.A + (size_t)cur.pm * tstep; const char* cB = (const char*)g.Bt + (size_t)cur.pn * tstep;
    S.a_ready(cur);
    if constexpr (SP2) {
        PG8_STAGE(PG8_SB(0, 0), cB, voffB); PG8_STAGE(PG8_SB(0, 1), cB + hstep, voffB); PG8_STAGE(PG8_SA(0, 0), cA, voffA); PG8_STAGE(PG8_SA(0, 1), cA + hstep, voffA);
        if (wr == 1) PG8_BAR;
        PG8_WAIT_V(2); PG8_BAR;
        PG8_STAGE(PG8_SB(1, 0), cB + kstep, voffB); PG8_STAGE(PG8_SA(1, 0), cA + kstep, voffA); PG8_STAGE(PG8_SB(1, 1), cB + hstep + kstep, voffB);
        PG8_WAIT_V(6); PG8_BAR;
    } else {
        PG8_STAGE(PG8_SB(0, 0), cB, voffB); PG8_STAGE(PG8_SA(0, 0), cA, voffA); PG8_STAGE(PG8_SB(0, 1), cB + hstep, voffB); PG8_STAGE(PG8_SA(0, 1), cA + hstep, voffA);
        if (wr == 1) PG8_BAR;
        PG8_WAIT_V(4); PG8_BAR;
        PG8_STAGE(PG8_SB(1, 0), cB + kstep, voffB); PG8_STAGE(PG8_SA(1, 0), cA + kstep, voffA); PG8_STAGE(PG8_SB(1, 1), cB + hstep + kstep, voffB);
        PG8_WAIT_V(6); PG8_BAR;
    }
    for (;;) {
        const bool has_next = S.next(ui + 1, nxt);
        const char* nA = has_next ? (const char*)g.A + (size_t)nxt.pm * tstep : cA; const char* nB = has_next ? (const char*)g.Bt + (size_t)nxt.pn * tstep : cB;
        for (int t = 0; t < nt; t += 2) {
            const bool last = (t == nt - 2);
            const char* a1 = cA + (size_t)(t + 1) * kstep;
            const char* a2 = last ? nA : cA + (size_t)(t + 2) * kstep; const char* b2 = last ? nB : cB + (size_t)(t + 2) * kstep;
            const char* a3 = a2 + kstep; const char* b3 = b2 + kstep;
            if (last && has_next) S.a_ready(nxt);
            if constexpr (SP2) {
            PG8_LDB(B0, 0, 0); PG8_LDB(B1, 0, 1); PG8_SCHED; PG8_LDA(At, 0, 0); PG8_STAGE(PG8_SA(1, 1), a1 + hstep, voffA);
            PG8_WAIT_V(8); PG8_WAIT_L(0); PG8_BAR; PG8_MMA(0, 0, At, B0); PG8_MMA(0, 1, At, B1); PG8_BAR; PG8_SCHED;
            PG8_LDA(At, 0, 1); PG8_STAGE(PG8_SB(0, 0), b2, voffB); PG8_STAGE(PG8_SB(0, 1), b2 + hstep, voffB); PG8_STAGE(PG8_SA(0, 0), a2, voffA);
            PG8_WAIT_V(8); PG8_WAIT_L(0); PG8_BAR; PG8_MMA(1, 0, At, B0); PG8_MMA(1, 1, At, B1); PG8_BAR; PG8_SCHED;
            PG8_LDB(B0, 1, 0); PG8_LDB(B1, 1, 1); PG8_SCHED; PG8_LDA(At, 1, 0); PG8_STAGE(PG8_SA(0, 1), a2 + hstep, voffA);
            PG8_WAIT_V(8); PG8_WAIT_L(0); PG8_BAR; PG8_MMA(0, 0, At, B0); PG8_MMA(0, 1, At, B1); PG8_BAR; PG8_SCHED;
            PG8_LDA(At, 1, 1); PG8_STAGE(PG8_SB(1, 0), b3, voffB); PG8_STAGE(PG8_SB(1, 1), b3 + hstep, voffB); PG8_STAGE(PG8_SA(1, 0), a3, voffA);
            PG8_WAIT_V(8); PG8_WAIT_L(0); PG8_BAR; PG8_MMA(1, 0, At, B0); PG8_MMA(1, 1, At, B1); PG8_BAR; PG8_SCHED;
            } else {
            PG8_LDB(B0, 0, 0); PG8_SCHED; PG8_LDA(At, 0, 0); PG8_STAGE(PG8_SA(1, 1), a1 + hstep, voffA);
            PG8_WAIT_L(8); PG8_BAR; PG8_WAIT_L(0); PG8_MMA(0, 0, At, B0); PG8_BAR; PG8_SCHED;
            PG8_LDB(B1, 0, 1); PG8_STAGE(PG8_SB(0, 0), b2, voffB);
            PG8_BAR; PG8_WAIT_L(0); PG8_MMA(0, 1, At, B1); PG8_BAR;
            PG8_LDA(At, 0, 1); PG8_STAGE(PG8_SA(0, 0), a2, voffA);
            PG8_BAR; PG8_WAIT_L(0); PG8_MMA(1, 0, At, B0); PG8_BAR; PG8_SCHED;
            PG8_STAGE(PG8_SB(0, 1), b2 + hstep, voffB);
            PG8_WAIT_V(6); PG8_BAR; PG8_MMA(1, 1, At, B1); PG8_BAR;
            PG8_LDB(B0, 1, 0); PG8_SCHED; PG8_LDA(At, 1, 0); PG8_STAGE(PG8_SA(0, 1), a2 + hstep, voffA);
            PG8_WAIT_L(8); PG8_BAR; PG8_WAIT_L(0); PG8_MMA(0, 0, At, B0); PG8_BAR; PG8_SCHED;
            PG8_LDB(B1, 1, 1); PG8_STAGE(PG8_SB(1, 0), b3, voffB);
            PG8_BAR; PG8_WAIT_L(0); PG8_MMA(0, 1, At, B1); PG8_BAR;
            PG8_LDA(At, 1, 1); PG8_STAGE(PG8_SA(1, 0), a3, voffA);
            PG8_BAR; PG8_WAIT_L(0); PG8_MMA(1, 0, At, B0); PG8_BAR; PG8_SCHED;
            PG8_STAGE(PG8_SB(1, 1), b3 + hstep, voffB);
            PG8_WAIT_V(6); PG8_BAR; PG8_MMA(1, 1, At, B1); PG8_BAR;
            }
        }
        if constexpr (ALIGN_EPI) { if (wr == 0) PG8_BAR; }
        if constexpr (!Epi::AFTER_DRAIN) { E(acc, cur, wr, wc, fr, fq); S.done(cur); }
        if (!has_next) break;
#pragma unroll
        for (int a = 0; a < 2; ++a)
#pragma unroll
            for (int b = 0; b < 2; ++b)
#pragma unroll
                for (int m = 0; m < 4; ++m)
#pragma unroll
                    for (int n = 0; n < 2; ++n) acc[a][b][m][n] = (f32x4){0.f, 0.f, 0.f, 0.f};
        cur = nxt; cA = nA; cB = nB; ++ui;
        if constexpr (ALIGN_EPI) { if (wr == 1) PG8_BAR; }
    }
    PG8_WAIT_V(0);
    if constexpr (!ALIGN_EPI) { if (wr == 0) PG8_BAR; }
    PG8_BAR;
    if constexpr (Epi::AFTER_DRAIN) { E.fused(acc, cur, wr, wc, fr, fq, lds, wid, lane); S.done(cur); }
#undef PG8_SA
#undef PG8_SB
#undef PG8_STAGE
#undef PG8_LDA
#undef PG8_LDB
#undef PG8_MMA
#undef PG8_WAIT_V
#undef PG8_WAIT_L
#undef PG8_BAR
#undef PG8_SCHED
}
}

DI u32x2 pack4(f32x4 v) { u32x2 r; r.x = cvtpk(v.x, v.y); r.y = cvtpk(v.z, v.w); return r; }
DI u32x4 pack8(f32x4 a, f32x4 b) { u32x4 r; r.x = cvtpk(a.x, a.y); r.y = cvtpk(a.z, a.w); r.z = cvtpk(b.x, b.y); r.w = cvtpk(b.z, b.w); return r; }

struct Epi1 {
    static constexpr bool PERM = true, AFTER_DRAIN = false;
    unsigned char* ws;
    DI void operator()(const f32x4 (&acc)[2][2][4][2], const pg8::Unit& u, int wr, int wc, int fr, int fq) const {
        const float* r1p = (const float*)(ws + WS_R1);
        const float* rope = (const float*)(ws + WS_ROPE);
        const float* lbp = (const float*)(ws + WS_LB);
        const int seg = u.pn >> 1;
#pragma unroll
        for (int ai = 0; ai < 2; ++ai)
#pragma unroll
            for (int m = 0; m < 4; ++m) {
                const int row = u.pm * 256 + ai * 128 + wr * 64 + m * 16 + fr;
                const bool meta = row >= NTOK;
                if (row >= NTOK + NMETA) continue;
                const float r1 = r1p[row];
                const int b = meta ? 0 : (row >> 12), t = meta ? (row - NTOK) : ((row & 4095) + NMETA);
                const int nrep = meta ? BATCH : 1;
#pragma unroll
                for (int bj = 0; bj < 2; ++bj) {
                    const int cs = (u.pn & 1) * 256 + bj * 128 + wc * 32 + 8 * fq;
                    const f32x4 v0 = acc[ai][bj][m][0] * r1, v1 = acc[ai][bj][m][1] * r1;
                    const int h = cs >> 7;
                    if (seg <= 1) {
                        const int comp = (cs >> 6) & 1, cc = cs & 63, i0 = 16 * (cc >> 5) + 4 * fq;
                        const f32x4 c4 = *(const f32x4*)(rope + (size_t)t * 64 + i0), s4 = *(const f32x4*)(rope + (size_t)t * 64 + 32 + i0);
                        f32x4 lo = v0 * c4 - v1 * s4, hi = v1 * c4 + v0 * s4;
                        if (seg == 0) {
                            if (meta) continue;
                            lo = lo * QSCALE; hi = hi * QSCALE;
                            bf16_t* qp = (bf16_t*)(ws + WS_Q) + ((size_t)(((b * 4 + h) * 2 + comp) * SEQ + (row & 4095))) * 64;
                            *(u32x2*)(qp + i0) = pack4(lo); *(u32x2*)(qp + i0 + 32) = pack4(hi);
                        } else {
                            const int pp = t + KPAD, tile = pp >> 6, key = pp & 63;
                            for (int bb = 0; bb < nrep; ++bb) {
                                const int b_ = meta ? bb : b;
                                unsigned char* img = ws + WS_K + ((size_t)((b_ * 4 + h) * 2 + comp) * KT + tile) * 8192;
                                *(u32x2*)(img + (i0 >> 3) * 1024 + key * 16 + (i0 & 7) * 2) = pack4(lo);
                                *(u32x2*)(img + ((i0 >> 3) + 4) * 1024 + key * 16 + (i0 & 7) * 2) = pack4(hi);
                            }
                        }
                    } else if (seg == 2) {
                        const int dv = cs & 127, pp = t + KPAD, tile = pp >> 6, key = pp & 63;
                        const u32x4 w = pack8(v0, v1);
                        for (int bb = 0; bb < nrep; ++bb) {
                            const int b_ = meta ? bb : b;
                            unsigned char* img = ws + WS_V + ((size_t)(b_ * 4 + h) * KT + tile) * 16384;
                            *(u32x4*)(img + (dv >> 5) * 4096 + key * 64 + (dv & 31) * 2) = w;
                        }
                    } else if (seg == 3 || seg == 5) {
                        const int dv = cs & 127;
                        f32x4 a = v0, c = v1;
                        if (seg == 3) { a.x = siluf_(a.x); a.y = siluf_(a.y); a.z = siluf_(a.z); a.w = siluf_(a.w); c.x = siluf_(c.x); c.y = siluf_(c.y); c.z = siluf_(c.z); c.w = siluf_(c.w); }
                        const u32x4 w = pack8(a, c);
                        const size_t base = (seg == 3) ? WS_HQ : WS_HV;
                        for (int bb = 0; bb < nrep; ++bb) {
                            const int b_ = meta ? bb : b;
                            *(u32x4*)((bf16_t*)(ws + base) + ((size_t)(b_ * 4 + h) * HT + t + 16) * 128 + dv) = w;
                        }
                    } else if (seg == 4) {
                        const int dv = cs & 127;
                        const f32x4 l0 = *(const f32x4*)(lbp + cs), l1 = *(const f32x4*)(lbp + cs + 4);
                        f32x4 g0, g1;
#pragma unroll
                        for (int e = 0; e < 4; ++e) { g0[e] = __logf(l0[e] + (1.f - l0[e]) * sigmoidf_(v0[e])); g1[e] = __logf(l1[e] + (1.f - l1[e]) * sigmoidf_(v1[e])); }
                        for (int bb = 0; bb < nrep; ++bb) {
                            const int b_ = meta ? bb : b;
                            float* gp = (float*)(ws + WS_HG) + ((size_t)(b_ * 4 + h) * HT + t + 16) * 128 + dv;
                            *(f32x4*)gp = g0; *(f32x4*)(gp + 4) = g1;
                        }
                    } else {
                        if (meta) continue;
                        f32x4 a = v0, c = v1;
                        a.x = siluf_(a.x); a.y = siluf_(a.y); a.z = siluf_(a.z); a.w = siluf_(a.w); c.x = siluf_(c.x); c.y = siluf_(c.y); c.z = siluf_(c.z); c.w = siluf_(c.w);
                        *(u32x4*)((bf16_t*)(ws + WS_SG) + (size_t)row * 512 + cs) = pack8(a, c);
                    }
                }
            }
    }
};

struct Epi3 {
    static constexpr bool PERM = true, AFTER_DRAIN = false;
    const float* x; float* H; bf16_t* HB; float* ssq;
    DI void operator()(const f32x4 (&acc)[2][2][4][2], const pg8::Unit& u, int wr, int wc, int fr, int fq) const {
#pragma unroll
        for (int ai = 0; ai < 2; ++ai)
#pragma unroll
            for (int m = 0; m < 4; ++m) {
                const int row = u.pm * 256 + ai * 128 + wr * 64 + m * 16 + fr;
                float s = 0.f;
#pragma unroll
                for (int bj = 0; bj < 2; ++bj) {
                    const int col = u.pn * 256 + bj * 128 + wc * 32 + 8 * fq;
                    const size_t o = (size_t)row * DM + col;
                    const u32x4 xb = *(const u32x4*)(HB + o);
                    const f32x4 x0 = (f32x4){bf2f(xb.x & 0xffffu), bf2f(xb.x >> 16), bf2f(xb.y & 0xffffu), bf2f(xb.y >> 16)}, x1 = (f32x4){bf2f(xb.z & 0xffffu), bf2f(xb.z >> 16), bf2f(xb.w & 0xffffu), bf2f(xb.w >> 16)};
                    const f32x4 h0 = x0 + acc[ai][bj][m][0], h1 = x1 + acc[ai][bj][m][1];
                    *(u32x4*)(HB + o) = pack8(h0, h1);
                    s += (h0.x * h0.x + h0.y * h0.y) + (h0.z * h0.z + h0.w * h0.w) + (h1.x * h1.x + h1.y * h1.y) + (h1.z * h1.z + h1.w * h1.w);
                }
                s += __shfl_xor(s, 16); s += __shfl_xor(s, 32);
                if (fq == 0) atomicAdd(ssq + row, s);
            }
    }
};

struct Epi4 {
    static constexpr bool PERM = true, AFTER_DRAIN = false;
    const float* ssq; bf16_t* PQ;
    DI void operator()(const f32x4 (&acc)[2][2][4][2], const pg8::Unit& u, int wr, int wc, int fr, int fq) const {
#pragma unroll
        for (int ai = 0; ai < 2; ++ai)
#pragma unroll
            for (int m = 0; m < 4; ++m) {
                const int row = u.pm * 256 + ai * 128 + wr * 64 + m * 16 + fr;
                const float r2 = 1.f / sqrtf(ssq[row] * (1.f / DM) + EPS);
#pragma unroll
                for (int bj = 0; bj < 2; ++bj) {
                    const int col = u.pn * 256 + bj * 128 + wc * 32 + 8 * fq;
                    *(u32x4*)(PQ + (size_t)row * 2048 + col) = pack8(acc[ai][bj][m][0] * r2, acc[ai][bj][m][1] * r2);
                }
            }
    }
};

template <class Epi>
DI void gemm_run(char* lds, const bf16_t* A, const bf16_t* Bt, int M, int N, int K, const Epi& E, int bid, int nblk) {
    pg8::Gemm g{A, Bt, M, N, K}; pg8::StaticOrder S; S.init(M, N, nblk, bid);
    pg8::gemm_phase<Epi, pg8::StaticOrder, true, true>((LAS unsigned char*)lds, g, S, E);
}
#define MFMA32(a, b, c) __builtin_amdgcn_mfma_f32_32x32x16_bf16(a, b, c, 0, 0, 0)
typedef short v4i16_t __attribute__((ext_vector_type(4)));
DI int crow(int r, int hi) { return (r & 3) + 8 * (r >> 2) + 4 * hi; }
DI s16x4 vtr(const LAS char* p) { return __builtin_bit_cast(s16x4, __builtin_amdgcn_ds_read_tr16_b64_v4i16((LAS v4i16_t*)p)); }
DI void glds16(const void* g, LAS char* l) { __builtin_amdgcn_global_load_lds((const unsigned*)g, (LAS unsigned*)l, 16, 0, 0); }
DI float swap_max(float m) { auto rr = __builtin_amdgcn_permlane32_swap(__float_as_uint(m), __float_as_uint(m), false, false); return fmaxf(__uint_as_float(rr[0]), __uint_as_float(rr[1])); }
DI float swap_sum(float m) { auto rr = __builtin_amdgcn_permlane32_swap(__float_as_uint(m), __float_as_uint(m), false, false); return __uint_as_float(rr[0]) + __uint_as_float(rr[1]); }
constexpr int ATT_BUF = 32768, ATT_WSF = 65536;
constexpr float ATT_THR = 8.f;

DI void attn_unit(const Params& P, int b, int h, int j, char* lds_g) {
    LAS char* lds = (LAS char*)lds_g;
    const int tid = tid_(), lane = tid & 63, r32 = lane & 31, hi = lane >> 5;
    const int wid = __builtin_amdgcn_readfirstlane(tid >> 6), comp = wid >> 2, wq = wid & 3;
    const unsigned char* ws = P.ws;
    const int bh = b * 4 + h;
    const bf16_t* Qw = (const bf16_t*)(ws + WS_Q) + ((size_t)((bh * 2 + comp) * SEQ + 128 * j + 32 * wq)) * 64;
    bf16x8 qr[4];
#pragma unroll
    for (int d0 = 0; d0 < 4; ++d0) qr[d0] = *(const bf16x8*)(Qw + r32 * 64 + d0 * 16 + hi * 8);
    const unsigned char* kimg0 = ws + WS_K + (size_t)(bh * 2) * KT * 8192 + wid * 1024 + lane * 16;
    const unsigned char* kimg1 = kimg0 + (size_t)KT * 8192;
    const unsigned char* vimg = ws + WS_V + (size_t)bh * KT * 16384 + wid * 1024 + lane * 16;
    const int NT = 2 * j + 3, my_last = (wq < 2) ? 2 * j + 1 : 2 * j + 2;
    LAS float* wsf = (LAS float*)(lds + ATT_WSF) + wid * 64;
#define ATT_ISSUE(t, s) do { LAS char* d_ = lds + (s) * ATT_BUF + wid * 1024; \
        glds16(kimg0 + (size_t)(t) * 8192, d_); glds16(kimg1 + (size_t)(t) * 8192, d_ + 8192); \
        glds16(vimg + (size_t)(t) * 16384, d_ + 16384); glds16(vimg + (size_t)(t) * 16384 + 8192, d_ + 24576); } while (0)
    f32x16 o[4];
#pragma unroll
    for (int nb = 0; nb < 4; ++nb) o[nb] = f32x16{};
    float mref = 0.f, lsum = 0.f;
    const int qpos = 64 + 128 * j + 32 * wq + r32;
    ATT_ISSUE(0, 0);
    __syncthreads();
    for (int t = 0; t < NT; ++t) {
        const int s = t & 1;
        if (t + 1 < NT) ATT_ISSUE(t + 1, s ^ 1);
        if (t <= my_last) {
            const LAS char* kp = lds + s * ATT_BUF + comp * 8192 + hi * 1024 + r32 * 16;
            f32x16 s0 = f32x16{}, s1 = f32x16{};
#pragma unroll
            for (int d0 = 0; d0 < 4; ++d0) {
                const bf16x8 k0 = *(const LAS bf16x8*)(kp + d0 * 2048), k1 = *(const LAS bf16x8*)(kp + d0 * 2048 + 512);
                s0 = MFMA32(k0, qr[d0], s0); s1 = MFMA32(k1, qr[d0], s1);
            }
            if (t == 0) {
#pragma unroll
                for (int r = 0; r < 16; ++r) { s0[r] = -INFINITY; if (32 + crow(r, hi) < KPAD) s1[r] = -INFINITY; }
            }
            if (t >= 2 * j + 1) {
                const int kb = 64 * t + 4 * hi;
#pragma unroll
                for (int r = 0; r < 16; ++r) { const int kv = kb + (r & 3) + 8 * (r >> 2); if (kv > qpos) s0[r] = -INFINITY; if (kv + 32 > qpos) s1[r] = -INFINITY; }
            }
            float rm = fmaxf(s0[0], s1[0]);
#pragma unroll
            for (int r = 1; r < 16; ++r) rm = fmaxf(rm, fmaxf(s0[r], s1[r]));
            rm = swap_max(rm);
            if (t == 0) mref = rm;
            else {
                const float grow = rm - mref;
                if (__any(grow > ATT_THR)) {
                    const float dl = fmaxf(grow, 0.f), f = __builtin_amdgcn_exp2f(-dl);
                    mref += dl; lsum *= f;
                    if (hi == 0) wsf[r32] = f;
                    asm volatile("s_waitcnt lgkmcnt(0)" ::: "memory");
#pragma unroll
                    for (int r = 0; r < 16; ++r) { const float fr_ = wsf[crow(r, hi)];
#pragma unroll
                        for (int nb = 0; nb < 4; ++nb) o[nb][r] *= fr_; }
                }
            }
            float ps = 0.f;
#pragma unroll
            for (int r = 0; r < 16; ++r) { s0[r] = __builtin_amdgcn_exp2f(s0[r] - mref); s1[r] = __builtin_amdgcn_exp2f(s1[r] - mref); ps += s0[r] + s1[r]; }
            lsum += ps;
            const LAS char* vp = lds + s * ATT_BUF + 16384 + ((lane >> 4) & 1) * 32 + (lane & 3) * 8 + (4 * hi + ((lane & 15) >> 2)) * 64;
#pragma unroll
            for (int ks = 0; ks < 4; ++ks) {
                u32x4 pw;
                if (ks < 2) { pw.x = cvtpk(s0[8 * ks], s0[8 * ks + 1]); pw.y = cvtpk(s0[8 * ks + 2], s0[8 * ks + 3]); pw.z = cvtpk(s0[8 * ks + 4], s0[8 * ks + 5]); pw.w = cvtpk(s0[8 * ks + 6], s0[8 * ks + 7]); }
                else { const int q_ = ks - 2; pw.x = cvtpk(s1[8 * q_], s1[8 * q_ + 1]); pw.y = cvtpk(s1[8 * q_ + 2], s1[8 * q_ + 3]); pw.z = cvtpk(s1[8 * q_ + 4], s1[8 * q_ + 5]); pw.w = cvtpk(s1[8 * q_ + 6], s1[8 * q_ + 7]); }
                const bf16x8 pa = __builtin_bit_cast(bf16x8, pw);
#pragma unroll
                for (int nb = 0; nb < 4; ++nb) {
                    const s16x4 vlo = vtr(vp + nb * 4096 + ks * 1024), vhi = vtr(vp + nb * 4096 + ks * 1024 + 512);
                    const bf16x8 vb = (bf16x8){vlo[0], vlo[1], vlo[2], vlo[3], vhi[0], vhi[1], vhi[2], vhi[3]};
                    o[nb] = MFMA32(pa, vb, o[nb]);
                }
            }
        }
        __syncthreads();
    }
#undef ATT_ISSUE
    lsum = swap_sum(lsum);
    if (hi == 0) wsf[r32] = lsum;
    asm volatile("s_waitcnt lgkmcnt(0)" ::: "memory");
    float rli[16];
#pragma unroll
    for (int r = 0; r < 16; ++r) rli[r] = 1.f / wsf[crow(r, hi)];
    const float lam = ((const float*)(ws + WS_LB))[512];
    LAS float* ex = (LAS float*)lds + wq * 4096;
    if (comp == 1) {
#pragma unroll
        for (int r = 0; r < 16; ++r)
#pragma unroll
            for (int nb = 0; nb < 4; ++nb) ex[(r * 4 + nb) * 64 + lane] = o[nb][r] * rli[r] * lam;
    }
    __syncthreads();
    if (comp == 0) {
        float ss[16];
#pragma unroll
        for (int r = 0; r < 16; ++r) { float a = 0.f;
#pragma unroll
            for (int nb = 0; nb < 4; ++nb) { const float v = o[nb][r] * rli[r] - ex[(r * 4 + nb) * 64 + lane]; o[nb][r] = v; a += v * v; }
            ss[r] = a; }
#pragma unroll
        for (int r = 0; r < 16; ++r) { float a = ss[r]; a += __shfl_xor(a, 1); a += __shfl_xor(a, 2); a += __shfl_xor(a, 4); a += __shfl_xor(a, 8); a += __shfl_xor(a, 16); ss[r] = (1.f - LAM_INIT) / sqrtf(a * (1.f / 128.f) + EPS); }
        bf16_t* mix = (bf16_t*)(ws + WS_MIX) + ((size_t)(b * SEQ + 128 * j + 32 * wq)) * DM + h * 128;
#pragma unroll
        for (int nb = 0; nb < 4; ++nb) { const float w = P.subln_w[32 * nb + r32];
#pragma unroll
            for (int r = 0; r < 16; ++r) mix[(size_t)crow(r, hi) * DM + 32 * nb + r32] = (bf16_t)f2bf(o[nb][r] * ss[r] * w); }
    }
    __syncthreads();
}
#define MFMA16(a, b, c) __builtin_amdgcn_mfma_f32_16x16x32_bf16(a, b, c, 0, 0, 0)
constexpr int HG_STR = 272;
constexpr int HL_QA = 0, HL_QB = HL_QA + 32 * HG_STR, HL_KB = HL_QB + 32 * HG_STR, HL_KT = HL_KB + 32 * HG_STR, HL_VV = HL_KT + 32 * HG_STR;
constexpr int HL_PS = HL_VV + 32 * HG_STR;
constexpr int HL_D = HL_PS + 4 * 128 * 4;
constexpr int HL_OUT = HL_D + 128 * 4;
constexpr int HL_END = HL_OUT + 32 * 132 * 4;

constexpr int HB_KTF = 0, HB_ATF = 8192, HB_DF = 10240;
DI void hgrn_prep_item(const Params& P, int bh, int c, char* lds_g) {
    LAS char* lds = (LAS char*)lds_g;
    const int tid = tid_(), lane = tid & 63, c16 = lane & 15, g4 = lane >> 4, ch = tid & 127, part = tid >> 7;
    const int wid = __builtin_amdgcn_readfirstlane(tid >> 6);
    const int vrow = tid >> 4, vcol = (tid & 15) * 8;
    unsigned char* ws = P.ws;
    const float* HG = (const float*)(ws + WS_HG) + (size_t)bh * HT * 128;
    const bf16_t* HQ = (const bf16_t*)(ws + WS_HQ) + (size_t)bh * HT * 128;
    const bf16_t* HV = (const bf16_t*)(ws + WS_HV) + (size_t)bh * HT * 128;
    const size_t r0 = (size_t)(32 * c + 8 * part);
    float g8[8], p8[8]; unsigned short q8[8];
    { float a = 0.f;
#pragma unroll
      for (int e = 0; e < 8; ++e) { g8[e] = HG[(r0 + e) * 128 + ch]; q8[e] = HQ[(r0 + e) * 128 + ch]; a += g8[e]; p8[e] = a; } }
    const u32x4 v16 = *(const u32x4*)(HV + ((size_t)(32 * c) + vrow) * 128 + vcol);
    ((LAS float*)(lds + HL_PS))[part * 128 + ch] = p8[7];
    __syncthreads();
    {
        const LAS float* ps = (const LAS float*)(lds + HL_PS);
        const float t0 = ps[ch], t1 = ps[128 + ch], t2 = ps[256 + ch], t3 = ps[384 + ch];
        const float off = (part > 0 ? t0 : 0.f) + (part > 1 ? t1 : 0.f) + (part > 2 ? t2 : 0.f);
        const float mid = t0 + t1, last = mid + t2 + t3;
        const float em = __expf(mid), el = __expf(last - mid);
        if (part == 0) ((LAS float*)(lds + HL_D))[ch] = __expf(last);
#pragma unroll
        for (int e = 0; e < 8; ++e) {
            const int tk = 8 * part + e;
            const float cum = off + p8[e];
            const float e1 = __expf(cum - mid), e2 = 1.f / e1;
            const float q = bf2f(q8[e]), k = 1.f - __expf(g8[e]);
            const float qb = q * e1, qa = qb * em, kb = k * e2, kt = kb * el;
            *(LAS bf16_t*)(lds + HL_QA + tk * HG_STR + ch * 2) = (bf16_t)f2bf(qa);
            *(LAS bf16_t*)(lds + HL_QB + tk * HG_STR + ch * 2) = (bf16_t)f2bf(qb);
            *(LAS bf16_t*)(lds + HL_KB + tk * HG_STR + ch * 2) = (bf16_t)f2bf(kb);
            *(LAS bf16_t*)(lds + HL_KT + tk * HG_STR + ch * 2) = (bf16_t)f2bf(kt);
        }
        *(LAS u32x4*)(lds + HL_VV + vrow * HG_STR + vcol * 2) = v16;
    }
    __syncthreads();
    unsigned char* qaf = ws + WS_HQA + ((size_t)bh * 129 + c) * 8192;
    unsigned char* hgb = ws + WS_HG + (size_t)bh * HT * 512 + (size_t)c * 16384;
    {
        const int ks = wid >> 1, nt = wid & 1;
        const LAS char* qp = lds + HL_QA + (16 * nt + c16) * HG_STR + (32 * ks + 4 * g4) * 2;
        const u32x2 lo = *(const LAS u32x2*)qp, hi2 = *(const LAS u32x2*)(qp + 32);
        *(u32x4*)(qaf + wid * 1024 + lane * 16) = (u32x4){lo.x, lo.y, hi2.x, hi2.y};
        const LAS char* kp = lds + HL_KT + (8 * g4 + (c16 >> 2)) * HG_STR + (16 * wid + 4 * (c16 & 3)) * 2;
        const s16x4 klo = vtr(kp), khi = vtr(kp + 4 * HG_STR);
        *(bf16x8*)(hgb + HB_KTF + wid * 1024 + lane * 16) = (bf16x8){klo[0], klo[1], klo[2], klo[3], khi[0], khi[1], khi[2], khi[3]};
    }
    if (wid == 0) {
        f32x4 at00 = (f32x4){0.f, 0.f, 0.f, 0.f}, at01 = at00, at11 = at00;
#pragma unroll
        for (int ks = 0; ks < 4; ++ks) {
            const bf16x8 ka0 = *(const LAS bf16x8*)(lds + HL_KB + c16 * HG_STR + (32 * ks + 8 * g4) * 2);
            const bf16x8 ka1 = *(const LAS bf16x8*)(lds + HL_KB + (16 + c16) * HG_STR + (32 * ks + 8 * g4) * 2);
            const bf16x8 qn0 = *(const LAS bf16x8*)(lds + HL_QB + c16 * HG_STR + (32 * ks + 8 * g4) * 2);
            const bf16x8 qn1 = *(const LAS bf16x8*)(lds + HL_QB + (16 + c16) * HG_STR + (32 * ks + 8 * g4) * 2);
            at00 = MFMA16(ka0, qn0, at00); at01 = MFMA16(ka0, qn1, at01); at11 = MFMA16(ka1, qn1, at11);
        }
#pragma unroll
        for (int r = 0; r < 4; ++r) { if (4 * g4 + r > c16) { at00[r] = 0.f; at11[r] = 0.f; } }
        u32x4 b0; b0.x = cvtpk(at00[0], at00[1]); b0.y = cvtpk(at00[2], at00[3]); b0.z = 0u; b0.w = 0u;
        u32x4 b1; b1.x = cvtpk(at01[0], at01[1]); b1.y = cvtpk(at01[2], at01[3]); b1.z = cvtpk(at11[0], at11[1]); b1.w = cvtpk(at11[2], at11[3]);
        *(u32x4*)(hgb + HB_ATF + lane * 16) = b0; *(u32x4*)(hgb + HB_ATF + 1024 + lane * 16) = b1;
    } else if (wid == 1 && lane < 32) {
        *(f32x4*)(hgb + HB_DF + lane * 16) = *(const LAS f32x4*)(lds + HL_D + lane * 16);
    }
    __syncthreads();
}

constexpr int RS_QAF = 0, RS_HGB = 8192, RS_V = 19456, RS_SLOT = 27648, RS_NSLOT = 5;
constexpr int RS_OUT = RS_NSLOT * RS_SLOT, RS_OUTB = 32 * 136 * 2, RS_END = RS_OUT + 2 * RS_OUTB;
static_assert(RS_END <= LDS_ITEM, "hgrn LDS map");
DI void glds16_asm(const void* g, unsigned lds_base) {
    unsigned sv; asm volatile("s_mov_b32 %0, m0\n\ts_mov_b32 m0, %2\n\ts_nop 0\n\tglobal_load_lds_dwordx4 %1, off\n\ts_mov_b32 m0, %0" : "=&s"(sv) : "v"(g), "s"(lds_base) : "memory"); }
#define HW_BAR() asm volatile("s_waitcnt lgkmcnt(0)\n\ts_barrier" ::: "memory")
DI void glds16_sb(unsigned voff, const void* sbase, unsigned lds_base) {
    unsigned sv; asm volatile("s_mov_b32 %0, m0\n\ts_mov_b32 m0, %3\n\ts_nop 0\n\tglobal_load_lds_dwordx4 %1, %2\n\ts_mov_b32 m0, %0" : "=&s"(sv) : "v"(voff), "s"(sbase), "s"(lds_base) : "memory"); }
DI void hgrn_unit(const Params& P, int b, int h, char* lds_g) {
    LAS char* lds = (LAS char*)lds_g;
    const int tid = tid_(), lane = tid & 63, c16 = lane & 15, g4 = lane >> 4;
    const int wid = __builtin_amdgcn_readfirstlane(tid >> 6);
    const unsigned char* ws = P.ws;
    const int bh = b * 4 + h;
    const unsigned lbase = (unsigned)__builtin_amdgcn_readfirstlane((int)(unsigned)(size_t)lds);
    constexpr int AHEAD = RS_NSLOT - 1;
    if (wid < 4) {
        const unsigned char* qafg = ws + WS_HQA + (size_t)bh * 129 * 8192;
        const unsigned char* hgbg = ws + WS_HG + (size_t)bh * HT * 512;
        const unsigned char* vg = ws + WS_HV + (size_t)bh * HT * 256;
        const unsigned voff = (unsigned)lane * 16u;
        auto issue = [&](int c) {
            const unsigned sb = lbase + (unsigned)((c % RS_NSLOT) * RS_SLOT);
#pragma unroll
            for (int k = 0; k < 7; ++k) {
                const int p = wid + 4 * k;
                if (p < 19) { const unsigned char* src = (p < 8) ? qafg + (size_t)c * 8192 + p * 1024 : hgbg + (size_t)c * 16384 + (p - 8) * 1024; glds16_sb(voff, src, sb + (unsigned)p * 1024u); }
                else if (p < 27) { const int r4 = 4 * (p - 19);
                    const unsigned vo = (unsigned)(lane >> 4) * 256u + (unsigned)(((lane & 15) ^ ((((r4 & 7) + (lane >> 4)) & 7) << 1)) * 16);
                    glds16_sb(vo, vg + ((size_t)(32 * c) + r4) * 256, sb + (unsigned)p * 1024u); }
            }
        };
        f32x4 S[2][8];
#pragma unroll
        for (int t = 0; t < 2; ++t)
#pragma unroll
            for (int i = 0; i < 8; ++i) S[t][i] = (f32x4){0.f, 0.f, 0.f, 0.f};
#pragma unroll
        for (int c = 0; c < AHEAD; ++c) issue(c);
        for (int c = 0; c < 129; ++c) {
            if (c + AHEAD - 1 > 128) asm volatile("s_waitcnt vmcnt(0)" ::: "memory");
            else if (wid < 3) asm volatile("s_waitcnt vmcnt(21)" ::: "memory"); else asm volatile("s_waitcnt vmcnt(18)" ::: "memory");
            HW_BAR();
            __builtin_amdgcn_sched_barrier(0);
            if (c + AHEAD < 129) issue(c + AHEAD);
            __builtin_amdgcn_sched_barrier(0);
            const LAS char* sl = lds + (c % RS_NSLOT) * RS_SLOT;
            f32x4 oacc[2][2];
#pragma unroll
            for (int t = 0; t < 2; ++t) { oacc[t][0] = (f32x4){0.f, 0.f, 0.f, 0.f}; oacc[t][1] = oacc[t][0]; }
#pragma unroll
            for (int ks = 0; ks < 4; ++ks) {
                const bf16x8 q0 = *(const LAS bf16x8*)(sl + RS_QAF + (2 * ks) * 1024 + lane * 16), q1 = *(const LAS bf16x8*)(sl + RS_QAF + (2 * ks + 1) * 1024 + lane * 16);
#pragma unroll
                for (int t = 0; t < 2; ++t) {
                    u32x4 sp; sp.x = cvtpk(S[t][2 * ks][0], S[t][2 * ks][1]); sp.y = cvtpk(S[t][2 * ks][2], S[t][2 * ks][3]); sp.z = cvtpk(S[t][2 * ks + 1][0], S[t][2 * ks + 1][1]); sp.w = cvtpk(S[t][2 * ks + 1][2], S[t][2 * ks + 1][3]);
                    const bf16x8 sf = __builtin_bit_cast(bf16x8, sp);
                    oacc[t][0] = MFMA16(sf, q0, oacc[t][0]); oacc[t][1] = MFMA16(sf, q1, oacc[t][1]);
                }
            }
            const int vq = c16 >> 2, vp4 = c16 & 3;
#define VTR(row, w_) vtr(sl + RS_V + (row) * 256 + (((2 * (w_) + (vp4 >> 1)) ^ ((((row) & 7)) << 1)) * 16) + 8 * (vp4 & 1))
            {
                const bf16x8 a0 = *(const LAS bf16x8*)(sl + RS_HGB + HB_ATF + lane * 16), a1 = *(const LAS bf16x8*)(sl + RS_HGB + HB_ATF + 1024 + lane * 16);
#pragma unroll
                for (int t = 0; t < 2; ++t) {
                    const s16x4 lo = VTR(4 * g4 + vq, 2 * wid + t), hi2 = VTR(16 + 4 * g4 + vq, 2 * wid + t);
                    const bf16x8 va = (bf16x8){lo[0], lo[1], lo[2], lo[3], hi2[0], hi2[1], hi2[2], hi2[3]};
                    oacc[t][0] = MFMA16(va, a0, oacc[t][0]); oacc[t][1] = MFMA16(va, a1, oacc[t][1]);
                }
            }
            {
                LAS char* ob = lds + RS_OUT + (c & 1) * RS_OUTB;
#pragma unroll
                for (int t = 0; t < 2; ++t)
#pragma unroll
                    for (int nt = 0; nt < 2; ++nt) { u32x2 w; w.x = cvtpk(oacc[t][nt][0], oacc[t][nt][1]); w.y = cvtpk(oacc[t][nt][2], oacc[t][nt][3]);
                        *(LAS u32x2*)(ob + ((16 * nt + c16) * 136 + 16 * (2 * wid + t) + 4 * g4) * 2) = w; }
            }
            {
                bf16x8 vb[2];
#pragma unroll
                for (int t = 0; t < 2; ++t) { const s16x4 lo = VTR(8 * g4 + vq, 2 * wid + t), hi2 = VTR(8 * g4 + 4 + vq, 2 * wid + t); vb[t] = (bf16x8){lo[0], lo[1], lo[2], lo[3], hi2[0], hi2[1], hi2[2], hi2[3]}; }
#pragma unroll
                for (int i = 0; i < 8; ++i) {
                    const f32x4 d4 = *(const LAS f32x4*)(sl + RS_HGB + HB_DF + (16 * i + 4 * g4) * 4);
                    const bf16x8 ka = *(const LAS bf16x8*)(sl + RS_HGB + HB_KTF + i * 1024 + lane * 16);
                    S[0][i] = MFMA16(ka, vb[0], S[0][i] * d4); S[1][i] = MFMA16(ka, vb[1], S[1][i] * d4);
                }
            }
#undef VTR
        }
        HW_BAR();
        HW_BAR();
    } else {
        const int tq = tid - 256, tok = tq >> 3, part = tq & 7;
        const bf16_t* sgg = (const bf16_t*)(ws + WS_SG) + ((size_t)b * SEQ + tok) * 512 + h * 128 + 16 * part;
        f32x4 nw[4];
#pragma unroll
        for (int q = 0; q < 4; ++q) nw[q] = *(const f32x4*)(P.rec_norm_w + h * 128 + 16 * part + 4 * q);
        auto epilogue = [&](int c, u32x4 s0, u32x4 s1) {
            const LAS char* ob = lds + RS_OUT + (c & 1) * RS_OUTB + (tok * 136 + 16 * part) * 2;
            const u32x4 o0 = *(const LAS u32x4*)ob, o1 = *(const LAS u32x4*)(ob + 16);
            const unsigned ou[8] = {o0.x, o0.y, o0.z, o0.w, o1.x, o1.y, o1.z, o1.w}, su[8] = {s0.x, s0.y, s0.z, s0.w, s1.x, s1.y, s1.z, s1.w};
            float v[16], ss = 0.f;
#pragma unroll
            for (int q = 0; q < 8; ++q) { v[2 * q] = bf2f(ou[q] & 0xffffu); v[2 * q + 1] = bf2f(ou[q] >> 16); ss += v[2 * q] * v[2 * q] + v[2 * q + 1] * v[2 * q + 1]; }
            ss += __shfl_xor(ss, 1); ss += __shfl_xor(ss, 2); ss += __shfl_xor(ss, 4);
            const float rs = 1.f / sqrtf(ss * (1.f / 128.f) + EPS);
            u32x4 w0, w1; unsigned wo[8];
#pragma unroll
            for (int q = 0; q < 8; ++q) wo[q] = cvtpk(v[2 * q] * rs * nw[q >> 1][(2 * q) & 3] * bf2f(su[q] & 0xffffu), v[2 * q + 1] * rs * nw[q >> 1][(2 * q + 1) & 3] * bf2f(su[q] >> 16));
            w0 = (u32x4){wo[0], wo[1], wo[2], wo[3]}; w1 = (u32x4){wo[4], wo[5], wo[6], wo[7]};
            bf16_t* mp = (bf16_t*)(ws + WS_MIX) + ((size_t)b * SEQ + 32 * (c - 1) + tok) * DM + 512 + h * 128 + 16 * part;
            *(u32x4*)mp = w0; *(u32x4*)(mp + 8) = w1;
        };
#define SG_LD(k, A, B) do { const bf16_t* p_ = sgg + (size_t)(32 * ((k) - 1)) * 512; A = *(const u32x4*)p_; B = *(const u32x4*)(p_ + 8); } while (0)
        u32x4 ga0, ga1, gb0, gb1, gc0, gc1, gd0, gd1;
        SG_LD(1, gb0, gb1); SG_LD(2, gc0, gc1); SG_LD(3, gd0, gd1);
        HW_BAR();
        HW_BAR();
        for (int k = 1; k <= 128; k += 4) {
            HW_BAR(); if (k + 3 <= 128) SG_LD(k + 3, ga0, ga1); epilogue(k, gb0, gb1);
            HW_BAR(); if (k + 4 <= 128) SG_LD(k + 4, gb0, gb1); epilogue(k + 1, gc0, gc1);
            HW_BAR(); if (k + 5 <= 128) SG_LD(k + 5, gc0, gc1); epilogue(k + 2, gd0, gd1);
            HW_BAR(); if (k + 6 <= 128) SG_LD(k + 6, gd0, gd1); epilogue(k + 3, ga0, ga1);
        }
#undef SG_LD
        HW_BAR();
    }
}
template <int CTRL> DI float dpp_f(float v) { return __builtin_bit_cast(float, __builtin_amdgcn_update_dpp(0, __builtin_bit_cast(int, v), CTRL, 0xf, 0xf, false)); }
DI float row16_max(float v) { v = fmaxf(v, dpp_f<0x128>(v)); v = fmaxf(v, dpp_f<0x124>(v)); v = fmaxf(v, dpp_f<0x122>(v)); v = fmaxf(v, dpp_f<0x121>(v)); return v; }
DI float row16_sum(float v) { v += dpp_f<0x128>(v); v += dpp_f<0x124>(v); v += dpp_f<0x122>(v); v += dpp_f<0x121>(v); return v; }
#define CE_D(a, b) do { const float hi_ = fmaxf(a, b), lo_ = fminf(a, b); a = hi_; b = lo_; } while (0)
DI void bitonic_sort16(float (&v)[16]) {
#pragma unroll
    for (int k = 2; k <= 16; k *= 2)
#pragma unroll
        for (int j = k / 2; j > 0; j /= 2)
#pragma unroll
            for (int i = 0; i < 16; ++i) { const int l = i ^ j; if (l > i) { if ((i & k) == 0) CE_D(v[i], v[l]); else CE_D(v[l], v[i]); } }
}
DI void merge_top16(float (&a)[16], const float (&b)[16]) {
#pragma unroll
    for (int i = 0; i < 16; ++i) a[i] = fmaxf(a[i], b[15 - i]);
#pragma unroll
    for (int j = 8; j > 0; j /= 2)
#pragma unroll
        for (int i = 0; i < 16; ++i) { const int l = i ^ j; if (l > i) CE_D(a[i], a[l]); }
}
DI float embed7(float v, unsigned code) { return __uint_as_float((__float_as_uint(v) & 0xFFFFFF80u) | code); }
DI float embed8(float v, unsigned code) { return __uint_as_float((__float_as_uint(v) & 0xFFFFFF00u) | code); }

DI void topk_list(const bf16_t* qp, const bf16_t* kp, int hi, float (&top)[16]) {
    f32x16 acc[4];
#pragma unroll
    for (int kb = 0; kb < 4; ++kb) acc[kb] = f32x16{};
#pragma unroll
    for (int ks = 0; ks < 8; ++ks) {
        const bf16x8 qf = *(const bf16x8*)(qp + 16 * ks);
#pragma unroll
        for (int kb = 0; kb < 4; ++kb) { const bf16x8 kf = *(const bf16x8*)(kp + (size_t)kb * 32 * 128 + 16 * ks); acc[kb] = MFMA32(kf, qf, acc[kb]); }
    }
    float blk[16];
#pragma unroll
    for (int kb = 0; kb < 4; ++kb) {
#pragma unroll
        for (int r = 0; r < 16; ++r) { const unsigned code = (unsigned)(32 * kb + (r & 3) + 8 * (r >> 2)) | (unsigned)(4 * hi); if (kb == 0) top[r] = embed7(acc[kb][r], code); else blk[r] = embed7(acc[kb][r], code); }
        if (kb == 0) bitonic_sort16(top); else { bitonic_sort16(blk); merge_top16(top, blk); }
    }
    float l0[16], l1[16];
#pragma unroll
    for (int r = 0; r < 16; ++r) { auto rr = __builtin_amdgcn_permlane32_swap(__float_as_uint(top[r]), __float_as_uint(top[r]), false, false); l0[r] = __uint_as_float(rr[0]); l1[r] = __uint_as_float(rr[1]); }
    merge_top16(l0, l1);
#pragma unroll
    for (int r = 0; r < 16; ++r) top[r] = l0[r];
}

DI void topk_wave_item(const Params& P, int tb, int hh, LAS char* wlds) {
    const int lane = tid_() & 63, r32 = lane & 31, hi = lane >> 5;
    const unsigned char* ws = P.ws;
    const bf16_t* qp = (const bf16_t*)(ws + WS_PQ) + (size_t)(32 * tb + r32) * 2048 + hh * 256 + 8 * hi;
    const bf16_t* kp = (const bf16_t*)(ws + WS_SKB) + (size_t)(hh * 2 * 128 + r32) * 128 + 8 * hi;
    float A[16], B[16];
    topk_list(qp, kp, hi, A);
    topk_list(qp + 128, kp + 128 * 128, hi, B);
    LAS unsigned* my = (LAS unsigned*)(wlds + lane * 32);
#pragma unroll
    for (int w = 0; w < 4; ++w) {
        my[w] = (__float_as_uint(A[4 * w]) & 127u) | ((__float_as_uint(A[4 * w + 1]) & 127u) << 8) | ((__float_as_uint(A[4 * w + 2]) & 127u) << 16) | ((__float_as_uint(A[4 * w + 3]) & 127u) << 24);
        my[4 + w] = (__float_as_uint(B[4 * w]) & 127u) | ((__float_as_uint(B[4 * w + 1]) & 127u) << 8) | ((__float_as_uint(B[4 * w + 2]) & 127u) << 16) | ((__float_as_uint(B[4 * w + 3]) & 127u) << 24);
    }
#pragma unroll
    for (int r = 0; r < 16; ++r) { A[r] = __uint_as_float(__float_as_uint(A[r]) & 0xFFFFFF80u); B[r] = __uint_as_float(__float_as_uint(B[r]) & 0xFFFFFF80u); }
    float T[16], R1[16], X[16], Y[16];
#pragma unroll
    for (int j = 0; j < 16; ++j) { T[j] = embed8(A[0] + B[j], (unsigned)j); R1[j] = (j < 8) ? embed8(A[1] + B[j], (unsigned)(16 + j)) : -INFINITY; }
#define CAND(i, j) embed8(A[i] + B[j], (unsigned)(16 * (i) + (j)))
    X[0] = CAND(2, 0); X[1] = CAND(2, 1); X[2] = CAND(2, 2); X[3] = CAND(2, 3); X[4] = CAND(2, 4); X[5] = CAND(3, 0); X[6] = CAND(3, 1); X[7] = CAND(3, 2);
    X[8] = CAND(3, 3); X[9] = CAND(4, 0); X[10] = CAND(4, 1); X[11] = CAND(4, 2); X[12] = CAND(5, 0); X[13] = CAND(5, 1); X[14] = CAND(6, 0); X[15] = CAND(6, 1);
    Y[0] = CAND(7, 0); Y[1] = CAND(7, 1); Y[2] = CAND(8, 0); Y[3] = CAND(9, 0); Y[4] = CAND(10, 0); Y[5] = CAND(11, 0); Y[6] = CAND(12, 0); Y[7] = CAND(13, 0);
    Y[8] = CAND(14, 0); Y[9] = CAND(15, 0); Y[10] = -INFINITY; Y[11] = -INFINITY; Y[12] = -INFINITY; Y[13] = -INFINITY; Y[14] = -INFINITY; Y[15] = -INFINITY;
#undef CAND
    bitonic_sort16(X); bitonic_sort16(Y);
    merge_top16(T, R1); merge_top16(T, X); merge_top16(T, Y);
    asm volatile("s_waitcnt lgkmcnt(0)" ::: "memory");
    float ssum = 0.f, e[16]; int eid[16];
    const float t0 = __uint_as_float(__float_as_uint(T[0]) & 0xFFFFFF00u);
#pragma unroll
    for (int r = 0; r < 16; ++r) {
        const unsigned bits = __float_as_uint(T[r]); const unsigned code = bits & 255u;
        e[r] = __expf(__uint_as_float(bits & 0xFFFFFF00u) - t0); ssum += e[r];
        const int ka = ((const LAS unsigned char*)my)[code >> 4], kb_ = ((const LAS unsigned char*)my)[16 + (code & 15u)];
        eid[r] = ka * 128 + kb_;
    }
    const float inv = 1.f / ssum;
    const size_t o = (size_t)(32 * tb + r32) * 128 + hh * 16 + 8 * hi;
    int* ei = (int*)(ws + WS_EIDX) + o; float* eg = (float*)(ws + WS_EGATE) + o;
    typedef int i32x4 __attribute__((ext_vector_type(4)));
    i32x4 w0, w1; f32x4 g0, g1;
    const unsigned mh = 0u - (unsigned)hi;
#define SELU(a, b) ((((unsigned)(b)) & mh) | (((unsigned)(a)) & ~mh))
#pragma unroll
    for (int q = 0; q < 4; ++q) { w0[q] = (int)SELU(eid[q], eid[8 + q]); w1[q] = (int)SELU(eid[4 + q], eid[12 + q]);
        g0[q] = __uint_as_float(SELU(__float_as_uint(e[q]), __float_as_uint(e[8 + q]))) * inv; g1[q] = __uint_as_float(SELU(__float_as_uint(e[4 + q]), __float_as_uint(e[12 + q]))) * inv; }
#undef SELU
    *(i32x4*)ei = w0; *(i32x4*)(ei + 4) = w1; *(f32x4*)eg = g0; *(f32x4*)(eg + 4) = g1;
}

DI void topk_phase(const Params& P, char* lds_g, int bid, int nblk) {
    const int wave = __builtin_amdgcn_readfirstlane(tid_() >> 6);
    LAS char* wlds = (LAS char*)lds_g + wave * 2048;
    const int gw = bid * NWAVES + wave, NGW = nblk * NWAVES;
    for (int it = gw; it < (NTOK / 32) * 8; it += NGW) topk_wave_item(P, it >> 3, it & 7, wlds);
}

DI float gelu_exact(float x) { return 0.5f * x * (1.f + erff(x * 0.70710678118654752f)); }
typedef __bf16 bf16x8_t __attribute__((ext_vector_type(8)));
DI float dot8(u32x4 a, u32x4 x, float acc) {
    const bf16x8_t a8 = __builtin_bit_cast(bf16x8_t, a), x8 = __builtin_bit_cast(bf16x8_t, x);
    acc = __builtin_amdgcn_fdot2_f32_bf16(__builtin_shufflevector(a8, a8, 0, 1), __builtin_shufflevector(x8, x8, 0, 1), acc, false);
    acc = __builtin_amdgcn_fdot2_f32_bf16(__builtin_shufflevector(a8, a8, 2, 3), __builtin_shufflevector(x8, x8, 2, 3), acc, false);
    acc = __builtin_amdgcn_fdot2_f32_bf16(__builtin_shufflevector(a8, a8, 4, 5), __builtin_shufflevector(x8, x8, 4, 5), acc, false);
    acc = __builtin_amdgcn_fdot2_f32_bf16(__builtin_shufflevector(a8, a8, 6, 7), __builtin_shufflevector(x8, x8, 6, 7), acc, false);
    return acc;
}
DI float readlane_f(float v, int l) { return __builtin_bit_cast(float, __builtin_amdgcn_readlane(__builtin_bit_cast(int, v), l)); }
DI float wave_sum_dpp(float v) {
    v = row16_sum(v);
    return (readlane_f(v, 0) + readlane_f(v, 16)) + (readlane_f(v, 32) + readlane_f(v, 48));
}

DI float dot16_fp8(u32x4 w, const f32x2 (&x)[8]) {
    f32x2 acc = __builtin_amdgcn_cvt_pk_f32_fp8((int)w.x, false) * x[0];
    acc = __builtin_amdgcn_cvt_pk_f32_fp8((int)w.x, true) * x[1] + acc;
    acc = __builtin_amdgcn_cvt_pk_f32_fp8((int)w.y, false) * x[2] + acc;
    acc = __builtin_amdgcn_cvt_pk_f32_fp8((int)w.y, true) * x[3] + acc;
    acc = __builtin_amdgcn_cvt_pk_f32_fp8((int)w.z, false) * x[4] + acc;
    acc = __builtin_amdgcn_cvt_pk_f32_fp8((int)w.z, true) * x[5] + acc;
    acc = __builtin_amdgcn_cvt_pk_f32_fp8((int)w.w, false) * x[6] + acc;
    acc = __builtin_amdgcn_cvt_pk_f32_fp8((int)w.w, true) * x[7] + acc;
    return acc.x + acc.y;
}
DI void peer_hid_phase(const Params& P, int bid, int nblk) {
    const int tid = tid_(), lane = tid & 63, wave = __builtin_amdgcn_readfirstlane(tid >> 6);
    const unsigned char* ws = P.ws;
    const unsigned char* U8 = ws + WS_UB; const float* USC = (const float*)(ws + WS_USC);
    const int gw = bid * NWAVES + wave, NGW = nblk * NWAVES;
    f32x4 wv[4];
#pragma unroll
    for (int q = 0; q < 4; ++q) wv[q] = *(const f32x4*)(P.ffn_norm_w + 16 * lane + 4 * q);
    for (int n = gw; n < NTOK; n += NGW) {
        const float* hrow = P.out + (size_t)n * DM + 16 * lane;
        f32x4 h[4]; float ss = 0.f;
#pragma unroll
        for (int q = 0; q < 4; ++q) { h[q] = *(const f32x4*)(hrow + 4 * q); ss += (h[q].x * h[q].x + h[q].y * h[q].y) + (h[q].z * h[q].z + h[q].w * h[q].w); }
        ss = wave_sum_dpp(ss);
        const float r2 = 1.f / sqrtf(ss * (1.f / DM) + EPS);
        f32x2 x[8];
#pragma unroll
        for (int q = 0; q < 4; ++q) { const f32x4 t = h[q] * wv[q] * r2; x[2 * q] = (f32x2){t.x, t.y}; x[2 * q + 1] = (f32x2){t.z, t.w}; }
        const int* eidx = (const int*)(ws + WS_EIDX) + (size_t)n * 128;
        const float* egate = (const float*)(ws + WS_EGATE) + (size_t)n * 128;
        const int id0 = eidx[lane], id1 = eidx[64 + lane];
        float hid0 = 0.f, hid1 = 0.f;
#pragma unroll 1
        for (int k0 = 0; k0 < 128; k0 += 16) {
            u32x4 ra[16]; float sc[16];
#pragma unroll
            for (int e = 0; e < 16; ++e) {
                const int k = k0 + e;
                const int id = (k0 < 64) ? __builtin_amdgcn_readlane(id0, k & 63) : __builtin_amdgcn_readlane(id1, k & 63);
                ra[e] = *(const u32x4*)(U8 + (size_t)id * DM + 16 * lane); sc[e] = USC[id];
            }
#pragma unroll
            for (int e = 0; e < 16; ++e) {
                const int k = k0 + e;
                const float d = wave_sum_dpp(dot16_fp8(ra[e], x)) * sc[e];
                if (k0 < 64) { if (lane == (k & 63)) hid0 = d; } else { if (lane == (k & 63)) hid1 = d; }
            }
        }
        float* hid = (float*)(ws + WS_HID) + (size_t)n * 128;
        hid[lane] = gelu_exact(hid0) * egate[lane];
        hid[64 + lane] = gelu_exact(hid1) * egate[64 + lane];
    }
}

DI void peer_out_phase(const Params& P, int bid, int nblk) {
    const int tid = tid_(), lane = tid & 63, wave = __builtin_amdgcn_readfirstlane(tid >> 6);
    const unsigned char* ws = P.ws;
    const unsigned char* V8 = ws + WS_VB; const float* VSC = (const float*)(ws + WS_VSC);
    const int gw = bid * NWAVES + wave, NGW = nblk * NWAVES;
    f32x4 wv[4];
#pragma unroll
    for (int q = 0; q < 4; ++q) wv[q] = *(const f32x4*)(P.final_w + 16 * lane + 4 * q);
    for (int n = gw; n < NTOK; n += NGW) {
        const int* eidx = (const int*)(ws + WS_EIDX) + (size_t)n * 128;
        const float* hid = (const float*)(ws + WS_HID) + (size_t)n * 128;
        const int id0 = eidx[lane], id1 = eidx[64 + lane];
        const float c0 = hid[lane], c1 = hid[64 + lane];
        f32x2 acc[8];
#pragma unroll
        for (int i = 0; i < 8; ++i) acc[i] = (f32x2){0.f, 0.f};
#pragma unroll 1
        for (int k0 = 0; k0 < 128; k0 += 16) {
            u32x4 ra[16]; float cf[16];
#pragma unroll
            for (int e = 0; e < 16; ++e) {
                const int k = k0 + e;
                const int id = (k0 < 64) ? __builtin_amdgcn_readlane(id0, k & 63) : __builtin_amdgcn_readlane(id1, k & 63);
                cf[e] = ((k0 < 64) ? readlane_f(c0, k & 63) : readlane_f(c1, k & 63)) * VSC[id];
                ra[e] = *(const u32x4*)(V8 + (size_t)id * DM + 16 * lane);
            }
#pragma unroll
            for (int e = 0; e < 16; ++e) {
                const f32x2 c = (f32x2){cf[e], cf[e]}; const u32x4 w = ra[e];
                acc[0] = __builtin_amdgcn_cvt_pk_f32_fp8((int)w.x, false) * c + acc[0]; acc[1] = __builtin_amdgcn_cvt_pk_f32_fp8((int)w.x, true) * c + acc[1];
                acc[2] = __builtin_amdgcn_cvt_pk_f32_fp8((int)w.y, false) * c + acc[2]; acc[3] = __builtin_amdgcn_cvt_pk_f32_fp8((int)w.y, true) * c + acc[3];
                acc[4] = __builtin_amdgcn_cvt_pk_f32_fp8((int)w.z, false) * c + acc[4]; acc[5] = __builtin_amdgcn_cvt_pk_f32_fp8((int)w.z, true) * c + acc[5];
                acc[6] = __builtin_amdgcn_cvt_pk_f32_fp8((int)w.w, false) * c + acc[6]; acc[7] = __builtin_amdgcn_cvt_pk_f32_fp8((int)w.w, true) * c + acc[7];
            }
        }
        float* orow = P.out + (size_t)n * DM + 16 * lane;
        f32x4 h[4]; float ss = 0.f;
#pragma unroll
        for (int q = 0; q < 4; ++q) { h[q] = *(const f32x4*)(orow + 4 * q) + (f32x4){acc[2 * q].x, acc[2 * q].y, acc[2 * q + 1].x, acc[2 * q + 1].y}; ss += (h[q].x * h[q].x + h[q].y * h[q].y) + (h[q].z * h[q].z + h[q].w * h[q].w); }
        ss = wave_sum_dpp(ss);
        const float rs = 1.f / sqrtf(ss * (1.f / DM) + EPS);
#pragma unroll
        for (int q = 0; q < 4; ++q) *(f32x4*)(orow + 4 * q) = h[q] * wv[q] * rs;
    }
}

#ifdef DBG_CHECK
DI void dbg_max(float* slot, float v) { atomicMax((unsigned*)slot, __float_as_uint(fmaxf(v, 0.f))); }
DI void dbg_check_topk(const Params& P, char* lds_g, int bid, int nblk) {
    LAS char* lds = (LAS char*)lds_g;
    const int tid = tid_(), lane = tid & 63, wave = __builtin_amdgcn_readfirstlane(tid >> 6);
    const unsigned char* ws = P.ws; float* dbg = (float*)(ws + WS_CTL) + 64;
    LAS float* sc = (LAS float*)(lds) + wave * 1024;
    const int gw = bid * NWAVES + wave;
    const int token = (gw * 37) % NTOK, hh = gw & 7;
    for (int p = 0; p < 2; ++p) for (int kk = 0; kk < 2; ++kk) {
        const int key = lane + 64 * kk; float a = 0.f;
        const bf16_t* q = (const bf16_t*)(ws + WS_PQ) + (size_t)token * 2048 + hh * 256 + p * 128;
        const bf16_t* sk = (const bf16_t*)(ws + WS_SKB) + (size_t)((hh * 2 + p) * 128 + key) * 128;
        for (int c = 0; c < 128; ++c) a += bf2f(q[c]) * bf2f(sk[c]);
        sc[p * 128 + key] = a;
    }
    asm volatile("s_waitcnt lgkmcnt(0)" ::: "memory");
    for (int p = 0; p < 2; ++p) for (int kk = 0; kk < 2; ++kk) {
        const int key = lane + 64 * kk; const float v = sc[p * 128 + key]; int rank = 0;
        for (int o = 0; o < 128; ++o) { const float w = sc[p * 128 + o]; rank += (w > v || (w == v && o < key)) ? 1 : 0; }
        if (rank < 16) { sc[256 + p * 16 + rank] = v; sc[288 + p * 16 + rank] = __int_as_float(key); }
    }
    asm volatile("s_waitcnt lgkmcnt(0)" ::: "memory");
    for (int e = 0; e < 4; ++e) {
        const int c = lane * 4 + e, i = c >> 4, j = c & 15; const float v = sc[256 + i] + sc[272 + j]; int rank = 0;
        for (int o = 0; o < 256; ++o) { const float w = sc[256 + (o >> 4)] + sc[272 + (o & 15)]; rank += (w > v || (w == v && o < c)) ? 1 : 0; }
        if (rank < 16) { sc[320 + rank] = __int_as_float(__float_as_int(sc[288 + i]) * 128 + __float_as_int(sc[304 + j])); sc[336 + rank] = v; }
    }
    asm volatile("s_waitcnt lgkmcnt(0)" ::: "memory");
    if (lane < 16) {
        const int eid = __float_as_int(sc[320 + lane]); const float sv = sc[336 + lane];
        float mx = sc[336], sum = 0.f; for (int o = 0; o < 16; ++o) sum += __expf(sc[336 + o] - mx);
        const float gate = __expf(sv - mx) / sum;
        const int* eidx = (const int*)(ws + WS_EIDX) + (size_t)token * 128 + hh * 16; const float* eg = (const float*)(ws + WS_EGATE) + (size_t)token * 128 + hh * 16;
        int found = -1; for (int o = 0; o < 16; ++o) if (eidx[o] == eid) found = o;
        if (found < 0) atomicAdd(dbg + 0, 1.f); else dbg_max(dbg + 1, fabsf(eg[found] - gate));
    }
    if (lane == 0) atomicAdd(dbg + 2, 16.f);
}
DI void dbg_check_hid(const Params& P, int bid, int nblk) {
    const int tid = tid_(), lane = tid & 63, wave = __builtin_amdgcn_readfirstlane(tid >> 6);
    const unsigned char* ws = P.ws; float* dbg = (float*)(ws + WS_CTL) + 64;
    const int gw = bid * NWAVES + wave; const int token = (gw * 53) % NTOK;
    const float* hrow = P.out + (size_t)token * DM;
    float ss = 0.f; for (int c = lane; c < DM; c += 64) ss += hrow[c] * hrow[c];
    ss = wave_sum(ss); const float r2 = 1.f / sqrtf(ss / DM + EPS);
    for (int kk = 0; kk < 2; ++kk) {
        const int k = lane + 64 * kk; const int eid = ((const int*)(ws + WS_EIDX))[(size_t)token * 128 + k];
        const float* urow = P.pu + (size_t)eid * DM; float d = 0.f;
        for (int c = 0; c < DM; ++c) d += urow[c] * (hrow[c] * r2 * P.ffn_norm_w[c]);
        const float hidv = gelu_exact(d) * ((const float*)(ws + WS_EGATE))[(size_t)token * 128 + k];
        const float got = ((const float*)(ws + WS_HID))[(size_t)token * 128 + k];
        dbg_max(dbg + 3, fabsf(got - hidv)); dbg_max(dbg + 4, fabsf(hidv));
    }
}
DI float dbg_enc(float m) { return 8.f + log10f(fmaxf(m, 1e-8f)); }
#endif

#ifdef DBG_CHECK
DI void dbg_check_attn(const Params& P, int bid, int nblk) {
    const int tid = tid_(), lane = tid & 63, wave = __builtin_amdgcn_readfirstlane(tid >> 6);
    const unsigned char* ws = P.ws; float* dbg = (float*)(ws + WS_CTL) + 64;
    const int gw = bid * NWAVES + wave;
    const unsigned hsh = (unsigned)gw * 2654435761u;
    const int b = (hsh >> 8) & 7, h = (hsh >> 11) & 3, i = (int)((hsh >> 13) % 4096u), bh = b * 4 + h;
    const float lam = ((const float*)(ws + WS_LB))[512];
    float oc[2][2], lsum[2], mx[2];
    for (int c = 0; c < 2; ++c) { oc[c][0] = oc[c][1] = 0.f; lsum[c] = 0.f; mx[c] = -1e30f; }
    for (int pp = KPAD; pp <= 64 + i; ++pp) {
        const int tile = pp >> 6, key = pp & 63;
        for (int c = 0; c < 2; ++c) {
            const bf16_t* q = (const bf16_t*)(ws + WS_Q) + ((size_t)((bh * 2 + c) * SEQ + i)) * 64;
            const unsigned char* kimg = ws + WS_K + ((size_t)(bh * 2 + c) * KT + tile) * 8192;
            float sdot = 0.f;
            for (int d = 0; d < 64; ++d) sdot += bf2f(q[d]) * bf2f(*(const bf16_t*)(kimg + (d >> 3) * 1024 + key * 16 + (d & 7) * 2));
            const float mn = fmaxf(mx[c], sdot), al = exp2f(mx[c] - mn), pe = exp2f(sdot - mn);
            const unsigned char* vimg = ws + WS_V + ((size_t)bh * KT + tile) * 16384;
            for (int e = 0; e < 2; ++e) { const int dv = lane + 64 * e; oc[c][e] = oc[c][e] * al + pe * bf2f(*(const bf16_t*)(vimg + (dv >> 5) * 4096 + key * 64 + (dv & 31) * 2)); }
            lsum[c] = lsum[c] * al + pe; mx[c] = mn;
        }
    }
    float o[2], ss = 0.f;
    for (int e = 0; e < 2; ++e) { o[e] = oc[0][e] / lsum[0] - lam * oc[1][e] / lsum[1]; ss += o[e] * o[e]; }
    ss = wave_sum(ss); const float rs = (1.f - LAM_INIT) / sqrtf(ss / 128.f + EPS);
    for (int e = 0; e < 2; ++e) { const int dv = lane + 64 * e; const float want = o[e] * rs * P.subln_w[dv];
        const float got = bf2f(((const bf16_t*)(ws + WS_MIX))[(size_t)(b * SEQ + i) * DM + h * 128 + dv]);
        dbg_max(dbg + 5, fabsf(got - want)); dbg_max(dbg + 6, fabsf(want)); }
}
DI void dbg_check_hgrn(const Params& P, char* lds_g, int bid, int nblk) {
    if (bid >= 32) return;
    LAS float* L = (LAS float*)lds_g;
    const int tid = tid_(), dv = tid & 127, qt = tid >> 7;
    const unsigned char* ws = P.ws; float* dbg = (float*)(ws + WS_CTL) + 64;
    const int bh = bid, b = bid >> 2, h = bid & 3;
    const float* HG = (const float*)(ws + WS_HG) + (size_t)bh * HT * 128;
    const bf16_t* HQ = (const bf16_t*)(ws + WS_HQ) + (size_t)bh * HT * 128;
    const bf16_t* HV = (const bf16_t*)(ws + WS_HV) + (size_t)bh * HT * 128;
    float S[32];
#pragma unroll
    for (int j = 0; j < 32; ++j) S[j] = 0.f;
    for (int pp = 16; pp < HT; ++pp) {
        if (tid < 128) { L[tid] = __expf(HG[(size_t)pp * 128 + tid]); L[128 + tid] = bf2f(HQ[(size_t)pp * 128 + tid]); L[256 + tid] = bf2f(HV[(size_t)pp * 128 + tid]); }
        __syncthreads();
        const float v = L[256 + dv]; float part = 0.f;
#pragma unroll
        for (int j = 0; j < 32; ++j) { const float f = L[32 * qt + j]; S[j] = f * S[j] + (1.f - f) * v; part += L[128 + 32 * qt + j] * S[j]; }
        L[384 + qt * 128 + dv] = part;
        __syncthreads();
        if (tid < 128) { const float o = L[384 + dv] + L[512 + dv] + L[640 + dv] + L[768 + dv]; L[896 + dv] = o; }
        __syncthreads();
        if (tid < 128 && pp >= 32) {
            float ss = 0.f; for (int j = 0; j < 128; ++j) ss += L[896 + j] * L[896 + j];
            const float rs = 1.f / sqrtf(ss / 128.f + EPS);
            const size_t row = (size_t)b * SEQ + (pp - 32);
            const float want = L[896 + dv] * rs * P.rec_norm_w[h * 128 + dv] * bf2f(((const bf16_t*)(ws + WS_SG))[row * 512 + h * 128 + dv]);
            const float got = bf2f(((const bf16_t*)(ws + WS_MIX))[row * DM + 512 + h * 128 + dv]);
            dbg_max(dbg + 7, fabsf(got - want)); dbg_max(dbg + 8, fabsf(want));
        }
        __syncthreads();
    }
}
#endif

#ifdef DBG_CHECK
DI float dbg_proj(const Params& P, int m, int c) {
    const float* xrow = (m < NTOK) ? P.x + (size_t)m * DM : P.meta + (size_t)(m - NTOK) * DM;
    float ss = 0.f, a = 0.f;
    for (int k = 0; k < DM; ++k) { const float xv = xrow[k]; ss += xv * xv; a += xv * P.mix_norm_w[k] * P.w_in[(size_t)k * NCOL1 + c]; }
    return a / sqrtf(ss / DM + EPS);
}
DI void dbg_check_gemm1(const Params& P, int bid, int nblk) {
    const unsigned char* ws = P.ws; float* dbg = (float*)(ws + WS_CTL) + 64;
    const int gt = bid * NTHREADS + tid_();
    if (gt >= 7 * 4096) return;
    const unsigned hsh = (unsigned)gt * 2654435761u;
    const int seg = gt % 7, cs = (hsh >> 7) & 511;
    const bool meta = ((gt / 7) & 15) == 0;
    const int m = meta ? NTOK + ((hsh >> 20) & 15) : (int)((hsh >> 3) % (unsigned)NTOK);
    const int b = meta ? (int)((hsh >> 25) & 7) : (m >> 12), t = meta ? (m - NTOK) : ((m & 4095) + NMETA);
    const int h = cs >> 7;
    float want = 0.f, got = 0.f;
    if (seg <= 1) {
        if (seg == 0 && meta) return;
        const int comp = (cs >> 6) & 1, d = cs & 63, dlo = d & 31;
        const float zlo = dbg_proj(P, m, seg * 512 + (cs & ~63) + dlo), zhi = dbg_proj(P, m, seg * 512 + (cs & ~63) + dlo + 32);
        const double inv = exp2(-(double)dlo * (13.287712379549449 / 32.0)); const float cv = (float)cos((double)t * inv), sv = (float)sin((double)t * inv);
        want = (d < 32) ? zlo * cv - zhi * sv : zhi * cv + zlo * sv;
        if (seg == 0) { want *= QSCALE; got = bf2f(((const bf16_t*)(ws + WS_Q))[((size_t)(((b * 4 + h) * 2 + comp) * SEQ + (m & 4095))) * 64 + d]); }
        else { const int pp = t + KPAD; got = bf2f(*(const bf16_t*)(ws + WS_K + ((size_t)((b * 4 + h) * 2 + comp) * KT + (pp >> 6)) * 8192 + (d >> 3) * 1024 + (pp & 63) * 16 + (d & 7) * 2)); }
    } else {
        const float z = dbg_proj(P, m, seg * 512 + cs); const int dv = cs & 127;
        if (seg == 2) { const int pp = t + KPAD; want = z; got = bf2f(*(const bf16_t*)(ws + WS_V + ((size_t)(b * 4 + h) * KT + (pp >> 6)) * 16384 + (dv >> 5) * 4096 + (pp & 63) * 64 + (dv & 31) * 2)); }
        else if (seg == 3) { want = siluf_(z); got = bf2f(((const bf16_t*)(ws + WS_HQ))[((size_t)(b * 4 + h) * HT + t + 16) * 128 + dv]); }
        else if (seg == 4) { const float l0 = P.lb_logits[cs], l1 = P.lb_logits[512 + cs], lb = __expf(l0) / (__expf(l0) + __expf(l1)); want = __logf(lb + (1.f - lb) * sigmoidf_(z)); got = ((const float*)(ws + WS_HG))[((size_t)(b * 4 + h) * HT + t + 16) * 128 + dv]; }
        else if (seg == 5) { want = z; got = bf2f(((const bf16_t*)(ws + WS_HV))[((size_t)(b * 4 + h) * HT + t + 16) * 128 + dv]); }
        else { if (meta) return; want = siluf_(z); got = bf2f(((const bf16_t*)(ws + WS_SG))[(size_t)m * 512 + cs]); }
    }
    dbg_max(dbg + 16 + seg + (meta ? 8 : 0), fabsf(got - want));
}
#endif
typedef unsigned u32x4v __attribute__((vector_size(16)));
DI float oct_sum(float v) {
    v += dpp_f<0xB1>(v); v += dpp_f<0x4E>(v); v += dpp_f<0x141>(v); return v;
}
DI unsigned my_xcc_id() { return (unsigned)__builtin_amdgcn_s_getreg((3 << 11) | 20) & 7u; }
constexpr int CTL_G1 = 16, CTL_G2 = 32;

DI void xn8_rows(const Params& P, int bid, int nblk) {
    const int tid = tid_(), lane = tid & 63, wave = __builtin_amdgcn_readfirstlane(tid >> 6);
    unsigned char* ws = P.ws;
    const int gw = bid * NWAVES + wave, NGW = nblk * NWAVES;
    f32x4 wv[4];
#pragma unroll
    for (int q = 0; q < 4; ++q) wv[q] = *(const f32x4*)(P.ffn_norm_w + 16 * lane + 4 * q);
    for (int n = gw; n < NTOK; n += NGW) {
        const bf16_t* hrow = (const bf16_t*)(ws + WS_XB) + (size_t)n * DM + 16 * lane;
        const float r2 = 1.f / sqrtf(((const float*)(ws + WS_SSQ))[n] * (1.f / DM) + EPS);
        const u32x4 ha = *(const u32x4*)hrow, hb = *(const u32x4*)(hrow + 8);
        const unsigned hu[8] = {ha.x, ha.y, ha.z, ha.w, hb.x, hb.y, hb.z, hb.w};
        f32x4 t[4]; float am = 0.f;
#pragma unroll
        for (int q = 0; q < 4; ++q) { t[q] = (f32x4){bf2f(hu[2 * q] & 0xffffu), bf2f(hu[2 * q] >> 16), bf2f(hu[2 * q + 1] & 0xffffu), bf2f(hu[2 * q + 1] >> 16)} * wv[q] * r2; am = fmaxf(am, fmaxf(fmaxf(fabsf(t[q].x), fabsf(t[q].y)), fmaxf(fabsf(t[q].z), fabsf(t[q].w)))); }
        am = row16_max(am); am = fmaxf(fmaxf(readlane_f(am, 0), readlane_f(am, 16)), fmaxf(readlane_f(am, 32), readlane_f(am, 48)));
        const float sc = (am > 0.f) ? exp2f(floorf(log2f(224.f / am))) : 1.f;
        int w[4];
#pragma unroll
        for (int q = 0; q < 4; ++q) { w[q] = __builtin_amdgcn_cvt_pk_fp8_f32(t[q].x * sc, t[q].y * sc, 0, false); w[q] = __builtin_amdgcn_cvt_pk_fp8_f32(t[q].z * sc, t[q].w * sc, w[q], true); }
        *(u32x4*)(ws + WS_XN8 + (size_t)n * DM + 16 * lane) = (u32x4){(unsigned)w[0], (unsigned)w[1], (unsigned)w[2], (unsigned)w[3]};
        if (lane == 0) ((float*)(ws + WS_XSC))[n] = 1.f / sc;
    }
}
typedef int i32x4 __attribute__((ext_vector_type(4)));
struct GMeta { i32x4 id[4]; f32x4 c[4]; u32x4 xq; };
template <int WHICH>
DI void g_meta(const Params& P, int n, int x, GMeta& M) {
    const int lane = tid_() & 63, i = lane & 7, g = lane >> 3;
    const i32x4* ip = (const i32x4*)((const int*)(P.ws + WS_EIDX) + (size_t)n * 128 + 16 * g);
#pragma unroll
    for (int q = 0; q < 4; ++q) M.id[q] = ip[q];
    if (WHICH == 1) M.xq = *(const u32x4*)(P.ws + WS_XN8 + (size_t)n * DM + 128 * x + 16 * i);
    else { const f32x4* cp = (const f32x4*)((const float*)(P.ws + WS_HID) + (size_t)n * 128 + 16 * g);
#pragma unroll
        for (int q = 0; q < 4; ++q) M.c[q] = cp[q]; }
}
DI void g_issue(int x, const GMeta& M, u32x4v (&rw)[16], __amdgpu_buffer_rsrc_t rs) {
    const int i = tid_() & 7;
    const unsigned lo = (unsigned)x * (unsigned)(NEXP * 128) + (unsigned)(16 * i);
#pragma unroll
    for (int j = 0; j < 16; ++j) rw[j] = __builtin_amdgcn_raw_buffer_load_b128(rs, ((unsigned)M.id[j >> 2][j & 3] << 7) + lo, 0, 0);
}
DI void g1_finish(const Params& P, int n, int x, u32x4 xq, const u32x4v (&rw)[16]) {
    const int lane = tid_() & 63, i = lane & 7, g = lane >> 3;
    f32x2 xv[8];
    xv[0] = __builtin_amdgcn_cvt_pk_f32_fp8((int)xq.x, false); xv[1] = __builtin_amdgcn_cvt_pk_f32_fp8((int)xq.x, true);
    xv[2] = __builtin_amdgcn_cvt_pk_f32_fp8((int)xq.y, false); xv[3] = __builtin_amdgcn_cvt_pk_f32_fp8((int)xq.y, true);
    xv[4] = __builtin_amdgcn_cvt_pk_f32_fp8((int)xq.z, false); xv[5] = __builtin_amdgcn_cvt_pk_f32_fp8((int)xq.z, true);
    xv[6] = __builtin_amdgcn_cvt_pk_f32_fp8((int)xq.w, false); xv[7] = __builtin_amdgcn_cvt_pk_f32_fp8((int)xq.w, true);
    float pd[16];
#pragma unroll
    for (int j = 0; j < 16; ++j) pd[j] = dot16_fp8(__builtin_bit_cast(u32x4, rw[j]), xv);
    const unsigned m1 = 0u - (unsigned)((i >> 2) & 1), m2 = 0u - (unsigned)(i & 1), m3 = 0u - (unsigned)((i >> 1) & 1);
#define BSEL(a, b, m) __uint_as_float((__float_as_uint(a) & ~(m)) | (__float_as_uint(b) & (m)))
    float z[8], w[4], u[2];
#pragma unroll
    for (int q = 0; q < 8; ++q) { const float snd = BSEL(pd[q + 8], pd[q], m1), kep = BSEL(pd[q], pd[q + 8], m1); z[q] = kep + dpp_f<0x141>(snd); }
#pragma unroll
    for (int q = 0; q < 4; ++q) { const float snd = BSEL(z[q + 4], z[q], m2), kep = BSEL(z[q], z[q + 4], m2); w[q] = kep + dpp_f<0xB1>(snd); }
#pragma unroll
    for (int q = 0; q < 2; ++q) { const float snd = BSEL(w[q + 2], w[q], m3), kep = BSEL(w[q], w[q + 2], m3); u[q] = kep + dpp_f<0x4E>(snd); }
    const int j0 = 8 * ((i >> 2) & 1) + 4 * (i & 1) + 2 * ((i >> 1) & 1);
#undef BSEL
    *(f32x2*)((float*)(P.ws + WS_HIDP) + ((size_t)x * NTOK + n) * 128 + 16 * g + j0) = (f32x2){u[0], u[1]};
}
DI void g2_finish(const Params& P, int n, int x, const f32x4 (&cv)[4], const u32x4v (&rw)[16]) {
    const int lane = tid_() & 63, i = lane & 7, g = lane >> 3;
    f32x2 acc[8];
#pragma unroll
    for (int q = 0; q < 8; ++q) acc[q] = (f32x2){0.f, 0.f};
#pragma unroll
    for (int j = 0; j < 16; ++j) {
        const float cj = cv[j >> 2][j & 3]; const f32x2 c = (f32x2){cj, cj}; const u32x4 w = __builtin_bit_cast(u32x4, rw[j]);
        acc[0] = __builtin_amdgcn_cvt_pk_f32_fp8((int)w.x, false) * c + acc[0]; acc[1] = __builtin_amdgcn_cvt_pk_f32_fp8((int)w.x, true) * c + acc[1];
        acc[2] = __builtin_amdgcn_cvt_pk_f32_fp8((int)w.y, false) * c + acc[2]; acc[3] = __builtin_amdgcn_cvt_pk_f32_fp8((int)w.y, true) * c + acc[3];
        acc[4] = __builtin_amdgcn_cvt_pk_f32_fp8((int)w.z, false) * c + acc[4]; acc[5] = __builtin_amdgcn_cvt_pk_f32_fp8((int)w.z, true) * c + acc[5];
        acc[6] = __builtin_amdgcn_cvt_pk_f32_fp8((int)w.w, false) * c + acc[6]; acc[7] = __builtin_amdgcn_cvt_pk_f32_fp8((int)w.w, true) * c + acc[7];
    }
    float y[16], z[8], w[4];
#pragma unroll
    for (int q = 0; q < 8; ++q) { y[2 * q] = acc[q].x; y[2 * q + 1] = acc[q].y; }
#pragma unroll
    for (int q = 0; q < 8; ++q) { auto rr = __builtin_amdgcn_permlane32_swap(__float_as_uint(y[q]), __float_as_uint(y[q + 8]), false, false); z[q] = __uint_as_float(rr[0]) + __uint_as_float(rr[1]); }
#pragma unroll
    for (int q = 0; q < 4; ++q) { auto rr = __builtin_amdgcn_permlane16_swap(__float_as_uint(z[q]), __float_as_uint(z[q + 4]), false, false); w[q] = __uint_as_float(rr[0]) + __uint_as_float(rr[1]); }
    const unsigned m3 = 0u - (unsigned)(g & 1);
#define BSEL(a, b, m) __uint_as_float((__float_as_uint(a) & ~(m)) | (__float_as_uint(b) & (m)))
    const float k0 = BSEL(w[0], w[2], m3) + dpp_f<0x128>(BSEL(w[2], w[0], m3)), k1 = BSEL(w[1], w[3], m3) + dpp_f<0x128>(BSEL(w[3], w[1], m3));
#undef BSEL
    float* hp = P.out + (size_t)n * DM + 128 * x + 16 * i + 2 * g;
    const f32x2 t = *(const f32x2*)hp + (f32x2){k0, k1}; *(f32x2*)hp = t;
    const float ss = wave_sum_dpp(t.x * t.x + t.y * t.y);
    if (lane == 0) atomicAdd((float*)(P.ws + WS_SSQ2) + n, ss);
}
constexpr int SL_CHUNK = 128, SL_T = SL_CHUNK / NWAVES;
#define SB() __builtin_amdgcn_sched_barrier(0)
template <int WHICH>
DI void g_chunk(const Params& P, int nbase, int x, __amdgpu_buffer_rsrc_t rs) {
    GMeta MA, MB; u32x4v RA[16], RB[16];
    g_meta<WHICH>(P, nbase, x, MA); SB(); g_meta<WHICH>(P, nbase + 8, x, MB); SB(); g_issue(x, MA, RA, rs); SB();
#pragma unroll
    for (int t = 0; t < SL_T; t += 2) {
        const u32x4 xA = MA.xq; const f32x4 cA[4] = {MA.c[0], MA.c[1], MA.c[2], MA.c[3]};
        if (t + 2 < SL_T) { g_meta<WHICH>(P, nbase + 8 * (t + 2), x, MA); SB(); }
        g_issue(x, MB, RB, rs); SB();
        if (WHICH == 1) g1_finish(P, nbase + 8 * t, x, xA, RA); else g2_finish(P, nbase + 8 * t, x, cA, RA);
        SB();
        const u32x4 xB = MB.xq; const f32x4 cB[4] = {MB.c[0], MB.c[1], MB.c[2], MB.c[3]};
        if (t + 3 < SL_T) { g_meta<WHICH>(P, nbase + 8 * (t + 3), x, MB); SB(); }
        if (t + 2 < SL_T) { g_issue(x, MA, RA, rs); SB(); }
        if (WHICH == 1) g1_finish(P, nbase + 8 * (t + 1), x, xB, RB); else g2_finish(P, nbase + 8 * (t + 1), x, cB, RB);
        SB();
    }
}
template <int WHICH>
DI void sliced_phase(const Params& P, char* lds_g) {
    const int tid = tid_(), wave = __builtin_amdgcn_readfirstlane(tid >> 6);
    unsigned* ctr = (unsigned*)(P.ws + WS_CTL) + (WHICH == 1 ? CTL_G1 : CTL_G2);
    const __amdgpu_buffer_rsrc_t rs = __builtin_amdgcn_make_buffer_rsrc((void*)(P.ws + (WHICH == 1 ? WS_UB : WS_VB)), 0, NEXP * DM, 0x00020000);
    const int x0 = (int)my_xcc_id();
    LAS int* slot = (LAS int*)((LAS char*)lds_g + LDS_ITEM);
    for (int s = 0; s < 8; ++s) {
        const int x = (x0 + s) & 7;
        for (;;) {
            if (tid == 0) *slot = (int)atomicAdd(ctr + x, 1u);
            __syncthreads();
            const int chunk = *slot;
            __syncthreads();
            if (chunk >= NTOK / SL_CHUNK) break;
            g_chunk<WHICH>(P, chunk * SL_CHUNK + wave, x, rs);
        }
    }
}
DI void hid_reduce_phase(const Params& P, int bid, int nblk) {
    const unsigned char* ws = P.ws;
    const size_t gt = (size_t)bid * NTHREADS + tid_(), NGT = (size_t)nblk * NTHREADS;
    const float* hp = (const float*)(ws + WS_HIDP);
    for (size_t o = gt; o < (size_t)NTOK * 128; o += NGT) {
        float a = 0.f;
#pragma unroll
        for (int x = 0; x < 8; ++x) a += hp[(size_t)x * NTOK * 128 + o];
        const int e = ((const int*)(ws + WS_EIDX))[o];
        const float d = a * ((const float*)(ws + WS_USC))[e] * ((const float*)(ws + WS_XSC))[o >> 7];
        ((float*)(ws + WS_HID))[o] = gelu_exact(d) * ((const float*)(ws + WS_EGATE))[o] * ((const float*)(ws + WS_VSC))[e];
    }
}
DI void final_norm_phase(const Params& P, int bid, int nblk) {
    const size_t gt = (size_t)bid * NTHREADS + tid_(), NGT = (size_t)nblk * NTHREADS;
    const float* ssq = (const float*)(P.ws + WS_SSQ2);
    for (size_t o = gt; o < (size_t)NTOK * DM / 4; o += NGT) {
        const size_t n = o >> 8; const int c4 = (int)(o & 255);
        const float rs = 1.f / sqrtf(ssq[n] * (1.f / DM) + EPS);
        f32x4* pp = (f32x4*)P.out + o;
        *pp = *pp * ((const f32x4*)P.final_w)[c4] * rs;
    }
}

typedef long i64_t;
constexpr int MG_HALF = 8192, MG_WAVE = 2 * MG_HALF;
#define MG_WAIT(N) asm volatile("s_waitcnt vmcnt(" #N ")" ::: "memory")
struct MgMeta { i32x4 id[4]; u32x4 a0, a1; };
template <int WHICH>
DI void mg_meta(const Params& P, int n, int x, MgMeta& M) {
    const int lane = tid_() & 63, g8 = lane >> 3, kg = lane >> 4;
    const int* ip = (const int*)(P.ws + WS_EIDX) + (size_t)n * 128 + 8 * g8;
    M.id[0] = *(const i32x4*)ip; M.id[1] = *(const i32x4*)(ip + 4); M.id[2] = *(const i32x4*)(ip + 64); M.id[3] = *(const i32x4*)(ip + 68);
    if (WHICH == 1) { const unsigned char* xr = P.ws + WS_XN8 + (size_t)n * DM + 128 * x + 16 * kg; M.a0 = *(const u32x4*)xr; M.a1 = *(const u32x4*)(xr + 64); }
    else { const unsigned char* cr = P.ws + WS_C8 + (size_t)n * 128 + 8 * kg;
        const u32x2 c0 = *(const u32x2*)cr, c1 = *(const u32x2*)(cr + 32), c2 = *(const u32x2*)(cr + 64), c3 = *(const u32x2*)(cr + 96);
        M.a0 = (u32x4){c0.x, c0.y, c1.x, c1.y}; M.a1 = (u32x4){c2.x, c2.y, c3.x, c3.y}; }
}
DI void mg_issue(const unsigned char* slice, const MgMeta& M, int h, unsigned lbase) {
    const int lane = tid_() & 63, pos = lane & 7;
    const i32x4 ia = M.id[2 * h], ib = M.id[2 * h + 1];
    const int ids[8] = {ia.x, ia.y, ia.z, ia.w, ib.x, ib.y, ib.z, ib.w};
#pragma unroll
    for (int p = 0; p < 8; ++p) glds16_asm(slice + (size_t)(unsigned)ids[p] * 128 + 16 * (pos ^ p), lbase + p * 1024);
}
DI i64_t pk64(unsigned lo, unsigned hi) { return (i64_t)(((unsigned long long)hi << 32) | lo); }
DI float mg1_half(const MgMeta& M, LAS char* hb) {
    const int lane = tid_() & 63, c = lane & 15, kg = lane >> 4;
    const i64_t a0 = pk64(M.a0.x, M.a0.y), a1 = pk64(M.a0.z, M.a0.w), a2 = pk64(M.a1.x, M.a1.y), a3 = pk64(M.a1.z, M.a1.w);
    float res = 0.f;
#pragma unroll
    for (int G = 0; G < 4; ++G) {
        const LAS char* row = hb + (c & 7) * 1024 + (2 * G + (c >> 3)) * 128;
        const u32x4 b0 = *(const LAS u32x4*)(row + ((kg ^ (c & 7)) << 4)), b1 = *(const LAS u32x4*)(row + (((kg + 4) ^ (c & 7)) << 4));
        f32x4 d = (f32x4){0.f, 0.f, 0.f, 0.f};
        d = __builtin_amdgcn_mfma_f32_16x16x32_fp8_fp8(a0, pk64(b0.x, b0.y), d, 0, 0, 0);
        d = __builtin_amdgcn_mfma_f32_16x16x32_fp8_fp8(a1, pk64(b0.z, b0.w), d, 0, 0, 0);
        d = __builtin_amdgcn_mfma_f32_16x16x32_fp8_fp8(a2, pk64(b1.x, b1.y), d, 0, 0, 0);
        d = __builtin_amdgcn_mfma_f32_16x16x32_fp8_fp8(a3, pk64(b1.z, b1.w), d, 0, 0, 0);
        if (G == kg) res = d[0];
    }
    return res;
}
typedef int v2i_t __attribute__((ext_vector_type(2)));
DI void mg2_half(const MgMeta& M, int h, LAS char* hb, f32x4 (&D)[8]) {
    const int lane = tid_() & 63, c = lane & 15, kg = lane >> 4;
#pragma unroll
    for (int kbl = 0; kbl < 2; ++kbl) {
        const u32x4 av = h ? M.a1 : M.a0;
        const i64_t a = kbl ? pk64(av.z, av.w) : pk64(av.x, av.y);
        const LAS char* row = hb + (c >> 1) * 1024 + (4 * kbl + kg) * 128 + 8 * (c & 1);
#pragma unroll
        for (int nt = 0; nt < 8; ++nt) {
            const v2i_t b = __builtin_amdgcn_ds_read_tr8_b64_v2i32((LAS v2i_t*)(row + ((nt ^ (c >> 1)) << 4)));
            D[nt] = __builtin_amdgcn_mfma_f32_16x16x32_fp8_fp8(a, pk64((unsigned)b.x, (unsigned)b.y), D[nt], 0, 0, 0);
        }
    }
}
template <int WHICH>
DI void mg_group(const Params& P, const unsigned char* slice, int n0, int x, LAS char* wl, unsigned wl_off, const MgMeta (&M)[4], MgMeta (&Mn)[4], bool more) {
    const int lane = tid_() & 63, kg = lane >> 4, c = lane & 15;
    float* outp = (float*)(P.ws + WS_HIDP) + (size_t)x * NTOK * 128;
    f32x4 D[8];
    mg_issue(slice, M[0], 0, wl_off); SB();
#define MG_STEP(h, WAITSTMT) do { \
        if ((h) + 1 < 8) { mg_issue(slice, M[((h) + 1) >> 1], ((h) + 1) & 1, wl_off + (((h) + 1) & 1) * MG_HALF); } \
        else if (more) { _Pragma("unroll") for (int q_ = 0; q_ < 4; ++q_) mg_meta<WHICH>(P, n0 + 8 * (4 + q_), x, Mn[q_]); } \
        SB(); WAITSTMT; SB(); \
        LAS char* hb_ = wl + ((h) & 1) * MG_HALF; const int n_ = n0 + 8 * ((h) >> 1); \
        if (WHICH == 1) { const float r_ = mg1_half(M[(h) >> 1], hb_); outp[(size_t)n_ * 128 + 64 * ((h) & 1) + lane] = r_; } \
        else { if (((h) & 1) == 0) { _Pragma("unroll") for (int q_ = 0; q_ < 8; ++q_) D[q_] = (f32x4){0.f, 0.f, 0.f, 0.f}; } \
            mg2_half(M[(h) >> 1], (h) & 1, hb_, D); \
            if ((h) & 1) { float v0_ = 0.f, v1_ = 0.f; _Pragma("unroll") for (int q_ = 0; q_ < 4; ++q_) { if (kg == q_) { v0_ = D[2 * q_][0]; v1_ = D[2 * q_ + 1][0]; } } \
                outp[(size_t)n_ * 128 + 32 * kg + c] = v0_; outp[(size_t)n_ * 128 + 32 * kg + 16 + c] = v1_; } } \
        SB(); } while (0)
    if (WHICH == 1) {
        MG_STEP(0, MG_WAIT(8)); MG_STEP(1, MG_WAIT(9)); MG_STEP(2, MG_WAIT(9)); MG_STEP(3, MG_WAIT(9)); MG_STEP(4, MG_WAIT(9)); MG_STEP(5, MG_WAIT(9)); MG_STEP(6, MG_WAIT(9));
        if (more) { MG_STEP(7, MG_WAIT(25)); } else { MG_STEP(7, MG_WAIT(1)); }
    } else {
        MG_STEP(0, MG_WAIT(8)); MG_STEP(1, MG_WAIT(8)); MG_STEP(2, MG_WAIT(10)); MG_STEP(3, MG_WAIT(8)); MG_STEP(4, MG_WAIT(10)); MG_STEP(5, MG_WAIT(8)); MG_STEP(6, MG_WAIT(10));
        if (more) { MG_STEP(7, MG_WAIT(32)); } else { MG_STEP(7, MG_WAIT(0)); }
    }
#undef MG_STEP
}
template <int WHICH>
DI void mg_phase(const Params& P, char* lds_g) {
    const int tid = tid_(), wave = __builtin_amdgcn_readfirstlane(tid >> 6);
    unsigned* ctr = (unsigned*)(P.ws + WS_CTL) + (WHICH == 1 ? CTL_G1 : CTL_G2);
    const int x0 = (int)my_xcc_id();
    LAS int* slot = (LAS int*)((LAS char*)lds_g + LDS_ITEM);
    LAS char* wl = (LAS char*)lds_g + wave * MG_WAVE;
    const unsigned wl_off = (unsigned)__builtin_amdgcn_readfirstlane((int)(unsigned)(size_t)wl);
    for (int s = 0; s < 8; ++s) {
        const int x = (x0 + s) & 7;
        const unsigned char* slice = P.ws + (WHICH == 1 ? WS_UB : WS_VB) + (size_t)x * ((size_t)NEXP * 128);
        for (;;) {
            if (tid == 0) *slot = (int)atomicAdd(ctr + x, 1u);
            __syncthreads();
            const int chunk = *slot;
            __syncthreads();
            if (chunk >= NTOK / SL_CHUNK) break;
            const int nb = chunk * SL_CHUNK + wave;
            MgMeta MA[4], MB[4];
#pragma unroll
            for (int q = 0; q < 4; ++q) mg_meta<WHICH>(P, nb + 8 * q, x, MA[q]);
            mg_group<WHICH>(P, slice, nb, x, wl, wl_off, MA, MB, true);
            mg_group<WHICH>(P, slice, nb + 32, x, wl, wl_off, MB, MA, true);
            mg_group<WHICH>(P, slice, nb + 64, x, wl, wl_off, MA, MB, true);
            mg_group<WHICH>(P, slice, nb + 96, x, wl, wl_off, MB, MA, false);
            MG_WAIT(0);
        }
    }
}
DI void hid_reduce8_phase(const Params& P, int bid, int nblk) {
    const int tid = tid_(), lane = tid & 63, wave = __builtin_amdgcn_readfirstlane(tid >> 6);
    unsigned char* ws = P.ws;
    const int gw = bid * NWAVES + wave, NGW = nblk * NWAVES;
    const float* hp = (const float*)(ws + WS_HIDP);
    for (int n = gw; n < NTOK; n += NGW) {
        const float xs = ((const float*)(ws + WS_XSC))[n];
        float cv[2]; float am = 0.f;
#pragma unroll
        for (int q = 0; q < 2; ++q) {
            const size_t o = (size_t)n * 128 + 64 * q + lane; float a = 0.f;
#pragma unroll
            for (int x = 0; x < 8; ++x) a += hp[(size_t)x * NTOK * 128 + o];
            const int e = ((const int*)(ws + WS_EIDX))[o];
            cv[q] = gelu_exact(a * ((const float*)(ws + WS_USC))[e] * xs) * ((const float*)(ws + WS_EGATE))[o] * ((const float*)(ws + WS_VSC))[e];
            am = fmaxf(am, fabsf(cv[q]));
        }
        am = row16_max(am); am = fmaxf(fmaxf(readlane_f(am, 0), readlane_f(am, 16)), fmaxf(readlane_f(am, 32), readlane_f(am, 48)));
        const float sc = (am > 0.f) ? exp2f(floorf(log2f(224.f / am))) : 1.f;
        const int w0 = __builtin_amdgcn_cvt_pk_fp8_f32(cv[0] * sc, cv[1] * sc, 0, false);
        ws[WS_C8 + (size_t)n * 128 + lane] = (unsigned char)(w0 & 255); ws[WS_C8 + (size_t)n * 128 + 64 + lane] = (unsigned char)((w0 >> 8) & 255);
        if (lane == 0) ((float*)(ws + WS_CSC))[n] = 1.f / sc;
    }
}
DI void final_norm8_phase(const Params& P, int bid, int nblk) {
    const int tid = tid_(), lane = tid & 63, wave = __builtin_amdgcn_readfirstlane(tid >> 6);
    const unsigned char* ws = P.ws;
    const int gw = bid * NWAVES + wave, NGW = nblk * NWAVES;
    f32x4 wv[4];
#pragma unroll
    for (int q = 0; q < 4; ++q) wv[q] = *(const f32x4*)(P.final_w + 16 * lane + 4 * q);
    for (int n = gw; n < NTOK; n += NGW) {
        float* orow = P.out + (size_t)n * DM + 16 * lane;
        const float* yrow = (const float*)(ws + WS_HIDP) + ((size_t)(lane >> 3) * NTOK + n) * 128 + 16 * (lane & 7);
        const float cs = ((const float*)(ws + WS_CSC))[n];
        const bf16_t* hrow = (const bf16_t*)(ws + WS_XB) + (size_t)n * DM + 16 * lane;
        const u32x4 ha = *(const u32x4*)hrow, hb = *(const u32x4*)(hrow + 8);
        const unsigned hu[8] = {ha.x, ha.y, ha.z, ha.w, hb.x, hb.y, hb.z, hb.w};
        f32x4 h[4]; float ss = 0.f;
#pragma unroll
        for (int q = 0; q < 4; ++q) { h[q] = (f32x4){bf2f(hu[2 * q] & 0xffffu), bf2f(hu[2 * q] >> 16), bf2f(hu[2 * q + 1] & 0xffffu), bf2f(hu[2 * q + 1] >> 16)} + *(const f32x4*)(yrow + 4 * q) * cs; ss += (h[q].x * h[q].x + h[q].y * h[q].y) + (h[q].z * h[q].z + h[q].w * h[q].w); }
        ss = wave_sum_dpp(ss);
        const float rs = 1.f / sqrtf(ss * (1.f / DM) + EPS);
#pragma unroll
        for (int q = 0; q < 4; ++q) *(f32x4*)(orow + 4 * q) = h[q] * wv[q] * rs;
    }
}

#define XB_TMO      128
#define XB_XCNT(j)  (256  + 64 * (j))
#define XB_XSUB(j)  (1280 + 64 * (j))
#define XB_XGEN(j)  (2304 + 64 * (j))
#define XB_TOP      3328
#define XB_TOPGEN   3392
#define XCD_BAR_WORDS 3456
#define XB_SPIN_CAP (1u << 18)

__device__ __forceinline__ unsigned xb_ld(unsigned* p)              { return __hip_atomic_load(p, __ATOMIC_RELAXED, __HIP_MEMORY_SCOPE_AGENT); }
__device__ __forceinline__ unsigned xb_add(unsigned* p, unsigned v) { return __hip_atomic_fetch_add(p, v, __ATOMIC_RELAXED, __HIP_MEMORY_SCOPE_AGENT); }
__device__ __forceinline__ unsigned xb_xcc_id() { return (unsigned)__builtin_amdgcn_s_getreg((3 << 11) | 20) & 0xFu; }
#define XB_SPIN(cond, bar) do { unsigned _sp = 0; while (cond) { __builtin_amdgcn_s_sleep(1); \
    if ((++_sp & 255u) == 0u) { if (xb_ld(&(bar)[XB_TMO])) break; if (_sp > XB_SPIN_CAP) { atomicAdd(&(bar)[XB_TMO], 1u); break; } } } } while (0)

struct XcdBarrier {
    unsigned* bar; unsigned x;
    volatile LAS unsigned* st;
};

__device__ __forceinline__ XcdBarrier xcd_barrier_post(unsigned* bar, volatile LAS unsigned* st) {
    XcdBarrier b; b.bar = bar; b.x = xb_xcc_id(); b.st = st;
    if (threadIdx.x == 0) (void)xb_add(&bar[XB_XCNT(b.x)], 1u);
    return b;
}
__device__ __forceinline__ void xcd_barrier_complete(unsigned* bar, unsigned x, unsigned& nloc, unsigned& nx) {
    const unsigned G = gridDim.x * gridDim.y * gridDim.z;
    unsigned sum, cnt, mine, sp = 0u;
    for (;;) {
        sum = 0u; cnt = 0u; mine = 0u;
#pragma unroll
        for (unsigned j = 0; j < 16; ++j) { const unsigned c = xb_ld(&bar[XB_XCNT(j)]); sum += c; cnt += (c > 0u) ? 1u : 0u; mine = (j == x) ? c : mine; }
        if (sum == G) break;
        __builtin_amdgcn_s_sleep(1);
        if ((++sp & 255u) == 0u) { if (xb_ld(&bar[XB_TMO])) break; if (sp > XB_SPIN_CAP) { atomicAdd(&bar[XB_TMO], 1u); break; } }
    }
    nloc = mine > 0u ? mine : 1u; nx = cnt > 0u ? cnt : 1u;
}

__device__ __forceinline__ void xcd_barrier(const XcdBarrier& b) {
    asm volatile("s_waitcnt vmcnt(0)" ::: "memory");
    __syncthreads();
    if (threadIdx.x == 0) {
        unsigned* bar = b.bar;
        __builtin_amdgcn_s_waitcnt(0);
        unsigned nloc = b.st[0], nx = b.st[1];
        if (nloc == 0u) { xcd_barrier_complete(bar, b.x, nloc, nx); b.st[0] = nloc; b.st[1] = nx; }
        const unsigned old = xb_add(&bar[XB_XSUB(b.x)], 1u);
        const unsigned gen = old / nloc;
        if (old + 1u == (gen + 1u) * nloc) {
            __builtin_amdgcn_fence(__ATOMIC_RELEASE, "agent");
            asm volatile("s_waitcnt vmcnt(0)" ::: "memory");
            const unsigned og = xb_add(&bar[XB_TOP], 1u);
            const unsigned tg = og / nx;
            if (og + 1u == (tg + 1u) * nx) xb_add(&bar[XB_TOPGEN], 1u);
            else XB_SPIN(xb_ld(&bar[XB_TOPGEN]) == tg, bar);
            __builtin_amdgcn_fence(__ATOMIC_ACQUIRE, "agent");
            xb_add(&bar[XB_XGEN(b.x)], 1u);
            asm volatile("s_waitcnt vmcnt(0)" ::: "memory");
        } else {
            XB_SPIN(xb_ld(&bar[XB_XGEN(b.x)]) == gen, bar);
            __builtin_amdgcn_fence(__ATOMIC_ACQUIRE, "agent");
            asm volatile("s_waitcnt vmcnt(0)" ::: "memory");
        }
    }
    __syncthreads();
}

constexpr int CTL_XB_WORD = 2048;
static_assert((CTL_XB_WORD + 3456) * 4 <= (int)CTL_BYTES, "barrier words inside CTL");
constexpr int N_HGRN_ITEMS = BATCH * 4, N_ATT_ITEMS = BATCH * 4 * 32;

DI void mixer_phase(const Params& P, char* lds) {
    unsigned* ctr = (unsigned*)(P.ws + WS_CTL);
    for (;;) {
        if (tid_() == 0) *(LAS int*)((LAS char*)lds + LDS_ITEM) = (int)atomicAdd(ctr, 1u);
        __syncthreads();
        const int item = *(LAS int*)((LAS char*)lds + LDS_ITEM);
        __syncthreads();
        if (item >= N_HGRN_ITEMS + N_ATT_ITEMS) break;
        if (item < N_HGRN_ITEMS) hgrn_unit(P, item >> 2, item & 3, lds);
        else { const int a = item - N_HGRN_ITEMS, j = 31 - (a >> 5), bh = a & 31; attn_unit(P, bh >> 2, bh & 3, j, lds); }
    }
}

#ifdef TS_PHASE
#ifndef TS_DIV
#define TS_DIV 4.0f
#endif
#define TS(i) do { if (blockIdx.x == 0 && threadIdx.x == 0) ((LAS unsigned long long*)((LAS char*)lds + LDS_BYTES - 512))[i] = __builtin_amdgcn_s_memrealtime(); } while (0)
#else
#define TS(i) do { } while (0)
#endif
__global__ void __launch_bounds__(NTHREADS, 2) fwd_megakernel(Params P) {
    extern __shared__ __attribute__((aligned(16))) char lds[];
    cg::grid_group grid = cg::this_grid();
    const int bid = blockIdx.x, nblk = gridDim.x;
    unsigned char* ws = P.ws;
    volatile LAS unsigned* xst = (volatile LAS unsigned*)((LAS char*)lds + LDS_XB);
    if (threadIdx.x < 4) xst[threadIdx.x] = 0u;
    __syncthreads();
    const XcdBarrier xbar = xcd_barrier_post((unsigned*)(ws + WS_CTL) + CTL_XB_WORD, xst);
    TS(0);
    phase0(P, lds, bid, nblk);
    grid.sync();
    TS(1);
    { Epi1 e{ws}; gemm_run(lds, (const bf16_t*)(ws + WS_XB), (const bf16_t*)(ws + WS_W1T), M1, NCOL1, DM, e, bid, nblk); }
    {
        constexpr int NUNITS = (M1 / 256) * (NCOL1 / 256);
        const int nlast = NUNITS % nblk, nfree = nlast ? nblk - nlast : nblk;
        const int wave = __builtin_amdgcn_readfirstlane(tid_() >> 6);
        if (nlast == 0 || bid >= nlast) table_fp8_rows(P, (bid - (nlast ? nlast : 0)) * NWAVES + wave, nfree * NWAVES);
    }
    xcd_barrier(xbar);
    TS(2);
    for (int it = bid; it < 32 * 129; it += nblk) hgrn_prep_item(P, it & 31, it >> 5, lds);
    xcd_barrier(xbar);
    TS(3);
    mixer_phase(P, lds);
    xcd_barrier(xbar);
    TS(4);
    { Epi3 e{P.x, P.out, (bf16_t*)(ws + WS_XB), (float*)(ws + WS_SSQ)}; gemm_run(lds, (const bf16_t*)(ws + WS_MIX), (const bf16_t*)(ws + WS_W2T), NTOK, DM, DM, e, bid, nblk); }
    xcd_barrier(xbar);
    TS(5);
    { Epi4 e{(const float*)(ws + WS_SSQ), (bf16_t*)(ws + WS_PQ)}; gemm_run(lds, (const bf16_t*)(ws + WS_XB), (const bf16_t*)(ws + WS_W3T), NTOK, 2048, DM, e, bid, nblk); }
    xcd_barrier(xbar);
    TS(6);
    topk_phase(P, lds, bid, nblk);
    xn8_rows(P, bid, nblk);
    xcd_barrier(xbar);
    TS(7);
    mg_phase<1>(P, lds);
    xcd_barrier(xbar);
    TS(8);
    hid_reduce8_phase(P, bid, nblk);
    xcd_barrier(xbar);
    TS(9);
    mg_phase<2>(P, lds);
    xcd_barrier(xbar);
    TS(10);
    final_norm8_phase(P, bid, nblk);
    TS(11);
#ifdef TS_PHASE
    if (blockIdx.x == 0 && threadIdx.x == 0) { const LAS unsigned long long* t = (const LAS unsigned long long*)((LAS char*)lds + LDS_BYTES - 512);
        P.out[0] += (float)(t[TS_PHASE + 1] - t[TS_PHASE]) * 0.01f / TS_DIV; }
#endif
}

extern "C" void kernel_launch(void* const* d_in, const int* in_sizes, int n_in, void* d_out, int out_size, void* d_ws, size_t ws_size, hipStream_t stream) {
    static int grid = 0;
    if (grid == 0) {
        int dev = 0, cus = 0, per_cu = 0;
        (void)hipGetDevice(&dev);
        (void)hipDeviceGetAttribute(&cus, hipDeviceAttributeMultiprocessorCount, dev);
        (void)hipFuncSetAttribute((const void*)fwd_megakernel, hipFuncAttributeMaxDynamicSharedMemorySize, LDS_BYTES);
        (void)hipOccupancyMaxActiveBlocksPerMultiprocessor(&per_cu, (const void*)fwd_megakernel, NTHREADS, LDS_BYTES);
        if (per_cu < 1) { fprintf(stderr, "kernel_launch: occupancy query says %d blocks per CU\n", per_cu); per_cu = 1; }
        grid = cus * 1;
        if (ws_size < WS_END) { fprintf(stderr, "kernel_launch: workspace too small: %zu < %zu\n", ws_size, (size_t)WS_END); grid = -1; }
    }
    if (grid < 0) return;
    (void)hipMemsetAsync((char*)d_ws + WS_CTL, 0, CTL_BYTES, stream);
    Params p{};
    p.x = (const float*)d_in[0]; p.meta = (const float*)d_in[1]; p.mix_norm_w = (const float*)d_in[2]; p.w_in = (const float*)d_in[3];
    p.lb_logits = (const float*)d_in[4]; p.rec_norm_w = (const float*)d_in[5]; p.lq1 = (const float*)d_in[6]; p.lk1 = (const float*)d_in[7];
    p.lq2 = (const float*)d_in[8]; p.lk2 = (const float*)d_in[9]; p.subln_w = (const float*)d_in[10]; p.w_out = (const float*)d_in[11];
    p.ffn_norm_w = (const float*)d_in[12]; p.wq = (const float*)d_in[13]; p.subkeys = (const float*)d_in[14]; p.pu = (const float*)d_in[15];
    p.pv = (const float*)d_in[16]; p.final_w = (const float*)d_in[17];
    p.out = (float*)d_out; p.ws = (unsigned char*)d_ws;
    void* args[] = {&p};
    hipError_t e = hipLaunchCooperativeKernel((const void*)fwd_megakernel, dim3(grid), dim3(NTHREADS), args, LDS_BYTES, stream);
    if (e != hipSuccess) fprintf(stderr, "cooperative launch failed: %s (grid %d)\n", hipGetErrorString(e), grid);
}
```

```cpp
#include <hip/hip_runtime.h>
#include <hip/hip_cooperative_groups.h>
#include <cstdio>
#include <cstdint>
#define DBG_SEL 1
namespace cg = cooperative_groups;

constexpr int BATCH = 8, SEQ = 4096, DM = 1024, NMETA = 16;
constexpr int NTOK = BATCH * SEQ;
constexpr int M1 = NTOK + 256;
constexpr int NCOL1 = 3584;
constexpr int TPOS = NMETA + SEQ;
constexpr int KT = 65;
constexpr int KPAD = 48;
constexpr int HT = 4128;
constexpr int NEXP = 16384;
constexpr float EPS = 1e-6f;
constexpr float LAM_INIT = 0.2f;
constexpr float QSCALE = 0.125f * 1.4426950408889634f;
constexpr int NTHREADS = 512, NWAVES = 8;
constexpr int LDS_BYTES = 163840;
constexpr int LDS_ITEM = LDS_BYTES - 64, LDS_XB = LDS_BYTES - 32;

typedef unsigned short bf16_t;
typedef short bf16x8 __attribute__((ext_vector_type(8)));
typedef float f32x4 __attribute__((ext_vector_type(4)));
typedef float f32x16 __attribute__((ext_vector_type(16)));
typedef float f32x2 __attribute__((ext_vector_type(2)));
typedef unsigned u32x4 __attribute__((ext_vector_type(4)));
typedef unsigned u32x2 __attribute__((ext_vector_type(2)));
typedef __bf16 bf16x2_t __attribute__((ext_vector_type(2)));
typedef short s16x4 __attribute__((ext_vector_type(4)));
#define LAS __attribute__((address_space(3)))
#define DI __device__ __forceinline__
__device__ __forceinline__ int tid_() { int t = threadIdx.x; asm volatile("" : "+v"(t)); return t; }

constexpr size_t al256(size_t x) { return (x + 255) & ~(size_t)255; }
constexpr size_t WS_CTL = 0, CTL_BYTES = 65536;
constexpr size_t WS_W1T = WS_CTL + CTL_BYTES;
constexpr size_t WS_W2T = WS_W1T + (size_t)NCOL1 * DM * 2;
constexpr size_t WS_W3T = WS_W2T + (size_t)DM * DM * 2;
constexpr size_t WS_SKB = WS_W3T + (size_t)2048 * DM * 2;
constexpr size_t WS_UB = WS_SKB + (size_t)16 * 128 * 128 * 2;
constexpr size_t WS_VB = WS_UB + (size_t)NEXP * DM * 2;
constexpr size_t WS_USC = WS_UB + (size_t)NEXP * DM, WS_VSC = WS_VB + (size_t)NEXP * DM;
constexpr size_t WS_ROPE = WS_VB + (size_t)NEXP * DM * 2;
constexpr size_t WS_LB = WS_ROPE + (size_t)TPOS * 64 * 4;
constexpr size_t WS_R1 = WS_LB + 4096;
constexpr size_t WS_SSQ = WS_R1 + al256((size_t)M1 * 4);
constexpr size_t WS_SSQ2 = WS_SSQ + (size_t)NTOK * 4;
constexpr size_t WS_XB = WS_SSQ2 + (size_t)NTOK * 4;
constexpr size_t WS_C = WS_XB + (size_t)M1 * DM * 2;
constexpr size_t WS_Q = WS_C;
constexpr size_t WS_K = WS_Q + (size_t)NTOK * 512 * 2;
constexpr size_t WS_V = WS_K + (size_t)BATCH * 4 * 2 * KT * 8192;
constexpr size_t WS_HQ = WS_V + (size_t)BATCH * 4 * KT * 16384;
constexpr size_t WS_HV = WS_HQ + (size_t)BATCH * 4 * HT * 128 * 2;
constexpr size_t WS_HG = WS_HV + (size_t)BATCH * 4 * HT * 128 * 2;
constexpr size_t WS_SG = WS_HG + (size_t)BATCH * 4 * HT * 128 * 4;
constexpr size_t WS_CEND = WS_SG + (size_t)NTOK * 512 * 2;
constexpr size_t WS_PQ = WS_C;
constexpr size_t WS_EIDX = WS_PQ + (size_t)NTOK * 2048 * 2;
constexpr size_t WS_EGATE = WS_EIDX + (size_t)NTOK * 128 * 4;
constexpr size_t WS_HID = WS_EGATE + (size_t)NTOK * 128 * 4;
constexpr size_t WS_XN8 = WS_HID + (size_t)NTOK * 128 * 4;
constexpr size_t WS_XSC = WS_XN8 + (size_t)NTOK * DM;
constexpr size_t WS_C8 = WS_XSC + (size_t)NTOK * 4;
constexpr size_t WS_CSC = WS_C8 + (size_t)NTOK * 128;
static_assert(WS_CSC + (size_t)NTOK * 4 <= WS_CEND, "overlay fits");
constexpr size_t WS_HIDP = WS_PQ;
constexpr size_t WS_MIX = WS_CEND;
constexpr size_t WS_HQA = WS_MIX + (size_t)NTOK * DM * 2;
constexpr size_t WS_HD = WS_HQA + (size_t)BATCH * 4 * HT * 128 * 2;
constexpr size_t WS_END = WS_HD + (size_t)BATCH * 4 * 129 * 128 * 4;
static_assert(WS_END <= (size_t)512 * 1024 * 1024, "workspace map must fit 512 MiB");

struct Params {
    const float* x; const float* meta; const float* mix_norm_w; const float* w_in; const float* lb_logits; const float* rec_norm_w;
    const float* lq1; const float* lk1; const float* lq2; const float* lk2; const float* subln_w; const float* w_out; const float* ffn_norm_w;
    const float* wq; const float* subkeys; const float* pu; const float* pv; const float* final_w;
    float* out; unsigned char* ws;
};

DI unsigned f2bf(float f) { unsigned u = __builtin_bit_cast(unsigned, f); return (u + 0x7fffu + ((u >> 16) & 1u)) >> 16; }
DI float bf2f(unsigned b) { return __builtin_bit_cast(float, b << 16); }
DI unsigned cvtpk(float lo, float hi) { f32x2 v = {lo, hi}; bf16x2_t b = __builtin_convertvector(v, bf16x2_t); return __builtin_bit_cast(unsigned, b); }
DI float wave_sum(float v) {
#pragma unroll
    for (int o = 1; o < 64; o <<= 1) v += __shfl_xor(v, o);
    return v;
}
DI float sigmoidf_(float x) { return 1.f / (1.f + __expf(-x)); }
DI float siluf_(float x) { return x * sigmoidf_(x); }

DI int sigma_col(int c) {
    if (c >= 1024) return c;
    const int cc = c & 63, a = cc >> 5, fq = (cc >> 3) & 3, n = (cc >> 2) & 1, j = cc & 3;
    return (c & ~63) + 4 * (4 * a + fq) + 32 * n + j;
}
template <bool PERMUTE>
DI void p0_transpose_item(const float* W, int K, int N, const float* scale, bf16_t* WT, LAS float* scr, int item, int lane) {
    const int nblk = N / 32, kb = item / nblk, nb = item % nblk, k0 = 64 * kb, n0 = 32 * nb;
    const int ncol = PERMUTE ? sigma_col(n0 + (lane & 31)) : n0 + (lane & 31);
#pragma unroll 8
    for (int i = 0; i < 32; ++i) { const int kk = 2 * i + (lane >> 5); float s = scale ? scale[k0 + kk] : 1.f; scr[kk * 33 + (lane & 31)] = W[(size_t)(k0 + kk) * N + ncol] * s; }
    asm volatile("s_waitcnt lgkmcnt(0)" ::: "memory");
    const int c = lane & 7;
#pragma unroll
    for (int j = 0; j < 4; ++j) { const int n = (lane >> 3) + 8 * j; const LAS float* s = scr + (8 * c) * 33 + n;
        u32x4 o; o.x = cvtpk(s[0 * 33], s[1 * 33]); o.y = cvtpk(s[2 * 33], s[3 * 33]); o.z = cvtpk(s[4 * 33], s[5 * 33]); o.w = cvtpk(s[6 * 33], s[7 * 33]);
        *(u32x4*)(WT + (size_t)(n0 + n) * K + k0 + 8 * c) = o; }
    asm volatile("s_waitcnt lgkmcnt(0)" ::: "memory");
}

DI void table_fp8_rows(const Params& P, int first, int stride) {
    const int lane = tid_() & 63;
    unsigned char* ws = P.ws;
    for (int r = first; r < 2 * NEXP; r += stride) {
        const bool isv = r >= NEXP; const int e = isv ? r - NEXP : r;
        const f32x4* src = (const f32x4*)((isv ? P.pv : P.pu) + (size_t)e * DM) + lane;
        f32x4 v[4]; float am = 0.f;
#pragma unroll
        for (int q = 0; q < 4; ++q) { v[q] = src[64 * q]; am = fmaxf(am, fmaxf(fmaxf(fabsf(v[q].x), fabsf(v[q].y)), fmaxf(fabsf(v[q].z), fabsf(v[q].w)))); }
#pragma unroll
        for (int o = 1; o < 64; o <<= 1) am = fmaxf(am, __shfl_xor(am, o));
        const float sc = (am > 0.f) ? exp2f(floorf(log2f(224.f / am))) : 1.f;
        unsigned char* dst = ws + (isv ? WS_VB : WS_UB) + (size_t)e * 128;
#pragma unroll
        for (int q = 0; q < 4; ++q) {
            int w = __builtin_amdgcn_cvt_pk_fp8_f32(v[q].x * sc, v[q].y * sc, 0, false); w = __builtin_amdgcn_cvt_pk_fp8_f32(v[q].z * sc, v[q].w * sc, w, true);
            const int col = 256 * q + 4 * lane;
            *(unsigned*)(dst + (size_t)(col >> 7) * ((size_t)NEXP * 128) + (col & 127)) = (unsigned)w;
        }
        if (lane == 0) ((float*)(ws + (isv ? WS_VSC : WS_USC)))[e] = 1.f / sc;
    }
}

DI void phase0(const Params& P, char* lds, int bid, int nblk) {
    const int tid = tid_(), lane = tid & 63, wave = __builtin_amdgcn_readfirstlane(tid >> 6);
    unsigned char* ws = P.ws;
    LAS float* scr = (LAS float*)(lds) + wave * (64 * 33);
    const int gw = bid * NWAVES + wave, NGW = nblk * NWAVES;
    constexpr int I1 = (DM / 64) * (NCOL1 / 32), I2 = (DM / 64) * (DM / 32), I3 = (DM / 64) * (2048 / 32);
    for (int it = gw; it < I1 + I2 + I3; it += NGW) {
        int r = it;
        if (r < I1) { p0_transpose_item<true>(P.w_in, DM, NCOL1, P.mix_norm_w, (bf16_t*)(ws + WS_W1T), scr, r, lane); continue; } r -= I1;
        if (r < I2) { p0_transpose_item<false>(P.w_out, DM, DM, nullptr, (bf16_t*)(ws + WS_W2T), scr, r, lane); continue; } r -= I2;
        p0_transpose_item<false>(P.wq, DM, 2048, P.ffn_norm_w, (bf16_t*)(ws + WS_W3T), scr, r, lane);
    }
    for (int m = gw; m < M1; m += NGW) {
        bf16_t* orow = (bf16_t*)(ws + WS_XB) + (size_t)m * DM;
        float* r1 = (float*)(ws + WS_R1);
        unsigned long long* o8 = (unsigned long long*)orow + lane;
        if (m >= NTOK + NMETA) { for (int j = 0; j < 4; ++j) o8[64 * j] = 0ull; if (lane == 0) r1[m] = 0.f; continue; }
        const float* xrow = (m < NTOK) ? P.x + (size_t)m * DM : P.meta + (size_t)(m - NTOK) * DM;
        const f32x4* xr = (const f32x4*)xrow + lane;
        f32x4 v[4]; float s = 0.f;
#pragma unroll
        for (int j = 0; j < 4; ++j) { v[j] = xr[64 * j]; s += (v[j].x * v[j].x + v[j].y * v[j].y) + (v[j].z * v[j].z + v[j].w * v[j].w); }
        s = wave_sum(s);
        if (lane == 0) r1[m] = 1.f / sqrtf(s * (1.f / DM) + EPS);
#pragma unroll
        for (int j = 0; j < 4; ++j) o8[64 * j] = (unsigned long long)cvtpk(v[j].x, v[j].y) | ((unsigned long long)cvtpk(v[j].z, v[j].w) << 32);
    }
    {
        const size_t gt = (size_t)bid * NTHREADS + tid, NGT = (size_t)nblk * NTHREADS;
        const size_t ns = (size_t)16 * 128 * 128 / 8;
        for (size_t e = gt; e < ns; e += NGT) {
            const f32x4 a = ((const f32x4*)P.subkeys)[2 * e], b = ((const f32x4*)P.subkeys)[2 * e + 1];
            u32x4 o; o.x = cvtpk(a.x, a.y); o.y = cvtpk(a.z, a.w); o.z = cvtpk(b.x, b.y); o.w = cvtpk(b.z, b.w);
            ((u32x4*)(ws + WS_SKB))[e] = o;
        }
        float* rope = (float*)(ws + WS_ROPE);
        for (size_t i = gt; i < (size_t)TPOS * 32; i += NGT) {
            const int t = (int)(i >> 5), f = (int)(i & 31);
            const double inv = exp2(-(double)f * (13.287712379549449 / 32.0));
            const double ang = (double)t * inv;
            rope[(size_t)t * 64 + f] = (float)cos(ang); rope[(size_t)t * 64 + 32 + f] = (float)sin(ang);
        }
        float* ssq = (float*)(ws + WS_SSQ);
        for (size_t i = gt; i < (size_t)2 * NTOK; i += NGT) ssq[i] = 0.f;
        for (size_t i = gt; i < (size_t)BATCH * 4 * 2 * 512; i += NGT) { const size_t img = i >> 9, o = i & 511; ((u32x4*)(ws + WS_K + img * KT * 8192))[o] = (u32x4){0u, 0u, 0u, 0u}; }
        for (size_t i = gt; i < (size_t)BATCH * 4 * 1024; i += NGT) { const size_t img = i >> 10, o = i & 1023; ((u32x4*)(ws + WS_V + img * KT * 16384))[o] = (u32x4){0u, 0u, 0u, 0u}; }
        for (size_t i = gt; i < (size_t)BATCH * 4 * 16 * 16; i += NGT) { const size_t bh = i >> 8, o = i & 255;
            ((u32x4*)(ws + WS_HQ + bh * HT * 256))[o] = (u32x4){0u, 0u, 0u, 0u}; ((u32x4*)(ws + WS_HV + bh * HT * 256))[o] = (u32x4){0u, 0u, 0u, 0u}; }
        for (size_t i = gt; i < (size_t)BATCH * 4 * 16 * 32; i += NGT) { const size_t bh = i >> 9, o = i & 511; ((u32x4*)(ws + WS_HG + bh * HT * 512))[o] = (u32x4){0u, 0u, 0u, 0u}; }
        float* lb = (float*)(ws + WS_LB);
        if (gt < 512) lb[gt] = sigmoidf_(P.lb_logits[gt] - P.lb_logits[512 + gt]);
        if (bid == 0 && wave == 0) {
            const float a = wave_sum(P.lq1[lane] * P.lk1[lane]), b = wave_sum(P.lq2[lane] * P.lk2[lane]);
            if (lane == 0) lb[512] = __expf(a) - __expf(b) + LAM_INIT;
        }
    }
}

namespace pg8 {
#define PG8_LAS __attribute__((address_space(3)))
typedef unsigned short bf16_t;
typedef short bf16x8 __attribute__((ext_vector_type(8)));
typedef float f32x4 __attribute__((ext_vector_type(4)));
typedef unsigned u32x4 __attribute__((ext_vector_type(4)));
constexpr int BM = 256, BK = 64, HALF = 128, HTB = HALF * BK * 2  , STAGE_BYTES = 8 * HTB, NXCD = 8, WGM = 8;

__host__ __device__ __forceinline__ int lds_byte(int r, int c) { const int st = (r >> 4) * 2 + (c >> 5), rr = r & 15, cc = c & 31, ob = rr * 64 + cc * 2; return st * 1024 + (ob ^ (((ob >> 9) & 1) << 5)); }
__host__ __device__ __forceinline__ void stage_rc(int b, int& R, int& C) { const int st = b / 1024, sb = b % 1024, swz = sb ^ (((sb >> 9) & 1) << 5); R = (st >> 1) * 16 + swz / 64; C = (st & 1) * 32 + (swz % 64) / 2; }
__host__ __device__ __forceinline__ int perm32(int rho) { const int n = rho >> 4, i = rho & 15; return 8 * (i >> 2) + 4 * n + (i & 3); }

struct Unit { int pm, pn; };
struct Gemm { const bf16_t* A; const bf16_t* Bt; int M, N, K; };

struct StaticOrder {
    int nM, nN, nwg, G, c;
    __host__ __device__ void init(int M, int N, int G_, int c_) { nM = M / BM; nN = N / BM; nwg = nM * nN; G = G_; c = c_; }
    __host__ __device__ bool next(int i, Unit& u) const {
        const long L = (long)i * G + c; if (L >= nwg) return false;
        int wgid = (int)L; { const int q = nwg / NXCD, r = nwg % NXCD, xcd = wgid % NXCD, off = wgid / NXCD; wgid = (xcd < r ? xcd * (q + 1) : r * (q + 1) + (xcd - r) * q) + off; }
        const int nig = WGM * nN, gid = wgid / nig, fm = gid * WGM, gsz = (nM - fm) < WGM ? (nM - fm) : WGM;
        u.pm = fm + ((wgid % nig) % gsz); u.pn = (wgid % nig) / gsz; return true;
    }
    __device__ __forceinline__ void a_ready(const Unit&) const {}
    __device__ __forceinline__ void done(const Unit&) const {}
};

template <class Epi, class Sched, bool ALIGN_EPI = false, bool SP2 = false>
__device__ __forceinline__ void gemm_phase(PG8_LAS unsigned char* lds, const Gemm g, const Sched& S, const Epi& E) {
    const int tid = tid_(), wid = __builtin_amdgcn_readfirstlane(tid >> 6), lane = tid & 63, wr = wid >> 2, wc = wid & 3, fr = lane & 15, fq = lane >> 4;
    const int K = g.K, nt = K / BK;
    unsigned voffA[2], voffB[2];
#pragma unroll
    for (int i = 0; i < 2; ++i) { int R, C; stage_rc(tid * 16 + i * 8192, R, C); const int Rb = Epi::PERM ? ((R & ~31) + perm32(R & 31)) : R;
        voffA[i] = (unsigned)(R * K + C) * 2u; voffB[i] = (unsigned)(Rb * K + C) * 2u; }
    const size_t kstep = (size_t)(BK * 2);
    const size_t hstep = (size_t)HALF * K * 2;
    const size_t tstep = 2 * hstep;
    const unsigned ldsw = (unsigned)wid * 1024u;
    const int aoff = lds_byte(wr * 64 + fr, fq * 8), boff = lds_byte(wc * 32 + fr, fq * 8);
#define PG8_SA(b, h) (((b) * 2 + (h)) * HTB)
#define PG8_SB(b, h) ((4 + (b) * 2 + (h)) * HTB)
#define PG8_STAGE(bufoff, gbase, voff) do { _Pragma("unroll") for (int _i = 0; _i < 2; ++_i) \
        __builtin_amdgcn_global_load_lds((const unsigned*)((const char*)(gbase) + (voff)[_i]), (PG8_LAS unsigned*)(lds + (bufoff) + ldsw + _i * 8192), 16, 0, 0); } while (0)
#define PG8_LDA(dst, b, h) do { _Pragma("unroll") for (int m = 0; m < 4; ++m) _Pragma("unroll") for (int k = 0; k < 2; ++k) dst[m][k] = *(const PG8_LAS bf16x8*)(lds + PG8_SA(b, h) + aoff + m * 2048 + k * 1024); } while (0)
#define PG8_LDB(dst, b, h) do { _Pragma("unroll") for (int n = 0; n < 2; ++n) _Pragma("unroll") for (int k = 0; k < 2; ++k) dst[n][k] = *(const PG8_LAS bf16x8*)(lds + PG8_SB(b, h) + boff + n * 2048 + k * 1024); } while (0)
#define PG8_MMA(ai, bj, At, Bt) do { __builtin_amdgcn_s_setprio(1); _Pragma("unroll") for (int m = 0; m < 4; ++m) _Pragma("unroll") for (int n = 0; n < 2; ++n) _Pragma("unroll") for (int k = 0; k < 2; ++k) \
        acc[ai][bj][m][n] = __builtin_amdgcn_mfma_f32_16x16x32_bf16(Bt[n][k], At[m][k], acc[ai][bj][m][n], 0, 0, 0); __builtin_amdgcn_s_setprio(0); } while (0)
#define PG8_WAIT_V(n) asm volatile("s_waitcnt vmcnt(" #n ")" ::: "memory")
#define PG8_WAIT_L(n) asm volatile("s_waitcnt lgkmcnt(" #n ")" ::: "memory")
#define PG8_BAR __builtin_amdgcn_s_barrier()
#define PG8_SCHED __builtin_amdgcn_sched_barrier(0)
    Unit cur, nxt; int ui = 0;
    if (!S.next(0, cur)) return;
    f32x4 acc[2][2][4][2];
#pragma unroll
    for (int a = 0; a < 2; ++a)
#pragma unroll
        for (int b = 0; b < 2; ++b)
#pragma unroll
            for (int m = 0; m < 4; ++m)
#pragma unroll
                for (int n = 0; n < 2; ++n) acc[a][b][m][n] = (f32x4){0.f, 0.f, 0.f, 0.f};
    bf16x8 At[4][2], B0[2][2], B1[2][2];
    const char* cA = (const char*)g.A + (size_t)cur.pm * tstep; const char* cB = (const char*)g.Bt + (size_t)cur.pn * tstep;
    S.a_ready(cur);
    if constexpr (SP2) {
        PG8_STAGE(PG8_SB(0, 0), cB, voffB); PG8_STAGE(PG8_SB(0, 1), cB + hstep, voffB); PG8_STAGE(PG8_SA(0, 0), cA, voffA); PG8_STAGE(PG8_SA(0, 1), cA + hstep, voffA);
        if (wr == 1) PG8_BAR;
        PG8_WAIT_V(2); PG8_BAR;
        PG8_STAGE(PG8_SB(1, 0), cB + kstep, voffB); PG8_STAGE(PG8_SA(1, 0), cA + kstep, voffA); PG8_STAGE(PG8_SB(1, 1), cB + hstep + kstep, voffB);
        PG8_WAIT_V(6); PG8_BAR;
    } else {
        PG8_STAGE(PG8_SB(0, 0), cB, voffB); PG8_STAGE(PG8_SA(0, 0), cA, voffA); PG8_STAGE(PG8_SB(0, 1), cB + hstep, voffB); PG8_STAGE(PG8_SA(0, 1), cA + hstep, voffA);
        if (wr == 1) PG8_BAR;
        PG8_WAIT_V(4); PG8_BAR;
        PG8_STAGE(PG8_SB(1, 0), cB + kstep, voffB); PG8_STAGE(PG8_SA(1, 0), cA + kstep, voffA); PG8_STAGE(PG8_SB(1, 1), cB + hstep + kstep, voffB);
        PG8_WAIT_V(6); PG8_BAR;
    }
    for (;;) {
        const bool has_next = S.next(ui + 1, nxt);
        const char* nA = has_next ? (const char*)g.A + (size_t)nxt.pm * tstep : cA; const char* nB = has_next ? (const char*)g.Bt + (size_t)nxt.pn * tstep : cB;
        for (int t = 0; t < nt; t += 2) {
            const bool last = (t == nt - 2);
            const char* a1 = cA + (size_t)(t + 1) * kstep;
            const char* a2 = last ? nA : cA + (size_t)(t + 2) * kstep; const char* b2 = last ? nB : cB + (size_t)(t + 2) * kstep;
            const char* a3 = a2 + kstep; const char* b3 = b2 + kstep;
            if (last && has_next) S.a_ready(nxt);
            if constexpr (SP2) {
            PG8_LDB(B0, 0, 0); PG8_LDB(B1, 0, 1); PG8_SCHED; PG8_LDA(At, 0, 0); PG8_STAGE(PG8_SA(1, 1), a1 + hstep, voffA);
            PG8_WAIT_V(8); PG8_WAIT_L(0); PG8_BAR; PG8_MMA(0, 0, At, B0); PG8_MMA(0, 1, At, B1); PG8_BAR; PG8_SCHED;
            PG8_LDA(At, 0, 1); PG8_STAGE(PG8_SB(0, 0), b2, voffB); PG8_STAGE(PG8_SB(0, 1), b2 + hstep, voffB); PG8_STAGE(PG8_SA(0, 0), a2, voffA);
            PG8_WAIT_V(8); PG8_WAIT_L(0); PG8_BAR; PG8_MMA(1, 0, At, B0); PG8_MMA(1, 1, At, B1); PG8_BAR; PG8_SCHED;
            PG8_LDB(B0, 1, 0); PG8_LDB(B1, 1, 1); PG8_SCHED; PG8_LDA(At, 1, 0); PG8_STAGE(PG8_SA(0, 1), a2 + hstep, voffA);
            PG8_WAIT_V(8); PG8_WAIT_L(0); PG8_BAR; PG8_MMA(0, 0, At, B0); PG8_MMA(0, 1, At, B1); PG8_BAR; PG8_SCHED;
            PG8_LDA(At, 1, 1); PG8_STAGE(PG8_SB(1, 0), b3, voffB); PG8_STAGE(PG8_SB(1, 1), b3 + hstep, voffB); PG8_STAGE(PG8_SA(1, 0), a3, voffA);
            PG8_WAIT_V(8); PG8_WAIT_L(0); PG8_BAR; PG8_MMA(1, 0, At, B0); PG8_MMA(1, 1, At, B1); PG8_BAR; PG8_SCHED;
            } else {
            PG8_LDB(B0, 0, 0); PG8_SCHED; PG8_LDA(At, 0, 0); PG8_STAGE(PG8_SA(1, 1), a1 + hstep, voffA);
            PG8_WAIT_L(8); PG8_BAR; PG8_WAIT_L(0); PG8_MMA(0, 0, At, B0); PG8_BAR; PG8_SCHED;
            PG8_LDB(B1, 0, 1); PG8_STAGE(PG8_SB(0, 0), b2, voffB);
            PG8_BAR; PG8_WAIT_L(0); PG8_MMA(0, 1, At, B1); PG8_BAR;
            PG8_LDA(At, 0, 1); PG8_STAGE(PG8_SA(0, 0), a2, voffA);
            PG8_BAR; PG8_WAIT_L(0); PG8_MMA(1, 0, At, B0); PG8_BAR; PG8_SCHED;
            PG8_STAGE(PG8_SB(0, 1), b2 + hstep, voffB);
            PG8_WAIT_V(6); PG8_BAR; PG8_MMA(1, 1, At, B1); PG8_BAR;
            PG8_LDB(B0, 1, 0); PG8_SCHED; PG8_LDA(At, 1, 0); PG8_STAGE(PG8_SA(0, 1), a2 + hstep, voffA);
            PG8_WAIT_L(8); PG8_BAR; PG8_WAIT_L(0); PG8_MMA(0, 0, At, B0); PG8_BAR; PG8_SCHED;
            PG8_LDB(B1, 1, 1); PG8_STAGE(PG8_SB(1, 0), b3, voffB);
            PG8_BAR; PG8_WAIT_L(0); PG8_MMA(0, 1, At, B1); PG8_BAR;
            PG8_LDA(At, 1, 1); PG8_STAGE(PG8_SA(1, 0), a3, voffA);
            PG8_BAR; PG8_WAIT_L(0); PG8_MMA(1, 0, At, B0); PG8_BAR; PG8_SCHED;
            PG8_STAGE(PG8_SB(1, 1), b3 + hstep, voffB);
            PG8_WAIT_V(6); PG8_BAR; PG8_MMA(1, 1, At, B1); PG8_BAR;
            }
        }
        if constexpr (ALIGN_EPI) { if (wr == 0) PG8_BAR; }
        if constexpr (!Epi::AFTER_DRAIN) { E(acc, cur, wr, wc, fr, fq); S.done(cur); }
        if (!has_next) break;
#pragma unroll
        for (int a = 0; a < 2; ++a)
#pragma unroll
            for (int b = 0; b < 2; ++b)
#pragma unroll
                for (int m = 0; m < 4; ++m)
#pragma unroll
                    for (int n = 0; n < 2; ++n) acc[a][b][m][n] = (f32x4){0.f, 0.f, 0.f, 0.f};
        cur = nxt; cA = nA; cB = nB; ++ui;
        if constexpr (ALIGN_EPI) { if (wr == 1) PG8_BAR; }
    }
    PG8_WAIT_V(0);
    if constexpr (!ALIGN_EPI) { if (wr == 0) PG8_BAR; }
    PG8_BAR;
    if constexpr (Epi::AFTER_DRAIN) { E.fused(acc, cur, wr, wc, fr, fq, lds, wid, lane); S.done(cur); }
#undef PG8_SA
#undef PG8_SB
#undef PG8_STAGE
#undef PG8_LDA
#undef PG8_LDB
#undef PG8_MMA
#undef PG8_WAIT_V
#undef PG8_WAIT_L
#undef PG8_BAR
#undef PG8_SCHED
}
}

DI u32x2 pack4(f32x4 v) { u32x2 r; r.x = cvtpk(v.x, v.y); r.y = cvtpk(v.z, v.w); return r; }
DI u32x4 pack8(f32x4 a, f32x4 b) { u32x4 r; r.x = cvtpk(a.x, a.y); r.y = cvtpk(a.z, a.w); r.z = cvtpk(b.x, b.y); r.w = cvtpk(b.z, b.w); return r; }

struct Epi1 {
    static constexpr bool PERM = true, AFTER_DRAIN = false;
    unsigned char* ws;
    DI void operator()(const f32x4 (&acc)[2][2][4][2], const pg8::Unit& u, int wr, int wc, int fr, int fq) const {
        const float* r1p = (const float*)(ws + WS_R1);
        const float* rope = (const float*)(ws + WS_ROPE);
        const float* lbp = (const float*)(ws + WS_LB);
        const int seg = u.pn >> 1;
#pragma unroll
        for (int ai = 0; ai < 2; ++ai)
#pragma unroll
            for (int m = 0; m < 4; ++m) {
                const int row = u.pm * 256 + ai * 128 + wr * 64 + m * 16 + fr;
                const bool meta = row >= NTOK;
                if (row >= NTOK + NMETA) continue;
                const float r1 = r1p[row];
                const int b = meta ? 0 : (row >> 12), t = meta ? (row - NTOK) : ((row & 4095) + NMETA);
                const int nrep = meta ? BATCH : 1;
#pragma unroll
                for (int bj = 0; bj < 2; ++bj) {
                    const int cs = (u.pn & 1) * 256 + bj * 128 + wc * 32 + 8 * fq;
                    const f32x4 v0 = acc[ai][bj][m][0] * r1, v1 = acc[ai][bj][m][1] * r1;
                    const int h = cs >> 7;
                    if (seg <= 1) {
                        const int comp = (cs >> 6) & 1, cc = cs & 63, i0 = 16 * (cc >> 5) + 4 * fq;
                        const f32x4 c4 = *(const f32x4*)(rope + (size_t)t * 64 + i0), s4 = *(const f32x4*)(rope + (size_t)t * 64 + 32 + i0);
                        f32x4 lo = v0 * c4 - v1 * s4, hi = v1 * c4 + v0 * s4;
                        if (seg == 0) {
                            if (meta) continue;
                            lo = lo * QSCALE; hi = hi * QSCALE;
                            bf16_t* qp = (bf16_t*)(ws + WS_Q) + ((size_t)(((b * 4 + h) * 2 + comp) * SEQ + (row & 4095))) * 64;
                            *(u32x2*)(qp + i0) = pack4(lo); *(u32x2*)(qp + i0 + 32) = pack4(hi);
                        } else {
                            const int pp = t + KPAD, tile = pp >> 6, key = pp & 63;
                            for (int bb = 0; bb < nrep; ++bb) {
                                const int b_ = meta ? bb : b;
                                unsigned char* img = ws + WS_K + ((size_t)((b_ * 4 + h) * 2 + comp) * KT + tile) * 8192;
                                *(u32x2*)(img + (i0 >> 3) * 1024 + key * 16 + (i0 & 7) * 2) = pack4(lo);
                                *(u32x2*)(img + ((i0 >> 3) + 4) * 1024 + key * 16 + (i0 & 7) * 2) = pack4(hi);
                            }
                        }
                    } else if (seg == 2) {
                        const int dv = cs & 127, pp = t + KPAD, tile = pp >> 6, key = pp & 63;
                        const u32x4 w = pack8(v0, v1);
                        for (int bb = 0; bb < nrep; ++bb) {
                            const int b_ = meta ? bb : b;
                            unsigned char* img = ws + WS_V + ((size_t)(b_ * 4 + h) * KT + tile) * 16384;
                            *(u32x4*)(img + (dv >> 5) * 4096 + key * 64 + (dv & 31) * 2) = w;
                        }
                    } else if (seg == 3 || seg == 5) {
                        const int dv = cs & 127;
                        f32x4 a = v0, c = v1;
                        if (seg == 3) { a.x = siluf_(a.x); a.y = siluf_(a.y); a.z = siluf_(a.z); a.w = siluf_(a.w); c.x = siluf_(c.x); c.y = siluf_(c.y); c.z = siluf_(c.z); c.w = siluf_(c.w); }
                        const u32x4 w = pack8(a, c);
                        const size_t base = (seg == 3) ? WS_HQ : WS_HV;
                        for (int bb = 0; bb < nrep; ++bb) {
                            const int b_ = meta ? bb : b;
                            *(u32x4*)((bf16_t*)(ws + base) + ((size_t)(b_ * 4 + h) * HT + t + 16) * 128 + dv) = w;
                        }
                    } else if (seg == 4) {
                        const int dv = cs & 127;
                        const f32x4 l0 = *(const f32x4*)(lbp + cs), l1 = *(const f32x4*)(lbp + cs + 4);
                        f32x4 g0, g1;
#pragma unroll
                        for (int e = 0; e < 4; ++e) { g0[e] = __logf(l0[e] + (1.f - l0[e]) * sigmoidf_(v0[e])); g1[e] = __logf(l1[e] + (1.f - l1[e]) * sigmoidf_(v1[e])); }
                        for (int bb = 0; bb < nrep; ++bb) {
                            const int b_ = meta ? bb : b;
                            float* gp = (float*)(ws + WS_HG) + ((size_t)(b_ * 4 + h) * HT + t + 16) * 128 + dv;
                            *(f32x4*)gp = g0; *(f32x4*)(gp + 4) = g1;
                        }
                    } else {
                        if (meta) continue;
                        f32x4 a = v0, c = v1;
                        a.x = siluf_(a.x); a.y = siluf_(a.y); a.z = siluf_(a.z); a.w = siluf_(a.w); c.x = siluf_(c.x); c.y = siluf_(c.y); c.z = siluf_(c.z); c.w = siluf_(c.w);
                        *(u32x4*)((bf16_t*)(ws + WS_SG) + (size_t)row * 512 + cs) = pack8(a, c);
                    }
                }
            }
    }
};

struct Epi3 {
    static constexpr bool PERM = true, AFTER_DRAIN = false;
    const float* x; float* H; bf16_t* HB; float* ssq;
    DI void operator()(const f32x4 (&acc)[2][2][4][2], const pg8::Unit& u, int wr, int wc, int fr, int fq) const {
#pragma unroll
        for (int ai = 0; ai < 2; ++ai)
#pragma unroll
            for (int m = 0; m < 4; ++m) {
                const int row = u.pm * 256 + ai * 128 + wr * 64 + m * 16 + fr;
                float s = 0.f;
#pragma unroll
                for (int bj = 0; bj < 2; ++bj) {
                    const int col = u.pn * 256 + bj * 128 + wc * 32 + 8 * fq;
                    const size_t o = (size_t)row * DM + col;
                    const u32x4 xb = *(const u32x4*)(HB + o);
                    const f32x4 x0 = (f32x4){bf2f(xb.x & 0xffffu), bf2f(xb.x >> 16), bf2f(xb.y & 0xffffu), bf2f(xb.y >> 16)}, x1 = (f32x4){bf2f(xb.z & 0xffffu), bf2f(xb.z >> 16), bf2f(xb.w & 0xffffu), bf2f(xb.w >> 16)};
                    const f32x4 h0 = x0 + acc[ai][bj][m][0], h1 = x1 + acc[ai][bj][m][1];
                    *(u32x4*)(HB + o) = pack8(h0, h1);
                    s += (h0.x * h0.x + h0.y * h0.y) + (h0.z * h0.z + h0.w * h0.w) + (h1.x * h1.x + h1.y * h1.y) + (h1.z * h1.z + h1.w * h1.w);
                }
                s += __shfl_xor(s, 16); s += __shfl_xor(s, 32);
                if (fq == 0) atomicAdd(ssq + row, s);
            }
    }
};

struct Epi4 {
    static constexpr bool PERM = true, AFTER_DRAIN = false;
    const float* ssq; bf16_t* PQ;
    DI void operator()(const f32x4 (&acc)[2][2][4][2], const pg8::Unit& u, int wr, int wc, int fr, int fq) const {
#pragma unroll
        for (int ai = 0; ai < 2; ++ai)
#pragma unroll
            for (int m = 0; m < 4; ++m) {
                const int row = u.pm * 256 + ai * 128 + wr * 64 + m * 16 + fr;
                const float r2 = 1.f / sqrtf(ssq[row] * (1.f / DM) + EPS);
#pragma unroll
                for (int bj = 0; bj < 2; ++bj) {
                    const int col = u.pn * 256 + bj * 128 + wc * 32 + 8 * fq;
                    *(u32x4*)(PQ + (size_t)row * 2048 + col) = pack8(acc[ai][bj][m][0] * r2, acc[ai][bj][m][1] * r2);
                }
            }
    }
};

template <class Epi>
DI void gemm_run(char* lds, const bf16_t* A, const bf16_t* Bt, int M, int N, int K, const Epi& E, int bid, int nblk) {
    pg8::Gemm g{A, Bt, M, N, K}; pg8::StaticOrder S; S.init(M, N, nblk, bid);
    pg8::gemm_phase<Epi, pg8::StaticOrder, true, true>((LAS unsigned char*)lds, g, S, E);
}
#define MFMA32(a, b, c) __builtin_amdgcn_mfma_f32_32x32x16_bf16(a, b, c, 0, 0, 0)
typedef short v4i16_t __attribute__((ext_vector_type(4)));
DI int crow(int r, int hi) { return (r & 3) + 8 * (r >> 2) + 4 * hi; }
DI s16x4 vtr(const LAS char* p) { return __builtin_bit_cast(s16x4, __builtin_amdgcn_ds_read_tr16_b64_v4i16((LAS v4i16_t*)p)); }
DI void glds16(const void* g, LAS char* l) { __builtin_amdgcn_global_load_lds((const unsigned*)g, (LAS unsigned*)l, 16, 0, 0); }
DI float swap_max(float m) { auto rr = __builtin_amdgcn_permlane32_swap(__float_as_uint(m), __float_as_uint(m), false, false); return fmaxf(__uint_as_float(rr[0]), __uint_as_float(rr[1])); }
DI float swap_sum(float m) { auto rr = __builtin_amdgcn_permlane32_swap(__float_as_uint(m), __float_as_uint(m), false, false); return __uint_as_float(rr[0]) + __uint_as_float(rr[1]); }
constexpr int ATT_BUF = 32768, ATT_WSF = 65536;
constexpr float ATT_THR = 8.f;

DI void attn_unit(const Params& P, int b, int h, int j, char* lds_g) {
    LAS char* lds = (LAS char*)lds_g;
    const int tid = tid_(), lane = tid & 63, r32 = lane & 31, hi = lane >> 5;
    const int wid = __builtin_amdgcn_readfirstlane(tid >> 6), comp = wid >> 2, wq = wid & 3;
    const unsigned char* ws = P.ws;
    const int bh = b * 4 + h;
    const bf16_t* Qw = (const bf16_t*)(ws + WS_Q) + ((size_t)((bh * 2 + comp) * SEQ + 128 * j + 32 * wq)) * 64;
    bf16x8 qr[4];
#pragma unroll
    for (int d0 = 0; d0 < 4; ++d0) qr[d0] = *(const bf16x8*)(Qw + r32 * 64 + d0 * 16 + hi * 8);
    const unsigned char* kimg0 = ws + WS_K + (size_t)(bh * 2) * KT * 8192 + wid * 1024 + lane * 16;
    const unsigned char* kimg1 = kimg0 + (size_t)KT * 8192;
    const unsigned char* vimg = ws + WS_V + (size_t)bh * KT * 16384 + wid * 1024 + lane * 16;
    const int NT = 2 * j + 3, my_last = (wq < 2) ? 2 * j + 1 : 2 * j + 2;
    LAS float* wsf = (LAS float*)(lds + ATT_WSF) + wid * 64;
#define ATT_ISSUE(t, s) do { LAS char* d_ = lds + (s) * ATT_BUF + wid * 1024; \
        glds16(kimg0 + (size_t)(t) * 8192, d_); glds16(kimg1 + (size_t)(t) * 8192, d_ + 8192); \
        glds16(vimg + (size_t)(t) * 16384, d_ + 16384); glds16(vimg + (size_t)(t) * 16384 + 8192, d_ + 24576); } while (0)
    f32x16 o[4];
#pragma unroll
    for (int nb = 0; nb < 4; ++nb) o[nb] = f32x16{};
    float mref = 0.f, lsum = 0.f;
    const int qpos = 64 + 128 * j + 32 * wq + r32;
    ATT_ISSUE(0, 0);
    __syncthreads();
    for (int t = 0; t < NT; ++t) {
        const int s = t & 1;
        if (t + 1 < NT) ATT_ISSUE(t + 1, s ^ 1);
        if (t <= my_last) {
            const LAS char* kp = lds + s * ATT_BUF + comp * 8192 + hi * 1024 + r32 * 16;
            f32x16 s0 = f32x16{}, s1 = f32x16{};
#pragma unroll
            for (int d0 = 0; d0 < 4; ++d0) {
                const bf16x8 k0 = *(const LAS bf16x8*)(kp + d0 * 2048), k1 = *(const LAS bf16x8*)(kp + d0 * 2048 + 512);
                s0 = MFMA32(k0, qr[d0], s0); s1 = MFMA32(k1, qr[d0], s1);
            }
            if (t == 0) {
#pragma unroll
                for (int r = 0; r < 16; ++r) { s0[r] = -INFINITY; if (32 + crow(r, hi) < KPAD) s1[r] = -INFINITY; }
            }
            if (t >= 2 * j + 1) {
                const int kb = 64 * t + 4 * hi;
#pragma unroll
                for (int r = 0; r < 16; ++r) { const int kv = kb + (r & 3) + 8 * (r >> 2); if (kv > qpos) s0[r] = -INFINITY; if (kv + 32 > qpos) s1[r] = -INFINITY; }
            }
            float rm = fmaxf(s0[0], s1[0]);
#pragma unroll
            for (int r = 1; r < 16; ++r) rm = fmaxf(rm, fmaxf(s0[r], s1[r]));
            rm = swap_max(rm);
            if (t == 0) mref = rm;
            else {
                const float grow = rm - mref;
                if (__any(grow > ATT_THR)) {
                    const float dl = fmaxf(grow, 0.f), f = __builtin_amdgcn_exp2f(-dl);
                    mref += dl; lsum *= f;
                    if (hi == 0) wsf[r32] = f;
                    asm volatile("s_waitcnt lgkmcnt(0)" ::: "memory");
#pragma unroll
                    for (int r = 0; r < 16; ++r) { const float fr_ = wsf[crow(r, hi)];
#pragma unroll
                        for (int nb = 0; nb < 4; ++nb) o[nb][r] *= fr_; }
                }
            }
            float ps = 0.f;
#pragma unroll
            for (int r = 0; r < 16; ++r) { s0[r] = __builtin_amdgcn_exp2f(s0[r] - mref); s1[r] = __builtin_amdgcn_exp2f(s1[r] - mref); ps += s0[r] + s1[r]; }
            lsum += ps;
            const LAS char* vp = lds + s * ATT_BUF + 16384 + ((lane >> 4) & 1) * 32 + (lane & 3) * 8 + (4 * hi + ((lane & 15) >> 2)) * 64;
#pragma unroll
            for (int ks = 0; ks < 4; ++ks) {
                u32x4 pw;
                if (ks < 2) { pw.x = cvtpk(s0[8 * ks], s0[8 * ks + 1]); pw.y = cvtpk(s0[8 * ks + 2], s0[8 * ks + 3]); pw.z = cvtpk(s0[8 * ks + 4], s0[8 * ks + 5]); pw.w = cvtpk(s0[8 * ks + 6], s0[8 * ks + 7]); }
                else { const int q_ = ks - 2; pw.x = cvtpk(s1[8 * q_], s1[8 * q_ + 1]); pw.y = cvtpk(s1[8 * q_ + 2], s1[8 * q_ + 3]); pw.z = cvtpk(s1[8 * q_ + 4], s1[8 * q_ + 5]); pw.w = cvtpk(s1[8 * q_ + 6], s1[8 * q_ + 7]); }
                const bf16x8 pa = __builtin_bit_cast(bf16x8, pw);
#pragma unroll
                for (int nb = 0; nb < 4; ++nb) {
                    const s16x4 vlo = vtr(vp + nb * 4096 + ks * 1024), vhi = vtr(vp + nb * 4096 + ks * 1024 + 512);
                    const bf16x8 vb = (bf16x8){vlo[0], vlo[1], vlo[2], vlo[3], vhi[0], vhi[1], vhi[2], vhi[3]};
                    o[nb] = MFMA32(pa, vb, o[nb]);
                }
            }
        }
        __syncthreads();
    }
#undef ATT_ISSUE
    lsum = swap_sum(lsum);
    if (hi == 0) wsf[r32] = lsum;
    asm volatile("s_waitcnt lgkmcnt(0)" ::: "memory");
    float rli[16];
#pragma unroll
    for (int r = 0; r < 16; ++r) rli[r] = 1.f / wsf[crow(r, hi)];
    const float lam = ((const float*)(ws + WS_LB))[512];
    LAS float* ex = (LAS float*)lds + wq * 4096;
    if (comp == 1) {
#pragma unroll
        for (int r = 0; r < 16; ++r)
#pragma unroll
            for (int nb = 0; nb < 4; ++nb) ex[(r * 4 + nb) * 64 + lane] = o[nb][r] * rli[r] * lam;
    }
    __syncthreads();
    if (comp == 0) {
        float ss[16];
#pragma unroll
        for (int r = 0; r < 16; ++r) { float a = 0.f;
#pragma unroll
            for (int nb = 0; nb < 4; ++nb) { const float v = o[nb][r] * rli[r] - ex[(r * 4 + nb) * 64 + lane]; o[nb][r] = v; a += v * v; }
            ss[r] = a; }
#pragma unroll
        for (int r = 0; r < 16; ++r) { float a = ss[r]; a += __shfl_xor(a, 1); a += __shfl_xor(a, 2); a += __shfl_xor(a, 4); a += __shfl_xor(a, 8); a += __shfl_xor(a, 16); ss[r] = (1.f - LAM_INIT) / sqrtf(a * (1.f / 128.f) + EPS); }
        bf16_t* mix = (bf16_t*)(ws + WS_MIX) + ((size_t)(b * SEQ + 128 * j + 32 * wq)) * DM + h * 128;
#pragma unroll
        for (int nb = 0; nb < 4; ++nb) { const float w = P.subln_w[32 * nb + r32];
#pragma unroll
            for (int r = 0; r < 16; ++r) mix[(size_t)crow(r, hi) * DM + 32 * nb + r32] = (bf16_t)f2bf(o[nb][r] * ss[r] * w); }
    }
    __syncthreads();
}
#define MFMA16(a, b, c) __builtin_amdgcn_mfma_f32_16x16x32_bf16(a, b, c, 0, 0, 0)
constexpr int HG_STR = 272;
constexpr int HL_QA = 0, HL_QB = HL_QA + 32 * HG_STR, HL_KB = HL_QB + 32 * HG_STR, HL_KT = HL_KB + 32 * HG_STR, HL_VV = HL_KT + 32 * HG_STR;
constexpr int HL_PS = HL_VV + 32 * HG_STR;
constexpr int HL_D = HL_PS + 4 * 128 * 4;
constexpr int HL_OUT = HL_D + 128 * 4;
constexpr int HL_END = HL_OUT + 32 * 132 * 4;

constexpr int HB_KTF = 0, HB_ATF = 8192, HB_DF = 10240;
DI void hgrn_prep_item(const Params& P, int bh, int c, char* lds_g) {
    LAS char* lds = (LAS char*)lds_g;
    const int tid = tid_(), lane = tid & 63, c16 = lane & 15, g4 = lane >> 4, ch = tid & 127, part = tid >> 7;
    const int wid = __builtin_amdgcn_readfirstlane(tid >> 6);
    const int vrow = tid >> 4, vcol = (tid & 15) * 8;
    unsigned char* ws = P.ws;
    const float* HG = (const float*)(ws + WS_HG) + (size_t)bh * HT * 128;
    const bf16_t* HQ = (const bf16_t*)(ws + WS_HQ) + (size_t)bh * HT * 128;
    const bf16_t* HV = (const bf16_t*)(ws + WS_HV) + (size_t)bh * HT * 128;
    const size_t r0 = (size_t)(32 * c + 8 * part);
    float g8[8], p8[8]; unsigned short q8[8];
    { float a = 0.f;
#pragma unroll
      for (int e = 0; e < 8; ++e) { g8[e] = HG[(r0 + e) * 128 + ch]; q8[e] = HQ[(r0 + e) * 128 + ch]; a += g8[e]; p8[e] = a; } }
    const u32x4 v16 = *(const u32x4*)(HV + ((size_t)(32 * c) + vrow) * 128 + vcol);
    ((LAS float*)(lds + HL_PS))[part * 128 + ch] = p8[7];
    __syncthreads();
    {
        const LAS float* ps = (const LAS float*)(lds + HL_PS);
        const float t0 = ps[ch], t1 = ps[128 + ch], t2 = ps[256 + ch], t3 = ps[384 + ch];
        const float off = (part > 0 ? t0 : 0.f) + (part > 1 ? t1 : 0.f) + (part > 2 ? t2 : 0.f);
        const float mid = t0 + t1, last = mid + t2 + t3;
        const float em = __expf(mid), el = __expf(last - mid);
        if (part == 0) ((LAS float*)(lds + HL_D))[ch] = __expf(last);
#pragma unroll
        for (int e = 0; e < 8; ++e) {
            const int tk = 8 * part + e;
            const float cum = off + p8[e];
            const float e1 = __expf(cum - mid), e2 = 1.f / e1;
            const float q = bf2f(q8[e]), k = 1.f - __expf(g8[e]);
            const float qb = q * e1, qa = qb * em, kb = k * e2, kt = kb * el;
            *(LAS bf16_t*)(lds + HL_QA + tk * HG_STR + ch * 2) = (bf16_t)f2bf(qa);
            *(LAS bf16_t*)(lds + HL_QB + tk * HG_STR + ch * 2) = (bf16_t)f2bf(qb);
            *(LAS bf16_t*)(lds + HL_KB + tk * HG_STR + ch * 2) = (bf16_t)f2bf(kb);
            *(LAS bf16_t*)(lds + HL_KT + tk * HG_STR + ch * 2) = (bf16_t)f2bf(kt);
        }
        *(LAS u32x4*)(lds + HL_VV + vrow * HG_STR + vcol * 2) = v16;
    }
    __syncthreads();
    unsigned char* qaf = ws + WS_HQA + ((size_t)bh * 129 + c) * 8192;
    unsigned char* hgb = ws + WS_HG + (size_t)bh * HT * 512 + (size_t)c * 16384;
    {
        const int ks = wid >> 1, nt = wid & 1;
        const LAS char* qp = lds + HL_QA + (16 * nt + c16) * HG_STR + (32 * ks + 4 * g4) * 2;
        const u32x2 lo = *(const LAS u32x2*)qp, hi2 = *(const LAS u32x2*)(qp + 32);
        *(u32x4*)(qaf + wid * 1024 + lane * 16) = (u32x4){lo.x, lo.y, hi2.x, hi2.y};
        const LAS char* kp = lds + HL_KT + (8 * g4 + (c16 >> 2)) * HG_STR + (16 * wid + 4 * (c16 & 3)) * 2;
        const s16x4 klo = vtr(kp), khi = vtr(kp + 4 * HG_STR);
        *(bf16x8*)(hgb + HB_KTF + wid * 1024 + lane * 16) = (bf16x8){klo[0], klo[1], klo[2], klo[3], khi[0], khi[1], khi[2], khi[3]};
    }
    if (wid == 0) {
        f32x4 at00 = (f32x4){0.f, 0.f, 0.f, 0.f}, at01 = at00, at11 = at00;
#pragma unroll
        for (int ks = 0; ks < 4; ++ks) {
            const bf16x8 ka0 = *(const LAS bf16x8*)(lds + HL_KB + c16 * HG_STR + (32 * ks + 8 * g4) * 2);
            const bf16x8 ka1 = *(const LAS bf16x8*)(lds + HL_KB + (16 + c16) * HG_STR + (32 * ks + 8 * g4) * 2);
            const bf16x8 qn0 = *(const LAS bf16x8*)(lds + HL_QB + c16 * HG_STR + (32 * ks + 8 * g4) * 2);
            const bf16x8 qn1 = *(const LAS bf16x8*)(lds + HL_QB + (16 + c16) * HG_STR + (32 * ks + 8 * g4) * 2);
            at00 = MFMA16(ka0, qn0, at00); at01 = MFMA16(ka0, qn1, at01); at11 = MFMA16(ka1, qn1, at11);
        }
#pragma unroll
        for (int r = 0; r < 4; ++r) { if (4 * g4 + r > c16) { at00[r] = 0.f; at11[r] = 0.f; } }
        u32x4 b0; b0.x = cvtpk(at00[0], at00[1]); b0.y = cvtpk(at00[2], at00[3]); b0.z = 0u; b0.w = 0u;
        u32x4 b1; b1.x = cvtpk(at01[0], at01[1]); b1.y = cvtpk(at01[2], at01[3]); b1.z = cvtpk(at11[0], at11[1]); b1.w = cvtpk(at11[2], at11[3]);
        *(u32x4*)(hgb + HB_ATF + lane * 16) = b0; *(u32x4*)(hgb + HB_ATF + 1024 + lane * 16) = b1;
    } else if (wid == 1 && lane < 32) {
        *(f32x4*)(hgb + HB_DF + lane * 16) = *(const LAS f32x4*)(lds + HL_D + lane * 16);
    }
    __syncthreads();
}

constexpr int RS_QAF = 0, RS_HGB = 8192, RS_V = 19456, RS_SLOT = 27648, RS_NSLOT = 5;
constexpr int RS_OUT = RS_NSLOT * RS_SLOT, RS_OUTB = 32 * 136 * 2, RS_END = RS_OUT + 2 * RS_OUTB;
static_assert(RS_END <= LDS_ITEM, "hgrn LDS map");
DI void glds16_asm(const void* g, unsigned lds_base) {
    unsigned sv; asm volatile("s_mov_b32 %0, m0\n\ts_mov_b32 m0, %2\n\ts_nop 0\n\tglobal_load_lds_dwordx4 %1, off\n\ts_mov_b32 m0, %0" : "=&s"(sv) : "v"(g), "s"(lds_base) : "memory"); }
#define HW_BAR() asm volatile("s_waitcnt lgkmcnt(0)\n\ts_barrier" ::: "memory")
DI void glds16_sb(unsigned voff, const void* sbase, unsigned lds_base) {
    unsigned sv; asm volatile("s_mov_b32 %0, m0\n\ts_mov_b32 m0, %3\n\ts_nop 0\n\tglobal_load_lds_dwordx4 %1, %2\n\ts_mov_b32 m0, %0" : "=&s"(sv) : "v"(voff), "s"(sbase), "s"(lds_base) : "memory"); }
DI void hgrn_unit(const Params& P, int b, int h, char* lds_g) {
    LAS char* lds = (LAS char*)lds_g;
    const int tid = tid_(), lane = tid & 63, c16 = lane & 15, g4 = lane >> 4;
    const int wid = __builtin_amdgcn_readfirstlane(tid >> 6);
    const unsigned char* ws = P.ws;
    const int bh = b * 4 + h;
    const unsigned lbase = (unsigned)__builtin_amdgcn_readfirstlane((int)(unsigned)(size_t)lds);
    constexpr int AHEAD = RS_NSLOT - 1;
    if (wid < 4) {
        const unsigned char* qafg = ws + WS_HQA + (size_t)bh * 129 * 8192;
        const unsigned char* hgbg = ws + WS_HG + (size_t)bh * HT * 512;
        const unsigned char* vg = ws + WS_HV + (size_t)bh * HT * 256;
        const unsigned voff = (unsigned)lane * 16u;
        auto issue = [&](int c) {
            const unsigned sb = lbase + (unsigned)((c % RS_NSLOT) * RS_SLOT);
#pragma unroll
            for (int k = 0; k < 7; ++k) {
                const int p = wid + 4 * k;
                if (p < 19) { const unsigned char* src = (p < 8) ? qafg + (size_t)c * 8192 + p * 1024 : hgbg + (size_t)c * 16384 + (p - 8) * 1024; glds16_sb(voff, src, sb + (unsigned)p * 1024u); }
                else if (p < 27) { const int r4 = 4 * (p - 19);
                    const unsigned vo = (unsigned)(lane >> 4) * 256u + (unsigned)(((lane & 15) ^ ((((r4 & 7) + (lane >> 4)) & 7) << 1)) * 16);
                    glds16_sb(vo, vg + ((size_t)(32 * c) + r4) * 256, sb + (unsigned)p * 1024u); }
            }
        };
        f32x4 S[2][8];
#pragma unroll
        for (int t = 0; t < 2; ++t)
#pragma unroll
            for (int i = 0; i < 8; ++i) S[t][i] = (f32x4){0.f, 0.f, 0.f, 0.f};
#pragma unroll
        for (int c = 0; c < AHEAD; ++c) issue(c);
        for (int c = 0; c < 129; ++c) {
            if (c + AHEAD - 1 > 128) asm volatile("s_waitcnt vmcnt(0)" ::: "memory");
            else if (wid < 3) asm volatile("s_waitcnt vmcnt(21)" ::: "memory"); else asm volatile("s_waitcnt vmcnt(18)" ::: "memory");
            HW_BAR();
            __builtin_amdgcn_sched_barrier(0);
            if (c + AHEAD < 129) issue(c + AHEAD);
            __builtin_amdgcn_sched_barrier(0);
            const LAS char* sl = lds + (c % RS_NSLOT) * RS_SLOT;
            f32x4 oacc[2][2];
#pragma unroll
            for (int t = 0; t < 2; ++t) { oacc[t][0] = (f32x4){0.f, 0.f, 0.f, 0.f}; oacc[t][1] = oacc[t][0]; }
#pragma unroll
            for (int ks = 0; ks < 4; ++ks) {
                const bf16x8 q0 = *(const LAS bf16x8*)(sl + RS_QAF + (2 * ks) * 1024 + lane * 16), q1 = *(const LAS bf16x8*)(sl + RS_QAF + (2 * ks + 1) * 1024 + lane * 16);
#pragma unroll
                for (int t = 0; t < 2; ++t) {
                    u32x4 sp; sp.x = cvtpk(S[t][2 * ks][0], S[t][2 * ks][1]); sp.y = cvtpk(S[t][2 * ks][2], S[t][2 * ks][3]); sp.z = cvtpk(S[t][2 * ks + 1][0], S[t][2 * ks + 1][1]); sp.w = cvtpk(S[t][2 * ks + 1][2], S[t][2 * ks + 1][3]);
                    const bf16x8 sf = __builtin_bit_cast(bf16x8, sp);
                    oacc[t][0] = MFMA16(sf, q0, oacc[t][0]); oacc[t][1] = MFMA16(sf, q1, oacc[t][1]);
                }
            }
            const int vq = c16 >> 2, vp4 = c16 & 3;
#define VTR(row, w_) vtr(sl + RS_V + (row) * 256 + (((2 * (w_) + (vp4 >> 1)) ^ ((((row) & 7)) << 1)) * 16) + 8 * (vp4 & 1))
            {
                const bf16x8 a0 = *(const LAS bf16x8*)(sl + RS_HGB + HB_ATF + lane * 16), a1 = *(const LAS bf16x8*)(sl + RS_HGB + HB_ATF + 1024 + lane * 16);
#pragma unroll
                for (int t = 0; t < 2; ++t) {
                    const s16x4 lo = VTR(4 * g4 + vq, 2 * wid + t), hi2 = VTR(16 + 4 * g4 + vq, 2 * wid + t);
                    const bf16x8 va = (bf16x8){lo[0], lo[1], lo[2], lo[3], hi2[0], hi2[1], hi2[2], hi2[3]};
                    oacc[t][0] = MFMA16(va, a0, oacc[t][0]); oacc[t][1] = MFMA16(va, a1, oacc[t][1]);
                }
            }
            {
                LAS char* ob = lds + RS_OUT + (c & 1) * RS_OUTB;
#pragma unroll
                for (int t = 0; t < 2; ++t)
#pragma unroll
                    for (int nt = 0; nt < 2; ++nt) { u32x2 w; w.x = cvtpk(oacc[t][nt][0], oacc[t][nt][1]); w.y = cvtpk(oacc[t][nt][2], oacc[t][nt][3]);
                        *(LAS u32x2*)(ob + ((16 * nt + c16) * 136 + 16 * (2 * wid + t) + 4 * g4) * 2) = w; }
            }
            {
                bf16x8 vb[2];
#pragma unroll
                for (int t = 0; t < 2; ++t) { const s16x4 lo = VTR(8 * g4 + vq, 2 * wid + t), hi2 = VTR(8 * g4 + 4 + vq, 2 * wid + t); vb[t] = (bf16x8){lo[0], lo[1], lo[2], lo[3], hi2[0], hi2[1], hi2[2], hi2[3]}; }
#pragma unroll
                for (int i = 0; i < 8; ++i) {
                    const f32x4 d4 = *(const LAS f32x4*)(sl + RS_HGB + HB_DF + (16 * i + 4 * g4) * 4);
                    const bf16x8 ka = *(const LAS bf16x8*)(sl + RS_HGB + HB_KTF + i * 1024 + lane * 16);
                    S[0][i] = MFMA16(ka, vb[0], S[0][i] * d4); S[1][i] = MFMA16(ka, vb[1], S[1][i] * d4);
                }
            }
#undef VTR
        }
        HW_BAR();
        HW_BAR();
    } else {
        const int tq = tid - 256, tok = tq >> 3, part = tq & 7;
        const bf16_t* sgg = (const bf16_t*)(ws + WS_SG) + ((size_t)b * SEQ + tok) * 512 + h * 128 + 16 * part;
        f32x4 nw[4];
#pragma unroll
        for (int q = 0; q < 4; ++q) nw[q] = *(const f32x4*)(P.rec_norm_w + h * 128 + 16 * part + 4 * q);
        auto epilogue = [&](int c, u32x4 s0, u32x4 s1) {
            const LAS char* ob = lds + RS_OUT + (c & 1) * RS_OUTB + (tok * 136 + 16 * part) * 2;
            const u32x4 o0 = *(const LAS u32x4*)ob, o1 = *(const LAS u32x4*)(ob + 16);
            const unsigned ou[8] = {o0.x, o0.y, o0.z, o0.w, o1.x, o1.y, o1.z, o1.w}, su[8] = {s0.x, s0.y, s0.z, s0.w, s1.x, s1.y, s1.z, s1.w};
            float v[16], ss = 0.f;
#pragma unroll
            for (int q = 0; q < 8; ++q) { v[2 * q] = bf2f(ou[q] & 0xffffu); v[2 * q + 1] = bf2f(ou[q] >> 16); ss += v[2 * q] * v[2 * q] + v[2 * q + 1] * v[2 * q + 1]; }
            ss += __shfl_xor(ss, 1); ss += __shfl_xor(ss, 2); ss += __shfl_xor(ss, 4);
            const float rs = 1.f / sqrtf(ss * (1.f / 128.f) + EPS);
            u32x4 w0, w1; unsigned wo[8];
#pragma unroll
            for (int q = 0; q < 8; ++q) wo[q] = cvtpk(v[2 * q] * rs * nw[q >> 1][(2 * q) & 3] * bf2f(su[q] & 0xffffu), v[2 * q + 1] * rs * nw[q >> 1][(2 * q + 1) & 3] * bf2f(su[q] >> 16));
            w0 = (u32x4){wo[0], wo[1], wo[2], wo[3]}; w1 = (u32x4){wo[4], wo[5], wo[6], wo[7]};
            bf16_t* mp = (bf16_t*)(ws + WS_MIX) + ((size_t)b * SEQ + 32 * (c - 1) + tok) * DM + 512 + h * 128 + 16 * part;
            *(u32x4*)mp = w0; *(u32x4*)(mp + 8) = w1;
        };
#define SG_LD(k, A, B) do { const bf16_t* p_ = sgg + (size_t)(32 * ((k) - 1)) * 512; A = *(const u32x4*)p_; B = *(const u32x4*)(p_ + 8); } while (0)
        u32x4 ga0, ga1, gb0, gb1, gc0, gc1, gd0, gd1;
        SG_LD(1, gb0, gb1); SG_LD(2, gc0, gc1); SG_LD(3, gd0, gd1);
        HW_BAR();
        HW_BAR();
        for (int k = 1; k <= 128; k += 4) {
            HW_BAR(); if (k + 3 <= 128) SG_LD(k + 3, ga0, ga1); epilogue(k, gb0, gb1);
            HW_BAR(); if (k + 4 <= 128) SG_LD(k + 4, gb0, gb1); epilogue(k + 1, gc0, gc1);
            HW_BAR(); if (k + 5 <= 128) SG_LD(k + 5, gc0, gc1); epilogue(k + 2, gd0, gd1);
            HW_BAR(); if (k + 6 <= 128) SG_LD(k + 6, gd0, gd1); epilogue(k + 3, ga0, ga1);
        }
#undef SG_LD
        HW_BAR();
    }
}
template <int CTRL> DI float dpp_f(float v) { return __builtin_bit_cast(float, __builtin_amdgcn_update_dpp(0, __builtin_bit_cast(int, v), CTRL, 0xf, 0xf, false)); }
DI float row16_max(float v) { v = fmaxf(v, dpp_f<0x128>(v)); v = fmaxf(v, dpp_f<0x124>(v)); v = fmaxf(v, dpp_f<0x122>(v)); v = fmaxf(v, dpp_f<0x121>(v)); return v; }
DI float row16_sum(float v) { v += dpp_f<0x128>(v); v += dpp_f<0x124>(v); v += dpp_f<0x122>(v); v += dpp_f<0x121>(v); return v; }
#define CE_D(a, b) do { const float hi_ = fmaxf(a, b), lo_ = fminf(a, b); a = hi_; b = lo_; } while (0)
DI void bitonic_sort16(float (&v)[16]) {
#pragma unroll
    for (int k = 2; k <= 16; k *= 2)
#pragma unroll
        for (int j = k / 2; j > 0; j /= 2)
#pragma unroll
            for (int i = 0; i < 16; ++i) { const int l = i ^ j; if (l > i) { if ((i & k) == 0) CE_D(v[i], v[l]); else CE_D(v[l], v[i]); } }
}
DI void merge_top16(float (&a)[16], const float (&b)[16]) {
#pragma unroll
    for (int i = 0; i < 16; ++i) a[i] = fmaxf(a[i], b[15 - i]);
#pragma unroll
    for (int j = 8; j > 0; j /= 2)
#pragma unroll
        for (int i = 0; i < 16; ++i) { const int l = i ^ j; if (l > i) CE_D(a[i], a[l]); }
}
DI float embed7(float v, unsigned code) { return __uint_as_float((__float_as_uint(v) & 0xFFFFFF80u) | code); }
DI float embed8(float v, unsigned code) { return __uint_as_float((__float_as_uint(v) & 0xFFFFFF00u) | code); }

DI void topk_list(const bf16_t* qp, const LAS char* skf, int lane, int hi, float (&top)[16]) {
    f32x16 acc[4];
#pragma unroll
    for (int kb = 0; kb < 4; ++kb) acc[kb] = f32x16{};
#pragma unroll
    for (int ks = 0; ks < 8; ++ks) {
        const bf16x8 qf = *(const bf16x8*)(qp + 16 * ks);
#pragma unroll
        for (int kb = 0; kb < 4; ++kb) { const bf16x8 kf = *(const LAS bf16x8*)(skf + (kb * 8 + ks) * 1024 + lane * 16); acc[kb] = MFMA32(kf, qf, acc[kb]); }
    }
    float blk[16];
#pragma unroll
    for (int kb = 0; kb < 4; ++kb) {
#pragma unroll
        for (int r = 0; r < 16; ++r) { const unsigned code = (unsigned)(32 * kb + (r & 3) + 8 * (r >> 2)) | (unsigned)(4 * hi); if (kb == 0) top[r] = embed7(acc[kb][r], code); else blk[r] = embed7(acc[kb][r], code); }
        if (kb == 0) bitonic_sort16(top); else { bitonic_sort16(blk); merge_top16(top, blk); }
    }
    float l0[16], l1[16];
#pragma unroll
    for (int r = 0; r < 16; ++r) { auto rr = __builtin_amdgcn_permlane32_swap(__float_as_uint(top[r]), __float_as_uint(top[r]), false, false); l0[r] = __uint_as_float(rr[0]); l1[r] = __uint_as_float(rr[1]); }
    merge_top16(l0, l1);
#pragma unroll
    for (int r = 0; r < 16; ++r) top[r] = l0[r];
}

DI void topk_wave_item(const Params& P, int tb, int hh, LAS char* wlds, const LAS char* skf) {
    const int lane = tid_() & 63, r32 = lane & 31, hi = lane >> 5;
    const unsigned char* ws = P.ws;
    const bf16_t* qp = (const bf16_t*)(ws + WS_PQ) + (size_t)(32 * tb + r32) * 2048 + hh * 256 + 8 * hi;
    float A[16], B[16];
    topk_list(qp, skf, lane, hi, A);
    topk_list(qp + 128, skf + 32768, lane, hi, B);
    LAS unsigned* my = (LAS unsigned*)(wlds + lane * 32);
#pragma unroll
    for (int w = 0; w < 4; ++w) {
        my[w] = (__float_as_uint(A[4 * w]) & 127u) | ((__float_as_uint(A[4 * w + 1]) & 127u) << 8) | ((__float_as_uint(A[4 * w + 2]) & 127u) << 16) | ((__float_as_uint(A[4 * w + 3]) & 127u) << 24);
        my[4 + w] = (__float_as_uint(B[4 * w]) & 127u) | ((__float_as_uint(B[4 * w + 1]) & 127u) << 8) | ((__float_as_uint(B[4 * w + 2]) & 127u) << 16) | ((__float_as_uint(B[4 * w + 3]) & 127u) << 24);
    }
#pragma unroll
    for (int r = 0; r < 16; ++r) { A[r] = __uint_as_float(__float_as_uint(A[r]) & 0xFFFFFF80u); B[r] = __uint_as_float(__float_as_uint(B[r]) & 0xFFFFFF80u); }
    float T[16], R1[16], X[16], Y[16];
#pragma unroll
    for (int j = 0; j < 16; ++j) { T[j] = embed8(A[0] + B[j], (unsigned)j); R1[j] = (j < 8) ? embed8(A[1] + B[j], (unsigned)(16 + j)) : -INFINITY; }
#define CAND(i, j) embed8(A[i] + B[j], (unsigned)(16 * (i) + (j)))
    X[0] = CAND(2, 0); X[1] = CAND(2, 1); X[2] = CAND(2, 2); X[3] = CAND(2, 3); X[4] = CAND(2, 4); X[5] = CAND(3, 0); X[6] = CAND(3, 1); X[7] = CAND(3, 2);
    X[8] = CAND(3, 3); X[9] = CAND(4, 0); X[10] = CAND(4, 1); X[11] = CAND(4, 2); X[12] = CAND(5, 0); X[13] = CAND(5, 1); X[14] = CAND(6, 0); X[15] = CAND(6, 1);
    Y[0] = CAND(7, 0); Y[1] = CAND(7, 1); Y[2] = CAND(8, 0); Y[3] = CAND(9, 0); Y[4] = CAND(10, 0); Y[5] = CAND(11, 0); Y[6] = CAND(12, 0); Y[7] = CAND(13, 0);
    Y[8] = CAND(14, 0); Y[9] = CAND(15, 0); Y[10] = -INFINITY; Y[11] = -INFINITY; Y[12] = -INFINITY; Y[13] = -INFINITY; Y[14] = -INFINITY; Y[15] = -INFINITY;
#undef CAND
    bitonic_sort16(X); bitonic_sort16(Y);
    merge_top16(T, R1); merge_top16(T, X); merge_top16(T, Y);
    asm volatile("s_waitcnt lgkmcnt(0)" ::: "memory");
    float ssum = 0.f, e[16]; int eid[16];
    const float t0 = __uint_as_float(__float_as_uint(T[0]) & 0xFFFFFF00u);
#pragma unroll
    for (int r = 0; r < 16; ++r) {
        const unsigned bits = __float_as_uint(T[r]); const unsigned code = bits & 255u;
        e[r] = __expf(__uint_as_float(bits & 0xFFFFFF00u) - t0); ssum += e[r];
        const int ka = ((const LAS unsigned char*)my)[code >> 4], kb_ = ((const LAS unsigned char*)my)[16 + (code & 15u)];
        eid[r] = ka * 128 + kb_;
    }
    const float inv = 1.f / ssum;
    const size_t o = (size_t)(32 * tb + r32) * 128 + hh * 16 + 8 * hi;
    int* ei = (int*)(ws + WS_EIDX) + o; float* eg = (float*)(ws + WS_EGATE) + o;
    typedef int i32x4 __attribute__((ext_vector_type(4)));
    i32x4 w0, w1; f32x4 g0, g1;
    const unsigned mh = 0u - (unsigned)hi;
#define SELU(a, b) ((((unsigned)(b)) & mh) | (((unsigned)(a)) & ~mh))
#pragma unroll
    for (int q = 0; q < 4; ++q) { w0[q] = (int)SELU(eid[q], eid[8 + q]); w1[q] = (int)SELU(eid[4 + q], eid[12 + q]);
        g0[q] = __uint_as_float(SELU(__float_as_uint(e[q]), __float_as_uint(e[8 + q]))) * inv; g1[q] = __uint_as_float(SELU(__float_as_uint(e[4 + q]), __float_as_uint(e[12 + q]))) * inv; }
#undef SELU
    *(i32x4*)ei = w0; *(i32x4*)(ei + 4) = w1; *(f32x4*)eg = g0; *(f32x4*)(eg + 4) = g1;
}

DI void topk_phase(const Params& P, char* lds_g, int bid, int nblk) {
    const int tid = tid_(), wave = __builtin_amdgcn_readfirstlane(tid >> 6);
    LAS char* lds = (LAS char*)lds_g;
    LAS char* wlds = lds + wave * 2048;
    LAS char* skf = lds + 16384;
    int cur_h = -1;
    for (int it = bid; it < (NTOK / 256) * 8; it += nblk) {
        const int hh = it & 7, tg = it >> 3;
        if (hh != cur_h) {
            __syncthreads();
#pragma unroll
            for (int i = 0; i < 8; ++i) {
                const int f = tid + 512 * i, l = f & 63, ks = (f >> 6) & 7, kb = (f >> 9) & 3, p = f >> 11;
                *(LAS u32x4*)(skf + f * 16) = *(const u32x4*)((const bf16_t*)(P.ws + WS_SKB) + (size_t)((hh * 2 + p) * 128 + 32 * kb + (l & 31)) * 128 + 16 * ks + 8 * (l >> 5));
            }
            __syncthreads();
            cur_h = hh;
        }
        topk_wave_item(P, tg * 8 + wave, hh, wlds, skf);
    }
}

DI float gelu_exact(float x) { return 0.5f * x * (1.f + erff(x * 0.70710678118654752f)); }
typedef __bf16 bf16x8_t __attribute__((ext_vector_type(8)));
DI float dot8(u32x4 a, u32x4 x, float acc) {
    const bf16x8_t a8 = __builtin_bit_cast(bf16x8_t, a), x8 = __builtin_bit_cast(bf16x8_t, x);
    acc = __builtin_amdgcn_fdot2_f32_bf16(__builtin_shufflevector(a8, a8, 0, 1), __builtin_shufflevector(x8, x8, 0, 1), acc, false);
    acc = __builtin_amdgcn_fdot2_f32_bf16(__builtin_shufflevector(a8, a8, 2, 3), __builtin_shufflevector(x8, x8, 2, 3), acc, false);
    acc = __builtin_amdgcn_fdot2_f32_bf16(__builtin_shufflevector(a8, a8, 4, 5), __builtin_shufflevector(x8, x8, 4, 5), acc, false);
    acc = __builtin_amdgcn_fdot2_f32_bf16(__builtin_shufflevector(a8, a8, 6, 7), __builtin_shufflevector(x8, x8, 6, 7), acc, false);
    return acc;
}
DI float readlane_f(float v, int l) { return __builtin_bit_cast(float, __builtin_amdgcn_readlane(__builtin_bit_cast(int, v), l)); }
DI float wave_sum_dpp(float v) {
    v = row16_sum(v);
    return (readlane_f(v, 0) + readlane_f(v, 16)) + (readlane_f(v, 32) + readlane_f(v, 48));
}

DI float dot16_fp8(u32x4 w, const f32x2 (&x)[8]) {
    f32x2 acc = __builtin_amdgcn_cvt_pk_f32_fp8((int)w.x, false) * x[0];
    acc = __builtin_amdgcn_cvt_pk_f32_fp8((int)w.x, true) * x[1] + acc;
    acc = __builtin_amdgcn_cvt_pk_f32_fp8((int)w.y, false) * x[2] + acc;
    acc = __builtin_amdgcn_cvt_pk_f32_fp8((int)w.y, true) * x[3] + acc;
    acc = __builtin_amdgcn_cvt_pk_f32_fp8((int)w.z, false) * x[4] + acc;
    acc = __builtin_amdgcn_cvt_pk_f32_fp8((int)w.z, true) * x[5] + acc;
    acc = __builtin_amdgcn_cvt_pk_f32_fp8((int)w.w, false) * x[6] + acc;
    acc = __builtin_amdgcn_cvt_pk_f32_fp8((int)w.w, true) * x[7] + acc;
    return acc.x + acc.y;
}
DI void peer_hid_phase(const Params& P, int bid, int nblk) {
    const int tid = tid_(), lane = tid & 63, wave = __builtin_amdgcn_readfirstlane(tid >> 6);
    const unsigned char* ws = P.ws;
    const unsigned char* U8 = ws + WS_UB; const float* USC = (const float*)(ws + WS_USC);
    const int gw = bid * NWAVES + wave, NGW = nblk * NWAVES;
    f32x4 wv[4];
#pragma unroll
    for (int q = 0; q < 4; ++q) wv[q] = *(const f32x4*)(P.ffn_norm_w + 16 * lane + 4 * q);
    for (int n = gw; n < NTOK; n += NGW) {
        const float* hrow = P.out + (size_t)n * DM + 16 * lane;
        f32x4 h[4]; float ss = 0.f;
#pragma unroll
        for (int q = 0; q < 4; ++q) { h[q] = *(const f32x4*)(hrow + 4 * q); ss += (h[q].x * h[q].x + h[q].y * h[q].y) + (h[q].z * h[q].z + h[q].w * h[q].w); }
        ss = wave_sum_dpp(ss);
        const float r2 = 1.f / sqrtf(ss * (1.f / DM) + EPS);
        f32x2 x[8];
#pragma unroll
        for (int q = 0; q < 4; ++q) { const f32x4 t = h[q] * wv[q] * r2; x[2 * q] = (f32x2){t.x, t.y}; x[2 * q + 1] = (f32x2){t.z, t.w}; }
        const int* eidx = (const int*)(ws + WS_EIDX) + (size_t)n * 128;
        const float* egate = (const float*)(ws + WS_EGATE) + (size_t)n * 128;
        const int id0 = eidx[lane], id1 = eidx[64 + lane];
        float hid0 = 0.f, hid1 = 0.f;
#pragma unroll 1
        for (int k0 = 0; k0 < 128; k0 += 16) {
            u32x4 ra[16]; float sc[16];
#pragma unroll
            for (int e = 0; e < 16; ++e) {
                const int k = k0 + e;
                const int id = (k0 < 64) ? __builtin_amdgcn_readlane(id0, k & 63) : __builtin_amdgcn_readlane(id1, k & 63);
                ra[e] = *(const u32x4*)(U8 + (size_t)id * DM + 16 * lane); sc[e] = USC[id];
            }
#pragma unroll
            for (int e = 0; e < 16; ++e) {
                const int k = k0 + e;
                const float d = wave_sum_dpp(dot16_fp8(ra[e], x)) * sc[e];
                if (k0 < 64) { if (lane == (k & 63)) hid0 = d; } else { if (lane == (k & 63)) hid1 = d; }
            }
        }
        float* hid = (float*)(ws + WS_HID) + (size_t)n * 128;
        hid[lane] = gelu_exact(hid0) * egate[lane];
        hid[64 + lane] = gelu_exact(hid1) * egate[64 + lane];
    }
}

DI void peer_out_phase(const Params& P, int bid, int nblk) {
    const int tid = tid_(), lane = tid & 63, wave = __builtin_amdgcn_readfirstlane(tid >> 6);
    const unsigned char* ws = P.ws;
    const unsigned char* V8 = ws + WS_VB; const float* VSC = (const float*)(ws + WS_VSC);
    const int gw = bid * NWAVES + wave, NGW = nblk * NWAVES;
    f32x4 wv[4];
#pragma unroll
    for (int q = 0; q < 4; ++q) wv[q] = *(const f32x4*)(P.final_w + 16 * lane + 4 * q);
    for (int n = gw; n < NTOK; n += NGW) {
        const int* eidx = (const int*)(ws + WS_EIDX) + (size_t)n * 128;
        const float* hid = (const float*)(ws + WS_HID) + (size_t)n * 128;
        const int id0 = eidx[lane], id1 = eidx[64 + lane];
        const float c0 = hid[lane], c1 = hid[64 + lane];
        f32x2 acc[8];
#pragma unroll
        for (int i = 0; i < 8; ++i) acc[i] = (f32x2){0.f, 0.f};
#pragma unroll 1
        for (int k0 = 0; k0 < 128; k0 += 16) {
            u32x4 ra[16]; float cf[16];
#pragma unroll
            for (int e = 0; e < 16; ++e) {
                const int k = k0 + e;
                const int id = (k0 < 64) ? __builtin_amdgcn_readlane(id0, k & 63) : __builtin_amdgcn_readlane(id1, k & 63);
                cf[e] = ((k0 < 64) ? readlane_f(c0, k & 63) : readlane_f(c1, k & 63)) * VSC[id];
                ra[e] = *(const u32x4*)(V8 + (size_t)id * DM + 16 * lane);
            }
#pragma unroll
            for (int e = 0; e < 16; ++e) {
                const f32x2 c = (f32x2){cf[e], cf[e]}; const u32x4 w = ra[e];
                acc[0] = __builtin_amdgcn_cvt_pk_f32_fp8((int)w.x, false) * c + acc[0]; acc[1] = __builtin_amdgcn_cvt_pk_f32_fp8((int)w.x, true) * c + acc[1];
                acc[2] = __builtin_amdgcn_cvt_pk_f32_fp8((int)w.y, false) * c + acc[2]; acc[3] = __builtin_amdgcn_cvt_pk_f32_fp8((int)w.y, true) * c + acc[3];
                acc[4] = __builtin_amdgcn_cvt_pk_f32_fp8((int)w.z, false) * c + acc[4]; acc[5] = __builtin_amdgcn_cvt_pk_f32_fp8((int)w.z, true) * c + acc[5];
                acc[6] = __builtin_amdgcn_cvt_pk_f32_fp8((int)w.w, false) * c + acc[6]; acc[7] = __builtin_amdgcn_cvt_pk_f32_fp8((int)w.w, true) * c + acc[7];
            }
        }
        float* orow = P.out + (size_t)n * DM + 16 * lane;
        f32x4 h[4]; float ss = 0.f;
#pragma unroll
        for (int q = 0; q < 4; ++q) { h[q] = *(const f32x4*)(orow + 4 * q) + (f32x4){acc[2 * q].x, acc[2 * q].y, acc[2 * q + 1].x, acc[2 * q + 1].y}; ss += (h[q].x * h[q].x + h[q].y * h[q].y) + (h[q].z * h[q].z + h[q].w * h[q].w); }
        ss = wave_sum_dpp(ss);
        const float rs = 1.f / sqrtf(ss * (1.f / DM) + EPS);
#pragma unroll
        for (int q = 0; q < 4; ++q) *(f32x4*)(orow + 4 * q) = h[q] * wv[q] * rs;
    }
}

#ifdef DBG_CHECK
DI void dbg_max(float* slot, float v) { atomicMax((unsigned*)slot, __float_as_uint(fmaxf(v, 0.f))); }
DI void dbg_check_topk(const Params& P, char* lds_g, int bid, int nblk) {
    LAS char* lds = (LAS char*)lds_g;
    const int tid = tid_(), lane = tid & 63, wave = __builtin_amdgcn_readfirstlane(tid >> 6);
    const unsigned char* ws = P.ws; float* dbg = (float*)(ws + WS_CTL) + 64;
    LAS float* sc = (LAS float*)(lds) + wave * 1024;
    const int gw = bid * NWAVES + wave;
    const int token = (gw * 37) % NTOK, hh = gw & 7;
    for (int p = 0; p < 2; ++p) for (int kk = 0; kk < 2; ++kk) {
        const int key = lane + 64 * kk; float a = 0.f;
        const bf16_t* q = (const bf16_t*)(ws + WS_PQ) + (size_t)token * 2048 + hh * 256 + p * 128;
        const bf16_t* sk = (const bf16_t*)(ws + WS_SKB) + (size_t)((hh * 2 + p) * 128 + key) * 128;
        for (int c = 0; c < 128; ++c) a += bf2f(q[c]) * bf2f(sk[c]);
        sc[p * 128 + key] = a;
    }
    asm volatile("s_waitcnt lgkmcnt(0)" ::: "memory");
    for (int p = 0; p < 2; ++p) for (int kk = 0; kk < 2; ++kk) {
        const int key = lane + 64 * kk; const float v = sc[p * 128 + key]; int rank = 0;
        for (int o = 0; o < 128; ++o) { const float w = sc[p * 128 + o]; rank += (w > v || (w == v && o < key)) ? 1 : 0; }
        if (rank < 16) { sc[256 + p * 16 + rank] = v; sc[288 + p * 16 + rank] = __int_as_float(key); }
    }
    asm volatile("s_waitcnt lgkmcnt(0)" ::: "memory");
    for (int e = 0; e < 4; ++e) {
        const int c = lane * 4 + e, i = c >> 4, j = c & 15; const float v = sc[256 + i] + sc[272 + j]; int rank = 0;
        for (int o = 0; o < 256; ++o) { const float w = sc[256 + (o >> 4)] + sc[272 + (o & 15)]; rank += (w > v || (w == v && o < c)) ? 1 : 0; }
        if (rank < 16) { sc[320 + rank] = __int_as_float(__float_as_int(sc[288 + i]) * 128 + __float_as_int(sc[304 + j])); sc[336 + rank] = v; }
    }
    asm volatile("s_waitcnt lgkmcnt(0)" ::: "memory");
    if (lane < 16) {
        const int eid = __float_as_int(sc[320 + lane]); const float sv = sc[336 + lane];
        float mx = sc[336], sum = 0.f; for (int o = 0; o < 16; ++o) sum += __expf(sc[336 + o] - mx);
        const float gate = __expf(sv - mx) / sum;
        const int* eidx = (const int*)(ws + WS_EIDX) + (size_t)token * 128 + hh * 16; const float* eg = (const float*)(ws + WS_EGATE) + (size_t)token * 128 + hh * 16;
        int found = -1; for (int o = 0; o < 16; ++o) if (eidx[o] == eid) found = o;
        if (found < 0) atomicAdd(dbg + 0, 1.f); else dbg_max(dbg + 1, fabsf(eg[found] - gate));
    }
    if (lane == 0) atomicAdd(dbg + 2, 16.f);
}
DI void dbg_check_hid(const Params& P, int bid, int nblk) {
    const int tid = tid_(), lane = tid & 63, wave = __builtin_amdgcn_readfirstlane(tid >> 6);
    const unsigned char* ws = P.ws; float* dbg = (float*)(ws + WS_CTL) + 64;
    const int gw = bid * NWAVES + wave; const int token = (gw * 53) % NTOK;
    const float* hrow = P.out + (size_t)token * DM;
    float ss = 0.f; for (int c = lane; c < DM; c += 64) ss += hrow[c] * hrow[c];
    ss = wave_sum(ss); const float r2 = 1.f / sqrtf(ss / DM + EPS);
    for (int kk = 0; kk < 2; ++kk) {
        const int k = lane + 64 * kk; const int eid = ((const int*)(ws + WS_EIDX))[(size_t)token * 128 + k];
        const float* urow = P.pu + (size_t)eid * DM; float d = 0.f;
        for (int c = 0; c < DM; ++c) d += urow[c] * (hrow[c] * r2 * P.ffn_norm_w[c]);
        const float hidv = gelu_exact(d) * ((const float*)(ws + WS_EGATE))[(size_t)token * 128 + k];
        const float got = ((const float*)(ws + WS_HID))[(size_t)token * 128 + k];
        dbg_max(dbg + 3, fabsf(got - hidv)); dbg_max(dbg + 4, fabsf(hidv));
    }
}
DI float dbg_enc(float m) { return 8.f + log10f(fmaxf(m, 1e-8f)); }
#endif

#ifdef DBG_CHECK
DI void dbg_check_attn(const Params& P, int bid, int nblk) {
    const int tid = tid_(), lane = tid & 63, wave = __builtin_amdgcn_readfirstlane(tid >> 6);
    const unsigned char* ws = P.ws; float* dbg = (float*)(ws + WS_CTL) + 64;
    const int gw = bid * NWAVES + wave;
    const unsigned hsh = (unsigned)gw * 2654435761u;
    const int b = (hsh >> 8) & 7, h = (hsh >> 11) & 3, i = (int)((hsh >> 13) % 4096u), bh = b * 4 + h;
    const float lam = ((const float*)(ws + WS_LB))[512];
    float oc[2][2], lsum[2], mx[2];
    for (int c = 0; c < 2; ++c) { oc[c][0] = oc[c][1] = 0.f; lsum[c] = 0.f; mx[c] = -1e30f; }
    for (int pp = KPAD; pp <= 64 + i; ++pp) {
        const int tile = pp >> 6, key = pp & 63;
        for (int c = 0; c < 2; ++c) {
            const bf16_t* q = (const bf16_t*)(ws + WS_Q) + ((size_t)((bh * 2 + c) * SEQ + i)) * 64;
            const unsigned char* kimg = ws + WS_K + ((size_t)(bh * 2 + c) * KT + tile) * 8192;
            float sdot = 0.f;
            for (int d = 0; d < 64; ++d) sdot += bf2f(q[d]) * bf2f(*(const bf16_t*)(kimg + (d >> 3) * 1024 + key * 16 + (d & 7) * 2));
            const float mn = fmaxf(mx[c], sdot), al = exp2f(mx[c] - mn), pe = exp2f(sdot - mn);
            const unsigned char* vimg = ws + WS_V + ((size_t)bh * KT + tile) * 16384;
            for (int e = 0; e < 2; ++e) { const int dv = lane + 64 * e; oc[c][e] = oc[c][e] * al + pe * bf2f(*(const bf16_t*)(vimg + (dv >> 5) * 4096 + key * 64 + (dv & 31) * 2)); }
            lsum[c] = lsum[c] * al + pe; mx[c] = mn;
        }
    }
    float o[2], ss = 0.f;
    for (int e = 0; e < 2; ++e) { o[e] = oc[0][e] / lsum[0] - lam * oc[1][e] / lsum[1]; ss += o[e] * o[e]; }
    ss = wave_sum(ss); const float rs = (1.f - LAM_INIT) / sqrtf(ss / 128.f + EPS);
    for (int e = 0; e < 2; ++e) { const int dv = lane + 64 * e; const float want = o[e] * rs * P.subln_w[dv];
        const float got = bf2f(((const bf16_t*)(ws + WS_MIX))[(size_t)(b * SEQ + i) * DM + h * 128 + dv]);
        dbg_max(dbg + 5, fabsf(got - want)); dbg_max(dbg + 6, fabsf(want)); }
}
DI void dbg_check_hgrn(const Params& P, char* lds_g, int bid, int nblk) {
    if (bid >= 32) return;
    LAS float* L = (LAS float*)lds_g;
    const int tid = tid_(), dv = tid & 127, qt = tid >> 7;
    const unsigned char* ws = P.ws; float* dbg = (float*)(ws + WS_CTL) + 64;
    const int bh = bid, b = bid >> 2, h = bid & 3;
    const float* HG = (const float*)(ws + WS_HG) + (size_t)bh * HT * 128;
    const bf16_t* HQ = (const bf16_t*)(ws + WS_HQ) + (size_t)bh * HT * 128;
    const bf16_t* HV = (const bf16_t*)(ws + WS_HV) + (size_t)bh * HT * 128;
    float S[32];
#pragma unroll
    for (int j = 0; j < 32; ++j) S[j] = 0.f;
    for (int pp = 16; pp < HT; ++pp) {
        if (tid < 128) { L[tid] = __expf(HG[(size_t)pp * 128 + tid]); L[128 + tid] = bf2f(HQ[(size_t)pp * 128 + tid]); L[256 + tid] = bf2f(HV[(size_t)pp * 128 + tid]); }
        __syncthreads();
        const float v = L[256 + dv]; float part = 0.f;
#pragma unroll
        for (int j = 0; j < 32; ++j) { const float f = L[32 * qt + j]; S[j] = f * S[j] + (1.f - f) * v; part += L[128 + 32 * qt + j] * S[j]; }
        L[384 + qt * 128 + dv] = part;
        __syncthreads();
        if (tid < 128) { const float o = L[384 + dv] + L[512 + dv] + L[640 + dv] + L[768 + dv]; L[896 + dv] = o; }
        __syncthreads();
        if (tid < 128 && pp >= 32) {
            float ss = 0.f; for (int j = 0; j < 128; ++j) ss += L[896 + j] * L[896 + j];
            const float rs = 1.f / sqrtf(ss / 128.f + EPS);
            const size_t row = (size_t)b * SEQ + (pp - 32);
            const float want = L[896 + dv] * rs * P.rec_norm_w[h * 128 + dv] * bf2f(((const bf16_t*)(ws + WS_SG))[row * 512 + h * 128 + dv]);
            const float got = bf2f(((const bf16_t*)(ws + WS_MIX))[row * DM + 512 + h * 128 + dv]);
            dbg_max(dbg + 7, fabsf(got - want)); dbg_max(dbg + 8, fabsf(want));
        }
        __syncthreads();
    }
}
#endif

#ifdef DBG_CHECK
DI float dbg_proj(const Params& P, int m, int c) {
    const float* xrow = (m < NTOK) ? P.x + (size_t)m * DM : P.meta + (size_t)(m - NTOK) * DM;
    float ss = 0.f, a = 0.f;
    for (int k = 0; k < DM; ++k) { const float xv = xrow[k]; ss += xv * xv; a += xv * P.mix_norm_w[k] * P.w_in[(size_t)k * NCOL1 + c]; }
    return a / sqrtf(ss / DM + EPS);
}
DI void dbg_check_gemm1(const Params& P, int bid, int nblk) {
    const unsigned char* ws = P.ws; float* dbg = (float*)(ws + WS_CTL) + 64;
    const int gt = bid * NTHREADS + tid_();
    if (gt >= 7 * 4096) return;
    const unsigned hsh = (unsigned)gt * 2654435761u;
    const int seg = gt % 7, cs = (hsh >> 7) & 511;
    const bool meta = ((gt / 7) & 15) == 0;
    const int m = meta ? NTOK + ((hsh >> 20) & 15) : (int)((hsh >> 3) % (unsigned)NTOK);
    const int b = meta ? (int)((hsh >> 25) & 7) : (m >> 12), t = meta ? (m - NTOK) : ((m & 4095) + NMETA);
    const int h = cs >> 7;
    float want = 0.f, got = 0.f;
    if (seg <= 1) {
        if (seg == 0 && meta) return;
        const int comp = (cs >> 6) & 1, d = cs & 63, dlo = d & 31;
        const float zlo = dbg_proj(P, m, seg * 512 + (cs & ~63) + dlo), zhi = dbg_proj(P, m, seg * 512 + (cs & ~63) + dlo + 32);
        const double inv = exp2(-(double)dlo * (13.287712379549449 / 32.0)); const float cv = (float)cos((double)t * inv), sv = (float)sin((double)t * inv);
        want = (d < 32) ? zlo * cv - zhi * sv : zhi * cv + zlo * sv;
        if (seg == 0) { want *= QSCALE; got = bf2f(((const bf16_t*)(ws + WS_Q))[((size_t)(((b * 4 + h) * 2 + comp) * SEQ + (m & 4095))) * 64 + d]); }
        else { const int pp = t + KPAD; got = bf2f(*(const bf16_t*)(ws + WS_K + ((size_t)((b * 4 + h) * 2 + comp) * KT + (pp >> 6)) * 8192 + (d >> 3) * 1024 + (pp & 63) * 16 + (d & 7) * 2)); }
    } else {
        const float z = dbg_proj(P, m, seg * 512 + cs); const int dv = cs & 127;
        if (seg == 2) { const int pp = t + KPAD; want = z; got = bf2f(*(const bf16_t*)(ws + WS_V + ((size_t)(b * 4 + h) * KT + (pp >> 6)) * 16384 + (dv >> 5) * 4096 + (pp & 63) * 64 + (dv & 31) * 2)); }
        else if (seg == 3) { want = siluf_(z); got = bf2f(((const bf16_t*)(ws + WS_HQ))[((size_t)(b * 4 + h) * HT + t + 16) * 128 + dv]); }
        else if (seg == 4) { const float l0 = P.lb_logits[cs], l1 = P.lb_logits[512 + cs], lb = __expf(l0) / (__expf(l0) + __expf(l1)); want = __logf(lb + (1.f - lb) * sigmoidf_(z)); got = ((const float*)(ws + WS_HG))[((size_t)(b * 4 + h) * HT + t + 16) * 128 + dv]; }
        else if (seg == 5) { want = z; got = bf2f(((const bf16_t*)(ws + WS_HV))[((size_t)(b * 4 + h) * HT + t + 16) * 128 + dv]); }
        else { if (meta) return; want = siluf_(z); got = bf2f(((const bf16_t*)(ws + WS_SG))[(size_t)m * 512 + cs]); }
    }
    dbg_max(dbg + 16 + seg + (meta ? 8 : 0), fabsf(got - want));
}
#endif
typedef unsigned u32x4v __attribute__((vector_size(16)));
DI float oct_sum(float v) {
    v += dpp_f<0xB1>(v); v += dpp_f<0x4E>(v); v += dpp_f<0x141>(v); return v;
}
DI unsigned my_xcc_id() { return (unsigned)__builtin_amdgcn_s_getreg((3 << 11) | 20) & 7u; }
constexpr int CTL_G1 = 16, CTL_G2 = 32;

DI void xn8_rows(const Params& P, int bid, int nblk) {
    const int tid = tid_(), lane = tid & 63, wave = __builtin_amdgcn_readfirstlane(tid >> 6);
    unsigned char* ws = P.ws;
    const int gw = bid * NWAVES + wave, NGW = nblk * NWAVES;
    f32x4 wv[4];
#pragma unroll
    for (int q = 0; q < 4; ++q) wv[q] = *(const f32x4*)(P.ffn_norm_w + 16 * lane + 4 * q);
    for (int n = gw; n < NTOK; n += NGW) {
        const bf16_t* hrow = (const bf16_t*)(ws + WS_XB) + (size_t)n * DM + 16 * lane;
        const float r2 = 1.f / sqrtf(((const float*)(ws + WS_SSQ))[n] * (1.f / DM) + EPS);
        const u32x4 ha = *(const u32x4*)hrow, hb = *(const u32x4*)(hrow + 8);
        const unsigned hu[8] = {ha.x, ha.y, ha.z, ha.w, hb.x, hb.y, hb.z, hb.w};
        f32x4 t[4]; float am = 0.f;
#pragma unroll
        for (int q = 0; q < 4; ++q) { t[q] = (f32x4){bf2f(hu[2 * q] & 0xffffu), bf2f(hu[2 * q] >> 16), bf2f(hu[2 * q + 1] & 0xffffu), bf2f(hu[2 * q + 1] >> 16)} * wv[q] * r2; am = fmaxf(am, fmaxf(fmaxf(fabsf(t[q].x), fabsf(t[q].y)), fmaxf(fabsf(t[q].z), fabsf(t[q].w)))); }
        am = row16_max(am); am = fmaxf(fmaxf(readlane_f(am, 0), readlane_f(am, 16)), fmaxf(readlane_f(am, 32), readlane_f(am, 48)));
        const float sc = (am > 0.f) ? exp2f(floorf(log2f(224.f / am))) : 1.f;
        int w[4];
#pragma unroll
        for (int q = 0; q < 4; ++q) { w[q] = __builtin_amdgcn_cvt_pk_fp8_f32(t[q].x * sc, t[q].y * sc, 0, false); w[q] = __builtin_amdgcn_cvt_pk_fp8_f32(t[q].z * sc, t[q].w * sc, w[q], true); }
        *(u32x4*)(ws + WS_XN8 + (size_t)n * DM + 16 * lane) = (u32x4){(unsigned)w[0], (unsigned)w[1], (unsigned)w[2], (unsigned)w[3]};
        if (lane == 0) ((float*)(ws + WS_XSC))[n] = 1.f / sc;
    }
}
typedef int i32x4 __attribute__((ext_vector_type(4)));
struct GMeta { i32x4 id[4]; f32x4 c[4]; u32x4 xq; };
template <int WHICH>
DI void g_meta(const Params& P, int n, int x, GMeta& M) {
    const int lane = tid_() & 63, i = lane & 7, g = lane >> 3;
    const i32x4* ip = (const i32x4*)((const int*)(P.ws + WS_EIDX) + (size_t)n * 128 + 16 * g);
#pragma unroll
    for (int q = 0; q < 4; ++q) M.id[q] = ip[q];
    if (WHICH == 1) M.xq = *(const u32x4*)(P.ws + WS_XN8 + (size_t)n * DM + 128 * x + 16 * i);
    else { const f32x4* cp = (const f32x4*)((const float*)(P.ws + WS_HID) + (size_t)n * 128 + 16 * g);
#pragma unroll
        for (int q = 0; q < 4; ++q) M.c[q] = cp[q]; }
}
DI void g_issue(int x, const GMeta& M, u32x4v (&rw)[16], __amdgpu_buffer_rsrc_t rs) {
    const int i = tid_() & 7;
    const unsigned lo = (unsigned)x * (unsigned)(NEXP * 128) + (unsigned)(16 * i);
#pragma unroll
    for (int j = 0; j < 16; ++j) rw[j] = __builtin_amdgcn_raw_buffer_load_b128(rs, ((unsigned)M.id[j >> 2][j & 3] << 7) + lo, 0, 0);
}
DI void g1_finish(const Params& P, int n, int x, u32x4 xq, const u32x4v (&rw)[16]) {
    const int lane = tid_() & 63, i = lane & 7, g = lane >> 3;
    f32x2 xv[8];
    xv[0] = __builtin_amdgcn_cvt_pk_f32_fp8((int)xq.x, false); xv[1] = __builtin_amdgcn_cvt_pk_f32_fp8((int)xq.x, true);
    xv[2] = __builtin_amdgcn_cvt_pk_f32_fp8((int)xq.y, false); xv[3] = __builtin_amdgcn_cvt_pk_f32_fp8((int)xq.y, true);
    xv[4] = __builtin_amdgcn_cvt_pk_f32_fp8((int)xq.z, false); xv[5] = __builtin_amdgcn_cvt_pk_f32_fp8((int)xq.z, true);
    xv[6] = __builtin_amdgcn_cvt_pk_f32_fp8((int)xq.w, false); xv[7] = __builtin_amdgcn_cvt_pk_f32_fp8((int)xq.w, true);
    float pd[16];
#pragma unroll
    for (int j = 0; j < 16; ++j) pd[j] = dot16_fp8(__builtin_bit_cast(u32x4, rw[j]), xv);
    const unsigned m1 = 0u - (unsigned)((i >> 2) & 1), m2 = 0u - (unsigned)(i & 1), m3 = 0u - (unsigned)((i >> 1) & 1);
#define BSEL(a, b, m) __uint_as_float((__float_as_uint(a) & ~(m)) | (__float_as_uint(b) & (m)))
    float z[8], w[4], u[2];
#pragma unroll
    for (int q = 0; q < 8; ++q) { const float snd = BSEL(pd[q + 8], pd[q], m1), kep = BSEL(pd[q], pd[q + 8], m1); z[q] = kep + dpp_f<0x141>(snd); }
#pragma unroll
    for (int q = 0; q < 4; ++q) { const float snd = BSEL(z[q + 4], z[q], m2), kep = BSEL(z[q], z[q + 4], m2); w[q] = kep + dpp_f<0xB1>(snd); }
#pragma unroll
    for (int q = 0; q < 2; ++q) { const float snd = BSEL(w[q + 2], w[q], m3), kep = BSEL(w[q], w[q + 2], m3); u[q] = kep + dpp_f<0x4E>(snd); }
    const int j0 = 8 * ((i >> 2) & 1) + 4 * (i & 1) + 2 * ((i >> 1) & 1);
#undef BSEL
    *(f32x2*)((float*)(P.ws + WS_HIDP) + ((size_t)x * NTOK + n) * 128 + 16 * g + j0) = (f32x2){u[0], u[1]};
}
DI void g2_finish(const Params& P, int n, int x, const f32x4 (&cv)[4], const u32x4v (&rw)[16]) {
    const int lane = tid_() & 63, i = lane & 7, g = lane >> 3;
    f32x2 acc[8];
#pragma unroll
    for (int q = 0; q < 8; ++q) acc[q] = (f32x2){0.f, 0.f};
#pragma unroll
    for (int j = 0; j < 16; ++j) {
        const float cj = cv[j >> 2][j & 3]; const f32x2 c = (f32x2){cj, cj}; const u32x4 w = __builtin_bit_cast(u32x4, rw[j]);
        acc[0] = __builtin_amdgcn_cvt_pk_f32_fp8((int)w.x, false) * c + acc[0]; acc[1] = __builtin_amdgcn_cvt_pk_f32_fp8((int)w.x, true) * c + acc[1];
        acc[2] = __builtin_amdgcn_cvt_pk_f32_fp8((int)w.y, false) * c + acc[2]; acc[3] = __builtin_amdgcn_cvt_pk_f32_fp8((int)w.y, true) * c + acc[3];
        acc[4] = __builtin_amdgcn_cvt_pk_f32_fp8((int)w.z, false) * c + acc[4]; acc[5] = __builtin_amdgcn_cvt_pk_f32_fp8((int)w.z, true) * c + acc[5];
        acc[6] = __builtin_amdgcn_cvt_pk_f32_fp8((int)w.w, false) * c + acc[6]; acc[7] = __builtin_amdgcn_cvt_pk_f32_fp8((int)w.w, true) * c + acc[7];
    }
    float y[16], z[8], w[4];
#pragma unroll
    for (int q = 0; q < 8; ++q) { y[2 * q] = acc[q].x; y[2 * q + 1] = acc[q].y; }
#pragma unroll
    for (int q = 0; q < 8; ++q) { auto rr = __builtin_amdgcn_permlane32_swap(__float_as_uint(y[q]), __float_as_uint(y[q + 8]), false, false); z[q] = __uint_as_float(rr[0]) + __uint_as_float(rr[1]); }
#pragma unroll
    for (int q = 0; q < 4; ++q) { auto rr = __builtin_amdgcn_permlane16_swap(__float_as_uint(z[q]), __float_as_uint(z[q + 4]), false, false); w[q] = __uint_as_float(rr[0]) + __uint_as_float(rr[1]); }
    const unsigned m3 = 0u - (unsigned)(g & 1);
#define BSEL(a, b, m) __uint_as_float((__float_as_uint(a) & ~(m)) | (__float_as_uint(b) & (m)))
    const float k0 = BSEL(w[0], w[2], m3) + dpp_f<0x128>(BSEL(w[2], w[0], m3)), k1 = BSEL(w[1], w[3], m3) + dpp_f<0x128>(BSEL(w[3], w[1], m3));
#undef BSEL
    float* hp = P.out + (size_t)n * DM + 128 * x + 16 * i + 2 * g;
    const f32x2 t = *(const f32x2*)hp + (f32x2){k0, k1}; *(f32x2*)hp = t;
    const float ss = wave_sum_dpp(t.x * t.x + t.y * t.y);
    if (lane == 0) atomicAdd((float*)(P.ws + WS_SSQ2) + n, ss);
}
constexpr int SL_CHUNK = 128, SL_T = SL_CHUNK / NWAVES;
#define SB() __builtin_amdgcn_sched_barrier(0)
template <int WHICH>
DI void g_chunk(const Params& P, int nbase, int x, __amdgpu_buffer_rsrc_t rs) {
    GMeta MA, MB; u32x4v RA[16], RB[16];
    g_meta<WHICH>(P, nbase, x, MA); SB(); g_meta<WHICH>(P, nbase + 8, x, MB); SB(); g_issue(x, MA, RA, rs); SB();
#pragma unroll
    for (int t = 0; t < SL_T; t += 2) {
        const u32x4 xA = MA.xq; const f32x4 cA[4] = {MA.c[0], MA.c[1], MA.c[2], MA.c[3]};
        if (t + 2 < SL_T) { g_meta<WHICH>(P, nbase + 8 * (t + 2), x, MA); SB(); }
        g_issue(x, MB, RB, rs); SB();
        if (WHICH == 1) g1_finish(P, nbase + 8 * t, x, xA, RA); else g2_finish(P, nbase + 8 * t, x, cA, RA);
        SB();
        const u32x4 xB = MB.xq; const f32x4 cB[4] = {MB.c[0], MB.c[1], MB.c[2], MB.c[3]};
        if (t + 3 < SL_T) { g_meta<WHICH>(P, nbase + 8 * (t + 3), x, MB); SB(); }
        if (t + 2 < SL_T) { g_issue(x, MA, RA, rs); SB(); }
        if (WHICH == 1) g1_finish(P, nbase + 8 * (t + 1), x, xB, RB); else g2_finish(P, nbase + 8 * (t + 1), x, cB, RB);
        SB();
    }
}
template <int WHICH>
DI void sliced_phase(const Params& P, char* lds_g) {
    const int tid = tid_(), wave = __builtin_amdgcn_readfirstlane(tid >> 6);
    unsigned* ctr = (unsigned*)(P.ws + WS_CTL) + (WHICH == 1 ? CTL_G1 : CTL_G2);
    const __amdgpu_buffer_rsrc_t rs = __builtin_amdgcn_make_buffer_rsrc((void*)(P.ws + (WHICH == 1 ? WS_UB : WS_VB)), 0, NEXP * DM, 0x00020000);
    const int x0 = (int)my_xcc_id();
    LAS int* slot = (LAS int*)((LAS char*)lds_g + LDS_ITEM);
    for (int s = 0; s < 8; ++s) {
        const int x = (x0 + s) & 7;
        for (;;) {
            if (tid == 0) *slot = (int)atomicAdd(ctr + x, 1u);
            __syncthreads();
            const int chunk = *slot;
            __syncthreads();
            if (chunk >= NTOK / SL_CHUNK) break;
            g_chunk<WHICH>(P, chunk * SL_CHUNK + wave, x, rs);
        }
    }
}
DI void hid_reduce_phase(const Params& P, int bid, int nblk) {
    const unsigned char* ws = P.ws;
    const size_t gt = (size_t)bid * NTHREADS + tid_(), NGT = (size_t)nblk * NTHREADS;
    const float* hp = (const float*)(ws + WS_HIDP);
    for (size_t o = gt; o < (size_t)NTOK * 128; o += NGT) {
        float a = 0.f;
#pragma unroll
        for (int x = 0; x < 8; ++x) a += hp[(size_t)x * NTOK * 128 + o];
        const int e = ((const int*)(ws + WS_EIDX))[o];
        const float d = a * ((const float*)(ws + WS_USC))[e] * ((const float*)(ws + WS_XSC))[o >> 7];
        ((float*)(ws + WS_HID))[o] = gelu_exact(d) * ((const float*)(ws + WS_EGATE))[o] * ((const float*)(ws + WS_VSC))[e];
    }
}
DI void final_norm_phase(const Params& P, int bid, int nblk) {
    const size_t gt = (size_t)bid * NTHREADS + tid_(), NGT = (size_t)nblk * NTHREADS;
    const float* ssq = (const float*)(P.ws + WS_SSQ2);
    for (size_t o = gt; o < (size_t)NTOK * DM / 4; o += NGT) {
        const size_t n = o >> 8; const int c4 = (int)(o & 255);
        const float rs = 1.f / sqrtf(ssq[n] * (1.f / DM) + EPS);
        f32x4* pp = (f32x4*)P.out + o;
        *pp = *pp * ((const f32x4*)P.final_w)[c4] * rs;
    }
}

typedef long i64_t;
constexpr int MG_HALF = 8192, MG_WAVE = 2 * MG_HALF;
#define MG_WAIT(N) asm volatile("s_waitcnt vmcnt(" #N ")" ::: "memory")
struct MgMeta { i32x4 id[4]; u32x4 a0, a1; };
template <int WHICH>
DI void mg_meta(const Params& P, int n, int x, MgMeta& M) {
    const int lane = tid_() & 63, g8 = lane >> 3, kg = lane >> 4;
    const int* ip = (const int*)(P.ws + WS_EIDX) + (size_t)n * 128 + 8 * g8;
    M.id[0] = *(const i32x4*)ip; M.id[1] = *(const i32x4*)(ip + 4); M.id[2] = *(const i32x4*)(ip + 64); M.id[3] = *(const i32x4*)(ip + 68);
    if (WHICH == 1) { const unsigned char* xr = P.ws + WS_XN8 + (size_t)n * DM + 128 * x + 16 * kg; M.a0 = *(const u32x4*)xr; M.a1 = *(const u32x4*)(xr + 64); }
    else { const unsigned char* cr = P.ws + WS_C8 + (size_t)n * 128 + 8 * kg;
        const u32x2 c0 = *(const u32x2*)cr, c1 = *(const u32x2*)(cr + 32), c2 = *(const u32x2*)(cr + 64), c3 = *(const u32x2*)(cr + 96);
        M.a0 = (u32x4){c0.x, c0.y, c1.x, c1.y}; M.a1 = (u32x4){c2.x, c2.y, c3.x, c3.y}; }
}
DI void mg_issue(const unsigned char* slice, const MgMeta& M, int h, unsigned lbase) {
    const int lane = tid_() & 63, pos = lane & 7;
    const i32x4 ia = M.id[2 * h], ib = M.id[2 * h + 1];
    const int ids[8] = {ia.x, ia.y, ia.z, ia.w, ib.x, ib.y, ib.z, ib.w};
#pragma unroll
    for (int p = 0; p < 8; ++p) glds16_asm(slice + (size_t)(unsigned)ids[p] * 128 + 16 * (pos ^ p), lbase + p * 1024);
}
DI i64_t pk64(unsigned lo, unsigned hi) { return (i64_t)(((unsigned long long)hi << 32) | lo); }
DI float mg1_half(const MgMeta& M, LAS char* hb) {
    const int lane = tid_() & 63, c = lane & 15, kg = lane >> 4;
    const i64_t a0 = pk64(M.a0.x, M.a0.y), a1 = pk64(M.a0.z, M.a0.w), a2 = pk64(M.a1.x, M.a1.y), a3 = pk64(M.a1.z, M.a1.w);
    float res = 0.f;
#pragma unroll
    for (int G = 0; G < 4; ++G) {
        const LAS char* row = hb + (c & 7) * 1024 + (2 * G + (c >> 3)) * 128;
        const u32x4 b0 = *(const LAS u32x4*)(row + ((kg ^ (c & 7)) << 4)), b1 = *(const LAS u32x4*)(row + (((kg + 4) ^ (c & 7)) << 4));
        f32x4 d = (f32x4){0.f, 0.f, 0.f, 0.f};
        d = __builtin_amdgcn_mfma_f32_16x16x32_fp8_fp8(a0, pk64(b0.x, b0.y), d, 0, 0, 0);
        d = __builtin_amdgcn_mfma_f32_16x16x32_fp8_fp8(a1, pk64(b0.z, b0.w), d, 0, 0, 0);
        d = __builtin_amdgcn_mfma_f32_16x16x32_fp8_fp8(a2, pk64(b1.x, b1.y), d, 0, 0, 0);
        d = __builtin_amdgcn_mfma_f32_16x16x32_fp8_fp8(a3, pk64(b1.z, b1.w), d, 0, 0, 0);
        if (G == kg) res = d[0];
    }
    return res;
}
typedef int v2i_t __attribute__((ext_vector_type(2)));
DI void mg2_half(const MgMeta& M, int h, LAS char* hb, f32x4 (&D)[8]) {
    const int lane = tid_() & 63, c = lane & 15, kg = lane >> 4;
#pragma unroll
    for (int kbl = 0; kbl < 2; ++kbl) {
        const u32x4 av = h ? M.a1 : M.a0;
        const i64_t a = kbl ? pk64(av.z, av.w) : pk64(av.x, av.y);
        const LAS char* row = hb + (c >> 1) * 1024 + (4 * kbl + kg) * 128 + 8 * (c & 1);
#pragma unroll
        for (int nt = 0; nt < 8; ++nt) {
            const v2i_t b = __builtin_amdgcn_ds_read_tr8_b64_v2i32((LAS v2i_t*)(row + ((nt ^ (c >> 1)) << 4)));
            D[nt] = __builtin_amdgcn_mfma_f32_16x16x32_fp8_fp8(a, pk64((unsigned)b.x, (unsigned)b.y), D[nt], 0, 0, 0);
        }
    }
}
template <int WHICH>
DI void mg_group(const Params& P, const unsigned char* slice, int n0, int x, LAS char* wl, unsigned wl_off, const MgMeta (&M)[4], MgMeta (&Mn)[4], bool more) {
    const int lane = tid_() & 63, kg = lane >> 4, c = lane & 15;
    bf16_t* outp = (bf16_t*)(P.ws + WS_HIDP) + (size_t)x * NTOK * 128;
    f32x4 D[8];
    mg_issue(slice, M[0], 0, wl_off); SB();
#define MG_STEP(h, WAITSTMT) do { \
        if ((h) + 1 < 8) { mg_issue(slice, M[((h) + 1) >> 1], ((h) + 1) & 1, wl_off + (((h) + 1) & 1) * MG_HALF); } \
        else if (more) { _Pragma("unroll") for (int q_ = 0; q_ < 4; ++q_) mg_meta<WHICH>(P, n0 + 8 * (4 + q_), x, Mn[q_]); } \
        SB(); WAITSTMT; SB(); \
        LAS char* hb_ = wl + ((h) & 1) * MG_HALF; const int n_ = n0 + 8 * ((h) >> 1); \
        if (WHICH == 1) { const float r_ = mg1_half(M[(h) >> 1], hb_); outp[(size_t)n_ * 128 + 64 * ((h) & 1) + lane] = (bf16_t)f2bf(r_); } \
        else { if (((h) & 1) == 0) { _Pragma("unroll") for (int q_ = 0; q_ < 8; ++q_) D[q_] = (f32x4){0.f, 0.f, 0.f, 0.f}; } \
            mg2_half(M[(h) >> 1], (h) & 1, hb_, D); \
            if ((h) & 1) { float v0_ = 0.f, v1_ = 0.f; _Pragma("unroll") for (int q_ = 0; q_ < 4; ++q_) { if (kg == q_) { v0_ = D[2 * q_][0]; v1_ = D[2 * q_ + 1][0]; } } \
                outp[(size_t)n_ * 128 + 32 * kg + c] = (bf16_t)f2bf(v0_); outp[(size_t)n_ * 128 + 32 * kg + 16 + c] = (bf16_t)f2bf(v1_); } } \
        SB(); } while (0)
    if (WHICH == 1) {
        MG_STEP(0, MG_WAIT(8)); MG_STEP(1, MG_WAIT(9)); MG_STEP(2, MG_WAIT(9)); MG_STEP(3, MG_WAIT(9)); MG_STEP(4, MG_WAIT(9)); MG_STEP(5, MG_WAIT(9)); MG_STEP(6, MG_WAIT(9));
        if (more) { MG_STEP(7, MG_WAIT(25)); } else { MG_STEP(7, MG_WAIT(1)); }
    } else {
        MG_STEP(0, MG_WAIT(8)); MG_STEP(1, MG_WAIT(8)); MG_STEP(2, MG_WAIT(10)); MG_STEP(3, MG_WAIT(8)); MG_STEP(4, MG_WAIT(10)); MG_STEP(5, MG_WAIT(8)); MG_STEP(6, MG_WAIT(10));
        if (more) { MG_STEP(7, MG_WAIT(32)); } else { MG_STEP(7, MG_WAIT(0)); }
    }
#undef MG_STEP
}
template <int WHICH>
DI void mg_phase(const Params& P, char* lds_g) {
    const int tid = tid_(), wave = __builtin_amdgcn_readfirstlane(tid >> 6);
    unsigned* ctr = (unsigned*)(P.ws + WS_CTL) + (WHICH == 1 ? CTL_G1 : CTL_G2);
    const int x0 = (int)my_xcc_id();
    LAS int* slot = (LAS int*)((LAS char*)lds_g + LDS_ITEM);
    LAS char* wl = (LAS char*)lds_g + wave * MG_WAVE;
    const unsigned wl_off = (unsigned)__builtin_amdgcn_readfirstlane((int)(unsigned)(size_t)wl);
    for (int s = 0; s < 8; ++s) {
        const int x = (x0 + s) & 7;
        const unsigned char* slice = P.ws + (WHICH == 1 ? WS_UB : WS_VB) + (size_t)x * ((size_t)NEXP * 128);
        for (;;) {
            if (tid == 0) *slot = (int)atomicAdd(ctr + x, 1u);
            __syncthreads();
            const int chunk = *slot;
            __syncthreads();
            if (chunk >= NTOK / SL_CHUNK) break;
            const int nb = chunk * SL_CHUNK + wave;
            MgMeta MA[4], MB[4];
#pragma unroll
            for (int q = 0; q < 4; ++q) mg_meta<WHICH>(P, nb + 8 * q, x, MA[q]);
            mg_group<WHICH>(P, slice, nb, x, wl, wl_off, MA, MB, true);
            mg_group<WHICH>(P, slice, nb + 32, x, wl, wl_off, MB, MA, true);
            mg_group<WHICH>(P, slice, nb + 64, x, wl, wl_off, MA, MB, true);
            mg_group<WHICH>(P, slice, nb + 96, x, wl, wl_off, MB, MA, false);
            MG_WAIT(0);
        }
    }
}
DI void hid_reduce8_phase(const Params& P, int bid, int nblk) {
    const int tid = tid_(), lane = tid & 63, wave = __builtin_amdgcn_readfirstlane(tid >> 6);
    unsigned char* ws = P.ws;
    const int gw = bid * NWAVES + wave, NGW = nblk * NWAVES;
    const bf16_t* hp = (const bf16_t*)(ws + WS_HIDP);
    for (int n = gw; n < NTOK; n += NGW) {
        const float xs = ((const float*)(ws + WS_XSC))[n];
        float cv[2]; float am = 0.f;
#pragma unroll
        for (int q = 0; q < 2; ++q) {
            const size_t o = (size_t)n * 128 + 64 * q + lane; float a = 0.f;
#pragma unroll
            for (int x = 0; x < 8; ++x) a += bf2f(hp[(size_t)x * NTOK * 128 + o]);
            const int e = ((const int*)(ws + WS_EIDX))[o];
            cv[q] = gelu_exact(a * ((const float*)(ws + WS_USC))[e] * xs) * ((const float*)(ws + WS_EGATE))[o] * ((const float*)(ws + WS_VSC))[e];
            am = fmaxf(am, fabsf(cv[q]));
        }
        am = row16_max(am); am = fmaxf(fmaxf(readlane_f(am, 0), readlane_f(am, 16)), fmaxf(readlane_f(am, 32), readlane_f(am, 48)));
        const float sc = (am > 0.f) ? exp2f(floorf(log2f(224.f / am))) : 1.f;
        const int w0 = __builtin_amdgcn_cvt_pk_fp8_f32(cv[0] * sc, cv[1] * sc, 0, false);
        ws[WS_C8 + (size_t)n * 128 + lane] = (unsigned char)(w0 & 255); ws[WS_C8 + (size_t)n * 128 + 64 + lane] = (unsigned char)((w0 >> 8) & 255);
        if (lane == 0) ((float*)(ws + WS_CSC))[n] = 1.f / sc;
    }
}
DI void final_norm8_phase(const Params& P, int bid, int nblk) {
    const int tid = tid_(), lane = tid & 63, wave = __builtin_amdgcn_readfirstlane(tid >> 6);
    const unsigned char* ws = P.ws;
    const int gw = bid * NWAVES + wave, NGW = nblk * NWAVES;
    f32x4 wv[4];
#pragma unroll
    for (int q = 0; q < 4; ++q) wv[q] = *(const f32x4*)(P.final_w + 16 * lane + 4 * q);
    for (int n = gw; n < NTOK; n += NGW) {
        float* orow = P.out + (size_t)n * DM + 16 * lane;
        const bf16_t* yrow = (const bf16_t*)(ws + WS_HIDP) + ((size_t)(lane >> 3) * NTOK + n) * 128 + 16 * (lane & 7);
        const u32x4 ya = *(const u32x4*)yrow, yb = *(const u32x4*)(yrow + 8);
        const unsigned yu[8] = {ya.x, ya.y, ya.z, ya.w, yb.x, yb.y, yb.z, yb.w};
        const float cs = ((const float*)(ws + WS_CSC))[n];
        const bf16_t* hrow = (const bf16_t*)(ws + WS_XB) + (size_t)n * DM + 16 * lane;
        const u32x4 ha = *(const u32x4*)hrow, hb = *(const u32x4*)(hrow + 8);
        const unsigned hu[8] = {ha.x, ha.y, ha.z, ha.w, hb.x, hb.y, hb.z, hb.w};
        f32x4 h[4]; float ss = 0.f;
#pragma unroll
        for (int q = 0; q < 4; ++q) { h[q] = (f32x4){bf2f(hu[2 * q] & 0xffffu), bf2f(hu[2 * q] >> 16), bf2f(hu[2 * q + 1] & 0xffffu), bf2f(hu[2 * q + 1] >> 16)} + (f32x4){bf2f(yu[2 * q] & 0xffffu), bf2f(yu[2 * q] >> 16), bf2f(yu[2 * q + 1] & 0xffffu), bf2f(yu[2 * q + 1] >> 16)} * cs; ss += (h[q].x * h[q].x + h[q].y * h[q].y) + (h[q].z * h[q].z + h[q].w * h[q].w); }
        ss = wave_sum_dpp(ss);
        const float rs = 1.f / sqrtf(ss * (1.f / DM) + EPS);
#pragma unroll
        for (int q = 0; q < 4; ++q) *(f32x4*)(orow + 4 * q) = h[q] * wv[q] * rs;
    }
}

#define XB_TMO      128
#define XB_XCNT(j)  (256  + 64 * (j))
#define XB_XSUB(j)  (1280 + 64 * (j))
#define XB_XGEN(j)  (2304 + 64 * (j))
#define XB_TOP      3328
#define XB_TOPGEN   3392
#define XCD_BAR_WORDS 3456
#define XB_SPIN_CAP (1u << 18)

__device__ __forceinline__ unsigned xb_ld(unsigned* p)              { return __hip_atomic_load(p, __ATOMIC_RELAXED, __HIP_MEMORY_SCOPE_AGENT); }
__device__ __forceinline__ unsigned xb_add(unsigned* p, unsigned v) { return __hip_atomic_fetch_add(p, v, __ATOMIC_RELAXED, __HIP_MEMORY_SCOPE_AGENT); }
__device__ __forceinline__ unsigned xb_xcc_id() { return (unsigned)__builtin_amdgcn_s_getreg((3 << 11) | 20) & 0xFu; }
#define XB_SPIN(cond, bar) do { unsigned _sp = 0; while (cond) { __builtin_amdgcn_s_sleep(1); \
    if ((++_sp & 255u) == 0u) { if (xb_ld(&(bar)[XB_TMO])) break; if (_sp > XB_SPIN_CAP) { atomicAdd(&(bar)[XB_TMO], 1u); break; } } } } while (0)

struct XcdBarrier {
    unsigned* bar; unsigned x;
    volatile LAS unsigned* st;
};

__device__ __forceinline__ XcdBarrier xcd_barrier_post(unsigned* bar, volatile LAS unsigned* st) {
    XcdBarrier b; b.bar = bar; b.x = xb_xcc_id(); b.st = st;
    if (threadIdx.x == 0) (void)xb_add(&bar[XB_XCNT(b.x)], 1u);
    return b;
}
__device__ __forceinline__ void xcd_barrier_complete(unsigned* bar, unsigned x, unsigned& nloc, unsigned& nx) {
    const unsigned G = gridDim.x * gridDim.y * gridDim.z;
    unsigned sum, cnt, mine, sp = 0u;
    for (;;) {
        sum = 0u; cnt = 0u; mine = 0u;
#pragma unroll
        for (unsigned j = 0; j < 16; ++j) { const unsigned c = xb_ld(&bar[XB_XCNT(j)]); sum += c; cnt += (c > 0u) ? 1u : 0u; mine = (j == x) ? c : mine; }
        if (sum == G) break;
        __builtin_amdgcn_s_sleep(1);
        if ((++sp & 255u) == 0u) { if (xb_ld(&bar[XB_TMO])) break; if (sp > XB_SPIN_CAP) { atomicAdd(&bar[XB_TMO], 1u); break; } }
    }
    nloc = mine > 0u ? mine : 1u; nx = cnt > 0u ? cnt : 1u;
}

__device__ __forceinline__ void xcd_barrier(const XcdBarrier& b) {
    asm volatile("s_waitcnt vmcnt(0)" ::: "memory");
    __syncthreads();
    if (threadIdx.x == 0) {
        unsigned* bar = b.bar;
        __builtin_amdgcn_s_waitcnt(0);
        unsigned nloc = b.st[0], nx = b.st[1];
        if (nloc == 0u) { xcd_barrier_complete(bar, b.x, nloc, nx); b.st[0] = nloc; b.st[1] = nx; }
        const unsigned old = xb_add(&bar[XB_XSUB(b.x)], 1u);
        const unsigned gen = old / nloc;
        if (old + 1u == (gen + 1u) * nloc) {
            __builtin_amdgcn_fence(__ATOMIC_RELEASE, "agent");
            asm volatile("s_waitcnt vmcnt(0)" ::: "memory");
            const unsigned og = xb_add(&bar[XB_TOP], 1u);
            const unsigned tg = og / nx;
            if (og + 1u == (tg + 1u) * nx) xb_add(&bar[XB_TOPGEN], 1u);
            else XB_SPIN(xb_ld(&bar[XB_TOPGEN]) == tg, bar);
            __builtin_amdgcn_fence(__ATOMIC_ACQUIRE, "agent");
            xb_add(&bar[XB_XGEN(b.x)], 1u);
            asm volatile("s_waitcnt vmcnt(0)" ::: "memory");
        } else {
            XB_SPIN(xb_ld(&bar[XB_XGEN(b.x)]) == gen, bar);
            __builtin_amdgcn_fence(__ATOMIC_ACQUIRE, "agent");
            asm volatile("s_waitcnt vmcnt(0)" ::: "memory");
        }
    }
    __syncthreads();
}

constexpr int CTL_XB_WORD = 2048;
static_assert((CTL_XB_WORD + 3456) * 4 <= (int)CTL_BYTES, "barrier words inside CTL");
constexpr int N_HGRN_ITEMS = BATCH * 4, N_ATT_ITEMS = BATCH * 4 * 32;

DI void mixer_phase(const Params& P, char* lds) {
    unsigned* ctr = (unsigned*)(P.ws + WS_CTL);
    for (;;) {
        if (tid_() == 0) *(LAS int*)((LAS char*)lds + LDS_ITEM) = (int)atomicAdd(ctr, 1u);
        __syncthreads();
        const int item = *(LAS int*)((LAS char*)lds + LDS_ITEM);
        __syncthreads();
        if (item >= N_HGRN_ITEMS + N_ATT_ITEMS) break;
        if (item < N_HGRN_ITEMS) hgrn_unit(P, item >> 2, item & 3, lds);
        else { const int a = item - N_HGRN_ITEMS, j = 31 - (a >> 5), bh = a & 31; attn_unit(P, bh >> 2, bh & 3, j, lds); }
    }
}

#ifdef TS_PHASE
#ifndef TS_DIV
#define TS_DIV 4.0f
#endif
#define TS(i) do { if (blockIdx.x == 0 && threadIdx.x == 0) ((LAS unsigned long long*)((LAS char*)lds + LDS_BYTES - 512))[i] = __builtin_amdgcn_s_memrealtime(); } while (0)
#else
#define TS(i) do { } while (0)
#endif
__global__ void __launch_bounds__(NTHREADS, 2) fwd_megakernel(Params P) {
    extern __shared__ __attribute__((aligned(16))) char lds[];
    cg::grid_group grid = cg::this_grid();
    const int bid = blockIdx.x, nblk = gridDim.x;
    unsigned char* ws = P.ws;
    volatile LAS unsigned* xst = (volatile LAS unsigned*)((LAS char*)lds + LDS_XB);
    if (threadIdx.x < 4) xst[threadIdx.x] = 0u;
    __syncthreads();
    const XcdBarrier xbar = xcd_barrier_post((unsigned*)(ws + WS_CTL) + CTL_XB_WORD, xst);
    TS(0);
    phase0(P, lds, bid, nblk);
    grid.sync();
    TS(1);
    { Epi1 e{ws}; gemm_run(lds, (const bf16_t*)(ws + WS_XB), (const bf16_t*)(ws + WS_W1T), M1, NCOL1, DM, e, bid, nblk); }
    {
        constexpr int NUNITS = (M1 / 256) * (NCOL1 / 256);
        const int nlast = NUNITS % nblk, nfree = nlast ? nblk - nlast : nblk;
        const int wave = __builtin_amdgcn_readfirstlane(tid_() >> 6);
        if (nlast == 0 || bid >= nlast) table_fp8_rows(P, (bid - (nlast ? nlast : 0)) * NWAVES + wave, nfree * NWAVES);
    }
    xcd_barrier(xbar);
    TS(2);
    for (int it = bid; it < 32 * 129; it += nblk) hgrn_prep_item(P, it & 31, it >> 5, lds);
    xcd_barrier(xbar);
    TS(3);
    mixer_phase(P, lds);
    xcd_barrier(xbar);
    TS(4);
    { Epi3 e{P.x, P.out, (bf16_t*)(ws + WS_XB), (float*)(ws + WS_SSQ)}; gemm_run(lds, (const bf16_t*)(ws + WS_MIX), (const bf16_t*)(ws + WS_W2T), NTOK, DM, DM, e, bid, nblk); }
    xcd_barrier(xbar);
    TS(5);
    { Epi4 e{(const float*)(ws + WS_SSQ), (bf16_t*)(ws + WS_PQ)}; gemm_run(lds, (const bf16_t*)(ws + WS_XB), (const bf16_t*)(ws + WS_W3T), NTOK, 2048, DM, e, bid, nblk); }
    xcd_barrier(xbar);
    TS(6);
    topk_phase(P, lds, bid, nblk);
    xn8_rows(P, bid, nblk);
    xcd_barrier(xbar);
    TS(7);
    mg_phase<1>(P, lds);
    xcd_barrier(xbar);
    TS(8);
    hid_reduce8_phase(P, bid, nblk);
    xcd_barrier(xbar);
    TS(9);
    mg_phase<2>(P, lds);
    xcd_barrier(xbar);
    TS(10);
    final_norm8_phase(P, bid, nblk);
    TS(11);
#ifdef TS_PHASE
    if (blockIdx.x == 0 && threadIdx.x == 0) { const LAS unsigned long long* t = (const LAS unsigned long long*)((LAS char*)lds + LDS_BYTES - 512);
        P.out[0] += (float)(t[TS_PHASE + 1] - t[TS_PHASE]) * 0.01f / TS_DIV; }
#endif
}

extern "C" void kernel_launch(void* const* d_in, const int* in_sizes, int n_in, void* d_out, int out_size, void* d_ws, size_t ws_size, hipStream_t stream) {
    static int grid = 0;
    if (grid == 0) {
        int dev = 0, cus = 0, per_cu = 0;
        (void)hipGetDevice(&dev);
        (void)hipDeviceGetAttribute(&cus, hipDeviceAttributeMultiprocessorCount, dev);
        (void)hipFuncSetAttribute((const void*)fwd_megakernel, hipFuncAttributeMaxDynamicSharedMemorySize, LDS_BYTES);
        (void)hipOccupancyMaxActiveBlocksPerMultiprocessor(&per_cu, (const void*)fwd_megakernel, NTHREADS, LDS_BYTES);
        if (per_cu < 1) { fprintf(stderr, "kernel_launch: occupancy query says %d blocks per CU\n", per_cu); per_cu = 1; }
        grid = cus * 1;
        if (ws_size < WS_END) { fprintf(stderr, "kernel_launch: workspace too small: %zu < %zu\n", ws_size, (size_t)WS_END); grid = -1; }
    }
    if (grid < 0) return;
    (void)hipMemsetAsync((char*)d_ws + WS_CTL, 0, CTL_BYTES, stream);
    Params p{};
    p.x = (const float*)d_in[0]; p.meta = (const float*)d_in[1]; p.mix_norm_w = (const float*)d_in[2]; p.w_in = (const float*)d_in[3];
    p.lb_logits = (const float*)d_in[4]; p.rec_norm_w = (const float*)d_in[5]; p.lq1 = (const float*)d_in[6]; p.lk1 = (const float*)d_in[7];
    p.lq2 = (const float*)d_in[8]; p.lk2 = (const float*)d_in[9]; p.subln_w = (const float*)d_in[10]; p.w_out = (const float*)d_in[11];
    p.ffn_norm_w = (const float*)d_in[12]; p.wq = (const float*)d_in[13]; p.subkeys = (const float*)d_in[14]; p.pu = (const float*)d_in[15];
    p.pv = (const float*)d_in[16]; p.final_w = (const float*)d_in[17];
    p.out = (float*)d_out; p.ws = (unsigned char*)d_ws;
    void* args[] = {&p};
    hipError_t e = hipLaunchCooperativeKernel((const void*)fwd_megakernel, dim3(grid), dim3(NTHREADS), args, LDS_BYTES, stream);
    if (e != hipSuccess) fprintf(stderr, "cooperative launch failed: %s (grid %d)\n", hipGetErrorString(e), grid);
}
```

```cpp
#include <hip/hip_runtime.h>
#include <hip/hip_cooperative_groups.h>
#include <cstdio>
#include <cstdint>
#define DBG_SEL 1
namespace cg = cooperative_groups;

constexpr int BATCH = 8, SEQ = 4096, DM = 1024, NMETA = 16;
constexpr int NTOK = BATCH * SEQ;
constexpr int M1 = NTOK + 256;
constexpr int NCOL1 = 3584;
constexpr int TPOS = NMETA + SEQ;
constexpr int KT = 65;
constexpr int KPAD = 48;
constexpr int HT = 4128;
constexpr int NEXP = 16384;
constexpr float EPS = 1e-6f;
constexpr float LAM_INIT = 0.2f;
constexpr float QSCALE = 0.125f * 1.4426950408889634f;
constexpr int NTHREADS = 512, NWAVES = 8;
constexpr int LDS_BYTES = 163840;
constexpr int LDS_ITEM = LDS_BYTES - 64, LDS_XB = LDS_BYTES - 32;

typedef unsigned short bf16_t;
typedef short bf16x8 __attribute__((ext_vector_type(8)));
typedef float f32x4 __attribute__((ext_vector_type(4)));
typedef float f32x16 __attribute__((ext_vector_type(16)));
typedef float f32x2 __attribute__((ext_vector_type(2)));
typedef unsigned u32x4 __attribute__((ext_vector_type(4)));
typedef unsigned u32x2 __attribute__((ext_vector_type(2)));
typedef __bf16 bf16x2_t __attribute__((ext_vector_type(2)));
typedef short s16x4 __attribute__((ext_vector_type(4)));
#define LAS __attribute__((address_space(3)))
#define DI __device__ __forceinline__
__device__ __forceinline__ int tid_() { int t = threadIdx.x; asm volatile("" : "+v"(t)); return t; }

constexpr size_t al256(size_t x) { return (x + 255) & ~(size_t)255; }
constexpr size_t WS_CTL = 0, CTL_BYTES = 65536;
constexpr size_t WS_W1T = WS_CTL + CTL_BYTES;
constexpr size_t WS_W2T = WS_W1T + (size_t)NCOL1 * DM * 2;
constexpr size_t WS_W3T = WS_W2T + (size_t)DM * DM * 2;
constexpr size_t WS_SKB = WS_W3T + (size_t)2048 * DM * 2;
constexpr size_t WS_UB = WS_SKB + (size_t)16 * 128 * 128 * 2;
constexpr size_t WS_VB = WS_UB + (size_t)NEXP * DM * 2;
constexpr size_t WS_USC = WS_UB + (size_t)NEXP * DM, WS_VSC = WS_VB + (size_t)NEXP * DM;
constexpr size_t WS_ROPE = WS_VB + (size_t)NEXP * DM * 2;
constexpr size_t WS_LB = WS_ROPE + (size_t)TPOS * 64 * 4;
constexpr size_t WS_R1 = WS_LB + 4096;
constexpr size_t WS_SSQ = WS_R1 + al256((size_t)M1 * 4);
constexpr size_t WS_SSQ2 = WS_SSQ + (size_t)NTOK * 4;
constexpr size_t WS_XB = WS_SSQ2 + (size_t)NTOK * 4;
constexpr size_t WS_C = WS_XB + (size_t)M1 * DM * 2;
constexpr size_t WS_Q = WS_C;
constexpr size_t WS_K = WS_Q + (size_t)NTOK * 512 * 2;
constexpr size_t WS_V = WS_K + (size_t)BATCH * 4 * 2 * KT * 8192;
constexpr size_t WS_HQ = WS_V + (size_t)BATCH * 4 * KT * 16384;
constexpr size_t WS_HV = WS_HQ + (size_t)BATCH * 4 * HT * 128 * 2;
constexpr size_t WS_HG = WS_HV + (size_t)BATCH * 4 * HT * 128 * 2;
constexpr size_t WS_SG = WS_HG + (size_t)BATCH * 4 * HT * 128 * 4;
constexpr size_t WS_CEND = WS_SG + (size_t)NTOK * 512 * 2;
constexpr size_t WS_PQ = WS_C;
constexpr size_t WS_EIDX = WS_PQ + (size_t)NTOK * 2048 * 2;
constexpr size_t WS_EGATE = WS_EIDX + (size_t)NTOK * 128 * 4;
constexpr size_t WS_HID = WS_EGATE + (size_t)NTOK * 128 * 4;
constexpr size_t WS_XN8 = WS_HID + (size_t)NTOK * 128 * 4;
constexpr size_t WS_XSC = WS_XN8 + (size_t)NTOK * DM;
constexpr size_t WS_C8 = WS_XSC + (size_t)NTOK * 4;
constexpr size_t WS_CSC = WS_C8 + (size_t)NTOK * 128;
static_assert(WS_CSC + (size_t)NTOK * 4 <= WS_CEND, "overlay fits");
constexpr size_t WS_HIDP = WS_PQ;
constexpr size_t WS_MIX = WS_CEND;
constexpr size_t WS_HQA = WS_MIX + (size_t)NTOK * DM * 2;
constexpr size_t WS_HD = WS_HQA + (size_t)BATCH * 4 * HT * 128 * 2;
constexpr size_t WS_END = WS_HD + (size_t)BATCH * 4 * 129 * 128 * 4;
static_assert(WS_END <= (size_t)512 * 1024 * 1024, "workspace map must fit 512 MiB");

struct Params {
    const float* x; const float* meta; const float* mix_norm_w; const float* w_in; const float* lb_logits; const float* rec_norm_w;
    const float* lq1; const float* lk1; const float* lq2; const float* lk2; const float* subln_w; const float* w_out; const float* ffn_norm_w;
    const float* wq; const float* subkeys; const float* pu; const float* pv; const float* final_w;
    float* out; unsigned char* ws;
};

DI unsigned f2bf(float f) { unsigned u = __builtin_bit_cast(unsigned, f); return (u + 0x7fffu + ((u >> 16) & 1u)) >> 16; }
DI float bf2f(unsigned b) { return __builtin_bit_cast(float, b << 16); }
DI unsigned cvtpk(float lo, float hi) { f32x2 v = {lo, hi}; bf16x2_t b = __builtin_convertvector(v, bf16x2_t); return __builtin_bit_cast(unsigned, b); }
DI float wave_sum(float v) {
#pragma unroll
    for (int o = 1; o < 64; o <<= 1) v += __shfl_xor(v, o);
    return v;
}
DI float sigmoidf_(float x) { return 1.f / (1.f + __expf(-x)); }
DI float siluf_(float x) { return x * sigmoidf_(x); }

DI int sigma_col(int c) {
    if (c >= 1024) return c;
    const int cc = c & 63, a = cc >> 5, fq = (cc >> 3) & 3, n = (cc >> 2) & 1, j = cc & 3;
    return (c & ~63) + 4 * (4 * a + fq) + 32 * n + j;
}
template <bool PERMUTE>
DI void p0_transpose_item(const float* W, int K, int N, const float* scale, bf16_t* WT, LAS float* scr, int item, int lane) {
    const int nblk = N / 32, kb = item / nblk, nb = item % nblk, k0 = 64 * kb, n0 = 32 * nb;
    const int ncol = PERMUTE ? sigma_col(n0 + (lane & 31)) : n0 + (lane & 31);
#pragma unroll 8
    for (int i = 0; i < 32; ++i) { const int kk = 2 * i + (lane >> 5); float s = scale ? scale[k0 + kk] : 1.f; scr[kk * 33 + (lane & 31)] = W[(size_t)(k0 + kk) * N + ncol] * s; }
    asm volatile("s_waitcnt lgkmcnt(0)" ::: "memory");
    const int c = lane & 7;
#pragma unroll
    for (int j = 0; j < 4; ++j) { const int n = (lane >> 3) + 8 * j; const LAS float* s = scr + (8 * c) * 33 + n;
        u32x4 o; o.x = cvtpk(s[0 * 33], s[1 * 33]); o.y = cvtpk(s[2 * 33], s[3 * 33]); o.z = cvtpk(s[4 * 33], s[5 * 33]); o.w = cvtpk(s[6 * 33], s[7 * 33]);
        *(u32x4*)(WT + (size_t)(n0 + n) * K + k0 + 8 * c) = o; }
    asm volatile("s_waitcnt lgkmcnt(0)" ::: "memory");
}

DI unsigned fp4_code(float x, float sc) {
    const float a = fabsf(x) * sc;
    const unsigned idx = (unsigned)(a > 0.25f) + (unsigned)(a > 0.75f) + (unsigned)(a > 1.25f) + (unsigned)(a > 1.75f) + (unsigned)(a > 2.5f) + (unsigned)(a > 3.5f) + (unsigned)(a > 5.0f);
    return idx | (x < 0.f ? 8u : 0u);
}
DI void table_fp8_rows(const Params& P, int first, int stride) {
    const int lane = tid_() & 63;
    unsigned char* ws = P.ws;
    for (int r = first; r < 2 * NEXP; r += stride) {
        const bool isv = r >= NEXP; const int e = isv ? r - NEXP : r;
        const f32x4* src = (const f32x4*)((isv ? P.pv : P.pu) + (size_t)e * DM) + lane;
        f32x4 v[4]; float amq[4];
#pragma unroll
        for (int q = 0; q < 4; ++q) { v[q] = src[64 * q]; amq[q] = fmaxf(fmaxf(fabsf(v[q].x), fabsf(v[q].y)), fmaxf(fabsf(v[q].z), fabsf(v[q].w))); }
#pragma unroll
        for (int o = 1; o < 64; o <<= 1) {
#pragma unroll
            for (int q = 0; q < 4; ++q) amq[q] = fmaxf(amq[q], __shfl_xor(amq[q], o));
        }
        if (isv) {
            const float am = fmaxf(fmaxf(amq[0], amq[1]), fmaxf(amq[2], amq[3]));
            const float sc = (am > 0.f) ? exp2f(floorf(log2f(224.f / am))) : 1.f;
            unsigned char* dst = ws + WS_VB + (size_t)e * 128;
#pragma unroll
            for (int q = 0; q < 4; ++q) {
                int w = __builtin_amdgcn_cvt_pk_fp8_f32(v[q].x * sc, v[q].y * sc, 0, false); w = __builtin_amdgcn_cvt_pk_fp8_f32(v[q].z * sc, v[q].w * sc, w, true);
                const int col = 256 * q + 4 * lane;
                *(unsigned*)(dst + (size_t)(col >> 7) * ((size_t)NEXP * 128) + (col & 127)) = (unsigned)w;
            }
            if (lane == 0) ((float*)(ws + WS_VSC))[e] = 1.f / sc;
        } else {
#pragma unroll
            for (int q = 0; q < 4; ++q) {
                const float sc = (amq[q] > 0.f) ? 6.f / amq[q] : 1.f;
                const unsigned w = fp4_code(v[q].x, sc) | (fp4_code(v[q].y, sc) << 4) | (fp4_code(v[q].z, sc) << 8) | (fp4_code(v[q].w, sc) << 12);
                *(unsigned short*)(ws + WS_UB + ((size_t)q * NEXP + e) * 128 + 2 * lane) = (unsigned short)w;
                if (lane == 0) ((float*)(ws + WS_USC))[(size_t)q * NEXP + e] = 1.f / sc;
            }
        }
    }
}

DI void phase0(const Params& P, char* lds, int bid, int nblk) {
    const int tid = tid_(), lane = tid & 63, wave = __builtin_amdgcn_readfirstlane(tid >> 6);
    unsigned char* ws = P.ws;
    LAS float* scr = (LAS float*)(lds) + wave * (64 * 33);
    const int gw = bid * NWAVES + wave, NGW = nblk * NWAVES;
    constexpr int I1 = (DM / 64) * (NCOL1 / 32), I2 = (DM / 64) * (DM / 32), I3 = (DM / 64) * (2048 / 32);
    for (int it = gw; it < I1 + I2 + I3; it += NGW) {
        int r = it;
        if (r < I1) { p0_transpose_item<true>(P.w_in, DM, NCOL1, P.mix_norm_w, (bf16_t*)(ws + WS_W1T), scr, r, lane); continue; } r -= I1;
        if (r < I2) { p0_transpose_item<false>(P.w_out, DM, DM, nullptr, (bf16_t*)(ws + WS_W2T), scr, r, lane); continue; } r -= I2;
        p0_transpose_item<false>(P.wq, DM, 2048, P.ffn_norm_w, (bf16_t*)(ws + WS_W3T), scr, r, lane);
    }
    for (int m = gw; m < M1; m += NGW) {
        bf16_t* orow = (bf16_t*)(ws + WS_XB) + (size_t)m * DM;
        float* r1 = (float*)(ws + WS_R1);
        unsigned long long* o8 = (unsigned long long*)orow + lane;
        if (m >= NTOK + NMETA) { for (int j = 0; j < 4; ++j) o8[64 * j] = 0ull; if (lane == 0) r1[m] = 0.f; continue; }
        const float* xrow = (m < NTOK) ? P.x + (size_t)m * DM : P.meta + (size_t)(m - NTOK) * DM;
        const f32x4* xr = (const f32x4*)xrow + lane;
        f32x4 v[4]; float s = 0.f;
#pragma unroll
        for (int j = 0; j < 4; ++j) { v[j] = xr[64 * j]; s += (v[j].x * v[j].x + v[j].y * v[j].y) + (v[j].z * v[j].z + v[j].w * v[j].w); }
        s = wave_sum(s);
        if (lane == 0) r1[m] = 1.f / sqrtf(s * (1.f / DM) + EPS);
#pragma unroll
        for (int j = 0; j < 4; ++j) o8[64 * j] = (unsigned long long)cvtpk(v[j].x, v[j].y) | ((unsigned long long)cvtpk(v[j].z, v[j].w) << 32);
    }
    {
        const size_t gt = (size_t)bid * NTHREADS + tid, NGT = (size_t)nblk * NTHREADS;
        const size_t ns = (size_t)16 * 128 * 128 / 8;
        for (size_t e = gt; e < ns; e += NGT) {
            const f32x4 a = ((const f32x4*)P.subkeys)[2 * e], b = ((const f32x4*)P.subkeys)[2 * e + 1];
            u32x4 o; o.x = cvtpk(a.x, a.y); o.y = cvtpk(a.z, a.w); o.z = cvtpk(b.x, b.y); o.w = cvtpk(b.z, b.w);
            ((u32x4*)(ws + WS_SKB))[e] = o;
        }
        float* rope = (float*)(ws + WS_ROPE);
        for (size_t i = gt; i < (size_t)TPOS * 32; i += NGT) {
            const int t = (int)(i >> 5), f = (int)(i & 31);
            const double inv = exp2(-(double)f * (13.287712379549449 / 32.0));
            const double ang = (double)t * inv;
            rope[(size_t)t * 64 + f] = (float)cos(ang); rope[(size_t)t * 64 + 32 + f] = (float)sin(ang);
        }
        float* ssq = (float*)(ws + WS_SSQ);
        for (size_t i = gt; i < (size_t)2 * NTOK; i += NGT) ssq[i] = 0.f;
        for (size_t i = gt; i < (size_t)BATCH * 4 * 2 * 512; i += NGT) { const size_t img = i >> 9, o = i & 511; ((u32x4*)(ws + WS_K + img * KT * 8192))[o] = (u32x4){0u, 0u, 0u, 0u}; }
        for (size_t i = gt; i < (size_t)BATCH * 4 * 1024; i += NGT) { const size_t img = i >> 10, o = i & 1023; ((u32x4*)(ws + WS_V + img * KT * 16384))[o] = (u32x4){0u, 0u, 0u, 0u}; }
        for (size_t i = gt; i < (size_t)BATCH * 4 * 16 * 16; i += NGT) { const size_t bh = i >> 8, o = i & 255;
            ((u32x4*)(ws + WS_HQ + bh * HT * 256))[o] = (u32x4){0u, 0u, 0u, 0u}; ((u32x4*)(ws + WS_HV + bh * HT * 256))[o] = (u32x4){0u, 0u, 0u, 0u}; }
        for (size_t i = gt; i < (size_t)BATCH * 4 * 16 * 32; i += NGT) { const size_t bh = i >> 9, o = i & 511; ((u32x4*)(ws + WS_HG + bh * HT * 512))[o] = (u32x4){0u, 0u, 0u, 0u}; }
        float* lb = (float*)(ws + WS_LB);
        if (gt < 512) lb[gt] = sigmoidf_(P.lb_logits[gt] - P.lb_logits[512 + gt]);
        if (bid == 0 && wave == 0) {
            const float a = wave_sum(P.lq1[lane] * P.lk1[lane]), b = wave_sum(P.lq2[lane] * P.lk2[lane]);
            if (lane == 0) lb[512] = __expf(a) - __expf(b) + LAM_INIT;
        }
    }
}

namespace pg8 {
#define PG8_LAS __attribute__((address_space(3)))
typedef unsigned short bf16_t;
typedef short bf16x8 __attribute__((ext_vector_type(8)));
typedef float f32x4 __attribute__((ext_vector_type(4)));
typedef unsigned u32x4 __attribute__((ext_vector_type(4)));
constexpr int BM = 256, BK = 64, HALF = 128, HTB = HALF * BK * 2  , STAGE_BYTES = 8 * HTB, NXCD = 8, WGM = 8;

__host__ __device__ __forceinline__ int lds_byte(int r, int c) { const int st = (r >> 4) * 2 + (c >> 5), rr = r & 15, cc = c & 31, ob = rr * 64 + cc * 2; return st * 1024 + (ob ^ (((ob >> 9) & 1) << 5)); }
__host__ __device__ __forceinline__ void stage_rc(int b, int& R, int& C) { const int st = b / 1024, sb = b % 1024, swz = sb ^ (((sb >> 9) & 1) << 5); R = (st >> 1) * 16 + swz / 64; C = (st & 1) * 32 + (swz % 64) / 2; }
__host__ __device__ __forceinline__ int perm32(int rho) { const int n = rho >> 4, i = rho & 15; return 8 * (i >> 2) + 4 * n + (i & 3); }

struct Unit { int pm, pn; };
struct Gemm { const bf16_t* A; const bf16_t* Bt; int M, N, K; };

struct StaticOrder {
    int nM, nN, nwg, G, c;
    __host__ __device__ void init(int M, int N, int G_, int c_) { nM = M / BM; nN = N / BM; nwg = nM * nN; G = G_; c = c_; }
    __host__ __device__ bool next(int i, Unit& u) const {
        const long L = (long)i * G + c; if (L >= nwg) return false;
        int wgid = (int)L; { const int q = nwg / NXCD, r = nwg % NXCD, xcd = wgid % NXCD, off = wgid / NXCD; wgid = (xcd < r ? xcd * (q + 1) : r * (q + 1) + (xcd - r) * q) + off; }
        const int nig = WGM * nN, gid = wgid / nig, fm = gid * WGM, gsz = (nM - fm) < WGM ? (nM - fm) : WGM;
        u.pm = fm + ((wgid % nig) % gsz); u.pn = (wgid % nig) / gsz; return true;
    }
    __device__ __forceinline__ void a_ready(const Unit&) const {}
    __device__ __forceinline__ void done(const Unit&) const {}
};

template <class Epi, class Sched, bool ALIGN_EPI = false, bool SP2 = false>
__device__ __forceinline__ void gemm_phase(PG8_LAS unsigned char* lds, const Gemm g, const Sched& S, const Epi& E) {
    const int tid = tid_(), wid = __builtin_amdgcn_readfirstlane(tid >> 6), lane = tid & 63, wr = wid >> 2, wc = wid & 3, fr = lane & 15, fq = lane >> 4;
    const int K = g.K, nt = K / BK;
    unsigned voffA[2], voffB[2];
#pragma unroll
    for (int i = 0; i < 2; ++i) { int R, C; stage_rc(tid * 16 + i * 8192, R, C); const int Rb = Epi::PERM ? ((R & ~31) + perm32(R & 31)) : R;
        voffA[i] = (unsigned)(R * K + C) * 2u; voffB[i] = (unsigned)(Rb * K + C) * 2u; }
    const size_t kstep = (size_t)(BK * 2);
    const size_t hstep = (size_t)HALF * K * 2;
    const size_t tstep = 2 * hstep;
    const unsigned ldsw = (unsigned)wid * 1024u;
    const int aoff = lds_byte(wr * 64 + fr, fq * 8), boff = lds_byte(wc * 32 + fr, fq * 8);
#define PG8_SA(b, h) (((b) * 2 + (h)) * HTB)
#define PG8_SB(b, h) ((4 + (b) * 2 + (h)) * HTB)
#define PG8_STAGE(bufoff, gbase, voff) do { _Pragma("unroll") for (int _i = 0; _i < 2; ++_i) \
        __builtin_amdgcn_global_load_lds((const unsigned*)((const char*)(gbase) + (voff)[_i]), (PG8_LAS unsigned*)(lds + (bufoff) + ldsw + _i * 8192), 16, 0, 0); } while (0)
#define PG8_LDA(dst, b, h) do { _Pragma("unroll") for (int m = 0; m < 4; ++m) _Pragma("unroll") for (int k = 0; k < 2; ++k) dst[m][k] = *(const PG8_LAS bf16x8*)(lds + PG8_SA(b, h) + aoff + m * 2048 + k * 1024); } while (0)
#define PG8_LDB(dst, b, h) do { _Pragma("unroll") for (int n = 0; n < 2; ++n) _Pragma("unroll") for (int k = 0; k < 2; ++k) dst[n][k] = *(const PG8_LAS bf16x8*)(lds + PG8_SB(b, h) + boff + n * 2048 + k * 1024); } while (0)
#define PG8_MMA(ai, bj, At, Bt) do { __builtin_amdgcn_s_setprio(1); _Pragma("unroll") for (int m = 0; m < 4; ++m) _Pragma("unroll") for (int n = 0; n < 2; ++n) _Pragma("unroll") for (int k = 0; k < 2; ++k) \
        acc[ai][bj][m][n] = __builtin_amdgcn_mfma_f32_16x16x32_bf16(Bt[n][k], At[m][k], acc[ai][bj][m][n], 0, 0, 0); __builtin_amdgcn_s_setprio(0); } while (0)
#define PG8_WAIT_V(n) asm volatile("s_waitcnt vmcnt(" #n ")" ::: "memory")
#define PG8_WAIT_L(n) asm volatile("s_waitcnt lgkmcnt(" #n ")" ::: "memory")
#define PG8_BAR __builtin_amdgcn_s_barrier()
#define PG8_SCHED __builtin_amdgcn_sched_barrier(0)
    Unit cur, nxt; int ui = 0;
    if (!S.next(0, cur)) return;
    f32x4 acc[2][2][4][2];
#pragma unroll
    for (int a = 0; a < 2; ++a)
#pragma unroll
        for (int b = 0; b < 2; ++b)
#pragma unroll
            for (int m = 0; m < 4; ++m)
#pragma unroll
                for (int n = 0; n < 2; ++n) acc[a][b][m][n] = (f32x4){0.f, 0.f, 0.f, 0.f};
    bf16x8 At[4][2], B0[2][2], B1[2][2];
    const char* cA = (const char*)g.A + (size_t)cur.pm * tstep; const char* cB = (const char*)g.Bt + (size_t)cur.pn * tstep;
    S.a_ready(cur);
    if constexpr (SP2) {
        PG8_STAGE(PG8_SB(0, 0), cB, voffB); PG8_STAGE(PG8_SB(0, 1), cB + hstep, voffB); PG8_STAGE(PG8_SA(0, 0), cA, voffA); PG8_STAGE(PG8_SA(0, 1), cA + hstep, voffA);
        if (wr == 1) PG8_BAR;
        PG8_WAIT_V(2); PG8_BAR;
        PG8_STAGE(PG8_SB(1, 0), cB + kstep, voffB); PG8_STAGE(PG8_SA(1, 0), cA + kstep, voffA); PG8_STAGE(PG8_SB(1, 1), cB + hstep + kstep, voffB);
        PG8_WAIT_V(6); PG8_BAR;
    } else {
        PG8_STAGE(PG8_SB(0, 0), cB, voffB); PG8_STAGE(PG8_SA(0, 0), cA, voffA); PG8_STAGE(PG8_SB(0, 1), cB + hstep, voffB); PG8_STAGE(PG8_SA(0, 1), cA + hstep, voffA);
        if (wr == 1) PG8_BAR;
        PG8_WAIT_V(4); PG8_BAR;
        PG8_STAGE(PG8_SB(1, 0), cB + kstep, voffB); PG8_STAGE(PG8_SA(1, 0), cA + kstep, voffA); PG8_STAGE(PG8_SB(1, 1), cB + hstep + kstep, voffB);
        PG8_WAIT_V(6); PG8_BAR;
    }
    for (;;) {
        const bool has_next = S.next(ui + 1, nxt);
        const char* nA = has_next ? (const char*)g.A + (size_t)nxt.pm * tstep : cA; const char* nB = has_next ? (const char*)g.Bt + (size_t)nxt.pn * tstep : cB;
        for (int t = 0; t < nt; t += 2) {
            const bool last = (t == nt - 2);
            const char* a1 = cA + (size_t)(t + 1) * kstep;
            const char* a2 = last ? nA : cA + (size_t)(t + 2) * kstep; const char* b2 = last ? nB : cB + (size_t)(t + 2) * kstep;
            const char* a3 = a2 + kstep; const char* b3 = b2 + kstep;
            if (last && has_next) S.a_ready(nxt);
            if constexpr (SP2) {
            PG8_LDB(B0, 0, 0); PG8_LDB(B1, 0, 1); PG8_SCHED; PG8_LDA(At, 0, 0); PG8_STAGE(PG8_SA(1, 1), a1 + hstep, voffA);
            PG8_WAIT_V(8); PG8_WAIT_L(0); PG8_BAR; PG8_MMA(0, 0, At, B0); PG8_MMA(0, 1, At, B1); PG8_BAR; PG8_SCHED;
            PG8_LDA(At, 0, 1); PG8_STAGE(PG8_SB(0, 0), b2, voffB); PG8_STAGE(PG8_SB(0, 1), b2 + hstep, voffB); PG8_STAGE(PG8_SA(0, 0), a2, voffA);
            PG8_WAIT_V(8); PG8_WAIT_L(0); PG8_BAR; PG8_MMA(1, 0, At, B0); PG8_MMA(1, 1, At, B1); PG8_BAR; PG8_SCHED;
            PG8_LDB(B0, 1, 0); PG8_LDB(B1, 1, 1); PG8_SCHED; PG8_LDA(At, 1, 0); PG8_STAGE(PG8_SA(0, 1), a2 + hstep, voffA);
            PG8_WAIT_V(8); PG8_WAIT_L(0); PG8_BAR; PG8_MMA(0, 0, At, B0); PG8_MMA(0, 1, At, B1); PG8_BAR; PG8_SCHED;
            PG8_LDA(At, 1, 1); PG8_STAGE(PG8_SB(1, 0), b3, voffB); PG8_STAGE(PG8_SB(1, 1), b3 + hstep, voffB); PG8_STAGE(PG8_SA(1, 0), a3, voffA);
            PG8_WAIT_V(8); PG8_WAIT_L(0); PG8_BAR; PG8_MMA(1, 0, At, B0); PG8_MMA(1, 1, At, B1); PG8_BAR; PG8_SCHED;
            } else {
            PG8_LDB(B0, 0, 0); PG8_SCHED; PG8_LDA(At, 0, 0); PG8_STAGE(PG8_SA(1, 1), a1 + hstep, voffA);
            PG8_WAIT_L(8); PG8_BAR; PG8_WAIT_L(0); PG8_MMA(0, 0, At, B0); PG8_BAR; PG8_SCHED;
            PG8_LDB(B1, 0, 1); PG8_STAGE(PG8_SB(0, 0), b2, voffB);
            PG8_BAR; PG8_WAIT_L(0); PG8_MMA(0, 1, At, B1); PG8_BAR;
            PG8_LDA(At, 0, 1); PG8_STAGE(PG8_SA(0, 0), a2, voffA);
            PG8_BAR; PG8_WAIT_L(0); PG8_MMA(1, 0, At, B0); PG8_BAR; PG8_SCHED;
            PG8_STAGE(PG8_SB(0, 1), b2 + hstep, voffB);
            PG8_WAIT_V(6); PG8_BAR; PG8_MMA(1, 1, At, B1); PG8_BAR;
            PG8_LDB(B0, 1, 0); PG8_SCHED; PG8_LDA(At, 1, 0); PG8_STAGE(PG8_SA(0, 1), a2 + hstep, voffA);
            PG8_WAIT_L(8); PG8_BAR; PG8_WAIT_L(0); PG8_MMA(0, 0, At, B0); PG8_BAR; PG8_SCHED;
            PG8_LDB(B1, 1, 1); PG8_STAGE(PG8_SB(1, 0), b3, voffB);
            PG8_BAR; PG8_WAIT_L(0); PG8_MMA(0, 1, At, B1); PG8_BAR;
            PG8_LDA(At, 1, 1); PG8_STAGE(PG8_SA(1, 0), a3, voffA);
            PG8_BAR; PG8_WAIT_L(0); PG8_MMA(1, 0, At, B0); PG8_BAR; PG8_SCHED;
            PG8_STAGE(PG8_SB(1, 1), b3 + hstep, voffB);
            PG8_WAIT_V(6); PG8_BAR; PG8_MMA(1, 1, At, B1); PG8_BAR;
            }
        }
        if constexpr (ALIGN_EPI) { if (wr == 0) PG8_BAR; }
        if constexpr (!Epi::AFTER_DRAIN) { E(acc, cur, wr, wc, fr, fq); S.done(cur); }
        if (!has_next) break;
#pragma unroll
        for (int a = 0; a < 2; ++a)
#pragma unroll
            for (int b = 0; b < 2; ++b)
#pragma unroll
                for (int m = 0; m < 4; ++m)
#pragma unroll
                    for (int n = 0; n < 2; ++n) acc[a][b][m][n] = (f32x4){0.f, 0.f, 0.f, 0.f};
        cur = nxt; cA = nA; cB = nB; ++ui;
        if constexpr (ALIGN_EPI) { if (wr == 1) PG8_BAR; }
    }
    PG8_WAIT_V(0);
    if constexpr (!ALIGN_EPI) { if (wr == 0) PG8_BAR; }
    PG8_BAR;
    if constexpr (Epi::AFTER_DRAIN) { E.fused(acc, cur, wr, wc, fr, fq, lds, wid, lane); S.done(cur); }
#undef PG8_SA
#undef PG8_SB
#undef PG8_STAGE
#undef PG8_LDA
#undef PG8_LDB
#undef PG8_MMA
#undef PG8_WAIT_V
#undef PG8_WAIT_L
#undef PG8_BAR
#undef PG8_SCHED
}
}

DI u32x2 pack4(f32x4 v) { u32x2 r; r.x = cvtpk(v.x, v.y); r.y = cvtpk(v.z, v.w); return r; }
DI u32x4 pack8(f32x4 a, f32x4 b) { u32x4 r; r.x = cvtpk(a.x, a.y); r.y = cvtpk(a.z, a.w); r.z = cvtpk(b.x, b.y); r.w = cvtpk(b.z, b.w); return r; }

struct Epi1 {
    static constexpr bool PERM = true, AFTER_DRAIN = false;
    unsigned char* ws;
    DI void operator()(const f32x4 (&acc)[2][2][4][2], const pg8::Unit& u, int wr, int wc, int fr, int fq) const {
        const float* r1p = (const float*)(ws + WS_R1);
        const float* rope = (const float*)(ws + WS_ROPE);
        const float* lbp = (const float*)(ws + WS_LB);
        const int seg = u.pn >> 1;
#pragma unroll
        for (int ai = 0; ai < 2; ++ai)
#pragma unroll
            for (int m = 0; m < 4; ++m) {
                const int row = u.pm * 256 + ai * 128 + wr * 64 + m * 16 + fr;
                const bool meta = row >= NTOK;
                if (row >= NTOK + NMETA) continue;
                const float r1 = r1p[row];
                const int b = meta ? 0 : (row >> 12), t = meta ? (row - NTOK) : ((row & 4095) + NMETA);
                const int nrep = meta ? BATCH : 1;
#pragma unroll
                for (int bj = 0; bj < 2; ++bj) {
                    const int cs = (u.pn & 1) * 256 + bj * 128 + wc * 32 + 8 * fq;
                    const f32x4 v0 = acc[ai][bj][m][0] * r1, v1 = acc[ai][bj][m][1] * r1;
                    const int h = cs >> 7;
                    if (seg <= 1) {
                        const int comp = (cs >> 6) & 1, cc = cs & 63, i0 = 16 * (cc >> 5) + 4 * fq;
                        const f32x4 c4 = *(const f32x4*)(rope + (size_t)t * 64 + i0), s4 = *(const f32x4*)(rope + (size_t)t * 64 + 32 + i0);
                        f32x4 lo = v0 * c4 - v1 * s4, hi = v1 * c4 + v0 * s4;
                        if (seg == 0) {
                            if (meta) continue;
                            lo = lo * QSCALE; hi = hi * QSCALE;
                            bf16_t* qp = (bf16_t*)(ws + WS_Q) + ((size_t)(((b * 4 + h) * 2 + comp) * SEQ + (row & 4095))) * 64;
                            *(u32x2*)(qp + i0) = pack4(lo); *(u32x2*)(qp + i0 + 32) = pack4(hi);
                        } else {
                            const int pp = t + KPAD, tile = pp >> 6, key = pp & 63;
                            for (int bb = 0; bb < nrep; ++bb) {
                                const int b_ = meta ? bb : b;
                                unsigned char* img = ws + WS_K + ((size_t)((b_ * 4 + h) * 2 + comp) * KT + tile) * 8192;
                                *(u32x2*)(img + (i0 >> 3) * 1024 + key * 16 + (i0 & 7) * 2) = pack4(lo);
                                *(u32x2*)(img + ((i0 >> 3) + 4) * 1024 + key * 16 + (i0 & 7) * 2) = pack4(hi);
                            }
                        }
                    } else if (seg == 2) {
                        const int dv = cs & 127, pp = t + KPAD, tile = pp >> 6, key = pp & 63;
                        const u32x4 w = pack8(v0, v1);
                        for (int bb = 0; bb < nrep; ++bb) {
                            const int b_ = meta ? bb : b;
                            unsigned char* img = ws + WS_V + ((size_t)(b_ * 4 + h) * KT + tile) * 16384;
                            *(u32x4*)(img + (dv >> 5) * 4096 + key * 64 + (dv & 31) * 2) = w;
                        }
                    } else if (seg == 3 || seg == 5) {
                        const int dv = cs & 127;
                        f32x4 a = v0, c = v1;
                        if (seg == 3) { a.x = siluf_(a.x); a.y = siluf_(a.y); a.z = siluf_(a.z); a.w = siluf_(a.w); c.x = siluf_(c.x); c.y = siluf_(c.y); c.z = siluf_(c.z); c.w = siluf_(c.w); }
                        const u32x4 w = pack8(a, c);
                        const size_t base = (seg == 3) ? WS_HQ : WS_HV;
                        for (int bb = 0; bb < nrep; ++bb) {
                            const int b_ = meta ? bb : b;
                            *(u32x4*)((bf16_t*)(ws + base) + ((size_t)(b_ * 4 + h) * HT + t + 16) * 128 + dv) = w;
                        }
                    } else if (seg == 4) {
                        const int dv = cs & 127;
                        const f32x4 l0 = *(const f32x4*)(lbp + cs), l1 = *(const f32x4*)(lbp + cs + 4);
                        f32x4 g0, g1;
#pragma unroll
                        for (int e = 0; e < 4; ++e) { g0[e] = __logf(l0[e] + (1.f - l0[e]) * sigmoidf_(v0[e])); g1[e] = __logf(l1[e] + (1.f - l1[e]) * sigmoidf_(v1[e])); }
                        for (int bb = 0; bb < nrep; ++bb) {
                            const int b_ = meta ? bb : b;
                            float* gp = (float*)(ws + WS_HG) + ((size_t)(b_ * 4 + h) * HT + t + 16) * 128 + dv;
                            *(f32x4*)gp = g0; *(f32x4*)(gp + 4) = g1;
                        }
                    } else {
                        if (meta) continue;
                        f32x4 a = v0, c = v1;
                        a.x = siluf_(a.x); a.y = siluf_(a.y); a.z = siluf_(a.z); a.w = siluf_(a.w); c.x = siluf_(c.x); c.y = siluf_(c.y); c.z = siluf_(c.z); c.w = siluf_(c.w);
                        *(u32x4*)((bf16_t*)(ws + WS_SG) + (size_t)row * 512 + cs) = pack8(a, c);
                    }
                }
            }
    }
};

struct Epi3 {
    static constexpr bool PERM = true, AFTER_DRAIN = false;
    const float* x; float* H; bf16_t* HB; float* ssq;
    DI void operator()(const f32x4 (&acc)[2][2][4][2], const pg8::Unit& u, int wr, int wc, int fr, int fq) const {
#pragma unroll
        for (int ai = 0; ai < 2; ++ai)
#pragma unroll
            for (int m = 0; m < 4; ++m) {
                const int row = u.pm * 256 + ai * 128 + wr * 64 + m * 16 + fr;
                float s = 0.f;
#pragma unroll
                for (int bj = 0; bj < 2; ++bj) {
                    const int col = u.pn * 256 + bj * 128 + wc * 32 + 8 * fq;
                    const size_t o = (size_t)row * DM + col;
                    const u32x4 xb = *(const u32x4*)(HB + o);
                    const f32x4 x0 = (f32x4){bf2f(xb.x & 0xffffu), bf2f(xb.x >> 16), bf2f(xb.y & 0xffffu), bf2f(xb.y >> 16)}, x1 = (f32x4){bf2f(xb.z & 0xffffu), bf2f(xb.z >> 16), bf2f(xb.w & 0xffffu), bf2f(xb.w >> 16)};
                    const f32x4 h0 = x0 + acc[ai][bj][m][0], h1 = x1 + acc[ai][bj][m][1];
                    *(u32x4*)(HB + o) = pack8(h0, h1);
                    s += (h0.x * h0.x + h0.y * h0.y) + (h0.z * h0.z + h0.w * h0.w) + (h1.x * h1.x + h1.y * h1.y) + (h1.z * h1.z + h1.w * h1.w);
                }
                s += __shfl_xor(s, 16); s += __shfl_xor(s, 32);
                if (fq == 0) atomicAdd(ssq + row, s);
            }
    }
};

struct Epi4 {
    static constexpr bool PERM = true, AFTER_DRAIN = false;
    const float* ssq; bf16_t* PQ;
    DI void operator()(const f32x4 (&acc)[2][2][4][2], const pg8::Unit& u, int wr, int wc, int fr, int fq) const {
#pragma unroll
        for (int ai = 0; ai < 2; ++ai)
#pragma unroll
            for (int m = 0; m < 4; ++m) {
                const int row = u.pm * 256 + ai * 128 + wr * 64 + m * 16 + fr;
                const float r2 = 1.f / sqrtf(ssq[row] * (1.f / DM) + EPS);
#pragma unroll
                for (int bj = 0; bj < 2; ++bj) {
                    const int col = u.pn * 256 + bj * 128 + wc * 32 + 8 * fq;
                    *(u32x4*)(PQ + (size_t)row * 2048 + col) = pack8(acc[ai][bj][m][0] * r2, acc[ai][bj][m][1] * r2);
                }
            }
    }
};

template <class Epi>
DI void gemm_run(char* lds, const bf16_t* A, const bf16_t* Bt, int M, int N, int K, const Epi& E, int bid, int nblk) {
    pg8::Gemm g{A, Bt, M, N, K}; pg8::StaticOrder S; S.init(M, N, nblk, bid);
    pg8::gemm_phase<Epi, pg8::StaticOrder, true, true>((LAS unsigned char*)lds, g, S, E);
}
#define MFMA32(a, b, c) __builtin_amdgcn_mfma_f32_32x32x16_bf16(a, b, c, 0, 0, 0)
typedef short v4i16_t __attribute__((ext_vector_type(4)));
DI int crow(int r, int hi) { return (r & 3) + 8 * (r >> 2) + 4 * hi; }
DI s16x4 vtr(const LAS char* p) { return __builtin_bit_cast(s16x4, __builtin_amdgcn_ds_read_tr16_b64_v4i16((LAS v4i16_t*)p)); }
DI void glds16(const void* g, LAS char* l) { __builtin_amdgcn_global_load_lds((const unsigned*)g, (LAS unsigned*)l, 16, 0, 0); }
DI float swap_max(float m) { auto rr = __builtin_amdgcn_permlane32_swap(__float_as_uint(m), __float_as_uint(m), false, false); return fmaxf(__uint_as_float(rr[0]), __uint_as_float(rr[1])); }
DI float swap_sum(float m) { auto rr = __builtin_amdgcn_permlane32_swap(__float_as_uint(m), __float_as_uint(m), false, false); return __uint_as_float(rr[0]) + __uint_as_float(rr[1]); }
constexpr int ATT_BUF = 32768, ATT_WSF = 65536;
constexpr float ATT_THR = 8.f;

DI void attn_unit(const Params& P, int b, int h, int j, char* lds_g) {
    LAS char* lds = (LAS char*)lds_g;
    const int tid = tid_(), lane = tid & 63, r32 = lane & 31, hi = lane >> 5;
    const int wid = __builtin_amdgcn_readfirstlane(tid >> 6), comp = wid >> 2, wq = wid & 3;
    const unsigned char* ws = P.ws;
    const int bh = b * 4 + h;
    const bf16_t* Qw = (const bf16_t*)(ws + WS_Q) + ((size_t)((bh * 2 + comp) * SEQ + 128 * j + 32 * wq)) * 64;
    bf16x8 qr[4];
#pragma unroll
    for (int d0 = 0; d0 < 4; ++d0) qr[d0] = *(const bf16x8*)(Qw + r32 * 64 + d0 * 16 + hi * 8);
    const unsigned char* kimg0 = ws + WS_K + (size_t)(bh * 2) * KT * 8192 + wid * 1024 + lane * 16;
    const unsigned char* kimg1 = kimg0 + (size_t)KT * 8192;
    const unsigned char* vimg = ws + WS_V + (size_t)bh * KT * 16384 + wid * 1024 + lane * 16;
    const int NT = 2 * j + 3, my_last = (wq < 2) ? 2 * j + 1 : 2 * j + 2;
    LAS float* wsf = (LAS float*)(lds + ATT_WSF) + wid * 64;
#define ATT_ISSUE(t, s) do { LAS char* d_ = lds + (s) * ATT_BUF + wid * 1024; \
        glds16(kimg0 + (size_t)(t) * 8192, d_); glds16(kimg1 + (size_t)(t) * 8192, d_ + 8192); \
        glds16(vimg + (size_t)(t) * 16384, d_ + 16384); glds16(vimg + (size_t)(t) * 16384 + 8192, d_ + 24576); } while (0)
    f32x16 o[4];
#pragma unroll
    for (int nb = 0; nb < 4; ++nb) o[nb] = f32x16{};
    float mref = 0.f, lsum = 0.f;
    const int qpos = 64 + 128 * j + 32 * wq + r32;
    ATT_ISSUE(0, 0);
    __syncthreads();
    for (int t = 0; t < NT; ++t) {
        const int s = t & 1;
        if (t + 1 < NT) ATT_ISSUE(t + 1, s ^ 1);
        if (t <= my_last) {
            const LAS char* kp = lds + s * ATT_BUF + comp * 8192 + hi * 1024 + r32 * 16;
            f32x16 s0 = f32x16{}, s1 = f32x16{};
#pragma unroll
            for (int d0 = 0; d0 < 4; ++d0) {
                const bf16x8 k0 = *(const LAS bf16x8*)(kp + d0 * 2048), k1 = *(const LAS bf16x8*)(kp + d0 * 2048 + 512);
                s0 = MFMA32(k0, qr[d0], s0); s1 = MFMA32(k1, qr[d0], s1);
            }
            if (t == 0) {
#pragma unroll
                for (int r = 0; r < 16; ++r) { s0[r] = -INFINITY; if (32 + crow(r, hi) < KPAD) s1[r] = -INFINITY; }
            }
            if (t >= 2 * j + 1) {
                const int kb = 64 * t + 4 * hi;
#pragma unroll
                for (int r = 0; r < 16; ++r) { const int kv = kb + (r & 3) + 8 * (r >> 2); if (kv > qpos) s0[r] = -INFINITY; if (kv + 32 > qpos) s1[r] = -INFINITY; }
            }
            float rm = fmaxf(s0[0], s1[0]);
#pragma unroll
            for (int r = 1; r < 16; ++r) rm = fmaxf(rm, fmaxf(s0[r], s1[r]));
            rm = swap_max(rm);
            if (t == 0) mref = rm;
            else {
                const float grow = rm - mref;
                if (__any(grow > ATT_THR)) {
                    const float dl = fmaxf(grow, 0.f), f = __builtin_amdgcn_exp2f(-dl);
                    mref += dl; lsum *= f;
                    if (hi == 0) wsf[r32] = f;
                    asm volatile("s_waitcnt lgkmcnt(0)" ::: "memory");
#pragma unroll
                    for (int r = 0; r < 16; ++r) { const float fr_ = wsf[crow(r, hi)];
#pragma unroll
                        for (int nb = 0; nb < 4; ++nb) o[nb][r] *= fr_; }
                }
            }
            float ps = 0.f;
#pragma unroll
            for (int r = 0; r < 16; ++r) { s0[r] = __builtin_amdgcn_exp2f(s0[r] - mref); s1[r] = __builtin_amdgcn_exp2f(s1[r] - mref); ps += s0[r] + s1[r]; }
            lsum += ps;
            const LAS char* vp = lds + s * ATT_BUF + 16384 + ((lane >> 4) & 1) * 32 + (lane & 3) * 8 + (4 * hi + ((lane & 15) >> 2)) * 64;
#pragma unroll
            for (int ks = 0; ks < 4; ++ks) {
                u32x4 pw;
                if (ks < 2) { pw.x = cvtpk(s0[8 * ks], s0[8 * ks + 1]); pw.y = cvtpk(s0[8 * ks + 2], s0[8 * ks + 3]); pw.z = cvtpk(s0[8 * ks + 4], s0[8 * ks + 5]); pw.w = cvtpk(s0[8 * ks + 6], s0[8 * ks + 7]); }
                else { const int q_ = ks - 2; pw.x = cvtpk(s1[8 * q_], s1[8 * q_ + 1]); pw.y = cvtpk(s1[8 * q_ + 2], s1[8 * q_ + 3]); pw.z = cvtpk(s1[8 * q_ + 4], s1[8 * q_ + 5]); pw.w = cvtpk(s1[8 * q_ + 6], s1[8 * q_ + 7]); }
                const bf16x8 pa = __builtin_bit_cast(bf16x8, pw);
#pragma unroll
                for (int nb = 0; nb < 4; ++nb) {
                    const s16x4 vlo = vtr(vp + nb * 4096 + ks * 1024), vhi = vtr(vp + nb * 4096 + ks * 1024 + 512);
                    const bf16x8 vb = (bf16x8){vlo[0], vlo[1], vlo[2], vlo[3], vhi[0], vhi[1], vhi[2], vhi[3]};
                    o[nb] = MFMA32(pa, vb, o[nb]);
                }
            }
        }
        __syncthreads();
    }
#undef ATT_ISSUE
    lsum = swap_sum(lsum);
    if (hi == 0) wsf[r32] = lsum;
    asm volatile("s_waitcnt lgkmcnt(0)" ::: "memory");
    float rli[16];
#pragma unroll
    for (int r = 0; r < 16; ++r) rli[r] = 1.f / wsf[crow(r, hi)];
    const float lam = ((const float*)(ws + WS_LB))[512];
    LAS float* ex = (LAS float*)lds + wq * 4096;
    if (comp == 1) {
#pragma unroll
        for (int r = 0; r < 16; ++r)
#pragma unroll
            for (int nb = 0; nb < 4; ++nb) ex[(r * 4 + nb) * 64 + lane] = o[nb][r] * rli[r] * lam;
    }
    __syncthreads();
    if (comp == 0) {
        float ss[16];
#pragma unroll
        for (int r = 0; r < 16; ++r) { float a = 0.f;
#pragma unroll
            for (int nb = 0; nb < 4; ++nb) { const float v = o[nb][r] * rli[r] - ex[(r * 4 + nb) * 64 + lane]; o[nb][r] = v; a += v * v; }
            ss[r] = a; }
#pragma unroll
        for (int r = 0; r < 16; ++r) { float a = ss[r]; a += __shfl_xor(a, 1); a += __shfl_xor(a, 2); a += __shfl_xor(a, 4); a += __shfl_xor(a, 8); a += __shfl_xor(a, 16); ss[r] = (1.f - LAM_INIT) / sqrtf(a * (1.f / 128.f) + EPS); }
        bf16_t* mix = (bf16_t*)(ws + WS_MIX) + ((size_t)(b * SEQ + 128 * j + 32 * wq)) * DM + h * 128;
#pragma unroll
        for (int nb = 0; nb < 4; ++nb) { const float w = P.subln_w[32 * nb + r32];
#pragma unroll
            for (int r = 0; r < 16; ++r) mix[(size_t)crow(r, hi) * DM + 32 * nb + r32] = (bf16_t)f2bf(o[nb][r] * ss[r] * w); }
    }
    __syncthreads();
}
#define MFMA16(a, b, c) __builtin_amdgcn_mfma_f32_16x16x32_bf16(a, b, c, 0, 0, 0)
constexpr int HG_STR = 272;
constexpr int HL_QA = 0, HL_QB = HL_QA + 32 * HG_STR, HL_KB = HL_QB + 32 * HG_STR, HL_KT = HL_KB + 32 * HG_STR, HL_VV = HL_KT + 32 * HG_STR;
constexpr int HL_PS = HL_VV + 32 * HG_STR;
constexpr int HL_D = HL_PS + 4 * 128 * 4;
constexpr int HL_OUT = HL_D + 128 * 4;
constexpr int HL_END = HL_OUT + 32 * 132 * 4;

constexpr int HB_KTF = 0, HB_ATF = 8192, HB_DF = 10240;
DI void hgrn_prep_item(const Params& P, int bh, int c, char* lds_g) {
    LAS char* lds = (LAS char*)lds_g;
    const int tid = tid_(), lane = tid & 63, c16 = lane & 15, g4 = lane >> 4, ch = tid & 127, part = tid >> 7;
    const int wid = __builtin_amdgcn_readfirstlane(tid >> 6);
    const int vrow = tid >> 4, vcol = (tid & 15) * 8;
    unsigned char* ws = P.ws;
    const float* HG = (const float*)(ws + WS_HG) + (size_t)bh * HT * 128;
    const bf16_t* HQ = (const bf16_t*)(ws + WS_HQ) + (size_t)bh * HT * 128;
    const bf16_t* HV = (const bf16_t*)(ws + WS_HV) + (size_t)bh * HT * 128;
    const size_t r0 = (size_t)(32 * c + 8 * part);
    float g8[8], p8[8]; unsigned short q8[8];
    { float a = 0.f;
#pragma unroll
      for (int e = 0; e < 8; ++e) { g8[e] = HG[(r0 + e) * 128 + ch]; q8[e] = HQ[(r0 + e) * 128 + ch]; a += g8[e]; p8[e] = a; } }
    const u32x4 v16 = *(const u32x4*)(HV + ((size_t)(32 * c) + vrow) * 128 + vcol);
    ((LAS float*)(lds + HL_PS))[part * 128 + ch] = p8[7];
    __syncthreads();
    {
        const LAS float* ps = (const LAS float*)(lds + HL_PS);
        const float t0 = ps[ch], t1 = ps[128 + ch], t2 = ps[256 + ch], t3 = ps[384 + ch];
        const float off = (part > 0 ? t0 : 0.f) + (part > 1 ? t1 : 0.f) + (part > 2 ? t2 : 0.f);
        const float mid = t0 + t1, last = mid + t2 + t3;
        const float em = __expf(mid), el = __expf(last - mid);
        if (part == 0) ((LAS float*)(lds + HL_D))[ch] = __expf(last);
#pragma unroll
        for (int e = 0; e < 8; ++e) {
            const int tk = 8 * part + e;
            const float cum = off + p8[e];
            const float e1 = __expf(cum - mid), e2 = 1.f / e1;
            const float q = bf2f(q8[e]), k = 1.f - __expf(g8[e]);
            const float qb = q * e1, qa = qb * em, kb = k * e2, kt = kb * el;
            *(LAS bf16_t*)(lds + HL_QA + tk * HG_STR + ch * 2) = (bf16_t)f2bf(qa);
            *(LAS bf16_t*)(lds + HL_QB + tk * HG_STR + ch * 2) = (bf16_t)f2bf(qb);
            *(LAS bf16_t*)(lds + HL_KB + tk * HG_STR + ch * 2) = (bf16_t)f2bf(kb);
            *(LAS bf16_t*)(lds + HL_KT + tk * HG_STR + ch * 2) = (bf16_t)f2bf(kt);
        }
        *(LAS u32x4*)(lds + HL_VV + vrow * HG_STR + vcol * 2) = v16;
    }
    __syncthreads();
    unsigned char* qaf = ws + WS_HQA + ((size_t)bh * 129 + c) * 8192;
    unsigned char* hgb = ws + WS_HG + (size_t)bh * HT * 512 + (size_t)c * 16384;
    {
        const int ks = wid >> 1, nt = wid & 1;
        const LAS char* qp = lds + HL_QA + (16 * nt + c16) * HG_STR + (32 * ks + 4 * g4) * 2;
        const u32x2 lo = *(const LAS u32x2*)qp, hi2 = *(const LAS u32x2*)(qp + 32);
        *(u32x4*)(qaf + wid * 1024 + lane * 16) = (u32x4){lo.x, lo.y, hi2.x, hi2.y};
        const LAS char* kp = lds + HL_KT + (8 * g4 + (c16 >> 2)) * HG_STR + (16 * wid + 4 * (c16 & 3)) * 2;
        const s16x4 klo = vtr(kp), khi = vtr(kp + 4 * HG_STR);
        *(bf16x8*)(hgb + HB_KTF + wid * 1024 + lane * 16) = (bf16x8){klo[0], klo[1], klo[2], klo[3], khi[0], khi[1], khi[2], khi[3]};
    }
    if (wid == 0) {
        f32x4 at00 = (f32x4){0.f, 0.f, 0.f, 0.f}, at01 = at00, at11 = at00;
#pragma unroll
        for (int ks = 0; ks < 4; ++ks) {
            const bf16x8 ka0 = *(const LAS bf16x8*)(lds + HL_KB + c16 * HG_STR + (32 * ks + 8 * g4) * 2);
            const bf16x8 ka1 = *(const LAS bf16x8*)(lds + HL_KB + (16 + c16) * HG_STR + (32 * ks + 8 * g4) * 2);
            const bf16x8 qn0 = *(const LAS bf16x8*)(lds + HL_QB + c16 * HG_STR + (32 * ks + 8 * g4) * 2);
            const bf16x8 qn1 = *(const LAS bf16x8*)(lds + HL_QB + (16 + c16) * HG_STR + (32 * ks + 8 * g4) * 2);
            at00 = MFMA16(ka0, qn0, at00); at01 = MFMA16(ka0, qn1, at01); at11 = MFMA16(ka1, qn1, at11);
        }
#pragma unroll
        for (int r = 0; r < 4; ++r) { if (4 * g4 + r > c16) { at00[r] = 0.f; at11[r] = 0.f; } }
        u32x4 b0; b0.x = cvtpk(at00[0], at00[1]); b0.y = cvtpk(at00[2], at00[3]); b0.z = 0u; b0.w = 0u;
        u32x4 b1; b1.x = cvtpk(at01[0], at01[1]); b1.y = cvtpk(at01[2], at01[3]); b1.z = cvtpk(at11[0], at11[1]); b1.w = cvtpk(at11[2], at11[3]);
        *(u32x4*)(hgb + HB_ATF + lane * 16) = b0; *(u32x4*)(hgb + HB_ATF + 1024 + lane * 16) = b1;
    } else if (wid == 1 && lane < 32) {
        *(f32x4*)(hgb + HB_DF + lane * 16) = *(const LAS f32x4*)(lds + HL_D + lane * 16);
    }
    __syncthreads();
}

constexpr int RS_QAF = 0, RS_HGB = 8192, RS_V = 19456, RS_SLOT = 27648, RS_NSLOT = 5;
constexpr int RS_OUT = RS_NSLOT * RS_SLOT, RS_OUTB = 32 * 136 * 2, RS_END = RS_OUT + 2 * RS_OUTB;
static_assert(RS_END <= LDS_ITEM, "hgrn LDS map");
DI void glds16_asm(const void* g, unsigned lds_base) {
    unsigned sv; asm volatile("s_mov_b32 %0, m0\n\ts_mov_b32 m0, %2\n\ts_nop 0\n\tglobal_load_lds_dwordx4 %1, off\n\ts_mov_b32 m0, %0" : "=&s"(sv) : "v"(g), "s"(lds_base) : "memory"); }
#define HW_BAR() asm volatile("s_waitcnt lgkmcnt(0)\n\ts_barrier" ::: "memory")
DI void glds16_sb(unsigned voff, const void* sbase, unsigned lds_base) {
    unsigned sv; asm volatile("s_mov_b32 %0, m0\n\ts_mov_b32 m0, %3\n\ts_nop 0\n\tglobal_load_lds_dwordx4 %1, %2\n\ts_mov_b32 m0, %0" : "=&s"(sv) : "v"(voff), "s"(sbase), "s"(lds_base) : "memory"); }
DI void hgrn_unit(const Params& P, int b, int h, char* lds_g) {
    LAS char* lds = (LAS char*)lds_g;
    const int tid = tid_(), lane = tid & 63, c16 = lane & 15, g4 = lane >> 4;
    const int wid = __builtin_amdgcn_readfirstlane(tid >> 6);
    const unsigned char* ws = P.ws;
    const int bh = b * 4 + h;
    const unsigned lbase = (unsigned)__builtin_amdgcn_readfirstlane((int)(unsigned)(size_t)lds);
    constexpr int AHEAD = RS_NSLOT - 1;
    if (wid < 4) {
        const unsigned char* qafg = ws + WS_HQA + (size_t)bh * 129 * 8192;
        const unsigned char* hgbg = ws + WS_HG + (size_t)bh * HT * 512;
        const unsigned char* vg = ws + WS_HV + (size_t)bh * HT * 256;
        const unsigned voff = (unsigned)lane * 16u;
        auto issue = [&](int c) {
            const unsigned sb = lbase + (unsigned)((c % RS_NSLOT) * RS_SLOT);
#pragma unroll
            for (int k = 0; k < 7; ++k) {
                const int p = wid + 4 * k;
                if (p < 19) { const unsigned char* src = (p < 8) ? qafg + (size_t)c * 8192 + p * 1024 : hgbg + (size_t)c * 16384 + (p - 8) * 1024; glds16_sb(voff, src, sb + (unsigned)p * 1024u); }
                else if (p < 27) { const int r4 = 4 * (p - 19);
                    const unsigned vo = (unsigned)(lane >> 4) * 256u + (unsigned)(((lane & 15) ^ ((((r4 & 7) + (lane >> 4)) & 7) << 1)) * 16);
                    glds16_sb(vo, vg + ((size_t)(32 * c) + r4) * 256, sb + (unsigned)p * 1024u); }
            }
        };
        f32x4 S[2][8];
#pragma unroll
        for (int t = 0; t < 2; ++t)
#pragma unroll
            for (int i = 0; i < 8; ++i) S[t][i] = (f32x4){0.f, 0.f, 0.f, 0.f};
#pragma unroll
        for (int c = 0; c < AHEAD; ++c) issue(c);
        for (int c = 0; c < 129; ++c) {
            if (c + AHEAD - 1 > 128) asm volatile("s_waitcnt vmcnt(0)" ::: "memory");
            else if (wid < 3) asm volatile("s_waitcnt vmcnt(21)" ::: "memory"); else asm volatile("s_waitcnt vmcnt(18)" ::: "memory");
            HW_BAR();
            __builtin_amdgcn_sched_barrier(0);
            if (c + AHEAD < 129) issue(c + AHEAD);
            __builtin_amdgcn_sched_barrier(0);
            const LAS char* sl = lds + (c % RS_NSLOT) * RS_SLOT;
            f32x4 oacc[2][2];
#pragma unroll
            for (int t = 0; t < 2; ++t) { oacc[t][0] = (f32x4){0.f, 0.f, 0.f, 0.f}; oacc[t][1] = oacc[t][0]; }
#pragma unroll
            for (int ks = 0; ks < 4; ++ks) {
                const bf16x8 q0 = *(const LAS bf16x8*)(sl + RS_QAF + (2 * ks) * 1024 + lane * 16), q1 = *(const LAS bf16x8*)(sl + RS_QAF + (2 * ks + 1) * 1024 + lane * 16);
#pragma unroll
                for (int t = 0; t < 2; ++t) {
                    u32x4 sp; sp.x = cvtpk(S[t][2 * ks][0], S[t][2 * ks][1]); sp.y = cvtpk(S[t][2 * ks][2], S[t][2 * ks][3]); sp.z = cvtpk(S[t][2 * ks + 1][0], S[t][2 * ks + 1][1]); sp.w = cvtpk(S[t][2 * ks + 1][2], S[t][2 * ks + 1][3]);
                    const bf16x8 sf = __builtin_bit_cast(bf16x8, sp);
                    oacc[t][0] = MFMA16(sf, q0, oacc[t][0]); oacc[t][1] = MFMA16(sf, q1, oacc[t][1]);
                }
            }
            const int vq = c16 >> 2, vp4 = c16 & 3;
#define VTR(row, w_) vtr(sl + RS_V + (row) * 256 + (((2 * (w_) + (vp4 >> 1)) ^ ((((row) & 7)) << 1)) * 16) + 8 * (vp4 & 1))
            {
                const bf16x8 a0 = *(const LAS bf16x8*)(sl + RS_HGB + HB_ATF + lane * 16), a1 = *(const LAS bf16x8*)(sl + RS_HGB + HB_ATF + 1024 + lane * 16);
#pragma unroll
                for (int t = 0; t < 2; ++t) {
                    const s16x4 lo = VTR(4 * g4 + vq, 2 * wid + t), hi2 = VTR(16 + 4 * g4 + vq, 2 * wid + t);
                    const bf16x8 va = (bf16x8){lo[0], lo[1], lo[2], lo[3], hi2[0], hi2[1], hi2[2], hi2[3]};
                    oacc[t][0] = MFMA16(va, a0, oacc[t][0]); oacc[t][1] = MFMA16(va, a1, oacc[t][1]);
                }
            }
            {
                LAS char* ob = lds + RS_OUT + (c & 1) * RS_OUTB;
#pragma unroll
                for (int t = 0; t < 2; ++t)
#pragma unroll
                    for (int nt = 0; nt < 2; ++nt) { u32x2 w; w.x = cvtpk(oacc[t][nt][0], oacc[t][nt][1]); w.y = cvtpk(oacc[t][nt][2], oacc[t][nt][3]);
                        *(LAS u32x2*)(ob + ((16 * nt + c16) * 136 + 16 * (2 * wid + t) + 4 * g4) * 2) = w; }
            }
            {
                bf16x8 vb[2];
#pragma unroll
                for (int t = 0; t < 2; ++t) { const s16x4 lo = VTR(8 * g4 + vq, 2 * wid + t), hi2 = VTR(8 * g4 + 4 + vq, 2 * wid + t); vb[t] = (bf16x8){lo[0], lo[1], lo[2], lo[3], hi2[0], hi2[1], hi2[2], hi2[3]}; }
#pragma unroll
                for (int i = 0; i < 8; ++i) {
                    const f32x4 d4 = *(const LAS f32x4*)(sl + RS_HGB + HB_DF + (16 * i + 4 * g4) * 4);
                    const bf16x8 ka = *(const LAS bf16x8*)(sl + RS_HGB + HB_KTF + i * 1024 + lane * 16);
                    S[0][i] = MFMA16(ka, vb[0], S[0][i] * d4); S[1][i] = MFMA16(ka, vb[1], S[1][i] * d4);
                }
            }
#undef VTR
        }
        HW_BAR();
        HW_BAR();
    } else {
        const int tq = tid - 256, tok = tq >> 3, part = tq & 7;
        const bf16_t* sgg = (const bf16_t*)(ws + WS_SG) + ((size_t)b * SEQ + tok) * 512 + h * 128 + 16 * part;
        f32x4 nw[4];
#pragma unroll
        for (int q = 0; q < 4; ++q) nw[q] = *(const f32x4*)(P.rec_norm_w + h * 128 + 16 * part + 4 * q);
        auto epilogue = [&](int c, u32x4 s0, u32x4 s1) {
            const LAS char* ob = lds + RS_OUT + (c & 1) * RS_OUTB + (tok * 136 + 16 * part) * 2;
            const u32x4 o0 = *(const LAS u32x4*)ob, o1 = *(const LAS u32x4*)(ob + 16);
            const unsigned ou[8] = {o0.x, o0.y, o0.z, o0.w, o1.x, o1.y, o1.z, o1.w}, su[8] = {s0.x, s0.y, s0.z, s0.w, s1.x, s1.y, s1.z, s1.w};
            float v[16], ss = 0.f;
#pragma unroll
            for (int q = 0; q < 8; ++q) { v[2 * q] = bf2f(ou[q] & 0xffffu); v[2 * q + 1] = bf2f(ou[q] >> 16); ss += v[2 * q] * v[2 * q] + v[2 * q + 1] * v[2 * q + 1]; }
            ss += __shfl_xor(ss, 1); ss += __shfl_xor(ss, 2); ss += __shfl_xor(ss, 4);
            const float rs = 1.f / sqrtf(ss * (1.f / 128.f) + EPS);
            u32x4 w0, w1; unsigned wo[8];
#pragma unroll
            for (int q = 0; q < 8; ++q) wo[q] = cvtpk(v[2 * q] * rs * nw[q >> 1][(2 * q) & 3] * bf2f(su[q] & 0xffffu), v[2 * q + 1] * rs * nw[q >> 1][(2 * q + 1) & 3] * bf2f(su[q] >> 16));
            w0 = (u32x4){wo[0], wo[1], wo[2], wo[3]}; w1 = (u32x4){wo[4], wo[5], wo[6], wo[7]};
            bf16_t* mp = (bf16_t*)(ws + WS_MIX) + ((size_t)b * SEQ + 32 * (c - 1) + tok) * DM + 512 + h * 128 + 16 * part;
            *(u32x4*)mp = w0; *(u32x4*)(mp + 8) = w1;
        };
#define SG_LD(k, A, B) do { const bf16_t* p_ = sgg + (size_t)(32 * ((k) - 1)) * 512; A = *(const u32x4*)p_; B = *(const u32x4*)(p_ + 8); } while (0)
        u32x4 ga0, ga1, gb0, gb1, gc0, gc1, gd0, gd1;
        SG_LD(1, gb0, gb1); SG_LD(2, gc0, gc1); SG_LD(3, gd0, gd1);
        HW_BAR();
        HW_BAR();
        for (int k = 1; k <= 128; k += 4) {
            HW_BAR(); if (k + 3 <= 128) SG_LD(k + 3, ga0, ga1); epilogue(k, gb0, gb1);
            HW_BAR(); if (k + 4 <= 128) SG_LD(k + 4, gb0, gb1); epilogue(k + 1, gc0, gc1);
            HW_BAR(); if (k + 5 <= 128) SG_LD(k + 5, gc0, gc1); epilogue(k + 2, gd0, gd1);
            HW_BAR(); if (k + 6 <= 128) SG_LD(k + 6, gd0, gd1); epilogue(k + 3, ga0, ga1);
        }
#undef SG_LD
        HW_BAR();
    }
}
template <int CTRL> DI float dpp_f(float v) { return __builtin_bit_cast(float, __builtin_amdgcn_update_dpp(0, __builtin_bit_cast(int, v), CTRL, 0xf, 0xf, false)); }
DI float row16_max(float v) { v = fmaxf(v, dpp_f<0x128>(v)); v = fmaxf(v, dpp_f<0x124>(v)); v = fmaxf(v, dpp_f<0x122>(v)); v = fmaxf(v, dpp_f<0x121>(v)); return v; }
DI float row16_sum(float v) { v += dpp_f<0x128>(v); v += dpp_f<0x124>(v); v += dpp_f<0x122>(v); v += dpp_f<0x121>(v); return v; }
#define CE_D(a, b) do { const float hi_ = fmaxf(a, b), lo_ = fminf(a, b); a = hi_; b = lo_; } while (0)
DI void bitonic_sort16(float (&v)[16]) {
#pragma unroll
    for (int k = 2; k <= 16; k *= 2)
#pragma unroll
        for (int j = k / 2; j > 0; j /= 2)
#pragma unroll
            for (int i = 0; i < 16; ++i) { const int l = i ^ j; if (l > i) { if ((i & k) == 0) CE_D(v[i], v[l]); else CE_D(v[l], v[i]); } }
}
DI void merge_top16(float (&a)[16], const float (&b)[16]) {
#pragma unroll
    for (int i = 0; i < 16; ++i) a[i] = fmaxf(a[i], b[15 - i]);
#pragma unroll
    for (int j = 8; j > 0; j /= 2)
#pragma unroll
        for (int i = 0; i < 16; ++i) { const int l = i ^ j; if (l > i) CE_D(a[i], a[l]); }
}
DI float embed7(float v, unsigned code) { return __uint_as_float((__float_as_uint(v) & 0xFFFFFF80u) | code); }
DI float embed8(float v, unsigned code) { return __uint_as_float((__float_as_uint(v) & 0xFFFFFF00u) | code); }

DI void topk_list(const bf16_t* qp, const LAS char* skf, int lane, int hi, float (&top)[16]) {
    f32x16 acc[4];
#pragma unroll
    for (int kb = 0; kb < 4; ++kb) acc[kb] = f32x16{};
#pragma unroll
    for (int ks = 0; ks < 8; ++ks) {
        const bf16x8 qf = *(const bf16x8*)(qp + 16 * ks);
#pragma unroll
        for (int kb = 0; kb < 4; ++kb) { const bf16x8 kf = *(const LAS bf16x8*)(skf + (kb * 8 + ks) * 1024 + lane * 16); acc[kb] = MFMA32(kf, qf, acc[kb]); }
    }
    float blk[16];
#pragma unroll
    for (int kb = 0; kb < 4; ++kb) {
#pragma unroll
        for (int r = 0; r < 16; ++r) { const unsigned code = (unsigned)(32 * kb + (r & 3) + 8 * (r >> 2)) | (unsigned)(4 * hi); if (kb == 0) top[r] = embed7(acc[kb][r], code); else blk[r] = embed7(acc[kb][r], code); }
        if (kb == 0) bitonic_sort16(top); else { bitonic_sort16(blk); merge_top16(top, blk); }
    }
    float l0[16], l1[16];
#pragma unroll
    for (int r = 0; r < 16; ++r) { auto rr = __builtin_amdgcn_permlane32_swap(__float_as_uint(top[r]), __float_as_uint(top[r]), false, false); l0[r] = __uint_as_float(rr[0]); l1[r] = __uint_as_float(rr[1]); }
    merge_top16(l0, l1);
#pragma unroll
    for (int r = 0; r < 16; ++r) top[r] = l0[r];
}

DI void topk_wave_item(const Params& P, int tb, int hh, LAS char* wlds, const LAS char* skf) {
    const int lane = tid_() & 63, r32 = lane & 31, hi = lane >> 5;
    const unsigned char* ws = P.ws;
    const bf16_t* qp = (const bf16_t*)(ws + WS_PQ) + (size_t)(32 * tb + r32) * 2048 + hh * 256 + 8 * hi;
    float A[16], B[16];
    topk_list(qp, skf, lane, hi, A);
    topk_list(qp + 128, skf + 32768, lane, hi, B);
    LAS unsigned* my = (LAS unsigned*)(wlds + lane * 32);
#pragma unroll
    for (int w = 0; w < 4; ++w) {
        my[w] = (__float_as_uint(A[4 * w]) & 127u) | ((__float_as_uint(A[4 * w + 1]) & 127u) << 8) | ((__float_as_uint(A[4 * w + 2]) & 127u) << 16) | ((__float_as_uint(A[4 * w + 3]) & 127u) << 24);
        my[4 + w] = (__float_as_uint(B[4 * w]) & 127u) | ((__float_as_uint(B[4 * w + 1]) & 127u) << 8) | ((__float_as_uint(B[4 * w + 2]) & 127u) << 16) | ((__float_as_uint(B[4 * w + 3]) & 127u) << 24);
    }
#pragma unroll
    for (int r = 0; r < 16; ++r) { A[r] = __uint_as_float(__float_as_uint(A[r]) & 0xFFFFFF80u); B[r] = __uint_as_float(__float_as_uint(B[r]) & 0xFFFFFF80u); }
    float T[16], R1[16], X[16], Y[16];
#pragma unroll
    for (int j = 0; j < 16; ++j) { T[j] = embed8(A[0] + B[j], (unsigned)j); R1[j] = (j < 8) ? embed8(A[1] + B[j], (unsigned)(16 + j)) : -INFINITY; }
#define CAND(i, j) embed8(A[i] + B[j], (unsigned)(16 * (i) + (j)))
    X[0] = CAND(2, 0); X[1] = CAND(2, 1); X[2] = CAND(2, 2); X[3] = CAND(2, 3); X[4] = CAND(2, 4); X[5] = CAND(3, 0); X[6] = CAND(3, 1); X[7] = CAND(3, 2);
    X[8] = CAND(3, 3); X[9] = CAND(4, 0); X[10] = CAND(4, 1); X[11] = CAND(4, 2); X[12] = CAND(5, 0); X[13] = CAND(5, 1); X[14] = CAND(6, 0); X[15] = CAND(6, 1);
    Y[0] = CAND(7, 0); Y[1] = CAND(7, 1); Y[2] = CAND(8, 0); Y[3] = CAND(9, 0); Y[4] = CAND(10, 0); Y[5] = CAND(11, 0); Y[6] = CAND(12, 0); Y[7] = CAND(13, 0);
    Y[8] = CAND(14, 0); Y[9] = CAND(15, 0); Y[10] = -INFINITY; Y[11] = -INFINITY; Y[12] = -INFINITY; Y[13] = -INFINITY; Y[14] = -INFINITY; Y[15] = -INFINITY;
#undef CAND
    bitonic_sort16(X); bitonic_sort16(Y);
    merge_top16(T, R1); merge_top16(T, X); merge_top16(T, Y);
    asm volatile("s_waitcnt lgkmcnt(0)" ::: "memory");
    float ssum = 0.f, e[16]; int eid[16];
    const float t0 = __uint_as_float(__float_as_uint(T[0]) & 0xFFFFFF00u);
#pragma unroll
    for (int r = 0; r < 16; ++r) {
        const unsigned bits = __float_as_uint(T[r]); const unsigned code = bits & 255u;
        e[r] = __expf(__uint_as_float(bits & 0xFFFFFF00u) - t0); ssum += e[r];
        const int ka = ((const LAS unsigned char*)my)[code >> 4], kb_ = ((const LAS unsigned char*)my)[16 + (code & 15u)];
        eid[r] = ka * 128 + kb_;
    }
    const float inv = 1.f / ssum;
    const size_t o = (size_t)(32 * tb + r32) * 128 + hh * 16 + 8 * hi;
    int* ei = (int*)(ws + WS_EIDX) + o; float* eg = (float*)(ws + WS_EGATE) + o;
    typedef int i32x4 __attribute__((ext_vector_type(4)));
    i32x4 w0, w1; f32x4 g0, g1;
    const unsigned mh = 0u - (unsigned)hi;
#define SELU(a, b) ((((unsigned)(b)) & mh) | (((unsigned)(a)) & ~mh))
#pragma unroll
    for (int q = 0; q < 4; ++q) { w0[q] = (int)SELU(eid[q], eid[8 + q]); w1[q] = (int)SELU(eid[4 + q], eid[12 + q]);
        g0[q] = __uint_as_float(SELU(__float_as_uint(e[q]), __float_as_uint(e[8 + q]))) * inv; g1[q] = __uint_as_float(SELU(__float_as_uint(e[4 + q]), __float_as_uint(e[12 + q]))) * inv; }
#undef SELU
    *(i32x4*)ei = w0; *(i32x4*)(ei + 4) = w1; *(f32x4*)eg = g0; *(f32x4*)(eg + 4) = g1;
}

DI void topk_phase(const Params& P, char* lds_g, int bid, int nblk) {
    const int tid = tid_(), wave = __builtin_amdgcn_readfirstlane(tid >> 6);
    LAS char* lds = (LAS char*)lds_g;
    LAS char* wlds = lds + wave * 2048;
    LAS char* skf = lds + 16384;
    int cur_h = -1;
    for (int it = bid; it < (NTOK / 256) * 8; it += nblk) {
        const int hh = it & 7, tg = it >> 3;
        if (hh != cur_h) {
            __syncthreads();
#pragma unroll
            for (int i = 0; i < 8; ++i) {
                const int f = tid + 512 * i, l = f & 63, ks = (f >> 6) & 7, kb = (f >> 9) & 3, p = f >> 11;
                *(LAS u32x4*)(skf + f * 16) = *(const u32x4*)((const bf16_t*)(P.ws + WS_SKB) + (size_t)((hh * 2 + p) * 128 + 32 * kb + (l & 31)) * 128 + 16 * ks + 8 * (l >> 5));
            }
            __syncthreads();
            cur_h = hh;
        }
        topk_wave_item(P, tg * 8 + wave, hh, wlds, skf);
    }
}

DI float gelu_exact(float x) { return 0.5f * x * (1.f + erff(x * 0.70710678118654752f)); }
typedef __bf16 bf16x8_t __attribute__((ext_vector_type(8)));
DI float dot8(u32x4 a, u32x4 x, float acc) {
    const bf16x8_t a8 = __builtin_bit_cast(bf16x8_t, a), x8 = __builtin_bit_cast(bf16x8_t, x);
    acc = __builtin_amdgcn_fdot2_f32_bf16(__builtin_shufflevector(a8, a8, 0, 1), __builtin_shufflevector(x8, x8, 0, 1), acc, false);
    acc = __builtin_amdgcn_fdot2_f32_bf16(__builtin_shufflevector(a8, a8, 2, 3), __builtin_shufflevector(x8, x8, 2, 3), acc, false);
    acc = __builtin_amdgcn_fdot2_f32_bf16(__builtin_shufflevector(a8, a8, 4, 5), __builtin_shufflevector(x8, x8, 4, 5), acc, false);
    acc = __builtin_amdgcn_fdot2_f32_bf16(__builtin_shufflevector(a8, a8, 6, 7), __builtin_shufflevector(x8, x8, 6, 7), acc, false);
    return acc;
}
DI float readlane_f(float v, int l) { return __builtin_bit_cast(float, __builtin_amdgcn_readlane(__builtin_bit_cast(int, v), l)); }
DI float wave_sum_dpp(float v) {
    v = row16_sum(v);
    return (readlane_f(v, 0) + readlane_f(v, 16)) + (readlane_f(v, 32) + readlane_f(v, 48));
}

DI float dot16_fp8(u32x4 w, const f32x2 (&x)[8]) {
    f32x2 acc = __builtin_amdgcn_cvt_pk_f32_fp8((int)w.x, false) * x[0];
    acc = __builtin_amdgcn_cvt_pk_f32_fp8((int)w.x, true) * x[1] + acc;
    acc = __builtin_amdgcn_cvt_pk_f32_fp8((int)w.y, false) * x[2] + acc;
    acc = __builtin_amdgcn_cvt_pk_f32_fp8((int)w.y, true) * x[3] + acc;
    acc = __builtin_amdgcn_cvt_pk_f32_fp8((int)w.z, false) * x[4] + acc;
    acc = __builtin_amdgcn_cvt_pk_f32_fp8((int)w.z, true) * x[5] + acc;
    acc = __builtin_amdgcn_cvt_pk_f32_fp8((int)w.w, false) * x[6] + acc;
    acc = __builtin_amdgcn_cvt_pk_f32_fp8((int)w.w, true) * x[7] + acc;
    return acc.x + acc.y;
}
DI void peer_hid_phase(const Params& P, int bid, int nblk) {
    const int tid = tid_(), lane = tid & 63, wave = __builtin_amdgcn_readfirstlane(tid >> 6);
    const unsigned char* ws = P.ws;
    const unsigned char* U8 = ws + WS_UB; const float* USC = (const float*)(ws + WS_USC);
    const int gw = bid * NWAVES + wave, NGW = nblk * NWAVES;
    f32x4 wv[4];
#pragma unroll
    for (int q = 0; q < 4; ++q) wv[q] = *(const f32x4*)(P.ffn_norm_w + 16 * lane + 4 * q);
    for (int n = gw; n < NTOK; n += NGW) {
        const float* hrow = P.out + (size_t)n * DM + 16 * lane;
        f32x4 h[4]; float ss = 0.f;
#pragma unroll
        for (int q = 0; q < 4; ++q) { h[q] = *(const f32x4*)(hrow + 4 * q); ss += (h[q].x * h[q].x + h[q].y * h[q].y) + (h[q].z * h[q].z + h[q].w * h[q].w); }
        ss = wave_sum_dpp(ss);
        const float r2 = 1.f / sqrtf(ss * (1.f / DM) + EPS);
        f32x2 x[8];
#pragma unroll
        for (int q = 0; q < 4; ++q) { const f32x4 t = h[q] * wv[q] * r2; x[2 * q] = (f32x2){t.x, t.y}; x[2 * q + 1] = (f32x2){t.z, t.w}; }
        const int* eidx = (const int*)(ws + WS_EIDX) + (size_t)n * 128;
        const float* egate = (const float*)(ws + WS_EGATE) + (size_t)n * 128;
        const int id0 = eidx[lane], id1 = eidx[64 + lane];
        float hid0 = 0.f, hid1 = 0.f;
#pragma unroll 1
        for (int k0 = 0; k0 < 128; k0 += 16) {
            u32x4 ra[16]; float sc[16];
#pragma unroll
            for (int e = 0; e < 16; ++e) {
                const int k = k0 + e;
                const int id = (k0 < 64) ? __builtin_amdgcn_readlane(id0, k & 63) : __builtin_amdgcn_readlane(id1, k & 63);
                ra[e] = *(const u32x4*)(U8 + (size_t)id * DM + 16 * lane); sc[e] = USC[id];
            }
#pragma unroll
            for (int e = 0; e < 16; ++e) {
                const int k = k0 + e;
                const float d = wave_sum_dpp(dot16_fp8(ra[e], x)) * sc[e];
                if (k0 < 64) { if (lane == (k & 63)) hid0 = d; } else { if (lane == (k & 63)) hid1 = d; }
            }
        }
        float* hid = (float*)(ws + WS_HID) + (size_t)n * 128;
        hid[lane] = gelu_exact(hid0) * egate[lane];
        hid[64 + lane] = gelu_exact(hid1) * egate[64 + lane];
    }
}

DI void peer_out_phase(const Params& P, int bid, int nblk) {
    const int tid = tid_(), lane = tid & 63, wave = __builtin_amdgcn_readfirstlane(tid >> 6);
    const unsigned char* ws = P.ws;
    const unsigned char* V8 = ws + WS_VB; const float* VSC = (const float*)(ws + WS_VSC);
    const int gw = bid * NWAVES + wave, NGW = nblk * NWAVES;
    f32x4 wv[4];
#pragma unroll
    for (int q = 0; q < 4; ++q) wv[q] = *(const f32x4*)(P.final_w + 16 * lane + 4 * q);
    for (int n = gw; n < NTOK; n += NGW) {
        const int* eidx = (const int*)(ws + WS_EIDX) + (size_t)n * 128;
        const float* hid = (const float*)(ws + WS_HID) + (size_t)n * 128;
        const int id0 = eidx[lane], id1 = eidx[64 + lane];
        const float c0 = hid[lane], c1 = hid[64 + lane];
        f32x2 acc[8];
#pragma unroll
        for (int i = 0; i < 8; ++i) acc[i] = (f32x2){0.f, 0.f};
#pragma unroll 1
        for (int k0 = 0; k0 < 128; k0 += 16) {
            u32x4 ra[16]; float cf[16];
#pragma unroll
            for (int e = 0; e < 16; ++e) {
                const int k = k0 + e;
                const int id = (k0 < 64) ? __builtin_amdgcn_readlane(id0, k & 63) : __builtin_amdgcn_readlane(id1, k & 63);
                cf[e] = ((k0 < 64) ? readlane_f(c0, k & 63) : readlane_f(c1, k & 63)) * VSC[id];
                ra[e] = *(const u32x4*)(V8 + (size_t)id * DM + 16 * lane);
            }
#pragma unroll
            for (int e = 0; e < 16; ++e) {
                const f32x2 c = (f32x2){cf[e], cf[e]}; const u32x4 w = ra[e];
                acc[0] = __builtin_amdgcn_cvt_pk_f32_fp8((int)w.x, false) * c + acc[0]; acc[1] = __builtin_amdgcn_cvt_pk_f32_fp8((int)w.x, true) * c + acc[1];
                acc[2] = __builtin_amdgcn_cvt_pk_f32_fp8((int)w.y, false) * c + acc[2]; acc[3] = __builtin_amdgcn_cvt_pk_f32_fp8((int)w.y, true) * c + acc[3];
                acc[4] = __builtin_amdgcn_cvt_pk_f32_fp8((int)w.z, false) * c + acc[4]; acc[5] = __builtin_amdgcn_cvt_pk_f32_fp8((int)w.z, true) * c + acc[5];
                acc[6] = __builtin_amdgcn_cvt_pk_f32_fp8((int)w.w, false) * c + acc[6]; acc[7] = __builtin_amdgcn_cvt_pk_f32_fp8((int)w.w, true) * c + acc[7];
            }
        }
        float* orow = P.out + (size_t)n * DM + 16 * lane;
        f32x4 h[4]; float ss = 0.f;
#pragma unroll
        for (int q = 0; q < 4; ++q) { h[q] = *(const f32x4*)(orow + 4 * q) + (f32x4){acc[2 * q].x, acc[2 * q].y, acc[2 * q + 1].x, acc[2 * q + 1].y}; ss += (h[q].x * h[q].x + h[q].y * h[q].y) + (h[q].z * h[q].z + h[q].w * h[q].w); }
        ss = wave_sum_dpp(ss);
        const float rs = 1.f / sqrtf(ss * (1.f / DM) + EPS);
#pragma unroll
        for (int q = 0; q < 4; ++q) *(f32x4*)(orow + 4 * q) = h[q] * wv[q] * rs;
    }
}

#ifdef DBG_CHECK
DI void dbg_max(float* slot, float v) { atomicMax((unsigned*)slot, __float_as_uint(fmaxf(v, 0.f))); }
DI void dbg_check_topk(const Params& P, char* lds_g, int bid, int nblk) {
    LAS char* lds = (LAS char*)lds_g;
    const int tid = tid_(), lane = tid & 63, wave = __builtin_amdgcn_readfirstlane(tid >> 6);
    const unsigned char* ws = P.ws; float* dbg = (float*)(ws + WS_CTL) + 64;
    LAS float* sc = (LAS float*)(lds) + wave * 1024;
    const int gw = bid * NWAVES + wave;
    const int token = (gw * 37) % NTOK, hh = gw & 7;
    for (int p = 0; p < 2; ++p) for (int kk = 0; kk < 2; ++kk) {
        const int key = lane + 64 * kk; float a = 0.f;
        const bf16_t* q = (const bf16_t*)(ws + WS_PQ) + (size_t)token * 2048 + hh * 256 + p * 128;
        const bf16_t* sk = (const bf16_t*)(ws + WS_SKB) + (size_t)((hh * 2 + p) * 128 + key) * 128;
        for (int c = 0; c < 128; ++c) a += bf2f(q[c]) * bf2f(sk[c]);
        sc[p * 128 + key] = a;
    }
    asm volatile("s_waitcnt lgkmcnt(0)" ::: "memory");
    for (int p = 0; p < 2; ++p) for (int kk = 0; kk < 2; ++kk) {
        const int key = lane + 64 * kk; const float v = sc[p * 128 + key]; int rank = 0;
        for (int o = 0; o < 128; ++o) { const float w = sc[p * 128 + o]; rank += (w > v || (w == v && o < key)) ? 1 : 0; }
        if (rank < 16) { sc[256 + p * 16 + rank] = v; sc[288 + p * 16 + rank] = __int_as_float(key); }
    }
    asm volatile("s_waitcnt lgkmcnt(0)" ::: "memory");
    for (int e = 0; e < 4; ++e) {
        const int c = lane * 4 + e, i = c >> 4, j = c & 15; const float v = sc[256 + i] + sc[272 + j]; int rank = 0;
        for (int o = 0; o < 256; ++o) { const float w = sc[256 + (o >> 4)] + sc[272 + (o & 15)]; rank += (w > v || (w == v && o < c)) ? 1 : 0; }
        if (rank < 16) { sc[320 + rank] = __int_as_float(__float_as_int(sc[288 + i]) * 128 + __float_as_int(sc[304 + j])); sc[336 + rank] = v; }
    }
    asm volatile("s_waitcnt lgkmcnt(0)" ::: "memory");
    if (lane < 16) {
        const int eid = __float_as_int(sc[320 + lane]); const float sv = sc[336 + lane];
        float mx = sc[336], sum = 0.f; for (int o = 0; o < 16; ++o) sum += __expf(sc[336 + o] - mx);
        const float gate = __expf(sv - mx) / sum;
        const int* eidx = (const int*)(ws + WS_EIDX) + (size_t)token * 128 + hh * 16; const float* eg = (const float*)(ws + WS_EGATE) + (size_t)token * 128 + hh * 16;
        int found = -1; for (int o = 0; o < 16; ++o) if (eidx[o] == eid) found = o;
        if (found < 0) atomicAdd(dbg + 0, 1.f); else dbg_max(dbg + 1, fabsf(eg[found] - gate));
    }
    if (lane == 0) atomicAdd(dbg + 2, 16.f);
}
DI void dbg_check_hid(const Params& P, int bid, int nblk) {
    const int tid = tid_(), lane = tid & 63, wave = __builtin_amdgcn_readfirstlane(tid >> 6);
    const unsigned char* ws = P.ws; float* dbg = (float*)(ws + WS_CTL) + 64;
    const int gw = bid * NWAVES + wave; const int token = (gw * 53) % NTOK;
    const float* hrow = P.out + (size_t)token * DM;
    float ss = 0.f; for (int c = lane; c < DM; c += 64) ss += hrow[c] * hrow[c];
    ss = wave_sum(ss); const float r2 = 1.f / sqrtf(ss / DM + EPS);
    for (int kk = 0; kk < 2; ++kk) {
        const int k = lane + 64 * kk; const int eid = ((const int*)(ws + WS_EIDX))[(size_t)token * 128 + k];
        const float* urow = P.pu + (size_t)eid * DM; float d = 0.f;
        for (int c = 0; c < DM; ++c) d += urow[c] * (hrow[c] * r2 * P.ffn_norm_w[c]);
        const float hidv = gelu_exact(d) * ((const float*)(ws + WS_EGATE))[(size_t)token * 128 + k];
        const float got = ((const float*)(ws + WS_HID))[(size_t)token * 128 + k];
        dbg_max(dbg + 3, fabsf(got - hidv)); dbg_max(dbg + 4, fabsf(hidv));
    }
}
DI float dbg_enc(float m) { return 8.f + log10f(fmaxf(m, 1e-8f)); }
#endif

#ifdef DBG_CHECK
DI void dbg_check_attn(const Params& P, int bid, int nblk) {
    const int tid = tid_(), lane = tid & 63, wave = __builtin_amdgcn_readfirstlane(tid >> 6);
    const unsigned char* ws = P.ws; float* dbg = (float*)(ws + WS_CTL) + 64;
    const int gw = bid * NWAVES + wave;
    const unsigned hsh = (unsigned)gw * 2654435761u;
    const int b = (hsh >> 8) & 7, h = (hsh >> 11) & 3, i = (int)((hsh >> 13) % 4096u), bh = b * 4 + h;
    const float lam = ((const float*)(ws + WS_LB))[512];
    float oc[2][2], lsum[2], mx[2];
    for (int c = 0; c < 2; ++c) { oc[c][0] = oc[c][1] = 0.f; lsum[c] = 0.f; mx[c] = -1e30f; }
    for (int pp = KPAD; pp <= 64 + i; ++pp) {
        const int tile = pp >> 6, key = pp & 63;
        for (int c = 0; c < 2; ++c) {
            const bf16_t* q = (const bf16_t*)(ws + WS_Q) + ((size_t)((bh * 2 + c) * SEQ + i)) * 64;
            const unsigned char* kimg = ws + WS_K + ((size_t)(bh * 2 + c) * KT + tile) * 8192;
            float sdot = 0.f;
            for (int d = 0; d < 64; ++d) sdot += bf2f(q[d]) * bf2f(*(const bf16_t*)(kimg + (d >> 3) * 1024 + key * 16 + (d & 7) * 2));
            const float mn = fmaxf(mx[c], sdot), al = exp2f(mx[c] - mn), pe = exp2f(sdot - mn);
            const unsigned char* vimg = ws + WS_V + ((size_t)bh * KT + tile) * 16384;
            for (int e = 0; e < 2; ++e) { const int dv = lane + 64 * e; oc[c][e] = oc[c][e] * al + pe * bf2f(*(const bf16_t*)(vimg + (dv >> 5) * 4096 + key * 64 + (dv & 31) * 2)); }
            lsum[c] = lsum[c] * al + pe; mx[c] = mn;
        }
    }
    float o[2], ss = 0.f;
    for (int e = 0; e < 2; ++e) { o[e] = oc[0][e] / lsum[0] - lam * oc[1][e] / lsum[1]; ss += o[e] * o[e]; }
    ss = wave_sum(ss); const float rs = (1.f - LAM_INIT) / sqrtf(ss / 128.f + EPS);
    for (int e = 0; e < 2; ++e) { const int dv = lane + 64 * e; const float want = o[e] * rs * P.subln_w[dv];
        const float got = bf2f(((const bf16_t*)(ws + WS_MIX))[(size_t)(b * SEQ + i) * DM + h * 128 + dv]);
        dbg_max(dbg + 5, fabsf(got - want)); dbg_max(dbg + 6, fabsf(want)); }
}
DI void dbg_check_hgrn(const Params& P, char* lds_g, int bid, int nblk) {
    if (bid >= 32) return;
    LAS float* L = (LAS float*)lds_g;
    const int tid = tid_(), dv = tid & 127, qt = tid >> 7;
    const unsigned char* ws = P.ws; float* dbg = (float*)(ws + WS_CTL) + 64;
    const int bh = bid, b = bid >> 2, h = bid & 3;
    const float* HG = (const float*)(ws + WS_HG) + (size_t)bh * HT * 128;
    const bf16_t* HQ = (const bf16_t*)(ws + WS_HQ) + (size_t)bh * HT * 128;
    const bf16_t* HV = (const bf16_t*)(ws + WS_HV) + (size_t)bh * HT * 128;
    float S[32];
#pragma unroll
    for (int j = 0; j < 32; ++j) S[j] = 0.f;
    for (int pp = 16; pp < HT; ++pp) {
        if (tid < 128) { L[tid] = __expf(HG[(size_t)pp * 128 + tid]); L[128 + tid] = bf2f(HQ[(size_t)pp * 128 + tid]); L[256 + tid] = bf2f(HV[(size_t)pp * 128 + tid]); }
        __syncthreads();
        const float v = L[256 + dv]; float part = 0.f;
#pragma unroll
        for (int j = 0; j < 32; ++j) { const float f = L[32 * qt + j]; S[j] = f * S[j] + (1.f - f) * v; part += L[128 + 32 * qt + j] * S[j]; }
        L[384 + qt * 128 + dv] = part;
        __syncthreads();
        if (tid < 128) { const float o = L[384 + dv] + L[512 + dv] + L[640 + dv] + L[768 + dv]; L[896 + dv] = o; }
        __syncthreads();
        if (tid < 128 && pp >= 32) {
            float ss = 0.f; for (int j = 0; j < 128; ++j) ss += L[896 + j] * L[896 + j];
            const float rs = 1.f / sqrtf(ss / 128.f + EPS);
            const size_t row = (size_t)b * SEQ + (pp - 32);
            const float want = L[896 + dv] * rs * P.rec_norm_w[h * 128 + dv] * bf2f(((const bf16_t*)(ws + WS_SG))[row * 512 + h * 128 + dv]);
            const float got = bf2f(((const bf16_t*)(ws + WS_MIX))[row * DM + 512 + h * 128 + dv]);
            dbg_max(dbg + 7, fabsf(got - want)); dbg_max(dbg + 8, fabsf(want));
        }
        __syncthreads();
    }
}
#endif

#ifdef DBG_CHECK
DI float dbg_proj(const Params& P, int m, int c) {
    const float* xrow = (m < NTOK) ? P.x + (size_t)m * DM : P.meta + (size_t)(m - NTOK) * DM;
    float ss = 0.f, a = 0.f;
    for (int k = 0; k < DM; ++k) { const float xv = xrow[k]; ss += xv * xv; a += xv * P.mix_norm_w[k] * P.w_in[(size_t)k * NCOL1 + c]; }
    return a / sqrtf(ss / DM + EPS);
}
DI void dbg_check_gemm1(const Params& P, int bid, int nblk) {
    const unsigned char* ws = P.ws; float* dbg = (float*)(ws + WS_CTL) + 64;
    const int gt = bid * NTHREADS + tid_();
    if (gt >= 7 * 4096) return;
    const unsigned hsh = (unsigned)gt * 2654435761u;
    const int seg = gt % 7, cs = (hsh >> 7) & 511;
    const bool meta = ((gt / 7) & 15) == 0;
    const int m = meta ? NTOK + ((hsh >> 20) & 15) : (int)((hsh >> 3) % (unsigned)NTOK);
    const int b = meta ? (int)((hsh >> 25) & 7) : (m >> 12), t = meta ? (m - NTOK) : ((m & 4095) + NMETA);
    const int h = cs >> 7;
    float want = 0.f, got = 0.f;
    if (seg <= 1) {
        if (seg == 0 && meta) return;
        const int comp = (cs >> 6) & 1, d = cs & 63, dlo = d & 31;
        const float zlo = dbg_proj(P, m, seg * 512 + (cs & ~63) + dlo), zhi = dbg_proj(P, m, seg * 512 + (cs & ~63) + dlo + 32);
        const double inv = exp2(-(double)dlo * (13.287712379549449 / 32.0)); const float cv = (float)cos((double)t * inv), sv = (float)sin((double)t * inv);
        want = (d < 32) ? zlo * cv - zhi * sv : zhi * cv + zlo * sv;
        if (seg == 0) { want *= QSCALE; got = bf2f(((const bf16_t*)(ws + WS_Q))[((size_t)(((b * 4 + h) * 2 + comp) * SEQ + (m & 4095))) * 64 + d]); }
        else { const int pp = t + KPAD; got = bf2f(*(const bf16_t*)(ws + WS_K + ((size_t)((b * 4 + h) * 2 + comp) * KT + (pp >> 6)) * 8192 + (d >> 3) * 1024 + (pp & 63) * 16 + (d & 7) * 2)); }
    } else {
        const float z = dbg_proj(P, m, seg * 512 + cs); const int dv = cs & 127;
        if (seg == 2) { const int pp = t + KPAD; want = z; got = bf2f(*(const bf16_t*)(ws + WS_V + ((size_t)(b * 4 + h) * KT + (pp >> 6)) * 16384 + (dv >> 5) * 4096 + (pp & 63) * 64 + (dv & 31) * 2)); }
        else if (seg == 3) { want = siluf_(z); got = bf2f(((const bf16_t*)(ws + WS_HQ))[((size_t)(b * 4 + h) * HT + t + 16) * 128 + dv]); }
        else if (seg == 4) { const float l0 = P.lb_logits[cs], l1 = P.lb_logits[512 + cs], lb = __expf(l0) / (__expf(l0) + __expf(l1)); want = __logf(lb + (1.f - lb) * sigmoidf_(z)); got = ((const float*)(ws + WS_HG))[((size_t)(b * 4 + h) * HT + t + 16) * 128 + dv]; }
        else if (seg == 5) { want = z; got = bf2f(((const bf16_t*)(ws + WS_HV))[((size_t)(b * 4 + h) * HT + t + 16) * 128 + dv]); }
        else { if (meta) return; want = siluf_(z); got = bf2f(((const bf16_t*)(ws + WS_SG))[(size_t)m * 512 + cs]); }
    }
    dbg_max(dbg + 16 + seg + (meta ? 8 : 0), fabsf(got - want));
}
#endif
typedef unsigned u32x4v __attribute__((vector_size(16)));
DI float oct_sum(float v) {
    v += dpp_f<0xB1>(v); v += dpp_f<0x4E>(v); v += dpp_f<0x141>(v); return v;
}
DI unsigned my_xcc_id() { return (unsigned)__builtin_amdgcn_s_getreg((3 << 11) | 20) & 7u; }
constexpr int CTL_G1 = 16, CTL_G2 = 32;

DI void xn8_rows(const Params& P, int bid, int nblk) {
    const int tid = tid_(), lane = tid & 63, wave = __builtin_amdgcn_readfirstlane(tid >> 6);
    unsigned char* ws = P.ws;
    const int gw = bid * NWAVES + wave, NGW = nblk * NWAVES;
    f32x4 wv[4];
#pragma unroll
    for (int q = 0; q < 4; ++q) wv[q] = *(const f32x4*)(P.ffn_norm_w + 16 * lane + 4 * q);
    for (int n = gw; n < NTOK; n += NGW) {
        const bf16_t* hrow = (const bf16_t*)(ws + WS_XB) + (size_t)n * DM + 16 * lane;
        const float r2 = 1.f / sqrtf(((const float*)(ws + WS_SSQ))[n] * (1.f / DM) + EPS);
        const u32x4 ha = *(const u32x4*)hrow, hb = *(const u32x4*)(hrow + 8);
        const unsigned hu[8] = {ha.x, ha.y, ha.z, ha.w, hb.x, hb.y, hb.z, hb.w};
        f32x4 t[4]; float am = 0.f;
#pragma unroll
        for (int q = 0; q < 4; ++q) { t[q] = (f32x4){bf2f(hu[2 * q] & 0xffffu), bf2f(hu[2 * q] >> 16), bf2f(hu[2 * q + 1] & 0xffffu), bf2f(hu[2 * q + 1] >> 16)} * wv[q] * r2; am = fmaxf(am, fmaxf(fmaxf(fabsf(t[q].x), fabsf(t[q].y)), fmaxf(fabsf(t[q].z), fabsf(t[q].w)))); }
        am = row16_max(am); am = fmaxf(fmaxf(readlane_f(am, 0), readlane_f(am, 16)), fmaxf(readlane_f(am, 32), readlane_f(am, 48)));
        const float sc = (am > 0.f) ? exp2f(floorf(log2f(224.f / am))) : 1.f;
        int w[4];
#pragma unroll
        for (int q = 0; q < 4; ++q) { w[q] = __builtin_amdgcn_cvt_pk_fp8_f32(t[q].x * sc, t[q].y * sc, 0, false); w[q] = __builtin_amdgcn_cvt_pk_fp8_f32(t[q].z * sc, t[q].w * sc, w[q], true); }
        *(u32x4*)(ws + WS_XN8 + (size_t)n * DM + 16 * lane) = (u32x4){(unsigned)w[0], (unsigned)w[1], (unsigned)w[2], (unsigned)w[3]};
        if (lane == 0) ((float*)(ws + WS_XSC))[n] = 1.f / sc;
    }
}
typedef int i32x4 __attribute__((ext_vector_type(4)));
struct GMeta { i32x4 id[4]; f32x4 c[4]; u32x4 xq; };
template <int WHICH>
DI void g_meta(const Params& P, int n, int x, GMeta& M) {
    const int lane = tid_() & 63, i = lane & 7, g = lane >> 3;
    const i32x4* ip = (const i32x4*)((const int*)(P.ws + WS_EIDX) + (size_t)n * 128 + 16 * g);
#pragma unroll
    for (int q = 0; q < 4; ++q) M.id[q] = ip[q];
    if (WHICH == 1) M.xq = *(const u32x4*)(P.ws + WS_XN8 + (size_t)n * DM + 128 * x + 16 * i);
    else { const f32x4* cp = (const f32x4*)((const float*)(P.ws + WS_HID) + (size_t)n * 128 + 16 * g);
#pragma unroll
        for (int q = 0; q < 4; ++q) M.c[q] = cp[q]; }
}
DI void g_issue(int x, const GMeta& M, u32x4v (&rw)[16], __amdgpu_buffer_rsrc_t rs) {
    const int i = tid_() & 7;
    const unsigned lo = (unsigned)x * (unsigned)(NEXP * 128) + (unsigned)(16 * i);
#pragma unroll
    for (int j = 0; j < 16; ++j) rw[j] = __builtin_amdgcn_raw_buffer_load_b128(rs, ((unsigned)M.id[j >> 2][j & 3] << 7) + lo, 0, 0);
}
DI void g1_finish(const Params& P, int n, int x, u32x4 xq, const u32x4v (&rw)[16]) {
    const int lane = tid_() & 63, i = lane & 7, g = lane >> 3;
    f32x2 xv[8];
    xv[0] = __builtin_amdgcn_cvt_pk_f32_fp8((int)xq.x, false); xv[1] = __builtin_amdgcn_cvt_pk_f32_fp8((int)xq.x, true);
    xv[2] = __builtin_amdgcn_cvt_pk_f32_fp8((int)xq.y, false); xv[3] = __builtin_amdgcn_cvt_pk_f32_fp8((int)xq.y, true);
    xv[4] = __builtin_amdgcn_cvt_pk_f32_fp8((int)xq.z, false); xv[5] = __builtin_amdgcn_cvt_pk_f32_fp8((int)xq.z, true);
    xv[6] = __builtin_amdgcn_cvt_pk_f32_fp8((int)xq.w, false); xv[7] = __builtin_amdgcn_cvt_pk_f32_fp8((int)xq.w, true);
    float pd[16];
#pragma unroll
    for (int j = 0; j < 16; ++j) pd[j] = dot16_fp8(__builtin_bit_cast(u32x4, rw[j]), xv);
    const unsigned m1 = 0u - (unsigned)((i >> 2) & 1), m2 = 0u - (unsigned)(i & 1), m3 = 0u - (unsigned)((i >> 1) & 1);
#define BSEL(a, b, m) __uint_as_float((__float_as_uint(a) & ~(m)) | (__float_as_uint(b) & (m)))
    float z[8], w[4], u[2];
#pragma unroll
    for (int q = 0; q < 8; ++q) { const float snd = BSEL(pd[q + 8], pd[q], m1), kep = BSEL(pd[q], pd[q + 8], m1); z[q] = kep + dpp_f<0x141>(snd); }
#pragma unroll
    for (int q = 0; q < 4; ++q) { const float snd = BSEL(z[q + 4], z[q], m2), kep = BSEL(z[q], z[q + 4], m2); w[q] = kep + dpp_f<0xB1>(snd); }
#pragma unroll
    for (int q = 0; q < 2; ++q) { const float snd = BSEL(w[q + 2], w[q], m3), kep = BSEL(w[q], w[q + 2], m3); u[q] = kep + dpp_f<0x4E>(snd); }
    const int j0 = 8 * ((i >> 2) & 1) + 4 * (i & 1) + 2 * ((i >> 1) & 1);
#undef BSEL
    *(f32x2*)((float*)(P.ws + WS_HIDP) + ((size_t)x * NTOK + n) * 128 + 16 * g + j0) = (f32x2){u[0], u[1]};
}
DI void g2_finish(const Params& P, int n, int x, const f32x4 (&cv)[4], const u32x4v (&rw)[16]) {
    const int lane = tid_() & 63, i = lane & 7, g = lane >> 3;
    f32x2 acc[8];
#pragma unroll
    for (int q = 0; q < 8; ++q) acc[q] = (f32x2){0.f, 0.f};
#pragma unroll
    for (int j = 0; j < 16; ++j) {
        const float cj = cv[j >> 2][j & 3]; const f32x2 c = (f32x2){cj, cj}; const u32x4 w = __builtin_bit_cast(u32x4, rw[j]);
        acc[0] = __builtin_amdgcn_cvt_pk_f32_fp8((int)w.x, false) * c + acc[0]; acc[1] = __builtin_amdgcn_cvt_pk_f32_fp8((int)w.x, true) * c + acc[1];
        acc[2] = __builtin_amdgcn_cvt_pk_f32_fp8((int)w.y, false) * c + acc[2]; acc[3] = __builtin_amdgcn_cvt_pk_f32_fp8((int)w.y, true) * c + acc[3];
        acc[4] = __builtin_amdgcn_cvt_pk_f32_fp8((int)w.z, false) * c + acc[4]; acc[5] = __builtin_amdgcn_cvt_pk_f32_fp8((int)w.z, true) * c + acc[5];
        acc[6] = __builtin_amdgcn_cvt_pk_f32_fp8((int)w.w, false) * c + acc[6]; acc[7] = __builtin_amdgcn_cvt_pk_f32_fp8((int)w.w, true) * c + acc[7];
    }
    float y[16], z[8], w[4];
#pragma unroll
    for (int q = 0; q < 8; ++q) { y[2 * q] = acc[q].x; y[2 * q + 1] = acc[q].y; }
#pragma unroll
    for (int q = 0; q < 8; ++q) { auto rr = __builtin_amdgcn_permlane32_swap(__float_as_uint(y[q]), __float_as_uint(y[q + 8]), false, false); z[q] = __uint_as_float(rr[0]) + __uint_as_float(rr[1]); }
#pragma unroll
    for (int q = 0; q < 4; ++q) { auto rr = __builtin_amdgcn_permlane16_swap(__float_as_uint(z[q]), __float_as_uint(z[q + 4]), false, false); w[q] = __uint_as_float(rr[0]) + __uint_as_float(rr[1]); }
    const unsigned m3 = 0u - (unsigned)(g & 1);
#define BSEL(a, b, m) __uint_as_float((__float_as_uint(a) & ~(m)) | (__float_as_uint(b) & (m)))
    const float k0 = BSEL(w[0], w[2], m3) + dpp_f<0x128>(BSEL(w[2], w[0], m3)), k1 = BSEL(w[1], w[3], m3) + dpp_f<0x128>(BSEL(w[3], w[1], m3));
#undef BSEL
    float* hp = P.out + (size_t)n * DM + 128 * x + 16 * i + 2 * g;
    const f32x2 t = *(const f32x2*)hp + (f32x2){k0, k1}; *(f32x2*)hp = t;
    const float ss = wave_sum_dpp(t.x * t.x + t.y * t.y);
    if (lane == 0) atomicAdd((float*)(P.ws + WS_SSQ2) + n, ss);
}
constexpr int SL_CHUNK = 128, SL_T = SL_CHUNK / NWAVES;
#define SB() __builtin_amdgcn_sched_barrier(0)
template <int WHICH>
DI void g_chunk(const Params& P, int nbase, int x, __amdgpu_buffer_rsrc_t rs) {
    GMeta MA, MB; u32x4v RA[16], RB[16];
    g_meta<WHICH>(P, nbase, x, MA); SB(); g_meta<WHICH>(P, nbase + 8, x, MB); SB(); g_issue(x, MA, RA, rs); SB();
#pragma unroll
    for (int t = 0; t < SL_T; t += 2) {
        const u32x4 xA = MA.xq; const f32x4 cA[4] = {MA.c[0], MA.c[1], MA.c[2], MA.c[3]};
        if (t + 2 < SL_T) { g_meta<WHICH>(P, nbase + 8 * (t + 2), x, MA); SB(); }
        g_issue(x, MB, RB, rs); SB();
        if (WHICH == 1) g1_finish(P, nbase + 8 * t, x, xA, RA); else g2_finish(P, nbase + 8 * t, x, cA, RA);
        SB();
        const u32x4 xB = MB.xq; const f32x4 cB[4] = {MB.c[0], MB.c[1], MB.c[2], MB.c[3]};
        if (t + 3 < SL_T) { g_meta<WHICH>(P, nbase + 8 * (t + 3), x, MB); SB(); }
        if (t + 2 < SL_T) { g_issue(x, MA, RA, rs); SB(); }
        if (WHICH == 1) g1_finish(P, nbase + 8 * (t + 1), x, xB, RB); else g2_finish(P, nbase + 8 * (t + 1), x, cB, RB);
        SB();
    }
}
template <int WHICH>
DI void sliced_phase(const Params& P, char* lds_g) {
    const int tid = tid_(), wave = __builtin_amdgcn_readfirstlane(tid >> 6);
    unsigned* ctr = (unsigned*)(P.ws + WS_CTL) + (WHICH == 1 ? CTL_G1 : CTL_G2);
    const __amdgpu_buffer_rsrc_t rs = __builtin_amdgcn_make_buffer_rsrc((void*)(P.ws + (WHICH == 1 ? WS_UB : WS_VB)), 0, NEXP * DM, 0x00020000);
    const int x0 = (int)my_xcc_id();
    LAS int* slot = (LAS int*)((LAS char*)lds_g + LDS_ITEM);
    for (int s = 0; s < 8; ++s) {
        const int x = (x0 + s) & 7;
        for (;;) {
            if (tid == 0) *slot = (int)atomicAdd(ctr + x, 1u);
            __syncthreads();
            const int chunk = *slot;
            __syncthreads();
            if (chunk >= NTOK / SL_CHUNK) break;
            g_chunk<WHICH>(P, chunk * SL_CHUNK + wave, x, rs);
        }
    }
}
DI void hid_reduce_phase(const Params& P, int bid, int nblk) {
    const unsigned char* ws = P.ws;
    const size_t gt = (size_t)bid * NTHREADS + tid_(), NGT = (size_t)nblk * NTHREADS;
    const float* hp = (const float*)(ws + WS_HIDP);
    for (size_t o = gt; o < (size_t)NTOK * 128; o += NGT) {
        float a = 0.f;
#pragma unroll
        for (int x = 0; x < 8; ++x) a += hp[(size_t)x * NTOK * 128 + o];
        const int e = ((const int*)(ws + WS_EIDX))[o];
        const float d = a * ((const float*)(ws + WS_USC))[e] * ((const float*)(ws + WS_XSC))[o >> 7];
        ((float*)(ws + WS_HID))[o] = gelu_exact(d) * ((const float*)(ws + WS_EGATE))[o] * ((const float*)(ws + WS_VSC))[e];
    }
}
DI void final_norm_phase(const Params& P, int bid, int nblk) {
    const size_t gt = (size_t)bid * NTHREADS + tid_(), NGT = (size_t)nblk * NTHREADS;
    const float* ssq = (const float*)(P.ws + WS_SSQ2);
    for (size_t o = gt; o < (size_t)NTOK * DM / 4; o += NGT) {
        const size_t n = o >> 8; const int c4 = (int)(o & 255);
        const float rs = 1.f / sqrtf(ssq[n] * (1.f / DM) + EPS);
        f32x4* pp = (f32x4*)P.out + o;
        *pp = *pp * ((const f32x4*)P.final_w)[c4] * rs;
    }
}

typedef long i64_t;
constexpr int MG_HALF = 8192, MG_WAVE = 2 * MG_HALF;
#define MG_WAIT(N) asm volatile("s_waitcnt vmcnt(" #N ")" ::: "memory")
struct MgMeta { i32x4 id[4]; u32x4 a0, a1, a2, a3; };
template <int WHICH>
DI void mg_meta(const Params& P, int n, int x, MgMeta& M) {
    const int lane = tid_() & 63, g8 = lane >> 3, kg = lane >> 4;
    const int* ip = (const int*)(P.ws + WS_EIDX) + (size_t)n * 128 + 8 * g8;
    M.id[0] = *(const i32x4*)ip; M.id[1] = *(const i32x4*)(ip + 4); M.id[2] = *(const i32x4*)(ip + 64); M.id[3] = *(const i32x4*)(ip + 68);
    if (WHICH == 1) { const unsigned char* xr = P.ws + WS_XN8 + (size_t)n * DM + 256 * x + 16 * kg;
        M.a0 = *(const u32x4*)xr; M.a1 = *(const u32x4*)(xr + 64); M.a2 = *(const u32x4*)(xr + 128); M.a3 = *(const u32x4*)(xr + 192); }
    else { const unsigned char* cr = P.ws + WS_C8 + (size_t)n * 128 + 8 * kg;
        const u32x2 c0 = *(const u32x2*)cr, c1 = *(const u32x2*)(cr + 32), c2 = *(const u32x2*)(cr + 64), c3 = *(const u32x2*)(cr + 96);
        M.a0 = (u32x4){c0.x, c0.y, c1.x, c1.y}; M.a1 = (u32x4){c2.x, c2.y, c3.x, c3.y}; }
}
DI void mg_issue(const unsigned char* slice, const MgMeta& M, int h, unsigned lbase) {
    const int lane = tid_() & 63, pos = lane & 7;
    const i32x4 ia = M.id[2 * h], ib = M.id[2 * h + 1];
    const int ids[8] = {ia.x, ia.y, ia.z, ia.w, ib.x, ib.y, ib.z, ib.w};
#pragma unroll
    for (int p = 0; p < 8; ++p) glds16_asm(slice + (size_t)(unsigned)ids[p] * 128 + 16 * (pos ^ p), lbase + p * 1024);
}
DI i64_t pk64(unsigned lo, unsigned hi) { return (i64_t)(((unsigned long long)hi << 32) | lo); }
typedef int i32x8 __attribute__((ext_vector_type(8)));
DI float mg1_half(const MgMeta& M, LAS char* hb) {
    const int lane = tid_() & 63, c = lane & 15, kg = lane >> 4;
    const i32x8 A0 = (i32x8){(int)M.a0.x, (int)M.a0.y, (int)M.a0.z, (int)M.a0.w, (int)M.a1.x, (int)M.a1.y, (int)M.a1.z, (int)M.a1.w};
    const i32x8 A1 = (i32x8){(int)M.a2.x, (int)M.a2.y, (int)M.a2.z, (int)M.a2.w, (int)M.a3.x, (int)M.a3.y, (int)M.a3.z, (int)M.a3.w};
    f32x4 d[4];
#pragma unroll
    for (int G = 0; G < 4; ++G) {
        const LAS char* row = hb + (c & 7) * 1024 + (2 * G + (c >> 3)) * 128;
        const u32x4 b0 = *(const LAS u32x4*)(row + ((kg ^ (c & 7)) << 4)), b1 = *(const LAS u32x4*)(row + (((kg + 4) ^ (c & 7)) << 4));
        d[G] = (f32x4){0.f, 0.f, 0.f, 0.f};
        d[G] = __builtin_amdgcn_mfma_scale_f32_16x16x128_f8f6f4(A0, (i32x8){(int)b0.x, (int)b0.y, (int)b0.z, (int)b0.w, 0, 0, 0, 0}, d[G], 0, 4, 0, 0x7F7F7F7F, 0, 0x7F7F7F7F);
        d[G] = __builtin_amdgcn_mfma_scale_f32_16x16x128_f8f6f4(A1, (i32x8){(int)b1.x, (int)b1.y, (int)b1.z, (int)b1.w, 0, 0, 0, 0}, d[G], 0, 4, 0, 0x7F7F7F7F, 0, 0x7F7F7F7F);
    }
    asm volatile("s_nop 15\n\ts_nop 15" : "+v"(d[0]), "+v"(d[1]), "+v"(d[2]), "+v"(d[3]));
    const float r01 = (kg & 1) ? d[1][0] : d[0][0], r23 = (kg & 1) ? d[3][0] : d[2][0];
    return (kg & 2) ? r23 : r01;
}
typedef int v2i_t __attribute__((ext_vector_type(2)));
DI void mg2_half(const MgMeta& M, int h, LAS char* hb, f32x4 (&D)[8]) {
    const int lane = tid_() & 63, c = lane & 15, kg = lane >> 4;
#pragma unroll
    for (int kbl = 0; kbl < 2; ++kbl) {
        const u32x4 av = h ? M.a1 : M.a0;
        const i64_t a = kbl ? pk64(av.z, av.w) : pk64(av.x, av.y);
        const LAS char* row = hb + (c >> 1) * 1024 + (4 * kbl + kg) * 128 + 8 * (c & 1);
#pragma unroll
        for (int nt = 0; nt < 8; ++nt) {
            const v2i_t b = __builtin_amdgcn_ds_read_tr8_b64_v2i32((LAS v2i_t*)(row + ((nt ^ (c >> 1)) << 4)));
            D[nt] = __builtin_amdgcn_mfma_f32_16x16x32_fp8_fp8(a, pk64((unsigned)b.x, (unsigned)b.y), D[nt], 0, 0, 0);
        }
    }
}
template <int WHICH>
DI void mg_group(const Params& P, const unsigned char* slice, int n0, int x, LAS char* wl, unsigned wl_off, const MgMeta (&M)[4], MgMeta (&Mn)[4], bool more) {
    const int lane = tid_() & 63, kg = lane >> 4, c = lane & 15;
    bf16_t* outp = (bf16_t*)(P.ws + WS_HIDP) + (size_t)x * NTOK * 128;
    f32x4 D[8];
    mg_issue(slice, M[0], 0, wl_off); SB();
#define MG_STEP(h, WAITSTMT) do { \
        if ((h) + 1 < 8) { mg_issue(slice, M[((h) + 1) >> 1], ((h) + 1) & 1, wl_off + (((h) + 1) & 1) * MG_HALF); } \
        else if (more) { _Pragma("unroll") for (int q_ = 0; q_ < 4; ++q_) mg_meta<WHICH>(P, n0 + 8 * (4 + q_), x, Mn[q_]); } \
        SB(); WAITSTMT; SB(); \
        LAS char* hb_ = wl + ((h) & 1) * MG_HALF; const int n_ = n0 + 8 * ((h) >> 1); \
        if (WHICH == 1) { const float r_ = mg1_half(M[(h) >> 1], hb_); outp[(size_t)n_ * 128 + 64 * ((h) & 1) + lane] = (bf16_t)f2bf(r_); } \
        else { if (((h) & 1) == 0) { _Pragma("unroll") for (int q_ = 0; q_ < 8; ++q_) D[q_] = (f32x4){0.f, 0.f, 0.f, 0.f}; } \
            mg2_half(M[(h) >> 1], (h) & 1, hb_, D); \
            if ((h) & 1) { float v0_ = 0.f, v1_ = 0.f; _Pragma("unroll") for (int q_ = 0; q_ < 4; ++q_) { if (kg == q_) { v0_ = D[2 * q_][0]; v1_ = D[2 * q_ + 1][0]; } } \
                outp[(size_t)n_ * 128 + 32 * kg + c] = (bf16_t)f2bf(v0_); outp[(size_t)n_ * 128 + 32 * kg + 16 + c] = (bf16_t)f2bf(v1_); } } \
        SB(); } while (0)
    if (WHICH == 1) {
        MG_STEP(0, MG_WAIT(8)); MG_STEP(1, MG_WAIT(9)); MG_STEP(2, MG_WAIT(9)); MG_STEP(3, MG_WAIT(9)); MG_STEP(4, MG_WAIT(9)); MG_STEP(5, MG_WAIT(9)); MG_STEP(6, MG_WAIT(9));
        if (more) { MG_STEP(7, MG_WAIT(33)); } else { MG_STEP(7, MG_WAIT(1)); }
    } else {
        MG_STEP(0, MG_WAIT(8)); MG_STEP(1, MG_WAIT(8)); MG_STEP(2, MG_WAIT(10)); MG_STEP(3, MG_WAIT(8)); MG_STEP(4, MG_WAIT(10)); MG_STEP(5, MG_WAIT(8)); MG_STEP(6, MG_WAIT(10));
        if (more) { MG_STEP(7, MG_WAIT(32)); } else { MG_STEP(7, MG_WAIT(0)); }
    }
#undef MG_STEP
}
template <int WHICH>
DI void mg_phase(const Params& P, char* lds_g) {
    const int tid = tid_(), wave = __builtin_amdgcn_readfirstlane(tid >> 6);
    unsigned* ctr = (unsigned*)(P.ws + WS_CTL) + (WHICH == 1 ? CTL_G1 : CTL_G2);
    const int x0 = (int)my_xcc_id();
    LAS int* slot = (LAS int*)((LAS char*)lds_g + LDS_ITEM);
    LAS char* wl = (LAS char*)lds_g + wave * MG_WAVE;
    const unsigned wl_off = (unsigned)__builtin_amdgcn_readfirstlane((int)(unsigned)(size_t)wl);
    constexpr int NSL = (WHICH == 1) ? 4 : 8;
    for (int s = 0; s < NSL; ++s) {
        const int x = (x0 + s) & (NSL - 1);
        const unsigned char* slice = P.ws + (WHICH == 1 ? WS_UB : WS_VB) + (size_t)x * ((size_t)NEXP * 128);
        for (;;) {
            if (tid == 0) *slot = (int)atomicAdd(ctr + x, 1u);
            __syncthreads();
            const int chunk = *slot;
            __syncthreads();
            if (chunk >= NTOK / SL_CHUNK) break;
            const int nb = chunk * SL_CHUNK + wave;
            MgMeta MA[4], MB[4];
#pragma unroll
            for (int q = 0; q < 4; ++q) mg_meta<WHICH>(P, nb + 8 * q, x, MA[q]);
            mg_group<WHICH>(P, slice, nb, x, wl, wl_off, MA, MB, true);
            mg_group<WHICH>(P, slice, nb + 32, x, wl, wl_off, MB, MA, true);
            mg_group<WHICH>(P, slice, nb + 64, x, wl, wl_off, MA, MB, true);
            mg_group<WHICH>(P, slice, nb + 96, x, wl, wl_off, MB, MA, false);
            MG_WAIT(0);
        }
    }
}
DI void hid_reduce8_phase(const Params& P, int bid, int nblk) {
    const int tid = tid_(), lane = tid & 63, wave = __builtin_amdgcn_readfirstlane(tid >> 6);
    unsigned char* ws = P.ws;
    const int gw = bid * NWAVES + wave, NGW = nblk * NWAVES;
    const bf16_t* hp = (const bf16_t*)(ws + WS_HIDP);
    for (int n = gw; n < NTOK; n += NGW) {
        const float xs = ((const float*)(ws + WS_XSC))[n];
        float cv[2]; float am = 0.f;
#pragma unroll
        for (int q = 0; q < 2; ++q) {
            const size_t o = (size_t)n * 128 + 64 * q + lane; float a = 0.f;
            const int e = ((const int*)(ws + WS_EIDX))[o];
#pragma unroll
            for (int x = 0; x < 4; ++x) a += bf2f(hp[(size_t)x * NTOK * 128 + o]) * ((const float*)(ws + WS_USC))[(size_t)x * NEXP + e];
            cv[q] = gelu_exact(a * xs) * ((const float*)(ws + WS_EGATE))[o] * ((const float*)(ws + WS_VSC))[e];
            am = fmaxf(am, fabsf(cv[q]));
        }
        am = row16_max(am); am = fmaxf(fmaxf(readlane_f(am, 0), readlane_f(am, 16)), fmaxf(readlane_f(am, 32), readlane_f(am, 48)));
        const float sc = (am > 0.f) ? exp2f(floorf(log2f(224.f / am))) : 1.f;
        const int w0 = __builtin_amdgcn_cvt_pk_fp8_f32(cv[0] * sc, cv[1] * sc, 0, false);
        ws[WS_C8 + (size_t)n * 128 + lane] = (unsigned char)(w0 & 255); ws[WS_C8 + (size_t)n * 128 + 64 + lane] = (unsigned char)((w0 >> 8) & 255);
        if (lane == 0) ((float*)(ws + WS_CSC))[n] = 1.f / sc;
    }
}
DI void final_norm8_phase(const Params& P, int bid, int nblk) {
    const int tid = tid_(), lane = tid & 63, wave = __builtin_amdgcn_readfirstlane(tid >> 6);
    const unsigned char* ws = P.ws;
    const int gw = bid * NWAVES + wave, NGW = nblk * NWAVES;
    f32x4 wv[4];
#pragma unroll
    for (int q = 0; q < 4; ++q) wv[q] = *(const f32x4*)(P.final_w + 16 * lane + 4 * q);
    for (int n = gw; n < NTOK; n += NGW) {
        float* orow = P.out + (size_t)n * DM + 16 * lane;
        const bf16_t* yrow = (const bf16_t*)(ws + WS_HIDP) + ((size_t)(lane >> 3) * NTOK + n) * 128 + 16 * (lane & 7);
        const u32x4 ya = *(const u32x4*)yrow, yb = *(const u32x4*)(yrow + 8);
        const unsigned yu[8] = {ya.x, ya.y, ya.z, ya.w, yb.x, yb.y, yb.z, yb.w};
        const float cs = ((const float*)(ws + WS_CSC))[n];
        const bf16_t* hrow = (const bf16_t*)(ws + WS_XB) + (size_t)n * DM + 16 * lane;
        const u32x4 ha = *(const u32x4*)hrow, hb = *(const u32x4*)(hrow + 8);
        const unsigned hu[8] = {ha.x, ha.y, ha.z, ha.w, hb.x, hb.y, hb.z, hb.w};
        f32x4 h[4]; float ss = 0.f;
#pragma unroll
        for (int q = 0; q < 4; ++q) { h[q] = (f32x4){bf2f(hu[2 * q] & 0xffffu), bf2f(hu[2 * q] >> 16), bf2f(hu[2 * q + 1] & 0xffffu), bf2f(hu[2 * q + 1] >> 16)} + (f32x4){bf2f(yu[2 * q] & 0xffffu), bf2f(yu[2 * q] >> 16), bf2f(yu[2 * q + 1] & 0xffffu), bf2f(yu[2 * q + 1] >> 16)} * cs; ss += (h[q].x * h[q].x + h[q].y * h[q].y) + (h[q].z * h[q].z + h[q].w * h[q].w); }
        ss = wave_sum_dpp(ss);
        const float rs = 1.f / sqrtf(ss * (1.f / DM) + EPS);
#pragma unroll
        for (int q = 0; q < 4; ++q) *(f32x4*)(orow + 4 * q) = h[q] * wv[q] * rs;
    }
}

#define XB_TMO      128
#define XB_XCNT(j)  (256  + 64 * (j))
#define XB_XSUB(j)  (1280 + 64 * (j))
#define XB_XGEN(j)  (2304 + 64 * (j))
#define XB_TOP      3328
#define XB_TOPGEN   3392
#define XCD_BAR_WORDS 3456
#define XB_SPIN_CAP (1u << 18)

__device__ __forceinline__ unsigned xb_ld(unsigned* p)              { return __hip_atomic_load(p, __ATOMIC_RELAXED, __HIP_MEMORY_SCOPE_AGENT); }
__device__ __forceinline__ unsigned xb_add(unsigned* p, unsigned v) { return __hip_atomic_fetch_add(p, v, __ATOMIC_RELAXED, __HIP_MEMORY_SCOPE_AGENT); }
__device__ __forceinline__ unsigned xb_xcc_id() { return (unsigned)__builtin_amdgcn_s_getreg((3 << 11) | 20) & 0xFu; }
#define XB_SPIN(cond, bar) do { unsigned _sp = 0; while (cond) { __builtin_amdgcn_s_sleep(1); \
    if ((++_sp & 255u) == 0u) { if (xb_ld(&(bar)[XB_TMO])) break; if (_sp > XB_SPIN_CAP) { atomicAdd(&(bar)[XB_TMO], 1u); break; } } } } while (0)

struct XcdBarrier {
    unsigned* bar; unsigned x;
    volatile LAS unsigned* st;
};

__device__ __forceinline__ XcdBarrier xcd_barrier_post(unsigned* bar, volatile LAS unsigned* st) {
    XcdBarrier b; b.bar = bar; b.x = xb_xcc_id(); b.st = st;
    if (threadIdx.x == 0) (void)xb_add(&bar[XB_XCNT(b.x)], 1u);
    return b;
}
__device__ __forceinline__ void xcd_barrier_complete(unsigned* bar, unsigned x, unsigned& nloc, unsigned& nx) {
    const unsigned G = gridDim.x * gridDim.y * gridDim.z;
    unsigned sum, cnt, mine, sp = 0u;
    for (;;) {
        sum = 0u; cnt = 0u; mine = 0u;
#pragma unroll
        for (unsigned j = 0; j < 16; ++j) { const unsigned c = xb_ld(&bar[XB_XCNT(j)]); sum += c; cnt += (c > 0u) ? 1u : 0u; mine = (j == x) ? c : mine; }
        if (sum == G) break;
        __builtin_amdgcn_s_sleep(1);
        if ((++sp & 255u) == 0u) { if (xb_ld(&bar[XB_TMO])) break; if (sp > XB_SPIN_CAP) { atomicAdd(&bar[XB_TMO], 1u); break; } }
    }
    nloc = mine > 0u ? mine : 1u; nx = cnt > 0u ? cnt : 1u;
}

__device__ __forceinline__ void xcd_barrier(const XcdBarrier& b) {
    asm volatile("s_waitcnt vmcnt(0)" ::: "memory");
    __syncthreads();
    if (threadIdx.x == 0) {
        unsigned* bar = b.bar;
        __builtin_amdgcn_s_waitcnt(0);
        unsigned nloc = b.st[0], nx = b.st[1];
        if (nloc == 0u) { xcd_barrier_complete(bar, b.x, nloc, nx); b.st[0] = nloc; b.st[1] = nx; }
        const unsigned old = xb_add(&bar[XB_XSUB(b.x)], 1u);
        const unsigned gen = old / nloc;
        if (old + 1u == (gen + 1u) * nloc) {
            __builtin_amdgcn_fence(__ATOMIC_RELEASE, "agent");
            asm volatile("s_waitcnt vmcnt(0)" ::: "memory");
            const unsigned og = xb_add(&bar[XB_TOP], 1u);
            const unsigned tg = og / nx;
            if (og + 1u == (tg + 1u) * nx) xb_add(&bar[XB_TOPGEN], 1u);
            else XB_SPIN(xb_ld(&bar[XB_TOPGEN]) == tg, bar);
            __builtin_amdgcn_fence(__ATOMIC_ACQUIRE, "agent");
            xb_add(&bar[XB_XGEN(b.x)], 1u);
            asm volatile("s_waitcnt vmcnt(0)" ::: "memory");
        } else {
            XB_SPIN(xb_ld(&bar[XB_XGEN(b.x)]) == gen, bar);
            __builtin_amdgcn_fence(__ATOMIC_ACQUIRE, "agent");
            asm volatile("s_waitcnt vmcnt(0)" ::: "memory");
        }
    }
    __syncthreads();
}

constexpr int CTL_XB_WORD = 2048;
static_assert((CTL_XB_WORD + 3456) * 4 <= (int)CTL_BYTES, "barrier words inside CTL");
constexpr int N_HGRN_ITEMS = BATCH * 4, N_ATT_ITEMS = BATCH * 4 * 32;

DI void mixer_phase(const Params& P, char* lds) {
    unsigned* ctr = (unsigned*)(P.ws + WS_CTL);
    for (;;) {
        if (tid_() == 0) *(LAS int*)((LAS char*)lds + LDS_ITEM) = (int)atomicAdd(ctr, 1u);
        __syncthreads();
        const int item = *(LAS int*)((LAS char*)lds + LDS_ITEM);
        __syncthreads();
        if (item >= N_HGRN_ITEMS + N_ATT_ITEMS) break;
        if (item < N_HGRN_ITEMS) hgrn_unit(P, item >> 2, item & 3, lds);
        else { const int a = item - N_HGRN_ITEMS, j = 31 - (a >> 5), bh = a & 31; attn_unit(P, bh >> 2, bh & 3, j, lds); }
    }
}

#ifdef TS_PHASE
#ifndef TS_DIV
#define TS_DIV 4.0f
#endif
#define TS(i) do { if (blockIdx.x == 0 && threadIdx.x == 0) ((LAS unsigned long long*)((LAS char*)lds + LDS_BYTES - 512))[i] = __builtin_amdgcn_s_memrealtime(); } while (0)
#else
#define TS(i) do { } while (0)
#endif
__global__ void __launch_bounds__(NTHREADS, 2) fwd_megakernel(Params P) {
    extern __shared__ __attribute__((aligned(16))) char lds[];
    cg::grid_group grid = cg::this_grid();
    const int bid = blockIdx.x, nblk = gridDim.x;
    unsigned char* ws = P.ws;
    volatile LAS unsigned* xst = (volatile LAS unsigned*)((LAS char*)lds + LDS_XB);
    if (threadIdx.x < 4) xst[threadIdx.x] = 0u;
    __syncthreads();
    const XcdBarrier xbar = xcd_barrier_post((unsigned*)(ws + WS_CTL) + CTL_XB_WORD, xst);
    TS(0);
    phase0(P, lds, bid, nblk);
    grid.sync();
    TS(1);
    { Epi1 e{ws}; gemm_run(lds, (const bf16_t*)(ws + WS_XB), (const bf16_t*)(ws + WS_W1T), M1, NCOL1, DM, e, bid, nblk); }
    {
        constexpr int NUNITS = (M1 / 256) * (NCOL1 / 256);
        const int nlast = NUNITS % nblk, nfree = nlast ? nblk - nlast : nblk;
        const int wave = __builtin_amdgcn_readfirstlane(tid_() >> 6);
        if (nlast == 0 || bid >= nlast) table_fp8_rows(P, (bid - (nlast ? nlast : 0)) * NWAVES + wave, nfree * NWAVES);
    }
    xcd_barrier(xbar);
    TS(2);
    for (int it = bid; it < 32 * 129; it += nblk) hgrn_prep_item(P, it & 31, it >> 5, lds);
    xcd_barrier(xbar);
    TS(3);
    mixer_phase(P, lds);
    xcd_barrier(xbar);
    TS(4);
    { Epi3 e{P.x, P.out, (bf16_t*)(ws + WS_XB), (float*)(ws + WS_SSQ)}; gemm_run(lds, (const bf16_t*)(ws + WS_MIX), (const bf16_t*)(ws + WS_W2T), NTOK, DM, DM, e, bid, nblk); }
    xcd_barrier(xbar);
    TS(5);
    { Epi4 e{(const float*)(ws + WS_SSQ), (bf16_t*)(ws + WS_PQ)}; gemm_run(lds, (const bf16_t*)(ws + WS_XB), (const bf16_t*)(ws + WS_W3T), NTOK, 2048, DM, e, bid, nblk); }
    xcd_barrier(xbar);
    TS(6);
    topk_phase(P, lds, bid, nblk);
    xn8_rows(P, bid, nblk);
    xcd_barrier(xbar);
    TS(7);
    mg_phase<1>(P, lds);
    xcd_barrier(xbar);
    TS(8);
    hid_reduce8_phase(P, bid, nblk);
    xcd_barrier(xbar);
    TS(9);
    mg_phase<2>(P, lds);
    xcd_barrier(xbar);
    TS(10);
    final_norm8_phase(P, bid, nblk);
    TS(11);
#ifdef TS_PHASE
    if (blockIdx.x == 0 && threadIdx.x == 0) { const LAS unsigned long long* t = (const LAS unsigned long long*)((LAS char*)lds + LDS_BYTES - 512);
        P.out[0] += (float)(t[TS_PHASE + 1] - t[TS_PHASE]) * 0.01f / TS_DIV; }
#endif
}

extern "C" void kernel_launch(void* const* d_in, const int* in_sizes, int n_in, void* d_out, int out_size, void* d_ws, size_t ws_size, hipStream_t stream) {
    static int grid = 0;
    if (grid == 0) {
        int dev = 0, cus = 0, per_cu = 0;
        (void)hipGetDevice(&dev);
        (void)hipDeviceGetAttribute(&cus, hipDeviceAttributeMultiprocessorCount, dev);
        (void)hipFuncSetAttribute((const void*)fwd_megakernel, hipFuncAttributeMaxDynamicSharedMemorySize, LDS_BYTES);
        (void)hipOccupancyMaxActiveBlocksPerMultiprocessor(&per_cu, (const void*)fwd_megakernel, NTHREADS, LDS_BYTES);
        if (per_cu < 1) { fprintf(stderr, "kernel_launch: occupancy query says %d blocks per CU\n", per_cu); per_cu = 1; }
        grid = cus * 1;
        if (ws_size < WS_END) { fprintf(stderr, "kernel_launch: workspace too small: %zu < %zu\n", ws_size, (size_t)WS_END); grid = -1; }
    }
    if (grid < 0) return;
    (void)hipMemsetAsync((char*)d_ws + WS_CTL, 0, CTL_BYTES, stream);
    Params p{};
    p.x = (const float*)d_in[0]; p.meta = (const float*)d_in[1]; p.mix_norm_w = (const float*)d_in[2]; p.w_in = (const float*)d_in[3];
    p.lb_logits = (const float*)d_in[4]; p.rec_norm_w = (const float*)d_in[5]; p.lq1 = (const float*)d_in[6]; p.lk1 = (const float*)d_in[7];
    p.lq2 = (const float*)d_in[8]; p.lk2 = (const float*)d_in[9]; p.subln_w = (const float*)d_in[10]; p.w_out = (const float*)d_in[11];
    p.ffn_norm_w = (const float*)d_in[12]; p.wq = (const float*)d_in[13]; p.subkeys = (const float*)d_in[14]; p.pu = (const float*)d_in[15];
    p.pv = (const float*)d_in[16]; p.final_w = (const float*)d_in[17];
    p.out = (float*)d_out; p.ws = (unsigned char*)d_ws;
    void* args[] = {&p};
    hipError_t e = hipLaunchCooperativeKernel((const void*)fwd_megakernel, dim3(grid), dim3(NTHREADS), args, LDS_BYTES, stream);
    if (e != hipSuccess) fprintf(stderr, "cooperative launch failed: %s (grid %d)\n", hipGetErrorString(e), grid);
}
```

```cpp
#include <hip/hip_runtime.h>
#include <hip/hip_cooperative_groups.h>
#include <cstdio>
#include <cstdint>
#define DBG_SEL 1
namespace cg = cooperative_groups;

constexpr int BATCH = 8, SEQ = 4096, DM = 1024, NMETA = 16;
constexpr int NTOK = BATCH * SEQ;
constexpr int M1 = NTOK + 256;
constexpr int NCOL1 = 3584;
constexpr int TPOS = NMETA + SEQ;
constexpr int KT = 65;
constexpr int KPAD = 48;
constexpr int HT = 4128;
constexpr int NEXP = 16384;
constexpr float EPS = 1e-6f;
constexpr float LAM_INIT = 0.2f;
constexpr float QSCALE = 0.125f * 1.4426950408889634f;
constexpr int NTHREADS = 512, NWAVES = 8;
constexpr int LDS_BYTES = 163840;
constexpr int LDS_ITEM = LDS_BYTES - 64, LDS_XB = LDS_BYTES - 32;

typedef unsigned short bf16_t;
typedef short bf16x8 __attribute__((ext_vector_type(8)));
typedef float f32x4 __attribute__((ext_vector_type(4)));
typedef float f32x16 __attribute__((ext_vector_type(16)));
typedef float f32x2 __attribute__((ext_vector_type(2)));
typedef unsigned u32x4 __attribute__((ext_vector_type(4)));
typedef unsigned u32x2 __attribute__((ext_vector_type(2)));
typedef __bf16 bf16x2_t __attribute__((ext_vector_type(2)));
typedef short s16x4 __attribute__((ext_vector_type(4)));
#define LAS __attribute__((address_space(3)))
#define DI __device__ __forceinline__
__device__ __forceinline__ int tid_() { int t = threadIdx.x; asm volatile("" : "+v"(t)); return t; }

constexpr size_t al256(size_t x) { return (x + 255) & ~(size_t)255; }
constexpr size_t WS_CTL = 0, CTL_BYTES = 65536;
constexpr size_t WS_W1T = WS_CTL + CTL_BYTES;
constexpr size_t WS_W2T = WS_W1T + (size_t)NCOL1 * DM * 2;
constexpr size_t WS_W3T = WS_W2T + (size_t)DM * DM * 2;
constexpr size_t WS_SKB = WS_W3T + (size_t)2048 * DM * 2;
constexpr size_t WS_UB = WS_SKB + (size_t)16 * 128 * 128 * 2;
constexpr size_t WS_VB = WS_UB + (size_t)NEXP * DM * 2;
constexpr size_t WS_USC = WS_UB + (size_t)NEXP * DM, WS_VSC = WS_VB + (size_t)NEXP * DM;
constexpr size_t WS_ROPE = WS_VB + (size_t)NEXP * DM * 2;
constexpr size_t WS_LB = WS_ROPE + (size_t)TPOS * 64 * 4;
constexpr size_t WS_R1 = WS_LB + 4096;
constexpr size_t WS_SSQ = WS_R1 + al256((size_t)M1 * 4);
constexpr size_t WS_SSQ2 = WS_SSQ + (size_t)NTOK * 4;
constexpr size_t WS_XB = WS_SSQ2 + (size_t)NTOK * 4;
constexpr size_t WS_C = WS_XB + (size_t)M1 * DM * 2;
constexpr size_t WS_Q = WS_C;
constexpr size_t WS_K = WS_Q + (size_t)NTOK * 512 * 2;
constexpr size_t WS_V = WS_K + (size_t)BATCH * 4 * 2 * KT * 8192;
constexpr size_t WS_HQ = WS_V + (size_t)BATCH * 4 * KT * 16384;
constexpr size_t WS_HV = WS_HQ + (size_t)BATCH * 4 * HT * 128 * 2;
constexpr size_t WS_HG = WS_HV + (size_t)BATCH * 4 * HT * 128 * 2;
constexpr size_t WS_SG = WS_HG + (size_t)BATCH * 4 * HT * 128 * 4;
constexpr size_t WS_CEND = WS_SG + (size_t)NTOK * 512 * 2;
constexpr size_t WS_PQ = WS_C;
constexpr size_t WS_EIDX = WS_PQ + (size_t)NTOK * 2048 * 2;
constexpr size_t WS_EGATE = WS_EIDX + (size_t)NTOK * 128 * 4;
constexpr size_t WS_HID = WS_EGATE + (size_t)NTOK * 128 * 4;
constexpr size_t WS_XN8 = WS_HID + (size_t)NTOK * 128 * 4;
constexpr size_t WS_XSC = WS_XN8 + (size_t)NTOK * DM;
constexpr size_t WS_C8 = WS_XSC + (size_t)NTOK * 4;
constexpr size_t WS_CSC = WS_C8 + (size_t)NTOK * 128;
static_assert(WS_CSC + (size_t)NTOK * 4 <= WS_CEND, "overlay fits");
constexpr size_t WS_HIDP = WS_PQ;
constexpr size_t WS_MIX = WS_CEND;
constexpr size_t WS_HQA = WS_MIX + (size_t)NTOK * DM * 2;
constexpr size_t WS_HD = WS_HQA + (size_t)BATCH * 4 * HT * 128 * 2;
constexpr size_t WS_END = WS_HD + (size_t)BATCH * 4 * 129 * 128 * 4;
static_assert(WS_END <= (size_t)512 * 1024 * 1024, "workspace map must fit 512 MiB");

struct Params {
    const float* x; const float* meta; const float* mix_norm_w; const float* w_in; const float* lb_logits; const float* rec_norm_w;
    const float* lq1; const float* lk1; const float* lq2; const float* lk2; const float* subln_w; const float* w_out; const float* ffn_norm_w;
    const float* wq; const float* subkeys; const float* pu; const float* pv; const float* final_w;
    float* out; unsigned char* ws;
};

DI unsigned f2bf(float f) { unsigned u = __builtin_bit_cast(unsigned, f); return (u + 0x7fffu + ((u >> 16) & 1u)) >> 16; }
DI float bf2f(unsigned b) { return __builtin_bit_cast(float, b << 16); }
DI unsigned cvtpk(float lo, float hi) { f32x2 v = {lo, hi}; bf16x2_t b = __builtin_convertvector(v, bf16x2_t); return __builtin_bit_cast(unsigned, b); }
DI float wave_sum(float v) {
#pragma unroll
    for (int o = 1; o < 64; o <<= 1) v += __shfl_xor(v, o);
    return v;
}
DI float sigmoidf_(float x) { return 1.f / (1.f + __expf(-x)); }
DI float siluf_(float x) { return x * sigmoidf_(x); }

DI int sigma_col(int c) {
    if (c >= 1024) return c;
    const int cc = c & 63, a = cc >> 5, fq = (cc >> 3) & 3, n = (cc >> 2) & 1, j = cc & 3;
    return (c & ~63) + 4 * (4 * a + fq) + 32 * n + j;
}
template <bool PERMUTE>
DI void p0_transpose_item(const float* W, int K, int N, const float* scale, bf16_t* WT, LAS float* scr, int item, int lane) {
    const int nblk = N / 32, kb = item / nblk, nb = item % nblk, k0 = 64 * kb, n0 = 32 * nb;
    const int ncol = PERMUTE ? sigma_col(n0 + (lane & 31)) : n0 + (lane & 31);
#pragma unroll 8
    for (int i = 0; i < 32; ++i) { const int kk = 2 * i + (lane >> 5); float s = scale ? scale[k0 + kk] : 1.f; scr[kk * 33 + (lane & 31)] = W[(size_t)(k0 + kk) * N + ncol] * s; }
    asm volatile("s_waitcnt lgkmcnt(0)" ::: "memory");
    const int c = lane & 7;
#pragma unroll
    for (int j = 0; j < 4; ++j) { const int n = (lane >> 3) + 8 * j; const LAS float* s = scr + (8 * c) * 33 + n;
        u32x4 o; o.x = cvtpk(s[0 * 33], s[1 * 33]); o.y = cvtpk(s[2 * 33], s[3 * 33]); o.z = cvtpk(s[4 * 33], s[5 * 33]); o.w = cvtpk(s[6 * 33], s[7 * 33]);
        *(u32x4*)(WT + (size_t)(n0 + n) * K + k0 + 8 * c) = o; }
    asm volatile("s_waitcnt lgkmcnt(0)" ::: "memory");
}

DI unsigned fp4_code(float x, float sc) {
    const float a = fabsf(x) * sc;
    const unsigned idx = (unsigned)(a > 0.25f) + (unsigned)(a > 0.75f) + (unsigned)(a > 1.25f) + (unsigned)(a > 1.75f) + (unsigned)(a > 2.5f) + (unsigned)(a > 3.5f) + (unsigned)(a > 5.0f);
    return idx | (x < 0.f ? 8u : 0u);
}
DI void table_fp8_rows(const Params& P, int first, int stride, int r_end) {
    const int lane = tid_() & 63;
    unsigned char* ws = P.ws;
    for (int r = first; r < r_end; r += stride) {
        const bool isv = r >= NEXP; const int e = isv ? r - NEXP : r;
        const f32x4* src = (const f32x4*)((isv ? P.pv : P.pu) + (size_t)e * DM) + lane;
        f32x4 v[4]; float amq[4];
#pragma unroll
        for (int q = 0; q < 4; ++q) { v[q] = src[64 * q]; amq[q] = fmaxf(fmaxf(fabsf(v[q].x), fabsf(v[q].y)), fmaxf(fabsf(v[q].z), fabsf(v[q].w))); }
#pragma unroll
        for (int o = 1; o < 64; o <<= 1) {
#pragma unroll
            for (int q = 0; q < 4; ++q) amq[q] = fmaxf(amq[q], __shfl_xor(amq[q], o));
        }
        if (isv) {
            const float am = fmaxf(fmaxf(amq[0], amq[1]), fmaxf(amq[2], amq[3]));
            const float sc = (am > 0.f) ? exp2f(floorf(log2f(224.f / am))) : 1.f;
            unsigned char* dst = ws + WS_VB + (size_t)e * 128;
#pragma unroll
            for (int q = 0; q < 4; ++q) {
                int w = __builtin_amdgcn_cvt_pk_fp8_f32(v[q].x * sc, v[q].y * sc, 0, false); w = __builtin_amdgcn_cvt_pk_fp8_f32(v[q].z * sc, v[q].w * sc, w, true);
                const int col = 256 * q + 4 * lane;
                *(unsigned*)(dst + (size_t)(col >> 7) * ((size_t)NEXP * 128) + (col & 127)) = (unsigned)w;
            }
            if (lane == 0) ((float*)(ws + WS_VSC))[e] = 1.f / sc;
        } else {
#pragma unroll
            for (int q = 0; q < 4; ++q) {
                const float sc = (amq[q] > 0.f) ? 6.f / amq[q] : 1.f;
                const unsigned w = fp4_code(v[q].x, sc) | (fp4_code(v[q].y, sc) << 4) | (fp4_code(v[q].z, sc) << 8) | (fp4_code(v[q].w, sc) << 12);
                *(unsigned short*)(ws + WS_UB + ((size_t)q * NEXP + e) * 128 + 2 * lane) = (unsigned short)w;
                if (lane == 0) ((float*)(ws + WS_USC))[(size_t)e * 4 + q] = 1.f / sc;
            }
        }
    }
}

DI void phase0(const Params& P, char* lds, int bid, int nblk) {
    const int tid = tid_(), lane = tid & 63, wave = __builtin_amdgcn_readfirstlane(tid >> 6);
    unsigned char* ws = P.ws;
    LAS float* scr = (LAS float*)(lds) + wave * (64 * 33);
    const int gw = bid * NWAVES + wave, NGW = nblk * NWAVES;
    constexpr int I1 = (DM / 64) * (NCOL1 / 32), I2 = (DM / 64) * (DM / 32), I3 = (DM / 64) * (2048 / 32);
    for (int it = gw; it < I1 + I2 + I3; it += NGW) {
        int r = it;
        if (r < I1) { p0_transpose_item<true>(P.w_in, DM, NCOL1, P.mix_norm_w, (bf16_t*)(ws + WS_W1T), scr, r, lane); continue; } r -= I1;
        if (r < I2) { p0_transpose_item<false>(P.w_out, DM, DM, nullptr, (bf16_t*)(ws + WS_W2T), scr, r, lane); continue; } r -= I2;
        p0_transpose_item<false>(P.wq, DM, 2048, P.ffn_norm_w, (bf16_t*)(ws + WS_W3T), scr, r, lane);
    }
    for (int m = gw; m < M1; m += NGW) {
        bf16_t* orow = (bf16_t*)(ws + WS_XB) + (size_t)m * DM;
        float* r1 = (float*)(ws + WS_R1);
        unsigned long long* o8 = (unsigned long long*)orow + lane;
        if (m >= NTOK + NMETA) { for (int j = 0; j < 4; ++j) o8[64 * j] = 0ull; if (lane == 0) r1[m] = 0.f; continue; }
        const float* xrow = (m < NTOK) ? P.x + (size_t)m * DM : P.meta + (size_t)(m - NTOK) * DM;
        const f32x4* xr = (const f32x4*)xrow + lane;
        f32x4 v[4]; float s = 0.f;
#pragma unroll
        for (int j = 0; j < 4; ++j) { v[j] = xr[64 * j]; s += (v[j].x * v[j].x + v[j].y * v[j].y) + (v[j].z * v[j].z + v[j].w * v[j].w); }
        s = wave_sum(s);
        if (lane == 0) r1[m] = 1.f / sqrtf(s * (1.f / DM) + EPS);
#pragma unroll
        for (int j = 0; j < 4; ++j) o8[64 * j] = (unsigned long long)cvtpk(v[j].x, v[j].y) | ((unsigned long long)cvtpk(v[j].z, v[j].w) << 32);
    }
    table_fp8_rows(P, gw, NGW, NEXP);
    {
        const size_t gt = (size_t)bid * NTHREADS + tid, NGT = (size_t)nblk * NTHREADS;
        const size_t ns = (size_t)16 * 128 * 128 / 8;
        for (size_t e = gt; e < ns; e += NGT) {
            const f32x4 a = ((const f32x4*)P.subkeys)[2 * e], b = ((const f32x4*)P.subkeys)[2 * e + 1];
            u32x4 o; o.x = cvtpk(a.x, a.y); o.y = cvtpk(a.z, a.w); o.z = cvtpk(b.x, b.y); o.w = cvtpk(b.z, b.w);
            ((u32x4*)(ws + WS_SKB))[e] = o;
        }
        float* rope = (float*)(ws + WS_ROPE);
        for (size_t i = gt; i < (size_t)TPOS * 32; i += NGT) {
            const int t = (int)(i >> 5), f = (int)(i & 31);
            const double inv = exp2(-(double)f * (13.287712379549449 / 32.0));
            const double ang = (double)t * inv;
            rope[(size_t)t * 64 + f] = (float)cos(ang); rope[(size_t)t * 64 + 32 + f] = (float)sin(ang);
        }
        float* ssq = (float*)(ws + WS_SSQ);
        for (size_t i = gt; i < (size_t)2 * NTOK; i += NGT) ssq[i] = 0.f;
        for (size_t i = gt; i < (size_t)BATCH * 4 * 2 * 512; i += NGT) { const size_t img = i >> 9, o = i & 511; ((u32x4*)(ws + WS_K + img * KT * 8192))[o] = (u32x4){0u, 0u, 0u, 0u}; }
        for (size_t i = gt; i < (size_t)BATCH * 4 * 1024; i += NGT) { const size_t img = i >> 10, o = i & 1023; ((u32x4*)(ws + WS_V + img * KT * 16384))[o] = (u32x4){0u, 0u, 0u, 0u}; }
        for (size_t i = gt; i < (size_t)BATCH * 4 * 16 * 16; i += NGT) { const size_t bh = i >> 8, o = i & 255;
            ((u32x4*)(ws + WS_HQ + bh * HT * 256))[o] = (u32x4){0u, 0u, 0u, 0u}; ((u32x4*)(ws + WS_HV + bh * HT * 256))[o] = (u32x4){0u, 0u, 0u, 0u}; }
        for (size_t i = gt; i < (size_t)BATCH * 4 * 16 * 32; i += NGT) { const size_t bh = i >> 9, o = i & 511; ((u32x4*)(ws + WS_HG + bh * HT * 512))[o] = (u32x4){0u, 0u, 0u, 0u}; }
        float* lb = (float*)(ws + WS_LB);
        if (gt < 512) lb[gt] = sigmoidf_(P.lb_logits[gt] - P.lb_logits[512 + gt]);
        if (bid == 0 && wave == 0) {
            const float a = wave_sum(P.lq1[lane] * P.lk1[lane]), b = wave_sum(P.lq2[lane] * P.lk2[lane]);
            if (lane == 0) lb[512] = __expf(a) - __expf(b) + LAM_INIT;
        }
    }
}

namespace pg8 {
#define PG8_LAS __attribute__((address_space(3)))
typedef unsigned short bf16_t;
typedef short bf16x8 __attribute__((ext_vector_type(8)));
typedef float f32x4 __attribute__((ext_vector_type(4)));
typedef unsigned u32x4 __attribute__((ext_vector_type(4)));
constexpr int BM = 256, BK = 64, HALF = 128, HTB = HALF * BK * 2  , STAGE_BYTES = 8 * HTB, NXCD = 8, WGM = 8;

__host__ __device__ __forceinline__ int lds_byte(int r, int c) { const int st = (r >> 4) * 2 + (c >> 5), rr = r & 15, cc = c & 31, ob = rr * 64 + cc * 2; return st * 1024 + (ob ^ (((ob >> 9) & 1) << 5)); }
__host__ __device__ __forceinline__ void stage_rc(int b, int& R, int& C) { const int st = b / 1024, sb = b % 1024, swz = sb ^ (((sb >> 9) & 1) << 5); R = (st >> 1) * 16 + swz / 64; C = (st & 1) * 32 + (swz % 64) / 2; }
__host__ __device__ __forceinline__ int perm32(int rho) { const int n = rho >> 4, i = rho & 15; return 8 * (i >> 2) + 4 * n + (i & 3); }

struct Unit { int pm, pn; };
struct Gemm { const bf16_t* A; const bf16_t* Bt; int M, N, K; };

struct StaticOrder {
    int nM, nN, nwg, G, c;
    __host__ __device__ void init(int M, int N, int G_, int c_) { nM = M / BM; nN = N / BM; nwg = nM * nN; G = G_; c = c_; }
    __host__ __device__ bool next(int i, Unit& u) const {
        const long L = (long)i * G + c; if (L >= nwg) return false;
        int wgid = (int)L; { const int q = nwg / NXCD, r = nwg % NXCD, xcd = wgid % NXCD, off = wgid / NXCD; wgid = (xcd < r ? xcd * (q + 1) : r * (q + 1) + (xcd - r) * q) + off; }
        const int nig = WGM * nN, gid = wgid / nig, fm = gid * WGM, gsz = (nM - fm) < WGM ? (nM - fm) : WGM;
        u.pm = fm + ((wgid % nig) % gsz); u.pn = (wgid % nig) / gsz; return true;
    }
    __device__ __forceinline__ void a_ready(const Unit&) const {}
    __device__ __forceinline__ void done(const Unit&) const {}
};

template <class Epi, class Sched, bool ALIGN_EPI = false, bool SP2 = false>
__device__ __forceinline__ void gemm_phase(PG8_LAS unsigned char* lds, const Gemm g, const Sched& S, const Epi& E) {
    const int tid = tid_(), wid = __builtin_amdgcn_readfirstlane(tid >> 6), lane = tid & 63, wr = wid >> 2, wc = wid & 3, fr = lane & 15, fq = lane >> 4;
    const int K = g.K, nt = K / BK;
    unsigned voffA[2], voffB[2];
#pragma unroll
    for (int i = 0; i < 2; ++i) { int R, C; stage_rc(tid * 16 + i * 8192, R, C); const int Rb = Epi::PERM ? ((R & ~31) + perm32(R & 31)) : R;
        voffA[i] = (unsigned)(R * K + C) * 2u; voffB[i] = (unsigned)(Rb * K + C) * 2u; }
    const size_t kstep = (size_t)(BK * 2);
    const size_t hstep = (size_t)HALF * K * 2;
    const size_t tstep = 2 * hstep;
    const unsigned ldsw = (unsigned)wid * 1024u;
    const int aoff = lds_byte(wr * 64 + fr, fq * 8), boff = lds_byte(wc * 32 + fr, fq * 8);
#define PG8_SA(b, h) (((b) * 2 + (h)) * HTB)
#define PG8_SB(b, h) ((4 + (b) * 2 + (h)) * HTB)
#define PG8_STAGE(bufoff, gbase, voff) do { _Pragma("unroll") for (int _i = 0; _i < 2; ++_i) \
        __builtin_amdgcn_global_load_lds((const unsigned*)((const char*)(gbase) + (voff)[_i]), (PG8_LAS unsigned*)(lds + (bufoff) + ldsw + _i * 8192), 16, 0, 0); } while (0)
#define PG8_LDA(dst, b, h) do { _Pragma("unroll") for (int m = 0; m < 4; ++m) _Pragma("unroll") for (int k = 0; k < 2; ++k) dst[m][k] = *(const PG8_LAS bf16x8*)(lds + PG8_SA(b, h) + aoff + m * 2048 + k * 1024); } while (0)
#define PG8_LDB(dst, b, h) do { _Pragma("unroll") for (int n = 0; n < 2; ++n) _Pragma("unroll") for (int k = 0; k < 2; ++k) dst[n][k] = *(const PG8_LAS bf16x8*)(lds + PG8_SB(b, h) + boff + n * 2048 + k * 1024); } while (0)
#define PG8_MMA(ai, bj, At, Bt) do { __builtin_amdgcn_s_setprio(1); _Pragma("unroll") for (int m = 0; m < 4; ++m) _Pragma("unroll") for (int n = 0; n < 2; ++n) _Pragma("unroll") for (int k = 0; k < 2; ++k) \
        acc[ai][bj][m][n] = __builtin_amdgcn_mfma_f32_16x16x32_bf16(Bt[n][k], At[m][k], acc[ai][bj][m][n], 0, 0, 0); __builtin_amdgcn_s_setprio(0); } while (0)
#define PG8_WAIT_V(n) asm volatile("s_waitcnt vmcnt(" #n ")" ::: "memory")
#define PG8_WAIT_L(n) asm volatile("s_waitcnt lgkmcnt(" #n ")" ::: "memory")
#define PG8_BAR __builtin_amdgcn_s_barrier()
#define PG8_SCHED __builtin_amdgcn_sched_barrier(0)
    Unit cur, nxt; int ui = 0;
    if (!S.next(0, cur)) return;
    f32x4 acc[2][2][4][2];
#pragma unroll
    for (int a = 0; a < 2; ++a)
#pragma unroll
        for (int b = 0; b < 2; ++b)
#pragma unroll
            for (int m = 0; m < 4; ++m)
#pragma unroll
                for (int n = 0; n < 2; ++n) acc[a][b][m][n] = (f32x4){0.f, 0.f, 0.f, 0.f};
    bf16x8 At[4][2], B0[2][2], B1[2][2];
    const char* cA = (const char*)g.A + (size_t)cur.pm * tstep; const char* cB = (const char*)g.Bt + (size_t)cur.pn * tstep;
    S.a_ready(cur);
    if constexpr (SP2) {
        PG8_STAGE(PG8_SB(0, 0), cB, voffB); PG8_STAGE(PG8_SB(0, 1), cB + hstep, voffB); PG8_STAGE(PG8_SA(0, 0), cA, voffA); PG8_STAGE(PG8_SA(0, 1), cA + hstep, voffA);
        if (wr == 1) PG8_BAR;
        PG8_WAIT_V(2); PG8_BAR;
        PG8_STAGE(PG8_SB(1, 0), cB + kstep, voffB); PG8_STAGE(PG8_SA(1, 0), cA + kstep, voffA); PG8_STAGE(PG8_SB(1, 1), cB + hstep + kstep, voffB);
        PG8_WAIT_V(6); PG8_BAR;
    } else {
        PG8_STAGE(PG8_SB(0, 0), cB, voffB); PG8_STAGE(PG8_SA(0, 0), cA, voffA); PG8_STAGE(PG8_SB(0, 1), cB + hstep, voffB); PG8_STAGE(PG8_SA(0, 1), cA + hstep, voffA);
        if (wr == 1) PG8_BAR;
        PG8_WAIT_V(4); PG8_BAR;
        PG8_STAGE(PG8_SB(1, 0), cB + kstep, voffB); PG8_STAGE(PG8_SA(1, 0), cA + kstep, voffA); PG8_STAGE(PG8_SB(1, 1), cB + hstep + kstep, voffB);
        PG8_WAIT_V(6); PG8_BAR;
    }
    for (;;) {
        const bool has_next = S.next(ui + 1, nxt);
        const char* nA = has_next ? (const char*)g.A + (size_t)nxt.pm * tstep : cA; const char* nB = has_next ? (const char*)g.Bt + (size_t)nxt.pn * tstep : cB;
        for (int t = 0; t < nt; t += 2) {
            const bool last = (t == nt - 2);
            const char* a1 = cA + (size_t)(t + 1) * kstep;
            const char* a2 = last ? nA : cA + (size_t)(t + 2) * kstep; const char* b2 = last ? nB : cB + (size_t)(t + 2) * kstep;
            const char* a3 = a2 + kstep; const char* b3 = b2 + kstep;
            if (last && has_next) S.a_ready(nxt);
            if constexpr (SP2) {
            PG8_LDB(B0, 0, 0); PG8_LDB(B1, 0, 1); PG8_SCHED; PG8_LDA(At, 0, 0); PG8_STAGE(PG8_SA(1, 1), a1 + hstep, voffA);
            PG8_WAIT_V(8); PG8_WAIT_L(0); PG8_BAR; PG8_MMA(0, 0, At, B0); PG8_MMA(0, 1, At, B1); PG8_BAR; PG8_SCHED;
            PG8_LDA(At, 0, 1); PG8_STAGE(PG8_SB(0, 0), b2, voffB); PG8_STAGE(PG8_SB(0, 1), b2 + hstep, voffB); PG8_STAGE(PG8_SA(0, 0), a2, voffA);
            PG8_WAIT_V(8); PG8_WAIT_L(0); PG8_BAR; PG8_MMA(1, 0, At, B0); PG8_MMA(1, 1, At, B1); PG8_BAR; PG8_SCHED;
            PG8_LDB(B0, 1, 0); PG8_LDB(B1, 1, 1); PG8_SCHED; PG8_LDA(At, 1, 0); PG8_STAGE(PG8_SA(0, 1), a2 + hstep, voffA);
            PG8_WAIT_V(8); PG8_WAIT_L(0); PG8_BAR; PG8_MMA(0, 0, At, B0); PG8_MMA(0, 1, At, B1); PG8_BAR; PG8_SCHED;
            PG8_LDA(At, 1, 1); PG8_STAGE(PG8_SB(1, 0), b3, voffB); PG8_STAGE(PG8_SB(1, 1), b3 + hstep, voffB); PG8_STAGE(PG8_SA(1, 0), a3, voffA);
            PG8_WAIT_V(8); PG8_WAIT_L(0); PG8_BAR; PG8_MMA(1, 0, At, B0); PG8_MMA(1, 1, At, B1); PG8_BAR; PG8_SCHED;
            } else {
            PG8_LDB(B0, 0, 0); PG8_SCHED; PG8_LDA(At, 0, 0); PG8_STAGE(PG8_SA(1, 1), a1 + hstep, voffA);
            PG8_WAIT_L(8); PG8_BAR; PG8_WAIT_L(0); PG8_MMA(0, 0, At, B0); PG8_BAR; PG8_SCHED;
            PG8_LDB(B1, 0, 1); PG8_STAGE(PG8_SB(0, 0), b2, voffB);
            PG8_BAR; PG8_WAIT_L(0); PG8_MMA(0, 1, At, B1); PG8_BAR;
            PG8_LDA(At, 0, 1); PG8_STAGE(PG8_SA(0, 0), a2, voffA);
            PG8_BAR; PG8_WAIT_L(0); PG8_MMA(1, 0, At, B0); PG8_BAR; PG8_SCHED;
            PG8_STAGE(PG8_SB(0, 1), b2 + hstep, voffB);
            PG8_WAIT_V(6); PG8_BAR; PG8_MMA(1, 1, At, B1); PG8_BAR;
            PG8_LDB(B0, 1, 0); PG8_SCHED; PG8_LDA(At, 1, 0); PG8_STAGE(PG8_SA(0, 1), a2 + hstep, voffA);
            PG8_WAIT_L(8); PG8_BAR; PG8_WAIT_L(0); PG8_MMA(0, 0, At, B0); PG8_BAR; PG8_SCHED;
            PG8_LDB(B1, 1, 1); PG8_STAGE(PG8_SB(1, 0), b3, voffB);
            PG8_BAR; PG8_WAIT_L(0); PG8_MMA(0, 1, At, B1); PG8_BAR;
            PG8_LDA(At, 1, 1); PG8_STAGE(PG8_SA(1, 0), a3, voffA);
            PG8_BAR; PG8_WAIT_L(0); PG8_MMA(1, 0, At, B0); PG8_BAR; PG8_SCHED;
            PG8_STAGE(PG8_SB(1, 1), b3 + hstep, voffB);
            PG8_WAIT_V(6); PG8_BAR; PG8_MMA(1, 1, At, B1); PG8_BAR;
            }
        }
        if constexpr (ALIGN_EPI) { if (wr == 0) PG8_BAR; }
        if constexpr (!Epi::AFTER_DRAIN) { E(acc, cur, wr, wc, fr, fq); S.done(cur); }
        if (!has_next) break;
#pragma unroll
        for (int a = 0; a < 2; ++a)
#pragma unroll
            for (int b = 0; b < 2; ++b)
#pragma unroll
                for (int m = 0; m < 4; ++m)
#pragma unroll
                    for (int n = 0; n < 2; ++n) acc[a][b][m][n] = (f32x4){0.f, 0.f, 0.f, 0.f};
        cur = nxt; cA = nA; cB = nB; ++ui;
        if constexpr (ALIGN_EPI) { if (wr == 1) PG8_BAR; }
    }
    PG8_WAIT_V(0);
    if constexpr (!ALIGN_EPI) { if (wr == 0) PG8_BAR; }
    PG8_BAR;
    if constexpr (Epi::AFTER_DRAIN) { E.fused(acc, cur, wr, wc, fr, fq, lds, wid, lane); S.done(cur); }
#undef PG8_SA
#undef PG8_SB
#undef PG8_STAGE
#undef PG8_LDA
#undef PG8_LDB
#undef PG8_MMA
#undef PG8_WAIT_V
#undef PG8_WAIT_L
#undef PG8_BAR
#undef PG8_SCHED
}
}

DI u32x2 pack4(f32x4 v) { u32x2 r; r.x = cvtpk(v.x, v.y); r.y = cvtpk(v.z, v.w); return r; }
DI u32x4 pack8(f32x4 a, f32x4 b) { u32x4 r; r.x = cvtpk(a.x, a.y); r.y = cvtpk(a.z, a.w); r.z = cvtpk(b.x, b.y); r.w = cvtpk(b.z, b.w); return r; }

struct Epi1 {
    static constexpr bool PERM = true, AFTER_DRAIN = false;
    unsigned char* ws;
    DI void operator()(const f32x4 (&acc)[2][2][4][2], const pg8::Unit& u, int wr, int wc, int fr, int fq) const {
        const float* r1p = (const float*)(ws + WS_R1);
        const float* rope = (const float*)(ws + WS_ROPE);
        const float* lbp = (const float*)(ws + WS_LB);
        const int seg = u.pn >> 1;
#pragma unroll
        for (int ai = 0; ai < 2; ++ai)
#pragma unroll
            for (int m = 0; m < 4; ++m) {
                const int row = u.pm * 256 + ai * 128 + wr * 64 + m * 16 + fr;
                const bool meta = row >= NTOK;
                if (row >= NTOK + NMETA) continue;
                const float r1 = r1p[row];
                const int b = meta ? 0 : (row >> 12), t = meta ? (row - NTOK) : ((row & 4095) + NMETA);
                const int nrep = meta ? BATCH : 1;
#pragma unroll
                for (int bj = 0; bj < 2; ++bj) {
                    const int cs = (u.pn & 1) * 256 + bj * 128 + wc * 32 + 8 * fq;
                    const f32x4 v0 = acc[ai][bj][m][0] * r1, v1 = acc[ai][bj][m][1] * r1;
                    const int h = cs >> 7;
                    if (seg <= 1) {
                        const int comp = (cs >> 6) & 1, cc = cs & 63, i0 = 16 * (cc >> 5) + 4 * fq;
                        const f32x4 c4 = *(const f32x4*)(rope + (size_t)t * 64 + i0), s4 = *(const f32x4*)(rope + (size_t)t * 64 + 32 + i0);
                        f32x4 lo = v0 * c4 - v1 * s4, hi = v1 * c4 + v0 * s4;
                        if (seg == 0) {
                            if (meta) continue;
                            lo = lo * QSCALE; hi = hi * QSCALE;
                            bf16_t* qp = (bf16_t*)(ws + WS_Q) + ((size_t)(((b * 4 + h) * 2 + comp) * SEQ + (row & 4095))) * 64;
                            *(u32x2*)(qp + i0) = pack4(lo); *(u32x2*)(qp + i0 + 32) = pack4(hi);
                        } else {
                            const int pp = t + KPAD, tile = pp >> 6, key = pp & 63;
                            for (int bb = 0; bb < nrep; ++bb) {
                                const int b_ = meta ? bb : b;
                                unsigned char* img = ws + WS_K + ((size_t)((b_ * 4 + h) * 2 + comp) * KT + tile) * 8192;
                                *(u32x2*)(img + (i0 >> 3) * 1024 + key * 16 + (i0 & 7) * 2) = pack4(lo);
                                *(u32x2*)(img + ((i0 >> 3) + 4) * 1024 + key * 16 + (i0 & 7) * 2) = pack4(hi);
                            }
                        }
                    } else if (seg == 2) {
                        const int dv = cs & 127, pp = t + KPAD, tile = pp >> 6, key = pp & 63;
                        const u32x4 w = pack8(v0, v1);
                        for (int bb = 0; bb < nrep; ++bb) {
                            const int b_ = meta ? bb : b;
                            unsigned char* img = ws + WS_V + ((size_t)(b_ * 4 + h) * KT + tile) * 16384;
                            *(u32x4*)(img + (dv >> 5) * 4096 + key * 64 + (dv & 31) * 2) = w;
                        }
                    } else if (seg == 3 || seg == 5) {
                        const int dv = cs & 127;
                        f32x4 a = v0, c = v1;
                        if (seg == 3) { a.x = siluf_(a.x); a.y = siluf_(a.y); a.z = siluf_(a.z); a.w = siluf_(a.w); c.x = siluf_(c.x); c.y = siluf_(c.y); c.z = siluf_(c.z); c.w = siluf_(c.w); }
                        const u32x4 w = pack8(a, c);
                        const size_t base = (seg == 3) ? WS_HQ : WS_HV;
                        for (int bb = 0; bb < nrep; ++bb) {
                            const int b_ = meta ? bb : b;
                            *(u32x4*)((bf16_t*)(ws + base) + ((size_t)(b_ * 4 + h) * HT + t + 16) * 128 + dv) = w;
                        }
                    } else if (seg == 4) {
                        const int dv = cs & 127;
                        const f32x4 l0 = *(const f32x4*)(lbp + cs), l1 = *(const f32x4*)(lbp + cs + 4);
                        f32x4 g0, g1;
#pragma unroll
                        for (int e = 0; e < 4; ++e) { g0[e] = __logf(l0[e] + (1.f - l0[e]) * sigmoidf_(v0[e])); g1[e] = __logf(l1[e] + (1.f - l1[e]) * sigmoidf_(v1[e])); }
                        for (int bb = 0; bb < nrep; ++bb) {
                            const int b_ = meta ? bb : b;
                            float* gp = (float*)(ws + WS_HG) + ((size_t)(b_ * 4 + h) * HT + t + 16) * 128 + dv;
                            *(f32x4*)gp = g0; *(f32x4*)(gp + 4) = g1;
                        }
                    } else {
                        if (meta) continue;
                        f32x4 a = v0, c = v1;
                        a.x = siluf_(a.x); a.y = siluf_(a.y); a.z = siluf_(a.z); a.w = siluf_(a.w); c.x = siluf_(c.x); c.y = siluf_(c.y); c.z = siluf_(c.z); c.w = siluf_(c.w);
                        *(u32x4*)((bf16_t*)(ws + WS_SG) + (size_t)row * 512 + cs) = pack8(a, c);
                    }
                }
            }
    }
};

struct Epi3 {
    static constexpr bool PERM = true, AFTER_DRAIN = false;
    const float* x; float* H; bf16_t* HB; float* ssq;
    DI void operator()(const f32x4 (&acc)[2][2][4][2], const pg8::Unit& u, int wr, int wc, int fr, int fq) const {
#pragma unroll
        for (int ai = 0; ai < 2; ++ai)
#pragma unroll
            for (int m = 0; m < 4; ++m) {
                const int row = u.pm * 256 + ai * 128 + wr * 64 + m * 16 + fr;
                float s = 0.f;
#pragma unroll
                for (int bj = 0; bj < 2; ++bj) {
                    const int col = u.pn * 256 + bj * 128 + wc * 32 + 8 * fq;
                    const size_t o = (size_t)row * DM + col;
                    const u32x4 xb = *(const u32x4*)(HB + o);
                    const f32x4 x0 = (f32x4){bf2f(xb.x & 0xffffu), bf2f(xb.x >> 16), bf2f(xb.y & 0xffffu), bf2f(xb.y >> 16)}, x1 = (f32x4){bf2f(xb.z & 0xffffu), bf2f(xb.z >> 16), bf2f(xb.w & 0xffffu), bf2f(xb.w >> 16)};
                    const f32x4 h0 = x0 + acc[ai][bj][m][0], h1 = x1 + acc[ai][bj][m][1];
                    *(u32x4*)(HB + o) = pack8(h0, h1);
                    s += (h0.x * h0.x + h0.y * h0.y) + (h0.z * h0.z + h0.w * h0.w) + (h1.x * h1.x + h1.y * h1.y) + (h1.z * h1.z + h1.w * h1.w);
                }
                s += __shfl_xor(s, 16); s += __shfl_xor(s, 32);
                if (fq == 0) atomicAdd(ssq + row, s);
            }
    }
};

struct Epi4 {
    static constexpr bool PERM = true, AFTER_DRAIN = false;
    const float* ssq; bf16_t* PQ;
    DI void operator()(const f32x4 (&acc)[2][2][4][2], const pg8::Unit& u, int wr, int wc, int fr, int fq) const {
#pragma unroll
        for (int ai = 0; ai < 2; ++ai)
#pragma unroll
            for (int m = 0; m < 4; ++m) {
                const int row = u.pm * 256 + ai * 128 + wr * 64 + m * 16 + fr;
                const float r2 = 1.f / sqrtf(ssq[row] * (1.f / DM) + EPS);
#pragma unroll
                for (int bj = 0; bj < 2; ++bj) {
                    const int col = u.pn * 256 + bj * 128 + wc * 32 + 8 * fq;
                    *(u32x4*)(PQ + (size_t)row * 2048 + col) = pack8(acc[ai][bj][m][0] * r2, acc[ai][bj][m][1] * r2);
                }
            }
    }
};

template <class Epi>
DI void gemm_run(char* lds, const bf16_t* A, const bf16_t* Bt, int M, int N, int K, const Epi& E, int bid, int nblk) {
    pg8::Gemm g{A, Bt, M, N, K}; pg8::StaticOrder S; S.init(M, N, nblk, bid);
    pg8::gemm_phase<Epi, pg8::StaticOrder, true, true>((LAS unsigned char*)lds, g, S, E);
}
#define MFMA32(a, b, c) __builtin_amdgcn_mfma_f32_32x32x16_bf16(a, b, c, 0, 0, 0)
typedef short v4i16_t __attribute__((ext_vector_type(4)));
DI int crow(int r, int hi) { return (r & 3) + 8 * (r >> 2) + 4 * hi; }
DI s16x4 vtr(const LAS char* p) { return __builtin_bit_cast(s16x4, __builtin_amdgcn_ds_read_tr16_b64_v4i16((LAS v4i16_t*)p)); }
DI void glds16(const void* g, LAS char* l) { __builtin_amdgcn_global_load_lds((const unsigned*)g, (LAS unsigned*)l, 16, 0, 0); }
DI float swap_max(float m) { auto rr = __builtin_amdgcn_permlane32_swap(__float_as_uint(m), __float_as_uint(m), false, false); return fmaxf(__uint_as_float(rr[0]), __uint_as_float(rr[1])); }
DI float swap_sum(float m) { auto rr = __builtin_amdgcn_permlane32_swap(__float_as_uint(m), __float_as_uint(m), false, false); return __uint_as_float(rr[0]) + __uint_as_float(rr[1]); }
constexpr int ATT_BUF = 32768, ATT_WSF = 65536;
constexpr float ATT_THR = 8.f;

DI void attn_unit(const Params& P, int b, int h, int j, char* lds_g) {
    LAS char* lds = (LAS char*)lds_g;
    const int tid = tid_(), lane = tid & 63, r32 = lane & 31, hi = lane >> 5;
    const int wid = __builtin_amdgcn_readfirstlane(tid >> 6), comp = wid >> 2, wq = wid & 3;
    const unsigned char* ws = P.ws;
    const int bh = b * 4 + h;
    const bf16_t* Qw = (const bf16_t*)(ws + WS_Q) + ((size_t)((bh * 2 + comp) * SEQ + 128 * j + 32 * wq)) * 64;
    bf16x8 qr[4];
#pragma unroll
    for (int d0 = 0; d0 < 4; ++d0) qr[d0] = *(const bf16x8*)(Qw + r32 * 64 + d0 * 16 + hi * 8);
    const unsigned char* kimg0 = ws + WS_K + (size_t)(bh * 2) * KT * 8192 + wid * 1024 + lane * 16;
    const unsigned char* kimg1 = kimg0 + (size_t)KT * 8192;
    const unsigned char* vimg = ws + WS_V + (size_t)bh * KT * 16384 + wid * 1024 + lane * 16;
    const int NT = 2 * j + 3, my_last = (wq < 2) ? 2 * j + 1 : 2 * j + 2;
    LAS float* wsf = (LAS float*)(lds + ATT_WSF) + wid * 64;
#define ATT_ISSUE(t, s) do { LAS char* d_ = lds + (s) * ATT_BUF + wid * 1024; \
        glds16(kimg0 + (size_t)(t) * 8192, d_); glds16(kimg1 + (size_t)(t) * 8192, d_ + 8192); \
        glds16(vimg + (size_t)(t) * 16384, d_ + 16384); glds16(vimg + (size_t)(t) * 16384 + 8192, d_ + 24576); } while (0)
    f32x16 o[4];
#pragma unroll
    for (int nb = 0; nb < 4; ++nb) o[nb] = f32x16{};
    float mref = 0.f, lsum = 0.f;
    const int qpos = 64 + 128 * j + 32 * wq + r32;
    ATT_ISSUE(0, 0);
    __syncthreads();
    for (int t = 0; t < NT; ++t) {
        const int s = t & 1;
        if (t + 1 < NT) ATT_ISSUE(t + 1, s ^ 1);
        if (t <= my_last) {
            const LAS char* kp = lds + s * ATT_BUF + comp * 8192 + hi * 1024 + r32 * 16;
            f32x16 s0 = f32x16{}, s1 = f32x16{};
#pragma unroll
            for (int d0 = 0; d0 < 4; ++d0) {
                const bf16x8 k0 = *(const LAS bf16x8*)(kp + d0 * 2048), k1 = *(const LAS bf16x8*)(kp + d0 * 2048 + 512);
                s0 = MFMA32(k0, qr[d0], s0); s1 = MFMA32(k1, qr[d0], s1);
            }
            if (t == 0) {
#pragma unroll
                for (int r = 0; r < 16; ++r) { s0[r] = -INFINITY; if (32 + crow(r, hi) < KPAD) s1[r] = -INFINITY; }
            }
            if (t >= 2 * j + 1) {
                const int kb = 64 * t + 4 * hi;
#pragma unroll
                for (int r = 0; r < 16; ++r) { const int kv = kb + (r & 3) + 8 * (r >> 2); if (kv > qpos) s0[r] = -INFINITY; if (kv + 32 > qpos) s1[r] = -INFINITY; }
            }
            float rm = fmaxf(s0[0], s1[0]);
#pragma unroll
            for (int r = 1; r < 16; ++r) rm = fmaxf(rm, fmaxf(s0[r], s1[r]));
            rm = swap_max(rm);
            if (t == 0) mref = rm;
            else {
                const float grow = rm - mref;
                if (__any(grow > ATT_THR)) {
                    const float dl = fmaxf(grow, 0.f), f = __builtin_amdgcn_exp2f(-dl);
                    mref += dl; lsum *= f;
                    if (hi == 0) wsf[r32] = f;
                    asm volatile("s_waitcnt lgkmcnt(0)" ::: "memory");
#pragma unroll
                    for (int r = 0; r < 16; ++r) { const float fr_ = wsf[crow(r, hi)];
#pragma unroll
                        for (int nb = 0; nb < 4; ++nb) o[nb][r] *= fr_; }
                }
            }
            float ps = 0.f;
#pragma unroll
            for (int r = 0; r < 16; ++r) { s0[r] = __builtin_amdgcn_exp2f(s0[r] - mref); s1[r] = __builtin_amdgcn_exp2f(s1[r] - mref); ps += s0[r] + s1[r]; }
            lsum += ps;
            const LAS char* vp = lds + s * ATT_BUF + 16384 + ((lane >> 4) & 1) * 32 + (lane & 3) * 8 + (4 * hi + ((lane & 15) >> 2)) * 64;
#pragma unroll
            for (int ks = 0; ks < 4; ++ks) {
                u32x4 pw;
                if (ks < 2) { pw.x = cvtpk(s0[8 * ks], s0[8 * ks + 1]); pw.y = cvtpk(s0[8 * ks + 2], s0[8 * ks + 3]); pw.z = cvtpk(s0[8 * ks + 4], s0[8 * ks + 5]); pw.w = cvtpk(s0[8 * ks + 6], s0[8 * ks + 7]); }
                else { const int q_ = ks - 2; pw.x = cvtpk(s1[8 * q_], s1[8 * q_ + 1]); pw.y = cvtpk(s1[8 * q_ + 2], s1[8 * q_ + 3]); pw.z = cvtpk(s1[8 * q_ + 4], s1[8 * q_ + 5]); pw.w = cvtpk(s1[8 * q_ + 6], s1[8 * q_ + 7]); }
                const bf16x8 pa = __builtin_bit_cast(bf16x8, pw);
#pragma unroll
                for (int nb = 0; nb < 4; ++nb) {
                    const s16x4 vlo = vtr(vp + nb * 4096 + ks * 1024), vhi = vtr(vp + nb * 4096 + ks * 1024 + 512);
                    const bf16x8 vb = (bf16x8){vlo[0], vlo[1], vlo[2], vlo[3], vhi[0], vhi[1], vhi[2], vhi[3]};
                    o[nb] = MFMA32(pa, vb, o[nb]);
                }
            }
        }
        __syncthreads();
    }
#undef ATT_ISSUE
    lsum = swap_sum(lsum);
    if (hi == 0) wsf[r32] = lsum;
    asm volatile("s_waitcnt lgkmcnt(0)" ::: "memory");
    float rli[16];
#pragma unroll
    for (int r = 0; r < 16; ++r) rli[r] = 1.f / wsf[crow(r, hi)];
    const float lam = ((const float*)(ws + WS_LB))[512];
    LAS float* ex = (LAS float*)lds + wq * 4096;
    if (comp == 1) {
#pragma unroll
        for (int r = 0; r < 16; ++r)
#pragma unroll
            for (int nb = 0; nb < 4; ++nb) ex[(r * 4 + nb) * 64 + lane] = o[nb][r] * rli[r] * lam;
    }
    __syncthreads();
    if (comp == 0) {
        float ss[16];
#pragma unroll
        for (int r = 0; r < 16; ++r) { float a = 0.f;
#pragma unroll
            for (int nb = 0; nb < 4; ++nb) { const float v = o[nb][r] * rli[r] - ex[(r * 4 + nb) * 64 + lane]; o[nb][r] = v; a += v * v; }
            ss[r] = a; }
#pragma unroll
        for (int r = 0; r < 16; ++r) { float a = ss[r]; a += __shfl_xor(a, 1); a += __shfl_xor(a, 2); a += __shfl_xor(a, 4); a += __shfl_xor(a, 8); a += __shfl_xor(a, 16); ss[r] = (1.f - LAM_INIT) / sqrtf(a * (1.f / 128.f) + EPS); }
        bf16_t* mix = (bf16_t*)(ws + WS_MIX) + ((size_t)(b * SEQ + 128 * j + 32 * wq)) * DM + h * 128;
#pragma unroll
        for (int nb = 0; nb < 4; ++nb) { const float w = P.subln_w[32 * nb + r32];
#pragma unroll
            for (int r = 0; r < 16; ++r) mix[(size_t)crow(r, hi) * DM + 32 * nb + r32] = (bf16_t)f2bf(o[nb][r] * ss[r] * w); }
    }
    __syncthreads();
}
#define MFMA16(a, b, c) __builtin_amdgcn_mfma_f32_16x16x32_bf16(a, b, c, 0, 0, 0)
constexpr int HG_STR = 272;
constexpr int HL_QA = 0, HL_QB = HL_QA + 32 * HG_STR, HL_KB = HL_QB + 32 * HG_STR, HL_KT = HL_KB + 32 * HG_STR, HL_VV = HL_KT + 32 * HG_STR;
constexpr int HL_PS = HL_VV + 32 * HG_STR;
constexpr int HL_D = HL_PS + 4 * 128 * 4;
constexpr int HL_OUT = HL_D + 128 * 4;
constexpr int HL_END = HL_OUT + 32 * 132 * 4;

constexpr int HB_KTF = 0, HB_ATF = 8192, HB_DF = 10240;
DI void hgrn_prep_item(const Params& P, int bh, int c, char* lds_g) {
    LAS char* lds = (LAS char*)lds_g;
    const int tid = tid_(), lane = tid & 63, c16 = lane & 15, g4 = lane >> 4, ch = tid & 127, part = tid >> 7;
    const int wid = __builtin_amdgcn_readfirstlane(tid >> 6);
    const int vrow = tid >> 4, vcol = (tid & 15) * 8;
    unsigned char* ws = P.ws;
    const float* HG = (const float*)(ws + WS_HG) + (size_t)bh * HT * 128;
    const bf16_t* HQ = (const bf16_t*)(ws + WS_HQ) + (size_t)bh * HT * 128;
    const bf16_t* HV = (const bf16_t*)(ws + WS_HV) + (size_t)bh * HT * 128;
    const size_t r0 = (size_t)(32 * c + 8 * part);
    float g8[8], p8[8]; unsigned short q8[8];
    { float a = 0.f;
#pragma unroll
      for (int e = 0; e < 8; ++e) { g8[e] = HG[(r0 + e) * 128 + ch]; q8[e] = HQ[(r0 + e) * 128 + ch]; a += g8[e]; p8[e] = a; } }
    const u32x4 v16 = *(const u32x4*)(HV + ((size_t)(32 * c) + vrow) * 128 + vcol);
    ((LAS float*)(lds + HL_PS))[part * 128 + ch] = p8[7];
    __syncthreads();
    {
        const LAS float* ps = (const LAS float*)(lds + HL_PS);
        const float t0 = ps[ch], t1 = ps[128 + ch], t2 = ps[256 + ch], t3 = ps[384 + ch];
        const float off = (part > 0 ? t0 : 0.f) + (part > 1 ? t1 : 0.f) + (part > 2 ? t2 : 0.f);
        const float mid = t0 + t1, last = mid + t2 + t3;
        const float em = __expf(mid), el = __expf(last - mid);
        if (part == 0) ((LAS float*)(lds + HL_D))[ch] = __expf(last);
#pragma unroll
        for (int e = 0; e < 8; ++e) {
            const int tk = 8 * part + e;
            const float cum = off + p8[e];
            const float e1 = __expf(cum - mid), e2 = 1.f / e1;
            const float q = bf2f(q8[e]), k = 1.f - __expf(g8[e]);
            const float qb = q * e1, qa = qb * em, kb = k * e2, kt = kb * el;
            *(LAS bf16_t*)(lds + HL_QA + tk * HG_STR + ch * 2) = (bf16_t)f2bf(qa);
            *(LAS bf16_t*)(lds + HL_QB + tk * HG_STR + ch * 2) = (bf16_t)f2bf(qb);
            *(LAS bf16_t*)(lds + HL_KB + tk * HG_STR + ch * 2) = (bf16_t)f2bf(kb);
            *(LAS bf16_t*)(lds + HL_KT + tk * HG_STR + ch * 2) = (bf16_t)f2bf(kt);
        }
        *(LAS u32x4*)(lds + HL_VV + vrow * HG_STR + vcol * 2) = v16;
    }
    __syncthreads();
    unsigned char* qaf = ws + WS_HQA + ((size_t)bh * 129 + c) * 8192;
    unsigned char* hgb = ws + WS_HG + (size_t)bh * HT * 512 + (size_t)c * 16384;
    {
        const int ks = wid >> 1, nt = wid & 1;
        const LAS char* qp = lds + HL_QA + (16 * nt + c16) * HG_STR + (32 * ks + 4 * g4) * 2;
        const u32x2 lo = *(const LAS u32x2*)qp, hi2 = *(const LAS u32x2*)(qp + 32);
        *(u32x4*)(qaf + wid * 1024 + lane * 16) = (u32x4){lo.x, lo.y, hi2.x, hi2.y};
        const LAS char* kp = lds + HL_KT + (8 * g4 + (c16 >> 2)) * HG_STR + (16 * wid + 4 * (c16 & 3)) * 2;
        const s16x4 klo = vtr(kp), khi = vtr(kp + 4 * HG_STR);
        *(bf16x8*)(hgb + HB_KTF + wid * 1024 + lane * 16) = (bf16x8){klo[0], klo[1], klo[2], klo[3], khi[0], khi[1], khi[2], khi[3]};
    }
    if (wid == 0) {
        f32x4 at00 = (f32x4){0.f, 0.f, 0.f, 0.f}, at01 = at00, at11 = at00;
#pragma unroll
        for (int ks = 0; ks < 4; ++ks) {
            const bf16x8 ka0 = *(const LAS bf16x8*)(lds + HL_KB + c16 * HG_STR + (32 * ks + 8 * g4) * 2);
            const bf16x8 ka1 = *(const LAS bf16x8*)(lds + HL_KB + (16 + c16) * HG_STR + (32 * ks + 8 * g4) * 2);
            const bf16x8 qn0 = *(const LAS bf16x8*)(lds + HL_QB + c16 * HG_STR + (32 * ks + 8 * g4) * 2);
            const bf16x8 qn1 = *(const LAS bf16x8*)(lds + HL_QB + (16 + c16) * HG_STR + (32 * ks + 8 * g4) * 2);
            at00 = MFMA16(ka0, qn0, at00); at01 = MFMA16(ka0, qn1, at01); at11 = MFMA16(ka1, qn1, at11);
        }
#pragma unroll
        for (int r = 0; r < 4; ++r) { if (4 * g4 + r > c16) { at00[r] = 0.f; at11[r] = 0.f; } }
        u32x4 b0; b0.x = cvtpk(at00[0], at00[1]); b0.y = cvtpk(at00[2], at00[3]); b0.z = 0u; b0.w = 0u;
        u32x4 b1; b1.x = cvtpk(at01[0], at01[1]); b1.y = cvtpk(at01[2], at01[3]); b1.z = cvtpk(at11[0], at11[1]); b1.w = cvtpk(at11[2], at11[3]);
        *(u32x4*)(hgb + HB_ATF + lane * 16) = b0; *(u32x4*)(hgb + HB_ATF + 1024 + lane * 16) = b1;
    } else if (wid == 1 && lane < 32) {
        *(f32x4*)(hgb + HB_DF + lane * 16) = *(const LAS f32x4*)(lds + HL_D + lane * 16);
    }
    __syncthreads();
}

constexpr int RS_QAF = 0, RS_HGB = 8192, RS_V = 19456, RS_SLOT = 27648, RS_NSLOT = 5;
constexpr int RS_OUT = RS_NSLOT * RS_SLOT, RS_OUTB = 32 * 136 * 2, RS_END = RS_OUT + 2 * RS_OUTB;
static_assert(RS_END <= LDS_ITEM, "hgrn LDS map");
DI void glds16_asm(const void* g, unsigned lds_base) {
    unsigned sv; asm volatile("s_mov_b32 %0, m0\n\ts_mov_b32 m0, %2\n\ts_nop 0\n\tglobal_load_lds_dwordx4 %1, off\n\ts_mov_b32 m0, %0" : "=&s"(sv) : "v"(g), "s"(lds_base) : "memory"); }
#define HW_BAR() asm volatile("s_waitcnt lgkmcnt(0)\n\ts_barrier" ::: "memory")
DI void glds16_sb(unsigned voff, const void* sbase, unsigned lds_base) {
    unsigned sv; asm volatile("s_mov_b32 %0, m0\n\ts_mov_b32 m0, %3\n\ts_nop 0\n\tglobal_load_lds_dwordx4 %1, %2\n\ts_mov_b32 m0, %0" : "=&s"(sv) : "v"(voff), "s"(sbase), "s"(lds_base) : "memory"); }
DI void hgrn_unit(const Params& P, int b, int h, char* lds_g) {
    LAS char* lds = (LAS char*)lds_g;
    const int tid = tid_(), lane = tid & 63, c16 = lane & 15, g4 = lane >> 4;
    const int wid = __builtin_amdgcn_readfirstlane(tid >> 6);
    const unsigned char* ws = P.ws;
    const int bh = b * 4 + h;
    const unsigned lbase = (unsigned)__builtin_amdgcn_readfirstlane((int)(unsigned)(size_t)lds);
    constexpr int AHEAD = RS_NSLOT - 1;
    if (wid < 4) {
        const unsigned char* qafg = ws + WS_HQA + (size_t)bh * 129 * 8192;
        const unsigned char* hgbg = ws + WS_HG + (size_t)bh * HT * 512;
        const unsigned char* vg = ws + WS_HV + (size_t)bh * HT * 256;
        const unsigned voff = (unsigned)lane * 16u;
        auto issue = [&](int c) {
            const unsigned sb = lbase + (unsigned)((c % RS_NSLOT) * RS_SLOT);
#pragma unroll
            for (int k = 0; k < 7; ++k) {
                const int p = wid + 4 * k;
                if (p < 19) { const unsigned char* src = (p < 8) ? qafg + (size_t)c * 8192 + p * 1024 : hgbg + (size_t)c * 16384 + (p - 8) * 1024; glds16_sb(voff, src, sb + (unsigned)p * 1024u); }
                else if (p < 27) { const int r4 = 4 * (p - 19);
                    const unsigned vo = (unsigned)(lane >> 4) * 256u + (unsigned)(((lane & 15) ^ ((((r4 & 7) + (lane >> 4)) & 7) << 1)) * 16);
                    glds16_sb(vo, vg + ((size_t)(32 * c) + r4) * 256, sb + (unsigned)p * 1024u); }
            }
        };
        f32x4 S[2][8];
#pragma unroll
        for (int t = 0; t < 2; ++t)
#pragma unroll
            for (int i = 0; i < 8; ++i) S[t][i] = (f32x4){0.f, 0.f, 0.f, 0.f};
#pragma unroll
        for (int c = 0; c < AHEAD; ++c) issue(c);
        for (int c = 0; c < 129; ++c) {
            if (c + AHEAD - 1 > 128) asm volatile("s_waitcnt vmcnt(0)" ::: "memory");
            else if (wid < 3) asm volatile("s_waitcnt vmcnt(21)" ::: "memory"); else asm volatile("s_waitcnt vmcnt(18)" ::: "memory");
            HW_BAR();
            __builtin_amdgcn_sched_barrier(0);
            if (c + AHEAD < 129) issue(c + AHEAD);
            __builtin_amdgcn_sched_barrier(0);
            const LAS char* sl = lds + (c % RS_NSLOT) * RS_SLOT;
            f32x4 oacc[2][2];
#pragma unroll
            for (int t = 0; t < 2; ++t) { oacc[t][0] = (f32x4){0.f, 0.f, 0.f, 0.f}; oacc[t][1] = oacc[t][0]; }
#pragma unroll
            for (int ks = 0; ks < 4; ++ks) {
                const bf16x8 q0 = *(const LAS bf16x8*)(sl + RS_QAF + (2 * ks) * 1024 + lane * 16), q1 = *(const LAS bf16x8*)(sl + RS_QAF + (2 * ks + 1) * 1024 + lane * 16);
#pragma unroll
                for (int t = 0; t < 2; ++t) {
                    u32x4 sp; sp.x = cvtpk(S[t][2 * ks][0], S[t][2 * ks][1]); sp.y = cvtpk(S[t][2 * ks][2], S[t][2 * ks][3]); sp.z = cvtpk(S[t][2 * ks + 1][0], S[t][2 * ks + 1][1]); sp.w = cvtpk(S[t][2 * ks + 1][2], S[t][2 * ks + 1][3]);
                    const bf16x8 sf = __builtin_bit_cast(bf16x8, sp);
                    oacc[t][0] = MFMA16(sf, q0, oacc[t][0]); oacc[t][1] = MFMA16(sf, q1, oacc[t][1]);
                }
            }
            const int vq = c16 >> 2, vp4 = c16 & 3;
#define VTR(row, w_) vtr(sl + RS_V + (row) * 256 + (((2 * (w_) + (vp4 >> 1)) ^ ((((row) & 7)) << 1)) * 16) + 8 * (vp4 & 1))
            {
                const bf16x8 a0 = *(const LAS bf16x8*)(sl + RS_HGB + HB_ATF + lane * 16), a1 = *(const LAS bf16x8*)(sl + RS_HGB + HB_ATF + 1024 + lane * 16);
#pragma unroll
                for (int t = 0; t < 2; ++t) {
                    const s16x4 lo = VTR(4 * g4 + vq, 2 * wid + t), hi2 = VTR(16 + 4 * g4 + vq, 2 * wid + t);
                    const bf16x8 va = (bf16x8){lo[0], lo[1], lo[2], lo[3], hi2[0], hi2[1], hi2[2], hi2[3]};
                    oacc[t][0] = MFMA16(va, a0, oacc[t][0]); oacc[t][1] = MFMA16(va, a1, oacc[t][1]);
                }
            }
            {
                LAS char* ob = lds + RS_OUT + (c & 1) * RS_OUTB;
#pragma unroll
                for (int t = 0; t < 2; ++t)
#pragma unroll
                    for (int nt = 0; nt < 2; ++nt) { u32x2 w; w.x = cvtpk(oacc[t][nt][0], oacc[t][nt][1]); w.y = cvtpk(oacc[t][nt][2], oacc[t][nt][3]);
                        *(LAS u32x2*)(ob + ((16 * nt + c16) * 136 + 16 * (2 * wid + t) + 4 * g4) * 2) = w; }
            }
            {
                bf16x8 vb[2];
#pragma unroll
                for (int t = 0; t < 2; ++t) { const s16x4 lo = VTR(8 * g4 + vq, 2 * wid + t), hi2 = VTR(8 * g4 + 4 + vq, 2 * wid + t); vb[t] = (bf16x8){lo[0], lo[1], lo[2], lo[3], hi2[0], hi2[1], hi2[2], hi2[3]}; }
#pragma unroll
                for (int i = 0; i < 8; ++i) {
                    const f32x4 d4 = *(const LAS f32x4*)(sl + RS_HGB + HB_DF + (16 * i + 4 * g4) * 4);
                    const bf16x8 ka = *(const LAS bf16x8*)(sl + RS_HGB + HB_KTF + i * 1024 + lane * 16);
                    S[0][i] = MFMA16(ka, vb[0], S[0][i] * d4); S[1][i] = MFMA16(ka, vb[1], S[1][i] * d4);
                }
            }
#undef VTR
        }
        HW_BAR();
        HW_BAR();
    } else {
        const int tq = tid - 256, tok = tq >> 3, part = tq & 7;
        const bf16_t* sgg = (const bf16_t*)(ws + WS_SG) + ((size_t)b * SEQ + tok) * 512 + h * 128 + 16 * part;
        f32x4 nw[4];
#pragma unroll
        for (int q = 0; q < 4; ++q) nw[q] = *(const f32x4*)(P.rec_norm_w + h * 128 + 16 * part + 4 * q);
        auto epilogue = [&](int c, u32x4 s0, u32x4 s1) {
            const LAS char* ob = lds + RS_OUT + (c & 1) * RS_OUTB + (tok * 136 + 16 * part) * 2;
            const u32x4 o0 = *(const LAS u32x4*)ob, o1 = *(const LAS u32x4*)(ob + 16);
            const unsigned ou[8] = {o0.x, o0.y, o0.z, o0.w, o1.x, o1.y, o1.z, o1.w}, su[8] = {s0.x, s0.y, s0.z, s0.w, s1.x, s1.y, s1.z, s1.w};
            float v[16], ss = 0.f;
#pragma unroll
            for (int q = 0; q < 8; ++q) { v[2 * q] = bf2f(ou[q] & 0xffffu); v[2 * q + 1] = bf2f(ou[q] >> 16); ss += v[2 * q] * v[2 * q] + v[2 * q + 1] * v[2 * q + 1]; }
            ss += __shfl_xor(ss, 1); ss += __shfl_xor(ss, 2); ss += __shfl_xor(ss, 4);
            const float rs = 1.f / sqrtf(ss * (1.f / 128.f) + EPS);
            u32x4 w0, w1; unsigned wo[8];
#pragma unroll
            for (int q = 0; q < 8; ++q) wo[q] = cvtpk(v[2 * q] * rs * nw[q >> 1][(2 * q) & 3] * bf2f(su[q] & 0xffffu), v[2 * q + 1] * rs * nw[q >> 1][(2 * q + 1) & 3] * bf2f(su[q] >> 16));
            w0 = (u32x4){wo[0], wo[1], wo[2], wo[3]}; w1 = (u32x4){wo[4], wo[5], wo[6], wo[7]};
            bf16_t* mp = (bf16_t*)(ws + WS_MIX) + ((size_t)b * SEQ + 32 * (c - 1) + tok) * DM + 512 + h * 128 + 16 * part;
            *(u32x4*)mp = w0; *(u32x4*)(mp + 8) = w1;
        };
#define SG_LD(k, A, B) do { const bf16_t* p_ = sgg + (size_t)(32 * ((k) - 1)) * 512; A = *(const u32x4*)p_; B = *(const u32x4*)(p_ + 8); } while (0)
        u32x4 ga0, ga1, gb0, gb1, gc0, gc1, gd0, gd1;
        SG_LD(1, gb0, gb1); SG_LD(2, gc0, gc1); SG_LD(3, gd0, gd1);
        HW_BAR();
        HW_BAR();
        for (int k = 1; k <= 128; k += 4) {
            HW_BAR(); if (k + 3 <= 128) SG_LD(k + 3, ga0, ga1); epilogue(k, gb0, gb1);
            HW_BAR(); if (k + 4 <= 128) SG_LD(k + 4, gb0, gb1); epilogue(k + 1, gc0, gc1);
            HW_BAR(); if (k + 5 <= 128) SG_LD(k + 5, gc0, gc1); epilogue(k + 2, gd0, gd1);
            HW_BAR(); if (k + 6 <= 128) SG_LD(k + 6, gd0, gd1); epilogue(k + 3, ga0, ga1);
        }
#undef SG_LD
        HW_BAR();
    }
}
template <int CTRL> DI float dpp_f(float v) { return __builtin_bit_cast(float, __builtin_amdgcn_update_dpp(0, __builtin_bit_cast(int, v), CTRL, 0xf, 0xf, false)); }
DI float row16_max(float v) { v = fmaxf(v, dpp_f<0x128>(v)); v = fmaxf(v, dpp_f<0x124>(v)); v = fmaxf(v, dpp_f<0x122>(v)); v = fmaxf(v, dpp_f<0x121>(v)); return v; }
DI float row16_sum(float v) { v += dpp_f<0x128>(v); v += dpp_f<0x124>(v); v += dpp_f<0x122>(v); v += dpp_f<0x121>(v); return v; }
#define CE_D(a, b) do { const float hi_ = fmaxf(a, b), lo_ = fminf(a, b); a = hi_; b = lo_; } while (0)
DI void bitonic_sort16(float (&v)[16]) {
#pragma unroll
    for (int k = 2; k <= 16; k *= 2)
#pragma unroll
        for (int j = k / 2; j > 0; j /= 2)
#pragma unroll
            for (int i = 0; i < 16; ++i) { const int l = i ^ j; if (l > i) { if ((i & k) == 0) CE_D(v[i], v[l]); else CE_D(v[l], v[i]); } }
}
DI void merge_top16(float (&a)[16], const float (&b)[16]) {
#pragma unroll
    for (int i = 0; i < 16; ++i) a[i] = fmaxf(a[i], b[15 - i]);
#pragma unroll
    for (int j = 8; j > 0; j /= 2)
#pragma unroll
        for (int i = 0; i < 16; ++i) { const int l = i ^ j; if (l > i) CE_D(a[i], a[l]); }
}
DI float embed7(float v, unsigned code) { return __uint_as_float((__float_as_uint(v) & 0xFFFFFF80u) | code); }
DI float embed8(float v, unsigned code) { return __uint_as_float((__float_as_uint(v) & 0xFFFFFF00u) | code); }

DI void topk_list(const bf16_t* qp, const LAS char* skf, int lane, int hi, float (&top)[16]) {
    f32x16 acc[4];
#pragma unroll
    for (int kb = 0; kb < 4; ++kb) acc[kb] = f32x16{};
#pragma unroll
    for (int ks = 0; ks < 8; ++ks) {
        const bf16x8 qf = *(const bf16x8*)(qp + 16 * ks);
#pragma unroll
        for (int kb = 0; kb < 4; ++kb) { const bf16x8 kf = *(const LAS bf16x8*)(skf + (kb * 8 + ks) * 1024 + lane * 16); acc[kb] = MFMA32(kf, qf, acc[kb]); }
    }
    float blk[16];
#pragma unroll
    for (int kb = 0; kb < 4; ++kb) {
#pragma unroll
        for (int r = 0; r < 16; ++r) { const unsigned code = (unsigned)(32 * kb + (r & 3) + 8 * (r >> 2)) | (unsigned)(4 * hi); if (kb == 0) top[r] = embed7(acc[kb][r], code); else blk[r] = embed7(acc[kb][r], code); }
        if (kb == 0) bitonic_sort16(top); else { bitonic_sort16(blk); merge_top16(top, blk); }
    }
    float l0[16], l1[16];
#pragma unroll
    for (int r = 0; r < 16; ++r) { auto rr = __builtin_amdgcn_permlane32_swap(__float_as_uint(top[r]), __float_as_uint(top[r]), false, false); l0[r] = __uint_as_float(rr[0]); l1[r] = __uint_as_float(rr[1]); }
    merge_top16(l0, l1);
#pragma unroll
    for (int r = 0; r < 16; ++r) top[r] = l0[r];
}

DI void topk_wave_item(const Params& P, int tb, int hh, LAS char* wlds, const LAS char* skf) {
    const int lane = tid_() & 63, r32 = lane & 31, hi = lane >> 5;
    const unsigned char* ws = P.ws;
    const bf16_t* qp = (const bf16_t*)(ws + WS_PQ) + (size_t)(32 * tb + r32) * 2048 + hh * 256 + 8 * hi;
    float A[16], B[16];
    topk_list(qp, skf, lane, hi, A);
    topk_list(qp + 128, skf + 32768, lane, hi, B);
    LAS unsigned* my = (LAS unsigned*)(wlds + lane * 32);
#pragma unroll
    for (int w = 0; w < 4; ++w) {
        my[w] = (__float_as_uint(A[4 * w]) & 127u) | ((__float_as_uint(A[4 * w + 1]) & 127u) << 8) | ((__float_as_uint(A[4 * w + 2]) & 127u) << 16) | ((__float_as_uint(A[4 * w + 3]) & 127u) << 24);
        my[4 + w] = (__float_as_uint(B[4 * w]) & 127u) | ((__float_as_uint(B[4 * w + 1]) & 127u) << 8) | ((__float_as_uint(B[4 * w + 2]) & 127u) << 16) | ((__float_as_uint(B[4 * w + 3]) & 127u) << 24);
    }
#pragma unroll
    for (int r = 0; r < 16; ++r) { A[r] = __uint_as_float(__float_as_uint(A[r]) & 0xFFFFFF80u); B[r] = __uint_as_float(__float_as_uint(B[r]) & 0xFFFFFF80u); }
    float T[16], R1[16], X[16], Y[16];
#pragma unroll
    for (int j = 0; j < 16; ++j) { T[j] = embed8(A[0] + B[j], (unsigned)j); R1[j] = (j < 8) ? embed8(A[1] + B[j], (unsigned)(16 + j)) : -INFINITY; }
#define CAND(i, j) embed8(A[i] + B[j], (unsigned)(16 * (i) + (j)))
    X[0] = CAND(2, 0); X[1] = CAND(2, 1); X[2] = CAND(2, 2); X[3] = CAND(2, 3); X[4] = CAND(2, 4); X[5] = CAND(3, 0); X[6] = CAND(3, 1); X[7] = CAND(3, 2);
    X[8] = CAND(3, 3); X[9] = CAND(4, 0); X[10] = CAND(4, 1); X[11] = CAND(4, 2); X[12] = CAND(5, 0); X[13] = CAND(5, 1); X[14] = CAND(6, 0); X[15] = CAND(6, 1);
    Y[0] = CAND(7, 0); Y[1] = CAND(7, 1); Y[2] = CAND(8, 0); Y[3] = CAND(9, 0); Y[4] = CAND(10, 0); Y[5] = CAND(11, 0); Y[6] = CAND(12, 0); Y[7] = CAND(13, 0);
    Y[8] = CAND(14, 0); Y[9] = CAND(15, 0); Y[10] = -INFINITY; Y[11] = -INFINITY; Y[12] = -INFINITY; Y[13] = -INFINITY; Y[14] = -INFINITY; Y[15] = -INFINITY;
#undef CAND
    bitonic_sort16(X); bitonic_sort16(Y);
    merge_top16(T, R1); merge_top16(T, X); merge_top16(T, Y);
    asm volatile("s_waitcnt lgkmcnt(0)" ::: "memory");
    float ssum = 0.f, e[16]; int eid[16];
    const float t0 = __uint_as_float(__float_as_uint(T[0]) & 0xFFFFFF00u);
#pragma unroll
    for (int r = 0; r < 16; ++r) {
        const unsigned bits = __float_as_uint(T[r]); const unsigned code = bits & 255u;
        e[r] = __expf(__uint_as_float(bits & 0xFFFFFF00u) - t0); ssum += e[r];
        const int ka = ((const LAS unsigned char*)my)[code >> 4], kb_ = ((const LAS unsigned char*)my)[16 + (code & 15u)];
        eid[r] = ka * 128 + kb_;
    }
    const float inv = 1.f / ssum;
    const size_t o = (size_t)(32 * tb + r32) * 128 + hh * 16 + 8 * hi;
    int* ei = (int*)(ws + WS_EIDX) + o; float* eg = (float*)(ws + WS_EGATE) + o;
    typedef int i32x4 __attribute__((ext_vector_type(4)));
    i32x4 w0, w1; f32x4 g0, g1;
    const unsigned mh = 0u - (unsigned)hi;
#define SELU(a, b) ((((unsigned)(b)) & mh) | (((unsigned)(a)) & ~mh))
#pragma unroll
    for (int q = 0; q < 4; ++q) { w0[q] = (int)SELU(eid[q], eid[8 + q]); w1[q] = (int)SELU(eid[4 + q], eid[12 + q]);
        g0[q] = __uint_as_float(SELU(__float_as_uint(e[q]), __float_as_uint(e[8 + q]))) * inv; g1[q] = __uint_as_float(SELU(__float_as_uint(e[4 + q]), __float_as_uint(e[12 + q]))) * inv; }
#undef SELU
    *(i32x4*)ei = w0; *(i32x4*)(ei + 4) = w1; *(f32x4*)eg = g0; *(f32x4*)(eg + 4) = g1;
}

DI void topk_phase(const Params& P, char* lds_g, int bid, int nblk) {
    const int tid = tid_(), wave = __builtin_amdgcn_readfirstlane(tid >> 6);
    LAS char* lds = (LAS char*)lds_g;
    LAS char* wlds = lds + wave * 2048;
    LAS char* skf = lds + 16384;
    int cur_h = -1;
    for (int it = bid; it < (NTOK / 256) * 8; it += nblk) {
        const int hh = it & 7, tg = it >> 3;
        if (hh != cur_h) {
            __syncthreads();
#pragma unroll
            for (int i = 0; i < 8; ++i) {
                const int f = tid + 512 * i, l = f & 63, ks = (f >> 6) & 7, kb = (f >> 9) & 3, p = f >> 11;
                *(LAS u32x4*)(skf + f * 16) = *(const u32x4*)((const bf16_t*)(P.ws + WS_SKB) + (size_t)((hh * 2 + p) * 128 + 32 * kb + (l & 31)) * 128 + 16 * ks + 8 * (l >> 5));
            }
            __syncthreads();
            cur_h = hh;
        }
        topk_wave_item(P, tg * 8 + wave, hh, wlds, skf);
    }
}

DI float gelu_exact(float x) { return 0.5f * x * (1.f + erff(x * 0.70710678118654752f)); }
typedef __bf16 bf16x8_t __attribute__((ext_vector_type(8)));
DI float dot8(u32x4 a, u32x4 x, float acc) {
    const bf16x8_t a8 = __builtin_bit_cast(bf16x8_t, a), x8 = __builtin_bit_cast(bf16x8_t, x);
    acc = __builtin_amdgcn_fdot2_f32_bf16(__builtin_shufflevector(a8, a8, 0, 1), __builtin_shufflevector(x8, x8, 0, 1), acc, false);
    acc = __builtin_amdgcn_fdot2_f32_bf16(__builtin_shufflevector(a8, a8, 2, 3), __builtin_shufflevector(x8, x8, 2, 3), acc, false);
    acc = __builtin_amdgcn_fdot2_f32_bf16(__builtin_shufflevector(a8, a8, 4, 5), __builtin_shufflevector(x8, x8, 4, 5), acc, false);
    acc = __builtin_amdgcn_fdot2_f32_bf16(__builtin_shufflevector(a8, a8, 6, 7), __builtin_shufflevector(x8, x8, 6, 7), acc, false);
    return acc;
}
DI float readlane_f(float v, int l) { return __builtin_bit_cast(float, __builtin_amdgcn_readlane(__builtin_bit_cast(int, v), l)); }
DI float wave_sum_dpp(float v) {
    v = row16_sum(v);
    return (readlane_f(v, 0) + readlane_f(v, 16)) + (readlane_f(v, 32) + readlane_f(v, 48));
}

DI float dot16_fp8(u32x4 w, const f32x2 (&x)[8]) {
    f32x2 acc = __builtin_amdgcn_cvt_pk_f32_fp8((int)w.x, false) * x[0];
    acc = __builtin_amdgcn_cvt_pk_f32_fp8((int)w.x, true) * x[1] + acc;
    acc = __builtin_amdgcn_cvt_pk_f32_fp8((int)w.y, false) * x[2] + acc;
    acc = __builtin_amdgcn_cvt_pk_f32_fp8((int)w.y, true) * x[3] + acc;
    acc = __builtin_amdgcn_cvt_pk_f32_fp8((int)w.z, false) * x[4] + acc;
    acc = __builtin_amdgcn_cvt_pk_f32_fp8((int)w.z, true) * x[5] + acc;
    acc = __builtin_amdgcn_cvt_pk_f32_fp8((int)w.w, false) * x[6] + acc;
    acc = __builtin_amdgcn_cvt_pk_f32_fp8((int)w.w, true) * x[7] + acc;
    return acc.x + acc.y;
}
DI void peer_hid_phase(const Params& P, int bid, int nblk) {
    const int tid = tid_(), lane = tid & 63, wave = __builtin_amdgcn_readfirstlane(tid >> 6);
    const unsigned char* ws = P.ws;
    const unsigned char* U8 = ws + WS_UB; const float* USC = (const float*)(ws + WS_USC);
    const int gw = bid * NWAVES + wave, NGW = nblk * NWAVES;
    f32x4 wv[4];
#pragma unroll
    for (int q = 0; q < 4; ++q) wv[q] = *(const f32x4*)(P.ffn_norm_w + 16 * lane + 4 * q);
    for (int n = gw; n < NTOK; n += NGW) {
        const float* hrow = P.out + (size_t)n * DM + 16 * lane;
        f32x4 h[4]; float ss = 0.f;
#pragma unroll
        for (int q = 0; q < 4; ++q) { h[q] = *(const f32x4*)(hrow + 4 * q); ss += (h[q].x * h[q].x + h[q].y * h[q].y) + (h[q].z * h[q].z + h[q].w * h[q].w); }
        ss = wave_sum_dpp(ss);
        const float r2 = 1.f / sqrtf(ss * (1.f / DM) + EPS);
        f32x2 x[8];
#pragma unroll
        for (int q = 0; q < 4; ++q) { const f32x4 t = h[q] * wv[q] * r2; x[2 * q] = (f32x2){t.x, t.y}; x[2 * q + 1] = (f32x2){t.z, t.w}; }
        const int* eidx = (const int*)(ws + WS_EIDX) + (size_t)n * 128;
        const float* egate = (const float*)(ws + WS_EGATE) + (size_t)n * 128;
        const int id0 = eidx[lane], id1 = eidx[64 + lane];
        float hid0 = 0.f, hid1 = 0.f;
#pragma unroll 1
        for (int k0 = 0; k0 < 128; k0 += 16) {
            u32x4 ra[16]; float sc[16];
#pragma unroll
            for (int e = 0; e < 16; ++e) {
                const int k = k0 + e;
                const int id = (k0 < 64) ? __builtin_amdgcn_readlane(id0, k & 63) : __builtin_amdgcn_readlane(id1, k & 63);
                ra[e] = *(const u32x4*)(U8 + (size_t)id * DM + 16 * lane); sc[e] = USC[id];
            }
#pragma unroll
            for (int e = 0; e < 16; ++e) {
                const int k = k0 + e;
                const float d = wave_sum_dpp(dot16_fp8(ra[e], x)) * sc[e];
                if (k0 < 64) { if (lane == (k & 63)) hid0 = d; } else { if (lane == (k & 63)) hid1 = d; }
            }
        }
        float* hid = (float*)(ws + WS_HID) + (size_t)n * 128;
        hid[lane] = gelu_exact(hid0) * egate[lane];
        hid[64 + lane] = gelu_exact(hid1) * egate[64 + lane];
    }
}

DI void peer_out_phase(const Params& P, int bid, int nblk) {
    const int tid = tid_(), lane = tid & 63, wave = __builtin_amdgcn_readfirstlane(tid >> 6);
    const unsigned char* ws = P.ws;
    const unsigned char* V8 = ws + WS_VB; const float* VSC = (const float*)(ws + WS_VSC);
    const int gw = bid * NWAVES + wave, NGW = nblk * NWAVES;
    f32x4 wv[4];
#pragma unroll
    for (int q = 0; q < 4; ++q) wv[q] = *(const f32x4*)(P.final_w + 16 * lane + 4 * q);
    for (int n = gw; n < NTOK; n += NGW) {
        const int* eidx = (const int*)(ws + WS_EIDX) + (size_t)n * 128;
        const float* hid = (const float*)(ws + WS_HID) + (size_t)n * 128;
        const int id0 = eidx[lane], id1 = eidx[64 + lane];
        const float c0 = hid[lane], c1 = hid[64 + lane];
        f32x2 acc[8];
#pragma unroll
        for (int i = 0; i < 8; ++i) acc[i] = (f32x2){0.f, 0.f};
#pragma unroll 1
        for (int k0 = 0; k0 < 128; k0 += 16) {
            u32x4 ra[16]; float cf[16];
#pragma unroll
            for (int e = 0; e < 16; ++e) {
                const int k = k0 + e;
                const int id = (k0 < 64) ? __builtin_amdgcn_readlane(id0, k & 63) : __builtin_amdgcn_readlane(id1, k & 63);
                cf[e] = ((k0 < 64) ? readlane_f(c0, k & 63) : readlane_f(c1, k & 63)) * VSC[id];
                ra[e] = *(const u32x4*)(V8 + (size_t)id * DM + 16 * lane);
            }
#pragma unroll
            for (int e = 0; e < 16; ++e) {
                const f32x2 c = (f32x2){cf[e], cf[e]}; const u32x4 w = ra[e];
                acc[0] = __builtin_amdgcn_cvt_pk_f32_fp8((int)w.x, false) * c + acc[0]; acc[1] = __builtin_amdgcn_cvt_pk_f32_fp8((int)w.x, true) * c + acc[1];
                acc[2] = __builtin_amdgcn_cvt_pk_f32_fp8((int)w.y, false) * c + acc[2]; acc[3] = __builtin_amdgcn_cvt_pk_f32_fp8((int)w.y, true) * c + acc[3];
                acc[4] = __builtin_amdgcn_cvt_pk_f32_fp8((int)w.z, false) * c + acc[4]; acc[5] = __builtin_amdgcn_cvt_pk_f32_fp8((int)w.z, true) * c + acc[5];
                acc[6] = __builtin_amdgcn_cvt_pk_f32_fp8((int)w.w, false) * c + acc[6]; acc[7] = __builtin_amdgcn_cvt_pk_f32_fp8((int)w.w, true) * c + acc[7];
            }
        }
        float* orow = P.out + (size_t)n * DM + 16 * lane;
        f32x4 h[4]; float ss = 0.f;
#pragma unroll
        for (int q = 0; q < 4; ++q) { h[q] = *(const f32x4*)(orow + 4 * q) + (f32x4){acc[2 * q].x, acc[2 * q].y, acc[2 * q + 1].x, acc[2 * q + 1].y}; ss += (h[q].x * h[q].x + h[q].y * h[q].y) + (h[q].z * h[q].z + h[q].w * h[q].w); }
        ss = wave_sum_dpp(ss);
        const float rs = 1.f / sqrtf(ss * (1.f / DM) + EPS);
#pragma unroll
        for (int q = 0; q < 4; ++q) *(f32x4*)(orow + 4 * q) = h[q] * wv[q] * rs;
    }
}

#ifdef DBG_CHECK
DI void dbg_max(float* slot, float v) { atomicMax((unsigned*)slot, __float_as_uint(fmaxf(v, 0.f))); }
DI void dbg_check_topk(const Params& P, char* lds_g, int bid, int nblk) {
    LAS char* lds = (LAS char*)lds_g;
    const int tid = tid_(), lane = tid & 63, wave = __builtin_amdgcn_readfirstlane(tid >> 6);
    const unsigned char* ws = P.ws; float* dbg = (float*)(ws + WS_CTL) + 64;
    LAS float* sc = (LAS float*)(lds) + wave * 1024;
    const int gw = bid * NWAVES + wave;
    const int token = (gw * 37) % NTOK, hh = gw & 7;
    for (int p = 0; p < 2; ++p) for (int kk = 0; kk < 2; ++kk) {
        const int key = lane + 64 * kk; float a = 0.f;
        const bf16_t* q = (const bf16_t*)(ws + WS_PQ) + (size_t)token * 2048 + hh * 256 + p * 128;
        const bf16_t* sk = (const bf16_t*)(ws + WS_SKB) + (size_t)((hh * 2 + p) * 128 + key) * 128;
        for (int c = 0; c < 128; ++c) a += bf2f(q[c]) * bf2f(sk[c]);
        sc[p * 128 + key] = a;
    }
    asm volatile("s_waitcnt lgkmcnt(0)" ::: "memory");
    for (int p = 0; p < 2; ++p) for (int kk = 0; kk < 2; ++kk) {
        const int key = lane + 64 * kk; const float v = sc[p * 128 + key]; int rank = 0;
        for (int o = 0; o < 128; ++o) { const float w = sc[p * 128 + o]; rank += (w > v || (w == v && o < key)) ? 1 : 0; }
        if (rank < 16) { sc[256 + p * 16 + rank] = v; sc[288 + p * 16 + rank] = __int_as_float(key); }
    }
    asm volatile("s_waitcnt lgkmcnt(0)" ::: "memory");
    for (int e = 0; e < 4; ++e) {
        const int c = lane * 4 + e, i = c >> 4, j = c & 15; const float v = sc[256 + i] + sc[272 + j]; int rank = 0;
        for (int o = 0; o < 256; ++o) { const float w = sc[256 + (o >> 4)] + sc[272 + (o & 15)]; rank += (w > v || (w == v && o < c)) ? 1 : 0; }
        if (rank < 16) { sc[320 + rank] = __int_as_float(__float_as_int(sc[288 + i]) * 128 + __float_as_int(sc[304 + j])); sc[336 + rank] = v; }
    }
    asm volatile("s_waitcnt lgkmcnt(0)" ::: "memory");
    if (lane < 16) {
        const int eid = __float_as_int(sc[320 + lane]); const float sv = sc[336 + lane];
        float mx = sc[336], sum = 0.f; for (int o = 0; o < 16; ++o) sum += __expf(sc[336 + o] - mx);
        const float gate = __expf(sv - mx) / sum;
        const int* eidx = (const int*)(ws + WS_EIDX) + (size_t)token * 128 + hh * 16; const float* eg = (const float*)(ws + WS_EGATE) + (size_t)token * 128 + hh * 16;
        int found = -1; for (int o = 0; o < 16; ++o) if (eidx[o] == eid) found = o;
        if (found < 0) atomicAdd(dbg + 0, 1.f); else dbg_max(dbg + 1, fabsf(eg[found] - gate));
    }
    if (lane == 0) atomicAdd(dbg + 2, 16.f);
}
DI void dbg_check_hid(const Params& P, int bid, int nblk) {
    const int tid = tid_(), lane = tid & 63, wave = __builtin_amdgcn_readfirstlane(tid >> 6);
    const unsigned char* ws = P.ws; float* dbg = (float*)(ws + WS_CTL) + 64;
    const int gw = bid * NWAVES + wave; const int token = (gw * 53) % NTOK;
    const float* hrow = P.out + (size_t)token * DM;
    float ss = 0.f; for (int c = lane; c < DM; c += 64) ss += hrow[c] * hrow[c];
    ss = wave_sum(ss); const float r2 = 1.f / sqrtf(ss / DM + EPS);
    for (int kk = 0; kk < 2; ++kk) {
        const int k = lane + 64 * kk; const int eid = ((const int*)(ws + WS_EIDX))[(size_t)token * 128 + k];
        const float* urow = P.pu + (size_t)eid * DM; float d = 0.f;
        for (int c = 0; c < DM; ++c) d += urow[c] * (hrow[c] * r2 * P.ffn_norm_w[c]);
        const float hidv = gelu_exact(d) * ((const float*)(ws + WS_EGATE))[(size_t)token * 128 + k];
        const float got = ((const float*)(ws + WS_HID))[(size_t)token * 128 + k];
        dbg_max(dbg + 3, fabsf(got - hidv)); dbg_max(dbg + 4, fabsf(hidv));
    }
}
DI float dbg_enc(float m) { return 8.f + log10f(fmaxf(m, 1e-8f)); }
#endif

#ifdef DBG_CHECK
DI void dbg_check_attn(const Params& P, int bid, int nblk) {
    const int tid = tid_(), lane = tid & 63, wave = __builtin_amdgcn_readfirstlane(tid >> 6);
    const unsigned char* ws = P.ws; float* dbg = (float*)(ws + WS_CTL) + 64;
    const int gw = bid * NWAVES + wave;
    const unsigned hsh = (unsigned)gw * 2654435761u;
    const int b = (hsh >> 8) & 7, h = (hsh >> 11) & 3, i = (int)((hsh >> 13) % 4096u), bh = b * 4 + h;
    const float lam = ((const float*)(ws + WS_LB))[512];
    float oc[2][2], lsum[2], mx[2];
    for (int c = 0; c < 2; ++c) { oc[c][0] = oc[c][1] = 0.f; lsum[c] = 0.f; mx[c] = -1e30f; }
    for (int pp = KPAD; pp <= 64 + i; ++pp) {
        const int tile = pp >> 6, key = pp & 63;
        for (int c = 0; c < 2; ++c) {
            const bf16_t* q = (const bf16_t*)(ws + WS_Q) + ((size_t)((bh * 2 + c) * SEQ + i)) * 64;
            const unsigned char* kimg = ws + WS_K + ((size_t)(bh * 2 + c) * KT + tile) * 8192;
            float sdot = 0.f;
            for (int d = 0; d < 64; ++d) sdot += bf2f(q[d]) * bf2f(*(const bf16_t*)(kimg + (d >> 3) * 1024 + key * 16 + (d & 7) * 2));
            const float mn = fmaxf(mx[c], sdot), al = exp2f(mx[c] - mn), pe = exp2f(sdot - mn);
            const unsigned char* vimg = ws + WS_V + ((size_t)bh * KT + tile) * 16384;
            for (int e = 0; e < 2; ++e) { const int dv = lane + 64 * e; oc[c][e] = oc[c][e] * al + pe * bf2f(*(const bf16_t*)(vimg + (dv >> 5) * 4096 + key * 64 + (dv & 31) * 2)); }
            lsum[c] = lsum[c] * al + pe; mx[c] = mn;
        }
    }
    float o[2], ss = 0.f;
    for (int e = 0; e < 2; ++e) { o[e] = oc[0][e] / lsum[0] - lam * oc[1][e] / lsum[1]; ss += o[e] * o[e]; }
    ss = wave_sum(ss); const float rs = (1.f - LAM_INIT) / sqrtf(ss / 128.f + EPS);
    for (int e = 0; e < 2; ++e) { const int dv = lane + 64 * e; const float want = o[e] * rs * P.subln_w[dv];
        const float got = bf2f(((const bf16_t*)(ws + WS_MIX))[(size_t)(b * SEQ + i) * DM + h * 128 + dv]);
        dbg_max(dbg + 5, fabsf(got - want)); dbg_max(dbg + 6, fabsf(want)); }
}
DI void dbg_check_hgrn(const Params& P, char* lds_g, int bid, int nblk) {
    if (bid >= 32) return;
    LAS float* L = (LAS float*)lds_g;
    const int tid = tid_(), dv = tid & 127, qt = tid >> 7;
    const unsigned char* ws = P.ws; float* dbg = (float*)(ws + WS_CTL) + 64;
    const int bh = bid, b = bid >> 2, h = bid & 3;
    const float* HG = (const float*)(ws + WS_HG) + (size_t)bh * HT * 128;
    const bf16_t* HQ = (const bf16_t*)(ws + WS_HQ) + (size_t)bh * HT * 128;
    const bf16_t* HV = (const bf16_t*)(ws + WS_HV) + (size_t)bh * HT * 128;
    float S[32];
#pragma unroll
    for (int j = 0; j < 32; ++j) S[j] = 0.f;
    for (int pp = 16; pp < HT; ++pp) {
        if (tid < 128) { L[tid] = __expf(HG[(size_t)pp * 128 + tid]); L[128 + tid] = bf2f(HQ[(size_t)pp * 128 + tid]); L[256 + tid] = bf2f(HV[(size_t)pp * 128 + tid]); }
        __syncthreads();
        const float v = L[256 + dv]; float part = 0.f;
#pragma unroll
        for (int j = 0; j < 32; ++j) { const float f = L[32 * qt + j]; S[j] = f * S[j] + (1.f - f) * v; part += L[128 + 32 * qt + j] * S[j]; }
        L[384 + qt * 128 + dv] = part;
        __syncthreads();
        if (tid < 128) { const float o = L[384 + dv] + L[512 + dv] + L[640 + dv] + L[768 + dv]; L[896 + dv] = o; }
        __syncthreads();
        if (tid < 128 && pp >= 32) {
            float ss = 0.f; for (int j = 0; j < 128; ++j) ss += L[896 + j] * L[896 + j];
            const float rs = 1.f / sqrtf(ss / 128.f + EPS);
            const size_t row = (size_t)b * SEQ + (pp - 32);
            const float want = L[896 + dv] * rs * P.rec_norm_w[h * 128 + dv] * bf2f(((const bf16_t*)(ws + WS_SG))[row * 512 + h * 128 + dv]);
            const float got = bf2f(((const bf16_t*)(ws + WS_MIX))[row * DM + 512 + h * 128 + dv]);
            dbg_max(dbg + 7, fabsf(got - want)); dbg_max(dbg + 8, fabsf(want));
        }
        __syncthreads();
    }
}
#endif

#ifdef DBG_CHECK
DI float dbg_proj(const Params& P, int m, int c) {
    const float* xrow = (m < NTOK) ? P.x + (size_t)m * DM : P.meta + (size_t)(m - NTOK) * DM;
    float ss = 0.f, a = 0.f;
    for (int k = 0; k < DM; ++k) { const float xv = xrow[k]; ss += xv * xv; a += xv * P.mix_norm_w[k] * P.w_in[(size_t)k * NCOL1 + c]; }
    return a / sqrtf(ss / DM + EPS);
}
DI void dbg_check_gemm1(const Params& P, int bid, int nblk) {
    const unsigned char* ws = P.ws; float* dbg = (float*)(ws + WS_CTL) + 64;
    const int gt = bid * NTHREADS + tid_();
    if (gt >= 7 * 4096) return;
    const unsigned hsh = (unsigned)gt * 2654435761u;
    const int seg = gt % 7, cs = (hsh >> 7) & 511;
    const bool meta = ((gt / 7) & 15) == 0;
    const int m = meta ? NTOK + ((hsh >> 20) & 15) : (int)((hsh >> 3) % (unsigned)NTOK);
    const int b = meta ? (int)((hsh >> 25) & 7) : (m >> 12), t = meta ? (m - NTOK) : ((m & 4095) + NMETA);
    const int h = cs >> 7;
    float want = 0.f, got = 0.f;
    if (seg <= 1) {
        if (seg == 0 && meta) return;
        const int comp = (cs >> 6) & 1, d = cs & 63, dlo = d & 31;
        const float zlo = dbg_proj(P, m, seg * 512 + (cs & ~63) + dlo), zhi = dbg_proj(P, m, seg * 512 + (cs & ~63) + dlo + 32);
        const double inv = exp2(-(double)dlo * (13.287712379549449 / 32.0)); const float cv = (float)cos((double)t * inv), sv = (float)sin((double)t * inv);
        want = (d < 32) ? zlo * cv - zhi * sv : zhi * cv + zlo * sv;
        if (seg == 0) { want *= QSCALE; got = bf2f(((const bf16_t*)(ws + WS_Q))[((size_t)(((b * 4 + h) * 2 + comp) * SEQ + (m & 4095))) * 64 + d]); }
        else { const int pp = t + KPAD; got = bf2f(*(const bf16_t*)(ws + WS_K + ((size_t)((b * 4 + h) * 2 + comp) * KT + (pp >> 6)) * 8192 + (d >> 3) * 1024 + (pp & 63) * 16 + (d & 7) * 2)); }
    } else {
        const float z = dbg_proj(P, m, seg * 512 + cs); const int dv = cs & 127;
        if (seg == 2) { const int pp = t + KPAD; want = z; got = bf2f(*(const bf16_t*)(ws + WS_V + ((size_t)(b * 4 + h) * KT + (pp >> 6)) * 16384 + (dv >> 5) * 4096 + (pp & 63) * 64 + (dv & 31) * 2)); }
        else if (seg == 3) { want = siluf_(z); got = bf2f(((const bf16_t*)(ws + WS_HQ))[((size_t)(b * 4 + h) * HT + t + 16) * 128 + dv]); }
        else if (seg == 4) { const float l0 = P.lb_logits[cs], l1 = P.lb_logits[512 + cs], lb = __expf(l0) / (__expf(l0) + __expf(l1)); want = __logf(lb + (1.f - lb) * sigmoidf_(z)); got = ((const float*)(ws + WS_HG))[((size_t)(b * 4 + h) * HT + t + 16) * 128 + dv]; }
        else if (seg == 5) { want = z; got = bf2f(((const bf16_t*)(ws + WS_HV))[((size_t)(b * 4 + h) * HT + t + 16) * 128 + dv]); }
        else { if (meta) return; want = siluf_(z); got = bf2f(((const bf16_t*)(ws + WS_SG))[(size_t)m * 512 + cs]); }
    }
    dbg_max(dbg + 16 + seg + (meta ? 8 : 0), fabsf(got - want));
}
#endif
typedef unsigned u32x4v __attribute__((vector_size(16)));
DI float oct_sum(float v) {
    v += dpp_f<0xB1>(v); v += dpp_f<0x4E>(v); v += dpp_f<0x141>(v); return v;
}
DI unsigned my_xcc_id() { return (unsigned)__builtin_amdgcn_s_getreg((3 << 11) | 20) & 7u; }
constexpr int CTL_G1 = 16, CTL_G2 = 32;

DI void xn8_rows(const Params& P, int bid, int nblk) {
    const int tid = tid_(), lane = tid & 63, wave = __builtin_amdgcn_readfirstlane(tid >> 6);
    unsigned char* ws = P.ws;
    const int gw = bid * NWAVES + wave, NGW = nblk * NWAVES;
    f32x4 wv[4];
#pragma unroll
    for (int q = 0; q < 4; ++q) wv[q] = *(const f32x4*)(P.ffn_norm_w + 16 * lane + 4 * q);
    for (int n = gw; n < NTOK; n += NGW) {
        const bf16_t* hrow = (const bf16_t*)(ws + WS_XB) + (size_t)n * DM + 16 * lane;
        const float r2 = 1.f / sqrtf(((const float*)(ws + WS_SSQ))[n] * (1.f / DM) + EPS);
        const u32x4 ha = *(const u32x4*)hrow, hb = *(const u32x4*)(hrow + 8);
        const unsigned hu[8] = {ha.x, ha.y, ha.z, ha.w, hb.x, hb.y, hb.z, hb.w};
        f32x4 t[4]; float am = 0.f;
#pragma unroll
        for (int q = 0; q < 4; ++q) { t[q] = (f32x4){bf2f(hu[2 * q] & 0xffffu), bf2f(hu[2 * q] >> 16), bf2f(hu[2 * q + 1] & 0xffffu), bf2f(hu[2 * q + 1] >> 16)} * wv[q] * r2; am = fmaxf(am, fmaxf(fmaxf(fabsf(t[q].x), fabsf(t[q].y)), fmaxf(fabsf(t[q].z), fabsf(t[q].w)))); }
        am = row16_max(am); am = fmaxf(fmaxf(readlane_f(am, 0), readlane_f(am, 16)), fmaxf(readlane_f(am, 32), readlane_f(am, 48)));
        const float sc = (am > 0.f) ? exp2f(floorf(log2f(224.f / am))) : 1.f;
        int w[4];
#pragma unroll
        for (int q = 0; q < 4; ++q) { w[q] = __builtin_amdgcn_cvt_pk_fp8_f32(t[q].x * sc, t[q].y * sc, 0, false); w[q] = __builtin_amdgcn_cvt_pk_fp8_f32(t[q].z * sc, t[q].w * sc, w[q], true); }
        *(u32x4*)(ws + WS_XN8 + (size_t)n * DM + 16 * lane) = (u32x4){(unsigned)w[0], (unsigned)w[1], (unsigned)w[2], (unsigned)w[3]};
        if (lane == 0) ((float*)(ws + WS_XSC))[n] = 1.f / sc;
    }
}
typedef int i32x4 __attribute__((ext_vector_type(4)));
struct GMeta { i32x4 id[4]; f32x4 c[4]; u32x4 xq; };
template <int WHICH>
DI void g_meta(const Params& P, int n, int x, GMeta& M) {
    const int lane = tid_() & 63, i = lane & 7, g = lane >> 3;
    const i32x4* ip = (const i32x4*)((const int*)(P.ws + WS_EIDX) + (size_t)n * 128 + 16 * g);
#pragma unroll
    for (int q = 0; q < 4; ++q) M.id[q] = ip[q];
    if (WHICH == 1) M.xq = *(const u32x4*)(P.ws + WS_XN8 + (size_t)n * DM + 128 * x + 16 * i);
    else { const f32x4* cp = (const f32x4*)((const float*)(P.ws + WS_HID) + (size_t)n * 128 + 16 * g);
#pragma unroll
        for (int q = 0; q < 4; ++q) M.c[q] = cp[q]; }
}
DI void g_issue(int x, const GMeta& M, u32x4v (&rw)[16], __amdgpu_buffer_rsrc_t rs) {
    const int i = tid_() & 7;
    const unsigned lo = (unsigned)x * (unsigned)(NEXP * 128) + (unsigned)(16 * i);
#pragma unroll
    for (int j = 0; j < 16; ++j) rw[j] = __builtin_amdgcn_raw_buffer_load_b128(rs, ((unsigned)M.id[j >> 2][j & 3] << 7) + lo, 0, 0);
}
DI void g1_finish(const Params& P, int n, int x, u32x4 xq, const u32x4v (&rw)[16]) {
    const int lane = tid_() & 63, i = lane & 7, g = lane >> 3;
    f32x2 xv[8];
    xv[0] = __builtin_amdgcn_cvt_pk_f32_fp8((int)xq.x, false); xv[1] = __builtin_amdgcn_cvt_pk_f32_fp8((int)xq.x, true);
    xv[2] = __builtin_amdgcn_cvt_pk_f32_fp8((int)xq.y, false); xv[3] = __builtin_amdgcn_cvt_pk_f32_fp8((int)xq.y, true);
    xv[4] = __builtin_amdgcn_cvt_pk_f32_fp8((int)xq.z, false); xv[5] = __builtin_amdgcn_cvt_pk_f32_fp8((int)xq.z, true);
    xv[6] = __builtin_amdgcn_cvt_pk_f32_fp8((int)xq.w, false); xv[7] = __builtin_amdgcn_cvt_pk_f32_fp8((int)xq.w, true);
    float pd[16];
#pragma unroll
    for (int j = 0; j < 16; ++j) pd[j] = dot16_fp8(__builtin_bit_cast(u32x4, rw[j]), xv);
    const unsigned m1 = 0u - (unsigned)((i >> 2) & 1), m2 = 0u - (unsigned)(i & 1), m3 = 0u - (unsigned)((i >> 1) & 1);
#define BSEL(a, b, m) __uint_as_float((__float_as_uint(a) & ~(m)) | (__float_as_uint(b) & (m)))
    float z[8], w[4], u[2];
#pragma unroll
    for (int q = 0; q < 8; ++q) { const float snd = BSEL(pd[q + 8], pd[q], m1), kep = BSEL(pd[q], pd[q + 8], m1); z[q] = kep + dpp_f<0x141>(snd); }
#pragma unroll
    for (int q = 0; q < 4; ++q) { const float snd = BSEL(z[q + 4], z[q], m2), kep = BSEL(z[q], z[q + 4], m2); w[q] = kep + dpp_f<0xB1>(snd); }
#pragma unroll
    for (int q = 0; q < 2; ++q) { const float snd = BSEL(w[q + 2], w[q], m3), kep = BSEL(w[q], w[q + 2], m3); u[q] = kep + dpp_f<0x4E>(snd); }
    const int j0 = 8 * ((i >> 2) & 1) + 4 * (i & 1) + 2 * ((i >> 1) & 1);
#undef BSEL
    *(f32x2*)((float*)(P.ws + WS_HIDP) + ((size_t)x * NTOK + n) * 128 + 16 * g + j0) = (f32x2){u[0], u[1]};
}
DI void g2_finish(const Params& P, int n, int x, const f32x4 (&cv)[4], const u32x4v (&rw)[16]) {
    const int lane = tid_() & 63, i = lane & 7, g = lane >> 3;
    f32x2 acc[8];
#pragma unroll
    for (int q = 0; q < 8; ++q) acc[q] = (f32x2){0.f, 0.f};
#pragma unroll
    for (int j = 0; j < 16; ++j) {
        const float cj = cv[j >> 2][j & 3]; const f32x2 c = (f32x2){cj, cj}; const u32x4 w = __builtin_bit_cast(u32x4, rw[j]);
        acc[0] = __builtin_amdgcn_cvt_pk_f32_fp8((int)w.x, false) * c + acc[0]; acc[1] = __builtin_amdgcn_cvt_pk_f32_fp8((int)w.x, true) * c + acc[1];
        acc[2] = __builtin_amdgcn_cvt_pk_f32_fp8((int)w.y, false) * c + acc[2]; acc[3] = __builtin_amdgcn_cvt_pk_f32_fp8((int)w.y, true) * c + acc[3];
        acc[4] = __builtin_amdgcn_cvt_pk_f32_fp8((int)w.z, false) * c + acc[4]; acc[5] = __builtin_amdgcn_cvt_pk_f32_fp8((int)w.z, true) * c + acc[5];
        acc[6] = __builtin_amdgcn_cvt_pk_f32_fp8((int)w.w, false) * c + acc[6]; acc[7] = __builtin_amdgcn_cvt_pk_f32_fp8((int)w.w, true) * c + acc[7];
    }
    float y[16], z[8], w[4];
#pragma unroll
    for (int q = 0; q < 8; ++q) { y[2 * q] = acc[q].x; y[2 * q + 1] = acc[q].y; }
#pragma unroll
    for (int q = 0; q < 8; ++q) { auto rr = __builtin_amdgcn_permlane32_swap(__float_as_uint(y[q]), __float_as_uint(y[q + 8]), false, false); z[q] = __uint_as_float(rr[0]) + __uint_as_float(rr[1]); }
#pragma unroll
    for (int q = 0; q < 4; ++q) { auto rr = __builtin_amdgcn_permlane16_swap(__float_as_uint(z[q]), __float_as_uint(z[q + 4]), false, false); w[q] = __uint_as_float(rr[0]) + __uint_as_float(rr[1]); }
    const unsigned m3 = 0u - (unsigned)(g & 1);
#define BSEL(a, b, m) __uint_as_float((__float_as_uint(a) & ~(m)) | (__float_as_uint(b) & (m)))
    const float k0 = BSEL(w[0], w[2], m3) + dpp_f<0x128>(BSEL(w[2], w[0], m3)), k1 = BSEL(w[1], w[3], m3) + dpp_f<0x128>(BSEL(w[3], w[1], m3));
#undef BSEL
    float* hp = P.out + (size_t)n * DM + 128 * x + 16 * i + 2 * g;
    const f32x2 t = *(const f32x2*)hp + (f32x2){k0, k1}; *(f32x2*)hp = t;
    const float ss = wave_sum_dpp(t.x * t.x + t.y * t.y);
    if (lane == 0) atomicAdd((float*)(P.ws + WS_SSQ2) + n, ss);
}
constexpr int SL_CHUNK = 128, SL_T = SL_CHUNK / NWAVES;
#define SB() __builtin_amdgcn_sched_barrier(0)
template <int WHICH>
DI void g_chunk(const Params& P, int nbase, int x, __amdgpu_buffer_rsrc_t rs) {
    GMeta MA, MB; u32x4v RA[16], RB[16];
    g_meta<WHICH>(P, nbase, x, MA); SB(); g_meta<WHICH>(P, nbase + 8, x, MB); SB(); g_issue(x, MA, RA, rs); SB();
#pragma unroll
    for (int t = 0; t < SL_T; t += 2) {
        const u32x4 xA = MA.xq; const f32x4 cA[4] = {MA.c[0], MA.c[1], MA.c[2], MA.c[3]};
        if (t + 2 < SL_T) { g_meta<WHICH>(P, nbase + 8 * (t + 2), x, MA); SB(); }
        g_issue(x, MB, RB, rs); SB();
        if (WHICH == 1) g1_finish(P, nbase + 8 * t, x, xA, RA); else g2_finish(P, nbase + 8 * t, x, cA, RA);
        SB();
        const u32x4 xB = MB.xq; const f32x4 cB[4] = {MB.c[0], MB.c[1], MB.c[2], MB.c[3]};
        if (t + 3 < SL_T) { g_meta<WHICH>(P, nbase + 8 * (t + 3), x, MB); SB(); }
        if (t + 2 < SL_T) { g_issue(x, MA, RA, rs); SB(); }
        if (WHICH == 1) g1_finish(P, nbase + 8 * (t + 1), x, xB, RB); else g2_finish(P, nbase + 8 * (t + 1), x, cB, RB);
        SB();
    }
}
template <int WHICH>
DI void sliced_phase(const Params& P, char* lds_g) {
    const int tid = tid_(), wave = __builtin_amdgcn_readfirstlane(tid >> 6);
    unsigned* ctr = (unsigned*)(P.ws + WS_CTL) + (WHICH == 1 ? CTL_G1 : CTL_G2);
    const __amdgpu_buffer_rsrc_t rs = __builtin_amdgcn_make_buffer_rsrc((void*)(P.ws + (WHICH == 1 ? WS_UB : WS_VB)), 0, NEXP * DM, 0x00020000);
    const int x0 = (int)my_xcc_id();
    LAS int* slot = (LAS int*)((LAS char*)lds_g + LDS_ITEM);
    for (int s = 0; s < 8; ++s) {
        const int x = (x0 + s) & 7;
        for (;;) {
            if (tid == 0) *slot = (int)atomicAdd(ctr + x, 1u);
            __syncthreads();
            const int chunk = *slot;
            __syncthreads();
            if (chunk >= NTOK / SL_CHUNK) break;
            g_chunk<WHICH>(P, chunk * SL_CHUNK + wave, x, rs);
        }
    }
}
DI void hid_reduce_phase(const Params& P, int bid, int nblk) {
    const unsigned char* ws = P.ws;
    const size_t gt = (size_t)bid * NTHREADS + tid_(), NGT = (size_t)nblk * NTHREADS;
    const float* hp = (const float*)(ws + WS_HIDP);
    for (size_t o = gt; o < (size_t)NTOK * 128; o += NGT) {
        float a = 0.f;
#pragma unroll
        for (int x = 0; x < 8; ++x) a += hp[(size_t)x * NTOK * 128 + o];
        const int e = ((const int*)(ws + WS_EIDX))[o];
        const float d = a * ((const float*)(ws + WS_USC))[e] * ((const float*)(ws + WS_XSC))[o >> 7];
        ((float*)(ws + WS_HID))[o] = gelu_exact(d) * ((const float*)(ws + WS_EGATE))[o] * ((const float*)(ws + WS_VSC))[e];
    }
}
DI void final_norm_phase(const Params& P, int bid, int nblk) {
    const size_t gt = (size_t)bid * NTHREADS + tid_(), NGT = (size_t)nblk * NTHREADS;
    const float* ssq = (const float*)(P.ws + WS_SSQ2);
    for (size_t o = gt; o < (size_t)NTOK * DM / 4; o += NGT) {
        const size_t n = o >> 8; const int c4 = (int)(o & 255);
        const float rs = 1.f / sqrtf(ssq[n] * (1.f / DM) + EPS);
        f32x4* pp = (f32x4*)P.out + o;
        *pp = *pp * ((const f32x4*)P.final_w)[c4] * rs;
    }
}

typedef long i64_t;
constexpr int MG_HALF = 8192, MG_WAVE = 2 * MG_HALF;
#define MG_WAIT(N) asm volatile("s_waitcnt vmcnt(" #N ")" ::: "memory")
struct MgMeta { i32x4 id[4]; u32x4 a0, a1, a2, a3; };
template <int WHICH>
DI void mg_meta(const Params& P, int n, int x, MgMeta& M) {
    const int lane = tid_() & 63, g8 = lane >> 3, kg = lane >> 4;
    const int* ip = (const int*)(P.ws + WS_EIDX) + (size_t)n * 128 + 8 * g8;
    M.id[0] = *(const i32x4*)ip; M.id[1] = *(const i32x4*)(ip + 4); M.id[2] = *(const i32x4*)(ip + 64); M.id[3] = *(const i32x4*)(ip + 68);
    if (WHICH == 1) { const unsigned char* xr = P.ws + WS_XN8 + (size_t)n * DM + 256 * x + 16 * kg;
        M.a0 = *(const u32x4*)xr; M.a1 = *(const u32x4*)(xr + 64); M.a2 = *(const u32x4*)(xr + 128); M.a3 = *(const u32x4*)(xr + 192); }
    else { const unsigned char* cr = P.ws + WS_C8 + (size_t)n * 128 + 8 * kg;
        const u32x2 c0 = *(const u32x2*)cr, c1 = *(const u32x2*)(cr + 32), c2 = *(const u32x2*)(cr + 64), c3 = *(const u32x2*)(cr + 96);
        M.a0 = (u32x4){c0.x, c0.y, c1.x, c1.y}; M.a1 = (u32x4){c2.x, c2.y, c3.x, c3.y}; }
}
DI void mg_issue(const unsigned char* slice, const MgMeta& M, int h, unsigned lbase) {
    const int lane = tid_() & 63, pos = lane & 7;
    const i32x4 ia = M.id[2 * h], ib = M.id[2 * h + 1];
    const int ids[8] = {ia.x, ia.y, ia.z, ia.w, ib.x, ib.y, ib.z, ib.w};
#pragma unroll
    for (int p = 0; p < 8; ++p) glds16_asm(slice + (size_t)(unsigned)ids[p] * 128 + 16 * (pos ^ p), lbase + p * 1024);
}
DI i64_t pk64(unsigned lo, unsigned hi) { return (i64_t)(((unsigned long long)hi << 32) | lo); }
typedef int i32x8 __attribute__((ext_vector_type(8)));
DI float mg1_half(const MgMeta& M, LAS char* hb) {
    const int lane = tid_() & 63, c = lane & 15, kg = lane >> 4;
    const i32x8 A0 = (i32x8){(int)M.a0.x, (int)M.a0.y, (int)M.a0.z, (int)M.a0.w, (int)M.a1.x, (int)M.a1.y, (int)M.a1.z, (int)M.a1.w};
    const i32x8 A1 = (i32x8){(int)M.a2.x, (int)M.a2.y, (int)M.a2.z, (int)M.a2.w, (int)M.a3.x, (int)M.a3.y, (int)M.a3.z, (int)M.a3.w};
    f32x4 d[4];
#pragma unroll
    for (int G = 0; G < 4; ++G) {
        const LAS char* row = hb + (c & 7) * 1024 + (2 * G + (c >> 3)) * 128;
        const u32x4 b0 = *(const LAS u32x4*)(row + ((kg ^ (c & 7)) << 4)), b1 = *(const LAS u32x4*)(row + (((kg + 4) ^ (c & 7)) << 4));
        d[G] = (f32x4){0.f, 0.f, 0.f, 0.f};
        d[G] = __builtin_amdgcn_mfma_scale_f32_16x16x128_f8f6f4(A0, (i32x8){(int)b0.x, (int)b0.y, (int)b0.z, (int)b0.w, 0, 0, 0, 0}, d[G], 0, 4, 0, 0x7F7F7F7F, 0, 0x7F7F7F7F);
        d[G] = __builtin_amdgcn_mfma_scale_f32_16x16x128_f8f6f4(A1, (i32x8){(int)b1.x, (int)b1.y, (int)b1.z, (int)b1.w, 0, 0, 0, 0}, d[G], 0, 4, 0, 0x7F7F7F7F, 0, 0x7F7F7F7F);
    }
    asm volatile("s_nop 15\n\ts_nop 15" : "+v"(d[0]), "+v"(d[1]), "+v"(d[2]), "+v"(d[3]));
    const float r01 = (kg & 1) ? d[1][0] : d[0][0], r23 = (kg & 1) ? d[3][0] : d[2][0];
    return (kg & 2) ? r23 : r01;
}
typedef int v2i_t __attribute__((ext_vector_type(2)));
DI void mg2_half(const MgMeta& M, int h, LAS char* hb, f32x4 (&D)[8]) {
    const int lane = tid_() & 63, c = lane & 15, kg = lane >> 4;
#pragma unroll
    for (int kbl = 0; kbl < 2; ++kbl) {
        const u32x4 av = h ? M.a1 : M.a0;
        const i64_t a = kbl ? pk64(av.z, av.w) : pk64(av.x, av.y);
        const LAS char* row = hb + (c >> 1) * 1024 + (4 * kbl + kg) * 128 + 8 * (c & 1);
#pragma unroll
        for (int nt = 0; nt < 8; ++nt) {
            const v2i_t b = __builtin_amdgcn_ds_read_tr8_b64_v2i32((LAS v2i_t*)(row + ((nt ^ (c >> 1)) << 4)));
            D[nt] = __builtin_amdgcn_mfma_f32_16x16x32_fp8_fp8(a, pk64((unsigned)b.x, (unsigned)b.y), D[nt], 0, 0, 0);
        }
    }
}
template <int WHICH>
DI void mg_group(const Params& P, const unsigned char* slice, int n0, int x, LAS char* wl, unsigned wl_off, const MgMeta (&M)[4], MgMeta (&Mn)[4], bool more) {
    const int lane = tid_() & 63, kg = lane >> 4, c = lane & 15;
    bf16_t* outp = (bf16_t*)(P.ws + WS_HIDP) + (size_t)x * NTOK * 128;
    f32x4 D[8];
    mg_issue(slice, M[0], 0, wl_off); SB();
#define MG_STEP(h, WAITSTMT) do { \
        if ((h) + 1 < 8) { mg_issue(slice, M[((h) + 1) >> 1], ((h) + 1) & 1, wl_off + (((h) + 1) & 1) * MG_HALF); } \
        else if (more) { _Pragma("unroll") for (int q_ = 0; q_ < 4; ++q_) mg_meta<WHICH>(P, n0 + 8 * (4 + q_), x, Mn[q_]); } \
        SB(); WAITSTMT; SB(); \
        LAS char* hb_ = wl + ((h) & 1) * MG_HALF; const int n_ = n0 + 8 * ((h) >> 1); \
        if (WHICH == 1) { const float r_ = mg1_half(M[(h) >> 1], hb_); outp[(size_t)n_ * 128 + 64 * ((h) & 1) + lane] = (bf16_t)f2bf(r_); } \
        else { if (((h) & 1) == 0) { _Pragma("unroll") for (int q_ = 0; q_ < 8; ++q_) D[q_] = (f32x4){0.f, 0.f, 0.f, 0.f}; } \
            mg2_half(M[(h) >> 1], (h) & 1, hb_, D); \
            if ((h) & 1) { float v0_ = 0.f, v1_ = 0.f; _Pragma("unroll") for (int q_ = 0; q_ < 4; ++q_) { if (kg == q_) { v0_ = D[2 * q_][0]; v1_ = D[2 * q_ + 1][0]; } } \
                outp[(size_t)n_ * 128 + 32 * kg + c] = (bf16_t)f2bf(v0_); outp[(size_t)n_ * 128 + 32 * kg + 16 + c] = (bf16_t)f2bf(v1_); } } \
        SB(); } while (0)
    if (WHICH == 1) {
        MG_STEP(0, MG_WAIT(8)); MG_STEP(1, MG_WAIT(9)); MG_STEP(2, MG_WAIT(9)); MG_STEP(3, MG_WAIT(9)); MG_STEP(4, MG_WAIT(9)); MG_STEP(5, MG_WAIT(9)); MG_STEP(6, MG_WAIT(9));
        if (more) { MG_STEP(7, MG_WAIT(33)); } else { MG_STEP(7, MG_WAIT(1)); }
    } else {
        MG_STEP(0, MG_WAIT(8)); MG_STEP(1, MG_WAIT(8)); MG_STEP(2, MG_WAIT(10)); MG_STEP(3, MG_WAIT(8)); MG_STEP(4, MG_WAIT(10)); MG_STEP(5, MG_WAIT(8)); MG_STEP(6, MG_WAIT(10));
        if (more) { MG_STEP(7, MG_WAIT(32)); } else { MG_STEP(7, MG_WAIT(0)); }
    }
#undef MG_STEP
}
template <int WHICH>
DI void mg_phase(const Params& P, char* lds_g) {
    const int tid = tid_(), wave = __builtin_amdgcn_readfirstlane(tid >> 6);
    unsigned* ctr = (unsigned*)(P.ws + WS_CTL) + (WHICH == 1 ? CTL_G1 : CTL_G2);
    const int x0 = (int)my_xcc_id();
    LAS int* slot = (LAS int*)((LAS char*)lds_g + LDS_ITEM);
    LAS char* wl = (LAS char*)lds_g + wave * MG_WAVE;
    const unsigned wl_off = (unsigned)__builtin_amdgcn_readfirstlane((int)(unsigned)(size_t)wl);
    constexpr int NSL = (WHICH == 1) ? 4 : 8;
    for (int s = 0; s < NSL; ++s) {
        const int x = (x0 + s) & (NSL - 1);
        const unsigned char* slice = P.ws + (WHICH == 1 ? WS_UB : WS_VB) + (size_t)x * ((size_t)NEXP * 128);
        for (;;) {
            if (tid == 0) *slot = (int)atomicAdd(ctr + x, 1u);
            __syncthreads();
            const int chunk = *slot;
            __syncthreads();
            if (chunk >= NTOK / SL_CHUNK) break;
            const int nb = chunk * SL_CHUNK + wave;
            MgMeta MA[4], MB[4];
#pragma unroll
            for (int q = 0; q < 4; ++q) mg_meta<WHICH>(P, nb + 8 * q, x, MA[q]);
            mg_group<WHICH>(P, slice, nb, x, wl, wl_off, MA, MB, true);
            mg_group<WHICH>(P, slice, nb + 32, x, wl, wl_off, MB, MA, true);
            mg_group<WHICH>(P, slice, nb + 64, x, wl, wl_off, MA, MB, true);
            mg_group<WHICH>(P, slice, nb + 96, x, wl, wl_off, MB, MA, false);
            MG_WAIT(0);
        }
    }
}
DI void hid_reduce8_phase(const Params& P, int bid, int nblk) {
    const int tid = tid_(), lane = tid & 63, wave = __builtin_amdgcn_readfirstlane(tid >> 6);
    unsigned char* ws = P.ws;
    const int gw = bid * NWAVES + wave, NGW = nblk * NWAVES;
    const bf16_t* hp = (const bf16_t*)(ws + WS_HIDP);
    for (int n = gw; n < NTOK; n += NGW) {
        const float xs = ((const float*)(ws + WS_XSC))[n];
        float cv[2]; float am = 0.f;
#pragma unroll
        for (int q = 0; q < 2; ++q) {
            const size_t o = (size_t)n * 128 + 64 * q + lane; float a = 0.f;
            const int e = ((const int*)(ws + WS_EIDX))[o];
            const f32x4 us = *(const f32x4*)((const float*)(ws + WS_USC) + (size_t)e * 4);
#pragma unroll
            for (int x = 0; x < 4; ++x) a += bf2f(hp[(size_t)x * NTOK * 128 + o]) * us[x];
            cv[q] = gelu_exact(a * xs) * ((const float*)(ws + WS_EGATE))[o] * ((const float*)(ws + WS_VSC))[e];
            am = fmaxf(am, fabsf(cv[q]));
        }
        am = row16_max(am); am = fmaxf(fmaxf(readlane_f(am, 0), readlane_f(am, 16)), fmaxf(readlane_f(am, 32), readlane_f(am, 48)));
        const float sc = (am > 0.f) ? exp2f(floorf(log2f(224.f / am))) : 1.f;
        const int w0 = __builtin_amdgcn_cvt_pk_fp8_f32(cv[0] * sc, cv[1] * sc, 0, false);
        ws[WS_C8 + (size_t)n * 128 + lane] = (unsigned char)(w0 & 255); ws[WS_C8 + (size_t)n * 128 + 64 + lane] = (unsigned char)((w0 >> 8) & 255);
        if (lane == 0) ((float*)(ws + WS_CSC))[n] = 1.f / sc;
    }
}
DI void final_norm8_phase(const Params& P, int bid, int nblk) {
    const int tid = tid_(), lane = tid & 63, wave = __builtin_amdgcn_readfirstlane(tid >> 6);
    const unsigned char* ws = P.ws;
    const int gw = bid * NWAVES + wave, NGW = nblk * NWAVES;
    f32x4 wv[4];
#pragma unroll
    for (int q = 0; q < 4; ++q) wv[q] = *(const f32x4*)(P.final_w + 16 * lane + 4 * q);
    for (int n = gw; n < NTOK; n += NGW) {
        float* orow = P.out + (size_t)n * DM + 16 * lane;
        const bf16_t* yrow = (const bf16_t*)(ws + WS_HIDP) + ((size_t)(lane >> 3) * NTOK + n) * 128 + 16 * (lane & 7);
        const u32x4 ya = *(const u32x4*)yrow, yb = *(const u32x4*)(yrow + 8);
        const unsigned yu[8] = {ya.x, ya.y, ya.z, ya.w, yb.x, yb.y, yb.z, yb.w};
        const float cs = ((const float*)(ws + WS_CSC))[n];
        const bf16_t* hrow = (const bf16_t*)(ws + WS_XB) + (size_t)n * DM + 16 * lane;
        const u32x4 ha = *(const u32x4*)hrow, hb = *(const u32x4*)(hrow + 8);
        const unsigned hu[8] = {ha.x, ha.y, ha.z, ha.w, hb.x, hb.y, hb.z, hb.w};
        f32x4 h[4]; float ss = 0.f;
#pragma unroll
        for (int q = 0; q < 4; ++q) { h[q] = (f32x4){bf2f(hu[2 * q] & 0xffffu), bf2f(hu[2 * q] >> 16), bf2f(hu[2 * q + 1] & 0xffffu), bf2f(hu[2 * q + 1] >> 16)} + (f32x4){bf2f(yu[2 * q] & 0xffffu), bf2f(yu[2 * q] >> 16), bf2f(yu[2 * q + 1] & 0xffffu), bf2f(yu[2 * q + 1] >> 16)} * cs; ss += (h[q].x * h[q].x + h[q].y * h[q].y) + (h[q].z * h[q].z + h[q].w * h[q].w); }
        ss = wave_sum_dpp(ss);
        const float rs = 1.f / sqrtf(ss * (1.f / DM) + EPS);
#pragma unroll
        for (int q = 0; q < 4; ++q) *(f32x4*)(orow + 4 * q) = h[q] * wv[q] * rs;
    }
}

#define XB_TMO      128
#define XB_XCNT(j)  (256  + 64 * (j))
#define XB_XSUB(j)  (1280 + 64 * (j))
#define XB_XGEN(j)  (2304 + 64 * (j))
#define XB_TOP      3328
#define XB_TOPGEN   3392
#define XCD_BAR_WORDS 3456
#define XB_SPIN_CAP (1u << 18)

__device__ __forceinline__ unsigned xb_ld(unsigned* p)              { return __hip_atomic_load(p, __ATOMIC_RELAXED, __HIP_MEMORY_SCOPE_AGENT); }
__device__ __forceinline__ unsigned xb_add(unsigned* p, unsigned v) { return __hip_atomic_fetch_add(p, v, __ATOMIC_RELAXED, __HIP_MEMORY_SCOPE_AGENT); }
__device__ __forceinline__ unsigned xb_xcc_id() { return (unsigned)__builtin_amdgcn_s_getreg((3 << 11) | 20) & 0xFu; }
#define XB_SPIN(cond, bar) do { unsigned _sp = 0; while (cond) { __builtin_amdgcn_s_sleep(1); \
    if ((++_sp & 255u) == 0u) { if (xb_ld(&(bar)[XB_TMO])) break; if (_sp > XB_SPIN_CAP) { atomicAdd(&(bar)[XB_TMO], 1u); break; } } } } while (0)

struct XcdBarrier {
    unsigned* bar; unsigned x;
    volatile LAS unsigned* st;
};

__device__ __forceinline__ XcdBarrier xcd_barrier_post(unsigned* bar, volatile LAS unsigned* st) {
    XcdBarrier b; b.bar = bar; b.x = xb_xcc_id(); b.st = st;
    if (threadIdx.x == 0) (void)xb_add(&bar[XB_XCNT(b.x)], 1u);
    return b;
}
__device__ __forceinline__ void xcd_barrier_complete(unsigned* bar, unsigned x, unsigned& nloc, unsigned& nx) {
    const unsigned G = gridDim.x * gridDim.y * gridDim.z;
    unsigned sum, cnt, mine, sp = 0u;
    for (;;) {
        sum = 0u; cnt = 0u; mine = 0u;
#pragma unroll
        for (unsigned j = 0; j < 16; ++j) { const unsigned c = xb_ld(&bar[XB_XCNT(j)]); sum += c; cnt += (c > 0u) ? 1u : 0u; mine = (j == x) ? c : mine; }
        if (sum == G) break;
        __builtin_amdgcn_s_sleep(1);
        if ((++sp & 255u) == 0u) { if (xb_ld(&bar[XB_TMO])) break; if (sp > XB_SPIN_CAP) { atomicAdd(&bar[XB_TMO], 1u); break; } }
    }
    nloc = mine > 0u ? mine : 1u; nx = cnt > 0u ? cnt : 1u;
}

__device__ __forceinline__ void xcd_barrier(const XcdBarrier& b) {
    asm volatile("s_waitcnt vmcnt(0)" ::: "memory");
    __syncthreads();
    if (threadIdx.x == 0) {
        unsigned* bar = b.bar;
        __builtin_amdgcn_s_waitcnt(0);
        unsigned nloc = b.st[0], nx = b.st[1];
        if (nloc == 0u) { xcd_barrier_complete(bar, b.x, nloc, nx); b.st[0] = nloc; b.st[1] = nx; }
        const unsigned old = xb_add(&bar[XB_XSUB(b.x)], 1u);
        const unsigned gen = old / nloc;
        if (old + 1u == (gen + 1u) * nloc) {
            __builtin_amdgcn_fence(__ATOMIC_RELEASE, "agent");
            asm volatile("s_waitcnt vmcnt(0)" ::: "memory");
            const unsigned og = xb_add(&bar[XB_TOP], 1u);
            const unsigned tg = og / nx;
            if (og + 1u == (tg + 1u) * nx) xb_add(&bar[XB_TOPGEN], 1u);
            else XB_SPIN(xb_ld(&bar[XB_TOPGEN]) == tg, bar);
            __builtin_amdgcn_fence(__ATOMIC_ACQUIRE, "agent");
            xb_add(&bar[XB_XGEN(b.x)], 1u);
            asm volatile("s_waitcnt vmcnt(0)" ::: "memory");
        } else {
            XB_SPIN(xb_ld(&bar[XB_XGEN(b.x)]) == gen, bar);
            __builtin_amdgcn_fence(__ATOMIC_ACQUIRE, "agent");
            asm volatile("s_waitcnt vmcnt(0)" ::: "memory");
        }
    }
    __syncthreads();
}

constexpr int CTL_XB_WORD = 2048;
static_assert((CTL_XB_WORD + 3456) * 4 <= (int)CTL_BYTES, "barrier words inside CTL");
constexpr int N_HGRN_ITEMS = BATCH * 4, N_ATT_ITEMS = BATCH * 4 * 32;

DI void mixer_phase(const Params& P, char* lds) {
    unsigned* ctr = (unsigned*)(P.ws + WS_CTL);
    for (;;) {
        if (tid_() == 0) *(LAS int*)((LAS char*)lds + LDS_ITEM) = (int)atomicAdd(ctr, 1u);
        __syncthreads();
        const int item = *(LAS int*)((LAS char*)lds + LDS_ITEM);
        __syncthreads();
        if (item >= N_HGRN_ITEMS + N_ATT_ITEMS) break;
        if (item < N_HGRN_ITEMS) hgrn_unit(P, item >> 2, item & 3, lds);
        else { const int a = item - N_HGRN_ITEMS, j = 31 - (a >> 5), bh = a & 31; attn_unit(P, bh >> 2, bh & 3, j, lds); }
    }
}

#ifdef TS_PHASE
#ifndef TS_DIV
#define TS_DIV 4.0f
#endif
#define TS(i) do { if (blockIdx.x == 0 && threadIdx.x == 0) ((LAS unsigned long long*)((LAS char*)lds + LDS_BYTES - 512))[i] = __builtin_amdgcn_s_memrealtime(); } while (0)
#else
#define TS(i) do { } while (0)
#endif
__global__ void __launch_bounds__(NTHREADS, 2) fwd_megakernel(Params P) {
    extern __shared__ __attribute__((aligned(16))) char lds[];
    cg::grid_group grid = cg::this_grid();
    const int bid = blockIdx.x, nblk = gridDim.x;
    unsigned char* ws = P.ws;
    volatile LAS unsigned* xst = (volatile LAS unsigned*)((LAS char*)lds + LDS_XB);
    if (threadIdx.x < 4) xst[threadIdx.x] = 0u;
    __syncthreads();
    const XcdBarrier xbar = xcd_barrier_post((unsigned*)(ws + WS_CTL) + CTL_XB_WORD, xst);
    TS(0);
    phase0(P, lds, bid, nblk);
    grid.sync();
    TS(1);
    { Epi1 e{ws}; gemm_run(lds, (const bf16_t*)(ws + WS_XB), (const bf16_t*)(ws + WS_W1T), M1, NCOL1, DM, e, bid, nblk); }
    {
        constexpr int NUNITS = (M1 / 256) * (NCOL1 / 256);
        const int nlast = NUNITS % nblk, nfree = nlast ? nblk - nlast : nblk;
        const int wave = __builtin_amdgcn_readfirstlane(tid_() >> 6);
        if (nlast == 0 || bid >= nlast) table_fp8_rows(P, NEXP + (bid - (nlast ? nlast : 0)) * NWAVES + wave, nfree * NWAVES, 2 * NEXP);
    }
    xcd_barrier(xbar);
    TS(2);
    for (int it = bid; it < 32 * 129; it += nblk) hgrn_prep_item(P, it & 31, it >> 5, lds);
    xcd_barrier(xbar);
    TS(3);
    mixer_phase(P, lds);
    xcd_barrier(xbar);
    TS(4);
    { Epi3 e{P.x, P.out, (bf16_t*)(ws + WS_XB), (float*)(ws + WS_SSQ)}; gemm_run(lds, (const bf16_t*)(ws + WS_MIX), (const bf16_t*)(ws + WS_W2T), NTOK, DM, DM, e, bid, nblk); }
    xcd_barrier(xbar);
    TS(5);
    { Epi4 e{(const float*)(ws + WS_SSQ), (bf16_t*)(ws + WS_PQ)}; gemm_run(lds, (const bf16_t*)(ws + WS_XB), (const bf16_t*)(ws + WS_W3T), NTOK, 2048, DM, e, bid, nblk); }
    xcd_barrier(xbar);
    TS(6);
    topk_phase(P, lds, bid, nblk);
    xn8_rows(P, bid, nblk);
    xcd_barrier(xbar);
    TS(7);
    mg_phase<1>(P, lds);
    xcd_barrier(xbar);
    TS(8);
    hid_reduce8_phase(P, bid, nblk);
    xcd_barrier(xbar);
    TS(9);
    mg_phase<2>(P, lds);
    xcd_barrier(xbar);
    TS(10);
    final_norm8_phase(P, bid, nblk);
    TS(11);
#ifdef TS_PHASE
    if (blockIdx.x == 0 && threadIdx.x == 0) { const LAS unsigned long long* t = (const LAS unsigned long long*)((LAS char*)lds + LDS_BYTES - 512);
        P.out[0] += (float)(t[TS_PHASE + 1] - t[TS_PHASE]) * 0.01f / TS_DIV; }
#endif
}

extern "C" void kernel_launch(void* const* d_in, const int* in_sizes, int n_in, void* d_out, int out_size, void* d_ws, size_t ws_size, hipStream_t stream) {
    static int grid = 0;
    if (grid == 0) {
        int dev = 0, cus = 0, per_cu = 0;
        (void)hipGetDevice(&dev);
        (void)hipDeviceGetAttribute(&cus, hipDeviceAttributeMultiprocessorCount, dev);
        (void)hipFuncSetAttribute((const void*)fwd_megakernel, hipFuncAttributeMaxDynamicSharedMemorySize, LDS_BYTES);
        (void)hipOccupancyMaxActiveBlocksPerMultiprocessor(&per_cu, (const void*)fwd_megakernel, NTHREADS, LDS_BYTES);
        if (per_cu < 1) { fprintf(stderr, "kernel_launch: occupancy query says %d blocks per CU\n", per_cu); per_cu = 1; }
        grid = cus * 1;
        if (ws_size < WS_END) { fprintf(stderr, "kernel_launch: workspace too small: %zu < %zu\n", ws_size, (size_t)WS_END); grid = -1; }
    }
    if (grid < 0) return;
    (void)hipMemsetAsync((char*)d_ws + WS_CTL, 0, CTL_BYTES, stream);
    Params p{};
    p.x = (const float*)d_in[0]; p.meta = (const float*)d_in[1]; p.mix_norm_w = (const float*)d_in[2]; p.w_in = (const float*)d_in[3];
    p.lb_logits = (const float*)d_in[4]; p.rec_norm_w = (const float*)d_in[5]; p.lq1 = (const float*)d_in[6]; p.lk1 = (const float*)d_in[7];
    p.lq2 = (const float*)d_in[8]; p.lk2 = (const float*)d_in[9]; p.subln_w = (const float*)d_in[10]; p.w_out = (const float*)d_in[11];
    p.ffn_norm_w = (const float*)d_in[12]; p.wq = (const float*)d_in[13]; p.subkeys = (const float*)d_in[14]; p.pu = (const float*)d_in[15];
    p.pv = (const float*)d_in[16]; p.final_w = (const float*)d_in[17];
    p.out = (float*)d_out; p.ws = (unsigned char*)d_ws;
    void* args[] = {&p};
    hipError_t e = hipLaunchCooperativeKernel((const void*)fwd_megakernel, dim3(grid), dim3(NTHREADS), args, LDS_BYTES, stream);
    if (e != hipSuccess) fprintf(stderr, "cooperative launch failed: %s (grid %d)\n", hipGetErrorString(e), grid);
}
```

```cpp
#include <hip/hip_runtime.h>
#include <hip/hip_cooperative_groups.h>
#include <cstdio>
#include <cstdint>
#define DBG_SEL 1
namespace cg = cooperative_groups;

constexpr int BATCH = 8, SEQ = 4096, DM = 1024, NMETA = 16;
constexpr int NTOK = BATCH * SEQ;
constexpr int M1 = NTOK + 256;
constexpr int NCOL1 = 3584;
constexpr int TPOS = NMETA + SEQ;
constexpr int KT = 65;
constexpr int KPAD = 48;
constexpr int HT = 4128;
constexpr int NEXP = 16384;
constexpr float EPS = 1e-6f;
constexpr float LAM_INIT = 0.2f;
constexpr float QSCALE = 0.125f * 1.4426950408889634f;
constexpr int NTHREADS = 512, NWAVES = 8;
constexpr int LDS_BYTES = 163840;
constexpr int LDS_ITEM = LDS_BYTES - 64, LDS_XB = LDS_BYTES - 32;

typedef unsigned short bf16_t;
typedef short bf16x8 __attribute__((ext_vector_type(8)));
typedef float f32x4 __attribute__((ext_vector_type(4)));
typedef float f32x16 __attribute__((ext_vector_type(16)));
typedef float f32x2 __attribute__((ext_vector_type(2)));
typedef unsigned u32x4 __attribute__((ext_vector_type(4)));
typedef unsigned u32x2 __attribute__((ext_vector_type(2)));
typedef __bf16 bf16x2_t __attribute__((ext_vector_type(2)));
typedef short s16x4 __attribute__((ext_vector_type(4)));
#define LAS __attribute__((address_space(3)))
#define DI __device__ __forceinline__
__device__ __forceinline__ int tid_() { int t = threadIdx.x; asm volatile("" : "+v"(t)); return t; }

constexpr size_t al256(size_t x) { return (x + 255) & ~(size_t)255; }
constexpr size_t WS_CTL = 0, CTL_BYTES = 65536;
constexpr size_t WS_W1T = WS_CTL + CTL_BYTES;
constexpr size_t WS_W2T = WS_W1T + (size_t)NCOL1 * DM * 2;
constexpr size_t WS_W3T = WS_W2T + (size_t)DM * DM * 2;
constexpr size_t WS_SKB = WS_W3T + (size_t)2048 * DM * 2;
constexpr size_t WS_UB = WS_SKB + (size_t)16 * 128 * 128 * 2;
constexpr size_t WS_VB = WS_UB + (size_t)NEXP * DM * 2;
constexpr size_t WS_USC = WS_UB + (size_t)NEXP * DM, WS_VSC = WS_VB + (size_t)NEXP * DM;
constexpr size_t WS_ROPE = WS_VB + (size_t)NEXP * DM * 2;
constexpr size_t WS_LB = WS_ROPE + (size_t)TPOS * 64 * 4;
constexpr size_t WS_R1 = WS_LB + 4096;
constexpr size_t WS_SSQ = WS_R1 + al256((size_t)M1 * 4);
constexpr size_t WS_SSQ2 = WS_SSQ + (size_t)NTOK * 4;
constexpr size_t WS_XB = WS_SSQ2 + (size_t)NTOK * 4;
constexpr size_t WS_C = WS_XB + (size_t)M1 * DM * 2;
constexpr size_t WS_Q = WS_C;
constexpr size_t WS_K = WS_Q + (size_t)NTOK * 512 * 2;
constexpr size_t WS_V = WS_K + (size_t)BATCH * 4 * 2 * KT * 8192;
constexpr size_t WS_HQ = WS_V + (size_t)BATCH * 4 * KT * 16384;
constexpr size_t WS_HV = WS_HQ + (size_t)BATCH * 4 * HT * 128 * 2;
constexpr size_t WS_HG = WS_HV + (size_t)BATCH * 4 * HT * 128 * 2;
constexpr size_t WS_SG = WS_HG + (size_t)BATCH * 4 * HT * 128 * 4;
constexpr size_t WS_CEND = WS_SG + (size_t)NTOK * 512 * 2;
constexpr size_t WS_PQ = WS_C;
constexpr size_t WS_EIDX = WS_PQ + (size_t)NTOK * 2048 * 2;
constexpr size_t WS_EGATE = WS_EIDX + (size_t)NTOK * 128 * 4;
constexpr size_t WS_HID = WS_EGATE + (size_t)NTOK * 128 * 4;
constexpr size_t WS_XN8 = WS_HID + (size_t)NTOK * 128 * 4;
constexpr size_t WS_XSC = WS_XN8 + (size_t)NTOK * DM;
constexpr size_t WS_C8 = WS_XSC + (size_t)NTOK * 4;
constexpr size_t WS_CSC = WS_C8 + (size_t)NTOK * 128 * 4;
static_assert(WS_CSC + (size_t)NTOK * 16 <= WS_CEND, "overlay fits");
constexpr size_t WS_HIDP = WS_PQ;
constexpr size_t WS_MIX = WS_CEND;
constexpr size_t WS_HQA = WS_MIX + (size_t)NTOK * DM * 2;
constexpr size_t WS_HD = WS_HQA + (size_t)BATCH * 4 * HT * 128 * 2;
constexpr size_t WS_END = WS_HD + (size_t)BATCH * 4 * 129 * 128 * 4;
static_assert(WS_END <= (size_t)512 * 1024 * 1024, "workspace map must fit 512 MiB");

struct Params {
    const float* x; const float* meta; const float* mix_norm_w; const float* w_in; const float* lb_logits; const float* rec_norm_w;
    const float* lq1; const float* lk1; const float* lq2; const float* lk2; const float* subln_w; const float* w_out; const float* ffn_norm_w;
    const float* wq; const float* subkeys; const float* pu; const float* pv; const float* final_w;
    float* out; unsigned char* ws;
};

DI unsigned f2bf(float f) { unsigned u = __builtin_bit_cast(unsigned, f); return (u + 0x7fffu + ((u >> 16) & 1u)) >> 16; }
DI float bf2f(unsigned b) { return __builtin_bit_cast(float, b << 16); }
DI unsigned cvtpk(float lo, float hi) { f32x2 v = {lo, hi}; bf16x2_t b = __builtin_convertvector(v, bf16x2_t); return __builtin_bit_cast(unsigned, b); }
DI float wave_sum(float v) {
#pragma unroll
    for (int o = 1; o < 64; o <<= 1) v += __shfl_xor(v, o);
    return v;
}
DI float sigmoidf_(float x) { return 1.f / (1.f + __expf(-x)); }
DI float siluf_(float x) { return x * sigmoidf_(x); }

DI int sigma_col(int c) {
    if (c >= 1024) return c;
    const int cc = c & 63, a = cc >> 5, fq = (cc >> 3) & 3, n = (cc >> 2) & 1, j = cc & 3;
    return (c & ~63) + 4 * (4 * a + fq) + 32 * n + j;
}
template <bool PERMUTE>
DI void p0_transpose_item(const float* W, int K, int N, const float* scale, bf16_t* WT, LAS float* scr, int item, int lane) {
    const int nblk = N / 32, kb = item / nblk, nb = item % nblk, k0 = 64 * kb, n0 = 32 * nb;
    const int ncol = PERMUTE ? sigma_col(n0 + (lane & 31)) : n0 + (lane & 31);
#pragma unroll 8
    for (int i = 0; i < 32; ++i) { const int kk = 2 * i + (lane >> 5); float s = scale ? scale[k0 + kk] : 1.f; scr[kk * 33 + (lane & 31)] = W[(size_t)(k0 + kk) * N + ncol] * s; }
    asm volatile("s_waitcnt lgkmcnt(0)" ::: "memory");
    const int c = lane & 7;
#pragma unroll
    for (int j = 0; j < 4; ++j) { const int n = (lane >> 3) + 8 * j; const LAS float* s = scr + (8 * c) * 33 + n;
        u32x4 o; o.x = cvtpk(s[0 * 33], s[1 * 33]); o.y = cvtpk(s[2 * 33], s[3 * 33]); o.z = cvtpk(s[4 * 33], s[5 * 33]); o.w = cvtpk(s[6 * 33], s[7 * 33]);
        *(u32x4*)(WT + (size_t)(n0 + n) * K + k0 + 8 * c) = o; }
    asm volatile("s_waitcnt lgkmcnt(0)" ::: "memory");
}

DI unsigned fp4_code(float x, float sc) {
    const float a = fabsf(x) * sc;
    const unsigned idx = (unsigned)(a > 0.25f) + (unsigned)(a > 0.75f) + (unsigned)(a > 1.25f) + (unsigned)(a > 1.75f) + (unsigned)(a > 2.5f) + (unsigned)(a > 3.5f) + (unsigned)(a > 5.0f);
    return idx | (x < 0.f ? 8u : 0u);
}
DI void table_fp8_rows(const Params& P, int first, int stride, int r_end) {
    const int lane = tid_() & 63;
    unsigned char* ws = P.ws;
    for (int r = first; r < r_end; r += stride) {
        const bool isv = r >= NEXP; const int e = isv ? r - NEXP : r;
        const f32x4* src = (const f32x4*)((isv ? P.pv : P.pu) + (size_t)e * DM) + lane;
        f32x4 v[4]; float amq[4];
#pragma unroll
        for (int q = 0; q < 4; ++q) { v[q] = src[64 * q]; amq[q] = fmaxf(fmaxf(fabsf(v[q].x), fabsf(v[q].y)), fmaxf(fabsf(v[q].z), fabsf(v[q].w))); }
#pragma unroll
        for (int o = 1; o < 64; o <<= 1) {
#pragma unroll
            for (int q = 0; q < 4; ++q) amq[q] = fmaxf(amq[q], __shfl_xor(amq[q], o));
        }
        {
            unsigned char* tb = ws + (isv ? WS_VB : WS_UB); float* scp = (float*)(ws + (isv ? WS_VSC : WS_USC));
#pragma unroll
            for (int q = 0; q < 4; ++q) {
                const float sc = (amq[q] > 0.f) ? 6.f / amq[q] : 1.f;
                unsigned w = __builtin_amdgcn_cvt_scalef32_pk_fp4_f32(0u, v[q].x * sc, v[q].y * sc, 1.0f, 0); w = __builtin_amdgcn_cvt_scalef32_pk_fp4_f32(w, v[q].z * sc, v[q].w * sc, 1.0f, 1);
                *(unsigned short*)(tb + ((size_t)q * NEXP + e) * 128 + 2 * lane) = (unsigned short)w;
                if (lane == 0) scp[(size_t)e * 4 + q] = 1.f / sc;
            }
        }
    }
}

DI void phase0(const Params& P, char* lds, int bid, int nblk) {
    const int tid = tid_(), lane = tid & 63, wave = __builtin_amdgcn_readfirstlane(tid >> 6);
    unsigned char* ws = P.ws;
    LAS float* scr = (LAS float*)(lds) + wave * (64 * 33);
    const int gw = bid * NWAVES + wave, NGW = nblk * NWAVES;
    constexpr int I1 = (DM / 64) * (NCOL1 / 32), I2 = (DM / 64) * (DM / 32), I3 = (DM / 64) * (2048 / 32);
    for (int it = gw; it < I1 + I2 + I3; it += NGW) {
        int r = it;
        if (r < I1) { p0_transpose_item<true>(P.w_in, DM, NCOL1, P.mix_norm_w, (bf16_t*)(ws + WS_W1T), scr, r, lane); continue; } r -= I1;
        if (r < I2) { p0_transpose_item<false>(P.w_out, DM, DM, nullptr, (bf16_t*)(ws + WS_W2T), scr, r, lane); continue; } r -= I2;
        p0_transpose_item<false>(P.wq, DM, 2048, P.ffn_norm_w, (bf16_t*)(ws + WS_W3T), scr, r, lane);
    }
    for (int m = gw; m < M1; m += NGW) {
        bf16_t* orow = (bf16_t*)(ws + WS_XB) + (size_t)m * DM;
        float* r1 = (float*)(ws + WS_R1);
        unsigned long long* o8 = (unsigned long long*)orow + lane;
        if (m >= NTOK + NMETA) { for (int j = 0; j < 4; ++j) o8[64 * j] = 0ull; if (lane == 0) r1[m] = 0.f; continue; }
        const float* xrow = (m < NTOK) ? P.x + (size_t)m * DM : P.meta + (size_t)(m - NTOK) * DM;
        const f32x4* xr = (const f32x4*)xrow + lane;
        f32x4 v[4]; float s = 0.f;
#pragma unroll
        for (int j = 0; j < 4; ++j) { v[j] = xr[64 * j]; s += (v[j].x * v[j].x + v[j].y * v[j].y) + (v[j].z * v[j].z + v[j].w * v[j].w); }
        s = wave_sum(s);
        if (lane == 0) r1[m] = 1.f / sqrtf(s * (1.f / DM) + EPS);
#pragma unroll
        for (int j = 0; j < 4; ++j) o8[64 * j] = (unsigned long long)cvtpk(v[j].x, v[j].y) | ((unsigned long long)cvtpk(v[j].z, v[j].w) << 32);
    }
    table_fp8_rows(P, gw, NGW, NEXP);
    {
        const size_t gt = (size_t)bid * NTHREADS + tid, NGT = (size_t)nblk * NTHREADS;
        const size_t ns = (size_t)16 * 128 * 128 / 8;
        for (size_t e = gt; e < ns; e += NGT) {
            const f32x4 a = ((const f32x4*)P.subkeys)[2 * e], b = ((const f32x4*)P.subkeys)[2 * e + 1];
            u32x4 o; o.x = cvtpk(a.x, a.y); o.y = cvtpk(a.z, a.w); o.z = cvtpk(b.x, b.y); o.w = cvtpk(b.z, b.w);
            ((u32x4*)(ws + WS_SKB))[e] = o;
        }
        float* rope = (float*)(ws + WS_ROPE);
        for (size_t i = gt; i < (size_t)TPOS * 32; i += NGT) {
            const int t = (int)(i >> 5), f = (int)(i & 31);
            const double inv = exp2(-(double)f * (13.287712379549449 / 32.0));
            const double ang = (double)t * inv;
            rope[(size_t)t * 64 + f] = (float)cos(ang); rope[(size_t)t * 64 + 32 + f] = (float)sin(ang);
        }
        float* ssq = (float*)(ws + WS_SSQ);
        for (size_t i = gt; i < (size_t)2 * NTOK; i += NGT) ssq[i] = 0.f;
        for (size_t i = gt; i < (size_t)BATCH * 4 * 2 * 512; i += NGT) { const size_t img = i >> 9, o = i & 511; ((u32x4*)(ws + WS_K + img * KT * 8192))[o] = (u32x4){0u, 0u, 0u, 0u}; }
        for (size_t i = gt; i < (size_t)BATCH * 4 * 1024; i += NGT) { const size_t img = i >> 10, o = i & 1023; ((u32x4*)(ws + WS_V + img * KT * 16384))[o] = (u32x4){0u, 0u, 0u, 0u}; }
        for (size_t i = gt; i < (size_t)BATCH * 4 * 16 * 16; i += NGT) { const size_t bh = i >> 8, o = i & 255;
            ((u32x4*)(ws + WS_HQ + bh * HT * 256))[o] = (u32x4){0u, 0u, 0u, 0u}; ((u32x4*)(ws + WS_HV + bh * HT * 256))[o] = (u32x4){0u, 0u, 0u, 0u}; }
        for (size_t i = gt; i < (size_t)BATCH * 4 * 16 * 32; i += NGT) { const size_t bh = i >> 9, o = i & 511; ((u32x4*)(ws + WS_HG + bh * HT * 512))[o] = (u32x4){0u, 0u, 0u, 0u}; }
        float* lb = (float*)(ws + WS_LB);
        if (gt < 512) lb[gt] = sigmoidf_(P.lb_logits[gt] - P.lb_logits[512 + gt]);
        if (bid == 0 && wave == 0) {
            const float a = wave_sum(P.lq1[lane] * P.lk1[lane]), b = wave_sum(P.lq2[lane] * P.lk2[lane]);
            if (lane == 0) lb[512] = __expf(a) - __expf(b) + LAM_INIT;
        }
    }
}

namespace pg8 {
#define PG8_LAS __attribute__((address_space(3)))
typedef unsigned short bf16_t;
typedef short bf16x8 __attribute__((ext_vector_type(8)));
typedef float f32x4 __attribute__((ext_vector_type(4)));
typedef unsigned u32x4 __attribute__((ext_vector_type(4)));
constexpr int BM = 256, BK = 64, HALF = 128, HTB = HALF * BK * 2  , STAGE_BYTES = 8 * HTB, NXCD = 8, WGM = 8;

__host__ __device__ __forceinline__ int lds_byte(int r, int c) { const int st = (r >> 4) * 2 + (c >> 5), rr = r & 15, cc = c & 31, ob = rr * 64 + cc * 2; return st * 1024 + (ob ^ (((ob >> 9) & 1) << 5)); }
__host__ __device__ __forceinline__ void stage_rc(int b, int& R, int& C) { const int st = b / 1024, sb = b % 1024, swz = sb ^ (((sb >> 9) & 1) << 5); R = (st >> 1) * 16 + swz / 64; C = (st & 1) * 32 + (swz % 64) / 2; }
__host__ __device__ __forceinline__ int perm32(int rho) { const int n = rho >> 4, i = rho & 15; return 8 * (i >> 2) + 4 * n + (i & 3); }

struct Unit { int pm, pn; };
struct Gemm { const bf16_t* A; const bf16_t* Bt; int M, N, K; };

struct StaticOrder {
    int nM, nN, nwg, G, c;
    __host__ __device__ void init(int M, int N, int G_, int c_) { nM = M / BM; nN = N / BM; nwg = nM * nN; G = G_; c = c_; }
    __host__ __device__ bool next(int i, Unit& u) const {
        const long L = (long)i * G + c; if (L >= nwg) return false;
        int wgid = (int)L; { const int q = nwg / NXCD, r = nwg % NXCD, xcd = wgid % NXCD, off = wgid / NXCD; wgid = (xcd < r ? xcd * (q + 1) : r * (q + 1) + (xcd - r) * q) + off; }
        const int nig = WGM * nN, gid = wgid / nig, fm = gid * WGM, gsz = (nM - fm) < WGM ? (nM - fm) : WGM;
        u.pm = fm + ((wgid % nig) % gsz); u.pn = (wgid % nig) / gsz; return true;
    }
    __device__ __forceinline__ void a_ready(const Unit&) const {}
    __device__ __forceinline__ void done(const Unit&) const {}
};

template <class Epi, class Sched, bool ALIGN_EPI = false, bool SP2 = false>
__device__ __forceinline__ void gemm_phase(PG8_LAS unsigned char* lds, const Gemm g, const Sched& S, const Epi& E) {
    const int tid = tid_(), wid = __builtin_amdgcn_readfirstlane(tid >> 6), lane = tid & 63, wr = wid >> 2, wc = wid & 3, fr = lane & 15, fq = lane >> 4;
    const int K = g.K, nt = K / BK;
    unsigned voffA[2], voffB[2];
#pragma unroll
    for (int i = 0; i < 2; ++i) { int R, C; stage_rc(tid * 16 + i * 8192, R, C); const int Rb = Epi::PERM ? ((R & ~31) + perm32(R & 31)) : R;
        voffA[i] = (unsigned)(R * K + C) * 2u; voffB[i] = (unsigned)(Rb * K + C) * 2u; }
    const size_t kstep = (size_t)(BK * 2);
    const size_t hstep = (size_t)HALF * K * 2;
    const size_t tstep = 2 * hstep;
    const unsigned ldsw = (unsigned)wid * 1024u;
    const int aoff = lds_byte(wr * 64 + fr, fq * 8), boff = lds_byte(wc * 32 + fr, fq * 8);
#define PG8_SA(b, h) (((b) * 2 + (h)) * HTB)
#define PG8_SB(b, h) ((4 + (b) * 2 + (h)) * HTB)
#define PG8_STAGE(bufoff, gbase, voff) do { _Pragma("unroll") for (int _i = 0; _i < 2; ++_i) \
        __builtin_amdgcn_global_load_lds((const unsigned*)((const char*)(gbase) + (voff)[_i]), (PG8_LAS unsigned*)(lds + (bufoff) + ldsw + _i * 8192), 16, 0, 0); } while (0)
#define PG8_LDA(dst, b, h) do { _Pragma("unroll") for (int m = 0; m < 4; ++m) _Pragma("unroll") for (int k = 0; k < 2; ++k) dst[m][k] = *(const PG8_LAS bf16x8*)(lds + PG8_SA(b, h) + aoff + m * 2048 + k * 1024); } while (0)
#define PG8_LDB(dst, b, h) do { _Pragma("unroll") for (int n = 0; n < 2; ++n) _Pragma("unroll") for (int k = 0; k < 2; ++k) dst[n][k] = *(const PG8_LAS bf16x8*)(lds + PG8_SB(b, h) + boff + n * 2048 + k * 1024); } while (0)
#define PG8_MMA(ai, bj, At, Bt) do { __builtin_amdgcn_s_setprio(1); _Pragma("unroll") for (int m = 0; m < 4; ++m) _Pragma("unroll") for (int n = 0; n < 2; ++n) _Pragma("unroll") for (int k = 0; k < 2; ++k) \
        acc[ai][bj][m][n] = __builtin_amdgcn_mfma_f32_16x16x32_bf16(Bt[n][k], At[m][k], acc[ai][bj][m][n], 0, 0, 0); __builtin_amdgcn_s_setprio(0); } while (0)
#define PG8_WAIT_V(n) asm volatile("s_waitcnt vmcnt(" #n ")" ::: "memory")
#define PG8_WAIT_L(n) asm volatile("s_waitcnt lgkmcnt(" #n ")" ::: "memory")
#define PG8_BAR __builtin_amdgcn_s_barrier()
#define PG8_SCHED __builtin_amdgcn_sched_barrier(0)
    Unit cur, nxt; int ui = 0;
    if (!S.next(0, cur)) return;
    f32x4 acc[2][2][4][2];
#pragma unroll
    for (int a = 0; a < 2; ++a)
#pragma unroll
        for (int b = 0; b < 2; ++b)
#pragma unroll
            for (int m = 0; m < 4; ++m)
#pragma unroll
                for (int n = 0; n < 2; ++n) acc[a][b][m][n] = (f32x4){0.f, 0.f, 0.f, 0.f};
    bf16x8 At[4][2], B0[2][2], B1[2][2];
    const char* cA = (const char*)g.A + (size_t)cur.pm * tstep; const char* cB = (const char*)g.Bt + (size_t)cur.pn * tstep;
    S.a_ready(cur);
    if constexpr (SP2) {
        PG8_STAGE(PG8_SB(0, 0), cB, voffB); PG8_STAGE(PG8_SB(0, 1), cB + hstep, voffB); PG8_STAGE(PG8_SA(0, 0), cA, voffA); PG8_STAGE(PG8_SA(0, 1), cA + hstep, voffA);
        if (wr == 1) PG8_BAR;
        PG8_WAIT_V(2); PG8_BAR;
        PG8_STAGE(PG8_SB(1, 0), cB + kstep, voffB); PG8_STAGE(PG8_SA(1, 0), cA + kstep, voffA); PG8_STAGE(PG8_SB(1, 1), cB + hstep + kstep, voffB);
        PG8_WAIT_V(6); PG8_BAR;
    } else {
        PG8_STAGE(PG8_SB(0, 0), cB, voffB); PG8_STAGE(PG8_SA(0, 0), cA, voffA); PG8_STAGE(PG8_SB(0, 1), cB + hstep, voffB); PG8_STAGE(PG8_SA(0, 1), cA + hstep, voffA);
        if (wr == 1) PG8_BAR;
        PG8_WAIT_V(4); PG8_BAR;
        PG8_STAGE(PG8_SB(1, 0), cB + kstep, voffB); PG8_STAGE(PG8_SA(1, 0), cA + kstep, voffA); PG8_STAGE(PG8_SB(1, 1), cB + hstep + kstep, voffB);
        PG8_WAIT_V(6); PG8_BAR;
    }
    for (;;) {
        const bool has_next = S.next(ui + 1, nxt);
        const char* nA = has_next ? (const char*)g.A + (size_t)nxt.pm * tstep : cA; const char* nB = has_next ? (const char*)g.Bt + (size_t)nxt.pn * tstep : cB;
        for (int t = 0; t < nt; t += 2) {
            const bool last = (t == nt - 2);
            const char* a1 = cA + (size_t)(t + 1) * kstep;
            const char* a2 = last ? nA : cA + (size_t)(t + 2) * kstep; const char* b2 = last ? nB : cB + (size_t)(t + 2) * kstep;
            const char* a3 = a2 + kstep; const char* b3 = b2 + kstep;
            if (last && has_next) S.a_ready(nxt);
            if constexpr (SP2) {
            PG8_LDB(B0, 0, 0); PG8_LDB(B1, 0, 1); PG8_SCHED; PG8_LDA(At, 0, 0); PG8_STAGE(PG8_SA(1, 1), a1 + hstep, voffA);
            PG8_WAIT_V(8); PG8_WAIT_L(0); PG8_BAR; PG8_MMA(0, 0, At, B0); PG8_MMA(0, 1, At, B1); PG8_BAR; PG8_SCHED;
            PG8_LDA(At, 0, 1); PG8_STAGE(PG8_SB(0, 0), b2, voffB); PG8_STAGE(PG8_SB(0, 1), b2 + hstep, voffB); PG8_STAGE(PG8_SA(0, 0), a2, voffA);
            PG8_WAIT_V(8); PG8_WAIT_L(0); PG8_BAR; PG8_MMA(1, 0, At, B0); PG8_MMA(1, 1, At, B1); PG8_BAR; PG8_SCHED;
            PG8_LDB(B0, 1, 0); PG8_LDB(B1, 1, 1); PG8_SCHED; PG8_LDA(At, 1, 0); PG8_STAGE(PG8_SA(0, 1), a2 + hstep, voffA);
            PG8_WAIT_V(8); PG8_WAIT_L(0); PG8_BAR; PG8_MMA(0, 0, At, B0); PG8_MMA(0, 1, At, B1); PG8_BAR; PG8_SCHED;
            PG8_LDA(At, 1, 1); PG8_STAGE(PG8_SB(1, 0), b3, voffB); PG8_STAGE(PG8_SB(1, 1), b3 + hstep, voffB); PG8_STAGE(PG8_SA(1, 0), a3, voffA);
            PG8_WAIT_V(8); PG8_WAIT_L(0); PG8_BAR; PG8_MMA(1, 0, At, B0); PG8_MMA(1, 1, At, B1); PG8_BAR; PG8_SCHED;
            } else {
            PG8_LDB(B0, 0, 0); PG8_SCHED; PG8_LDA(At, 0, 0); PG8_STAGE(PG8_SA(1, 1), a1 + hstep, voffA);
            PG8_WAIT_L(8); PG8_BAR; PG8_WAIT_L(0); PG8_MMA(0, 0, At, B0); PG8_BAR; PG8_SCHED;
            PG8_LDB(B1, 0, 1); PG8_STAGE(PG8_SB(0, 0), b2, voffB);
            PG8_BAR; PG8_WAIT_L(0); PG8_MMA(0, 1, At, B1); PG8_BAR;
            PG8_LDA(At, 0, 1); PG8_STAGE(PG8_SA(0, 0), a2, voffA);
            PG8_BAR; PG8_WAIT_L(0); PG8_MMA(1, 0, At, B0); PG8_BAR; PG8_SCHED;
            PG8_STAGE(PG8_SB(0, 1), b2 + hstep, voffB);
            PG8_WAIT_V(6); PG8_BAR; PG8_MMA(1, 1, At, B1); PG8_BAR;
            PG8_LDB(B0, 1, 0); PG8_SCHED; PG8_LDA(At, 1, 0); PG8_STAGE(PG8_SA(0, 1), a2 + hstep, voffA);
            PG8_WAIT_L(8); PG8_BAR; PG8_WAIT_L(0); PG8_MMA(0, 0, At, B0); PG8_BAR; PG8_SCHED;
            PG8_LDB(B1, 1, 1); PG8_STAGE(PG8_SB(1, 0), b3, voffB);
            PG8_BAR; PG8_WAIT_L(0); PG8_MMA(0, 1, At, B1); PG8_BAR;
            PG8_LDA(At, 1, 1); PG8_STAGE(PG8_SA(1, 0), a3, voffA);
            PG8_BAR; PG8_WAIT_L(0); PG8_MMA(1, 0, At, B0); PG8_BAR; PG8_SCHED;
            PG8_STAGE(PG8_SB(1, 1), b3 + hstep, voffB);
            PG8_WAIT_V(6); PG8_BAR; PG8_MMA(1, 1, At, B1); PG8_BAR;
            }
        }
        if constexpr (ALIGN_EPI) { if (wr == 0) PG8_BAR; }
        if constexpr (!Epi::AFTER_DRAIN) { E(acc, cur, wr, wc, fr, fq); S.done(cur); }
        if (!has_next) break;
#pragma unroll
        for (int a = 0; a < 2; ++a)
#pragma unroll
            for (int b = 0; b < 2; ++b)
#pragma unroll
                for (int m = 0; m < 4; ++m)
#pragma unroll
                    for (int n = 0; n < 2; ++n) acc[a][b][m][n] = (f32x4){0.f, 0.f, 0.f, 0.f};
        cur = nxt; cA = nA; cB = nB; ++ui;
        if constexpr (ALIGN_EPI) { if (wr == 1) PG8_BAR; }
    }
    PG8_WAIT_V(0);
    if constexpr (!ALIGN_EPI) { if (wr == 0) PG8_BAR; }
    PG8_BAR;
    if constexpr (Epi::AFTER_DRAIN) { E.fused(acc, cur, wr, wc, fr, fq, lds, wid, lane); S.done(cur); }
#undef PG8_SA
#undef PG8_SB
#undef PG8_STAGE
#undef PG8_LDA
#undef PG8_LDB
#undef PG8_MMA
#undef PG8_WAIT_V
#undef PG8_WAIT_L
#undef PG8_BAR
#undef PG8_SCHED
}
}

DI u32x2 pack4(f32x4 v) { u32x2 r; r.x = cvtpk(v.x, v.y); r.y = cvtpk(v.z, v.w); return r; }
DI u32x4 pack8(f32x4 a, f32x4 b) { u32x4 r; r.x = cvtpk(a.x, a.y); r.y = cvtpk(a.z, a.w); r.z = cvtpk(b.x, b.y); r.w = cvtpk(b.z, b.w); return r; }

struct Epi1 {
    static constexpr bool PERM = true, AFTER_DRAIN = false;
    unsigned char* ws;
    DI void operator()(const f32x4 (&acc)[2][2][4][2], const pg8::Unit& u, int wr, int wc, int fr, int fq) const {
        const float* r1p = (const float*)(ws + WS_R1);
        const float* rope = (const float*)(ws + WS_ROPE);
        const float* lbp = (const float*)(ws + WS_LB);
        const int seg = u.pn >> 1;
#pragma unroll
        for (int ai = 0; ai < 2; ++ai)
#pragma unroll
            for (int m = 0; m < 4; ++m) {
                const int row = u.pm * 256 + ai * 128 + wr * 64 + m * 16 + fr;
                const bool meta = row >= NTOK;
                if (row >= NTOK + NMETA) continue;
                const float r1 = r1p[row];
                const int b = meta ? 0 : (row >> 12), t = meta ? (row - NTOK) : ((row & 4095) + NMETA);
                const int nrep = meta ? BATCH : 1;
#pragma unroll
                for (int bj = 0; bj < 2; ++bj) {
                    const int cs = (u.pn & 1) * 256 + bj * 128 + wc * 32 + 8 * fq;
                    const f32x4 v0 = acc[ai][bj][m][0] * r1, v1 = acc[ai][bj][m][1] * r1;
                    const int h = cs >> 7;
                    if (seg <= 1) {
                        const int comp = (cs >> 6) & 1, cc = cs & 63, i0 = 16 * (cc >> 5) + 4 * fq;
                        const f32x4 c4 = *(const f32x4*)(rope + (size_t)t * 64 + i0), s4 = *(const f32x4*)(rope + (size_t)t * 64 + 32 + i0);
                        f32x4 lo = v0 * c4 - v1 * s4, hi = v1 * c4 + v0 * s4;
                        if (seg == 0) {
                            if (meta) continue;
                            lo = lo * QSCALE; hi = hi * QSCALE;
                            bf16_t* qp = (bf16_t*)(ws + WS_Q) + ((size_t)(((b * 4 + h) * 2 + comp) * SEQ + (row & 4095))) * 64;
                            *(u32x2*)(qp + i0) = pack4(lo); *(u32x2*)(qp + i0 + 32) = pack4(hi);
                        } else {
                            const int pp = t + KPAD, tile = pp >> 6, key = pp & 63;
                            for (int bb = 0; bb < nrep; ++bb) {
                                const int b_ = meta ? bb : b;
                                unsigned char* img = ws + WS_K + ((size_t)((b_ * 4 + h) * 2 + comp) * KT + tile) * 8192;
                                *(u32x2*)(img + (i0 >> 3) * 1024 + key * 16 + (i0 & 7) * 2) = pack4(lo);
                                *(u32x2*)(img + ((i0 >> 3) + 4) * 1024 + key * 16 + (i0 & 7) * 2) = pack4(hi);
                            }
                        }
                    } else if (seg == 2) {
                        const int dv = cs & 127, pp = t + KPAD, tile = pp >> 6, key = pp & 63;
                        const u32x4 w = pack8(v0, v1);
                        for (int bb = 0; bb < nrep; ++bb) {
                            const int b_ = meta ? bb : b;
                            unsigned char* img = ws + WS_V + ((size_t)(b_ * 4 + h) * KT + tile) * 16384;
                            *(u32x4*)(img + (dv >> 5) * 4096 + key * 64 + (dv & 31) * 2) = w;
                        }
                    } else if (seg == 3 || seg == 5) {
                        const int dv = cs & 127;
                        f32x4 a = v0, c = v1;
                        if (seg == 3) { a.x = siluf_(a.x); a.y = siluf_(a.y); a.z = siluf_(a.z); a.w = siluf_(a.w); c.x = siluf_(c.x); c.y = siluf_(c.y); c.z = siluf_(c.z); c.w = siluf_(c.w); }
                        const u32x4 w = pack8(a, c);
                        const size_t base = (seg == 3) ? WS_HQ : WS_HV;
                        for (int bb = 0; bb < nrep; ++bb) {
                            const int b_ = meta ? bb : b;
                            *(u32x4*)((bf16_t*)(ws + base) + ((size_t)(b_ * 4 + h) * HT + t + 16) * 128 + dv) = w;
                        }
                    } else if (seg == 4) {
                        const int dv = cs & 127;
                        const f32x4 l0 = *(const f32x4*)(lbp + cs), l1 = *(const f32x4*)(lbp + cs + 4);
                        f32x4 g0, g1;
#pragma unroll
                        for (int e = 0; e < 4; ++e) { g0[e] = __logf(l0[e] + (1.f - l0[e]) * sigmoidf_(v0[e])); g1[e] = __logf(l1[e] + (1.f - l1[e]) * sigmoidf_(v1[e])); }
                        for (int bb = 0; bb < nrep; ++bb) {
                            const int b_ = meta ? bb : b;
                            float* gp = (float*)(ws + WS_HG) + ((size_t)(b_ * 4 + h) * HT + t + 16) * 128 + dv;
                            *(f32x4*)gp = g0; *(f32x4*)(gp + 4) = g1;
                        }
                    } else {
                        if (meta) continue;
                        f32x4 a = v0, c = v1;
                        a.x = siluf_(a.x); a.y = siluf_(a.y); a.z = siluf_(a.z); a.w = siluf_(a.w); c.x = siluf_(c.x); c.y = siluf_(c.y); c.z = siluf_(c.z); c.w = siluf_(c.w);
                        *(u32x4*)((bf16_t*)(ws + WS_SG) + (size_t)row * 512 + cs) = pack8(a, c);
                    }
                }
            }
    }
};

struct Epi3 {
    static constexpr bool PERM = true, AFTER_DRAIN = false;
    const float* x; float* H; bf16_t* HB; float* ssq;
    DI void operator()(const f32x4 (&acc)[2][2][4][2], const pg8::Unit& u, int wr, int wc, int fr, int fq) const {
#pragma unroll
        for (int ai = 0; ai < 2; ++ai)
#pragma unroll
            for (int m = 0; m < 4; ++m) {
                const int row = u.pm * 256 + ai * 128 + wr * 64 + m * 16 + fr;
                float s = 0.f;
#pragma unroll
                for (int bj = 0; bj < 2; ++bj) {
                    const int col = u.pn * 256 + bj * 128 + wc * 32 + 8 * fq;
                    const size_t o = (size_t)row * DM + col;
                    const u32x4 xb = *(const u32x4*)(HB + o);
                    const f32x4 x0 = (f32x4){bf2f(xb.x & 0xffffu), bf2f(xb.x >> 16), bf2f(xb.y & 0xffffu), bf2f(xb.y >> 16)}, x1 = (f32x4){bf2f(xb.z & 0xffffu), bf2f(xb.z >> 16), bf2f(xb.w & 0xffffu), bf2f(xb.w >> 16)};
                    const f32x4 h0 = x0 + acc[ai][bj][m][0], h1 = x1 + acc[ai][bj][m][1];
                    *(u32x4*)(HB + o) = pack8(h0, h1);
                    s += (h0.x * h0.x + h0.y * h0.y) + (h0.z * h0.z + h0.w * h0.w) + (h1.x * h1.x + h1.y * h1.y) + (h1.z * h1.z + h1.w * h1.w);
                }
                s += __shfl_xor(s, 16); s += __shfl_xor(s, 32);
                if (fq == 0) atomicAdd(ssq + row, s);
            }
    }
};

struct Epi4 {
    static constexpr bool PERM = true, AFTER_DRAIN = false;
    const float* ssq; bf16_t* PQ;
    DI void operator()(const f32x4 (&acc)[2][2][4][2], const pg8::Unit& u, int wr, int wc, int fr, int fq) const {
#pragma unroll
        for (int ai = 0; ai < 2; ++ai)
#pragma unroll
            for (int m = 0; m < 4; ++m) {
                const int row = u.pm * 256 + ai * 128 + wr * 64 + m * 16 + fr;
                const float r2 = 1.f / sqrtf(ssq[row] * (1.f / DM) + EPS);
#pragma unroll
                for (int bj = 0; bj < 2; ++bj) {
                    const int col = u.pn * 256 + bj * 128 + wc * 32 + 8 * fq;
                    *(u32x4*)(PQ + (size_t)row * 2048 + col) = pack8(acc[ai][bj][m][0] * r2, acc[ai][bj][m][1] * r2);
                }
            }
    }
};

template <class Epi>
DI void gemm_run(char* lds, const bf16_t* A, const bf16_t* Bt, int M, int N, int K, const Epi& E, int bid, int nblk) {
    pg8::Gemm g{A, Bt, M, N, K}; pg8::StaticOrder S; S.init(M, N, nblk, bid);
    pg8::gemm_phase<Epi, pg8::StaticOrder, true, true>((LAS unsigned char*)lds, g, S, E);
}
#define MFMA32(a, b, c) __builtin_amdgcn_mfma_f32_32x32x16_bf16(a, b, c, 0, 0, 0)
typedef short v4i16_t __attribute__((ext_vector_type(4)));
DI int crow(int r, int hi) { return (r & 3) + 8 * (r >> 2) + 4 * hi; }
DI s16x4 vtr(const LAS char* p) { return __builtin_bit_cast(s16x4, __builtin_amdgcn_ds_read_tr16_b64_v4i16((LAS v4i16_t*)p)); }
DI void glds16(const void* g, LAS char* l) { __builtin_amdgcn_global_load_lds((const unsigned*)g, (LAS unsigned*)l, 16, 0, 0); }
DI float swap_max(float m) { auto rr = __builtin_amdgcn_permlane32_swap(__float_as_uint(m), __float_as_uint(m), false, false); return fmaxf(__uint_as_float(rr[0]), __uint_as_float(rr[1])); }
DI float swap_sum(float m) { auto rr = __builtin_amdgcn_permlane32_swap(__float_as_uint(m), __float_as_uint(m), false, false); return __uint_as_float(rr[0]) + __uint_as_float(rr[1]); }
constexpr int ATT_BUF = 32768, ATT_WSF = 65536;
constexpr float ATT_THR = 8.f;

DI void attn_unit(const Params& P, int b, int h, int j, char* lds_g) {
    LAS char* lds = (LAS char*)lds_g;
    const int tid = tid_(), lane = tid & 63, r32 = lane & 31, hi = lane >> 5;
    const int wid = __builtin_amdgcn_readfirstlane(tid >> 6), comp = wid >> 2, wq = wid & 3;
    const unsigned char* ws = P.ws;
    const int bh = b * 4 + h;
    const bf16_t* Qw = (const bf16_t*)(ws + WS_Q) + ((size_t)((bh * 2 + comp) * SEQ + 128 * j + 32 * wq)) * 64;
    bf16x8 qr[4];
#pragma unroll
    for (int d0 = 0; d0 < 4; ++d0) qr[d0] = *(const bf16x8*)(Qw + r32 * 64 + d0 * 16 + hi * 8);
    const unsigned char* kimg0 = ws + WS_K + (size_t)(bh * 2) * KT * 8192 + wid * 1024 + lane * 16;
    const unsigned char* kimg1 = kimg0 + (size_t)KT * 8192;
    const unsigned char* vimg = ws + WS_V + (size_t)bh * KT * 16384 + wid * 1024 + lane * 16;
    const int NT = 2 * j + 3, my_last = (wq < 2) ? 2 * j + 1 : 2 * j + 2;
    LAS float* wsf = (LAS float*)(lds + ATT_WSF) + wid * 64;
#define ATT_ISSUE(t, s) do { LAS char* d_ = lds + (s) * ATT_BUF + wid * 1024; \
        glds16(kimg0 + (size_t)(t) * 8192, d_); glds16(kimg1 + (size_t)(t) * 8192, d_ + 8192); \
        glds16(vimg + (size_t)(t) * 16384, d_ + 16384); glds16(vimg + (size_t)(t) * 16384 + 8192, d_ + 24576); } while (0)
    f32x16 o[4];
#pragma unroll
    for (int nb = 0; nb < 4; ++nb) o[nb] = f32x16{};
    float mref = 0.f, lsum = 0.f;
    const int qpos = 64 + 128 * j + 32 * wq + r32;
    ATT_ISSUE(0, 0);
    __syncthreads();
    for (int t = 0; t < NT; ++t) {
        const int s = t & 1;
        if (t + 1 < NT) ATT_ISSUE(t + 1, s ^ 1);
        if (t <= my_last) {
            const LAS char* kp = lds + s * ATT_BUF + comp * 8192 + hi * 1024 + r32 * 16;
            f32x16 s0 = f32x16{}, s1 = f32x16{};
#pragma unroll
            for (int d0 = 0; d0 < 4; ++d0) {
                const bf16x8 k0 = *(const LAS bf16x8*)(kp + d0 * 2048), k1 = *(const LAS bf16x8*)(kp + d0 * 2048 + 512);
                s0 = MFMA32(k0, qr[d0], s0); s1 = MFMA32(k1, qr[d0], s1);
            }
            if (t == 0) {
#pragma unroll
                for (int r = 0; r < 16; ++r) { s0[r] = -INFINITY; if (32 + crow(r, hi) < KPAD) s1[r] = -INFINITY; }
            }
            if (t >= 2 * j + 1) {
                const int kb = 64 * t + 4 * hi;
#pragma unroll
                for (int r = 0; r < 16; ++r) { const int kv = kb + (r & 3) + 8 * (r >> 2); if (kv > qpos) s0[r] = -INFINITY; if (kv + 32 > qpos) s1[r] = -INFINITY; }
            }
            float rm = fmaxf(s0[0], s1[0]);
#pragma unroll
            for (int r = 1; r < 16; ++r) rm = fmaxf(rm, fmaxf(s0[r], s1[r]));
            rm = swap_max(rm);
            if (t == 0) mref = rm;
            else {
                const float grow = rm - mref;
                if (__any(grow > ATT_THR)) {
                    const float dl = fmaxf(grow, 0.f), f = __builtin_amdgcn_exp2f(-dl);
                    mref += dl; lsum *= f;
                    if (hi == 0) wsf[r32] = f;
                    asm volatile("s_waitcnt lgkmcnt(0)" ::: "memory");
#pragma unroll
                    for (int r = 0; r < 16; ++r) { const float fr_ = wsf[crow(r, hi)];
#pragma unroll
                        for (int nb = 0; nb < 4; ++nb) o[nb][r] *= fr_; }
                }
            }
            float ps = 0.f;
#pragma unroll
            for (int r = 0; r < 16; ++r) { s0[r] = __builtin_amdgcn_exp2f(s0[r] - mref); s1[r] = __builtin_amdgcn_exp2f(s1[r] - mref); ps += s0[r] + s1[r]; }
            lsum += ps;
            const LAS char* vp = lds + s * ATT_BUF + 16384 + ((lane >> 4) & 1) * 32 + (lane & 3) * 8 + (4 * hi + ((lane & 15) >> 2)) * 64;
#pragma unroll
            for (int ks = 0; ks < 4; ++ks) {
                u32x4 pw;
                if (ks < 2) { pw.x = cvtpk(s0[8 * ks], s0[8 * ks + 1]); pw.y = cvtpk(s0[8 * ks + 2], s0[8 * ks + 3]); pw.z = cvtpk(s0[8 * ks + 4], s0[8 * ks + 5]); pw.w = cvtpk(s0[8 * ks + 6], s0[8 * ks + 7]); }
                else { const int q_ = ks - 2; pw.x = cvtpk(s1[8 * q_], s1[8 * q_ + 1]); pw.y = cvtpk(s1[8 * q_ + 2], s1[8 * q_ + 3]); pw.z = cvtpk(s1[8 * q_ + 4], s1[8 * q_ + 5]); pw.w = cvtpk(s1[8 * q_ + 6], s1[8 * q_ + 7]); }
                const bf16x8 pa = __builtin_bit_cast(bf16x8, pw);
#pragma unroll
                for (int nb = 0; nb < 4; ++nb) {
                    const s16x4 vlo = vtr(vp + nb * 4096 + ks * 1024), vhi = vtr(vp + nb * 4096 + ks * 1024 + 512);
                    const bf16x8 vb = (bf16x8){vlo[0], vlo[1], vlo[2], vlo[3], vhi[0], vhi[1], vhi[2], vhi[3]};
                    o[nb] = MFMA32(pa, vb, o[nb]);
                }
            }
        }
        __syncthreads();
    }
#undef ATT_ISSUE
    lsum = swap_sum(lsum);
    if (hi == 0) wsf[r32] = lsum;
    asm volatile("s_waitcnt lgkmcnt(0)" ::: "memory");
    float rli[16];
#pragma unroll
    for (int r = 0; r < 16; ++r) rli[r] = 1.f / wsf[crow(r, hi)];
    const float lam = ((const float*)(ws + WS_LB))[512];
    LAS float* ex = (LAS float*)lds + wq * 4096;
    if (comp == 1) {
#pragma unroll
        for (int r = 0; r < 16; ++r)
#pragma unroll
            for (int nb = 0; nb < 4; ++nb) ex[(r * 4 + nb) * 64 + lane] = o[nb][r] * rli[r] * lam;
    }
    __syncthreads();
    if (comp == 0) {
        float ss[16];
#pragma unroll
        for (int r = 0; r < 16; ++r) { float a = 0.f;
#pragma unroll
            for (int nb = 0; nb < 4; ++nb) { const float v = o[nb][r] * rli[r] - ex[(r * 4 + nb) * 64 + lane]; o[nb][r] = v; a += v * v; }
            ss[r] = a; }
#pragma unroll
        for (int r = 0; r < 16; ++r) { float a = ss[r]; a += __shfl_xor(a, 1); a += __shfl_xor(a, 2); a += __shfl_xor(a, 4); a += __shfl_xor(a, 8); a += __shfl_xor(a, 16); ss[r] = (1.f - LAM_INIT) / sqrtf(a * (1.f / 128.f) + EPS); }
        bf16_t* mix = (bf16_t*)(ws + WS_MIX) + ((size_t)(b * SEQ + 128 * j + 32 * wq)) * DM + h * 128;
#pragma unroll
        for (int nb = 0; nb < 4; ++nb) { const float w = P.subln_w[32 * nb + r32];
#pragma unroll
            for (int r = 0; r < 16; ++r) mix[(size_t)crow(r, hi) * DM + 32 * nb + r32] = (bf16_t)f2bf(o[nb][r] * ss[r] * w); }
    }
    __syncthreads();
}
#define MFMA16(a, b, c) __builtin_amdgcn_mfma_f32_16x16x32_bf16(a, b, c, 0, 0, 0)
constexpr int HG_STR = 272;
constexpr int HL_QA = 0, HL_QB = HL_QA + 32 * HG_STR, HL_KB = HL_QB + 32 * HG_STR, HL_KT = HL_KB + 32 * HG_STR, HL_VV = HL_KT + 32 * HG_STR;
constexpr int HL_PS = HL_VV + 32 * HG_STR;
constexpr int HL_D = HL_PS + 4 * 128 * 4;
constexpr int HL_OUT = HL_D + 128 * 4;
constexpr int HL_END = HL_OUT + 32 * 132 * 4;

constexpr int HB_KTF = 0, HB_ATF = 8192, HB_DF = 10240;
DI void hgrn_prep_item(const Params& P, int bh, int c, char* lds_g) {
    LAS char* lds = (LAS char*)lds_g;
    const int tid = tid_(), lane = tid & 63, c16 = lane & 15, g4 = lane >> 4, ch = tid & 127, part = tid >> 7;
    const int wid = __builtin_amdgcn_readfirstlane(tid >> 6);
    const int vrow = tid >> 4, vcol = (tid & 15) * 8;
    unsigned char* ws = P.ws;
    const float* HG = (const float*)(ws + WS_HG) + (size_t)bh * HT * 128;
    const bf16_t* HQ = (const bf16_t*)(ws + WS_HQ) + (size_t)bh * HT * 128;
    const bf16_t* HV = (const bf16_t*)(ws + WS_HV) + (size_t)bh * HT * 128;
    const size_t r0 = (size_t)(32 * c + 8 * part);
    float g8[8], p8[8]; unsigned short q8[8];
    { float a = 0.f;
#pragma unroll
      for (int e = 0; e < 8; ++e) { g8[e] = HG[(r0 + e) * 128 + ch]; q8[e] = HQ[(r0 + e) * 128 + ch]; a += g8[e]; p8[e] = a; } }
    const u32x4 v16 = *(const u32x4*)(HV + ((size_t)(32 * c) + vrow) * 128 + vcol);
    ((LAS float*)(lds + HL_PS))[part * 128 + ch] = p8[7];
    __syncthreads();
    {
        const LAS float* ps = (const LAS float*)(lds + HL_PS);
        const float t0 = ps[ch], t1 = ps[128 + ch], t2 = ps[256 + ch], t3 = ps[384 + ch];
        const float off = (part > 0 ? t0 : 0.f) + (part > 1 ? t1 : 0.f) + (part > 2 ? t2 : 0.f);
        const float mid = t0 + t1, last = mid + t2 + t3;
        const float em = __expf(mid), el = __expf(last - mid);
        if (part == 0) ((LAS float*)(lds + HL_D))[ch] = __expf(last);
#pragma unroll
        for (int e = 0; e < 8; ++e) {
            const int tk = 8 * part + e;
            const float cum = off + p8[e];
            const float e1 = __expf(cum - mid), e2 = 1.f / e1;
            const float q = bf2f(q8[e]), k = 1.f - __expf(g8[e]);
            const float qb = q * e1, qa = qb * em, kb = k * e2, kt = kb * el;
            *(LAS bf16_t*)(lds + HL_QA + tk * HG_STR + ch * 2) = (bf16_t)f2bf(qa);
            *(LAS bf16_t*)(lds + HL_QB + tk * HG_STR + ch * 2) = (bf16_t)f2bf(qb);
            *(LAS bf16_t*)(lds + HL_KB + tk * HG_STR + ch * 2) = (bf16_t)f2bf(kb);
            *(LAS bf16_t*)(lds + HL_KT + tk * HG_STR + ch * 2) = (bf16_t)f2bf(kt);
        }
        *(LAS u32x4*)(lds + HL_VV + vrow * HG_STR + vcol * 2) = v16;
    }
    __syncthreads();
    unsigned char* qaf = ws + WS_HQA + ((size_t)bh * 129 + c) * 8192;
    unsigned char* hgb = ws + WS_HG + (size_t)bh * HT * 512 + (size_t)c * 16384;
    {
        const int ks = wid >> 1, nt = wid & 1;
        const LAS char* qp = lds + HL_QA + (16 * nt + c16) * HG_STR + (32 * ks + 4 * g4) * 2;
        const u32x2 lo = *(const LAS u32x2*)qp, hi2 = *(const LAS u32x2*)(qp + 32);
        *(u32x4*)(qaf + wid * 1024 + lane * 16) = (u32x4){lo.x, lo.y, hi2.x, hi2.y};
        const LAS char* kp = lds + HL_KT + (8 * g4 + (c16 >> 2)) * HG_STR + (16 * wid + 4 * (c16 & 3)) * 2;
        const s16x4 klo = vtr(kp), khi = vtr(kp + 4 * HG_STR);
        *(bf16x8*)(hgb + HB_KTF + wid * 1024 + lane * 16) = (bf16x8){klo[0], klo[1], klo[2], klo[3], khi[0], khi[1], khi[2], khi[3]};
    }
    if (wid == 0) {
        f32x4 at00 = (f32x4){0.f, 0.f, 0.f, 0.f}, at01 = at00, at11 = at00;
#pragma unroll
        for (int ks = 0; ks < 4; ++ks) {
            const bf16x8 ka0 = *(const LAS bf16x8*)(lds + HL_KB + c16 * HG_STR + (32 * ks + 8 * g4) * 2);
            const bf16x8 ka1 = *(const LAS bf16x8*)(lds + HL_KB + (16 + c16) * HG_STR + (32 * ks + 8 * g4) * 2);
            const bf16x8 qn0 = *(const LAS bf16x8*)(lds + HL_QB + c16 * HG_STR + (32 * ks + 8 * g4) * 2);
            const bf16x8 qn1 = *(const LAS bf16x8*)(lds + HL_QB + (16 + c16) * HG_STR + (32 * ks + 8 * g4) * 2);
            at00 = MFMA16(ka0, qn0, at00); at01 = MFMA16(ka0, qn1, at01); at11 = MFMA16(ka1, qn1, at11);
        }
#pragma unroll
        for (int r = 0; r < 4; ++r) { if (4 * g4 + r > c16) { at00[r] = 0.f; at11[r] = 0.f; } }
        u32x4 b0; b0.x = cvtpk(at00[0], at00[1]); b0.y = cvtpk(at00[2], at00[3]); b0.z = 0u; b0.w = 0u;
        u32x4 b1; b1.x = cvtpk(at01[0], at01[1]); b1.y = cvtpk(at01[2], at01[3]); b1.z = cvtpk(at11[0], at11[1]); b1.w = cvtpk(at11[2], at11[3]);
        *(u32x4*)(hgb + HB_ATF + lane * 16) = b0; *(u32x4*)(hgb + HB_ATF + 1024 + lane * 16) = b1;
    } else if (wid == 1 && lane < 32) {
        *(f32x4*)(hgb + HB_DF + lane * 16) = *(const LAS f32x4*)(lds + HL_D + lane * 16);
    }
    __syncthreads();
}

constexpr int RS_QAF = 0, RS_HGB = 8192, RS_V = 19456, RS_SLOT = 27648, RS_NSLOT = 5;
constexpr int RS_OUT = RS_NSLOT * RS_SLOT, RS_OUTB = 32 * 136 * 2, RS_END = RS_OUT + 2 * RS_OUTB;
static_assert(RS_END <= LDS_ITEM, "hgrn LDS map");
DI void glds16_asm(const void* g, unsigned lds_base) {
    unsigned sv; asm volatile("s_mov_b32 %0, m0\n\ts_mov_b32 m0, %2\n\ts_nop 0\n\tglobal_load_lds_dwordx4 %1, off\n\ts_mov_b32 m0, %0" : "=&s"(sv) : "v"(g), "s"(lds_base) : "memory"); }
#define HW_BAR() asm volatile("s_waitcnt lgkmcnt(0)\n\ts_barrier" ::: "memory")
DI void glds16_sb(unsigned voff, const void* sbase, unsigned lds_base) {
    unsigned sv; asm volatile("s_mov_b32 %0, m0\n\ts_mov_b32 m0, %3\n\ts_nop 0\n\tglobal_load_lds_dwordx4 %1, %2\n\ts_mov_b32 m0, %0" : "=&s"(sv) : "v"(voff), "s"(sbase), "s"(lds_base) : "memory"); }
DI void hgrn_unit(const Params& P, int b, int h, char* lds_g) {
    LAS char* lds = (LAS char*)lds_g;
    const int tid = tid_(), lane = tid & 63, c16 = lane & 15, g4 = lane >> 4;
    const int wid = __builtin_amdgcn_readfirstlane(tid >> 6);
    const unsigned char* ws = P.ws;
    const int bh = b * 4 + h;
    const unsigned lbase = (unsigned)__builtin_amdgcn_readfirstlane((int)(unsigned)(size_t)lds);
    constexpr int AHEAD = RS_NSLOT - 1;
    if (wid < 4) {
        const unsigned char* qafg = ws + WS_HQA + (size_t)bh * 129 * 8192;
        const unsigned char* hgbg = ws + WS_HG + (size_t)bh * HT * 512;
        const unsigned char* vg = ws + WS_HV + (size_t)bh * HT * 256;
        const unsigned voff = (unsigned)lane * 16u;
        auto issue = [&](int c) {
            const unsigned sb = lbase + (unsigned)((c % RS_NSLOT) * RS_SLOT);
#pragma unroll
            for (int k = 0; k < 7; ++k) {
                const int p = wid + 4 * k;
                if (p < 19) { const unsigned char* src = (p < 8) ? qafg + (size_t)c * 8192 + p * 1024 : hgbg + (size_t)c * 16384 + (p - 8) * 1024; glds16_sb(voff, src, sb + (unsigned)p * 1024u); }
                else if (p < 27) { const int r4 = 4 * (p - 19);
                    const unsigned vo = (unsigned)(lane >> 4) * 256u + (unsigned)(((lane & 15) ^ ((((r4 & 7) + (lane >> 4)) & 7) << 1)) * 16);
                    glds16_sb(vo, vg + ((size_t)(32 * c) + r4) * 256, sb + (unsigned)p * 1024u); }
            }
        };
        f32x4 S[2][8];
#pragma unroll
        for (int t = 0; t < 2; ++t)
#pragma unroll
            for (int i = 0; i < 8; ++i) S[t][i] = (f32x4){0.f, 0.f, 0.f, 0.f};
#pragma unroll
        for (int c = 0; c < AHEAD; ++c) issue(c);
        for (int c = 0; c < 129; ++c) {
            if (c + AHEAD - 1 > 128) asm volatile("s_waitcnt vmcnt(0)" ::: "memory");
            else if (wid < 3) asm volatile("s_waitcnt vmcnt(21)" ::: "memory"); else asm volatile("s_waitcnt vmcnt(18)" ::: "memory");
            HW_BAR();
            __builtin_amdgcn_sched_barrier(0);
            if (c + AHEAD < 129) issue(c + AHEAD);
            __builtin_amdgcn_sched_barrier(0);
            const LAS char* sl = lds + (c % RS_NSLOT) * RS_SLOT;
            f32x4 oacc[2][2];
#pragma unroll
            for (int t = 0; t < 2; ++t) { oacc[t][0] = (f32x4){0.f, 0.f, 0.f, 0.f}; oacc[t][1] = oacc[t][0]; }
#pragma unroll
            for (int ks = 0; ks < 4; ++ks) {
                const bf16x8 q0 = *(const LAS bf16x8*)(sl + RS_QAF + (2 * ks) * 1024 + lane * 16), q1 = *(const LAS bf16x8*)(sl + RS_QAF + (2 * ks + 1) * 1024 + lane * 16);
#pragma unroll
                for (int t = 0; t < 2; ++t) {
                    u32x4 sp; sp.x = cvtpk(S[t][2 * ks][0], S[t][2 * ks][1]); sp.y = cvtpk(S[t][2 * ks][2], S[t][2 * ks][3]); sp.z = cvtpk(S[t][2 * ks + 1][0], S[t][2 * ks + 1][1]); sp.w = cvtpk(S[t][2 * ks + 1][2], S[t][2 * ks + 1][3]);
                    const bf16x8 sf = __builtin_bit_cast(bf16x8, sp);
                    oacc[t][0] = MFMA16(sf, q0, oacc[t][0]); oacc[t][1] = MFMA16(sf, q1, oacc[t][1]);
                }
            }
            const int vq = c16 >> 2, vp4 = c16 & 3;
#define VTR(row, w_) vtr(sl + RS_V + (row) * 256 + (((2 * (w_) + (vp4 >> 1)) ^ ((((row) & 7)) << 1)) * 16) + 8 * (vp4 & 1))
            {
                const bf16x8 a0 = *(const LAS bf16x8*)(sl + RS_HGB + HB_ATF + lane * 16), a1 = *(const LAS bf16x8*)(sl + RS_HGB + HB_ATF + 1024 + lane * 16);
#pragma unroll
                for (int t = 0; t < 2; ++t) {
                    const s16x4 lo = VTR(4 * g4 + vq, 2 * wid + t), hi2 = VTR(16 + 4 * g4 + vq, 2 * wid + t);
                    const bf16x8 va = (bf16x8){lo[0], lo[1], lo[2], lo[3], hi2[0], hi2[1], hi2[2], hi2[3]};
                    oacc[t][0] = MFMA16(va, a0, oacc[t][0]); oacc[t][1] = MFMA16(va, a1, oacc[t][1]);
                }
            }
            {
                LAS char* ob = lds + RS_OUT + (c & 1) * RS_OUTB;
#pragma unroll
                for (int t = 0; t < 2; ++t)
#pragma unroll
                    for (int nt = 0; nt < 2; ++nt) { u32x2 w; w.x = cvtpk(oacc[t][nt][0], oacc[t][nt][1]); w.y = cvtpk(oacc[t][nt][2], oacc[t][nt][3]);
                        *(LAS u32x2*)(ob + ((16 * nt + c16) * 136 + 16 * (2 * wid + t) + 4 * g4) * 2) = w; }
            }
            {
                bf16x8 vb[2];
#pragma unroll
                for (int t = 0; t < 2; ++t) { const s16x4 lo = VTR(8 * g4 + vq, 2 * wid + t), hi2 = VTR(8 * g4 + 4 + vq, 2 * wid + t); vb[t] = (bf16x8){lo[0], lo[1], lo[2], lo[3], hi2[0], hi2[1], hi2[2], hi2[3]}; }
#pragma unroll
                for (int i = 0; i < 8; ++i) {
                    const f32x4 d4 = *(const LAS f32x4*)(sl + RS_HGB + HB_DF + (16 * i + 4 * g4) * 4);
                    const bf16x8 ka = *(const LAS bf16x8*)(sl + RS_HGB + HB_KTF + i * 1024 + lane * 16);
                    S[0][i] = MFMA16(ka, vb[0], S[0][i] * d4); S[1][i] = MFMA16(ka, vb[1], S[1][i] * d4);
                }
            }
#undef VTR
        }
        HW_BAR();
        HW_BAR();
    } else {
        const int tq = tid - 256, tok = tq >> 3, part = tq & 7;
        const bf16_t* sgg = (const bf16_t*)(ws + WS_SG) + ((size_t)b * SEQ + tok) * 512 + h * 128 + 16 * part;
        f32x4 nw[4];
#pragma unroll
        for (int q = 0; q < 4; ++q) nw[q] = *(const f32x4*)(P.rec_norm_w + h * 128 + 16 * part + 4 * q);
        auto epilogue = [&](int c, u32x4 s0, u32x4 s1) {
            const LAS char* ob = lds + RS_OUT + (c & 1) * RS_OUTB + (tok * 136 + 16 * part) * 2;
            const u32x4 o0 = *(const LAS u32x4*)ob, o1 = *(const LAS u32x4*)(ob + 16);
            const unsigned ou[8] = {o0.x, o0.y, o0.z, o0.w, o1.x, o1.y, o1.z, o1.w}, su[8] = {s0.x, s0.y, s0.z, s0.w, s1.x, s1.y, s1.z, s1.w};
            float v[16], ss = 0.f;
#pragma unroll
            for (int q = 0; q < 8; ++q) { v[2 * q] = bf2f(ou[q] & 0xffffu); v[2 * q + 1] = bf2f(ou[q] >> 16); ss += v[2 * q] * v[2 * q] + v[2 * q + 1] * v[2 * q + 1]; }
            ss += __shfl_xor(ss, 1); ss += __shfl_xor(ss, 2); ss += __shfl_xor(ss, 4);
            const float rs = 1.f / sqrtf(ss * (1.f / 128.f) + EPS);
            u32x4 w0, w1; unsigned wo[8];
#pragma unroll
            for (int q = 0; q < 8; ++q) wo[q] = cvtpk(v[2 * q] * rs * nw[q >> 1][(2 * q) & 3] * bf2f(su[q] & 0xffffu), v[2 * q + 1] * rs * nw[q >> 1][(2 * q + 1) & 3] * bf2f(su[q] >> 16));
            w0 = (u32x4){wo[0], wo[1], wo[2], wo[3]}; w1 = (u32x4){wo[4], wo[5], wo[6], wo[7]};
            bf16_t* mp = (bf16_t*)(ws + WS_MIX) + ((size_t)b * SEQ + 32 * (c - 1) + tok) * DM + 512 + h * 128 + 16 * part;
            *(u32x4*)mp = w0; *(u32x4*)(mp + 8) = w1;
        };
#define SG_LD(k, A, B) do { const bf16_t* p_ = sgg + (size_t)(32 * ((k) - 1)) * 512; A = *(const u32x4*)p_; B = *(const u32x4*)(p_ + 8); } while (0)
        u32x4 ga0, ga1, gb0, gb1, gc0, gc1, gd0, gd1;
        SG_LD(1, gb0, gb1); SG_LD(2, gc0, gc1); SG_LD(3, gd0, gd1);
        HW_BAR();
        HW_BAR();
        for (int k = 1; k <= 128; k += 4) {
            HW_BAR(); if (k + 3 <= 128) SG_LD(k + 3, ga0, ga1); epilogue(k, gb0, gb1);
            HW_BAR(); if (k + 4 <= 128) SG_LD(k + 4, gb0, gb1); epilogue(k + 1, gc0, gc1);
            HW_BAR(); if (k + 5 <= 128) SG_LD(k + 5, gc0, gc1); epilogue(k + 2, gd0, gd1);
            HW_BAR(); if (k + 6 <= 128) SG_LD(k + 6, gd0, gd1); epilogue(k + 3, ga0, ga1);
        }
#undef SG_LD
        HW_BAR();
    }
}
template <int CTRL> DI float dpp_f(float v) { return __builtin_bit_cast(float, __builtin_amdgcn_update_dpp(0, __builtin_bit_cast(int, v), CTRL, 0xf, 0xf, false)); }
DI float row16_max(float v) { v = fmaxf(v, dpp_f<0x128>(v)); v = fmaxf(v, dpp_f<0x124>(v)); v = fmaxf(v, dpp_f<0x122>(v)); v = fmaxf(v, dpp_f<0x121>(v)); return v; }
DI float row16_sum(float v) { v += dpp_f<0x128>(v); v += dpp_f<0x124>(v); v += dpp_f<0x122>(v); v += dpp_f<0x121>(v); return v; }
#define CE_D(a, b) do { const float hi_ = fmaxf(a, b), lo_ = fminf(a, b); a = hi_; b = lo_; } while (0)
DI void bitonic_sort16(float (&v)[16]) {
#pragma unroll
    for (int k = 2; k <= 16; k *= 2)
#pragma unroll
        for (int j = k / 2; j > 0; j /= 2)
#pragma unroll
            for (int i = 0; i < 16; ++i) { const int l = i ^ j; if (l > i) { if ((i & k) == 0) CE_D(v[i], v[l]); else CE_D(v[l], v[i]); } }
}
DI void merge_top16(float (&a)[16], const float (&b)[16]) {
#pragma unroll
    for (int i = 0; i < 16; ++i) a[i] = fmaxf(a[i], b[15 - i]);
#pragma unroll
    for (int j = 8; j > 0; j /= 2)
#pragma unroll
        for (int i = 0; i < 16; ++i) { const int l = i ^ j; if (l > i) CE_D(a[i], a[l]); }
}
DI float embed7(float v, unsigned code) { return __uint_as_float((__float_as_uint(v) & 0xFFFFFF80u) | code); }
DI float embed8(float v, unsigned code) { return __uint_as_float((__float_as_uint(v) & 0xFFFFFF00u) | code); }

DI void topk_list(const bf16_t* qp, const LAS char* skf, int lane, int hi, float (&top)[16]) {
    f32x16 acc[4];
#pragma unroll
    for (int kb = 0; kb < 4; ++kb) acc[kb] = f32x16{};
#pragma unroll
    for (int ks = 0; ks < 8; ++ks) {
        const bf16x8 qf = *(const bf16x8*)(qp + 16 * ks);
#pragma unroll
        for (int kb = 0; kb < 4; ++kb) { const bf16x8 kf = *(const LAS bf16x8*)(skf + (kb * 8 + ks) * 1024 + lane * 16); acc[kb] = MFMA32(kf, qf, acc[kb]); }
    }
    float blk[16];
#pragma unroll
    for (int kb = 0; kb < 4; ++kb) {
#pragma unroll
        for (int r = 0; r < 16; ++r) { const unsigned code = (unsigned)(32 * kb + (r & 3) + 8 * (r >> 2)) | (unsigned)(4 * hi); if (kb == 0) top[r] = embed7(acc[kb][r], code); else blk[r] = embed7(acc[kb][r], code); }
        if (kb == 0) bitonic_sort16(top); else { bitonic_sort16(blk); merge_top16(top, blk); }
    }
    float l0[16], l1[16];
#pragma unroll
    for (int r = 0; r < 16; ++r) { auto rr = __builtin_amdgcn_permlane32_swap(__float_as_uint(top[r]), __float_as_uint(top[r]), false, false); l0[r] = __uint_as_float(rr[0]); l1[r] = __uint_as_float(rr[1]); }
    merge_top16(l0, l1);
#pragma unroll
    for (int r = 0; r < 16; ++r) top[r] = l0[r];
}

DI void topk_wave_item(const Params& P, int tb, int hh, LAS char* wlds, const LAS char* skf) {
    const int lane = tid_() & 63, r32 = lane & 31, hi = lane >> 5;
    const unsigned char* ws = P.ws;
    const bf16_t* qp = (const bf16_t*)(ws + WS_PQ) + (size_t)(32 * tb + r32) * 2048 + hh * 256 + 8 * hi;
    float A[16], B[16];
    topk_list(qp, skf, lane, hi, A);
    topk_list(qp + 128, skf + 32768, lane, hi, B);
    LAS unsigned* my = (LAS unsigned*)(wlds + lane * 32);
#pragma unroll
    for (int w = 0; w < 4; ++w) {
        my[w] = (__float_as_uint(A[4 * w]) & 127u) | ((__float_as_uint(A[4 * w + 1]) & 127u) << 8) | ((__float_as_uint(A[4 * w + 2]) & 127u) << 16) | ((__float_as_uint(A[4 * w + 3]) & 127u) << 24);
        my[4 + w] = (__float_as_uint(B[4 * w]) & 127u) | ((__float_as_uint(B[4 * w + 1]) & 127u) << 8) | ((__float_as_uint(B[4 * w + 2]) & 127u) << 16) | ((__float_as_uint(B[4 * w + 3]) & 127u) << 24);
    }
#pragma unroll
    for (int r = 0; r < 16; ++r) { A[r] = __uint_as_float(__float_as_uint(A[r]) & 0xFFFFFF80u); B[r] = __uint_as_float(__float_as_uint(B[r]) & 0xFFFFFF80u); }
    float T[16], R1[16], X[16], Y[16];
#pragma unroll
    for (int j = 0; j < 16; ++j) { T[j] = embed8(A[0] + B[j], (unsigned)j); R1[j] = (j < 8) ? embed8(A[1] + B[j], (unsigned)(16 + j)) : -INFINITY; }
#define CAND(i, j) embed8(A[i] + B[j], (unsigned)(16 * (i) + (j)))
    X[0] = CAND(2, 0); X[1] = CAND(2, 1); X[2] = CAND(2, 2); X[3] = CAND(2, 3); X[4] = CAND(2, 4); X[5] = CAND(3, 0); X[6] = CAND(3, 1); X[7] = CAND(3, 2);
    X[8] = CAND(3, 3); X[9] = CAND(4, 0); X[10] = CAND(4, 1); X[11] = CAND(4, 2); X[12] = CAND(5, 0); X[13] = CAND(5, 1); X[14] = CAND(6, 0); X[15] = CAND(6, 1);
    Y[0] = CAND(7, 0); Y[1] = CAND(7, 1); Y[2] = CAND(8, 0); Y[3] = CAND(9, 0); Y[4] = CAND(10, 0); Y[5] = CAND(11, 0); Y[6] = CAND(12, 0); Y[7] = CAND(13, 0);
    Y[8] = CAND(14, 0); Y[9] = CAND(15, 0); Y[10] = -INFINITY; Y[11] = -INFINITY; Y[12] = -INFINITY; Y[13] = -INFINITY; Y[14] = -INFINITY; Y[15] = -INFINITY;
#undef CAND
    bitonic_sort16(X); bitonic_sort16(Y);
    merge_top16(T, R1); merge_top16(T, X); merge_top16(T, Y);
    asm volatile("s_waitcnt lgkmcnt(0)" ::: "memory");
    float ssum = 0.f, e[16]; int eid[16];
    const float t0 = __uint_as_float(__float_as_uint(T[0]) & 0xFFFFFF00u);
#pragma unroll
    for (int r = 0; r < 16; ++r) {
        const unsigned bits = __float_as_uint(T[r]); const unsigned code = bits & 255u;
        e[r] = __expf(__uint_as_float(bits & 0xFFFFFF00u) - t0); ssum += e[r];
        const int ka = ((const LAS unsigned char*)my)[code >> 4], kb_ = ((const LAS unsigned char*)my)[16 + (code & 15u)];
        eid[r] = ka * 128 + kb_;
    }
    const float inv = 1.f / ssum;
    const size_t o = (size_t)(32 * tb + r32) * 128 + hh * 16 + 8 * hi;
    int* ei = (int*)(ws + WS_EIDX) + o; float* eg = (float*)(ws + WS_EGATE) + o;
    typedef int i32x4 __attribute__((ext_vector_type(4)));
    i32x4 w0, w1; f32x4 g0, g1;
    const unsigned mh = 0u - (unsigned)hi;
#define SELU(a, b) ((((unsigned)(b)) & mh) | (((unsigned)(a)) & ~mh))
#pragma unroll
    for (int q = 0; q < 4; ++q) { w0[q] = (int)SELU(eid[q], eid[8 + q]); w1[q] = (int)SELU(eid[4 + q], eid[12 + q]);
        g0[q] = __uint_as_float(SELU(__float_as_uint(e[q]), __float_as_uint(e[8 + q]))) * inv; g1[q] = __uint_as_float(SELU(__float_as_uint(e[4 + q]), __float_as_uint(e[12 + q]))) * inv; }
#undef SELU
    *(i32x4*)ei = w0; *(i32x4*)(ei + 4) = w1; *(f32x4*)eg = g0; *(f32x4*)(eg + 4) = g1;
}

DI void topk_phase(const Params& P, char* lds_g, int bid, int nblk) {
    const int tid = tid_(), wave = __builtin_amdgcn_readfirstlane(tid >> 6);
    LAS char* lds = (LAS char*)lds_g;
    LAS char* wlds = lds + wave * 2048;
    LAS char* skf = lds + 16384;
    int cur_h = -1;
    for (int it = bid; it < (NTOK / 256) * 8; it += nblk) {
        const int hh = it & 7, tg = it >> 3;
        if (hh != cur_h) {
            __syncthreads();
#pragma unroll
            for (int i = 0; i < 8; ++i) {
                const int f = tid + 512 * i, l = f & 63, ks = (f >> 6) & 7, kb = (f >> 9) & 3, p = f >> 11;
                *(LAS u32x4*)(skf + f * 16) = *(const u32x4*)((const bf16_t*)(P.ws + WS_SKB) + (size_t)((hh * 2 + p) * 128 + 32 * kb + (l & 31)) * 128 + 16 * ks + 8 * (l >> 5));
            }
            __syncthreads();
            cur_h = hh;
        }
        topk_wave_item(P, tg * 8 + wave, hh, wlds, skf);
    }
}

DI float gelu_exact(float x) { return 0.5f * x * (1.f + erff(x * 0.70710678118654752f)); }
typedef __bf16 bf16x8_t __attribute__((ext_vector_type(8)));
DI float dot8(u32x4 a, u32x4 x, float acc) {
    const bf16x8_t a8 = __builtin_bit_cast(bf16x8_t, a), x8 = __builtin_bit_cast(bf16x8_t, x);
    acc = __builtin_amdgcn_fdot2_f32_bf16(__builtin_shufflevector(a8, a8, 0, 1), __builtin_shufflevector(x8, x8, 0, 1), acc, false);
    acc = __builtin_amdgcn_fdot2_f32_bf16(__builtin_shufflevector(a8, a8, 2, 3), __builtin_shufflevector(x8, x8, 2, 3), acc, false);
    acc = __builtin_amdgcn_fdot2_f32_bf16(__builtin_shufflevector(a8, a8, 4, 5), __builtin_shufflevector(x8, x8, 4, 5), acc, false);
    acc = __builtin_amdgcn_fdot2_f32_bf16(__builtin_shufflevector(a8, a8, 6, 7), __builtin_shufflevector(x8, x8, 6, 7), acc, false);
    return acc;
}
DI float readlane_f(float v, int l) { return __builtin_bit_cast(float, __builtin_amdgcn_readlane(__builtin_bit_cast(int, v), l)); }
DI float wave_sum_dpp(float v) {
    v = row16_sum(v);
    return (readlane_f(v, 0) + readlane_f(v, 16)) + (readlane_f(v, 32) + readlane_f(v, 48));
}

DI float dot16_fp8(u32x4 w, const f32x2 (&x)[8]) {
    f32x2 acc = __builtin_amdgcn_cvt_pk_f32_fp8((int)w.x, false) * x[0];
    acc = __builtin_amdgcn_cvt_pk_f32_fp8((int)w.x, true) * x[1] + acc;
    acc = __builtin_amdgcn_cvt_pk_f32_fp8((int)w.y, false) * x[2] + acc;
    acc = __builtin_amdgcn_cvt_pk_f32_fp8((int)w.y, true) * x[3] + acc;
    acc = __builtin_amdgcn_cvt_pk_f32_fp8((int)w.z, false) * x[4] + acc;
    acc = __builtin_amdgcn_cvt_pk_f32_fp8((int)w.z, true) * x[5] + acc;
    acc = __builtin_amdgcn_cvt_pk_f32_fp8((int)w.w, false) * x[6] + acc;
    acc = __builtin_amdgcn_cvt_pk_f32_fp8((int)w.w, true) * x[7] + acc;
    return acc.x + acc.y;
}
DI void peer_hid_phase(const Params& P, int bid, int nblk) {
    const int tid = tid_(), lane = tid & 63, wave = __builtin_amdgcn_readfirstlane(tid >> 6);
    const unsigned char* ws = P.ws;
    const unsigned char* U8 = ws + WS_UB; const float* USC = (const float*)(ws + WS_USC);
    const int gw = bid * NWAVES + wave, NGW = nblk * NWAVES;
    f32x4 wv[4];
#pragma unroll
    for (int q = 0; q < 4; ++q) wv[q] = *(const f32x4*)(P.ffn_norm_w + 16 * lane + 4 * q);
    for (int n = gw; n < NTOK; n += NGW) {
        const float* hrow = P.out + (size_t)n * DM + 16 * lane;
        f32x4 h[4]; float ss = 0.f;
#pragma unroll
        for (int q = 0; q < 4; ++q) { h[q] = *(const f32x4*)(hrow + 4 * q); ss += (h[q].x * h[q].x + h[q].y * h[q].y) + (h[q].z * h[q].z + h[q].w * h[q].w); }
        ss = wave_sum_dpp(ss);
        const float r2 = 1.f / sqrtf(ss * (1.f / DM) + EPS);
        f32x2 x[8];
#pragma unroll
        for (int q = 0; q < 4; ++q) { const f32x4 t = h[q] * wv[q] * r2; x[2 * q] = (f32x2){t.x, t.y}; x[2 * q + 1] = (f32x2){t.z, t.w}; }
        const int* eidx = (const int*)(ws + WS_EIDX) + (size_t)n * 128;
        const float* egate = (const float*)(ws + WS_EGATE) + (size_t)n * 128;
        const int id0 = eidx[lane], id1 = eidx[64 + lane];
        float hid0 = 0.f, hid1 = 0.f;
#pragma unroll 1
        for (int k0 = 0; k0 < 128; k0 += 16) {
            u32x4 ra[16]; float sc[16];
#pragma unroll
            for (int e = 0; e < 16; ++e) {
                const int k = k0 + e;
                const int id = (k0 < 64) ? __builtin_amdgcn_readlane(id0, k & 63) : __builtin_amdgcn_readlane(id1, k & 63);
                ra[e] = *(const u32x4*)(U8 + (size_t)id * DM + 16 * lane); sc[e] = USC[id];
            }
#pragma unroll
            for (int e = 0; e < 16; ++e) {
                const int k = k0 + e;
                const float d = wave_sum_dpp(dot16_fp8(ra[e], x)) * sc[e];
                if (k0 < 64) { if (lane == (k & 63)) hid0 = d; } else { if (lane == (k & 63)) hid1 = d; }
            }
        }
        float* hid = (float*)(ws + WS_HID) + (size_t)n * 128;
        hid[lane] = gelu_exact(hid0) * egate[lane];
        hid[64 + lane] = gelu_exact(hid1) * egate[64 + lane];
    }
}

DI void peer_out_phase(const Params& P, int bid, int nblk) {
    const int tid = tid_(), lane = tid & 63, wave = __builtin_amdgcn_readfirstlane(tid >> 6);
    const unsigned char* ws = P.ws;
    const unsigned char* V8 = ws + WS_VB; const float* VSC = (const float*)(ws + WS_VSC);
    const int gw = bid * NWAVES + wave, NGW = nblk * NWAVES;
    f32x4 wv[4];
#pragma unroll
    for (int q = 0; q < 4; ++q) wv[q] = *(const f32x4*)(P.final_w + 16 * lane + 4 * q);
    for (int n = gw; n < NTOK; n += NGW) {
        const int* eidx = (const int*)(ws + WS_EIDX) + (size_t)n * 128;
        const float* hid = (const float*)(ws + WS_HID) + (size_t)n * 128;
        const int id0 = eidx[lane], id1 = eidx[64 + lane];
        const float c0 = hid[lane], c1 = hid[64 + lane];
        f32x2 acc[8];
#pragma unroll
        for (int i = 0; i < 8; ++i) acc[i] = (f32x2){0.f, 0.f};
#pragma unroll 1
        for (int k0 = 0; k0 < 128; k0 += 16) {
            u32x4 ra[16]; float cf[16];
#pragma unroll
            for (int e = 0; e < 16; ++e) {
                const int k = k0 + e;
                const int id = (k0 < 64) ? __builtin_amdgcn_readlane(id0, k & 63) : __builtin_amdgcn_readlane(id1, k & 63);
                cf[e] = ((k0 < 64) ? readlane_f(c0, k & 63) : readlane_f(c1, k & 63)) * VSC[id];
                ra[e] = *(const u32x4*)(V8 + (size_t)id * DM + 16 * lane);
            }
#pragma unroll
            for (int e = 0; e < 16; ++e) {
                const f32x2 c = (f32x2){cf[e], cf[e]}; const u32x4 w = ra[e];
                acc[0] = __builtin_amdgcn_cvt_pk_f32_fp8((int)w.x, false) * c + acc[0]; acc[1] = __builtin_amdgcn_cvt_pk_f32_fp8((int)w.x, true) * c + acc[1];
                acc[2] = __builtin_amdgcn_cvt_pk_f32_fp8((int)w.y, false) * c + acc[2]; acc[3] = __builtin_amdgcn_cvt_pk_f32_fp8((int)w.y, true) * c + acc[3];
                acc[4] = __builtin_amdgcn_cvt_pk_f32_fp8((int)w.z, false) * c + acc[4]; acc[5] = __builtin_amdgcn_cvt_pk_f32_fp8((int)w.z, true) * c + acc[5];
                acc[6] = __builtin_amdgcn_cvt_pk_f32_fp8((int)w.w, false) * c + acc[6]; acc[7] = __builtin_amdgcn_cvt_pk_f32_fp8((int)w.w, true) * c + acc[7];
            }
        }
        float* orow = P.out + (size_t)n * DM + 16 * lane;
        f32x4 h[4]; float ss = 0.f;
#pragma unroll
        for (int q = 0; q < 4; ++q) { h[q] = *(const f32x4*)(orow + 4 * q) + (f32x4){acc[2 * q].x, acc[2 * q].y, acc[2 * q + 1].x, acc[2 * q + 1].y}; ss += (h[q].x * h[q].x + h[q].y * h[q].y) + (h[q].z * h[q].z + h[q].w * h[q].w); }
        ss = wave_sum_dpp(ss);
        const float rs = 1.f / sqrtf(ss * (1.f / DM) + EPS);
#pragma unroll
        for (int q = 0; q < 4; ++q) *(f32x4*)(orow + 4 * q) = h[q] * wv[q] * rs;
    }
}

#ifdef DBG_CHECK
DI void dbg_max(float* slot, float v) { atomicMax((unsigned*)slot, __float_as_uint(fmaxf(v, 0.f))); }
DI void dbg_check_topk(const Params& P, char* lds_g, int bid, int nblk) {
    LAS char* lds = (LAS char*)lds_g;
    const int tid = tid_(), lane = tid & 63, wave = __builtin_amdgcn_readfirstlane(tid >> 6);
    const unsigned char* ws = P.ws; float* dbg = (float*)(ws + WS_CTL) + 64;
    LAS float* sc = (LAS float*)(lds) + wave * 1024;
    const int gw = bid * NWAVES + wave;
    const int token = (gw * 37) % NTOK, hh = gw & 7;
    for (int p = 0; p < 2; ++p) for (int kk = 0; kk < 2; ++kk) {
        const int key = lane + 64 * kk; float a = 0.f;
        const bf16_t* q = (const bf16_t*)(ws + WS_PQ) + (size_t)token * 2048 + hh * 256 + p * 128;
        const bf16_t* sk = (const bf16_t*)(ws + WS_SKB) + (size_t)((hh * 2 + p) * 128 + key) * 128;
        for (int c = 0; c < 128; ++c) a += bf2f(q[c]) * bf2f(sk[c]);
        sc[p * 128 + key] = a;
    }
    asm volatile("s_waitcnt lgkmcnt(0)" ::: "memory");
    for (int p = 0; p < 2; ++p) for (int kk = 0; kk < 2; ++kk) {
        const int key = lane + 64 * kk; const float v = sc[p * 128 + key]; int rank = 0;
        for (int o = 0; o < 128; ++o) { const float w = sc[p * 128 + o]; rank += (w > v || (w == v && o < key)) ? 1 : 0; }
        if (rank < 16) { sc[256 + p * 16 + rank] = v; sc[288 + p * 16 + rank] = __int_as_float(key); }
    }
    asm volatile("s_waitcnt lgkmcnt(0)" ::: "memory");
    for (int e = 0; e < 4; ++e) {
        const int c = lane * 4 + e, i = c >> 4, j = c & 15; const float v = sc[256 + i] + sc[272 + j]; int rank = 0;
        for (int o = 0; o < 256; ++o) { const float w = sc[256 + (o >> 4)] + sc[272 + (o & 15)]; rank += (w > v || (w == v && o < c)) ? 1 : 0; }
        if (rank < 16) { sc[320 + rank] = __int_as_float(__float_as_int(sc[288 + i]) * 128 + __float_as_int(sc[304 + j])); sc[336 + rank] = v; }
    }
    asm volatile("s_waitcnt lgkmcnt(0)" ::: "memory");
    if (lane < 16) {
        const int eid = __float_as_int(sc[320 + lane]); const float sv = sc[336 + lane];
        float mx = sc[336], sum = 0.f; for (int o = 0; o < 16; ++o) sum += __expf(sc[336 + o] - mx);
        const float gate = __expf(sv - mx) / sum;
        const int* eidx = (const int*)(ws + WS_EIDX) + (size_t)token * 128 + hh * 16; const float* eg = (const float*)(ws + WS_EGATE) + (size_t)token * 128 + hh * 16;
        int found = -1; for (int o = 0; o < 16; ++o) if (eidx[o] == eid) found = o;
        if (found < 0) atomicAdd(dbg + 0, 1.f); else dbg_max(dbg + 1, fabsf(eg[found] - gate));
    }
    if (lane == 0) atomicAdd(dbg + 2, 16.f);
}
DI void dbg_check_hid(const Params& P, int bid, int nblk) {
    const int tid = tid_(), lane = tid & 63, wave = __builtin_amdgcn_readfirstlane(tid >> 6);
    const unsigned char* ws = P.ws; float* dbg = (float*)(ws + WS_CTL) + 64;
    const int gw = bid * NWAVES + wave; const int token = (gw * 53) % NTOK;
    const float* hrow = P.out + (size_t)token * DM;
    float ss = 0.f; for (int c = lane; c < DM; c += 64) ss += hrow[c] * hrow[c];
    ss = wave_sum(ss); const float r2 = 1.f / sqrtf(ss / DM + EPS);
    for (int kk = 0; kk < 2; ++kk) {
        const int k = lane + 64 * kk; const int eid = ((const int*)(ws + WS_EIDX))[(size_t)token * 128 + k];
        const float* urow = P.pu + (size_t)eid * DM; float d = 0.f;
        for (int c = 0; c < DM; ++c) d += urow[c] * (hrow[c] * r2 * P.ffn_norm_w[c]);
        const float hidv = gelu_exact(d) * ((const float*)(ws + WS_EGATE))[(size_t)token * 128 + k];
        const float got = ((const float*)(ws + WS_HID))[(size_t)token * 128 + k];
        dbg_max(dbg + 3, fabsf(got - hidv)); dbg_max(dbg + 4, fabsf(hidv));
    }
}
DI float dbg_enc(float m) { return 8.f + log10f(fmaxf(m, 1e-8f)); }
#endif

#ifdef DBG_CHECK
DI void dbg_check_attn(const Params& P, int bid, int nblk) {
    const int tid = tid_(), lane = tid & 63, wave = __builtin_amdgcn_readfirstlane(tid >> 6);
    const unsigned char* ws = P.ws; float* dbg = (float*)(ws + WS_CTL) + 64;
    const int gw = bid * NWAVES + wave;
    const unsigned hsh = (unsigned)gw * 2654435761u;
    const int b = (hsh >> 8) & 7, h = (hsh >> 11) & 3, i = (int)((hsh >> 13) % 4096u), bh = b * 4 + h;
    const float lam = ((const float*)(ws + WS_LB))[512];
    float oc[2][2], lsum[2], mx[2];
    for (int c = 0; c < 2; ++c) { oc[c][0] = oc[c][1] = 0.f; lsum[c] = 0.f; mx[c] = -1e30f; }
    for (int pp = KPAD; pp <= 64 + i; ++pp) {
        const int tile = pp >> 6, key = pp & 63;
        for (int c = 0; c < 2; ++c) {
            const bf16_t* q = (const bf16_t*)(ws + WS_Q) + ((size_t)((bh * 2 + c) * SEQ + i)) * 64;
            const unsigned char* kimg = ws + WS_K + ((size_t)(bh * 2 + c) * KT + tile) * 8192;
            float sdot = 0.f;
            for (int d = 0; d < 64; ++d) sdot += bf2f(q[d]) * bf2f(*(const bf16_t*)(kimg + (d >> 3) * 1024 + key * 16 + (d & 7) * 2));
            const float mn = fmaxf(mx[c], sdot), al = exp2f(mx[c] - mn), pe = exp2f(sdot - mn);
            const unsigned char* vimg = ws + WS_V + ((size_t)bh * KT + tile) * 16384;
            for (int e = 0; e < 2; ++e) { const int dv = lane + 64 * e; oc[c][e] = oc[c][e] * al + pe * bf2f(*(const bf16_t*)(vimg + (dv >> 5) * 4096 + key * 64 + (dv & 31) * 2)); }
            lsum[c] = lsum[c] * al + pe; mx[c] = mn;
        }
    }
    float o[2], ss = 0.f;
    for (int e = 0; e < 2; ++e) { o[e] = oc[0][e] / lsum[0] - lam * oc[1][e] / lsum[1]; ss += o[e] * o[e]; }
    ss = wave_sum(ss); const float rs = (1.f - LAM_INIT) / sqrtf(ss / 128.f + EPS);
    for (int e = 0; e < 2; ++e) { const int dv = lane + 64 * e; const float want = o[e] * rs * P.subln_w[dv];
        const float got = bf2f(((const bf16_t*)(ws + WS_MIX))[(size_t)(b * SEQ + i) * DM + h * 128 + dv]);
        dbg_max(dbg + 5, fabsf(got - want)); dbg_max(dbg + 6, fabsf(want)); }
}
DI void dbg_check_hgrn(const Params& P, char* lds_g, int bid, int nblk) {
    if (bid >= 32) return;
    LAS float* L = (LAS float*)lds_g;
    const int tid = tid_(), dv = tid & 127, qt = tid >> 7;
    const unsigned char* ws = P.ws; float* dbg = (float*)(ws + WS_CTL) + 64;
    const int bh = bid, b = bid >> 2, h = bid & 3;
    const float* HG = (const float*)(ws + WS_HG) + (size_t)bh * HT * 128;
    const bf16_t* HQ = (const bf16_t*)(ws + WS_HQ) + (size_t)bh * HT * 128;
    const bf16_t* HV = (const bf16_t*)(ws + WS_HV) + (size_t)bh * HT * 128;
    float S[32];
#pragma unroll
    for (int j = 0; j < 32; ++j) S[j] = 0.f;
    for (int pp = 16; pp < HT; ++pp) {
        if (tid < 128) { L[tid] = __expf(HG[(size_t)pp * 128 + tid]); L[128 + tid] = bf2f(HQ[(size_t)pp * 128 + tid]); L[256 + tid] = bf2f(HV[(size_t)pp * 128 + tid]); }
        __syncthreads();
        const float v = L[256 + dv]; float part = 0.f;
#pragma unroll
        for (int j = 0; j < 32; ++j) { const float f = L[32 * qt + j]; S[j] = f * S[j] + (1.f - f) * v; part += L[128 + 32 * qt + j] * S[j]; }
        L[384 + qt * 128 + dv] = part;
        __syncthreads();
        if (tid < 128) { const float o = L[384 + dv] + L[512 + dv] + L[640 + dv] + L[768 + dv]; L[896 + dv] = o; }
        __syncthreads();
        if (tid < 128 && pp >= 32) {
            float ss = 0.f; for (int j = 0; j < 128; ++j) ss += L[896 + j] * L[896 + j];
            const float rs = 1.f / sqrtf(ss / 128.f + EPS);
            const size_t row = (size_t)b * SEQ + (pp - 32);
            const float want = L[896 + dv] * rs * P.rec_norm_w[h * 128 + dv] * bf2f(((const bf16_t*)(ws + WS_SG))[row * 512 + h * 128 + dv]);
            const float got = bf2f(((const bf16_t*)(ws + WS_MIX))[row * DM + 512 + h * 128 + dv]);
            dbg_max(dbg + 7, fabsf(got - want)); dbg_max(dbg + 8, fabsf(want));
        }
        __syncthreads();
    }
}
#endif

#ifdef DBG_CHECK
DI float dbg_proj(const Params& P, int m, int c) {
    const float* xrow = (m < NTOK) ? P.x + (size_t)m * DM : P.meta + (size_t)(m - NTOK) * DM;
    float ss = 0.f, a = 0.f;
    for (int k = 0; k < DM; ++k) { const float xv = xrow[k]; ss += xv * xv; a += xv * P.mix_norm_w[k] * P.w_in[(size_t)k * NCOL1 + c]; }
    return a / sqrtf(ss / DM + EPS);
}
DI void dbg_check_gemm1(const Params& P, int bid, int nblk) {
    const unsigned char* ws = P.ws; float* dbg = (float*)(ws + WS_CTL) + 64;
    const int gt = bid * NTHREADS + tid_();
    if (gt >= 7 * 4096) return;
    const unsigned hsh = (unsigned)gt * 2654435761u;
    const int seg = gt % 7, cs = (hsh >> 7) & 511;
    const bool meta = ((gt / 7) & 15) == 0;
    const int m = meta ? NTOK + ((hsh >> 20) & 15) : (int)((hsh >> 3) % (unsigned)NTOK);
    const int b = meta ? (int)((hsh >> 25) & 7) : (m >> 12), t = meta ? (m - NTOK) : ((m & 4095) + NMETA);
    const int h = cs >> 7;
    float want = 0.f, got = 0.f;
    if (seg <= 1) {
        if (seg == 0 && meta) return;
        const int comp = (cs >> 6) & 1, d = cs & 63, dlo = d & 31;
        const float zlo = dbg_proj(P, m, seg * 512 + (cs & ~63) + dlo), zhi = dbg_proj(P, m, seg * 512 + (cs & ~63) + dlo + 32);
        const double inv = exp2(-(double)dlo * (13.287712379549449 / 32.0)); const float cv = (float)cos((double)t * inv), sv = (float)sin((double)t * inv);
        want = (d < 32) ? zlo * cv - zhi * sv : zhi * cv + zlo * sv;
        if (seg == 0) { want *= QSCALE; got = bf2f(((const bf16_t*)(ws + WS_Q))[((size_t)(((b * 4 + h) * 2 + comp) * SEQ + (m & 4095))) * 64 + d]); }
        else { const int pp = t + KPAD; got = bf2f(*(const bf16_t*)(ws + WS_K + ((size_t)((b * 4 + h) * 2 + comp) * KT + (pp >> 6)) * 8192 + (d >> 3) * 1024 + (pp & 63) * 16 + (d & 7) * 2)); }
    } else {
        const float z = dbg_proj(P, m, seg * 512 + cs); const int dv = cs & 127;
        if (seg == 2) { const int pp = t + KPAD; want = z; got = bf2f(*(const bf16_t*)(ws + WS_V + ((size_t)(b * 4 + h) * KT + (pp >> 6)) * 16384 + (dv >> 5) * 4096 + (pp & 63) * 64 + (dv & 31) * 2)); }
        else if (seg == 3) { want = siluf_(z); got = bf2f(((const bf16_t*)(ws + WS_HQ))[((size_t)(b * 4 + h) * HT + t + 16) * 128 + dv]); }
        else if (seg == 4) { const float l0 = P.lb_logits[cs], l1 = P.lb_logits[512 + cs], lb = __expf(l0) / (__expf(l0) + __expf(l1)); want = __logf(lb + (1.f - lb) * sigmoidf_(z)); got = ((const float*)(ws + WS_HG))[((size_t)(b * 4 + h) * HT + t + 16) * 128 + dv]; }
        else if (seg == 5) { want = z; got = bf2f(((const bf16_t*)(ws + WS_HV))[((size_t)(b * 4 + h) * HT + t + 16) * 128 + dv]); }
        else { if (meta) return; want = siluf_(z); got = bf2f(((const bf16_t*)(ws + WS_SG))[(size_t)m * 512 + cs]); }
    }
    dbg_max(dbg + 16 + seg + (meta ? 8 : 0), fabsf(got - want));
}
#endif
typedef unsigned u32x4v __attribute__((vector_size(16)));
DI float oct_sum(float v) {
    v += dpp_f<0xB1>(v); v += dpp_f<0x4E>(v); v += dpp_f<0x141>(v); return v;
}
DI unsigned my_xcc_id() { return (unsigned)__builtin_amdgcn_s_getreg((3 << 11) | 20) & 7u; }
constexpr int CTL_G1 = 16, CTL_G2 = 32;

DI void xn8_rows(const Params& P, int bid, int nblk) {
    const int tid = tid_(), lane = tid & 63, wave = __builtin_amdgcn_readfirstlane(tid >> 6);
    unsigned char* ws = P.ws;
    const int gw = bid * NWAVES + wave, NGW = nblk * NWAVES;
    f32x4 wv[4];
#pragma unroll
    for (int q = 0; q < 4; ++q) wv[q] = *(const f32x4*)(P.ffn_norm_w + 16 * lane + 4 * q);
    for (int n = gw; n < NTOK; n += NGW) {
        const bf16_t* hrow = (const bf16_t*)(ws + WS_XB) + (size_t)n * DM + 16 * lane;
        const float r2 = 1.f / sqrtf(((const float*)(ws + WS_SSQ))[n] * (1.f / DM) + EPS);
        const u32x4 ha = *(const u32x4*)hrow, hb = *(const u32x4*)(hrow + 8);
        const unsigned hu[8] = {ha.x, ha.y, ha.z, ha.w, hb.x, hb.y, hb.z, hb.w};
        f32x4 t[4]; float am = 0.f;
#pragma unroll
        for (int q = 0; q < 4; ++q) { t[q] = (f32x4){bf2f(hu[2 * q] & 0xffffu), bf2f(hu[2 * q] >> 16), bf2f(hu[2 * q + 1] & 0xffffu), bf2f(hu[2 * q + 1] >> 16)} * wv[q] * r2; am = fmaxf(am, fmaxf(fmaxf(fabsf(t[q].x), fabsf(t[q].y)), fmaxf(fabsf(t[q].z), fabsf(t[q].w)))); }
        am = row16_max(am); am = fmaxf(fmaxf(readlane_f(am, 0), readlane_f(am, 16)), fmaxf(readlane_f(am, 32), readlane_f(am, 48)));
        const float sc = (am > 0.f) ? exp2f(floorf(log2f(224.f / am))) : 1.f;
        int w[4];
#pragma unroll
        for (int q = 0; q < 4; ++q) { w[q] = __builtin_amdgcn_cvt_pk_fp8_f32(t[q].x * sc, t[q].y * sc, 0, false); w[q] = __builtin_amdgcn_cvt_pk_fp8_f32(t[q].z * sc, t[q].w * sc, w[q], true); }
        *(u32x4*)(ws + WS_XN8 + (size_t)n * DM + 16 * lane) = (u32x4){(unsigned)w[0], (unsigned)w[1], (unsigned)w[2], (unsigned)w[3]};
        if (lane == 0) ((float*)(ws + WS_XSC))[n] = 1.f / sc;
    }
}
typedef int i32x4 __attribute__((ext_vector_type(4)));
struct GMeta { i32x4 id[4]; f32x4 c[4]; u32x4 xq; };
template <int WHICH>
DI void g_meta(const Params& P, int n, int x, GMeta& M) {
    const int lane = tid_() & 63, i = lane & 7, g = lane >> 3;
    const i32x4* ip = (const i32x4*)((const int*)(P.ws + WS_EIDX) + (size_t)n * 128 + 16 * g);
#pragma unroll
    for (int q = 0; q < 4; ++q) M.id[q] = ip[q];
    if (WHICH == 1) M.xq = *(const u32x4*)(P.ws + WS_XN8 + (size_t)n * DM + 128 * x + 16 * i);
    else { const f32x4* cp = (const f32x4*)((const float*)(P.ws + WS_HID) + (size_t)n * 128 + 16 * g);
#pragma unroll
        for (int q = 0; q < 4; ++q) M.c[q] = cp[q]; }
}
DI void g_issue(int x, const GMeta& M, u32x4v (&rw)[16], __amdgpu_buffer_rsrc_t rs) {
    const int i = tid_() & 7;
    const unsigned lo = (unsigned)x * (unsigned)(NEXP * 128) + (unsigned)(16 * i);
#pragma unroll
    for (int j = 0; j < 16; ++j) rw[j] = __builtin_amdgcn_raw_buffer_load_b128(rs, ((unsigned)M.id[j >> 2][j & 3] << 7) + lo, 0, 0);
}
DI void g1_finish(const Params& P, int n, int x, u32x4 xq, const u32x4v (&rw)[16]) {
    const int lane = tid_() & 63, i = lane & 7, g = lane >> 3;
    f32x2 xv[8];
    xv[0] = __builtin_amdgcn_cvt_pk_f32_fp8((int)xq.x, false); xv[1] = __builtin_amdgcn_cvt_pk_f32_fp8((int)xq.x, true);
    xv[2] = __builtin_amdgcn_cvt_pk_f32_fp8((int)xq.y, false); xv[3] = __builtin_amdgcn_cvt_pk_f32_fp8((int)xq.y, true);
    xv[4] = __builtin_amdgcn_cvt_pk_f32_fp8((int)xq.z, false); xv[5] = __builtin_amdgcn_cvt_pk_f32_fp8((int)xq.z, true);
    xv[6] = __builtin_amdgcn_cvt_pk_f32_fp8((int)xq.w, false); xv[7] = __builtin_amdgcn_cvt_pk_f32_fp8((int)xq.w, true);
    float pd[16];
#pragma unroll
    for (int j = 0; j < 16; ++j) pd[j] = dot16_fp8(__builtin_bit_cast(u32x4, rw[j]), xv);
    const unsigned m1 = 0u - (unsigned)((i >> 2) & 1), m2 = 0u - (unsigned)(i & 1), m3 = 0u - (unsigned)((i >> 1) & 1);
#define BSEL(a, b, m) __uint_as_float((__float_as_uint(a) & ~(m)) | (__float_as_uint(b) & (m)))
    float z[8], w[4], u[2];
#pragma unroll
    for (int q = 0; q < 8; ++q) { const float snd = BSEL(pd[q + 8], pd[q], m1), kep = BSEL(pd[q], pd[q + 8], m1); z[q] = kep + dpp_f<0x141>(snd); }
#pragma unroll
    for (int q = 0; q < 4; ++q) { const float snd = BSEL(z[q + 4], z[q], m2), kep = BSEL(z[q], z[q + 4], m2); w[q] = kep + dpp_f<0xB1>(snd); }
#pragma unroll
    for (int q = 0; q < 2; ++q) { const float snd = BSEL(w[q + 2], w[q], m3), kep = BSEL(w[q], w[q + 2], m3); u[q] = kep + dpp_f<0x4E>(snd); }
    const int j0 = 8 * ((i >> 2) & 1) + 4 * (i & 1) + 2 * ((i >> 1) & 1);
#undef BSEL
    *(f32x2*)((float*)(P.ws + WS_HIDP) + ((size_t)x * NTOK + n) * 128 + 16 * g + j0) = (f32x2){u[0], u[1]};
}
DI void g2_finish(const Params& P, int n, int x, const f32x4 (&cv)[4], const u32x4v (&rw)[16]) {
    const int lane = tid_() & 63, i = lane & 7, g = lane >> 3;
    f32x2 acc[8];
#pragma unroll
    for (int q = 0; q < 8; ++q) acc[q] = (f32x2){0.f, 0.f};
#pragma unroll
    for (int j = 0; j < 16; ++j) {
        const float cj = cv[j >> 2][j & 3]; const f32x2 c = (f32x2){cj, cj}; const u32x4 w = __builtin_bit_cast(u32x4, rw[j]);
        acc[0] = __builtin_amdgcn_cvt_pk_f32_fp8((int)w.x, false) * c + acc[0]; acc[1] = __builtin_amdgcn_cvt_pk_f32_fp8((int)w.x, true) * c + acc[1];
        acc[2] = __builtin_amdgcn_cvt_pk_f32_fp8((int)w.y, false) * c + acc[2]; acc[3] = __builtin_amdgcn_cvt_pk_f32_fp8((int)w.y, true) * c + acc[3];
        acc[4] = __builtin_amdgcn_cvt_pk_f32_fp8((int)w.z, false) * c + acc[4]; acc[5] = __builtin_amdgcn_cvt_pk_f32_fp8((int)w.z, true) * c + acc[5];
        acc[6] = __builtin_amdgcn_cvt_pk_f32_fp8((int)w.w, false) * c + acc[6]; acc[7] = __builtin_amdgcn_cvt_pk_f32_fp8((int)w.w, true) * c + acc[7];
    }
    float y[16], z[8], w[4];
#pragma unroll
    for (int q = 0; q < 8; ++q) { y[2 * q] = acc[q].x; y[2 * q + 1] = acc[q].y; }
#pragma unroll
    for (int q = 0; q < 8; ++q) { auto rr = __builtin_amdgcn_permlane32_swap(__float_as_uint(y[q]), __float_as_uint(y[q + 8]), false, false); z[q] = __uint_as_float(rr[0]) + __uint_as_float(rr[1]); }
#pragma unroll
    for (int q = 0; q < 4; ++q) { auto rr = __builtin_amdgcn_permlane16_swap(__float_as_uint(z[q]), __float_as_uint(z[q + 4]), false, false); w[q] = __uint_as_float(rr[0]) + __uint_as_float(rr[1]); }
    const unsigned m3 = 0u - (unsigned)(g & 1);
#define BSEL(a, b, m) __uint_as_float((__float_as_uint(a) & ~(m)) | (__float_as_uint(b) & (m)))
    const float k0 = BSEL(w[0], w[2], m3) + dpp_f<0x128>(BSEL(w[2], w[0], m3)), k1 = BSEL(w[1], w[3], m3) + dpp_f<0x128>(BSEL(w[3], w[1], m3));
#undef BSEL
    float* hp = P.out + (size_t)n * DM + 128 * x + 16 * i + 2 * g;
    const f32x2 t = *(const f32x2*)hp + (f32x2){k0, k1}; *(f32x2*)hp = t;
    const float ss = wave_sum_dpp(t.x * t.x + t.y * t.y);
    if (lane == 0) atomicAdd((float*)(P.ws + WS_SSQ2) + n, ss);
}
constexpr int SL_CHUNK = 128, SL_T = SL_CHUNK / NWAVES;
#define SB() __builtin_amdgcn_sched_barrier(0)
template <int WHICH>
DI void g_chunk(const Params& P, int nbase, int x, __amdgpu_buffer_rsrc_t rs) {
    GMeta MA, MB; u32x4v RA[16], RB[16];
    g_meta<WHICH>(P, nbase, x, MA); SB(); g_meta<WHICH>(P, nbase + 8, x, MB); SB(); g_issue(x, MA, RA, rs); SB();
#pragma unroll
    for (int t = 0; t < SL_T; t += 2) {
        const u32x4 xA = MA.xq; const f32x4 cA[4] = {MA.c[0], MA.c[1], MA.c[2], MA.c[3]};
        if (t + 2 < SL_T) { g_meta<WHICH>(P, nbase + 8 * (t + 2), x, MA); SB(); }
        g_issue(x, MB, RB, rs); SB();
        if (WHICH == 1) g1_finish(P, nbase + 8 * t, x, xA, RA); else g2_finish(P, nbase + 8 * t, x, cA, RA);
        SB();
        const u32x4 xB = MB.xq; const f32x4 cB[4] = {MB.c[0], MB.c[1], MB.c[2], MB.c[3]};
        if (t + 3 < SL_T) { g_meta<WHICH>(P, nbase + 8 * (t + 3), x, MB); SB(); }
        if (t + 2 < SL_T) { g_issue(x, MA, RA, rs); SB(); }
        if (WHICH == 1) g1_finish(P, nbase + 8 * (t + 1), x, xB, RB); else g2_finish(P, nbase + 8 * (t + 1), x, cB, RB);
        SB();
    }
}
template <int WHICH>
DI void sliced_phase(const Params& P, char* lds_g) {
    const int tid = tid_(), wave = __builtin_amdgcn_readfirstlane(tid >> 6);
    unsigned* ctr = (unsigned*)(P.ws + WS_CTL) + (WHICH == 1 ? CTL_G1 : CTL_G2);
    const __amdgpu_buffer_rsrc_t rs = __builtin_amdgcn_make_buffer_rsrc((void*)(P.ws + (WHICH == 1 ? WS_UB : WS_VB)), 0, NEXP * DM, 0x00020000);
    const int x0 = (int)my_xcc_id();
    LAS int* slot = (LAS int*)((LAS char*)lds_g + LDS_ITEM);
    for (int s = 0; s < 8; ++s) {
        const int x = (x0 + s) & 7;
        for (;;) {
            if (tid == 0) *slot = (int)atomicAdd(ctr + x, 1u);
            __syncthreads();
            const int chunk = *slot;
            __syncthreads();
            if (chunk >= NTOK / SL_CHUNK) break;
            g_chunk<WHICH>(P, chunk * SL_CHUNK + wave, x, rs);
        }
    }
}
DI void hid_reduce_phase(const Params& P, int bid, int nblk) {
    const unsigned char* ws = P.ws;
    const size_t gt = (size_t)bid * NTHREADS + tid_(), NGT = (size_t)nblk * NTHREADS;
    const float* hp = (const float*)(ws + WS_HIDP);
    for (size_t o = gt; o < (size_t)NTOK * 128; o += NGT) {
        float a = 0.f;
#pragma unroll
        for (int x = 0; x < 8; ++x) a += hp[(size_t)x * NTOK * 128 + o];
        const int e = ((const int*)(ws + WS_EIDX))[o];
        const float d = a * ((const float*)(ws + WS_USC))[e] * ((const float*)(ws + WS_XSC))[o >> 7];
        ((float*)(ws + WS_HID))[o] = gelu_exact(d) * ((const float*)(ws + WS_EGATE))[o] * ((const float*)(ws + WS_VSC))[e];
    }
}
DI void final_norm_phase(const Params& P, int bid, int nblk) {
    const size_t gt = (size_t)bid * NTHREADS + tid_(), NGT = (size_t)nblk * NTHREADS;
    const float* ssq = (const float*)(P.ws + WS_SSQ2);
    for (size_t o = gt; o < (size_t)NTOK * DM / 4; o += NGT) {
        const size_t n = o >> 8; const int c4 = (int)(o & 255);
        const float rs = 1.f / sqrtf(ssq[n] * (1.f / DM) + EPS);
        f32x4* pp = (f32x4*)P.out + o;
        *pp = *pp * ((const f32x4*)P.final_w)[c4] * rs;
    }
}

typedef long i64_t;
constexpr int MG_HALF = 8192, MG_WAVE = 2 * MG_HALF;
#define MG_WAIT(N) asm volatile("s_waitcnt vmcnt(" #N ")" ::: "memory")
struct MgMeta { i32x4 id[4]; u32x4 a0, a1, a2, a3; };
template <int WHICH>
DI void mg_meta(const Params& P, int n, int x, MgMeta& M) {
    const int lane = tid_() & 63, g8 = lane >> 3, kg = lane >> 4;
    const int* ip = (const int*)(P.ws + WS_EIDX) + (size_t)n * 128 + 8 * g8;
    M.id[0] = *(const i32x4*)ip; M.id[1] = *(const i32x4*)(ip + 4); M.id[2] = *(const i32x4*)(ip + 64); M.id[3] = *(const i32x4*)(ip + 68);
    if (WHICH == 1) { const unsigned char* xr = P.ws + WS_XN8 + (size_t)n * DM + 256 * x + 16 * kg;
        M.a0 = *(const u32x4*)xr; M.a1 = *(const u32x4*)(xr + 64); M.a2 = *(const u32x4*)(xr + 128); M.a3 = *(const u32x4*)(xr + 192); }
    else { const unsigned char* cr = P.ws + WS_C8 + ((size_t)x * NTOK + n) * 128 + 16 * kg;
        M.a0 = *(const u32x4*)cr; M.a1 = *(const u32x4*)(cr + 64); }
}
DI void mg_issue(const unsigned char* slice, const MgMeta& M, int h, unsigned lbase) {
    const int lane = tid_() & 63, pos = lane & 7;
    const i32x4 ia = M.id[2 * h], ib = M.id[2 * h + 1];
    const int ids[8] = {ia.x, ia.y, ia.z, ia.w, ib.x, ib.y, ib.z, ib.w};
#pragma unroll
    for (int p = 0; p < 8; ++p) glds16_asm(slice + (size_t)(unsigned)ids[p] * 128 + 16 * (pos ^ p), lbase + p * 1024);
}
DI i64_t pk64(unsigned lo, unsigned hi) { return (i64_t)(((unsigned long long)hi << 32) | lo); }
typedef int i32x8 __attribute__((ext_vector_type(8)));
DI float mg1_half(const MgMeta& M, LAS char* hb) {
    const int lane = tid_() & 63, c = lane & 15, kg = lane >> 4;
    const i32x8 A0 = (i32x8){(int)M.a0.x, (int)M.a0.y, (int)M.a0.z, (int)M.a0.w, (int)M.a1.x, (int)M.a1.y, (int)M.a1.z, (int)M.a1.w};
    const i32x8 A1 = (i32x8){(int)M.a2.x, (int)M.a2.y, (int)M.a2.z, (int)M.a2.w, (int)M.a3.x, (int)M.a3.y, (int)M.a3.z, (int)M.a3.w};
    f32x4 d[4];
#pragma unroll
    for (int G = 0; G < 4; ++G) {
        const LAS char* row = hb + (c & 7) * 1024 + (2 * G + (c >> 3)) * 128;
        const u32x4 b0 = *(const LAS u32x4*)(row + ((kg ^ (c & 7)) << 4)), b1 = *(const LAS u32x4*)(row + (((kg + 4) ^ (c & 7)) << 4));
        d[G] = (f32x4){0.f, 0.f, 0.f, 0.f};
        d[G] = __builtin_amdgcn_mfma_scale_f32_16x16x128_f8f6f4(A0, (i32x8){(int)b0.x, (int)b0.y, (int)b0.z, (int)b0.w, 0, 0, 0, 0}, d[G], 0, 4, 0, 0x7F7F7F7F, 0, 0x7F7F7F7F);
        d[G] = __builtin_amdgcn_mfma_scale_f32_16x16x128_f8f6f4(A1, (i32x8){(int)b1.x, (int)b1.y, (int)b1.z, (int)b1.w, 0, 0, 0, 0}, d[G], 0, 4, 0, 0x7F7F7F7F, 0, 0x7F7F7F7F);
    }
    asm volatile("s_nop 15\n\ts_nop 15" : "+v"(d[0]), "+v"(d[1]), "+v"(d[2]), "+v"(d[3]));
    const float r01 = (kg & 1) ? d[1][0] : d[0][0], r23 = (kg & 1) ? d[3][0] : d[2][0];
    return (kg & 2) ? r23 : r01;
}
typedef int v2i_t __attribute__((ext_vector_type(2)));
DI void mg2_half(const MgMeta& M, int h, LAS char* hb, f32x4 (&D)[8]) {
    const int lane = tid_() & 63, c = lane & 15, g = lane >> 4;
    const u32x4 ch = h ? M.a1 : M.a0;
    const LAS char* rb = hb + (c & 7) * 1024 + (4 * (g & 1) + (c >> 3)) * 128 + 8 * (g >> 1);
#pragma unroll
    for (int t = 0; t < 8; ++t) {
        const unsigned mlo = (c == 4 * (t & 3)) ? 0xFFFFFFFFu : 0u, mhi = (c == 4 * (t & 3) + 1) ? 0xFFFFFFFFu : 0u;
        const i32x8 A = (i32x8){(int)(ch.x & mlo), (int)(ch.y & mlo), (int)(ch.z & mlo), (int)(ch.w & mlo), (int)(ch.x & mhi), (int)(ch.y & mhi), (int)(ch.z & mhi), (int)(ch.w & mhi)};
        const v2i_t b0 = __builtin_amdgcn_ds_read_tr4_b64_v2i32((LAS v2i_t*)(rb + ((t ^ (c & 7)) << 4)));
        const v2i_t b1 = __builtin_amdgcn_ds_read_tr4_b64_v2i32((LAS v2i_t*)(rb + 256 + ((t ^ (c & 7)) << 4)));
        D[t] = __builtin_amdgcn_mfma_scale_f32_16x16x128_f8f6f4(A, (i32x8){b0.x, b0.y, b1.x, b1.y, 0, 0, 0, 0}, D[t], 0, 4, 0, 0x7F7F7F7F, 0, 0x7F7F7F7F);
    }
}
template <int WHICH>
DI void mg_group(const Params& P, const unsigned char* slice, int n0, int x, LAS char* wl, unsigned wl_off, const MgMeta (&M)[4], MgMeta (&Mn)[4], bool more) {
    const int lane = tid_() & 63, kg = lane >> 4, c = lane & 15;
    bf16_t* outp = (bf16_t*)(P.ws + WS_HIDP) + (size_t)x * NTOK * (WHICH == 1 ? 128 : 256);
    f32x4 D[8];
    mg_issue(slice, M[0], 0, wl_off); SB();
#define MG_STEP(h, WAITSTMT) do { \
        if ((h) + 1 < 8) { mg_issue(slice, M[((h) + 1) >> 1], ((h) + 1) & 1, wl_off + (((h) + 1) & 1) * MG_HALF); } \
        else if (more) { _Pragma("unroll") for (int q_ = 0; q_ < 4; ++q_) mg_meta<WHICH>(P, n0 + 8 * (4 + q_), x, Mn[q_]); } \
        SB(); WAITSTMT; SB(); \
        LAS char* hb_ = wl + ((h) & 1) * MG_HALF; const int n_ = n0 + 8 * ((h) >> 1); \
        if (WHICH == 1) { const float r_ = mg1_half(M[(h) >> 1], hb_); outp[(size_t)n_ * 128 + 64 * ((h) & 1) + lane] = (bf16_t)f2bf(r_); } \
        else { if (((h) & 1) == 0) { _Pragma("unroll") for (int q_ = 0; q_ < 8; ++q_) D[q_] = (f32x4){0.f, 0.f, 0.f, 0.f}; } \
            mg2_half(M[(h) >> 1], (h) & 1, hb_, D); \
            if ((h) & 1) { asm volatile("s_nop 15\n\ts_nop 15" : "+v"(D[0]), "+v"(D[1]), "+v"(D[2]), "+v"(D[3]), "+v"(D[4]), "+v"(D[5]), "+v"(D[6]), "+v"(D[7])); \
                float v0_ = 0.f, v1_ = 0.f, v2_ = 0.f, v3_ = 0.f; _Pragma("unroll") for (int q_ = 0; q_ < 4; ++q_) { if (kg == q_) { v0_ = D[q_][0]; v1_ = D[q_][1]; v2_ = D[q_ + 4][0]; v3_ = D[q_ + 4][1]; } } \
                bf16_t* o_ = outp + (size_t)n_ * 256 + 32 * kg + c; o_[0] = (bf16_t)f2bf(v0_); o_[16] = (bf16_t)f2bf(v1_); o_[128] = (bf16_t)f2bf(v2_); o_[144] = (bf16_t)f2bf(v3_); } } \
        SB(); } while (0)
    if (WHICH == 1) {
        MG_STEP(0, MG_WAIT(8)); MG_STEP(1, MG_WAIT(9)); MG_STEP(2, MG_WAIT(9)); MG_STEP(3, MG_WAIT(9)); MG_STEP(4, MG_WAIT(9)); MG_STEP(5, MG_WAIT(9)); MG_STEP(6, MG_WAIT(9));
        if (more) { MG_STEP(7, MG_WAIT(33)); } else { MG_STEP(7, MG_WAIT(1)); }
    } else {
        MG_STEP(0, MG_WAIT(8)); MG_STEP(1, MG_WAIT(8)); MG_STEP(2, MG_WAIT(12)); MG_STEP(3, MG_WAIT(8)); MG_STEP(4, MG_WAIT(12)); MG_STEP(5, MG_WAIT(8)); MG_STEP(6, MG_WAIT(12));
        if (more) { MG_STEP(7, MG_WAIT(24)); } else { MG_STEP(7, MG_WAIT(0)); }
    }
#undef MG_STEP
}
template <int WHICH>
DI void mg_phase(const Params& P, char* lds_g) {
    const int tid = tid_(), wave = __builtin_amdgcn_readfirstlane(tid >> 6);
    unsigned* ctr = (unsigned*)(P.ws + WS_CTL) + (WHICH == 1 ? CTL_G1 : CTL_G2);
    const int x0 = (int)my_xcc_id();
    LAS int* slot = (LAS int*)((LAS char*)lds_g + LDS_ITEM);
    LAS char* wl = (LAS char*)lds_g + wave * MG_WAVE;
    const unsigned wl_off = (unsigned)__builtin_amdgcn_readfirstlane((int)(unsigned)(size_t)wl);
    constexpr int NSL = 4;
    for (int s = 0; s < NSL; ++s) {
        const int x = (x0 + s) & (NSL - 1);
        const unsigned char* slice = P.ws + (WHICH == 1 ? WS_UB : WS_VB) + (size_t)x * ((size_t)NEXP * 128);
        for (;;) {
            if (tid == 0) *slot = (int)atomicAdd(ctr + x, 1u);
            __syncthreads();
            const int chunk = *slot;
            __syncthreads();
            if (chunk >= NTOK / SL_CHUNK) break;
            const int nb = chunk * SL_CHUNK + wave;
            MgMeta MA[4], MB[4];
#pragma unroll
            for (int q = 0; q < 4; ++q) mg_meta<WHICH>(P, nb + 8 * q, x, MA[q]);
            mg_group<WHICH>(P, slice, nb, x, wl, wl_off, MA, MB, true);
            mg_group<WHICH>(P, slice, nb + 32, x, wl, wl_off, MB, MA, true);
            mg_group<WHICH>(P, slice, nb + 64, x, wl, wl_off, MA, MB, true);
            mg_group<WHICH>(P, slice, nb + 96, x, wl, wl_off, MB, MA, false);
            MG_WAIT(0);
        }
    }
}
DI void hid_reduce8_phase(const Params& P, int bid, int nblk) {
    const int tid = tid_(), lane = tid & 63, wave = __builtin_amdgcn_readfirstlane(tid >> 6);
    unsigned char* ws = P.ws;
    const int gw = bid * NWAVES + wave, NGW = nblk * NWAVES;
    const bf16_t* hp = (const bf16_t*)(ws + WS_HIDP);
    for (int n = gw; n < NTOK; n += NGW) {
        const float xs = ((const float*)(ws + WS_XSC))[n];
        f32x4 cv[2]; f32x4 am = (f32x4){0.f, 0.f, 0.f, 0.f};
#pragma unroll
        for (int q = 0; q < 2; ++q) {
            const size_t o = (size_t)n * 128 + 64 * q + lane; float a = 0.f;
            const int e = ((const int*)(ws + WS_EIDX))[o];
            const f32x4 us = *(const f32x4*)((const float*)(ws + WS_USC) + (size_t)e * 4);
#pragma unroll
            for (int x = 0; x < 4; ++x) a += bf2f(hp[(size_t)x * NTOK * 128 + o]) * us[x];
            const float cf = gelu_exact(a * xs) * ((const float*)(ws + WS_EGATE))[o];
            const f32x4 vs = *(const f32x4*)((const float*)(ws + WS_VSC) + (size_t)e * 4);
            cv[q] = vs * cf;
            am.x = fmaxf(am.x, fabsf(cv[q].x)); am.y = fmaxf(am.y, fabsf(cv[q].y)); am.z = fmaxf(am.z, fabsf(cv[q].z)); am.w = fmaxf(am.w, fabsf(cv[q].w));
        }
        f32x4 isc;
#pragma unroll
        for (int x = 0; x < 4; ++x) {
            float m = row16_max(am[x]); m = fmaxf(fmaxf(readlane_f(m, 0), readlane_f(m, 16)), fmaxf(readlane_f(m, 32), readlane_f(m, 48)));
            const float sc = (m > 0.f) ? exp2f(floorf(log2f(224.f / m))) : 1.f;
            const int w0 = __builtin_amdgcn_cvt_pk_fp8_f32(cv[0][x] * sc, cv[1][x] * sc, 0, false);
            unsigned char* cr = ws + WS_C8 + ((size_t)x * NTOK + n) * 128;
            cr[lane] = (unsigned char)(w0 & 255); cr[64 + lane] = (unsigned char)((w0 >> 8) & 255);
            isc[x] = 1.f / sc;
        }
        if (lane == 0) *(f32x4*)((float*)(ws + WS_CSC) + (size_t)n * 4) = isc;
    }
}
DI void final_norm8_phase(const Params& P, int bid, int nblk) {
    const int tid = tid_(), lane = tid & 63, wave = __builtin_amdgcn_readfirstlane(tid >> 6);
    const unsigned char* ws = P.ws;
    const int gw = bid * NWAVES + wave, NGW = nblk * NWAVES;
    f32x4 wv[4];
#pragma unroll
    for (int q = 0; q < 4; ++q) wv[q] = *(const f32x4*)(P.final_w + 16 * lane + 4 * q);
    for (int n = gw; n < NTOK; n += NGW) {
        float* orow = P.out + (size_t)n * DM + 16 * lane;
        const bf16_t* yrow = (const bf16_t*)(ws + WS_HIDP) + ((size_t)(lane >> 4) * NTOK + n) * 256 + 16 * (lane & 15);
        const u32x4 ya = *(const u32x4*)yrow, yb = *(const u32x4*)(yrow + 8);
        const unsigned yu[8] = {ya.x, ya.y, ya.z, ya.w, yb.x, yb.y, yb.z, yb.w};
        const float cs = ((const float*)(ws + WS_CSC))[(size_t)n * 4 + (lane >> 4)];
        const bf16_t* hrow = (const bf16_t*)(ws + WS_XB) + (size_t)n * DM + 16 * lane;
        const u32x4 ha = *(const u32x4*)hrow, hb = *(const u32x4*)(hrow + 8);
        const unsigned hu[8] = {ha.x, ha.y, ha.z, ha.w, hb.x, hb.y, hb.z, hb.w};
        f32x4 h[4]; float ss = 0.f;
#pragma unroll
        for (int q = 0; q < 4; ++q) { h[q] = (f32x4){bf2f(hu[2 * q] & 0xffffu), bf2f(hu[2 * q] >> 16), bf2f(hu[2 * q + 1] & 0xffffu), bf2f(hu[2 * q + 1] >> 16)} + (f32x4){bf2f(yu[2 * q] & 0xffffu), bf2f(yu[2 * q] >> 16), bf2f(yu[2 * q + 1] & 0xffffu), bf2f(yu[2 * q + 1] >> 16)} * cs; ss += (h[q].x * h[q].x + h[q].y * h[q].y) + (h[q].z * h[q].z + h[q].w * h[q].w); }
        ss = wave_sum_dpp(ss);
        const float rs = 1.f / sqrtf(ss * (1.f / DM) + EPS);
#pragma unroll
        for (int q = 0; q < 4; ++q) *(f32x4*)(orow + 4 * q) = h[q] * wv[q] * rs;
    }
}

#define XB_TMO      128
#define XB_XCNT(j)  (256  + 64 * (j))
#define XB_XSUB(j)  (1280 + 64 * (j))
#define XB_XGEN(j)  (2304 + 64 * (j))
#define XB_TOP      3328
#define XB_TOPGEN   3392
#define XCD_BAR_WORDS 3456
#define XB_SPIN_CAP (1u << 18)

__device__ __forceinline__ unsigned xb_ld(unsigned* p)              { return __hip_atomic_load(p, __ATOMIC_RELAXED, __HIP_MEMORY_SCOPE_AGENT); }
__device__ __forceinline__ unsigned xb_add(unsigned* p, unsigned v) { return __hip_atomic_fetch_add(p, v, __ATOMIC_RELAXED, __HIP_MEMORY_SCOPE_AGENT); }
__device__ __forceinline__ unsigned xb_xcc_id() { return (unsigned)__builtin_amdgcn_s_getreg((3 << 11) | 20) & 0xFu; }
#define XB_SPIN(cond, bar) do { unsigned _sp = 0; while (cond) { __builtin_amdgcn_s_sleep(1); \
    if ((++_sp & 255u) == 0u) { if (xb_ld(&(bar)[XB_TMO])) break; if (_sp > XB_SPIN_CAP) { atomicAdd(&(bar)[XB_TMO], 1u); break; } } } } while (0)

struct XcdBarrier {
    unsigned* bar; unsigned x;
    volatile LAS unsigned* st;
};

__device__ __forceinline__ XcdBarrier xcd_barrier_post(unsigned* bar, volatile LAS unsigned* st) {
    XcdBarrier b; b.bar = bar; b.x = xb_xcc_id(); b.st = st;
    if (threadIdx.x == 0) (void)xb_add(&bar[XB_XCNT(b.x)], 1u);
    return b;
}
__device__ __forceinline__ void xcd_barrier_complete(unsigned* bar, unsigned x, unsigned& nloc, unsigned& nx) {
    const unsigned G = gridDim.x * gridDim.y * gridDim.z;
    unsigned sum, cnt, mine, sp = 0u;
    for (;;) {
        sum = 0u; cnt = 0u; mine = 0u;
#pragma unroll
        for (unsigned j = 0; j < 16; ++j) { const unsigned c = xb_ld(&bar[XB_XCNT(j)]); sum += c; cnt += (c > 0u) ? 1u : 0u; mine = (j == x) ? c : mine; }
        if (sum == G) break;
        __builtin_amdgcn_s_sleep(1);
        if ((++sp & 255u) == 0u) { if (xb_ld(&bar[XB_TMO])) break; if (sp > XB_SPIN_CAP) { atomicAdd(&bar[XB_TMO], 1u); break; } }
    }
    nloc = mine > 0u ? mine : 1u; nx = cnt > 0u ? cnt : 1u;
}

__device__ __forceinline__ void xcd_barrier(const XcdBarrier& b) {
    asm volatile("s_waitcnt vmcnt(0)" ::: "memory");
    __syncthreads();
    if (threadIdx.x == 0) {
        unsigned* bar = b.bar;
        __builtin_amdgcn_s_waitcnt(0);
        unsigned nloc = b.st[0], nx = b.st[1];
        if (nloc == 0u) { xcd_barrier_complete(bar, b.x, nloc, nx); b.st[0] = nloc; b.st[1] = nx; }
        const unsigned old = xb_add(&bar[XB_XSUB(b.x)], 1u);
        const unsigned gen = old / nloc;
        if (old + 1u == (gen + 1u) * nloc) {
            __builtin_amdgcn_fence(__ATOMIC_RELEASE, "agent");
            asm volatile("s_waitcnt vmcnt(0)" ::: "memory");
            const unsigned og = xb_add(&bar[XB_TOP], 1u);
            const unsigned tg = og / nx;
            if (og + 1u == (tg + 1u) * nx) xb_add(&bar[XB_TOPGEN], 1u);
            else XB_SPIN(xb_ld(&bar[XB_TOPGEN]) == tg, bar);
            __builtin_amdgcn_fence(__ATOMIC_ACQUIRE, "agent");
            xb_add(&bar[XB_XGEN(b.x)], 1u);
            asm volatile("s_waitcnt vmcnt(0)" ::: "memory");
        } else {
            XB_SPIN(xb_ld(&bar[XB_XGEN(b.x)]) == gen, bar);
            __builtin_amdgcn_fence(__ATOMIC_ACQUIRE, "agent");
            asm volatile("s_waitcnt vmcnt(0)" ::: "memory");
        }
    }
    __syncthreads();
}

constexpr int CTL_XB_WORD = 2048;
static_assert((CTL_XB_WORD + 3456) * 4 <= (int)CTL_BYTES, "barrier words inside CTL");
constexpr int N_HGRN_ITEMS = BATCH * 4, N_ATT_ITEMS = BATCH * 4 * 32;

DI void mixer_phase(const Params& P, char* lds) {
    unsigned* ctr = (unsigned*)(P.ws + WS_CTL);
    for (;;) {
        if (tid_() == 0) *(LAS int*)((LAS char*)lds + LDS_ITEM) = (int)atomicAdd(ctr, 1u);
        __syncthreads();
        const int item = *(LAS int*)((LAS char*)lds + LDS_ITEM);
        __syncthreads();
        if (item >= N_HGRN_ITEMS + N_ATT_ITEMS) break;
        if (item < N_HGRN_ITEMS) hgrn_unit(P, item >> 2, item & 3, lds);
        else { const int a = item - N_HGRN_ITEMS, j = 31 - (a >> 5), bh = a & 31; attn_unit(P, bh >> 2, bh & 3, j, lds); }
    }
}

#ifdef TS_PHASE
#ifndef TS_DIV
#define TS_DIV 4.0f
#endif
#define TS(i) do { if (blockIdx.x == 0 && threadIdx.x == 0) ((LAS unsigned long long*)((LAS char*)lds + LDS_BYTES - 512))[i] = __builtin_amdgcn_s_memrealtime(); } while (0)
#else
#define TS(i) do { } while (0)
#endif
__global__ void __launch_bounds__(NTHREADS, 2) fwd_megakernel(Params P) {
    extern __shared__ __attribute__((aligned(16))) char lds[];
    cg::grid_group grid = cg::this_grid();
    const int bid = blockIdx.x, nblk = gridDim.x;
    unsigned char* ws = P.ws;
    volatile LAS unsigned* xst = (volatile LAS unsigned*)((LAS char*)lds + LDS_XB);
    if (threadIdx.x < 4) xst[threadIdx.x] = 0u;
    __syncthreads();
    const XcdBarrier xbar = xcd_barrier_post((unsigned*)(ws + WS_CTL) + CTL_XB_WORD, xst);
    TS(0);
    phase0(P, lds, bid, nblk);
    grid.sync();
    TS(1);
    { Epi1 e{ws}; gemm_run(lds, (const bf16_t*)(ws + WS_XB), (const bf16_t*)(ws + WS_W1T), M1, NCOL1, DM, e, bid, nblk); }
    {
        constexpr int NUNITS = (M1 / 256) * (NCOL1 / 256);
        const int nlast = NUNITS % nblk, nfree = nlast ? nblk - nlast : nblk;
        const int wave = __builtin_amdgcn_readfirstlane(tid_() >> 6);
        if (nlast == 0 || bid >= nlast) table_fp8_rows(P, NEXP + (bid - (nlast ? nlast : 0)) * NWAVES + wave, nfree * NWAVES, 2 * NEXP);
    }
    xcd_barrier(xbar);
    TS(2);
    for (int it = bid; it < 32 * 129; it += nblk) hgrn_prep_item(P, it & 31, it >> 5, lds);
    xcd_barrier(xbar);
    TS(3);
    mixer_phase(P, lds);
    xcd_barrier(xbar);
    TS(4);
    { Epi3 e{P.x, P.out, (bf16_t*)(ws + WS_XB), (float*)(ws + WS_SSQ)}; gemm_run(lds, (const bf16_t*)(ws + WS_MIX), (const bf16_t*)(ws + WS_W2T), NTOK, DM, DM, e, bid, nblk); }
    xcd_barrier(xbar);
    TS(5);
    { Epi4 e{(const float*)(ws + WS_SSQ), (bf16_t*)(ws + WS_PQ)}; gemm_run(lds, (const bf16_t*)(ws + WS_XB), (const bf16_t*)(ws + WS_W3T), NTOK, 2048, DM, e, bid, nblk); }
    xcd_barrier(xbar);
    TS(6);
    topk_phase(P, lds, bid, nblk);
    xn8_rows(P, bid, nblk);
    xcd_barrier(xbar);
    TS(7);
    mg_phase<1>(P, lds);
    xcd_barrier(xbar);
    TS(8);
    hid_reduce8_phase(P, bid, nblk);
    xcd_barrier(xbar);
    TS(9);
    mg_phase<2>(P, lds);
    xcd_barrier(xbar);
    TS(10);
    final_norm8_phase(P, bid, nblk);
    TS(11);
#ifdef TS_PHASE
    if (blockIdx.x == 0 && threadIdx.x == 0) { const LAS unsigned long long* t = (const LAS unsigned long long*)((LAS char*)lds + LDS_BYTES - 512);
        P.out[0] += (float)(t[TS_PHASE + 1] - t[TS_PHASE]) * 0.01f / TS_DIV; }
#endif
}

extern "C" void kernel_launch(void* const* d_in, const int* in_sizes, int n_in, void* d_out, int out_size, void* d_ws, size_t ws_size, hipStream_t stream) {
    static int grid = 0;
    if (grid == 0) {
        int dev = 0, cus = 0, per_cu = 0;
        (void)hipGetDevice(&dev);
        (void)hipDeviceGetAttribute(&cus, hipDeviceAttributeMultiprocessorCount, dev);
        (void)hipFuncSetAttribute((const void*)fwd_megakernel, hipFuncAttributeMaxDynamicSharedMemorySize, LDS_BYTES);
        (void)hipOccupancyMaxActiveBlocksPerMultiprocessor(&per_cu, (const void*)fwd_megakernel, NTHREADS, LDS_BYTES);
        if (per_cu < 1) { fprintf(stderr, "kernel_launch: occupancy query says %d blocks per CU\n", per_cu); per_cu = 1; }
        grid = cus * 1;
        if (ws_size < WS_END) { fprintf(stderr, "kernel_launch: workspace too small: %zu < %zu\n", ws_size, (size_t)WS_END); grid = -1; }
    }
    if (grid < 0) return;
    (void)hipMemsetAsync((char*)d_ws + WS_CTL, 0, CTL_BYTES, stream);
    Params p{};
    p.x = (const float*)d_in[0]; p.meta = (const float*)d_in[1]; p.mix_norm_w = (const float*)d_in[2]; p.w_in = (const float*)d_in[3];
    p.lb_logits = (const float*)d_in[4]; p.rec_norm_w = (const float*)d_in[5]; p.lq1 = (const float*)d_in[6]; p.lk1 = (const float*)d_in[7];
    p.lq2 = (const float*)d_in[8]; p.lk2 = (const float*)d_in[9]; p.subln_w = (const float*)d_in[10]; p.w_out = (const float*)d_in[11];
    p.ffn_norm_w = (const float*)d_in[12]; p.wq = (const float*)d_in[13]; p.subkeys = (const float*)d_in[14]; p.pu = (const float*)d_in[15];
    p.pv = (const float*)d_in[16]; p.final_w = (const float*)d_in[17];
    p.out = (float*)d_out; p.ws = (unsigned char*)d_ws;
    void* args[] = {&p};
    hipError_t e = hipLaunchCooperativeKernel((const void*)fwd_megakernel, dim3(grid), dim3(NTHREADS), args, LDS_BYTES, stream);
    if (e != hipSuccess) fprintf(stderr, "cooperative launch failed: %s (grid %d)\n", hipGetErrorString(e), grid);
}
```

```cpp
#include <hip/hip_runtime.h>
#include <hip/hip_cooperative_groups.h>
#include <cstdio>
#include <cstdint>
#define DBG_SEL 1
namespace cg = cooperative_groups;

constexpr int BATCH = 8, SEQ = 4096, DM = 1024, NMETA = 16;
constexpr int NTOK = BATCH * SEQ;
constexpr int M1 = NTOK + 256;
constexpr int NCOL1 = 3584;
constexpr int TPOS = NMETA + SEQ;
constexpr int KT = 65;
constexpr int KPAD = 48;
constexpr int HT = 4128;
constexpr int NEXP = 16384;
constexpr float EPS = 1e-6f;
constexpr float LAM_INIT = 0.2f;
constexpr float QSCALE = 0.125f * 1.4426950408889634f;
constexpr int NTHREADS = 512, NWAVES = 8;
constexpr int LDS_BYTES = 163840;
constexpr int LDS_ITEM = LDS_BYTES - 64, LDS_XB = LDS_BYTES - 32;

typedef unsigned short bf16_t;
typedef short bf16x8 __attribute__((ext_vector_type(8)));
typedef float f32x4 __attribute__((ext_vector_type(4)));
typedef float f32x16 __attribute__((ext_vector_type(16)));
typedef float f32x2 __attribute__((ext_vector_type(2)));
typedef unsigned u32x4 __attribute__((ext_vector_type(4)));
typedef unsigned u32x2 __attribute__((ext_vector_type(2)));
typedef __bf16 bf16x2_t __attribute__((ext_vector_type(2)));
typedef short s16x4 __attribute__((ext_vector_type(4)));
#define LAS __attribute__((address_space(3)))
#define DI __device__ __forceinline__
__device__ __forceinline__ int tid_() { int t = threadIdx.x; asm volatile("" : "+v"(t)); return t; }

constexpr size_t al256(size_t x) { return (x + 255) & ~(size_t)255; }
constexpr size_t WS_CTL = 0, CTL_BYTES = 65536;
constexpr size_t WS_W1T = WS_CTL + CTL_BYTES;
constexpr size_t WS_W2T = WS_W1T + (size_t)NCOL1 * DM * 2;
constexpr size_t WS_W3T = WS_W2T + (size_t)DM * DM * 2;
constexpr size_t WS_SKB = WS_W3T + (size_t)2048 * DM * 2;
constexpr size_t WS_UB = WS_SKB + (size_t)16 * 128 * 128 * 2;
constexpr size_t WS_VB = WS_UB + (size_t)NEXP * DM * 2;
constexpr size_t WS_USC = WS_UB + (size_t)NEXP * DM, WS_VSC = WS_VB + (size_t)NEXP * DM;
constexpr size_t WS_ROPE = WS_VB + (size_t)NEXP * DM * 2;
constexpr size_t WS_LB = WS_ROPE + (size_t)TPOS * 64 * 4;
constexpr size_t WS_R1 = WS_LB + 4096;
constexpr size_t WS_SSQ = WS_R1 + al256((size_t)M1 * 4);
constexpr size_t WS_SSQ2 = WS_SSQ + (size_t)NTOK * 4;
constexpr size_t WS_XB = WS_SSQ2 + (size_t)NTOK * 4;
constexpr size_t WS_C = WS_XB + (size_t)M1 * DM * 2;
constexpr size_t WS_Q = WS_C;
constexpr size_t WS_K = WS_Q + (size_t)NTOK * 512 * 2;
constexpr size_t WS_V = WS_K + (size_t)BATCH * 4 * 2 * KT * 8192;
constexpr size_t WS_HQ = WS_V + (size_t)BATCH * 4 * KT * 16384;
constexpr size_t WS_HV = WS_HQ + (size_t)BATCH * 4 * HT * 128 * 2;
constexpr size_t WS_HG = WS_HV + (size_t)BATCH * 4 * HT * 128 * 2;
constexpr size_t WS_SG = WS_HG + (size_t)BATCH * 4 * HT * 128 * 4;
constexpr size_t WS_CEND = WS_SG + (size_t)NTOK * 512 * 2;
constexpr size_t WS_PQ = WS_C;
constexpr size_t WS_EIDX = WS_PQ + (size_t)NTOK * 2048 * 2;
constexpr size_t WS_EGATE = WS_EIDX + (size_t)NTOK * 128 * 4;
constexpr size_t WS_HID = WS_EGATE + (size_t)NTOK * 128 * 4;
constexpr size_t WS_XN8 = WS_HID + (size_t)NTOK * 128 * 4;
constexpr size_t WS_XSC = WS_XN8 + (size_t)NTOK * DM;
constexpr size_t WS_C8 = WS_XSC + (size_t)NTOK * 4;
constexpr size_t WS_CSC = WS_C8 + (size_t)NTOK * 128 * 4;
static_assert(WS_CSC + (size_t)NTOK * 16 <= WS_CEND, "overlay fits");
constexpr size_t WS_HIDP = WS_PQ;
constexpr size_t WS_MIX = WS_CEND;
constexpr size_t WS_HQA = WS_MIX + (size_t)NTOK * DM * 2;
constexpr size_t WS_HD = WS_HQA + (size_t)BATCH * 4 * HT * 128 * 2;
constexpr size_t WS_END = WS_HD + (size_t)BATCH * 4 * 129 * 128 * 4;
static_assert(WS_END <= (size_t)512 * 1024 * 1024, "workspace map must fit 512 MiB");

struct Params {
    const float* x; const float* meta; const float* mix_norm_w; const float* w_in; const float* lb_logits; const float* rec_norm_w;
    const float* lq1; const float* lk1; const float* lq2; const float* lk2; const float* subln_w; const float* w_out; const float* ffn_norm_w;
    const float* wq; const float* subkeys; const float* pu; const float* pv; const float* final_w;
    float* out; unsigned char* ws;
};

DI unsigned f2bf(float f) { unsigned u = __builtin_bit_cast(unsigned, f); return (u + 0x7fffu + ((u >> 16) & 1u)) >> 16; }
DI float bf2f(unsigned b) { return __builtin_bit_cast(float, b << 16); }
DI unsigned cvtpk(float lo, float hi) { f32x2 v = {lo, hi}; bf16x2_t b = __builtin_convertvector(v, bf16x2_t); return __builtin_bit_cast(unsigned, b); }
DI float wave_sum(float v) {
#pragma unroll
    for (int o = 1; o < 64; o <<= 1) v += __shfl_xor(v, o);
    return v;
}
DI float sigmoidf_(float x) { return 1.f / (1.f + __expf(-x)); }
DI float siluf_(float x) { return x * sigmoidf_(x); }

DI int sigma_col(int c) {
    if (c >= 1024) return c;
    const int cc = c & 63, a = cc >> 5, fq = (cc >> 3) & 3, n = (cc >> 2) & 1, j = cc & 3;
    return (c & ~63) + 4 * (4 * a + fq) + 32 * n + j;
}
template <bool PERMUTE>
DI void p0_transpose_item(const float* W, int K, int N, const float* scale, bf16_t* WT, LAS float* scr, int item, int lane) {
    const int nblk = N / 32, kb = item / nblk, nb = item % nblk, k0 = 64 * kb, n0 = 32 * nb;
    const int ncol = PERMUTE ? sigma_col(n0 + (lane & 31)) : n0 + (lane & 31);
#pragma unroll 8
    for (int i = 0; i < 32; ++i) { const int kk = 2 * i + (lane >> 5); float s = scale ? scale[k0 + kk] : 1.f; scr[kk * 33 + (lane & 31)] = W[(size_t)(k0 + kk) * N + ncol] * s; }
    asm volatile("s_waitcnt lgkmcnt(0)" ::: "memory");
    const int c = lane & 7;
#pragma unroll
    for (int j = 0; j < 4; ++j) { const int n = (lane >> 3) + 8 * j; const LAS float* s = scr + (8 * c) * 33 + n;
        u32x4 o; o.x = cvtpk(s[0 * 33], s[1 * 33]); o.y = cvtpk(s[2 * 33], s[3 * 33]); o.z = cvtpk(s[4 * 33], s[5 * 33]); o.w = cvtpk(s[6 * 33], s[7 * 33]);
        *(u32x4*)(WT + (size_t)(n0 + n) * K + k0 + 8 * c) = o; }
    asm volatile("s_waitcnt lgkmcnt(0)" ::: "memory");
}

DI unsigned fp4_code(float x, float sc) {
    const float a = fabsf(x) * sc;
    const unsigned idx = (unsigned)(a > 0.25f) + (unsigned)(a > 0.75f) + (unsigned)(a > 1.25f) + (unsigned)(a > 1.75f) + (unsigned)(a > 2.5f) + (unsigned)(a > 3.5f) + (unsigned)(a > 5.0f);
    return idx | (x < 0.f ? 8u : 0u);
}
DI void table_fp8_rows(const Params& P, int first, int stride, int r_end) {
    const int lane = tid_() & 63;
    unsigned char* ws = P.ws;
    for (int r = first; r < r_end; r += stride) {
        const bool isv = r >= NEXP; const int e = isv ? r - NEXP : r;
        const f32x4* src = (const f32x4*)((isv ? P.pv : P.pu) + (size_t)e * DM) + lane;
        f32x4 v[4]; float amq[4];
#pragma unroll
        for (int q = 0; q < 4; ++q) { v[q] = src[64 * q]; amq[q] = fmaxf(fmaxf(fabsf(v[q].x), fabsf(v[q].y)), fmaxf(fabsf(v[q].z), fabsf(v[q].w))); }
#pragma unroll
        for (int o = 1; o < 64; o <<= 1) {
#pragma unroll
            for (int q = 0; q < 4; ++q) amq[q] = fmaxf(amq[q], __shfl_xor(amq[q], o));
        }
        {
            unsigned char* tb = ws + (isv ? WS_VB : WS_UB); float* scp = (float*)(ws + (isv ? WS_VSC : WS_USC));
#pragma unroll
            for (int q = 0; q < 4; ++q) {
                const float sc = (amq[q] > 0.f) ? 6.f / amq[q] : 1.f;
                unsigned w = __builtin_amdgcn_cvt_scalef32_pk_fp4_f32(0u, v[q].x * sc, v[q].y * sc, 1.0f, 0); w = __builtin_amdgcn_cvt_scalef32_pk_fp4_f32(w, v[q].z * sc, v[q].w * sc, 1.0f, 1);
                *(unsigned short*)(tb + ((size_t)q * NEXP + e) * 128 + 2 * lane) = (unsigned short)w;
                if (lane == 0) scp[(size_t)e * 4 + q] = 1.f / sc;
            }
        }
    }
}

DI void phase0(const Params& P, char* lds, int bid, int nblk) {
    const int tid = tid_(), lane = tid & 63, wave = __builtin_amdgcn_readfirstlane(tid >> 6);
    unsigned char* ws = P.ws;
    LAS float* scr = (LAS float*)(lds) + wave * (64 * 33);
    const int gw = bid * NWAVES + wave, NGW = nblk * NWAVES;
    constexpr int I1 = (DM / 64) * (NCOL1 / 32), I2 = (DM / 64) * (DM / 32), I3 = (DM / 64) * (2048 / 32);
    for (int it = gw; it < I1 + I2 + I3; it += NGW) {
        int r = it;
        if (r < I1) { p0_transpose_item<true>(P.w_in, DM, NCOL1, P.mix_norm_w, (bf16_t*)(ws + WS_W1T), scr, r, lane); continue; } r -= I1;
        if (r < I2) { p0_transpose_item<false>(P.w_out, DM, DM, nullptr, (bf16_t*)(ws + WS_W2T), scr, r, lane); continue; } r -= I2;
        p0_transpose_item<false>(P.wq, DM, 2048, P.ffn_norm_w, (bf16_t*)(ws + WS_W3T), scr, r, lane);
    }
    for (int m = gw; m < M1; m += NGW) {
        bf16_t* orow = (bf16_t*)(ws + WS_XB) + (size_t)m * DM;
        float* r1 = (float*)(ws + WS_R1);
        unsigned long long* o8 = (unsigned long long*)orow + lane;
        if (m >= NTOK + NMETA) { for (int j = 0; j < 4; ++j) o8[64 * j] = 0ull; if (lane == 0) r1[m] = 0.f; continue; }
        const float* xrow = (m < NTOK) ? P.x + (size_t)m * DM : P.meta + (size_t)(m - NTOK) * DM;
        const f32x4* xr = (const f32x4*)xrow + lane;
        f32x4 v[4]; float s = 0.f;
#pragma unroll
        for (int j = 0; j < 4; ++j) { v[j] = xr[64 * j]; s += (v[j].x * v[j].x + v[j].y * v[j].y) + (v[j].z * v[j].z + v[j].w * v[j].w); }
        s = wave_sum(s);
        if (lane == 0) r1[m] = 1.f / sqrtf(s * (1.f / DM) + EPS);
#pragma unroll
        for (int j = 0; j < 4; ++j) o8[64 * j] = (unsigned long long)cvtpk(v[j].x, v[j].y) | ((unsigned long long)cvtpk(v[j].z, v[j].w) << 32);
    }
    table_fp8_rows(P, gw, NGW, NEXP);
    {
        const size_t gt = (size_t)bid * NTHREADS + tid, NGT = (size_t)nblk * NTHREADS;
        const size_t ns = (size_t)16 * 128 * 128 / 8;
        for (size_t e = gt; e < ns; e += NGT) {
            const f32x4 a = ((const f32x4*)P.subkeys)[2 * e], b = ((const f32x4*)P.subkeys)[2 * e + 1];
            u32x4 o; o.x = cvtpk(a.x, a.y); o.y = cvtpk(a.z, a.w); o.z = cvtpk(b.x, b.y); o.w = cvtpk(b.z, b.w);
            ((u32x4*)(ws + WS_SKB))[e] = o;
        }
        float* rope = (float*)(ws + WS_ROPE);
        for (size_t i = gt; i < (size_t)TPOS * 32; i += NGT) {
            const int t = (int)(i >> 5), f = (int)(i & 31);
            const double inv = exp2(-(double)f * (13.287712379549449 / 32.0));
            const double ang = (double)t * inv;
            rope[(size_t)t * 64 + f] = (float)cos(ang); rope[(size_t)t * 64 + 32 + f] = (float)sin(ang);
        }
        for (size_t i = gt; i < CTL_BYTES / 16; i += NGT) ((u32x4*)(ws + WS_CTL))[i] = (u32x4){0u, 0u, 0u, 0u};
        float* ssq = (float*)(ws + WS_SSQ);
        for (size_t i = gt; i < (size_t)2 * NTOK; i += NGT) ssq[i] = 0.f;
        for (size_t i = gt; i < (size_t)BATCH * 4 * 2 * 512; i += NGT) { const size_t img = i >> 9, o = i & 511; ((u32x4*)(ws + WS_K + img * KT * 8192))[o] = (u32x4){0u, 0u, 0u, 0u}; }
        for (size_t i = gt; i < (size_t)BATCH * 4 * 1024; i += NGT) { const size_t img = i >> 10, o = i & 1023; ((u32x4*)(ws + WS_V + img * KT * 16384))[o] = (u32x4){0u, 0u, 0u, 0u}; }
        for (size_t i = gt; i < (size_t)BATCH * 4 * 16 * 16; i += NGT) { const size_t bh = i >> 8, o = i & 255;
            ((u32x4*)(ws + WS_HQ + bh * HT * 256))[o] = (u32x4){0u, 0u, 0u, 0u}; ((u32x4*)(ws + WS_HV + bh * HT * 256))[o] = (u32x4){0u, 0u, 0u, 0u}; }
        for (size_t i = gt; i < (size_t)BATCH * 4 * 16 * 32; i += NGT) { const size_t bh = i >> 9, o = i & 511; ((u32x4*)(ws + WS_HG + bh * HT * 512))[o] = (u32x4){0u, 0u, 0u, 0u}; }
        float* lb = (float*)(ws + WS_LB);
        if (gt < 512) lb[gt] = sigmoidf_(P.lb_logits[gt] - P.lb_logits[512 + gt]);
        if (bid == 0 && wave == 0) {
            const float a = wave_sum(P.lq1[lane] * P.lk1[lane]), b = wave_sum(P.lq2[lane] * P.lk2[lane]);
            if (lane == 0) lb[512] = __expf(a) - __expf(b) + LAM_INIT;
        }
    }
}

namespace pg8 {
#define PG8_LAS __attribute__((address_space(3)))
typedef unsigned short bf16_t;
typedef short bf16x8 __attribute__((ext_vector_type(8)));
typedef float f32x4 __attribute__((ext_vector_type(4)));
typedef unsigned u32x4 __attribute__((ext_vector_type(4)));
constexpr int BM = 256, BK = 64, HALF = 128, HTB = HALF * BK * 2  , STAGE_BYTES = 8 * HTB, NXCD = 8, WGM = 8;

__host__ __device__ __forceinline__ int lds_byte(int r, int c) { const int st = (r >> 4) * 2 + (c >> 5), rr = r & 15, cc = c & 31, ob = rr * 64 + cc * 2; return st * 1024 + (ob ^ (((ob >> 9) & 1) << 5)); }
__host__ __device__ __forceinline__ void stage_rc(int b, int& R, int& C) { const int st = b / 1024, sb = b % 1024, swz = sb ^ (((sb >> 9) & 1) << 5); R = (st >> 1) * 16 + swz / 64; C = (st & 1) * 32 + (swz % 64) / 2; }
__host__ __device__ __forceinline__ int perm32(int rho) { const int n = rho >> 4, i = rho & 15; return 8 * (i >> 2) + 4 * n + (i & 3); }

struct Unit { int pm, pn; };
struct Gemm { const bf16_t* A; const bf16_t* Bt; int M, N, K; };

struct StaticOrder {
    int nM, nN, nwg, G, c;
    __host__ __device__ void init(int M, int N, int G_, int c_) { nM = M / BM; nN = N / BM; nwg = nM * nN; G = G_; c = c_; }
    __host__ __device__ bool next(int i, Unit& u) const {
        const long L = (long)i * G + c; if (L >= nwg) return false;
        int wgid = (int)L; { const int q = nwg / NXCD, r = nwg % NXCD, xcd = wgid % NXCD, off = wgid / NXCD; wgid = (xcd < r ? xcd * (q + 1) : r * (q + 1) + (xcd - r) * q) + off; }
        const int nig = WGM * nN, gid = wgid / nig, fm = gid * WGM, gsz = (nM - fm) < WGM ? (nM - fm) : WGM;
        u.pm = fm + ((wgid % nig) % gsz); u.pn = (wgid % nig) / gsz; return true;
    }
    __device__ __forceinline__ void a_ready(const Unit&) const {}
    __device__ __forceinline__ void done(const Unit&) const {}
};

template <class Epi, class Sched, bool ALIGN_EPI = false, bool SP2 = false>
__device__ __forceinline__ void gemm_phase(PG8_LAS unsigned char* lds, const Gemm g, const Sched& S, const Epi& E) {
    const int tid = tid_(), wid = __builtin_amdgcn_readfirstlane(tid >> 6), lane = tid & 63, wr = wid >> 2, wc = wid & 3, fr = lane & 15, fq = lane >> 4;
    const int K = g.K, nt = K / BK;
    unsigned voffA[2], voffB[2];
#pragma unroll
    for (int i = 0; i < 2; ++i) { int R, C; stage_rc(tid * 16 + i * 8192, R, C); const int Rb = Epi::PERM ? ((R & ~31) + perm32(R & 31)) : R;
        voffA[i] = (unsigned)(R * K + C) * 2u; voffB[i] = (unsigned)(Rb * K + C) * 2u; }
    const size_t kstep = (size_t)(BK * 2);
    const size_t hstep = (size_t)HALF * K * 2;
    const size_t tstep = 2 * hstep;
    const unsigned ldsw = (unsigned)wid * 1024u;
    const int aoff = lds_byte(wr * 64 + fr, fq * 8), boff = lds_byte(wc * 32 + fr, fq * 8);
#define PG8_SA(b, h) (((b) * 2 + (h)) * HTB)
#define PG8_SB(b, h) ((4 + (b) * 2 + (h)) * HTB)
#define PG8_STAGE(bufoff, gbase, voff) do { _Pragma("unroll") for (int _i = 0; _i < 2; ++_i) \
        __builtin_amdgcn_global_load_lds((const unsigned*)((const char*)(gbase) + (voff)[_i]), (PG8_LAS unsigned*)(lds + (bufoff) + ldsw + _i * 8192), 16, 0, 0); } while (0)
#define PG8_LDA(dst, b, h) do { _Pragma("unroll") for (int m = 0; m < 4; ++m) _Pragma("unroll") for (int k = 0; k < 2; ++k) dst[m][k] = *(const PG8_LAS bf16x8*)(lds + PG8_SA(b, h) + aoff + m * 2048 + k * 1024); } while (0)
#define PG8_LDB(dst, b, h) do { _Pragma("unroll") for (int n = 0; n < 2; ++n) _Pragma("unroll") for (int k = 0; k < 2; ++k) dst[n][k] = *(const PG8_LAS bf16x8*)(lds + PG8_SB(b, h) + boff + n * 2048 + k * 1024); } while (0)
#define PG8_MMA(ai, bj, At, Bt) do { __builtin_amdgcn_s_setprio(1); _Pragma("unroll") for (int m = 0; m < 4; ++m) _Pragma("unroll") for (int n = 0; n < 2; ++n) _Pragma("unroll") for (int k = 0; k < 2; ++k) \
        acc[ai][bj][m][n] = __builtin_amdgcn_mfma_f32_16x16x32_bf16(Bt[n][k], At[m][k], acc[ai][bj][m][n], 0, 0, 0); __builtin_amdgcn_s_setprio(0); } while (0)
#define PG8_WAIT_V(n) asm volatile("s_waitcnt vmcnt(" #n ")" ::: "memory")
#define PG8_WAIT_L(n) asm volatile("s_waitcnt lgkmcnt(" #n ")" ::: "memory")
#define PG8_BAR __builtin_amdgcn_s_barrier()
#define PG8_SCHED __builtin_amdgcn_sched_barrier(0)
    Unit cur, nxt; int ui = 0;
    if (!S.next(0, cur)) return;
    f32x4 acc[2][2][4][2];
#pragma unroll
    for (int a = 0; a < 2; ++a)
#pragma unroll
        for (int b = 0; b < 2; ++b)
#pragma unroll
            for (int m = 0; m < 4; ++m)
#pragma unroll
                for (int n = 0; n < 2; ++n) acc[a][b][m][n] = (f32x4){0.f, 0.f, 0.f, 0.f};
    bf16x8 At[4][2], B0[2][2], B1[2][2];
    const char* cA = (const char*)g.A + (size_t)cur.pm * tstep; const char* cB = (const char*)g.Bt + (size_t)cur.pn * tstep;
    S.a_ready(cur);
    if constexpr (SP2) {
        PG8_STAGE(PG8_SB(0, 0), cB, voffB); PG8_STAGE(PG8_SB(0, 1), cB + hstep, voffB); PG8_STAGE(PG8_SA(0, 0), cA, voffA); PG8_STAGE(PG8_SA(0, 1), cA + hstep, voffA);
        if (wr == 1) PG8_BAR;
        PG8_WAIT_V(2); PG8_BAR;
        PG8_STAGE(PG8_SB(1, 0), cB + kstep, voffB); PG8_STAGE(PG8_SA(1, 0), cA + kstep, voffA); PG8_STAGE(PG8_SB(1, 1), cB + hstep + kstep, voffB);
        PG8_WAIT_V(6); PG8_BAR;
    } else {
        PG8_STAGE(PG8_SB(0, 0), cB, voffB); PG8_STAGE(PG8_SA(0, 0), cA, voffA); PG8_STAGE(PG8_SB(0, 1), cB + hstep, voffB); PG8_STAGE(PG8_SA(0, 1), cA + hstep, voffA);
        if (wr == 1) PG8_BAR;
        PG8_WAIT_V(4); PG8_BAR;
        PG8_STAGE(PG8_SB(1, 0), cB + kstep, voffB); PG8_STAGE(PG8_SA(1, 0), cA + kstep, voffA); PG8_STAGE(PG8_SB(1, 1), cB + hstep + kstep, voffB);
        PG8_WAIT_V(6); PG8_BAR;
    }
    for (;;) {
        const bool has_next = S.next(ui + 1, nxt);
        const char* nA = has_next ? (const char*)g.A + (size_t)nxt.pm * tstep : cA; const char* nB = has_next ? (const char*)g.Bt + (size_t)nxt.pn * tstep : cB;
        for (int t = 0; t < nt; t += 2) {
            const bool last = (t == nt - 2);
            const char* a1 = cA + (size_t)(t + 1) * kstep;
            const char* a2 = last ? nA : cA + (size_t)(t + 2) * kstep; const char* b2 = last ? nB : cB + (size_t)(t + 2) * kstep;
            const char* a3 = a2 + kstep; const char* b3 = b2 + kstep;
            if (last && has_next) S.a_ready(nxt);
            if constexpr (SP2) {
            PG8_LDB(B0, 0, 0); PG8_LDB(B1, 0, 1); PG8_SCHED; PG8_LDA(At, 0, 0); PG8_STAGE(PG8_SA(1, 1), a1 + hstep, voffA);
            PG8_WAIT_V(8); PG8_WAIT_L(0); PG8_BAR; PG8_MMA(0, 0, At, B0); PG8_MMA(0, 1, At, B1); PG8_BAR; PG8_SCHED;
            PG8_LDA(At, 0, 1); PG8_STAGE(PG8_SB(0, 0), b2, voffB); PG8_STAGE(PG8_SB(0, 1), b2 + hstep, voffB); PG8_STAGE(PG8_SA(0, 0), a2, voffA);
            PG8_WAIT_V(8); PG8_WAIT_L(0); PG8_BAR; PG8_MMA(1, 0, At, B0); PG8_MMA(1, 1, At, B1); PG8_BAR; PG8_SCHED;
            PG8_LDB(B0, 1, 0); PG8_LDB(B1, 1, 1); PG8_SCHED; PG8_LDA(At, 1, 0); PG8_STAGE(PG8_SA(0, 1), a2 + hstep, voffA);
            PG8_WAIT_V(8); PG8_WAIT_L(0); PG8_BAR; PG8_MMA(0, 0, At, B0); PG8_MMA(0, 1, At, B1); PG8_BAR; PG8_SCHED;
            PG8_LDA(At, 1, 1); PG8_STAGE(PG8_SB(1, 0), b3, voffB); PG8_STAGE(PG8_SB(1, 1), b3 + hstep, voffB); PG8_STAGE(PG8_SA(1, 0), a3, voffA);
            PG8_WAIT_V(8); PG8_WAIT_L(0); PG8_BAR; PG8_MMA(1, 0, At, B0); PG8_MMA(1, 1, At, B1); PG8_BAR; PG8_SCHED;
            } else {
            PG8_LDB(B0, 0, 0); PG8_SCHED; PG8_LDA(At, 0, 0); PG8_STAGE(PG8_SA(1, 1), a1 + hstep, voffA);
            PG8_WAIT_L(8); PG8_BAR; PG8_WAIT_L(0); PG8_MMA(0, 0, At, B0); PG8_BAR; PG8_SCHED;
            PG8_LDB(B1, 0, 1); PG8_STAGE(PG8_SB(0, 0), b2, voffB);
            PG8_BAR; PG8_WAIT_L(0); PG8_MMA(0, 1, At, B1); PG8_BAR;
            PG8_LDA(At, 0, 1); PG8_STAGE(PG8_SA(0, 0), a2, voffA);
            PG8_BAR; PG8_WAIT_L(0); PG8_MMA(1, 0, At, B0); PG8_BAR; PG8_SCHED;
            PG8_STAGE(PG8_SB(0, 1), b2 + hstep, voffB);
            PG8_WAIT_V(6); PG8_BAR; PG8_MMA(1, 1, At, B1); PG8_BAR;
            PG8_LDB(B0, 1, 0); PG8_SCHED; PG8_LDA(At, 1, 0); PG8_STAGE(PG8_SA(0, 1), a2 + hstep, voffA);
            PG8_WAIT_L(8); PG8_BAR; PG8_WAIT_L(0); PG8_MMA(0, 0, At, B0); PG8_BAR; PG8_SCHED;
            PG8_LDB(B1, 1, 1); PG8_STAGE(PG8_SB(1, 0), b3, voffB);
            PG8_BAR; PG8_WAIT_L(0); PG8_MMA(0, 1, At, B1); PG8_BAR;
            PG8_LDA(At, 1, 1); PG8_STAGE(PG8_SA(1, 0), a3, voffA);
            PG8_BAR; PG8_WAIT_L(0); PG8_MMA(1, 0, At, B0); PG8_BAR; PG8_SCHED;
            PG8_STAGE(PG8_SB(1, 1), b3 + hstep, voffB);
            PG8_WAIT_V(6); PG8_BAR; PG8_MMA(1, 1, At, B1); PG8_BAR;
            }
        }
        if constexpr (ALIGN_EPI) { if (wr == 0) PG8_BAR; }
        if constexpr (!Epi::AFTER_DRAIN) { E(acc, cur, wr, wc, fr, fq); S.done(cur); }
        if (!has_next) break;
#pragma unroll
        for (int a = 0; a < 2; ++a)
#pragma unroll
            for (int b = 0; b < 2; ++b)
#pragma unroll
                for (int m = 0; m < 4; ++m)
#pragma unroll
                    for (int n = 0; n < 2; ++n) acc[a][b][m][n] = (f32x4){0.f, 0.f, 0.f, 0.f};
        cur = nxt; cA = nA; cB = nB; ++ui;
        if constexpr (ALIGN_EPI) { if (wr == 1) PG8_BAR; }
    }
    PG8_WAIT_V(0);
    if constexpr (!ALIGN_EPI) { if (wr == 0) PG8_BAR; }
    PG8_BAR;
    if constexpr (Epi::AFTER_DRAIN) { E.fused(acc, cur, wr, wc, fr, fq, lds, wid, lane); S.done(cur); }
#undef PG8_SA
#undef PG8_SB
#undef PG8_STAGE
#undef PG8_LDA
#undef PG8_LDB
#undef PG8_MMA
#undef PG8_WAIT_V
#undef PG8_WAIT_L
#undef PG8_BAR
#undef PG8_SCHED
}
}

DI u32x2 pack4(f32x4 v) { u32x2 r; r.x = cvtpk(v.x, v.y); r.y = cvtpk(v.z, v.w); return r; }
DI u32x4 pack8(f32x4 a, f32x4 b) { u32x4 r; r.x = cvtpk(a.x, a.y); r.y = cvtpk(a.z, a.w); r.z = cvtpk(b.x, b.y); r.w = cvtpk(b.z, b.w); return r; }

struct Epi1 {
    static constexpr bool PERM = true, AFTER_DRAIN = false;
    unsigned char* ws;
    DI void operator()(const f32x4 (&acc)[2][2][4][2], const pg8::Unit& u, int wr, int wc, int fr, int fq) const {
        const float* r1p = (const float*)(ws + WS_R1);
        const float* rope = (const float*)(ws + WS_ROPE);
        const float* lbp = (const float*)(ws + WS_LB);
        const int seg = u.pn >> 1;
#pragma unroll
        for (int ai = 0; ai < 2; ++ai)
#pragma unroll
            for (int m = 0; m < 4; ++m) {
                const int row = u.pm * 256 + ai * 128 + wr * 64 + m * 16 + fr;
                const bool meta = row >= NTOK;
                if (row >= NTOK + NMETA) continue;
                const float r1 = r1p[row];
                const int b = meta ? 0 : (row >> 12), t = meta ? (row - NTOK) : ((row & 4095) + NMETA);
                const int nrep = meta ? BATCH : 1;
#pragma unroll
                for (int bj = 0; bj < 2; ++bj) {
                    const int cs = (u.pn & 1) * 256 + bj * 128 + wc * 32 + 8 * fq;
                    const f32x4 v0 = acc[ai][bj][m][0] * r1, v1 = acc[ai][bj][m][1] * r1;
                    const int h = cs >> 7;
                    if (seg <= 1) {
                        const int comp = (cs >> 6) & 1, cc = cs & 63, i0 = 16 * (cc >> 5) + 4 * fq;
                        const f32x4 c4 = *(const f32x4*)(rope + (size_t)t * 64 + i0), s4 = *(const f32x4*)(rope + (size_t)t * 64 + 32 + i0);
                        f32x4 lo = v0 * c4 - v1 * s4, hi = v1 * c4 + v0 * s4;
                        if (seg == 0) {
                            if (meta) continue;
                            lo = lo * QSCALE; hi = hi * QSCALE;
                            bf16_t* qp = (bf16_t*)(ws + WS_Q) + ((size_t)(((b * 4 + h) * 2 + comp) * SEQ + (row & 4095))) * 64;
                            *(u32x2*)(qp + i0) = pack4(lo); *(u32x2*)(qp + i0 + 32) = pack4(hi);
                        } else {
                            const int pp = t + KPAD, tile = pp >> 6, key = pp & 63;
                            for (int bb = 0; bb < nrep; ++bb) {
                                const int b_ = meta ? bb : b;
                                unsigned char* img = ws + WS_K + ((size_t)((b_ * 4 + h) * 2 + comp) * KT + tile) * 8192;
                                *(u32x2*)(img + (i0 >> 3) * 1024 + key * 16 + (i0 & 7) * 2) = pack4(lo);
                                *(u32x2*)(img + ((i0 >> 3) + 4) * 1024 + key * 16 + (i0 & 7) * 2) = pack4(hi);
                            }
                        }
                    } else if (seg == 2) {
                        const int dv = cs & 127, pp = t + KPAD, tile = pp >> 6, key = pp & 63;
                        const u32x4 w = pack8(v0, v1);
                        for (int bb = 0; bb < nrep; ++bb) {
                            const int b_ = meta ? bb : b;
                            unsigned char* img = ws + WS_V + ((size_t)(b_ * 4 + h) * KT + tile) * 16384;
                            *(u32x4*)(img + (dv >> 5) * 4096 + key * 64 + (dv & 31) * 2) = w;
                        }
                    } else if (seg == 3 || seg == 5) {
                        const int dv = cs & 127;
                        f32x4 a = v0, c = v1;
                        if (seg == 3) { a.x = siluf_(a.x); a.y = siluf_(a.y); a.z = siluf_(a.z); a.w = siluf_(a.w); c.x = siluf_(c.x); c.y = siluf_(c.y); c.z = siluf_(c.z); c.w = siluf_(c.w); }
                        const u32x4 w = pack8(a, c);
                        const size_t base = (seg == 3) ? WS_HQ : WS_HV;
                        for (int bb = 0; bb < nrep; ++bb) {
                            const int b_ = meta ? bb : b;
                            *(u32x4*)((bf16_t*)(ws + base) + ((size_t)(b_ * 4 + h) * HT + t + 16) * 128 + dv) = w;
                        }
                    } else if (seg == 4) {
                        const int dv = cs & 127;
                        const f32x4 l0 = *(const f32x4*)(lbp + cs), l1 = *(const f32x4*)(lbp + cs + 4);
                        f32x4 g0, g1;
#pragma unroll
                        for (int e = 0; e < 4; ++e) { g0[e] = __logf(l0[e] + (1.f - l0[e]) * sigmoidf_(v0[e])); g1[e] = __logf(l1[e] + (1.f - l1[e]) * sigmoidf_(v1[e])); }
                        for (int bb = 0; bb < nrep; ++bb) {
                            const int b_ = meta ? bb : b;
                            float* gp = (float*)(ws + WS_HG) + ((size_t)(b_ * 4 + h) * HT + t + 16) * 128 + dv;
                            *(f32x4*)gp = g0; *(f32x4*)(gp + 4) = g1;
                        }
                    } else {
                        if (meta) continue;
                        f32x4 a = v0, c = v1;
                        a.x = siluf_(a.x); a.y = siluf_(a.y); a.z = siluf_(a.z); a.w = siluf_(a.w); c.x = siluf_(c.x); c.y = siluf_(c.y); c.z = siluf_(c.z); c.w = siluf_(c.w);
                        *(u32x4*)((bf16_t*)(ws + WS_SG) + (size_t)row * 512 + cs) = pack8(a, c);
                    }
                }
            }
    }
};

struct Epi3 {
    static constexpr bool PERM = true, AFTER_DRAIN = false;
    const float* x; float* H; bf16_t* HB; float* ssq;
    DI void operator()(const f32x4 (&acc)[2][2][4][2], const pg8::Unit& u, int wr, int wc, int fr, int fq) const {
#pragma unroll
        for (int ai = 0; ai < 2; ++ai)
#pragma unroll
            for (int m = 0; m < 4; ++m) {
                const int row = u.pm * 256 + ai * 128 + wr * 64 + m * 16 + fr;
                float s = 0.f;
#pragma unroll
                for (int bj = 0; bj < 2; ++bj) {
                    const int col = u.pn * 256 + bj * 128 + wc * 32 + 8 * fq;
                    const size_t o = (size_t)row * DM + col;
                    const u32x4 xb = *(const u32x4*)(HB + o);
                    const f32x4 x0 = (f32x4){bf2f(xb.x & 0xffffu), bf2f(xb.x >> 16), bf2f(xb.y & 0xffffu), bf2f(xb.y >> 16)}, x1 = (f32x4){bf2f(xb.z & 0xffffu), bf2f(xb.z >> 16), bf2f(xb.w & 0xffffu), bf2f(xb.w >> 16)};
                    const f32x4 h0 = x0 + acc[ai][bj][m][0], h1 = x1 + acc[ai][bj][m][1];
                    *(u32x4*)(HB + o) = pack8(h0, h1);
                    s += (h0.x * h0.x + h0.y * h0.y) + (h0.z * h0.z + h0.w * h0.w) + (h1.x * h1.x + h1.y * h1.y) + (h1.z * h1.z + h1.w * h1.w);
                }
                s += __shfl_xor(s, 16); s += __shfl_xor(s, 32);
                if (fq == 0) atomicAdd(ssq + row, s);
            }
    }
};

struct Epi4 {
    static constexpr bool PERM = true, AFTER_DRAIN = false;
    const float* ssq; bf16_t* PQ;
    DI void operator()(const f32x4 (&acc)[2][2][4][2], const pg8::Unit& u, int wr, int wc, int fr, int fq) const {
#pragma unroll
        for (int ai = 0; ai < 2; ++ai)
#pragma unroll
            for (int m = 0; m < 4; ++m) {
                const int row = u.pm * 256 + ai * 128 + wr * 64 + m * 16 + fr;
                const float r2 = 1.f / sqrtf(ssq[row] * (1.f / DM) + EPS);
#pragma unroll
                for (int bj = 0; bj < 2; ++bj) {
                    const int col = u.pn * 256 + bj * 128 + wc * 32 + 8 * fq;
                    *(u32x4*)(PQ + (size_t)row * 2048 + col) = pack8(acc[ai][bj][m][0] * r2, acc[ai][bj][m][1] * r2);
                }
            }
    }
};

template <class Epi>
DI void gemm_run(char* lds, const bf16_t* A, const bf16_t* Bt, int M, int N, int K, const Epi& E, int bid, int nblk) {
    pg8::Gemm g{A, Bt, M, N, K}; pg8::StaticOrder S; S.init(M, N, nblk, bid);
    pg8::gemm_phase<Epi, pg8::StaticOrder, true, true>((LAS unsigned char*)lds, g, S, E);
}
#define MFMA32(a, b, c) __builtin_amdgcn_mfma_f32_32x32x16_bf16(a, b, c, 0, 0, 0)
typedef short v4i16_t __attribute__((ext_vector_type(4)));
DI int crow(int r, int hi) { return (r & 3) + 8 * (r >> 2) + 4 * hi; }
DI s16x4 vtr(const LAS char* p) { return __builtin_bit_cast(s16x4, __builtin_amdgcn_ds_read_tr16_b64_v4i16((LAS v4i16_t*)p)); }
DI void glds16(const void* g, LAS char* l) { __builtin_amdgcn_global_load_lds((const unsigned*)g, (LAS unsigned*)l, 16, 0, 0); }
DI float swap_max(float m) { auto rr = __builtin_amdgcn_permlane32_swap(__float_as_uint(m), __float_as_uint(m), false, false); return fmaxf(__uint_as_float(rr[0]), __uint_as_float(rr[1])); }
DI float swap_sum(float m) { auto rr = __builtin_amdgcn_permlane32_swap(__float_as_uint(m), __float_as_uint(m), false, false); return __uint_as_float(rr[0]) + __uint_as_float(rr[1]); }
constexpr int ATT_BUF = 32768, ATT_WSF = 65536;
constexpr float ATT_THR = 8.f;

DI void attn_unit(const Params& P, int b, int h, int j, char* lds_g) {
    LAS char* lds = (LAS char*)lds_g;
    const int tid = tid_(), lane = tid & 63, r32 = lane & 31, hi = lane >> 5;
    const int wid = __builtin_amdgcn_readfirstlane(tid >> 6), comp = wid >> 2, wq = wid & 3;
    const unsigned char* ws = P.ws;
    const int bh = b * 4 + h;
    const bf16_t* Qw = (const bf16_t*)(ws + WS_Q) + ((size_t)((bh * 2 + comp) * SEQ + 128 * j + 32 * wq)) * 64;
    bf16x8 qr[4];
#pragma unroll
    for (int d0 = 0; d0 < 4; ++d0) qr[d0] = *(const bf16x8*)(Qw + r32 * 64 + d0 * 16 + hi * 8);
    const unsigned char* kimg0 = ws + WS_K + (size_t)(bh * 2) * KT * 8192 + wid * 1024 + lane * 16;
    const unsigned char* kimg1 = kimg0 + (size_t)KT * 8192;
    const unsigned char* vimg = ws + WS_V + (size_t)bh * KT * 16384 + wid * 1024 + lane * 16;
    const int NT = 2 * j + 3, my_last = (wq < 2) ? 2 * j + 1 : 2 * j + 2;
    LAS float* wsf = (LAS float*)(lds + ATT_WSF) + wid * 64;
#define ATT_ISSUE(t, s) do { LAS char* d_ = lds + (s) * ATT_BUF + wid * 1024; \
        glds16(kimg0 + (size_t)(t) * 8192, d_); glds16(kimg1 + (size_t)(t) * 8192, d_ + 8192); \
        glds16(vimg + (size_t)(t) * 16384, d_ + 16384); glds16(vimg + (size_t)(t) * 16384 + 8192, d_ + 24576); } while (0)
    f32x16 o[4];
#pragma unroll
    for (int nb = 0; nb < 4; ++nb) o[nb] = f32x16{};
    float mref = 0.f, lsum = 0.f;
    const int qpos = 64 + 128 * j + 32 * wq + r32;
    ATT_ISSUE(0, 0);
    __syncthreads();
    for (int t = 0; t < NT; ++t) {
        const int s = t & 1;
        if (t + 1 < NT) ATT_ISSUE(t + 1, s ^ 1);
        if (t <= my_last) {
            const LAS char* kp = lds + s * ATT_BUF + comp * 8192 + hi * 1024 + r32 * 16;
            f32x16 s0 = f32x16{}, s1 = f32x16{};
#pragma unroll
            for (int d0 = 0; d0 < 4; ++d0) {
                const bf16x8 k0 = *(const LAS bf16x8*)(kp + d0 * 2048), k1 = *(const LAS bf16x8*)(kp + d0 * 2048 + 512);
                s0 = MFMA32(k0, qr[d0], s0); s1 = MFMA32(k1, qr[d0], s1);
            }
            if (t == 0) {
#pragma unroll
                for (int r = 0; r < 16; ++r) { s0[r] = -INFINITY; if (32 + crow(r, hi) < KPAD) s1[r] = -INFINITY; }
            }
            if (t >= 2 * j + 1) {
                const int kb = 64 * t + 4 * hi;
#pragma unroll
                for (int r = 0; r < 16; ++r) { const int kv = kb + (r & 3) + 8 * (r >> 2); if (kv > qpos) s0[r] = -INFINITY; if (kv + 32 > qpos) s1[r] = -INFINITY; }
            }
            float rm = fmaxf(s0[0], s1[0]);
#pragma unroll
            for (int r = 1; r < 16; ++r) rm = fmaxf(rm, fmaxf(s0[r], s1[r]));
            rm = swap_max(rm);
            if (t == 0) mref = rm;
            else {
                const float grow = rm - mref;
                if (__any(grow > ATT_THR)) {
                    const float dl = fmaxf(grow, 0.f), f = __builtin_amdgcn_exp2f(-dl);
                    mref += dl; lsum *= f;
                    if (hi == 0) wsf[r32] = f;
                    asm volatile("s_waitcnt lgkmcnt(0)" ::: "memory");
#pragma unroll
                    for (int r = 0; r < 16; ++r) { const float fr_ = wsf[crow(r, hi)];
#pragma unroll
                        for (int nb = 0; nb < 4; ++nb) o[nb][r] *= fr_; }
                }
            }
            float ps = 0.f;
#pragma unroll
            for (int r = 0; r < 16; ++r) { s0[r] = __builtin_amdgcn_exp2f(s0[r] - mref); s1[r] = __builtin_amdgcn_exp2f(s1[r] - mref); ps += s0[r] + s1[r]; }
            lsum += ps;
            const LAS char* vp = lds + s * ATT_BUF + 16384 + ((lane >> 4) & 1) * 32 + (lane & 3) * 8 + (4 * hi + ((lane & 15) >> 2)) * 64;
#pragma unroll
            for (int ks = 0; ks < 4; ++ks) {
                u32x4 pw;
                if (ks < 2) { pw.x = cvtpk(s0[8 * ks], s0[8 * ks + 1]); pw.y = cvtpk(s0[8 * ks + 2], s0[8 * ks + 3]); pw.z = cvtpk(s0[8 * ks + 4], s0[8 * ks + 5]); pw.w = cvtpk(s0[8 * ks + 6], s0[8 * ks + 7]); }
                else { const int q_ = ks - 2; pw.x = cvtpk(s1[8 * q_], s1[8 * q_ + 1]); pw.y = cvtpk(s1[8 * q_ + 2], s1[8 * q_ + 3]); pw.z = cvtpk(s1[8 * q_ + 4], s1[8 * q_ + 5]); pw.w = cvtpk(s1[8 * q_ + 6], s1[8 * q_ + 7]); }
                const bf16x8 pa = __builtin_bit_cast(bf16x8, pw);
#pragma unroll
                for (int nb = 0; nb < 4; ++nb) {
                    const s16x4 vlo = vtr(vp + nb * 4096 + ks * 1024), vhi = vtr(vp + nb * 4096 + ks * 1024 + 512);
                    const bf16x8 vb = (bf16x8){vlo[0], vlo[1], vlo[2], vlo[3], vhi[0], vhi[1], vhi[2], vhi[3]};
                    o[nb] = MFMA32(pa, vb, o[nb]);
                }
            }
        }
        __syncthreads();
    }
#undef ATT_ISSUE
    lsum = swap_sum(lsum);
    if (hi == 0) wsf[r32] = lsum;
    asm volatile("s_waitcnt lgkmcnt(0)" ::: "memory");
    float rli[16];
#pragma unroll
    for (int r = 0; r < 16; ++r) rli[r] = 1.f / wsf[crow(r, hi)];
    const float lam = ((const float*)(ws + WS_LB))[512];
    LAS float* ex = (LAS float*)lds + wq * 4096;
    if (comp == 1) {
#pragma unroll
        for (int r = 0; r < 16; ++r)
#pragma unroll
            for (int nb = 0; nb < 4; ++nb) ex[(r * 4 + nb) * 64 + lane] = o[nb][r] * rli[r] * lam;
    }
    __syncthreads();
    if (comp == 0) {
        float ss[16];
#pragma unroll
        for (int r = 0; r < 16; ++r) { float a = 0.f;
#pragma unroll
            for (int nb = 0; nb < 4; ++nb) { const float v = o[nb][r] * rli[r] - ex[(r * 4 + nb) * 64 + lane]; o[nb][r] = v; a += v * v; }
            ss[r] = a; }
#pragma unroll
        for (int r = 0; r < 16; ++r) { float a = ss[r]; a += __shfl_xor(a, 1); a += __shfl_xor(a, 2); a += __shfl_xor(a, 4); a += __shfl_xor(a, 8); a += __shfl_xor(a, 16); ss[r] = (1.f - LAM_INIT) / sqrtf(a * (1.f / 128.f) + EPS); }
        bf16_t* mix = (bf16_t*)(ws + WS_MIX) + ((size_t)(b * SEQ + 128 * j + 32 * wq)) * DM + h * 128;
#pragma unroll
        for (int nb = 0; nb < 4; ++nb) { const float w = P.subln_w[32 * nb + r32];
#pragma unroll
            for (int r = 0; r < 16; ++r) mix[(size_t)crow(r, hi) * DM + 32 * nb + r32] = (bf16_t)f2bf(o[nb][r] * ss[r] * w); }
    }
    __syncthreads();
}
#define MFMA16(a, b, c) __builtin_amdgcn_mfma_f32_16x16x32_bf16(a, b, c, 0, 0, 0)
constexpr int HG_STR = 272;
constexpr int HL_QA = 0, HL_QB = HL_QA + 32 * HG_STR, HL_KB = HL_QB + 32 * HG_STR, HL_KT = HL_KB + 32 * HG_STR, HL_VV = HL_KT + 32 * HG_STR;
constexpr int HL_PS = HL_VV + 32 * HG_STR;
constexpr int HL_D = HL_PS + 4 * 128 * 4;
constexpr int HL_OUT = HL_D + 128 * 4;
constexpr int HL_END = HL_OUT + 32 * 132 * 4;

constexpr int HB_KTF = 0, HB_ATF = 8192, HB_DF = 10240;
DI void hgrn_prep_item(const Params& P, int bh, int c, char* lds_g) {
    LAS char* lds = (LAS char*)lds_g;
    const int tid = tid_(), lane = tid & 63, c16 = lane & 15, g4 = lane >> 4, ch = tid & 127, part = tid >> 7;
    const int wid = __builtin_amdgcn_readfirstlane(tid >> 6);
    const int vrow = tid >> 4, vcol = (tid & 15) * 8;
    unsigned char* ws = P.ws;
    const float* HG = (const float*)(ws + WS_HG) + (size_t)bh * HT * 128;
    const bf16_t* HQ = (const bf16_t*)(ws + WS_HQ) + (size_t)bh * HT * 128;
    const bf16_t* HV = (const bf16_t*)(ws + WS_HV) + (size_t)bh * HT * 128;
    const size_t r0 = (size_t)(32 * c + 8 * part);
    float g8[8], p8[8]; unsigned short q8[8];
    { float a = 0.f;
#pragma unroll
      for (int e = 0; e < 8; ++e) { g8[e] = HG[(r0 + e) * 128 + ch]; q8[e] = HQ[(r0 + e) * 128 + ch]; a += g8[e]; p8[e] = a; } }
    const u32x4 v16 = *(const u32x4*)(HV + ((size_t)(32 * c) + vrow) * 128 + vcol);
    ((LAS float*)(lds + HL_PS))[part * 128 + ch] = p8[7];
    __syncthreads();
    {
        const LAS float* ps = (const LAS float*)(lds + HL_PS);
        const float t0 = ps[ch], t1 = ps[128 + ch], t2 = ps[256 + ch], t3 = ps[384 + ch];
        const float off = (part > 0 ? t0 : 0.f) + (part > 1 ? t1 : 0.f) + (part > 2 ? t2 : 0.f);
        const float mid = t0 + t1, last = mid + t2 + t3;
        const float em = __expf(mid), el = __expf(last - mid);
        if (part == 0) ((LAS float*)(lds + HL_D))[ch] = __expf(last);
#pragma unroll
        for (int e = 0; e < 8; ++e) {
            const int tk = 8 * part + e;
            const float cum = off + p8[e];
            const float e1 = __expf(cum - mid), e2 = 1.f / e1;
            const float q = bf2f(q8[e]), k = 1.f - __expf(g8[e]);
            const float qb = q * e1, qa = qb * em, kb = k * e2, kt = kb * el;
            *(LAS bf16_t*)(lds + HL_QA + tk * HG_STR + ch * 2) = (bf16_t)f2bf(qa);
            *(LAS bf16_t*)(lds + HL_QB + tk * HG_STR + ch * 2) = (bf16_t)f2bf(qb);
            *(LAS bf16_t*)(lds + HL_KB + tk * HG_STR + ch * 2) = (bf16_t)f2bf(kb);
            *(LAS bf16_t*)(lds + HL_KT + tk * HG_STR + ch * 2) = (bf16_t)f2bf(kt);
        }
        *(LAS u32x4*)(lds + HL_VV + vrow * HG_STR + vcol * 2) = v16;
    }
    __syncthreads();
    unsigned char* qaf = ws + WS_HQA + ((size_t)bh * 129 + c) * 8192;
    unsigned char* hgb = ws + WS_HG + (size_t)bh * HT * 512 + (size_t)c * 16384;
    {
        const int ks = wid >> 1, nt = wid & 1;
        const LAS char* qp = lds + HL_QA + (16 * nt + c16) * HG_STR + (32 * ks + 4 * g4) * 2;
        const u32x2 lo = *(const LAS u32x2*)qp, hi2 = *(const LAS u32x2*)(qp + 32);
        *(u32x4*)(qaf + wid * 1024 + lane * 16) = (u32x4){lo.x, lo.y, hi2.x, hi2.y};
        const LAS char* kp = lds + HL_KT + (8 * g4 + (c16 >> 2)) * HG_STR + (16 * wid + 4 * (c16 & 3)) * 2;
        const s16x4 klo = vtr(kp), khi = vtr(kp + 4 * HG_STR);
        *(bf16x8*)(hgb + HB_KTF + wid * 1024 + lane * 16) = (bf16x8){klo[0], klo[1], klo[2], klo[3], khi[0], khi[1], khi[2], khi[3]};
    }
    if (wid == 0) {
        f32x4 at00 = (f32x4){0.f, 0.f, 0.f, 0.f}, at01 = at00, at11 = at00;
#pragma unroll
        for (int ks = 0; ks < 4; ++ks) {
            const bf16x8 ka0 = *(const LAS bf16x8*)(lds + HL_KB + c16 * HG_STR + (32 * ks + 8 * g4) * 2);
            const bf16x8 ka1 = *(const LAS bf16x8*)(lds + HL_KB + (16 + c16) * HG_STR + (32 * ks + 8 * g4) * 2);
            const bf16x8 qn0 = *(const LAS bf16x8*)(lds + HL_QB + c16 * HG_STR + (32 * ks + 8 * g4) * 2);
            const bf16x8 qn1 = *(const LAS bf16x8*)(lds + HL_QB + (16 + c16) * HG_STR + (32 * ks + 8 * g4) * 2);
            at00 = MFMA16(ka0, qn0, at00); at01 = MFMA16(ka0, qn1, at01); at11 = MFMA16(ka1, qn1, at11);
        }
#pragma unroll
        for (int r = 0; r < 4; ++r) { if (4 * g4 + r > c16) { at00[r] = 0.f; at11[r] = 0.f; } }
        u32x4 b0; b0.x = cvtpk(at00[0], at00[1]); b0.y = cvtpk(at00[2], at00[3]); b0.z = 0u; b0.w = 0u;
        u32x4 b1; b1.x = cvtpk(at01[0], at01[1]); b1.y = cvtpk(at01[2], at01[3]); b1.z = cvtpk(at11[0], at11[1]); b1.w = cvtpk(at11[2], at11[3]);
        *(u32x4*)(hgb + HB_ATF + lane * 16) = b0; *(u32x4*)(hgb + HB_ATF + 1024 + lane * 16) = b1;
    } else if (wid == 1 && lane < 32) {
        *(f32x4*)(hgb + HB_DF + lane * 16) = *(const LAS f32x4*)(lds + HL_D + lane * 16);
    }
    __syncthreads();
}

constexpr int RS_QAF = 0, RS_HGB = 8192, RS_V = 19456, RS_SLOT = 27648, RS_NSLOT = 5;
constexpr int RS_OUT = RS_NSLOT * RS_SLOT, RS_OUTB = 32 * 136 * 2, RS_END = RS_OUT + 2 * RS_OUTB;
static_assert(RS_END <= LDS_ITEM, "hgrn LDS map");
DI void glds16_asm(const void* g, unsigned lds_base) {
    unsigned sv; asm volatile("s_mov_b32 %0, m0\n\ts_mov_b32 m0, %2\n\ts_nop 0\n\tglobal_load_lds_dwordx4 %1, off\n\ts_mov_b32 m0, %0" : "=&s"(sv) : "v"(g), "s"(lds_base) : "memory"); }
#define HW_BAR() asm volatile("s_waitcnt lgkmcnt(0)\n\ts_barrier" ::: "memory")
DI void glds16_sb(unsigned voff, const void* sbase, unsigned lds_base) {
    unsigned sv; asm volatile("s_mov_b32 %0, m0\n\ts_mov_b32 m0, %3\n\ts_nop 0\n\tglobal_load_lds_dwordx4 %1, %2\n\ts_mov_b32 m0, %0" : "=&s"(sv) : "v"(voff), "s"(sbase), "s"(lds_base) : "memory"); }
DI void hgrn_unit(const Params& P, int b, int h, char* lds_g) {
    LAS char* lds = (LAS char*)lds_g;
    const int tid = tid_(), lane = tid & 63, c16 = lane & 15, g4 = lane >> 4;
    const int wid = __builtin_amdgcn_readfirstlane(tid >> 6);
    const unsigned char* ws = P.ws;
    const int bh = b * 4 + h;
    const unsigned lbase = (unsigned)__builtin_amdgcn_readfirstlane((int)(unsigned)(size_t)lds);
    constexpr int AHEAD = RS_NSLOT - 1;
    if (wid < 4) {
        const unsigned char* qafg = ws + WS_HQA + (size_t)bh * 129 * 8192;
        const unsigned char* hgbg = ws + WS_HG + (size_t)bh * HT * 512;
        const unsigned char* vg = ws + WS_HV + (size_t)bh * HT * 256;
        const unsigned voff = (unsigned)lane * 16u;
        auto issue = [&](int c) {
            const unsigned sb = lbase + (unsigned)((c % RS_NSLOT) * RS_SLOT);
#pragma unroll
            for (int k = 0; k < 7; ++k) {
                const int p = wid + 4 * k;
                if (p < 19) { const unsigned char* src = (p < 8) ? qafg + (size_t)c * 8192 + p * 1024 : hgbg + (size_t)c * 16384 + (p - 8) * 1024; glds16_sb(voff, src, sb + (unsigned)p * 1024u); }
                else if (p < 27) { const int r4 = 4 * (p - 19);
                    const unsigned vo = (unsigned)(lane >> 4) * 256u + (unsigned)(((lane & 15) ^ ((((r4 & 7) + (lane >> 4)) & 7) << 1)) * 16);
                    glds16_sb(vo, vg + ((size_t)(32 * c) + r4) * 256, sb + (unsigned)p * 1024u); }
            }
        };
        f32x4 S[2][8];
#pragma unroll
        for (int t = 0; t < 2; ++t)
#pragma unroll
            for (int i = 0; i < 8; ++i) S[t][i] = (f32x4){0.f, 0.f, 0.f, 0.f};
#pragma unroll
        for (int c = 0; c < AHEAD; ++c) issue(c);
        for (int c = 0; c < 129; ++c) {
            if (c + AHEAD - 1 > 128) asm volatile("s_waitcnt vmcnt(0)" ::: "memory");
            else if (wid < 3) asm volatile("s_waitcnt vmcnt(21)" ::: "memory"); else asm volatile("s_waitcnt vmcnt(18)" ::: "memory");
            HW_BAR();
            __builtin_amdgcn_sched_barrier(0);
            if (c + AHEAD < 129) issue(c + AHEAD);
            __builtin_amdgcn_sched_barrier(0);
            const LAS char* sl = lds + (c % RS_NSLOT) * RS_SLOT;
            f32x4 oacc[2][2];
#pragma unroll
            for (int t = 0; t < 2; ++t) { oacc[t][0] = (f32x4){0.f, 0.f, 0.f, 0.f}; oacc[t][1] = oacc[t][0]; }
#pragma unroll
            for (int ks = 0; ks < 4; ++ks) {
                const bf16x8 q0 = *(const LAS bf16x8*)(sl + RS_QAF + (2 * ks) * 1024 + lane * 16), q1 = *(const LAS bf16x8*)(sl + RS_QAF + (2 * ks + 1) * 1024 + lane * 16);
#pragma unroll
                for (int t = 0; t < 2; ++t) {
                    u32x4 sp; sp.x = cvtpk(S[t][2 * ks][0], S[t][2 * ks][1]); sp.y = cvtpk(S[t][2 * ks][2], S[t][2 * ks][3]); sp.z = cvtpk(S[t][2 * ks + 1][0], S[t][2 * ks + 1][1]); sp.w = cvtpk(S[t][2 * ks + 1][2], S[t][2 * ks + 1][3]);
                    const bf16x8 sf = __builtin_bit_cast(bf16x8, sp);
                    oacc[t][0] = MFMA16(sf, q0, oacc[t][0]); oacc[t][1] = MFMA16(sf, q1, oacc[t][1]);
                }
            }
            const int vq = c16 >> 2, vp4 = c16 & 3;
#define VTR(row, w_) vtr(sl + RS_V + (row) * 256 + (((2 * (w_) + (vp4 >> 1)) ^ ((((row) & 7)) << 1)) * 16) + 8 * (vp4 & 1))
            {
                const bf16x8 a0 = *(const LAS bf16x8*)(sl + RS_HGB + HB_ATF + lane * 16), a1 = *(const LAS bf16x8*)(sl + RS_HGB + HB_ATF + 1024 + lane * 16);
#pragma unroll
                for (int t = 0; t < 2; ++t) {
                    const s16x4 lo = VTR(4 * g4 + vq, 2 * wid + t), hi2 = VTR(16 + 4 * g4 + vq, 2 * wid + t);
                    const bf16x8 va = (bf16x8){lo[0], lo[1], lo[2], lo[3], hi2[0], hi2[1], hi2[2], hi2[3]};
                    oacc[t][0] = MFMA16(va, a0, oacc[t][0]); oacc[t][1] = MFMA16(va, a1, oacc[t][1]);
                }
            }
            {
                LAS char* ob = lds + RS_OUT + (c & 1) * RS_OUTB;
#pragma unroll
                for (int t = 0; t < 2; ++t)
#pragma unroll
                    for (int nt = 0; nt < 2; ++nt) { u32x2 w; w.x = cvtpk(oacc[t][nt][0], oacc[t][nt][1]); w.y = cvtpk(oacc[t][nt][2], oacc[t][nt][3]);
                        *(LAS u32x2*)(ob + ((16 * nt + c16) * 136 + 16 * (2 * wid + t) + 4 * g4) * 2) = w; }
            }
            {
                bf16x8 vb[2];
#pragma unroll
                for (int t = 0; t < 2; ++t) { const s16x4 lo = VTR(8 * g4 + vq, 2 * wid + t), hi2 = VTR(8 * g4 + 4 + vq, 2 * wid + t); vb[t] = (bf16x8){lo[0], lo[1], lo[2], lo[3], hi2[0], hi2[1], hi2[2], hi2[3]}; }
#pragma unroll
                for (int i = 0; i < 8; ++i) {
                    const f32x4 d4 = *(const LAS f32x4*)(sl + RS_HGB + HB_DF + (16 * i + 4 * g4) * 4);
                    const bf16x8 ka = *(const LAS bf16x8*)(sl + RS_HGB + HB_KTF + i * 1024 + lane * 16);
                    S[0][i] = MFMA16(ka, vb[0], S[0][i] * d4); S[1][i] = MFMA16(ka, vb[1], S[1][i] * d4);
                }
            }
#undef VTR
        }
        HW_BAR();
        HW_BAR();
    } else {
        const int tq = tid - 256, tok = tq >> 3, part = tq & 7;
        const bf16_t* sgg = (const bf16_t*)(ws + WS_SG) + ((size_t)b * SEQ + tok) * 512 + h * 128 + 16 * part;
        f32x4 nw[4];
#pragma unroll
        for (int q = 0; q < 4; ++q) nw[q] = *(const f32x4*)(P.rec_norm_w + h * 128 + 16 * part + 4 * q);
        auto epilogue = [&](int c, u32x4 s0, u32x4 s1) {
            const LAS char* ob = lds + RS_OUT + (c & 1) * RS_OUTB + (tok * 136 + 16 * part) * 2;
            const u32x4 o0 = *(const LAS u32x4*)ob, o1 = *(const LAS u32x4*)(ob + 16);
            const unsigned ou[8] = {o0.x, o0.y, o0.z, o0.w, o1.x, o1.y, o1.z, o1.w}, su[8] = {s0.x, s0.y, s0.z, s0.w, s1.x, s1.y, s1.z, s1.w};
            float v[16], ss = 0.f;
#pragma unroll
            for (int q = 0; q < 8; ++q) { v[2 * q] = bf2f(ou[q] & 0xffffu); v[2 * q + 1] = bf2f(ou[q] >> 16); ss += v[2 * q] * v[2 * q] + v[2 * q + 1] * v[2 * q + 1]; }
            ss += __shfl_xor(ss, 1); ss += __shfl_xor(ss, 2); ss += __shfl_xor(ss, 4);
            const float rs = 1.f / sqrtf(ss * (1.f / 128.f) + EPS);
            u32x4 w0, w1; unsigned wo[8];
#pragma unroll
            for (int q = 0; q < 8; ++q) wo[q] = cvtpk(v[2 * q] * rs * nw[q >> 1][(2 * q) & 3] * bf2f(su[q] & 0xffffu), v[2 * q + 1] * rs * nw[q >> 1][(2 * q + 1) & 3] * bf2f(su[q] >> 16));
            w0 = (u32x4){wo[0], wo[1], wo[2], wo[3]}; w1 = (u32x4){wo[4], wo[5], wo[6], wo[7]};
            bf16_t* mp = (bf16_t*)(ws + WS_MIX) + ((size_t)b * SEQ + 32 * (c - 1) + tok) * DM + 512 + h * 128 + 16 * part;
            *(u32x4*)mp = w0; *(u32x4*)(mp + 8) = w1;
        };
#define SG_LD(k, A, B) do { const bf16_t* p_ = sgg + (size_t)(32 * ((k) - 1)) * 512; A = *(const u32x4*)p_; B = *(const u32x4*)(p_ + 8); } while (0)
        u32x4 ga0, ga1, gb0, gb1, gc0, gc1, gd0, gd1;
        SG_LD(1, gb0, gb1); SG_LD(2, gc0, gc1); SG_LD(3, gd0, gd1);
        HW_BAR();
        HW_BAR();
        for (int k = 1; k <= 128; k += 4) {
            HW_BAR(); if (k + 3 <= 128) SG_LD(k + 3, ga0, ga1); epilogue(k, gb0, gb1);
            HW_BAR(); if (k + 4 <= 128) SG_LD(k + 4, gb0, gb1); epilogue(k + 1, gc0, gc1);
            HW_BAR(); if (k + 5 <= 128) SG_LD(k + 5, gc0, gc1); epilogue(k + 2, gd0, gd1);
            HW_BAR(); if (k + 6 <= 128) SG_LD(k + 6, gd0, gd1); epilogue(k + 3, ga0, ga1);
        }
#undef SG_LD
        HW_BAR();
    }
}
template <int CTRL> DI float dpp_f(float v) { return __builtin_bit_cast(float, __builtin_amdgcn_update_dpp(0, __builtin_bit_cast(int, v), CTRL, 0xf, 0xf, false)); }
DI float row16_max(float v) { v = fmaxf(v, dpp_f<0x128>(v)); v = fmaxf(v, dpp_f<0x124>(v)); v = fmaxf(v, dpp_f<0x122>(v)); v = fmaxf(v, dpp_f<0x121>(v)); return v; }
DI float row16_sum(float v) { v += dpp_f<0x128>(v); v += dpp_f<0x124>(v); v += dpp_f<0x122>(v); v += dpp_f<0x121>(v); return v; }
#define CE_D(a, b) do { const float hi_ = fmaxf(a, b), lo_ = fminf(a, b); a = hi_; b = lo_; } while (0)
DI void bitonic_sort16(float (&v)[16]) {
#pragma unroll
    for (int k = 2; k <= 16; k *= 2)
#pragma unroll
        for (int j = k / 2; j > 0; j /= 2)
#pragma unroll
            for (int i = 0; i < 16; ++i) { const int l = i ^ j; if (l > i) { if ((i & k) == 0) CE_D(v[i], v[l]); else CE_D(v[l], v[i]); } }
}
DI void merge_top16(float (&a)[16], const float (&b)[16]) {
#pragma unroll
    for (int i = 0; i < 16; ++i) a[i] = fmaxf(a[i], b[15 - i]);
#pragma unroll
    for (int j = 8; j > 0; j /= 2)
#pragma unroll
        for (int i = 0; i < 16; ++i) { const int l = i ^ j; if (l > i) CE_D(a[i], a[l]); }
}
DI float embed7(float v, unsigned code) { return __uint_as_float((__float_as_uint(v) & 0xFFFFFF80u) | code); }
DI float embed8(float v, unsigned code) { return __uint_as_float((__float_as_uint(v) & 0xFFFFFF00u) | code); }

DI void topk_list(const bf16_t* qp, const LAS char* skf, int lane, int hi, float (&top)[16]) {
    f32x16 acc[4];
#pragma unroll
    for (int kb = 0; kb < 4; ++kb) acc[kb] = f32x16{};
#pragma unroll
    for (int ks = 0; ks < 8; ++ks) {
        const bf16x8 qf = *(const bf16x8*)(qp + 16 * ks);
#pragma unroll
        for (int kb = 0; kb < 4; ++kb) { const bf16x8 kf = *(const LAS bf16x8*)(skf + (kb * 8 + ks) * 1024 + lane * 16); acc[kb] = MFMA32(kf, qf, acc[kb]); }
    }
    float blk[16];
#pragma unroll
    for (int kb = 0; kb < 4; ++kb) {
#pragma unroll
        for (int r = 0; r < 16; ++r) { const unsigned code = (unsigned)(32 * kb + (r & 3) + 8 * (r >> 2)) | (unsigned)(4 * hi); if (kb == 0) top[r] = embed7(acc[kb][r], code); else blk[r] = embed7(acc[kb][r], code); }
        if (kb == 0) bitonic_sort16(top); else { bitonic_sort16(blk); merge_top16(top, blk); }
    }
    float l0[16], l1[16];
#pragma unroll
    for (int r = 0; r < 16; ++r) { auto rr = __builtin_amdgcn_permlane32_swap(__float_as_uint(top[r]), __float_as_uint(top[r]), false, false); l0[r] = __uint_as_float(rr[0]); l1[r] = __uint_as_float(rr[1]); }
    merge_top16(l0, l1);
#pragma unroll
    for (int r = 0; r < 16; ++r) top[r] = l0[r];
}

DI void topk_wave_item(const Params& P, int tb, int hh, LAS char* wlds, const LAS char* skf) {
    const int lane = tid_() & 63, r32 = lane & 31, hi = lane >> 5;
    const unsigned char* ws = P.ws;
    const bf16_t* qp = (const bf16_t*)(ws + WS_PQ) + (size_t)(32 * tb + r32) * 2048 + hh * 256 + 8 * hi;
    float A[16], B[16];
    topk_list(qp, skf, lane, hi, A);
    topk_list(qp + 128, skf + 32768, lane, hi, B);
    LAS unsigned* my = (LAS unsigned*)(wlds + lane * 32);
#pragma unroll
    for (int w = 0; w < 4; ++w) {
        my[w] = (__float_as_uint(A[4 * w]) & 127u) | ((__float_as_uint(A[4 * w + 1]) & 127u) << 8) | ((__float_as_uint(A[4 * w + 2]) & 127u) << 16) | ((__float_as_uint(A[4 * w + 3]) & 127u) << 24);
        my[4 + w] = (__float_as_uint(B[4 * w]) & 127u) | ((__float_as_uint(B[4 * w + 1]) & 127u) << 8) | ((__float_as_uint(B[4 * w + 2]) & 127u) << 16) | ((__float_as_uint(B[4 * w + 3]) & 127u) << 24);
    }
#pragma unroll
    for (int r = 0; r < 16; ++r) { A[r] = __uint_as_float(__float_as_uint(A[r]) & 0xFFFFFF80u); B[r] = __uint_as_float(__float_as_uint(B[r]) & 0xFFFFFF80u); }
    float T[16], R1[16], X[16], Y[16];
#pragma unroll
    for (int j = 0; j < 16; ++j) { T[j] = embed8(A[0] + B[j], (unsigned)j); R1[j] = (j < 8) ? embed8(A[1] + B[j], (unsigned)(16 + j)) : -INFINITY; }
#define CAND(i, j) embed8(A[i] + B[j], (unsigned)(16 * (i) + (j)))
    X[0] = CAND(2, 0); X[1] = CAND(2, 1); X[2] = CAND(2, 2); X[3] = CAND(2, 3); X[4] = CAND(2, 4); X[5] = CAND(3, 0); X[6] = CAND(3, 1); X[7] = CAND(3, 2);
    X[8] = CAND(3, 3); X[9] = CAND(4, 0); X[10] = CAND(4, 1); X[11] = CAND(4, 2); X[12] = CAND(5, 0); X[13] = CAND(5, 1); X[14] = CAND(6, 0); X[15] = CAND(6, 1);
    Y[0] = CAND(7, 0); Y[1] = CAND(7, 1); Y[2] = CAND(8, 0); Y[3] = CAND(9, 0); Y[4] = CAND(10, 0); Y[5] = CAND(11, 0); Y[6] = CAND(12, 0); Y[7] = CAND(13, 0);
    Y[8] = CAND(14, 0); Y[9] = CAND(15, 0); Y[10] = -INFINITY; Y[11] = -INFINITY; Y[12] = -INFINITY; Y[13] = -INFINITY; Y[14] = -INFINITY; Y[15] = -INFINITY;
#undef CAND
    bitonic_sort16(X); bitonic_sort16(Y);
    merge_top16(T, R1); merge_top16(T, X); merge_top16(T, Y);
    asm volatile("s_waitcnt lgkmcnt(0)" ::: "memory");
    float ssum = 0.f, e[16]; int eid[16];
    const float t0 = __uint_as_float(__float_as_uint(T[0]) & 0xFFFFFF00u);
#pragma unroll
    for (int r = 0; r < 16; ++r) {
        const unsigned bits = __float_as_uint(T[r]); const unsigned code = bits & 255u;
        e[r] = __expf(__uint_as_float(bits & 0xFFFFFF00u) - t0); ssum += e[r];
        const int ka = ((const LAS unsigned char*)my)[code >> 4], kb_ = ((const LAS unsigned char*)my)[16 + (code & 15u)];
        eid[r] = ka * 128 + kb_;
    }
    const float inv = 1.f / ssum;
    const size_t o = (size_t)(32 * tb + r32) * 128 + hh * 16 + 8 * hi;
    int* ei = (int*)(ws + WS_EIDX) + o; float* eg = (float*)(ws + WS_EGATE) + o;
    typedef int i32x4 __attribute__((ext_vector_type(4)));
    i32x4 w0, w1; f32x4 g0, g1;
    const unsigned mh = 0u - (unsigned)hi;
#define SELU(a, b) ((((unsigned)(b)) & mh) | (((unsigned)(a)) & ~mh))
#pragma unroll
    for (int q = 0; q < 4; ++q) { w0[q] = (int)SELU(eid[q], eid[8 + q]); w1[q] = (int)SELU(eid[4 + q], eid[12 + q]);
        g0[q] = __uint_as_float(SELU(__float_as_uint(e[q]), __float_as_uint(e[8 + q]))) * inv; g1[q] = __uint_as_float(SELU(__float_as_uint(e[4 + q]), __float_as_uint(e[12 + q]))) * inv; }
#undef SELU
    *(i32x4*)ei = w0; *(i32x4*)(ei + 4) = w1; *(f32x4*)eg = g0; *(f32x4*)(eg + 4) = g1;
}

DI void topk_phase(const Params& P, char* lds_g, int bid, int nblk) {
    const int tid = tid_(), wave = __builtin_amdgcn_readfirstlane(tid >> 6);
    LAS char* lds = (LAS char*)lds_g;
    LAS char* wlds = lds + wave * 2048;
    LAS char* skf = lds + 16384;
    int cur_h = -1;
    for (int it = bid; it < (NTOK / 256) * 8; it += nblk) {
        const int hh = it & 7, tg = it >> 3;
        if (hh != cur_h) {
            __syncthreads();
#pragma unroll
            for (int i = 0; i < 8; ++i) {
                const int f = tid + 512 * i, l = f & 63, ks = (f >> 6) & 7, kb = (f >> 9) & 3, p = f >> 11;
                *(LAS u32x4*)(skf + f * 16) = *(const u32x4*)((const bf16_t*)(P.ws + WS_SKB) + (size_t)((hh * 2 + p) * 128 + 32 * kb + (l & 31)) * 128 + 16 * ks + 8 * (l >> 5));
            }
            __syncthreads();
            cur_h = hh;
        }
        topk_wave_item(P, tg * 8 + wave, hh, wlds, skf);
    }
}

DI float gelu_exact(float x) { return 0.5f * x * (1.f + erff(x * 0.70710678118654752f)); }
typedef __bf16 bf16x8_t __attribute__((ext_vector_type(8)));
DI float dot8(u32x4 a, u32x4 x, float acc) {
    const bf16x8_t a8 = __builtin_bit_cast(bf16x8_t, a), x8 = __builtin_bit_cast(bf16x8_t, x);
    acc = __builtin_amdgcn_fdot2_f32_bf16(__builtin_shufflevector(a8, a8, 0, 1), __builtin_shufflevector(x8, x8, 0, 1), acc, false);
    acc = __builtin_amdgcn_fdot2_f32_bf16(__builtin_shufflevector(a8, a8, 2, 3), __builtin_shufflevector(x8, x8, 2, 3), acc, false);
    acc = __builtin_amdgcn_fdot2_f32_bf16(__builtin_shufflevector(a8, a8, 4, 5), __builtin_shufflevector(x8, x8, 4, 5), acc, false);
    acc = __builtin_amdgcn_fdot2_f32_bf16(__builtin_shufflevector(a8, a8, 6, 7), __builtin_shufflevector(x8, x8, 6, 7), acc, false);
    return acc;
}
DI float readlane_f(float v, int l) { return __builtin_bit_cast(float, __builtin_amdgcn_readlane(__builtin_bit_cast(int, v), l)); }
DI float wave_sum_dpp(float v) {
    v = row16_sum(v);
    return (readlane_f(v, 0) + readlane_f(v, 16)) + (readlane_f(v, 32) + readlane_f(v, 48));
}

DI float dot16_fp8(u32x4 w, const f32x2 (&x)[8]) {
    f32x2 acc = __builtin_amdgcn_cvt_pk_f32_fp8((int)w.x, false) * x[0];
    acc = __builtin_amdgcn_cvt_pk_f32_fp8((int)w.x, true) * x[1] + acc;
    acc = __builtin_amdgcn_cvt_pk_f32_fp8((int)w.y, false) * x[2] + acc;
    acc = __builtin_amdgcn_cvt_pk_f32_fp8((int)w.y, true) * x[3] + acc;
    acc = __builtin_amdgcn_cvt_pk_f32_fp8((int)w.z, false) * x[4] + acc;
    acc = __builtin_amdgcn_cvt_pk_f32_fp8((int)w.z, true) * x[5] + acc;
    acc = __builtin_amdgcn_cvt_pk_f32_fp8((int)w.w, false) * x[6] + acc;
    acc = __builtin_amdgcn_cvt_pk_f32_fp8((int)w.w, true) * x[7] + acc;
    return acc.x + acc.y;
}
DI void peer_hid_phase(const Params& P, int bid, int nblk) {
    const int tid = tid_(), lane = tid & 63, wave = __builtin_amdgcn_readfirstlane(tid >> 6);
    const unsigned char* ws = P.ws;
    const unsigned char* U8 = ws + WS_UB; const float* USC = (const float*)(ws + WS_USC);
    const int gw = bid * NWAVES + wave, NGW = nblk * NWAVES;
    f32x4 wv[4];
#pragma unroll
    for (int q = 0; q < 4; ++q) wv[q] = *(const f32x4*)(P.ffn_norm_w + 16 * lane + 4 * q);
    for (int n = gw; n < NTOK; n += NGW) {
        const float* hrow = P.out + (size_t)n * DM + 16 * lane;
        f32x4 h[4]; float ss = 0.f;
#pragma unroll
        for (int q = 0; q < 4; ++q) { h[q] = *(const f32x4*)(hrow + 4 * q); ss += (h[q].x * h[q].x + h[q].y * h[q].y) + (h[q].z * h[q].z + h[q].w * h[q].w); }
        ss = wave_sum_dpp(ss);
        const float r2 = 1.f / sqrtf(ss * (1.f / DM) + EPS);
        f32x2 x[8];
#pragma unroll
        for (int q = 0; q < 4; ++q) { const f32x4 t = h[q] * wv[q] * r2; x[2 * q] = (f32x2){t.x, t.y}; x[2 * q + 1] = (f32x2){t.z, t.w}; }
        const int* eidx = (const int*)(ws + WS_EIDX) + (size_t)n * 128;
        const float* egate = (const float*)(ws + WS_EGATE) + (size_t)n * 128;
        const int id0 = eidx[lane], id1 = eidx[64 + lane];
        float hid0 = 0.f, hid1 = 0.f;
#pragma unroll 1
        for (int k0 = 0; k0 < 128; k0 += 16) {
            u32x4 ra[16]; float sc[16];
#pragma unroll
            for (int e = 0; e < 16; ++e) {
                const int k = k0 + e;
                const int id = (k0 < 64) ? __builtin_amdgcn_readlane(id0, k & 63) : __builtin_amdgcn_readlane(id1, k & 63);
                ra[e] = *(const u32x4*)(U8 + (size_t)id * DM + 16 * lane); sc[e] = USC[id];
            }
#pragma unroll
            for (int e = 0; e < 16; ++e) {
                const int k = k0 + e;
                const float d = wave_sum_dpp(dot16_fp8(ra[e], x)) * sc[e];
                if (k0 < 64) { if (lane == (k & 63)) hid0 = d; } else { if (lane == (k & 63)) hid1 = d; }
            }
        }
        float* hid = (float*)(ws + WS_HID) + (size_t)n * 128;
        hid[lane] = gelu_exact(hid0) * egate[lane];
        hid[64 + lane] = gelu_exact(hid1) * egate[64 + lane];
    }
}

DI void peer_out_phase(const Params& P, int bid, int nblk) {
    const int tid = tid_(), lane = tid & 63, wave = __builtin_amdgcn_readfirstlane(tid >> 6);
    const unsigned char* ws = P.ws;
    const unsigned char* V8 = ws + WS_VB; const float* VSC = (const float*)(ws + WS_VSC);
    const int gw = bid * NWAVES + wave, NGW = nblk * NWAVES;
    f32x4 wv[4];
#pragma unroll
    for (int q = 0; q < 4; ++q) wv[q] = *(const f32x4*)(P.final_w + 16 * lane + 4 * q);
    for (int n = gw; n < NTOK; n += NGW) {
        const int* eidx = (const int*)(ws + WS_EIDX) + (size_t)n * 128;
        const float* hid = (const float*)(ws + WS_HID) + (size_t)n * 128;
        const int id0 = eidx[lane], id1 = eidx[64 + lane];
        const float c0 = hid[lane], c1 = hid[64 + lane];
        f32x2 acc[8];
#pragma unroll
        for (int i = 0; i < 8; ++i) acc[i] = (f32x2){0.f, 0.f};
#pragma unroll 1
        for (int k0 = 0; k0 < 128; k0 += 16) {
            u32x4 ra[16]; float cf[16];
#pragma unroll
            for (int e = 0; e < 16; ++e) {
                const int k = k0 + e;
                const int id = (k0 < 64) ? __builtin_amdgcn_readlane(id0, k & 63) : __builtin_amdgcn_readlane(id1, k & 63);
                cf[e] = ((k0 < 64) ? readlane_f(c0, k & 63) : readlane_f(c1, k & 63)) * VSC[id];
                ra[e] = *(const u32x4*)(V8 + (size_t)id * DM + 16 * lane);
            }
#pragma unroll
            for (int e = 0; e < 16; ++e) {
                const f32x2 c = (f32x2){cf[e], cf[e]}; const u32x4 w = ra[e];
                acc[0] = __builtin_amdgcn_cvt_pk_f32_fp8((int)w.x, false) * c + acc[0]; acc[1] = __builtin_amdgcn_cvt_pk_f32_fp8((int)w.x, true) * c + acc[1];
                acc[2] = __builtin_amdgcn_cvt_pk_f32_fp8((int)w.y, false) * c + acc[2]; acc[3] = __builtin_amdgcn_cvt_pk_f32_fp8((int)w.y, true) * c + acc[3];
                acc[4] = __builtin_amdgcn_cvt_pk_f32_fp8((int)w.z, false) * c + acc[4]; acc[5] = __builtin_amdgcn_cvt_pk_f32_fp8((int)w.z, true) * c + acc[5];
                acc[6] = __builtin_amdgcn_cvt_pk_f32_fp8((int)w.w, false) * c + acc[6]; acc[7] = __builtin_amdgcn_cvt_pk_f32_fp8((int)w.w, true) * c + acc[7];
            }
        }
        float* orow = P.out + (size_t)n * DM + 16 * lane;
        f32x4 h[4]; float ss = 0.f;
#pragma unroll
        for (int q = 0; q < 4; ++q) { h[q] = *(const f32x4*)(orow + 4 * q) + (f32x4){acc[2 * q].x, acc[2 * q].y, acc[2 * q + 1].x, acc[2 * q + 1].y}; ss += (h[q].x * h[q].x + h[q].y * h[q].y) + (h[q].z * h[q].z + h[q].w * h[q].w); }
        ss = wave_sum_dpp(ss);
        const float rs = 1.f / sqrtf(ss * (1.f / DM) + EPS);
#pragma unroll
        for (int q = 0; q < 4; ++q) *(f32x4*)(orow + 4 * q) = h[q] * wv[q] * rs;
    }
}

#ifdef DBG_CHECK
DI void dbg_max(float* slot, float v) { atomicMax((unsigned*)slot, __float_as_uint(fmaxf(v, 0.f))); }
DI void dbg_check_topk(const Params& P, char* lds_g, int bid, int nblk) {
    LAS char* lds = (LAS char*)lds_g;
    const int tid = tid_(), lane = tid & 63, wave = __builtin_amdgcn_readfirstlane(tid >> 6);
    const unsigned char* ws = P.ws; float* dbg = (float*)(ws + WS_CTL) + 64;
    LAS float* sc = (LAS float*)(lds) + wave * 1024;
    const int gw = bid * NWAVES + wave;
    const int token = (gw * 37) % NTOK, hh = gw & 7;
    for (int p = 0; p < 2; ++p) for (int kk = 0; kk < 2; ++kk) {
        const int key = lane + 64 * kk; float a = 0.f;
        const bf16_t* q = (const bf16_t*)(ws + WS_PQ) + (size_t)token * 2048 + hh * 256 + p * 128;
        const bf16_t* sk = (const bf16_t*)(ws + WS_SKB) + (size_t)((hh * 2 + p) * 128 + key) * 128;
        for (int c = 0; c < 128; ++c) a += bf2f(q[c]) * bf2f(sk[c]);
        sc[p * 128 + key] = a;
    }
    asm volatile("s_waitcnt lgkmcnt(0)" ::: "memory");
    for (int p = 0; p < 2; ++p) for (int kk = 0; kk < 2; ++kk) {
        const int key = lane + 64 * kk; const float v = sc[p * 128 + key]; int rank = 0;
        for (int o = 0; o < 128; ++o) { const float w = sc[p * 128 + o]; rank += (w > v || (w == v && o < key)) ? 1 : 0; }
        if (rank < 16) { sc[256 + p * 16 + rank] = v; sc[288 + p * 16 + rank] = __int_as_float(key); }
    }
    asm volatile("s_waitcnt lgkmcnt(0)" ::: "memory");
    for (int e = 0; e < 4; ++e) {
        const int c = lane * 4 + e, i = c >> 4, j = c & 15; const float v = sc[256 + i] + sc[272 + j]; int rank = 0;
        for (int o = 0; o < 256; ++o) { const float w = sc[256 + (o >> 4)] + sc[272 + (o & 15)]; rank += (w > v || (w == v && o < c)) ? 1 : 0; }
        if (rank < 16) { sc[320 + rank] = __int_as_float(__float_as_int(sc[288 + i]) * 128 + __float_as_int(sc[304 + j])); sc[336 + rank] = v; }
    }
    asm volatile("s_waitcnt lgkmcnt(0)" ::: "memory");
    if (lane < 16) {
        const int eid = __float_as_int(sc[320 + lane]); const float sv = sc[336 + lane];
        float mx = sc[336], sum = 0.f; for (int o = 0; o < 16; ++o) sum += __expf(sc[336 + o] - mx);
        const float gate = __expf(sv - mx) / sum;
        const int* eidx = (const int*)(ws + WS_EIDX) + (size_t)token * 128 + hh * 16; const float* eg = (const float*)(ws + WS_EGATE) + (size_t)token * 128 + hh * 16;
        int found = -1; for (int o = 0; o < 16; ++o) if (eidx[o] == eid) found = o;
        if (found < 0) atomicAdd(dbg + 0, 1.f); else dbg_max(dbg + 1, fabsf(eg[found] - gate));
    }
    if (lane == 0) atomicAdd(dbg + 2, 16.f);
}
DI void dbg_check_hid(const Params& P, int bid, int nblk) {
    const int tid = tid_(), lane = tid & 63, wave = __builtin_amdgcn_readfirstlane(tid >> 6);
    const unsigned char* ws = P.ws; float* dbg = (float*)(ws + WS_CTL) + 64;
    const int gw = bid * NWAVES + wave; const int token = (gw * 53) % NTOK;
    const float* hrow = P.out + (size_t)token * DM;
    float ss = 0.f; for (int c = lane; c < DM; c += 64) ss += hrow[c] * hrow[c];
    ss = wave_sum(ss); const float r2 = 1.f / sqrtf(ss / DM + EPS);
    for (int kk = 0; kk < 2; ++kk) {
        const int k = lane + 64 * kk; const int eid = ((const int*)(ws + WS_EIDX))[(size_t)token * 128 + k];
        const float* urow = P.pu + (size_t)eid * DM; float d = 0.f;
        for (int c = 0; c < DM; ++c) d += urow[c] * (hrow[c] * r2 * P.ffn_norm_w[c]);
        const float hidv = gelu_exact(d) * ((const float*)(ws + WS_EGATE))[(size_t)token * 128 + k];
        const float got = ((const float*)(ws + WS_HID))[(size_t)token * 128 + k];
        dbg_max(dbg + 3, fabsf(got - hidv)); dbg_max(dbg + 4, fabsf(hidv));
    }
}
DI float dbg_enc(float m) { return 8.f + log10f(fmaxf(m, 1e-8f)); }
#endif

#ifdef DBG_CHECK
DI void dbg_check_attn(const Params& P, int bid, int nblk) {
    const int tid = tid_(), lane = tid & 63, wave = __builtin_amdgcn_readfirstlane(tid >> 6);
    const unsigned char* ws = P.ws; float* dbg = (float*)(ws + WS_CTL) + 64;
    const int gw = bid * NWAVES + wave;
    const unsigned hsh = (unsigned)gw * 2654435761u;
    const int b = (hsh >> 8) & 7, h = (hsh >> 11) & 3, i = (int)((hsh >> 13) % 4096u), bh = b * 4 + h;
    const float lam = ((const float*)(ws + WS_LB))[512];
    float oc[2][2], lsum[2], mx[2];
    for (int c = 0; c < 2; ++c) { oc[c][0] = oc[c][1] = 0.f; lsum[c] = 0.f; mx[c] = -1e30f; }
    for (int pp = KPAD; pp <= 64 + i; ++pp) {
        const int tile = pp >> 6, key = pp & 63;
        for (int c = 0; c < 2; ++c) {
            const bf16_t* q = (const bf16_t*)(ws + WS_Q) + ((size_t)((bh * 2 + c) * SEQ + i)) * 64;
            const unsigned char* kimg = ws + WS_K + ((size_t)(bh * 2 + c) * KT + tile) * 8192;
            float sdot = 0.f;
            for (int d = 0; d < 64; ++d) sdot += bf2f(q[d]) * bf2f(*(const bf16_t*)(kimg + (d >> 3) * 1024 + key * 16 + (d & 7) * 2));
            const float mn = fmaxf(mx[c], sdot), al = exp2f(mx[c] - mn), pe = exp2f(sdot - mn);
            const unsigned char* vimg = ws + WS_V + ((size_t)bh * KT + tile) * 16384;
            for (int e = 0; e < 2; ++e) { const int dv = lane + 64 * e; oc[c][e] = oc[c][e] * al + pe * bf2f(*(const bf16_t*)(vimg + (dv >> 5) * 4096 + key * 64 + (dv & 31) * 2)); }
            lsum[c] = lsum[c] * al + pe; mx[c] = mn;
        }
    }
    float o[2], ss = 0.f;
    for (int e = 0; e < 2; ++e) { o[e] = oc[0][e] / lsum[0] - lam * oc[1][e] / lsum[1]; ss += o[e] * o[e]; }
    ss = wave_sum(ss); const float rs = (1.f - LAM_INIT) / sqrtf(ss / 128.f + EPS);
    for (int e = 0; e < 2; ++e) { const int dv = lane + 64 * e; const float want = o[e] * rs * P.subln_w[dv];
        const float got = bf2f(((const bf16_t*)(ws + WS_MIX))[(size_t)(b * SEQ + i) * DM + h * 128 + dv]);
        dbg_max(dbg + 5, fabsf(got - want)); dbg_max(dbg + 6, fabsf(want)); }
}
DI void dbg_check_hgrn(const Params& P, char* lds_g, int bid, int nblk) {
    if (bid >= 32) return;
    LAS float* L = (LAS float*)lds_g;
    const int tid = tid_(), dv = tid & 127, qt = tid >> 7;
    const unsigned char* ws = P.ws; float* dbg = (float*)(ws + WS_CTL) + 64;
    const int bh = bid, b = bid >> 2, h = bid & 3;
    const float* HG = (const float*)(ws + WS_HG) + (size_t)bh * HT * 128;
    const bf16_t* HQ = (const bf16_t*)(ws + WS_HQ) + (size_t)bh * HT * 128;
    const bf16_t* HV = (const bf16_t*)(ws + WS_HV) + (size_t)bh * HT * 128;
    float S[32];
#pragma unroll
    for (int j = 0; j < 32; ++j) S[j] = 0.f;
    for (int pp = 16; pp < HT; ++pp) {
        if (tid < 128) { L[tid] = __expf(HG[(size_t)pp * 128 + tid]); L[128 + tid] = bf2f(HQ[(size_t)pp * 128 + tid]); L[256 + tid] = bf2f(HV[(size_t)pp * 128 + tid]); }
        __syncthreads();
        const float v = L[256 + dv]; float part = 0.f;
#pragma unroll
        for (int j = 0; j < 32; ++j) { const float f = L[32 * qt + j]; S[j] = f * S[j] + (1.f - f) * v; part += L[128 + 32 * qt + j] * S[j]; }
        L[384 + qt * 128 + dv] = part;
        __syncthreads();
        if (tid < 128) { const float o = L[384 + dv] + L[512 + dv] + L[640 + dv] + L[768 + dv]; L[896 + dv] = o; }
        __syncthreads();
        if (tid < 128 && pp >= 32) {
            float ss = 0.f; for (int j = 0; j < 128; ++j) ss += L[896 + j] * L[896 + j];
            const float rs = 1.f / sqrtf(ss / 128.f + EPS);
            const size_t row = (size_t)b * SEQ + (pp - 32);
            const float want = L[896 + dv] * rs * P.rec_norm_w[h * 128 + dv] * bf2f(((const bf16_t*)(ws + WS_SG))[row * 512 + h * 128 + dv]);
            const float got = bf2f(((const bf16_t*)(ws + WS_MIX))[row * DM + 512 + h * 128 + dv]);
            dbg_max(dbg + 7, fabsf(got - want)); dbg_max(dbg + 8, fabsf(want));
        }
        __syncthreads();
    }
}
#endif

#ifdef DBG_CHECK
DI float dbg_proj(const Params& P, int m, int c) {
    const float* xrow = (m < NTOK) ? P.x + (size_t)m * DM : P.meta + (size_t)(m - NTOK) * DM;
    float ss = 0.f, a = 0.f;
    for (int k = 0; k < DM; ++k) { const float xv = xrow[k]; ss += xv * xv; a += xv * P.mix_norm_w[k] * P.w_in[(size_t)k * NCOL1 + c]; }
    return a / sqrtf(ss / DM + EPS);
}
DI void dbg_check_gemm1(const Params& P, int bid, int nblk) {
    const unsigned char* ws = P.ws; float* dbg = (float*)(ws + WS_CTL) + 64;
    const int gt = bid * NTHREADS + tid_();
    if (gt >= 7 * 4096) return;
    const unsigned hsh = (unsigned)gt * 2654435761u;
    const int seg = gt % 7, cs = (hsh >> 7) & 511;
    const bool meta = ((gt / 7) & 15) == 0;
    const int m = meta ? NTOK + ((hsh >> 20) & 15) : (int)((hsh >> 3) % (unsigned)NTOK);
    const int b = meta ? (int)((hsh >> 25) & 7) : (m >> 12), t = meta ? (m - NTOK) : ((m & 4095) + NMETA);
    const int h = cs >> 7;
    float want = 0.f, got = 0.f;
    if (seg <= 1) {
        if (seg == 0 && meta) return;
        const int comp = (cs >> 6) & 1, d = cs & 63, dlo = d & 31;
        const float zlo = dbg_proj(P, m, seg * 512 + (cs & ~63) + dlo), zhi = dbg_proj(P, m, seg * 512 + (cs & ~63) + dlo + 32);
        const double inv = exp2(-(double)dlo * (13.287712379549449 / 32.0)); const float cv = (float)cos((double)t * inv), sv = (float)sin((double)t * inv);
        want = (d < 32) ? zlo * cv - zhi * sv : zhi * cv + zlo * sv;
        if (seg == 0) { want *= QSCALE; got = bf2f(((const bf16_t*)(ws + WS_Q))[((size_t)(((b * 4 + h) * 2 + comp) * SEQ + (m & 4095))) * 64 + d]); }
        else { const int pp = t + KPAD; got = bf2f(*(const bf16_t*)(ws + WS_K + ((size_t)((b * 4 + h) * 2 + comp) * KT + (pp >> 6)) * 8192 + (d >> 3) * 1024 + (pp & 63) * 16 + (d & 7) * 2)); }
    } else {
        const float z = dbg_proj(P, m, seg * 512 + cs); const int dv = cs & 127;
        if (seg == 2) { const int pp = t + KPAD; want = z; got = bf2f(*(const bf16_t*)(ws + WS_V + ((size_t)(b * 4 + h) * KT + (pp >> 6)) * 16384 + (dv >> 5) * 4096 + (pp & 63) * 64 + (dv & 31) * 2)); }
        else if (seg == 3) { want = siluf_(z); got = bf2f(((const bf16_t*)(ws + WS_HQ))[((size_t)(b * 4 + h) * HT + t + 16) * 128 + dv]); }
        else if (seg == 4) { const float l0 = P.lb_logits[cs], l1 = P.lb_logits[512 + cs], lb = __expf(l0) / (__expf(l0) + __expf(l1)); want = __logf(lb + (1.f - lb) * sigmoidf_(z)); got = ((const float*)(ws + WS_HG))[((size_t)(b * 4 + h) * HT + t + 16) * 128 + dv]; }
        else if (seg == 5) { want = z; got = bf2f(((const bf16_t*)(ws + WS_HV))[((size_t)(b * 4 + h) * HT + t + 16) * 128 + dv]); }
        else { if (meta) return; want = siluf_(z); got = bf2f(((const bf16_t*)(ws + WS_SG))[(size_t)m * 512 + cs]); }
    }
    dbg_max(dbg + 16 + seg + (meta ? 8 : 0), fabsf(got - want));
}
#endif
typedef unsigned u32x4v __attribute__((vector_size(16)));
DI float oct_sum(float v) {
    v += dpp_f<0xB1>(v); v += dpp_f<0x4E>(v); v += dpp_f<0x141>(v); return v;
}
DI unsigned my_xcc_id() { return (unsigned)__builtin_amdgcn_s_getreg((3 << 11) | 20) & 7u; }
constexpr int CTL_G1 = 16, CTL_G2 = 32;

DI void xn8_rows(const Params& P, int bid, int nblk) {
    const int tid = tid_(), lane = tid & 63, wave = __builtin_amdgcn_readfirstlane(tid >> 6);
    unsigned char* ws = P.ws;
    const int gw = bid * NWAVES + wave, NGW = nblk * NWAVES;
    f32x4 wv[4];
#pragma unroll
    for (int q = 0; q < 4; ++q) wv[q] = *(const f32x4*)(P.ffn_norm_w + 16 * lane + 4 * q);
    for (int n = gw; n < NTOK; n += NGW) {
        const bf16_t* hrow = (const bf16_t*)(ws + WS_XB) + (size_t)n * DM + 16 * lane;
        const float r2 = 1.f / sqrtf(((const float*)(ws + WS_SSQ))[n] * (1.f / DM) + EPS);
        const u32x4 ha = *(const u32x4*)hrow, hb = *(const u32x4*)(hrow + 8);
        const unsigned hu[8] = {ha.x, ha.y, ha.z, ha.w, hb.x, hb.y, hb.z, hb.w};
        f32x4 t[4]; float am = 0.f;
#pragma unroll
        for (int q = 0; q < 4; ++q) { t[q] = (f32x4){bf2f(hu[2 * q] & 0xffffu), bf2f(hu[2 * q] >> 16), bf2f(hu[2 * q + 1] & 0xffffu), bf2f(hu[2 * q + 1] >> 16)} * wv[q] * r2; am = fmaxf(am, fmaxf(fmaxf(fabsf(t[q].x), fabsf(t[q].y)), fmaxf(fabsf(t[q].z), fabsf(t[q].w)))); }
        am = row16_max(am); am = fmaxf(fmaxf(readlane_f(am, 0), readlane_f(am, 16)), fmaxf(readlane_f(am, 32), readlane_f(am, 48)));
        const float sc = (am > 0.f) ? exp2f(floorf(log2f(224.f / am))) : 1.f;
        int w[4];
#pragma unroll
        for (int q = 0; q < 4; ++q) { w[q] = __builtin_amdgcn_cvt_pk_fp8_f32(t[q].x * sc, t[q].y * sc, 0, false); w[q] = __builtin_amdgcn_cvt_pk_fp8_f32(t[q].z * sc, t[q].w * sc, w[q], true); }
        *(u32x4*)(ws + WS_XN8 + (size_t)n * DM + 16 * lane) = (u32x4){(unsigned)w[0], (unsigned)w[1], (unsigned)w[2], (unsigned)w[3]};
        if (lane == 0) ((float*)(ws + WS_XSC))[n] = 1.f / sc;
    }
}
typedef int i32x4 __attribute__((ext_vector_type(4)));
struct GMeta { i32x4 id[4]; f32x4 c[4]; u32x4 xq; };
template <int WHICH>
DI void g_meta(const Params& P, int n, int x, GMeta& M) {
    const int lane = tid_() & 63, i = lane & 7, g = lane >> 3;
    const i32x4* ip = (const i32x4*)((const int*)(P.ws + WS_EIDX) + (size_t)n * 128 + 16 * g);
#pragma unroll
    for (int q = 0; q < 4; ++q) M.id[q] = ip[q];
    if (WHICH == 1) M.xq = *(const u32x4*)(P.ws + WS_XN8 + (size_t)n * DM + 128 * x + 16 * i);
    else { const f32x4* cp = (const f32x4*)((const float*)(P.ws + WS_HID) + (size_t)n * 128 + 16 * g);
#pragma unroll
        for (int q = 0; q < 4; ++q) M.c[q] = cp[q]; }
}
DI void g_issue(int x, const GMeta& M, u32x4v (&rw)[16], __amdgpu_buffer_rsrc_t rs) {
    const int i = tid_() & 7;
    const unsigned lo = (unsigned)x * (unsigned)(NEXP * 128) + (unsigned)(16 * i);
#pragma unroll
    for (int j = 0; j < 16; ++j) rw[j] = __builtin_amdgcn_raw_buffer_load_b128(rs, ((unsigned)M.id[j >> 2][j & 3] << 7) + lo, 0, 0);
}
DI void g1_finish(const Params& P, int n, int x, u32x4 xq, const u32x4v (&rw)[16]) {
    const int lane = tid_() & 63, i = lane & 7, g = lane >> 3;
    f32x2 xv[8];
    xv[0] = __builtin_amdgcn_cvt_pk_f32_fp8((int)xq.x, false); xv[1] = __builtin_amdgcn_cvt_pk_f32_fp8((int)xq.x, true);
    xv[2] = __builtin_amdgcn_cvt_pk_f32_fp8((int)xq.y, false); xv[3] = __builtin_amdgcn_cvt_pk_f32_fp8((int)xq.y, true);
    xv[4] = __builtin_amdgcn_cvt_pk_f32_fp8((int)xq.z, false); xv[5] = __builtin_amdgcn_cvt_pk_f32_fp8((int)xq.z, true);
    xv[6] = __builtin_amdgcn_cvt_pk_f32_fp8((int)xq.w, false); xv[7] = __builtin_amdgcn_cvt_pk_f32_fp8((int)xq.w, true);
    float pd[16];
#pragma unroll
    for (int j = 0; j < 16; ++j) pd[j] = dot16_fp8(__builtin_bit_cast(u32x4, rw[j]), xv);
    const unsigned m1 = 0u - (unsigned)((i >> 2) & 1), m2 = 0u - (unsigned)(i & 1), m3 = 0u - (unsigned)((i >> 1) & 1);
#define BSEL(a, b, m) __uint_as_float((__float_as_uint(a) & ~(m)) | (__float_as_uint(b) & (m)))
    float z[8], w[4], u[2];
#pragma unroll
    for (int q = 0; q < 8; ++q) { const float snd = BSEL(pd[q + 8], pd[q], m1), kep = BSEL(pd[q], pd[q + 8], m1); z[q] = kep + dpp_f<0x141>(snd); }
#pragma unroll
    for (int q = 0; q < 4; ++q) { const float snd = BSEL(z[q + 4], z[q], m2), kep = BSEL(z[q], z[q + 4], m2); w[q] = kep + dpp_f<0xB1>(snd); }
#pragma unroll
    for (int q = 0; q < 2; ++q) { const float snd = BSEL(w[q + 2], w[q], m3), kep = BSEL(w[q], w[q + 2], m3); u[q] = kep + dpp_f<0x4E>(snd); }
    const int j0 = 8 * ((i >> 2) & 1) + 4 * (i & 1) + 2 * ((i >> 1) & 1);
#undef BSEL
    *(f32x2*)((float*)(P.ws + WS_HIDP) + ((size_t)x * NTOK + n) * 128 + 16 * g + j0) = (f32x2){u[0], u[1]};
}
DI void g2_finish(const Params& P, int n, int x, const f32x4 (&cv)[4], const u32x4v (&rw)[16]) {
    const int lane = tid_() & 63, i = lane & 7, g = lane >> 3;
    f32x2 acc[8];
#pragma unroll
    for (int q = 0; q < 8; ++q) acc[q] = (f32x2){0.f, 0.f};
#pragma unroll
    for (int j = 0; j < 16; ++j) {
        const float cj = cv[j >> 2][j & 3]; const f32x2 c = (f32x2){cj, cj}; const u32x4 w = __builtin_bit_cast(u32x4, rw[j]);
        acc[0] = __builtin_amdgcn_cvt_pk_f32_fp8((int)w.x, false) * c + acc[0]; acc[1] = __builtin_amdgcn_cvt_pk_f32_fp8((int)w.x, true) * c + acc[1];
        acc[2] = __builtin_amdgcn_cvt_pk_f32_fp8((int)w.y, false) * c + acc[2]; acc[3] = __builtin_amdgcn_cvt_pk_f32_fp8((int)w.y, true) * c + acc[3];
        acc[4] = __builtin_amdgcn_cvt_pk_f32_fp8((int)w.z, false) * c + acc[4]; acc[5] = __builtin_amdgcn_cvt_pk_f32_fp8((int)w.z, true) * c + acc[5];
        acc[6] = __builtin_amdgcn_cvt_pk_f32_fp8((int)w.w, false) * c + acc[6]; acc[7] = __builtin_amdgcn_cvt_pk_f32_fp8((int)w.w, true) * c + acc[7];
    }
    float y[16], z[8], w[4];
#pragma unroll
    for (int q = 0; q < 8; ++q) { y[2 * q] = acc[q].x; y[2 * q + 1] = acc[q].y; }
#pragma unroll
    for (int q = 0; q < 8; ++q) { auto rr = __builtin_amdgcn_permlane32_swap(__float_as_uint(y[q]), __float_as_uint(y[q + 8]), false, false); z[q] = __uint_as_float(rr[0]) + __uint_as_float(rr[1]); }
#pragma unroll
    for (int q = 0; q < 4; ++q) { auto rr = __builtin_amdgcn_permlane16_swap(__float_as_uint(z[q]), __float_as_uint(z[q + 4]), false, false); w[q] = __uint_as_float(rr[0]) + __uint_as_float(rr[1]); }
    const unsigned m3 = 0u - (unsigned)(g & 1);
#define BSEL(a, b, m) __uint_as_float((__float_as_uint(a) & ~(m)) | (__float_as_uint(b) & (m)))
    const float k0 = BSEL(w[0], w[2], m3) + dpp_f<0x128>(BSEL(w[2], w[0], m3)), k1 = BSEL(w[1], w[3], m3) + dpp_f<0x128>(BSEL(w[3], w[1], m3));
#undef BSEL
    float* hp = P.out + (size_t)n * DM + 128 * x + 16 * i + 2 * g;
    const f32x2 t = *(const f32x2*)hp + (f32x2){k0, k1}; *(f32x2*)hp = t;
    const float ss = wave_sum_dpp(t.x * t.x + t.y * t.y);
    if (lane == 0) atomicAdd((float*)(P.ws + WS_SSQ2) + n, ss);
}
constexpr int SL_CHUNK = 128, SL_T = SL_CHUNK / NWAVES;
#define SB() __builtin_amdgcn_sched_barrier(0)
template <int WHICH>
DI void g_chunk(const Params& P, int nbase, int x, __amdgpu_buffer_rsrc_t rs) {
    GMeta MA, MB; u32x4v RA[16], RB[16];
    g_meta<WHICH>(P, nbase, x, MA); SB(); g_meta<WHICH>(P, nbase + 8, x, MB); SB(); g_issue(x, MA, RA, rs); SB();
#pragma unroll
    for (int t = 0; t < SL_T; t += 2) {
        const u32x4 xA = MA.xq; const f32x4 cA[4] = {MA.c[0], MA.c[1], MA.c[2], MA.c[3]};
        if (t + 2 < SL_T) { g_meta<WHICH>(P, nbase + 8 * (t + 2), x, MA); SB(); }
        g_issue(x, MB, RB, rs); SB();
        if (WHICH == 1) g1_finish(P, nbase + 8 * t, x, xA, RA); else g2_finish(P, nbase + 8 * t, x, cA, RA);
        SB();
        const u32x4 xB = MB.xq; const f32x4 cB[4] = {MB.c[0], MB.c[1], MB.c[2], MB.c[3]};
        if (t + 3 < SL_T) { g_meta<WHICH>(P, nbase + 8 * (t + 3), x, MB); SB(); }
        if (t + 2 < SL_T) { g_issue(x, MA, RA, rs); SB(); }
        if (WHICH == 1) g1_finish(P, nbase + 8 * (t + 1), x, xB, RB); else g2_finish(P, nbase + 8 * (t + 1), x, cB, RB);
        SB();
    }
}
template <int WHICH>
DI void sliced_phase(const Params& P, char* lds_g) {
    const int tid = tid_(), wave = __builtin_amdgcn_readfirstlane(tid >> 6);
    unsigned* ctr = (unsigned*)(P.ws + WS_CTL) + (WHICH == 1 ? CTL_G1 : CTL_G2);
    const __amdgpu_buffer_rsrc_t rs = __builtin_amdgcn_make_buffer_rsrc((void*)(P.ws + (WHICH == 1 ? WS_UB : WS_VB)), 0, NEXP * DM, 0x00020000);
    const int x0 = (int)my_xcc_id();
    LAS int* slot = (LAS int*)((LAS char*)lds_g + LDS_ITEM);
    for (int s = 0; s < 8; ++s) {
        const int x = (x0 + s) & 7;
        for (;;) {
            if (tid == 0) *slot = (int)atomicAdd(ctr + x, 1u);
            __syncthreads();
            const int chunk = *slot;
            __syncthreads();
            if (chunk >= NTOK / SL_CHUNK) break;
            g_chunk<WHICH>(P, chunk * SL_CHUNK + wave, x, rs);
        }
    }
}
DI void hid_reduce_phase(const Params& P, int bid, int nblk) {
    const unsigned char* ws = P.ws;
    const size_t gt = (size_t)bid * NTHREADS + tid_(), NGT = (size_t)nblk * NTHREADS;
    const float* hp = (const float*)(ws + WS_HIDP);
    for (size_t o = gt; o < (size_t)NTOK * 128; o += NGT) {
        float a = 0.f;
#pragma unroll
        for (int x = 0; x < 8; ++x) a += hp[(size_t)x * NTOK * 128 + o];
        const int e = ((const int*)(ws + WS_EIDX))[o];
        const float d = a * ((const float*)(ws + WS_USC))[e] * ((const float*)(ws + WS_XSC))[o >> 7];
        ((float*)(ws + WS_HID))[o] = gelu_exact(d) * ((const float*)(ws + WS_EGATE))[o] * ((const float*)(ws + WS_VSC))[e];
    }
}
DI void final_norm_phase(const Params& P, int bid, int nblk) {
    const size_t gt = (size_t)bid * NTHREADS + tid_(), NGT = (size_t)nblk * NTHREADS;
    const float* ssq = (const float*)(P.ws + WS_SSQ2);
    for (size_t o = gt; o < (size_t)NTOK * DM / 4; o += NGT) {
        const size_t n = o >> 8; const int c4 = (int)(o & 255);
        const float rs = 1.f / sqrtf(ssq[n] * (1.f / DM) + EPS);
        f32x4* pp = (f32x4*)P.out + o;
        *pp = *pp * ((const f32x4*)P.final_w)[c4] * rs;
    }
}

typedef long i64_t;
constexpr int MG_HALF = 8192, MG_WAVE = 2 * MG_HALF;
#define MG_WAIT(N) asm volatile("s_waitcnt vmcnt(" #N ")" ::: "memory")
struct MgMeta { i32x4 id[4]; u32x4 a0, a1, a2, a3; };
template <int WHICH>
DI void mg_meta(const Params& P, int n, int x, MgMeta& M) {
    const int lane = tid_() & 63, g8 = lane >> 3, kg = lane >> 4;
    const int* ip = (const int*)(P.ws + WS_EIDX) + (size_t)n * 128 + 8 * g8;
    M.id[0] = *(const i32x4*)ip; M.id[1] = *(const i32x4*)(ip + 4); M.id[2] = *(const i32x4*)(ip + 64); M.id[3] = *(const i32x4*)(ip + 68);
    if (WHICH == 1) { const unsigned char* xr = P.ws + WS_XN8 + (size_t)n * DM + 256 * x + 16 * kg;
        M.a0 = *(const u32x4*)xr; M.a1 = *(const u32x4*)(xr + 64); M.a2 = *(const u32x4*)(xr + 128); M.a3 = *(const u32x4*)(xr + 192); }
    else { const unsigned char* cr = P.ws + WS_C8 + ((size_t)x * NTOK + n) * 128 + 16 * kg;
        M.a0 = *(const u32x4*)cr; M.a1 = *(const u32x4*)(cr + 64); }
}
DI void mg_issue(const unsigned char* slice, const MgMeta& M, int h, unsigned lbase) {
    const int lane = tid_() & 63, pos = lane & 7;
    const i32x4 ia = M.id[2 * h], ib = M.id[2 * h + 1];
    const int ids[8] = {ia.x, ia.y, ia.z, ia.w, ib.x, ib.y, ib.z, ib.w};
#pragma unroll
    for (int p = 0; p < 8; ++p) glds16_asm(slice + (size_t)(unsigned)ids[p] * 128 + 16 * (pos ^ p), lbase + p * 1024);
}
DI i64_t pk64(unsigned lo, unsigned hi) { return (i64_t)(((unsigned long long)hi << 32) | lo); }
typedef int i32x8 __attribute__((ext_vector_type(8)));
DI float mg1_half(const MgMeta& M, LAS char* hb) {
    const int lane = tid_() & 63, c = lane & 15, kg = lane >> 4;
    const i32x8 A0 = (i32x8){(int)M.a0.x, (int)M.a0.y, (int)M.a0.z, (int)M.a0.w, (int)M.a1.x, (int)M.a1.y, (int)M.a1.z, (int)M.a1.w};
    const i32x8 A1 = (i32x8){(int)M.a2.x, (int)M.a2.y, (int)M.a2.z, (int)M.a2.w, (int)M.a3.x, (int)M.a3.y, (int)M.a3.z, (int)M.a3.w};
    f32x4 d[4];
#pragma unroll
    for (int G = 0; G < 4; ++G) {
        const LAS char* row = hb + (c & 7) * 1024 + (2 * G + (c >> 3)) * 128;
        const u32x4 b0 = *(const LAS u32x4*)(row + ((kg ^ (c & 7)) << 4)), b1 = *(const LAS u32x4*)(row + (((kg + 4) ^ (c & 7)) << 4));
        d[G] = (f32x4){0.f, 0.f, 0.f, 0.f};
        d[G] = __builtin_amdgcn_mfma_scale_f32_16x16x128_f8f6f4(A0, (i32x8){(int)b0.x, (int)b0.y, (int)b0.z, (int)b0.w, 0, 0, 0, 0}, d[G], 0, 4, 0, 0x7F7F7F7F, 0, 0x7F7F7F7F);
        d[G] = __builtin_amdgcn_mfma_scale_f32_16x16x128_f8f6f4(A1, (i32x8){(int)b1.x, (int)b1.y, (int)b1.z, (int)b1.w, 0, 0, 0, 0}, d[G], 0, 4, 0, 0x7F7F7F7F, 0, 0x7F7F7F7F);
    }
    asm volatile("s_nop 15\n\ts_nop 15" : "+v"(d[0]), "+v"(d[1]), "+v"(d[2]), "+v"(d[3]));
    const float r01 = (kg & 1) ? d[1][0] : d[0][0], r23 = (kg & 1) ? d[3][0] : d[2][0];
    return (kg & 2) ? r23 : r01;
}
typedef int v2i_t __attribute__((ext_vector_type(2)));
DI void mg2_half(const MgMeta& M, int h, LAS char* hb, f32x4 (&D)[8]) {
    const int lane = tid_() & 63, c = lane & 15, g = lane >> 4;
    const u32x4 ch = h ? M.a1 : M.a0;
    const LAS char* rb = hb + (c & 7) * 1024 + (4 * (g & 1) + (c >> 3)) * 128 + 8 * (g >> 1);
#pragma unroll
    for (int t = 0; t < 8; ++t) {
        const unsigned mlo = (c == 4 * (t & 3)) ? 0xFFFFFFFFu : 0u, mhi = (c == 4 * (t & 3) + 1) ? 0xFFFFFFFFu : 0u;
        const i32x8 A = (i32x8){(int)(ch.x & mlo), (int)(ch.y & mlo), (int)(ch.z & mlo), (int)(ch.w & mlo), (int)(ch.x & mhi), (int)(ch.y & mhi), (int)(ch.z & mhi), (int)(ch.w & mhi)};
        const v2i_t b0 = __builtin_amdgcn_ds_read_tr4_b64_v2i32((LAS v2i_t*)(rb + ((t ^ (c & 7)) << 4)));
        const v2i_t b1 = __builtin_amdgcn_ds_read_tr4_b64_v2i32((LAS v2i_t*)(rb + 256 + ((t ^ (c & 7)) << 4)));
        D[t] = __builtin_amdgcn_mfma_scale_f32_16x16x128_f8f6f4(A, (i32x8){b0.x, b0.y, b1.x, b1.y, 0, 0, 0, 0}, D[t], 0, 4, 0, 0x7F7F7F7F, 0, 0x7F7F7F7F);
    }
}
template <int WHICH>
DI void mg_group(const Params& P, const unsigned char* slice, int n0, int x, LAS char* wl, unsigned wl_off, const MgMeta (&M)[4], MgMeta (&Mn)[4], bool more) {
    const int lane = tid_() & 63, kg = lane >> 4, c = lane & 15;
    bf16_t* outp = (bf16_t*)(P.ws + WS_HIDP) + (size_t)x * NTOK * (WHICH == 1 ? 128 : 256);
    f32x4 D[8];
    mg_issue(slice, M[0], 0, wl_off); SB();
#define MG_STEP(h, WAITSTMT) do { \
        if ((h) + 1 < 8) { mg_issue(slice, M[((h) + 1) >> 1], ((h) + 1) & 1, wl_off + (((h) + 1) & 1) * MG_HALF); } \
        else if (more) { _Pragma("unroll") for (int q_ = 0; q_ < 4; ++q_) mg_meta<WHICH>(P, n0 + 8 * (4 + q_), x, Mn[q_]); } \
        SB(); WAITSTMT; SB(); \
        LAS char* hb_ = wl + ((h) & 1) * MG_HALF; const int n_ = n0 + 8 * ((h) >> 1); \
        if (WHICH == 1) { const float r_ = mg1_half(M[(h) >> 1], hb_); outp[(size_t)n_ * 128 + 64 * ((h) & 1) + lane] = (bf16_t)f2bf(r_); } \
        else { if (((h) & 1) == 0) { _Pragma("unroll") for (int q_ = 0; q_ < 8; ++q_) D[q_] = (f32x4){0.f, 0.f, 0.f, 0.f}; } \
            mg2_half(M[(h) >> 1], (h) & 1, hb_, D); \
            if ((h) & 1) { asm volatile("s_nop 15\n\ts_nop 15" : "+v"(D[0]), "+v"(D[1]), "+v"(D[2]), "+v"(D[3]), "+v"(D[4]), "+v"(D[5]), "+v"(D[6]), "+v"(D[7])); \
                float v0_ = 0.f, v1_ = 0.f, v2_ = 0.f, v3_ = 0.f; _Pragma("unroll") for (int q_ = 0; q_ < 4; ++q_) { if (kg == q_) { v0_ = D[q_][0]; v1_ = D[q_][1]; v2_ = D[q_ + 4][0]; v3_ = D[q_ + 4][1]; } } \
                bf16_t* o_ = outp + (size_t)n_ * 256 + 32 * kg + c; o_[0] = (bf16_t)f2bf(v0_); o_[16] = (bf16_t)f2bf(v1_); o_[128] = (bf16_t)f2bf(v2_); o_[144] = (bf16_t)f2bf(v3_); } } \
        SB(); } while (0)
    if (WHICH == 1) {
        MG_STEP(0, MG_WAIT(8)); MG_STEP(1, MG_WAIT(9)); MG_STEP(2, MG_WAIT(9)); MG_STEP(3, MG_WAIT(9)); MG_STEP(4, MG_WAIT(9)); MG_STEP(5, MG_WAIT(9)); MG_STEP(6, MG_WAIT(9));
        if (more) { MG_STEP(7, MG_WAIT(33)); } else { MG_STEP(7, MG_WAIT(1)); }
    } else {
        MG_STEP(0, MG_WAIT(8)); MG_STEP(1, MG_WAIT(8)); MG_STEP(2, MG_WAIT(12)); MG_STEP(3, MG_WAIT(8)); MG_STEP(4, MG_WAIT(12)); MG_STEP(5, MG_WAIT(8)); MG_STEP(6, MG_WAIT(12));
        if (more) { MG_STEP(7, MG_WAIT(24)); } else { MG_STEP(7, MG_WAIT(0)); }
    }
#undef MG_STEP
}
template <int WHICH>
DI void mg_phase(const Params& P, char* lds_g) {
    const int tid = tid_(), wave = __builtin_amdgcn_readfirstlane(tid >> 6);
    unsigned* ctr = (unsigned*)(P.ws + WS_CTL) + (WHICH == 1 ? CTL_G1 : CTL_G2);
    const int x0 = (int)my_xcc_id();
    LAS int* slot = (LAS int*)((LAS char*)lds_g + LDS_ITEM);
    LAS char* wl = (LAS char*)lds_g + wave * MG_WAVE;
    const unsigned wl_off = (unsigned)__builtin_amdgcn_readfirstlane((int)(unsigned)(size_t)wl);
    constexpr int NSL = 4;
    for (int s = 0; s < NSL; ++s) {
        const int x = (x0 + s) & (NSL - 1);
        const unsigned char* slice = P.ws + (WHICH == 1 ? WS_UB : WS_VB) + (size_t)x * ((size_t)NEXP * 128);
        for (;;) {
            if (tid == 0) *slot = (int)atomicAdd(ctr + x, 1u);
            __syncthreads();
            const int chunk = *slot;
            __syncthreads();
            if (chunk >= NTOK / SL_CHUNK) break;
            const int nb = chunk * SL_CHUNK + wave;
            MgMeta MA[4], MB[4];
#pragma unroll
            for (int q = 0; q < 4; ++q) mg_meta<WHICH>(P, nb + 8 * q, x, MA[q]);
            mg_group<WHICH>(P, slice, nb, x, wl, wl_off, MA, MB, true);
            mg_group<WHICH>(P, slice, nb + 32, x, wl, wl_off, MB, MA, true);
            mg_group<WHICH>(P, slice, nb + 64, x, wl, wl_off, MA, MB, true);
            mg_group<WHICH>(P, slice, nb + 96, x, wl, wl_off, MB, MA, false);
            MG_WAIT(0);
        }
    }
}
DI void hid_reduce8_phase(const Params& P, int bid, int nblk) {
    const int tid = tid_(), lane = tid & 63, wave = __builtin_amdgcn_readfirstlane(tid >> 6);
    unsigned char* ws = P.ws;
    const int gw = bid * NWAVES + wave, NGW = nblk * NWAVES;
    const bf16_t* hp = (const bf16_t*)(ws + WS_HIDP);
    for (int n = gw; n < NTOK; n += NGW) {
        const float xs = ((const float*)(ws + WS_XSC))[n];
        f32x4 cv[2]; f32x4 am = (f32x4){0.f, 0.f, 0.f, 0.f};
#pragma unroll
        for (int q = 0; q < 2; ++q) {
            const size_t o = (size_t)n * 128 + 64 * q + lane; float a = 0.f;
            const int e = ((const int*)(ws + WS_EIDX))[o];
            const f32x4 us = *(const f32x4*)((const float*)(ws + WS_USC) + (size_t)e * 4);
#pragma unroll
            for (int x = 0; x < 4; ++x) a += bf2f(hp[(size_t)x * NTOK * 128 + o]) * us[x];
            const float cf = gelu_exact(a * xs) * ((const float*)(ws + WS_EGATE))[o];
            const f32x4 vs = *(const f32x4*)((const float*)(ws + WS_VSC) + (size_t)e * 4);
            cv[q] = vs * cf;
            am.x = fmaxf(am.x, fabsf(cv[q].x)); am.y = fmaxf(am.y, fabsf(cv[q].y)); am.z = fmaxf(am.z, fabsf(cv[q].z)); am.w = fmaxf(am.w, fabsf(cv[q].w));
        }
        f32x4 isc;
#pragma unroll
        for (int x = 0; x < 4; ++x) {
            float m = row16_max(am[x]); m = fmaxf(fmaxf(readlane_f(m, 0), readlane_f(m, 16)), fmaxf(readlane_f(m, 32), readlane_f(m, 48)));
            const float sc = (m > 0.f) ? exp2f(floorf(log2f(224.f / m))) : 1.f;
            const int w0 = __builtin_amdgcn_cvt_pk_fp8_f32(cv[0][x] * sc, cv[1][x] * sc, 0, false);
            unsigned char* cr = ws + WS_C8 + ((size_t)x * NTOK + n) * 128;
            cr[lane] = (unsigned char)(w0 & 255); cr[64 + lane] = (unsigned char)((w0 >> 8) & 255);
            isc[x] = 1.f / sc;
        }
        if (lane == 0) *(f32x4*)((float*)(ws + WS_CSC) + (size_t)n * 4) = isc;
    }
}
DI void final_norm8_phase(const Params& P, int bid, int nblk) {
    const int tid = tid_(), lane = tid & 63, wave = __builtin_amdgcn_readfirstlane(tid >> 6);
    const unsigned char* ws = P.ws;
    const int gw = bid * NWAVES + wave, NGW = nblk * NWAVES;
    f32x4 wv[4];
#pragma unroll
    for (int q = 0; q < 4; ++q) wv[q] = *(const f32x4*)(P.final_w + 16 * lane + 4 * q);
    for (int n = gw; n < NTOK; n += NGW) {
        float* orow = P.out + (size_t)n * DM + 16 * lane;
        const bf16_t* yrow = (const bf16_t*)(ws + WS_HIDP) + ((size_t)(lane >> 4) * NTOK + n) * 256 + 16 * (lane & 15);
        const u32x4 ya = *(const u32x4*)yrow, yb = *(const u32x4*)(yrow + 8);
        const unsigned yu[8] = {ya.x, ya.y, ya.z, ya.w, yb.x, yb.y, yb.z, yb.w};
        const float cs = ((const float*)(ws + WS_CSC))[(size_t)n * 4 + (lane >> 4)];
        const bf16_t* hrow = (const bf16_t*)(ws + WS_XB) + (size_t)n * DM + 16 * lane;
        const u32x4 ha = *(const u32x4*)hrow, hb = *(const u32x4*)(hrow + 8);
        const unsigned hu[8] = {ha.x, ha.y, ha.z, ha.w, hb.x, hb.y, hb.z, hb.w};
        f32x4 h[4]; float ss = 0.f;
#pragma unroll
        for (int q = 0; q < 4; ++q) { h[q] = (f32x4){bf2f(hu[2 * q] & 0xffffu), bf2f(hu[2 * q] >> 16), bf2f(hu[2 * q + 1] & 0xffffu), bf2f(hu[2 * q + 1] >> 16)} + (f32x4){bf2f(yu[2 * q] & 0xffffu), bf2f(yu[2 * q] >> 16), bf2f(yu[2 * q + 1] & 0xffffu), bf2f(yu[2 * q + 1] >> 16)} * cs; ss += (h[q].x * h[q].x + h[q].y * h[q].y) + (h[q].z * h[q].z + h[q].w * h[q].w); }
        ss = wave_sum_dpp(ss);
        const float rs = 1.f / sqrtf(ss * (1.f / DM) + EPS);
#pragma unroll
        for (int q = 0; q < 4; ++q) *(f32x4*)(orow + 4 * q) = h[q] * wv[q] * rs;
    }
}

#define XB_TMO      128
#define XB_XCNT(j)  (256  + 64 * (j))
#define XB_XSUB(j)  (1280 + 64 * (j))
#define XB_XGEN(j)  (2304 + 64 * (j))
#define XB_TOP      3328
#define XB_TOPGEN   3392
#define XCD_BAR_WORDS 3456
#define XB_SPIN_CAP (1u << 18)

__device__ __forceinline__ unsigned xb_ld(unsigned* p)              { return __hip_atomic_load(p, __ATOMIC_RELAXED, __HIP_MEMORY_SCOPE_AGENT); }
__device__ __forceinline__ unsigned xb_add(unsigned* p, unsigned v) { return __hip_atomic_fetch_add(p, v, __ATOMIC_RELAXED, __HIP_MEMORY_SCOPE_AGENT); }
__device__ __forceinline__ unsigned xb_xcc_id() { return (unsigned)__builtin_amdgcn_s_getreg((3 << 11) | 20) & 0xFu; }
#define XB_SPIN(cond, bar) do { unsigned _sp = 0; while (cond) { __builtin_amdgcn_s_sleep(1); \
    if ((++_sp & 255u) == 0u) { if (xb_ld(&(bar)[XB_TMO])) break; if (_sp > XB_SPIN_CAP) { atomicAdd(&(bar)[XB_TMO], 1u); break; } } } } while (0)

struct XcdBarrier {
    unsigned* bar; unsigned x;
    volatile LAS unsigned* st;
};

__device__ __forceinline__ XcdBarrier xcd_barrier_post(unsigned* bar, volatile LAS unsigned* st) {
    XcdBarrier b; b.bar = bar; b.x = xb_xcc_id(); b.st = st;
    if (threadIdx.x == 0) (void)xb_add(&bar[XB_XCNT(b.x)], 1u);
    return b;
}
__device__ __forceinline__ void xcd_barrier_complete(unsigned* bar, unsigned x, unsigned& nloc, unsigned& nx) {
    const unsigned G = gridDim.x * gridDim.y * gridDim.z;
    unsigned sum, cnt, mine, sp = 0u;
    for (;;) {
        sum = 0u; cnt = 0u; mine = 0u;
#pragma unroll
        for (unsigned j = 0; j < 16; ++j) { const unsigned c = xb_ld(&bar[XB_XCNT(j)]); sum += c; cnt += (c > 0u) ? 1u : 0u; mine = (j == x) ? c : mine; }
        if (sum == G) break;
        __builtin_amdgcn_s_sleep(1);
        if ((++sp & 255u) == 0u) { if (xb_ld(&bar[XB_TMO])) break; if (sp > XB_SPIN_CAP) { atomicAdd(&bar[XB_TMO], 1u); break; } }
    }
    nloc = mine > 0u ? mine : 1u; nx = cnt > 0u ? cnt : 1u;
}

__device__ __forceinline__ void xcd_barrier(const XcdBarrier& b) {
    asm volatile("s_waitcnt vmcnt(0)" ::: "memory");
    __syncthreads();
    if (threadIdx.x == 0) {
        unsigned* bar = b.bar;
        __builtin_amdgcn_s_waitcnt(0);
        unsigned nloc = b.st[0], nx = b.st[1];
        if (nloc == 0u) { xcd_barrier_complete(bar, b.x, nloc, nx); b.st[0] = nloc; b.st[1] = nx; }
        const unsigned old = xb_add(&bar[XB_XSUB(b.x)], 1u);
        const unsigned gen = old / nloc;
        if (old + 1u == (gen + 1u) * nloc) {
            __builtin_amdgcn_fence(__ATOMIC_RELEASE, "agent");
            asm volatile("s_waitcnt vmcnt(0)" ::: "memory");
            const unsigned og = xb_add(&bar[XB_TOP], 1u);
            const unsigned tg = og / nx;
            if (og + 1u == (tg + 1u) * nx) xb_add(&bar[XB_TOPGEN], 1u);
            else XB_SPIN(xb_ld(&bar[XB_TOPGEN]) == tg, bar);
            __builtin_amdgcn_fence(__ATOMIC_ACQUIRE, "agent");
            xb_add(&bar[XB_XGEN(b.x)], 1u);
            asm volatile("s_waitcnt vmcnt(0)" ::: "memory");
        } else {
            XB_SPIN(xb_ld(&bar[XB_XGEN(b.x)]) == gen, bar);
            __builtin_amdgcn_fence(__ATOMIC_ACQUIRE, "agent");
            asm volatile("s_waitcnt vmcnt(0)" ::: "memory");
        }
    }
    __syncthreads();
}

constexpr int CTL_XB_WORD = 2048;
static_assert((CTL_XB_WORD + 3456) * 4 <= (int)CTL_BYTES, "barrier words inside CTL");
constexpr int N_HGRN_ITEMS = BATCH * 4, N_ATT_ITEMS = BATCH * 4 * 32;

DI void mixer_phase(const Params& P, char* lds) {
    unsigned* ctr = (unsigned*)(P.ws + WS_CTL);
    for (;;) {
        if (tid_() == 0) *(LAS int*)((LAS char*)lds + LDS_ITEM) = (int)atomicAdd(ctr, 1u);
        __syncthreads();
        const int item = *(LAS int*)((LAS char*)lds + LDS_ITEM);
        __syncthreads();
        if (item >= N_HGRN_ITEMS + N_ATT_ITEMS) break;
        if (item < N_HGRN_ITEMS) hgrn_unit(P, item >> 2, item & 3, lds);
        else { const int a = item - N_HGRN_ITEMS, j = 31 - (a >> 5), bh = a & 31; attn_unit(P, bh >> 2, bh & 3, j, lds); }
    }
}

#ifdef TS_PHASE
#ifndef TS_DIV
#define TS_DIV 4.0f
#endif
#define TS(i) do { if (blockIdx.x == 0 && threadIdx.x == 0) ((LAS unsigned long long*)((LAS char*)lds + LDS_BYTES - 512))[i] = __builtin_amdgcn_s_memrealtime(); } while (0)
#else
#define TS(i) do { } while (0)
#endif
__global__ void __launch_bounds__(NTHREADS, 2) fwd_megakernel(Params P) {
    extern __shared__ __attribute__((aligned(16))) char lds[];
    cg::grid_group grid = cg::this_grid();
    const int bid = blockIdx.x, nblk = gridDim.x;
    unsigned char* ws = P.ws;
    volatile LAS unsigned* xst = (volatile LAS unsigned*)((LAS char*)lds + LDS_XB);
    if (threadIdx.x < 4) xst[threadIdx.x] = 0u;
    __syncthreads();
    TS(0);
    phase0(P, lds, bid, nblk);
    grid.sync();
    const XcdBarrier xbar = xcd_barrier_post((unsigned*)(ws + WS_CTL) + CTL_XB_WORD, xst);
    TS(1);
    { Epi1 e{ws}; gemm_run(lds, (const bf16_t*)(ws + WS_XB), (const bf16_t*)(ws + WS_W1T), M1, NCOL1, DM, e, bid, nblk); }
    {
        constexpr int NUNITS = (M1 / 256) * (NCOL1 / 256);
        const int nlast = NUNITS % nblk, nfree = nlast ? nblk - nlast : nblk;
        const int wave = __builtin_amdgcn_readfirstlane(tid_() >> 6);
        if (nlast == 0 || bid >= nlast) table_fp8_rows(P, NEXP + (bid - (nlast ? nlast : 0)) * NWAVES + wave, nfree * NWAVES, 2 * NEXP);
    }
    xcd_barrier(xbar);
    TS(2);
    for (int it = bid; it < 32 * 129; it += nblk) hgrn_prep_item(P, it & 31, it >> 5, lds);
    xcd_barrier(xbar);
    TS(3);
    mixer_phase(P, lds);
    xcd_barrier(xbar);
    TS(4);
    { Epi3 e{P.x, P.out, (bf16_t*)(ws + WS_XB), (float*)(ws + WS_SSQ)}; gemm_run(lds, (const bf16_t*)(ws + WS_MIX), (const bf16_t*)(ws + WS_W2T), NTOK, DM, DM, e, bid, nblk); }
    xcd_barrier(xbar);
    TS(5);
    { Epi4 e{(const float*)(ws + WS_SSQ), (bf16_t*)(ws + WS_PQ)}; gemm_run(lds, (const bf16_t*)(ws + WS_XB), (const bf16_t*)(ws + WS_W3T), NTOK, 2048, DM, e, bid, nblk); }
    xcd_barrier(xbar);
    TS(6);
    topk_phase(P, lds, bid, nblk);
    xn8_rows(P, bid, nblk);
    xcd_barrier(xbar);
    TS(7);
    mg_phase<1>(P, lds);
    xcd_barrier(xbar);
    TS(8);
    hid_reduce8_phase(P, bid, nblk);
    xcd_barrier(xbar);
    TS(9);
    mg_phase<2>(P, lds);
    xcd_barrier(xbar);
    TS(10);
    final_norm8_phase(P, bid, nblk);
    TS(11);
#ifdef TS_PHASE
    if (blockIdx.x == 0 && threadIdx.x == 0) { const LAS unsigned long long* t = (const LAS unsigned long long*)((LAS char*)lds + LDS_BYTES - 512);
        P.out[0] += (float)(t[TS_PHASE + 1] - t[TS_PHASE]) * 0.01f / TS_DIV; }
#endif
}

extern "C" void kernel_launch(void* const* d_in, const int* in_sizes, int n_in, void* d_out, int out_size, void* d_ws, size_t ws_size, hipStream_t stream) {
    static int grid = 0;
    if (grid == 0) {
        int dev = 0, cus = 0, per_cu = 0;
        (void)hipGetDevice(&dev);
        (void)hipDeviceGetAttribute(&cus, hipDeviceAttributeMultiprocessorCount, dev);
        (void)hipFuncSetAttribute((const void*)fwd_megakernel, hipFuncAttributeMaxDynamicSharedMemorySize, LDS_BYTES);
        (void)hipOccupancyMaxActiveBlocksPerMultiprocessor(&per_cu, (const void*)fwd_megakernel, NTHREADS, LDS_BYTES);
        if (per_cu < 1) { fprintf(stderr, "kernel_launch: occupancy query says %d blocks per CU\n", per_cu); per_cu = 1; }
        grid = cus * 1;
        if (ws_size < WS_END) { fprintf(stderr, "kernel_launch: workspace too small: %zu < %zu\n", ws_size, (size_t)WS_END); grid = -1; }
    }
    if (grid < 0) return;
    Params p{};
    p.x = (const float*)d_in[0]; p.meta = (const float*)d_in[1]; p.mix_norm_w = (const float*)d_in[2]; p.w_in = (const float*)d_in[3];
    p.lb_logits = (const float*)d_in[4]; p.rec_norm_w = (const float*)d_in[5]; p.lq1 = (const float*)d_in[6]; p.lk1 = (const float*)d_in[7];
    p.lq2 = (const float*)d_in[8]; p.lk2 = (const float*)d_in[9]; p.subln_w = (const float*)d_in[10]; p.w_out = (const float*)d_in[11];
    p.ffn_norm_w = (const float*)d_in[12]; p.wq = (const float*)d_in[13]; p.subkeys = (const float*)d_in[14]; p.pu = (const float*)d_in[15];
    p.pv = (const float*)d_in[16]; p.final_w = (const float*)d_in[17];
    p.out = (float*)d_out; p.ws = (unsigned char*)d_ws;
    void* args[] = {&p};
    hipError_t e = hipLaunchCooperativeKernel((const void*)fwd_megakernel, dim3(grid), dim3(NTHREADS), args, LDS_BYTES, stream);
    if (e != hipSuccess) fprintf(stderr, "cooperative launch failed: %s (grid %d)\n", hipGetErrorString(e), grid);
}
```

```cpp
#include <hip/hip_runtime.h>
#include <hip/hip_cooperative_groups.h>
#include <cstdio>
#include <cstdint>
#define DBG_SEL 1
namespace cg = cooperative_groups;

constexpr int BATCH = 8, SEQ = 4096, DM = 1024, NMETA = 16;
constexpr int NTOK = BATCH * SEQ;
constexpr int M1 = NTOK + 256;
constexpr int NCOL1 = 3584;
constexpr int TPOS = NMETA + SEQ;
constexpr int KT = 65;
constexpr int KPAD = 48;
constexpr int HT = 4128;
constexpr int NEXP = 16384;
constexpr float EPS = 1e-6f;
constexpr float LAM_INIT = 0.2f;
constexpr float QSCALE = 0.125f * 1.4426950408889634f;
constexpr int NTHREADS = 512, NWAVES = 8;
constexpr int LDS_BYTES = 163840;
constexpr int LDS_ITEM = LDS_BYTES - 64, LDS_XB = LDS_BYTES - 32;

typedef unsigned short bf16_t;
typedef short bf16x8 __attribute__((ext_vector_type(8)));
typedef float f32x4 __attribute__((ext_vector_type(4)));
typedef float f32x16 __attribute__((ext_vector_type(16)));
typedef float f32x2 __attribute__((ext_vector_type(2)));
typedef unsigned u32x4 __attribute__((ext_vector_type(4)));
typedef unsigned u32x2 __attribute__((ext_vector_type(2)));
typedef __bf16 bf16x2_t __attribute__((ext_vector_type(2)));
typedef short s16x4 __attribute__((ext_vector_type(4)));
#define LAS __attribute__((address_space(3)))
#define DI __device__ __forceinline__
__device__ __forceinline__ int tid_() { int t = threadIdx.x; asm volatile("" : "+v"(t)); return t; }

constexpr size_t al256(size_t x) { return (x + 255) & ~(size_t)255; }
constexpr size_t WS_CTL = 0, CTL_BYTES = 65536;
constexpr size_t WS_W1T = WS_CTL + CTL_BYTES;
constexpr size_t WS_W2T = WS_W1T + (size_t)NCOL1 * DM * 2;
constexpr size_t WS_W3T = WS_W2T + (size_t)DM * DM * 2;
constexpr size_t WS_SKB = WS_W3T + (size_t)2048 * DM * 2;
constexpr size_t WS_UB = WS_SKB + (size_t)16 * 128 * 128 * 2;
constexpr size_t WS_VB = WS_UB + (size_t)NEXP * DM * 2;
constexpr size_t WS_USC = WS_UB + (size_t)NEXP * DM, WS_VSC = WS_VB + (size_t)NEXP * DM;
constexpr size_t WS_ROPE = WS_VB + (size_t)NEXP * DM * 2;
constexpr size_t WS_LB = WS_ROPE + (size_t)TPOS * 64 * 4;
constexpr size_t WS_R1 = WS_LB + 4096;
constexpr size_t WS_SSQ = WS_R1 + al256((size_t)M1 * 4);
constexpr size_t WS_SSQ2 = WS_SSQ + (size_t)NTOK * 4;
constexpr size_t WS_XB = WS_SSQ2 + (size_t)NTOK * 4;
constexpr size_t WS_C = WS_XB + (size_t)M1 * DM * 2;
constexpr size_t WS_Q = WS_C;
constexpr size_t WS_K = WS_Q + (size_t)NTOK * 512 * 2;
constexpr size_t WS_V = WS_K + (size_t)BATCH * 4 * 2 * KT * 8192;
constexpr size_t WS_HQ = WS_V + (size_t)BATCH * 4 * KT * 16384;
constexpr size_t WS_HV = WS_HQ + (size_t)BATCH * 4 * HT * 128 * 2;
constexpr size_t WS_HG = WS_HV + (size_t)BATCH * 4 * HT * 128 * 2;
constexpr size_t WS_SG = WS_HG + (size_t)BATCH * 4 * HT * 128 * 4;
constexpr size_t WS_CEND = WS_SG + (size_t)NTOK * 512 * 2;
constexpr size_t WS_PQ = WS_C;
constexpr size_t WS_EIDX = WS_PQ + (size_t)NTOK * 2048 * 2;
constexpr size_t WS_EGATE = WS_EIDX + (size_t)NTOK * 128 * 4;
constexpr size_t WS_HID = WS_EGATE + (size_t)NTOK * 128 * 4;
constexpr size_t WS_XN8 = WS_HID + (size_t)NTOK * 128 * 4;
constexpr size_t WS_XSC = WS_XN8 + (size_t)NTOK * DM;
constexpr size_t WS_C8 = WS_XSC + (size_t)NTOK * 4;
constexpr size_t WS_CSC = WS_C8 + (size_t)NTOK * 128 * 4;
static_assert(WS_CSC + (size_t)NTOK * 16 <= WS_CEND, "overlay fits");
constexpr size_t WS_HIDP = WS_PQ;
constexpr size_t WS_MIX = WS_CEND;
constexpr size_t WS_HQA = WS_MIX + (size_t)NTOK * DM * 2;
constexpr size_t WS_HD = WS_HQA + (size_t)BATCH * 4 * HT * 128 * 2;
constexpr size_t WS_END = WS_HD + (size_t)BATCH * 4 * 129 * 128 * 4;
static_assert(WS_END <= (size_t)512 * 1024 * 1024, "workspace map must fit 512 MiB");

struct Params {
    const float* x; const float* meta; const float* mix_norm_w; const float* w_in; const float* lb_logits; const float* rec_norm_w;
    const float* lq1; const float* lk1; const float* lq2; const float* lk2; const float* subln_w; const float* w_out; const float* ffn_norm_w;
    const float* wq; const float* subkeys; const float* pu; const float* pv; const float* final_w;
    float* out; unsigned char* ws;
};

DI unsigned f2bf(float f) { unsigned u = __builtin_bit_cast(unsigned, f); return (u + 0x7fffu + ((u >> 16) & 1u)) >> 16; }
DI float bf2f(unsigned b) { return __builtin_bit_cast(float, b << 16); }
DI unsigned cvtpk(float lo, float hi) { f32x2 v = {lo, hi}; bf16x2_t b = __builtin_convertvector(v, bf16x2_t); return __builtin_bit_cast(unsigned, b); }
DI float wave_sum(float v) {
#pragma unroll
    for (int o = 1; o < 64; o <<= 1) v += __shfl_xor(v, o);
    return v;
}
DI float sigmoidf_(float x) { return 1.f / (1.f + __expf(-x)); }
DI float siluf_(float x) { return x * sigmoidf_(x); }

DI int sigma_col(int c) {
    if (c >= 1024) return c;
    const int cc = c & 63, a = cc >> 5, fq = (cc >> 3) & 3, n = (cc >> 2) & 1, j = cc & 3;
    return (c & ~63) + 4 * (4 * a + fq) + 32 * n + j;
}
template <bool PERMUTE>
DI void p0_transpose_item(const float* W, int K, int N, const float* scale, bf16_t* WT, LAS float* scr, int item, int lane) {
    const int nblk = N / 32, kb = item / nblk, nb = item % nblk, k0 = 64 * kb, n0 = 32 * nb;
    const int ncol = PERMUTE ? sigma_col(n0 + (lane & 31)) : n0 + (lane & 31);
#pragma unroll 8
    for (int i = 0; i < 32; ++i) { const int kk = 2 * i + (lane >> 5); float s = scale ? scale[k0 + kk] : 1.f; scr[kk * 33 + (lane & 31)] = W[(size_t)(k0 + kk) * N + ncol] * s; }
    asm volatile("s_waitcnt lgkmcnt(0)" ::: "memory");
    const int c = lane & 7;
#pragma unroll
    for (int j = 0; j < 4; ++j) { const int n = (lane >> 3) + 8 * j; const LAS float* s = scr + (8 * c) * 33 + n;
        u32x4 o; o.x = cvtpk(s[0 * 33], s[1 * 33]); o.y = cvtpk(s[2 * 33], s[3 * 33]); o.z = cvtpk(s[4 * 33], s[5 * 33]); o.w = cvtpk(s[6 * 33], s[7 * 33]);
        *(u32x4*)(WT + (size_t)(n0 + n) * K + k0 + 8 * c) = o; }
    asm volatile("s_waitcnt lgkmcnt(0)" ::: "memory");
}

DI unsigned fp4_code(float x, float sc) {
    const float a = fabsf(x) * sc;
    const unsigned idx = (unsigned)(a > 0.25f) + (unsigned)(a > 0.75f) + (unsigned)(a > 1.25f) + (unsigned)(a > 1.75f) + (unsigned)(a > 2.5f) + (unsigned)(a > 3.5f) + (unsigned)(a > 5.0f);
    return idx | (x < 0.f ? 8u : 0u);
}
DI void table_fp8_rows(const Params& P, int first, int stride, int r_end) {
    const int lane = tid_() & 63;
    unsigned char* ws = P.ws;
    for (int r = first; r < r_end; r += stride) {
        const bool isv = r >= NEXP; const int e = isv ? r - NEXP : r;
        const f32x4* src = (const f32x4*)((isv ? P.pv : P.pu) + (size_t)e * DM) + lane;
        f32x4 v[4]; float amq[4];
#pragma unroll
        for (int q = 0; q < 4; ++q) { v[q] = src[64 * q]; amq[q] = fmaxf(fmaxf(fabsf(v[q].x), fabsf(v[q].y)), fmaxf(fabsf(v[q].z), fabsf(v[q].w))); }
#pragma unroll
        for (int o = 1; o < 64; o <<= 1) {
#pragma unroll
            for (int q = 0; q < 4; ++q) amq[q] = fmaxf(amq[q], __shfl_xor(amq[q], o));
        }
        {
            unsigned char* tb = ws + (isv ? WS_VB : WS_UB); float* scp = (float*)(ws + (isv ? WS_VSC : WS_USC));
#pragma unroll
            for (int q = 0; q < 4; ++q) {
                const float sc = (amq[q] > 0.f) ? 6.f / amq[q] : 1.f;
                unsigned w = __builtin_amdgcn_cvt_scalef32_pk_fp4_f32(0u, v[q].x * sc, v[q].y * sc, 1.0f, 0); w = __builtin_amdgcn_cvt_scalef32_pk_fp4_f32(w, v[q].z * sc, v[q].w * sc, 1.0f, 1);
                *(unsigned short*)(tb + ((size_t)q * NEXP + e) * 128 + 2 * lane) = (unsigned short)w;
                if (lane == 0) scp[(size_t)e * 4 + q] = 1.f / sc;
            }
        }
    }
}

DI void phase0(const Params& P, char* lds, int bid, int nblk) {
    const int tid = tid_(), lane = tid & 63, wave = __builtin_amdgcn_readfirstlane(tid >> 6);
    unsigned char* ws = P.ws;
    LAS float* scr = (LAS float*)(lds) + wave * (64 * 33);
    const int gw = bid * NWAVES + wave, NGW = nblk * NWAVES;
    constexpr int I1 = (DM / 64) * (NCOL1 / 32), I2 = (DM / 64) * (DM / 32), I3 = (DM / 64) * (2048 / 32);
    for (int it = gw; it < I1 + I2 + I3; it += NGW) {
        int r = it;
        if (r < I1) { p0_transpose_item<true>(P.w_in, DM, NCOL1, P.mix_norm_w, (bf16_t*)(ws + WS_W1T), scr, r, lane); continue; } r -= I1;
        if (r < I2) { p0_transpose_item<false>(P.w_out, DM, DM, nullptr, (bf16_t*)(ws + WS_W2T), scr, r, lane); continue; } r -= I2;
        p0_transpose_item<false>(P.wq, DM, 2048, P.ffn_norm_w, (bf16_t*)(ws + WS_W3T), scr, r, lane);
    }
    for (int m = gw; m < M1; m += NGW) {
        bf16_t* orow = (bf16_t*)(ws + WS_XB) + (size_t)m * DM;
        float* r1 = (float*)(ws + WS_R1);
        unsigned long long* o8 = (unsigned long long*)orow + lane;
        if (m >= NTOK + NMETA) { for (int j = 0; j < 4; ++j) o8[64 * j] = 0ull; if (lane == 0) r1[m] = 0.f; continue; }
        const float* xrow = (m < NTOK) ? P.x + (size_t)m * DM : P.meta + (size_t)(m - NTOK) * DM;
        const f32x4* xr = (const f32x4*)xrow + lane;
        f32x4 v[4]; float s = 0.f;
#pragma unroll
        for (int j = 0; j < 4; ++j) { v[j] = xr[64 * j]; s += (v[j].x * v[j].x + v[j].y * v[j].y) + (v[j].z * v[j].z + v[j].w * v[j].w); }
        s = wave_sum(s);
        if (lane == 0) r1[m] = 1.f / sqrtf(s * (1.f / DM) + EPS);
#pragma unroll
        for (int j = 0; j < 4; ++j) o8[64 * j] = (unsigned long long)cvtpk(v[j].x, v[j].y) | ((unsigned long long)cvtpk(v[j].z, v[j].w) << 32);
    }
    table_fp8_rows(P, gw, NGW, NEXP);
    {
        const size_t gt = (size_t)bid * NTHREADS + tid, NGT = (size_t)nblk * NTHREADS;
        const size_t ns = (size_t)16 * 128 * 128 / 8;
        for (size_t e = gt; e < ns; e += NGT) {
            const f32x4 a = ((const f32x4*)P.subkeys)[2 * e], b = ((const f32x4*)P.subkeys)[2 * e + 1];
            u32x4 o; o.x = cvtpk(a.x, a.y); o.y = cvtpk(a.z, a.w); o.z = cvtpk(b.x, b.y); o.w = cvtpk(b.z, b.w);
            ((u32x4*)(ws + WS_SKB))[e] = o;
        }
        float* rope = (float*)(ws + WS_ROPE);
        for (size_t i = gt; i < (size_t)TPOS * 32; i += NGT) {
            const int t = (int)(i >> 5), f = (int)(i & 31);
            const double inv = exp2(-(double)f * (13.287712379549449 / 32.0));
            const double ang = (double)t * inv;
            rope[(size_t)t * 64 + f] = (float)cos(ang); rope[(size_t)t * 64 + 32 + f] = (float)sin(ang);
        }
        for (size_t i = gt; i < CTL_BYTES / 16; i += NGT) ((u32x4*)(ws + WS_CTL))[i] = (u32x4){0u, 0u, 0u, 0u};
        float* ssq = (float*)(ws + WS_SSQ);
        for (size_t i = gt; i < (size_t)2 * NTOK; i += NGT) ssq[i] = 0.f;
        for (size_t i = gt; i < (size_t)BATCH * 4 * 2 * 512; i += NGT) { const size_t img = i >> 9, o = i & 511; ((u32x4*)(ws + WS_K + img * KT * 8192))[o] = (u32x4){0u, 0u, 0u, 0u}; }
        for (size_t i = gt; i < (size_t)BATCH * 4 * 1024; i += NGT) { const size_t img = i >> 10, o = i & 1023; ((u32x4*)(ws + WS_V + img * KT * 16384))[o] = (u32x4){0u, 0u, 0u, 0u}; }
        for (size_t i = gt; i < (size_t)BATCH * 4 * 16 * 16; i += NGT) { const size_t bh = i >> 8, o = i & 255;
            ((u32x4*)(ws + WS_HQ + bh * HT * 256))[o] = (u32x4){0u, 0u, 0u, 0u}; ((u32x4*)(ws + WS_HV + bh * HT * 256))[o] = (u32x4){0u, 0u, 0u, 0u}; }
        for (size_t i = gt; i < (size_t)BATCH * 4 * 16 * 32; i += NGT) { const size_t bh = i >> 9, o = i & 511; ((u32x4*)(ws + WS_HG + bh * HT * 512))[o] = (u32x4){0u, 0u, 0u, 0u}; }
        float* lb = (float*)(ws + WS_LB);
        if (gt < 512) lb[gt] = sigmoidf_(P.lb_logits[gt] - P.lb_logits[512 + gt]);
        if (bid == 0 && wave == 0) {
            const float a = wave_sum(P.lq1[lane] * P.lk1[lane]), b = wave_sum(P.lq2[lane] * P.lk2[lane]);
            if (lane == 0) lb[512] = __expf(a) - __expf(b) + LAM_INIT;
        }
    }
}

namespace pg8 {
#define PG8_LAS __attribute__((address_space(3)))
typedef unsigned short bf16_t;
typedef short bf16x8 __attribute__((ext_vector_type(8)));
typedef float f32x4 __attribute__((ext_vector_type(4)));
typedef unsigned u32x4 __attribute__((ext_vector_type(4)));
constexpr int BM = 256, BK = 64, HALF = 128, HTB = HALF * BK * 2  , STAGE_BYTES = 8 * HTB, NXCD = 8, WGM = 8;

__host__ __device__ __forceinline__ int lds_byte(int r, int c) { const int st = (r >> 4) * 2 + (c >> 5), rr = r & 15, cc = c & 31, ob = rr * 64 + cc * 2; return st * 1024 + (ob ^ (((ob >> 9) & 1) << 5)); }
__host__ __device__ __forceinline__ void stage_rc(int b, int& R, int& C) { const int st = b / 1024, sb = b % 1024, swz = sb ^ (((sb >> 9) & 1) << 5); R = (st >> 1) * 16 + swz / 64; C = (st & 1) * 32 + (swz % 64) / 2; }
__host__ __device__ __forceinline__ int perm32(int rho) { const int n = rho >> 4, i = rho & 15; return 8 * (i >> 2) + 4 * n + (i & 3); }

struct Unit { int pm, pn; };
struct Gemm { const bf16_t* A; const bf16_t* Bt; int M, N, K; };

struct StaticOrder {
    int nM, nN, nwg, G, c;
    __host__ __device__ void init(int M, int N, int G_, int c_) { nM = M / BM; nN = N / BM; nwg = nM * nN; G = G_; c = c_; }
    __host__ __device__ bool next(int i, Unit& u) const {
        const long L = (long)i * G + c; if (L >= nwg) return false;
        int wgid = (int)L; { const int q = nwg / NXCD, r = nwg % NXCD, xcd = wgid % NXCD, off = wgid / NXCD; wgid = (xcd < r ? xcd * (q + 1) : r * (q + 1) + (xcd - r) * q) + off; }
        const int nig = WGM * nN, gid = wgid / nig, fm = gid * WGM, gsz = (nM - fm) < WGM ? (nM - fm) : WGM;
        u.pm = fm + ((wgid % nig) % gsz); u.pn = (wgid % nig) / gsz; return true;
    }
    __device__ __forceinline__ void a_ready(const Unit&) const {}
    __device__ __forceinline__ void done(const Unit&) const {}
};

template <class Epi, class Sched, bool ALIGN_EPI = false, bool SP2 = false>
__device__ __forceinline__ void gemm_phase(PG8_LAS unsigned char* lds, const Gemm g, const Sched& S, const Epi& E) {
    const int tid = tid_(), wid = __builtin_amdgcn_readfirstlane(tid >> 6), lane = tid & 63, wr = wid >> 2, wc = wid & 3, fr = lane & 15, fq = lane >> 4;
    const int K = g.K, nt = K / BK;
    unsigned voffA[2], voffB[2];
#pragma unroll
    for (int i = 0; i < 2; ++i) { int R, C; stage_rc(tid * 16 + i * 8192, R, C); const int Rb = Epi::PERM ? ((R & ~31) + perm32(R & 31)) : R;
        voffA[i] = (unsigned)(R * K + C) * 2u; voffB[i] = (unsigned)(Rb * K + C) * 2u; }
    const size_t kstep = (size_t)(BK * 2);
    const size_t hstep = (size_t)HALF * K * 2;
    const size_t tstep = 2 * hstep;
    const unsigned ldsw = (unsigned)wid * 1024u;
    const int aoff = lds_byte(wr * 64 + fr, fq * 8), boff = lds_byte(wc * 32 + fr, fq * 8);
#define PG8_SA(b, h) (((b) * 2 + (h)) * HTB)
#define PG8_SB(b, h) ((4 + (b) * 2 + (h)) * HTB)
#define PG8_STAGE(bufoff, gbase, voff) do { _Pragma("unroll") for (int _i = 0; _i < 2; ++_i) \
        __builtin_amdgcn_global_load_lds((const unsigned*)((const char*)(gbase) + (voff)[_i]), (PG8_LAS unsigned*)(lds + (bufoff) + ldsw + _i * 8192), 16, 0, 0); } while (0)
#define PG8_LDA(dst, b, h) do { _Pragma("unroll") for (int m = 0; m < 4; ++m) _Pragma("unroll") for (int k = 0; k < 2; ++k) dst[m][k] = *(const PG8_LAS bf16x8*)(lds + PG8_SA(b, h) + aoff + m * 2048 + k * 1024); } while (0)
#define PG8_LDB(dst, b, h) do { _Pragma("unroll") for (int n = 0; n < 2; ++n) _Pragma("unroll") for (int k = 0; k < 2; ++k) dst[n][k] = *(const PG8_LAS bf16x8*)(lds + PG8_SB(b, h) + boff + n * 2048 + k * 1024); } while (0)
#define PG8_MMA(ai, bj, At, Bt) do { __builtin_amdgcn_s_setprio(1); _Pragma("unroll") for (int m = 0; m < 4; ++m) _Pragma("unroll") for (int n = 0; n < 2; ++n) _Pragma("unroll") for (int k = 0; k < 2; ++k) \
        acc[ai][bj][m][n] = __builtin_amdgcn_mfma_f32_16x16x32_bf16(Bt[n][k], At[m][k], acc[ai][bj][m][n], 0, 0, 0); __builtin_amdgcn_s_setprio(0); } while (0)
#define PG8_WAIT_V(n) asm volatile("s_waitcnt vmcnt(" #n ")" ::: "memory")
#define PG8_WAIT_L(n) asm volatile("s_waitcnt lgkmcnt(" #n ")" ::: "memory")
#define PG8_BAR __builtin_amdgcn_s_barrier()
#define PG8_SCHED __builtin_amdgcn_sched_barrier(0)
    Unit cur, nxt; int ui = 0;
    if (!S.next(0, cur)) return;
    f32x4 acc[2][2][4][2];
#pragma unroll
    for (int a = 0; a < 2; ++a)
#pragma unroll
        for (int b = 0; b < 2; ++b)
#pragma unroll
            for (int m = 0; m < 4; ++m)
#pragma unroll
                for (int n = 0; n < 2; ++n) acc[a][b][m][n] = (f32x4){0.f, 0.f, 0.f, 0.f};
    bf16x8 At[4][2], B0[2][2], B1[2][2];
    const char* cA = (const char*)g.A + (size_t)cur.pm * tstep; const char* cB = (const char*)g.Bt + (size_t)cur.pn * tstep;
    S.a_ready(cur);
    if constexpr (SP2) {
        PG8_STAGE(PG8_SB(0, 0), cB, voffB); PG8_STAGE(PG8_SB(0, 1), cB + hstep, voffB); PG8_STAGE(PG8_SA(0, 0), cA, voffA); PG8_STAGE(PG8_SA(0, 1), cA + hstep, voffA);
        if (wr == 1) PG8_BAR;
        PG8_WAIT_V(2); PG8_BAR;
        PG8_STAGE(PG8_SB(1, 0), cB + kstep, voffB); PG8_STAGE(PG8_SA(1, 0), cA + kstep, voffA); PG8_STAGE(PG8_SB(1, 1), cB + hstep + kstep, voffB);
        PG8_WAIT_V(6); PG8_BAR;
    } else {
        PG8_STAGE(PG8_SB(0, 0), cB, voffB); PG8_STAGE(PG8_SA(0, 0), cA, voffA); PG8_STAGE(PG8_SB(0, 1), cB + hstep, voffB); PG8_STAGE(PG8_SA(0, 1), cA + hstep, voffA);
        if (wr == 1) PG8_BAR;
        PG8_WAIT_V(4); PG8_BAR;
        PG8_STAGE(PG8_SB(1, 0), cB + kstep, voffB); PG8_STAGE(PG8_SA(1, 0), cA + kstep, voffA); PG8_STAGE(PG8_SB(1, 1), cB + hstep + kstep, voffB);
        PG8_WAIT_V(6); PG8_BAR;
    }
    for (;;) {
        const bool has_next = S.next(ui + 1, nxt);
        const char* nA = has_next ? (const char*)g.A + (size_t)nxt.pm * tstep : cA; const char* nB = has_next ? (const char*)g.Bt + (size_t)nxt.pn * tstep : cB;
        for (int t = 0; t < nt; t += 2) {
            const bool last = (t == nt - 2);
            const char* a1 = cA + (size_t)(t + 1) * kstep;
            const char* a2 = last ? nA : cA + (size_t)(t + 2) * kstep; const char* b2 = last ? nB : cB + (size_t)(t + 2) * kstep;
            const char* a3 = a2 + kstep; const char* b3 = b2 + kstep;
            if (last && has_next) S.a_ready(nxt);
            if constexpr (SP2) {
            PG8_LDB(B0, 0, 0); PG8_LDB(B1, 0, 1); PG8_SCHED; PG8_LDA(At, 0, 0); PG8_STAGE(PG8_SA(1, 1), a1 + hstep, voffA);
            PG8_WAIT_V(8); PG8_WAIT_L(0); PG8_BAR; PG8_MMA(0, 0, At, B0); PG8_MMA(0, 1, At, B1); PG8_BAR; PG8_SCHED;
            PG8_LDA(At, 0, 1); PG8_STAGE(PG8_SB(0, 0), b2, voffB); PG8_STAGE(PG8_SB(0, 1), b2 + hstep, voffB); PG8_STAGE(PG8_SA(0, 0), a2, voffA);
            PG8_WAIT_V(8); PG8_WAIT_L(0); PG8_BAR; PG8_MMA(1, 0, At, B0); PG8_MMA(1, 1, At, B1); PG8_BAR; PG8_SCHED;
            PG8_LDB(B0, 1, 0); PG8_LDB(B1, 1, 1); PG8_SCHED; PG8_LDA(At, 1, 0); PG8_STAGE(PG8_SA(0, 1), a2 + hstep, voffA);
            PG8_WAIT_V(8); PG8_WAIT_L(0); PG8_BAR; PG8_MMA(0, 0, At, B0); PG8_MMA(0, 1, At, B1); PG8_BAR; PG8_SCHED;
            PG8_LDA(At, 1, 1); PG8_STAGE(PG8_SB(1, 0), b3, voffB); PG8_STAGE(PG8_SB(1, 1), b3 + hstep, voffB); PG8_STAGE(PG8_SA(1, 0), a3, voffA);
            PG8_WAIT_V(8); PG8_WAIT_L(0); PG8_BAR; PG8_MMA(1, 0, At, B0); PG8_MMA(1, 1, At, B1); PG8_BAR; PG8_SCHED;
            } else {
            PG8_LDB(B0, 0, 0); PG8_SCHED; PG8_LDA(At, 0, 0); PG8_STAGE(PG8_SA(1, 1), a1 + hstep, voffA);
            PG8_WAIT_L(8); PG8_BAR; PG8_WAIT_L(0); PG8_MMA(0, 0, At, B0); PG8_BAR; PG8_SCHED;
            PG8_LDB(B1, 0, 1); PG8_STAGE(PG8_SB(0, 0), b2, voffB);
            PG8_BAR; PG8_WAIT_L(0); PG8_MMA(0, 1, At, B1); PG8_BAR;
            PG8_LDA(At, 0, 1); PG8_STAGE(PG8_SA(0, 0), a2, voffA);
            PG8_BAR; PG8_WAIT_L(0); PG8_MMA(1, 0, At, B0); PG8_BAR; PG8_SCHED;
            PG8_STAGE(PG8_SB(0, 1), b2 + hstep, voffB);
            PG8_WAIT_V(6); PG8_BAR; PG8_MMA(1, 1, At, B1); PG8_BAR;
            PG8_LDB(B0, 1, 0); PG8_SCHED; PG8_LDA(At, 1, 0); PG8_STAGE(PG8_SA(0, 1), a2 + hstep, voffA);
            PG8_WAIT_L(8); PG8_BAR; PG8_WAIT_L(0); PG8_MMA(0, 0, At, B0); PG8_BAR; PG8_SCHED;
            PG8_LDB(B1, 1, 1); PG8_STAGE(PG8_SB(1, 0), b3, voffB);
            PG8_BAR; PG8_WAIT_L(0); PG8_MMA(0, 1, At, B1); PG8_BAR;
            PG8_LDA(At, 1, 1); PG8_STAGE(PG8_SA(1, 0), a3, voffA);
            PG8_BAR; PG8_WAIT_L(0); PG8_MMA(1, 0, At, B0); PG8_BAR; PG8_SCHED;
            PG8_STAGE(PG8_SB(1, 1), b3 + hstep, voffB);
            PG8_WAIT_V(6); PG8_BAR; PG8_MMA(1, 1, At, B1); PG8_BAR;
            }
        }
        if constexpr (ALIGN_EPI) { if (wr == 0) PG8_BAR; }
        if constexpr (!Epi::AFTER_DRAIN) { E(acc, cur, wr, wc, fr, fq); S.done(cur); }
        if (!has_next) break;
#pragma unroll
        for (int a = 0; a < 2; ++a)
#pragma unroll
            for (int b = 0; b < 2; ++b)
#pragma unroll
                for (int m = 0; m < 4; ++m)
#pragma unroll
                    for (int n = 0; n < 2; ++n) acc[a][b][m][n] = (f32x4){0.f, 0.f, 0.f, 0.f};
        cur = nxt; cA = nA; cB = nB; ++ui;
        if constexpr (ALIGN_EPI) { if (wr == 1) PG8_BAR; }
    }
    PG8_WAIT_V(0);
    if constexpr (!ALIGN_EPI) { if (wr == 0) PG8_BAR; }
    PG8_BAR;
    if constexpr (Epi::AFTER_DRAIN) { E.fused(acc, cur, wr, wc, fr, fq, lds, wid, lane); S.done(cur); }
#undef PG8_SA
#undef PG8_SB
#undef PG8_STAGE
#undef PG8_LDA
#undef PG8_LDB
#undef PG8_MMA
#undef PG8_WAIT_V
#undef PG8_WAIT_L
#undef PG8_BAR
#undef PG8_SCHED
}
}

DI u32x2 pack4(f32x4 v) { u32x2 r; r.x = cvtpk(v.x, v.y); r.y = cvtpk(v.z, v.w); return r; }
DI u32x4 pack8(f32x4 a, f32x4 b) { u32x4 r; r.x = cvtpk(a.x, a.y); r.y = cvtpk(a.z, a.w); r.z = cvtpk(b.x, b.y); r.w = cvtpk(b.z, b.w); return r; }

struct Epi1 {
    static constexpr bool PERM = true, AFTER_DRAIN = false;
    unsigned char* ws;
    DI void operator()(const f32x4 (&acc)[2][2][4][2], const pg8::Unit& u, int wr, int wc, int fr, int fq) const {
        const float* r1p = (const float*)(ws + WS_R1);
        const float* rope = (const float*)(ws + WS_ROPE);
        const float* lbp = (const float*)(ws + WS_LB);
        const int seg = u.pn >> 1;
#pragma unroll
        for (int ai = 0; ai < 2; ++ai)
#pragma unroll
            for (int m = 0; m < 4; ++m) {
                const int row = u.pm * 256 + ai * 128 + wr * 64 + m * 16 + fr;
                const bool meta = row >= NTOK;
                if (row >= NTOK + NMETA) continue;
                const float r1 = r1p[row];
                const int b = meta ? 0 : (row >> 12), t = meta ? (row - NTOK) : ((row & 4095) + NMETA);
                const int nrep = meta ? BATCH : 1;
#pragma unroll
                for (int bj = 0; bj < 2; ++bj) {
                    const int cs = (u.pn & 1) * 256 + bj * 128 + wc * 32 + 8 * fq;
                    const f32x4 v0 = acc[ai][bj][m][0] * r1, v1 = acc[ai][bj][m][1] * r1;
                    const int h = cs >> 7;
                    if (seg <= 1) {
                        const int comp = (cs >> 6) & 1, cc = cs & 63, i0 = 16 * (cc >> 5) + 4 * fq;
                        const f32x4 c4 = *(const f32x4*)(rope + (size_t)t * 64 + i0), s4 = *(const f32x4*)(rope + (size_t)t * 64 + 32 + i0);
                        f32x4 lo = v0 * c4 - v1 * s4, hi = v1 * c4 + v0 * s4;
                        if (seg == 0) {
                            if (meta) continue;
                            lo = lo * QSCALE; hi = hi * QSCALE;
                            bf16_t* qp = (bf16_t*)(ws + WS_Q) + ((size_t)(((b * 4 + h) * 2 + comp) * SEQ + (row & 4095))) * 64;
                            *(u32x2*)(qp + i0) = pack4(lo); *(u32x2*)(qp + i0 + 32) = pack4(hi);
                        } else {
                            const int pp = t + KPAD, tile = pp >> 6, key = pp & 63;
                            for (int bb = 0; bb < nrep; ++bb) {
                                const int b_ = meta ? bb : b;
                                unsigned char* img = ws + WS_K + ((size_t)((b_ * 4 + h) * 2 + comp) * KT + tile) * 8192;
                                *(u32x2*)(img + (i0 >> 3) * 1024 + key * 16 + (i0 & 7) * 2) = pack4(lo);
                                *(u32x2*)(img + ((i0 >> 3) + 4) * 1024 + key * 16 + (i0 & 7) * 2) = pack4(hi);
                            }
                        }
                    } else if (seg == 2) {
                        const int dv = cs & 127, pp = t + KPAD, tile = pp >> 6, key = pp & 63;
                        const u32x4 w = pack8(v0, v1);
                        for (int bb = 0; bb < nrep; ++bb) {
                            const int b_ = meta ? bb : b;
                            unsigned char* img = ws + WS_V + ((size_t)(b_ * 4 + h) * KT + tile) * 16384;
                            *(u32x4*)(img + (dv >> 5) * 4096 + key * 64 + (dv & 31) * 2) = w;
                        }
                    } else if (seg == 3 || seg == 5) {
                        const int dv = cs & 127;
                        f32x4 a = v0, c = v1;
                        if (seg == 3) { a.x = siluf_(a.x); a.y = siluf_(a.y); a.z = siluf_(a.z); a.w = siluf_(a.w); c.x = siluf_(c.x); c.y = siluf_(c.y); c.z = siluf_(c.z); c.w = siluf_(c.w); }
                        const u32x4 w = pack8(a, c);
                        const size_t base = (seg == 3) ? WS_HQ : WS_HV;
                        for (int bb = 0; bb < nrep; ++bb) {
                            const int b_ = meta ? bb : b;
                            *(u32x4*)((bf16_t*)(ws + base) + ((size_t)(b_ * 4 + h) * HT + t + 16) * 128 + dv) = w;
                        }
                    } else if (seg == 4) {
                        const int dv = cs & 127;
                        const f32x4 l0 = *(const f32x4*)(lbp + cs), l1 = *(const f32x4*)(lbp + cs + 4);
                        f32x4 g0, g1;
#pragma unroll
                        for (int e = 0; e < 4; ++e) { g0[e] = __logf(l0[e] + (1.f - l0[e]) * sigmoidf_(v0[e])); g1[e] = __logf(l1[e] + (1.f - l1[e]) * sigmoidf_(v1[e])); }
                        for (int bb = 0; bb < nrep; ++bb) {
                            const int b_ = meta ? bb : b;
                            float* gp = (float*)(ws + WS_HG) + ((size_t)(b_ * 4 + h) * HT + t + 16) * 128 + dv;
                            *(f32x4*)gp = g0; *(f32x4*)(gp + 4) = g1;
                        }
                    } else {
                        if (meta) continue;
                        f32x4 a = v0, c = v1;
                        a.x = siluf_(a.x); a.y = siluf_(a.y); a.z = siluf_(a.z); a.w = siluf_(a.w); c.x = siluf_(c.x); c.y = siluf_(c.y); c.z = siluf_(c.z); c.w = siluf_(c.w);
                        *(u32x4*)((bf16_t*)(ws + WS_SG) + (size_t)row * 512 + cs) = pack8(a, c);
                    }
                }
            }
    }
};

struct Epi3 {
    static constexpr bool PERM = true, AFTER_DRAIN = false;
    const float* x; float* H; bf16_t* HB; float* ssq;
    DI void operator()(const f32x4 (&acc)[2][2][4][2], const pg8::Unit& u, int wr, int wc, int fr, int fq) const {
#pragma unroll
        for (int ai = 0; ai < 2; ++ai)
#pragma unroll
            for (int m = 0; m < 4; ++m) {
                const int row = u.pm * 256 + ai * 128 + wr * 64 + m * 16 + fr;
                float s = 0.f;
#pragma unroll
                for (int bj = 0; bj < 2; ++bj) {
                    const int col = u.pn * 256 + bj * 128 + wc * 32 + 8 * fq;
                    const size_t o = (size_t)row * DM + col;
                    const u32x4 xb = *(const u32x4*)(HB + o);
                    const f32x4 x0 = (f32x4){bf2f(xb.x & 0xffffu), bf2f(xb.x >> 16), bf2f(xb.y & 0xffffu), bf2f(xb.y >> 16)}, x1 = (f32x4){bf2f(xb.z & 0xffffu), bf2f(xb.z >> 16), bf2f(xb.w & 0xffffu), bf2f(xb.w >> 16)};
                    const f32x4 h0 = x0 + acc[ai][bj][m][0], h1 = x1 + acc[ai][bj][m][1];
                    *(u32x4*)(HB + o) = pack8(h0, h1);
                    s += (h0.x * h0.x + h0.y * h0.y) + (h0.z * h0.z + h0.w * h0.w) + (h1.x * h1.x + h1.y * h1.y) + (h1.z * h1.z + h1.w * h1.w);
                }
                s += __shfl_xor(s, 16); s += __shfl_xor(s, 32);
                if (fq == 0) atomicAdd(ssq + row, s);
            }
    }
};

struct Epi4 {
    static constexpr bool PERM = true, AFTER_DRAIN = false;
    const float* ssq; bf16_t* PQ;
    DI void operator()(const f32x4 (&acc)[2][2][4][2], const pg8::Unit& u, int wr, int wc, int fr, int fq) const {
#pragma unroll
        for (int ai = 0; ai < 2; ++ai)
#pragma unroll
            for (int m = 0; m < 4; ++m) {
                const int row = u.pm * 256 + ai * 128 + wr * 64 + m * 16 + fr;
                const float r2 = 1.f / sqrtf(ssq[row] * (1.f / DM) + EPS);
#pragma unroll
                for (int bj = 0; bj < 2; ++bj) {
                    const int col = u.pn * 256 + bj * 128 + wc * 32 + 8 * fq;
                    *(u32x4*)(PQ + (size_t)row * 2048 + col) = pack8(acc[ai][bj][m][0] * r2, acc[ai][bj][m][1] * r2);
                }
            }
    }
};

template <class Epi>
DI void gemm_run(char* lds, const bf16_t* A, const bf16_t* Bt, int M, int N, int K, const Epi& E, int bid, int nblk) {
    pg8::Gemm g{A, Bt, M, N, K}; pg8::StaticOrder S; S.init(M, N, nblk, bid);
    pg8::gemm_phase<Epi, pg8::StaticOrder, true, true>((LAS unsigned char*)lds, g, S, E);
}
#define MFMA32(a, b, c) __builtin_amdgcn_mfma_f32_32x32x16_bf16(a, b, c, 0, 0, 0)
typedef short v4i16_t __attribute__((ext_vector_type(4)));
DI int crow(int r, int hi) { return (r & 3) + 8 * (r >> 2) + 4 * hi; }
DI s16x4 vtr(const LAS char* p) { return __builtin_bit_cast(s16x4, __builtin_amdgcn_ds_read_tr16_b64_v4i16((LAS v4i16_t*)p)); }
DI void glds16(const void* g, LAS char* l) { __builtin_amdgcn_global_load_lds((const unsigned*)g, (LAS unsigned*)l, 16, 0, 0); }
DI float swap_max(float m) { auto rr = __builtin_amdgcn_permlane32_swap(__float_as_uint(m), __float_as_uint(m), false, false); return fmaxf(__uint_as_float(rr[0]), __uint_as_float(rr[1])); }
DI float swap_sum(float m) { auto rr = __builtin_amdgcn_permlane32_swap(__float_as_uint(m), __float_as_uint(m), false, false); return __uint_as_float(rr[0]) + __uint_as_float(rr[1]); }
constexpr int ATT_BUF = 32768, ATT_WSF = 65536;
constexpr float ATT_THR = 8.f;

DI void attn_unit(const Params& P, int b, int h, int j, char* lds_g) {
    LAS char* lds = (LAS char*)lds_g;
    const int tid = tid_(), lane = tid & 63, r32 = lane & 31, hi = lane >> 5;
    const int wid = __builtin_amdgcn_readfirstlane(tid >> 6), comp = wid >> 2, wq = wid & 3;
    const unsigned char* ws = P.ws;
    const int bh = b * 4 + h;
    const bf16_t* Qw = (const bf16_t*)(ws + WS_Q) + ((size_t)((bh * 2 + comp) * SEQ + 128 * j + 32 * wq)) * 64;
    bf16x8 qr[4];
#pragma unroll
    for (int d0 = 0; d0 < 4; ++d0) qr[d0] = *(const bf16x8*)(Qw + r32 * 64 + d0 * 16 + hi * 8);
    const unsigned char* kimg0 = ws + WS_K + (size_t)(bh * 2) * KT * 8192 + wid * 1024 + lane * 16;
    const unsigned char* kimg1 = kimg0 + (size_t)KT * 8192;
    const unsigned char* vimg = ws + WS_V + (size_t)bh * KT * 16384 + wid * 1024 + lane * 16;
    const int NT = 2 * j + 3, my_last = (wq < 2) ? 2 * j + 1 : 2 * j + 2;
    LAS float* wsf = (LAS float*)(lds + ATT_WSF) + wid * 64;
#define ATT_ISSUE(t, s) do { LAS char* d_ = lds + (s) * ATT_BUF + wid * 1024; \
        glds16(kimg0 + (size_t)(t) * 8192, d_); glds16(kimg1 + (size_t)(t) * 8192, d_ + 8192); \
        glds16(vimg + (size_t)(t) * 16384, d_ + 16384); glds16(vimg + (size_t)(t) * 16384 + 8192, d_ + 24576); } while (0)
    f32x16 o[4];
#pragma unroll
    for (int nb = 0; nb < 4; ++nb) o[nb] = f32x16{};
    float mref = 0.f, lsum = 0.f;
    f32x16 mv = f32x16{};
    const int qpos = 64 + 128 * j + 32 * wq + r32;
    ATT_ISSUE(0, 0);
    __syncthreads();
    for (int t = 0; t < NT; ++t) {
        const int s = t & 1;
        if (t + 1 < NT) ATT_ISSUE(t + 1, s ^ 1);
        if (t <= my_last) {
            const LAS char* kp = lds + s * ATT_BUF + comp * 8192 + hi * 1024 + r32 * 16;
            asm volatile("" : "+v"(mv));
            f32x16 s0, s1;
#pragma unroll
            for (int d0 = 0; d0 < 4; ++d0) {
                const bf16x8 k0 = *(const LAS bf16x8*)(kp + d0 * 2048), k1 = *(const LAS bf16x8*)(kp + d0 * 2048 + 512);
                if (d0 == 0) { s0 = MFMA32(k0, qr[d0], mv); s1 = MFMA32(k1, qr[d0], mv); }
                else { s0 = MFMA32(k0, qr[d0], s0); s1 = MFMA32(k1, qr[d0], s1); }
            }
            if (t == 0 || t >= 2 * j + 1) {
                const int kb = 64 * t + 4 * hi - KPAD; const unsigned lim = (unsigned)(qpos - KPAD);
#pragma unroll
                for (int r = 0; r < 16; ++r) { const int kv = kb + (r & 3) + 8 * (r >> 2); if ((unsigned)kv > lim) s0[r] = -INFINITY; if ((unsigned)(kv + 32) > lim) s1[r] = -INFINITY; }
            }
            asm volatile("s_nop 15" : "+v"(s0), "+v"(s1));
            float rm;
            asm("v_max3_f32 %0, %1, %2, %3" : "=v"(rm) : "v"(s0[0]), "v"(s1[0]), "v"(s0[1]));
            asm("v_max3_f32 %0, %1, %2, %3" : "=v"(rm) : "v"(rm), "v"(s1[1]), "v"(s0[2]));
#pragma unroll
            for (int r = 2; r < 15; ++r) asm("v_max3_f32 %0, %1, %2, %3" : "=v"(rm) : "v"(rm), "v"(s1[r]), "v"(s0[r + 1]));
            asm("v_max_f32 %0, %1, %2" : "=v"(rm) : "v"(rm), "v"(s1[15]));
            { auto rr = __builtin_amdgcn_permlane32_swap(__float_as_uint(rm), __float_as_uint(rm), false, false); const float ra = __uint_as_float(rr[0]), rb = __uint_as_float(rr[1]);
              asm("v_max_f32 %0, %1, %2" : "=v"(rm) : "v"(ra), "v"(rb)); }
            const bool first = (t == 0);
            if (first || __any(rm > ATT_THR)) {
                const float dl = first ? rm : fmaxf(rm, 0.f), f = first ? 1.f : __builtin_amdgcn_exp2f(-dl);
                mref += dl; lsum *= f;
                if (hi == 0) wsf[r32] = f;
                asm volatile("s_waitcnt lgkmcnt(0)" ::: "memory");
#pragma unroll
                for (int r = 0; r < 16; ++r) { const float fr_ = wsf[crow(r, hi)]; s0[r] -= dl; s1[r] -= dl; mv[r] = -mref;
#pragma unroll
                    for (int nb = 0; nb < 4; ++nb) o[nb][r] *= fr_; }
            }
            f32x2 ps2 = (f32x2){0.f, 0.f};
#pragma unroll
            for (int r = 0; r < 16; ++r) { s0[r] = __builtin_amdgcn_exp2f(s0[r]); s1[r] = __builtin_amdgcn_exp2f(s1[r]); }
#pragma unroll
            for (int r = 0; r < 16; r += 2) { ps2 += (f32x2){s0[r], s0[r + 1]}; ps2 += (f32x2){s1[r], s1[r + 1]}; }
            lsum += ps2.x + ps2.y;
            const LAS char* vp = lds + s * ATT_BUF + 16384 + ((lane >> 4) & 1) * 32 + (lane & 3) * 8 + (4 * hi + ((lane & 15) >> 2)) * 64;
#pragma unroll
            for (int ks = 0; ks < 4; ++ks) {
                u32x4 pw;
                if (ks < 2) { pw.x = cvtpk(s0[8 * ks], s0[8 * ks + 1]); pw.y = cvtpk(s0[8 * ks + 2], s0[8 * ks + 3]); pw.z = cvtpk(s0[8 * ks + 4], s0[8 * ks + 5]); pw.w = cvtpk(s0[8 * ks + 6], s0[8 * ks + 7]); }
                else { const int q_ = ks - 2; pw.x = cvtpk(s1[8 * q_], s1[8 * q_ + 1]); pw.y = cvtpk(s1[8 * q_ + 2], s1[8 * q_ + 3]); pw.z = cvtpk(s1[8 * q_ + 4], s1[8 * q_ + 5]); pw.w = cvtpk(s1[8 * q_ + 6], s1[8 * q_ + 7]); }
                const bf16x8 pa = __builtin_bit_cast(bf16x8, pw);
#pragma unroll
                for (int nb = 0; nb < 4; ++nb) {
                    const s16x4 vlo = vtr(vp + nb * 4096 + ks * 1024), vhi = vtr(vp + nb * 4096 + ks * 1024 + 512);
                    const bf16x8 vb = (bf16x8){vlo[0], vlo[1], vlo[2], vlo[3], vhi[0], vhi[1], vhi[2], vhi[3]};
                    o[nb] = MFMA32(pa, vb, o[nb]);
                }
            }
        }
        __syncthreads();
    }
#undef ATT_ISSUE
    lsum = swap_sum(lsum);
    if (hi == 0) wsf[r32] = lsum;
    asm volatile("s_waitcnt lgkmcnt(0)" ::: "memory");
    float rli[16];
#pragma unroll
    for (int r = 0; r < 16; ++r) rli[r] = 1.f / wsf[crow(r, hi)];
    const float lam = ((const float*)(ws + WS_LB))[512];
    LAS float* ex = (LAS float*)lds + wq * 4096;
    if (comp == 1) {
#pragma unroll
        for (int r = 0; r < 16; ++r)
#pragma unroll
            for (int nb = 0; nb < 4; ++nb) ex[(r * 4 + nb) * 64 + lane] = o[nb][r] * rli[r] * lam;
    }
    __syncthreads();
    if (comp == 0) {
        float ss[16];
#pragma unroll
        for (int r = 0; r < 16; ++r) { float a = 0.f;
#pragma unroll
            for (int nb = 0; nb < 4; ++nb) { const float v = o[nb][r] * rli[r] - ex[(r * 4 + nb) * 64 + lane]; o[nb][r] = v; a += v * v; }
            ss[r] = a; }
#pragma unroll
        for (int r = 0; r < 16; ++r) { float a = ss[r]; a += __shfl_xor(a, 1); a += __shfl_xor(a, 2); a += __shfl_xor(a, 4); a += __shfl_xor(a, 8); a += __shfl_xor(a, 16); ss[r] = (1.f - LAM_INIT) / sqrtf(a * (1.f / 128.f) + EPS); }
        bf16_t* mix = (bf16_t*)(ws + WS_MIX) + ((size_t)(b * SEQ + 128 * j + 32 * wq)) * DM + h * 128;
#pragma unroll
        for (int nb = 0; nb < 4; ++nb) { const float w = P.subln_w[32 * nb + r32];
#pragma unroll
            for (int r = 0; r < 16; ++r) mix[(size_t)crow(r, hi) * DM + 32 * nb + r32] = (bf16_t)f2bf(o[nb][r] * ss[r] * w); }
    }
    __syncthreads();
}
#define MFMA16(a, b, c) __builtin_amdgcn_mfma_f32_16x16x32_bf16(a, b, c, 0, 0, 0)
constexpr int HG_STR = 272;
constexpr int HL_QA = 0, HL_QB = HL_QA + 32 * HG_STR, HL_KB = HL_QB + 32 * HG_STR, HL_KT = HL_KB + 32 * HG_STR, HL_VV = HL_KT + 32 * HG_STR;
constexpr int HL_PS = HL_VV + 32 * HG_STR;
constexpr int HL_D = HL_PS + 4 * 128 * 4;
constexpr int HL_OUT = HL_D + 128 * 4;
constexpr int HL_END = HL_OUT + 32 * 132 * 4;

constexpr int HB_KTF = 0, HB_ATF = 8192, HB_DF = 10240;
DI void hgrn_prep_item(const Params& P, int bh, int c, char* lds_g) {
    LAS char* lds = (LAS char*)lds_g;
    const int tid = tid_(), lane = tid & 63, c16 = lane & 15, g4 = lane >> 4, ch = tid & 127, part = tid >> 7;
    const int wid = __builtin_amdgcn_readfirstlane(tid >> 6);
    const int vrow = tid >> 4, vcol = (tid & 15) * 8;
    unsigned char* ws = P.ws;
    const float* HG = (const float*)(ws + WS_HG) + (size_t)bh * HT * 128;
    const bf16_t* HQ = (const bf16_t*)(ws + WS_HQ) + (size_t)bh * HT * 128;
    const bf16_t* HV = (const bf16_t*)(ws + WS_HV) + (size_t)bh * HT * 128;
    const size_t r0 = (size_t)(32 * c + 8 * part);
    float g8[8], p8[8]; unsigned short q8[8];
    { float a = 0.f;
#pragma unroll
      for (int e = 0; e < 8; ++e) { g8[e] = HG[(r0 + e) * 128 + ch]; q8[e] = HQ[(r0 + e) * 128 + ch]; a += g8[e]; p8[e] = a; } }
    const u32x4 v16 = *(const u32x4*)(HV + ((size_t)(32 * c) + vrow) * 128 + vcol);
    ((LAS float*)(lds + HL_PS))[part * 128 + ch] = p8[7];
    __syncthreads();
    {
        const LAS float* ps = (const LAS float*)(lds + HL_PS);
        const float t0 = ps[ch], t1 = ps[128 + ch], t2 = ps[256 + ch], t3 = ps[384 + ch];
        const float off = (part > 0 ? t0 : 0.f) + (part > 1 ? t1 : 0.f) + (part > 2 ? t2 : 0.f);
        const float mid = t0 + t1, last = mid + t2 + t3;
        const float em = __expf(mid), el = __expf(last - mid);
        if (part == 0) ((LAS float*)(lds + HL_D))[ch] = __expf(last);
#pragma unroll
        for (int e = 0; e < 8; ++e) {
            const int tk = 8 * part + e;
            const float cum = off + p8[e];
            const float e1 = __expf(cum - mid), e2 = 1.f / e1;
            const float q = bf2f(q8[e]), k = 1.f - __expf(g8[e]);
            const float qb = q * e1, qa = qb * em, kb = k * e2, kt = kb * el;
            *(LAS bf16_t*)(lds + HL_QA + tk * HG_STR + ch * 2) = (bf16_t)f2bf(qa);
            *(LAS bf16_t*)(lds + HL_QB + tk * HG_STR + ch * 2) = (bf16_t)f2bf(qb);
            *(LAS bf16_t*)(lds + HL_KB + tk * HG_STR + ch * 2) = (bf16_t)f2bf(kb);
            *(LAS bf16_t*)(lds + HL_KT + tk * HG_STR + ch * 2) = (bf16_t)f2bf(kt);
        }
        *(LAS u32x4*)(lds + HL_VV + vrow * HG_STR + vcol * 2) = v16;
    }
    __syncthreads();
    unsigned char* qaf = ws + WS_HQA + ((size_t)bh * 129 + c) * 8192;
    unsigned char* hgb = ws + WS_HG + (size_t)bh * HT * 512 + (size_t)c * 16384;
    {
        const int ks = wid >> 1, nt = wid & 1;
        const LAS char* qp = lds + HL_QA + (16 * nt + c16) * HG_STR + (32 * ks + 4 * g4) * 2;
        const u32x2 lo = *(const LAS u32x2*)qp, hi2 = *(const LAS u32x2*)(qp + 32);
        *(u32x4*)(qaf + wid * 1024 + lane * 16) = (u32x4){lo.x, lo.y, hi2.x, hi2.y};
        const LAS char* kp = lds + HL_KT + (8 * g4 + (c16 >> 2)) * HG_STR + (16 * wid + 4 * (c16 & 3)) * 2;
        const s16x4 klo = vtr(kp), khi = vtr(kp + 4 * HG_STR);
        *(bf16x8*)(hgb + HB_KTF + wid * 1024 + lane * 16) = (bf16x8){klo[0], klo[1], klo[2], klo[3], khi[0], khi[1], khi[2], khi[3]};
    }
    if (wid == 0) {
        f32x4 at00 = (f32x4){0.f, 0.f, 0.f, 0.f}, at01 = at00, at11 = at00;
#pragma unroll
        for (int ks = 0; ks < 4; ++ks) {
            const bf16x8 ka0 = *(const LAS bf16x8*)(lds + HL_KB + c16 * HG_STR + (32 * ks + 8 * g4) * 2);
            const bf16x8 ka1 = *(const LAS bf16x8*)(lds + HL_KB + (16 + c16) * HG_STR + (32 * ks + 8 * g4) * 2);
            const bf16x8 qn0 = *(const LAS bf16x8*)(lds + HL_QB + c16 * HG_STR + (32 * ks + 8 * g4) * 2);
            const bf16x8 qn1 = *(const LAS bf16x8*)(lds + HL_QB + (16 + c16) * HG_STR + (32 * ks + 8 * g4) * 2);
            at00 = MFMA16(ka0, qn0, at00); at01 = MFMA16(ka0, qn1, at01); at11 = MFMA16(ka1, qn1, at11);
        }
#pragma unroll
        for (int r = 0; r < 4; ++r) { if (4 * g4 + r > c16) { at00[r] = 0.f; at11[r] = 0.f; } }
        u32x4 b0; b0.x = cvtpk(at00[0], at00[1]); b0.y = cvtpk(at00[2], at00[3]); b0.z = 0u; b0.w = 0u;
        u32x4 b1; b1.x = cvtpk(at01[0], at01[1]); b1.y = cvtpk(at01[2], at01[3]); b1.z = cvtpk(at11[0], at11[1]); b1.w = cvtpk(at11[2], at11[3]);
        *(u32x4*)(hgb + HB_ATF + lane * 16) = b0; *(u32x4*)(hgb + HB_ATF + 1024 + lane * 16) = b1;
    } else if (wid == 1 && lane < 32) {
        *(f32x4*)(hgb + HB_DF + lane * 16) = *(const LAS f32x4*)(lds + HL_D + lane * 16);
    }
    __syncthreads();
}

constexpr int RS_QAF = 0, RS_HGB = 8192, RS_V = 19456, RS_SLOT = 27648, RS_NSLOT = 5;
constexpr int RS_OUT = RS_NSLOT * RS_SLOT, RS_OUTB = 32 * 136 * 2, RS_END = RS_OUT + 2 * RS_OUTB;
static_assert(RS_END <= LDS_ITEM, "hgrn LDS map");
DI void glds16_asm(const void* g, unsigned lds_base) {
    unsigned sv; asm volatile("s_mov_b32 %0, m0\n\ts_mov_b32 m0, %2\n\ts_nop 0\n\tglobal_load_lds_dwordx4 %1, off\n\ts_mov_b32 m0, %0" : "=&s"(sv) : "v"(g), "s"(lds_base) : "memory"); }
#define HW_BAR() asm volatile("s_waitcnt lgkmcnt(0)\n\ts_barrier" ::: "memory")
DI void glds16_sb(unsigned voff, const void* sbase, unsigned lds_base) {
    unsigned sv; asm volatile("s_mov_b32 %0, m0\n\ts_mov_b32 m0, %3\n\ts_nop 0\n\tglobal_load_lds_dwordx4 %1, %2\n\ts_mov_b32 m0, %0" : "=&s"(sv) : "v"(voff), "s"(sbase), "s"(lds_base) : "memory"); }
DI void hgrn_unit(const Params& P, int b, int h, char* lds_g) {
    LAS char* lds = (LAS char*)lds_g;
    const int tid = tid_(), lane = tid & 63, c16 = lane & 15, g4 = lane >> 4;
    const int wid = __builtin_amdgcn_readfirstlane(tid >> 6);
    const unsigned char* ws = P.ws;
    const int bh = b * 4 + h;
    const unsigned lbase = (unsigned)__builtin_amdgcn_readfirstlane((int)(unsigned)(size_t)lds);
    constexpr int AHEAD = RS_NSLOT - 1;
    if (wid < 4) {
        const unsigned char* qafg = ws + WS_HQA + (size_t)bh * 129 * 8192;
        const unsigned char* hgbg = ws + WS_HG + (size_t)bh * HT * 512;
        const unsigned char* vg = ws + WS_HV + (size_t)bh * HT * 256;
        const unsigned voff = (unsigned)lane * 16u;
        auto issue = [&](int c) {
            const unsigned sb = lbase + (unsigned)((c % RS_NSLOT) * RS_SLOT);
#pragma unroll
            for (int k = 0; k < 7; ++k) {
                const int p = wid + 4 * k;
                if (p < 19) { const unsigned char* src = (p < 8) ? qafg + (size_t)c * 8192 + p * 1024 : hgbg + (size_t)c * 16384 + (p - 8) * 1024; glds16_sb(voff, src, sb + (unsigned)p * 1024u); }
                else if (p < 27) { const int r4 = 4 * (p - 19);
                    const unsigned vo = (unsigned)(lane >> 4) * 256u + (unsigned)(((lane & 15) ^ ((((r4 & 7) + (lane >> 4)) & 7) << 1)) * 16);
                    glds16_sb(vo, vg + ((size_t)(32 * c) + r4) * 256, sb + (unsigned)p * 1024u); }
            }
        };
        f32x4 S[2][8];
#pragma unroll
        for (int t = 0; t < 2; ++t)
#pragma unroll
            for (int i = 0; i < 8; ++i) S[t][i] = (f32x4){0.f, 0.f, 0.f, 0.f};
#pragma unroll
        for (int c = 0; c < AHEAD; ++c) issue(c);
        for (int c = 0; c < 129; ++c) {
            if (c + AHEAD - 1 > 128) asm volatile("s_waitcnt vmcnt(0)" ::: "memory");
            else if (wid < 3) asm volatile("s_waitcnt vmcnt(21)" ::: "memory"); else asm volatile("s_waitcnt vmcnt(18)" ::: "memory");
            HW_BAR();
            __builtin_amdgcn_sched_barrier(0);
            if (c + AHEAD < 129) issue(c + AHEAD);
            __builtin_amdgcn_sched_barrier(0);
            const LAS char* sl = lds + (c % RS_NSLOT) * RS_SLOT;
            f32x4 oacc[2][2];
#pragma unroll
            for (int t = 0; t < 2; ++t) { oacc[t][0] = (f32x4){0.f, 0.f, 0.f, 0.f}; oacc[t][1] = oacc[t][0]; }
#pragma unroll
            for (int ks = 0; ks < 4; ++ks) {
                const bf16x8 q0 = *(const LAS bf16x8*)(sl + RS_QAF + (2 * ks) * 1024 + lane * 16), q1 = *(const LAS bf16x8*)(sl + RS_QAF + (2 * ks + 1) * 1024 + lane * 16);
#pragma unroll
                for (int t = 0; t < 2; ++t) {
                    u32x4 sp; sp.x = cvtpk(S[t][2 * ks][0], S[t][2 * ks][1]); sp.y = cvtpk(S[t][2 * ks][2], S[t][2 * ks][3]); sp.z = cvtpk(S[t][2 * ks + 1][0], S[t][2 * ks + 1][1]); sp.w = cvtpk(S[t][2 * ks + 1][2], S[t][2 * ks + 1][3]);
                    const bf16x8 sf = __builtin_bit_cast(bf16x8, sp);
                    oacc[t][0] = MFMA16(sf, q0, oacc[t][0]); oacc[t][1] = MFMA16(sf, q1, oacc[t][1]);
                }
            }
            const int vq = c16 >> 2, vp4 = c16 & 3;
#define VTR(row, w_) vtr(sl + RS_V + (row) * 256 + (((2 * (w_) + (vp4 >> 1)) ^ ((((row) & 7)) << 1)) * 16) + 8 * (vp4 & 1))
            {
                const bf16x8 a0 = *(const LAS bf16x8*)(sl + RS_HGB + HB_ATF + lane * 16), a1 = *(const LAS bf16x8*)(sl + RS_HGB + HB_ATF + 1024 + lane * 16);
#pragma unroll
                for (int t = 0; t < 2; ++t) {
                    const s16x4 lo = VTR(4 * g4 + vq, 2 * wid + t), hi2 = VTR(16 + 4 * g4 + vq, 2 * wid + t);
                    const bf16x8 va = (bf16x8){lo[0], lo[1], lo[2], lo[3], hi2[0], hi2[1], hi2[2], hi2[3]};
                    oacc[t][0] = MFMA16(va, a0, oacc[t][0]); oacc[t][1] = MFMA16(va, a1, oacc[t][1]);
                }
            }
            {
                LAS char* ob = lds + RS_OUT + (c & 1) * RS_OUTB;
#pragma unroll
                for (int t = 0; t < 2; ++t)
#pragma unroll
                    for (int nt = 0; nt < 2; ++nt) { u32x2 w; w.x = cvtpk(oacc[t][nt][0], oacc[t][nt][1]); w.y = cvtpk(oacc[t][nt][2], oacc[t][nt][3]);
                        *(LAS u32x2*)(ob + ((16 * nt + c16) * 136 + 16 * (2 * wid + t) + 4 * g4) * 2) = w; }
            }
            {
                bf16x8 vb[2];
#pragma unroll
                for (int t = 0; t < 2; ++t) { const s16x4 lo = VTR(8 * g4 + vq, 2 * wid + t), hi2 = VTR(8 * g4 + 4 + vq, 2 * wid + t); vb[t] = (bf16x8){lo[0], lo[1], lo[2], lo[3], hi2[0], hi2[1], hi2[2], hi2[3]}; }
#pragma unroll
                for (int i = 0; i < 8; ++i) {
                    const f32x4 d4 = *(const LAS f32x4*)(sl + RS_HGB + HB_DF + (16 * i + 4 * g4) * 4);
                    const bf16x8 ka = *(const LAS bf16x8*)(sl + RS_HGB + HB_KTF + i * 1024 + lane * 16);
                    S[0][i] = MFMA16(ka, vb[0], S[0][i] * d4); S[1][i] = MFMA16(ka, vb[1], S[1][i] * d4);
                }
            }
#undef VTR
        }
        HW_BAR();
        HW_BAR();
    } else {
        const int tq = tid - 256, tok = tq >> 3, part = tq & 7;
        const bf16_t* sgg = (const bf16_t*)(ws + WS_SG) + ((size_t)b * SEQ + tok) * 512 + h * 128 + 16 * part;
        f32x4 nw[4];
#pragma unroll
        for (int q = 0; q < 4; ++q) nw[q] = *(const f32x4*)(P.rec_norm_w + h * 128 + 16 * part + 4 * q);
        auto epilogue = [&](int c, u32x4 s0, u32x4 s1) {
            const LAS char* ob = lds + RS_OUT + (c & 1) * RS_OUTB + (tok * 136 + 16 * part) * 2;
            const u32x4 o0 = *(const LAS u32x4*)ob, o1 = *(const LAS u32x4*)(ob + 16);
            const unsigned ou[8] = {o0.x, o0.y, o0.z, o0.w, o1.x, o1.y, o1.z, o1.w}, su[8] = {s0.x, s0.y, s0.z, s0.w, s1.x, s1.y, s1.z, s1.w};
            float v[16], ss = 0.f;
#pragma unroll
            for (int q = 0; q < 8; ++q) { v[2 * q] = bf2f(ou[q] & 0xffffu); v[2 * q + 1] = bf2f(ou[q] >> 16); ss += v[2 * q] * v[2 * q] + v[2 * q + 1] * v[2 * q + 1]; }
            ss += __shfl_xor(ss, 1); ss += __shfl_xor(ss, 2); ss += __shfl_xor(ss, 4);
            const float rs = 1.f / sqrtf(ss * (1.f / 128.f) + EPS);
            u32x4 w0, w1; unsigned wo[8];
#pragma unroll
            for (int q = 0; q < 8; ++q) wo[q] = cvtpk(v[2 * q] * rs * nw[q >> 1][(2 * q) & 3] * bf2f(su[q] & 0xffffu), v[2 * q + 1] * rs * nw[q >> 1][(2 * q + 1) & 3] * bf2f(su[q] >> 16));
            w0 = (u32x4){wo[0], wo[1], wo[2], wo[3]}; w1 = (u32x4){wo[4], wo[5], wo[6], wo[7]};
            bf16_t* mp = (bf16_t*)(ws + WS_MIX) + ((size_t)b * SEQ + 32 * (c - 1) + tok) * DM + 512 + h * 128 + 16 * part;
            *(u32x4*)mp = w0; *(u32x4*)(mp + 8) = w1;
        };
#define SG_LD(k, A, B) do { const bf16_t* p_ = sgg + (size_t)(32 * ((k) - 1)) * 512; A = *(const u32x4*)p_; B = *(const u32x4*)(p_ + 8); } while (0)
        u32x4 ga0, ga1, gb0, gb1, gc0, gc1, gd0, gd1;
        SG_LD(1, gb0, gb1); SG_LD(2, gc0, gc1); SG_LD(3, gd0, gd1);
        HW_BAR();
        HW_BAR();
        for (int k = 1; k <= 128; k += 4) {
            HW_BAR(); if (k + 3 <= 128) SG_LD(k + 3, ga0, ga1); epilogue(k, gb0, gb1);
            HW_BAR(); if (k + 4 <= 128) SG_LD(k + 4, gb0, gb1); epilogue(k + 1, gc0, gc1);
            HW_BAR(); if (k + 5 <= 128) SG_LD(k + 5, gc0, gc1); epilogue(k + 2, gd0, gd1);
            HW_BAR(); if (k + 6 <= 128) SG_LD(k + 6, gd0, gd1); epilogue(k + 3, ga0, ga1);
        }
#undef SG_LD
        HW_BAR();
    }
}
template <int CTRL> DI float dpp_f(float v) { return __builtin_bit_cast(float, __builtin_amdgcn_update_dpp(0, __builtin_bit_cast(int, v), CTRL, 0xf, 0xf, false)); }
DI float row16_max(float v) { v = fmaxf(v, dpp_f<0x128>(v)); v = fmaxf(v, dpp_f<0x124>(v)); v = fmaxf(v, dpp_f<0x122>(v)); v = fmaxf(v, dpp_f<0x121>(v)); return v; }
DI float row16_sum(float v) { v += dpp_f<0x128>(v); v += dpp_f<0x124>(v); v += dpp_f<0x122>(v); v += dpp_f<0x121>(v); return v; }
#define CE_D(a, b) do { const float hi_ = fmaxf(a, b), lo_ = fminf(a, b); a = hi_; b = lo_; } while (0)
DI void bitonic_sort16(float (&v)[16]) {
#pragma unroll
    for (int k = 2; k <= 16; k *= 2)
#pragma unroll
        for (int j = k / 2; j > 0; j /= 2)
#pragma unroll
            for (int i = 0; i < 16; ++i) { const int l = i ^ j; if (l > i) { if ((i & k) == 0) CE_D(v[i], v[l]); else CE_D(v[l], v[i]); } }
}
DI void merge_top16(float (&a)[16], const float (&b)[16]) {
#pragma unroll
    for (int i = 0; i < 16; ++i) a[i] = fmaxf(a[i], b[15 - i]);
#pragma unroll
    for (int j = 8; j > 0; j /= 2)
#pragma unroll
        for (int i = 0; i < 16; ++i) { const int l = i ^ j; if (l > i) CE_D(a[i], a[l]); }
}
DI float embed7(float v, unsigned code) { return __uint_as_float((__float_as_uint(v) & 0xFFFFFF80u) | code); }
DI float embed8(float v, unsigned code) { return __uint_as_float((__float_as_uint(v) & 0xFFFFFF00u) | code); }

DI void topk_list(const bf16_t* qp, const LAS char* skf, int lane, int hi, float (&top)[16]) {
    f32x16 acc[4];
#pragma unroll
    for (int kb = 0; kb < 4; ++kb) acc[kb] = f32x16{};
#pragma unroll
    for (int ks = 0; ks < 8; ++ks) {
        const bf16x8 qf = *(const bf16x8*)(qp + 16 * ks);
#pragma unroll
        for (int kb = 0; kb < 4; ++kb) { const bf16x8 kf = *(const LAS bf16x8*)(skf + (kb * 8 + ks) * 1024 + lane * 16); acc[kb] = MFMA32(kf, qf, acc[kb]); }
    }
    float blk[16];
#pragma unroll
    for (int kb = 0; kb < 4; ++kb) {
#pragma unroll
        for (int r = 0; r < 16; ++r) { const unsigned code = (unsigned)(32 * kb + (r & 3) + 8 * (r >> 2)) | (unsigned)(4 * hi); if (kb == 0) top[r] = embed7(acc[kb][r], code); else blk[r] = embed7(acc[kb][r], code); }
        if (kb == 0) bitonic_sort16(top); else { bitonic_sort16(blk); merge_top16(top, blk); }
    }
    float l0[16], l1[16];
#pragma unroll
    for (int r = 0; r < 16; ++r) { auto rr = __builtin_amdgcn_permlane32_swap(__float_as_uint(top[r]), __float_as_uint(top[r]), false, false); l0[r] = __uint_as_float(rr[0]); l1[r] = __uint_as_float(rr[1]); }
    merge_top16(l0, l1);
#pragma unroll
    for (int r = 0; r < 16; ++r) top[r] = l0[r];
}

DI void topk_wave_item(const Params& P, int tb, int hh, LAS char* wlds, const LAS char* skf) {
    const int lane = tid_() & 63, r32 = lane & 31, hi = lane >> 5;
    const unsigned char* ws = P.ws;
    const bf16_t* qp = (const bf16_t*)(ws + WS_PQ) + (size_t)(32 * tb + r32) * 2048 + hh * 256 + 8 * hi;
    float A[16], B[16];
    topk_list(qp, skf, lane, hi, A);
    topk_list(qp + 128, skf + 32768, lane, hi, B);
    LAS unsigned* my = (LAS unsigned*)(wlds + lane * 32);
#pragma unroll
    for (int w = 0; w < 4; ++w) {
        my[w] = (__float_as_uint(A[4 * w]) & 127u) | ((__float_as_uint(A[4 * w + 1]) & 127u) << 8) | ((__float_as_uint(A[4 * w + 2]) & 127u) << 16) | ((__float_as_uint(A[4 * w + 3]) & 127u) << 24);
        my[4 + w] = (__float_as_uint(B[4 * w]) & 127u) | ((__float_as_uint(B[4 * w + 1]) & 127u) << 8) | ((__float_as_uint(B[4 * w + 2]) & 127u) << 16) | ((__float_as_uint(B[4 * w + 3]) & 127u) << 24);
    }
#pragma unroll
    for (int r = 0; r < 16; ++r) { A[r] = __uint_as_float(__float_as_uint(A[r]) & 0xFFFFFF80u); B[r] = __uint_as_float(__float_as_uint(B[r]) & 0xFFFFFF80u); }
    float T[16], R1[16], X[16], Y[16];
#pragma unroll
    for (int j = 0; j < 16; ++j) { T[j] = embed8(A[0] + B[j], (unsigned)j); R1[j] = (j < 8) ? embed8(A[1] + B[j], (unsigned)(16 + j)) : -INFINITY; }
#define CAND(i, j) embed8(A[i] + B[j], (unsigned)(16 * (i) + (j)))
    X[0] = CAND(2, 0); X[1] = CAND(2, 1); X[2] = CAND(2, 2); X[3] = CAND(2, 3); X[4] = CAND(2, 4); X[5] = CAND(3, 0); X[6] = CAND(3, 1); X[7] = CAND(3, 2);
    X[8] = CAND(3, 3); X[9] = CAND(4, 0); X[10] = CAND(4, 1); X[11] = CAND(4, 2); X[12] = CAND(5, 0); X[13] = CAND(5, 1); X[14] = CAND(6, 0); X[15] = CAND(6, 1);
    Y[0] = CAND(7, 0); Y[1] = CAND(7, 1); Y[2] = CAND(8, 0); Y[3] = CAND(9, 0); Y[4] = CAND(10, 0); Y[5] = CAND(11, 0); Y[6] = CAND(12, 0); Y[7] = CAND(13, 0);
    Y[8] = CAND(14, 0); Y[9] = CAND(15, 0); Y[10] = -INFINITY; Y[11] = -INFINITY; Y[12] = -INFINITY; Y[13] = -INFINITY; Y[14] = -INFINITY; Y[15] = -INFINITY;
#undef CAND
    bitonic_sort16(X); bitonic_sort16(Y);
    merge_top16(T, R1); merge_top16(T, X); merge_top16(T, Y);
    asm volatile("s_waitcnt lgkmcnt(0)" ::: "memory");
    float ssum = 0.f, e[16]; int eid[16];
    const float t0 = __uint_as_float(__float_as_uint(T[0]) & 0xFFFFFF00u);
#pragma unroll
    for (int r = 0; r < 16; ++r) {
        const unsigned bits = __float_as_uint(T[r]); const unsigned code = bits & 255u;
        e[r] = __expf(__uint_as_float(bits & 0xFFFFFF00u) - t0); ssum += e[r];
        const int ka = ((const LAS unsigned char*)my)[code >> 4], kb_ = ((const LAS unsigned char*)my)[16 + (code & 15u)];
        eid[r] = ka * 128 + kb_;
    }
    const float inv = 1.f / ssum;
    const size_t o = (size_t)(32 * tb + r32) * 128 + hh * 16 + 8 * hi;
    int* ei = (int*)(ws + WS_EIDX) + o; float* eg = (float*)(ws + WS_EGATE) + o;
    typedef int i32x4 __attribute__((ext_vector_type(4)));
    i32x4 w0, w1; f32x4 g0, g1;
    const unsigned mh = 0u - (unsigned)hi;
#define SELU(a, b) ((((unsigned)(b)) & mh) | (((unsigned)(a)) & ~mh))
#pragma unroll
    for (int q = 0; q < 4; ++q) { w0[q] = (int)SELU(eid[q], eid[8 + q]); w1[q] = (int)SELU(eid[4 + q], eid[12 + q]);
        g0[q] = __uint_as_float(SELU(__float_as_uint(e[q]), __float_as_uint(e[8 + q]))) * inv; g1[q] = __uint_as_float(SELU(__float_as_uint(e[4 + q]), __float_as_uint(e[12 + q]))) * inv; }
#undef SELU
    *(i32x4*)ei = w0; *(i32x4*)(ei + 4) = w1; *(f32x4*)eg = g0; *(f32x4*)(eg + 4) = g1;
}

DI void topk_phase(const Params& P, char* lds_g, int bid, int nblk) {
    const int tid = tid_(), wave = __builtin_amdgcn_readfirstlane(tid >> 6);
    LAS char* lds = (LAS char*)lds_g;
    LAS char* wlds = lds + wave * 2048;
    LAS char* skf = lds + 16384;
    int cur_h = -1;
    for (int it = bid; it < (NTOK / 256) * 8; it += nblk) {
        const int hh = it & 7, tg = it >> 3;
        if (hh != cur_h) {
            __syncthreads();
#pragma unroll
            for (int i = 0; i < 8; ++i) {
                const int f = tid + 512 * i, l = f & 63, ks = (f >> 6) & 7, kb = (f >> 9) & 3, p = f >> 11;
                *(LAS u32x4*)(skf + f * 16) = *(const u32x4*)((const bf16_t*)(P.ws + WS_SKB) + (size_t)((hh * 2 + p) * 128 + 32 * kb + (l & 31)) * 128 + 16 * ks + 8 * (l >> 5));
            }
            __syncthreads();
            cur_h = hh;
        }
        topk_wave_item(P, tg * 8 + wave, hh, wlds, skf);
    }
}

DI float gelu_exact(float x) { return 0.5f * x * (1.f + erff(x * 0.70710678118654752f)); }
typedef __bf16 bf16x8_t __attribute__((ext_vector_type(8)));
DI float dot8(u32x4 a, u32x4 x, float acc) {
    const bf16x8_t a8 = __builtin_bit_cast(bf16x8_t, a), x8 = __builtin_bit_cast(bf16x8_t, x);
    acc = __builtin_amdgcn_fdot2_f32_bf16(__builtin_shufflevector(a8, a8, 0, 1), __builtin_shufflevector(x8, x8, 0, 1), acc, false);
    acc = __builtin_amdgcn_fdot2_f32_bf16(__builtin_shufflevector(a8, a8, 2, 3), __builtin_shufflevector(x8, x8, 2, 3), acc, false);
    acc = __builtin_amdgcn_fdot2_f32_bf16(__builtin_shufflevector(a8, a8, 4, 5), __builtin_shufflevector(x8, x8, 4, 5), acc, false);
    acc = __builtin_amdgcn_fdot2_f32_bf16(__builtin_shufflevector(a8, a8, 6, 7), __builtin_shufflevector(x8, x8, 6, 7), acc, false);
    return acc;
}
DI float readlane_f(float v, int l) { return __builtin_bit_cast(float, __builtin_amdgcn_readlane(__builtin_bit_cast(int, v), l)); }
DI float wave_sum_dpp(float v) {
    v = row16_sum(v);
    return (readlane_f(v, 0) + readlane_f(v, 16)) + (readlane_f(v, 32) + readlane_f(v, 48));
}

DI float dot16_fp8(u32x4 w, const f32x2 (&x)[8]) {
    f32x2 acc = __builtin_amdgcn_cvt_pk_f32_fp8((int)w.x, false) * x[0];
    acc = __builtin_amdgcn_cvt_pk_f32_fp8((int)w.x, true) * x[1] + acc;
    acc = __builtin_amdgcn_cvt_pk_f32_fp8((int)w.y, false) * x[2] + acc;
    acc = __builtin_amdgcn_cvt_pk_f32_fp8((int)w.y, true) * x[3] + acc;
    acc = __builtin_amdgcn_cvt_pk_f32_fp8((int)w.z, false) * x[4] + acc;
    acc = __builtin_amdgcn_cvt_pk_f32_fp8((int)w.z, true) * x[5] + acc;
    acc = __builtin_amdgcn_cvt_pk_f32_fp8((int)w.w, false) * x[6] + acc;
    acc = __builtin_amdgcn_cvt_pk_f32_fp8((int)w.w, true) * x[7] + acc;
    return acc.x + acc.y;
}
DI void peer_hid_phase(const Params& P, int bid, int nblk) {
    const int tid = tid_(), lane = tid & 63, wave = __builtin_amdgcn_readfirstlane(tid >> 6);
    const unsigned char* ws = P.ws;
    const unsigned char* U8 = ws + WS_UB; const float* USC = (const float*)(ws + WS_USC);
    const int gw = bid * NWAVES + wave, NGW = nblk * NWAVES;
    f32x4 wv[4];
#pragma unroll
    for (int q = 0; q < 4; ++q) wv[q] = *(const f32x4*)(P.ffn_norm_w + 16 * lane + 4 * q);
    for (int n = gw; n < NTOK; n += NGW) {
        const float* hrow = P.out + (size_t)n * DM + 16 * lane;
        f32x4 h[4]; float ss = 0.f;
#pragma unroll
        for (int q = 0; q < 4; ++q) { h[q] = *(const f32x4*)(hrow + 4 * q); ss += (h[q].x * h[q].x + h[q].y * h[q].y) + (h[q].z * h[q].z + h[q].w * h[q].w); }
        ss = wave_sum_dpp(ss);
        const float r2 = 1.f / sqrtf(ss * (1.f / DM) + EPS);
        f32x2 x[8];
#pragma unroll
        for (int q = 0; q < 4; ++q) { const f32x4 t = h[q] * wv[q] * r2; x[2 * q] = (f32x2){t.x, t.y}; x[2 * q + 1] = (f32x2){t.z, t.w}; }
        const int* eidx = (const int*)(ws + WS_EIDX) + (size_t)n * 128;
        const float* egate = (const float*)(ws + WS_EGATE) + (size_t)n * 128;
        const int id0 = eidx[lane], id1 = eidx[64 + lane];
        float hid0 = 0.f, hid1 = 0.f;
#pragma unroll 1
        for (int k0 = 0; k0 < 128; k0 += 16) {
            u32x4 ra[16]; float sc[16];
#pragma unroll
            for (int e = 0; e < 16; ++e) {
                const int k = k0 + e;
                const int id = (k0 < 64) ? __builtin_amdgcn_readlane(id0, k & 63) : __builtin_amdgcn_readlane(id1, k & 63);
                ra[e] = *(const u32x4*)(U8 + (size_t)id * DM + 16 * lane); sc[e] = USC[id];
            }
#pragma unroll
            for (int e = 0; e < 16; ++e) {
                const int k = k0 + e;
                const float d = wave_sum_dpp(dot16_fp8(ra[e], x)) * sc[e];
                if (k0 < 64) { if (lane == (k & 63)) hid0 = d; } else { if (lane == (k & 63)) hid1 = d; }
            }
        }
        float* hid = (float*)(ws + WS_HID) + (size_t)n * 128;
        hid[lane] = gelu_exact(hid0) * egate[lane];
        hid[64 + lane] = gelu_exact(hid1) * egate[64 + lane];
    }
}

DI void peer_out_phase(const Params& P, int bid, int nblk) {
    const int tid = tid_(), lane = tid & 63, wave = __builtin_amdgcn_readfirstlane(tid >> 6);
    const unsigned char* ws = P.ws;
    const unsigned char* V8 = ws + WS_VB; const float* VSC = (const float*)(ws + WS_VSC);
    const int gw = bid * NWAVES + wave, NGW = nblk * NWAVES;
    f32x4 wv[4];
#pragma unroll
    for (int q = 0; q < 4; ++q) wv[q] = *(const f32x4*)(P.final_w + 16 * lane + 4 * q);
    for (int n = gw; n < NTOK; n += NGW) {
        const int* eidx = (const int*)(ws + WS_EIDX) + (size_t)n * 128;
        const float* hid = (const float*)(ws + WS_HID) + (size_t)n * 128;
        const int id0 = eidx[lane], id1 = eidx[64 + lane];
        const float c0 = hid[lane], c1 = hid[64 + lane];
        f32x2 acc[8];
#pragma unroll
        for (int i = 0; i < 8; ++i) acc[i] = (f32x2){0.f, 0.f};
#pragma unroll 1
        for (int k0 = 0; k0 < 128; k0 += 16) {
            u32x4 ra[16]; float cf[16];
#pragma unroll
            for (int e = 0; e < 16; ++e) {
                const int k = k0 + e;
                const int id = (k0 < 64) ? __builtin_amdgcn_readlane(id0, k & 63) : __builtin_amdgcn_readlane(id1, k & 63);
                cf[e] = ((k0 < 64) ? readlane_f(c0, k & 63) : readlane_f(c1, k & 63)) * VSC[id];
                ra[e] = *(const u32x4*)(V8 + (size_t)id * DM + 16 * lane);
            }
#pragma unroll
            for (int e = 0; e < 16; ++e) {
                const f32x2 c = (f32x2){cf[e], cf[e]}; const u32x4 w = ra[e];
                acc[0] = __builtin_amdgcn_cvt_pk_f32_fp8((int)w.x, false) * c + acc[0]; acc[1] = __builtin_amdgcn_cvt_pk_f32_fp8((int)w.x, true) * c + acc[1];
                acc[2] = __builtin_amdgcn_cvt_pk_f32_fp8((int)w.y, false) * c + acc[2]; acc[3] = __builtin_amdgcn_cvt_pk_f32_fp8((int)w.y, true) * c + acc[3];
                acc[4] = __builtin_amdgcn_cvt_pk_f32_fp8((int)w.z, false) * c + acc[4]; acc[5] = __builtin_amdgcn_cvt_pk_f32_fp8((int)w.z, true) * c + acc[5];
                acc[6] = __builtin_amdgcn_cvt_pk_f32_fp8((int)w.w, false) * c + acc[6]; acc[7] = __builtin_amdgcn_cvt_pk_f32_fp8((int)w.w, true) * c + acc[7];
            }
        }
        float* orow = P.out + (size_t)n * DM + 16 * lane;
        f32x4 h[4]; float ss = 0.f;
#pragma unroll
        for (int q = 0; q < 4; ++q) { h[q] = *(const f32x4*)(orow + 4 * q) + (f32x4){acc[2 * q].x, acc[2 * q].y, acc[2 * q + 1].x, acc[2 * q + 1].y}; ss += (h[q].x * h[q].x + h[q].y * h[q].y) + (h[q].z * h[q].z + h[q].w * h[q].w); }
        ss = wave_sum_dpp(ss);
        const float rs = 1.f / sqrtf(ss * (1.f / DM) + EPS);
#pragma unroll
        for (int q = 0; q < 4; ++q) *(f32x4*)(orow + 4 * q) = h[q] * wv[q] * rs;
    }
}

#ifdef DBG_CHECK
DI void dbg_max(float* slot, float v) { atomicMax((unsigned*)slot, __float_as_uint(fmaxf(v, 0.f))); }
DI void dbg_check_topk(const Params& P, char* lds_g, int bid, int nblk) {
    LAS char* lds = (LAS char*)lds_g;
    const int tid = tid_(), lane = tid & 63, wave = __builtin_amdgcn_readfirstlane(tid >> 6);
    const unsigned char* ws = P.ws; float* dbg = (float*)(ws + WS_CTL) + 64;
    LAS float* sc = (LAS float*)(lds) + wave * 1024;
    const int gw = bid * NWAVES + wave;
    const int token = (gw * 37) % NTOK, hh = gw & 7;
    for (int p = 0; p < 2; ++p) for (int kk = 0; kk < 2; ++kk) {
        const int key = lane + 64 * kk; float a = 0.f;
        const bf16_t* q = (const bf16_t*)(ws + WS_PQ) + (size_t)token * 2048 + hh * 256 + p * 128;
        const bf16_t* sk = (const bf16_t*)(ws + WS_SKB) + (size_t)((hh * 2 + p) * 128 + key) * 128;
        for (int c = 0; c < 128; ++c) a += bf2f(q[c]) * bf2f(sk[c]);
        sc[p * 128 + key] = a;
    }
    asm volatile("s_waitcnt lgkmcnt(0)" ::: "memory");
    for (int p = 0; p < 2; ++p) for (int kk = 0; kk < 2; ++kk) {
        const int key = lane + 64 * kk; const float v = sc[p * 128 + key]; int rank = 0;
        for (int o = 0; o < 128; ++o) { const float w = sc[p * 128 + o]; rank += (w > v || (w == v && o < key)) ? 1 : 0; }
        if (rank < 16) { sc[256 + p * 16 + rank] = v; sc[288 + p * 16 + rank] = __int_as_float(key); }
    }
    asm volatile("s_waitcnt lgkmcnt(0)" ::: "memory");
    for (int e = 0; e < 4; ++e) {
        const int c = lane * 4 + e, i = c >> 4, j = c & 15; const float v = sc[256 + i] + sc[272 + j]; int rank = 0;
        for (int o = 0; o < 256; ++o) { const float w = sc[256 + (o >> 4)] + sc[272 + (o & 15)]; rank += (w > v || (w == v && o < c)) ? 1 : 0; }
        if (rank < 16) { sc[320 + rank] = __int_as_float(__float_as_int(sc[288 + i]) * 128 + __float_as_int(sc[304 + j])); sc[336 + rank] = v; }
    }
    asm volatile("s_waitcnt lgkmcnt(0)" ::: "memory");
    if (lane < 16) {
        const int eid = __float_as_int(sc[320 + lane]); const float sv = sc[336 + lane];
        float mx = sc[336], sum = 0.f; for (int o = 0; o < 16; ++o) sum += __expf(sc[336 + o] - mx);
        const float gate = __expf(sv - mx) / sum;
        const int* eidx = (const int*)(ws + WS_EIDX) + (size_t)token * 128 + hh * 16; const float* eg = (const float*)(ws + WS_EGATE) + (size_t)token * 128 + hh * 16;
        int found = -1; for (int o = 0; o < 16; ++o) if (eidx[o] == eid) found = o;
        if (found < 0) atomicAdd(dbg + 0, 1.f); else dbg_max(dbg + 1, fabsf(eg[found] - gate));
    }
    if (lane == 0) atomicAdd(dbg + 2, 16.f);
}
DI void dbg_check_hid(const Params& P, int bid, int nblk) {
    const int tid = tid_(), lane = tid & 63, wave = __builtin_amdgcn_readfirstlane(tid >> 6);
    const unsigned char* ws = P.ws; float* dbg = (float*)(ws + WS_CTL) + 64;
    const int gw = bid * NWAVES + wave; const int token = (gw * 53) % NTOK;
    const float* hrow = P.out + (size_t)token * DM;
    float ss = 0.f; for (int c = lane; c < DM; c += 64) ss += hrow[c] * hrow[c];
    ss = wave_sum(ss); const float r2 = 1.f / sqrtf(ss / DM + EPS);
    for (int kk = 0; kk < 2; ++kk) {
        const int k = lane + 64 * kk; const int eid = ((const int*)(ws + WS_EIDX))[(size_t)token * 128 + k];
        const float* urow = P.pu + (size_t)eid * DM; float d = 0.f;
        for (int c = 0; c < DM; ++c) d += urow[c] * (hrow[c] * r2 * P.ffn_norm_w[c]);
        const float hidv = gelu_exact(d) * ((const float*)(ws + WS_EGATE))[(size_t)token * 128 + k];
        const float got = ((const float*)(ws + WS_HID))[(size_t)token * 128 + k];
        dbg_max(dbg + 3, fabsf(got - hidv)); dbg_max(dbg + 4, fabsf(hidv));
    }
}
DI float dbg_enc(float m) { return 8.f + log10f(fmaxf(m, 1e-8f)); }
#endif

#ifdef DBG_CHECK
DI void dbg_check_attn(const Params& P, int bid, int nblk) {
    const int tid = tid_(), lane = tid & 63, wave = __builtin_amdgcn_readfirstlane(tid >> 6);
    const unsigned char* ws = P.ws; float* dbg = (float*)(ws + WS_CTL) + 64;
    const int gw = bid * NWAVES + wave;
    const unsigned hsh = (unsigned)gw * 2654435761u;
    const int b = (hsh >> 8) & 7, h = (hsh >> 11) & 3, i = (int)((hsh >> 13) % 4096u), bh = b * 4 + h;
    const float lam = ((const float*)(ws + WS_LB))[512];
    float oc[2][2], lsum[2], mx[2];
    for (int c = 0; c < 2; ++c) { oc[c][0] = oc[c][1] = 0.f; lsum[c] = 0.f; mx[c] = -1e30f; }
    for (int pp = KPAD; pp <= 64 + i; ++pp) {
        const int tile = pp >> 6, key = pp & 63;
        for (int c = 0; c < 2; ++c) {
            const bf16_t* q = (const bf16_t*)(ws + WS_Q) + ((size_t)((bh * 2 + c) * SEQ + i)) * 64;
            const unsigned char* kimg = ws + WS_K + ((size_t)(bh * 2 + c) * KT + tile) * 8192;
            float sdot = 0.f;
            for (int d = 0; d < 64; ++d) sdot += bf2f(q[d]) * bf2f(*(const bf16_t*)(kimg + (d >> 3) * 1024 + key * 16 + (d & 7) * 2));
            const float mn = fmaxf(mx[c], sdot), al = exp2f(mx[c] - mn), pe = exp2f(sdot - mn);
            const unsigned char* vimg = ws + WS_V + ((size_t)bh * KT + tile) * 16384;
            for (int e = 0; e < 2; ++e) { const int dv = lane + 64 * e; oc[c][e] = oc[c][e] * al + pe * bf2f(*(const bf16_t*)(vimg + (dv >> 5) * 4096 + key * 64 + (dv & 31) * 2)); }
            lsum[c] = lsum[c] * al + pe; mx[c] = mn;
        }
    }
    float o[2], ss = 0.f;
    for (int e = 0; e < 2; ++e) { o[e] = oc[0][e] / lsum[0] - lam * oc[1][e] / lsum[1]; ss += o[e] * o[e]; }
    ss = wave_sum(ss); const float rs = (1.f - LAM_INIT) / sqrtf(ss / 128.f + EPS);
    for (int e = 0; e < 2; ++e) { const int dv = lane + 64 * e; const float want = o[e] * rs * P.subln_w[dv];
        const float got = bf2f(((const bf16_t*)(ws + WS_MIX))[(size_t)(b * SEQ + i) * DM + h * 128 + dv]);
        dbg_max(dbg + 5, fabsf(got - want)); dbg_max(dbg + 6, fabsf(want)); }
}
DI void dbg_check_hgrn(const Params& P, char* lds_g, int bid, int nblk) {
    if (bid >= 32) return;
    LAS float* L = (LAS float*)lds_g;
    const int tid = tid_(), dv = tid & 127, qt = tid >> 7;
    const unsigned char* ws = P.ws; float* dbg = (float*)(ws + WS_CTL) + 64;
    const int bh = bid, b = bid >> 2, h = bid & 3;
    const float* HG = (const float*)(ws + WS_HG) + (size_t)bh * HT * 128;
    const bf16_t* HQ = (const bf16_t*)(ws + WS_HQ) + (size_t)bh * HT * 128;
    const bf16_t* HV = (const bf16_t*)(ws + WS_HV) + (size_t)bh * HT * 128;
    float S[32];
#pragma unroll
    for (int j = 0; j < 32; ++j) S[j] = 0.f;
    for (int pp = 16; pp < HT; ++pp) {
        if (tid < 128) { L[tid] = __expf(HG[(size_t)pp * 128 + tid]); L[128 + tid] = bf2f(HQ[(size_t)pp * 128 + tid]); L[256 + tid] = bf2f(HV[(size_t)pp * 128 + tid]); }
        __syncthreads();
        const float v = L[256 + dv]; float part = 0.f;
#pragma unroll
        for (int j = 0; j < 32; ++j) { const float f = L[32 * qt + j]; S[j] = f * S[j] + (1.f - f) * v; part += L[128 + 32 * qt + j] * S[j]; }
        L[384 + qt * 128 + dv] = part;
        __syncthreads();
        if (tid < 128) { const float o = L[384 + dv] + L[512 + dv] + L[640 + dv] + L[768 + dv]; L[896 + dv] = o; }
        __syncthreads();
        if (tid < 128 && pp >= 32) {
            float ss = 0.f; for (int j = 0; j < 128; ++j) ss += L[896 + j] * L[896 + j];
            const float rs = 1.f / sqrtf(ss / 128.f + EPS);
            const size_t row = (size_t)b * SEQ + (pp - 32);
            const float want = L[896 + dv] * rs * P.rec_norm_w[h * 128 + dv] * bf2f(((const bf16_t*)(ws + WS_SG))[row * 512 + h * 128 + dv]);
            const float got = bf2f(((const bf16_t*)(ws + WS_MIX))[row * DM + 512 + h * 128 + dv]);
            dbg_max(dbg + 7, fabsf(got - want)); dbg_max(dbg + 8, fabsf(want));
        }
        __syncthreads();
    }
}
#endif

#ifdef DBG_CHECK
DI float dbg_proj(const Params& P, int m, int c) {
    const float* xrow = (m < NTOK) ? P.x + (size_t)m * DM : P.meta + (size_t)(m - NTOK) * DM;
    float ss = 0.f, a = 0.f;
    for (int k = 0; k < DM; ++k) { const float xv = xrow[k]; ss += xv * xv; a += xv * P.mix_norm_w[k] * P.w_in[(size_t)k * NCOL1 + c]; }
    return a / sqrtf(ss / DM + EPS);
}
DI void dbg_check_gemm1(const Params& P, int bid, int nblk) {
    const unsigned char* ws = P.ws; float* dbg = (float*)(ws + WS_CTL) + 64;
    const int gt = bid * NTHREADS + tid_();
    if (gt >= 7 * 4096) return;
    const unsigned hsh = (unsigned)gt * 2654435761u;
    const int seg = gt % 7, cs = (hsh >> 7) & 511;
    const bool meta = ((gt / 7) & 15) == 0;
    const int m = meta ? NTOK + ((hsh >> 20) & 15) : (int)((hsh >> 3) % (unsigned)NTOK);
    const int b = meta ? (int)((hsh >> 25) & 7) : (m >> 12), t = meta ? (m - NTOK) : ((m & 4095) + NMETA);
    const int h = cs >> 7;
    float want = 0.f, got = 0.f;
    if (seg <= 1) {
        if (seg == 0 && meta) return;
        const int comp = (cs >> 6) & 1, d = cs & 63, dlo = d & 31;
        const float zlo = dbg_proj(P, m, seg * 512 + (cs & ~63) + dlo), zhi = dbg_proj(P, m, seg * 512 + (cs & ~63) + dlo + 32);
        const double inv = exp2(-(double)dlo * (13.287712379549449 / 32.0)); const float cv = (float)cos((double)t * inv), sv = (float)sin((double)t * inv);
        want = (d < 32) ? zlo * cv - zhi * sv : zhi * cv + zlo * sv;
        if (seg == 0) { want *= QSCALE; got = bf2f(((const bf16_t*)(ws + WS_Q))[((size_t)(((b * 4 + h) * 2 + comp) * SEQ + (m & 4095))) * 64 + d]); }
        else { const int pp = t + KPAD; got = bf2f(*(const bf16_t*)(ws + WS_K + ((size_t)((b * 4 + h) * 2 + comp) * KT + (pp >> 6)) * 8192 + (d >> 3) * 1024 + (pp & 63) * 16 + (d & 7) * 2)); }
    } else {
        const float z = dbg_proj(P, m, seg * 512 + cs); const int dv = cs & 127;
        if (seg == 2) { const int pp = t + KPAD; want = z; got = bf2f(*(const bf16_t*)(ws + WS_V + ((size_t)(b * 4 + h) * KT + (pp >> 6)) * 16384 + (dv >> 5) * 4096 + (pp & 63) * 64 + (dv & 31) * 2)); }
        else if (seg == 3) { want = siluf_(z); got = bf2f(((const bf16_t*)(ws + WS_HQ))[((size_t)(b * 4 + h) * HT + t + 16) * 128 + dv]); }
        else if (seg == 4) { const float l0 = P.lb_logits[cs], l1 = P.lb_logits[512 + cs], lb = __expf(l0) / (__expf(l0) + __expf(l1)); want = __logf(lb + (1.f - lb) * sigmoidf_(z)); got = ((const float*)(ws + WS_HG))[((size_t)(b * 4 + h) * HT + t + 16) * 128 + dv]; }
        else if (seg == 5) { want = z; got = bf2f(((const bf16_t*)(ws + WS_HV))[((size_t)(b * 4 + h) * HT + t + 16) * 128 + dv]); }
        else { if (meta) return; want = siluf_(z); got = bf2f(((const bf16_t*)(ws + WS_SG))[(size_t)m * 512 + cs]); }
    }
    dbg_max(dbg + 16 + seg + (meta ? 8 : 0), fabsf(got - want));
}
#endif
typedef unsigned u32x4v __attribute__((vector_size(16)));
DI float oct_sum(float v) {
    v += dpp_f<0xB1>(v); v += dpp_f<0x4E>(v); v += dpp_f<0x141>(v); return v;
}
DI unsigned my_xcc_id() { return (unsigned)__builtin_amdgcn_s_getreg((3 << 11) | 20) & 7u; }
constexpr int CTL_G1 = 16, CTL_G2 = 32;

DI void xn8_rows(const Params& P, int bid, int nblk) {
    const int tid = tid_(), lane = tid & 63, wave = __builtin_amdgcn_readfirstlane(tid >> 6);
    unsigned char* ws = P.ws;
    const int gw = bid * NWAVES + wave, NGW = nblk * NWAVES;
    f32x4 wv[4];
#pragma unroll
    for (int q = 0; q < 4; ++q) wv[q] = *(const f32x4*)(P.ffn_norm_w + 16 * lane + 4 * q);
    for (int n = gw; n < NTOK; n += NGW) {
        const bf16_t* hrow = (const bf16_t*)(ws + WS_XB) + (size_t)n * DM + 16 * lane;
        const float r2 = 1.f / sqrtf(((const float*)(ws + WS_SSQ))[n] * (1.f / DM) + EPS);
        const u32x4 ha = *(const u32x4*)hrow, hb = *(const u32x4*)(hrow + 8);
        const unsigned hu[8] = {ha.x, ha.y, ha.z, ha.w, hb.x, hb.y, hb.z, hb.w};
        f32x4 t[4]; float am = 0.f;
#pragma unroll
        for (int q = 0; q < 4; ++q) { t[q] = (f32x4){bf2f(hu[2 * q] & 0xffffu), bf2f(hu[2 * q] >> 16), bf2f(hu[2 * q + 1] & 0xffffu), bf2f(hu[2 * q + 1] >> 16)} * wv[q] * r2; am = fmaxf(am, fmaxf(fmaxf(fabsf(t[q].x), fabsf(t[q].y)), fmaxf(fabsf(t[q].z), fabsf(t[q].w)))); }
        am = row16_max(am); am = fmaxf(fmaxf(readlane_f(am, 0), readlane_f(am, 16)), fmaxf(readlane_f(am, 32), readlane_f(am, 48)));
        const float sc = (am > 0.f) ? exp2f(floorf(log2f(224.f / am))) : 1.f;
        int w[4];
#pragma unroll
        for (int q = 0; q < 4; ++q) { w[q] = __builtin_amdgcn_cvt_pk_fp8_f32(t[q].x * sc, t[q].y * sc, 0, false); w[q] = __builtin_amdgcn_cvt_pk_fp8_f32(t[q].z * sc, t[q].w * sc, w[q], true); }
        *(u32x4*)(ws + WS_XN8 + (size_t)n * DM + 16 * lane) = (u32x4){(unsigned)w[0], (unsigned)w[1], (unsigned)w[2], (unsigned)w[3]};
        if (lane == 0) ((float*)(ws + WS_XSC))[n] = 1.f / sc;
    }
}
typedef int i32x4 __attribute__((ext_vector_type(4)));
struct GMeta { i32x4 id[4]; f32x4 c[4]; u32x4 xq; };
template <int WHICH>
DI void g_meta(const Params& P, int n, int x, GMeta& M) {
    const int lane = tid_() & 63, i = lane & 7, g = lane >> 3;
    const i32x4* ip = (const i32x4*)((const int*)(P.ws + WS_EIDX) + (size_t)n * 128 + 16 * g);
#pragma unroll
    for (int q = 0; q < 4; ++q) M.id[q] = ip[q];
    if (WHICH == 1) M.xq = *(const u32x4*)(P.ws + WS_XN8 + (size_t)n * DM + 128 * x + 16 * i);
    else { const f32x4* cp = (const f32x4*)((const float*)(P.ws + WS_HID) + (size_t)n * 128 + 16 * g);
#pragma unroll
        for (int q = 0; q < 4; ++q) M.c[q] = cp[q]; }
}
DI void g_issue(int x, const GMeta& M, u32x4v (&rw)[16], __amdgpu_buffer_rsrc_t rs) {
    const int i = tid_() & 7;
    const unsigned lo = (unsigned)x * (unsigned)(NEXP * 128) + (unsigned)(16 * i);
#pragma unroll
    for (int j = 0; j < 16; ++j) rw[j] = __builtin_amdgcn_raw_buffer_load_b128(rs, ((unsigned)M.id[j >> 2][j & 3] << 7) + lo, 0, 0);
}
DI void g1_finish(const Params& P, int n, int x, u32x4 xq, const u32x4v (&rw)[16]) {
    const int lane = tid_() & 63, i = lane & 7, g = lane >> 3;
    f32x2 xv[8];
    xv[0] = __builtin_amdgcn_cvt_pk_f32_fp8((int)xq.x, false); xv[1] = __builtin_amdgcn_cvt_pk_f32_fp8((int)xq.x, true);
    xv[2] = __builtin_amdgcn_cvt_pk_f32_fp8((int)xq.y, false); xv[3] = __builtin_amdgcn_cvt_pk_f32_fp8((int)xq.y, true);
    xv[4] = __builtin_amdgcn_cvt_pk_f32_fp8((int)xq.z, false); xv[5] = __builtin_amdgcn_cvt_pk_f32_fp8((int)xq.z, true);
    xv[6] = __builtin_amdgcn_cvt_pk_f32_fp8((int)xq.w, false); xv[7] = __builtin_amdgcn_cvt_pk_f32_fp8((int)xq.w, true);
    float pd[16];
#pragma unroll
    for (int j = 0; j < 16; ++j) pd[j] = dot16_fp8(__builtin_bit_cast(u32x4, rw[j]), xv);
    const unsigned m1 = 0u - (unsigned)((i >> 2) & 1), m2 = 0u - (unsigned)(i & 1), m3 = 0u - (unsigned)((i >> 1) & 1);
#define BSEL(a, b, m) __uint_as_float((__float_as_uint(a) & ~(m)) | (__float_as_uint(b) & (m)))
    float z[8], w[4], u[2];
#pragma unroll
    for (int q = 0; q < 8; ++q) { const float snd = BSEL(pd[q + 8], pd[q], m1), kep = BSEL(pd[q], pd[q + 8], m1); z[q] = kep + dpp_f<0x141>(snd); }
#pragma unroll
    for (int q = 0; q < 4; ++q) { const float snd = BSEL(z[q + 4], z[q], m2), kep = BSEL(z[q], z[q + 4], m2); w[q] = kep + dpp_f<0xB1>(snd); }
#pragma unroll
    for (int q = 0; q < 2; ++q) { const float snd = BSEL(w[q + 2], w[q], m3), kep = BSEL(w[q], w[q + 2], m3); u[q] = kep + dpp_f<0x4E>(snd); }
    const int j0 = 8 * ((i >> 2) & 1) + 4 * (i & 1) + 2 * ((i >> 1) & 1);
#undef BSEL
    *(f32x2*)((float*)(P.ws + WS_HIDP) + ((size_t)x * NTOK + n) * 128 + 16 * g + j0) = (f32x2){u[0], u[1]};
}
DI void g2_finish(const Params& P, int n, int x, const f32x4 (&cv)[4], const u32x4v (&rw)[16]) {
    const int lane = tid_() & 63, i = lane & 7, g = lane >> 3;
    f32x2 acc[8];
#pragma unroll
    for (int q = 0; q < 8; ++q) acc[q] = (f32x2){0.f, 0.f};
#pragma unroll
    for (int j = 0; j < 16; ++j) {
        const float cj = cv[j >> 2][j & 3]; const f32x2 c = (f32x2){cj, cj}; const u32x4 w = __builtin_bit_cast(u32x4, rw[j]);
        acc[0] = __builtin_amdgcn_cvt_pk_f32_fp8((int)w.x, false) * c + acc[0]; acc[1] = __builtin_amdgcn_cvt_pk_f32_fp8((int)w.x, true) * c + acc[1];
        acc[2] = __builtin_amdgcn_cvt_pk_f32_fp8((int)w.y, false) * c + acc[2]; acc[3] = __builtin_amdgcn_cvt_pk_f32_fp8((int)w.y, true) * c + acc[3];
        acc[4] = __builtin_amdgcn_cvt_pk_f32_fp8((int)w.z, false) * c + acc[4]; acc[5] = __builtin_amdgcn_cvt_pk_f32_fp8((int)w.z, true) * c + acc[5];
        acc[6] = __builtin_amdgcn_cvt_pk_f32_fp8((int)w.w, false) * c + acc[6]; acc[7] = __builtin_amdgcn_cvt_pk_f32_fp8((int)w.w, true) * c + acc[7];
    }
    float y[16], z[8], w[4];
#pragma unroll
    for (int q = 0; q < 8; ++q) { y[2 * q] = acc[q].x; y[2 * q + 1] = acc[q].y; }
#pragma unroll
    for (int q = 0; q < 8; ++q) { auto rr = __builtin_amdgcn_permlane32_swap(__float_as_uint(y[q]), __float_as_uint(y[q + 8]), false, false); z[q] = __uint_as_float(rr[0]) + __uint_as_float(rr[1]); }
#pragma unroll
    for (int q = 0; q < 4; ++q) { auto rr = __builtin_amdgcn_permlane16_swap(__float_as_uint(z[q]), __float_as_uint(z[q + 4]), false, false); w[q] = __uint_as_float(rr[0]) + __uint_as_float(rr[1]); }
    const unsigned m3 = 0u - (unsigned)(g & 1);
#define BSEL(a, b, m) __uint_as_float((__float_as_uint(a) & ~(m)) | (__float_as_uint(b) & (m)))
    const float k0 = BSEL(w[0], w[2], m3) + dpp_f<0x128>(BSEL(w[2], w[0], m3)), k1 = BSEL(w[1], w[3], m3) + dpp_f<0x128>(BSEL(w[3], w[1], m3));
#undef BSEL
    float* hp = P.out + (size_t)n * DM + 128 * x + 16 * i + 2 * g;
    const f32x2 t = *(const f32x2*)hp + (f32x2){k0, k1}; *(f32x2*)hp = t;
    const float ss = wave_sum_dpp(t.x * t.x + t.y * t.y);
    if (lane == 0) atomicAdd((float*)(P.ws + WS_SSQ2) + n, ss);
}
constexpr int SL_CHUNK = 128, SL_T = SL_CHUNK / NWAVES;
#define SB() __builtin_amdgcn_sched_barrier(0)
template <int WHICH>
DI void g_chunk(const Params& P, int nbase, int x, __amdgpu_buffer_rsrc_t rs) {
    GMeta MA, MB; u32x4v RA[16], RB[16];
    g_meta<WHICH>(P, nbase, x, MA); SB(); g_meta<WHICH>(P, nbase + 8, x, MB); SB(); g_issue(x, MA, RA, rs); SB();
#pragma unroll
    for (int t = 0; t < SL_T; t += 2) {
        const u32x4 xA = MA.xq; const f32x4 cA[4] = {MA.c[0], MA.c[1], MA.c[2], MA.c[3]};
        if (t + 2 < SL_T) { g_meta<WHICH>(P, nbase + 8 * (t + 2), x, MA); SB(); }
        g_issue(x, MB, RB, rs); SB();
        if (WHICH == 1) g1_finish(P, nbase + 8 * t, x, xA, RA); else g2_finish(P, nbase + 8 * t, x, cA, RA);
        SB();
        const u32x4 xB = MB.xq; const f32x4 cB[4] = {MB.c[0], MB.c[1], MB.c[2], MB.c[3]};
        if (t + 3 < SL_T) { g_meta<WHICH>(P, nbase + 8 * (t + 3), x, MB); SB(); }
        if (t + 2 < SL_T) { g_issue(x, MA, RA, rs); SB(); }
        if (WHICH == 1) g1_finish(P, nbase + 8 * (t + 1), x, xB, RB); else g2_finish(P, nbase + 8 * (t + 1), x, cB, RB);
        SB();
    }
}
template <int WHICH>
DI void sliced_phase(const Params& P, char* lds_g) {
    const int tid = tid_(), wave = __builtin_amdgcn_readfirstlane(tid >> 6);
    unsigned* ctr = (unsigned*)(P.ws + WS_CTL) + (WHICH == 1 ? CTL_G1 : CTL_G2);
    const __amdgpu_buffer_rsrc_t rs = __builtin_amdgcn_make_buffer_rsrc((void*)(P.ws + (WHICH == 1 ? WS_UB : WS_VB)), 0, NEXP * DM, 0x00020000);
    const int x0 = (int)my_xcc_id();
    LAS int* slot = (LAS int*)((LAS char*)lds_g + LDS_ITEM);
    for (int s = 0; s < 8; ++s) {
        const int x = (x0 + s) & 7;
        for (;;) {
            if (tid == 0) *slot = (int)atomicAdd(ctr + x, 1u);
            __syncthreads();
            const int chunk = *slot;
            __syncthreads();
            if (chunk >= NTOK / SL_CHUNK) break;
            g_chunk<WHICH>(P, chunk * SL_CHUNK + wave, x, rs);
        }
    }
}
DI void hid_reduce_phase(const Params& P, int bid, int nblk) {
    const unsigned char* ws = P.ws;
    const size_t gt = (size_t)bid * NTHREADS + tid_(), NGT = (size_t)nblk * NTHREADS;
    const float* hp = (const float*)(ws + WS_HIDP);
    for (size_t o = gt; o < (size_t)NTOK * 128; o += NGT) {
        float a = 0.f;
#pragma unroll
        for (int x = 0; x < 8; ++x) a += hp[(size_t)x * NTOK * 128 + o];
        const int e = ((const int*)(ws + WS_EIDX))[o];
        const float d = a * ((const float*)(ws + WS_USC))[e] * ((const float*)(ws + WS_XSC))[o >> 7];
        ((float*)(ws + WS_HID))[o] = gelu_exact(d) * ((const float*)(ws + WS_EGATE))[o] * ((const float*)(ws + WS_VSC))[e];
    }
}
DI void final_norm_phase(const Params& P, int bid, int nblk) {
    const size_t gt = (size_t)bid * NTHREADS + tid_(), NGT = (size_t)nblk * NTHREADS;
    const float* ssq = (const float*)(P.ws + WS_SSQ2);
    for (size_t o = gt; o < (size_t)NTOK * DM / 4; o += NGT) {
        const size_t n = o >> 8; const int c4 = (int)(o & 255);
        const float rs = 1.f / sqrtf(ssq[n] * (1.f / DM) + EPS);
        f32x4* pp = (f32x4*)P.out + o;
        *pp = *pp * ((const f32x4*)P.final_w)[c4] * rs;
    }
}

typedef long i64_t;
constexpr int MG_HALF = 8192, MG_WAVE = 2 * MG_HALF;
#define MG_WAIT(N) asm volatile("s_waitcnt vmcnt(" #N ")" ::: "memory")
struct MgMeta { i32x4 id[4]; u32x4 a0, a1, a2, a3; };
template <int WHICH>
DI void mg_meta(const Params& P, int n, int x, MgMeta& M) {
    const int lane = tid_() & 63, g8 = lane >> 3, kg = lane >> 4;
    const int* ip = (const int*)(P.ws + WS_EIDX) + (size_t)n * 128 + 8 * g8;
    M.id[0] = *(const i32x4*)ip; M.id[1] = *(const i32x4*)(ip + 4); M.id[2] = *(const i32x4*)(ip + 64); M.id[3] = *(const i32x4*)(ip + 68);
    if (WHICH == 1) { const unsigned char* xr = P.ws + WS_XN8 + (size_t)n * DM + 256 * x + 16 * kg;
        M.a0 = *(const u32x4*)xr; M.a1 = *(const u32x4*)(xr + 64); M.a2 = *(const u32x4*)(xr + 128); M.a3 = *(const u32x4*)(xr + 192); }
    else { const unsigned char* cr = P.ws + WS_C8 + ((size_t)x * NTOK + n) * 128 + 16 * kg;
        M.a0 = *(const u32x4*)cr; M.a1 = *(const u32x4*)(cr + 64); }
}
DI void mg_issue(const unsigned char* slice, const MgMeta& M, int h, unsigned lbase) {
    const int lane = tid_() & 63, pos = lane & 7;
    const i32x4 ia = M.id[2 * h], ib = M.id[2 * h + 1];
    const int ids[8] = {ia.x, ia.y, ia.z, ia.w, ib.x, ib.y, ib.z, ib.w};
#pragma unroll
    for (int p = 0; p < 8; ++p) glds16_asm(slice + (size_t)(unsigned)ids[p] * 128 + 16 * (pos ^ p), lbase + p * 1024);
}
DI i64_t pk64(unsigned lo, unsigned hi) { return (i64_t)(((unsigned long long)hi << 32) | lo); }
typedef int i32x8 __attribute__((ext_vector_type(8)));
DI float mg1_half(const MgMeta& M, LAS char* hb) {
    const int lane = tid_() & 63, c = lane & 15, kg = lane >> 4;
    const i32x8 A0 = (i32x8){(int)M.a0.x, (int)M.a0.y, (int)M.a0.z, (int)M.a0.w, (int)M.a1.x, (int)M.a1.y, (int)M.a1.z, (int)M.a1.w};
    const i32x8 A1 = (i32x8){(int)M.a2.x, (int)M.a2.y, (int)M.a2.z, (int)M.a2.w, (int)M.a3.x, (int)M.a3.y, (int)M.a3.z, (int)M.a3.w};
    f32x4 d[4];
#pragma unroll
    for (int G = 0; G < 4; ++G) {
        const LAS char* row = hb + (c & 7) * 1024 + (2 * G + (c >> 3)) * 128;
        const u32x4 b0 = *(const LAS u32x4*)(row + ((kg ^ (c & 7)) << 4)), b1 = *(const LAS u32x4*)(row + (((kg + 4) ^ (c & 7)) << 4));
        d[G] = (f32x4){0.f, 0.f, 0.f, 0.f};
        d[G] = __builtin_amdgcn_mfma_scale_f32_16x16x128_f8f6f4(A0, (i32x8){(int)b0.x, (int)b0.y, (int)b0.z, (int)b0.w, 0, 0, 0, 0}, d[G], 0, 4, 0, 0x7F7F7F7F, 0, 0x7F7F7F7F);
        d[G] = __builtin_amdgcn_mfma_scale_f32_16x16x128_f8f6f4(A1, (i32x8){(int)b1.x, (int)b1.y, (int)b1.z, (int)b1.w, 0, 0, 0, 0}, d[G], 0, 4, 0, 0x7F7F7F7F, 0, 0x7F7F7F7F);
    }
    asm volatile("s_nop 15\n\ts_nop 15" : "+v"(d[0]), "+v"(d[1]), "+v"(d[2]), "+v"(d[3]));
    const float r01 = (kg & 1) ? d[1][0] : d[0][0], r23 = (kg & 1) ? d[3][0] : d[2][0];
    return (kg & 2) ? r23 : r01;
}
typedef int v2i_t __attribute__((ext_vector_type(2)));
DI void mg2_half(const MgMeta& M, int h, LAS char* hb, f32x4 (&D)[8]) {
    const int lane = tid_() & 63, c = lane & 15, g = lane >> 4;
    const u32x4 ch = h ? M.a1 : M.a0;
    const LAS char* rb = hb + (c & 7) * 1024 + (4 * (g & 1) + (c >> 3)) * 128 + 8 * (g >> 1);
#pragma unroll
    for (int t = 0; t < 8; ++t) {
        const unsigned mlo = (c == 4 * (t & 3)) ? 0xFFFFFFFFu : 0u, mhi = (c == 4 * (t & 3) + 1) ? 0xFFFFFFFFu : 0u;
        const i32x8 A = (i32x8){(int)(ch.x & mlo), (int)(ch.y & mlo), (int)(ch.z & mlo), (int)(ch.w & mlo), (int)(ch.x & mhi), (int)(ch.y & mhi), (int)(ch.z & mhi), (int)(ch.w & mhi)};
        const v2i_t b0 = __builtin_amdgcn_ds_read_tr4_b64_v2i32((LAS v2i_t*)(rb + ((t ^ (c & 7)) << 4)));
        const v2i_t b1 = __builtin_amdgcn_ds_read_tr4_b64_v2i32((LAS v2i_t*)(rb + 256 + ((t ^ (c & 7)) << 4)));
        D[t] = __builtin_amdgcn_mfma_scale_f32_16x16x128_f8f6f4(A, (i32x8){b0.x, b0.y, b1.x, b1.y, 0, 0, 0, 0}, D[t], 0, 4, 0, 0x7F7F7F7F, 0, 0x7F7F7F7F);
    }
}
template <int WHICH>
DI void mg_group(const Params& P, const unsigned char* slice, int n0, int x, LAS char* wl, unsigned wl_off, const MgMeta (&M)[4], MgMeta (&Mn)[4], bool more) {
    const int lane = tid_() & 63, kg = lane >> 4, c = lane & 15;
    bf16_t* outp = (bf16_t*)(P.ws + WS_HIDP) + (size_t)x * NTOK * (WHICH == 1 ? 128 : 256);
    f32x4 D[8];
    mg_issue(slice, M[0], 0, wl_off); SB();
#define MG_STEP(h, WAITSTMT) do { \
        if ((h) + 1 < 8) { mg_issue(slice, M[((h) + 1) >> 1], ((h) + 1) & 1, wl_off + (((h) + 1) & 1) * MG_HALF); } \
        else if (more) { _Pragma("unroll") for (int q_ = 0; q_ < 4; ++q_) mg_meta<WHICH>(P, n0 + 8 * (4 + q_), x, Mn[q_]); } \
        SB(); WAITSTMT; SB(); \
        LAS char* hb_ = wl + ((h) & 1) * MG_HALF; const int n_ = n0 + 8 * ((h) >> 1); \
        if (WHICH == 1) { const float r_ = mg1_half(M[(h) >> 1], hb_); outp[(size_t)n_ * 128 + 64 * ((h) & 1) + lane] = (bf16_t)f2bf(r_); } \
        else { if (((h) & 1) == 0) { _Pragma("unroll") for (int q_ = 0; q_ < 8; ++q_) D[q_] = (f32x4){0.f, 0.f, 0.f, 0.f}; } \
            mg2_half(M[(h) >> 1], (h) & 1, hb_, D); \
            if ((h) & 1) { asm volatile("s_nop 15\n\ts_nop 15" : "+v"(D[0]), "+v"(D[1]), "+v"(D[2]), "+v"(D[3]), "+v"(D[4]), "+v"(D[5]), "+v"(D[6]), "+v"(D[7])); \
                float v0_ = 0.f, v1_ = 0.f, v2_ = 0.f, v3_ = 0.f; _Pragma("unroll") for (int q_ = 0; q_ < 4; ++q_) { if (kg == q_) { v0_ = D[q_][0]; v1_ = D[q_][1]; v2_ = D[q_ + 4][0]; v3_ = D[q_ + 4][1]; } } \
                bf16_t* o_ = outp + (size_t)n_ * 256 + 32 * kg + c; o_[0] = (bf16_t)f2bf(v0_); o_[16] = (bf16_t)f2bf(v1_); o_[128] = (bf16_t)f2bf(v2_); o_[144] = (bf16_t)f2bf(v3_); } } \
        SB(); } while (0)
    if (WHICH == 1) {
        MG_STEP(0, MG_WAIT(8)); MG_STEP(1, MG_WAIT(9)); MG_STEP(2, MG_WAIT(9)); MG_STEP(3, MG_WAIT(9)); MG_STEP(4, MG_WAIT(9)); MG_STEP(5, MG_WAIT(9)); MG_STEP(6, MG_WAIT(9));
        if (more) { MG_STEP(7, MG_WAIT(33)); } else { MG_STEP(7, MG_WAIT(1)); }
    } else {
        MG_STEP(0, MG_WAIT(8)); MG_STEP(1, MG_WAIT(8)); MG_STEP(2, MG_WAIT(12)); MG_STEP(3, MG_WAIT(8)); MG_STEP(4, MG_WAIT(12)); MG_STEP(5, MG_WAIT(8)); MG_STEP(6, MG_WAIT(12));
        if (more) { MG_STEP(7, MG_WAIT(24)); } else { MG_STEP(7, MG_WAIT(0)); }
    }
#undef MG_STEP
}
template <int WHICH>
DI void mg_phase(const Params& P, char* lds_g) {
    const int tid = tid_(), wave = __builtin_amdgcn_readfirstlane(tid >> 6);
    unsigned* ctr = (unsigned*)(P.ws + WS_CTL) + (WHICH == 1 ? CTL_G1 : CTL_G2);
    const int x0 = (int)my_xcc_id();
    LAS int* slot = (LAS int*)((LAS char*)lds_g + LDS_ITEM);
    LAS char* wl = (LAS char*)lds_g + wave * MG_WAVE;
    const unsigned wl_off = (unsigned)__builtin_amdgcn_readfirstlane((int)(unsigned)(size_t)wl);
    constexpr int NSL = 4;
    for (int s = 0; s < NSL; ++s) {
        const int x = (x0 + s) & (NSL - 1);
        const unsigned char* slice = P.ws + (WHICH == 1 ? WS_UB : WS_VB) + (size_t)x * ((size_t)NEXP * 128);
        for (;;) {
            if (tid == 0) *slot = (int)atomicAdd(ctr + x, 1u);
            __syncthreads();
            const int chunk = *slot;
            __syncthreads();
            if (chunk >= NTOK / SL_CHUNK) break;
            const int nb = chunk * SL_CHUNK + wave;
            MgMeta MA[4], MB[4];
#pragma unroll
            for (int q = 0; q < 4; ++q) mg_meta<WHICH>(P, nb + 8 * q, x, MA[q]);
            mg_group<WHICH>(P, slice, nb, x, wl, wl_off, MA, MB, true);
            mg_group<WHICH>(P, slice, nb + 32, x, wl, wl_off, MB, MA, true);
            mg_group<WHICH>(P, slice, nb + 64, x, wl, wl_off, MA, MB, true);
            mg_group<WHICH>(P, slice, nb + 96, x, wl, wl_off, MB, MA, false);
            MG_WAIT(0);
        }
    }
}
DI void hid_reduce8_phase(const Params& P, int bid, int nblk) {
    const int tid = tid_(), lane = tid & 63, wave = __builtin_amdgcn_readfirstlane(tid >> 6);
    unsigned char* ws = P.ws;
    const int gw = bid * NWAVES + wave, NGW = nblk * NWAVES;
    const bf16_t* hp = (const bf16_t*)(ws + WS_HIDP);
    for (int n = gw; n < NTOK; n += NGW) {
        const float xs = ((const float*)(ws + WS_XSC))[n];
        f32x4 cv[2]; f32x4 am = (f32x4){0.f, 0.f, 0.f, 0.f};
#pragma unroll
        for (int q = 0; q < 2; ++q) {
            const size_t o = (size_t)n * 128 + 64 * q + lane; float a = 0.f;
            const int e = ((const int*)(ws + WS_EIDX))[o];
            const f32x4 us = *(const f32x4*)((const float*)(ws + WS_USC) + (size_t)e * 4);
#pragma unroll
            for (int x = 0; x < 4; ++x) a += bf2f(hp[(size_t)x * NTOK * 128 + o]) * us[x];
            const float cf = gelu_exact(a * xs) * ((const float*)(ws + WS_EGATE))[o];
            const f32x4 vs = *(const f32x4*)((const float*)(ws + WS_VSC) + (size_t)e * 4);
            cv[q] = vs * cf;
            am.x = fmaxf(am.x, fabsf(cv[q].x)); am.y = fmaxf(am.y, fabsf(cv[q].y)); am.z = fmaxf(am.z, fabsf(cv[q].z)); am.w = fmaxf(am.w, fabsf(cv[q].w));
        }
        f32x4 isc;
#pragma unroll
        for (int x = 0; x < 4; ++x) {
            float m = row16_max(am[x]); m = fmaxf(fmaxf(readlane_f(m, 0), readlane_f(m, 16)), fmaxf(readlane_f(m, 32), readlane_f(m, 48)));
            const float sc = (m > 0.f) ? exp2f(floorf(log2f(224.f / m))) : 1.f;
            const int w0 = __builtin_amdgcn_cvt_pk_fp8_f32(cv[0][x] * sc, cv[1][x] * sc, 0, false);
            unsigned char* cr = ws + WS_C8 + ((size_t)x * NTOK + n) * 128;
            cr[lane] = (unsigned char)(w0 & 255); cr[64 + lane] = (unsigned char)((w0 >> 8) & 255);
            isc[x] = 1.f / sc;
        }
        if (lane == 0) *(f32x4*)((float*)(ws + WS_CSC) + (size_t)n * 4) = isc;
    }
}
DI void final_norm8_phase(const Params& P, int bid, int nblk) {
    const int tid = tid_(), lane = tid & 63, wave = __builtin_amdgcn_readfirstlane(tid >> 6);
    const unsigned char* ws = P.ws;
    const int gw = bid * NWAVES + wave, NGW = nblk * NWAVES;
    f32x4 wv[4];
#pragma unroll
    for (int q = 0; q < 4; ++q) wv[q] = *(const f32x4*)(P.final_w + 16 * lane + 4 * q);
    for (int n = gw; n < NTOK; n += NGW) {
        float* orow = P.out + (size_t)n * DM + 16 * lane;
        const bf16_t* yrow = (const bf16_t*)(ws + WS_HIDP) + ((size_t)(lane >> 4) * NTOK + n) * 256 + 16 * (lane & 15);
        const u32x4 ya = *(const u32x4*)yrow, yb = *(const u32x4*)(yrow + 8);
        const unsigned yu[8] = {ya.x, ya.y, ya.z, ya.w, yb.x, yb.y, yb.z, yb.w};
        const float cs = ((const float*)(ws + WS_CSC))[(size_t)n * 4 + (lane >> 4)];
        const bf16_t* hrow = (const bf16_t*)(ws + WS_XB) + (size_t)n * DM + 16 * lane;
        const u32x4 ha = *(const u32x4*)hrow, hb = *(const u32x4*)(hrow + 8);
        const unsigned hu[8] = {ha.x, ha.y, ha.z, ha.w, hb.x, hb.y, hb.z, hb.w};
        f32x4 h[4]; float ss = 0.f;
#pragma unroll
        for (int q = 0; q < 4; ++q) { h[q] = (f32x4){bf2f(hu[2 * q] & 0xffffu), bf2f(hu[2 * q] >> 16), bf2f(hu[2 * q + 1] & 0xffffu), bf2f(hu[2 * q + 1] >> 16)} + (f32x4){bf2f(yu[2 * q] & 0xffffu), bf2f(yu[2 * q] >> 16), bf2f(yu[2 * q + 1] & 0xffffu), bf2f(yu[2 * q + 1] >> 16)} * cs; ss += (h[q].x * h[q].x + h[q].y * h[q].y) + (h[q].z * h[q].z + h[q].w * h[q].w); }
        ss = wave_sum_dpp(ss);
        const float rs = 1.f / sqrtf(ss * (1.f / DM) + EPS);
#pragma unroll
        for (int q = 0; q < 4; ++q) *(f32x4*)(orow + 4 * q) = h[q] * wv[q] * rs;
    }
}

#define XB_TMO      128
#define XB_XCNT(j)  (256  + 64 * (j))
#define XB_XSUB(j)  (1280 + 64 * (j))
#define XB_XGEN(j)  (2304 + 64 * (j))
#define XB_TOP      3328
#define XB_TOPGEN   3392
#define XCD_BAR_WORDS 3456
#define XB_SPIN_CAP (1u << 18)

__device__ __forceinline__ unsigned xb_ld(unsigned* p)              { return __hip_atomic_load(p, __ATOMIC_RELAXED, __HIP_MEMORY_SCOPE_AGENT); }
__device__ __forceinline__ unsigned xb_add(unsigned* p, unsigned v) { return __hip_atomic_fetch_add(p, v, __ATOMIC_RELAXED, __HIP_MEMORY_SCOPE_AGENT); }
__device__ __forceinline__ unsigned xb_xcc_id() { return (unsigned)__builtin_amdgcn_s_getreg((3 << 11) | 20) & 0xFu; }
#define XB_SPIN(cond, bar) do { unsigned _sp = 0; while (cond) { __builtin_amdgcn_s_sleep(1); \
    if ((++_sp & 255u) == 0u) { if (xb_ld(&(bar)[XB_TMO])) break; if (_sp > XB_SPIN_CAP) { atomicAdd(&(bar)[XB_TMO], 1u); break; } } } } while (0)

struct XcdBarrier {
    unsigned* bar; unsigned x;
    volatile LAS unsigned* st;
};

__device__ __forceinline__ XcdBarrier xcd_barrier_post(unsigned* bar, volatile LAS unsigned* st) {
    XcdBarrier b; b.bar = bar; b.x = xb_xcc_id(); b.st = st;
    if (threadIdx.x == 0) (void)xb_add(&bar[XB_XCNT(b.x)], 1u);
    return b;
}
__device__ __forceinline__ void xcd_barrier_complete(unsigned* bar, unsigned x, unsigned& nloc, unsigned& nx) {
    const unsigned G = gridDim.x * gridDim.y * gridDim.z;
    unsigned sum, cnt, mine, sp = 0u;
    for (;;) {
        sum = 0u; cnt = 0u; mine = 0u;
#pragma unroll
        for (unsigned j = 0; j < 16; ++j) { const unsigned c = xb_ld(&bar[XB_XCNT(j)]); sum += c; cnt += (c > 0u) ? 1u : 0u; mine = (j == x) ? c : mine; }
        if (sum == G) break;
        __builtin_amdgcn_s_sleep(1);
        if ((++sp & 255u) == 0u) { if (xb_ld(&bar[XB_TMO])) break; if (sp > XB_SPIN_CAP) { atomicAdd(&bar[XB_TMO], 1u); break; } }
    }
    nloc = mine > 0u ? mine : 1u; nx = cnt > 0u ? cnt : 1u;
}

__device__ __forceinline__ void xcd_barrier(const XcdBarrier& b) {
    asm volatile("s_waitcnt vmcnt(0)" ::: "memory");
    __syncthreads();
    if (threadIdx.x == 0) {
        unsigned* bar = b.bar;
        __builtin_amdgcn_s_waitcnt(0);
        unsigned nloc = b.st[0], nx = b.st[1];
        if (nloc == 0u) { xcd_barrier_complete(bar, b.x, nloc, nx); b.st[0] = nloc; b.st[1] = nx; }
        const unsigned old = xb_add(&bar[XB_XSUB(b.x)], 1u);
        const unsigned gen = old / nloc;
        if (old + 1u == (gen + 1u) * nloc) {
            __builtin_amdgcn_fence(__ATOMIC_RELEASE, "agent");
            asm volatile("s_waitcnt vmcnt(0)" ::: "memory");
            const unsigned og = xb_add(&bar[XB_TOP], 1u);
            const unsigned tg = og / nx;
            if (og + 1u == (tg + 1u) * nx) xb_add(&bar[XB_TOPGEN], 1u);
            else XB_SPIN(xb_ld(&bar[XB_TOPGEN]) == tg, bar);
            __builtin_amdgcn_fence(__ATOMIC_ACQUIRE, "agent");
            xb_add(&bar[XB_XGEN(b.x)], 1u);
            asm volatile("s_waitcnt vmcnt(0)" ::: "memory");
        } else {
            XB_SPIN(xb_ld(&bar[XB_XGEN(b.x)]) == gen, bar);
            __builtin_amdgcn_fence(__ATOMIC_ACQUIRE, "agent");
            asm volatile("s_waitcnt vmcnt(0)" ::: "memory");
        }
    }
    __syncthreads();
}

constexpr int CTL_XB_WORD = 2048;
static_assert((CTL_XB_WORD + 3456) * 4 <= (int)CTL_BYTES, "barrier words inside CTL");
constexpr int N_HGRN_ITEMS = BATCH * 4, N_ATT_ITEMS = BATCH * 4 * 32;

DI void mixer_phase(const Params& P, char* lds) {
    unsigned* ctr = (unsigned*)(P.ws + WS_CTL);
    for (;;) {
        if (tid_() == 0) *(LAS int*)((LAS char*)lds + LDS_ITEM) = (int)atomicAdd(ctr, 1u);
        __syncthreads();
        const int item = *(LAS int*)((LAS char*)lds + LDS_ITEM);
        __syncthreads();
        if (item >= N_HGRN_ITEMS + N_ATT_ITEMS) break;
        if (item < N_HGRN_ITEMS) hgrn_unit(P, item >> 2, item & 3, lds);
        else { const int a = item - N_HGRN_ITEMS, j = 31 - (a >> 5), bh = a & 31; attn_unit(P, bh >> 2, bh & 3, j, lds); }
    }
}

#ifdef TS_PHASE
#ifndef TS_DIV
#define TS_DIV 4.0f
#endif
#ifndef TS_OFF
#define TS_OFF 0.0f
#endif
#define TS(i) do { if (blockIdx.x == 0 && threadIdx.x == 0) ((LAS unsigned long long*)((LAS char*)lds + LDS_BYTES - 512))[i] = __builtin_amdgcn_s_memrealtime(); } while (0)
#else
#define TS(i) do { } while (0)
#endif
__global__ void __launch_bounds__(NTHREADS, 2) fwd_megakernel(Params P) {
    extern __shared__ __attribute__((aligned(16))) char lds[];
    cg::grid_group grid = cg::this_grid();
    const int bid = blockIdx.x, nblk = gridDim.x;
    unsigned char* ws = P.ws;
    volatile LAS unsigned* xst = (volatile LAS unsigned*)((LAS char*)lds + LDS_XB);
    if (threadIdx.x < 4) xst[threadIdx.x] = 0u;
    __syncthreads();
    TS(0);
    phase0(P, lds, bid, nblk);
    grid.sync();
    const XcdBarrier xbar = xcd_barrier_post((unsigned*)(ws + WS_CTL) + CTL_XB_WORD, xst);
    TS(1);
    { Epi1 e{ws}; gemm_run(lds, (const bf16_t*)(ws + WS_XB), (const bf16_t*)(ws + WS_W1T), M1, NCOL1, DM, e, bid, nblk); }
    {
        constexpr int NUNITS = (M1 / 256) * (NCOL1 / 256);
        const int nlast = NUNITS % nblk, nfree = nlast ? nblk - nlast : nblk;
        const int wave = __builtin_amdgcn_readfirstlane(tid_() >> 6);
        if (nlast == 0 || bid >= nlast) table_fp8_rows(P, NEXP + (bid - (nlast ? nlast : 0)) * NWAVES + wave, nfree * NWAVES, 2 * NEXP);
    }
    xcd_barrier(xbar);
    TS(2);
    for (int it = bid; it < 32 * 129; it += nblk) hgrn_prep_item(P, it & 31, it >> 5, lds);
    xcd_barrier(xbar);
    TS(3);
    mixer_phase(P, lds);
    xcd_barrier(xbar);
    TS(4);
    { Epi3 e{P.x, P.out, (bf16_t*)(ws + WS_XB), (float*)(ws + WS_SSQ)}; gemm_run(lds, (const bf16_t*)(ws + WS_MIX), (const bf16_t*)(ws + WS_W2T), NTOK, DM, DM, e, bid, nblk); }
    xcd_barrier(xbar);
    TS(5);
    { Epi4 e{(const float*)(ws + WS_SSQ), (bf16_t*)(ws + WS_PQ)}; gemm_run(lds, (const bf16_t*)(ws + WS_XB), (const bf16_t*)(ws + WS_W3T), NTOK, 2048, DM, e, bid, nblk); }
    xcd_barrier(xbar);
    TS(6);
    topk_phase(P, lds, bid, nblk);
    xn8_rows(P, bid, nblk);
    xcd_barrier(xbar);
    TS(7);
    mg_phase<1>(P, lds);
    xcd_barrier(xbar);
    TS(8);
    hid_reduce8_phase(P, bid, nblk);
    xcd_barrier(xbar);
    TS(9);
    mg_phase<2>(P, lds);
    xcd_barrier(xbar);
    TS(10);
    final_norm8_phase(P, bid, nblk);
    TS(11);
#ifdef TS_PHASE
    if (blockIdx.x == 0 && threadIdx.x == 0) { const LAS unsigned long long* t = (const LAS unsigned long long*)((LAS char*)lds + LDS_BYTES - 512);
        P.out[0] += ((float)(t[TS_PHASE + 1] - t[TS_PHASE]) * 0.01f - TS_OFF) / TS_DIV; }
#endif
}

extern "C" void kernel_launch(void* const* d_in, const int* in_sizes, int n_in, void* d_out, int out_size, void* d_ws, size_t ws_size, hipStream_t stream) {
    static int grid = 0;
    if (grid == 0) {
        int dev = 0, cus = 0, per_cu = 0;
        (void)hipGetDevice(&dev);
        (void)hipDeviceGetAttribute(&cus, hipDeviceAttributeMultiprocessorCount, dev);
        (void)hipFuncSetAttribute((const void*)fwd_megakernel, hipFuncAttributeMaxDynamicSharedMemorySize, LDS_BYTES);
        (void)hipOccupancyMaxActiveBlocksPerMultiprocessor(&per_cu, (const void*)fwd_megakernel, NTHREADS, LDS_BYTES);
        if (per_cu < 1) { fprintf(stderr, "kernel_launch: occupancy query says %d blocks per CU\n", per_cu); per_cu = 1; }
        grid = cus * 1;
        if (ws_size < WS_END) { fprintf(stderr, "kernel_launch: workspace too small: %zu < %zu\n", ws_size, (size_t)WS_END); grid = -1; }
    }
    if (grid < 0) return;
    Params p{};
    p.x = (const float*)d_in[0]; p.meta = (const float*)d_in[1]; p.mix_norm_w = (const float*)d_in[2]; p.w_in = (const float*)d_in[3];
    p.lb_logits = (const float*)d_in[4]; p.rec_norm_w = (const float*)d_in[5]; p.lq1 = (const float*)d_in[6]; p.lk1 = (const float*)d_in[7];
    p.lq2 = (const float*)d_in[8]; p.lk2 = (const float*)d_in[9]; p.subln_w = (const float*)d_in[10]; p.w_out = (const float*)d_in[11];
    p.ffn_norm_w = (const float*)d_in[12]; p.wq = (const float*)d_in[13]; p.subkeys = (const float*)d_in[14]; p.pu = (const float*)d_in[15];
    p.pv = (const float*)d_in[16]; p.final_w = (const float*)d_in[17];
    p.out = (float*)d_out; p.ws = (unsigned char*)d_ws;
    void* args[] = {&p};
    hipError_t e = hipLaunchCooperativeKernel((const void*)fwd_megakernel, dim3(grid), dim3(NTHREADS), args, LDS_BYTES, stream);
    if (e != hipSuccess) fprintf(stderr, "cooperative launch failed: %s (grid %d)\n", hipGetErrorString(e), grid);
}
```

```cpp
#include <hip/hip_runtime.h>
#include <hip/hip_cooperative_groups.h>
#include <cstdio>
#include <cstdint>
#define DBG_SEL 1
namespace cg = cooperative_groups;

constexpr int BATCH = 8, SEQ = 4096, DM = 1024, NMETA = 16;
constexpr int NTOK = BATCH * SEQ;
constexpr int M1 = NTOK + 256;
constexpr int NCOL1 = 3584;
constexpr int TPOS = NMETA + SEQ;
constexpr int KT = 65;
constexpr int KPAD = 48;
constexpr int HT = 4128;
constexpr int NEXP = 16384;
constexpr float EPS = 1e-6f;
constexpr float LAM_INIT = 0.2f;
constexpr float QSCALE = 0.125f * 1.4426950408889634f;
constexpr int NTHREADS = 512, NWAVES = 8;
constexpr int LDS_BYTES = 163840;
constexpr int LDS_ITEM = LDS_BYTES - 64, LDS_XB = LDS_BYTES - 32;

typedef unsigned short bf16_t;
typedef short bf16x8 __attribute__((ext_vector_type(8)));
typedef float f32x4 __attribute__((ext_vector_type(4)));
typedef float f32x16 __attribute__((ext_vector_type(16)));
typedef float f32x2 __attribute__((ext_vector_type(2)));
typedef unsigned u32x4 __attribute__((ext_vector_type(4)));
typedef unsigned u32x2 __attribute__((ext_vector_type(2)));
typedef __bf16 bf16x2_t __attribute__((ext_vector_type(2)));
typedef short s16x4 __attribute__((ext_vector_type(4)));
#define LAS __attribute__((address_space(3)))
#define DI __device__ __forceinline__
__device__ __forceinline__ int tid_() { int t = threadIdx.x; asm volatile("" : "+v"(t)); return t; }

constexpr size_t al256(size_t x) { return (x + 255) & ~(size_t)255; }
constexpr size_t WS_CTL = 0, CTL_BYTES = 65536;
constexpr size_t WS_W1T = WS_CTL + CTL_BYTES;
constexpr size_t WS_W2T = WS_W1T + (size_t)NCOL1 * DM * 2;
constexpr size_t WS_W3T = WS_W2T + (size_t)DM * DM * 2;
constexpr size_t WS_SKB = WS_W3T + (size_t)2048 * DM * 2;
constexpr size_t WS_UB = WS_SKB + (size_t)16 * 128 * 128 * 2;
constexpr size_t WS_VB = WS_UB + (size_t)NEXP * DM * 2;
constexpr size_t WS_USC = WS_UB + (size_t)NEXP * DM, WS_VSC = WS_VB + (size_t)NEXP * DM;
constexpr size_t WS_ROPE = WS_VB + (size_t)NEXP * DM * 2;
constexpr size_t WS_LB = WS_ROPE + (size_t)TPOS * 64 * 4;
constexpr size_t WS_R1 = WS_LB + 4096;
constexpr size_t WS_SSQ = WS_R1 + al256((size_t)M1 * 4);
constexpr size_t WS_SSQ2 = WS_SSQ + (size_t)NTOK * 4;
constexpr size_t WS_XB = WS_SSQ2 + (size_t)NTOK * 4;
constexpr size_t WS_C = WS_XB + (size_t)M1 * DM * 2;
constexpr size_t WS_Q = WS_C;
constexpr size_t WS_K = WS_Q + (size_t)NTOK * 512 * 2;
constexpr size_t WS_V = WS_K + (size_t)BATCH * 4 * 2 * KT * 8192;
constexpr size_t WS_HQ = WS_V + (size_t)BATCH * 4 * KT * 16384;
constexpr size_t WS_HV = WS_HQ + (size_t)BATCH * 4 * HT * 128 * 2;
constexpr size_t WS_HG = WS_HV + (size_t)BATCH * 4 * HT * 128 * 2;
constexpr size_t WS_SG = WS_HG + (size_t)BATCH * 4 * HT * 128 * 4;
constexpr size_t WS_CEND = WS_SG + (size_t)NTOK * 512 * 2;
constexpr size_t WS_PQ = WS_C;
constexpr size_t WS_EIDX = WS_PQ + (size_t)NTOK * 2048 * 2;
constexpr size_t WS_EGATE = WS_EIDX + (size_t)NTOK * 128 * 4;
constexpr size_t WS_HID = WS_EGATE + (size_t)NTOK * 128 * 4;
constexpr size_t WS_XN8 = WS_HID + (size_t)NTOK * 128 * 4;
constexpr size_t WS_XSC = WS_XN8 + (size_t)NTOK * DM;
constexpr size_t WS_C8 = WS_XSC + (size_t)NTOK * 4;
constexpr size_t WS_CSC = WS_C8 + (size_t)NTOK * 128 * 4;
static_assert(WS_CSC + (size_t)NTOK * 16 <= WS_CEND, "overlay fits");
constexpr size_t WS_HIDP = WS_PQ;
constexpr size_t WS_MIX = WS_CEND;
constexpr size_t WS_HQA = WS_MIX + (size_t)NTOK * DM * 2;
constexpr size_t WS_HD = WS_HQA + (size_t)BATCH * 4 * HT * 128 * 2;
constexpr size_t WS_END = WS_HD + (size_t)BATCH * 4 * 129 * 128 * 4;
static_assert(WS_END <= (size_t)512 * 1024 * 1024, "workspace map must fit 512 MiB");

struct Params {
    const float* x; const float* meta; const float* mix_norm_w; const float* w_in; const float* lb_logits; const float* rec_norm_w;
    const float* lq1; const float* lk1; const float* lq2; const float* lk2; const float* subln_w; const float* w_out; const float* ffn_norm_w;
    const float* wq; const float* subkeys; const float* pu; const float* pv; const float* final_w;
    float* out; unsigned char* ws;
};

DI unsigned f2bf(float f) { unsigned u = __builtin_bit_cast(unsigned, f); return (u + 0x7fffu + ((u >> 16) & 1u)) >> 16; }
DI float bf2f(unsigned b) { return __builtin_bit_cast(float, b << 16); }
DI unsigned cvtpk(float lo, float hi) { f32x2 v = {lo, hi}; bf16x2_t b = __builtin_convertvector(v, bf16x2_t); return __builtin_bit_cast(unsigned, b); }
DI float wave_sum(float v) {
#pragma unroll
    for (int o = 1; o < 64; o <<= 1) v += __shfl_xor(v, o);
    return v;
}
DI float sigmoidf_(float x) { return 1.f / (1.f + __expf(-x)); }
DI float siluf_(float x) { return x * sigmoidf_(x); }

DI int sigma_col(int c) {
    if (c >= 1024) return c;
    const int cc = c & 63, a = cc >> 5, fq = (cc >> 3) & 3, n = (cc >> 2) & 1, j = cc & 3;
    return (c & ~63) + 4 * (4 * a + fq) + 32 * n + j;
}
template <bool PERMUTE>
DI void p0_transpose_item(const float* W, int K, int N, const float* scale, bf16_t* WT, LAS float* scr, int item, int lane) {
    const int nblk = N / 32, kb = item / nblk, nb = item % nblk, k0 = 64 * kb, n0 = 32 * nb;
    const int ncol = PERMUTE ? sigma_col(n0 + (lane & 31)) : n0 + (lane & 31);
#pragma unroll 8
    for (int i = 0; i < 32; ++i) { const int kk = 2 * i + (lane >> 5); float s = scale ? scale[k0 + kk] : 1.f; scr[kk * 33 + (lane & 31)] = W[(size_t)(k0 + kk) * N + ncol] * s; }
    asm volatile("s_waitcnt lgkmcnt(0)" ::: "memory");
    const int c = lane & 7;
#pragma unroll
    for (int j = 0; j < 4; ++j) { const int n = (lane >> 3) + 8 * j; const LAS float* s = scr + (8 * c) * 33 + n;
        u32x4 o; o.x = cvtpk(s[0 * 33], s[1 * 33]); o.y = cvtpk(s[2 * 33], s[3 * 33]); o.z = cvtpk(s[4 * 33], s[5 * 33]); o.w = cvtpk(s[6 * 33], s[7 * 33]);
        *(u32x4*)(WT + (size_t)(n0 + n) * K + k0 + 8 * c) = o; }
    asm volatile("s_waitcnt lgkmcnt(0)" ::: "memory");
}

DI unsigned fp4_code(float x, float sc) {
    const float a = fabsf(x) * sc;
    const unsigned idx = (unsigned)(a > 0.25f) + (unsigned)(a > 0.75f) + (unsigned)(a > 1.25f) + (unsigned)(a > 1.75f) + (unsigned)(a > 2.5f) + (unsigned)(a > 3.5f) + (unsigned)(a > 5.0f);
    return idx | (x < 0.f ? 8u : 0u);
}
template <int CTRL> DI float dpp_f(float v) { return __builtin_bit_cast(float, __builtin_amdgcn_update_dpp(0, __builtin_bit_cast(int, v), CTRL, 0xf, 0xf, false)); }
DI float row16_max(float v) { v = fmaxf(v, dpp_f<0x128>(v)); v = fmaxf(v, dpp_f<0x124>(v)); v = fmaxf(v, dpp_f<0x122>(v)); v = fmaxf(v, dpp_f<0x121>(v)); return v; }
DI float row16_sum(float v) { v += dpp_f<0x128>(v); v += dpp_f<0x124>(v); v += dpp_f<0x122>(v); v += dpp_f<0x121>(v); return v; }
DI float readlane_f(float v, int l) { return __builtin_bit_cast(float, __builtin_amdgcn_readlane(__builtin_bit_cast(int, v), l)); }
DI void table_row_load(const Params& P, int r, int lane, f32x4 (&v)[4]) {
    const bool isv = r >= NEXP; const int e = isv ? r - NEXP : r;
    const f32x4* src = (const f32x4*)((isv ? P.pv : P.pu) + (size_t)e * DM) + lane;
#pragma unroll
    for (int q = 0; q < 4; ++q) v[q] = src[64 * q];
}
DI void table_row_finish(const Params& P, int r, int lane, const f32x4 (&v)[4]) {
    unsigned char* ws = P.ws;
    const bool isv = r >= NEXP; const int e = isv ? r - NEXP : r;
    unsigned char* tb = ws + (isv ? WS_VB : WS_UB); float* scp = (float*)(ws + (isv ? WS_VSC : WS_USC));
    f32x4 isc;
#pragma unroll
    for (int q = 0; q < 4; ++q) {
        float am = fmaxf(fmaxf(fabsf(v[q].x), fabsf(v[q].y)), fmaxf(fabsf(v[q].z), fabsf(v[q].w)));
        am = row16_max(am); am = fmaxf(fmaxf(readlane_f(am, 0), readlane_f(am, 16)), fmaxf(readlane_f(am, 32), readlane_f(am, 48)));
        const float sc = (am > 0.f) ? 6.f / am : 1.f;
        unsigned w = __builtin_amdgcn_cvt_scalef32_pk_fp4_f32(0u, v[q].x * sc, v[q].y * sc, 1.0f, 0); w = __builtin_amdgcn_cvt_scalef32_pk_fp4_f32(w, v[q].z * sc, v[q].w * sc, 1.0f, 1);
        *(unsigned short*)(tb + ((size_t)q * NEXP + e) * 128 + 2 * lane) = (unsigned short)w;
        isc[q] = 1.f / sc;
    }
    if (lane == 0) *(f32x4*)(scp + (size_t)e * 4) = isc;
}
DI void table_fp8_rows(const Params& P, int first, int stride, int r_end) {
    const int lane = tid_() & 63;
    f32x4 a[4], b[4];
    int r = first;
    if (r < r_end) table_row_load(P, r, lane, a);
    for (; r < r_end; r += stride) {
        const int rn = r + stride;
        if (rn < r_end) table_row_load(P, rn, lane, b);
        table_row_finish(P, r, lane, a);
#pragma unroll
        for (int q = 0; q < 4; ++q) a[q] = b[q];
    }
}

__device__ const double ROPE_INV[32] = {
    1.0, 0.7498942093324559, 0.5623413251903491, 0.4216965034285822, 0.31622776601683794, 0.23713737056616552, 0.1778279410038923, 0.1333521432163324,
    0.1, 0.07498942093324558, 0.05623413251903491, 0.042169650342858224, 0.03162277660168379, 0.023713737056616554, 0.01778279410038923, 0.01333521432163324,
    0.01, 0.007498942093324558, 0.005623413251903491, 0.004216965034285823, 0.0031622776601683794, 0.0023713737056616554, 0.0017782794100389228, 0.001333521432163324,
    0.001, 0.0007498942093324559, 0.0005623413251903491, 0.00042169650342858224, 0.00031622776601683794, 0.00023713737056616554, 0.00017782794100389227, 0.0001333521432163324};
DI void p0_row_load(const Params& P, int m, int lane, f32x4 (&v)[4]) {
    if (m >= NTOK + NMETA) {
#pragma unroll
        for (int j = 0; j < 4; ++j) v[j] = (f32x4){0.f, 0.f, 0.f, 0.f};
        return; }
    const float* xrow = (m < NTOK) ? P.x + (size_t)m * DM : P.meta + (size_t)(m - NTOK) * DM;
    const f32x4* xr = (const f32x4*)xrow + lane;
#pragma unroll
    for (int j = 0; j < 4; ++j) v[j] = xr[64 * j];
}
DI void p0_row_finish(unsigned char* ws, int m, int lane, const f32x4 (&v)[4]) {
    unsigned long long* o8 = (unsigned long long*)((bf16_t*)(ws + WS_XB) + (size_t)m * DM) + lane;
    float s = 0.f;
#pragma unroll
    for (int j = 0; j < 4; ++j) s += (v[j].x * v[j].x + v[j].y * v[j].y) + (v[j].z * v[j].z + v[j].w * v[j].w);
    s = wave_sum(s);
    if (lane == 0) ((float*)(ws + WS_R1))[m] = (m >= NTOK + NMETA) ? 0.f : 1.f / sqrtf(s * (1.f / DM) + EPS);
#pragma unroll
    for (int j = 0; j < 4; ++j) o8[64 * j] = (unsigned long long)cvtpk(v[j].x, v[j].y) | ((unsigned long long)cvtpk(v[j].z, v[j].w) << 32);
}
DI void phase0(const Params& P, char* lds, int bid, int nblk) {
    const int tid = tid_(), lane = tid & 63, wave = __builtin_amdgcn_readfirstlane(tid >> 6);
    unsigned char* ws = P.ws;
    LAS float* scr = (LAS float*)(lds) + wave * (64 * 33);
    const int gw = bid * NWAVES + wave, NGW = nblk * NWAVES;
    constexpr int I1 = (DM / 64) * (NCOL1 / 32), I2 = (DM / 64) * (DM / 32), I3 = (DM / 64) * (2048 / 32);
    for (int it = gw; it < I1 + I2 + I3; it += NGW) {
        int r = it;
        if (r < I1) { p0_transpose_item<true>(P.w_in, DM, NCOL1, P.mix_norm_w, (bf16_t*)(ws + WS_W1T), scr, r, lane); continue; } r -= I1;
        if (r < I2) { p0_transpose_item<false>(P.w_out, DM, DM, nullptr, (bf16_t*)(ws + WS_W2T), scr, r, lane); continue; } r -= I2;
        p0_transpose_item<false>(P.wq, DM, 2048, P.ffn_norm_w, (bf16_t*)(ws + WS_W3T), scr, r, lane);
    }
    {
        f32x4 va[4], vb[4];
        int m = gw;
        if (m < M1) p0_row_load(P, m, lane, va);
        for (; m < M1; m += NGW) {
            const int mn = m + NGW;
            if (mn < M1) p0_row_load(P, mn, lane, vb);
            p0_row_finish(ws, m, lane, va);
#pragma unroll
            for (int j = 0; j < 4; ++j) va[j] = vb[j];
        }
    }
    table_fp8_rows(P, gw, NGW, NEXP);
    {
        const size_t gt = (size_t)bid * NTHREADS + tid, NGT = (size_t)nblk * NTHREADS;
        const size_t ns = (size_t)16 * 128 * 128 / 8;
        for (size_t e = gt; e < ns; e += NGT) {
            const f32x4 a = ((const f32x4*)P.subkeys)[2 * e], b = ((const f32x4*)P.subkeys)[2 * e + 1];
            u32x4 o; o.x = cvtpk(a.x, a.y); o.y = cvtpk(a.z, a.w); o.z = cvtpk(b.x, b.y); o.w = cvtpk(b.z, b.w);
            ((u32x4*)(ws + WS_SKB))[e] = o;
        }
        float* rope = (float*)(ws + WS_ROPE);
        for (size_t i = gt; i < (size_t)TPOS * 32; i += NGT) {
            const int t = (int)(i >> 5), f = (int)(i & 31);
            const double rev = (double)t * ROPE_INV[f] * 0.15915494309189535;
            const float ang = (float)((rev - __builtin_rint(rev)) * 6.283185307179586);
            rope[(size_t)t * 64 + f] = cosf(ang); rope[(size_t)t * 64 + 32 + f] = sinf(ang);
        }
        float* ssq = (float*)(ws + WS_SSQ);
        for (size_t i = gt; i < (size_t)2 * NTOK; i += NGT) ssq[i] = 0.f;
        for (size_t i = gt; i < (size_t)BATCH * 4 * 2 * 512; i += NGT) { const size_t img = i >> 9, o = i & 511; ((u32x4*)(ws + WS_K + img * KT * 8192))[o] = (u32x4){0u, 0u, 0u, 0u}; }
        for (size_t i = gt; i < (size_t)BATCH * 4 * 1024; i += NGT) { const size_t img = i >> 10, o = i & 1023; ((u32x4*)(ws + WS_V + img * KT * 16384))[o] = (u32x4){0u, 0u, 0u, 0u}; }
        for (size_t i = gt; i < (size_t)BATCH * 4 * 16 * 16; i += NGT) { const size_t bh = i >> 8, o = i & 255;
            ((u32x4*)(ws + WS_HQ + bh * HT * 256))[o] = (u32x4){0u, 0u, 0u, 0u}; ((u32x4*)(ws + WS_HV + bh * HT * 256))[o] = (u32x4){0u, 0u, 0u, 0u}; }
        for (size_t i = gt; i < (size_t)BATCH * 4 * 16 * 32; i += NGT) { const size_t bh = i >> 9, o = i & 511; ((u32x4*)(ws + WS_HG + bh * HT * 512))[o] = (u32x4){0u, 0u, 0u, 0u}; }
        float* lb = (float*)(ws + WS_LB);
        if (gt < 512) lb[gt] = sigmoidf_(P.lb_logits[gt] - P.lb_logits[512 + gt]);
        if (bid == 0 && wave == 0) {
            const float a = wave_sum(P.lq1[lane] * P.lk1[lane]), b = wave_sum(P.lq2[lane] * P.lk2[lane]);
            if (lane == 0) lb[512] = __expf(a) - __expf(b) + LAM_INIT;
        }
    }
}

namespace pg8 {
#define PG8_LAS __attribute__((address_space(3)))
typedef unsigned short bf16_t;
typedef short bf16x8 __attribute__((ext_vector_type(8)));
typedef float f32x4 __attribute__((ext_vector_type(4)));
typedef unsigned u32x4 __attribute__((ext_vector_type(4)));
constexpr int BM = 256, BK = 64, HALF = 128, HTB = HALF * BK * 2  , STAGE_BYTES = 8 * HTB, NXCD = 8, WGM = 8;

__host__ __device__ __forceinline__ int lds_byte(int r, int c) { const int st = (r >> 4) * 2 + (c >> 5), rr = r & 15, cc = c & 31, ob = rr * 64 + cc * 2; return st * 1024 + (ob ^ (((ob >> 9) & 1) << 5)); }
__host__ __device__ __forceinline__ void stage_rc(int b, int& R, int& C) { const int st = b / 1024, sb = b % 1024, swz = sb ^ (((sb >> 9) & 1) << 5); R = (st >> 1) * 16 + swz / 64; C = (st & 1) * 32 + (swz % 64) / 2; }
__host__ __device__ __forceinline__ int perm32(int rho) { const int n = rho >> 4, i = rho & 15; return 8 * (i >> 2) + 4 * n + (i & 3); }

struct Unit { int pm, pn; };
struct Gemm { const bf16_t* A; const bf16_t* Bt; int M, N, K; };

struct StaticOrder {
    int nM, nN, nwg, G, c;
    __host__ __device__ void init(int M, int N, int G_, int c_) { nM = M / BM; nN = N / BM; nwg = nM * nN; G = G_; c = c_; }
    __host__ __device__ bool next(int i, Unit& u) const {
        const long L = (long)i * G + c; if (L >= nwg) return false;
        int wgid = (int)L; { const int q = nwg / NXCD, r = nwg % NXCD, xcd = wgid % NXCD, off = wgid / NXCD; wgid = (xcd < r ? xcd * (q + 1) : r * (q + 1) + (xcd - r) * q) + off; }
        const int nig = WGM * nN, gid = wgid / nig, fm = gid * WGM, gsz = (nM - fm) < WGM ? (nM - fm) : WGM;
        u.pm = fm + ((wgid % nig) % gsz); u.pn = (wgid % nig) / gsz; return true;
    }
    __device__ __forceinline__ void a_ready(const Unit&) const {}
    __device__ __forceinline__ void done(const Unit&) const {}
};

template <class Epi, class Sched, bool ALIGN_EPI = false, bool SP2 = false>
__device__ __forceinline__ void gemm_phase(PG8_LAS unsigned char* lds, const Gemm g, const Sched& S, const Epi& E) {
    const int tid = tid_(), wid = __builtin_amdgcn_readfirstlane(tid >> 6), lane = tid & 63, wr = wid >> 2, wc = wid & 3, fr = lane & 15, fq = lane >> 4;
    const int K = g.K, nt = K / BK;
    unsigned voffA[2], voffB[2];
#pragma unroll
    for (int i = 0; i < 2; ++i) { int R, C; stage_rc(tid * 16 + i * 8192, R, C); const int Rb = Epi::PERM ? ((R & ~31) + perm32(R & 31)) : R;
        voffA[i] = (unsigned)(R * K + C) * 2u; voffB[i] = (unsigned)(Rb * K + C) * 2u; }
    const size_t kstep = (size_t)(BK * 2);
    const size_t hstep = (size_t)HALF * K * 2;
    const size_t tstep = 2 * hstep;
    const unsigned ldsw = (unsigned)wid * 1024u;
    const int aoff = lds_byte(wr * 64 + fr, fq * 8), boff = lds_byte(wc * 32 + fr, fq * 8);
#define PG8_SA(b, h) (((b) * 2 + (h)) * HTB)
#define PG8_SB(b, h) ((4 + (b) * 2 + (h)) * HTB)
#define PG8_STAGE(bufoff, gbase, voff) do { _Pragma("unroll") for (int _i = 0; _i < 2; ++_i) \
        __builtin_amdgcn_global_load_lds((const unsigned*)((const char*)(gbase) + (voff)[_i]), (PG8_LAS unsigned*)(lds + (bufoff) + ldsw + _i * 8192), 16, 0, 0); } while (0)
#define PG8_LDA(dst, b, h) do { _Pragma("unroll") for (int m = 0; m < 4; ++m) _Pragma("unroll") for (int k = 0; k < 2; ++k) dst[m][k] = *(const PG8_LAS bf16x8*)(lds + PG8_SA(b, h) + aoff + m * 2048 + k * 1024); } while (0)
#define PG8_LDB(dst, b, h) do { _Pragma("unroll") for (int n = 0; n < 2; ++n) _Pragma("unroll") for (int k = 0; k < 2; ++k) dst[n][k] = *(const PG8_LAS bf16x8*)(lds + PG8_SB(b, h) + boff + n * 2048 + k * 1024); } while (0)
#define PG8_MMA(ai, bj, At, Bt) do { __builtin_amdgcn_s_setprio(1); _Pragma("unroll") for (int m = 0; m < 4; ++m) _Pragma("unroll") for (int n = 0; n < 2; ++n) _Pragma("unroll") for (int k = 0; k < 2; ++k) \
        acc[ai][bj][m][n] = __builtin_amdgcn_mfma_f32_16x16x32_bf16(Bt[n][k], At[m][k], acc[ai][bj][m][n], 0, 0, 0); __builtin_amdgcn_s_setprio(0); } while (0)
#define PG8_WAIT_V(n) asm volatile("s_waitcnt vmcnt(" #n ")" ::: "memory")
#define PG8_WAIT_L(n) asm volatile("s_waitcnt lgkmcnt(" #n ")" ::: "memory")
#define PG8_BAR __builtin_amdgcn_s_barrier()
#define PG8_SCHED __builtin_amdgcn_sched_barrier(0)
    Unit cur, nxt; int ui = 0;
    if (!S.next(0, cur)) return;
    f32x4 acc[2][2][4][2];
#pragma unroll
    for (int a = 0; a < 2; ++a)
#pragma unroll
        for (int b = 0; b < 2; ++b)
#pragma unroll
            for (int m = 0; m < 4; ++m)
#pragma unroll
                for (int n = 0; n < 2; ++n) acc[a][b][m][n] = (f32x4){0.f, 0.f, 0.f, 0.f};
    bf16x8 At[4][2], B0[2][2], B1[2][2];
    const char* cA = (const char*)g.A + (size_t)cur.pm * tstep; const char* cB = (const char*)g.Bt + (size_t)cur.pn * tstep;
    S.a_ready(cur);
    if constexpr (SP2) {
        PG8_STAGE(PG8_SB(0, 0), cB, voffB); PG8_STAGE(PG8_SB(0, 1), cB + hstep, voffB); PG8_STAGE(PG8_SA(0, 0), cA, voffA); PG8_STAGE(PG8_SA(0, 1), cA + hstep, voffA);
        if (wr == 1) PG8_BAR;
        PG8_WAIT_V(2); PG8_BAR;
        PG8_STAGE(PG8_SB(1, 0), cB + kstep, voffB); PG8_STAGE(PG8_SA(1, 0), cA + kstep, voffA); PG8_STAGE(PG8_SB(1, 1), cB + hstep + kstep, voffB);
        PG8_WAIT_V(6); PG8_BAR;
    } else {
        PG8_STAGE(PG8_SB(0, 0), cB, voffB); PG8_STAGE(PG8_SA(0, 0), cA, voffA); PG8_STAGE(PG8_SB(0, 1), cB + hstep, voffB); PG8_STAGE(PG8_SA(0, 1), cA + hstep, voffA);
        if (wr == 1) PG8_BAR;
        PG8_WAIT_V(4); PG8_BAR;
        PG8_STAGE(PG8_SB(1, 0), cB + kstep, voffB); PG8_STAGE(PG8_SA(1, 0), cA + kstep, voffA); PG8_STAGE(PG8_SB(1, 1), cB + hstep + kstep, voffB);
        PG8_WAIT_V(6); PG8_BAR;
    }
    for (;;) {
        const bool has_next = S.next(ui + 1, nxt);
        const char* nA = has_next ? (const char*)g.A + (size_t)nxt.pm * tstep : cA; const char* nB = has_next ? (const char*)g.Bt + (size_t)nxt.pn * tstep : cB;
        for (int t = 0; t < nt; t += 2) {
            const bool last = (t == nt - 2);
            const char* a1 = cA + (size_t)(t + 1) * kstep;
            const char* a2 = last ? nA : cA + (size_t)(t + 2) * kstep; const char* b2 = last ? nB : cB + (size_t)(t + 2) * kstep;
            const char* a3 = a2 + kstep; const char* b3 = b2 + kstep;
            if (last && has_next) S.a_ready(nxt);
            if constexpr (SP2) {
            PG8_LDB(B0, 0, 0); PG8_LDB(B1, 0, 1); PG8_SCHED; PG8_LDA(At, 0, 0); PG8_STAGE(PG8_SA(1, 1), a1 + hstep, voffA);
            PG8_WAIT_V(8); PG8_WAIT_L(0); PG8_BAR; PG8_MMA(0, 0, At, B0); PG8_MMA(0, 1, At, B1); PG8_BAR; PG8_SCHED;
            PG8_LDA(At, 0, 1); PG8_STAGE(PG8_SB(0, 0), b2, voffB); PG8_STAGE(PG8_SB(0, 1), b2 + hstep, voffB); PG8_STAGE(PG8_SA(0, 0), a2, voffA);
            PG8_WAIT_V(8); PG8_WAIT_L(0); PG8_BAR; PG8_MMA(1, 0, At, B0); PG8_MMA(1, 1, At, B1); PG8_BAR; PG8_SCHED;
            PG8_LDB(B0, 1, 0); PG8_LDB(B1, 1, 1); PG8_SCHED; PG8_LDA(At, 1, 0); PG8_STAGE(PG8_SA(0, 1), a2 + hstep, voffA);
            PG8_WAIT_V(8); PG8_WAIT_L(0); PG8_BAR; PG8_MMA(0, 0, At, B0); PG8_MMA(0, 1, At, B1); PG8_BAR; PG8_SCHED;
            PG8_LDA(At, 1, 1); PG8_STAGE(PG8_SB(1, 0), b3, voffB); PG8_STAGE(PG8_SB(1, 1), b3 + hstep, voffB); PG8_STAGE(PG8_SA(1, 0), a3, voffA);
            PG8_WAIT_V(8); PG8_WAIT_L(0); PG8_BAR; PG8_MMA(1, 0, At, B0); PG8_MMA(1, 1, At, B1); PG8_BAR; PG8_SCHED;
            } else {
            PG8_LDB(B0, 0, 0); PG8_SCHED; PG8_LDA(At, 0, 0); PG8_STAGE(PG8_SA(1, 1), a1 + hstep, voffA);
            PG8_WAIT_L(8); PG8_BAR; PG8_WAIT_L(0); PG8_MMA(0, 0, At, B0); PG8_BAR; PG8_SCHED;
            PG8_LDB(B1, 0, 1); PG8_STAGE(PG8_SB(0, 0), b2, voffB);
            PG8_BAR; PG8_WAIT_L(0); PG8_MMA(0, 1, At, B1); PG8_BAR;
            PG8_LDA(At, 0, 1); PG8_STAGE(PG8_SA(0, 0), a2, voffA);
            PG8_BAR; PG8_WAIT_L(0); PG8_MMA(1, 0, At, B0); PG8_BAR; PG8_SCHED;
            PG8_STAGE(PG8_SB(0, 1), b2 + hstep, voffB);
            PG8_WAIT_V(6); PG8_BAR; PG8_MMA(1, 1, At, B1); PG8_BAR;
            PG8_LDB(B0, 1, 0); PG8_SCHED; PG8_LDA(At, 1, 0); PG8_STAGE(PG8_SA(0, 1), a2 + hstep, voffA);
            PG8_WAIT_L(8); PG8_BAR; PG8_WAIT_L(0); PG8_MMA(0, 0, At, B0); PG8_BAR; PG8_SCHED;
            PG8_LDB(B1, 1, 1); PG8_STAGE(PG8_SB(1, 0), b3, voffB);
            PG8_BAR; PG8_WAIT_L(0); PG8_MMA(0, 1, At, B1); PG8_BAR;
            PG8_LDA(At, 1, 1); PG8_STAGE(PG8_SA(1, 0), a3, voffA);
            PG8_BAR; PG8_WAIT_L(0); PG8_MMA(1, 0, At, B0); PG8_BAR; PG8_SCHED;
            PG8_STAGE(PG8_SB(1, 1), b3 + hstep, voffB);
            PG8_WAIT_V(6); PG8_BAR; PG8_MMA(1, 1, At, B1); PG8_BAR;
            }
        }
        if constexpr (ALIGN_EPI) { if (wr == 0) PG8_BAR; }
        if constexpr (!Epi::AFTER_DRAIN) { E(acc, cur, wr, wc, fr, fq); S.done(cur); }
        if (!has_next) break;
#pragma unroll
        for (int a = 0; a < 2; ++a)
#pragma unroll
            for (int b = 0; b < 2; ++b)
#pragma unroll
                for (int m = 0; m < 4; ++m)
#pragma unroll
                    for (int n = 0; n < 2; ++n) acc[a][b][m][n] = (f32x4){0.f, 0.f, 0.f, 0.f};
        cur = nxt; cA = nA; cB = nB; ++ui;
        if constexpr (ALIGN_EPI) { if (wr == 1) PG8_BAR; }
    }
    PG8_WAIT_V(0);
    if constexpr (!ALIGN_EPI) { if (wr == 0) PG8_BAR; }
    PG8_BAR;
    if constexpr (Epi::AFTER_DRAIN) { E.fused(acc, cur, wr, wc, fr, fq, lds, wid, lane); S.done(cur); }
#undef PG8_SA
#undef PG8_SB
#undef PG8_STAGE
#undef PG8_LDA
#undef PG8_LDB
#undef PG8_MMA
#undef PG8_WAIT_V
#undef PG8_WAIT_L
#undef PG8_BAR
#undef PG8_SCHED
}
}

DI u32x2 pack4(f32x4 v) { u32x2 r; r.x = cvtpk(v.x, v.y); r.y = cvtpk(v.z, v.w); return r; }
DI u32x4 pack8(f32x4 a, f32x4 b) { u32x4 r; r.x = cvtpk(a.x, a.y); r.y = cvtpk(a.z, a.w); r.z = cvtpk(b.x, b.y); r.w = cvtpk(b.z, b.w); return r; }

struct Epi1 {
    static constexpr bool PERM = true, AFTER_DRAIN = false;
    unsigned char* ws;
    DI void operator()(const f32x4 (&acc)[2][2][4][2], const pg8::Unit& u, int wr, int wc, int fr, int fq) const {
        const float* r1p = (const float*)(ws + WS_R1);
        const float* rope = (const float*)(ws + WS_ROPE);
        const float* lbp = (const float*)(ws + WS_LB);
        const int seg = u.pn >> 1;
#pragma unroll
        for (int ai = 0; ai < 2; ++ai)
#pragma unroll
            for (int m = 0; m < 4; ++m) {
                const int row = u.pm * 256 + ai * 128 + wr * 64 + m * 16 + fr;
                const bool meta = row >= NTOK;
                if (row >= NTOK + NMETA) continue;
                const float r1 = r1p[row];
                const int b = meta ? 0 : (row >> 12), t = meta ? (row - NTOK) : ((row & 4095) + NMETA);
                const int nrep = meta ? BATCH : 1;
#pragma unroll
                for (int bj = 0; bj < 2; ++bj) {
                    const int cs = (u.pn & 1) * 256 + bj * 128 + wc * 32 + 8 * fq;
                    const f32x4 v0 = acc[ai][bj][m][0] * r1, v1 = acc[ai][bj][m][1] * r1;
                    const int h = cs >> 7;
                    if (seg <= 1) {
                        const int comp = (cs >> 6) & 1, cc = cs & 63, i0 = 16 * (cc >> 5) + 4 * fq;
                        const f32x4 c4 = *(const f32x4*)(rope + (size_t)t * 64 + i0), s4 = *(const f32x4*)(rope + (size_t)t * 64 + 32 + i0);
                        f32x4 lo = v0 * c4 - v1 * s4, hi = v1 * c4 + v0 * s4;
                        if (seg == 0) {
                            if (meta) continue;
                            lo = lo * QSCALE; hi = hi * QSCALE;
                            bf16_t* qp = (bf16_t*)(ws + WS_Q) + ((size_t)(((b * 4 + h) * 2 + comp) * SEQ + (row & 4095))) * 64;
                            *(u32x2*)(qp + i0) = pack4(lo); *(u32x2*)(qp + i0 + 32) = pack4(hi);
                        } else {
                            const int pp = t + KPAD, tile = pp >> 6, key = pp & 63;
                            for (int bb = 0; bb < nrep; ++bb) {
                                const int b_ = meta ? bb : b;
                                unsigned char* img = ws + WS_K + ((size_t)((b_ * 4 + h) * 2 + comp) * KT + tile) * 8192;
                                *(u32x2*)(img + (i0 >> 3) * 1024 + key * 16 + (i0 & 7) * 2) = pack4(lo);
                                *(u32x2*)(img + ((i0 >> 3) + 4) * 1024 + key * 16 + (i0 & 7) * 2) = pack4(hi);
                            }
                        }
                    } else if (seg == 2) {
                        const int dv = cs & 127, pp = t + KPAD, tile = pp >> 6, key = pp & 63;
                        const u32x4 w = pack8(v0, v1);
                        for (int bb = 0; bb < nrep; ++bb) {
                            const int b_ = meta ? bb : b;
                            unsigned char* img = ws + WS_V + ((size_t)(b_ * 4 + h) * KT + tile) * 16384;
                            *(u32x4*)(img + (dv >> 5) * 4096 + key * 64 + (dv & 31) * 2) = w;
                        }
                    } else if (seg == 3 || seg == 5) {
                        const int dv = cs & 127;
                        f32x4 a = v0, c = v1;
                        if (seg == 3) { a.x = siluf_(a.x); a.y = siluf_(a.y); a.z = siluf_(a.z); a.w = siluf_(a.w); c.x = siluf_(c.x); c.y = siluf_(c.y); c.z = siluf_(c.z); c.w = siluf_(c.w); }
                        const u32x4 w = pack8(a, c);
                        const size_t base = (seg == 3) ? WS_HQ : WS_HV;
                        for (int bb = 0; bb < nrep; ++bb) {
                            const int b_ = meta ? bb : b;
                            *(u32x4*)((bf16_t*)(ws + base) + ((size_t)(b_ * 4 + h) * HT + t + 16) * 128 + dv) = w;
                        }
                    } else if (seg == 4) {
                        const int dv = cs & 127;
                        const f32x4 l0 = *(const f32x4*)(lbp + cs), l1 = *(const f32x4*)(lbp + cs + 4);
                        f32x4 g0, g1;
#pragma unroll
                        for (int e = 0; e < 4; ++e) { g0[e] = __logf(l0[e] + (1.f - l0[e]) * sigmoidf_(v0[e])); g1[e] = __logf(l1[e] + (1.f - l1[e]) * sigmoidf_(v1[e])); }
                        for (int bb = 0; bb < nrep; ++bb) {
                            const int b_ = meta ? bb : b;
                            float* gp = (float*)(ws + WS_HG) + ((size_t)(b_ * 4 + h) * HT + t + 16) * 128 + dv;
                            *(f32x4*)gp = g0; *(f32x4*)(gp + 4) = g1;
                        }
                    } else {
                        if (meta) continue;
                        f32x4 a = v0, c = v1;
                        a.x = siluf_(a.x); a.y = siluf_(a.y); a.z = siluf_(a.z); a.w = siluf_(a.w); c.x = siluf_(c.x); c.y = siluf_(c.y); c.z = siluf_(c.z); c.w = siluf_(c.w);
                        *(u32x4*)((bf16_t*)(ws + WS_SG) + (size_t)row * 512 + cs) = pack8(a, c);
                    }
                }
            }
    }
};

struct Epi3 {
    static constexpr bool PERM = true, AFTER_DRAIN = false;
    const float* x; float* H; bf16_t* HB; float* ssq;
    DI void operator()(const f32x4 (&acc)[2][2][4][2], const pg8::Unit& u, int wr, int wc, int fr, int fq) const {
#pragma unroll
        for (int ai = 0; ai < 2; ++ai)
#pragma unroll
            for (int m = 0; m < 4; ++m) {
                const int row = u.pm * 256 + ai * 128 + wr * 64 + m * 16 + fr;
                float s = 0.f;
#pragma unroll
                for (int bj = 0; bj < 2; ++bj) {
                    const int col = u.pn * 256 + bj * 128 + wc * 32 + 8 * fq;
                    const size_t o = (size_t)row * DM + col;
                    const u32x4 xb = *(const u32x4*)(HB + o);
                    const f32x4 x0 = (f32x4){bf2f(xb.x & 0xffffu), bf2f(xb.x >> 16), bf2f(xb.y & 0xffffu), bf2f(xb.y >> 16)}, x1 = (f32x4){bf2f(xb.z & 0xffffu), bf2f(xb.z >> 16), bf2f(xb.w & 0xffffu), bf2f(xb.w >> 16)};
                    const f32x4 h0 = x0 + acc[ai][bj][m][0], h1 = x1 + acc[ai][bj][m][1];
                    *(u32x4*)(HB + o) = pack8(h0, h1);
                    s += (h0.x * h0.x + h0.y * h0.y) + (h0.z * h0.z + h0.w * h0.w) + (h1.x * h1.x + h1.y * h1.y) + (h1.z * h1.z + h1.w * h1.w);
                }
                s += __shfl_xor(s, 16); s += __shfl_xor(s, 32);
                if (fq == 0) atomicAdd(ssq + row, s);
            }
    }
};

struct Epi4 {
    static constexpr bool PERM = true, AFTER_DRAIN = false;
    const float* ssq; bf16_t* PQ;
    DI void operator()(const f32x4 (&acc)[2][2][4][2], const pg8::Unit& u, int wr, int wc, int fr, int fq) const {
#pragma unroll
        for (int ai = 0; ai < 2; ++ai)
#pragma unroll
            for (int m = 0; m < 4; ++m) {
                const int row = u.pm * 256 + ai * 128 + wr * 64 + m * 16 + fr;
                const float r2 = 1.f / sqrtf(ssq[row] * (1.f / DM) + EPS);
#pragma unroll
                for (int bj = 0; bj < 2; ++bj) {
                    const int col = u.pn * 256 + bj * 128 + wc * 32 + 8 * fq;
                    *(u32x4*)(PQ + (size_t)row * 2048 + col) = pack8(acc[ai][bj][m][0] * r2, acc[ai][bj][m][1] * r2);
                }
            }
    }
};

template <class Epi>
DI void gemm_run(char* lds, const bf16_t* A, const bf16_t* Bt, int M, int N, int K, const Epi& E, int bid, int nblk) {
    pg8::Gemm g{A, Bt, M, N, K}; pg8::StaticOrder S; S.init(M, N, nblk, bid);
    pg8::gemm_phase<Epi, pg8::StaticOrder, true, true>((LAS unsigned char*)lds, g, S, E);
}
#define MFMA32(a, b, c) __builtin_amdgcn_mfma_f32_32x32x16_bf16(a, b, c, 0, 0, 0)
typedef short v4i16_t __attribute__((ext_vector_type(4)));
DI int crow(int r, int hi) { return (r & 3) + 8 * (r >> 2) + 4 * hi; }
DI s16x4 vtr(const LAS char* p) { return __builtin_bit_cast(s16x4, __builtin_amdgcn_ds_read_tr16_b64_v4i16((LAS v4i16_t*)p)); }
DI void glds16(const void* g, LAS char* l) { __builtin_amdgcn_global_load_lds((const unsigned*)g, (LAS unsigned*)l, 16, 0, 0); }
DI float swap_max(float m) { auto rr = __builtin_amdgcn_permlane32_swap(__float_as_uint(m), __float_as_uint(m), false, false); return fmaxf(__uint_as_float(rr[0]), __uint_as_float(rr[1])); }
DI float swap_sum(float m) { auto rr = __builtin_amdgcn_permlane32_swap(__float_as_uint(m), __float_as_uint(m), false, false); return __uint_as_float(rr[0]) + __uint_as_float(rr[1]); }
constexpr int ATT_BUF = 32768, ATT_WSF = 65536;
constexpr float ATT_THR = 8.f;

DI void attn_unit(const Params& P, int b, int h, int j, char* lds_g) {
    LAS char* lds = (LAS char*)lds_g;
    const int tid = tid_(), lane = tid & 63, r32 = lane & 31, hi = lane >> 5;
    const int wid = __builtin_amdgcn_readfirstlane(tid >> 6), comp = wid >> 2, wq = wid & 3;
    const unsigned char* ws = P.ws;
    const int bh = b * 4 + h;
    const bf16_t* Qw = (const bf16_t*)(ws + WS_Q) + ((size_t)((bh * 2 + comp) * SEQ + 128 * j + 32 * wq)) * 64;
    bf16x8 qr[4];
#pragma unroll
    for (int d0 = 0; d0 < 4; ++d0) qr[d0] = *(const bf16x8*)(Qw + r32 * 64 + d0 * 16 + hi * 8);
    const unsigned char* kimg0 = ws + WS_K + (size_t)(bh * 2) * KT * 8192 + wid * 1024 + lane * 16;
    const unsigned char* kimg1 = kimg0 + (size_t)KT * 8192;
    const unsigned char* vimg = ws + WS_V + (size_t)bh * KT * 16384 + wid * 1024 + lane * 16;
    const int NT = 2 * j + 3, my_last = (wq < 2) ? 2 * j + 1 : 2 * j + 2;
    LAS float* wsf = (LAS float*)(lds + ATT_WSF) + wid * 64;
#define ATT_ISSUE(t, s) do { LAS char* d_ = lds + (s) * ATT_BUF + wid * 1024; \
        glds16(kimg0 + (size_t)(t) * 8192, d_); glds16(kimg1 + (size_t)(t) * 8192, d_ + 8192); \
        glds16(vimg + (size_t)(t) * 16384, d_ + 16384); glds16(vimg + (size_t)(t) * 16384 + 8192, d_ + 24576); } while (0)
    f32x16 o[4];
#pragma unroll
    for (int nb = 0; nb < 4; ++nb) o[nb] = f32x16{};
    float mref = 0.f, lsum = 0.f;
    f32x16 mv = f32x16{};
    const int qpos = 64 + 128 * j + 32 * wq + r32;
    ATT_ISSUE(0, 0);
    __syncthreads();
    for (int t = 0; t < NT; ++t) {
        const int s = t & 1;
        if (t + 1 < NT) ATT_ISSUE(t + 1, s ^ 1);
        if (t <= my_last) {
            const LAS char* kp = lds + s * ATT_BUF + comp * 8192 + hi * 1024 + r32 * 16;
            asm volatile("" : "+v"(mv));
            f32x16 s0, s1;
#pragma unroll
            for (int d0 = 0; d0 < 4; ++d0) {
                const bf16x8 k0 = *(const LAS bf16x8*)(kp + d0 * 2048), k1 = *(const LAS bf16x8*)(kp + d0 * 2048 + 512);
                if (d0 == 0) { s0 = MFMA32(k0, qr[d0], mv); s1 = MFMA32(k1, qr[d0], mv); }
                else { s0 = MFMA32(k0, qr[d0], s0); s1 = MFMA32(k1, qr[d0], s1); }
            }
            if (t == 0 || t >= 2 * j + 1) {
                const int kb = 64 * t + 4 * hi - KPAD; const unsigned lim = (unsigned)(qpos - KPAD);
#pragma unroll
                for (int r = 0; r < 16; ++r) { const int kv = kb + (r & 3) + 8 * (r >> 2); if ((unsigned)kv > lim) s0[r] = -INFINITY; if ((unsigned)(kv + 32) > lim) s1[r] = -INFINITY; }
            }
            asm volatile("s_nop 15" : "+v"(s0), "+v"(s1));
            float rm;
            asm("v_max3_f32 %0, %1, %2, %3" : "=v"(rm) : "v"(s0[0]), "v"(s1[0]), "v"(s0[1]));
            asm("v_max3_f32 %0, %1, %2, %3" : "=v"(rm) : "v"(rm), "v"(s1[1]), "v"(s0[2]));
#pragma unroll
            for (int r = 2; r < 15; ++r) asm("v_max3_f32 %0, %1, %2, %3" : "=v"(rm) : "v"(rm), "v"(s1[r]), "v"(s0[r + 1]));
            asm("v_max_f32 %0, %1, %2" : "=v"(rm) : "v"(rm), "v"(s1[15]));
            { auto rr = __builtin_amdgcn_permlane32_swap(__float_as_uint(rm), __float_as_uint(rm), false, false); const float ra = __uint_as_float(rr[0]), rb = __uint_as_float(rr[1]);
              asm("v_max_f32 %0, %1, %2" : "=v"(rm) : "v"(ra), "v"(rb)); }
            const bool first = (t == 0);
            if (first || __any(rm > ATT_THR)) {
                const float dl = first ? rm : fmaxf(rm, 0.f), f = first ? 1.f : __builtin_amdgcn_exp2f(-dl);
                mref += dl; lsum *= f;
                if (hi == 0) wsf[r32] = f;
                asm volatile("s_waitcnt lgkmcnt(0)" ::: "memory");
#pragma unroll
                for (int r = 0; r < 16; ++r) { const float fr_ = wsf[crow(r, hi)]; s0[r] -= dl; s1[r] -= dl; mv[r] = -mref;
#pragma unroll
                    for (int nb = 0; nb < 4; ++nb) o[nb][r] *= fr_; }
            }
            f32x2 ps2 = (f32x2){0.f, 0.f};
#pragma unroll
            for (int r = 0; r < 16; ++r) { s0[r] = __builtin_amdgcn_exp2f(s0[r]); s1[r] = __builtin_amdgcn_exp2f(s1[r]); }
#pragma unroll
            for (int r = 0; r < 16; r += 2) { ps2 += (f32x2){s0[r], s0[r + 1]}; ps2 += (f32x2){s1[r], s1[r + 1]}; }
            lsum += ps2.x + ps2.y;
            const LAS char* vp = lds + s * ATT_BUF + 16384 + ((lane >> 4) & 1) * 32 + (lane & 3) * 8 + (4 * hi + ((lane & 15) >> 2)) * 64;
#pragma unroll
            for (int ks = 0; ks < 4; ++ks) {
                u32x4 pw;
                if (ks < 2) { pw.x = cvtpk(s0[8 * ks], s0[8 * ks + 1]); pw.y = cvtpk(s0[8 * ks + 2], s0[8 * ks + 3]); pw.z = cvtpk(s0[8 * ks + 4], s0[8 * ks + 5]); pw.w = cvtpk(s0[8 * ks + 6], s0[8 * ks + 7]); }
                else { const int q_ = ks - 2; pw.x = cvtpk(s1[8 * q_], s1[8 * q_ + 1]); pw.y = cvtpk(s1[8 * q_ + 2], s1[8 * q_ + 3]); pw.z = cvtpk(s1[8 * q_ + 4], s1[8 * q_ + 5]); pw.w = cvtpk(s1[8 * q_ + 6], s1[8 * q_ + 7]); }
                const bf16x8 pa = __builtin_bit_cast(bf16x8, pw);
#pragma unroll
                for (int nb = 0; nb < 4; ++nb) {
                    const s16x4 vlo = vtr(vp + nb * 4096 + ks * 1024), vhi = vtr(vp + nb * 4096 + ks * 1024 + 512);
                    const bf16x8 vb = (bf16x8){vlo[0], vlo[1], vlo[2], vlo[3], vhi[0], vhi[1], vhi[2], vhi[3]};
                    o[nb] = MFMA32(pa, vb, o[nb]);
                }
            }
        }
        __syncthreads();
    }
#undef ATT_ISSUE
    lsum = swap_sum(lsum);
    if (hi == 0) wsf[r32] = lsum;
    asm volatile("s_waitcnt lgkmcnt(0)" ::: "memory");
    float rli[16];
#pragma unroll
    for (int r = 0; r < 16; ++r) rli[r] = 1.f / wsf[crow(r, hi)];
    const float lam = ((const float*)(ws + WS_LB))[512];
    LAS float* ex = (LAS float*)lds + wq * 4096;
    if (comp == 1) {
#pragma unroll
        for (int r = 0; r < 16; ++r)
#pragma unroll
            for (int nb = 0; nb < 4; ++nb) ex[(r * 4 + nb) * 64 + lane] = o[nb][r] * rli[r] * lam;
    }
    __syncthreads();
    if (comp == 0) {
        float ss[16];
#pragma unroll
        for (int r = 0; r < 16; ++r) { float a = 0.f;
#pragma unroll
            for (int nb = 0; nb < 4; ++nb) { const float v = o[nb][r] * rli[r] - ex[(r * 4 + nb) * 64 + lane]; o[nb][r] = v; a += v * v; }
            ss[r] = a; }
#pragma unroll
        for (int r = 0; r < 16; ++r) { float a = ss[r]; a += __shfl_xor(a, 1); a += __shfl_xor(a, 2); a += __shfl_xor(a, 4); a += __shfl_xor(a, 8); a += __shfl_xor(a, 16); ss[r] = (1.f - LAM_INIT) / sqrtf(a * (1.f / 128.f) + EPS); }
        bf16_t* mix = (bf16_t*)(ws + WS_MIX) + ((size_t)(b * SEQ + 128 * j + 32 * wq)) * DM + h * 128;
#pragma unroll
        for (int nb = 0; nb < 4; ++nb) { const float w = P.subln_w[32 * nb + r32];
#pragma unroll
            for (int r = 0; r < 16; ++r) mix[(size_t)crow(r, hi) * DM + 32 * nb + r32] = (bf16_t)f2bf(o[nb][r] * ss[r] * w); }
    }
    __syncthreads();
}
#define MFMA16(a, b, c) __builtin_amdgcn_mfma_f32_16x16x32_bf16(a, b, c, 0, 0, 0)
constexpr int HG_STR = 272;
constexpr int HL_QA = 0, HL_QB = HL_QA + 32 * HG_STR, HL_KB = HL_QB + 32 * HG_STR, HL_KT = HL_KB + 32 * HG_STR, HL_VV = HL_KT + 32 * HG_STR;
constexpr int HL_PS = HL_VV + 32 * HG_STR;
constexpr int HL_D = HL_PS + 4 * 128 * 4;
constexpr int HL_OUT = HL_D + 128 * 4;
constexpr int HL_END = HL_OUT + 32 * 132 * 4;

constexpr int HB_KTF = 0, HB_ATF = 8192, HB_DF = 10240;
DI void hgrn_prep_item(const Params& P, int bh, int c, char* lds_g) {
    LAS char* lds = (LAS char*)lds_g;
    const int tid = tid_(), lane = tid & 63, c16 = lane & 15, g4 = lane >> 4, ch = tid & 127, part = tid >> 7;
    const int wid = __builtin_amdgcn_readfirstlane(tid >> 6);
    const int vrow = tid >> 4, vcol = (tid & 15) * 8;
    unsigned char* ws = P.ws;
    const float* HG = (const float*)(ws + WS_HG) + (size_t)bh * HT * 128;
    const bf16_t* HQ = (const bf16_t*)(ws + WS_HQ) + (size_t)bh * HT * 128;
    const bf16_t* HV = (const bf16_t*)(ws + WS_HV) + (size_t)bh * HT * 128;
    const size_t r0 = (size_t)(32 * c + 8 * part);
    float g8[8], p8[8]; unsigned short q8[8];
    { float a = 0.f;
#pragma unroll
      for (int e = 0; e < 8; ++e) { g8[e] = HG[(r0 + e) * 128 + ch]; q8[e] = HQ[(r0 + e) * 128 + ch]; a += g8[e]; p8[e] = a; } }
    const u32x4 v16 = *(const u32x4*)(HV + ((size_t)(32 * c) + vrow) * 128 + vcol);
    ((LAS float*)(lds + HL_PS))[part * 128 + ch] = p8[7];
    __syncthreads();
    {
        const LAS float* ps = (const LAS float*)(lds + HL_PS);
        const float t0 = ps[ch], t1 = ps[128 + ch], t2 = ps[256 + ch], t3 = ps[384 + ch];
        const float off = (part > 0 ? t0 : 0.f) + (part > 1 ? t1 : 0.f) + (part > 2 ? t2 : 0.f);
        const float mid = t0 + t1, last = mid + t2 + t3;
        const float em = __expf(mid), el = __expf(last - mid);
        if (part == 0) ((LAS float*)(lds + HL_D))[ch] = __expf(last);
#pragma unroll
        for (int e = 0; e < 8; ++e) {
            const int tk = 8 * part + e;
            const float cum = off + p8[e];
            const float e1 = __expf(cum - mid), e2 = 1.f / e1;
            const float q = bf2f(q8[e]), k = 1.f - __expf(g8[e]);
            const float qb = q * e1, qa = qb * em, kb = k * e2, kt = kb * el;
            *(LAS bf16_t*)(lds + HL_QA + tk * HG_STR + ch * 2) = (bf16_t)f2bf(qa);
            *(LAS bf16_t*)(lds + HL_QB + tk * HG_STR + ch * 2) = (bf16_t)f2bf(qb);
            *(LAS bf16_t*)(lds + HL_KB + tk * HG_STR + ch * 2) = (bf16_t)f2bf(kb);
            *(LAS bf16_t*)(lds + HL_KT + tk * HG_STR + ch * 2) = (bf16_t)f2bf(kt);
        }
        *(LAS u32x4*)(lds + HL_VV + vrow * HG_STR + vcol * 2) = v16;
    }
    __syncthreads();
    unsigned char* qaf = ws + WS_HQA + ((size_t)bh * 129 + c) * 8192;
    unsigned char* hgb = ws + WS_HG + (size_t)bh * HT * 512 + (size_t)c * 16384;
    {
        const int ks = wid >> 1, nt = wid & 1;
        const LAS char* qp = lds + HL_QA + (16 * nt + c16) * HG_STR + (32 * ks + 4 * g4) * 2;
        const u32x2 lo = *(const LAS u32x2*)qp, hi2 = *(const LAS u32x2*)(qp + 32);
        *(u32x4*)(qaf + wid * 1024 + lane * 16) = (u32x4){lo.x, lo.y, hi2.x, hi2.y};
        const LAS char* kp = lds + HL_KT + (8 * g4 + (c16 >> 2)) * HG_STR + (16 * wid + 4 * (c16 & 3)) * 2;
        const s16x4 klo = vtr(kp), khi = vtr(kp + 4 * HG_STR);
        *(bf16x8*)(hgb + HB_KTF + wid * 1024 + lane * 16) = (bf16x8){klo[0], klo[1], klo[2], klo[3], khi[0], khi[1], khi[2], khi[3]};
    }
    if (wid == 0) {
        f32x4 at00 = (f32x4){0.f, 0.f, 0.f, 0.f}, at01 = at00, at11 = at00;
#pragma unroll
        for (int ks = 0; ks < 4; ++ks) {
            const bf16x8 ka0 = *(const LAS bf16x8*)(lds + HL_KB + c16 * HG_STR + (32 * ks + 8 * g4) * 2);
            const bf16x8 ka1 = *(const LAS bf16x8*)(lds + HL_KB + (16 + c16) * HG_STR + (32 * ks + 8 * g4) * 2);
            const bf16x8 qn0 = *(const LAS bf16x8*)(lds + HL_QB + c16 * HG_STR + (32 * ks + 8 * g4) * 2);
            const bf16x8 qn1 = *(const LAS bf16x8*)(lds + HL_QB + (16 + c16) * HG_STR + (32 * ks + 8 * g4) * 2);
            at00 = MFMA16(ka0, qn0, at00); at01 = MFMA16(ka0, qn1, at01); at11 = MFMA16(ka1, qn1, at11);
        }
#pragma unroll
        for (int r = 0; r < 4; ++r) { if (4 * g4 + r > c16) { at00[r] = 0.f; at11[r] = 0.f; } }
        u32x4 b0; b0.x = cvtpk(at00[0], at00[1]); b0.y = cvtpk(at00[2], at00[3]); b0.z = 0u; b0.w = 0u;
        u32x4 b1; b1.x = cvtpk(at01[0], at01[1]); b1.y = cvtpk(at01[2], at01[3]); b1.z = cvtpk(at11[0], at11[1]); b1.w = cvtpk(at11[2], at11[3]);
        *(u32x4*)(hgb + HB_ATF + lane * 16) = b0; *(u32x4*)(hgb + HB_ATF + 1024 + lane * 16) = b1;
    } else if (wid == 1 && lane < 32) {
        *(f32x4*)(hgb + HB_DF + lane * 16) = *(const LAS f32x4*)(lds + HL_D + lane * 16);
    }
    __syncthreads();
}

constexpr int RS_QAF = 0, RS_HGB = 8192, RS_V = 19456, RS_SLOT = 27648, RS_NSLOT = 5;
constexpr int RS_OUT = RS_NSLOT * RS_SLOT, RS_OUTB = 32 * 136 * 2, RS_END = RS_OUT + 2 * RS_OUTB;
static_assert(RS_END <= LDS_ITEM, "hgrn LDS map");
DI void glds16_asm(const void* g, unsigned lds_base) {
    unsigned sv; asm volatile("s_mov_b32 %0, m0\n\ts_mov_b32 m0, %2\n\ts_nop 0\n\tglobal_load_lds_dwordx4 %1, off\n\ts_mov_b32 m0, %0" : "=&s"(sv) : "v"(g), "s"(lds_base) : "memory"); }
#define HW_BAR() asm volatile("s_waitcnt lgkmcnt(0)\n\ts_barrier" ::: "memory")
DI void glds16_sb(unsigned voff, const void* sbase, unsigned lds_base) {
    unsigned sv; asm volatile("s_mov_b32 %0, m0\n\ts_mov_b32 m0, %3\n\ts_nop 0\n\tglobal_load_lds_dwordx4 %1, %2\n\ts_mov_b32 m0, %0" : "=&s"(sv) : "v"(voff), "s"(sbase), "s"(lds_base) : "memory"); }
DI void hgrn_unit(const Params& P, int b, int h, char* lds_g) {
    LAS char* lds = (LAS char*)lds_g;
    const int tid = tid_(), lane = tid & 63, c16 = lane & 15, g4 = lane >> 4;
    const int wid = __builtin_amdgcn_readfirstlane(tid >> 6);
    const unsigned char* ws = P.ws;
    const int bh = b * 4 + h;
    const unsigned lbase = (unsigned)__builtin_amdgcn_readfirstlane((int)(unsigned)(size_t)lds);
    constexpr int AHEAD = RS_NSLOT - 1;
    if (wid < 4) {
        const unsigned char* qafg = ws + WS_HQA + (size_t)bh * 129 * 8192;
        const unsigned char* hgbg = ws + WS_HG + (size_t)bh * HT * 512;
        const unsigned char* vg = ws + WS_HV + (size_t)bh * HT * 256;
        const unsigned voff = (unsigned)lane * 16u;
        auto issue = [&](int c) {
            const unsigned sb = lbase + (unsigned)((c % RS_NSLOT) * RS_SLOT);
#pragma unroll
            for (int k = 0; k < 7; ++k) {
                const int p = wid + 4 * k;
                if (p < 19) { const unsigned char* src = (p < 8) ? qafg + (size_t)c * 8192 + p * 1024 : hgbg + (size_t)c * 16384 + (p - 8) * 1024; glds16_sb(voff, src, sb + (unsigned)p * 1024u); }
                else if (p < 27) { const int r4 = 4 * (p - 19);
                    const unsigned vo = (unsigned)(lane >> 4) * 256u + (unsigned)(((lane & 15) ^ ((((r4 & 7) + (lane >> 4)) & 7) << 1)) * 16);
                    glds16_sb(vo, vg + ((size_t)(32 * c) + r4) * 256, sb + (unsigned)p * 1024u); }
            }
        };
        f32x4 S[2][8];
#pragma unroll
        for (int t = 0; t < 2; ++t)
#pragma unroll
            for (int i = 0; i < 8; ++i) S[t][i] = (f32x4){0.f, 0.f, 0.f, 0.f};
#pragma unroll
        for (int c = 0; c < AHEAD; ++c) issue(c);
        for (int c = 0; c < 129; ++c) {
            if (c + AHEAD - 1 > 128) asm volatile("s_waitcnt vmcnt(0)" ::: "memory");
            else if (wid < 3) asm volatile("s_waitcnt vmcnt(21)" ::: "memory"); else asm volatile("s_waitcnt vmcnt(18)" ::: "memory");
            HW_BAR();
            __builtin_amdgcn_sched_barrier(0);
            if (c + AHEAD < 129) issue(c + AHEAD);
            __builtin_amdgcn_sched_barrier(0);
            const LAS char* sl = lds + (c % RS_NSLOT) * RS_SLOT;
            f32x4 oacc[2][2];
#pragma unroll
            for (int t = 0; t < 2; ++t) { oacc[t][0] = (f32x4){0.f, 0.f, 0.f, 0.f}; oacc[t][1] = oacc[t][0]; }
#pragma unroll
            for (int ks = 0; ks < 4; ++ks) {
                const bf16x8 q0 = *(const LAS bf16x8*)(sl + RS_QAF + (2 * ks) * 1024 + lane * 16), q1 = *(const LAS bf16x8*)(sl + RS_QAF + (2 * ks + 1) * 1024 + lane * 16);
#pragma unroll
                for (int t = 0; t < 2; ++t) {
                    u32x4 sp; sp.x = cvtpk(S[t][2 * ks][0], S[t][2 * ks][1]); sp.y = cvtpk(S[t][2 * ks][2], S[t][2 * ks][3]); sp.z = cvtpk(S[t][2 * ks + 1][0], S[t][2 * ks + 1][1]); sp.w = cvtpk(S[t][2 * ks + 1][2], S[t][2 * ks + 1][3]);
                    const bf16x8 sf = __builtin_bit_cast(bf16x8, sp);
                    oacc[t][0] = MFMA16(sf, q0, oacc[t][0]); oacc[t][1] = MFMA16(sf, q1, oacc[t][1]);
                }
            }
            const int vq = c16 >> 2, vp4 = c16 & 3;
#define VTR(row, w_) vtr(sl + RS_V + (row) * 256 + (((2 * (w_) + (vp4 >> 1)) ^ ((((row) & 7)) << 1)) * 16) + 8 * (vp4 & 1))
            {
                const bf16x8 a0 = *(const LAS bf16x8*)(sl + RS_HGB + HB_ATF + lane * 16), a1 = *(const LAS bf16x8*)(sl + RS_HGB + HB_ATF + 1024 + lane * 16);
#pragma unroll
                for (int t = 0; t < 2; ++t) {
                    const s16x4 lo = VTR(4 * g4 + vq, 2 * wid + t), hi2 = VTR(16 + 4 * g4 + vq, 2 * wid + t);
                    const bf16x8 va = (bf16x8){lo[0], lo[1], lo[2], lo[3], hi2[0], hi2[1], hi2[2], hi2[3]};
                    oacc[t][0] = MFMA16(va, a0, oacc[t][0]); oacc[t][1] = MFMA16(va, a1, oacc[t][1]);
                }
            }
            {
                LAS char* ob = lds + RS_OUT + (c & 1) * RS_OUTB;
#pragma unroll
                for (int t = 0; t < 2; ++t)
#pragma unroll
                    for (int nt = 0; nt < 2; ++nt) { u32x2 w; w.x = cvtpk(oacc[t][nt][0], oacc[t][nt][1]); w.y = cvtpk(oacc[t][nt][2], oacc[t][nt][3]);
                        *(LAS u32x2*)(ob + ((16 * nt + c16) * 136 + 16 * (2 * wid + t) + 4 * g4) * 2) = w; }
            }
            {
                bf16x8 vb[2];
#pragma unroll
                for (int t = 0; t < 2; ++t) { const s16x4 lo = VTR(8 * g4 + vq, 2 * wid + t), hi2 = VTR(8 * g4 + 4 + vq, 2 * wid + t); vb[t] = (bf16x8){lo[0], lo[1], lo[2], lo[3], hi2[0], hi2[1], hi2[2], hi2[3]}; }
#pragma unroll
                for (int i = 0; i < 8; ++i) {
                    const f32x4 d4 = *(const LAS f32x4*)(sl + RS_HGB + HB_DF + (16 * i + 4 * g4) * 4);
                    const bf16x8 ka = *(const LAS bf16x8*)(sl + RS_HGB + HB_KTF + i * 1024 + lane * 16);
                    S[0][i] = MFMA16(ka, vb[0], S[0][i] * d4); S[1][i] = MFMA16(ka, vb[1], S[1][i] * d4);
                }
            }
#undef VTR
        }
        HW_BAR();
        HW_BAR();
    } else {
        const int tq = tid - 256, tok = tq >> 3, part = tq & 7;
        const bf16_t* sgg = (const bf16_t*)(ws + WS_SG) + ((size_t)b * SEQ + tok) * 512 + h * 128 + 16 * part;
        f32x4 nw[4];
#pragma unroll
        for (int q = 0; q < 4; ++q) nw[q] = *(const f32x4*)(P.rec_norm_w + h * 128 + 16 * part + 4 * q);
        auto epilogue = [&](int c, u32x4 s0, u32x4 s1) {
            const LAS char* ob = lds + RS_OUT + (c & 1) * RS_OUTB + (tok * 136 + 16 * part) * 2;
            const u32x4 o0 = *(const LAS u32x4*)ob, o1 = *(const LAS u32x4*)(ob + 16);
            const unsigned ou[8] = {o0.x, o0.y, o0.z, o0.w, o1.x, o1.y, o1.z, o1.w}, su[8] = {s0.x, s0.y, s0.z, s0.w, s1.x, s1.y, s1.z, s1.w};
            float v[16], ss = 0.f;
#pragma unroll
            for (int q = 0; q < 8; ++q) { v[2 * q] = bf2f(ou[q] & 0xffffu); v[2 * q + 1] = bf2f(ou[q] >> 16); ss += v[2 * q] * v[2 * q] + v[2 * q + 1] * v[2 * q + 1]; }
            ss += __shfl_xor(ss, 1); ss += __shfl_xor(ss, 2); ss += __shfl_xor(ss, 4);
            const float rs = 1.f / sqrtf(ss * (1.f / 128.f) + EPS);
            u32x4 w0, w1; unsigned wo[8];
#pragma unroll
            for (int q = 0; q < 8; ++q) wo[q] = cvtpk(v[2 * q] * rs * nw[q >> 1][(2 * q) & 3] * bf2f(su[q] & 0xffffu), v[2 * q + 1] * rs * nw[q >> 1][(2 * q + 1) & 3] * bf2f(su[q] >> 16));
            w0 = (u32x4){wo[0], wo[1], wo[2], wo[3]}; w1 = (u32x4){wo[4], wo[5], wo[6], wo[7]};
            bf16_t* mp = (bf16_t*)(ws + WS_MIX) + ((size_t)b * SEQ + 32 * (c - 1) + tok) * DM + 512 + h * 128 + 16 * part;
            *(u32x4*)mp = w0; *(u32x4*)(mp + 8) = w1;
        };
#define SG_LD(k, A, B) do { const bf16_t* p_ = sgg + (size_t)(32 * ((k) - 1)) * 512; A = *(const u32x4*)p_; B = *(const u32x4*)(p_ + 8); } while (0)
        u32x4 ga0, ga1, gb0, gb1, gc0, gc1, gd0, gd1;
        SG_LD(1, gb0, gb1); SG_LD(2, gc0, gc1); SG_LD(3, gd0, gd1);
        HW_BAR();
        HW_BAR();
        for (int k = 1; k <= 128; k += 4) {
            HW_BAR(); if (k + 3 <= 128) SG_LD(k + 3, ga0, ga1); epilogue(k, gb0, gb1);
            HW_BAR(); if (k + 4 <= 128) SG_LD(k + 4, gb0, gb1); epilogue(k + 1, gc0, gc1);
            HW_BAR(); if (k + 5 <= 128) SG_LD(k + 5, gc0, gc1); epilogue(k + 2, gd0, gd1);
            HW_BAR(); if (k + 6 <= 128) SG_LD(k + 6, gd0, gd1); epilogue(k + 3, ga0, ga1);
        }
#undef SG_LD
        HW_BAR();
    }
}
#define CE_D(a, b) do { const float hi_ = fmaxf(a, b), lo_ = fminf(a, b); a = hi_; b = lo_; } while (0)
DI void bitonic_sort16(float (&v)[16]) {
#pragma unroll
    for (int k = 2; k <= 16; k *= 2)
#pragma unroll
        for (int j = k / 2; j > 0; j /= 2)
#pragma unroll
            for (int i = 0; i < 16; ++i) { const int l = i ^ j; if (l > i) { if ((i & k) == 0) CE_D(v[i], v[l]); else CE_D(v[l], v[i]); } }
}
DI void merge_top16(float (&a)[16], const float (&b)[16]) {
#pragma unroll
    for (int i = 0; i < 16; ++i) a[i] = fmaxf(a[i], b[15 - i]);
#pragma unroll
    for (int j = 8; j > 0; j /= 2)
#pragma unroll
        for (int i = 0; i < 16; ++i) { const int l = i ^ j; if (l > i) CE_D(a[i], a[l]); }
}
DI float embed7(float v, unsigned code) { return __uint_as_float((__float_as_uint(v) & 0xFFFFFF80u) | code); }
DI float embed8(float v, unsigned code) { return __uint_as_float((__float_as_uint(v) & 0xFFFFFF00u) | code); }

DI void topk_list(const bf16_t* qp, const LAS char* skf, int lane, int hi, float (&top)[16]) {
    f32x16 acc[4];
#pragma unroll
    for (int kb = 0; kb < 4; ++kb) acc[kb] = f32x16{};
#pragma unroll
    for (int ks = 0; ks < 8; ++ks) {
        const bf16x8 qf = *(const bf16x8*)(qp + 16 * ks);
#pragma unroll
        for (int kb = 0; kb < 4; ++kb) { const bf16x8 kf = *(const LAS bf16x8*)(skf + (kb * 8 + ks) * 1024 + lane * 16); acc[kb] = MFMA32(kf, qf, acc[kb]); }
    }
    float blk[16];
#pragma unroll
    for (int kb = 0; kb < 4; ++kb) {
#pragma unroll
        for (int r = 0; r < 16; ++r) { const unsigned code = (unsigned)(32 * kb + (r & 3) + 8 * (r >> 2)) | (unsigned)(4 * hi); if (kb == 0) top[r] = embed7(acc[kb][r], code); else blk[r] = embed7(acc[kb][r], code); }
        if (kb == 0) bitonic_sort16(top); else { bitonic_sort16(blk); merge_top16(top, blk); }
    }
    float l0[16], l1[16];
#pragma unroll
    for (int r = 0; r < 16; ++r) { auto rr = __builtin_amdgcn_permlane32_swap(__float_as_uint(top[r]), __float_as_uint(top[r]), false, false); l0[r] = __uint_as_float(rr[0]); l1[r] = __uint_as_float(rr[1]); }
    merge_top16(l0, l1);
#pragma unroll
    for (int r = 0; r < 16; ++r) top[r] = l0[r];
}

DI void topk_wave_item(const Params& P, int tb, int hh, LAS char* wlds, const LAS char* skf) {
    const int lane = tid_() & 63, r32 = lane & 31, hi = lane >> 5;
    const unsigned char* ws = P.ws;
    const bf16_t* qp = (const bf16_t*)(ws + WS_PQ) + (size_t)(32 * tb + r32) * 2048 + hh * 256 + 8 * hi;
    float A[16], B[16];
    topk_list(qp, skf, lane, hi, A);
    topk_list(qp + 128, skf + 32768, lane, hi, B);
    LAS unsigned* my = (LAS unsigned*)(wlds + lane * 32);
#pragma unroll
    for (int w = 0; w < 4; ++w) {
        my[w] = (__float_as_uint(A[4 * w]) & 127u) | ((__float_as_uint(A[4 * w + 1]) & 127u) << 8) | ((__float_as_uint(A[4 * w + 2]) & 127u) << 16) | ((__float_as_uint(A[4 * w + 3]) & 127u) << 24);
        my[4 + w] = (__float_as_uint(B[4 * w]) & 127u) | ((__float_as_uint(B[4 * w + 1]) & 127u) << 8) | ((__float_as_uint(B[4 * w + 2]) & 127u) << 16) | ((__float_as_uint(B[4 * w + 3]) & 127u) << 24);
    }
#pragma unroll
    for (int r = 0; r < 16; ++r) { A[r] = __uint_as_float(__float_as_uint(A[r]) & 0xFFFFFF80u); B[r] = __uint_as_float(__float_as_uint(B[r]) & 0xFFFFFF80u); }
    float T[16], R1[16], X[16], Y[16];
#pragma unroll
    for (int j = 0; j < 16; ++j) { T[j] = embed8(A[0] + B[j], (unsigned)j); R1[j] = (j < 8) ? embed8(A[1] + B[j], (unsigned)(16 + j)) : -INFINITY; }
#define CAND(i, j) embed8(A[i] + B[j], (unsigned)(16 * (i) + (j)))
    X[0] = CAND(2, 0); X[1] = CAND(2, 1); X[2] = CAND(2, 2); X[3] = CAND(2, 3); X[4] = CAND(2, 4); X[5] = CAND(3, 0); X[6] = CAND(3, 1); X[7] = CAND(3, 2);
    X[8] = CAND(3, 3); X[9] = CAND(4, 0); X[10] = CAND(4, 1); X[11] = CAND(4, 2); X[12] = CAND(5, 0); X[13] = CAND(5, 1); X[14] = CAND(6, 0); X[15] = CAND(6, 1);
    Y[0] = CAND(7, 0); Y[1] = CAND(7, 1); Y[2] = CAND(8, 0); Y[3] = CAND(9, 0); Y[4] = CAND(10, 0); Y[5] = CAND(11, 0); Y[6] = CAND(12, 0); Y[7] = CAND(13, 0);
    Y[8] = CAND(14, 0); Y[9] = CAND(15, 0); Y[10] = -INFINITY; Y[11] = -INFINITY; Y[12] = -INFINITY; Y[13] = -INFINITY; Y[14] = -INFINITY; Y[15] = -INFINITY;
#undef CAND
    bitonic_sort16(X); bitonic_sort16(Y);
    merge_top16(T, R1); merge_top16(T, X); merge_top16(T, Y);
    asm volatile("s_waitcnt lgkmcnt(0)" ::: "memory");
    float ssum = 0.f, e[16]; int eid[16];
    const float t0 = __uint_as_float(__float_as_uint(T[0]) & 0xFFFFFF00u);
#pragma unroll
    for (int r = 0; r < 16; ++r) {
        const unsigned bits = __float_as_uint(T[r]); const unsigned code = bits & 255u;
        e[r] = __expf(__uint_as_float(bits & 0xFFFFFF00u) - t0); ssum += e[r];
        const int ka = ((const LAS unsigned char*)my)[code >> 4], kb_ = ((const LAS unsigned char*)my)[16 + (code & 15u)];
        eid[r] = ka * 128 + kb_;
    }
    const float inv = 1.f / ssum;
    const size_t o = (size_t)(32 * tb + r32) * 128 + hh * 16 + 8 * hi;
    int* ei = (int*)(ws + WS_EIDX) + o; float* eg = (float*)(ws + WS_EGATE) + o;
    typedef int i32x4 __attribute__((ext_vector_type(4)));
    i32x4 w0, w1; f32x4 g0, g1;
    const unsigned mh = 0u - (unsigned)hi;
#define SELU(a, b) ((((unsigned)(b)) & mh) | (((unsigned)(a)) & ~mh))
#pragma unroll
    for (int q = 0; q < 4; ++q) { w0[q] = (int)SELU(eid[q], eid[8 + q]); w1[q] = (int)SELU(eid[4 + q], eid[12 + q]);
        g0[q] = __uint_as_float(SELU(__float_as_uint(e[q]), __float_as_uint(e[8 + q]))) * inv; g1[q] = __uint_as_float(SELU(__float_as_uint(e[4 + q]), __float_as_uint(e[12 + q]))) * inv; }
#undef SELU
    *(i32x4*)ei = w0; *(i32x4*)(ei + 4) = w1; *(f32x4*)eg = g0; *(f32x4*)(eg + 4) = g1;
}

DI void topk_phase(const Params& P, char* lds_g, int bid, int nblk) {
    const int tid = tid_(), wave = __builtin_amdgcn_readfirstlane(tid >> 6);
    LAS char* lds = (LAS char*)lds_g;
    LAS char* wlds = lds + wave * 2048;
    LAS char* skf = lds + 16384;
    int cur_h = -1;
    for (int it = bid; it < (NTOK / 256) * 8; it += nblk) {
        const int hh = it & 7, tg = it >> 3;
        if (hh != cur_h) {
            __syncthreads();
#pragma unroll
            for (int i = 0; i < 8; ++i) {
                const int f = tid + 512 * i, l = f & 63, ks = (f >> 6) & 7, kb = (f >> 9) & 3, p = f >> 11;
                *(LAS u32x4*)(skf + f * 16) = *(const u32x4*)((const bf16_t*)(P.ws + WS_SKB) + (size_t)((hh * 2 + p) * 128 + 32 * kb + (l & 31)) * 128 + 16 * ks + 8 * (l >> 5));
            }
            __syncthreads();
            cur_h = hh;
        }
        topk_wave_item(P, tg * 8 + wave, hh, wlds, skf);
    }
}

DI float gelu_exact(float x) { return 0.5f * x * (1.f + erff(x * 0.70710678118654752f)); }
typedef __bf16 bf16x8_t __attribute__((ext_vector_type(8)));
DI float dot8(u32x4 a, u32x4 x, float acc) {
    const bf16x8_t a8 = __builtin_bit_cast(bf16x8_t, a), x8 = __builtin_bit_cast(bf16x8_t, x);
    acc = __builtin_amdgcn_fdot2_f32_bf16(__builtin_shufflevector(a8, a8, 0, 1), __builtin_shufflevector(x8, x8, 0, 1), acc, false);
    acc = __builtin_amdgcn_fdot2_f32_bf16(__builtin_shufflevector(a8, a8, 2, 3), __builtin_shufflevector(x8, x8, 2, 3), acc, false);
    acc = __builtin_amdgcn_fdot2_f32_bf16(__builtin_shufflevector(a8, a8, 4, 5), __builtin_shufflevector(x8, x8, 4, 5), acc, false);
    acc = __builtin_amdgcn_fdot2_f32_bf16(__builtin_shufflevector(a8, a8, 6, 7), __builtin_shufflevector(x8, x8, 6, 7), acc, false);
    return acc;
}
DI float wave_sum_dpp(float v) {
    v = row16_sum(v);
    return (readlane_f(v, 0) + readlane_f(v, 16)) + (readlane_f(v, 32) + readlane_f(v, 48));
}

DI float dot16_fp8(u32x4 w, const f32x2 (&x)[8]) {
    f32x2 acc = __builtin_amdgcn_cvt_pk_f32_fp8((int)w.x, false) * x[0];
    acc = __builtin_amdgcn_cvt_pk_f32_fp8((int)w.x, true) * x[1] + acc;
    acc = __builtin_amdgcn_cvt_pk_f32_fp8((int)w.y, false) * x[2] + acc;
    acc = __builtin_amdgcn_cvt_pk_f32_fp8((int)w.y, true) * x[3] + acc;
    acc = __builtin_amdgcn_cvt_pk_f32_fp8((int)w.z, false) * x[4] + acc;
    acc = __builtin_amdgcn_cvt_pk_f32_fp8((int)w.z, true) * x[5] + acc;
    acc = __builtin_amdgcn_cvt_pk_f32_fp8((int)w.w, false) * x[6] + acc;
    acc = __builtin_amdgcn_cvt_pk_f32_fp8((int)w.w, true) * x[7] + acc;
    return acc.x + acc.y;
}
DI void peer_hid_phase(const Params& P, int bid, int nblk) {
    const int tid = tid_(), lane = tid & 63, wave = __builtin_amdgcn_readfirstlane(tid >> 6);
    const unsigned char* ws = P.ws;
    const unsigned char* U8 = ws + WS_UB; const float* USC = (const float*)(ws + WS_USC);
    const int gw = bid * NWAVES + wave, NGW = nblk * NWAVES;
    f32x4 wv[4];
#pragma unroll
    for (int q = 0; q < 4; ++q) wv[q] = *(const f32x4*)(P.ffn_norm_w + 16 * lane + 4 * q);
    for (int n = gw; n < NTOK; n += NGW) {
        const float* hrow = P.out + (size_t)n * DM + 16 * lane;
        f32x4 h[4]; float ss = 0.f;
#pragma unroll
        for (int q = 0; q < 4; ++q) { h[q] = *(const f32x4*)(hrow + 4 * q); ss += (h[q].x * h[q].x + h[q].y * h[q].y) + (h[q].z * h[q].z + h[q].w * h[q].w); }
        ss = wave_sum_dpp(ss);
        const float r2 = 1.f / sqrtf(ss * (1.f / DM) + EPS);
        f32x2 x[8];
#pragma unroll
        for (int q = 0; q < 4; ++q) { const f32x4 t = h[q] * wv[q] * r2; x[2 * q] = (f32x2){t.x, t.y}; x[2 * q + 1] = (f32x2){t.z, t.w}; }
        const int* eidx = (const int*)(ws + WS_EIDX) + (size_t)n * 128;
        const float* egate = (const float*)(ws + WS_EGATE) + (size_t)n * 128;
        const int id0 = eidx[lane], id1 = eidx[64 + lane];
        float hid0 = 0.f, hid1 = 0.f;
#pragma unroll 1
        for (int k0 = 0; k0 < 128; k0 += 16) {
            u32x4 ra[16]; float sc[16];
#pragma unroll
            for (int e = 0; e < 16; ++e) {
                const int k = k0 + e;
                const int id = (k0 < 64) ? __builtin_amdgcn_readlane(id0, k & 63) : __builtin_amdgcn_readlane(id1, k & 63);
                ra[e] = *(const u32x4*)(U8 + (size_t)id * DM + 16 * lane); sc[e] = USC[id];
            }
#pragma unroll
            for (int e = 0; e < 16; ++e) {
                const int k = k0 + e;
                const float d = wave_sum_dpp(dot16_fp8(ra[e], x)) * sc[e];
                if (k0 < 64) { if (lane == (k & 63)) hid0 = d; } else { if (lane == (k & 63)) hid1 = d; }
            }
        }
        float* hid = (float*)(ws + WS_HID) + (size_t)n * 128;
        hid[lane] = gelu_exact(hid0) * egate[lane];
        hid[64 + lane] = gelu_exact(hid1) * egate[64 + lane];
    }
}

DI void peer_out_phase(const Params& P, int bid, int nblk) {
    const int tid = tid_(), lane = tid & 63, wave = __builtin_amdgcn_readfirstlane(tid >> 6);
    const unsigned char* ws = P.ws;
    const unsigned char* V8 = ws + WS_VB; const float* VSC = (const float*)(ws + WS_VSC);
    const int gw = bid * NWAVES + wave, NGW = nblk * NWAVES;
    f32x4 wv[4];
#pragma unroll
    for (int q = 0; q < 4; ++q) wv[q] = *(const f32x4*)(P.final_w + 16 * lane + 4 * q);
    for (int n = gw; n < NTOK; n += NGW) {
        const int* eidx = (const int*)(ws + WS_EIDX) + (size_t)n * 128;
        const float* hid = (const float*)(ws + WS_HID) + (size_t)n * 128;
        const int id0 = eidx[lane], id1 = eidx[64 + lane];
        const float c0 = hid[lane], c1 = hid[64 + lane];
        f32x2 acc[8];
#pragma unroll
        for (int i = 0; i < 8; ++i) acc[i] = (f32x2){0.f, 0.f};
#pragma unroll 1
        for (int k0 = 0; k0 < 128; k0 += 16) {
            u32x4 ra[16]; float cf[16];
#pragma unroll
            for (int e = 0; e < 16; ++e) {
                const int k = k0 + e;
                const int id = (k0 < 64) ? __builtin_amdgcn_readlane(id0, k & 63) : __builtin_amdgcn_readlane(id1, k & 63);
                cf[e] = ((k0 < 64) ? readlane_f(c0, k & 63) : readlane_f(c1, k & 63)) * VSC[id];
                ra[e] = *(const u32x4*)(V8 + (size_t)id * DM + 16 * lane);
            }
#pragma unroll
            for (int e = 0; e < 16; ++e) {
                const f32x2 c = (f32x2){cf[e], cf[e]}; const u32x4 w = ra[e];
                acc[0] = __builtin_amdgcn_cvt_pk_f32_fp8((int)w.x, false) * c + acc[0]; acc[1] = __builtin_amdgcn_cvt_pk_f32_fp8((int)w.x, true) * c + acc[1];
                acc[2] = __builtin_amdgcn_cvt_pk_f32_fp8((int)w.y, false) * c + acc[2]; acc[3] = __builtin_amdgcn_cvt_pk_f32_fp8((int)w.y, true) * c + acc[3];
                acc[4] = __builtin_amdgcn_cvt_pk_f32_fp8((int)w.z, false) * c + acc[4]; acc[5] = __builtin_amdgcn_cvt_pk_f32_fp8((int)w.z, true) * c + acc[5];
                acc[6] = __builtin_amdgcn_cvt_pk_f32_fp8((int)w.w, false) * c + acc[6]; acc[7] = __builtin_amdgcn_cvt_pk_f32_fp8((int)w.w, true) * c + acc[7];
            }
        }
        float* orow = P.out + (size_t)n * DM + 16 * lane;
        f32x4 h[4]; float ss = 0.f;
#pragma unroll
        for (int q = 0; q < 4; ++q) { h[q] = *(const f32x4*)(orow + 4 * q) + (f32x4){acc[2 * q].x, acc[2 * q].y, acc[2 * q + 1].x, acc[2 * q + 1].y}; ss += (h[q].x * h[q].x + h[q].y * h[q].y) + (h[q].z * h[q].z + h[q].w * h[q].w); }
        ss = wave_sum_dpp(ss);
        const float rs = 1.f / sqrtf(ss * (1.f / DM) + EPS);
#pragma unroll
        for (int q = 0; q < 4; ++q) *(f32x4*)(orow + 4 * q) = h[q] * wv[q] * rs;
    }
}

#ifdef DBG_CHECK
DI void dbg_max(float* slot, float v) { atomicMax((unsigned*)slot, __float_as_uint(fmaxf(v, 0.f))); }
DI void dbg_check_topk(const Params& P, char* lds_g, int bid, int nblk) {
    LAS char* lds = (LAS char*)lds_g;
    const int tid = tid_(), lane = tid & 63, wave = __builtin_amdgcn_readfirstlane(tid >> 6);
    const unsigned char* ws = P.ws; float* dbg = (float*)(ws + WS_CTL) + 64;
    LAS float* sc = (LAS float*)(lds) + wave * 1024;
    const int gw = bid * NWAVES + wave;
    const int token = (gw * 37) % NTOK, hh = gw & 7;
    for (int p = 0; p < 2; ++p) for (int kk = 0; kk < 2; ++kk) {
        const int key = lane + 64 * kk; float a = 0.f;
        const bf16_t* q = (const bf16_t*)(ws + WS_PQ) + (size_t)token * 2048 + hh * 256 + p * 128;
        const bf16_t* sk = (const bf16_t*)(ws + WS_SKB) + (size_t)((hh * 2 + p) * 128 + key) * 128;
        for (int c = 0; c < 128; ++c) a += bf2f(q[c]) * bf2f(sk[c]);
        sc[p * 128 + key] = a;
    }
    asm volatile("s_waitcnt lgkmcnt(0)" ::: "memory");
    for (int p = 0; p < 2; ++p) for (int kk = 0; kk < 2; ++kk) {
        const int key = lane + 64 * kk; const float v = sc[p * 128 + key]; int rank = 0;
        for (int o = 0; o < 128; ++o) { const float w = sc[p * 128 + o]; rank += (w > v || (w == v && o < key)) ? 1 : 0; }
        if (rank < 16) { sc[256 + p * 16 + rank] = v; sc[288 + p * 16 + rank] = __int_as_float(key); }
    }
    asm volatile("s_waitcnt lgkmcnt(0)" ::: "memory");
    for (int e = 0; e < 4; ++e) {
        const int c = lane * 4 + e, i = c >> 4, j = c & 15; const float v = sc[256 + i] + sc[272 + j]; int rank = 0;
        for (int o = 0; o < 256; ++o) { const float w = sc[256 + (o >> 4)] + sc[272 + (o & 15)]; rank += (w > v || (w == v && o < c)) ? 1 : 0; }
        if (rank < 16) { sc[320 + rank] = __int_as_float(__float_as_int(sc[288 + i]) * 128 + __float_as_int(sc[304 + j])); sc[336 + rank] = v; }
    }
    asm volatile("s_waitcnt lgkmcnt(0)" ::: "memory");
    if (lane < 16) {
        const int eid = __float_as_int(sc[320 + lane]); const float sv = sc[336 + lane];
        float mx = sc[336], sum = 0.f; for (int o = 0; o < 16; ++o) sum += __expf(sc[336 + o] - mx);
        const float gate = __expf(sv - mx) / sum;
        const int* eidx = (const int*)(ws + WS_EIDX) + (size_t)token * 128 + hh * 16; const float* eg = (const float*)(ws + WS_EGATE) + (size_t)token * 128 + hh * 16;
        int found = -1; for (int o = 0; o < 16; ++o) if (eidx[o] == eid) found = o;
        if (found < 0) atomicAdd(dbg + 0, 1.f); else dbg_max(dbg + 1, fabsf(eg[found] - gate));
    }
    if (lane == 0) atomicAdd(dbg + 2, 16.f);
}
DI void dbg_check_hid(const Params& P, int bid, int nblk) {
    const int tid = tid_(), lane = tid & 63, wave = __builtin_amdgcn_readfirstlane(tid >> 6);
    const unsigned char* ws = P.ws; float* dbg = (float*)(ws + WS_CTL) + 64;
    const int gw = bid * NWAVES + wave; const int token = (gw * 53) % NTOK;
    const float* hrow = P.out + (size_t)token * DM;
    float ss = 0.f; for (int c = lane; c < DM; c += 64) ss += hrow[c] * hrow[c];
    ss = wave_sum(ss); const float r2 = 1.f / sqrtf(ss / DM + EPS);
    for (int kk = 0; kk < 2; ++kk) {
        const int k = lane + 64 * kk; const int eid = ((const int*)(ws + WS_EIDX))[(size_t)token * 128 + k];
        const float* urow = P.pu + (size_t)eid * DM; float d = 0.f;
        for (int c = 0; c < DM; ++c) d += urow[c] * (hrow[c] * r2 * P.ffn_norm_w[c]);
        const float hidv = gelu_exact(d) * ((const float*)(ws + WS_EGATE))[(size_t)token * 128 + k];
        const float got = ((const float*)(ws + WS_HID))[(size_t)token * 128 + k];
        dbg_max(dbg + 3, fabsf(got - hidv)); dbg_max(dbg + 4, fabsf(hidv));
    }
}
DI float dbg_enc(float m) { return 8.f + log10f(fmaxf(m, 1e-8f)); }
#endif

#ifdef DBG_CHECK
DI void dbg_check_attn(const Params& P, int bid, int nblk) {
    const int tid = tid_(), lane = tid & 63, wave = __builtin_amdgcn_readfirstlane(tid >> 6);
    const unsigned char* ws = P.ws; float* dbg = (float*)(ws + WS_CTL) + 64;
    const int gw = bid * NWAVES + wave;
    const unsigned hsh = (unsigned)gw * 2654435761u;
    const int b = (hsh >> 8) & 7, h = (hsh >> 11) & 3, i = (int)((hsh >> 13) % 4096u), bh = b * 4 + h;
    const float lam = ((const float*)(ws + WS_LB))[512];
    float oc[2][2], lsum[2], mx[2];
    for (int c = 0; c < 2; ++c) { oc[c][0] = oc[c][1] = 0.f; lsum[c] = 0.f; mx[c] = -1e30f; }
    for (int pp = KPAD; pp <= 64 + i; ++pp) {
        const int tile = pp >> 6, key = pp & 63;
        for (int c = 0; c < 2; ++c) {
            const bf16_t* q = (const bf16_t*)(ws + WS_Q) + ((size_t)((bh * 2 + c) * SEQ + i)) * 64;
            const unsigned char* kimg = ws + WS_K + ((size_t)(bh * 2 + c) * KT + tile) * 8192;
            float sdot = 0.f;
            for (int d = 0; d < 64; ++d) sdot += bf2f(q[d]) * bf2f(*(const bf16_t*)(kimg + (d >> 3) * 1024 + key * 16 + (d & 7) * 2));
            const float mn = fmaxf(mx[c], sdot), al = exp2f(mx[c] - mn), pe = exp2f(sdot - mn);
            const unsigned char* vimg = ws + WS_V + ((size_t)bh * KT + tile) * 16384;
            for (int e = 0; e < 2; ++e) { const int dv = lane + 64 * e; oc[c][e] = oc[c][e] * al + pe * bf2f(*(const bf16_t*)(vimg + (dv >> 5) * 4096 + key * 64 + (dv & 31) * 2)); }
            lsum[c] = lsum[c] * al + pe; mx[c] = mn;
        }
    }
    float o[2], ss = 0.f;
    for (int e = 0; e < 2; ++e) { o[e] = oc[0][e] / lsum[0] - lam * oc[1][e] / lsum[1]; ss += o[e] * o[e]; }
    ss = wave_sum(ss); const float rs = (1.f - LAM_INIT) / sqrtf(ss / 128.f + EPS);
    for (int e = 0; e < 2; ++e) { const int dv = lane + 64 * e; const float want = o[e] * rs * P.subln_w[dv];
        const float got = bf2f(((const bf16_t*)(ws + WS_MIX))[(size_t)(b * SEQ + i) * DM + h * 128 + dv]);
        dbg_max(dbg + 5, fabsf(got - want)); dbg_max(dbg + 6, fabsf(want)); }
}
DI void dbg_check_hgrn(const Params& P, char* lds_g, int bid, int nblk) {
    if (bid >= 32) return;
    LAS float* L = (LAS float*)lds_g;
    const int tid = tid_(), dv = tid & 127, qt = tid >> 7;
    const unsigned char* ws = P.ws; float* dbg = (float*)(ws + WS_CTL) + 64;
    const int bh = bid, b = bid >> 2, h = bid & 3;
    const float* HG = (const float*)(ws + WS_HG) + (size_t)bh * HT * 128;
    const bf16_t* HQ = (const bf16_t*)(ws + WS_HQ) + (size_t)bh * HT * 128;
    const bf16_t* HV = (const bf16_t*)(ws + WS_HV) + (size_t)bh * HT * 128;
    float S[32];
#pragma unroll
    for (int j = 0; j < 32; ++j) S[j] = 0.f;
    for (int pp = 16; pp < HT; ++pp) {
        if (tid < 128) { L[tid] = __expf(HG[(size_t)pp * 128 + tid]); L[128 + tid] = bf2f(HQ[(size_t)pp * 128 + tid]); L[256 + tid] = bf2f(HV[(size_t)pp * 128 + tid]); }
        __syncthreads();
        const float v = L[256 + dv]; float part = 0.f;
#pragma unroll
        for (int j = 0; j < 32; ++j) { const float f = L[32 * qt + j]; S[j] = f * S[j] + (1.f - f) * v; part += L[128 + 32 * qt + j] * S[j]; }
        L[384 + qt * 128 + dv] = part;
        __syncthreads();
        if (tid < 128) { const float o = L[384 + dv] + L[512 + dv] + L[640 + dv] + L[768 + dv]; L[896 + dv] = o; }
        __syncthreads();
        if (tid < 128 && pp >= 32) {
            float ss = 0.f; for (int j = 0; j < 128; ++j) ss += L[896 + j] * L[896 + j];
            const float rs = 1.f / sqrtf(ss / 128.f + EPS);
            const size_t row = (size_t)b * SEQ + (pp - 32);
            const float want = L[896 + dv] * rs * P.rec_norm_w[h * 128 + dv] * bf2f(((const bf16_t*)(ws + WS_SG))[row * 512 + h * 128 + dv]);
            const float got = bf2f(((const bf16_t*)(ws + WS_MIX))[row * DM + 512 + h * 128 + dv]);
            dbg_max(dbg + 7, fabsf(got - want)); dbg_max(dbg + 8, fabsf(want));
        }
        __syncthreads();
    }
}
#endif

#ifdef DBG_CHECK
DI float dbg_proj(const Params& P, int m, int c) {
    const float* xrow = (m < NTOK) ? P.x + (size_t)m * DM : P.meta + (size_t)(m - NTOK) * DM;
    float ss = 0.f, a = 0.f;
    for (int k = 0; k < DM; ++k) { const float xv = xrow[k]; ss += xv * xv; a += xv * P.mix_norm_w[k] * P.w_in[(size_t)k * NCOL1 + c]; }
    return a / sqrtf(ss / DM + EPS);
}
DI void dbg_check_gemm1(const Params& P, int bid, int nblk) {
    const unsigned char* ws = P.ws; float* dbg = (float*)(ws + WS_CTL) + 64;
    const int gt = bid * NTHREADS + tid_();
    if (gt >= 7 * 4096) return;
    const unsigned hsh = (unsigned)gt * 2654435761u;
    const int seg = gt % 7, cs = (hsh >> 7) & 511;
    const bool meta = ((gt / 7) & 15) == 0;
    const int m = meta ? NTOK + ((hsh >> 20) & 15) : (int)((hsh >> 3) % (unsigned)NTOK);
    const int b = meta ? (int)((hsh >> 25) & 7) : (m >> 12), t = meta ? (m - NTOK) : ((m & 4095) + NMETA);
    const int h = cs >> 7;
    float want = 0.f, got = 0.f;
    if (seg <= 1) {
        if (seg == 0 && meta) return;
        const int comp = (cs >> 6) & 1, d = cs & 63, dlo = d & 31;
        const float zlo = dbg_proj(P, m, seg * 512 + (cs & ~63) + dlo), zhi = dbg_proj(P, m, seg * 512 + (cs & ~63) + dlo + 32);
        const double inv = exp2(-(double)dlo * (13.287712379549449 / 32.0)); const float cv = (float)cos((double)t * inv), sv = (float)sin((double)t * inv);
        want = (d < 32) ? zlo * cv - zhi * sv : zhi * cv + zlo * sv;
        if (seg == 0) { want *= QSCALE; got = bf2f(((const bf16_t*)(ws + WS_Q))[((size_t)(((b * 4 + h) * 2 + comp) * SEQ + (m & 4095))) * 64 + d]); }
        else { const int pp = t + KPAD; got = bf2f(*(const bf16_t*)(ws + WS_K + ((size_t)((b * 4 + h) * 2 + comp) * KT + (pp >> 6)) * 8192 + (d >> 3) * 1024 + (pp & 63) * 16 + (d & 7) * 2)); }
    } else {
        const float z = dbg_proj(P, m, seg * 512 + cs); const int dv = cs & 127;
        if (seg == 2) { const int pp = t + KPAD; want = z; got = bf2f(*(const bf16_t*)(ws + WS_V + ((size_t)(b * 4 + h) * KT + (pp >> 6)) * 16384 + (dv >> 5) * 4096 + (pp & 63) * 64 + (dv & 31) * 2)); }
        else if (seg == 3) { want = siluf_(z); got = bf2f(((const bf16_t*)(ws + WS_HQ))[((size_t)(b * 4 + h) * HT + t + 16) * 128 + dv]); }
        else if (seg == 4) { const float l0 = P.lb_logits[cs], l1 = P.lb_logits[512 + cs], lb = __expf(l0) / (__expf(l0) + __expf(l1)); want = __logf(lb + (1.f - lb) * sigmoidf_(z)); got = ((const float*)(ws + WS_HG))[((size_t)(b * 4 + h) * HT + t + 16) * 128 + dv]; }
        else if (seg == 5) { want = z; got = bf2f(((const bf16_t*)(ws + WS_HV))[((size_t)(b * 4 + h) * HT + t + 16) * 128 + dv]); }
        else { if (meta) return; want = siluf_(z); got = bf2f(((const bf16_t*)(ws + WS_SG))[(size_t)m * 512 + cs]); }
    }
    dbg_max(dbg + 16 + seg + (meta ? 8 : 0), fabsf(got - want));
}
#endif
typedef unsigned u32x4v __attribute__((vector_size(16)));
DI float oct_sum(float v) {
    v += dpp_f<0xB1>(v); v += dpp_f<0x4E>(v); v += dpp_f<0x141>(v); return v;
}
DI unsigned my_xcc_id() { return (unsigned)__builtin_amdgcn_s_getreg((3 << 11) | 20) & 7u; }
constexpr int CTL_G1 = 16, CTL_G2 = 32;

DI void xn8_rows(const Params& P, int bid, int nblk) {
    const int tid = tid_(), lane = tid & 63, wave = __builtin_amdgcn_readfirstlane(tid >> 6);
    unsigned char* ws = P.ws;
    const int gw = bid * NWAVES + wave, NGW = nblk * NWAVES;
    f32x4 wv[4];
#pragma unroll
    for (int q = 0; q < 4; ++q) wv[q] = *(const f32x4*)(P.ffn_norm_w + 16 * lane + 4 * q);
    u32x4 ha, hb, na, nb_; float sq, nsq;
#define XN8_LD(n_, A, B, S) do { const bf16_t* hrow_ = (const bf16_t*)(ws + WS_XB) + (size_t)(n_) * DM + 16 * lane; A = *(const u32x4*)hrow_; B = *(const u32x4*)(hrow_ + 8); S = ((const float*)(ws + WS_SSQ))[n_]; } while (0)
    if (gw < NTOK) XN8_LD(gw, ha, hb, sq);
    for (int n = gw; n < NTOK; n += NGW) {
        if (n + NGW < NTOK) XN8_LD(n + NGW, na, nb_, nsq);
        const float r2 = 1.f / sqrtf(sq * (1.f / DM) + EPS);
        const unsigned hu[8] = {ha.x, ha.y, ha.z, ha.w, hb.x, hb.y, hb.z, hb.w};
        f32x4 t[4]; float am = 0.f;
#pragma unroll
        for (int q = 0; q < 4; ++q) { t[q] = (f32x4){bf2f(hu[2 * q] & 0xffffu), bf2f(hu[2 * q] >> 16), bf2f(hu[2 * q + 1] & 0xffffu), bf2f(hu[2 * q + 1] >> 16)} * wv[q] * r2; am = fmaxf(am, fmaxf(fmaxf(fabsf(t[q].x), fabsf(t[q].y)), fmaxf(fabsf(t[q].z), fabsf(t[q].w)))); }
        am = row16_max(am); am = fmaxf(fmaxf(readlane_f(am, 0), readlane_f(am, 16)), fmaxf(readlane_f(am, 32), readlane_f(am, 48)));
        const float sc = (am > 0.f) ? exp2f(floorf(log2f(224.f / am))) : 1.f;
        int w[4];
#pragma unroll
        for (int q = 0; q < 4; ++q) { w[q] = __builtin_amdgcn_cvt_pk_fp8_f32(t[q].x * sc, t[q].y * sc, 0, false); w[q] = __builtin_amdgcn_cvt_pk_fp8_f32(t[q].z * sc, t[q].w * sc, w[q], true); }
        *(u32x4*)(ws + WS_XN8 + (size_t)n * DM + 16 * lane) = (u32x4){(unsigned)w[0], (unsigned)w[1], (unsigned)w[2], (unsigned)w[3]};
        if (lane == 0) ((float*)(ws + WS_XSC))[n] = 1.f / sc;
        ha = na; hb = nb_; sq = nsq;
    }
#undef XN8_LD
}
typedef int i32x4 __attribute__((ext_vector_type(4)));
struct GMeta { i32x4 id[4]; f32x4 c[4]; u32x4 xq; };
template <int WHICH>
DI void g_meta(const Params& P, int n, int x, GMeta& M) {
    const int lane = tid_() & 63, i = lane & 7, g = lane >> 3;
    const i32x4* ip = (const i32x4*)((const int*)(P.ws + WS_EIDX) + (size_t)n * 128 + 16 * g);
#pragma unroll
    for (int q = 0; q < 4; ++q) M.id[q] = ip[q];
    if (WHICH == 1) M.xq = *(const u32x4*)(P.ws + WS_XN8 + (size_t)n * DM + 128 * x + 16 * i);
    else { const f32x4* cp = (const f32x4*)((const float*)(P.ws + WS_HID) + (size_t)n * 128 + 16 * g);
#pragma unroll
        for (int q = 0; q < 4; ++q) M.c[q] = cp[q]; }
}
DI void g_issue(int x, const GMeta& M, u32x4v (&rw)[16], __amdgpu_buffer_rsrc_t rs) {
    const int i = tid_() & 7;
    const unsigned lo = (unsigned)x * (unsigned)(NEXP * 128) + (unsigned)(16 * i);
#pragma unroll
    for (int j = 0; j < 16; ++j) rw[j] = __builtin_amdgcn_raw_buffer_load_b128(rs, ((unsigned)M.id[j >> 2][j & 3] << 7) + lo, 0, 0);
}
DI void g1_finish(const Params& P, int n, int x, u32x4 xq, const u32x4v (&rw)[16]) {
    const int lane = tid_() & 63, i = lane & 7, g = lane >> 3;
    f32x2 xv[8];
    xv[0] = __builtin_amdgcn_cvt_pk_f32_fp8((int)xq.x, false); xv[1] = __builtin_amdgcn_cvt_pk_f32_fp8((int)xq.x, true);
    xv[2] = __builtin_amdgcn_cvt_pk_f32_fp8((int)xq.y, false); xv[3] = __builtin_amdgcn_cvt_pk_f32_fp8((int)xq.y, true);
    xv[4] = __builtin_amdgcn_cvt_pk_f32_fp8((int)xq.z, false); xv[5] = __builtin_amdgcn_cvt_pk_f32_fp8((int)xq.z, true);
    xv[6] = __builtin_amdgcn_cvt_pk_f32_fp8((int)xq.w, false); xv[7] = __builtin_amdgcn_cvt_pk_f32_fp8((int)xq.w, true);
    float pd[16];
#pragma unroll
    for (int j = 0; j < 16; ++j) pd[j] = dot16_fp8(__builtin_bit_cast(u32x4, rw[j]), xv);
    const unsigned m1 = 0u - (unsigned)((i >> 2) & 1), m2 = 0u - (unsigned)(i & 1), m3 = 0u - (unsigned)((i >> 1) & 1);
#define BSEL(a, b, m) __uint_as_float((__float_as_uint(a) & ~(m)) | (__float_as_uint(b) & (m)))
    float z[8], w[4], u[2];
#pragma unroll
    for (int q = 0; q < 8; ++q) { const float snd = BSEL(pd[q + 8], pd[q], m1), kep = BSEL(pd[q], pd[q + 8], m1); z[q] = kep + dpp_f<0x141>(snd); }
#pragma unroll
    for (int q = 0; q < 4; ++q) { const float snd = BSEL(z[q + 4], z[q], m2), kep = BSEL(z[q], z[q + 4], m2); w[q] = kep + dpp_f<0xB1>(snd); }
#pragma unroll
    for (int q = 0; q < 2; ++q) { const float snd = BSEL(w[q + 2], w[q], m3), kep = BSEL(w[q], w[q + 2], m3); u[q] = kep + dpp_f<0x4E>(snd); }
    const int j0 = 8 * ((i >> 2) & 1) + 4 * (i & 1) + 2 * ((i >> 1) & 1);
#undef BSEL
    *(f32x2*)((float*)(P.ws + WS_HIDP) + ((size_t)x * NTOK + n) * 128 + 16 * g + j0) = (f32x2){u[0], u[1]};
}
DI void g2_finish(const Params& P, int n, int x, const f32x4 (&cv)[4], const u32x4v (&rw)[16]) {
    const int lane = tid_() & 63, i = lane & 7, g = lane >> 3;
    f32x2 acc[8];
#pragma unroll
    for (int q = 0; q < 8; ++q) acc[q] = (f32x2){0.f, 0.f};
#pragma unroll
    for (int j = 0; j < 16; ++j) {
        const float cj = cv[j >> 2][j & 3]; const f32x2 c = (f32x2){cj, cj}; const u32x4 w = __builtin_bit_cast(u32x4, rw[j]);
        acc[0] = __builtin_amdgcn_cvt_pk_f32_fp8((int)w.x, false) * c + acc[0]; acc[1] = __builtin_amdgcn_cvt_pk_f32_fp8((int)w.x, true) * c + acc[1];
        acc[2] = __builtin_amdgcn_cvt_pk_f32_fp8((int)w.y, false) * c + acc[2]; acc[3] = __builtin_amdgcn_cvt_pk_f32_fp8((int)w.y, true) * c + acc[3];
        acc[4] = __builtin_amdgcn_cvt_pk_f32_fp8((int)w.z, false) * c + acc[4]; acc[5] = __builtin_amdgcn_cvt_pk_f32_fp8((int)w.z, true) * c + acc[5];
        acc[6] = __builtin_amdgcn_cvt_pk_f32_fp8((int)w.w, false) * c + acc[6]; acc[7] = __builtin_amdgcn_cvt_pk_f32_fp8((int)w.w, true) * c + acc[7];
    }
    float y[16], z[8], w[4];
#pragma unroll
    for (int q = 0; q < 8; ++q) { y[2 * q] = acc[q].x; y[2 * q + 1] = acc[q].y; }
#pragma unroll
    for (int q = 0; q < 8; ++q) { auto rr = __builtin_amdgcn_permlane32_swap(__float_as_uint(y[q]), __float_as_uint(y[q + 8]), false, false); z[q] = __uint_as_float(rr[0]) + __uint_as_float(rr[1]); }
#pragma unroll
    for (int q = 0; q < 4; ++q) { auto rr = __builtin_amdgcn_permlane16_swap(__float_as_uint(z[q]), __float_as_uint(z[q + 4]), false, false); w[q] = __uint_as_float(rr[0]) + __uint_as_float(rr[1]); }
    const unsigned m3 = 0u - (unsigned)(g & 1);
#define BSEL(a, b, m) __uint_as_float((__float_as_uint(a) & ~(m)) | (__float_as_uint(b) & (m)))
    const float k0 = BSEL(w[0], w[2], m3) + dpp_f<0x128>(BSEL(w[2], w[0], m3)), k1 = BSEL(w[1], w[3], m3) + dpp_f<0x128>(BSEL(w[3], w[1], m3));
#undef BSEL
    float* hp = P.out + (size_t)n * DM + 128 * x + 16 * i + 2 * g;
    const f32x2 t = *(const f32x2*)hp + (f32x2){k0, k1}; *(f32x2*)hp = t;
    const float ss = wave_sum_dpp(t.x * t.x + t.y * t.y);
    if (lane == 0) atomicAdd((float*)(P.ws + WS_SSQ2) + n, ss);
}
constexpr int SL_CHUNK = 128, SL_T = SL_CHUNK / NWAVES;
#define SB() __builtin_amdgcn_sched_barrier(0)
template <int WHICH>
DI void g_chunk(const Params& P, int nbase, int x, __amdgpu_buffer_rsrc_t rs) {
    GMeta MA, MB; u32x4v RA[16], RB[16];
    g_meta<WHICH>(P, nbase, x, MA); SB(); g_meta<WHICH>(P, nbase + 8, x, MB); SB(); g_issue(x, MA, RA, rs); SB();
#pragma unroll
    for (int t = 0; t < SL_T; t += 2) {
        const u32x4 xA = MA.xq; const f32x4 cA[4] = {MA.c[0], MA.c[1], MA.c[2], MA.c[3]};
        if (t + 2 < SL_T) { g_meta<WHICH>(P, nbase + 8 * (t + 2), x, MA); SB(); }
        g_issue(x, MB, RB, rs); SB();
        if (WHICH == 1) g1_finish(P, nbase + 8 * t, x, xA, RA); else g2_finish(P, nbase + 8 * t, x, cA, RA);
        SB();
        const u32x4 xB = MB.xq; const f32x4 cB[4] = {MB.c[0], MB.c[1], MB.c[2], MB.c[3]};
        if (t + 3 < SL_T) { g_meta<WHICH>(P, nbase + 8 * (t + 3), x, MB); SB(); }
        if (t + 2 < SL_T) { g_issue(x, MA, RA, rs); SB(); }
        if (WHICH == 1) g1_finish(P, nbase + 8 * (t + 1), x, xB, RB); else g2_finish(P, nbase + 8 * (t + 1), x, cB, RB);
        SB();
    }
}
template <int WHICH>
DI void sliced_phase(const Params& P, char* lds_g) {
    const int tid = tid_(), wave = __builtin_amdgcn_readfirstlane(tid >> 6);
    unsigned* ctr = (unsigned*)(P.ws + WS_CTL) + (WHICH == 1 ? CTL_G1 : CTL_G2);
    const __amdgpu_buffer_rsrc_t rs = __builtin_amdgcn_make_buffer_rsrc((void*)(P.ws + (WHICH == 1 ? WS_UB : WS_VB)), 0, NEXP * DM, 0x00020000);
    const int x0 = (int)my_xcc_id();
    LAS int* slot = (LAS int*)((LAS char*)lds_g + LDS_ITEM);
    for (int s = 0; s < 8; ++s) {
        const int x = (x0 + s) & 7;
        for (;;) {
            if (tid == 0) *slot = (int)atomicAdd(ctr + x, 1u);
            __syncthreads();
            const int chunk = *slot;
            __syncthreads();
            if (chunk >= NTOK / SL_CHUNK) break;
            g_chunk<WHICH>(P, chunk * SL_CHUNK + wave, x, rs);
        }
    }
}
DI void hid_reduce_phase(const Params& P, int bid, int nblk) {
    const unsigned char* ws = P.ws;
    const size_t gt = (size_t)bid * NTHREADS + tid_(), NGT = (size_t)nblk * NTHREADS;
    const float* hp = (const float*)(ws + WS_HIDP);
    for (size_t o = gt; o < (size_t)NTOK * 128; o += NGT) {
        float a = 0.f;
#pragma unroll
        for (int x = 0; x < 8; ++x) a += hp[(size_t)x * NTOK * 128 + o];
        const int e = ((const int*)(ws + WS_EIDX))[o];
        const float d = a * ((const float*)(ws + WS_USC))[e] * ((const float*)(ws + WS_XSC))[o >> 7];
        ((float*)(ws + WS_HID))[o] = gelu_exact(d) * ((const float*)(ws + WS_EGATE))[o] * ((const float*)(ws + WS_VSC))[e];
    }
}
DI void final_norm_phase(const Params& P, int bid, int nblk) {
    const size_t gt = (size_t)bid * NTHREADS + tid_(), NGT = (size_t)nblk * NTHREADS;
    const float* ssq = (const float*)(P.ws + WS_SSQ2);
    for (size_t o = gt; o < (size_t)NTOK * DM / 4; o += NGT) {
        const size_t n = o >> 8; const int c4 = (int)(o & 255);
        const float rs = 1.f / sqrtf(ssq[n] * (1.f / DM) + EPS);
        f32x4* pp = (f32x4*)P.out + o;
        *pp = *pp * ((const f32x4*)P.final_w)[c4] * rs;
    }
}

typedef long i64_t;
constexpr int MG_HALF = 8192, MG_WAVE = 2 * MG_HALF;
#define MG_WAIT(N) asm volatile("s_waitcnt vmcnt(" #N ")" ::: "memory")
struct MgMeta { i32x4 id[4]; u32x4 a0, a1, a2, a3; };
template <int WHICH>
DI void mg_meta(const Params& P, int n, int x, MgMeta& M) {
    const int lane = tid_() & 63, g8 = lane >> 3, kg = lane >> 4;
    const int* ip = (const int*)(P.ws + WS_EIDX) + (size_t)n * 128 + 8 * g8;
    M.id[0] = *(const i32x4*)ip; M.id[1] = *(const i32x4*)(ip + 4); M.id[2] = *(const i32x4*)(ip + 64); M.id[3] = *(const i32x4*)(ip + 68);
    if (WHICH == 1) { const unsigned char* xr = P.ws + WS_XN8 + (size_t)n * DM + 256 * x + 16 * kg;
        M.a0 = *(const u32x4*)xr; M.a1 = *(const u32x4*)(xr + 64); M.a2 = *(const u32x4*)(xr + 128); M.a3 = *(const u32x4*)(xr + 192); }
    else { const unsigned char* cr = P.ws + WS_C8 + ((size_t)x * NTOK + n) * 128 + 16 * kg;
        M.a0 = *(const u32x4*)cr; M.a1 = *(const u32x4*)(cr + 64); }
}
DI void mg_issue(const unsigned char* slice, const MgMeta& M, int h, unsigned lbase) {
    const int lane = tid_() & 63, pos = lane & 7;
    const i32x4 ia = M.id[2 * h], ib = M.id[2 * h + 1];
    const int ids[8] = {ia.x, ia.y, ia.z, ia.w, ib.x, ib.y, ib.z, ib.w};
#pragma unroll
    for (int p = 0; p < 8; ++p) glds16_asm(slice + (size_t)(unsigned)ids[p] * 128 + 16 * (pos ^ p), lbase + p * 1024);
}
DI i64_t pk64(unsigned lo, unsigned hi) { return (i64_t)(((unsigned long long)hi << 32) | lo); }
typedef int i32x8 __attribute__((ext_vector_type(8)));
DI float mg1_half(const MgMeta& M, LAS char* hb) {
    const int lane = tid_() & 63, c = lane & 15, kg = lane >> 4;
    const i32x8 A0 = (i32x8){(int)M.a0.x, (int)M.a0.y, (int)M.a0.z, (int)M.a0.w, (int)M.a1.x, (int)M.a1.y, (int)M.a1.z, (int)M.a1.w};
    const i32x8 A1 = (i32x8){(int)M.a2.x, (int)M.a2.y, (int)M.a2.z, (int)M.a2.w, (int)M.a3.x, (int)M.a3.y, (int)M.a3.z, (int)M.a3.w};
    f32x4 d[4];
#pragma unroll
    for (int G = 0; G < 4; ++G) {
        const LAS char* row = hb + (c & 7) * 1024 + (2 * G + (c >> 3)) * 128;
        const u32x4 b0 = *(const LAS u32x4*)(row + ((kg ^ (c & 7)) << 4)), b1 = *(const LAS u32x4*)(row + (((kg + 4) ^ (c & 7)) << 4));
        d[G] = (f32x4){0.f, 0.f, 0.f, 0.f};
        d[G] = __builtin_amdgcn_mfma_scale_f32_16x16x128_f8f6f4(A0, (i32x8){(int)b0.x, (int)b0.y, (int)b0.z, (int)b0.w, 0, 0, 0, 0}, d[G], 0, 4, 0, 0x7F7F7F7F, 0, 0x7F7F7F7F);
        d[G] = __builtin_amdgcn_mfma_scale_f32_16x16x128_f8f6f4(A1, (i32x8){(int)b1.x, (int)b1.y, (int)b1.z, (int)b1.w, 0, 0, 0, 0}, d[G], 0, 4, 0, 0x7F7F7F7F, 0, 0x7F7F7F7F);
    }
    asm volatile("s_nop 15\n\ts_nop 15" : "+v"(d[0]), "+v"(d[1]), "+v"(d[2]), "+v"(d[3]));
    const float r01 = (kg & 1) ? d[1][0] : d[0][0], r23 = (kg & 1) ? d[3][0] : d[2][0];
    return (kg & 2) ? r23 : r01;
}
typedef int v2i_t __attribute__((ext_vector_type(2)));
DI void mg2_half(const MgMeta& M, int h, LAS char* hb, f32x4 (&D)[8]) {
    const int lane = tid_() & 63, c = lane & 15, g = lane >> 4;
    const u32x4 ch = h ? M.a1 : M.a0;
    const LAS char* rb = hb + (c & 7) * 1024 + (4 * (g & 1) + (c >> 3)) * 128 + 8 * (g >> 1);
#pragma unroll
    for (int t = 0; t < 8; ++t) {
        const unsigned mlo = (c == 4 * (t & 3)) ? 0xFFFFFFFFu : 0u, mhi = (c == 4 * (t & 3) + 1) ? 0xFFFFFFFFu : 0u;
        const i32x8 A = (i32x8){(int)(ch.x & mlo), (int)(ch.y & mlo), (int)(ch.z & mlo), (int)(ch.w & mlo), (int)(ch.x & mhi), (int)(ch.y & mhi), (int)(ch.z & mhi), (int)(ch.w & mhi)};
        const v2i_t b0 = __builtin_amdgcn_ds_read_tr4_b64_v2i32((LAS v2i_t*)(rb + ((t ^ (c & 7)) << 4)));
        const v2i_t b1 = __builtin_amdgcn_ds_read_tr4_b64_v2i32((LAS v2i_t*)(rb + 256 + ((t ^ (c & 7)) << 4)));
        D[t] = __builtin_amdgcn_mfma_scale_f32_16x16x128_f8f6f4(A, (i32x8){b0.x, b0.y, b1.x, b1.y, 0, 0, 0, 0}, D[t], 0, 4, 0, 0x7F7F7F7F, 0, 0x7F7F7F7F);
    }
}
template <int WHICH>
DI void mg_group(const Params& P, const unsigned char* slice, int n0, int x, LAS char* wl, unsigned wl_off, const MgMeta (&M)[4], MgMeta (&Mn)[4], bool more) {
    const int lane = tid_() & 63, kg = lane >> 4, c = lane & 15;
    bf16_t* outp = (bf16_t*)(P.ws + WS_HIDP) + (size_t)x * NTOK * (WHICH == 1 ? 128 : 256);
    f32x4 D[8];
    mg_issue(slice, M[0], 0, wl_off); SB();
#define MG_STEP(h, WAITSTMT) do { \
        if ((h) + 1 < 8) { mg_issue(slice, M[((h) + 1) >> 1], ((h) + 1) & 1, wl_off + (((h) + 1) & 1) * MG_HALF); } \
        else if (more) { _Pragma("unroll") for (int q_ = 0; q_ < 4; ++q_) mg_meta<WHICH>(P, n0 + 8 * (4 + q_), x, Mn[q_]); } \
        SB(); WAITSTMT; SB(); \
        LAS char* hb_ = wl + ((h) & 1) * MG_HALF; const int n_ = n0 + 8 * ((h) >> 1); \
        if (WHICH == 1) { const float r_ = mg1_half(M[(h) >> 1], hb_); outp[(size_t)n_ * 128 + 64 * ((h) & 1) + lane] = (bf16_t)f2bf(r_); } \
        else { if (((h) & 1) == 0) { _Pragma("unroll") for (int q_ = 0; q_ < 8; ++q_) D[q_] = (f32x4){0.f, 0.f, 0.f, 0.f}; } \
            mg2_half(M[(h) >> 1], (h) & 1, hb_, D); \
            if ((h) & 1) { asm volatile("s_nop 15\n\ts_nop 15" : "+v"(D[0]), "+v"(D[1]), "+v"(D[2]), "+v"(D[3]), "+v"(D[4]), "+v"(D[5]), "+v"(D[6]), "+v"(D[7])); \
                float v0_ = 0.f, v1_ = 0.f, v2_ = 0.f, v3_ = 0.f; _Pragma("unroll") for (int q_ = 0; q_ < 4; ++q_) { if (kg == q_) { v0_ = D[q_][0]; v1_ = D[q_][1]; v2_ = D[q_ + 4][0]; v3_ = D[q_ + 4][1]; } } \
                bf16_t* o_ = outp + (size_t)n_ * 256 + 32 * kg + c; o_[0] = (bf16_t)f2bf(v0_); o_[16] = (bf16_t)f2bf(v1_); o_[128] = (bf16_t)f2bf(v2_); o_[144] = (bf16_t)f2bf(v3_); } } \
        SB(); } while (0)
    if (WHICH == 1) {
        MG_STEP(0, MG_WAIT(8)); MG_STEP(1, MG_WAIT(9)); MG_STEP(2, MG_WAIT(9)); MG_STEP(3, MG_WAIT(9)); MG_STEP(4, MG_WAIT(9)); MG_STEP(5, MG_WAIT(9)); MG_STEP(6, MG_WAIT(9));
        if (more) { MG_STEP(7, MG_WAIT(33)); } else { MG_STEP(7, MG_WAIT(1)); }
    } else {
        MG_STEP(0, MG_WAIT(8)); MG_STEP(1, MG_WAIT(8)); MG_STEP(2, MG_WAIT(12)); MG_STEP(3, MG_WAIT(8)); MG_STEP(4, MG_WAIT(12)); MG_STEP(5, MG_WAIT(8)); MG_STEP(6, MG_WAIT(12));
        if (more) { MG_STEP(7, MG_WAIT(24)); } else { MG_STEP(7, MG_WAIT(0)); }
    }
#undef MG_STEP
}
template <int WHICH>
DI void mg_phase(const Params& P, char* lds_g) {
    const int tid = tid_(), wave = __builtin_amdgcn_readfirstlane(tid >> 6);
    unsigned* ctr = (unsigned*)(P.ws + WS_CTL) + (WHICH == 1 ? CTL_G1 : CTL_G2);
    const int x0 = (int)my_xcc_id();
    LAS int* slot = (LAS int*)((LAS char*)lds_g + LDS_ITEM);
    LAS char* wl = (LAS char*)lds_g + wave * MG_WAVE;
    const unsigned wl_off = (unsigned)__builtin_amdgcn_readfirstlane((int)(unsigned)(size_t)wl);
    constexpr int NSL = 4;
    for (int s = 0; s < NSL; ++s) {
        const int x = (x0 + s) & (NSL - 1);
        const unsigned char* slice = P.ws + (WHICH == 1 ? WS_UB : WS_VB) + (size_t)x * ((size_t)NEXP * 128);
        for (;;) {
            if (tid == 0) *slot = (int)atomicAdd(ctr + x, 1u);
            __syncthreads();
            const int chunk = *slot;
            __syncthreads();
            if (chunk >= NTOK / SL_CHUNK) break;
            const int nb = chunk * SL_CHUNK + wave;
            MgMeta MA[4], MB[4];
#pragma unroll
            for (int q = 0; q < 4; ++q) mg_meta<WHICH>(P, nb + 8 * q, x, MA[q]);
            mg_group<WHICH>(P, slice, nb, x, wl, wl_off, MA, MB, true);
            mg_group<WHICH>(P, slice, nb + 32, x, wl, wl_off, MB, MA, true);
            mg_group<WHICH>(P, slice, nb + 64, x, wl, wl_off, MA, MB, true);
            mg_group<WHICH>(P, slice, nb + 96, x, wl, wl_off, MB, MA, false);
            MG_WAIT(0);
        }
    }
}
struct Red1 { int e[2]; unsigned short hp[2][4]; float g[2]; float xs; };
struct Red2 { f32x4 us[2], vs[2]; };
DI void red_load1(const unsigned char* ws, int n, int lane, Red1& R) {
    const bf16_t* hp = (const bf16_t*)(ws + WS_HIDP);
    R.xs = ((const float*)(ws + WS_XSC))[n];
#pragma unroll
    for (int q = 0; q < 2; ++q) {
        const size_t o = (size_t)n * 128 + 64 * q + lane;
        R.e[q] = ((const int*)(ws + WS_EIDX))[o];
        R.g[q] = ((const float*)(ws + WS_EGATE))[o];
#pragma unroll
        for (int x = 0; x < 4; ++x) R.hp[q][x] = (unsigned short)hp[(size_t)x * NTOK * 128 + o];
    }
}
DI void red_load2(const unsigned char* ws, const Red1& R, Red2& G) {
#pragma unroll
    for (int q = 0; q < 2; ++q) { G.us[q] = *(const f32x4*)((const float*)(ws + WS_USC) + (size_t)R.e[q] * 4); G.vs[q] = *(const f32x4*)((const float*)(ws + WS_VSC) + (size_t)R.e[q] * 4); }
}
DI void red_finish(unsigned char* ws, int n, int lane, const Red1& R, const Red2& G) {
    f32x4 cv[2]; f32x4 am = (f32x4){0.f, 0.f, 0.f, 0.f};
#pragma unroll
    for (int q = 0; q < 2; ++q) {
        float a = 0.f;
#pragma unroll
        for (int x = 0; x < 4; ++x) a += bf2f(R.hp[q][x]) * G.us[q][x];
        const float cf = gelu_exact(a * R.xs) * R.g[q];
        cv[q] = G.vs[q] * cf;
        am.x = fmaxf(am.x, fabsf(cv[q].x)); am.y = fmaxf(am.y, fabsf(cv[q].y)); am.z = fmaxf(am.z, fabsf(cv[q].z)); am.w = fmaxf(am.w, fabsf(cv[q].w));
    }
    f32x4 isc;
#pragma unroll
    for (int x = 0; x < 4; ++x) {
        float m = row16_max(am[x]); m = fmaxf(fmaxf(readlane_f(m, 0), readlane_f(m, 16)), fmaxf(readlane_f(m, 32), readlane_f(m, 48)));
        const float sc = (m > 0.f) ? exp2f(floorf(log2f(224.f / m))) : 1.f;
        const int w0 = __builtin_amdgcn_cvt_pk_fp8_f32(cv[0][x] * sc, cv[1][x] * sc, 0, false);
        unsigned char* cr = ws + WS_C8 + ((size_t)x * NTOK + n) * 128;
        cr[lane] = (unsigned char)(w0 & 255); cr[64 + lane] = (unsigned char)((w0 >> 8) & 255);
        isc[x] = 1.f / sc;
    }
    if (lane == 0) *(f32x4*)((float*)(ws + WS_CSC) + (size_t)n * 4) = isc;
}
DI void hid_reduce8_phase(const Params& P, int bid, int nblk) {
    const int tid = tid_(), lane = tid & 63, wave = __builtin_amdgcn_readfirstlane(tid >> 6);
    unsigned char* ws = P.ws;
    const int gw = bid * NWAVES + wave, NGW = nblk * NWAVES;
    Red1 r0, r1, r2; Red2 g0, g1;
    if (gw < NTOK) red_load1(ws, gw, lane, r0);
    if (gw + NGW < NTOK) red_load1(ws, gw + NGW, lane, r1);
    if (gw < NTOK) red_load2(ws, r0, g0);
    for (int n = gw; n < NTOK; n += NGW) {
        if (n + 2 * NGW < NTOK) red_load1(ws, n + 2 * NGW, lane, r2);
        if (n + NGW < NTOK) red_load2(ws, r1, g1);
        red_finish(ws, n, lane, r0, g0);
        r0 = r1; r1 = r2; g0 = g1;
    }
}
DI void final_norm8_phase(const Params& P, int bid, int nblk) {
    const int tid = tid_(), lane = tid & 63, wave = __builtin_amdgcn_readfirstlane(tid >> 6);
    const unsigned char* ws = P.ws;
    const int gw = bid * NWAVES + wave, NGW = nblk * NWAVES;
    f32x4 wv[4];
#pragma unroll
    for (int q = 0; q < 4; ++q) wv[q] = *(const f32x4*)(P.final_w + 16 * lane + 4 * q);
    for (int n = gw; n < NTOK; n += NGW) {
        float* orow = P.out + (size_t)n * DM + 16 * lane;
        const bf16_t* yrow = (const bf16_t*)(ws + WS_HIDP) + ((size_t)(lane >> 4) * NTOK + n) * 256 + 16 * (lane & 15);
        const u32x4 ya = *(const u32x4*)yrow, yb = *(const u32x4*)(yrow + 8);
        const unsigned yu[8] = {ya.x, ya.y, ya.z, ya.w, yb.x, yb.y, yb.z, yb.w};
        const float cs = ((const float*)(ws + WS_CSC))[(size_t)n * 4 + (lane >> 4)];
        const bf16_t* hrow = (const bf16_t*)(ws + WS_XB) + (size_t)n * DM + 16 * lane;
        const u32x4 ha = *(const u32x4*)hrow, hb = *(const u32x4*)(hrow + 8);
        const unsigned hu[8] = {ha.x, ha.y, ha.z, ha.w, hb.x, hb.y, hb.z, hb.w};
        f32x4 h[4]; float ss = 0.f;
#pragma unroll
        for (int q = 0; q < 4; ++q) { h[q] = (f32x4){bf2f(hu[2 * q] & 0xffffu), bf2f(hu[2 * q] >> 16), bf2f(hu[2 * q + 1] & 0xffffu), bf2f(hu[2 * q + 1] >> 16)} + (f32x4){bf2f(yu[2 * q] & 0xffffu), bf2f(yu[2 * q] >> 16), bf2f(yu[2 * q + 1] & 0xffffu), bf2f(yu[2 * q + 1] >> 16)} * cs; ss += (h[q].x * h[q].x + h[q].y * h[q].y) + (h[q].z * h[q].z + h[q].w * h[q].w); }
        ss = wave_sum_dpp(ss);
        const float rs = 1.f / sqrtf(ss * (1.f / DM) + EPS);
#pragma unroll
        for (int q = 0; q < 4; ++q) *(f32x4*)(orow + 4 * q) = h[q] * wv[q] * rs;
    }
}

#define XB_TMO      128
#define XB_XCNT(j)  (256  + 64 * (j))
#define XB_XSUB(j)  (1280 + 64 * (j))
#define XB_XGEN(j)  (2304 + 64 * (j))
#define XB_TOP      3328
#define XB_TOPGEN   3392
#define XCD_BAR_WORDS 3456
#define XB_SPIN_CAP (1u << 18)

__device__ __forceinline__ unsigned xb_ld(unsigned* p)              { return __hip_atomic_load(p, __ATOMIC_RELAXED, __HIP_MEMORY_SCOPE_AGENT); }
__device__ __forceinline__ unsigned xb_add(unsigned* p, unsigned v) { return __hip_atomic_fetch_add(p, v, __ATOMIC_RELAXED, __HIP_MEMORY_SCOPE_AGENT); }
__device__ __forceinline__ unsigned xb_xcc_id() { return (unsigned)__builtin_amdgcn_s_getreg((3 << 11) | 20) & 0xFu; }
#define XB_SPIN(cond, bar) do { unsigned _sp = 0; while (cond) { __builtin_amdgcn_s_sleep(1); \
    if ((++_sp & 255u) == 0u) { if (xb_ld(&(bar)[XB_TMO])) break; if (_sp > XB_SPIN_CAP) { atomicAdd(&(bar)[XB_TMO], 1u); break; } } } } while (0)

struct XcdBarrier {
    unsigned* bar; unsigned x;
    volatile LAS unsigned* st;
};

__device__ __forceinline__ XcdBarrier xcd_barrier_post(unsigned* bar, volatile LAS unsigned* st) {
    XcdBarrier b; b.bar = bar; b.x = xb_xcc_id(); b.st = st;
    if (threadIdx.x == 0) (void)xb_add(&bar[XB_XCNT(b.x)], 1u);
    return b;
}
__device__ __forceinline__ void xcd_barrier_complete(unsigned* bar, unsigned x, unsigned& nloc, unsigned& nx) {
    const unsigned G = gridDim.x * gridDim.y * gridDim.z;
    unsigned sum, cnt, mine, sp = 0u;
    for (;;) {
        sum = 0u; cnt = 0u; mine = 0u;
#pragma unroll
        for (unsigned j = 0; j < 16; ++j) { const unsigned c = xb_ld(&bar[XB_XCNT(j)]); sum += c; cnt += (c > 0u) ? 1u : 0u; mine = (j == x) ? c : mine; }
        if (sum == G) break;
        __builtin_amdgcn_s_sleep(1);
        if ((++sp & 255u) == 0u) { if (xb_ld(&bar[XB_TMO])) break; if (sp > XB_SPIN_CAP) { atomicAdd(&bar[XB_TMO], 1u); break; } }
    }
    nloc = mine > 0u ? mine : 1u; nx = cnt > 0u ? cnt : 1u;
}

__device__ __forceinline__ void xcd_barrier(const XcdBarrier& b) {
    asm volatile("s_waitcnt vmcnt(0)" ::: "memory");
    __syncthreads();
    if (threadIdx.x == 0) {
        unsigned* bar = b.bar;
        __builtin_amdgcn_s_waitcnt(0);
        unsigned nloc = b.st[0], nx = b.st[1];
        if (nloc == 0u) { xcd_barrier_complete(bar, b.x, nloc, nx); b.st[0] = nloc; b.st[1] = nx; }
        const unsigned old = xb_add(&bar[XB_XSUB(b.x)], 1u);
        const unsigned gen = old / nloc;
        if (old + 1u == (gen + 1u) * nloc) {
            __builtin_amdgcn_fence(__ATOMIC_RELEASE, "agent");
            asm volatile("s_waitcnt vmcnt(0)" ::: "memory");
            const unsigned og = xb_add(&bar[XB_TOP], 1u);
            const unsigned tg = og / nx;
            if (og + 1u == (tg + 1u) * nx) xb_add(&bar[XB_TOPGEN], 1u);
            else XB_SPIN(xb_ld(&bar[XB_TOPGEN]) == tg, bar);
            __builtin_amdgcn_fence(__ATOMIC_ACQUIRE, "agent");
            xb_add(&bar[XB_XGEN(b.x)], 1u);
            asm volatile("s_waitcnt vmcnt(0)" ::: "memory");
        } else {
            XB_SPIN(xb_ld(&bar[XB_XGEN(b.x)]) == gen, bar);
            __builtin_amdgcn_fence(__ATOMIC_ACQUIRE, "agent");
            asm volatile("s_waitcnt vmcnt(0)" ::: "memory");
        }
    }
    __syncthreads();
}

constexpr int CTL_XB_WORD = 2048;
static_assert((CTL_XB_WORD + 3456) * 4 <= (int)CTL_BYTES, "barrier words inside CTL");
constexpr int N_HGRN_ITEMS = BATCH * 4, N_ATT_ITEMS = BATCH * 4 * 32;

DI void mixer_phase(const Params& P, char* lds) {
    unsigned* ctr = (unsigned*)(P.ws + WS_CTL);
    for (;;) {
        if (tid_() == 0) *(LAS int*)((LAS char*)lds + LDS_ITEM) = (int)atomicAdd(ctr, 1u);
        __syncthreads();
        const int item = *(LAS int*)((LAS char*)lds + LDS_ITEM);
        __syncthreads();
        if (item >= N_HGRN_ITEMS + N_ATT_ITEMS) break;
        if (item < N_HGRN_ITEMS) hgrn_unit(P, item >> 2, item & 3, lds);
        else { const int a = item - N_HGRN_ITEMS, j = 31 - (a >> 5), bh = a & 31; attn_unit(P, bh >> 2, bh & 3, j, lds); }
    }
}

#ifdef TS_PHASE
#ifndef TS_DIV
#define TS_DIV 4.0f
#endif
#ifndef TS_OFF
#define TS_OFF 0.0f
#endif
#define TS(i) do { if (blockIdx.x == 0 && threadIdx.x == 0) ((LAS unsigned long long*)((LAS char*)lds + LDS_BYTES - 512))[i] = __builtin_amdgcn_s_memrealtime(); } while (0)
#else
#define TS(i) do { } while (0)
#endif
__global__ void __launch_bounds__(NTHREADS, 2) fwd_megakernel(Params P) {
    extern __shared__ __attribute__((aligned(16))) char lds[];
    cg::grid_group grid = cg::this_grid();
    const int bid = blockIdx.x, nblk = gridDim.x;
    unsigned char* ws = P.ws;
    volatile LAS unsigned* xst = (volatile LAS unsigned*)((LAS char*)lds + LDS_XB);
    if (threadIdx.x < 4) xst[threadIdx.x] = 0u;
    __syncthreads();
    const XcdBarrier xbar = xcd_barrier_post((unsigned*)(ws + WS_CTL) + CTL_XB_WORD, xst);
    TS(0);
    phase0(P, lds, bid, nblk);
    xcd_barrier(xbar);
    TS(1);
    { Epi1 e{ws}; gemm_run(lds, (const bf16_t*)(ws + WS_XB), (const bf16_t*)(ws + WS_W1T), M1, NCOL1, DM, e, bid, nblk); }
    {
        constexpr int NUNITS = (M1 / 256) * (NCOL1 / 256);
        const int nlast = NUNITS % nblk, nfree = nlast ? nblk - nlast : nblk;
        const int wave = __builtin_amdgcn_readfirstlane(tid_() >> 6);
        if (nlast == 0 || bid >= nlast) table_fp8_rows(P, NEXP + (bid - (nlast ? nlast : 0)) * NWAVES + wave, nfree * NWAVES, 2 * NEXP);
    }
    xcd_barrier(xbar);
    TS(2);
    for (int it = bid; it < 32 * 129; it += nblk) hgrn_prep_item(P, it & 31, it >> 5, lds);
    xcd_barrier(xbar);
    TS(3);
    mixer_phase(P, lds);
    xcd_barrier(xbar);
    TS(4);
    { Epi3 e{P.x, P.out, (bf16_t*)(ws + WS_XB), (float*)(ws + WS_SSQ)}; gemm_run(lds, (const bf16_t*)(ws + WS_MIX), (const bf16_t*)(ws + WS_W2T), NTOK, DM, DM, e, bid, nblk); }
    xcd_barrier(xbar);
    TS(5);
    { Epi4 e{(const float*)(ws + WS_SSQ), (bf16_t*)(ws + WS_PQ)}; gemm_run(lds, (const bf16_t*)(ws + WS_XB), (const bf16_t*)(ws + WS_W3T), NTOK, 2048, DM, e, bid, nblk); }
    xcd_barrier(xbar);
    TS(6);
    topk_phase(P, lds, bid, nblk);
    xn8_rows(P, bid, nblk);
    xcd_barrier(xbar);
    TS(7);
    mg_phase<1>(P, lds);
    xcd_barrier(xbar);
    TS(8);
    hid_reduce8_phase(P, bid, nblk);
    xcd_barrier(xbar);
    TS(9);
    mg_phase<2>(P, lds);
    xcd_barrier(xbar);
    TS(10);
    final_norm8_phase(P, bid, nblk);
    TS(11);
#ifdef TS_PHASE
    if (blockIdx.x == 0 && threadIdx.x == 0) { const LAS unsigned long long* t = (const LAS unsigned long long*)((LAS char*)lds + LDS_BYTES - 512);
        P.out[0] += ((float)(t[TS_PHASE + 1] - t[TS_PHASE]) * 0.01f - TS_OFF) / TS_DIV; }
#endif
}

extern "C" void kernel_launch(void* const* d_in, const int* in_sizes, int n_in, void* d_out, int out_size, void* d_ws, size_t ws_size, hipStream_t stream) {
    static int grid = 0;
    if (grid == 0) {
        int dev = 0, cus = 0, per_cu = 0;
        (void)hipGetDevice(&dev);
        (void)hipDeviceGetAttribute(&cus, hipDeviceAttributeMultiprocessorCount, dev);
        (void)hipFuncSetAttribute((const void*)fwd_megakernel, hipFuncAttributeMaxDynamicSharedMemorySize, LDS_BYTES);
        (void)hipOccupancyMaxActiveBlocksPerMultiprocessor(&per_cu, (const void*)fwd_megakernel, NTHREADS, LDS_BYTES);
        if (per_cu < 1) { fprintf(stderr, "kernel_launch: occupancy query says %d blocks per CU\n", per_cu); per_cu = 1; }
        grid = cus * 1;
        if (ws_size < WS_END) { fprintf(stderr, "kernel_launch: workspace too small: %zu < %zu\n", ws_size, (size_t)WS_END); grid = -1; }
    }
    if (grid < 0) return;
    Params p{};
    p.x = (const float*)d_in[0]; p.meta = (const float*)d_in[1]; p.mix_norm_w = (const float*)d_in[2]; p.w_in = (const float*)d_in[3];
    p.lb_logits = (const float*)d_in[4]; p.rec_norm_w = (const float*)d_in[5]; p.lq1 = (const float*)d_in[6]; p.lk1 = (const float*)d_in[7];
    p.lq2 = (const float*)d_in[8]; p.lk2 = (const float*)d_in[9]; p.subln_w = (const float*)d_in[10]; p.w_out = (const float*)d_in[11];
    p.ffn_norm_w = (const float*)d_in[12]; p.wq = (const float*)d_in[13]; p.subkeys = (const float*)d_in[14]; p.pu = (const float*)d_in[15];
    p.pv = (const float*)d_in[16]; p.final_w = (const float*)d_in[17];
    p.out = (float*)d_out; p.ws = (unsigned char*)d_ws;
    (void)hipMemsetAsync((char*)d_ws + WS_CTL, 0, CTL_BYTES, stream);
    void* args[] = {&p};
    hipError_t e = hipLaunchCooperativeKernel((const void*)fwd_megakernel, dim3(grid), dim3(NTHREADS), args, LDS_BYTES, stream);
    if (e != hipSuccess) fprintf(stderr, "cooperative launch failed: %s (grid %d)\n", hipGetErrorString(e), grid);
}
```

```cpp
#include <hip/hip_runtime.h>
#include <hip/hip_cooperative_groups.h>
#include <cstdio>
#include <cstdint>
#define DBG_SEL 1
namespace cg = cooperative_groups;

constexpr int BATCH = 8, SEQ = 4096, DM = 1024, NMETA = 16;
constexpr int NTOK = BATCH * SEQ;
constexpr int M1 = NTOK + 256;
constexpr int NCOL1 = 3584;
constexpr int TPOS = NMETA + SEQ;
constexpr int KT = 65;
constexpr int KPAD = 48;
constexpr int HT = 4128;
constexpr int NEXP = 16384;
constexpr float EPS = 1e-6f;
constexpr float LAM_INIT = 0.2f;
constexpr float QSCALE = 0.125f * 1.4426950408889634f;
constexpr int NTHREADS = 512, NWAVES = 8;
constexpr int LDS_BYTES = 163840;
constexpr int LDS_ITEM = LDS_BYTES - 64, LDS_XB = LDS_BYTES - 32;

typedef unsigned short bf16_t;
typedef short bf16x8 __attribute__((ext_vector_type(8)));
typedef float f32x4 __attribute__((ext_vector_type(4)));
typedef float f32x16 __attribute__((ext_vector_type(16)));
typedef float f32x2 __attribute__((ext_vector_type(2)));
typedef unsigned u32x4 __attribute__((ext_vector_type(4)));
typedef unsigned u32x2 __attribute__((ext_vector_type(2)));
typedef __bf16 bf16x2_t __attribute__((ext_vector_type(2)));
typedef short s16x4 __attribute__((ext_vector_type(4)));
#define LAS __attribute__((address_space(3)))
#define DI __device__ __forceinline__
__device__ __forceinline__ int tid_() { int t = threadIdx.x; asm volatile("" : "+v"(t)); return t; }

constexpr size_t al256(size_t x) { return (x + 255) & ~(size_t)255; }
constexpr size_t WS_CTL = 0, CTL_BYTES = 65536;
constexpr size_t WS_W1T = WS_CTL + CTL_BYTES;
constexpr size_t WS_W2T = WS_W1T + (size_t)NCOL1 * DM * 2;
constexpr size_t WS_W3T = WS_W2T + (size_t)DM * DM * 2;
constexpr size_t WS_SKB = WS_W3T + (size_t)2048 * DM * 2;
constexpr size_t WS_UB = WS_SKB + (size_t)16 * 128 * 128 * 2;
constexpr size_t WS_VB = WS_UB + (size_t)NEXP * DM * 2;
constexpr size_t WS_USC = WS_UB + (size_t)NEXP * DM, WS_VSC = WS_VB + (size_t)NEXP * DM;
constexpr size_t WS_ROPE = WS_VB + (size_t)NEXP * DM * 2;
constexpr size_t WS_LB = WS_ROPE + (size_t)TPOS * 64 * 4;
constexpr size_t WS_R1 = WS_LB + 4096;
constexpr size_t WS_SSQ = WS_R1 + al256((size_t)M1 * 4);
constexpr size_t WS_SSQ2 = WS_SSQ + (size_t)NTOK * 4;
constexpr size_t WS_XB = WS_SSQ2 + (size_t)NTOK * 4;
constexpr size_t WS_C = WS_XB + (size_t)M1 * DM * 2;
constexpr size_t WS_Q = WS_C;
constexpr size_t WS_K = WS_Q + (size_t)NTOK * 512 * 2;
constexpr size_t WS_V = WS_K + (size_t)BATCH * 4 * 2 * KT * 8192;
constexpr size_t WS_HQ = WS_V + (size_t)BATCH * 4 * KT * 16384;
constexpr size_t WS_HV = WS_HQ + (size_t)BATCH * 4 * HT * 128 * 2;
constexpr size_t WS_HG = WS_HV + (size_t)BATCH * 4 * HT * 128 * 2;
constexpr size_t WS_SG = WS_HG + (size_t)BATCH * 4 * HT * 128 * 4;
constexpr size_t WS_CEND = WS_SG + (size_t)NTOK * 512 * 2;
constexpr size_t WS_PQ = WS_C;
constexpr size_t WS_EIDX = WS_PQ + (size_t)NTOK * 2048 * 2;
constexpr size_t WS_EGATE = WS_EIDX + (size_t)NTOK * 128 * 4;
constexpr size_t WS_HID = WS_EGATE + (size_t)NTOK * 128 * 4;
constexpr size_t WS_XN8 = WS_HID + (size_t)NTOK * 128 * 4;
constexpr size_t WS_XSC = WS_XN8 + (size_t)NTOK * DM;
constexpr size_t WS_C8 = WS_XSC + (size_t)NTOK * 4;
constexpr size_t WS_CSC = WS_C8 + (size_t)NTOK * 128 * 4;
static_assert(WS_CSC + (size_t)NTOK * 16 <= WS_CEND, "overlay fits");
constexpr size_t WS_HIDP = WS_PQ;
constexpr size_t WS_MIX = WS_CEND;
constexpr size_t WS_HQA = WS_MIX + (size_t)NTOK * DM * 2;
constexpr size_t WS_HD = WS_HQA + (size_t)BATCH * 4 * HT * 128 * 2;
constexpr size_t WS_END = WS_HD + (size_t)BATCH * 4 * 129 * 128 * 4;
static_assert(WS_END <= (size_t)512 * 1024 * 1024, "workspace map must fit 512 MiB");

struct Params {
    const float* x; const float* meta; const float* mix_norm_w; const float* w_in; const float* lb_logits; const float* rec_norm_w;
    const float* lq1; const float* lk1; const float* lq2; const float* lk2; const float* subln_w; const float* w_out; const float* ffn_norm_w;
    const float* wq; const float* subkeys; const float* pu; const float* pv; const float* final_w;
    float* out; unsigned char* ws;
};

DI unsigned f2bf(float f) { unsigned u = __builtin_bit_cast(unsigned, f); return (u + 0x7fffu + ((u >> 16) & 1u)) >> 16; }
DI float bf2f(unsigned b) { return __builtin_bit_cast(float, b << 16); }
DI unsigned cvtpk(float lo, float hi) { f32x2 v = {lo, hi}; bf16x2_t b = __builtin_convertvector(v, bf16x2_t); return __builtin_bit_cast(unsigned, b); }
DI float wave_sum(float v) {
#pragma unroll
    for (int o = 1; o < 64; o <<= 1) v += __shfl_xor(v, o);
    return v;
}
DI float sigmoidf_(float x) { return 1.f / (1.f + __expf(-x)); }
DI float siluf_(float x) { return x * sigmoidf_(x); }

DI int sigma_col(int c) {
    if (c >= 1024) return c;
    const int cc = c & 63, a = cc >> 5, fq = (cc >> 3) & 3, n = (cc >> 2) & 1, j = cc & 3;
    return (c & ~63) + 4 * (4 * a + fq) + 32 * n + j;
}
template <bool PERMUTE>
DI void p0_transpose_item(const float* W, int K, int N, const float* scale, bf16_t* WT, LAS float* scr, int item, int lane) {
    const int nblk = N / 32, kb = item / nblk, nb = item % nblk, k0 = 64 * kb, n0 = 32 * nb;
    const int ncol = PERMUTE ? sigma_col(n0 + (lane & 31)) : n0 + (lane & 31);
#pragma unroll 8
    for (int i = 0; i < 32; ++i) { const int kk = 2 * i + (lane >> 5); float s = scale ? scale[k0 + kk] : 1.f; scr[kk * 33 + (lane & 31)] = W[(size_t)(k0 + kk) * N + ncol] * s; }
    asm volatile("s_waitcnt lgkmcnt(0)" ::: "memory");
    const int c = lane & 7;
#pragma unroll
    for (int j = 0; j < 4; ++j) { const int n = (lane >> 3) + 8 * j; const LAS float* s = scr + (8 * c) * 33 + n;
        u32x4 o; o.x = cvtpk(s[0 * 33], s[1 * 33]); o.y = cvtpk(s[2 * 33], s[3 * 33]); o.z = cvtpk(s[4 * 33], s[5 * 33]); o.w = cvtpk(s[6 * 33], s[7 * 33]);
        *(u32x4*)(WT + (size_t)(n0 + n) * K + k0 + 8 * c) = o; }
    asm volatile("s_waitcnt lgkmcnt(0)" ::: "memory");
}

DI unsigned fp4_code(float x, float sc) {
    const float a = fabsf(x) * sc;
    const unsigned idx = (unsigned)(a > 0.25f) + (unsigned)(a > 0.75f) + (unsigned)(a > 1.25f) + (unsigned)(a > 1.75f) + (unsigned)(a > 2.5f) + (unsigned)(a > 3.5f) + (unsigned)(a > 5.0f);
    return idx | (x < 0.f ? 8u : 0u);
}
template <int CTRL> DI float dpp_f(float v) { return __builtin_bit_cast(float, __builtin_amdgcn_update_dpp(0, __builtin_bit_cast(int, v), CTRL, 0xf, 0xf, false)); }
DI float row16_max(float v) { v = fmaxf(v, dpp_f<0x128>(v)); v = fmaxf(v, dpp_f<0x124>(v)); v = fmaxf(v, dpp_f<0x122>(v)); v = fmaxf(v, dpp_f<0x121>(v)); return v; }
DI float row16_sum(float v) { v += dpp_f<0x128>(v); v += dpp_f<0x124>(v); v += dpp_f<0x122>(v); v += dpp_f<0x121>(v); return v; }
DI float readlane_f(float v, int l) { return __builtin_bit_cast(float, __builtin_amdgcn_readlane(__builtin_bit_cast(int, v), l)); }
DI void table_row_load(const Params& P, int r, int lane, f32x4 (&v)[4]) {
    const bool isv = r >= NEXP; const int e = isv ? r - NEXP : r;
    const f32x4* src = (const f32x4*)((isv ? P.pv : P.pu) + (size_t)e * DM) + lane;
#pragma unroll
    for (int q = 0; q < 4; ++q) v[q] = src[64 * q];
}
DI void table_row_finish(const Params& P, int r, int lane, const f32x4 (&v)[4]) {
    unsigned char* ws = P.ws;
    const bool isv = r >= NEXP; const int e = isv ? r - NEXP : r;
    unsigned char* tb = ws + (isv ? WS_VB : WS_UB); float* scp = (float*)(ws + (isv ? WS_VSC : WS_USC));
    f32x4 isc;
#pragma unroll
    for (int q = 0; q < 4; ++q) {
        float am = fmaxf(fmaxf(fabsf(v[q].x), fabsf(v[q].y)), fmaxf(fabsf(v[q].z), fabsf(v[q].w)));
        am = row16_max(am); am = fmaxf(fmaxf(readlane_f(am, 0), readlane_f(am, 16)), fmaxf(readlane_f(am, 32), readlane_f(am, 48)));
        const float sc = (am > 0.f) ? 6.f / am : 1.f;
        unsigned w = __builtin_amdgcn_cvt_scalef32_pk_fp4_f32(0u, v[q].x * sc, v[q].y * sc, 1.0f, 0); w = __builtin_amdgcn_cvt_scalef32_pk_fp4_f32(w, v[q].z * sc, v[q].w * sc, 1.0f, 1);
        *(unsigned short*)(tb + ((size_t)q * NEXP + e) * 128 + 2 * lane) = (unsigned short)w;
        isc[q] = 1.f / sc;
    }
    if (lane == 0) *(f32x4*)(scp + (size_t)e * 4) = isc;
}
DI void table_fp8_rows(const Params& P, int first, int stride, int r_end) {
    const int lane = tid_() & 63;
    f32x4 a[4], b[4];
    int r = first;
    if (r < r_end) table_row_load(P, r, lane, a);
    for (; r < r_end; r += stride) {
        const int rn = r + stride;
        if (rn < r_end) table_row_load(P, rn, lane, b);
        table_row_finish(P, r, lane, a);
#pragma unroll
        for (int q = 0; q < 4; ++q) a[q] = b[q];
    }
}

__device__ const double ROPE_INV[32] = {
    1.0, 0.7498942093324559, 0.5623413251903491, 0.4216965034285822, 0.31622776601683794, 0.23713737056616552, 0.1778279410038923, 0.1333521432163324,
    0.1, 0.07498942093324558, 0.05623413251903491, 0.042169650342858224, 0.03162277660168379, 0.023713737056616554, 0.01778279410038923, 0.01333521432163324,
    0.01, 0.007498942093324558, 0.005623413251903491, 0.004216965034285823, 0.0031622776601683794, 0.0023713737056616554, 0.0017782794100389228, 0.001333521432163324,
    0.001, 0.0007498942093324559, 0.0005623413251903491, 0.00042169650342858224, 0.00031622776601683794, 0.00023713737056616554, 0.00017782794100389227, 0.0001333521432163324};
DI void p0_row_load(const Params& P, int m, int lane, f32x4 (&v)[4]) {
    if (m >= NTOK + NMETA) {
#pragma unroll
        for (int j = 0; j < 4; ++j) v[j] = (f32x4){0.f, 0.f, 0.f, 0.f};
        return; }
    const float* xrow = (m < NTOK) ? P.x + (size_t)m * DM : P.meta + (size_t)(m - NTOK) * DM;
    const f32x4* xr = (const f32x4*)xrow + lane;
#pragma unroll
    for (int j = 0; j < 4; ++j) v[j] = xr[64 * j];
}
DI void p0_row_finish(unsigned char* ws, int m, int lane, const f32x4 (&v)[4]) {
    unsigned long long* o8 = (unsigned long long*)((bf16_t*)(ws + WS_XB) + (size_t)m * DM) + lane;
    float s = 0.f;
#pragma unroll
    for (int j = 0; j < 4; ++j) s += (v[j].x * v[j].x + v[j].y * v[j].y) + (v[j].z * v[j].z + v[j].w * v[j].w);
    s = wave_sum(s);
    if (lane == 0) ((float*)(ws + WS_R1))[m] = (m >= NTOK + NMETA) ? 0.f : 1.f / sqrtf(s * (1.f / DM) + EPS);
#pragma unroll
    for (int j = 0; j < 4; ++j) o8[64 * j] = (unsigned long long)cvtpk(v[j].x, v[j].y) | ((unsigned long long)cvtpk(v[j].z, v[j].w) << 32);
}
DI void phase0(const Params& P, char* lds, int bid, int nblk) {
    const int tid = tid_(), lane = tid & 63, wave = __builtin_amdgcn_readfirstlane(tid >> 6);
    unsigned char* ws = P.ws;
    LAS float* scr = (LAS float*)(lds) + wave * (64 * 33);
    const int gw = bid * NWAVES + wave, NGW = nblk * NWAVES;
    constexpr int I1 = (DM / 64) * (NCOL1 / 32), I2 = (DM / 64) * (DM / 32), I3 = (DM / 64) * (2048 / 32);
    for (int it = gw; it < I1 + I2 + I3; it += NGW) {
        int r = it;
        if (r < I1) { p0_transpose_item<true>(P.w_in, DM, NCOL1, P.mix_norm_w, (bf16_t*)(ws + WS_W1T), scr, r, lane); continue; } r -= I1;
        if (r < I2) { p0_transpose_item<false>(P.w_out, DM, DM, nullptr, (bf16_t*)(ws + WS_W2T), scr, r, lane); continue; } r -= I2;
        p0_transpose_item<false>(P.wq, DM, 2048, P.ffn_norm_w, (bf16_t*)(ws + WS_W3T), scr, r, lane);
    }
    {
        f32x4 va[4], vb[4];
        int m = gw;
        if (m < M1) p0_row_load(P, m, lane, va);
        for (; m < M1; m += NGW) {
            const int mn = m + NGW;
            if (mn < M1) p0_row_load(P, mn, lane, vb);
            p0_row_finish(ws, m, lane, va);
#pragma unroll
            for (int j = 0; j < 4; ++j) va[j] = vb[j];
        }
    }
    table_fp8_rows(P, gw, NGW, NEXP);
    {
        const size_t gt = (size_t)bid * NTHREADS + tid, NGT = (size_t)nblk * NTHREADS;
        const size_t ns = (size_t)16 * 128 * 128 / 8;
        for (size_t e = gt; e < ns; e += NGT) {
            const f32x4 a = ((const f32x4*)P.subkeys)[2 * e], b = ((const f32x4*)P.subkeys)[2 * e + 1];
            u32x4 o; o.x = cvtpk(a.x, a.y); o.y = cvtpk(a.z, a.w); o.z = cvtpk(b.x, b.y); o.w = cvtpk(b.z, b.w);
            ((u32x4*)(ws + WS_SKB))[e] = o;
        }
        float* rope = (float*)(ws + WS_ROPE);
        for (size_t i = gt; i < (size_t)TPOS * 32; i += NGT) {
            const int t = (int)(i >> 5), f = (int)(i & 31);
            const double rev = (double)t * ROPE_INV[f] * 0.15915494309189535;
            const float ang = (float)((rev - __builtin_rint(rev)) * 6.283185307179586);
            rope[(size_t)t * 64 + f] = cosf(ang); rope[(size_t)t * 64 + 32 + f] = sinf(ang);
        }
        float* ssq = (float*)(ws + WS_SSQ);
        for (size_t i = gt; i < (size_t)2 * NTOK; i += NGT) ssq[i] = 0.f;
        for (size_t i = gt; i < (size_t)BATCH * 4 * 2 * 512; i += NGT) { const size_t img = i >> 9, o = i & 511; ((u32x4*)(ws + WS_K + img * KT * 8192))[o] = (u32x4){0u, 0u, 0u, 0u}; }
        for (size_t i = gt; i < (size_t)BATCH * 4 * 1024; i += NGT) { const size_t img = i >> 10, o = i & 1023; ((u32x4*)(ws + WS_V + img * KT * 16384))[o] = (u32x4){0u, 0u, 0u, 0u}; }
        for (size_t i = gt; i < (size_t)BATCH * 4 * 16 * 16; i += NGT) { const size_t bh = i >> 8, o = i & 255;
            ((u32x4*)(ws + WS_HQ + bh * HT * 256))[o] = (u32x4){0u, 0u, 0u, 0u}; ((u32x4*)(ws + WS_HV + bh * HT * 256))[o] = (u32x4){0u, 0u, 0u, 0u}; }
        for (size_t i = gt; i < (size_t)BATCH * 4 * 16 * 32; i += NGT) { const size_t bh = i >> 9, o = i & 511; ((u32x4*)(ws + WS_HG + bh * HT * 512))[o] = (u32x4){0u, 0u, 0u, 0u}; }
        float* lb = (float*)(ws + WS_LB);
        if (gt < 512) lb[gt] = sigmoidf_(P.lb_logits[gt] - P.lb_logits[512 + gt]);
        if (bid == 0 && wave == 0) {
            const float a = wave_sum(P.lq1[lane] * P.lk1[lane]), b = wave_sum(P.lq2[lane] * P.lk2[lane]);
            if (lane == 0) lb[512] = __expf(a) - __expf(b) + LAM_INIT;
        }
    }
}

namespace pg8 {
#define PG8_LAS __attribute__((address_space(3)))
typedef unsigned short bf16_t;
typedef short bf16x8 __attribute__((ext_vector_type(8)));
typedef float f32x4 __attribute__((ext_vector_type(4)));
typedef unsigned u32x4 __attribute__((ext_vector_type(4)));
constexpr int BM = 256, BK = 64, HALF = 128, HTB = HALF * BK * 2  , STAGE_BYTES = 8 * HTB, NXCD = 8, WGM = 8;

__host__ __device__ __forceinline__ int lds_byte(int r, int c) { const int st = (r >> 4) * 2 + (c >> 5), rr = r & 15, cc = c & 31, ob = rr * 64 + cc * 2; return st * 1024 + (ob ^ (((ob >> 9) & 1) << 5)); }
__host__ __device__ __forceinline__ void stage_rc(int b, int& R, int& C) { const int st = b / 1024, sb = b % 1024, swz = sb ^ (((sb >> 9) & 1) << 5); R = (st >> 1) * 16 + swz / 64; C = (st & 1) * 32 + (swz % 64) / 2; }
__host__ __device__ __forceinline__ int perm32(int rho) { const int n = rho >> 4, i = rho & 15; return 8 * (i >> 2) + 4 * n + (i & 3); }

struct Unit { int pm, pn; };
struct Gemm { const bf16_t* A; const bf16_t* Bt; int M, N, K; };

struct StaticOrder {
    int nM, nN, nwg, G, c;
    __host__ __device__ void init(int M, int N, int G_, int c_) { nM = M / BM; nN = N / BM; nwg = nM * nN; G = G_; c = c_; }
    __host__ __device__ bool next(int i, Unit& u) const {
        const long L = (long)i * G + c; if (L >= nwg) return false;
        int wgid = (int)L; { const int q = nwg / NXCD, r = nwg % NXCD, xcd = wgid % NXCD, off = wgid / NXCD; wgid = (xcd < r ? xcd * (q + 1) : r * (q + 1) + (xcd - r) * q) + off; }
        const int nig = WGM * nN, gid = wgid / nig, fm = gid * WGM, gsz = (nM - fm) < WGM ? (nM - fm) : WGM;
        u.pm = fm + ((wgid % nig) % gsz); u.pn = (wgid % nig) / gsz; return true;
    }
    __device__ __forceinline__ void a_ready(const Unit&) const {}
    __device__ __forceinline__ void done(const Unit&) const {}
};

template <class Epi, class Sched, bool ALIGN_EPI = false, bool SP2 = false>
__device__ __forceinline__ void gemm_phase(PG8_LAS unsigned char* lds, const Gemm g, const Sched& S, const Epi& E) {
    const int tid = tid_(), wid = __builtin_amdgcn_readfirstlane(tid >> 6), lane = tid & 63, wr = wid >> 2, wc = wid & 3, fr = lane & 15, fq = lane >> 4;
    const int K = g.K, nt = K / BK;
    unsigned voffA[2], voffB[2];
#pragma unroll
    for (int i = 0; i < 2; ++i) { int R, C; stage_rc(tid * 16 + i * 8192, R, C); const int Rb = Epi::PERM ? ((R & ~31) + perm32(R & 31)) : R;
        voffA[i] = (unsigned)(R * K + C) * 2u; voffB[i] = (unsigned)(Rb * K + C) * 2u; }
    const size_t kstep = (size_t)(BK * 2);
    const size_t hstep = (size_t)HALF * K * 2;
    const size_t tstep = 2 * hstep;
    const unsigned ldsw = (unsigned)wid * 1024u;
    const int aoff = lds_byte(wr * 64 + fr, fq * 8), boff = lds_byte(wc * 32 + fr, fq * 8);
#define PG8_SA(b, h) (((b) * 2 + (h)) * HTB)
#define PG8_SB(b, h) ((4 + (b) * 2 + (h)) * HTB)
#define PG8_STAGE(bufoff, gbase, voff) do { _Pragma("unroll") for (int _i = 0; _i < 2; ++_i) \
        __builtin_amdgcn_global_load_lds((const unsigned*)((const char*)(gbase) + (voff)[_i]), (PG8_LAS unsigned*)(lds + (bufoff) + ldsw + _i * 8192), 16, 0, 0); } while (0)
#define PG8_LDA(dst, b, h) do { _Pragma("unroll") for (int m = 0; m < 4; ++m) _Pragma("unroll") for (int k = 0; k < 2; ++k) dst[m][k] = *(const PG8_LAS bf16x8*)(lds + PG8_SA(b, h) + aoff + m * 2048 + k * 1024); } while (0)
#define PG8_LDB(dst, b, h) do { _Pragma("unroll") for (int n = 0; n < 2; ++n) _Pragma("unroll") for (int k = 0; k < 2; ++k) dst[n][k] = *(const PG8_LAS bf16x8*)(lds + PG8_SB(b, h) + boff + n * 2048 + k * 1024); } while (0)
#define PG8_MMA(ai, bj, At, Bt) do { __builtin_amdgcn_s_setprio(1); _Pragma("unroll") for (int m = 0; m < 4; ++m) _Pragma("unroll") for (int n = 0; n < 2; ++n) _Pragma("unroll") for (int k = 0; k < 2; ++k) \
        acc[ai][bj][m][n] = __builtin_amdgcn_mfma_f32_16x16x32_bf16(Bt[n][k], At[m][k], acc[ai][bj][m][n], 0, 0, 0); __builtin_amdgcn_s_setprio(0); } while (0)
#define PG8_WAIT_V(n) asm volatile("s_waitcnt vmcnt(" #n ")" ::: "memory")
#define PG8_WAIT_L(n) asm volatile("s_waitcnt lgkmcnt(" #n ")" ::: "memory")
#define PG8_BAR __builtin_amdgcn_s_barrier()
#define PG8_SCHED __builtin_amdgcn_sched_barrier(0)
    Unit cur, nxt; int ui = 0;
    if (!S.next(0, cur)) return;
    f32x4 acc[2][2][4][2];
#pragma unroll
    for (int a = 0; a < 2; ++a)
#pragma unroll
        for (int b = 0; b < 2; ++b)
#pragma unroll
            for (int m = 0; m < 4; ++m)
#pragma unroll
                for (int n = 0; n < 2; ++n) acc[a][b][m][n] = (f32x4){0.f, 0.f, 0.f, 0.f};
    bf16x8 At[4][2], B0[2][2], B1[2][2];
    const char* cA = (const char*)g.A + (size_t)cur.pm * tstep; const char* cB = (const char*)g.Bt + (size_t)cur.pn * tstep;
    S.a_ready(cur);
    if constexpr (SP2) {
        PG8_STAGE(PG8_SB(0, 0), cB, voffB); PG8_STAGE(PG8_SB(0, 1), cB + hstep, voffB); PG8_STAGE(PG8_SA(0, 0), cA, voffA); PG8_STAGE(PG8_SA(0, 1), cA + hstep, voffA);
        if (wr == 1) PG8_BAR;
        PG8_WAIT_V(2); PG8_BAR;
        PG8_STAGE(PG8_SB(1, 0), cB + kstep, voffB); PG8_STAGE(PG8_SA(1, 0), cA + kstep, voffA); PG8_STAGE(PG8_SB(1, 1), cB + hstep + kstep, voffB);
        PG8_WAIT_V(6); PG8_BAR;
    } else {
        PG8_STAGE(PG8_SB(0, 0), cB, voffB); PG8_STAGE(PG8_SA(0, 0), cA, voffA); PG8_STAGE(PG8_SB(0, 1), cB + hstep, voffB); PG8_STAGE(PG8_SA(0, 1), cA + hstep, voffA);
        if (wr == 1) PG8_BAR;
        PG8_WAIT_V(4); PG8_BAR;
        PG8_STAGE(PG8_SB(1, 0), cB + kstep, voffB); PG8_STAGE(PG8_SA(1, 0), cA + kstep, voffA); PG8_STAGE(PG8_SB(1, 1), cB + hstep + kstep, voffB);
        PG8_WAIT_V(6); PG8_BAR;
    }
    for (;;) {
        const bool has_next = S.next(ui + 1, nxt);
        const char* nA = has_next ? (const char*)g.A + (size_t)nxt.pm * tstep : cA; const char* nB = has_next ? (const char*)g.Bt + (size_t)nxt.pn * tstep : cB;
        for (int t = 0; t < nt; t += 2) {
            const bool last = (t == nt - 2);
            const char* a1 = cA + (size_t)(t + 1) * kstep;
            const char* a2 = last ? nA : cA + (size_t)(t + 2) * kstep; const char* b2 = last ? nB : cB + (size_t)(t + 2) * kstep;
            const char* a3 = a2 + kstep; const char* b3 = b2 + kstep;
            if (last && has_next) S.a_ready(nxt);
            if constexpr (SP2) {
            PG8_LDB(B0, 0, 0); PG8_LDB(B1, 0, 1); PG8_SCHED; PG8_LDA(At, 0, 0); PG8_STAGE(PG8_SA(1, 1), a1 + hstep, voffA);
            PG8_WAIT_V(8); PG8_WAIT_L(0); PG8_BAR; PG8_MMA(0, 0, At, B0); PG8_MMA(0, 1, At, B1); PG8_BAR; PG8_SCHED;
            PG8_LDA(At, 0, 1); PG8_STAGE(PG8_SB(0, 0), b2, voffB); PG8_STAGE(PG8_SB(0, 1), b2 + hstep, voffB); PG8_STAGE(PG8_SA(0, 0), a2, voffA);
            PG8_WAIT_V(8); PG8_WAIT_L(0); PG8_BAR; PG8_MMA(1, 0, At, B0); PG8_MMA(1, 1, At, B1); PG8_BAR; PG8_SCHED;
            PG8_LDB(B0, 1, 0); PG8_LDB(B1, 1, 1); PG8_SCHED; PG8_LDA(At, 1, 0); PG8_STAGE(PG8_SA(0, 1), a2 + hstep, voffA);
            PG8_WAIT_V(8); PG8_WAIT_L(0); PG8_BAR; PG8_MMA(0, 0, At, B0); PG8_MMA(0, 1, At, B1); PG8_BAR; PG8_SCHED;
            PG8_LDA(At, 1, 1); PG8_STAGE(PG8_SB(1, 0), b3, voffB); PG8_STAGE(PG8_SB(1, 1), b3 + hstep, voffB); PG8_STAGE(PG8_SA(1, 0), a3, voffA);
            PG8_WAIT_V(8); PG8_WAIT_L(0); PG8_BAR; PG8_MMA(1, 0, At, B0); PG8_MMA(1, 1, At, B1); PG8_BAR; PG8_SCHED;
            } else {
            PG8_LDB(B0, 0, 0); PG8_SCHED; PG8_LDA(At, 0, 0); PG8_STAGE(PG8_SA(1, 1), a1 + hstep, voffA);
            PG8_WAIT_L(8); PG8_BAR; PG8_WAIT_L(0); PG8_MMA(0, 0, At, B0); PG8_BAR; PG8_SCHED;
            PG8_LDB(B1, 0, 1); PG8_STAGE(PG8_SB(0, 0), b2, voffB);
            PG8_BAR; PG8_WAIT_L(0); PG8_MMA(0, 1, At, B1); PG8_BAR;
            PG8_LDA(At, 0, 1); PG8_STAGE(PG8_SA(0, 0), a2, voffA);
            PG8_BAR; PG8_WAIT_L(0); PG8_MMA(1, 0, At, B0); PG8_BAR; PG8_SCHED;
            PG8_STAGE(PG8_SB(0, 1), b2 + hstep, voffB);
            PG8_WAIT_V(6); PG8_BAR; PG8_MMA(1, 1, At, B1); PG8_BAR;
            PG8_LDB(B0, 1, 0); PG8_SCHED; PG8_LDA(At, 1, 0); PG8_STAGE(PG8_SA(0, 1), a2 + hstep, voffA);
            PG8_WAIT_L(8); PG8_BAR; PG8_WAIT_L(0); PG8_MMA(0, 0, At, B0); PG8_BAR; PG8_SCHED;
            PG8_LDB(B1, 1, 1); PG8_STAGE(PG8_SB(1, 0), b3, voffB);
            PG8_BAR; PG8_WAIT_L(0); PG8_MMA(0, 1, At, B1); PG8_BAR;
            PG8_LDA(At, 1, 1); PG8_STAGE(PG8_SA(1, 0), a3, voffA);
            PG8_BAR; PG8_WAIT_L(0); PG8_MMA(1, 0, At, B0); PG8_BAR; PG8_SCHED;
            PG8_STAGE(PG8_SB(1, 1), b3 + hstep, voffB);
            PG8_WAIT_V(6); PG8_BAR; PG8_MMA(1, 1, At, B1); PG8_BAR;
            }
        }
        if constexpr (ALIGN_EPI) { if (wr == 0) PG8_BAR; }
        if constexpr (!Epi::AFTER_DRAIN) { E(acc, cur, wr, wc, fr, fq); S.done(cur); }
        if (!has_next) break;
#pragma unroll
        for (int a = 0; a < 2; ++a)
#pragma unroll
            for (int b = 0; b < 2; ++b)
#pragma unroll
                for (int m = 0; m < 4; ++m)
#pragma unroll
                    for (int n = 0; n < 2; ++n) acc[a][b][m][n] = (f32x4){0.f, 0.f, 0.f, 0.f};
        cur = nxt; cA = nA; cB = nB; ++ui;
        if constexpr (ALIGN_EPI) { if (wr == 1) PG8_BAR; }
    }
    PG8_WAIT_V(0);
    if constexpr (!ALIGN_EPI) { if (wr == 0) PG8_BAR; }
    PG8_BAR;
    if constexpr (Epi::AFTER_DRAIN) { E.fused(acc, cur, wr, wc, fr, fq, lds, wid, lane); S.done(cur); }
#undef PG8_SA
#undef PG8_SB
#undef PG8_STAGE
#undef PG8_LDA
#undef PG8_LDB
#undef PG8_MMA
#undef PG8_WAIT_V
#undef PG8_WAIT_L
#undef PG8_BAR
#undef PG8_SCHED
}
}

DI u32x2 pack4(f32x4 v) { u32x2 r; r.x = cvtpk(v.x, v.y); r.y = cvtpk(v.z, v.w); return r; }
DI u32x4 pack8(f32x4 a, f32x4 b) { u32x4 r; r.x = cvtpk(a.x, a.y); r.y = cvtpk(a.z, a.w); r.z = cvtpk(b.x, b.y); r.w = cvtpk(b.z, b.w); return r; }

struct Epi1 {
    static constexpr bool PERM = true, AFTER_DRAIN = false;
    unsigned char* ws;
    DI void operator()(const f32x4 (&acc)[2][2][4][2], const pg8::Unit& u, int wr, int wc, int fr, int fq) const {
        const float* r1p = (const float*)(ws + WS_R1);
        const float* rope = (const float*)(ws + WS_ROPE);
        const float* lbp = (const float*)(ws + WS_LB);
        const int seg = u.pn >> 1;
#pragma unroll
        for (int ai = 0; ai < 2; ++ai)
#pragma unroll
            for (int m = 0; m < 4; ++m) {
                const int row = u.pm * 256 + ai * 128 + wr * 64 + m * 16 + fr;
                const bool meta = row >= NTOK;
                if (row >= NTOK + NMETA) continue;
                const float r1 = r1p[row];
                const int b = meta ? 0 : (row >> 12), t = meta ? (row - NTOK) : ((row & 4095) + NMETA);
                const int nrep = meta ? BATCH : 1;
#pragma unroll
                for (int bj = 0; bj < 2; ++bj) {
                    const int cs = (u.pn & 1) * 256 + bj * 128 + wc * 32 + 8 * fq;
                    const f32x4 v0 = acc[ai][bj][m][0] * r1, v1 = acc[ai][bj][m][1] * r1;
                    const int h = cs >> 7;
                    if (seg <= 1) {
                        const int comp = (cs >> 6) & 1, cc = cs & 63, i0 = 16 * (cc >> 5) + 4 * fq;
                        const f32x4 c4 = *(const f32x4*)(rope + (size_t)t * 64 + i0), s4 = *(const f32x4*)(rope + (size_t)t * 64 + 32 + i0);
                        f32x4 lo = v0 * c4 - v1 * s4, hi = v1 * c4 + v0 * s4;
                        if (seg == 0) {
                            if (meta) continue;
                            lo = lo * QSCALE; hi = hi * QSCALE;
                            bf16_t* qp = (bf16_t*)(ws + WS_Q) + ((size_t)(((b * 4 + h) * 2 + comp) * SEQ + (row & 4095))) * 64;
                            *(u32x2*)(qp + i0) = pack4(lo); *(u32x2*)(qp + i0 + 32) = pack4(hi);
                        } else {
                            const int pp = t + KPAD, tile = pp >> 6, key = pp & 63;
                            for (int bb = 0; bb < nrep; ++bb) {
                                const int b_ = meta ? bb : b;
                                unsigned char* img = ws + WS_K + ((size_t)((b_ * 4 + h) * 2 + comp) * KT + tile) * 8192;
                                *(u32x2*)(img + (i0 >> 3) * 1024 + key * 16 + (i0 & 7) * 2) = pack4(lo);
                                *(u32x2*)(img + ((i0 >> 3) + 4) * 1024 + key * 16 + (i0 & 7) * 2) = pack4(hi);
                            }
                        }
                    } else if (seg == 2) {
                        const int dv = cs & 127, pp = t + KPAD, tile = pp >> 6, key = pp & 63;
                        const u32x4 w = pack8(v0, v1);
                        for (int bb = 0; bb < nrep; ++bb) {
                            const int b_ = meta ? bb : b;
                            unsigned char* img = ws + WS_V + ((size_t)(b_ * 4 + h) * KT + tile) * 16384;
                            *(u32x4*)(img + (dv >> 5) * 4096 + key * 64 + (dv & 31) * 2) = w;
                        }
                    } else if (seg == 3 || seg == 5) {
                        const int dv = cs & 127;
                        f32x4 a = v0, c = v1;
                        if (seg == 3) { a.x = siluf_(a.x); a.y = siluf_(a.y); a.z = siluf_(a.z); a.w = siluf_(a.w); c.x = siluf_(c.x); c.y = siluf_(c.y); c.z = siluf_(c.z); c.w = siluf_(c.w); }
                        const u32x4 w = pack8(a, c);
                        const size_t base = (seg == 3) ? WS_HQ : WS_HV;
                        for (int bb = 0; bb < nrep; ++bb) {
                            const int b_ = meta ? bb : b;
                            *(u32x4*)((bf16_t*)(ws + base) + ((size_t)(b_ * 4 + h) * HT + t + 16) * 128 + dv) = w;
                        }
                    } else if (seg == 4) {
                        const int dv = cs & 127;
                        const f32x4 l0 = *(const f32x4*)(lbp + cs), l1 = *(const f32x4*)(lbp + cs + 4);
                        f32x4 g0, g1;
#pragma unroll
                        for (int e = 0; e < 4; ++e) { g0[e] = __logf(l0[e] + (1.f - l0[e]) * sigmoidf_(v0[e])); g1[e] = __logf(l1[e] + (1.f - l1[e]) * sigmoidf_(v1[e])); }
                        for (int bb = 0; bb < nrep; ++bb) {
                            const int b_ = meta ? bb : b;
                            float* gp = (float*)(ws + WS_HG) + ((size_t)(b_ * 4 + h) * HT + t + 16) * 128 + dv;
                            *(f32x4*)gp = g0; *(f32x4*)(gp + 4) = g1;
                        }
                    } else {
                        if (meta) continue;
                        f32x4 a = v0, c = v1;
                        a.x = siluf_(a.x); a.y = siluf_(a.y); a.z = siluf_(a.z); a.w = siluf_(a.w); c.x = siluf_(c.x); c.y = siluf_(c.y); c.z = siluf_(c.z); c.w = siluf_(c.w);
                        *(u32x4*)((bf16_t*)(ws + WS_SG) + (size_t)row * 512 + cs) = pack8(a, c);
                    }
                }
            }
    }
};

struct Epi3 {
    static constexpr bool PERM = true, AFTER_DRAIN = false;
    const float* x; float* H; bf16_t* HB; float* ssq;
    DI void operator()(const f32x4 (&acc)[2][2][4][2], const pg8::Unit& u, int wr, int wc, int fr, int fq) const {
#pragma unroll
        for (int ai = 0; ai < 2; ++ai)
#pragma unroll
            for (int m = 0; m < 4; ++m) {
                const int row = u.pm * 256 + ai * 128 + wr * 64 + m * 16 + fr;
                float s = 0.f;
#pragma unroll
                for (int bj = 0; bj < 2; ++bj) {
                    const int col = u.pn * 256 + bj * 128 + wc * 32 + 8 * fq;
                    const size_t o = (size_t)row * DM + col;
                    const u32x4 xb = *(const u32x4*)(HB + o);
                    const f32x4 x0 = (f32x4){bf2f(xb.x & 0xffffu), bf2f(xb.x >> 16), bf2f(xb.y & 0xffffu), bf2f(xb.y >> 16)}, x1 = (f32x4){bf2f(xb.z & 0xffffu), bf2f(xb.z >> 16), bf2f(xb.w & 0xffffu), bf2f(xb.w >> 16)};
                    const f32x4 h0 = x0 + acc[ai][bj][m][0], h1 = x1 + acc[ai][bj][m][1];
                    *(u32x4*)(HB + o) = pack8(h0, h1);
                    s += (h0.x * h0.x + h0.y * h0.y) + (h0.z * h0.z + h0.w * h0.w) + (h1.x * h1.x + h1.y * h1.y) + (h1.z * h1.z + h1.w * h1.w);
                }
                s += __shfl_xor(s, 16); s += __shfl_xor(s, 32);
                if (fq == 0) atomicAdd(ssq + row, s);
            }
    }
};

struct Epi4 {
    static constexpr bool PERM = true, AFTER_DRAIN = false;
    const float* ssq; bf16_t* PQ;
    DI void operator()(const f32x4 (&acc)[2][2][4][2], const pg8::Unit& u, int wr, int wc, int fr, int fq) const {
#pragma unroll
        for (int ai = 0; ai < 2; ++ai)
#pragma unroll
            for (int m = 0; m < 4; ++m) {
                const int row = u.pm * 256 + ai * 128 + wr * 64 + m * 16 + fr;
                const float r2 = 1.f / sqrtf(ssq[row] * (1.f / DM) + EPS);
#pragma unroll
                for (int bj = 0; bj < 2; ++bj) {
                    const int col = u.pn * 256 + bj * 128 + wc * 32 + 8 * fq;
                    *(u32x4*)(PQ + (size_t)row * 2048 + col) = pack8(acc[ai][bj][m][0] * r2, acc[ai][bj][m][1] * r2);
                }
            }
    }
};

template <class Epi>
DI void gemm_run(char* lds, const bf16_t* A, const bf16_t* Bt, int M, int N, int K, const Epi& E, int bid, int nblk) {
    pg8::Gemm g{A, Bt, M, N, K}; pg8::StaticOrder S; S.init(M, N, nblk, bid);
    pg8::gemm_phase<Epi, pg8::StaticOrder, true, true>((LAS unsigned char*)lds, g, S, E);
}
#define MFMA32(a, b, c) __builtin_amdgcn_mfma_f32_32x32x16_bf16(a, b, c, 0, 0, 0)
typedef short v4i16_t __attribute__((ext_vector_type(4)));
DI int crow(int r, int hi) { return (r & 3) + 8 * (r >> 2) + 4 * hi; }
DI s16x4 vtr(const LAS char* p) { return __builtin_bit_cast(s16x4, __builtin_amdgcn_ds_read_tr16_b64_v4i16((LAS v4i16_t*)p)); }
DI void glds16(const void* g, LAS char* l) { __builtin_amdgcn_global_load_lds((const unsigned*)g, (LAS unsigned*)l, 16, 0, 0); }
DI float swap_max(float m) { auto rr = __builtin_amdgcn_permlane32_swap(__float_as_uint(m), __float_as_uint(m), false, false); return fmaxf(__uint_as_float(rr[0]), __uint_as_float(rr[1])); }
DI float swap_sum(float m) { auto rr = __builtin_amdgcn_permlane32_swap(__float_as_uint(m), __float_as_uint(m), false, false); return __uint_as_float(rr[0]) + __uint_as_float(rr[1]); }
constexpr int ATT_BUF = 32768, ATT_WSF = 65536;
constexpr float ATT_THR = 8.f;

DI void attn_unit(const Params& P, int b, int h, int j, char* lds_g) {
    LAS char* lds = (LAS char*)lds_g;
    const int tid = tid_(), lane = tid & 63, r32 = lane & 31, hi = lane >> 5;
    const int wid = __builtin_amdgcn_readfirstlane(tid >> 6), comp = wid >> 2, wq = wid & 3;
    const unsigned char* ws = P.ws;
    const int bh = b * 4 + h;
    const bf16_t* Qw = (const bf16_t*)(ws + WS_Q) + ((size_t)((bh * 2 + comp) * SEQ + 128 * j + 32 * wq)) * 64;
    bf16x8 qr[4];
#pragma unroll
    for (int d0 = 0; d0 < 4; ++d0) qr[d0] = *(const bf16x8*)(Qw + r32 * 64 + d0 * 16 + hi * 8);
    const unsigned char* kimg0 = ws + WS_K + (size_t)(bh * 2) * KT * 8192 + wid * 1024 + lane * 16;
    const unsigned char* kimg1 = kimg0 + (size_t)KT * 8192;
    const unsigned char* vimg = ws + WS_V + (size_t)bh * KT * 16384 + wid * 1024 + lane * 16;
    const int NT = 2 * j + 3, my_last = (wq < 2) ? 2 * j + 1 : 2 * j + 2;
    LAS float* wsf = (LAS float*)(lds + ATT_WSF) + wid * 64;
#define ATT_ISSUE(t, s) do { LAS char* d_ = lds + (s) * ATT_BUF + wid * 1024; \
        glds16(kimg0 + (size_t)(t) * 8192, d_); glds16(kimg1 + (size_t)(t) * 8192, d_ + 8192); \
        glds16(vimg + (size_t)(t) * 16384, d_ + 16384); glds16(vimg + (size_t)(t) * 16384 + 8192, d_ + 24576); } while (0)
    f32x16 o[4];
#pragma unroll
    for (int nb = 0; nb < 4; ++nb) o[nb] = f32x16{};
    float mref = 0.f, lsum = 0.f;
    f32x16 mv = f32x16{};
    const int qpos = 64 + 128 * j + 32 * wq + r32;
    ATT_ISSUE(0, 0);
    __syncthreads();
    for (int t = 0; t < NT; ++t) {
        const int s = t & 1;
        if (t + 1 < NT) ATT_ISSUE(t + 1, s ^ 1);
        if (t <= my_last) {
            const LAS char* kp = lds + s * ATT_BUF + comp * 8192 + hi * 1024 + r32 * 16;
            asm volatile("" : "+v"(mv));
            f32x16 s0, s1;
#pragma unroll
            for (int d0 = 0; d0 < 4; ++d0) {
                const bf16x8 k0 = *(const LAS bf16x8*)(kp + d0 * 2048), k1 = *(const LAS bf16x8*)(kp + d0 * 2048 + 512);
                if (d0 == 0) { s0 = MFMA32(k0, qr[d0], mv); s1 = MFMA32(k1, qr[d0], mv); }
                else { s0 = MFMA32(k0, qr[d0], s0); s1 = MFMA32(k1, qr[d0], s1); }
            }
            if (t == 0 || t >= 2 * j + 1) {
                const int kb = 64 * t + 4 * hi - KPAD; const unsigned lim = (unsigned)(qpos - KPAD);
#pragma unroll
                for (int r = 0; r < 16; ++r) { const int kv = kb + (r & 3) + 8 * (r >> 2); if ((unsigned)kv > lim) s0[r] = -INFINITY; if ((unsigned)(kv + 32) > lim) s1[r] = -INFINITY; }
            }
            asm volatile("s_nop 15" : "+v"(s0), "+v"(s1));
            float rm;
            asm("v_max3_f32 %0, %1, %2, %3" : "=v"(rm) : "v"(s0[0]), "v"(s1[0]), "v"(s0[1]));
            asm("v_max3_f32 %0, %1, %2, %3" : "=v"(rm) : "v"(rm), "v"(s1[1]), "v"(s0[2]));
#pragma unroll
            for (int r = 2; r < 15; ++r) asm("v_max3_f32 %0, %1, %2, %3" : "=v"(rm) : "v"(rm), "v"(s1[r]), "v"(s0[r + 1]));
            asm("v_max_f32 %0, %1, %2" : "=v"(rm) : "v"(rm), "v"(s1[15]));
            { auto rr = __builtin_amdgcn_permlane32_swap(__float_as_uint(rm), __float_as_uint(rm), false, false); const float ra = __uint_as_float(rr[0]), rb = __uint_as_float(rr[1]);
              asm("v_max_f32 %0, %1, %2" : "=v"(rm) : "v"(ra), "v"(rb)); }
            const bool first = (t == 0);
            if (first || __any(rm > ATT_THR)) {
                const float dl = first ? rm : fmaxf(rm, 0.f), f = first ? 1.f : __builtin_amdgcn_exp2f(-dl);
                mref += dl; lsum *= f;
                if (hi == 0) wsf[r32] = f;
                asm volatile("s_waitcnt lgkmcnt(0)" ::: "memory");
#pragma unroll
                for (int r = 0; r < 16; ++r) { const float fr_ = wsf[crow(r, hi)]; s0[r] -= dl; s1[r] -= dl; mv[r] = -mref;
#pragma unroll
                    for (int nb = 0; nb < 4; ++nb) o[nb][r] *= fr_; }
            }
            f32x2 ps2 = (f32x2){0.f, 0.f};
#pragma unroll
            for (int r = 0; r < 16; ++r) { s0[r] = __builtin_amdgcn_exp2f(s0[r]); s1[r] = __builtin_amdgcn_exp2f(s1[r]); }
#pragma unroll
            for (int r = 0; r < 16; r += 2) { ps2 += (f32x2){s0[r], s0[r + 1]}; ps2 += (f32x2){s1[r], s1[r + 1]}; }
            lsum += ps2.x + ps2.y;
            const LAS char* vp = lds + s * ATT_BUF + 16384 + ((lane >> 4) & 1) * 32 + (lane & 3) * 8 + (4 * hi + ((lane & 15) >> 2)) * 64;
#pragma unroll
            for (int ks = 0; ks < 4; ++ks) {
                u32x4 pw;
                if (ks < 2) { pw.x = cvtpk(s0[8 * ks], s0[8 * ks + 1]); pw.y = cvtpk(s0[8 * ks + 2], s0[8 * ks + 3]); pw.z = cvtpk(s0[8 * ks + 4], s0[8 * ks + 5]); pw.w = cvtpk(s0[8 * ks + 6], s0[8 * ks + 7]); }
                else { const int q_ = ks - 2; pw.x = cvtpk(s1[8 * q_], s1[8 * q_ + 1]); pw.y = cvtpk(s1[8 * q_ + 2], s1[8 * q_ + 3]); pw.z = cvtpk(s1[8 * q_ + 4], s1[8 * q_ + 5]); pw.w = cvtpk(s1[8 * q_ + 6], s1[8 * q_ + 7]); }
                const bf16x8 pa = __builtin_bit_cast(bf16x8, pw);
#pragma unroll
                for (int nb = 0; nb < 4; ++nb) {
                    const s16x4 vlo = vtr(vp + nb * 4096 + ks * 1024), vhi = vtr(vp + nb * 4096 + ks * 1024 + 512);
                    const bf16x8 vb = (bf16x8){vlo[0], vlo[1], vlo[2], vlo[3], vhi[0], vhi[1], vhi[2], vhi[3]};
                    o[nb] = MFMA32(pa, vb, o[nb]);
                }
            }
        }
        __syncthreads();
    }
#undef ATT_ISSUE
    lsum = swap_sum(lsum);
    if (hi == 0) wsf[r32] = lsum;
    asm volatile("s_waitcnt lgkmcnt(0)" ::: "memory");
    float rli[16];
#pragma unroll
    for (int r = 0; r < 16; ++r) rli[r] = 1.f / wsf[crow(r, hi)];
    const float lam = ((const float*)(ws + WS_LB))[512];
    LAS float* ex = (LAS float*)lds + wq * 4096;
    if (comp == 1) {
#pragma unroll
        for (int r = 0; r < 16; ++r)
#pragma unroll
            for (int nb = 0; nb < 4; ++nb) ex[(r * 4 + nb) * 64 + lane] = o[nb][r] * rli[r] * lam;
    }
    __syncthreads();
    if (comp == 0) {
        float ss[16];
#pragma unroll
        for (int r = 0; r < 16; ++r) { float a = 0.f;
#pragma unroll
            for (int nb = 0; nb < 4; ++nb) { const float v = o[nb][r] * rli[r] - ex[(r * 4 + nb) * 64 + lane]; o[nb][r] = v; a += v * v; }
            ss[r] = a; }
#pragma unroll
        for (int r = 0; r < 16; ++r) { float a = ss[r]; a += __shfl_xor(a, 1); a += __shfl_xor(a, 2); a += __shfl_xor(a, 4); a += __shfl_xor(a, 8); a += __shfl_xor(a, 16); ss[r] = (1.f - LAM_INIT) / sqrtf(a * (1.f / 128.f) + EPS); }
        bf16_t* mix = (bf16_t*)(ws + WS_MIX) + ((size_t)(b * SEQ + 128 * j + 32 * wq)) * DM + h * 128;
#pragma unroll
        for (int nb = 0; nb < 4; ++nb) { const float w = P.subln_w[32 * nb + r32];
#pragma unroll
            for (int r = 0; r < 16; ++r) mix[(size_t)crow(r, hi) * DM + 32 * nb + r32] = (bf16_t)f2bf(o[nb][r] * ss[r] * w); }
    }
    __syncthreads();
}
#define MFMA16(a, b, c) __builtin_amdgcn_mfma_f32_16x16x32_bf16(a, b, c, 0, 0, 0)
constexpr int HG_STR = 272;
constexpr int HL_QA = 0, HL_QB = HL_QA + 32 * HG_STR, HL_KB = HL_QB + 32 * HG_STR, HL_KT = HL_KB + 32 * HG_STR, HL_VV = HL_KT + 32 * HG_STR;
constexpr int HL_PS = HL_VV + 32 * HG_STR;
constexpr int HL_D = HL_PS + 4 * 128 * 4;
constexpr int HL_OUT = HL_D + 128 * 4;
constexpr int HL_END = HL_OUT + 32 * 132 * 4;

constexpr int HB_KTF = 0, HB_ATF = 8192, HB_DF = 10240;
DI void hgrn_prep_item(const Params& P, int bh, int c, char* lds_g) {
    LAS char* lds = (LAS char*)lds_g;
    const int tid = tid_(), lane = tid & 63, c16 = lane & 15, g4 = lane >> 4, ch = tid & 127, part = tid >> 7;
    const int wid = __builtin_amdgcn_readfirstlane(tid >> 6);
    const int vrow = tid >> 4, vcol = (tid & 15) * 8;
    unsigned char* ws = P.ws;
    const float* HG = (const float*)(ws + WS_HG) + (size_t)bh * HT * 128;
    const bf16_t* HQ = (const bf16_t*)(ws + WS_HQ) + (size_t)bh * HT * 128;
    const bf16_t* HV = (const bf16_t*)(ws + WS_HV) + (size_t)bh * HT * 128;
    const size_t r0 = (size_t)(32 * c + 8 * part);
    float g8[8], p8[8]; unsigned short q8[8];
    { float a = 0.f;
#pragma unroll
      for (int e = 0; e < 8; ++e) { g8[e] = HG[(r0 + e) * 128 + ch]; q8[e] = HQ[(r0 + e) * 128 + ch]; a += g8[e]; p8[e] = a; } }
    const u32x4 v16 = *(const u32x4*)(HV + ((size_t)(32 * c) + vrow) * 128 + vcol);
    ((LAS float*)(lds + HL_PS))[part * 128 + ch] = p8[7];
    __syncthreads();
    {
        const LAS float* ps = (const LAS float*)(lds + HL_PS);
        const float t0 = ps[ch], t1 = ps[128 + ch], t2 = ps[256 + ch], t3 = ps[384 + ch];
        const float off = (part > 0 ? t0 : 0.f) + (part > 1 ? t1 : 0.f) + (part > 2 ? t2 : 0.f);
        const float mid = t0 + t1, last = mid + t2 + t3;
        const float em = __expf(mid), el = __expf(last - mid);
        if (part == 0) ((LAS float*)(lds + HL_D))[ch] = __expf(last);
#pragma unroll
        for (int e = 0; e < 8; ++e) {
            const int tk = 8 * part + e;
            const float cum = off + p8[e];
            const float e1 = __expf(cum - mid), e2 = 1.f / e1;
            const float q = bf2f(q8[e]), k = 1.f - __expf(g8[e]);
            const float qb = q * e1, qa = qb * em, kb = k * e2, kt = kb * el;
            *(LAS bf16_t*)(lds + HL_QA + tk * HG_STR + ch * 2) = (bf16_t)f2bf(qa);
            *(LAS bf16_t*)(lds + HL_QB + tk * HG_STR + ch * 2) = (bf16_t)f2bf(qb);
            *(LAS bf16_t*)(lds + HL_KB + tk * HG_STR + ch * 2) = (bf16_t)f2bf(kb);
            *(LAS bf16_t*)(lds + HL_KT + tk * HG_STR + ch * 2) = (bf16_t)f2bf(kt);
        }
        *(LAS u32x4*)(lds + HL_VV + vrow * HG_STR + vcol * 2) = v16;
    }
    __syncthreads();
    unsigned char* qaf = ws + WS_HQA + ((size_t)bh * 129 + c) * 8192;
    unsigned char* hgb = ws + WS_HG + (size_t)bh * HT * 512 + (size_t)c * 16384;
    {
        const int ks = wid >> 1, nt = wid & 1;
        const LAS char* qp = lds + HL_QA + (16 * nt + c16) * HG_STR + (32 * ks + 4 * g4) * 2;
        const u32x2 lo = *(const LAS u32x2*)qp, hi2 = *(const LAS u32x2*)(qp + 32);
        *(u32x4*)(qaf + wid * 1024 + lane * 16) = (u32x4){lo.x, lo.y, hi2.x, hi2.y};
        const LAS char* kp = lds + HL_KT + (8 * g4 + (c16 >> 2)) * HG_STR + (16 * wid + 4 * (c16 & 3)) * 2;
        const s16x4 klo = vtr(kp), khi = vtr(kp + 4 * HG_STR);
        *(bf16x8*)(hgb + HB_KTF + wid * 1024 + lane * 16) = (bf16x8){klo[0], klo[1], klo[2], klo[3], khi[0], khi[1], khi[2], khi[3]};
    }
    if (wid == 0) {
        f32x4 at00 = (f32x4){0.f, 0.f, 0.f, 0.f}, at01 = at00, at11 = at00;
#pragma unroll
        for (int ks = 0; ks < 4; ++ks) {
            const bf16x8 ka0 = *(const LAS bf16x8*)(lds + HL_KB + c16 * HG_STR + (32 * ks + 8 * g4) * 2);
            const bf16x8 ka1 = *(const LAS bf16x8*)(lds + HL_KB + (16 + c16) * HG_STR + (32 * ks + 8 * g4) * 2);
            const bf16x8 qn0 = *(const LAS bf16x8*)(lds + HL_QB + c16 * HG_STR + (32 * ks + 8 * g4) * 2);
            const bf16x8 qn1 = *(const LAS bf16x8*)(lds + HL_QB + (16 + c16) * HG_STR + (32 * ks + 8 * g4) * 2);
            at00 = MFMA16(ka0, qn0, at00); at01 = MFMA16(ka0, qn1, at01); at11 = MFMA16(ka1, qn1, at11);
        }
#pragma unroll
        for (int r = 0; r < 4; ++r) { if (4 * g4 + r > c16) { at00[r] = 0.f; at11[r] = 0.f; } }
        u32x4 b0; b0.x = cvtpk(at00[0], at00[1]); b0.y = cvtpk(at00[2], at00[3]); b0.z = 0u; b0.w = 0u;
        u32x4 b1; b1.x = cvtpk(at01[0], at01[1]); b1.y = cvtpk(at01[2], at01[3]); b1.z = cvtpk(at11[0], at11[1]); b1.w = cvtpk(at11[2], at11[3]);
        *(u32x4*)(hgb + HB_ATF + lane * 16) = b0; *(u32x4*)(hgb + HB_ATF + 1024 + lane * 16) = b1;
    } else if (wid == 1 && lane < 32) {
        *(f32x4*)(hgb + HB_DF + lane * 16) = *(const LAS f32x4*)(lds + HL_D + lane * 16);
    }
    __syncthreads();
}

constexpr int RS_QAF = 0, RS_HGB = 8192, RS_V = 19456, RS_SLOT = 27648, RS_NSLOT = 5;
constexpr int RS_OUT = RS_NSLOT * RS_SLOT, RS_OUTB = 32 * 136 * 2, RS_END = RS_OUT + 2 * RS_OUTB;
static_assert(RS_END <= LDS_ITEM, "hgrn LDS map");
DI void glds16_asm(const void* g, unsigned lds_base) {
    unsigned sv; asm volatile("s_mov_b32 %0, m0\n\ts_mov_b32 m0, %2\n\ts_nop 0\n\tglobal_load_lds_dwordx4 %1, off\n\ts_mov_b32 m0, %0" : "=&s"(sv) : "v"(g), "s"(lds_base) : "memory"); }
#define HW_BAR() asm volatile("s_waitcnt lgkmcnt(0)\n\ts_barrier" ::: "memory")
DI void glds16_sb(unsigned voff, const void* sbase, unsigned lds_base) {
    unsigned sv; asm volatile("s_mov_b32 %0, m0\n\ts_mov_b32 m0, %3\n\ts_nop 0\n\tglobal_load_lds_dwordx4 %1, %2\n\ts_mov_b32 m0, %0" : "=&s"(sv) : "v"(voff), "s"(sbase), "s"(lds_base) : "memory"); }
DI void hgrn_unit(const Params& P, int b, int h, char* lds_g) {
    LAS char* lds = (LAS char*)lds_g;
    const int tid = tid_(), lane = tid & 63, c16 = lane & 15, g4 = lane >> 4;
    const int wid = __builtin_amdgcn_readfirstlane(tid >> 6);
    const unsigned char* ws = P.ws;
    const int bh = b * 4 + h;
    const unsigned lbase = (unsigned)__builtin_amdgcn_readfirstlane((int)(unsigned)(size_t)lds);
    constexpr int AHEAD = RS_NSLOT - 1;
    if (wid < 4) {
        const unsigned char* qafg = ws + WS_HQA + (size_t)bh * 129 * 8192;
        const unsigned char* hgbg = ws + WS_HG + (size_t)bh * HT * 512;
        const unsigned char* vg = ws + WS_HV + (size_t)bh * HT * 256;
        const unsigned voff = (unsigned)lane * 16u;
        auto issue = [&](int c) {
            const unsigned sb = lbase + (unsigned)((c % RS_NSLOT) * RS_SLOT);
#pragma unroll
            for (int k = 0; k < 7; ++k) {
                const int p = wid + 4 * k;
                if (p < 19) { const unsigned char* src = (p < 8) ? qafg + (size_t)c * 8192 + p * 1024 : hgbg + (size_t)c * 16384 + (p - 8) * 1024; glds16_sb(voff, src, sb + (unsigned)p * 1024u); }
                else if (p < 27) { const int r4 = 4 * (p - 19);
                    const unsigned vo = (unsigned)(lane >> 4) * 256u + (unsigned)(((lane & 15) ^ ((((r4 & 7) + (lane >> 4)) & 7) << 1)) * 16);
                    glds16_sb(vo, vg + ((size_t)(32 * c) + r4) * 256, sb + (unsigned)p * 1024u); }
            }
        };
        f32x4 S[2][8];
#pragma unroll
        for (int t = 0; t < 2; ++t)
#pragma unroll
            for (int i = 0; i < 8; ++i) S[t][i] = (f32x4){0.f, 0.f, 0.f, 0.f};
#pragma unroll
        for (int c = 0; c < AHEAD; ++c) issue(c);
        for (int c = 0; c < 129; ++c) {
            if (c + AHEAD - 1 > 128) asm volatile("s_waitcnt vmcnt(0)" ::: "memory");
            else if (wid < 3) asm volatile("s_waitcnt vmcnt(21)" ::: "memory"); else asm volatile("s_waitcnt vmcnt(18)" ::: "memory");
            HW_BAR();
            __builtin_amdgcn_sched_barrier(0);
            if (c + AHEAD < 129) issue(c + AHEAD);
            __builtin_amdgcn_sched_barrier(0);
            const LAS char* sl = lds + (c % RS_NSLOT) * RS_SLOT;
            f32x4 oacc[2][2];
#pragma unroll
            for (int t = 0; t < 2; ++t) { oacc[t][0] = (f32x4){0.f, 0.f, 0.f, 0.f}; oacc[t][1] = oacc[t][0]; }
#pragma unroll
            for (int ks = 0; ks < 4; ++ks) {
                const bf16x8 q0 = *(const LAS bf16x8*)(sl + RS_QAF + (2 * ks) * 1024 + lane * 16), q1 = *(const LAS bf16x8*)(sl + RS_QAF + (2 * ks + 1) * 1024 + lane * 16);
#pragma unroll
                for (int t = 0; t < 2; ++t) {
                    u32x4 sp; sp.x = cvtpk(S[t][2 * ks][0], S[t][2 * ks][1]); sp.y = cvtpk(S[t][2 * ks][2], S[t][2 * ks][3]); sp.z = cvtpk(S[t][2 * ks + 1][0], S[t][2 * ks + 1][1]); sp.w = cvtpk(S[t][2 * ks + 1][2], S[t][2 * ks + 1][3]);
                    const bf16x8 sf = __builtin_bit_cast(bf16x8, sp);
                    oacc[t][0] = MFMA16(sf, q0, oacc[t][0]); oacc[t][1] = MFMA16(sf, q1, oacc[t][1]);
                }
            }
            const int vq = c16 >> 2, vp4 = c16 & 3;
#define VTR(row, w_) vtr(sl + RS_V + (row) * 256 + (((2 * (w_) + (vp4 >> 1)) ^ ((((row) & 7)) << 1)) * 16) + 8 * (vp4 & 1))
            {
                const bf16x8 a0 = *(const LAS bf16x8*)(sl + RS_HGB + HB_ATF + lane * 16), a1 = *(const LAS bf16x8*)(sl + RS_HGB + HB_ATF + 1024 + lane * 16);
#pragma unroll
                for (int t = 0; t < 2; ++t) {
                    const s16x4 lo = VTR(4 * g4 + vq, 2 * wid + t), hi2 = VTR(16 + 4 * g4 + vq, 2 * wid + t);
                    const bf16x8 va = (bf16x8){lo[0], lo[1], lo[2], lo[3], hi2[0], hi2[1], hi2[2], hi2[3]};
                    oacc[t][0] = MFMA16(va, a0, oacc[t][0]); oacc[t][1] = MFMA16(va, a1, oacc[t][1]);
                }
            }
            {
                LAS char* ob = lds + RS_OUT + (c & 1) * RS_OUTB;
#pragma unroll
                for (int t = 0; t < 2; ++t)
#pragma unroll
                    for (int nt = 0; nt < 2; ++nt) { u32x2 w; w.x = cvtpk(oacc[t][nt][0], oacc[t][nt][1]); w.y = cvtpk(oacc[t][nt][2], oacc[t][nt][3]);
                        *(LAS u32x2*)(ob + ((16 * nt + c16) * 136 + 16 * (2 * wid + t) + 4 * g4) * 2) = w; }
            }
            {
                bf16x8 vb[2];
#pragma unroll
                for (int t = 0; t < 2; ++t) { const s16x4 lo = VTR(8 * g4 + vq, 2 * wid + t), hi2 = VTR(8 * g4 + 4 + vq, 2 * wid + t); vb[t] = (bf16x8){lo[0], lo[1], lo[2], lo[3], hi2[0], hi2[1], hi2[2], hi2[3]}; }
#pragma unroll
                for (int i = 0; i < 8; ++i) {
                    const f32x4 d4 = *(const LAS f32x4*)(sl + RS_HGB + HB_DF + (16 * i + 4 * g4) * 4);
                    const bf16x8 ka = *(const LAS bf16x8*)(sl + RS_HGB + HB_KTF + i * 1024 + lane * 16);
                    S[0][i] = MFMA16(ka, vb[0], S[0][i] * d4); S[1][i] = MFMA16(ka, vb[1], S[1][i] * d4);
                }
            }
#undef VTR
        }
        HW_BAR();
        HW_BAR();
    } else {
        const int tq = tid - 256, tok = tq >> 3, part = tq & 7;
        const bf16_t* sgg = (const bf16_t*)(ws + WS_SG) + ((size_t)b * SEQ + tok) * 512 + h * 128 + 16 * part;
        f32x4 nw[4];
#pragma unroll
        for (int q = 0; q < 4; ++q) nw[q] = *(const f32x4*)(P.rec_norm_w + h * 128 + 16 * part + 4 * q);
        auto epilogue = [&](int c, u32x4 s0, u32x4 s1) {
            const LAS char* ob = lds + RS_OUT + (c & 1) * RS_OUTB + (tok * 136 + 16 * part) * 2;
            const u32x4 o0 = *(const LAS u32x4*)ob, o1 = *(const LAS u32x4*)(ob + 16);
            const unsigned ou[8] = {o0.x, o0.y, o0.z, o0.w, o1.x, o1.y, o1.z, o1.w}, su[8] = {s0.x, s0.y, s0.z, s0.w, s1.x, s1.y, s1.z, s1.w};
            float v[16], ss = 0.f;
#pragma unroll
            for (int q = 0; q < 8; ++q) { v[2 * q] = bf2f(ou[q] & 0xffffu); v[2 * q + 1] = bf2f(ou[q] >> 16); ss += v[2 * q] * v[2 * q] + v[2 * q + 1] * v[2 * q + 1]; }
            ss += __shfl_xor(ss, 1); ss += __shfl_xor(ss, 2); ss += __shfl_xor(ss, 4);
            const float rs = 1.f / sqrtf(ss * (1.f / 128.f) + EPS);
            u32x4 w0, w1; unsigned wo[8];
#pragma unroll
            for (int q = 0; q < 8; ++q) wo[q] = cvtpk(v[2 * q] * rs * nw[q >> 1][(2 * q) & 3] * bf2f(su[q] & 0xffffu), v[2 * q + 1] * rs * nw[q >> 1][(2 * q + 1) & 3] * bf2f(su[q] >> 16));
            w0 = (u32x4){wo[0], wo[1], wo[2], wo[3]}; w1 = (u32x4){wo[4], wo[5], wo[6], wo[7]};
            bf16_t* mp = (bf16_t*)(ws + WS_MIX) + ((size_t)b * SEQ + 32 * (c - 1) + tok) * DM + 512 + h * 128 + 16 * part;
            *(u32x4*)mp = w0; *(u32x4*)(mp + 8) = w1;
        };
#define SG_LD(k, A, B) do { const bf16_t* p_ = sgg + (size_t)(32 * ((k) - 1)) * 512; A = *(const u32x4*)p_; B = *(const u32x4*)(p_ + 8); } while (0)
        u32x4 ga0, ga1, gb0, gb1, gc0, gc1, gd0, gd1;
        SG_LD(1, gb0, gb1); SG_LD(2, gc0, gc1); SG_LD(3, gd0, gd1);
        HW_BAR();
        HW_BAR();
        for (int k = 1; k <= 128; k += 4) {
            HW_BAR(); if (k + 3 <= 128) SG_LD(k + 3, ga0, ga1); epilogue(k, gb0, gb1);
            HW_BAR(); if (k + 4 <= 128) SG_LD(k + 4, gb0, gb1); epilogue(k + 1, gc0, gc1);
            HW_BAR(); if (k + 5 <= 128) SG_LD(k + 5, gc0, gc1); epilogue(k + 2, gd0, gd1);
            HW_BAR(); if (k + 6 <= 128) SG_LD(k + 6, gd0, gd1); epilogue(k + 3, ga0, ga1);
        }
#undef SG_LD
        HW_BAR();
    }
}
DI float rawmax(float a, float b) { float d; asm("v_max_f32 %0, %1, %2" : "=v"(d) : "v"(a), "v"(b)); return d; }
DI float rawmin(float a, float b) { float d; asm("v_min_f32 %0, %1, %2" : "=v"(d) : "v"(a), "v"(b)); return d; }
#define CE_D(a, b) do { const float hi_ = rawmax(a, b), lo_ = rawmin(a, b); a = hi_; b = lo_; } while (0)
DI void bitonic_sort16(float (&v)[16]) {
#pragma unroll
    for (int k = 2; k <= 16; k *= 2)
#pragma unroll
        for (int j = k / 2; j > 0; j /= 2)
#pragma unroll
            for (int i = 0; i < 16; ++i) { const int l = i ^ j; if (l > i) { if ((i & k) == 0) CE_D(v[i], v[l]); else CE_D(v[l], v[i]); } }
}
DI void merge_top16(float (&a)[16], const float (&b)[16]) {
#pragma unroll
    for (int i = 0; i < 16; ++i) a[i] = rawmax(a[i], b[15 - i]);
#pragma unroll
    for (int j = 8; j > 0; j /= 2)
#pragma unroll
        for (int i = 0; i < 16; ++i) { const int l = i ^ j; if (l > i) CE_D(a[i], a[l]); }
}
DI float embed7(float v, unsigned code) { return __uint_as_float((__float_as_uint(v) & 0xFFFFFF80u) | code); }
DI float embed8(float v, unsigned code) { return __uint_as_float((__float_as_uint(v) & 0xFFFFFF00u) | code); }

DI void topk_list(const bf16_t* qp, const LAS char* skf, int lane, int hi, float (&top)[16]) {
    f32x16 acc[4];
#pragma unroll
    for (int kb = 0; kb < 4; ++kb) acc[kb] = f32x16{};
#pragma unroll
    for (int ks = 0; ks < 8; ++ks) {
        const bf16x8 qf = *(const bf16x8*)(qp + 16 * ks);
#pragma unroll
        for (int kb = 0; kb < 4; ++kb) { const bf16x8 kf = *(const LAS bf16x8*)(skf + (kb * 8 + ks) * 1024 + lane * 16); acc[kb] = MFMA32(kf, qf, acc[kb]); }
    }
    float blk[16];
#pragma unroll
    for (int kb = 0; kb < 4; ++kb) {
#pragma unroll
        for (int r = 0; r < 16; ++r) { const unsigned code = (unsigned)(32 * kb + (r & 3) + 8 * (r >> 2)) | (unsigned)(4 * hi); if (kb == 0) top[r] = embed7(acc[kb][r], code); else blk[r] = embed7(acc[kb][r], code); }
        if (kb == 0) bitonic_sort16(top); else { bitonic_sort16(blk); merge_top16(top, blk); }
    }
    float l0[16], l1[16];
#pragma unroll
    for (int r = 0; r < 16; ++r) { auto rr = __builtin_amdgcn_permlane32_swap(__float_as_uint(top[r]), __float_as_uint(top[r]), false, false); l0[r] = __uint_as_float(rr[0]); l1[r] = __uint_as_float(rr[1]); }
    merge_top16(l0, l1);
#pragma unroll
    for (int r = 0; r < 16; ++r) top[r] = l0[r];
}

DI void topk_wave_item(const Params& P, int tb, int hh, LAS char* wlds, const LAS char* skf) {
    const int lane = tid_() & 63, r32 = lane & 31, hi = lane >> 5;
    const unsigned char* ws = P.ws;
    const bf16_t* qp = (const bf16_t*)(ws + WS_PQ) + (size_t)(32 * tb + r32) * 2048 + hh * 256 + 8 * hi;
    float A[16], B[16];
    topk_list(qp, skf, lane, hi, A);
    topk_list(qp + 128, skf + 32768, lane, hi, B);
    LAS unsigned* my = (LAS unsigned*)(wlds + lane * 32);
#pragma unroll
    for (int w = 0; w < 4; ++w) {
        my[w] = (__float_as_uint(A[4 * w]) & 127u) | ((__float_as_uint(A[4 * w + 1]) & 127u) << 8) | ((__float_as_uint(A[4 * w + 2]) & 127u) << 16) | ((__float_as_uint(A[4 * w + 3]) & 127u) << 24);
        my[4 + w] = (__float_as_uint(B[4 * w]) & 127u) | ((__float_as_uint(B[4 * w + 1]) & 127u) << 8) | ((__float_as_uint(B[4 * w + 2]) & 127u) << 16) | ((__float_as_uint(B[4 * w + 3]) & 127u) << 24);
    }
#pragma unroll
    for (int r = 0; r < 16; ++r) { A[r] = __uint_as_float(__float_as_uint(A[r]) & 0xFFFFFF80u); B[r] = __uint_as_float(__float_as_uint(B[r]) & 0xFFFFFF80u); }
    float T[16], R1[16], X[16], Y[16];
#pragma unroll
    for (int j = 0; j < 16; ++j) { T[j] = embed8(A[0] + B[j], (unsigned)j); R1[j] = (j < 8) ? embed8(A[1] + B[j], (unsigned)(16 + j)) : -INFINITY; }
#define CAND(i, j) embed8(A[i] + B[j], (unsigned)(16 * (i) + (j)))
    X[0] = CAND(2, 0); X[1] = CAND(2, 1); X[2] = CAND(2, 2); X[3] = CAND(2, 3); X[4] = CAND(2, 4); X[5] = CAND(3, 0); X[6] = CAND(3, 1); X[7] = CAND(3, 2);
    X[8] = CAND(3, 3); X[9] = CAND(4, 0); X[10] = CAND(4, 1); X[11] = CAND(4, 2); X[12] = CAND(5, 0); X[13] = CAND(5, 1); X[14] = CAND(6, 0); X[15] = CAND(6, 1);
    Y[0] = CAND(7, 0); Y[1] = CAND(7, 1); Y[2] = CAND(8, 0); Y[3] = CAND(9, 0); Y[4] = CAND(10, 0); Y[5] = CAND(11, 0); Y[6] = CAND(12, 0); Y[7] = CAND(13, 0);
    Y[8] = CAND(14, 0); Y[9] = CAND(15, 0); Y[10] = -INFINITY; Y[11] = -INFINITY; Y[12] = -INFINITY; Y[13] = -INFINITY; Y[14] = -INFINITY; Y[15] = -INFINITY;
#undef CAND
    bitonic_sort16(X); bitonic_sort16(Y);
    merge_top16(T, R1); merge_top16(T, X); merge_top16(T, Y);
    asm volatile("s_waitcnt lgkmcnt(0)" ::: "memory");
    float ssum = 0.f, e[16]; int eid[16];
    const float t0 = __uint_as_float(__float_as_uint(T[0]) & 0xFFFFFF00u);
#pragma unroll
    for (int r = 0; r < 16; ++r) {
        const unsigned bits = __float_as_uint(T[r]); const unsigned code = bits & 255u;
        e[r] = __expf(__uint_as_float(bits & 0xFFFFFF00u) - t0); ssum += e[r];
        const int ka = ((const LAS unsigned char*)my)[code >> 4], kb_ = ((const LAS unsigned char*)my)[16 + (code & 15u)];
        eid[r] = ka * 128 + kb_;
    }
    const float inv = 1.f / ssum;
    const size_t o = (size_t)(32 * tb + r32) * 128 + hh * 16 + 8 * hi;
    int* ei = (int*)(ws + WS_EIDX) + o; float* eg = (float*)(ws + WS_EGATE) + o;
    typedef int i32x4 __attribute__((ext_vector_type(4)));
    i32x4 w0, w1; f32x4 g0, g1;
    const unsigned mh = 0u - (unsigned)hi;
#define SELU(a, b) ((((unsigned)(b)) & mh) | (((unsigned)(a)) & ~mh))
#pragma unroll
    for (int q = 0; q < 4; ++q) { w0[q] = (int)SELU(eid[q], eid[8 + q]); w1[q] = (int)SELU(eid[4 + q], eid[12 + q]);
        g0[q] = __uint_as_float(SELU(__float_as_uint(e[q]), __float_as_uint(e[8 + q]))) * inv; g1[q] = __uint_as_float(SELU(__float_as_uint(e[4 + q]), __float_as_uint(e[12 + q]))) * inv; }
#undef SELU
    *(i32x4*)ei = w0; *(i32x4*)(ei + 4) = w1; *(f32x4*)eg = g0; *(f32x4*)(eg + 4) = g1;
}

DI void xn8_rows(const Params& P, int bid, int nblk);
DI void topk_phase(const Params& P, char* lds_g, int bid, int nblk) {
    const int tid = tid_(), wave = __builtin_amdgcn_readfirstlane(tid >> 6);
    LAS char* lds = (LAS char*)lds_g;
    LAS char* wlds = lds + wave * 2048;
    LAS char* skf = lds + 16384;
    int cur_h = -1; bool rows_done = false;
    for (int it = bid; it < (NTOK / 256) * 8; it += nblk) {
        const int hh = it & 7, tg = it >> 3;
        if (hh != cur_h) {
            __syncthreads();
#pragma unroll
            for (int i = 0; i < 8; ++i) {
                const int f = tid + 512 * i, l = f & 63, ks = (f >> 6) & 7, kb = (f >> 9) & 3, p = f >> 11;
                *(LAS u32x4*)(skf + f * 16) = *(const u32x4*)((const bf16_t*)(P.ws + WS_SKB) + (size_t)((hh * 2 + p) * 128 + 32 * kb + (l & 31)) * 128 + 16 * ks + 8 * (l >> 5));
            }
            __syncthreads();
            cur_h = hh;
        }
        if (wave >= 4 && !rows_done) { xn8_rows(P, bid, nblk); rows_done = true; }
        topk_wave_item(P, tg * 8 + wave, hh, wlds, skf);
    }
    if (!rows_done) xn8_rows(P, bid, nblk);
}

DI float gelu_exact(float x) { return 0.5f * x * (1.f + erff(x * 0.70710678118654752f)); }
typedef __bf16 bf16x8_t __attribute__((ext_vector_type(8)));
DI float dot8(u32x4 a, u32x4 x, float acc) {
    const bf16x8_t a8 = __builtin_bit_cast(bf16x8_t, a), x8 = __builtin_bit_cast(bf16x8_t, x);
    acc = __builtin_amdgcn_fdot2_f32_bf16(__builtin_shufflevector(a8, a8, 0, 1), __builtin_shufflevector(x8, x8, 0, 1), acc, false);
    acc = __builtin_amdgcn_fdot2_f32_bf16(__builtin_shufflevector(a8, a8, 2, 3), __builtin_shufflevector(x8, x8, 2, 3), acc, false);
    acc = __builtin_amdgcn_fdot2_f32_bf16(__builtin_shufflevector(a8, a8, 4, 5), __builtin_shufflevector(x8, x8, 4, 5), acc, false);
    acc = __builtin_amdgcn_fdot2_f32_bf16(__builtin_shufflevector(a8, a8, 6, 7), __builtin_shufflevector(x8, x8, 6, 7), acc, false);
    return acc;
}
DI float wave_sum_dpp(float v) {
    v = row16_sum(v);
    return (readlane_f(v, 0) + readlane_f(v, 16)) + (readlane_f(v, 32) + readlane_f(v, 48));
}

DI float dot16_fp8(u32x4 w, const f32x2 (&x)[8]) {
    f32x2 acc = __builtin_amdgcn_cvt_pk_f32_fp8((int)w.x, false) * x[0];
    acc = __builtin_amdgcn_cvt_pk_f32_fp8((int)w.x, true) * x[1] + acc;
    acc = __builtin_amdgcn_cvt_pk_f32_fp8((int)w.y, false) * x[2] + acc;
    acc = __builtin_amdgcn_cvt_pk_f32_fp8((int)w.y, true) * x[3] + acc;
    acc = __builtin_amdgcn_cvt_pk_f32_fp8((int)w.z, false) * x[4] + acc;
    acc = __builtin_amdgcn_cvt_pk_f32_fp8((int)w.z, true) * x[5] + acc;
    acc = __builtin_amdgcn_cvt_pk_f32_fp8((int)w.w, false) * x[6] + acc;
    acc = __builtin_amdgcn_cvt_pk_f32_fp8((int)w.w, true) * x[7] + acc;
    return acc.x + acc.y;
}
DI void peer_hid_phase(const Params& P, int bid, int nblk) {
    const int tid = tid_(), lane = tid & 63, wave = __builtin_amdgcn_readfirstlane(tid >> 6);
    const unsigned char* ws = P.ws;
    const unsigned char* U8 = ws + WS_UB; const float* USC = (const float*)(ws + WS_USC);
    const int gw = bid * NWAVES + wave, NGW = nblk * NWAVES;
    f32x4 wv[4];
#pragma unroll
    for (int q = 0; q < 4; ++q) wv[q] = *(const f32x4*)(P.ffn_norm_w + 16 * lane + 4 * q);
    for (int n = gw; n < NTOK; n += NGW) {
        const float* hrow = P.out + (size_t)n * DM + 16 * lane;
        f32x4 h[4]; float ss = 0.f;
#pragma unroll
        for (int q = 0; q < 4; ++q) { h[q] = *(const f32x4*)(hrow + 4 * q); ss += (h[q].x * h[q].x + h[q].y * h[q].y) + (h[q].z * h[q].z + h[q].w * h[q].w); }
        ss = wave_sum_dpp(ss);
        const float r2 = 1.f / sqrtf(ss * (1.f / DM) + EPS);
        f32x2 x[8];
#pragma unroll
        for (int q = 0; q < 4; ++q) { const f32x4 t = h[q] * wv[q] * r2; x[2 * q] = (f32x2){t.x, t.y}; x[2 * q + 1] = (f32x2){t.z, t.w}; }
        const int* eidx = (const int*)(ws + WS_EIDX) + (size_t)n * 128;
        const float* egate = (const float*)(ws + WS_EGATE) + (size_t)n * 128;
        const int id0 = eidx[lane], id1 = eidx[64 + lane];
        float hid0 = 0.f, hid1 = 0.f;
#pragma unroll 1
        for (int k0 = 0; k0 < 128; k0 += 16) {
            u32x4 ra[16]; float sc[16];
#pragma unroll
            for (int e = 0; e < 16; ++e) {
                const int k = k0 + e;
                const int id = (k0 < 64) ? __builtin_amdgcn_readlane(id0, k & 63) : __builtin_amdgcn_readlane(id1, k & 63);
                ra[e] = *(const u32x4*)(U8 + (size_t)id * DM + 16 * lane); sc[e] = USC[id];
            }
#pragma unroll
            for (int e = 0; e < 16; ++e) {
                const int k = k0 + e;
                const float d = wave_sum_dpp(dot16_fp8(ra[e], x)) * sc[e];
                if (k0 < 64) { if (lane == (k & 63)) hid0 = d; } else { if (lane == (k & 63)) hid1 = d; }
            }
        }
        float* hid = (float*)(ws + WS_HID) + (size_t)n * 128;
        hid[lane] = gelu_exact(hid0) * egate[lane];
        hid[64 + lane] = gelu_exact(hid1) * egate[64 + lane];
    }
}

DI void peer_out_phase(const Params& P, int bid, int nblk) {
    const int tid = tid_(), lane = tid & 63, wave = __builtin_amdgcn_readfirstlane(tid >> 6);
    const unsigned char* ws = P.ws;
    const unsigned char* V8 = ws + WS_VB; const float* VSC = (const float*)(ws + WS_VSC);
    const int gw = bid * NWAVES + wave, NGW = nblk * NWAVES;
    f32x4 wv[4];
#pragma unroll
    for (int q = 0; q < 4; ++q) wv[q] = *(const f32x4*)(P.final_w + 16 * lane + 4 * q);
    for (int n = gw; n < NTOK; n += NGW) {
        const int* eidx = (const int*)(ws + WS_EIDX) + (size_t)n * 128;
        const float* hid = (const float*)(ws + WS_HID) + (size_t)n * 128;
        const int id0 = eidx[lane], id1 = eidx[64 + lane];
        const float c0 = hid[lane], c1 = hid[64 + lane];
        f32x2 acc[8];
#pragma unroll
        for (int i = 0; i < 8; ++i) acc[i] = (f32x2){0.f, 0.f};
#pragma unroll 1
        for (int k0 = 0; k0 < 128; k0 += 16) {
            u32x4 ra[16]; float cf[16];
#pragma unroll
            for (int e = 0; e < 16; ++e) {
                const int k = k0 + e;
                const int id = (k0 < 64) ? __builtin_amdgcn_readlane(id0, k & 63) : __builtin_amdgcn_readlane(id1, k & 63);
                cf[e] = ((k0 < 64) ? readlane_f(c0, k & 63) : readlane_f(c1, k & 63)) * VSC[id];
                ra[e] = *(const u32x4*)(V8 + (size_t)id * DM + 16 * lane);
            }
#pragma unroll
            for (int e = 0; e < 16; ++e) {
                const f32x2 c = (f32x2){cf[e], cf[e]}; const u32x4 w = ra[e];
                acc[0] = __builtin_amdgcn_cvt_pk_f32_fp8((int)w.x, false) * c + acc[0]; acc[1] = __builtin_amdgcn_cvt_pk_f32_fp8((int)w.x, true) * c + acc[1];
                acc[2] = __builtin_amdgcn_cvt_pk_f32_fp8((int)w.y, false) * c + acc[2]; acc[3] = __builtin_amdgcn_cvt_pk_f32_fp8((int)w.y, true) * c + acc[3];
                acc[4] = __builtin_amdgcn_cvt_pk_f32_fp8((int)w.z, false) * c + acc[4]; acc[5] = __builtin_amdgcn_cvt_pk_f32_fp8((int)w.z, true) * c + acc[5];
                acc[6] = __builtin_amdgcn_cvt_pk_f32_fp8((int)w.w, false) * c + acc[6]; acc[7] = __builtin_amdgcn_cvt_pk_f32_fp8((int)w.w, true) * c + acc[7];
            }
        }
        float* orow = P.out + (size_t)n * DM + 16 * lane;
        f32x4 h[4]; float ss = 0.f;
#pragma unroll
        for (int q = 0; q < 4; ++q) { h[q] = *(const f32x4*)(orow + 4 * q) + (f32x4){acc[2 * q].x, acc[2 * q].y, acc[2 * q + 1].x, acc[2 * q + 1].y}; ss += (h[q].x * h[q].x + h[q].y * h[q].y) + (h[q].z * h[q].z + h[q].w * h[q].w); }
        ss = wave_sum_dpp(ss);
        const float rs = 1.f / sqrtf(ss * (1.f / DM) + EPS);
#pragma unroll
        for (int q = 0; q < 4; ++q) *(f32x4*)(orow + 4 * q) = h[q] * wv[q] * rs;
    }
}

#ifdef DBG_CHECK
DI void dbg_max(float* slot, float v) { atomicMax((unsigned*)slot, __float_as_uint(fmaxf(v, 0.f))); }
DI void dbg_check_topk(const Params& P, char* lds_g, int bid, int nblk) {
    LAS char* lds = (LAS char*)lds_g;
    const int tid = tid_(), lane = tid & 63, wave = __builtin_amdgcn_readfirstlane(tid >> 6);
    const unsigned char* ws = P.ws; float* dbg = (float*)(ws + WS_CTL) + 64;
    LAS float* sc = (LAS float*)(lds) + wave * 1024;
    const int gw = bid * NWAVES + wave;
    const int token = (gw * 37) % NTOK, hh = gw & 7;
    for (int p = 0; p < 2; ++p) for (int kk = 0; kk < 2; ++kk) {
        const int key = lane + 64 * kk; float a = 0.f;
        const bf16_t* q = (const bf16_t*)(ws + WS_PQ) + (size_t)token * 2048 + hh * 256 + p * 128;
        const bf16_t* sk = (const bf16_t*)(ws + WS_SKB) + (size_t)((hh * 2 + p) * 128 + key) * 128;
        for (int c = 0; c < 128; ++c) a += bf2f(q[c]) * bf2f(sk[c]);
        sc[p * 128 + key] = a;
    }
    asm volatile("s_waitcnt lgkmcnt(0)" ::: "memory");
    for (int p = 0; p < 2; ++p) for (int kk = 0; kk < 2; ++kk) {
        const int key = lane + 64 * kk; const float v = sc[p * 128 + key]; int rank = 0;
        for (int o = 0; o < 128; ++o) { const float w = sc[p * 128 + o]; rank += (w > v || (w == v && o < key)) ? 1 : 0; }
        if (rank < 16) { sc[256 + p * 16 + rank] = v; sc[288 + p * 16 + rank] = __int_as_float(key); }
    }
    asm volatile("s_waitcnt lgkmcnt(0)" ::: "memory");
    for (int e = 0; e < 4; ++e) {
        const int c = lane * 4 + e, i = c >> 4, j = c & 15; const float v = sc[256 + i] + sc[272 + j]; int rank = 0;
        for (int o = 0; o < 256; ++o) { const float w = sc[256 + (o >> 4)] + sc[272 + (o & 15)]; rank += (w > v || (w == v && o < c)) ? 1 : 0; }
        if (rank < 16) { sc[320 + rank] = __int_as_float(__float_as_int(sc[288 + i]) * 128 + __float_as_int(sc[304 + j])); sc[336 + rank] = v; }
    }
    asm volatile("s_waitcnt lgkmcnt(0)" ::: "memory");
    if (lane < 16) {
        const int eid = __float_as_int(sc[320 + lane]); const float sv = sc[336 + lane];
        float mx = sc[336], sum = 0.f; for (int o = 0; o < 16; ++o) sum += __expf(sc[336 + o] - mx);
        const float gate = __expf(sv - mx) / sum;
        const int* eidx = (const int*)(ws + WS_EIDX) + (size_t)token * 128 + hh * 16; const float* eg = (const float*)(ws + WS_EGATE) + (size_t)token * 128 + hh * 16;
        int found = -1; for (int o = 0; o < 16; ++o) if (eidx[o] == eid) found = o;
        if (found < 0) atomicAdd(dbg + 0, 1.f); else dbg_max(dbg + 1, fabsf(eg[found] - gate));
    }
    if (lane == 0) atomicAdd(dbg + 2, 16.f);
}
DI void dbg_check_hid(const Params& P, int bid, int nblk) {
    const int tid = tid_(), lane = tid & 63, wave = __builtin_amdgcn_readfirstlane(tid >> 6);
    const unsigned char* ws = P.ws; float* dbg = (float*)(ws + WS_CTL) + 64;
    const int gw = bid * NWAVES + wave; const int token = (gw * 53) % NTOK;
    const float* hrow = P.out + (size_t)token * DM;
    float ss = 0.f; for (int c = lane; c < DM; c += 64) ss += hrow[c] * hrow[c];
    ss = wave_sum(ss); const float r2 = 1.f / sqrtf(ss / DM + EPS);
    for (int kk = 0; kk < 2; ++kk) {
        const int k = lane + 64 * kk; const int eid = ((const int*)(ws + WS_EIDX))[(size_t)token * 128 + k];
        const float* urow = P.pu + (size_t)eid * DM; float d = 0.f;
        for (int c = 0; c < DM; ++c) d += urow[c] * (hrow[c] * r2 * P.ffn_norm_w[c]);
        const float hidv = gelu_exact(d) * ((const float*)(ws + WS_EGATE))[(size_t)token * 128 + k];
        const float got = ((const float*)(ws + WS_HID))[(size_t)token * 128 + k];
        dbg_max(dbg + 3, fabsf(got - hidv)); dbg_max(dbg + 4, fabsf(hidv));
    }
}
DI float dbg_enc(float m) { return 8.f + log10f(fmaxf(m, 1e-8f)); }
#endif

#ifdef DBG_CHECK
DI void dbg_check_attn(const Params& P, int bid, int nblk) {
    const int tid = tid_(), lane = tid & 63, wave = __builtin_amdgcn_readfirstlane(tid >> 6);
    const unsigned char* ws = P.ws; float* dbg = (float*)(ws + WS_CTL) + 64;
    const int gw = bid * NWAVES + wave;
    const unsigned hsh = (unsigned)gw * 2654435761u;
    const int b = (hsh >> 8) & 7, h = (hsh >> 11) & 3, i = (int)((hsh >> 13) % 4096u), bh = b * 4 + h;
    const float lam = ((const float*)(ws + WS_LB))[512];
    float oc[2][2], lsum[2], mx[2];
    for (int c = 0; c < 2; ++c) { oc[c][0] = oc[c][1] = 0.f; lsum[c] = 0.f; mx[c] = -1e30f; }
    for (int pp = KPAD; pp <= 64 + i; ++pp) {
        const int tile = pp >> 6, key = pp & 63;
        for (int c = 0; c < 2; ++c) {
            const bf16_t* q = (const bf16_t*)(ws + WS_Q) + ((size_t)((bh * 2 + c) * SEQ + i)) * 64;
            const unsigned char* kimg = ws + WS_K + ((size_t)(bh * 2 + c) * KT + tile) * 8192;
            float sdot = 0.f;
            for (int d = 0; d < 64; ++d) sdot += bf2f(q[d]) * bf2f(*(const bf16_t*)(kimg + (d >> 3) * 1024 + key * 16 + (d & 7) * 2));
            const float mn = fmaxf(mx[c], sdot), al = exp2f(mx[c] - mn), pe = exp2f(sdot - mn);
            const unsigned char* vimg = ws + WS_V + ((size_t)bh * KT + tile) * 16384;
            for (int e = 0; e < 2; ++e) { const int dv = lane + 64 * e; oc[c][e] = oc[c][e] * al + pe * bf2f(*(const bf16_t*)(vimg + (dv >> 5) * 4096 + key * 64 + (dv & 31) * 2)); }
            lsum[c] = lsum[c] * al + pe; mx[c] = mn;
        }
    }
    float o[2], ss = 0.f;
    for (int e = 0; e < 2; ++e) { o[e] = oc[0][e] / lsum[0] - lam * oc[1][e] / lsum[1]; ss += o[e] * o[e]; }
    ss = wave_sum(ss); const float rs = (1.f - LAM_INIT) / sqrtf(ss / 128.f + EPS);
    for (int e = 0; e < 2; ++e) { const int dv = lane + 64 * e; const float want = o[e] * rs * P.subln_w[dv];
        const float got = bf2f(((const bf16_t*)(ws + WS_MIX))[(size_t)(b * SEQ + i) * DM + h * 128 + dv]);
        dbg_max(dbg + 5, fabsf(got - want)); dbg_max(dbg + 6, fabsf(want)); }
}
DI void dbg_check_hgrn(const Params& P, char* lds_g, int bid, int nblk) {
    if (bid >= 32) return;
    LAS float* L = (LAS float*)lds_g;
    const int tid = tid_(), dv = tid & 127, qt = tid >> 7;
    const unsigned char* ws = P.ws; float* dbg = (float*)(ws + WS_CTL) + 64;
    const int bh = bid, b = bid >> 2, h = bid & 3;
    const float* HG = (const float*)(ws + WS_HG) + (size_t)bh * HT * 128;
    const bf16_t* HQ = (const bf16_t*)(ws + WS_HQ) + (size_t)bh * HT * 128;
    const bf16_t* HV = (const bf16_t*)(ws + WS_HV) + (size_t)bh * HT * 128;
    float S[32];
#pragma unroll
    for (int j = 0; j < 32; ++j) S[j] = 0.f;
    for (int pp = 16; pp < HT; ++pp) {
        if (tid < 128) { L[tid] = __expf(HG[(size_t)pp * 128 + tid]); L[128 + tid] = bf2f(HQ[(size_t)pp * 128 + tid]); L[256 + tid] = bf2f(HV[(size_t)pp * 128 + tid]); }
        __syncthreads();
        const float v = L[256 + dv]; float part = 0.f;
#pragma unroll
        for (int j = 0; j < 32; ++j) { const float f = L[32 * qt + j]; S[j] = f * S[j] + (1.f - f) * v; part += L[128 + 32 * qt + j] * S[j]; }
        L[384 + qt * 128 + dv] = part;
        __syncthreads();
        if (tid < 128) { const float o = L[384 + dv] + L[512 + dv] + L[640 + dv] + L[768 + dv]; L[896 + dv] = o; }
        __syncthreads();
        if (tid < 128 && pp >= 32) {
            float ss = 0.f; for (int j = 0; j < 128; ++j) ss += L[896 + j] * L[896 + j];
            const float rs = 1.f / sqrtf(ss / 128.f + EPS);
            const size_t row = (size_t)b * SEQ + (pp - 32);
            const float want = L[896 + dv] * rs * P.rec_norm_w[h * 128 + dv] * bf2f(((const bf16_t*)(ws + WS_SG))[row * 512 + h * 128 + dv]);
            const float got = bf2f(((const bf16_t*)(ws + WS_MIX))[row * DM + 512 + h * 128 + dv]);
            dbg_max(dbg + 7, fabsf(got - want)); dbg_max(dbg + 8, fabsf(want));
        }
        __syncthreads();
    }
}
#endif

#ifdef DBG_CHECK
DI float dbg_proj(const Params& P, int m, int c) {
    const float* xrow = (m < NTOK) ? P.x + (size_t)m * DM : P.meta + (size_t)(m - NTOK) * DM;
    float ss = 0.f, a = 0.f;
    for (int k = 0; k < DM; ++k) { const float xv = xrow[k]; ss += xv * xv; a += xv * P.mix_norm_w[k] * P.w_in[(size_t)k * NCOL1 + c]; }
    return a / sqrtf(ss / DM + EPS);
}
DI void dbg_check_gemm1(const Params& P, int bid, int nblk) {
    const unsigned char* ws = P.ws; float* dbg = (float*)(ws + WS_CTL) + 64;
    const int gt = bid * NTHREADS + tid_();
    if (gt >= 7 * 4096) return;
    const unsigned hsh = (unsigned)gt * 2654435761u;
    const int seg = gt % 7, cs = (hsh >> 7) & 511;
    const bool meta = ((gt / 7) & 15) == 0;
    const int m = meta ? NTOK + ((hsh >> 20) & 15) : (int)((hsh >> 3) % (unsigned)NTOK);
    const int b = meta ? (int)((hsh >> 25) & 7) : (m >> 12), t = meta ? (m - NTOK) : ((m & 4095) + NMETA);
    const int h = cs >> 7;
    float want = 0.f, got = 0.f;
    if (seg <= 1) {
        if (seg == 0 && meta) return;
        const int comp = (cs >> 6) & 1, d = cs & 63, dlo = d & 31;
        const float zlo = dbg_proj(P, m, seg * 512 + (cs & ~63) + dlo), zhi = dbg_proj(P, m, seg * 512 + (cs & ~63) + dlo + 32);
        const double inv = exp2(-(double)dlo * (13.287712379549449 / 32.0)); const float cv = (float)cos((double)t * inv), sv = (float)sin((double)t * inv);
        want = (d < 32) ? zlo * cv - zhi * sv : zhi * cv + zlo * sv;
        if (seg == 0) { want *= QSCALE; got = bf2f(((const bf16_t*)(ws + WS_Q))[((size_t)(((b * 4 + h) * 2 + comp) * SEQ + (m & 4095))) * 64 + d]); }
        else { const int pp = t + KPAD; got = bf2f(*(const bf16_t*)(ws + WS_K + ((size_t)((b * 4 + h) * 2 + comp) * KT + (pp >> 6)) * 8192 + (d >> 3) * 1024 + (pp & 63) * 16 + (d & 7) * 2)); }
    } else {
        const float z = dbg_proj(P, m, seg * 512 + cs); const int dv = cs & 127;
        if (seg == 2) { const int pp = t + KPAD; want = z; got = bf2f(*(const bf16_t*)(ws + WS_V + ((size_t)(b * 4 + h) * KT + (pp >> 6)) * 16384 + (dv >> 5) * 4096 + (pp & 63) * 64 + (dv & 31) * 2)); }
        else if (seg == 3) { want = siluf_(z); got = bf2f(((const bf16_t*)(ws + WS_HQ))[((size_t)(b * 4 + h) * HT + t + 16) * 128 + dv]); }
        else if (seg == 4) { const float l0 = P.lb_logits[cs], l1 = P.lb_logits[512 + cs], lb = __expf(l0) / (__expf(l0) + __expf(l1)); want = __logf(lb + (1.f - lb) * sigmoidf_(z)); got = ((const float*)(ws + WS_HG))[((size_t)(b * 4 + h) * HT + t + 16) * 128 + dv]; }
        else if (seg == 5) { want = z; got = bf2f(((const bf16_t*)(ws + WS_HV))[((size_t)(b * 4 + h) * HT + t + 16) * 128 + dv]); }
        else { if (meta) return; want = siluf_(z); got = bf2f(((const bf16_t*)(ws + WS_SG))[(size_t)m * 512 + cs]); }
    }
    dbg_max(dbg + 16 + seg + (meta ? 8 : 0), fabsf(got - want));
}
#endif
typedef unsigned u32x4v __attribute__((vector_size(16)));
DI float oct_sum(float v) {
    v += dpp_f<0xB1>(v); v += dpp_f<0x4E>(v); v += dpp_f<0x141>(v); return v;
}
DI unsigned my_xcc_id() { return (unsigned)__builtin_amdgcn_s_getreg((3 << 11) | 20) & 7u; }
constexpr int CTL_G1 = 16, CTL_G2 = 32;

DI void xn8_rows(const Params& P, int bid, int nblk) {
    const int tid = tid_(), lane = tid & 63, wave = __builtin_amdgcn_readfirstlane(tid >> 6);
    unsigned char* ws = P.ws;
    const int gw = bid * NWAVES + wave, NGW = nblk * NWAVES;
    f32x4 wv[4];
#pragma unroll
    for (int q = 0; q < 4; ++q) wv[q] = *(const f32x4*)(P.ffn_norm_w + 16 * lane + 4 * q);
    u32x4 ha, hb, na, nb_; float sq, nsq;
#define XN8_LD(n_, A, B, S) do { const bf16_t* hrow_ = (const bf16_t*)(ws + WS_XB) + (size_t)(n_) * DM + 16 * lane; A = *(const u32x4*)hrow_; B = *(const u32x4*)(hrow_ + 8); S = ((const float*)(ws + WS_SSQ))[n_]; } while (0)
    if (gw < NTOK) XN8_LD(gw, ha, hb, sq);
    for (int n = gw; n < NTOK; n += NGW) {
        if (n + NGW < NTOK) XN8_LD(n + NGW, na, nb_, nsq);
        const float r2 = 1.f / sqrtf(sq * (1.f / DM) + EPS);
        const unsigned hu[8] = {ha.x, ha.y, ha.z, ha.w, hb.x, hb.y, hb.z, hb.w};
        f32x4 t[4]; float am = 0.f;
#pragma unroll
        for (int q = 0; q < 4; ++q) { t[q] = (f32x4){bf2f(hu[2 * q] & 0xffffu), bf2f(hu[2 * q] >> 16), bf2f(hu[2 * q + 1] & 0xffffu), bf2f(hu[2 * q + 1] >> 16)} * wv[q] * r2; am = fmaxf(am, fmaxf(fmaxf(fabsf(t[q].x), fabsf(t[q].y)), fmaxf(fabsf(t[q].z), fabsf(t[q].w)))); }
        am = row16_max(am); am = fmaxf(fmaxf(readlane_f(am, 0), readlane_f(am, 16)), fmaxf(readlane_f(am, 32), readlane_f(am, 48)));
        const float sc = (am > 0.f) ? exp2f(floorf(log2f(224.f / am))) : 1.f;
        int w[4];
#pragma unroll
        for (int q = 0; q < 4; ++q) { w[q] = __builtin_amdgcn_cvt_pk_fp8_f32(t[q].x * sc, t[q].y * sc, 0, false); w[q] = __builtin_amdgcn_cvt_pk_fp8_f32(t[q].z * sc, t[q].w * sc, w[q], true); }
        *(u32x4*)(ws + WS_XN8 + (size_t)n * DM + 16 * lane) = (u32x4){(unsigned)w[0], (unsigned)w[1], (unsigned)w[2], (unsigned)w[3]};
        if (lane == 0) ((float*)(ws + WS_XSC))[n] = 1.f / sc;
        ha = na; hb = nb_; sq = nsq;
    }
#undef XN8_LD
}
typedef int i32x4 __attribute__((ext_vector_type(4)));
struct GMeta { i32x4 id[4]; f32x4 c[4]; u32x4 xq; };
template <int WHICH>
DI void g_meta(const Params& P, int n, int x, GMeta& M) {
    const int lane = tid_() & 63, i = lane & 7, g = lane >> 3;
    const i32x4* ip = (const i32x4*)((const int*)(P.ws + WS_EIDX) + (size_t)n * 128 + 16 * g);
#pragma unroll
    for (int q = 0; q < 4; ++q) M.id[q] = ip[q];
    if (WHICH == 1) M.xq = *(const u32x4*)(P.ws + WS_XN8 + (size_t)n * DM + 128 * x + 16 * i);
    else { const f32x4* cp = (const f32x4*)((const float*)(P.ws + WS_HID) + (size_t)n * 128 + 16 * g);
#pragma unroll
        for (int q = 0; q < 4; ++q) M.c[q] = cp[q]; }
}
DI void g_issue(int x, const GMeta& M, u32x4v (&rw)[16], __amdgpu_buffer_rsrc_t rs) {
    const int i = tid_() & 7;
    const unsigned lo = (unsigned)x * (unsigned)(NEXP * 128) + (unsigned)(16 * i);
#pragma unroll
    for (int j = 0; j < 16; ++j) rw[j] = __builtin_amdgcn_raw_buffer_load_b128(rs, ((unsigned)M.id[j >> 2][j & 3] << 7) + lo, 0, 0);
}
DI void g1_finish(const Params& P, int n, int x, u32x4 xq, const u32x4v (&rw)[16]) {
    const int lane = tid_() & 63, i = lane & 7, g = lane >> 3;
    f32x2 xv[8];
    xv[0] = __builtin_amdgcn_cvt_pk_f32_fp8((int)xq.x, false); xv[1] = __builtin_amdgcn_cvt_pk_f32_fp8((int)xq.x, true);
    xv[2] = __builtin_amdgcn_cvt_pk_f32_fp8((int)xq.y, false); xv[3] = __builtin_amdgcn_cvt_pk_f32_fp8((int)xq.y, true);
    xv[4] = __builtin_amdgcn_cvt_pk_f32_fp8((int)xq.z, false); xv[5] = __builtin_amdgcn_cvt_pk_f32_fp8((int)xq.z, true);
    xv[6] = __builtin_amdgcn_cvt_pk_f32_fp8((int)xq.w, false); xv[7] = __builtin_amdgcn_cvt_pk_f32_fp8((int)xq.w, true);
    float pd[16];
#pragma unroll
    for (int j = 0; j < 16; ++j) pd[j] = dot16_fp8(__builtin_bit_cast(u32x4, rw[j]), xv);
    const unsigned m1 = 0u - (unsigned)((i >> 2) & 1), m2 = 0u - (unsigned)(i & 1), m3 = 0u - (unsigned)((i >> 1) & 1);
#define BSEL(a, b, m) __uint_as_float((__float_as_uint(a) & ~(m)) | (__float_as_uint(b) & (m)))
    float z[8], w[4], u[2];
#pragma unroll
    for (int q = 0; q < 8; ++q) { const float snd = BSEL(pd[q + 8], pd[q], m1), kep = BSEL(pd[q], pd[q + 8], m1); z[q] = kep + dpp_f<0x141>(snd); }
#pragma unroll
    for (int q = 0; q < 4; ++q) { const float snd = BSEL(z[q + 4], z[q], m2), kep = BSEL(z[q], z[q + 4], m2); w[q] = kep + dpp_f<0xB1>(snd); }
#pragma unroll
    for (int q = 0; q < 2; ++q) { const float snd = BSEL(w[q + 2], w[q], m3), kep = BSEL(w[q], w[q + 2], m3); u[q] = kep + dpp_f<0x4E>(snd); }
    const int j0 = 8 * ((i >> 2) & 1) + 4 * (i & 1) + 2 * ((i >> 1) & 1);
#undef BSEL
    *(f32x2*)((float*)(P.ws + WS_HIDP) + ((size_t)x * NTOK + n) * 128 + 16 * g + j0) = (f32x2){u[0], u[1]};
}
DI void g2_finish(const Params& P, int n, int x, const f32x4 (&cv)[4], const u32x4v (&rw)[16]) {
    const int lane = tid_() & 63, i = lane & 7, g = lane >> 3;
    f32x2 acc[8];
#pragma unroll
    for (int q = 0; q < 8; ++q) acc[q] = (f32x2){0.f, 0.f};
#pragma unroll
    for (int j = 0; j < 16; ++j) {
        const float cj = cv[j >> 2][j & 3]; const f32x2 c = (f32x2){cj, cj}; const u32x4 w = __builtin_bit_cast(u32x4, rw[j]);
        acc[0] = __builtin_amdgcn_cvt_pk_f32_fp8((int)w.x, false) * c + acc[0]; acc[1] = __builtin_amdgcn_cvt_pk_f32_fp8((int)w.x, true) * c + acc[1];
        acc[2] = __builtin_amdgcn_cvt_pk_f32_fp8((int)w.y, false) * c + acc[2]; acc[3] = __builtin_amdgcn_cvt_pk_f32_fp8((int)w.y, true) * c + acc[3];
        acc[4] = __builtin_amdgcn_cvt_pk_f32_fp8((int)w.z, false) * c + acc[4]; acc[5] = __builtin_amdgcn_cvt_pk_f32_fp8((int)w.z, true) * c + acc[5];
        acc[6] = __builtin_amdgcn_cvt_pk_f32_fp8((int)w.w, false) * c + acc[6]; acc[7] = __builtin_amdgcn_cvt_pk_f32_fp8((int)w.w, true) * c + acc[7];
    }
    float y[16], z[8], w[4];
#pragma unroll
    for (int q = 0; q < 8; ++q) { y[2 * q] = acc[q].x; y[2 * q + 1] = acc[q].y; }
#pragma unroll
    for (int q = 0; q < 8; ++q) { auto rr = __builtin_amdgcn_permlane32_swap(__float_as_uint(y[q]), __float_as_uint(y[q + 8]), false, false); z[q] = __uint_as_float(rr[0]) + __uint_as_float(rr[1]); }
#pragma unroll
    for (int q = 0; q < 4; ++q) { auto rr = __builtin_amdgcn_permlane16_swap(__float_as_uint(z[q]), __float_as_uint(z[q + 4]), false, false); w[q] = __uint_as_float(rr[0]) + __uint_as_float(rr[1]); }
    const unsigned m3 = 0u - (unsigned)(g & 1);
#define BSEL(a, b, m) __uint_as_float((__float_as_uint(a) & ~(m)) | (__float_as_uint(b) & (m)))
    const float k0 = BSEL(w[0], w[2], m3) + dpp_f<0x128>(BSEL(w[2], w[0], m3)), k1 = BSEL(w[1], w[3], m3) + dpp_f<0x128>(BSEL(w[3], w[1], m3));
#undef BSEL
    float* hp = P.out + (size_t)n * DM + 128 * x + 16 * i + 2 * g;
    const f32x2 t = *(const f32x2*)hp + (f32x2){k0, k1}; *(f32x2*)hp = t;
    const float ss = wave_sum_dpp(t.x * t.x + t.y * t.y);
    if (lane == 0) atomicAdd((float*)(P.ws + WS_SSQ2) + n, ss);
}
constexpr int SL_CHUNK = 128, SL_T = SL_CHUNK / NWAVES;
#define SB() __builtin_amdgcn_sched_barrier(0)
template <int WHICH>
DI void g_chunk(const Params& P, int nbase, int x, __amdgpu_buffer_rsrc_t rs) {
    GMeta MA, MB; u32x4v RA[16], RB[16];
    g_meta<WHICH>(P, nbase, x, MA); SB(); g_meta<WHICH>(P, nbase + 8, x, MB); SB(); g_issue(x, MA, RA, rs); SB();
#pragma unroll
    for (int t = 0; t < SL_T; t += 2) {
        const u32x4 xA = MA.xq; const f32x4 cA[4] = {MA.c[0], MA.c[1], MA.c[2], MA.c[3]};
        if (t + 2 < SL_T) { g_meta<WHICH>(P, nbase + 8 * (t + 2), x, MA); SB(); }
        g_issue(x, MB, RB, rs); SB();
        if (WHICH == 1) g1_finish(P, nbase + 8 * t, x, xA, RA); else g2_finish(P, nbase + 8 * t, x, cA, RA);
        SB();
        const u32x4 xB = MB.xq; const f32x4 cB[4] = {MB.c[0], MB.c[1], MB.c[2], MB.c[3]};
        if (t + 3 < SL_T) { g_meta<WHICH>(P, nbase + 8 * (t + 3), x, MB); SB(); }
        if (t + 2 < SL_T) { g_issue(x, MA, RA, rs); SB(); }
        if (WHICH == 1) g1_finish(P, nbase + 8 * (t + 1), x, xB, RB); else g2_finish(P, nbase + 8 * (t + 1), x, cB, RB);
        SB();
    }
}
template <int WHICH>
DI void sliced_phase(const Params& P, char* lds_g) {
    const int tid = tid_(), wave = __builtin_amdgcn_readfirstlane(tid >> 6);
    unsigned* ctr = (unsigned*)(P.ws + WS_CTL) + (WHICH == 1 ? CTL_G1 : CTL_G2);
    const __amdgpu_buffer_rsrc_t rs = __builtin_amdgcn_make_buffer_rsrc((void*)(P.ws + (WHICH == 1 ? WS_UB : WS_VB)), 0, NEXP * DM, 0x00020000);
    const int x0 = (int)my_xcc_id();
    LAS int* slot = (LAS int*)((LAS char*)lds_g + LDS_ITEM);
    for (int s = 0; s < 8; ++s) {
        const int x = (x0 + s) & 7;
        for (;;) {
            if (tid == 0) *slot = (int)atomicAdd(ctr + x, 1u);
            __syncthreads();
            const int chunk = *slot;
            __syncthreads();
            if (chunk >= NTOK / SL_CHUNK) break;
            g_chunk<WHICH>(P, chunk * SL_CHUNK + wave, x, rs);
        }
    }
}
DI void hid_reduce_phase(const Params& P, int bid, int nblk) {
    const unsigned char* ws = P.ws;
    const size_t gt = (size_t)bid * NTHREADS + tid_(), NGT = (size_t)nblk * NTHREADS;
    const float* hp = (const float*)(ws + WS_HIDP);
    for (size_t o = gt; o < (size_t)NTOK * 128; o += NGT) {
        float a = 0.f;
#pragma unroll
        for (int x = 0; x < 8; ++x) a += hp[(size_t)x * NTOK * 128 + o];
        const int e = ((const int*)(ws + WS_EIDX))[o];
        const float d = a * ((const float*)(ws + WS_USC))[e] * ((const float*)(ws + WS_XSC))[o >> 7];
        ((float*)(ws + WS_HID))[o] = gelu_exact(d) * ((const float*)(ws + WS_EGATE))[o] * ((const float*)(ws + WS_VSC))[e];
    }
}
DI void final_norm_phase(const Params& P, int bid, int nblk) {
    const size_t gt = (size_t)bid * NTHREADS + tid_(), NGT = (size_t)nblk * NTHREADS;
    const float* ssq = (const float*)(P.ws + WS_SSQ2);
    for (size_t o = gt; o < (size_t)NTOK * DM / 4; o += NGT) {
        const size_t n = o >> 8; const int c4 = (int)(o & 255);
        const float rs = 1.f / sqrtf(ssq[n] * (1.f / DM) + EPS);
        f32x4* pp = (f32x4*)P.out + o;
        *pp = *pp * ((const f32x4*)P.final_w)[c4] * rs;
    }
}

typedef long i64_t;
constexpr int MG_HALF = 8192, MG_WAVE = 2 * MG_HALF;
#define MG_WAIT(N) asm volatile("s_waitcnt vmcnt(" #N ")" ::: "memory")
struct MgMeta { i32x4 id[4]; u32x4 a0, a1, a2, a3; };
template <int WHICH>
DI void mg_meta(const Params& P, int n, int x, MgMeta& M) {
    const int lane = tid_() & 63, g8 = lane >> 3, kg = lane >> 4;
    const int* ip = (const int*)(P.ws + WS_EIDX) + (size_t)n * 128 + 8 * g8;
    M.id[0] = *(const i32x4*)ip; M.id[1] = *(const i32x4*)(ip + 4); M.id[2] = *(const i32x4*)(ip + 64); M.id[3] = *(const i32x4*)(ip + 68);
    if (WHICH == 1) { const unsigned char* xr = P.ws + WS_XN8 + (size_t)n * DM + 256 * x + 16 * kg;
        M.a0 = *(const u32x4*)xr; M.a1 = *(const u32x4*)(xr + 64); M.a2 = *(const u32x4*)(xr + 128); M.a3 = *(const u32x4*)(xr + 192); }
    else { const unsigned char* cr = P.ws + WS_C8 + ((size_t)x * NTOK + n) * 128 + 16 * kg;
        M.a0 = *(const u32x4*)cr; M.a1 = *(const u32x4*)(cr + 64); }
}
DI void mg_issue(const unsigned char* slice, const MgMeta& M, int h, unsigned lbase) {
    const int lane = tid_() & 63, pos = lane & 7;
    const i32x4 ia = M.id[2 * h], ib = M.id[2 * h + 1];
    const int ids[8] = {ia.x, ia.y, ia.z, ia.w, ib.x, ib.y, ib.z, ib.w};
#pragma unroll
    for (int p = 0; p < 8; ++p) glds16_asm(slice + (size_t)(unsigned)ids[p] * 128 + 16 * (pos ^ p), lbase + p * 1024);
}
DI i64_t pk64(unsigned lo, unsigned hi) { return (i64_t)(((unsigned long long)hi << 32) | lo); }
typedef int i32x8 __attribute__((ext_vector_type(8)));
DI float mg1_half(const MgMeta& M, LAS char* hb) {
    const int lane = tid_() & 63, c = lane & 15, kg = lane >> 4;
    const i32x8 A0 = (i32x8){(int)M.a0.x, (int)M.a0.y, (int)M.a0.z, (int)M.a0.w, (int)M.a1.x, (int)M.a1.y, (int)M.a1.z, (int)M.a1.w};
    const i32x8 A1 = (i32x8){(int)M.a2.x, (int)M.a2.y, (int)M.a2.z, (int)M.a2.w, (int)M.a3.x, (int)M.a3.y, (int)M.a3.z, (int)M.a3.w};
    f32x4 d[4];
#pragma unroll
    for (int G = 0; G < 4; ++G) {
        const LAS char* row = hb + (c & 7) * 1024 + (2 * G + (c >> 3)) * 128;
        const u32x4 b0 = *(const LAS u32x4*)(row + ((kg ^ (c & 7)) << 4)), b1 = *(const LAS u32x4*)(row + (((kg + 4) ^ (c & 7)) << 4));
        d[G] = (f32x4){0.f, 0.f, 0.f, 0.f};
        d[G] = __builtin_amdgcn_mfma_scale_f32_16x16x128_f8f6f4(A0, (i32x8){(int)b0.x, (int)b0.y, (int)b0.z, (int)b0.w, 0, 0, 0, 0}, d[G], 0, 4, 0, 0x7F7F7F7F, 0, 0x7F7F7F7F);
        d[G] = __builtin_amdgcn_mfma_scale_f32_16x16x128_f8f6f4(A1, (i32x8){(int)b1.x, (int)b1.y, (int)b1.z, (int)b1.w, 0, 0, 0, 0}, d[G], 0, 4, 0, 0x7F7F7F7F, 0, 0x7F7F7F7F);
    }
    asm volatile("s_nop 15\n\ts_nop 15" : "+v"(d[0]), "+v"(d[1]), "+v"(d[2]), "+v"(d[3]));
    const float r01 = (kg & 1) ? d[1][0] : d[0][0], r23 = (kg & 1) ? d[3][0] : d[2][0];
    return (kg & 2) ? r23 : r01;
}
typedef int v2i_t __attribute__((ext_vector_type(2)));
DI void mg2_half(const MgMeta& M, int h, LAS char* hb, f32x4 (&D)[8]) {
    const int lane = tid_() & 63, c = lane & 15, g = lane >> 4;
    const u32x4 ch = h ? M.a1 : M.a0;
    const LAS char* rb = hb + (c & 7) * 1024 + (4 * (g & 1) + (c >> 3)) * 128 + 8 * (g >> 1);
#pragma unroll
    for (int t = 0; t < 8; ++t) {
        const unsigned mlo = (c == 4 * (t & 3)) ? 0xFFFFFFFFu : 0u, mhi = (c == 4 * (t & 3) + 1) ? 0xFFFFFFFFu : 0u;
        const i32x8 A = (i32x8){(int)(ch.x & mlo), (int)(ch.y & mlo), (int)(ch.z & mlo), (int)(ch.w & mlo), (int)(ch.x & mhi), (int)(ch.y & mhi), (int)(ch.z & mhi), (int)(ch.w & mhi)};
        const v2i_t b0 = __builtin_amdgcn_ds_read_tr4_b64_v2i32((LAS v2i_t*)(rb + ((t ^ (c & 7)) << 4)));
        const v2i_t b1 = __builtin_amdgcn_ds_read_tr4_b64_v2i32((LAS v2i_t*)(rb + 256 + ((t ^ (c & 7)) << 4)));
        D[t] = __builtin_amdgcn_mfma_scale_f32_16x16x128_f8f6f4(A, (i32x8){b0.x, b0.y, b1.x, b1.y, 0, 0, 0, 0}, D[t], 0, 4, 0, 0x7F7F7F7F, 0, 0x7F7F7F7F);
    }
}
template <int WHICH>
DI void mg_group(const Params& P, const unsigned char* slice, int n0, int x, LAS char* wl, unsigned wl_off, const MgMeta (&M)[4], MgMeta (&Mn)[4], bool more) {
    const int lane = tid_() & 63, kg = lane >> 4, c = lane & 15;
    bf16_t* outp = (bf16_t*)(P.ws + WS_HIDP) + (size_t)x * NTOK * (WHICH == 1 ? 128 : 256);
    f32x4 D[8];
    mg_issue(slice, M[0], 0, wl_off); SB();
#define MG_STEP(h, WAITSTMT) do { \
        if ((h) + 1 < 8) { mg_issue(slice, M[((h) + 1) >> 1], ((h) + 1) & 1, wl_off + (((h) + 1) & 1) * MG_HALF); } \
        else if (more) { _Pragma("unroll") for (int q_ = 0; q_ < 4; ++q_) mg_meta<WHICH>(P, n0 + 8 * (4 + q_), x, Mn[q_]); } \
        SB(); WAITSTMT; SB(); \
        LAS char* hb_ = wl + ((h) & 1) * MG_HALF; const int n_ = n0 + 8 * ((h) >> 1); \
        if (WHICH == 1) { const float r_ = mg1_half(M[(h) >> 1], hb_); outp[(size_t)n_ * 128 + 64 * ((h) & 1) + lane] = (bf16_t)f2bf(r_); } \
        else { if (((h) & 1) == 0) { _Pragma("unroll") for (int q_ = 0; q_ < 8; ++q_) D[q_] = (f32x4){0.f, 0.f, 0.f, 0.f}; } \
            mg2_half(M[(h) >> 1], (h) & 1, hb_, D); \
            if ((h) & 1) { asm volatile("s_nop 15\n\ts_nop 15" : "+v"(D[0]), "+v"(D[1]), "+v"(D[2]), "+v"(D[3]), "+v"(D[4]), "+v"(D[5]), "+v"(D[6]), "+v"(D[7])); \
                float v0_ = 0.f, v1_ = 0.f, v2_ = 0.f, v3_ = 0.f; _Pragma("unroll") for (int q_ = 0; q_ < 4; ++q_) { if (kg == q_) { v0_ = D[q_][0]; v1_ = D[q_][1]; v2_ = D[q_ + 4][0]; v3_ = D[q_ + 4][1]; } } \
                bf16_t* o_ = outp + (size_t)n_ * 256 + 32 * kg + c; o_[0] = (bf16_t)f2bf(v0_); o_[16] = (bf16_t)f2bf(v1_); o_[128] = (bf16_t)f2bf(v2_); o_[144] = (bf16_t)f2bf(v3_); } } \
        SB(); } while (0)
    if (WHICH == 1) {
        MG_STEP(0, MG_WAIT(8)); MG_STEP(1, MG_WAIT(9)); MG_STEP(2, MG_WAIT(9)); MG_STEP(3, MG_WAIT(9)); MG_STEP(4, MG_WAIT(9)); MG_STEP(5, MG_WAIT(9)); MG_STEP(6, MG_WAIT(9));
        if (more) { MG_STEP(7, MG_WAIT(33)); } else { MG_STEP(7, MG_WAIT(1)); }
    } else {
        MG_STEP(0, MG_WAIT(8)); MG_STEP(1, MG_WAIT(8)); MG_STEP(2, MG_WAIT(12)); MG_STEP(3, MG_WAIT(8)); MG_STEP(4, MG_WAIT(12)); MG_STEP(5, MG_WAIT(8)); MG_STEP(6, MG_WAIT(12));
        if (more) { MG_STEP(7, MG_WAIT(24)); } else { MG_STEP(7, MG_WAIT(0)); }
    }
#undef MG_STEP
}
template <int WHICH>
DI void mg_phase(const Params& P, char* lds_g) {
    const int tid = tid_(), wave = __builtin_amdgcn_readfirstlane(tid >> 6);
    unsigned* ctr = (unsigned*)(P.ws + WS_CTL) + (WHICH == 1 ? CTL_G1 : CTL_G2);
    const int x0 = (int)my_xcc_id();
    LAS int* slot = (LAS int*)((LAS char*)lds_g + LDS_ITEM);
    LAS char* wl = (LAS char*)lds_g + wave * MG_WAVE;
    const unsigned wl_off = (unsigned)__builtin_amdgcn_readfirstlane((int)(unsigned)(size_t)wl);
    constexpr int NSL = 4;
    for (int s = 0; s < NSL; ++s) {
        const int x = (x0 + s) & (NSL - 1);
        const unsigned char* slice = P.ws + (WHICH == 1 ? WS_UB : WS_VB) + (size_t)x * ((size_t)NEXP * 128);
        for (;;) {
            if (tid == 0) *slot = (int)atomicAdd(ctr + x, 1u);
            __syncthreads();
            const int chunk = *slot;
            __syncthreads();
            if (chunk >= NTOK / SL_CHUNK) break;
            const int nb = chunk * SL_CHUNK + wave;
            MgMeta MA[4], MB[4];
#pragma unroll
            for (int q = 0; q < 4; ++q) mg_meta<WHICH>(P, nb + 8 * q, x, MA[q]);
            mg_group<WHICH>(P, slice, nb, x, wl, wl_off, MA, MB, true);
            mg_group<WHICH>(P, slice, nb + 32, x, wl, wl_off, MB, MA, true);
            mg_group<WHICH>(P, slice, nb + 64, x, wl, wl_off, MA, MB, true);
            mg_group<WHICH>(P, slice, nb + 96, x, wl, wl_off, MB, MA, false);
            MG_WAIT(0);
        }
    }
}
struct Red1 { int e[2]; unsigned short hp[2][4]; float g[2]; float xs; };
struct Red2 { f32x4 us[2], vs[2]; };
DI void red_load1(const unsigned char* ws, int n, int lane, Red1& R) {
    const bf16_t* hp = (const bf16_t*)(ws + WS_HIDP);
    R.xs = ((const float*)(ws + WS_XSC))[n];
#pragma unroll
    for (int q = 0; q < 2; ++q) {
        const size_t o = (size_t)n * 128 + 64 * q + lane;
        R.e[q] = ((const int*)(ws + WS_EIDX))[o];
        R.g[q] = ((const float*)(ws + WS_EGATE))[o];
#pragma unroll
        for (int x = 0; x < 4; ++x) R.hp[q][x] = (unsigned short)hp[(size_t)x * NTOK * 128 + o];
    }
}
DI void red_load2(const unsigned char* ws, const Red1& R, Red2& G) {
#pragma unroll
    for (int q = 0; q < 2; ++q) { G.us[q] = *(const f32x4*)((const float*)(ws + WS_USC) + (size_t)R.e[q] * 4); G.vs[q] = *(const f32x4*)((const float*)(ws + WS_VSC) + (size_t)R.e[q] * 4); }
}
DI void red_finish(unsigned char* ws, int n, int lane, const Red1& R, const Red2& G) {
    f32x4 cv[2]; f32x4 am = (f32x4){0.f, 0.f, 0.f, 0.f};
#pragma unroll
    for (int q = 0; q < 2; ++q) {
        float a = 0.f;
#pragma unroll
        for (int x = 0; x < 4; ++x) a += bf2f(R.hp[q][x]) * G.us[q][x];
        const float cf = gelu_exact(a * R.xs) * R.g[q];
        cv[q] = G.vs[q] * cf;
        am.x = fmaxf(am.x, fabsf(cv[q].x)); am.y = fmaxf(am.y, fabsf(cv[q].y)); am.z = fmaxf(am.z, fabsf(cv[q].z)); am.w = fmaxf(am.w, fabsf(cv[q].w));
    }
    f32x4 isc;
#pragma unroll
    for (int x = 0; x < 4; ++x) {
        float m = row16_max(am[x]); m = fmaxf(fmaxf(readlane_f(m, 0), readlane_f(m, 16)), fmaxf(readlane_f(m, 32), readlane_f(m, 48)));
        const float sc = (m > 0.f) ? exp2f(floorf(log2f(224.f / m))) : 1.f;
        const int w0 = __builtin_amdgcn_cvt_pk_fp8_f32(cv[0][x] * sc, cv[1][x] * sc, 0, false);
        unsigned char* cr = ws + WS_C8 + ((size_t)x * NTOK + n) * 128;
        cr[lane] = (unsigned char)(w0 & 255); cr[64 + lane] = (unsigned char)((w0 >> 8) & 255);
        isc[x] = 1.f / sc;
    }
    if (lane == 0) *(f32x4*)((float*)(ws + WS_CSC) + (size_t)n * 4) = isc;
}
DI void hid_reduce8_phase(const Params& P, int bid, int nblk) {
    const int tid = tid_(), lane = tid & 63, wave = __builtin_amdgcn_readfirstlane(tid >> 6);
    unsigned char* ws = P.ws;
    const int gw = bid * NWAVES + wave, NGW = nblk * NWAVES;
    Red1 r0, r1, r2; Red2 g0, g1;
    if (gw < NTOK) red_load1(ws, gw, lane, r0);
    if (gw + NGW < NTOK) red_load1(ws, gw + NGW, lane, r1);
    if (gw < NTOK) red_load2(ws, r0, g0);
    for (int n = gw; n < NTOK; n += NGW) {
        if (n + 2 * NGW < NTOK) red_load1(ws, n + 2 * NGW, lane, r2);
        if (n + NGW < NTOK) red_load2(ws, r1, g1);
        red_finish(ws, n, lane, r0, g0);
        r0 = r1; r1 = r2; g0 = g1;
    }
}
DI void final_norm8_phase(const Params& P, int bid, int nblk) {
    const int tid = tid_(), lane = tid & 63, wave = __builtin_amdgcn_readfirstlane(tid >> 6);
    const unsigned char* ws = P.ws;
    const int gw = bid * NWAVES + wave, NGW = nblk * NWAVES;
    f32x4 wv[4];
#pragma unroll
    for (int q = 0; q < 4; ++q) wv[q] = *(const f32x4*)(P.final_w + 16 * lane + 4 * q);
    for (int n = gw; n < NTOK; n += NGW) {
        float* orow = P.out + (size_t)n * DM + 16 * lane;
        const bf16_t* yrow = (const bf16_t*)(ws + WS_HIDP) + ((size_t)(lane >> 4) * NTOK + n) * 256 + 16 * (lane & 15);
        const u32x4 ya = *(const u32x4*)yrow, yb = *(const u32x4*)(yrow + 8);
        const unsigned yu[8] = {ya.x, ya.y, ya.z, ya.w, yb.x, yb.y, yb.z, yb.w};
        const float cs = ((const float*)(ws + WS_CSC))[(size_t)n * 4 + (lane >> 4)];
        const bf16_t* hrow = (const bf16_t*)(ws + WS_XB) + (size_t)n * DM + 16 * lane;
        const u32x4 ha = *(const u32x4*)hrow, hb = *(const u32x4*)(hrow + 8);
        const unsigned hu[8] = {ha.x, ha.y, ha.z, ha.w, hb.x, hb.y, hb.z, hb.w};
        f32x4 h[4]; float ss = 0.f;
#pragma unroll
        for (int q = 0; q < 4; ++q) { h[q] = (f32x4){bf2f(hu[2 * q] & 0xffffu), bf2f(hu[2 * q] >> 16), bf2f(hu[2 * q + 1] & 0xffffu), bf2f(hu[2 * q + 1] >> 16)} + (f32x4){bf2f(yu[2 * q] & 0xffffu), bf2f(yu[2 * q] >> 16), bf2f(yu[2 * q + 1] & 0xffffu), bf2f(yu[2 * q + 1] >> 16)} * cs; ss += (h[q].x * h[q].x + h[q].y * h[q].y) + (h[q].z * h[q].z + h[q].w * h[q].w); }
        ss = wave_sum_dpp(ss);
        const float rs = 1.f / sqrtf(ss * (1.f / DM) + EPS);
#pragma unroll
        for (int q = 0; q < 4; ++q) *(f32x4*)(orow + 4 * q) = h[q] * wv[q] * rs;
    }
}

#define XB_TMO      128
#define XB_XCNT(j)  (256  + 64 * (j))
#define XB_XSUB(j)  (1280 + 64 * (j))
#define XB_XGEN(j)  (2304 + 64 * (j))
#define XB_TOP      3328
#define XB_TOPGEN   3392
#define XCD_BAR_WORDS 3456
#define XB_SPIN_CAP (1u << 18)

__device__ __forceinline__ unsigned xb_ld(unsigned* p)              { return __hip_atomic_load(p, __ATOMIC_RELAXED, __HIP_MEMORY_SCOPE_AGENT); }
__device__ __forceinline__ unsigned xb_add(unsigned* p, unsigned v) { return __hip_atomic_fetch_add(p, v, __ATOMIC_RELAXED, __HIP_MEMORY_SCOPE_AGENT); }
__device__ __forceinline__ unsigned xb_xcc_id() { return (unsigned)__builtin_amdgcn_s_getreg((3 << 11) | 20) & 0xFu; }
#define XB_SPIN(cond, bar) do { unsigned _sp = 0; while (cond) { __builtin_amdgcn_s_sleep(1); \
    if ((++_sp & 255u) == 0u) { if (xb_ld(&(bar)[XB_TMO])) break; if (_sp > XB_SPIN_CAP) { atomicAdd(&(bar)[XB_TMO], 1u); break; } } } } while (0)

struct XcdBarrier {
    unsigned* bar; unsigned x;
    volatile LAS unsigned* st;
};

__device__ __forceinline__ XcdBarrier xcd_barrier_post(unsigned* bar, volatile LAS unsigned* st) {
    XcdBarrier b; b.bar = bar; b.x = xb_xcc_id(); b.st = st;
    if (threadIdx.x == 0) (void)xb_add(&bar[XB_XCNT(b.x)], 1u);
    return b;
}
__device__ __forceinline__ void xcd_barrier_complete(unsigned* bar, unsigned x, unsigned& nloc, unsigned& nx) {
    const unsigned G = gridDim.x * gridDim.y * gridDim.z;
    unsigned sum, cnt, mine, sp = 0u;
    for (;;) {
        sum = 0u; cnt = 0u; mine = 0u;
#pragma unroll
        for (unsigned j = 0; j < 16; ++j) { const unsigned c = xb_ld(&bar[XB_XCNT(j)]); sum += c; cnt += (c > 0u) ? 1u : 0u; mine = (j == x) ? c : mine; }
        if (sum == G) break;
        __builtin_amdgcn_s_sleep(1);
        if ((++sp & 255u) == 0u) { if (xb_ld(&bar[XB_TMO])) break; if (sp > XB_SPIN_CAP) { atomicAdd(&bar[XB_TMO], 1u); break; } }
    }
    nloc = mine > 0u ? mine : 1u; nx = cnt > 0u ? cnt : 1u;
}

__device__ __forceinline__ void xcd_barrier(const XcdBarrier& b) {
    asm volatile("s_waitcnt vmcnt(0)" ::: "memory");
    __syncthreads();
    if (threadIdx.x == 0) {
        unsigned* bar = b.bar;
        __builtin_amdgcn_s_waitcnt(0);
        unsigned nloc = b.st[0], nx = b.st[1];
        if (nloc == 0u) { xcd_barrier_complete(bar, b.x, nloc, nx); b.st[0] = nloc; b.st[1] = nx; }
        const unsigned old = xb_add(&bar[XB_XSUB(b.x)], 1u);
        const unsigned gen = old / nloc;
        if (old + 1u == (gen + 1u) * nloc) {
            __builtin_amdgcn_fence(__ATOMIC_RELEASE, "agent");
            asm volatile("s_waitcnt vmcnt(0)" ::: "memory");
            const unsigned og = xb_add(&bar[XB_TOP], 1u);
            const unsigned tg = og / nx;
            if (og + 1u == (tg + 1u) * nx) xb_add(&bar[XB_TOPGEN], 1u);
            else XB_SPIN(xb_ld(&bar[XB_TOPGEN]) == tg, bar);
            __builtin_amdgcn_fence(__ATOMIC_ACQUIRE, "agent");
            xb_add(&bar[XB_XGEN(b.x)], 1u);
            asm volatile("s_waitcnt vmcnt(0)" ::: "memory");
        } else {
            XB_SPIN(xb_ld(&bar[XB_XGEN(b.x)]) == gen, bar);
            __builtin_amdgcn_fence(__ATOMIC_ACQUIRE, "agent");
            asm volatile("s_waitcnt vmcnt(0)" ::: "memory");
        }
    }
    __syncthreads();
}

constexpr int CTL_XB_WORD = 2048;
static_assert((CTL_XB_WORD + 3456) * 4 <= (int)CTL_BYTES, "barrier words inside CTL");
constexpr int N_HGRN_ITEMS = BATCH * 4, N_ATT_ITEMS = BATCH * 4 * 32;

DI void mixer_phase(const Params& P, char* lds) {
    unsigned* ctr = (unsigned*)(P.ws + WS_CTL);
    for (;;) {
        if (tid_() == 0) *(LAS int*)((LAS char*)lds + LDS_ITEM) = (int)atomicAdd(ctr, 1u);
        __syncthreads();
        const int item = *(LAS int*)((LAS char*)lds + LDS_ITEM);
        __syncthreads();
        if (item >= N_HGRN_ITEMS + N_ATT_ITEMS) break;
        if (item < N_HGRN_ITEMS) hgrn_unit(P, item >> 2, item & 3, lds);
        else { const int a = item - N_HGRN_ITEMS, j = 31 - (a >> 5), bh = a & 31; attn_unit(P, bh >> 2, bh & 3, j, lds); }
    }
}

#ifdef TS_PHASE
#ifndef TS_DIV
#define TS_DIV 4.0f
#endif
#ifndef TS_OFF
#define TS_OFF 0.0f
#endif
#define TS(i) do { if (blockIdx.x == 0 && threadIdx.x == 0) ((LAS unsigned long long*)((LAS char*)lds + LDS_BYTES - 512))[i] = __builtin_amdgcn_s_memrealtime(); } while (0)
#else
#define TS(i) do { } while (0)
#endif
__global__ void __launch_bounds__(NTHREADS, 2) fwd_megakernel(Params P) {
    extern __shared__ __attribute__((aligned(16))) char lds[];
    cg::grid_group grid = cg::this_grid();
    const int bid = blockIdx.x, nblk = gridDim.x;
    unsigned char* ws = P.ws;
    volatile LAS unsigned* xst = (volatile LAS unsigned*)((LAS char*)lds + LDS_XB);
    if (threadIdx.x < 4) xst[threadIdx.x] = 0u;
    __syncthreads();
    const XcdBarrier xbar = xcd_barrier_post((unsigned*)(ws + WS_CTL) + CTL_XB_WORD, xst);
    TS(0);
    phase0(P, lds, bid, nblk);
    xcd_barrier(xbar);
    TS(1);
    { Epi1 e{ws}; gemm_run(lds, (const bf16_t*)(ws + WS_XB), (const bf16_t*)(ws + WS_W1T), M1, NCOL1, DM, e, bid, nblk); }
    {
        constexpr int NUNITS = (M1 / 256) * (NCOL1 / 256);
        const int nlast = NUNITS % nblk, nfree = nlast ? nblk - nlast : nblk;
        const int wave = __builtin_amdgcn_readfirstlane(tid_() >> 6);
        if (nlast == 0 || bid >= nlast) table_fp8_rows(P, NEXP + (bid - (nlast ? nlast : 0)) * NWAVES + wave, nfree * NWAVES, 2 * NEXP);
    }
    xcd_barrier(xbar);
    TS(2);
    for (int it = bid; it < 32 * 129; it += nblk) hgrn_prep_item(P, it & 31, it >> 5, lds);
    xcd_barrier(xbar);
    TS(3);
    mixer_phase(P, lds);
    xcd_barrier(xbar);
    TS(4);
    { Epi3 e{P.x, P.out, (bf16_t*)(ws + WS_XB), (float*)(ws + WS_SSQ)}; gemm_run(lds, (const bf16_t*)(ws + WS_MIX), (const bf16_t*)(ws + WS_W2T), NTOK, DM, DM, e, bid, nblk); }
    xcd_barrier(xbar);
    TS(5);
    { Epi4 e{(const float*)(ws + WS_SSQ), (bf16_t*)(ws + WS_PQ)}; gemm_run(lds, (const bf16_t*)(ws + WS_XB), (const bf16_t*)(ws + WS_W3T), NTOK, 2048, DM, e, bid, nblk); }
    xcd_barrier(xbar);
    TS(6);
    topk_phase(P, lds, bid, nblk);
    xcd_barrier(xbar);
    TS(7);
    mg_phase<1>(P, lds);
    xcd_barrier(xbar);
    TS(8);
    hid_reduce8_phase(P, bid, nblk);
    xcd_barrier(xbar);
    TS(9);
    mg_phase<2>(P, lds);
    xcd_barrier(xbar);
    TS(10);
    final_norm8_phase(P, bid, nblk);
    TS(11);
#ifdef TS_PHASE
    if (blockIdx.x == 0 && threadIdx.x == 0) { const LAS unsigned long long* t = (const LAS unsigned long long*)((LAS char*)lds + LDS_BYTES - 512);
        P.out[0] += ((float)(t[TS_PHASE + 1] - t[TS_PHASE]) * 0.01f - TS_OFF) / TS_DIV; }
#endif
}

extern "C" void kernel_launch(void* const* d_in, const int* in_sizes, int n_in, void* d_out, int out_size, void* d_ws, size_t ws_size, hipStream_t stream) {
    static int grid = 0;
    if (grid == 0) {
        int dev = 0, cus = 0, per_cu = 0;
        (void)hipGetDevice(&dev);
        (void)hipDeviceGetAttribute(&cus, hipDeviceAttributeMultiprocessorCount, dev);
        (void)hipFuncSetAttribute((const void*)fwd_megakernel, hipFuncAttributeMaxDynamicSharedMemorySize, LDS_BYTES);
        (void)hipOccupancyMaxActiveBlocksPerMultiprocessor(&per_cu, (const void*)fwd_megakernel, NTHREADS, LDS_BYTES);
        if (per_cu < 1) { fprintf(stderr, "kernel_launch: occupancy query says %d blocks per CU\n", per_cu); per_cu = 1; }
        grid = cus * 1;
        if (ws_size < WS_END) { fprintf(stderr, "kernel_launch: workspace too small: %zu < %zu\n", ws_size, (size_t)WS_END); grid = -1; }
    }
    if (grid < 0) return;
    Params p{};
    p.x = (const float*)d_in[0]; p.meta = (const float*)d_in[1]; p.mix_norm_w = (const float*)d_in[2]; p.w_in = (const float*)d_in[3];
    p.lb_logits = (const float*)d_in[4]; p.rec_norm_w = (const float*)d_in[5]; p.lq1 = (const float*)d_in[6]; p.lk1 = (const float*)d_in[7];
    p.lq2 = (const float*)d_in[8]; p.lk2 = (const float*)d_in[9]; p.subln_w = (const float*)d_in[10]; p.w_out = (const float*)d_in[11];
    p.ffn_norm_w = (const float*)d_in[12]; p.wq = (const float*)d_in[13]; p.subkeys = (const float*)d_in[14]; p.pu = (const float*)d_in[15];
    p.pv = (const float*)d_in[16]; p.final_w = (const float*)d_in[17];
    p.out = (float*)d_out; p.ws = (unsigned char*)d_ws;
    (void)hipMemsetAsync((char*)d_ws + WS_CTL, 0, CTL_BYTES, stream);
    void* args[] = {&p};
    hipError_t e = hipLaunchCooperativeKernel((const void*)fwd_megakernel, dim3(grid), dim3(NTHREADS), args, LDS_BYTES, stream);
    if (e != hipSuccess) fprintf(stderr, "cooperative launch failed: %s (grid %d)\n", hipGetErrorString(e), grid);
}
```

```cpp
#include <hip/hip_runtime.h>
#include <hip/hip_cooperative_groups.h>
#include <cstdio>
#include <cstdint>
namespace cg = cooperative_groups;

constexpr int BATCH = 8, SEQ = 4096, DM = 1024, NMETA = 16;
constexpr int NTOK = BATCH * SEQ;
constexpr int M1 = NTOK + 256;
constexpr int NCOL1 = 3584;
constexpr int TPOS = NMETA + SEQ;
constexpr int KT = 65;
constexpr int KPAD = 48;
constexpr int HT = 4128;
constexpr int NEXP = 16384;
constexpr float EPS = 1e-6f;
constexpr float LAM_INIT = 0.2f;
constexpr float QSCALE = 0.125f * 1.4426950408889634f;
constexpr int NTHREADS = 512, NWAVES = 8;
constexpr int LDS_BYTES = 163840;
constexpr int LDS_ITEM = LDS_BYTES - 64, LDS_XB = LDS_BYTES - 32;

typedef unsigned short bf16_t;
typedef short bf16x8 __attribute__((ext_vector_type(8)));
typedef float f32x4 __attribute__((ext_vector_type(4)));
typedef float f32x16 __attribute__((ext_vector_type(16)));
typedef float f32x2 __attribute__((ext_vector_type(2)));
typedef unsigned u32x4 __attribute__((ext_vector_type(4)));
typedef unsigned u32x2 __attribute__((ext_vector_type(2)));
typedef __bf16 bf16x2_t __attribute__((ext_vector_type(2)));
typedef short s16x4 __attribute__((ext_vector_type(4)));
#define LAS __attribute__((address_space(3)))
#define DI __device__ __forceinline__
__device__ __forceinline__ int tid_() { int t = threadIdx.x; asm volatile("" : "+v"(t)); return t; }

constexpr size_t al256(size_t x) { return (x + 255) & ~(size_t)255; }
constexpr size_t WS_CTL = 0, CTL_BYTES = 65536;
constexpr size_t WS_W1T = WS_CTL + CTL_BYTES;
constexpr size_t WS_W2T = WS_W1T + (size_t)NCOL1 * DM * 2;
constexpr size_t WS_W3T = WS_W2T + (size_t)DM * DM * 2;
constexpr size_t WS_SKB = WS_W3T + (size_t)2048 * DM * 2;
constexpr size_t WS_UB = WS_SKB + (size_t)16 * 128 * 128 * 2;
constexpr size_t WS_VB = WS_UB + (size_t)NEXP * DM * 2;
constexpr size_t WS_USC = WS_UB + (size_t)NEXP * DM, WS_VSC = WS_VB + (size_t)NEXP * DM;
constexpr size_t WS_ROPE = WS_VB + (size_t)NEXP * DM * 2;
constexpr size_t WS_LB = WS_ROPE + (size_t)TPOS * 64 * 4;
constexpr size_t WS_R1 = WS_LB + 4096;
constexpr size_t WS_SSQ = WS_R1 + al256((size_t)M1 * 4);
constexpr size_t WS_SSQ2 = WS_SSQ + (size_t)NTOK * 4;
constexpr size_t WS_XB = WS_SSQ2 + (size_t)NTOK * 4;
constexpr size_t WS_C = WS_XB + (size_t)M1 * DM * 2;
constexpr size_t WS_Q = WS_C;
constexpr size_t WS_K = WS_Q + (size_t)NTOK * 512 * 2;
constexpr size_t WS_V = WS_K + (size_t)BATCH * 4 * 2 * KT * 8192;
constexpr size_t WS_HQ = WS_V + (size_t)BATCH * 4 * KT * 16384;
constexpr size_t WS_HV = WS_HQ + (size_t)BATCH * 4 * HT * 128 * 2;
constexpr size_t WS_HG = WS_HV + (size_t)BATCH * 4 * HT * 128 * 2;
constexpr size_t WS_SG = WS_HG + (size_t)BATCH * 4 * HT * 128 * 4;
constexpr size_t WS_CEND = WS_SG + (size_t)NTOK * 512 * 2;
constexpr size_t WS_PQ = WS_C;
constexpr size_t WS_EIDX = WS_PQ + (size_t)NTOK * 2048 * 2;
constexpr size_t WS_EGATE = WS_EIDX + (size_t)NTOK * 128 * 4;
constexpr size_t WS_HID = WS_EGATE + (size_t)NTOK * 128 * 4;
constexpr size_t WS_XN8 = WS_HID + (size_t)NTOK * 128 * 4;
constexpr size_t WS_XSC = WS_XN8 + (size_t)NTOK * DM;
constexpr size_t WS_C8 = WS_XSC + (size_t)NTOK * 4;
constexpr size_t WS_CSC = WS_C8 + (size_t)NTOK * 128 * 4;
static_assert(WS_CSC + (size_t)NTOK * 16 <= WS_CEND, "overlay fits");
constexpr size_t WS_HIDP = WS_PQ;
constexpr size_t WS_MIX = WS_CEND;
constexpr size_t WS_HQA = WS_MIX + (size_t)NTOK * DM * 2;
constexpr size_t WS_HD = WS_HQA + (size_t)BATCH * 4 * HT * 128 * 2;
constexpr size_t WS_END = WS_HD + (size_t)BATCH * 4 * 129 * 128 * 4;
static_assert(WS_END <= (size_t)512 * 1024 * 1024, "workspace map must fit 512 MiB");

struct Params {
    const float* x; const float* meta; const float* mix_norm_w; const float* w_in; const float* lb_logits; const float* rec_norm_w;
    const float* lq1; const float* lk1; const float* lq2; const float* lk2; const float* subln_w; const float* w_out; const float* ffn_norm_w;
    const float* wq; const float* subkeys; const float* pu; const float* pv; const float* final_w;
    float* out; unsigned char* ws;
};

DI unsigned f2bf(float f) { unsigned u = __builtin_bit_cast(unsigned, f); return (u + 0x7fffu + ((u >> 16) & 1u)) >> 16; }
DI float bf2f(unsigned b) { return __builtin_bit_cast(float, b << 16); }
DI unsigned cvtpk(float lo, float hi) { f32x2 v = {lo, hi}; bf16x2_t b = __builtin_convertvector(v, bf16x2_t); return __builtin_bit_cast(unsigned, b); }
DI float wave_sum(float v) {
#pragma unroll
    for (int o = 1; o < 64; o <<= 1) v += __shfl_xor(v, o);
    return v;
}
DI float readlane_f(float v, int l) { return __builtin_bit_cast(float, __builtin_amdgcn_readlane(__builtin_bit_cast(int, v), l)); }
DI float sigmoidf_(float x) { return __builtin_amdgcn_rcpf(1.f + __expf(-x)); }
DI float siluf_(float x) { return x * sigmoidf_(x); }

DI int sigma_col(int c) {
    if (c >= 1024) return c;
    const int cc = c & 63, a = cc >> 5, fq = (cc >> 3) & 3, n = (cc >> 2) & 1, j = cc & 3;
    return (c & ~63) + 4 * (4 * a + fq) + 32 * n + j;
}
template <bool PERMUTE>
DI void p0_transpose_item(const float* W, int K, int N, const float* scale, bf16_t* WT, LAS float* scr, int item, int lane) {
    const int nblk = N / 32, kb = item / nblk, nb = item % nblk, k0 = 64 * kb, n0 = 32 * nb;
    const int ncol = PERMUTE ? sigma_col(n0 + (lane & 31)) : n0 + (lane & 31);
    float wv_[32];
#pragma unroll
    for (int i = 0; i < 32; ++i) wv_[i] = W[(size_t)(k0 + 2 * i + (lane >> 5)) * N + ncol];
    const float sc_ = scale ? scale[k0 + lane] : 1.f;
#pragma unroll
    for (int i = 0; i < 32; ++i) { const int kk = 2 * i + (lane >> 5); const float s = (lane >> 5) ? readlane_f(sc_, 2 * i + 1) : readlane_f(sc_, 2 * i); scr[kk * 33 + (lane & 31)] = wv_[i] * s; }
    asm volatile("s_waitcnt lgkmcnt(0)" ::: "memory");
    const int c = lane & 7;
#pragma unroll
    for (int j = 0; j < 4; ++j) { const int n = (lane >> 3) + 8 * j; const LAS float* s = scr + (8 * c) * 33 + n;
        u32x4 o; o.x = cvtpk(s[0 * 33], s[1 * 33]); o.y = cvtpk(s[2 * 33], s[3 * 33]); o.z = cvtpk(s[4 * 33], s[5 * 33]); o.w = cvtpk(s[6 * 33], s[7 * 33]);
        *(u32x4*)(WT + (size_t)(n0 + n) * K + k0 + 8 * c) = o; }
    asm volatile("s_waitcnt lgkmcnt(0)" ::: "memory");
}

template <int CTRL> DI float dpp_f(float v) { return __builtin_bit_cast(float, __builtin_amdgcn_update_dpp(0, __builtin_bit_cast(int, v), CTRL, 0xf, 0xf, false)); }
DI float row16_max(float v) { v = fmaxf(v, dpp_f<0x128>(v)); v = fmaxf(v, dpp_f<0x124>(v)); v = fmaxf(v, dpp_f<0x122>(v)); v = fmaxf(v, dpp_f<0x121>(v)); return v; }
DI float row16_sum(float v) { v += dpp_f<0x128>(v); v += dpp_f<0x124>(v); v += dpp_f<0x122>(v); v += dpp_f<0x121>(v); return v; }
constexpr int TAB_P0_ROWS = 6144;
DI void table_row_load(const Params& P, int r, int lane, f32x4 (&v)[4]) {
    const bool isv = r >= NEXP; const int e = isv ? r - NEXP : r;
    const f32x4* src = (const f32x4*)((isv ? P.pv : P.pu) + (size_t)e * DM) + lane;
#pragma unroll
    for (int q = 0; q < 4; ++q) v[q] = src[64 * q];
}
DI void table_row_finish(const Params& P, int r, int lane, const f32x4 (&v)[4]) {
    unsigned char* ws = P.ws;
    const bool isv = r >= NEXP; const int e = isv ? r - NEXP : r;
    unsigned char* tb = ws + (isv ? WS_VB : WS_UB);
    float am = 0.f;
#pragma unroll
    for (int q = 0; q < 4; ++q) am = fmaxf(am, fmaxf(fmaxf(fabsf(v[q].x), fabsf(v[q].y)), fmaxf(fabsf(v[q].z), fabsf(v[q].w))));
    am = row16_max(am); am = fmaxf(fmaxf(readlane_f(am, 0), readlane_f(am, 16)), fmaxf(readlane_f(am, 32), readlane_f(am, 48)));
    const float sc = (am > 0.f) ? 6.f * __builtin_amdgcn_rcpf(am) : 1.f;
#pragma unroll
    for (int q = 0; q < 4; ++q) {
        unsigned w = __builtin_amdgcn_cvt_scalef32_pk_fp4_f32(0u, v[q].x * sc, v[q].y * sc, 1.0f, 0); w = __builtin_amdgcn_cvt_scalef32_pk_fp4_f32(w, v[q].z * sc, v[q].w * sc, 1.0f, 1);
        *(unsigned short*)(tb + ((size_t)q * NEXP + e) * 128 + 2 * lane) = (unsigned short)w;
    }
    if (lane == 0) ((float*)(ws + WS_USC))[(size_t)e * 2 + (isv ? 1 : 0)] = (am > 0.f) ? am * (1.f / 6.f) : 1.f;
}
DI void table_fp8_rows(const Params& P, int first, int stride, int r_end) {
    const int lane = tid_() & 63;
    f32x4 a[4], b[4];
    int r = first;
    if (r < r_end) table_row_load(P, r, lane, a);
    while (r < r_end) {
        if (r + stride < r_end) table_row_load(P, r + stride, lane, b);
        table_row_finish(P, r, lane, a);
        r += stride; if (r >= r_end) break;
        if (r + stride < r_end) table_row_load(P, r + stride, lane, a);
        table_row_finish(P, r, lane, b);
        r += stride;
    }
}

__device__ const double ROPE_INV[32] = {
    1.0, 0.7498942093324559, 0.5623413251903491, 0.4216965034285822, 0.31622776601683794, 0.23713737056616552, 0.1778279410038923, 0.1333521432163324,
    0.1, 0.07498942093324558, 0.05623413251903491, 0.042169650342858224, 0.03162277660168379, 0.023713737056616554, 0.01778279410038923, 0.01333521432163324,
    0.01, 0.007498942093324558, 0.005623413251903491, 0.004216965034285823, 0.0031622776601683794, 0.0023713737056616554, 0.0017782794100389228, 0.001333521432163324,
    0.001, 0.0007498942093324559, 0.0005623413251903491, 0.00042169650342858224, 0.00031622776601683794, 0.00023713737056616554, 0.00017782794100389227, 0.0001333521432163324};
DI void p0_row_load(const Params& P, int m, int lane, f32x4 (&v)[4]) {
    if (m >= NTOK + NMETA) {
#pragma unroll
        for (int j = 0; j < 4; ++j) v[j] = (f32x4){0.f, 0.f, 0.f, 0.f};
        return; }
    const float* xrow = (m < NTOK) ? P.x + (size_t)m * DM : P.meta + (size_t)(m - NTOK) * DM;
    const f32x4* xr = (const f32x4*)xrow + lane;
#pragma unroll
    for (int j = 0; j < 4; ++j) v[j] = xr[64 * j];
}
DI void p0_row_finish(unsigned char* ws, int m, int lane, const f32x4 (&v)[4]) {
    unsigned long long* o8 = (unsigned long long*)((bf16_t*)(ws + WS_XB) + (size_t)m * DM) + lane;
    float s = 0.f;
#pragma unroll
    for (int j = 0; j < 4; ++j) s += (v[j].x * v[j].x + v[j].y * v[j].y) + (v[j].z * v[j].z + v[j].w * v[j].w);
    s = wave_sum(s);
    if (lane == 0) ((float*)(ws + WS_R1))[m] = (m >= NTOK + NMETA) ? 0.f : __builtin_amdgcn_rsqf(s * (1.f / DM) + EPS);
#pragma unroll
    for (int j = 0; j < 4; ++j) o8[64 * j] = (unsigned long long)cvtpk(v[j].x, v[j].y) | ((unsigned long long)cvtpk(v[j].z, v[j].w) << 32);
}
DI void phase0(const Params& P, char* lds, int bid, int nblk) {
    const int tid = tid_(), lane = tid & 63, wave = __builtin_amdgcn_readfirstlane(tid >> 6);
    unsigned char* ws = P.ws;
    LAS float* scr = (LAS float*)(lds) + wave * (64 * 33);
    const int gw = bid * NWAVES + wave, NGW = nblk * NWAVES;
    constexpr int I1 = (DM / 64) * (NCOL1 / 32), I2 = (DM / 64) * (DM / 32), I3 = (DM / 64) * (2048 / 32);
    for (int it = gw; it < I1 + I2 + I3; it += NGW) {
        int r = it;
        if (r < I1) { p0_transpose_item<true>(P.w_in, DM, NCOL1, P.mix_norm_w, (bf16_t*)(ws + WS_W1T), scr, r, lane); continue; } r -= I1;
        if (r < I2) { p0_transpose_item<false>(P.w_out, DM, DM, nullptr, (bf16_t*)(ws + WS_W2T), scr, r, lane); continue; } r -= I2;
        p0_transpose_item<false>(P.wq, DM, 2048, P.ffn_norm_w, (bf16_t*)(ws + WS_W3T), scr, r, lane);
    }
    {
        f32x4 va[4], vb[4];
        int m = gw;
        if (m < M1) p0_row_load(P, m, lane, va);
        while (m < M1) {
            if (m + NGW < M1) p0_row_load(P, m + NGW, lane, vb);
            p0_row_finish(ws, m, lane, va);
            m += NGW; if (m >= M1) break;
            if (m + NGW < M1) p0_row_load(P, m + NGW, lane, va);
            p0_row_finish(ws, m, lane, vb);
            m += NGW;
        }
    }
    table_fp8_rows(P, gw, NGW, TAB_P0_ROWS);
    {
        const size_t gt = (size_t)bid * NTHREADS + tid, NGT = (size_t)nblk * NTHREADS;
        const size_t ns = (size_t)16 * 128 * 128 / 8;
        for (size_t e = gt; e < ns; e += NGT) {
            const f32x4 a = ((const f32x4*)P.subkeys)[2 * e], b = ((const f32x4*)P.subkeys)[2 * e + 1];
            u32x4 o; o.x = cvtpk(a.x, a.y); o.y = cvtpk(a.z, a.w); o.z = cvtpk(b.x, b.y); o.w = cvtpk(b.z, b.w);
            ((u32x4*)(ws + WS_SKB))[e] = o;
        }
        float* rope = (float*)(ws + WS_ROPE);
        for (size_t i = gt; i < (size_t)TPOS * 32; i += NGT) {
            const int t = (int)(i >> 5), f = (int)(i & 31);
            const double rev = (double)t * ROPE_INV[f] * 0.15915494309189535;
            const float ang = (float)((rev - __builtin_rint(rev)) * 6.283185307179586);
            float* rp = rope + ((size_t)(f >> 4) * TPOS + t) * 32 + (f & 15);
            rp[0] = cosf(ang); rp[16] = sinf(ang);
        }
        float* ssq = (float*)(ws + WS_SSQ);
        for (size_t i = gt; i < (size_t)2 * NTOK; i += NGT) ssq[i] = 0.f;
        for (size_t i = gt; i < (size_t)BATCH * 4 * 2 * 512; i += NGT) { const size_t img = i >> 9, o = i & 511; ((u32x4*)(ws + WS_K + img * KT * 8192))[o] = (u32x4){0u, 0u, 0u, 0u}; }
        for (size_t i = gt; i < (size_t)BATCH * 4 * 1024; i += NGT) { const size_t img = i >> 10, o = i & 1023; ((u32x4*)(ws + WS_V + img * KT * 16384))[o] = (u32x4){0u, 0u, 0u, 0u}; }
        for (size_t i = gt; i < (size_t)BATCH * 4 * 16 * 16; i += NGT) { const size_t bh = i >> 8, o = i & 255;
            ((u32x4*)(ws + WS_HQ + bh * HT * 256))[o] = (u32x4){0u, 0u, 0u, 0u}; ((u32x4*)(ws + WS_HV + bh * HT * 256))[o] = (u32x4){0u, 0u, 0u, 0u}; }
        for (size_t i = gt; i < (size_t)BATCH * 4 * 16 * 32; i += NGT) { const size_t bh = i >> 9, o = i & 511; ((u32x4*)(ws + WS_HG + bh * HT * 512))[o] = (u32x4){0u, 0u, 0u, 0u}; }
        float* lb = (float*)(ws + WS_LB);
        if (gt < 512) lb[gt] = sigmoidf_(P.lb_logits[gt] - P.lb_logits[512 + gt]);
        if (bid == 0 && wave == 0) {
            const float a = wave_sum(P.lq1[lane] * P.lk1[lane]), b = wave_sum(P.lq2[lane] * P.lk2[lane]);
            if (lane == 0) lb[512] = __expf(a) - __expf(b) + LAM_INIT;
        }
    }
}

namespace pg8 {
#define PG8_LAS __attribute__((address_space(3)))
typedef unsigned short bf16_t;
typedef short bf16x8 __attribute__((ext_vector_type(8)));
typedef float f32x4 __attribute__((ext_vector_type(4)));
typedef unsigned u32x4 __attribute__((ext_vector_type(4)));
constexpr int BM = 256, BK = 64, HALF = 128, HTB = HALF * BK * 2  , STAGE_BYTES = 8 * HTB, NXCD = 8, WGM = 8;

__host__ __device__ __forceinline__ int lds_byte(int r, int c) { const int st = (r >> 4) * 2 + (c >> 5), rr = r & 15, cc = c & 31, ob = rr * 64 + cc * 2; return st * 1024 + (ob ^ (((ob >> 9) & 1) << 5)); }
__host__ __device__ __forceinline__ void stage_rc(int b, int& R, int& C) { const int st = b / 1024, sb = b % 1024, swz = sb ^ (((sb >> 9) & 1) << 5); R = (st >> 1) * 16 + swz / 64; C = (st & 1) * 32 + (swz % 64) / 2; }
__host__ __device__ __forceinline__ int perm32(int rho) { const int n = rho >> 4, i = rho & 15; return 8 * (i >> 2) + 4 * n + (i & 3); }

struct Unit { int pm, pn; };
struct Gemm { const bf16_t* A; const bf16_t* Bt; int M, N, K; };

struct StaticOrder {
    int nM, nN, nwg, G, c;
    __host__ __device__ void init(int M, int N, int G_, int c_) { nM = M / BM; nN = N / BM; nwg = nM * nN; G = G_; c = c_; }
    __host__ __device__ bool next(int i, Unit& u) const {
        const long L = (long)i * G + c; if (L >= nwg) return false;
        int wgid = (int)L; { const int q = nwg / NXCD, r = nwg % NXCD, xcd = wgid % NXCD, off = wgid / NXCD; wgid = (xcd < r ? xcd * (q + 1) : r * (q + 1) + (xcd - r) * q) + off; }
        const int nig = WGM * nN, gid = wgid / nig, fm = gid * WGM, gsz = (nM - fm) < WGM ? (nM - fm) : WGM;
        u.pm = fm + ((wgid % nig) % gsz); u.pn = (wgid % nig) / gsz; return true;
    }
    __device__ __forceinline__ void a_ready(const Unit&) const {}
    __device__ __forceinline__ void done(const Unit&) const {}
};

template <class Epi, class Sched, bool ALIGN_EPI = false, bool SP2 = false>
__device__ __forceinline__ void gemm_phase(PG8_LAS unsigned char* lds, const Gemm g, const Sched& S, const Epi& E) {
    const int tid = tid_(), wid = __builtin_amdgcn_readfirstlane(tid >> 6), lane = tid & 63, wr = wid >> 2, wc = wid & 3, fr = lane & 15, fq = lane >> 4;
    const int K = g.K, nt = K / BK;
    unsigned voffA[2], voffB[2];
#pragma unroll
    for (int i = 0; i < 2; ++i) { int R, C; stage_rc(tid * 16 + i * 8192, R, C); const int Rb = Epi::PERM ? ((R & ~31) + perm32(R & 31)) : R;
        voffA[i] = (unsigned)(R * K + C) * 2u; voffB[i] = (unsigned)(Rb * K + C) * 2u; }
    const size_t kstep = (size_t)(BK * 2);
    const size_t hstep = (size_t)HALF * K * 2;
    const size_t tstep = 2 * hstep;
    const unsigned ldsw = (unsigned)wid * 1024u;
    const int aoff = lds_byte(wr * 64 + fr, fq * 8), boff = lds_byte(wc * 32 + fr, fq * 8);
#define PG8_SA(b, h) (((b) * 2 + (h)) * HTB)
#define PG8_SB(b, h) ((4 + (b) * 2 + (h)) * HTB)
#define PG8_STAGE(bufoff, gbase, voff) do { _Pragma("unroll") for (int _i = 0; _i < 2; ++_i) \
        __builtin_amdgcn_global_load_lds((const unsigned*)((const char*)(gbase) + (voff)[_i]), (PG8_LAS unsigned*)(lds + (bufoff) + ldsw + _i * 8192), 16, 0, 0); } while (0)
#define PG8_LDA(dst, b, h) do { _Pragma("unroll") for (int m = 0; m < 4; ++m) _Pragma("unroll") for (int k = 0; k < 2; ++k) dst[m][k] = *(const PG8_LAS bf16x8*)(lds + PG8_SA(b, h) + aoff + m * 2048 + k * 1024); } while (0)
#define PG8_LDB(dst, b, h) do { _Pragma("unroll") for (int n = 0; n < 2; ++n) _Pragma("unroll") for (int k = 0; k < 2; ++k) dst[n][k] = *(const PG8_LAS bf16x8*)(lds + PG8_SB(b, h) + boff + n * 2048 + k * 1024); } while (0)
#define PG8_MMA(ai, bj, At, Bt) do { __builtin_amdgcn_s_setprio(1); _Pragma("unroll") for (int m = 0; m < 4; ++m) _Pragma("unroll") for (int n = 0; n < 2; ++n) _Pragma("unroll") for (int k = 0; k < 2; ++k) \
        acc[ai][bj][m][n] = __builtin_amdgcn_mfma_f32_16x16x32_bf16(Bt[n][k], At[m][k], acc[ai][bj][m][n], 0, 0, 0); __builtin_amdgcn_s_setprio(0); } while (0)
#define PG8_WAIT_V(n) asm volatile("s_waitcnt vmcnt(" #n ")" ::: "memory")
#define PG8_WAIT_L(n) asm volatile("s_waitcnt lgkmcnt(" #n ")" ::: "memory")
#define PG8_BAR __builtin_amdgcn_s_barrier()
#define PG8_SCHED __builtin_amdgcn_sched_barrier(0)
    Unit cur, nxt; int ui = 0;
    if (!S.next(0, cur)) return;
    f32x4 acc[2][2][4][2];
#pragma unroll
    for (int a = 0; a < 2; ++a)
#pragma unroll
        for (int b = 0; b < 2; ++b)
#pragma unroll
            for (int m = 0; m < 4; ++m)
#pragma unroll
                for (int n = 0; n < 2; ++n) acc[a][b][m][n] = (f32x4){0.f, 0.f, 0.f, 0.f};
    bf16x8 At[4][2], B0[2][2], B1[2][2];
    const char* cA = (const char*)g.A + (size_t)cur.pm * tstep; const char* cB = (const char*)g.Bt + (size_t)cur.pn * tstep;
    S.a_ready(cur);
    if constexpr (SP2) {
        PG8_STAGE(PG8_SB(0, 0), cB, voffB); PG8_STAGE(PG8_SB(0, 1), cB + hstep, voffB); PG8_STAGE(PG8_SA(0, 0), cA, voffA); PG8_STAGE(PG8_SA(0, 1), cA + hstep, voffA);
        if (wr == 1) PG8_BAR;
        PG8_WAIT_V(2); PG8_BAR;
        PG8_STAGE(PG8_SB(1, 0), cB + kstep, voffB); PG8_STAGE(PG8_SA(1, 0), cA + kstep, voffA); PG8_STAGE(PG8_SB(1, 1), cB + hstep + kstep, voffB);
        PG8_WAIT_V(6); PG8_BAR;
    } else {
        PG8_STAGE(PG8_SB(0, 0), cB, voffB); PG8_STAGE(PG8_SA(0, 0), cA, voffA); PG8_STAGE(PG8_SB(0, 1), cB + hstep, voffB); PG8_STAGE(PG8_SA(0, 1), cA + hstep, voffA);
        if (wr == 1) PG8_BAR;
        PG8_WAIT_V(4); PG8_BAR;
        PG8_STAGE(PG8_SB(1, 0), cB + kstep, voffB); PG8_STAGE(PG8_SA(1, 0), cA + kstep, voffA); PG8_STAGE(PG8_SB(1, 1), cB + hstep + kstep, voffB);
        PG8_WAIT_V(6); PG8_BAR;
    }
    for (;;) {
        const bool has_next = S.next(ui + 1, nxt);
        const char* nA = has_next ? (const char*)g.A + (size_t)nxt.pm * tstep : cA; const char* nB = has_next ? (const char*)g.Bt + (size_t)nxt.pn * tstep : cB;
        for (int t = 0; t < nt; t += 2) {
            const bool last = (t == nt - 2);
            const char* a1 = cA + (size_t)(t + 1) * kstep;
            const char* a2 = last ? nA : cA + (size_t)(t + 2) * kstep; const char* b2 = last ? nB : cB + (size_t)(t + 2) * kstep;
            const char* a3 = a2 + kstep; const char* b3 = b2 + kstep;
            if (last && has_next) S.a_ready(nxt);
            if constexpr (SP2) {
            PG8_LDB(B0, 0, 0); PG8_LDB(B1, 0, 1); PG8_SCHED; PG8_LDA(At, 0, 0); PG8_STAGE(PG8_SA(1, 1), a1 + hstep, voffA);
            PG8_WAIT_V(8); PG8_WAIT_L(0); PG8_BAR; PG8_MMA(0, 0, At, B0); PG8_MMA(0, 1, At, B1); PG8_BAR; PG8_SCHED;
            PG8_LDA(At, 0, 1); PG8_STAGE(PG8_SB(0, 0), b2, voffB); PG8_STAGE(PG8_SB(0, 1), b2 + hstep, voffB); PG8_STAGE(PG8_SA(0, 0), a2, voffA);
            PG8_WAIT_V(8); PG8_WAIT_L(0); PG8_BAR; PG8_MMA(1, 0, At, B0); PG8_MMA(1, 1, At, B1); PG8_BAR; PG8_SCHED;
            PG8_LDB(B0, 1, 0); PG8_LDB(B1, 1, 1); PG8_SCHED; PG8_LDA(At, 1, 0); PG8_STAGE(PG8_SA(0, 1), a2 + hstep, voffA);
            PG8_WAIT_V(8); PG8_WAIT_L(0); PG8_BAR; PG8_MMA(0, 0, At, B0); PG8_MMA(0, 1, At, B1); PG8_BAR; PG8_SCHED;
            PG8_LDA(At, 1, 1); PG8_STAGE(PG8_SB(1, 0), b3, voffB); PG8_STAGE(PG8_SB(1, 1), b3 + hstep, voffB); PG8_STAGE(PG8_SA(1, 0), a3, voffA);
            PG8_WAIT_V(8); PG8_WAIT_L(0); PG8_BAR; PG8_MMA(1, 0, At, B0); PG8_MMA(1, 1, At, B1); PG8_BAR; PG8_SCHED;
            } else {
            PG8_LDB(B0, 0, 0); PG8_SCHED; PG8_LDA(At, 0, 0); PG8_STAGE(PG8_SA(1, 1), a1 + hstep, voffA);
            PG8_WAIT_L(8); PG8_BAR; PG8_WAIT_L(0); PG8_MMA(0, 0, At, B0); PG8_BAR; PG8_SCHED;
            PG8_LDB(B1, 0, 1); PG8_STAGE(PG8_SB(0, 0), b2, voffB);
            PG8_BAR; PG8_WAIT_L(0); PG8_MMA(0, 1, At, B1); PG8_BAR;
            PG8_LDA(At, 0, 1); PG8_STAGE(PG8_SA(0, 0), a2, voffA);
            PG8_BAR; PG8_WAIT_L(0); PG8_MMA(1, 0, At, B0); PG8_BAR; PG8_SCHED;
            PG8_STAGE(PG8_SB(0, 1), b2 + hstep, voffB);
            PG8_WAIT_V(6); PG8_BAR; PG8_MMA(1, 1, At, B1); PG8_BAR;
            PG8_LDB(B0, 1, 0); PG8_SCHED; PG8_LDA(At, 1, 0); PG8_STAGE(PG8_SA(0, 1), a2 + hstep, voffA);
            PG8_WAIT_L(8); PG8_BAR; PG8_WAIT_L(0); PG8_MMA(0, 0, At, B0); PG8_BAR; PG8_SCHED;
            PG8_LDB(B1, 1, 1); PG8_STAGE(PG8_SB(1, 0), b3, voffB);
            PG8_BAR; PG8_WAIT_L(0); PG8_MMA(0, 1, At, B1); PG8_BAR;
            PG8_LDA(At, 1, 1); PG8_STAGE(PG8_SA(1, 0), a3, voffA);
            PG8_BAR; PG8_WAIT_L(0); PG8_MMA(1, 0, At, B0); PG8_BAR; PG8_SCHED;
            PG8_STAGE(PG8_SB(1, 1), b3 + hstep, voffB);
            PG8_WAIT_V(6); PG8_BAR; PG8_MMA(1, 1, At, B1); PG8_BAR;
            }
        }
        if constexpr (ALIGN_EPI) { if (wr == 0) PG8_BAR; }
        if constexpr (!Epi::AFTER_DRAIN) { E(acc, cur, wr, wc, fr, fq); S.done(cur); }
        if (!has_next) break;
#pragma unroll
        for (int a = 0; a < 2; ++a)
#pragma unroll
            for (int b = 0; b < 2; ++b)
#pragma unroll
                for (int m = 0; m < 4; ++m)
#pragma unroll
                    for (int n = 0; n < 2; ++n) acc[a][b][m][n] = (f32x4){0.f, 0.f, 0.f, 0.f};
        cur = nxt; cA = nA; cB = nB; ++ui;
        if constexpr (ALIGN_EPI) { if (wr == 1) PG8_BAR; }
    }
    PG8_WAIT_V(0);
    if constexpr (!ALIGN_EPI) { if (wr == 0) PG8_BAR; }
    PG8_BAR;
    if constexpr (Epi::AFTER_DRAIN) { E.fused(acc, cur, wr, wc, fr, fq, lds, wid, lane); S.done(cur); }
#undef PG8_SA
#undef PG8_SB
#undef PG8_STAGE
#undef PG8_LDA
#undef PG8_LDB
#undef PG8_MMA
#undef PG8_WAIT_V
#undef PG8_WAIT_L
#undef PG8_BAR
#undef PG8_SCHED
}
}

DI u32x2 pack4(f32x4 v) { u32x2 r; r.x = cvtpk(v.x, v.y); r.y = cvtpk(v.z, v.w); return r; }
DI u32x4 pack8(f32x4 a, f32x4 b) { u32x4 r; r.x = cvtpk(a.x, a.y); r.y = cvtpk(a.z, a.w); r.z = cvtpk(b.x, b.y); r.w = cvtpk(b.z, b.w); return r; }

struct Epi1 {
    static constexpr bool PERM = true, AFTER_DRAIN = false;
    unsigned char* ws;
    DI void operator()(const f32x4 (&acc)[2][2][4][2], const pg8::Unit& u, int wr, int wc, int fr, int fq) const {
        const float* r1p = (const float*)(ws + WS_R1);
        const float* rope = (const float*)(ws + WS_ROPE);
        const float* lbp = (const float*)(ws + WS_LB);
        const int seg = u.pn >> 1;
#pragma unroll
        for (int ai = 0; ai < 2; ++ai)
#pragma unroll
            for (int m = 0; m < 4; ++m) {
                const int row = u.pm * 256 + ai * 128 + wr * 64 + m * 16 + fr;
                const bool meta = row >= NTOK;
                if (row >= NTOK + NMETA) continue;
                const float r1 = r1p[row];
                const int b = meta ? 0 : (row >> 12), t = meta ? (row - NTOK) : ((row & 4095) + NMETA);
                const int nrep = meta ? BATCH : 1;
#pragma unroll
                for (int bj = 0; bj < 2; ++bj) {
                    const int cs = (u.pn & 1) * 256 + bj * 128 + wc * 32 + 8 * fq;
                    const f32x4 v0 = acc[ai][bj][m][0] * r1, v1 = acc[ai][bj][m][1] * r1;
                    const int h = cs >> 7;
                    if (seg <= 1) {
                        const int comp = (cs >> 6) & 1, cc = cs & 63, i0 = 16 * (cc >> 5) + 4 * fq;
                        const float* rp = rope + ((size_t)(cc >> 5) * TPOS + t) * 32 + 4 * fq;
                        const f32x4 c4 = *(const f32x4*)rp, s4 = *(const f32x4*)(rp + 16);
                        f32x4 lo = v0 * c4 - v1 * s4, hi = v1 * c4 + v0 * s4;
                        if (seg == 0) {
                            if (meta) continue;
                            lo = lo * QSCALE; hi = hi * QSCALE;
                            bf16_t* qp = (bf16_t*)(ws + WS_Q) + (size_t)((b * 4 + h) * 2 + comp) * SEQ * 64 + ((size_t)(i0 >> 3) * SEQ + (row & 4095)) * 8 + (i0 & 7);
                            *(u32x2*)qp = pack4(lo); *(u32x2*)(qp + (size_t)4 * SEQ * 8) = pack4(hi);
                        } else {
                            const int pp = t + KPAD, tile = pp >> 6, key = pp & 63;
                            for (int bb = 0; bb < nrep; ++bb) {
                                const int b_ = meta ? bb : b;
                                unsigned char* img = ws + WS_K + ((size_t)((b_ * 4 + h) * 2 + comp) * KT + tile) * 8192;
                                *(u32x2*)(img + (i0 >> 3) * 1024 + key * 16 + (i0 & 7) * 2) = pack4(lo);
                                *(u32x2*)(img + ((i0 >> 3) + 4) * 1024 + key * 16 + (i0 & 7) * 2) = pack4(hi);
                            }
                        }
                    } else if (seg == 2) {
                        const int dv = cs & 127, pp = t + KPAD, tile = pp >> 6, key = pp & 63;
                        const u32x4 w = pack8(v0, v1);
                        for (int bb = 0; bb < nrep; ++bb) {
                            const int b_ = meta ? bb : b;
                            unsigned char* img = ws + WS_V + ((size_t)(b_ * 4 + h) * KT + tile) * 16384;
                            *(u32x4*)(img + (dv >> 5) * 4096 + key * 64 + (dv & 31) * 2) = w;
                        }
                    } else if (seg == 3 || seg == 5) {
                        const int dv = cs & 127;
                        f32x4 a = v0, c = v1;
                        if (seg == 3) { a.x = siluf_(a.x); a.y = siluf_(a.y); a.z = siluf_(a.z); a.w = siluf_(a.w); c.x = siluf_(c.x); c.y = siluf_(c.y); c.z = siluf_(c.z); c.w = siluf_(c.w); }
                        const u32x4 w = pack8(a, c);
                        const size_t base = (seg == 3) ? WS_HQ : WS_HV;
                        for (int bb = 0; bb < nrep; ++bb) {
                            const int b_ = meta ? bb : b;
                            *(u32x4*)((bf16_t*)(ws + base) + ((size_t)(b_ * 4 + h) * HT + t + 16) * 128 + dv) = w;
                        }
                    } else if (seg == 4) {
                        const int dv = cs & 127;
                        const f32x4 l0 = *(const f32x4*)(lbp + cs), l1 = *(const f32x4*)(lbp + cs + 4);
                        f32x4 g0, g1;
#pragma unroll
                        for (int e = 0; e < 4; ++e) { g0[e] = __builtin_amdgcn_logf(l0[e] + (1.f - l0[e]) * sigmoidf_(v0[e])); g1[e] = __builtin_amdgcn_logf(l1[e] + (1.f - l1[e]) * sigmoidf_(v1[e]));        }
                        for (int bb = 0; bb < nrep; ++bb) {
                            const int b_ = meta ? bb : b;
                            _Float16* gp = (_Float16*)(ws + WS_HG + ((size_t)(b_ * 4 + h) * HT + t + 16) * 512) + dv;
                            typedef _Float16 f16x8_t __attribute__((ext_vector_type(8)));
                            *(f16x8_t*)gp = (f16x8_t){(_Float16)g0.x, (_Float16)g0.y, (_Float16)g0.z, (_Float16)g0.w, (_Float16)g1.x, (_Float16)g1.y, (_Float16)g1.z, (_Float16)g1.w};
                        }
                    } else {
                        if (meta) continue;
                        f32x4 a = v0, c = v1;
                        a.x = siluf_(a.x); a.y = siluf_(a.y); a.z = siluf_(a.z); a.w = siluf_(a.w); c.x = siluf_(c.x); c.y = siluf_(c.y); c.z = siluf_(c.z); c.w = siluf_(c.w);
                        *(u32x4*)((bf16_t*)(ws + WS_SG) + (size_t)row * 512 + cs) = pack8(a, c);
                    }
                }
            }
    }
};

struct Epi3 {
    static constexpr bool PERM = true, AFTER_DRAIN = false;
    const float* x; float* H; bf16_t* HB; float* ssq;
    DI void operator()(const f32x4 (&acc)[2][2][4][2], const pg8::Unit& u, int wr, int wc, int fr, int fq) const {
#pragma unroll
        for (int ai = 0; ai < 2; ++ai)
#pragma unroll
            for (int m = 0; m < 4; ++m) {
                const int row = u.pm * 256 + ai * 128 + wr * 64 + m * 16 + fr;
                float s = 0.f;
#pragma unroll
                for (int bj = 0; bj < 2; ++bj) {
                    const int col = u.pn * 256 + bj * 128 + wc * 32 + 8 * fq;
                    const size_t o = (size_t)row * DM + col;
                    const u32x4 xb = *(const u32x4*)(HB + o);
                    const f32x4 x0 = (f32x4){bf2f(xb.x & 0xffffu), bf2f(xb.x >> 16), bf2f(xb.y & 0xffffu), bf2f(xb.y >> 16)}, x1 = (f32x4){bf2f(xb.z & 0xffffu), bf2f(xb.z >> 16), bf2f(xb.w & 0xffffu), bf2f(xb.w >> 16)};
                    const f32x4 h0 = x0 + acc[ai][bj][m][0], h1 = x1 + acc[ai][bj][m][1];
                    *(u32x4*)(HB + o) = pack8(h0, h1);
                    s += (h0.x * h0.x + h0.y * h0.y) + (h0.z * h0.z + h0.w * h0.w) + (h1.x * h1.x + h1.y * h1.y) + (h1.z * h1.z + h1.w * h1.w);
                }
                s += __shfl_xor(s, 16); s += __shfl_xor(s, 32);
                if (fq == 0) atomicAdd(ssq + row, s);
            }
    }
};

struct Epi4 {
    static constexpr bool PERM = true, AFTER_DRAIN = false;
    const float* ssq; bf16_t* PQ;
    DI void operator()(const f32x4 (&acc)[2][2][4][2], const pg8::Unit& u, int wr, int wc, int fr, int fq) const {
#pragma unroll
        for (int ai = 0; ai < 2; ++ai)
#pragma unroll
            for (int m = 0; m < 4; ++m) {
                const int row = u.pm * 256 + ai * 128 + wr * 64 + m * 16 + fr;
                const float r2 = __builtin_amdgcn_rsqf(ssq[row] * (1.f / DM) + EPS);
#pragma unroll
                for (int bj = 0; bj < 2; ++bj) {
                    const int col = u.pn * 256 + bj * 128 + wc * 32 + 8 * fq;
                    *(u32x4*)(PQ + (size_t)row * 2048 + col) = pack8(acc[ai][bj][m][0] * r2, acc[ai][bj][m][1] * r2);
                }
            }
    }
};

template <class Epi>
DI void gemm_run(char* lds, const bf16_t* A, const bf16_t* Bt, int M, int N, int K, const Epi& E, int bid, int nblk) {
    pg8::Gemm g{A, Bt, M, N, K}; pg8::StaticOrder S; S.init(M, N, nblk, bid);
    pg8::gemm_phase<Epi, pg8::StaticOrder, true, true>((LAS unsigned char*)lds, g, S, E);
}
#define MFMA32(a, b, c) __builtin_amdgcn_mfma_f32_32x32x16_bf16(a, b, c, 0, 0, 0)
typedef short v4i16_t __attribute__((ext_vector_type(4)));
DI int crow(int r, int hi) { return (r & 3) + 8 * (r >> 2) + 4 * hi; }
DI s16x4 vtr(const LAS char* p) { return __builtin_bit_cast(s16x4, __builtin_amdgcn_ds_read_tr16_b64_v4i16((LAS v4i16_t*)p)); }
DI void glds16(const void* g, LAS char* l) { __builtin_amdgcn_global_load_lds((const unsigned*)g, (LAS unsigned*)l, 16, 0, 0); }
DI float swap_sum(float m) { auto rr = __builtin_amdgcn_permlane32_swap(__float_as_uint(m), __float_as_uint(m), false, false); return __uint_as_float(rr[0]) + __uint_as_float(rr[1]); }
constexpr int ATT_BUF = 32768, ATT_WSF = 65536;
constexpr float ATT_THR = 8.f;

DI void attn_unit(const Params& P, int b, int h, int j, char* lds_g) {
    LAS char* lds = (LAS char*)lds_g;
    const int tid = tid_(), lane = tid & 63, r32 = lane & 31, hi = lane >> 5;
    const int wid = __builtin_amdgcn_readfirstlane(tid >> 6), comp = wid >> 2, wq = wid & 3;
    const unsigned char* ws = P.ws;
    const int bh = b * 4 + h;
    const bf16_t* Qw = (const bf16_t*)(ws + WS_Q) + (size_t)(bh * 2 + comp) * SEQ * 64 + (size_t)(128 * j + 32 * wq + r32) * 8;
    bf16x8 qr[4];
#pragma unroll
    for (int d0 = 0; d0 < 4; ++d0) qr[d0] = *(const bf16x8*)(Qw + (size_t)(2 * d0 + hi) * SEQ * 8);
    const unsigned char* kimg0 = ws + WS_K + (size_t)(bh * 2) * KT * 8192 + wid * 1024 + lane * 16;
    const unsigned char* kimg1 = kimg0 + (size_t)KT * 8192;
    const unsigned char* vimg = ws + WS_V + (size_t)bh * KT * 16384 + wid * 1024 + lane * 16;
    const int NT = 2 * j + 3, my_last = (wq < 2) ? 2 * j + 1 : 2 * j + 2;
    LAS float* wsf = (LAS float*)(lds + ATT_WSF) + wid * 64;
#define ATT_ISSUE(t, s) do { LAS char* d_ = lds + (s) * ATT_BUF + wid * 1024; \
        glds16(kimg0 + (size_t)(t) * 8192, d_); glds16(kimg1 + (size_t)(t) * 8192, d_ + 8192); \
        glds16(vimg + (size_t)(t) * 16384, d_ + 16384); glds16(vimg + (size_t)(t) * 16384 + 8192, d_ + 24576); } while (0)
    f32x16 o[4];
#pragma unroll
    for (int nb = 0; nb < 4; ++nb) o[nb] = f32x16{};
    float mref = 0.f, lsum = 0.f;
    f32x16 mv = f32x16{};
    const int qpos = 64 + 128 * j + 32 * wq + r32;
    ATT_ISSUE(0, 0);
    __syncthreads();
    for (int t = 0; t < NT; ++t) {
        const int s = t & 1;
        if (t + 1 < NT) ATT_ISSUE(t + 1, s ^ 1);
        if (t <= my_last) {
            const LAS char* kp = lds + s * ATT_BUF + comp * 8192 + hi * 1024 + r32 * 16;
            asm volatile("" : "+v"(mv));
            f32x16 s0, s1;
#pragma unroll
            for (int d0 = 0; d0 < 4; ++d0) {
                const bf16x8 k0 = *(const LAS bf16x8*)(kp + d0 * 2048), k1 = *(const LAS bf16x8*)(kp + d0 * 2048 + 512);
                if (d0 == 0) { s0 = MFMA32(k0, qr[d0], mv); s1 = MFMA32(k1, qr[d0], mv); }
                else { s0 = MFMA32(k0, qr[d0], s0); s1 = MFMA32(k1, qr[d0], s1); }
            }
            if (t == 0 || t >= 2 * j + 1) {
                const int kb = 64 * t + 4 * hi - KPAD; const unsigned lim = (unsigned)(qpos - KPAD);
#pragma unroll
                for (int r = 0; r < 16; ++r) { const int kv = kb + (r & 3) + 8 * (r >> 2); if ((unsigned)kv > lim) s0[r] = -INFINITY; if ((unsigned)(kv + 32) > lim) s1[r] = -INFINITY; }
            }
            asm volatile("s_nop 15" : "+v"(s0), "+v"(s1));
            float rm;
            asm("v_max3_f32 %0, %1, %2, %3" : "=v"(rm) : "v"(s0[0]), "v"(s1[0]), "v"(s0[1]));
            asm("v_max3_f32 %0, %1, %2, %3" : "=v"(rm) : "v"(rm), "v"(s1[1]), "v"(s0[2]));
#pragma unroll
            for (int r = 2; r < 15; ++r) asm("v_max3_f32 %0, %1, %2, %3" : "=v"(rm) : "v"(rm), "v"(s1[r]), "v"(s0[r + 1]));
            asm("v_max_f32 %0, %1, %2" : "=v"(rm) : "v"(rm), "v"(s1[15]));
            { auto rr = __builtin_amdgcn_permlane32_swap(__float_as_uint(rm), __float_as_uint(rm), false, false); const float ra = __uint_as_float(rr[0]), rb = __uint_as_float(rr[1]);
              asm("v_max_f32 %0, %1, %2" : "=v"(rm) : "v"(ra), "v"(rb)); }
            const bool first = (t == 0);
            if (first || __any(rm > ATT_THR)) {
                const float dl = first ? rm : fmaxf(rm, 0.f), f = first ? 1.f : __builtin_amdgcn_exp2f(-dl);
                mref += dl; lsum *= f;
                if (hi == 0) wsf[r32] = f;
                asm volatile("s_waitcnt lgkmcnt(0)" ::: "memory");
#pragma unroll
                for (int r = 0; r < 16; ++r) { const float fr_ = wsf[crow(r, hi)]; s0[r] -= dl; s1[r] -= dl; mv[r] = -mref;
#pragma unroll
                    for (int nb = 0; nb < 4; ++nb) o[nb][r] *= fr_; }
            }
            f32x2 ps2 = (f32x2){0.f, 0.f};
#pragma unroll
            for (int r = 0; r < 16; ++r) { s0[r] = __builtin_amdgcn_exp2f(s0[r]); s1[r] = __builtin_amdgcn_exp2f(s1[r]); }
#pragma unroll
            for (int r = 0; r < 16; r += 2) { ps2 += (f32x2){s0[r], s0[r + 1]}; ps2 += (f32x2){s1[r], s1[r + 1]}; }
            lsum += ps2.x + ps2.y;
            const LAS char* vp = lds + s * ATT_BUF + 16384 + ((lane >> 4) & 1) * 32 + (lane & 3) * 8 + (4 * hi + ((lane & 15) >> 2)) * 64;
#pragma unroll
            for (int ks = 0; ks < 4; ++ks) {
                u32x4 pw;
                if (ks < 2) { pw.x = cvtpk(s0[8 * ks], s0[8 * ks + 1]); pw.y = cvtpk(s0[8 * ks + 2], s0[8 * ks + 3]); pw.z = cvtpk(s0[8 * ks + 4], s0[8 * ks + 5]); pw.w = cvtpk(s0[8 * ks + 6], s0[8 * ks + 7]); }
                else { const int q_ = ks - 2; pw.x = cvtpk(s1[8 * q_], s1[8 * q_ + 1]); pw.y = cvtpk(s1[8 * q_ + 2], s1[8 * q_ + 3]); pw.z = cvtpk(s1[8 * q_ + 4], s1[8 * q_ + 5]); pw.w = cvtpk(s1[8 * q_ + 6], s1[8 * q_ + 7]); }
                const bf16x8 pa = __builtin_bit_cast(bf16x8, pw);
#pragma unroll
                for (int nb = 0; nb < 4; ++nb) {
                    const s16x4 vlo = vtr(vp + nb * 4096 + ks * 1024), vhi = vtr(vp + nb * 4096 + ks * 1024 + 512);
                    const bf16x8 vb = (bf16x8){vlo[0], vlo[1], vlo[2], vlo[3], vhi[0], vhi[1], vhi[2], vhi[3]};
                    o[nb] = MFMA32(pa, vb, o[nb]);
                }
            }
        }
        __syncthreads();
    }
#undef ATT_ISSUE
    lsum = swap_sum(lsum);
    if (hi == 0) wsf[r32] = lsum;
    asm volatile("s_waitcnt lgkmcnt(0)" ::: "memory");
    float rli[16];
#pragma unroll
    for (int r = 0; r < 16; ++r) rli[r] = __builtin_amdgcn_rcpf(wsf[crow(r, hi)]);
    const float lam = ((const float*)(ws + WS_LB))[512];
    LAS float* ex = (LAS float*)lds + wq * 4096;
    if (comp == 1) {
#pragma unroll
        for (int r = 0; r < 16; ++r)
#pragma unroll
            for (int nb = 0; nb < 4; ++nb) ex[(r * 4 + nb) * 64 + lane] = o[nb][r] * rli[r] * lam;
    }
    __syncthreads();
    if (comp == 0) {
        float ss[16];
#pragma unroll
        for (int r = 0; r < 16; ++r) { float a = 0.f;
#pragma unroll
            for (int nb = 0; nb < 4; ++nb) { const float v = o[nb][r] * rli[r] - ex[(r * 4 + nb) * 64 + lane]; o[nb][r] = v; a += v * v; }
            ss[r] = a; }
#pragma unroll
        for (int r = 0; r < 16; ++r) { float a = ss[r]; a += __shfl_xor(a, 1); a += __shfl_xor(a, 2); a += __shfl_xor(a, 4); a += __shfl_xor(a, 8); a += __shfl_xor(a, 16); ss[r] = (1.f - LAM_INIT) * __builtin_amdgcn_rsqf(a * (1.f / 128.f) + EPS); }
        bf16_t* mix = (bf16_t*)(ws + WS_MIX) + ((size_t)(b * SEQ + 128 * j + 32 * wq)) * DM + h * 128;
#pragma unroll
        for (int nb = 0; nb < 4; ++nb) { const float w = P.subln_w[32 * nb + r32];
#pragma unroll
            for (int r = 0; r < 16; ++r) mix[(size_t)crow(r, hi) * DM + 32 * nb + r32] = (bf16_t)f2bf(o[nb][r] * ss[r] * w); }
    }
    __syncthreads();
}
#define MFMA16(a, b, c) __builtin_amdgcn_mfma_f32_16x16x32_bf16(a, b, c, 0, 0, 0)
constexpr int HG_STR = 272;
constexpr int HL_QA = 0, HL_QB = HL_QA + 32 * HG_STR, HL_KB = HL_QB + 32 * HG_STR, HL_KT = HL_KB + 32 * HG_STR, HL_VV = HL_KT + 32 * HG_STR;
constexpr int HL_PS = HL_VV + 32 * HG_STR;
constexpr int HL_D = HL_PS + 4 * 128 * 4;
constexpr int HL_OUT = HL_D + 128 * 4;
constexpr int HL_END = HL_OUT + 32 * 132 * 4;

constexpr int HB_KTF = 0, HB_ATF = 8192, HB_DF = 10240;
constexpr int PREP_BUF = 65536;
static_assert(HL_END <= PREP_BUF && 2 * PREP_BUF <= LDS_ITEM, "prep LDS map");
#define PREP_BAR() asm volatile("s_waitcnt lgkmcnt(0)\n\ts_barrier" ::: "memory")
struct PrepIn { float g8[8]; unsigned short q8[8]; };
DI void hgrn_prep_load(const Params& P, int bh, int c, PrepIn& I) {
    const int tid = tid_(), ch = tid & 127, part = tid >> 7;
    const unsigned char* ws = P.ws;
    const unsigned char* HG = ws + WS_HG + (size_t)bh * HT * 512;
    const bf16_t* HQ = (const bf16_t*)(ws + WS_HQ) + (size_t)bh * HT * 128;
    const size_t r0 = (size_t)(32 * c + 8 * part);
#pragma unroll
    for (int e = 0; e < 8; ++e) { I.g8[e] = (float)((const _Float16*)(HG + (r0 + e) * 512))[ch]; I.q8[e] = HQ[(r0 + e) * 128 + ch]; }
}
DI void hgrn_prep_front(const PrepIn& I, LAS char* lds) {
    const int tid = tid_(), ch = tid & 127, part = tid >> 7;
    float p8[8];
    { float a = 0.f;
#pragma unroll
      for (int e = 0; e < 8; ++e) { a += I.g8[e]; p8[e] = a; } }
    ((LAS float*)(lds + HL_PS))[part * 128 + ch] = p8[7];
    PREP_BAR();
    {
        const LAS float* ps = (const LAS float*)(lds + HL_PS);
        const float t0 = ps[ch], t1 = ps[128 + ch], t2 = ps[256 + ch], t3 = ps[384 + ch];
        const float off = (part > 0 ? t0 : 0.f) + (part > 1 ? t1 : 0.f) + (part > 2 ? t2 : 0.f);
        const float mid = t0 + t1, last = mid + t2 + t3;
        const float em = __builtin_amdgcn_exp2f(mid), el = __builtin_amdgcn_exp2f(last - mid);
        if (part == 0) ((LAS float*)(lds + HL_D))[ch] = __builtin_amdgcn_exp2f(last);
#pragma unroll
        for (int e = 0; e < 8; ++e) {
            const int tk = 8 * part + e;
            const float cum = off + p8[e];
            const float e1 = __builtin_amdgcn_exp2f(cum - mid), e2 = __builtin_amdgcn_rcpf(e1);
            const float q = bf2f(I.q8[e]), k = 1.f - __builtin_amdgcn_exp2f(I.g8[e]);
            const float qb = q * e1, qa = qb * em, kb = k * e2, kt = kb * el;
            const unsigned wq = cvtpk(qa, qb), wk = cvtpk(kb, kt);
            *(LAS unsigned short*)(lds + HL_QA + tk * HG_STR + ch * 2) = (unsigned short)(wq & 0xffffu);
            *(LAS unsigned short*)(lds + HL_QB + tk * HG_STR + ch * 2) = (unsigned short)(wq >> 16);
            *(LAS unsigned short*)(lds + HL_KB + tk * HG_STR + ch * 2) = (unsigned short)(wk & 0xffffu);
            *(LAS unsigned short*)(lds + HL_KT + tk * HG_STR + ch * 2) = (unsigned short)(wk >> 16);
        }
    }
}
DI void hgrn_prep_back(const Params& P, int bh, int c, LAS char* lds) {
    const int tid = tid_(), lane = tid & 63, c16 = lane & 15, g4 = lane >> 4;
    const int wid = __builtin_amdgcn_readfirstlane(tid >> 6);
    unsigned char* ws = P.ws;
    unsigned char* qaf = ws + WS_HQA + ((size_t)bh * 129 + c) * 8192;
    unsigned char* hgb = ws + WS_HG + (size_t)bh * HT * 512 + (size_t)c * 16384;
    {
        const int ks = wid >> 1, nt = wid & 1;
        const LAS char* qp = lds + HL_QA + (16 * nt + c16) * HG_STR + (32 * ks + 4 * g4) * 2;
        const u32x2 lo = *(const LAS u32x2*)qp, hi2 = *(const LAS u32x2*)(qp + 32);
        *(u32x4*)(qaf + wid * 1024 + lane * 16) = (u32x4){lo.x, lo.y, hi2.x, hi2.y};
        const LAS char* kp = lds + HL_KT + (8 * g4 + (c16 >> 2)) * HG_STR + (16 * wid + 4 * (c16 & 3)) * 2;
        const s16x4 klo = vtr(kp), khi = vtr(kp + 4 * HG_STR);
        *(bf16x8*)(hgb + HB_KTF + wid * 1024 + lane * 16) = (bf16x8){klo[0], klo[1], klo[2], klo[3], khi[0], khi[1], khi[2], khi[3]};
    }
    if (wid == 0) {
        f32x4 at00 = (f32x4){0.f, 0.f, 0.f, 0.f}, at01 = at00, at11 = at00;
#pragma unroll
        for (int ks = 0; ks < 4; ++ks) {
            const bf16x8 ka0 = *(const LAS bf16x8*)(lds + HL_KB + c16 * HG_STR + (32 * ks + 8 * g4) * 2);
            const bf16x8 ka1 = *(const LAS bf16x8*)(lds + HL_KB + (16 + c16) * HG_STR + (32 * ks + 8 * g4) * 2);
            const bf16x8 qn0 = *(const LAS bf16x8*)(lds + HL_QB + c16 * HG_STR + (32 * ks + 8 * g4) * 2);
            const bf16x8 qn1 = *(const LAS bf16x8*)(lds + HL_QB + (16 + c16) * HG_STR + (32 * ks + 8 * g4) * 2);
            at00 = MFMA16(ka0, qn0, at00); at01 = MFMA16(ka0, qn1, at01); at11 = MFMA16(ka1, qn1, at11);
        }
#pragma unroll
        for (int r = 0; r < 4; ++r) { if (4 * g4 + r > c16) { at00[r] = 0.f; at11[r] = 0.f; } }
        u32x4 b0; b0.x = cvtpk(at00[0], at00[1]); b0.y = cvtpk(at00[2], at00[3]); b0.z = 0u; b0.w = 0u;
        u32x4 b1; b1.x = cvtpk(at01[0], at01[1]); b1.y = cvtpk(at01[2], at01[3]); b1.z = cvtpk(at11[0], at11[1]); b1.w = cvtpk(at11[2], at11[3]);
        *(u32x4*)(hgb + HB_ATF + lane * 16) = b0; *(u32x4*)(hgb + HB_ATF + 1024 + lane * 16) = b1;
    } else if (wid == 1 && lane < 32) {
        *(f32x4*)(hgb + HB_DF + lane * 16) = *(const LAS f32x4*)(lds + HL_D + lane * 16);
    }
}
DI void hgrn_prep_phase(const Params& P, char* lds_g, int bid, int nblk) {
    LAS char* lds = (LAS char*)lds_g;
    constexpr int NIT = 32 * 129;
    PrepIn I;
    int it = bid, k = 0;
    if (it < NIT) { hgrn_prep_load(P, it & 31, it >> 5, I); hgrn_prep_front(I, lds); }
    PREP_BAR();
    for (; it < NIT; it += nblk, ++k) {
        const int nx = it + nblk;
        if (nx < NIT) hgrn_prep_load(P, nx & 31, nx >> 5, I);
        hgrn_prep_back(P, it & 31, it >> 5, lds + (k & 1) * PREP_BUF);
        if (nx < NIT) hgrn_prep_front(I, lds + ((k + 1) & 1) * PREP_BUF);
        PREP_BAR();
    }
}

constexpr int RS_QAF = 0, RS_HGB = 8192, RS_V = 19456, RS_SLOT = 27648, RS_NSLOT = 5;
constexpr int RS_OUT = RS_NSLOT * RS_SLOT, RS_OUTB = 32 * 136 * 2, RS_END = RS_OUT + 2 * RS_OUTB;
static_assert(RS_END <= LDS_ITEM, "hgrn LDS map");
DI void glds16_asm(const void* g, unsigned lds_base) {
    unsigned sv; asm volatile("s_mov_b32 %0, m0\n\ts_mov_b32 m0, %2\n\ts_nop 0\n\tglobal_load_lds_dwordx4 %1, off\n\ts_mov_b32 m0, %0" : "=&s"(sv) : "v"(g), "s"(lds_base) : "memory"); }
#define HW_BAR() asm volatile("s_waitcnt lgkmcnt(0)\n\ts_barrier" ::: "memory")
DI void glds16_sb(unsigned voff, const void* sbase, unsigned lds_base) {
    unsigned sv; asm volatile("s_mov_b32 %0, m0\n\ts_mov_b32 m0, %3\n\ts_nop 0\n\tglobal_load_lds_dwordx4 %1, %2\n\ts_mov_b32 m0, %0" : "=&s"(sv) : "v"(voff), "s"(sbase), "s"(lds_base) : "memory"); }
DI void hgrn_unit(const Params& P, int b, int h, char* lds_g) {
    LAS char* lds = (LAS char*)lds_g;
    const int tid = tid_(), lane = tid & 63, c16 = lane & 15, g4 = lane >> 4;
    const int wid = __builtin_amdgcn_readfirstlane(tid >> 6);
    const unsigned char* ws = P.ws;
    const int bh = b * 4 + h;
    const unsigned lbase = (unsigned)__builtin_amdgcn_readfirstlane((int)(unsigned)(size_t)lds);
    constexpr int AHEAD = RS_NSLOT - 1;
    if (wid < 4) {
        const unsigned char* qafg = ws + WS_HQA + (size_t)bh * 129 * 8192;
        const unsigned char* hgbg = ws + WS_HG + (size_t)bh * HT * 512;
        const unsigned char* vg = ws + WS_HV + (size_t)bh * HT * 256;
        const unsigned voff = (unsigned)lane * 16u;
        auto issue = [&](int c) {
            const unsigned sb = lbase + (unsigned)((c % RS_NSLOT) * RS_SLOT);
#pragma unroll
            for (int k = 0; k < 7; ++k) {
                const int p = wid + 4 * k;
                if (p < 19) { const unsigned char* src = (p < 8) ? qafg + (size_t)c * 8192 + p * 1024 : hgbg + (size_t)c * 16384 + (p - 8) * 1024; glds16_sb(voff, src, sb + (unsigned)p * 1024u); }
                else if (p < 27) { const int r4 = 4 * (p - 19);
                    const unsigned vo = (unsigned)(lane >> 4) * 256u + (unsigned)(((lane & 15) ^ ((((r4 & 7) + (lane >> 4)) & 7) << 1)) * 16);
                    glds16_sb(vo, vg + ((size_t)(32 * c) + r4) * 256, sb + (unsigned)p * 1024u); }
            }
        };
        f32x4 S[2][8];
#pragma unroll
        for (int t = 0; t < 2; ++t)
#pragma unroll
            for (int i = 0; i < 8; ++i) S[t][i] = (f32x4){0.f, 0.f, 0.f, 0.f};
#pragma unroll
        for (int c = 0; c < AHEAD; ++c) issue(c);
        for (int c = 0; c < 129; ++c) {
            if (c + AHEAD - 1 > 128) asm volatile("s_waitcnt vmcnt(0)" ::: "memory");
            else if (wid < 3) asm volatile("s_waitcnt vmcnt(21)" ::: "memory"); else asm volatile("s_waitcnt vmcnt(18)" ::: "memory");
            HW_BAR();
            __builtin_amdgcn_sched_barrier(0);
            if (c + AHEAD < 129) issue(c + AHEAD);
            __builtin_amdgcn_sched_barrier(0);
            const LAS char* sl = lds + (c % RS_NSLOT) * RS_SLOT;
            f32x4 oacc[2][2];
#pragma unroll
            for (int t = 0; t < 2; ++t) { oacc[t][0] = (f32x4){0.f, 0.f, 0.f, 0.f}; oacc[t][1] = oacc[t][0]; }
#pragma unroll
            for (int ks = 0; ks < 4; ++ks) {
                const bf16x8 q0 = *(const LAS bf16x8*)(sl + RS_QAF + (2 * ks) * 1024 + lane * 16), q1 = *(const LAS bf16x8*)(sl + RS_QAF + (2 * ks + 1) * 1024 + lane * 16);
#pragma unroll
                for (int t = 0; t < 2; ++t) {
                    u32x4 sp; sp.x = cvtpk(S[t][2 * ks][0], S[t][2 * ks][1]); sp.y = cvtpk(S[t][2 * ks][2], S[t][2 * ks][3]); sp.z = cvtpk(S[t][2 * ks + 1][0], S[t][2 * ks + 1][1]); sp.w = cvtpk(S[t][2 * ks + 1][2], S[t][2 * ks + 1][3]);
                    const bf16x8 sf = __builtin_bit_cast(bf16x8, sp);
                    oacc[t][0] = MFMA16(sf, q0, oacc[t][0]); oacc[t][1] = MFMA16(sf, q1, oacc[t][1]);
                }
            }
            const int vq = c16 >> 2, vp4 = c16 & 3;
#define VTR(row, w_) vtr(sl + RS_V + (row) * 256 + (((2 * (w_) + (vp4 >> 1)) ^ ((((row) & 7)) << 1)) * 16) + 8 * (vp4 & 1))
            {
                const bf16x8 a0 = *(const LAS bf16x8*)(sl + RS_HGB + HB_ATF + lane * 16), a1 = *(const LAS bf16x8*)(sl + RS_HGB + HB_ATF + 1024 + lane * 16);
#pragma unroll
                for (int t = 0; t < 2; ++t) {
                    const s16x4 lo = VTR(4 * g4 + vq, 2 * wid + t), hi2 = VTR(16 + 4 * g4 + vq, 2 * wid + t);
                    const bf16x8 va = (bf16x8){lo[0], lo[1], lo[2], lo[3], hi2[0], hi2[1], hi2[2], hi2[3]};
                    oacc[t][0] = MFMA16(va, a0, oacc[t][0]); oacc[t][1] = MFMA16(va, a1, oacc[t][1]);
                }
            }
            {
                LAS char* ob = lds + RS_OUT + (c & 1) * RS_OUTB;
#pragma unroll
                for (int t = 0; t < 2; ++t)
#pragma unroll
                    for (int nt = 0; nt < 2; ++nt) { u32x2 w; w.x = cvtpk(oacc[t][nt][0], oacc[t][nt][1]); w.y = cvtpk(oacc[t][nt][2], oacc[t][nt][3]);
                        *(LAS u32x2*)(ob + ((16 * nt + c16) * 136 + 16 * (2 * wid + t) + 4 * g4) * 2) = w; }
            }
            {
                bf16x8 vb[2];
#pragma unroll
                for (int t = 0; t < 2; ++t) { const s16x4 lo = VTR(8 * g4 + vq, 2 * wid + t), hi2 = VTR(8 * g4 + 4 + vq, 2 * wid + t); vb[t] = (bf16x8){lo[0], lo[1], lo[2], lo[3], hi2[0], hi2[1], hi2[2], hi2[3]}; }
#pragma unroll
                for (int i = 0; i < 8; ++i) {
                    const f32x4 d4 = *(const LAS f32x4*)(sl + RS_HGB + HB_DF + (16 * i + 4 * g4) * 4);
                    const bf16x8 ka = *(const LAS bf16x8*)(sl + RS_HGB + HB_KTF + i * 1024 + lane * 16);
                    S[0][i] = MFMA16(ka, vb[0], S[0][i] * d4); S[1][i] = MFMA16(ka, vb[1], S[1][i] * d4);
                }
            }
#undef VTR
        }
        HW_BAR();
        HW_BAR();
    } else {
        const int tq = tid - 256, tok = tq >> 3, part = tq & 7;
        const bf16_t* sgg = (const bf16_t*)(ws + WS_SG) + ((size_t)b * SEQ + tok) * 512 + h * 128 + 16 * part;
        f32x4 nw[4];
#pragma unroll
        for (int q = 0; q < 4; ++q) nw[q] = *(const f32x4*)(P.rec_norm_w + h * 128 + 16 * part + 4 * q);
        auto epilogue = [&](int c, u32x4 s0, u32x4 s1) {
            const LAS char* ob = lds + RS_OUT + (c & 1) * RS_OUTB + (tok * 136 + 16 * part) * 2;
            const u32x4 o0 = *(const LAS u32x4*)ob, o1 = *(const LAS u32x4*)(ob + 16);
            const unsigned ou[8] = {o0.x, o0.y, o0.z, o0.w, o1.x, o1.y, o1.z, o1.w}, su[8] = {s0.x, s0.y, s0.z, s0.w, s1.x, s1.y, s1.z, s1.w};
            float v[16], ss = 0.f;
#pragma unroll
            for (int q = 0; q < 8; ++q) { v[2 * q] = bf2f(ou[q] & 0xffffu); v[2 * q + 1] = bf2f(ou[q] >> 16); ss += v[2 * q] * v[2 * q] + v[2 * q + 1] * v[2 * q + 1]; }
            ss += __shfl_xor(ss, 1); ss += __shfl_xor(ss, 2); ss += __shfl_xor(ss, 4);
            const float rs = __builtin_amdgcn_rsqf(ss * (1.f / 128.f) + EPS);
            u32x4 w0, w1; unsigned wo[8];
#pragma unroll
            for (int q = 0; q < 8; ++q) wo[q] = cvtpk(v[2 * q] * rs * nw[q >> 1][(2 * q) & 3] * bf2f(su[q] & 0xffffu), v[2 * q + 1] * rs * nw[q >> 1][(2 * q + 1) & 3] * bf2f(su[q] >> 16));
            w0 = (u32x4){wo[0], wo[1], wo[2], wo[3]}; w1 = (u32x4){wo[4], wo[5], wo[6], wo[7]};
            bf16_t* mp = (bf16_t*)(ws + WS_MIX) + ((size_t)b * SEQ + 32 * (c - 1) + tok) * DM + 512 + h * 128 + 16 * part;
            *(u32x4*)mp = w0; *(u32x4*)(mp + 8) = w1;
        };
#define SG_LD(k, A, B) do { const bf16_t* p_ = sgg + (size_t)(32 * ((k) - 1)) * 512; A = *(const u32x4*)p_; B = *(const u32x4*)(p_ + 8); } while (0)
        u32x4 ga0, ga1, gb0, gb1, gc0, gc1, gd0, gd1;
        SG_LD(1, gb0, gb1); SG_LD(2, gc0, gc1); SG_LD(3, gd0, gd1);
        HW_BAR();
        HW_BAR();
        for (int k = 1; k <= 128; k += 4) {
            HW_BAR(); if (k + 3 <= 128) SG_LD(k + 3, ga0, ga1); epilogue(k, gb0, gb1);
            HW_BAR(); if (k + 4 <= 128) SG_LD(k + 4, gb0, gb1); epilogue(k + 1, gc0, gc1);
            HW_BAR(); if (k + 5 <= 128) SG_LD(k + 5, gc0, gc1); epilogue(k + 2, gd0, gd1);
            HW_BAR(); if (k + 6 <= 128) SG_LD(k + 6, gd0, gd1); epilogue(k + 3, ga0, ga1);
        }
#undef SG_LD
        HW_BAR();
    }
}
DI float rawmax(float a, float b) { float d; asm("v_max_f32 %0, %1, %2" : "=v"(d) : "v"(a), "v"(b)); return d; }
DI float rawmin(float a, float b) { float d; asm("v_min_f32 %0, %1, %2" : "=v"(d) : "v"(a), "v"(b)); return d; }
#define CE_D(a, b) do { const float hi_ = rawmax(a, b), lo_ = rawmin(a, b); a = hi_; b = lo_; } while (0)
DI void bitonic_sort16(float (&v)[16]) {
#define S2(i, j) CE_D(v[i], v[j])
    S2(0, 13); S2(1, 12); S2(2, 15); S2(3, 14); S2(4, 8); S2(5, 6); S2(7, 11); S2(9, 10);
    S2(0, 5); S2(1, 7); S2(2, 9); S2(3, 4); S2(6, 13); S2(8, 14); S2(10, 15); S2(11, 12);
    S2(0, 1); S2(2, 3); S2(4, 5); S2(6, 8); S2(7, 9); S2(10, 11); S2(12, 13); S2(14, 15);
    S2(0, 2); S2(1, 3); S2(4, 10); S2(5, 11); S2(6, 7); S2(8, 9); S2(12, 14); S2(13, 15);
    S2(1, 2); S2(3, 12); S2(4, 6); S2(5, 7); S2(8, 10); S2(9, 11); S2(13, 14);
    S2(1, 4); S2(2, 6); S2(5, 8); S2(7, 10); S2(9, 13); S2(11, 14);
    S2(2, 4); S2(3, 6); S2(9, 12); S2(11, 13);
    S2(3, 5); S2(6, 8); S2(7, 9); S2(10, 12);
    S2(3, 4); S2(5, 6); S2(7, 8); S2(9, 10); S2(11, 12);
    S2(6, 7); S2(8, 9);
#undef S2
}
DI void merge_top16(float (&a)[16], const float (&b)[16]) {
#pragma unroll
    for (int i = 0; i < 16; ++i) a[i] = rawmax(a[i], b[15 - i]);
#pragma unroll
    for (int j = 8; j > 0; j /= 2)
#pragma unroll
        for (int i = 0; i < 16; ++i) { const int l = i ^ j; if (l > i) CE_D(a[i], a[l]); }
}
DI float embed7(float v, unsigned code) { return __uint_as_float((__float_as_uint(v) & 0xFFFFFF80u) | code); }
DI float embed8(float v, unsigned code) { return __uint_as_float((__float_as_uint(v) & 0xFFFFFF00u) | code); }

constexpr int TQ_STR = 272, TQ_WAVE = 32 * TQ_STR;
DI void topk_stage_q(const bf16_t* qrow, LAS char* qst, int lane) {
    u32x4 v[8];
#pragma unroll
    for (int i = 0; i < 8; ++i) v[i] = *(const u32x4*)(qrow + (size_t)(4 * i + (lane >> 4)) * 2048 + (lane & 15) * 8);
#pragma unroll
    for (int i = 0; i < 8; ++i) *(LAS u32x4*)(qst + (4 * i + (lane >> 4)) * TQ_STR + (lane & 15) * 16) = v[i];
    asm volatile("s_waitcnt lgkmcnt(0)" ::: "memory");
}
DI void topk_list(const LAS char* qst, const LAS char* skf, int lane, int hi, float (&top)[16]) {
    f32x16 acc[4];
#pragma unroll
    for (int kb = 0; kb < 4; ++kb) acc[kb] = f32x16{};
    const LAS char* qp = qst + (lane & 31) * TQ_STR + 16 * hi;
#pragma unroll
    for (int ks = 0; ks < 8; ++ks) {
        const bf16x8 qf = *(const LAS bf16x8*)(qp + 32 * ks);
#pragma unroll
        for (int kb = 0; kb < 4; ++kb) { const bf16x8 kf = *(const LAS bf16x8*)(skf + (kb * 8 + ks) * 1024 + lane * 16); acc[kb] = MFMA32(kf, qf, acc[kb]); }
    }
    float blk[16];
#pragma unroll
    for (int kb = 0; kb < 4; ++kb) {
#pragma unroll
        for (int r = 0; r < 16; ++r) { const unsigned code = (unsigned)(32 * kb + (r & 3) + 8 * (r >> 2)) | (unsigned)(4 * hi); if (kb == 0) top[r] = embed7(acc[kb][r], code); else blk[r] = embed7(acc[kb][r], code); }
        if (kb == 0) bitonic_sort16(top); else { bitonic_sort16(blk); merge_top16(top, blk); }
    }
    float l0[16], l1[16];
#pragma unroll
    for (int r = 0; r < 16; ++r) { auto rr = __builtin_amdgcn_permlane32_swap(__float_as_uint(top[r]), __float_as_uint(top[r]), false, false); l0[r] = __uint_as_float(rr[0]); l1[r] = __uint_as_float(rr[1]); }
    merge_top16(l0, l1);
#pragma unroll
    for (int r = 0; r < 16; ++r) top[r] = l0[r];
}

template <bool FULL>
DI void topk_finish(const Params& P, int trow, int hh, LAS char* wlds, float (&A)[16], float (&B)[16]) {
    const int lane = tid_() & 63, hi = lane >> 5;
    const unsigned char* ws = P.ws;
    LAS unsigned* my = (LAS unsigned*)(wlds + lane * 32);
#pragma unroll
    for (int w = 0; w < 4; ++w) {
        my[w] = (__float_as_uint(A[4 * w]) & 127u) | ((__float_as_uint(A[4 * w + 1]) & 127u) << 8) | ((__float_as_uint(A[4 * w + 2]) & 127u) << 16) | ((__float_as_uint(A[4 * w + 3]) & 127u) << 24);
        my[4 + w] = (__float_as_uint(B[4 * w]) & 127u) | ((__float_as_uint(B[4 * w + 1]) & 127u) << 8) | ((__float_as_uint(B[4 * w + 2]) & 127u) << 16) | ((__float_as_uint(B[4 * w + 3]) & 127u) << 24);
    }
#pragma unroll
    for (int r = 0; r < 16; ++r) { A[r] = __uint_as_float(__float_as_uint(A[r]) & 0xFFFFFF80u); B[r] = __uint_as_float(__float_as_uint(B[r]) & 0xFFFFFF80u); }
    float T[16], R1[16], X[16], Y[16];
#pragma unroll
    for (int j = 0; j < 16; ++j) { T[j] = embed8(A[0] + B[j], (unsigned)j); R1[j] = (j < 8) ? embed8(A[1] + B[j], (unsigned)(16 + j)) : -INFINITY; }
#define CAND(i, j) embed8(A[i] + B[j], (unsigned)(16 * (i) + (j)))
    X[0] = CAND(2, 0); X[1] = CAND(2, 1); X[2] = CAND(2, 2); X[3] = CAND(2, 3); X[4] = CAND(2, 4); X[5] = CAND(3, 0); X[6] = CAND(3, 1); X[7] = CAND(3, 2);
    X[8] = CAND(3, 3); X[9] = CAND(4, 0); X[10] = CAND(4, 1); X[11] = CAND(4, 2); X[12] = CAND(5, 0); X[13] = CAND(5, 1); X[14] = CAND(6, 0); X[15] = CAND(6, 1);
    Y[0] = CAND(7, 0); Y[1] = CAND(7, 1); Y[2] = CAND(8, 0); Y[3] = CAND(9, 0); Y[4] = CAND(10, 0); Y[5] = CAND(11, 0); Y[6] = CAND(12, 0); Y[7] = CAND(13, 0);
    Y[8] = CAND(14, 0); Y[9] = CAND(15, 0); Y[10] = -INFINITY; Y[11] = -INFINITY; Y[12] = -INFINITY; Y[13] = -INFINITY; Y[14] = -INFINITY; Y[15] = -INFINITY;
#undef CAND
    bitonic_sort16(X); bitonic_sort16(Y);
    merge_top16(T, R1); merge_top16(T, X); merge_top16(T, Y);
    asm volatile("s_waitcnt lgkmcnt(0)" ::: "memory");
    float ssum = 0.f, e[16]; int eid[16];
    const float t0 = __uint_as_float(__float_as_uint(T[0]) & 0xFFFFFF00u);
#pragma unroll
    for (int r = 0; r < 16; ++r) {
        const unsigned bits = __float_as_uint(T[r]); const unsigned code = bits & 255u;
        e[r] = __expf(__uint_as_float(bits & 0xFFFFFF00u) - t0); ssum += e[r];
        const int ka = ((const LAS unsigned char*)my)[code >> 4], kb_ = ((const LAS unsigned char*)my)[16 + (code & 15u)];
        eid[r] = ka * 128 + kb_;
    }
    const float inv = __builtin_amdgcn_rcpf(ssum);
    typedef int i32x4 __attribute__((ext_vector_type(4)));
    if (FULL) {
        const size_t o = (size_t)trow * 128 + hh * 16;
        unsigned short* ei = (unsigned short*)(ws + WS_EIDX) + o; _Float16* eg = (_Float16*)(ws + WS_EGATE) + o;
        typedef _Float16 f16x8_t __attribute__((ext_vector_type(8)));
#pragma unroll
        for (int q = 0; q < 2; ++q)
            *(u32x4*)(ei + 8 * q) = (u32x4){(unsigned)eid[8 * q] | ((unsigned)eid[8 * q + 1] << 16), (unsigned)eid[8 * q + 2] | ((unsigned)eid[8 * q + 3] << 16), (unsigned)eid[8 * q + 4] | ((unsigned)eid[8 * q + 5] << 16), (unsigned)eid[8 * q + 6] | ((unsigned)eid[8 * q + 7] << 16)};
#pragma unroll
        for (int q = 0; q < 2; ++q) *(f16x8_t*)(eg + 8 * q) = (f16x8_t){(_Float16)(e[8 * q] * inv), (_Float16)(e[8 * q + 1] * inv), (_Float16)(e[8 * q + 2] * inv), (_Float16)(e[8 * q + 3] * inv), (_Float16)(e[8 * q + 4] * inv), (_Float16)(e[8 * q + 5] * inv), (_Float16)(e[8 * q + 6] * inv), (_Float16)(e[8 * q + 7] * inv)};
    } else {
        const size_t o = (size_t)trow * 128 + hh * 16 + 8 * hi;
        unsigned short* ei = (unsigned short*)(ws + WS_EIDX) + o; _Float16* eg = (_Float16*)(ws + WS_EGATE) + o;
        typedef _Float16 f16x8_t __attribute__((ext_vector_type(8)));
        i32x4 w0, w1; f32x4 g0, g1;
        const unsigned mh = 0u - (unsigned)hi;
#define SELU(a, b) ((((unsigned)(b)) & mh) | (((unsigned)(a)) & ~mh))
#pragma unroll
        for (int q = 0; q < 4; ++q) { w0[q] = (int)SELU(eid[q], eid[8 + q]); w1[q] = (int)SELU(eid[4 + q], eid[12 + q]);
            g0[q] = __uint_as_float(SELU(__float_as_uint(e[q]), __float_as_uint(e[8 + q]))) * inv; g1[q] = __uint_as_float(SELU(__float_as_uint(e[4 + q]), __float_as_uint(e[12 + q]))) * inv; }
#undef SELU
        *(u32x4*)ei = (u32x4){(unsigned)w0.x | ((unsigned)w0.y << 16), (unsigned)w0.z | ((unsigned)w0.w << 16), (unsigned)w1.x | ((unsigned)w1.y << 16), (unsigned)w1.z | ((unsigned)w1.w << 16)};
        *(f16x8_t*)eg = (f16x8_t){(_Float16)g0.x, (_Float16)g0.y, (_Float16)g0.z, (_Float16)g0.w, (_Float16)g1.x, (_Float16)g1.y, (_Float16)g1.z, (_Float16)g1.w};
    }
}
DI void topk_lists(const Params& P, int tb, int hh, const LAS char* skf, LAS char* qst, float (&A)[16], float (&B)[16]) {
    const int lane = tid_() & 63, hi = lane >> 5;
    const bf16_t* qrow = (const bf16_t*)(P.ws + WS_PQ) + (size_t)(32 * tb) * 2048 + hh * 256;
    topk_stage_q(qrow, qst, lane);
    topk_list(qst, skf, lane, hi, A);
    topk_stage_q(qrow + 128, qst, lane);
    topk_list(qst, skf + 32768, lane, hi, B);
}
DI void topk_wave_item(const Params& P, int tb, int hh, LAS char* wlds, const LAS char* skf, LAS char* qst) {
    float A[16], B[16];
    topk_lists(P, tb, hh, skf, qst, A, B);
    topk_finish<false>(P, 32 * tb + (tid_() & 31), hh, wlds, A, B);
}
DI void topk_wave_pair(const Params& P, int tb0, int tb1, int hh, LAS char* wlds, const LAS char* skf, LAS char* qst) {
    const int lane = tid_() & 63, hi = lane >> 5;
    float A[16], B[16];
    topk_lists(P, tb0, hh, skf, qst, A, B);
    { float A1[16], B1[16];
      topk_lists(P, tb1, hh, skf, qst, A1, B1);
#pragma unroll
      for (int r = 0; r < 16; ++r) { A[r] = hi ? A1[r] : A[r]; B[r] = hi ? B1[r] : B[r]; } }
    topk_finish<true>(P, 32 * (hi ? tb1 : tb0) + (lane & 31), hh, wlds, A, B);
}

DI void xn8_rows(const Params& P, int bid, int nblk);
DI void topk_phase(const Params& P, char* lds_g, int bid, int nblk) {
    const int tid = tid_(), wave = __builtin_amdgcn_readfirstlane(tid >> 6);
    LAS char* lds = (LAS char*)lds_g;
    LAS char* wlds = lds + wave * 2048;
    LAS char* skf = lds + 16384;
    static_assert(81920 + NWAVES * TQ_WAVE <= LDS_ITEM, "routing LDS map");
    int cur_h = -1; bool rows_done = false;
    for (int it = bid; it < (NTOK / 256) * 8; it += nblk) {
        const int hh = it & 7, tg = it >> 3;
        if (hh != cur_h) {
            __syncthreads();
#pragma unroll
            for (int i = 0; i < 8; ++i) {
                const int f = tid + 512 * i, l = f & 63, ks = (f >> 6) & 7, kb = (f >> 9) & 3, p = f >> 11;
                *(LAS u32x4*)(skf + f * 16) = *(const u32x4*)((const bf16_t*)(P.ws + WS_SKB) + (size_t)((hh * 2 + p) * 128 + 32 * kb + (l & 31)) * 128 + 16 * ks + 8 * (l >> 5));
            }
            __syncthreads();
            cur_h = hh;
        }
        if (wave >= 4 && !rows_done) { xn8_rows(P, bid, nblk); rows_done = true; }
        const int it2 = it + nblk;
        if (it2 < (NTOK / 256) * 8 && (it2 & 7) == hh) { topk_wave_pair(P, tg * 8 + wave, (it2 >> 3) * 8 + wave, hh, wlds, skf, lds + 81920 + wave * TQ_WAVE); it += nblk; }
        else topk_wave_item(P, tg * 8 + wave, hh, wlds, skf, lds + 81920 + wave * TQ_WAVE);
    }
    if (!rows_done) xn8_rows(P, bid, nblk);
}

DI float gelu_exact(float x) { return 0.5f * x * (1.f + erff(x * 0.70710678118654752f)); }
typedef __bf16 bf16x8_t __attribute__((ext_vector_type(8)));
DI float wave_sum_dpp(float v) {
    v = row16_sum(v);
    return (readlane_f(v, 0) + readlane_f(v, 16)) + (readlane_f(v, 32) + readlane_f(v, 48));
}

DI unsigned my_xcc_id() { return (unsigned)__builtin_amdgcn_s_getreg((3 << 11) | 20) & 7u; }
constexpr int CTL_G1 = 16, CTL_G2 = 32;

struct Xn8In { u32x4 ha, hb; float sq; };
DI void xn8_load(const unsigned char* ws, int n, int lane, Xn8In& I) {
    const bf16_t* hrow = (const bf16_t*)(ws + WS_XB) + (size_t)n * DM + 16 * lane;
    I.ha = *(const u32x4*)hrow; I.hb = *(const u32x4*)(hrow + 8); I.sq = ((const float*)(ws + WS_SSQ))[n];
}
DI void xn8_finish(unsigned char* ws, int n, int lane, const f32x4 (&wv)[4], const Xn8In& I) {
    const float r2 = __builtin_amdgcn_rsqf(I.sq * (1.f / DM) + EPS);
    const unsigned hu[8] = {I.ha.x, I.ha.y, I.ha.z, I.ha.w, I.hb.x, I.hb.y, I.hb.z, I.hb.w};
    f32x4 t[4]; float am = 0.f;
#pragma unroll
    for (int q = 0; q < 4; ++q) { t[q] = (f32x4){bf2f(hu[2 * q] & 0xffffu), bf2f(hu[2 * q] >> 16), bf2f(hu[2 * q + 1] & 0xffffu), bf2f(hu[2 * q + 1] >> 16)} * wv[q] * r2; am = fmaxf(am, fmaxf(fmaxf(fabsf(t[q].x), fabsf(t[q].y)), fmaxf(fabsf(t[q].z), fabsf(t[q].w)))); }
    am = row16_max(am); am = fmaxf(fmaxf(readlane_f(am, 0), readlane_f(am, 16)), fmaxf(readlane_f(am, 32), readlane_f(am, 48)));
    const float sc = (am > 0.f) ? exp2f(floorf(log2f(224.f / am))) : 1.f;
    int w[4];
#pragma unroll
    for (int q = 0; q < 4; ++q) { w[q] = __builtin_amdgcn_cvt_pk_fp8_f32(t[q].x * sc, t[q].y * sc, 0, false); w[q] = __builtin_amdgcn_cvt_pk_fp8_f32(t[q].z * sc, t[q].w * sc, w[q], true); }
    *(u32x4*)(ws + WS_XN8 + (size_t)n * DM + 16 * lane) = (u32x4){(unsigned)w[0], (unsigned)w[1], (unsigned)w[2], (unsigned)w[3]};
    if (lane == 0) ((float*)(ws + WS_XSC))[n] = 1.f / sc;
}
DI void xn8_rows(const Params& P, int bid, int nblk) {
    const int tid = tid_(), lane = tid & 63, wave = __builtin_amdgcn_readfirstlane(tid >> 6);
    unsigned char* ws = P.ws;
    const int gw = bid * NWAVES + wave, NGW = nblk * NWAVES;
    f32x4 wv[4];
#pragma unroll
    for (int q = 0; q < 4; ++q) wv[q] = *(const f32x4*)(P.ffn_norm_w + 16 * lane + 4 * q);
    Xn8In A, B;
    int n = gw;
    if (n < NTOK) xn8_load(ws, n, lane, A);
    while (n < NTOK) {
        if (n + NGW < NTOK) xn8_load(ws, n + NGW, lane, B);
        xn8_finish(ws, n, lane, wv, A);
        n += NGW; if (n >= NTOK) break;
        if (n + NGW < NTOK) xn8_load(ws, n + NGW, lane, A);
        xn8_finish(ws, n, lane, wv, B);
        n += NGW;
    }
}
typedef int i32x4 __attribute__((ext_vector_type(4)));
constexpr int SL_CHUNK = 512;
#define SB() __builtin_amdgcn_sched_barrier(0)
typedef long i64_t;
constexpr int MG_HALF = 8192, MG_WAVE = 2 * MG_HALF;
#define MG_WAIT(N) asm volatile("s_waitcnt vmcnt(" #N ")" ::: "memory")
struct MgMeta { i32x4 id[4]; u32x4 a0, a1, a2, a3; };
constexpr int MR_SLOT = 512, MR_WAVE = 4 * MR_SLOT, MR_BASE = NWAVES * MG_WAVE;
static_assert(MR_BASE + NWAVES * MR_WAVE <= LDS_ITEM, "meta ring fits under the control words");
template <int WHICH>
DI void mg_meta_dma2(const Params& P, int n, int x, unsigned slot_off) {
    const int lane = tid_() & 63, l32 = lane & 31;
    const int nt = n + 8 * (lane >> 5);
    const unsigned char* g = (l32 < 16) ? P.ws + WS_EIDX + (size_t)nt * 256 + l32 * 16
                           : (WHICH == 1 ? P.ws + WS_XN8 + (size_t)nt * DM + 256 * x + (l32 - 16) * 16 : P.ws + WS_C8 + (size_t)nt * 128 + (l32 - 16) * 16);
    if (l32 < (WHICH == 1 ? 32 : 24)) glds16_asm(g, slot_off);
}
template <int WHICH>
DI void mg_meta_read(const LAS char* sl, MgMeta& M) {
    const int lane = tid_() & 63, g8 = lane >> 3, kg = lane >> 4;
    const u32x4 ia = *(const LAS u32x4*)(sl + 16 * g8), ib = *(const LAS u32x4*)(sl + 128 + 16 * g8);
#define IDLO(w) (int)(((w) << 7) & 0x7fff80u)
#define IDHI(w) (int)(((w) >> 9) & 0x7fff80u)
    M.id[0] = (i32x4){IDLO(ia.x), IDHI(ia.x), IDLO(ia.y), IDHI(ia.y)}; M.id[1] = (i32x4){IDLO(ia.z), IDHI(ia.z), IDLO(ia.w), IDHI(ia.w)};
    M.id[2] = (i32x4){IDLO(ib.x), IDHI(ib.x), IDLO(ib.y), IDHI(ib.y)}; M.id[3] = (i32x4){IDLO(ib.z), IDHI(ib.z), IDLO(ib.w), IDHI(ib.w)};
#undef IDLO
#undef IDHI
    const LAS char* ar = sl + 256 + 16 * kg;
    M.a0 = *(const LAS u32x4*)ar; M.a1 = *(const LAS u32x4*)(ar + 64);
    if (WHICH == 1) { M.a2 = *(const LAS u32x4*)(ar + 128); M.a3 = *(const LAS u32x4*)(ar + 192); }
}
DI void mg_issue(const unsigned char* slice, const MgMeta& M, int h, unsigned lbase) {
    const int lane = tid_() & 63; const unsigned pos16 = (unsigned)(lane & 7) << 4;
    const i32x4 ia = M.id[2 * h], ib = M.id[2 * h + 1];
    const int ids[8] = {ia.x, ia.y, ia.z, ia.w, ib.x, ib.y, ib.z, ib.w};
#pragma unroll
    for (int p = 0; p < 8; ++p) glds16_sb((unsigned)ids[p] + (pos16 ^ (16u * p)), slice, lbase + p * 1024);
}
typedef int i32x8 __attribute__((ext_vector_type(8)));
DI float mg1_half(const MgMeta& M, LAS char* hb) {
    const int lane = tid_() & 63, c = lane & 15, kg = lane >> 4;
    const i32x8 A0 = (i32x8){(int)M.a0.x, (int)M.a0.y, (int)M.a0.z, (int)M.a0.w, (int)M.a1.x, (int)M.a1.y, (int)M.a1.z, (int)M.a1.w};
    const i32x8 A1 = (i32x8){(int)M.a2.x, (int)M.a2.y, (int)M.a2.z, (int)M.a2.w, (int)M.a3.x, (int)M.a3.y, (int)M.a3.z, (int)M.a3.w};
    f32x4 d[4];
#pragma unroll
    for (int G = 0; G < 4; ++G) {
        const LAS char* row = hb + (c & 7) * 1024 + (2 * G + (c >> 3)) * 128;
        const u32x4 b0 = *(const LAS u32x4*)(row + ((kg ^ (c & 7)) << 4)), b1 = *(const LAS u32x4*)(row + (((kg + 4) ^ (c & 7)) << 4));
        d[G] = (f32x4){0.f, 0.f, 0.f, 0.f};
        d[G] = __builtin_amdgcn_mfma_scale_f32_16x16x128_f8f6f4(A0, (i32x8){(int)b0.x, (int)b0.y, (int)b0.z, (int)b0.w, 0, 0, 0, 0}, d[G], 0, 4, 0, 0x7F7F7F7F, 0, 0x7F7F7F7F);
        d[G] = __builtin_amdgcn_mfma_scale_f32_16x16x128_f8f6f4(A1, (i32x8){(int)b1.x, (int)b1.y, (int)b1.z, (int)b1.w, 0, 0, 0, 0}, d[G], 0, 4, 0, 0x7F7F7F7F, 0, 0x7F7F7F7F);
    }
    asm volatile("s_nop 15\n\ts_nop 15" : "+v"(d[0]), "+v"(d[1]), "+v"(d[2]), "+v"(d[3]));
    const float r01 = (kg & 1) ? d[1][0] : d[0][0], r23 = (kg & 1) ? d[3][0] : d[2][0];
    return (kg & 2) ? r23 : r01;
}
typedef int v2i_t __attribute__((ext_vector_type(2)));
DI void mg2_half(const MgMeta& M, int h, LAS char* hb, f32x4 (&D)[8]) {
    const int lane = tid_() & 63, c = lane & 15, g = lane >> 4;
    const u32x4 ch = h ? M.a1 : M.a0;
    const LAS char* rb = hb + (c & 7) * 1024 + (4 * (g & 1) + (c >> 3)) * 128 + 8 * (g >> 1);
    const unsigned mlo = (c & 1) ? 0u : 0xFFFFFFFFu, mhi = ~mlo;
    const i32x8 A = (i32x8){(int)(ch.x & mlo), (int)(ch.y & mlo), (int)(ch.z & mlo), (int)(ch.w & mlo), (int)(ch.x & mhi), (int)(ch.y & mhi), (int)(ch.z & mhi), (int)(ch.w & mhi)};
#pragma unroll
    for (int t = 0; t < 8; ++t) {
        const v2i_t b0 = __builtin_amdgcn_ds_read_tr4_b64_v2i32((LAS v2i_t*)(rb + ((t ^ (c & 7)) << 4)));
        const v2i_t b1 = __builtin_amdgcn_ds_read_tr4_b64_v2i32((LAS v2i_t*)(rb + 256 + ((t ^ (c & 7)) << 4)));
        D[t] = __builtin_amdgcn_mfma_scale_f32_16x16x128_f8f6f4(A, (i32x8){b0.x, b0.y, b1.x, b1.y, 0, 0, 0, 0}, h ? D[t] : (f32x4){0.f, 0.f, 0.f, 0.f}, 0, 4, 0, 0x7F7F7F7F, 0, 0x7F7F7F7F);
    }
}
template <int WHICH>
DI void mg_group(const Params& P, const unsigned char* slice, int n0, int x, LAS char* wl, unsigned wl_off, const LAS char* mr, unsigned mr_off, bool more) {
    const int lane = tid_() & 63, kg = lane >> 4, c = lane & 15;
    bf16_t* outp = (bf16_t*)(P.ws + WS_HIDP) + (size_t)x * NTOK * (WHICH == 1 ? 128 : 256);
    f32x4 D[8];
    MgMeta M[4];
#pragma unroll
    for (int q_ = 0; q_ < 4; ++q_) mg_meta_read<WHICH>(mr + q_ * MR_SLOT, M[q_]);
    SB();
    mg_issue(slice, M[0], 0, wl_off); SB();
#define MG_STEP(h, WAITSTMT) do { \
        if ((h) + 1 < 8) { mg_issue(slice, M[((h) + 1) >> 1], ((h) + 1) & 1, wl_off + (((h) + 1) & 1) * MG_HALF); } \
        if ((h) == 3 && more) { mg_meta_dma2<WHICH>(P, n0 + 32, x, mr_off); mg_meta_dma2<WHICH>(P, n0 + 48, x, mr_off + 2 * MR_SLOT); }     \
        SB(); WAITSTMT; SB(); \
        LAS char* hb_ = wl + ((h) & 1) * MG_HALF; const int n_ = n0 + 8 * ((h) >> 1); \
        if (WHICH == 1) { const float r_ = mg1_half(M[(h) >> 1], hb_); outp[(size_t)n_ * 128 + 64 * ((h) & 1) + lane] = (bf16_t)f2bf(r_); } \
        else { \
            mg2_half(M[(h) >> 1], (h) & 1, hb_, D); \
            if ((h) & 1) { asm volatile("s_nop 15\n\ts_nop 15" : "+v"(D[0]), "+v"(D[1]), "+v"(D[2]), "+v"(D[3]), "+v"(D[4]), "+v"(D[5]), "+v"(D[6]), "+v"(D[7])); \
                float v0_ = 0.f, v1_ = 0.f, v2_ = 0.f, v3_ = 0.f; _Pragma("unroll") for (int q_ = 0; q_ < 4; ++q_) { if (kg == q_) { v0_ = D[q_][0]; v1_ = D[q_][1]; v2_ = D[q_ + 4][0]; v3_ = D[q_ + 4][1]; } } \
                bf16_t* o_ = outp + (size_t)n_ * 256 + 32 * kg + c; const unsigned w01_ = cvtpk(v0_, v1_), w23_ = cvtpk(v2_, v3_); o_[0] = (bf16_t)(w01_ & 0xffffu); o_[16] = (bf16_t)(w01_ >> 16); o_[128] = (bf16_t)(w23_ & 0xffffu); o_[144] = (bf16_t)(w23_ >> 16); } } \
        SB(); } while (0)
    if (WHICH == 1) {
        MG_STEP(0, MG_WAIT(8)); MG_STEP(1, MG_WAIT(9)); MG_STEP(2, MG_WAIT(9));
        if (more) { MG_STEP(3, MG_WAIT(11)); MG_STEP(4, MG_WAIT(11)); } else { MG_STEP(3, MG_WAIT(9)); MG_STEP(4, MG_WAIT(9)); }
        MG_STEP(5, MG_WAIT(9)); MG_STEP(6, MG_WAIT(9)); MG_STEP(7, MG_WAIT(1));
    } else {
        MG_STEP(0, MG_WAIT(8)); MG_STEP(1, MG_WAIT(8)); MG_STEP(2, MG_WAIT(12));
        if (more) { MG_STEP(3, MG_WAIT(10)); MG_STEP(4, MG_WAIT(14)); } else { MG_STEP(3, MG_WAIT(8)); MG_STEP(4, MG_WAIT(12)); }
        MG_STEP(5, MG_WAIT(8)); MG_STEP(6, MG_WAIT(12)); MG_STEP(7, MG_WAIT(0));
    }
#undef MG_STEP
}
template <int WHICH>
DI void mg_phase(const Params& P, char* lds_g) {
    const int tid = tid_(), wave = __builtin_amdgcn_readfirstlane(tid >> 6);
    unsigned* ctr = (unsigned*)(P.ws + WS_CTL) + (WHICH == 1 ? CTL_G1 : CTL_G2);
    const int x0 = (int)my_xcc_id();
    LAS int* slot = (LAS int*)((LAS char*)lds_g + LDS_ITEM);
    LAS char* wl = (LAS char*)lds_g + wave * MG_WAVE;
    const unsigned wl_off = (unsigned)__builtin_amdgcn_readfirstlane((int)(unsigned)(size_t)wl);
    const LAS char* mr = (const LAS char*)lds_g + MR_BASE + wave * MR_WAVE;
    const unsigned mr_off = (unsigned)__builtin_amdgcn_readfirstlane((int)(unsigned)(size_t)mr);
    constexpr int NSL = 4;
    bool first = true;
    for (int s = 0; s < NSL; ++s) {
        const int x = (x0 + s) & (NSL - 1);
        const unsigned char* slice = P.ws + (WHICH == 1 ? WS_UB : WS_VB) + (size_t)x * ((size_t)NEXP * 128);
        for (;;) {
            if (tid == 0 && first) *slot = (int)atomicAdd(ctr + x, 1u);
            if (tid == 0 && !first) {
                const unsigned c0 = __hip_atomic_load(ctr + 0, __ATOMIC_RELAXED, __HIP_MEMORY_SCOPE_AGENT), c1 = __hip_atomic_load(ctr + 1, __ATOMIC_RELAXED, __HIP_MEMORY_SCOPE_AGENT),
                               c2 = __hip_atomic_load(ctr + 2, __ATOMIC_RELAXED, __HIP_MEMORY_SCOPE_AGENT), c3 = __hip_atomic_load(ctr + 3, __ATOMIC_RELAXED, __HIP_MEMORY_SCOPE_AGENT);
                constexpr unsigned LIM = NTOK / SL_CHUNK;
                const unsigned mine = (x == 0) ? c0 : (x == 1) ? c1 : (x == 2) ? c2 : c3;
                int t = (int)LIM;
                if (c0 >= LIM && c1 >= LIM && c2 >= LIM && c3 >= LIM) t = -1;
                else if (mine < LIM) t = (int)atomicAdd(ctr + x, 1u);
                *slot = t; }
            first = false;
            __syncthreads();
            const int chunk = *slot;
            __syncthreads();
            if (chunk < 0) return;
            if (chunk >= NTOK / SL_CHUNK) break;
            const int nb = chunk * SL_CHUNK + wave;
            mg_meta_dma2<WHICH>(P, nb, x, mr_off); mg_meta_dma2<WHICH>(P, nb + 16, x, mr_off + 2 * MR_SLOT);
            MG_WAIT(0);
            for (int g = 0; g < SL_CHUNK / 32; ++g) mg_group<WHICH>(P, slice, nb + 32 * g, x, wl, wl_off, mr, mr_off, g + 1 < SL_CHUNK / 32);
            MG_WAIT(0);
        }
    }
}
typedef int i32x2_t __attribute__((ext_vector_type(2)));
struct RedIn { u32x4 hp[4]; u32x4 g, e; float xs; };
DI void red_load(const unsigned char* ws, int n4, int lane, RedIn& R) {
    const int n = n4 + (lane >> 4), j = lane & 15;
    const bf16_t* hp = (const bf16_t*)(ws + WS_HIDP);
    R.xs = ((const float*)(ws + WS_XSC))[n];
    const size_t o = (size_t)n * 128 + 8 * j;
    R.g = *(const u32x4*)((const _Float16*)(ws + WS_EGATE) + o);
    R.e = *(const u32x4*)((const unsigned short*)(ws + WS_EIDX) + o);
#pragma unroll
    for (int x = 0; x < 4; ++x) R.hp[x] = *(const u32x4*)(hp + (size_t)x * NTOK * 128 + o);
}
DI void red_finish(unsigned char* ws, const LAS f32x2* tab, int n4, int lane, const RedIn& R) {
    const int n = n4 + (lane >> 4), j = lane & 15;
    float c[8]; float m = 0.f;
#pragma unroll
    for (int i = 0; i < 4; ++i) {
        const unsigned ew = R.e[i];
        const f32x2 r0 = tab[ew & 0xffffu], r1 = tab[ew >> 16];
        float a0 = 0.f, a1 = 0.f;
#pragma unroll
        for (int x = 0; x < 4; ++x) { const unsigned w = R.hp[x][i]; a0 += bf2f(w & 0xffffu); a1 += bf2f(w >> 16); }
        const unsigned gw_ = R.g[i];
        const float ga = (float)__builtin_bit_cast(_Float16, (unsigned short)(gw_ & 0xffffu)), gb = (float)__builtin_bit_cast(_Float16, (unsigned short)(gw_ >> 16));
        c[2 * i] = gelu_exact(a0 * r0.x * R.xs) * ga * r0.y; c[2 * i + 1] = gelu_exact(a1 * r1.x * R.xs) * gb * r1.y;
        m = fmaxf(m, fmaxf(fabsf(c[2 * i]), fabsf(c[2 * i + 1])));
    }
    m = row16_max(m);
    const float sc = (m > 0.f) ? exp2f(floorf(log2f(224.f / m))) : 1.f;
    int w0 = __builtin_amdgcn_cvt_pk_fp8_f32(c[0] * sc, c[1] * sc, 0, false); w0 = __builtin_amdgcn_cvt_pk_fp8_f32(c[2] * sc, c[3] * sc, w0, true);
    int w1 = __builtin_amdgcn_cvt_pk_fp8_f32(c[4] * sc, c[5] * sc, 0, false); w1 = __builtin_amdgcn_cvt_pk_fp8_f32(c[6] * sc, c[7] * sc, w1, true);
    *(u32x2*)(ws + WS_C8 + (size_t)n * 128 + 8 * j) = (u32x2){(unsigned)w0, (unsigned)w1};
    if (j == 0) ((float*)(ws + WS_CSC))[n] = 1.f / sc;
}
DI void hid_reduce8_phase(const Params& P, char* lds_g, int bid, int nblk) {
    const int tid = tid_(), lane = tid & 63, wave = __builtin_amdgcn_readfirstlane(tid >> 6);
    unsigned char* ws = P.ws;
    const int gw = bid * NWAVES + wave, NGW = nblk * NWAVES;
    LAS f32x2* tab = (LAS f32x2*)lds_g;
    static_assert(NEXP * 8 <= LDS_ITEM, "scale table fits in LDS");
    static_assert(NTOK % 4 == 0, "token quads");
    RedIn A, B;
    int n = 4 * gw; const int NS = 4 * NGW;
    if (n < NTOK) red_load(ws, n, lane, A);
#pragma unroll 4
    for (int i = tid; i < NEXP * 8 / 16; i += NTHREADS) ((LAS u32x4*)lds_g)[i] = ((const u32x4*)(ws + WS_USC))[i];
    __syncthreads();
    while (n < NTOK) {
        if (n + NS < NTOK) red_load(ws, n + NS, lane, B);
        red_finish(ws, tab, n, lane, A);
        n += NS; if (n >= NTOK) break;
        if (n + NS < NTOK) red_load(ws, n + NS, lane, A);
        red_finish(ws, tab, n, lane, B);
        n += NS;
    }
    __syncthreads();
}
struct FinIn { u32x4 ya, yb, ha, hb; float cs; };
DI void fin_load(const unsigned char* ws, int n, int lane, FinIn& I) {
    const bf16_t* yrow = (const bf16_t*)(ws + WS_HIDP) + ((size_t)(lane >> 4) * NTOK + n) * 256 + 16 * (lane & 15);
    I.ya = *(const u32x4*)yrow; I.yb = *(const u32x4*)(yrow + 8);
    I.cs = ((const float*)(ws + WS_CSC))[n];
    const bf16_t* hrow = (const bf16_t*)(ws + WS_XB) + (size_t)n * DM + 16 * lane;
    I.ha = *(const u32x4*)hrow; I.hb = *(const u32x4*)(hrow + 8);
}
DI void fin_finish(const Params& P, int n, int lane, const f32x4 (&wv)[4], const FinIn& I) {
    float* orow = P.out + (size_t)n * DM + 16 * lane;
    const unsigned yu[8] = {I.ya.x, I.ya.y, I.ya.z, I.ya.w, I.yb.x, I.yb.y, I.yb.z, I.yb.w};
    const unsigned hu[8] = {I.ha.x, I.ha.y, I.ha.z, I.ha.w, I.hb.x, I.hb.y, I.hb.z, I.hb.w};
    const float cs = I.cs;
    f32x4 h[4]; float ss = 0.f;
#pragma unroll
    for (int q = 0; q < 4; ++q) { h[q] = (f32x4){bf2f(hu[2 * q] & 0xffffu), bf2f(hu[2 * q] >> 16), bf2f(hu[2 * q + 1] & 0xffffu), bf2f(hu[2 * q + 1] >> 16)} + (f32x4){bf2f(yu[2 * q] & 0xffffu), bf2f(yu[2 * q] >> 16), bf2f(yu[2 * q + 1] & 0xffffu), bf2f(yu[2 * q + 1] >> 16)} * cs; ss += (h[q].x * h[q].x + h[q].y * h[q].y) + (h[q].z * h[q].z + h[q].w * h[q].w); }
    ss = wave_sum_dpp(ss);
    const float rs = __builtin_amdgcn_rsqf(ss * (1.f / DM) + EPS);
#pragma unroll
    for (int q = 0; q < 4; ++q) *(f32x4*)(orow + 4 * q) = h[q] * wv[q] * rs;
}
DI void final_norm8_phase(const Params& P, int bid, int nblk) {
    const int tid = tid_(), lane = tid & 63, wave = __builtin_amdgcn_readfirstlane(tid >> 6);
    const unsigned char* ws = P.ws;
    const int gw = bid * NWAVES + wave, NGW = nblk * NWAVES;
    f32x4 wv[4];
#pragma unroll
    for (int q = 0; q < 4; ++q) wv[q] = *(const f32x4*)(P.final_w + 16 * lane + 4 * q);
    FinIn A, B;
    int n = gw;
    if (n < NTOK) fin_load(ws, n, lane, A);
    while (n < NTOK) {
        if (n + NGW < NTOK) fin_load(ws, n + NGW, lane, B);
        fin_finish(P, n, lane, wv, A);
        n += NGW; if (n >= NTOK) break;
        if (n + NGW < NTOK) fin_load(ws, n + NGW, lane, A);
        fin_finish(P, n, lane, wv, B);
        n += NGW;
    }
}

#define XB_TMO      128
#define XB_XCNT(j)  (256  + 64 * (j))
#define XB_XSUB(j)  (1280 + 64 * (j))
#define XB_XGEN(j)  (2304 + 64 * (j))
#define XB_TOP      3328
#define XB_TOPGEN   3392
#define XCD_BAR_WORDS 3456
#define XB_SPIN_CAP (1u << 18)

__device__ __forceinline__ unsigned xb_ld(unsigned* p)              { return __hip_atomic_load(p, __ATOMIC_RELAXED, __HIP_MEMORY_SCOPE_AGENT); }
__device__ __forceinline__ unsigned xb_add(unsigned* p, unsigned v) { return __hip_atomic_fetch_add(p, v, __ATOMIC_RELAXED, __HIP_MEMORY_SCOPE_AGENT); }
__device__ __forceinline__ unsigned xb_xcc_id() { return (unsigned)__builtin_amdgcn_s_getreg((3 << 11) | 20) & 0xFu; }
#define XB_SPIN(cond, bar) do { unsigned _sp = 0; while (cond) { __builtin_amdgcn_s_sleep(1); \
    if ((++_sp & 255u) == 0u) { if (xb_ld(&(bar)[XB_TMO])) break; if (_sp > XB_SPIN_CAP) { atomicAdd(&(bar)[XB_TMO], 1u); break; } } } } while (0)

struct XcdBarrier {
    unsigned* bar; unsigned x;
    volatile LAS unsigned* st;
};

__device__ __forceinline__ XcdBarrier xcd_barrier_post(unsigned* bar, volatile LAS unsigned* st) {
    XcdBarrier b; b.bar = bar; b.x = xb_xcc_id(); b.st = st;
    if (threadIdx.x == 0) (void)xb_add(&bar[XB_XCNT(b.x)], 1u);
    return b;
}
__device__ __forceinline__ void xcd_barrier_complete(unsigned* bar, unsigned x, unsigned& nloc, unsigned& nx) {
    const unsigned G = gridDim.x * gridDim.y * gridDim.z;
    unsigned sum, cnt, mine, sp = 0u;
    for (;;) {
        sum = 0u; cnt = 0u; mine = 0u;
#pragma unroll
        for (unsigned j = 0; j < 16; ++j) { const unsigned c = xb_ld(&bar[XB_XCNT(j)]); sum += c; cnt += (c > 0u) ? 1u : 0u; mine = (j == x) ? c : mine; }
        if (sum == G) break;
        __builtin_amdgcn_s_sleep(1);
        if ((++sp & 255u) == 0u) { if (xb_ld(&bar[XB_TMO])) break; if (sp > XB_SPIN_CAP) { atomicAdd(&bar[XB_TMO], 1u); break; } }
    }
    nloc = mine > 0u ? mine : 1u; nx = cnt > 0u ? cnt : 1u;
}

__device__ __forceinline__ void xcd_barrier(const XcdBarrier& b) {
    asm volatile("s_waitcnt vmcnt(0)" ::: "memory");
    __syncthreads();
    if (threadIdx.x == 0) {
        unsigned* bar = b.bar;
        __builtin_amdgcn_s_waitcnt(0);
        unsigned nloc = b.st[0], nx = b.st[1];
        if (nloc == 0u) { xcd_barrier_complete(bar, b.x, nloc, nx); b.st[0] = nloc; b.st[1] = nx; }
        const unsigned old = xb_add(&bar[XB_XSUB(b.x)], 1u);
        const unsigned gen = old / nloc;
        if (old + 1u == (gen + 1u) * nloc) {
            __builtin_amdgcn_fence(__ATOMIC_RELEASE, "agent");
            asm volatile("s_waitcnt vmcnt(0)" ::: "memory");
            const unsigned og = xb_add(&bar[XB_TOP], 1u);
            const unsigned tg = og / nx;
            if (og + 1u == (tg + 1u) * nx) xb_add(&bar[XB_TOPGEN], 1u);
            else XB_SPIN(xb_ld(&bar[XB_TOPGEN]) == tg, bar);
            __builtin_amdgcn_fence(__ATOMIC_ACQUIRE, "agent");
            xb_add(&bar[XB_XGEN(b.x)], 1u);
            asm volatile("s_waitcnt vmcnt(0)" ::: "memory");
        } else {
            XB_SPIN(xb_ld(&bar[XB_XGEN(b.x)]) == gen, bar);
            __builtin_amdgcn_fence(__ATOMIC_ACQUIRE, "agent");
            asm volatile("s_waitcnt vmcnt(0)" ::: "memory");
        }
    }
    __syncthreads();
}

constexpr int CTL_XB_WORD = 2048;
static_assert((CTL_XB_WORD + 3456) * 4 <= (int)CTL_BYTES, "barrier words inside CTL");
constexpr int N_HGRN_ITEMS = BATCH * 4, N_ATT_ITEMS = BATCH * 4 * 32;

DI void mixer_phase(const Params& P, char* lds) {
    unsigned* ctr = (unsigned*)(P.ws + WS_CTL);
    for (;;) {
        if (tid_() == 0) *(LAS int*)((LAS char*)lds + LDS_ITEM) = (int)atomicAdd(ctr, 1u);
        __syncthreads();
        const int item = *(LAS int*)((LAS char*)lds + LDS_ITEM);
        __syncthreads();
        if (item >= N_HGRN_ITEMS + N_ATT_ITEMS) break;
        if (item < N_HGRN_ITEMS) hgrn_unit(P, item >> 2, item & 3, lds);
        else { const int a = item - N_HGRN_ITEMS, j = 31 - (a >> 5), bh = a & 31; attn_unit(P, bh >> 2, bh & 3, j, lds); }
    }
}

#ifdef TS_PHASE
#ifndef TS_DIV
#define TS_DIV 4.0f
#endif
#ifndef TS_OFF
#define TS_OFF 0.0f
#endif
#define TS(i) do { if (blockIdx.x == 0 && threadIdx.x == 0) ((LAS unsigned long long*)((LAS char*)lds + LDS_BYTES - 512))[i] = __builtin_amdgcn_s_memrealtime(); } while (0)
#else
#define TS(i) do { } while (0)
#endif
__global__ void __launch_bounds__(NTHREADS, 2) fwd_megakernel(Params P) {
    extern __shared__ __attribute__((aligned(16))) char lds[];
    const int bid = blockIdx.x, nblk = gridDim.x;
    unsigned char* ws = P.ws;
    volatile LAS unsigned* xst = (volatile LAS unsigned*)((LAS char*)lds + LDS_XB);
    if (threadIdx.x < 4) xst[threadIdx.x] = 0u;
    __syncthreads();
    const XcdBarrier xbar = xcd_barrier_post((unsigned*)(ws + WS_CTL) + CTL_XB_WORD, xst);
    TS(0);
    phase0(P, lds, bid, nblk);
    xcd_barrier(xbar);
    TS(1);
    { Epi1 e{ws}; gemm_run(lds, (const bf16_t*)(ws + WS_XB), (const bf16_t*)(ws + WS_W1T), M1, NCOL1, DM, e, bid, nblk); }
    {
        constexpr int NUNITS = (M1 / 256) * (NCOL1 / 256);
        const int nlast = NUNITS % nblk, nfree = nlast ? nblk - nlast : nblk;
        const int wave = __builtin_amdgcn_readfirstlane(tid_() >> 6);
        if (nlast == 0 || bid >= nlast) table_fp8_rows(P, TAB_P0_ROWS + (bid - (nlast ? nlast : 0)) * NWAVES + wave, nfree * NWAVES, 2 * NEXP);
    }
    xcd_barrier(xbar);
    TS(2);
    hgrn_prep_phase(P, lds, bid, nblk);
    xcd_barrier(xbar);
    TS(3);
    mixer_phase(P, lds);
    xcd_barrier(xbar);
    TS(4);
    { Epi3 e{P.x, P.out, (bf16_t*)(ws + WS_XB), (float*)(ws + WS_SSQ)}; gemm_run(lds, (const bf16_t*)(ws + WS_MIX), (const bf16_t*)(ws + WS_W2T), NTOK, DM, DM, e, bid, nblk); }
    xcd_barrier(xbar);
    TS(5);
    { Epi4 e{(const float*)(ws + WS_SSQ), (bf16_t*)(ws + WS_PQ)}; gemm_run(lds, (const bf16_t*)(ws + WS_XB), (const bf16_t*)(ws + WS_W3T), NTOK, 2048, DM, e, bid, nblk); }
    xcd_barrier(xbar);
    TS(6);
    topk_phase(P, lds, bid, nblk);
    xcd_barrier(xbar);
    TS(7);
    mg_phase<1>(P, lds);
    xcd_barrier(xbar);
    TS(8);
    hid_reduce8_phase(P, lds, bid, nblk);
    xcd_barrier(xbar);
    TS(9);
    mg_phase<2>(P, lds);
    xcd_barrier(xbar);
    TS(10);
    final_norm8_phase(P, bid, nblk);
    TS(11);
#ifdef TS_PHASE
    if (blockIdx.x == 0 && threadIdx.x == 0) { const LAS unsigned long long* t = (const LAS unsigned long long*)((LAS char*)lds + LDS_BYTES - 512);
        P.out[0] += ((float)(t[TS_PHASE + 1] - t[TS_PHASE]) * 0.01f - TS_OFF) / TS_DIV; }
#endif
}

extern "C" void kernel_launch(void* const* d_in, const int* in_sizes, int n_in, void* d_out, int out_size, void* d_ws, size_t ws_size, hipStream_t stream) {
    static int grid = 0;
    if (grid == 0) {
        int dev = 0, cus = 0, per_cu = 0;
        (void)hipGetDevice(&dev);
        (void)hipDeviceGetAttribute(&cus, hipDeviceAttributeMultiprocessorCount, dev);
        (void)hipFuncSetAttribute((const void*)fwd_megakernel, hipFuncAttributeMaxDynamicSharedMemorySize, LDS_BYTES);
        (void)hipOccupancyMaxActiveBlocksPerMultiprocessor(&per_cu, (const void*)fwd_megakernel, NTHREADS, LDS_BYTES);
        if (per_cu < 1) { fprintf(stderr, "kernel_launch: occupancy query says %d blocks per CU\n", per_cu); per_cu = 1; }
        grid = cus * 1;
        if (ws_size < WS_END) { fprintf(stderr, "kernel_launch: workspace too small: %zu < %zu\n", ws_size, (size_t)WS_END); grid = -1; }
    }
    if (grid < 0) return;
    Params p{};
    p.x = (const float*)d_in[0]; p.meta = (const float*)d_in[1]; p.mix_norm_w = (const float*)d_in[2]; p.w_in = (const float*)d_in[3];
    p.lb_logits = (const float*)d_in[4]; p.rec_norm_w = (const float*)d_in[5]; p.lq1 = (const float*)d_in[6]; p.lk1 = (const float*)d_in[7];
    p.lq2 = (const float*)d_in[8]; p.lk2 = (const float*)d_in[9]; p.subln_w = (const float*)d_in[10]; p.w_out = (const float*)d_in[11];
    p.ffn_norm_w = (const float*)d_in[12]; p.wq = (const float*)d_in[13]; p.subkeys = (const float*)d_in[14]; p.pu = (const float*)d_in[15];
    p.pv = (const float*)d_in[16]; p.final_w = (const float*)d_in[17];
    p.out = (float*)d_out; p.ws = (unsigned char*)d_ws;
    (void)hipMemsetAsync((char*)d_ws + WS_CTL, 0, CTL_BYTES, stream);
    void* args[] = {&p};
    hipError_t e = hipLaunchCooperativeKernel((const void*)fwd_megakernel, dim3(grid), dim3(NTHREADS), args, LDS_BYTES, stream);
    if (e != hipSuccess) fprintf(stderr, "cooperative launch failed: %s (grid %d)\n", hipGetErrorString(e), grid);
}
```
